# Optimizing an MI355X kernel written in HIP

```python
import math
import jax, jax.numpy as jnp
from jax import lax
import numpy as np


D_MODEL = 1024
BATCH = 16
SEQ = 2048
DEPTH = 1

D_MIX = D_MODEL
D_LRU = D_MIX // 2
N_LRU_BLOCKS = 8
LRU_BLOCK = D_LRU // N_LRU_BLOCKS
CONV_WIDTH = 4
RG_C = 8.0
N_HEADS = 8
HEAD_DIM = (D_MIX - D_LRU) // N_HEADS
D_ATTN = N_HEADS * HEAD_DIM
ROT_DIM = HEAD_DIM // 4
ROPE_THETA = 500000.0
MOBA_BLOCK = 256
MOBA_TOPK = 3
Q_CHUNK = 8
MEM_LEN = 256
N_XHEADS = 4
XHEAD_DIM = D_MODEL // N_XHEADS
N_GROUPS = 4
EXPERTS_PER_GROUP = 8
N_EXPERTS = N_GROUPS * EXPERTS_PER_GROUP
EXPERT_TOPK = 2
D_FF_EXPERT = D_MODEL // 2
MOE_ROWS = 128
D_IN = 2 * D_LRU + 3 * D_ATTN
EPS = 1e-6

kernel_name = 'hymba_rglru_moba_hmoe_block'


def rms_norm(x, g):
    xf = x.astype(jnp.float32)
    y = xf * lax.rsqrt(jnp.mean(xf * xf, axis=-1, keepdims=True) + EPS)
    return (y * g.astype(jnp.float32)).astype(x.dtype)


def partial_rope(x, pos):
    half = ROT_DIM // 2
    inv_freq = ROPE_THETA ** (-jnp.arange(0, ROT_DIM, 2, dtype=jnp.float32) / ROT_DIM)
    ang = pos.astype(jnp.float32)[:, None] * inv_freq[None, :]
    cos, sin = jnp.cos(ang), jnp.sin(ang)
    xf = x.astype(jnp.float32)
    x1, x2, rest = xf[..., :half], xf[..., half:ROT_DIM], xf[..., ROT_DIM:]
    out = jnp.concatenate([x1 * cos - x2 * sin, x2 * cos + x1 * sin, rest], axis=-1)
    return out.astype(x.dtype)


def causal_depthwise_conv(x, w, b):
    C = x.shape[-1]
    y = lax.conv_general_dilated(x, w[:, None, :].astype(x.dtype), window_strides=(1,),
                                 padding=[(CONV_WIDTH - 1, 0)],
                                 dimension_numbers=('NWC', 'WIO', 'NWC'),
                                 feature_group_count=C)
    return y + b


def rg_lru(xc, w_rg, b_rg, w_ig, b_ig, lru_lambda):
    B, S, C = xc.shape
    xh = xc.reshape(B, S, N_LRU_BLOCKS, LRU_BLOCK)
    r = jax.nn.sigmoid((jnp.einsum('bshi,hij->bshj', xh, w_rg).reshape(B, S, C) + b_rg).astype(jnp.float32))
    i = jax.nn.sigmoid((jnp.einsum('bshi,hij->bshj', xh, w_ig).reshape(B, S, C) + b_ig).astype(jnp.float32))
    log_a = -RG_C * r * jax.nn.softplus(-lru_lambda.astype(jnp.float32))
    a = jnp.exp(log_a)
    u = jnp.sqrt(-jnp.expm1(2.0 * log_a)) * (i * xc.astype(jnp.float32))

    def step(h, au):
        a_t, u_t = au
        h = a_t * h + u_t
        return h, h

    _, hs = lax.scan(step, jnp.zeros((B, C), jnp.float32), (jnp.swapaxes(a, 0, 1), jnp.swapaxes(u, 0, 1)))
    return jnp.swapaxes(hs, 0, 1).astype(xc.dtype)


def moba_attention(q, k, v):
    B, H, S, hd = q.shape
    nb = -(-S // MOBA_BLOCK)
    sp = nb * MOBA_BLOCK
    pad = ((0, 0), (0, 0), (0, sp - S), (0, 0))
    q, k, v = jnp.pad(q, pad), jnp.pad(k, pad), jnp.pad(v, pad)
    kb = k.reshape(B, H, nb, MOBA_BLOCK, hd)
    vb = v.reshape(B, H, nb, MOBA_BLOCK, hd)
    kmean = jnp.mean(kb.astype(jnp.float32), axis=3)
    pos = jnp.arange(sp, dtype=jnp.int32)
    qblk = pos // MOBA_BLOCK
    gate = jnp.einsum('bhsd,bhnd->bhsn', q.astype(jnp.float32), kmean)
    past = jnp.arange(nb, dtype=jnp.int32)[None, :] < qblk[:, None]
    gate = jnp.where(past, gate, -jnp.inf)
    n_pick = min(MOBA_TOPK, nb)
    _, top = lax.top_k(gate, n_pick)
    top = top.astype(jnp.int32)
    top_valid = top < qblk[:, None]
    own = jnp.broadcast_to(qblk[:, None], (B, H, sp, 1))
    idx = jnp.concatenate([top, own], axis=-1)
    valid = jnp.concatenate([top_valid, jnp.ones_like(own, dtype=bool)], axis=-1)
    nsel = n_pick + 1
    nc = sp // Q_CHUNK
    kflat = kb.reshape(B * H * nb, MOBA_BLOCK, hd)
    vflat = vb.reshape(B * H * nb, MOBA_BLOCK, hd)
    bh_off = (jnp.arange(B * H, dtype=jnp.int32) * nb).reshape(B, H, 1, 1)
    scale = HEAD_DIM ** -0.5

    def to_chunks(t):
        return jnp.moveaxis(t.reshape(B, H, nc, Q_CHUNK, *t.shape[3:]), 2, 0)

    def attend(args):
        q_c, idx_c, valid_c, t_c = args
        gidx = bh_off + idx_c
        kg = kflat[gidx]
        vg = vflat[gidx]
        s = jnp.einsum('bhqd,bhqnkd->bhqnk', q_c, kg).astype(jnp.float32) * scale
        keypos = idx_c[..., None] * MOBA_BLOCK + jnp.arange(MOBA_BLOCK, dtype=jnp.int32)
        mask = valid_c[..., None] & (keypos <= t_c[None, None, :, None, None])
        s = jnp.where(mask, s, -jnp.inf).reshape(B, H, Q_CHUNK, nsel * MOBA_BLOCK)
        p = jax.nn.softmax(s, axis=-1).astype(vg.dtype)
        return jnp.einsum('bhqm,bhqmd->bhqd', p, vg.reshape(B, H, Q_CHUNK, nsel * MOBA_BLOCK, hd))

    out = lax.map(attend, (to_chunks(q), to_chunks(idx), to_chunks(valid), pos.reshape(nc, Q_CHUNK)))
    out = jnp.moveaxis(out, 0, 2).reshape(B, H, sp, hd)
    return out[:, :, :S]


def hybrid_mixer(xn, w_in, conv_w, conv_b, w_rg, b_rg, w_ig, b_ig, lru_lambda,
                 norm_lru_out, norm_attn_out, w_out):
    B, S, _ = xn.shape
    proj = xn @ w_in
    x_lru, g_lru, q, k, v = jnp.split(
        proj, [D_LRU, 2 * D_LRU, 2 * D_LRU + D_ATTN, 2 * D_LRU + 2 * D_ATTN], axis=-1)
    xc = causal_depthwise_conv(x_lru, conv_w, conv_b)
    y_lru = rg_lru(xc, w_rg, b_rg, w_ig, b_ig, lru_lambda) * jax.nn.gelu(g_lru)
    pos = jnp.arange(S, dtype=jnp.int32)
    heads = lambda t: t.reshape(B, S, N_HEADS, HEAD_DIM).transpose(0, 2, 1, 3)
    qh = partial_rope(heads(q), pos)
    kh = partial_rope(heads(k), pos)
    y_att = moba_attention(qh, kh, heads(v)).transpose(0, 2, 1, 3).reshape(B, S, D_ATTN)
    y = jnp.concatenate([rms_norm(y_lru, norm_lru_out), rms_norm(y_att, norm_attn_out)], axis=-1)
    return y @ w_out


def memory_cross_attention(hn, mem, norm_mem, w_xq, w_xkv, w_xo):
    B, S, _ = hn.shape
    M = mem.shape[1]
    q = (hn @ w_xq).reshape(B, S, N_XHEADS, XHEAD_DIM)
    k, v = jnp.split(rms_norm(mem, norm_mem) @ w_xkv, 2, axis=-1)
    k = k.reshape(B, M, N_XHEADS, XHEAD_DIM)
    v = v.reshape(B, M, N_XHEADS, XHEAD_DIM)
    s = jnp.einsum('bshd,bmhd->bhsm', q, k).astype(jnp.float32) * (XHEAD_DIM ** -0.5)
    p = jax.nn.softmax(s, axis=-1).astype(v.dtype)
    o = jnp.einsum('bhsm,bmhd->bshd', p, v).reshape(B, S, D_MODEL)
    return o @ w_xo


def hier_moe(xn, w_router_group, b_router_group, w_router_expert, b_router_expert, w_gate_up, w_down):
    B, S, D = xn.shape
    N = B * S
    xt = xn.reshape(N, D)
    g_logits = (xt @ w_router_group + b_router_group).astype(jnp.float32)
    g_prob = jax.nn.softmax(g_logits, axis=-1)
    grp = jnp.argmax(g_logits, axis=-1).astype(jnp.int32)
    g_w = jnp.take_along_axis(g_prob, grp[:, None], axis=-1)
    e_logits = (xt @ w_router_expert + b_router_expert).astype(jnp.float32).reshape(N, N_GROUPS, EXPERTS_PER_GROUP)
    e_logits = jnp.take_along_axis(e_logits, grp[:, None, None], axis=1)[:, 0]
    e_prob = jax.nn.softmax(e_logits, axis=-1)
    top_p, top_i = lax.top_k(e_prob, EXPERT_TOPK)
    gates = g_w * top_p / jnp.sum(top_p, axis=-1, keepdims=True)
    expert = grp[:, None] * EXPERTS_PER_GROUP + top_i.astype(jnp.int32)
    M = N * EXPERT_TOPK
    e_flat = expert.reshape(M)
    g_flat = gates.reshape(M)
    order = jnp.argsort(e_flat).astype(jnp.int32)
    e_sorted = e_flat[order]
    tok_sorted = order // EXPERT_TOPK
    gate_sorted = g_flat[order]
    counts = jnp.bincount(e_flat, length=N_EXPERTS).astype(jnp.int32)
    starts = jnp.cumsum(counts) - counts
    padded = (counts + MOE_ROWS - 1) // MOE_ROWS * MOE_ROWS
    pad_ends = jnp.cumsum(padded)
    pad_starts = pad_ends - padded
    dest = pad_starts[e_sorted] + jnp.arange(M, dtype=jnp.int32) - starts[e_sorted]
    n_blocks = -(-M // MOE_ROWS) + N_EXPERTS
    x_buf = jnp.zeros((n_blocks * MOE_ROWS, D), xt.dtype).at[dest].set(xt[tok_sorted])
    blk_expert = jnp.minimum(
        jnp.searchsorted(pad_ends, jnp.arange(n_blocks, dtype=jnp.int32) * MOE_ROWS, side='right'),
        N_EXPERTS - 1).astype(jnp.int32)

    def expert_block(args):
        e, xb = args
        gate, up = jnp.split(xb @ w_gate_up[e], 2, axis=-1)
        return (jax.nn.silu(gate) * up) @ w_down[e]

    y_buf = lax.map(expert_block, (blk_expert, x_buf.reshape(n_blocks, MOE_ROWS, D))).reshape(-1, D)
    y = y_buf[dest] * gate_sorted[:, None].astype(xt.dtype)
    out = jnp.zeros((N, D), xt.dtype).at[tok_sorted].add(y)
    return out.reshape(B, S, D)


def setup_inputs(seed: int = 0) -> dict:
    key = jax.random.key(seed)
    ks = jax.random.split(key, 32)
    f32 = jnp.float32

    def nrm(k, shape, scale):
        return jax.random.normal(k, shape, f32) * scale

    def gain(k, shape):
        return 1.0 + 0.02 * jax.random.normal(k, shape, f32)

    u = jax.random.uniform(ks[8], (DEPTH, D_LRU), f32, minval=0.9, maxval=0.999)
    a = u ** (1.0 / RG_C)
    lru_lambda = jnp.log(a) - jnp.log1p(-a)
    return {
        'x': nrm(ks[0], (BATCH, SEQ, D_MODEL), 1.0),
        'mem': nrm(ks[1], (BATCH, MEM_LEN, D_MODEL), 1.0),
        'norm_mix': gain(ks[2], (DEPTH, D_MODEL)),
        'w_in': nrm(ks[3], (DEPTH, D_MODEL, D_IN), D_MODEL ** -0.5),
        'conv_w': nrm(ks[4], (DEPTH, CONV_WIDTH, D_LRU), CONV_WIDTH ** -0.5),
        'conv_b': nrm(ks[5], (DEPTH, D_LRU), 0.02),
        'w_rg': nrm(ks[6], (DEPTH, N_LRU_BLOCKS, LRU_BLOCK, LRU_BLOCK), LRU_BLOCK ** -0.5),
        'b_rg': nrm(ks[7], (DEPTH, D_LRU), 0.02),
        'w_ig': nrm(ks[9], (DEPTH, N_LRU_BLOCKS, LRU_BLOCK, LRU_BLOCK), LRU_BLOCK ** -0.5),
        'b_ig': nrm(ks[10], (DEPTH, D_LRU), 0.02),
        'lru_lambda': lru_lambda,
        'norm_lru_out': gain(ks[11], (DEPTH, D_LRU)),
        'norm_attn_out': gain(ks[12], (DEPTH, D_ATTN)),
        'w_out': nrm(ks[13], (DEPTH, D_MIX, D_MODEL), D_MIX ** -0.5),
        'norm_cross': gain(ks[14], (DEPTH, D_MODEL)),
        'norm_mem': gain(ks[15], (DEPTH, D_MODEL)),
        'w_xq': nrm(ks[16], (DEPTH, D_MODEL, D_MODEL), D_MODEL ** -0.5),
        'w_xkv': nrm(ks[17], (DEPTH, D_MODEL, 2 * D_MODEL), D_MODEL ** -0.5),
        'w_xo': nrm(ks[18], (DEPTH, D_MODEL, D_MODEL), D_MODEL ** -0.5),
        'norm_ffn': gain(ks[19], (DEPTH, D_MODEL)),
        'w_router_group': nrm(ks[20], (DEPTH, D_MODEL, N_GROUPS), D_MODEL ** -0.5),
        'b_router_group': nrm(ks[21], (DEPTH, N_GROUPS), 0.01),
        'w_router_expert': nrm(ks[22], (DEPTH, D_MODEL, N_EXPERTS), D_MODEL ** -0.5),
        'b_router_expert': nrm(ks[23], (DEPTH, N_EXPERTS), 0.01),
        'w_gate_up': nrm(ks[24], (DEPTH, N_EXPERTS, D_MODEL, 2 * D_FF_EXPERT), D_MODEL ** -0.5),
        'w_down': nrm(ks[25], (DEPTH, N_EXPERTS, D_FF_EXPERT, D_MODEL), D_FF_EXPERT ** -0.5),
        'norm_final': gain(ks[26], (D_MODEL,)),
    }


def reference(x, mem, norm_mix, w_in, conv_w, conv_b, w_rg, b_rg, w_ig, b_ig, lru_lambda,
              norm_lru_out, norm_attn_out, w_out, norm_cross, norm_mem, w_xq, w_xkv, w_xo,
              norm_ffn, w_router_group, b_router_group, w_router_expert, b_router_expert,
              w_gate_up, w_down, norm_final):
    h = x
    for l in range(DEPTH):
        h = h + hybrid_mixer(rms_norm(h, norm_mix[l]), w_in[l], conv_w[l], conv_b[l], w_rg[l], b_rg[l],
                             w_ig[l], b_ig[l], lru_lambda[l], norm_lru_out[l], norm_attn_out[l], w_out[l])
        h = h + memory_cross_attention(rms_norm(h, norm_cross[l]), mem, norm_mem[l], w_xq[l], w_xkv[l], w_xo[l])
        h = h + hier_moe(rms_norm(h, norm_ffn[l]), w_router_group[l], b_router_group[l],
                         w_router_expert[l], b_router_expert[l], w_gate_up[l], w_down[l])
    return rms_norm(h, norm_final)
```

```cpp
#include <hip/hip_runtime.h>
#include <cstdio>
#include <cstdint>

#define LAS __attribute__((address_space(3)))
#define GAS __attribute__((address_space(1)))
typedef unsigned short bf16_t;
typedef short bf16x8 __attribute__((ext_vector_type(8)));
typedef float f32x4 __attribute__((ext_vector_type(4)));
typedef float f32x2 __attribute__((ext_vector_type(2)));
typedef unsigned u32x4 __attribute__((ext_vector_type(4)));
typedef unsigned u32x2 __attribute__((ext_vector_type(2)));

#ifndef MK_N_LAUNCHES
#define MK_N_LAUNCHES 1
#endif
constexpr int N_PHASES = 14;
constexpr int N_LAUNCHES = MK_N_LAUNCHES;

constexpr int BATCH = 16, SEQ = 2048, DM = 1024, NTOK = BATCH * SEQ;
constexpr int DLRU = 512, DATT = 512, DIN = 2560, NHEAD = 8, HD = 64, NBLK = 8, MBLK = 256;
constexpr int MEMLEN = 256, NXH = 4, XHD = 256, NMEM = BATCH * MEMLEN;
constexpr int NEXP = 32, EPG = 8, NGRP = 4, DFF = 512;
constexpr float EPS = 1e-6f;
constexpr int MAXTILES = 288, LCAP = 65536, LDH = 2048;
constexpr float QSCALE = 0.125f * 1.4426950408889634f;
constexpr float XSCALE = 0.0625f * 1.4426950408889634f;

constexpr size_t MiB = 1u << 20;
constexpr size_t WS_CTL = 0, CTL_ZERO_BYTES = 1 * MiB;
constexpr int CW_TMO = 0, CW_BAR = 4096, CW_CNT = 8192;
constexpr size_t WS_KSUM = 512 * 1024;
constexpr size_t WS_WIN = 2 * MiB, WS_WXK = 7 * MiB, WS_WXV = 9 * MiB, WS_WOUT = 11 * MiB, WS_WXQ = 13 * MiB, WS_WXO = 15 * MiB;
constexpr size_t WS_WR = 17 * MiB, WS_ROPE = 18 * MiB, WS_SSQ1 = 19 * MiB, WS_SSQ2 = 21 * MiB, WS_TOK = 23 * MiB, WS_RSC = 24 * MiB;
constexpr size_t WS_MEMN = 25 * MiB, WS_KM = 33 * MiB, WS_VMT = 41 * MiB, WS_WGU = 49 * MiB, WS_WDN = 113 * MiB;
constexpr size_t WS_A = 145 * MiB, WS_B = 305 * MiB, WS_C = 385 * MiB, WS_SSQL = 449 * MiB, WS_SSQA = 451 * MiB, WS_LTOK = 452 * MiB, WS_LRS = 460 * MiB, WS_END = 468 * MiB;
constexpr size_t TOK_E = 0, TOK_R = 256 * 1024, TOK_G = 512 * 1024, TOK_D = 768 * 1024;

constexpr int RING_BYTES = 131072;
constexpr int LDSCTL_OFF = RING_BYTES, MISC_OFF = LDSCTL_OFF + 320, MOE_OFF = LDSCTL_OFF + 1024;
constexpr int LDS_BYTES = 147456;

__device__ __forceinline__ unsigned cvt_pk_bf16(float lo, float hi) { unsigned r; asm volatile("v_cvt_pk_bf16_f32 %0, %1, %2" : "=v"(r) : "v"(lo), "v"(hi)); return r; }
__device__ __forceinline__ float bflo(unsigned w) { return __uint_as_float(w << 16); }
__device__ __forceinline__ float bfhi(unsigned w) { return __uint_as_float(w & 0xffff0000u); }
__device__ __forceinline__ float bf2f(bf16_t b) { return __uint_as_float((unsigned)b << 16); }
__device__ __forceinline__ float wave_sum(float v) {
#pragma unroll
    for (int o = 1; o < 64; o <<= 1) v += __shfl_xor(v, o);
    return v;
}
#define LDS_WAIT() asm volatile("s_waitcnt lgkmcnt(0)" ::: "memory")
__device__ __forceinline__ float sigmoidf_(float x) { return __builtin_amdgcn_rcpf(1.0f + __builtin_amdgcn_exp2f(x * -1.4426950408889634f)); }

#define XB_TMO      128
#define XB_XCNT(j)  (256  + 64 * (j))
#define XB_XSUB(j)  (1280 + 64 * (j))
#define XB_XGEN(j)  (2304 + 64 * (j))
#define XB_TOP      3328
#define XB_TOPGEN   3392
#define XCD_BAR_WORDS 3456
#define XB_SPIN_CAP (1u << 18)
__device__ __forceinline__ unsigned xb_ld(unsigned* p)              { return __hip_atomic_load(p, __ATOMIC_RELAXED, __HIP_MEMORY_SCOPE_AGENT); }
__device__ __forceinline__ unsigned xb_add(unsigned* p, unsigned v) { return __hip_atomic_fetch_add(p, v, __ATOMIC_RELAXED, __HIP_MEMORY_SCOPE_AGENT); }
__device__ __forceinline__ unsigned xb_xcc_id() { return (unsigned)__builtin_amdgcn_s_getreg((3 << 11) | 20) & 0xFu; }
#define XB_SPIN(cond, bar) do { unsigned _sp = 0; while (cond) { __builtin_amdgcn_s_sleep(1); \
    if ((++_sp & 255u) == 0u) { if (xb_ld(&(bar)[XB_TMO])) break; if (_sp > XB_SPIN_CAP) { atomicAdd(&(bar)[XB_TMO], 1u); break; } } } } while (0)
struct XcdBarrier { unsigned* bar; unsigned x; volatile LAS unsigned* st; };
__device__ __forceinline__ XcdBarrier xcd_barrier_post(unsigned* bar, volatile LAS unsigned* st) {
    XcdBarrier b; b.bar = bar; b.x = xb_xcc_id(); b.st = st;
    if (threadIdx.x == 0) (void)xb_add(&bar[XB_XCNT(b.x)], 1u);
    return b;
}
__device__ __forceinline__ void xcd_barrier_complete(unsigned* bar, unsigned x, unsigned& nloc, unsigned& nx) {
    const unsigned G = gridDim.x * gridDim.y * gridDim.z;
    unsigned sum, cnt, mine, sp = 0u;
    for (;;) {
        sum = 0u; cnt = 0u; mine = 0u;
#pragma unroll
        for (unsigned j = 0; j < 16; ++j) { const unsigned c = xb_ld(&bar[XB_XCNT(j)]); sum += c; cnt += (c > 0u) ? 1u : 0u; mine = (j == x) ? c : mine; }
        if (sum == G) break;
        __builtin_amdgcn_s_sleep(1);
        if ((++sp & 255u) == 0u) { if (xb_ld(&bar[XB_TMO])) break; if (sp > XB_SPIN_CAP) { atomicAdd(&bar[XB_TMO], 1u); break; } }
    }
    nloc = mine > 0u ? mine : 1u; nx = cnt > 0u ? cnt : 1u;
}
__device__ __forceinline__ void xcd_barrier(const XcdBarrier& b) {
    asm volatile("s_waitcnt vmcnt(0)" ::: "memory");
    __syncthreads();
    if (threadIdx.x == 0) {
        unsigned* bar = b.bar;
        __builtin_amdgcn_s_waitcnt(0);
        unsigned nloc = b.st[0], nx = b.st[1];
        if (nloc == 0u) { xcd_barrier_complete(bar, b.x, nloc, nx); b.st[0] = nloc; b.st[1] = nx; }
        const unsigned old = xb_add(&bar[XB_XSUB(b.x)], 1u);
        const unsigned gen = old / nloc;
        if (old + 1u == (gen + 1u) * nloc) {
            __builtin_amdgcn_fence(__ATOMIC_RELEASE, "agent");
            asm volatile("s_waitcnt vmcnt(0)" ::: "memory");
            const unsigned og = xb_add(&bar[XB_TOP], 1u);
            const unsigned tg = og / nx;
            if (og + 1u == (tg + 1u) * nx) xb_add(&bar[XB_TOPGEN], 1u);
            else XB_SPIN(xb_ld(&bar[XB_TOPGEN]) == tg, bar);
            __builtin_amdgcn_fence(__ATOMIC_ACQUIRE, "agent");
            xb_add(&bar[XB_XGEN(b.x)], 1u);
            asm volatile("s_waitcnt vmcnt(0)" ::: "memory");
        } else {
            XB_SPIN(xb_ld(&bar[XB_XGEN(b.x)]) == gen, bar);
            __builtin_amdgcn_fence(__ATOMIC_ACQUIRE, "agent");
            asm volatile("s_waitcnt vmcnt(0)" ::: "memory");
        }
    }
    __syncthreads();
}

struct Unit { int pm, pn; size_t a_off, b_off; int lbase, nvalid; };
struct Gemm { const bf16_t* A; const bf16_t* Bt; int lda, ldb, K; };
__host__ __device__ __forceinline__ int perm32(int rho) { const int n = rho >> 4, i = rho & 15; return 8 * (i >> 2) + 4 * n + (i & 3); }

struct PlainOrder {     static constexpr bool GATHER = false;
    int nM, nN, nwg, G, c, lda, ldb;
    __device__ void init(int M, int N, int G_, int c_, int lda_, int ldb_) { nM = M / 256; nN = N / 256; nwg = nM * nN; G = G_; c = c_; lda = lda_; ldb = ldb_; }
    __device__ bool next(int i, Unit& u) const {
        const long L = (long)i * G + c; if (L >= nwg) return false;
        int wgid = (int)L; { const int q = nwg / 8, r = nwg % 8, xcd = wgid % 8, off = wgid / 8; wgid = (xcd < r ? xcd * (q + 1) : r * (q + 1) + (xcd - r) * q) + off; }
        const int nig = 8 * nN, gid = wgid / nig, fm = gid * 8, gsz = (nM - fm) < 8 ? (nM - fm) : 8;
        u.pm = fm + ((wgid % nig) % gsz); u.pn = (wgid % nig) / gsz;
        u.a_off = (size_t)u.pm * 256 * lda; u.b_off = (size_t)u.pn * 256 * ldb; return true;
    }
};
struct XpreOrder {
    static constexpr bool GATHER = false;
    int G, c, mode;
    __device__ bool next(int i, Unit& u) const {
        const int L = i * G + c; if (L >= 256) return false;
        const int b = L >> 4, x = (L >> 2) & 3, y = L & 3;
        if (mode == 0) { const int h = x, kt = y; u.pm = b * 4 + h; u.pn = kt; u.a_off = (size_t)b * MEMLEN * DM + h * XHD; u.b_off = (size_t)kt * 256 * DM + h * XHD; }
        else { const int nt = x, h = y; u.pm = b * 4 + nt; u.pn = h; u.a_off = (size_t)nt * 256 * DM + h * XHD; u.b_off = (size_t)b * MEMLEN * DM + h * XHD; }
        return true;
    }
};
struct XattnOrder {
    static constexpr bool GATHER = false;
    int G, c, mode, lda;
    __device__ bool next(int i, Unit& u) const {
        const int L = i * G + c; if (L >= (NTOK / 256) * 4) return false;
        u.pm = L >> 2; u.pn = L & 3; const int b = u.pm >> 3;
        u.a_off = (size_t)u.pm * 256 * lda;
        u.b_off = mode == 0 ? (size_t)(b * 4 + u.pn) * 256 * DM : (size_t)(b * 1024 + u.pn * 256) * DM;
        return true;
    }
};
template <bool GATH_> struct MoeOrder {
    static constexpr bool GATHER = GATH_;
    const LAS int* ts; int G, c, lda, ldb; const int* ltok;
    __device__ bool next(int i, Unit& u) const {
        const int L = i * G + c; if (L >= ts[NEXP] * 4) return false;
        const int T = L >> 2, j = L & 3; int e = 0; while (ts[e + 1] <= T) ++e;
        const int lt = T - ts[e];
        u.pm = T; u.pn = j; u.a_off = GATH_ ? (size_t)0 : (size_t)T * 256 * lda; u.b_off = ((size_t)e * 1024 + j * 256) * ldb;
        u.lbase = e * LCAP + lt * 256; u.nvalid = ts[33 + e] - lt * 256; return true;
    }
    __device__ __forceinline__ unsigned rowoff(const Unit& u, int r) const { return (r < u.nvalid) ? (unsigned)ltok[u.lbase + r] * (unsigned)(LDH * 2) : 0u; }
};

template <class Epi, class Sched>
__device__ __forceinline__ void gemm_phase_simple(LAS unsigned char* lds, const Gemm g, const Sched& S, const Epi& E) {
    int tid = threadIdx.x; asm volatile("" : "+v"(tid));
    const int wid = __builtin_amdgcn_readfirstlane(tid >> 6), lane = tid & 63, wr = wid >> 2, wc = wid & 3, fr = lane & 15, fq = lane >> 4;
    Unit u;
    for (int i = 0; S.next(i, u); ++i) {
        f32x4 acc[2][2][4][2];
#pragma unroll
        for (int a = 0; a < 2; ++a)
#pragma unroll
            for (int b = 0; b < 2; ++b)
#pragma unroll
                for (int m = 0; m < 4; ++m)
#pragma unroll
                    for (int n = 0; n < 2; ++n) acc[a][b][m][n] = (f32x4){0.f, 0.f, 0.f, 0.f};
        const char* Ab = (const char*)(g.A + u.a_off); const char* Bb = (const char*)(g.Bt + u.b_off);
        const int c0 = Epi::PERM ? perm32(fr) : fr, c1 = Epi::PERM ? perm32(16 + fr) : 16 + fr;
        unsigned ao[2][4], bo[2][2];
#pragma unroll
        for (int ai = 0; ai < 2; ++ai)
#pragma unroll
            for (int m = 0; m < 4; ++m) ao[ai][m] = (unsigned)((128 * ai + 64 * wr + 16 * m + fr) * g.lda + 8 * fq) * 2u;
#pragma unroll
        for (int bj = 0; bj < 2; ++bj) { bo[bj][0] = (unsigned)((128 * bj + 32 * wc + c0) * g.ldb + 8 * fq) * 2u; bo[bj][1] = (unsigned)((128 * bj + 32 * wc + c1) * g.ldb + 8 * fq) * 2u; }
#pragma unroll 1
        for (int k0 = 0; k0 < g.K; k0 += 32) {
            if constexpr (Epi::MIDK) { if (k0 == (g.K >> 1)) E.midk(acc, u, wr, wc, fr, fq); }
            const char* Ak = Ab + (size_t)k0 * 2; const char* Bk = Bb + (size_t)k0 * 2;
            bf16x8 bfr[2][2];
#pragma unroll
            for (int bj = 0; bj < 2; ++bj) { bfr[bj][0] = *(const bf16x8*)(Bk + bo[bj][0]); bfr[bj][1] = *(const bf16x8*)(Bk + bo[bj][1]); }
#pragma unroll
            for (int ai = 0; ai < 2; ++ai) {
                bf16x8 af[4];
#pragma unroll
                for (int m = 0; m < 4; ++m) af[m] = *(const bf16x8*)(Ak + ao[ai][m]);
#pragma unroll
                for (int bj = 0; bj < 2; ++bj)
#pragma unroll
                    for (int m = 0; m < 4; ++m)
#pragma unroll
                        for (int n = 0; n < 2; ++n) acc[ai][bj][m][n] = __builtin_amdgcn_mfma_f32_16x16x32_bf16(bfr[bj][n], af[m], acc[ai][bj][m][n], 0, 0, 0);
            }
        }
        E(acc, u, wr, wc, fr, fq);
    }
}

__host__ __device__ __forceinline__ int lds_byte(int r, int c) { const int st = (r >> 4) * 2 + (c >> 5), rr = r & 15, cc = c & 31, ob = rr * 64 + cc * 2; return st * 1024 + (ob ^ (((ob >> 9) & 1) << 5)); }
__host__ __device__ __forceinline__ void stage_rc(int b, int& R, int& C) { const int st = b / 1024, sb = b % 1024, swz = sb ^ (((sb >> 9) & 1) << 5); R = (st >> 1) * 16 + swz / 64; C = (st & 1) * 32 + (swz % 64) / 2; }
template <class Epi, class Sched, bool ALIGN_EPI = false, bool SP2 = false>
__device__ __forceinline__ void gemm_phase(LAS unsigned char* lds, const Gemm g, const Sched& S, const Epi& E) {
    constexpr int BK = 64, HALF = 128, HTB = HALF * BK * 2;
    int tid = threadIdx.x; asm volatile("" : "+v"(tid));
    const int wid = __builtin_amdgcn_readfirstlane(tid >> 6), lane = tid & 63, wr = wid >> 2, wc = wid & 3, fr = lane & 15, fq = lane >> 4;
    const int K = g.K, nt = K / BK;
    unsigned voffA[2], voffB[2];
#pragma unroll
    for (int i = 0; i < 2; ++i) { int R, C; stage_rc(tid * 16 + i * 8192, R, C); const int Rb = Epi::PERM ? ((R & ~31) + perm32(R & 31)) : R;
        voffA[i] = (unsigned)(R * g.lda + C) * 2u; voffB[i] = (unsigned)(Rb * g.ldb + C) * 2u; }
    constexpr bool GATH = Sched::GATHER;
    unsigned vcu[2][2] = {{0u, 0u}, {0u, 0u}}, vnx[2][2] = {{0u, 0u}, {0u, 0u}}; int gR[2] = {0, 0}; unsigned gC[2] = {0u, 0u};
    if constexpr (GATH) {
#pragma unroll
        for (int i = 0; i < 2; ++i) { int R, Cq; stage_rc(tid * 16 + i * 8192, R, Cq); gR[i] = R; gC[i] = (unsigned)Cq * 2u; } }
    const size_t kstep = (size_t)(BK * 2);
    const size_t hstepA = (size_t)HALF * g.lda * 2, hstepB = (size_t)HALF * g.ldb * 2;
    const unsigned ldsw = (unsigned)wid * 1024u;
    const int aoff = lds_byte(wr * 64 + fr, fq * 8), boff = lds_byte(wc * 32 + fr, fq * 8);
#define PG8_SA(b, h) (((b) * 2 + (h)) * HTB)
#define PG8_SB(b, h) ((4 + (b) * 2 + (h)) * HTB)
#define PG8_STAGE(bufoff, gbase, voff) do { _Pragma("unroll") for (int _i = 0; _i < 2; ++_i) \
        __builtin_amdgcn_global_load_lds((const unsigned*)((const char*)(gbase) + (voff)[_i]), (LAS unsigned*)(lds + (bufoff) + ldsw + _i * 8192), 16, 0, 0); } while (0)
#define PG8_STA(bufoff, ptr, h, nx) do { if constexpr (GATH) { const unsigned vsel_[2] = {(nx) ? vnx[h][0] : vcu[h][0], (nx) ? vnx[h][1] : vcu[h][1]}; PG8_STAGE(bufoff, ptr, vsel_); } \
        else { PG8_STAGE(bufoff, (ptr) + (h) * hstepA, voffA); } } while (0)
#define PG8_LDA(dst, b, h) do { _Pragma("unroll") for (int m = 0; m < 4; ++m) _Pragma("unroll") for (int k = 0; k < 2; ++k) dst[m][k] = *(const LAS bf16x8*)(lds + PG8_SA(b, h) + aoff + m * 2048 + k * 1024); } while (0)
#define PG8_LDB(dst, b, h) do { _Pragma("unroll") for (int n = 0; n < 2; ++n) _Pragma("unroll") for (int k = 0; k < 2; ++k) dst[n][k] = *(const LAS bf16x8*)(lds + PG8_SB(b, h) + boff + n * 2048 + k * 1024); } while (0)
#define PG8_MMA(ai, bj, At, Bt) do { __builtin_amdgcn_s_setprio(1); _Pragma("unroll") for (int m = 0; m < 4; ++m) _Pragma("unroll") for (int n = 0; n < 2; ++n) _Pragma("unroll") for (int k = 0; k < 2; ++k) \
        acc[ai][bj][m][n] = __builtin_amdgcn_mfma_f32_16x16x32_bf16(Bt[n][k], At[m][k], acc[ai][bj][m][n], 0, 0, 0); __builtin_amdgcn_s_setprio(0); } while (0)
#define PG8_WAIT_V(n) asm volatile("s_waitcnt vmcnt(" #n ")" ::: "memory")
#define PG8_WAIT_L(n) asm volatile("s_waitcnt lgkmcnt(" #n ")" ::: "memory")
#define PG8_BAR __builtin_amdgcn_s_barrier()
#define PG8_SCHED __builtin_amdgcn_sched_barrier(0)
    Unit cur, nxt; int ui = 0;
    if (!S.next(0, cur)) return;
    f32x4 acc[2][2][4][2];
#pragma unroll
    for (int a = 0; a < 2; ++a)
#pragma unroll
        for (int b = 0; b < 2; ++b)
#pragma unroll
            for (int m = 0; m < 4; ++m)
#pragma unroll
                for (int n = 0; n < 2; ++n) acc[a][b][m][n] = (f32x4){0.f, 0.f, 0.f, 0.f};
    bf16x8 At[4][2], B0[2][2], B1[2][2];
    const char* cA = (const char*)(g.A + cur.a_off); const char* cB = (const char*)(g.Bt + cur.b_off);
    if constexpr (GATH) {
#pragma unroll
        for (int h = 0; h < 2; ++h)
#pragma unroll
            for (int i = 0; i < 2; ++i) vcu[h][i] = S.rowoff(cur, h * HALF + gR[i]) + gC[i]; }
    if constexpr (SP2) {
        PG8_STAGE(PG8_SB(0, 0), cB, voffB); PG8_STAGE(PG8_SB(0, 1), cB + hstepB, voffB); PG8_STA(PG8_SA(0, 0), cA, 0, false); PG8_STA(PG8_SA(0, 1), cA, 1, false);
        if (wr == 1) PG8_BAR;
        PG8_WAIT_V(2); PG8_BAR;
        PG8_STAGE(PG8_SB(1, 0), cB + kstep, voffB); PG8_STA(PG8_SA(1, 0), cA + kstep, 0, false); PG8_STAGE(PG8_SB(1, 1), cB + hstepB + kstep, voffB);
        PG8_WAIT_V(6); PG8_BAR;
    } else {
        PG8_STAGE(PG8_SB(0, 0), cB, voffB); PG8_STA(PG8_SA(0, 0), cA, 0, false); PG8_STAGE(PG8_SB(0, 1), cB + hstepB, voffB); PG8_STA(PG8_SA(0, 1), cA, 1, false);
        if (wr == 1) PG8_BAR;
        PG8_WAIT_V(4); PG8_BAR;
        PG8_STAGE(PG8_SB(1, 0), cB + kstep, voffB); PG8_STA(PG8_SA(1, 0), cA + kstep, 0, false); PG8_STAGE(PG8_SB(1, 1), cB + hstepB + kstep, voffB);
        PG8_WAIT_V(6); PG8_BAR;
    }
    for (;;) {
        const bool has_next = S.next(ui + 1, nxt);
        const char* nA = has_next ? (const char*)(g.A + nxt.a_off) : cA; const char* nB = has_next ? (const char*)(g.Bt + nxt.b_off) : cB;
        if constexpr (GATH) {
#pragma unroll
            for (int h = 0; h < 2; ++h)
#pragma unroll
                for (int i = 0; i < 2; ++i) vnx[h][i] = has_next ? (S.rowoff(nxt, h * HALF + gR[i]) + gC[i]) : vcu[h][i]; }
#pragma unroll 1
        for (int t = 0; t < nt; t += 2) {
            if constexpr (Epi::MIDK) { if (t == (nt >> 1)) E.midk(acc, cur, wr, wc, fr, fq); }
            const bool last = (t == nt - 2);
            const char* a1 = cA + (size_t)(t + 1) * kstep;
            const char* a2 = last ? nA : cA + (size_t)(t + 2) * kstep; const char* b2 = last ? nB : cB + (size_t)(t + 2) * kstep;
            const char* a3 = a2 + kstep; const char* b3 = b2 + kstep;
            if constexpr (SP2) {
            PG8_LDB(B0, 0, 0); PG8_LDB(B1, 0, 1); PG8_SCHED; PG8_LDA(At, 0, 0); PG8_STA(PG8_SA(1, 1), a1, 1, false);
            PG8_WAIT_V(8); PG8_WAIT_L(0); PG8_BAR; PG8_MMA(0, 0, At, B0); PG8_MMA(0, 1, At, B1); PG8_BAR; PG8_SCHED;
            PG8_LDA(At, 0, 1); PG8_STAGE(PG8_SB(0, 0), b2, voffB); PG8_STAGE(PG8_SB(0, 1), b2 + hstepB, voffB); PG8_STA(PG8_SA(0, 0), a2, 0, last);
            PG8_WAIT_V(8); PG8_WAIT_L(0); PG8_BAR; PG8_MMA(1, 0, At, B0); PG8_MMA(1, 1, At, B1); PG8_BAR; PG8_SCHED;
            PG8_LDB(B0, 1, 0); PG8_LDB(B1, 1, 1); PG8_SCHED; PG8_LDA(At, 1, 0); PG8_STA(PG8_SA(0, 1), a2, 1, last);
            PG8_WAIT_V(8); PG8_WAIT_L(0); PG8_BAR; PG8_MMA(0, 0, At, B0); PG8_MMA(0, 1, At, B1); PG8_BAR; PG8_SCHED;
            PG8_LDA(At, 1, 1); PG8_STAGE(PG8_SB(1, 0), b3, voffB); PG8_STAGE(PG8_SB(1, 1), b3 + hstepB, voffB); PG8_STA(PG8_SA(1, 0), a3, 0, last);
            PG8_WAIT_V(8); PG8_WAIT_L(0); PG8_BAR; PG8_MMA(1, 0, At, B0); PG8_MMA(1, 1, At, B1); PG8_BAR; PG8_SCHED;
            } else {
            PG8_LDB(B0, 0, 0); PG8_SCHED; PG8_LDA(At, 0, 0); PG8_STA(PG8_SA(1, 1), a1, 1, false);
            PG8_WAIT_L(8); PG8_BAR; PG8_WAIT_L(0); PG8_MMA(0, 0, At, B0); PG8_BAR; PG8_SCHED;
            PG8_LDB(B1, 0, 1); PG8_STAGE(PG8_SB(0, 0), b2, voffB);
            PG8_BAR; PG8_WAIT_L(0); PG8_MMA(0, 1, At, B1); PG8_BAR;
            PG8_LDA(At, 0, 1); PG8_STA(PG8_SA(0, 0), a2, 0, last);
            PG8_BAR; PG8_WAIT_L(0); PG8_MMA(1, 0, At, B0); PG8_BAR; PG8_SCHED;
            PG8_STAGE(PG8_SB(0, 1), b2 + hstepB, voffB);
            PG8_WAIT_V(6); PG8_BAR; PG8_MMA(1, 1, At, B1); PG8_BAR;
            PG8_LDB(B0, 1, 0); PG8_SCHED; PG8_LDA(At, 1, 0); PG8_STA(PG8_SA(0, 1), a2, 1, last);
            PG8_WAIT_L(8); PG8_BAR; PG8_WAIT_L(0); PG8_MMA(0, 0, At, B0); PG8_BAR; PG8_SCHED;
            PG8_LDB(B1, 1, 1); PG8_STAGE(PG8_SB(1, 0), b3, voffB);
            PG8_BAR; PG8_WAIT_L(0); PG8_MMA(0, 1, At, B1); PG8_BAR;
            PG8_LDA(At, 1, 1); PG8_STA(PG8_SA(1, 0), a3, 0, last);
            PG8_BAR; PG8_WAIT_L(0); PG8_MMA(1, 0, At, B0); PG8_BAR; PG8_SCHED;
            PG8_STAGE(PG8_SB(1, 1), b3 + hstepB, voffB);
            PG8_WAIT_V(6); PG8_BAR; PG8_MMA(1, 1, At, B1); PG8_BAR;
            }
        }
        if constexpr (ALIGN_EPI) { if (wr == 0) PG8_BAR; }
        E(acc, cur, wr, wc, fr, fq);
        if (!has_next) break;
#pragma unroll
        for (int a = 0; a < 2; ++a)
#pragma unroll
            for (int b = 0; b < 2; ++b)
#pragma unroll
                for (int m = 0; m < 4; ++m)
#pragma unroll
                    for (int n = 0; n < 2; ++n) acc[a][b][m][n] = (f32x4){0.f, 0.f, 0.f, 0.f};
        cur = nxt; cA = nA; cB = nB; ++ui;
        if constexpr (GATH) {
#pragma unroll
            for (int h = 0; h < 2; ++h)
#pragma unroll
                for (int i = 0; i < 2; ++i) vcu[h][i] = vnx[h][i]; }
        if constexpr (ALIGN_EPI) { if (wr == 1) PG8_BAR; }
    }
    PG8_WAIT_V(0);
    if constexpr (!ALIGN_EPI) { if (wr == 0) PG8_BAR; }
    PG8_BAR;
#undef PG8_SA
#undef PG8_SB
#undef PG8_STAGE
#undef PG8_STA
#undef PG8_LDA
#undef PG8_LDB
#undef PG8_MMA
#undef PG8_WAIT_V
#undef PG8_WAIT_L
#undef PG8_BAR
#undef PG8_SCHED
}
#ifdef GEMM_SIMPLE
#define GEMM_PHASE(lds, g, S, E) gemm_phase_simple(lds, g, S, E)
#else
#define GEMM_PHASE(lds, g, S, E) gemm_phase<decltype(E), decltype(S), true, true>(lds, g, S, E)
#endif

__device__ __forceinline__ float rstd_from_ssq(const float* ssq, int row) {
    const f32x4* p = (const f32x4*)(ssq + (size_t)row * 16); const f32x4 a = p[0], b = p[1], c = p[2], d = p[3];
    const float s = ((a[0] + a[1]) + (a[2] + a[3])) + ((b[0] + b[1]) + (b[2] + b[3])) + ((c[0] + c[1]) + (c[2] + c[3])) + ((d[0] + d[1]) + (d[2] + d[3]));
    return __builtin_amdgcn_rsqf(s * (1.0f / DM) + EPS);
}
__device__ __forceinline__ u32x4 pack8(const f32x4 v0, const f32x4 v1) { u32x4 w; w.x = cvt_pk_bf16(v0[0], v0[1]); w.y = cvt_pk_bf16(v0[2], v0[3]); w.z = cvt_pk_bf16(v1[0], v1[1]); w.w = cvt_pk_bf16(v1[2], v1[3]); return w; }

struct EpiProj {
    static constexpr bool PERM = true, LDSX = false, MIDK = false;
    bf16_t* base; const float* rope; float* ksum;
    __device__ __forceinline__ void operator()(f32x4 (&acc)[2][2][4][2], const Unit& u, int wr, int wc, int fr, int fq) const {
        const int type = u.pn >> 1, colt = (u.pn & 1) * 256;
        bf16_t* O = base + (size_t)type * NTOK * 512;
        const bool is_q = (type == 2), is_k = (type == 3);
        if ((is_q || is_k) && !(wc & 1)) {
#pragma unroll
            for (int ai = 0; ai < 2; ++ai)
#pragma unroll
                for (int m = 0; m < 4; ++m) {
                    const int row = u.pm * 256 + 128 * ai + 64 * wr + 16 * m + fr, pos = row & (SEQ - 1);
                    const float* rp = rope + pos * 16;
                    const f32x4 cs[2] = { *(const f32x4*)(rp), *(const f32x4*)(rp + 4) }, sn[2] = { *(const f32x4*)(rp + 8), *(const f32x4*)(rp + 12) };
#pragma unroll
                    for (int bj = 0; bj < 2; ++bj)
#pragma unroll
                        for (int n = 0; n < 2; ++n) {
                            const f32x4 mine = acc[ai][bj][m][n]; f32x4 oth;
#pragma unroll
                            for (int e = 0; e < 4; ++e) oth[e] = __shfl_xor(mine[e], 16);
                            f32x4 res = mine;
                            if (fq == 0) res = mine * cs[n] - oth * sn[n];
                            else if (fq == 1) res = mine * cs[n] + oth * sn[n];
                            acc[ai][bj][m][n] = res;
                        }
                }
        }
        const float sc = is_q ? QSCALE : 1.0f;
#pragma unroll
        for (int ai = 0; ai < 2; ++ai)
#pragma unroll
            for (int m = 0; m < 4; ++m) {
                const int row = u.pm * 256 + 128 * ai + 64 * wr + 16 * m + fr;
                bf16_t* rowp = O + (size_t)row * 512 + colt + 32 * wc + 8 * fq;
#pragma unroll
                for (int bj = 0; bj < 2; ++bj) *(u32x4*)(rowp + bj * 128) = pack8(acc[ai][bj][m][0] * sc, acc[ai][bj][m][1] * sc);
            }
        if (is_k) {
#pragma unroll
            for (int bj = 0; bj < 2; ++bj)
#pragma unroll
                for (int n = 0; n < 2; ++n)
#pragma unroll
                    for (int e = 0; e < 4; ++e) {
                        float s = 0.f;
#pragma unroll
                        for (int ai = 0; ai < 2; ++ai)
#pragma unroll
                            for (int m = 0; m < 4; ++m) s += acc[ai][bj][m][n][e];
                        s += __shfl_xor(s, 1); s += __shfl_xor(s, 2); s += __shfl_xor(s, 4); s += __shfl_xor(s, 8);
                        if (fr == 0) atomicAdd(ksum + (size_t)u.pm * 512 + colt + 128 * bj + 32 * wc + 8 * fq + 4 * n + e, s);
                    }
        }
    }
};
struct EpiStore {
    static constexpr bool PERM = true, LDSX = false, MIDK = false;
    bf16_t* O; int ldc;
    __device__ __forceinline__ void operator()(f32x4 (&acc)[2][2][4][2], const Unit& u, int wr, int wc, int fr, int fq) const {
#pragma unroll
        for (int ai = 0; ai < 2; ++ai)
#pragma unroll
            for (int m = 0; m < 4; ++m) {
                const int row = u.pm * 256 + 128 * ai + 64 * wr + 16 * m + fr;
                bf16_t* rowp = O + (size_t)row * ldc + u.pn * 256 + 32 * wc + 8 * fq;
#pragma unroll
                for (int bj = 0; bj < 2; ++bj) *(u32x4*)(rowp + bj * 128) = pack8(acc[ai][bj][m][0], acc[ai][bj][m][1]);
            }
    }
};
template <bool BASE_F32, bool KSPLIT> struct EpiResid {
    static constexpr bool PERM = false, LDSX = false, MIDK = KSPLIT;
    const void* base; bf16_t* hb; float* ssq; const float* ssql; const float* ssqa;
    __device__ __forceinline__ void stats(int row, int fq, float& rl, float& ra) const {
        const f32x4 pl = *(const f32x4*)(ssql + (size_t)row * 16 + 4 * fq); const f32x2 pa = *(const f32x2*)(ssqa + (size_t)row * 8 + 2 * fq);
        float sl = (pl[0] + pl[1]) + (pl[2] + pl[3]), sa = pa[0] + pa[1];
        sl += __shfl_xor(sl, 16); sl += __shfl_xor(sl, 32); sa += __shfl_xor(sa, 16); sa += __shfl_xor(sa, 32);
        rl = __builtin_amdgcn_rsqf(sl * (1.0f / 512.0f) + EPS); ra = __builtin_amdgcn_rsqf(sa * (1.0f / 512.0f) + EPS);
    }
    __device__ __forceinline__ void midk(f32x4 (&acc)[2][2][4][2], const Unit& u, int wr, int wc, int fr, int fq) const {
        asm volatile("" : "+v"(fr), "+v"(fq));
#pragma unroll
        for (int ai = 0; ai < 2; ++ai)
#pragma unroll
            for (int m = 0; m < 4; ++m) { float rl, ra; stats(u.pm * 256 + 128 * ai + 64 * wr + 16 * m + fr, fq, rl, ra); const float ratio = rl * __builtin_amdgcn_rcpf(ra);
#pragma unroll
                for (int bj = 0; bj < 2; ++bj)
#pragma unroll
                    for (int n = 0; n < 2; ++n) acc[ai][bj][m][n] *= ratio; }
    }
    __device__ __forceinline__ void operator()(f32x4 (&acc)[2][2][4][2], const Unit& u, int wr, int wc, int fr, int fq) const {
#pragma unroll
        for (int ai = 0; ai < 2; ++ai)
#pragma unroll
            for (int m = 0; m < 4; ++m) {
                const int row = u.pm * 256 + 128 * ai + 64 * wr + 16 * m + fr; float q = 0.f, osc = 1.0f;
                if constexpr (KSPLIT) { float rl; stats(row, fq, rl, osc); }
#pragma unroll
                for (int bj = 0; bj < 2; ++bj)
#pragma unroll
                    for (int n = 0; n < 2; ++n) {
                        const int col = u.pn * 256 + 128 * bj + 32 * wc + 16 * n + 4 * fq;
                        f32x4 bv;
                        if constexpr (BASE_F32) bv = *(const f32x4*)((const float*)base + (size_t)row * DM + col);
                        else { const u32x2 w = *(const u32x2*)((const bf16_t*)base + (size_t)row * LDH + col); bv = (f32x4){bflo(w.x), bfhi(w.x), bflo(w.y), bfhi(w.y)}; }
                        const f32x4 v = bv + acc[ai][bj][m][n] * osc;
                        q += (v[0] * v[0] + v[1] * v[1]) + (v[2] * v[2] + v[3] * v[3]);
                        u32x2 w; w.x = cvt_pk_bf16(v[0], v[1]); w.y = cvt_pk_bf16(v[2], v[3]); *(u32x2*)(hb + (size_t)row * LDH + col) = w;
                    }
                q += __shfl_xor(q, 16); q += __shfl_xor(q, 32);
                if (fq == 0) ssq[(size_t)row * 16 + u.pn * 4 + wc] = q;
            }
    }
};
struct EpiRowScale {
    static constexpr bool PERM = true, LDSX = false, MIDK = false;
    bf16_t* O; int ldc; const float* ssq; float cs;
    __device__ __forceinline__ void operator()(f32x4 (&acc)[2][2][4][2], const Unit& u, int wr, int wc, int fr, int fq) const {
#pragma unroll
        for (int ai = 0; ai < 2; ++ai)
#pragma unroll
            for (int m = 0; m < 4; ++m) {
                const int row = u.pm * 256 + 128 * ai + 64 * wr + 16 * m + fr; const float s = rstd_from_ssq(ssq, row) * cs;
                bf16_t* rowp = O + (size_t)row * ldc + u.pn * 256 + 32 * wc + 8 * fq;
#pragma unroll
                for (int bj = 0; bj < 2; ++bj) *(u32x4*)(rowp + bj * 128) = pack8(acc[ai][bj][m][0] * s, acc[ai][bj][m][1] * s);
            }
    }
};
#define XBAR() do { asm volatile("s_waitcnt lgkmcnt(0)" ::: "memory"); __builtin_amdgcn_s_barrier(); asm volatile("" ::: "memory"); } while (0)
struct EpiSoftmax {
    static constexpr bool PERM = true, LDSX = false, MIDK = false;
    bf16_t* O; int ldc; LAS unsigned char* xl; const float* ssq; float cs;
    __device__ __forceinline__ void operator()(f32x4 (&acc)[2][2][4][2], const Unit& u, int wr, int wc, int fr, int fq) const {
        LAS float* P = (LAS float*)xl;
        LAS float* Q = (LAS float*)(xl + 4096);
#pragma unroll
        for (int ai = 0; ai < 2; ++ai)
#pragma unroll
            for (int m = 0; m < 4; ++m) {
                float v = -INFINITY; const float sc = rstd_from_ssq(ssq, u.pm * 256 + 128 * ai + 64 * wr + 16 * m + fr) * cs;
#pragma unroll
                for (int bj = 0; bj < 2; ++bj)
#pragma unroll
                    for (int n = 0; n < 2; ++n) { const f32x4 x = acc[ai][bj][m][n] * sc; acc[ai][bj][m][n] = x; v = fmaxf(v, fmaxf(fmaxf(x[0], x[1]), fmaxf(x[2], x[3]))); }
                v = fmaxf(v, __shfl_xor(v, 16)); v = fmaxf(v, __shfl_xor(v, 32));
                if (fq == 0) P[(128 * ai + 64 * wr + 16 * m + fr) * 4 + wc] = v;
            }
        XBAR();
#pragma unroll
        for (int ai = 0; ai < 2; ++ai)
#pragma unroll
            for (int m = 0; m < 4; ++m) {
                const int r = 128 * ai + 64 * wr + 16 * m + fr;
                const float v = fmaxf(fmaxf(P[r * 4 + 0], P[r * 4 + 1]), fmaxf(P[r * 4 + 2], P[r * 4 + 3]));
                float s = 0.f;
#pragma unroll
                for (int bj = 0; bj < 2; ++bj)
#pragma unroll
                    for (int n = 0; n < 2; ++n) { f32x4 x = acc[ai][bj][m][n];
#pragma unroll
                        for (int e = 0; e < 4; ++e) { x[e] = __builtin_amdgcn_exp2f(x[e] - v); s += x[e]; }
                        acc[ai][bj][m][n] = x; }
                s += __shfl_xor(s, 16); s += __shfl_xor(s, 32);
                if (fq == 0) Q[r * 4 + wc] = s;
            }
        XBAR();
#pragma unroll
        for (int ai = 0; ai < 2; ++ai)
#pragma unroll
            for (int m = 0; m < 4; ++m) {
                const int r = 128 * ai + 64 * wr + 16 * m + fr;
                const float inv = 1.0f / ((Q[r * 4 + 0] + Q[r * 4 + 1]) + (Q[r * 4 + 2] + Q[r * 4 + 3]));
                bf16_t* rowp = O + (size_t)(u.pm * 256 + r) * ldc + u.pn * 256 + 32 * wc + 8 * fq;
#pragma unroll
                for (int bj = 0; bj < 2; ++bj) *(u32x4*)(rowp + bj * 128) = pack8(acc[ai][bj][m][0] * inv, acc[ai][bj][m][1] * inv);
            }
        XBAR();
    }
};
struct EpiGateUp {
    static constexpr bool PERM = true, LDSX = false, MIDK = false;
    bf16_t* O; const float* lrs;
    __device__ __forceinline__ void operator()(f32x4 (&acc)[2][2][4][2], const Unit& u, int wr, int wc, int fr, int fq) const {
#pragma unroll
        for (int ai = 0; ai < 2; ++ai)
#pragma unroll
            for (int m = 0; m < 4; ++m) {
                const int r = 128 * ai + 64 * wr + 16 * m + fr, row = u.pm * 256 + r; const float rs = (r < u.nvalid) ? lrs[u.lbase + r] : 0.f;
                f32x4 o[2];
#pragma unroll
                for (int n = 0; n < 2; ++n)
#pragma unroll
                    for (int e = 0; e < 4; ++e) { const float g = acc[ai][0][m][n][e] * rs, up = acc[ai][1][m][n][e] * rs; o[n][e] = g * sigmoidf_(g) * up; }
                *(u32x4*)(O + (size_t)row * DFF + u.pn * 128 + 32 * wc + 8 * fq) = pack8(o[0], o[1]);
            }
    }
};

struct Args { const float* in[27]; float* out; unsigned char* ws; int ph_lo, ph_hi; float invf[8]; };
struct Ctx { LAS unsigned char* lds; int tid, lane, wave, vcu, G; };

__device__ __forceinline__ void tr_item(const float* W, int ldw, int k0, int n0s, bf16_t* WT, int ldt, int r0d, const float* gain, LAS float* scr, int lane) {
    const int kr = lane >> 3, ch = lane & 7;
    f32x4 v[8];
#pragma unroll
    for (int i = 0; i < 8; ++i) v[i] = *(const f32x4*)(W + (size_t)(k0 + 8 * i + kr) * ldw + n0s + 4 * ch);
    const int c = lane & 7;
    f32x4 g0 = {1.f, 1.f, 1.f, 1.f}, g1 = {1.f, 1.f, 1.f, 1.f};
    if (gain) { g0 = *(const f32x4*)(gain + k0 + 8 * c); g1 = *(const f32x4*)(gain + k0 + 8 * c + 4); }
#pragma unroll
    for (int i = 0; i < 8; ++i) { LAS float* d = scr + (8 * i + kr) * 33 + 4 * ch; d[0] = v[i][0]; d[1] = v[i][1]; d[2] = v[i][2]; d[3] = v[i][3]; }
    LDS_WAIT(); asm volatile("" ::: "memory");
#pragma unroll
    for (int j = 0; j < 4; ++j) { const int n = (lane >> 3) + 8 * j; const LAS float* s = scr + (8 * c) * 33 + n;
        u32x4 o; o.x = cvt_pk_bf16(s[0 * 33] * g0[0], s[1 * 33] * g0[1]); o.y = cvt_pk_bf16(s[2 * 33] * g0[2], s[3 * 33] * g0[3]); o.z = cvt_pk_bf16(s[4 * 33] * g1[0], s[5 * 33] * g1[1]); o.w = cvt_pk_bf16(s[6 * 33] * g1[2], s[7 * 33] * g1[3]);
        *(u32x4*)(WT + (size_t)(r0d + n) * ldt + k0 + 8 * c) = o; }
    LDS_WAIT(); asm volatile("" ::: "memory");
}
__device__ __forceinline__ void rms_row_to_bf16(const float* xrow, const float* gain, bf16_t* orow, int lane) {
    const f32x4* xr = (const f32x4*)xrow + lane; const f32x4* gr = (const f32x4*)gain + lane;
    f32x4 v[4]; float s = 0.f;
#pragma unroll
    for (int j = 0; j < 4; ++j) { v[j] = xr[64 * j]; s += (v[j][0] * v[j][0] + v[j][1] * v[j][1]) + (v[j][2] * v[j][2] + v[j][3] * v[j][3]); }
    const float rstd = 1.0f / sqrtf(wave_sum(s) * (1.0f / DM) + EPS);
    u32x2* o8 = (u32x2*)orow + lane;
#pragma unroll
    for (int j = 0; j < 4; ++j) { const f32x4 g = gr[64 * j]; u32x2 w; w.x = cvt_pk_bf16(v[j][0] * rstd * g[0], v[j][1] * rstd * g[1]); w.y = cvt_pk_bf16(v[j][2] * rstd * g[2], v[j][3] * rstd * g[3]); o8[64 * j] = w; }
}

__device__ __forceinline__ void rms_row2_to_bf16(const float* xrow, const float* gain, bf16_t* orow, int lane) {
    const f32x4* xr = (const f32x4*)xrow + lane; const f32x4* gr = (const f32x4*)gain + lane;
    f32x4 v[2][4]; float s[2] = {0.f, 0.f};
#pragma unroll
    for (int r = 0; r < 2; ++r)
#pragma unroll
        for (int j = 0; j < 4; ++j) v[r][j] = xr[256 * r + 64 * j];
#pragma unroll
    for (int r = 0; r < 2; ++r)
#pragma unroll
        for (int j = 0; j < 4; ++j) s[r] += (v[r][j][0] * v[r][j][0] + v[r][j][1] * v[r][j][1]) + (v[r][j][2] * v[r][j][2] + v[r][j][3] * v[r][j][3]);
#pragma unroll
    for (int r = 0; r < 2; ++r) { const float rstd = 1.0f / sqrtf(wave_sum(s[r]) * (1.0f / DM) + EPS); u32x2* o8 = (u32x2*)(orow + (size_t)r * DM) + lane;
#pragma unroll
        for (int j = 0; j < 4; ++j) { const f32x4 g = gr[64 * j]; u32x2 w; w.x = cvt_pk_bf16(v[r][j][0] * rstd * g[0], v[r][j][1] * rstd * g[1]); w.y = cvt_pk_bf16(v[r][j][2] * rstd * g[2], v[r][j][3] * rstd * g[3]); o8[64 * j] = w; } }
}

__device__ __forceinline__ void ph_prologue(const Args& a, const Ctx& C) {
    unsigned char* ws = a.ws;
    LAS float* scr = (LAS float*)(C.lds + C.wave * 16384);
    const int gw = C.vcu * 8 + C.wave, NGW = C.G * 8, lane = C.lane;
    for (int it = gw; it < 16 * 80; it += NGW) { const int kb = it / 80, nb = it % 80; tr_item(a.in[3], DIN, 64 * kb, 32 * nb, (bf16_t*)(ws + WS_WIN), DM, 32 * nb, nullptr, scr, lane); }
    for (int it = gw; it < 16 * 64; it += NGW) { const int kb = it / 64, nb = it % 64;
        if (nb < 32) tr_item(a.in[17], 2 * DM, 64 * kb, 32 * nb, (bf16_t*)(ws + WS_WXK), DM, 32 * nb, nullptr, scr, lane);
        else tr_item(a.in[17], 2 * DM, 64 * kb, 32 * nb, (bf16_t*)(ws + WS_WXV), DM, 32 * (nb - 32), nullptr, scr, lane); }
    for (int it = gw; it < 16 * 32; it += NGW) { const int kb = it / 32, nb = it % 32;
        tr_item(a.in[13], DM, 64 * kb, 32 * nb, (bf16_t*)(ws + WS_WOUT), DM, 32 * nb, (kb < 8) ? a.in[11] : (a.in[12] - DLRU), scr, lane);
        tr_item(a.in[18], DM, 64 * kb, 32 * nb, (bf16_t*)(ws + WS_WXO), DM, 32 * nb, nullptr, scr, lane); }
    for (int it = gw; it < NEXP * 16 * 32; it += NGW) { const int e = it / 512, r = it % 512, kb = r / 32, nb = r % 32, j = nb >> 3, half = (nb >> 2) & 1, q = nb & 3;
        tr_item(a.in[24] + (size_t)e * DM * DM, DM, 64 * kb, half * 512 + j * 128 + q * 32, (bf16_t*)(ws + WS_WGU), DM, e * 1024 + j * 256 + half * 128 + q * 32, a.in[19], scr, lane); }
    for (int it = gw; it < NEXP * 8 * 32; it += NGW) { const int e = it / 256, r = it % 256, kb = r / 32, nb = r % 32;
        tr_item(a.in[25] + (size_t)e * DFF * DM, DM, 64 * kb, 32 * nb, (bf16_t*)(ws + WS_WDN), DFF, e * 1024 + 32 * nb, nullptr, scr, lane); }
    for (int r = gw; r < DM; r += NGW) { const float gk = a.in[14][r]; const f32x4* src = (const f32x4*)(a.in[16] + (size_t)r * DM) + lane; u32x2* dst = (u32x2*)((bf16_t*)(ws + WS_WXQ) + (size_t)r * DM) + lane;
#pragma unroll
        for (int j = 0; j < 4; ++j) { const f32x4 v = src[64 * j]; u32x2 w; w.x = cvt_pk_bf16(v[0] * gk, v[1] * gk); w.y = cvt_pk_bf16(v[2] * gk, v[3] * gk); dst[64 * j] = w; } }
    { bf16_t* WR = (bf16_t*)(ws + WS_WR); const int gt = C.vcu * 512 + C.tid, NT = C.G * 512;
      for (int i = gt; i < 48 * DM; i += NT) { const int r = i / DM, k = i % DM; float v = 0.f;
          if (r < 4) v = a.in[20][k * NGRP + r] * a.in[19][k]; else if (r < 36) v = a.in[22][k * NEXP + (r - 4)] * a.in[19][k];
          WR[i] = (bf16_t)(cvt_pk_bf16(v, 0.f) & 0xffffu); }
      float* rope = (float*)(ws + WS_ROPE);
      for (int i = gt; i < SEQ * 8; i += NT) { const int pos = i >> 3, j = i & 7; const float ang = (float)pos * a.invf[j];
          const double tw = 6.283185307179586476925286766559; const double ad = (double)ang; const double red = ad - tw * __builtin_rint(ad / tw); const float rf = (float)red;
          rope[pos * 16 + j] = __cosf(rf); rope[pos * 16 + 8 + j] = __sinf(rf); } }
    for (int m = 2 * gw; m < NTOK; m += 2 * NGW) rms_row2_to_bf16(a.in[0] + (size_t)m * DM, a.in[2], (bf16_t*)(ws + WS_B) + (size_t)m * DM, lane);
    for (int m = 2 * gw; m < NMEM; m += 2 * NGW) rms_row2_to_bf16(a.in[1] + (size_t)m * DM, a.in[15], (bf16_t*)(ws + WS_MEMN) + (size_t)m * DM, lane);
}

__device__ __forceinline__ float gelu_tanh(float x) { const float x2 = x * x; const float z2 = x * (-2.0f * 0.7978845608028654f * 1.4426950408889634f) * (1.0f + 0.044715f * x2);
    return x * __builtin_amdgcn_rcpf(1.0f + __builtin_amdgcn_exp2f(z2)); }
__device__ __forceinline__ float one_minus_exp(float x) {
    const float p = -x * (1.0f + x * (0.5f + x * (0.16666667f + x * (0.041666668f + x * 0.0083333338f))));
    const float e = 1.0f - __builtin_amdgcn_exp2f(x * 1.4426950408889634f);
    return (x > -0.25f) ? p : e;
}
__device__ __forceinline__ void lru_unit(const Args& a, const Ctx& C, int b, int blk, int half) {
    unsigned char* ws = a.ws;
    const bf16_t* XL = (const bf16_t*)(ws + WS_A); const bf16_t* GL = XL + (size_t)NTOK * 512; bf16_t* YC = (bf16_t*)(ws + WS_C); float* SSQL = (float*)(ws + WS_SSQL);
    const int tid = C.tid, lane = C.lane, wave = C.wave, fr = lane & 15, fq = lane >> 4;
    LAS float* XW = (LAS float*)(C.lds + wave * 5120);
    LAS bf16_t* GW = (LAS bf16_t*)(C.lds + wave * 5120 + 2304);
    LAS bf16_t* YW = (LAS bf16_t*)(C.lds + wave * 5120 + 3584);
    LAS float* WSUM = (LAS float*)(C.lds + 40960);
    LAS float* CW = (LAS float*)(C.lds + 45056);
    const int c0 = blk * 64, oc0 = c0 + half * 32;
    bf16x8 wfr[2][2][2];
#pragma unroll
    for (int gt = 0; gt < 2; ++gt) { const float* W = a.in[gt == 0 ? 6 : 8] + (size_t)blk * 64 * 64;
#pragma unroll
        for (int nt = 0; nt < 2; ++nt)
#pragma unroll
            for (int ks = 0; ks < 2; ++ks) { u32x4 w; float f[8];
#pragma unroll
                for (int j = 0; j < 8; ++j) f[j] = W[(32 * ks + 8 * fq + j) * 64 + half * 32 + 16 * nt + fr];
                w.x = cvt_pk_bf16(f[0], f[1]); w.y = cvt_pk_bf16(f[2], f[3]); w.z = cvt_pk_bf16(f[4], f[5]); w.w = cvt_pk_bf16(f[6], f[7]);
                wfr[gt][nt][ks] = __builtin_bit_cast(bf16x8, w); } }
    float brg[2], big[2], sp[2], hc[2] = {0.f, 0.f};
#pragma unroll
    for (int nt = 0; nt < 2; ++nt) { const int ch = oc0 + 16 * nt + fr; brg[nt] = a.in[7][ch] * -1.4426950408889634f; big[nt] = a.in[9][ch] * -1.4426950408889634f; const float lam = a.in[10][ch];
        sp[nt] = -8.0f * 1.4426950408889634f * ((lam > 15.f) ? __expf(-lam) : log1pf(__expf(-lam))); }
    if (tid < 320) { const int k = tid >> 6, c = tid & 63; CW[tid] = (k < 4) ? a.in[4][k * DLRU + c0 + c] : a.in[5][c0 + c]; }
    u32x4 xr[4][2], gr;
    const bf16_t* xrow0 = XL + ((size_t)b * SEQ + 16 * wave + fr) * 512 + c0 + 8 * fq;
    const bf16_t* grow0 = GL + ((size_t)b * SEQ + 16 * wave + (lane >> 2)) * 512 + oc0 + 8 * (lane & 3);
    const int tloc = 16 * wave + fr;
#define LRU_PREFETCH(t0_) do { _Pragma("unroll") for (int k = 0; k < 4; ++k) { const int tt = (t0_) + tloc - 3 + k; \
        if (tt >= 0) { const bf16_t* xp = xrow0 + (ptrdiff_t)((t0_) - 3 + k) * 512; xr[k][0] = *(const u32x4*)xp; xr[k][1] = *(const u32x4*)(xp + 32); } else { xr[k][0] = (u32x4){0u, 0u, 0u, 0u}; xr[k][1] = (u32x4){0u, 0u, 0u, 0u}; } } \
        gr = *(const u32x4*)(grow0 + (size_t)(t0_) * 512); } while (0)
    LRU_PREFETCH(0);
    __syncthreads();
    for (int ch = 0; ch < SEQ / 128; ++ch) {
        const int t0 = ch * 128;
        bf16x8 af[2];
#pragma unroll
        for (int ks = 0; ks < 2; ++ks) { float accv[8];
            { const f32x4 b0 = *(const LAS f32x4*)(CW + 256 + 32 * ks + 8 * fq), b1 = *(const LAS f32x4*)(CW + 256 + 32 * ks + 8 * fq + 4);
              accv[0] = b0[0]; accv[1] = b0[1]; accv[2] = b0[2]; accv[3] = b0[3]; accv[4] = b1[0]; accv[5] = b1[1]; accv[6] = b1[2]; accv[7] = b1[3]; }
#pragma unroll
            for (int k = 0; k < 4; ++k) { const f32x4 w0 = *(const LAS f32x4*)(CW + 64 * k + 32 * ks + 8 * fq), w1 = *(const LAS f32x4*)(CW + 64 * k + 32 * ks + 8 * fq + 4); const u32x4 x = xr[k][ks];
                accv[0] += w0[0] * bflo(x.x); accv[1] += w0[1] * bfhi(x.x); accv[2] += w0[2] * bflo(x.y); accv[3] += w0[3] * bfhi(x.y);
                accv[4] += w1[0] * bflo(x.z); accv[5] += w1[1] * bfhi(x.z); accv[6] += w1[2] * bflo(x.w); accv[7] += w1[3] * bfhi(x.w); }
            u32x4 p; p.x = cvt_pk_bf16(accv[0], accv[1]); p.y = cvt_pk_bf16(accv[2], accv[3]); p.z = cvt_pk_bf16(accv[4], accv[5]); p.w = cvt_pk_bf16(accv[6], accv[7]);
            af[ks] = __builtin_bit_cast(bf16x8, p);
            if (ks == half) { *(LAS f32x4*)(XW + fr * 36 + 8 * fq) = (f32x4){accv[0], accv[1], accv[2], accv[3]}; *(LAS f32x4*)(XW + fr * 36 + 8 * fq + 4) = (f32x4){accv[4], accv[5], accv[6], accv[7]}; } }
        *(LAS u32x4*)(GW + (lane >> 2) * 40 + 8 * (lane & 3)) = gr;
        if (ch + 1 < SEQ / 128) LRU_PREFETCH(t0 + 128);
        LDS_WAIT(); asm volatile("" ::: "memory");
        float Hl[2][4], Al[2][4], Aex[2], Hex[2];
        { f32x4 ar[2] = {{0.f, 0.f, 0.f, 0.f}, {0.f, 0.f, 0.f, 0.f}}, ai_[2] = {{0.f, 0.f, 0.f, 0.f}, {0.f, 0.f, 0.f, 0.f}};
#pragma unroll
          for (int ks = 0; ks < 2; ++ks)
#pragma unroll
              for (int nt = 0; nt < 2; ++nt) { ar[nt] = __builtin_amdgcn_mfma_f32_16x16x32_bf16(af[ks], wfr[0][nt][ks], ar[nt], 0, 0, 0); ai_[nt] = __builtin_amdgcn_mfma_f32_16x16x32_bf16(af[ks], wfr[1][nt][ks], ai_[nt], 0, 0, 0); }
#pragma unroll
          for (int nt = 0; nt < 2; ++nt) {
              float hrun = 0.f, arun = 1.f;
#pragma unroll
              for (int r = 0; r < 4; ++r) { const int chn = 16 * nt + fr;
                  const float rg = __builtin_amdgcn_rcpf(1.0f + __builtin_amdgcn_exp2f(__builtin_fmaf(ar[nt][r], -1.4426950408889634f, brg[nt])));
                  const float ig = __builtin_amdgcn_rcpf(1.0f + __builtin_amdgcn_exp2f(__builtin_fmaf(ai_[nt][r], -1.4426950408889634f, big[nt])));
                  const float av = __builtin_amdgcn_exp2f(rg * sp[nt]); const float mult = __builtin_amdgcn_sqrtf(fmaxf(1.0f - av * av, 0.f));
                  const float uv = mult * ig * XW[(4 * fq + r) * 36 + chn];
                  hrun = av * hrun + uv; arun *= av; Hl[nt][r] = hrun; Al[nt][r] = arun; }
              const float A0 = __shfl(arun, fr), H0 = __shfl(hrun, fr), A1 = __shfl(arun, fr + 16), H1 = __shfl(hrun, fr + 16), A2 = __shfl(arun, fr + 32), H2 = __shfl(hrun, fr + 32), A3 = __shfl(arun, fr + 48), H3 = __shfl(hrun, fr + 48);
              const float h01 = A1 * H0 + H1, a01 = A1 * A0, h012 = A2 * h01 + H2, a012 = A2 * a01;
              Aex[nt] = (fq == 0) ? 1.f : (fq == 1) ? A0 : (fq == 2) ? a01 : a012;
              Hex[nt] = (fq == 0) ? 0.f : (fq == 1) ? H0 : (fq == 2) ? h01 : h012;
              if (fq == 0) *(LAS f32x2*)(WSUM + (((ch & 1) * 8 + wave) * 32 + 16 * nt + fr) * 2) = (f32x2){A3 * a012, A3 * h012 + H3}; } }
        __syncthreads();
        { float ssr[4] = {0.f, 0.f, 0.f, 0.f};
#pragma unroll
          for (int nt = 0; nt < 2; ++nt) { const int chn = 16 * nt + fr; float x = hc[nt], mine = 0.f;
#pragma unroll
              for (int w2 = 0; w2 < 8; ++w2) { const f32x2 sm = *(const LAS f32x2*)(WSUM + (((ch & 1) * 8 + w2) * 32 + chn) * 2); if (w2 == wave) mine = x; x = sm[0] * x + sm[1]; }
              hc[nt] = x;
              const float hstart = Aex[nt] * mine + Hex[nt];
#pragma unroll
              for (int r = 0; r < 4; ++r) { const int tl = 4 * fq + r; const float h = Al[nt][r] * hstart + Hl[nt][r];
                  const float y = h * gelu_tanh(bf2f(GW[tl * 40 + chn])); const unsigned yb = cvt_pk_bf16(y, 0.f) & 0xffffu; YW[tl * 40 + chn] = (bf16_t)yb;
                  const float yr = __uint_as_float(yb << 16); ssr[r] += yr * yr; } }
#pragma unroll
          for (int r = 0; r < 4; ++r) { float q = ssr[r]; q += __shfl_xor(q, 1); q += __shfl_xor(q, 2); q += __shfl_xor(q, 4); q += __shfl_xor(q, 8);
              if (fr == 0) SSQL[((size_t)b * SEQ + t0 + 16 * wave + 4 * fq + r) * 16 + blk * 2 + half] = q; } }
        LDS_WAIT(); asm volatile("" ::: "memory");
        *(u32x4*)(YC + ((size_t)b * SEQ + t0 + 16 * wave + (lane >> 2)) * DM + oc0 + 8 * (lane & 3)) = *(const LAS u32x4*)(YW + (lane >> 2) * 40 + 8 * (lane & 3));
    }
#undef LRU_PREFETCH
    __syncthreads();
}

__device__ __forceinline__ void moba_unit_simple(const Args& a, const Ctx& C, int b, int h, int qb) {
    unsigned char* ws = a.ws;
    const bf16_t* Q = (const bf16_t*)(ws + WS_A) + (size_t)2 * NTOK * 512; const bf16_t* K = Q + (size_t)NTOK * 512; const bf16_t* V = K + (size_t)NTOK * 512;
    bf16_t* YA = (bf16_t*)(ws + WS_B) + (size_t)NTOK * 512; const float* KSUM = (const float*)(ws + WS_KSUM);
    const int q = C.tid & 255, hf = C.tid >> 8; const size_t row = (size_t)b * SEQ + qb * 256 + q;
    float qv[64];
    { const u32x4* qp = (const u32x4*)(Q + row * 512 + h * 64);
#pragma unroll
      for (int i = 0; i < 8; ++i) { const u32x4 w = qp[i]; qv[8 * i] = bflo(w.x); qv[8 * i + 1] = bfhi(w.x); qv[8 * i + 2] = bflo(w.y); qv[8 * i + 3] = bfhi(w.y); qv[8 * i + 4] = bflo(w.z); qv[8 * i + 5] = bfhi(w.z); qv[8 * i + 6] = bflo(w.w); qv[8 * i + 7] = bfhi(w.w); } }
    unsigned sel = 0u;
    { float g[8];
#pragma unroll
      for (int n = 0; n < 8; ++n) { g[n] = -INFINITY;
          if (n < qb) { const float* ks = KSUM + (size_t)(b * 8 + n) * 512 + h * 64; float s = 0.f;
#pragma unroll
              for (int d = 0; d < 64; ++d) s += qv[d] * ks[d];
              g[n] = s; } }
      const int npick = qb < 3 ? qb : 3;
      for (int p = 0; p < npick; ++p) { int best = -1; float bv = -INFINITY;
#pragma unroll
          for (int n = 0; n < 8; ++n) { const bool ok = (n < qb) && !((sel >> n) & 1u) && (best < 0 || g[n] > bv); if (ok) { best = n; bv = g[n]; } }
          if (best >= 0) sel |= 1u << best; } }
    float o[32], mrun = -1e30f, l = 0.f;
#pragma unroll
    for (int d = 0; d < 32; ++d) o[d] = 0.f;
    for (int n = 0; n <= qb; ++n) {
        const bool own = (n == qb); const bool use = own || ((sel >> n) & 1u);
        if (!__any(use)) continue;
        for (int j = 0; j < 256; ++j) {
            const bool valid = use && (!own || j <= q);
            if (!__any(valid)) continue;
            const size_t krow = (size_t)b * SEQ + n * 256 + j;
            const u32x4* kp = (const u32x4*)(K + krow * 512 + h * 64); float s = 0.f;
#pragma unroll
            for (int i = 0; i < 8; ++i) { const u32x4 w = kp[i];
                s += qv[8 * i] * bflo(w.x) + qv[8 * i + 1] * bfhi(w.x) + qv[8 * i + 2] * bflo(w.y) + qv[8 * i + 3] * bfhi(w.y) + qv[8 * i + 4] * bflo(w.z) + qv[8 * i + 5] * bfhi(w.z) + qv[8 * i + 6] * bflo(w.w) + qv[8 * i + 7] * bfhi(w.w); }
            if (valid) {
                const float mnew = fmaxf(mrun, s), f = __builtin_amdgcn_exp2f(mrun - mnew), p = __builtin_amdgcn_exp2f(s - mnew);
                l = l * f + p; mrun = mnew;
                const u32x4* vp = (const u32x4*)(V + krow * 512 + h * 64 + 32 * hf);
#pragma unroll
                for (int i = 0; i < 4; ++i) { const u32x4 w = vp[i];
                    o[8 * i] = o[8 * i] * f + p * bflo(w.x); o[8 * i + 1] = o[8 * i + 1] * f + p * bfhi(w.x); o[8 * i + 2] = o[8 * i + 2] * f + p * bflo(w.y); o[8 * i + 3] = o[8 * i + 3] * f + p * bfhi(w.y);
                    o[8 * i + 4] = o[8 * i + 4] * f + p * bflo(w.z); o[8 * i + 5] = o[8 * i + 5] * f + p * bfhi(w.z); o[8 * i + 6] = o[8 * i + 6] * f + p * bflo(w.w); o[8 * i + 7] = o[8 * i + 7] * f + p * bfhi(w.w); }
            }
        }
    }
    const float inv = 1.0f / l;
    u32x4* op = (u32x4*)(YA + row * 512 + h * 64 + 32 * hf);
#pragma unroll
    for (int i = 0; i < 4; ++i) { u32x4 w; w.x = cvt_pk_bf16(o[8 * i] * inv, o[8 * i + 1] * inv); w.y = cvt_pk_bf16(o[8 * i + 2] * inv, o[8 * i + 3] * inv); w.z = cvt_pk_bf16(o[8 * i + 4] * inv, o[8 * i + 5] * inv); w.w = cvt_pk_bf16(o[8 * i + 6] * inv, o[8 * i + 7] * inv); op[i] = w; }
}

__device__ __forceinline__ void ph_ymix(const Args& a, const Ctx& C) {
    const bf16_t* YL = (const bf16_t*)(a.ws + WS_B); const bf16_t* YA = YL + (size_t)NTOK * 512; bf16_t* YM = (bf16_t*)(a.ws + WS_C);
    const int gw = C.vcu * 8 + C.wave, NGW = C.G * 8, lane = C.lane;
    for (int m = gw; m < NTOK; m += NGW) {
#pragma unroll
        for (int part = 0; part < 2; ++part) {
            const u32x4 w = *((const u32x4*)((part ? YA : YL) + (size_t)m * 512) + lane);
            float v[8] = {bflo(w.x), bfhi(w.x), bflo(w.y), bfhi(w.y), bflo(w.z), bfhi(w.z), bflo(w.w), bfhi(w.w)}; float s = 0.f;
#pragma unroll
            for (int i = 0; i < 8; ++i) s += v[i] * v[i];
            const float rstd = 1.0f / sqrtf(wave_sum(s) * (1.0f / 512.0f) + EPS);
            u32x4 o; o.x = cvt_pk_bf16(v[0] * rstd, v[1] * rstd); o.y = cvt_pk_bf16(v[2] * rstd, v[3] * rstd); o.z = cvt_pk_bf16(v[4] * rstd, v[5] * rstd); o.w = cvt_pk_bf16(v[6] * rstd, v[7] * rstd);
            *((u32x4*)(YM + (size_t)m * DM + part * 512) + lane) = o;
        }
    }
}

__device__ __forceinline__ void ph_router(const Args& a, const Ctx& C) {
    unsigned char* ws = a.ws;
    const bf16_t* H2B = (const bf16_t*)a.out + DM; const bf16_t* WR = (const bf16_t*)(ws + WS_WR); const float* SSQ2 = (const float*)(ws + WS_SSQ2);
    unsigned* CNT = (unsigned*)(ws + WS_CTL) + CW_CNT;
    int* TOKE = (int*)(ws + WS_TOK + TOK_E); int* TOKR = (int*)(ws + WS_TOK + TOK_R); float* TOKG = (float*)(ws + WS_TOK + TOK_G); int* LTOK = (int*)(ws + WS_LTOK); float* LRS = (float*)(ws + WS_LRS);
    LAS float* LG = (LAS float*)C.lds + C.wave * (16 * 49);
    LAS unsigned* lcnt = (LAS unsigned*)(C.lds + 32768); LAS unsigned* lbase = lcnt + 32;
    const int lane = C.lane, fr = lane & 15, fq = lane >> 4;
    for (int pass = 0; (pass * C.G) * 128 < NTOK; ++pass) {
        const int blk = pass * C.G + C.vcu; const bool live = blk * 128 < NTOK;
        if (C.tid < 32) lcnt[C.tid] = 0u;
        __syncthreads();
        int E1 = 0, E2 = 0; unsigned r1 = 0, r2 = 0; float ga = 0.f, gb = 0.f, rstd_t = 0.f; const int tb = blk * 128 + 16 * C.wave;
        if (live) {
            f32x4 acc[3] = {{0.f, 0.f, 0.f, 0.f}, {0.f, 0.f, 0.f, 0.f}, {0.f, 0.f, 0.f, 0.f}};
            for (int ks = 0; ks < 32; ++ks) { const bf16x8 af = *(const bf16x8*)(H2B + (size_t)(tb + fr) * LDH + 32 * ks + 8 * fq);
#pragma unroll
                for (int nt = 0; nt < 3; ++nt) { const bf16x8 bfg = *(const bf16x8*)(WR + (size_t)(16 * nt + fr) * DM + 32 * ks + 8 * fq); acc[nt] = __builtin_amdgcn_mfma_f32_16x16x32_bf16(af, bfg, acc[nt], 0, 0, 0); } }
#pragma unroll
            for (int nt = 0; nt < 3; ++nt)
#pragma unroll
                for (int r = 0; r < 4; ++r) LG[(4 * fq + r) * 49 + 16 * nt + fr] = acc[nt][r];
            LDS_WAIT(); asm volatile("" ::: "memory");
            if (lane < 16) { const int t = tb + lane; const float rstd = rstd_from_ssq(SSQ2, t); rstd_t = rstd; const LAS float* lg = LG + lane * 49;
                float g[4]; int grp = 0;
#pragma unroll
                for (int i = 0; i < 4; ++i) g[i] = lg[i] * rstd + a.in[21][i];
#pragma unroll
                for (int i = 1; i < 4; ++i) if (g[i] > g[grp]) grp = i;
                float gs = 0.f;
#pragma unroll
                for (int i = 0; i < 4; ++i) gs += __expf(g[i] - g[grp]);
                const float gw_ = 1.0f / gs;
                float e[8];
#pragma unroll
                for (int i = 0; i < 8; ++i) e[i] = lg[4 + 8 * grp + i] * rstd + a.in[23][8 * grp + i];
                int i1 = 0;
#pragma unroll
                for (int i = 1; i < 8; ++i) if (e[i] > e[i1]) i1 = i;
                int i2 = (i1 == 0) ? 1 : 0;
#pragma unroll
                for (int i = 0; i < 8; ++i) if (i != i1 && i != i2 && e[i] > e[i2]) i2 = i;
                const float eb = __expf(e[i2] - e[i1]); ga = gw_ / (1.0f + eb); gb = gw_ * eb / (1.0f + eb);
                E1 = grp * 8 + i1; E2 = grp * 8 + i2;
                r1 = atomicAdd((unsigned*)&lcnt[E1], 1u); r2 = atomicAdd((unsigned*)&lcnt[E2], 1u);
            }
        }
        __syncthreads();
        if (C.tid < 32) lbase[C.tid] = lcnt[C.tid] ? __hip_atomic_fetch_add(CNT + C.tid, lcnt[C.tid], __ATOMIC_RELAXED, __HIP_MEMORY_SCOPE_AGENT) : 0u;
        __syncthreads();
        if (live && lane < 16) { const int t = tb + lane;
            const int k1 = (int)(lbase[E1] + r1), k2 = (int)(lbase[E2] + r2);
            TOKE[2 * t] = E1; TOKR[2 * t] = k1; TOKG[2 * t] = ga; LTOK[E1 * LCAP + k1] = t; LRS[E1 * LCAP + k1] = rstd_t;
            TOKE[2 * t + 1] = E2; TOKR[2 * t + 1] = k2; TOKG[2 * t + 1] = gb; LTOK[E2 * LCAP + k2] = t; LRS[E2 * LCAP + k2] = rstd_t; }
        __syncthreads();
    }
}
__device__ __forceinline__ void moe_table(const Args& a, const Ctx& C) {
    LAS int* ts = (LAS int*)(C.lds + MOE_OFF);
    if (C.tid == 0) { const unsigned* CNT = (const unsigned*)(a.ws + WS_CTL) + CW_CNT; int acc = 0;
        for (int e = 0; e < NEXP; ++e) { ts[e] = acc; const unsigned c = __hip_atomic_load(CNT + e, __ATOMIC_RELAXED, __HIP_MEMORY_SCOPE_AGENT); ts[33 + e] = (int)c; acc += (int)((c + 255u) >> 8); }
        ts[NEXP] = acc; }
    __syncthreads();
}
__device__ __forceinline__ void ph_final(const Args& a, const Ctx& C) {
    unsigned char* ws = a.ws;
    const bf16_t* YB = (const bf16_t*)(ws + WS_A); const float* TOKG = (const float*)(ws + WS_TOK + TOK_G); const int* TOKE = (const int*)(ws + WS_TOK + TOK_E); const int* TOKR = (const int*)(ws + WS_TOK + TOK_R);
    const LAS int* ts = (const LAS int*)(C.lds + MOE_OFF);
    float* out = a.out; const float* gf = a.in[26];
    const int gw = C.vcu * 8 + C.wave, NGW = C.G * 8, lane = C.lane;
    for (int t = gw; t < NTOK; t += NGW) { const int d0 = ts[TOKE[2 * t]] * 256 + TOKR[2 * t], d1 = ts[TOKE[2 * t + 1]] * 256 + TOKR[2 * t + 1]; const float g0 = TOKG[2 * t], g1 = TOKG[2 * t + 1];
        f32x4 v[4]; float s = 0.f; u32x2 hw[4], y0[4], y1[4];
#pragma unroll
        for (int j = 0; j < 4; ++j) { hw[j] = *((const u32x2*)((const bf16_t*)out + (size_t)t * LDH + DM) + lane + 64 * j);
            y0[j] = *((const u32x2*)(YB + (size_t)d0 * DM) + lane + 64 * j); y1[j] = *((const u32x2*)(YB + (size_t)d1 * DM) + lane + 64 * j); }
#pragma unroll
        for (int j = 0; j < 4; ++j) {
            v[j][0] = bflo(hw[j].x) + g0 * bflo(y0[j].x) + g1 * bflo(y1[j].x); v[j][1] = bfhi(hw[j].x) + g0 * bfhi(y0[j].x) + g1 * bfhi(y1[j].x);
            v[j][2] = bflo(hw[j].y) + g0 * bflo(y0[j].y) + g1 * bflo(y1[j].y); v[j][3] = bfhi(hw[j].y) + g0 * bfhi(y0[j].y) + g1 * bfhi(y1[j].y);
            s += (v[j][0] * v[j][0] + v[j][1] * v[j][1]) + (v[j][2] * v[j][2] + v[j][3] * v[j][3]); }
        const float rstd = 1.0f / sqrtf(wave_sum(s) * (1.0f / DM) + EPS);
#pragma unroll
        for (int j = 0; j < 4; ++j) { const f32x4 g = *((const f32x4*)gf + lane + 64 * j); *((f32x4*)(out + (size_t)t * DM) + lane + 64 * j) = v[j] * rstd * g; } }
}

#include <hip/hip_bf16.h>
#include <cmath>
namespace attn_body {
using bf16=__hip_bfloat16;
using bf16x8=__attribute__((ext_vector_type(8)))short;
using s16x4=__attribute__((ext_vector_type(4)))short;
using f32x16=__attribute__((ext_vector_type(16)))float;
using u32x4=__attribute__((ext_vector_type(4)))unsigned;
using f32x4_t=__attribute__((ext_vector_type(4)))float;
constexpr int BATCH=16,NHEAD=8,SEQ=2048,D=64,DM=NHEAD*D,DMO=1024;
constexpr int NW=8,QBLK=32,QB=QBLK*NW,KVBLK=64,NQB=SEQ/QB;
constexpr int ATTN_PITCH=DM, ATTN_UNIT_ROWS=QB;
__device__ __forceinline__ int crow(int r,int hi){return (r&3)+8*(r>>2)+4*hi;}
#define SBAR() __builtin_amdgcn_sched_barrier(0)
__device__ __forceinline__ void cmask(f32x16&p0,f32x16&p1,int jb,int qrel,int hi){
  const float NEG=-INFINITY; int kb=64*jb+4*hi; asm volatile("":"+v"(kb));
  #pragma unroll
  for(int r=0;r<16;++r){int kv=kb+(r&3)+8*(r>>2); if(kv>qrel)p0[r]=NEG; if(kv+32>qrel)p1[r]=NEG;}
}

constexpr int NSLOT=3, SLOTB=8192;
constexpr int LDS_K=0, LDS_V=NSLOT*SLOTB, LDS_WS=2*NSLOT*SLOTB, LDS_OST=LDS_WS+NW*64*4, LDS_BYTES=LDS_OST+NW*4096;
constexpr float C2=0.125f*1.4426950408889634f;
__device__ __forceinline__ void glds16(const char*sbase,unsigned voff,unsigned lds_dst){unsigned keep;
  asm volatile("s_nop 4\n\ts_mov_b32 %0, m0\n\ts_mov_b32 m0, %3\n\ts_nop 0\n\tglobal_load_lds_dwordx4 %1, %2\n\ts_mov_b32 m0, %0":"=&s"(keep):"v"(voff),"s"(sbase),"s"(lds_dst):"memory");}
__device__ __forceinline__ const char* uni_ptr(const void*p){const unsigned long long v=(unsigned long long)p;const unsigned lo=__builtin_amdgcn_readfirstlane((unsigned)v),hi=__builtin_amdgcn_readfirstlane((unsigned)(v>>32));return (const char*)(((unsigned long long)hi<<32)|lo);}
__device__ __forceinline__ float max3f(float a,float b,float c){float r;asm("v_max3_f32 %0, %1, %2, %3":"=v"(r):"v"(a),"v"(b),"v"(c));return r;}
__device__ __forceinline__ float max2f(float a,float b){float r;asm("v_max_f32_e32 %0, %1, %2":"=v"(r):"v"(a),"v"(b));return r;}
__device__ __forceinline__ float fadd_s(float a,float b){float r;asm("v_add_f32_e32 %0, %1, %2":"=v"(r):"v"(a),"v"(b));return r;}
__device__ __forceinline__ float fsub_s(float a,float b){float r;asm("v_sub_f32_e32 %0, %1, %2":"=v"(r):"v"(a),"v"(b));return r;}
typedef float f32x2_t __attribute__((ext_vector_type(2))); typedef __bf16 bf16x2_t __attribute__((ext_vector_type(2)));
__device__ __forceinline__ unsigned cvtpk_s(float lo,float hi){f32x2_t v={lo,hi};bf16x2_t b=__builtin_convertvector(v,bf16x2_t);return __builtin_bit_cast(unsigned,b);}
#define WAIT_BAR(N) asm volatile("s_waitcnt vmcnt(" #N ") lgkmcnt(0)\n\ts_barrier":::"memory")

__device__ __forceinline__ void qkt(f32x16&p0,f32x16&p1,const char*Kslot,const bf16x8*qr,const f32x16&negm,int r32,int hi){
  const char*kb=Kslot+hi*1024+r32*16;
  #pragma unroll
  for(int d0=0;d0<4;++d0){
    const bf16x8 b0=*reinterpret_cast<const bf16x8*>(kb+d0*2048);
    const bf16x8 b1=*reinterpret_cast<const bf16x8*>(kb+d0*2048+512);
    if(d0==0){p0=__builtin_amdgcn_mfma_f32_32x32x16_bf16(b0,qr[0],negm,0,0,0);p1=__builtin_amdgcn_mfma_f32_32x32x16_bf16(b1,qr[0],negm,0,0,0);}
    else{p0=__builtin_amdgcn_mfma_f32_32x32x16_bf16(b0,qr[d0],p0,0,0,0);p1=__builtin_amdgcn_mfma_f32_32x32x16_bf16(b1,qr[d0],p1,0,0,0);}}
}
typedef __attribute__((address_space(3))) const char* lds_cptr;
typedef short v4i16_t __attribute__((ext_vector_type(4)));
__device__ __forceinline__ void kload8(bf16x8*kf,lds_cptr kp){
  kf[0]=*(const __attribute__((address_space(3))) bf16x8*)(kp);      kf[1]=*(const __attribute__((address_space(3))) bf16x8*)(kp+512);
  kf[2]=*(const __attribute__((address_space(3))) bf16x8*)(kp+2048); kf[3]=*(const __attribute__((address_space(3))) bf16x8*)(kp+2560);
  kf[4]=*(const __attribute__((address_space(3))) bf16x8*)(kp+4096); kf[5]=*(const __attribute__((address_space(3))) bf16x8*)(kp+4608);
  kf[6]=*(const __attribute__((address_space(3))) bf16x8*)(kp+6144); kf[7]=*(const __attribute__((address_space(3))) bf16x8*)(kp+6656);
}
__device__ __forceinline__ void kload2(bf16x8*kf,lds_cptr kp,int j){ kf[2*j]=*(const __attribute__((address_space(3))) bf16x8*)(kp+j*2048); kf[2*j+1]=*(const __attribute__((address_space(3))) bf16x8*)(kp+j*2048+512); }
__device__ __forceinline__ s16x4 vtr(lds_cptr p){ return __builtin_bit_cast(s16x4,__builtin_amdgcn_ds_read_tr16_b64_v4i16((__attribute__((address_space(3))) v4i16_t*)p)); }
__device__ __forceinline__ float rowmax(const f32x16&p0,const f32x16&p1){
  float a=max3f(p0[0],p0[1],p1[0]),b=max3f(p0[2],p0[3],p1[1]);a=max3f(a,p1[2],p1[3]);
  #pragma unroll
  for(int r=4;r<16;r+=4){a=max3f(a,p0[r],p0[r+1]);b=max3f(b,p0[r+2],p0[r+3]);a=max3f(a,p1[r],p1[r+1]);b=max3f(b,p1[r+2],p1[r+3]);}
  const float m=max2f(a,b);
  auto rr=__builtin_amdgcn_permlane32_swap(__float_as_uint(m),__float_as_uint(m),false,false);
  return max2f(__uint_as_float(rr[0]),__uint_as_float(rr[1]));
}
__device__ __forceinline__ void pv(f32x16*o,int vb,bf16x8 pa0,bf16x8 pa1,bf16x8 pa2,bf16x8 pa3){
  #pragma unroll
  for(int d0=0;d0<2;++d0){s16x4 lo[4],hi[4];
    #pragma unroll
    for(int ks=0;ks<4;++ks){
      asm volatile("ds_read_b64_tr_b16 %0,%1 offset:%c2":"=&v"(lo[ks]):"v"(vb),"i"(d0*4096+ks*1024):"memory");
      asm volatile("ds_read_b64_tr_b16 %0,%1 offset:%c2":"=&v"(hi[ks]):"v"(vb),"i"(d0*4096+ks*1024+512):"memory");}
    asm volatile("s_waitcnt lgkmcnt(0)":::"memory");SBAR();
    #define PK(k) (bf16x8){lo[k][0],lo[k][1],lo[k][2],lo[k][3],hi[k][0],hi[k][1],hi[k][2],hi[k][3]}
    o[d0]=__builtin_amdgcn_mfma_f32_32x32x16_bf16(pa0,PK(0),o[d0],0,0,0);
    o[d0]=__builtin_amdgcn_mfma_f32_32x32x16_bf16(pa1,PK(1),o[d0],0,0,0);
    o[d0]=__builtin_amdgcn_mfma_f32_32x32x16_bf16(pa2,PK(2),o[d0],0,0,0);
    o[d0]=__builtin_amdgcn_mfma_f32_32x32x16_bf16(pa3,PK(3),o[d0],0,0,0);
    #undef PK
  }
}

#ifndef ATTN_STORE16
#define ATTN_STORE16(p,v) (*(u32x4*)(p)=(v))
#endif
template<int THRL> __device__ __forceinline__ void attn_unit(int b,int h,int qb,const bf16*Q,const bf16*__restrict__ K,const bf16*__restrict__ V,bf16*O,const float*__restrict__ KSUM,float*__restrict__ SSQA,char*shm){
  int tid=threadIdx.x; asm volatile("":"+v"(tid));
  const int lane=tid&63,r32=lane&31,hi=lane>>5; const int wid=__builtin_amdgcn_readfirstlane(tid>>6);
  const long rowbase=(long)b*SEQ; const int q0=qb*QB;
  const bf16*Qw=Q+(rowbase+q0+wid*QBLK)*DM+h*D;
  const bf16*Kh=K+rowbase*DM+h*D,*Vh=V+rowbase*DM+h*D;
  const unsigned lds0=(unsigned)(uintptr_t)shm;
  float*wsf=(float*)(shm+LDS_WS)+wid*64;
  const char*Khu=uni_ptr(Kh);const char*Vhu=uni_ptr(Vh);
  const unsigned kvo=(unsigned)(lane*DM+wid*8)*2u;
  const unsigned vvo=(unsigned)((16*(wid&3)+(lane>>2))*DM+(wid>>2)*32+(lane&3)*8)*2u;
  const unsigned kdst=lds0+LDS_K+wid*1024, vdst=lds0+LDS_V+wid*1024;
  #define DMA_K(t,slot) glds16(Khu+(size_t)(t)*(KVBLK*DM*2),kvo,(unsigned)__builtin_amdgcn_readfirstlane(kdst+(slot)))
  #define DMA_V(t,slot) glds16(Vhu+(size_t)(t)*(KVBLK*DM*2),vvo,(unsigned)__builtin_amdgcn_readfirstlane(vdst+(slot)))
  const int vb0=(int)(lds0+LDS_V)+((lane>>4)&1)*32+(lane&3)*8+(4*hi+((lane&15)>>2))*64;
  const char*Kbase=shm+LDS_K; bf16x8 kf[8];
  const lds_cptr shm3=(lds_cptr)shm; const lds_cptr kp0=shm3+LDS_K+hi*1024+r32*16; const lds_cptr vp0=shm3+LDS_V+((lane>>4)&1)*32+(lane&3)*8+(4*hi+((lane&15)>>2))*64;
  const int NT=(q0+QB)/KVBLK;
  DMA_K(0,0);DMA_V(0,0);DMA_K(1,SLOTB);
  bf16x8 qr[4];
  #pragma unroll
  for(int d0=0;d0<4;++d0)qr[d0]=*reinterpret_cast<const bf16x8*>(&Qw[(long)r32*DM+d0*16+hi*8]);
  unsigned selm=1u<<qb;
  { float g[8];
    #pragma unroll
    for(int n=0;n<8;++n){ g[n]=-INFINITY;
      if(n<qb){ const float*ks=KSUM+(long)(b*8+n)*DM+h*D+hi*8; float s=0.f;
        #pragma unroll
        for(int d0=0;d0<4;++d0){ const f32x4_t k0=*reinterpret_cast<const f32x4_t*>(ks+d0*16), k1=*reinterpret_cast<const f32x4_t*>(ks+d0*16+4);
          const u32x4 qw=__builtin_bit_cast(u32x4,qr[d0]);
          s+=__uint_as_float(qw[0]<<16)*k0[0]+__uint_as_float(qw[0]&0xffff0000u)*k0[1]+__uint_as_float(qw[1]<<16)*k0[2]+__uint_as_float(qw[1]&0xffff0000u)*k0[3]
            +__uint_as_float(qw[2]<<16)*k1[0]+__uint_as_float(qw[2]&0xffff0000u)*k1[1]+__uint_as_float(qw[3]<<16)*k1[2]+__uint_as_float(qw[3]&0xffff0000u)*k1[3]; }
        s+=__shfl_xor(s,32); g[n]=s; } }
    const int npick=qb<3?qb:3;
    for(int p=0;p<npick;++p){ int best=-1; float bv=-INFINITY;
      #pragma unroll
      for(int n=0;n<8;++n){ const bool ok=(n<qb)&&!((selm>>n)&1u)&&(best<0||g[n]>bv); if(ok){best=n;bv=g[n];} }
      if(best>=0)selm|=1u<<best; } }
  #define BMASK(P0,P1,t) do{ float bias_=((selm>>((t)>>2))&1u)?-mhat:-INFINITY; asm volatile("":"+v"(bias_)); _Pragma("unroll") for(int r=0;r<16;++r){P0[r]+=bias_;P1[r]+=bias_;} }while(0)
  float mhat=0.f,l_reg=0.f;f32x16 o[2];{float z0_=0.f;asm volatile("":"+v"(z0_));_Pragma("unroll") for(int r=0;r<16;++r){o[0][r]=z0_;o[1][r]=z0_;}}const f32x16 negm=f32x16{};
  const int qrel=wid*QBLK+r32;
  #define CMASK(P0,P1,t) do{int jb_=(t)-(NT-4); if(jb_>=0)cmask(P0,P1,jb_,qrel,hi);}while(0)
  bool resc=false;
  #define START(P0,P1) do{ const float rm=__builtin_fmaxf(rowmax(P0,P1),-100.0f); resc=false; \
    { const float dl=rm; mhat=fadd_s(mhat,dl); \
      _Pragma("unroll") for(int r=0;r<16;++r){P0[r]=fsub_s(P0[r],dl);P1[r]=fsub_s(P1[r],dl);} \
      } \
    _Pragma("unroll") for(int r=0;r<16;++r)P0[r]=__builtin_amdgcn_exp2f(P0[r]); }while(0)
  #define RESC() do{ if(resc){ asm volatile("s_waitcnt lgkmcnt(0)":::"memory"); \
      _Pragma("unroll") for(int d_=0;d_<2;++d_) _Pragma("unroll") for(int r=0;r<16;++r)o[d_][r]*=wsf[crow(r,hi)]; } }while(0)
  f32x16 pA0,pA1,pB0,pB1;
  int sl_prev=0,sl_cur=0,sl_next=SLOTB;
  #define ROT() do{sl_prev=sl_cur;sl_cur=sl_next;sl_next=(sl_next==(NSLOT-1)*SLOTB)?0:sl_next+SLOTB;}while(0)
  DMA_K(2,2*SLOTB);
  WAIT_BAR(3);
  qkt(pA0,pA1,Kbase,qr,negm,r32,hi);asm volatile("s_nop 15\n\ts_nop 7":"+v"(pA0),"+v"(pA1));CMASK(pA0,pA1,0);BMASK(pA0,pA1,0);
  START(pA0,pA1);
  _Pragma("unroll") for(int r=0;r<16;++r)pA1[r]=__builtin_amdgcn_exp2f(pA1[r]);
  WAIT_BAR(0);
  DMA_K(3,0);DMA_V(1,SLOTB);
  ROT();
  kload8(kf,kp0+sl_cur);
  WAIT_BAR(2);
  s16x4 vlo[8],vhi[8]; u32x4 pw0,pw1,pw2,pw3;
  #define PKW(P,B) cvtpk_s(P[B],P[B+1])
  #define PAF(k) __builtin_bit_cast(bf16x8,pw##k)
  #define VFR(i) (bf16x8){vlo[i][0],vlo[i][1],vlo[i][2],vlo[i][3],vhi[i][0],vhi[i][1],vhi[i][2],vhi[i][3]}
  #define PIN(x) asm volatile("":"+v"(x))
  #define MX3(a,b,c) __builtin_fmaxf(__builtin_fmaxf((a),(b)),(c))
  #define GAPA(MF,A0,A1,A2,A3,W0,W1,PW) do{ MF; sacc+=A0; sacc+=A1; sacc+=A2; sacc+=A3; PIN(sacc); W0; W1; PIN(PW); SBAR(); }while(0)
  #define EX(v) __builtin_amdgcn_exp2f(v)
  #define GAPB(MF,X,B) do{ MF; X[B]=EX(X[B]); X[B+1]=EX(X[B+1]); X[B+2]=EX(X[B+2]); X[B+3]=EX(X[B+3]); PIN(X); SBAR(); }while(0)
  #define VRD(i) do{ vlo[i]=vtr(vp_+(((i)>>2)*4096+((i)&3)*1024)); vhi[i]=vtr(vp_+(((i)>>2)*4096+((i)&3)*1024+512)); }while(0)
  #define KRD(G,j) do{ if(G){ kload2(kf,kp0+sl_next,j); SBAR(); } }while(0)
  #define STEP(C0,C1,P0,P1,t,GK,GV,GL) do{ SBAR(); \
    const lds_cptr vp_=vp0+sl_prev; \
    VRD(0); SBAR(); float sacc=(P0[0]+P0[1]); \
    GAPA(C0=__builtin_amdgcn_mfma_f32_32x32x16_bf16(kf[0],qr[0],negm,0,0,0), P0[2],P0[3],P0[4],P0[5],     pw0[0]=PKW(P0,0), pw0[1]=PKW(P0,2), pw0); \
    VRD(4); SBAR(); GAPA(C1=__builtin_amdgcn_mfma_f32_32x32x16_bf16(kf[1],qr[0],negm,0,0,0), P0[6],P0[7],P0[8],P0[9],     pw0[2]=PKW(P0,4), pw0[3]=PKW(P0,6), pw0); \
    VRD(1); SBAR(); GAPA(C0=__builtin_amdgcn_mfma_f32_32x32x16_bf16(kf[2],qr[1],C0,0,0,0),   P0[10],P0[11],P0[12],P0[13], pw1[0]=PKW(P0,8), pw1[1]=PKW(P0,10), pw1); \
    VRD(5); SBAR(); GAPA(C1=__builtin_amdgcn_mfma_f32_32x32x16_bf16(kf[3],qr[1],C1,0,0,0),   P0[14],P0[15],P1[0],P1[1],   pw1[2]=PKW(P0,12),pw1[3]=PKW(P0,14), pw1); \
    VRD(2); SBAR(); GAPA(C0=__builtin_amdgcn_mfma_f32_32x32x16_bf16(kf[4],qr[2],C0,0,0,0),   P1[2],P1[3],P1[4],P1[5],     pw2[0]=PKW(P1,0), pw2[1]=PKW(P1,2), pw2); \
    VRD(6); SBAR(); GAPA(C1=__builtin_amdgcn_mfma_f32_32x32x16_bf16(kf[5],qr[2],C1,0,0,0),   P1[6],P1[7],P1[8],P1[9],     pw2[2]=PKW(P1,4), pw2[3]=PKW(P1,6), pw2); \
    VRD(3); SBAR(); GAPA(C0=__builtin_amdgcn_mfma_f32_32x32x16_bf16(kf[6],qr[3],C0,0,0,0),   P1[10],P1[11],P1[12],P1[13], pw3[0]=PKW(P1,8), pw3[1]=PKW(P1,10), pw3); \
    VRD(7); SBAR(); GAPA(C1=__builtin_amdgcn_mfma_f32_32x32x16_bf16(kf[7],qr[3],C1,0,0,0),   P1[14],P1[15],0.f,0.f,       pw3[2]=PKW(P1,12),pw3[3]=PKW(P1,14), pw3); \
    l_reg+=sacc; \
    if(GK){DMA_K((t)+3,sl_cur);} if(GV){DMA_V((t)+1,sl_next);} \
    CMASK(C0,C1,t); BMASK(C0,C1,t); \
    { float a=MX3(C0[0],C0[1],C1[0]),b=MX3(C0[2],C0[3],C1[1]); a=MX3(a,C1[2],C1[3]); \
      _Pragma("unroll") for(int r=4;r<16;r+=4){a=MX3(a,C0[r],C0[r+1]);b=MX3(b,C0[r+2],C0[r+3]);a=MX3(a,C1[r],C1[r+1]);b=MX3(b,C1[r+2],C1[r+3]);} \
      float rm=__builtin_fmaxf(a,b); { auto rr=__builtin_amdgcn_permlane32_swap(__float_as_uint(rm),__float_as_uint(rm),false,false); rm=__builtin_fmaxf(__uint_as_float(rr[0]),__uint_as_float(rr[1])); } \
      resc=false; \
      if(__builtin_expect(__any(rm>(float)THRL),0)){ const float dl=__builtin_fmaxf(rm,0.f); mhat+=dl; \
        _Pragma("unroll") for(int r=0;r<16;++r){C0[r]-=dl;C1[r]-=dl;} \
        const float f=__builtin_amdgcn_exp2f(-dl); l_reg*=f; if(hi==0)wsf[r32]=f; resc=true; } } \
    SBAR(); \
    GAPB(o[0]=__builtin_amdgcn_mfma_f32_32x32x16_bf16(PAF(0),VFR(0),o[0],0,0,0), C0,0); \
    GAPB(o[1]=__builtin_amdgcn_mfma_f32_32x32x16_bf16(PAF(0),VFR(4),o[1],0,0,0), C0,4); \
    KRD(GL,0); GAPB(o[0]=__builtin_amdgcn_mfma_f32_32x32x16_bf16(PAF(1),VFR(1),o[0],0,0,0), C0,8); \
    KRD(GL,1); GAPB(o[1]=__builtin_amdgcn_mfma_f32_32x32x16_bf16(PAF(1),VFR(5),o[1],0,0,0), C0,12); \
    KRD(GL,2); GAPB(o[0]=__builtin_amdgcn_mfma_f32_32x32x16_bf16(PAF(2),VFR(2),o[0],0,0,0), C1,0); \
    KRD(GL,3); GAPB(o[1]=__builtin_amdgcn_mfma_f32_32x32x16_bf16(PAF(2),VFR(6),o[1],0,0,0), C1,4); \
    GAPB(o[0]=__builtin_amdgcn_mfma_f32_32x32x16_bf16(PAF(3),VFR(3),o[0],0,0,0), C1,8); \
    GAPB(o[1]=__builtin_amdgcn_mfma_f32_32x32x16_bf16(PAF(3),VFR(7),o[1],0,0,0), C1,12); \
    }while(0)
  int t=1;
  #undef CMASK
  #define CMASK(P0,P1,t) do{}while(0)
  for(;t+5<NT;t+=2){
    STEP(pB0,pB1,pA0,pA1,t,true,true,true);     WAIT_BAR(2); RESC(); ROT();
    STEP(pA0,pA1,pB0,pB1,t+1,true,true,true);   WAIT_BAR(2); RESC(); ROT();
  }
  #undef CMASK
  #define CMASK(P0,P1,t) do{int jb_=(t)-(NT-4); if(jb_>=0)cmask(P0,P1,jb_,qrel,hi);}while(0)
  #define ENDW(tt) do{ if((tt)+3<NT){WAIT_BAR(2);} else if((tt)+2<NT){WAIT_BAR(1);} else {WAIT_BAR(0);} }while(0)
  for(;t+1<NT;t+=2){
    STEP(pB0,pB1,pA0,pA1,t,(t+3<NT),(t+1<NT),(t+1<NT));       ENDW(t);   RESC(); ROT();
    STEP(pA0,pA1,pB0,pB1,t+1,(t+4<NT),(t+2<NT),(t+2<NT));     ENDW(t+1); RESC(); ROT();
  }
  STEP(pB0,pB1,pA0,pA1,NT-1,false,false,false); RESC();
  { float sacc=pB0[0]+pB0[1]; _Pragma("unroll") for(int r=2;r<16;++r)sacc+=pB0[r]; _Pragma("unroll") for(int r=0;r<16;++r)sacc+=pB1[r]; l_reg+=sacc;
    pw0=(u32x4){PKW(pB0,0),PKW(pB0,2),PKW(pB0,4),PKW(pB0,6)};pw1=(u32x4){PKW(pB0,8),PKW(pB0,10),PKW(pB0,12),PKW(pB0,14)};pw2=(u32x4){PKW(pB1,0),PKW(pB1,2),PKW(pB1,4),PKW(pB1,6)};pw3=(u32x4){PKW(pB1,8),PKW(pB1,10),PKW(pB1,12),PKW(pB1,14)};
    SBAR(); pv(o,vb0+sl_cur,PAF(0),PAF(1),PAF(2),PAF(3)); }
  #undef PKW
  #undef PAF
  #undef VFR
  #undef PIN
  #undef MX3
  #undef GAPA
  #undef GAPB
  #undef EX
  #undef VRD
  #undef KRD
  #undef STEP
  #undef ENDW
  {auto rr=__builtin_amdgcn_permlane32_swap(__float_as_uint(l_reg),__float_as_uint(l_reg),false,false);l_reg=__uint_as_float(rr[0])+__uint_as_float(rr[1]);}
  if(hi==0)wsf[32+r32]=l_reg;asm volatile("s_waitcnt lgkmcnt(0)":::"memory");
  float rli[16];
  #pragma unroll
  for(int r=0;r<16;++r)rli[r]=__builtin_amdgcn_rcpf(wsf[32+crow(r,hi)]);
  bf16*Ow=O+(rowbase+q0+wid*QBLK)*DMO+h*D;
  { bf16*stg=(bf16*)(shm+LDS_OST)+wid*2048;
    #pragma unroll
    for(int r=0;r<16;++r){const int orow=crow(r,hi);
      #pragma unroll
      for(int d0=0;d0<2;++d0)stg[orow*64+d0*32+r32]=__float2bfloat16(o[d0][r]*rli[r]);}
    asm volatile("s_waitcnt lgkmcnt(0)":::"memory");
    #pragma unroll
    for(int i=0;i<4;++i){const int row=i*8+(lane>>3),ch=lane&7; const u32x4 v=*(const u32x4*)(stg+row*64+ch*8); ATTN_STORE16(Ow+(long)row*DMO+ch*8,v);
      float q=0.f;
      #pragma unroll
      for(int e=0;e<4;++e){const float lo=__uint_as_float(v[e]<<16),hi2=__uint_as_float(v[e]&0xffff0000u);q+=lo*lo+hi2*hi2;}
      q+=__shfl_xor(q,1);q+=__shfl_xor(q,2);q+=__shfl_xor(q,4);
      if(ch==0)SSQA[(rowbase+q0+wid*QBLK+row)*8+h]=q;} }
  asm volatile("s_waitcnt lgkmcnt(0)\n\ts_barrier":::"memory");
  #undef BMASK
  #undef DMA_K
  #undef DMA_V
  #undef CMASK
  #undef START
  #undef RESC
  #undef ROT
}
constexpr int ATTN_LDS_BYTES=LDS_BYTES;
#undef SBAR
#undef WAIT_BAR
}

__global__ void __launch_bounds__(512, 2) mk_fwd(Args args) {
    extern __shared__ __attribute__((aligned(16))) unsigned char lds_raw[];
    Ctx C; C.lds = (LAS unsigned char*)lds_raw; C.tid = threadIdx.x; C.lane = C.tid & 63; C.wave = __builtin_amdgcn_readfirstlane(C.tid >> 6);
    C.G = gridDim.x; { const int bx = blockIdx.x; C.vcu = (C.G % 8 == 0) ? (bx % 8) * (C.G / 8) + bx / 8 : bx; }
    unsigned char* ws = args.ws;
    for (int u = C.tid; u < (LDS_BYTES - LDSCTL_OFF) / 4; u += 512) ((LAS unsigned*)(C.lds + LDSCTL_OFF))[u] = 0u;
    __syncthreads();
    XcdBarrier bar; bar.bar = (unsigned*)(ws + WS_CTL) + CW_BAR; bar.x = 0; bar.st = nullptr;
    if (N_LAUNCHES == 1) bar = xcd_barrier_post((unsigned*)(ws + WS_CTL) + CW_BAR, (volatile LAS unsigned*)(C.lds + MISC_OFF) + 8);
    const int lo = args.ph_lo, hi = args.ph_hi;
#ifndef PH_MASK
#define PH_MASK 0x3fff
#endif
#define IN(k) ((((PH_MASK) >> (k)) & 1) && lo <= (k) && (k) < hi)
#ifndef PROBE_REP
#define PROBE_REP -1
#endif
#define REP(k) for (int rep_ = 0; rep_ < ((PROBE_REP == (k)) ? 2 : 1); ++rep_)
#define REPBAR() do { if (rep_ > 0) xcd_barrier(bar); } while (0)
#define FRESH() do { int t_ = threadIdx.x; asm volatile("" : "+v"(t_)); C.tid = t_; C.lane = t_ & 63; C.wave = __builtin_amdgcn_readfirstlane(t_ >> 6); } while (0)
#define SEAM(k) do { if (IN(k) && IN((k) + 1)) xcd_barrier(bar); } while (0)
    const int cb = (int)blockIdx.x;

    if (IN(0)) REP(0) { REPBAR(); FRESH(); ph_prologue(args, C); SEAM(0); }
    if (IN(1)) REP(1) { REPBAR();
        { Gemm g{(const bf16_t*)(ws + WS_B), (const bf16_t*)(ws + WS_WIN), DM, DM, DM}; PlainOrder S; S.init(NTOK, DIN, C.G, cb, DM, DM);
          EpiProj E{(bf16_t*)(ws + WS_A), (const float*)(ws + WS_ROPE), (float*)(ws + WS_KSUM)}; GEMM_PHASE(C.lds, g, S, E); }
        { Gemm g{(const bf16_t*)(ws + WS_MEMN), (const bf16_t*)(ws + WS_WXK), DM, DM, DM}; PlainOrder S; S.init(NMEM, DM, C.G, cb, DM, DM);
          EpiStore E{(bf16_t*)(ws + WS_KM), DM}; GEMM_PHASE(C.lds, g, S, E); }
        { Gemm g{(const bf16_t*)(ws + WS_MEMN), (const bf16_t*)(ws + WS_WXV), DM, DM, DM}; PlainOrder S; S.init(NMEM, DM, C.G, (cb + C.G - 64 % C.G) % C.G, DM, DM);
          EpiStore E{(bf16_t*)(ws + WS_VMT), DM}; GEMM_PHASE(C.lds, g, S, E); }
        SEAM(1);
    }
    if (IN(2)) REP(2) { REPBAR(); FRESH();
        for (int lrep_ = 0; lrep_ < ((PROBE_REP == 102) ? 2 : 1); ++lrep_)
        for (int L = C.vcu; L < 256; L += C.G) lru_unit(args, C, L >> 4, (L >> 1) & 7, L & 1);
        for (int arep_ = 0; arep_ < ((PROBE_REP == 103) ? 2 : 1); ++arep_)
        for (int i = 0;; ++i) { const int aidx = i * C.G + C.vcu; if (aidx >= 1024) break; const int cc = aidx & 255, ii = aidx >> 8, bh = cc >> 1;
            const int qb = (cc & 1) ? ((ii == 0) ? 6 : (ii == 1) ? 1 : (ii == 2) ? 5 : 2) : ((ii == 0) ? 7 : (ii == 1) ? 0 : (ii == 2) ? 4 : 3);
#ifdef ATTN_SIMPLE
            moba_unit_simple(args, C, bh >> 3, bh & 7, qb); }
#else
            { const attn_body::bf16* Qp = (const attn_body::bf16*)(ws + WS_A) + (size_t)2 * NTOK * 512;
              attn_body::attn_unit<8>(bh >> 3, bh & 7, qb, Qp, Qp + (size_t)NTOK * 512, Qp + (size_t)2 * NTOK * 512, (attn_body::bf16*)(ws + WS_C) + 512, (const float*)(ws + WS_KSUM), (float*)(ws + WS_SSQA), (char*)lds_raw); } }
#endif
        SEAM(2);
    }
    if (IN(4)) REP(4) { REPBAR(); Gemm g{(const bf16_t*)(ws + WS_C), (const bf16_t*)(ws + WS_WOUT), DM, DM, DM}; PlainOrder S; S.init(NTOK, DM, C.G, cb, DM, DM);
        EpiResid<true, true> E{args.in[0], (bf16_t*)args.out, (float*)(ws + WS_SSQ1), (const float*)(ws + WS_SSQL), (const float*)(ws + WS_SSQA)}; GEMM_PHASE(C.lds, g, S, E);
        { Gemm g2{(const bf16_t*)(ws + WS_KM), (const bf16_t*)(ws + WS_WXQ), DM, DM, XHD}; XpreOrder S2{C.G, cb, 0}; EpiStore E2{(bf16_t*)(ws + WS_A), DM}; GEMM_PHASE(C.lds, g2, S2, E2); }
        { Gemm g3{(const bf16_t*)(ws + WS_WXO), (const bf16_t*)(ws + WS_VMT), DM, DM, XHD}; XpreOrder S3{C.G, cb, 1}; EpiStore E3{(bf16_t*)(ws + WS_A) + (size_t)32 * MiB / 2, DM}; GEMM_PHASE(C.lds, g3, S3, E3); }
        SEAM(4); }
    if (IN(5)) REP(5) { REPBAR(); Gemm g{(const bf16_t*)args.out, (const bf16_t*)(ws + WS_A), LDH, DM, DM}; XattnOrder S{C.G, cb, 0, LDH};
        EpiSoftmax E{(bf16_t*)(ws + WS_B), DM, C.lds + LDSCTL_OFF + 4096, (const float*)(ws + WS_SSQ1), XSCALE}; GEMM_PHASE(C.lds, g, S, E); SEAM(5); }
    if (IN(8)) REP(8) { REPBAR(); Gemm g{(const bf16_t*)(ws + WS_B), (const bf16_t*)(ws + WS_A) + (size_t)32 * MiB / 2, DM, DM, DM}; XattnOrder S{C.G, cb, 1, DM};
        EpiResid<false, false> E{(const bf16_t*)args.out, (bf16_t*)args.out + DM, (float*)(ws + WS_SSQ2), nullptr, nullptr}; GEMM_PHASE(C.lds, g, S, E); SEAM(8); }
    if (IN(9)) REP(9) { REPBAR(); FRESH(); ph_router(args, C); SEAM(9); }
    if (IN(11)) REP(11) { REPBAR(); FRESH(); moe_table(args, C); Gemm g{(const bf16_t*)args.out + DM, (const bf16_t*)(ws + WS_WGU), LDH, DM, DM};
        MoeOrder<true> S{(const LAS int*)(C.lds + MOE_OFF), C.G, cb, LDH, DM, (const int*)(ws + WS_LTOK)};
        EpiGateUp E{(bf16_t*)(ws + WS_B), (const float*)(ws + WS_LRS)}; GEMM_PHASE(C.lds, g, S, E); SEAM(11); }
    if (IN(12)) REP(12) { REPBAR(); FRESH(); moe_table(args, C); Gemm g{(const bf16_t*)(ws + WS_B), (const bf16_t*)(ws + WS_WDN), DFF, DFF, DFF};
        MoeOrder<false> S{(const LAS int*)(C.lds + MOE_OFF), C.G, cb, DFF, DFF, nullptr};
        EpiStore E{(bf16_t*)(ws + WS_A), DM}; GEMM_PHASE(C.lds, g, S, E); SEAM(12); }
    if (IN(13)) REP(13) { REPBAR(); FRESH(); moe_table(args, C); ph_final(args, C); }
#undef IN
#undef FRESH
#undef SEAM
}

extern "C" void kernel_launch(void* const* d_in, const int* in_sizes, int n_in, void* d_out, int out_size, void* d_ws, size_t ws_size, hipStream_t stream) {
    static int grid = 0;
    if (grid == 0) {
        if (n_in != 27 || out_size != NTOK * DM || ws_size < WS_END) { fprintf(stderr, "kernel_launch: unexpected shapes (n_in %d out %d ws %zu)\n", n_in, out_size, ws_size); grid = -1; return; }
        int dev = 0, cus = 0, per_cu = 0;
        if (hipGetDevice(&dev) != hipSuccess || hipDeviceGetAttribute(&cus, hipDeviceAttributeMultiprocessorCount, dev) != hipSuccess) { grid = -1; return; }
        if (hipFuncSetAttribute((const void*)mk_fwd, hipFuncAttributeMaxDynamicSharedMemorySize, LDS_BYTES) != hipSuccess) { fprintf(stderr, "kernel_launch: hipFuncSetAttribute failed\n"); grid = -1; return; }
        if (hipOccupancyMaxActiveBlocksPerMultiprocessor(&per_cu, (const void*)mk_fwd, 512, LDS_BYTES) != hipSuccess || per_cu < 1) fprintf(stderr, "kernel_launch: occupancy query reports %d\n", per_cu);
        (void)hipGetLastError();
        grid = cus;
    }
    if (grid < 0) return;
    (void)hipMemsetAsync((char*)d_ws + WS_CTL, 0, CTL_ZERO_BYTES, stream);
    Args a{};
    for (int i = 0; i < 27; ++i) a.in[i] = (const float*)d_in[i];
    a.out = (float*)d_out; a.ws = (unsigned char*)d_ws;
    const float invf[8] = {1.0f, 0.1939227432012558f, 0.03760603070259094f, 0.007292664609849453f, 0.0014142135623842478f, 0.00027424818836152554f, 5.318296098266728e-05f, 1.0313386155758053e-05f};
    for (int i = 0; i < 8; ++i) a.invf[i] = invf[i];
    if (N_LAUNCHES == 1) { a.ph_lo = 0; a.ph_hi = N_PHASES; hipLaunchKernelGGL(mk_fwd, dim3(grid), dim3(512), LDS_BYTES, stream, a); }
    else for (int p = 0; p < N_PHASES; ++p) { a.ph_lo = p; a.ph_hi = p + 1; hipLaunchKernelGGL(mk_fwd, dim3(grid), dim3(512), LDS_BYTES, stream, a); }
}
```

```cpp
#include <hip/hip_runtime.h>
#include <cstdio>
#include <cstdint>

#define LAS __attribute__((address_space(3)))
#define GAS __attribute__((address_space(1)))
typedef unsigned short bf16_t;
typedef short bf16x8 __attribute__((ext_vector_type(8)));
typedef float f32x4 __attribute__((ext_vector_type(4)));
typedef float f32x2 __attribute__((ext_vector_type(2)));
typedef unsigned u32x4 __attribute__((ext_vector_type(4)));
typedef unsigned u32x2 __attribute__((ext_vector_type(2)));

#ifndef MK_N_LAUNCHES
#define MK_N_LAUNCHES 1
#endif
constexpr int N_PHASES = 14;
constexpr int N_LAUNCHES = MK_N_LAUNCHES;

constexpr int BATCH = 16, SEQ = 2048, DM = 1024, NTOK = BATCH * SEQ;
constexpr int DLRU = 512, DATT = 512, DIN = 2560, NHEAD = 8, HD = 64, NBLK = 8, MBLK = 256;
constexpr int MEMLEN = 256, NXH = 4, XHD = 256, NMEM = BATCH * MEMLEN;
constexpr int NEXP = 32, EPG = 8, NGRP = 4, DFF = 512;
constexpr float EPS = 1e-6f;
constexpr int MAXTILES = 288, LCAP = 65536, LDH = 2048;
constexpr float QSCALE = 0.125f * 1.4426950408889634f;
constexpr float XSCALE = 0.0625f * 1.4426950408889634f;

constexpr size_t MiB = 1u << 20;
constexpr size_t WS_CTL = 0, CTL_ZERO_BYTES = 1 * MiB;
constexpr int CW_TMO = 0, CW_BAR = 4096, CW_CNT = 8192;
constexpr size_t WS_KSUM = 512 * 1024;
constexpr size_t WS_WIN = 2 * MiB, WS_WXK = 7 * MiB, WS_WXV = 9 * MiB, WS_WOUT = 11 * MiB, WS_WXQ = 13 * MiB, WS_WXO = 15 * MiB;
constexpr size_t WS_WR = 17 * MiB, WS_ROPE = 18 * MiB, WS_SSQ1 = 19 * MiB, WS_SSQ2 = 21 * MiB, WS_TOK = 23 * MiB, WS_RSC = 24 * MiB;
constexpr size_t WS_MEMN = 25 * MiB, WS_KM = 33 * MiB, WS_VMT = 41 * MiB, WS_WGU = 49 * MiB, WS_WDN = 113 * MiB;
constexpr size_t WS_A = 145 * MiB, WS_B = 305 * MiB, WS_C = 385 * MiB, WS_SSQL = 449 * MiB, WS_SSQA = 451 * MiB, WS_LTOK = 452 * MiB, WS_LRS = 460 * MiB, WS_END = 468 * MiB;
constexpr size_t TOK_E = 0, TOK_R = 256 * 1024, TOK_G = 512 * 1024, TOK_D = 768 * 1024;

constexpr int RING_BYTES = 131072;
constexpr int LDSCTL_OFF = RING_BYTES, MISC_OFF = LDSCTL_OFF + 320, MOE_OFF = LDSCTL_OFF + 1024;
constexpr int LDS_BYTES = 147456;

__device__ __forceinline__ unsigned cvt_pk_bf16(float lo, float hi) { unsigned r; asm volatile("v_cvt_pk_bf16_f32 %0, %1, %2" : "=v"(r) : "v"(lo), "v"(hi)); return r; }
__device__ __forceinline__ float bflo(unsigned w) { return __uint_as_float(w << 16); }
__device__ __forceinline__ float bfhi(unsigned w) { return __uint_as_float(w & 0xffff0000u); }
__device__ __forceinline__ float bf2f(bf16_t b) { return __uint_as_float((unsigned)b << 16); }
__device__ __forceinline__ float wave_sum(float v) {
#pragma unroll
    for (int o = 1; o < 64; o <<= 1) v += __shfl_xor(v, o);
    return v;
}
#define LDS_WAIT() asm volatile("s_waitcnt lgkmcnt(0)" ::: "memory")
__device__ __forceinline__ float sigmoidf_(float x) { return __builtin_amdgcn_rcpf(1.0f + __builtin_amdgcn_exp2f(x * -1.4426950408889634f)); }

#define XB_TMO      128
#define XB_XCNT(j)  (256  + 64 * (j))
#define XB_XSUB(j)  (1280 + 64 * (j))
#define XB_XGEN(j)  (2304 + 64 * (j))
#define XB_TOP      3328
#define XB_TOPGEN   3392
#define XCD_BAR_WORDS 3456
#define XB_SPIN_CAP (1u << 18)
__device__ __forceinline__ unsigned xb_ld(unsigned* p)              { return __hip_atomic_load(p, __ATOMIC_RELAXED, __HIP_MEMORY_SCOPE_AGENT); }
__device__ __forceinline__ unsigned xb_add(unsigned* p, unsigned v) { return __hip_atomic_fetch_add(p, v, __ATOMIC_RELAXED, __HIP_MEMORY_SCOPE_AGENT); }
__device__ __forceinline__ unsigned xb_xcc_id() { return (unsigned)__builtin_amdgcn_s_getreg((3 << 11) | 20) & 0xFu; }
#define XB_SPIN(cond, bar) do { unsigned _sp = 0; while (cond) { __builtin_amdgcn_s_sleep(1); \
    if ((++_sp & 255u) == 0u) { if (xb_ld(&(bar)[XB_TMO])) break; if (_sp > XB_SPIN_CAP) { atomicAdd(&(bar)[XB_TMO], 1u); break; } } } } while (0)
struct XcdBarrier { unsigned* bar; unsigned x; volatile LAS unsigned* st; };
__device__ __forceinline__ XcdBarrier xcd_barrier_post(unsigned* bar, volatile LAS unsigned* st) {
    XcdBarrier b; b.bar = bar; b.x = xb_xcc_id(); b.st = st;
    if (threadIdx.x == 0) (void)xb_add(&bar[XB_XCNT(b.x)], 1u);
    return b;
}
__device__ __forceinline__ void xcd_barrier_complete(unsigned* bar, unsigned x, unsigned& nloc, unsigned& nx) {
    const unsigned G = gridDim.x * gridDim.y * gridDim.z;
    unsigned sum, cnt, mine, sp = 0u;
    for (;;) {
        sum = 0u; cnt = 0u; mine = 0u;
#pragma unroll
        for (unsigned j = 0; j < 16; ++j) { const unsigned c = xb_ld(&bar[XB_XCNT(j)]); sum += c; cnt += (c > 0u) ? 1u : 0u; mine = (j == x) ? c : mine; }
        if (sum == G) break;
        __builtin_amdgcn_s_sleep(1);
        if ((++sp & 255u) == 0u) { if (xb_ld(&bar[XB_TMO])) break; if (sp > XB_SPIN_CAP) { atomicAdd(&bar[XB_TMO], 1u); break; } }
    }
    nloc = mine > 0u ? mine : 1u; nx = cnt > 0u ? cnt : 1u;
}
__device__ __forceinline__ void xcd_barrier(const XcdBarrier& b) {
    asm volatile("s_waitcnt vmcnt(0)" ::: "memory");
    __syncthreads();
    if (threadIdx.x == 0) {
        unsigned* bar = b.bar;
        __builtin_amdgcn_s_waitcnt(0);
        unsigned nloc = b.st[0], nx = b.st[1];
        if (nloc == 0u) { xcd_barrier_complete(bar, b.x, nloc, nx); b.st[0] = nloc; b.st[1] = nx; }
        const unsigned old = xb_add(&bar[XB_XSUB(b.x)], 1u);
        const unsigned gen = old / nloc;
        if (old + 1u == (gen + 1u) * nloc) {
            __builtin_amdgcn_fence(__ATOMIC_RELEASE, "agent");
            asm volatile("s_waitcnt vmcnt(0)" ::: "memory");
            const unsigned og = xb_add(&bar[XB_TOP], 1u);
            const unsigned tg = og / nx;
            if (og + 1u == (tg + 1u) * nx) xb_add(&bar[XB_TOPGEN], 1u);
            else XB_SPIN(xb_ld(&bar[XB_TOPGEN]) == tg, bar);
            __builtin_amdgcn_fence(__ATOMIC_ACQUIRE, "agent");
            xb_add(&bar[XB_XGEN(b.x)], 1u);
            asm volatile("s_waitcnt vmcnt(0)" ::: "memory");
        } else {
            XB_SPIN(xb_ld(&bar[XB_XGEN(b.x)]) == gen, bar);
            __builtin_amdgcn_fence(__ATOMIC_ACQUIRE, "agent");
            asm volatile("s_waitcnt vmcnt(0)" ::: "memory");
        }
    }
    __syncthreads();
}

struct Unit { int pm, pn; size_t a_off, b_off; int lbase, nvalid; };
struct Gemm { const bf16_t* A; const bf16_t* Bt; int lda, ldb, K; };
__host__ __device__ __forceinline__ int perm32(int rho) { const int n = rho >> 4, i = rho & 15; return 8 * (i >> 2) + 4 * n + (i & 3); }

struct PlainOrder {     static constexpr bool GATHER = false;
    int nM, nN, nwg, G, c, lda, ldb;
    __device__ void init(int M, int N, int G_, int c_, int lda_, int ldb_) { nM = M / 256; nN = N / 256; nwg = nM * nN; G = G_; c = c_; lda = lda_; ldb = ldb_; }
    __device__ bool next(int i, Unit& u) const {
        const long L = (long)i * G + c; if (L >= nwg) return false;
        int wgid = (int)L; { const int q = nwg / 8, r = nwg % 8, xcd = wgid % 8, off = wgid / 8; wgid = (xcd < r ? xcd * (q + 1) : r * (q + 1) + (xcd - r) * q) + off; }
        const int nig = 8 * nN, gid = wgid / nig, fm = gid * 8, gsz = (nM - fm) < 8 ? (nM - fm) : 8;
        u.pm = fm + ((wgid % nig) % gsz); u.pn = (wgid % nig) / gsz;
        u.a_off = (size_t)u.pm * 256 * lda; u.b_off = (size_t)u.pn * 256 * ldb; return true;
    }
};
struct XpreOrder {
    static constexpr bool GATHER = false;
    int G, c, mode;
    __device__ bool next(int i, Unit& u) const {
        const int L = i * G + c; if (L >= 256) return false;
        const int b = L >> 4, x = (L >> 2) & 3, y = L & 3;
        if (mode == 0) { const int h = x, kt = y; u.pm = b * 4 + h; u.pn = kt; u.a_off = (size_t)b * MEMLEN * DM + h * XHD; u.b_off = (size_t)kt * 256 * DM + h * XHD; }
        else { const int nt = x, h = y; u.pm = b * 4 + nt; u.pn = h; u.a_off = (size_t)nt * 256 * DM + h * XHD; u.b_off = (size_t)b * MEMLEN * DM + h * XHD; }
        return true;
    }
};
struct XattnOrder {
    static constexpr bool GATHER = false;
    int G, c, mode, lda;
    __device__ bool next(int i, Unit& u) const {
        const int L = i * G + c; if (L >= (NTOK / 256) * 4) return false;
        u.pm = L >> 2; u.pn = L & 3; const int b = u.pm >> 3;
        u.a_off = (size_t)u.pm * 256 * lda;
        u.b_off = mode == 0 ? (size_t)(b * 4 + u.pn) * 256 * DM : (size_t)(b * 1024 + u.pn * 256) * DM;
        return true;
    }
};
template <bool GATH_> struct MoeOrder {
    static constexpr bool GATHER = GATH_;
    const LAS int* ts; int G, c, lda, ldb; const int* ltok;
    __device__ bool next(int i, Unit& u) const {
        const int L = i * G + c; if (L >= ts[NEXP] * 4) return false;
        const int T = L >> 2, j = L & 3; int e = 0; while (ts[e + 1] <= T) ++e;
        const int lt = T - ts[e];
        u.pm = T; u.pn = j; u.a_off = GATH_ ? (size_t)0 : (size_t)T * 256 * lda; u.b_off = ((size_t)e * 1024 + j * 256) * ldb;
        u.lbase = e * LCAP + lt * 256; u.nvalid = ts[33 + e] - lt * 256; return true;
    }
    __device__ __forceinline__ unsigned rowoff(const Unit& u, int r) const { return (r < u.nvalid) ? (unsigned)ltok[u.lbase + r] * (unsigned)(LDH * 2) : 0u; }
};

template <class Epi, class Sched>
__device__ __forceinline__ void gemm_phase_simple(LAS unsigned char* lds, const Gemm g, const Sched& S, const Epi& E) {
    int tid = threadIdx.x; asm volatile("" : "+v"(tid));
    const int wid = __builtin_amdgcn_readfirstlane(tid >> 6), lane = tid & 63, wr = wid >> 2, wc = wid & 3, fr = lane & 15, fq = lane >> 4;
    Unit u;
    for (int i = 0; S.next(i, u); ++i) {
        f32x4 acc[2][2][4][2];
#pragma unroll
        for (int a = 0; a < 2; ++a)
#pragma unroll
            for (int b = 0; b < 2; ++b)
#pragma unroll
                for (int m = 0; m < 4; ++m)
#pragma unroll
                    for (int n = 0; n < 2; ++n) acc[a][b][m][n] = (f32x4){0.f, 0.f, 0.f, 0.f};
        const char* Ab = (const char*)(g.A + u.a_off); const char* Bb = (const char*)(g.Bt + u.b_off);
        const int c0 = Epi::PERM ? perm32(fr) : fr, c1 = Epi::PERM ? perm32(16 + fr) : 16 + fr;
        unsigned ao[2][4], bo[2][2];
#pragma unroll
        for (int ai = 0; ai < 2; ++ai)
#pragma unroll
            for (int m = 0; m < 4; ++m) ao[ai][m] = (unsigned)((128 * ai + 64 * wr + 16 * m + fr) * g.lda + 8 * fq) * 2u;
#pragma unroll
        for (int bj = 0; bj < 2; ++bj) { bo[bj][0] = (unsigned)((128 * bj + 32 * wc + c0) * g.ldb + 8 * fq) * 2u; bo[bj][1] = (unsigned)((128 * bj + 32 * wc + c1) * g.ldb + 8 * fq) * 2u; }
#pragma unroll 1
        for (int k0 = 0; k0 < g.K; k0 += 32) {
            if constexpr (Epi::MIDK) { if (k0 == (g.K >> 1)) E.midk(acc, u, wr, wc, fr, fq); }
            const char* Ak = Ab + (size_t)k0 * 2; const char* Bk = Bb + (size_t)k0 * 2;
            bf16x8 bfr[2][2];
#pragma unroll
            for (int bj = 0; bj < 2; ++bj) { bfr[bj][0] = *(const bf16x8*)(Bk + bo[bj][0]); bfr[bj][1] = *(const bf16x8*)(Bk + bo[bj][1]); }
#pragma unroll
            for (int ai = 0; ai < 2; ++ai) {
                bf16x8 af[4];
#pragma unroll
                for (int m = 0; m < 4; ++m) af[m] = *(const bf16x8*)(Ak + ao[ai][m]);
#pragma unroll
                for (int bj = 0; bj < 2; ++bj)
#pragma unroll
                    for (int m = 0; m < 4; ++m)
#pragma unroll
                        for (int n = 0; n < 2; ++n) acc[ai][bj][m][n] = __builtin_amdgcn_mfma_f32_16x16x32_bf16(bfr[bj][n], af[m], acc[ai][bj][m][n], 0, 0, 0);
            }
        }
        E(acc, u, wr, wc, fr, fq);
    }
}

__host__ __device__ __forceinline__ int lds_byte(int r, int c) { const int st = (r >> 4) * 2 + (c >> 5), rr = r & 15, cc = c & 31, ob = rr * 64 + cc * 2; return st * 1024 + (ob ^ (((ob >> 9) & 1) << 5)); }
__host__ __device__ __forceinline__ void stage_rc(int b, int& R, int& C) { const int st = b / 1024, sb = b % 1024, swz = sb ^ (((sb >> 9) & 1) << 5); R = (st >> 1) * 16 + swz / 64; C = (st & 1) * 32 + (swz % 64) / 2; }
template <class Epi, class Sched, bool ALIGN_EPI = false, bool SP2 = false>
__device__ __forceinline__ void gemm_phase(LAS unsigned char* lds, const Gemm g, const Sched& S, const Epi& E) {
    constexpr int BK = 64, HALF = 128, HTB = HALF * BK * 2;
    int tid = threadIdx.x; asm volatile("" : "+v"(tid));
    const int wid = __builtin_amdgcn_readfirstlane(tid >> 6), lane = tid & 63, wr = wid >> 2, wc = wid & 3, fr = lane & 15, fq = lane >> 4;
    const int K = g.K, nt = K / BK;
    unsigned voffA[2], voffB[2];
#pragma unroll
    for (int i = 0; i < 2; ++i) { int R, C; stage_rc(tid * 16 + i * 8192, R, C); const int Rb = Epi::PERM ? ((R & ~31) + perm32(R & 31)) : R;
        voffA[i] = (unsigned)(R * g.lda + C) * 2u; voffB[i] = (unsigned)(Rb * g.ldb + C) * 2u; }
    constexpr bool GATH = Sched::GATHER;
    unsigned vcu[2][2] = {{0u, 0u}, {0u, 0u}}, vnx[2][2] = {{0u, 0u}, {0u, 0u}}; int gR[2] = {0, 0}; unsigned gC[2] = {0u, 0u};
    if constexpr (GATH) {
#pragma unroll
        for (int i = 0; i < 2; ++i) { int R, Cq; stage_rc(tid * 16 + i * 8192, R, Cq); gR[i] = R; gC[i] = (unsigned)Cq * 2u; } }
    const size_t kstep = (size_t)(BK * 2);
    const size_t hstepA = (size_t)HALF * g.lda * 2, hstepB = (size_t)HALF * g.ldb * 2;
    const unsigned ldsw = (unsigned)wid * 1024u;
    const int aoff = lds_byte(wr * 64 + fr, fq * 8), boff = lds_byte(wc * 32 + fr, fq * 8);
#define PG8_SA(b, h) (((b) * 2 + (h)) * HTB)
#define PG8_SB(b, h) ((4 + (b) * 2 + (h)) * HTB)
#define PG8_STAGE(bufoff, gbase, voff) do { _Pragma("unroll") for (int _i = 0; _i < 2; ++_i) \
        __builtin_amdgcn_global_load_lds((const unsigned*)((const char*)(gbase) + (voff)[_i]), (LAS unsigned*)(lds + (bufoff) + ldsw + _i * 8192), 16, 0, 0); } while (0)
#define PG8_STA(bufoff, ptr, h, nx) do { if constexpr (GATH) { const unsigned vsel_[2] = {(nx) ? vnx[h][0] : vcu[h][0], (nx) ? vnx[h][1] : vcu[h][1]}; PG8_STAGE(bufoff, ptr, vsel_); } \
        else { PG8_STAGE(bufoff, (ptr) + (h) * hstepA, voffA); } } while (0)
#define PG8_LDA(dst, b, h) do { _Pragma("unroll") for (int m = 0; m < 4; ++m) _Pragma("unroll") for (int k = 0; k < 2; ++k) dst[m][k] = *(const LAS bf16x8*)(lds + PG8_SA(b, h) + aoff + m * 2048 + k * 1024); } while (0)
#define PG8_LDB(dst, b, h) do { _Pragma("unroll") for (int n = 0; n < 2; ++n) _Pragma("unroll") for (int k = 0; k < 2; ++k) dst[n][k] = *(const LAS bf16x8*)(lds + PG8_SB(b, h) + boff + n * 2048 + k * 1024); } while (0)
#define PG8_MMA(ai, bj, At, Bt) do { __builtin_amdgcn_s_setprio(1); _Pragma("unroll") for (int m = 0; m < 4; ++m) _Pragma("unroll") for (int n = 0; n < 2; ++n) _Pragma("unroll") for (int k = 0; k < 2; ++k) \
        acc[ai][bj][m][n] = __builtin_amdgcn_mfma_f32_16x16x32_bf16(Bt[n][k], At[m][k], acc[ai][bj][m][n], 0, 0, 0); __builtin_amdgcn_s_setprio(0); } while (0)
#define PG8_WAIT_V(n) asm volatile("s_waitcnt vmcnt(" #n ")" ::: "memory")
#define PG8_WAIT_L(n) asm volatile("s_waitcnt lgkmcnt(" #n ")" ::: "memory")
#define PG8_BAR __builtin_amdgcn_s_barrier()
#define PG8_SCHED __builtin_amdgcn_sched_barrier(0)
    Unit cur, nxt; int ui = 0;
    if (!S.next(0, cur)) return;
    f32x4 acc[2][2][4][2];
#pragma unroll
    for (int a = 0; a < 2; ++a)
#pragma unroll
        for (int b = 0; b < 2; ++b)
#pragma unroll
            for (int m = 0; m < 4; ++m)
#pragma unroll
                for (int n = 0; n < 2; ++n) acc[a][b][m][n] = (f32x4){0.f, 0.f, 0.f, 0.f};
    bf16x8 At[4][2], B0[2][2], B1[2][2];
    const char* cA = (const char*)(g.A + cur.a_off); const char* cB = (const char*)(g.Bt + cur.b_off);
    if constexpr (GATH) {
#pragma unroll
        for (int h = 0; h < 2; ++h)
#pragma unroll
            for (int i = 0; i < 2; ++i) vcu[h][i] = S.rowoff(cur, h * HALF + gR[i]) + gC[i]; }
    if constexpr (SP2) {
        PG8_STAGE(PG8_SB(0, 0), cB, voffB); PG8_STAGE(PG8_SB(0, 1), cB + hstepB, voffB); PG8_STA(PG8_SA(0, 0), cA, 0, false); PG8_STA(PG8_SA(0, 1), cA, 1, false);
        if (wr == 1) PG8_BAR;
        PG8_WAIT_V(2); PG8_BAR;
        PG8_STAGE(PG8_SB(1, 0), cB + kstep, voffB); PG8_STA(PG8_SA(1, 0), cA + kstep, 0, false); PG8_STAGE(PG8_SB(1, 1), cB + hstepB + kstep, voffB);
        PG8_WAIT_V(6); PG8_BAR;
    } else {
        PG8_STAGE(PG8_SB(0, 0), cB, voffB); PG8_STA(PG8_SA(0, 0), cA, 0, false); PG8_STAGE(PG8_SB(0, 1), cB + hstepB, voffB); PG8_STA(PG8_SA(0, 1), cA, 1, false);
        if (wr == 1) PG8_BAR;
        PG8_WAIT_V(4); PG8_BAR;
        PG8_STAGE(PG8_SB(1, 0), cB + kstep, voffB); PG8_STA(PG8_SA(1, 0), cA + kstep, 0, false); PG8_STAGE(PG8_SB(1, 1), cB + hstepB + kstep, voffB);
        PG8_WAIT_V(6); PG8_BAR;
    }
    for (;;) {
        const bool has_next = S.next(ui + 1, nxt);
        const char* nA = has_next ? (const char*)(g.A + nxt.a_off) : cA; const char* nB = has_next ? (const char*)(g.Bt + nxt.b_off) : cB;
        if constexpr (GATH) {
#pragma unroll
            for (int h = 0; h < 2; ++h)
#pragma unroll
                for (int i = 0; i < 2; ++i) vnx[h][i] = has_next ? (S.rowoff(nxt, h * HALF + gR[i]) + gC[i]) : vcu[h][i]; }
#pragma unroll 1
        for (int t = 0; t < nt; t += 2) {
            if constexpr (Epi::MIDK) { if (t == (nt >> 1)) E.midk(acc, cur, wr, wc, fr, fq); }
            const bool last = (t == nt - 2);
            const char* a1 = cA + (size_t)(t + 1) * kstep;
            const char* a2 = last ? nA : cA + (size_t)(t + 2) * kstep; const char* b2 = last ? nB : cB + (size_t)(t + 2) * kstep;
            const char* a3 = a2 + kstep; const char* b3 = b2 + kstep;
            if constexpr (SP2) {
            PG8_LDB(B0, 0, 0); PG8_LDB(B1, 0, 1); PG8_SCHED; PG8_LDA(At, 0, 0); PG8_STA(PG8_SA(1, 1), a1, 1, false);
            PG8_WAIT_V(8); PG8_WAIT_L(0); PG8_BAR; PG8_MMA(0, 0, At, B0); PG8_MMA(0, 1, At, B1); PG8_BAR; PG8_SCHED;
            PG8_LDA(At, 0, 1); PG8_STAGE(PG8_SB(0, 0), b2, voffB); PG8_STAGE(PG8_SB(0, 1), b2 + hstepB, voffB); PG8_STA(PG8_SA(0, 0), a2, 0, last);
            PG8_WAIT_V(8); PG8_WAIT_L(0); PG8_BAR; PG8_MMA(1, 0, At, B0); PG8_MMA(1, 1, At, B1); PG8_BAR; PG8_SCHED;
            PG8_LDB(B0, 1, 0); PG8_LDB(B1, 1, 1); PG8_SCHED; PG8_LDA(At, 1, 0); PG8_STA(PG8_SA(0, 1), a2, 1, last);
            PG8_WAIT_V(8); PG8_WAIT_L(0); PG8_BAR; PG8_MMA(0, 0, At, B0); PG8_MMA(0, 1, At, B1); PG8_BAR; PG8_SCHED;
            PG8_LDA(At, 1, 1); PG8_STAGE(PG8_SB(1, 0), b3, voffB); PG8_STAGE(PG8_SB(1, 1), b3 + hstepB, voffB); PG8_STA(PG8_SA(1, 0), a3, 0, last);
            PG8_WAIT_V(8); PG8_WAIT_L(0); PG8_BAR; PG8_MMA(1, 0, At, B0); PG8_MMA(1, 1, At, B1); PG8_BAR; PG8_SCHED;
            } else {
            PG8_LDB(B0, 0, 0); PG8_SCHED; PG8_LDA(At, 0, 0); PG8_STA(PG8_SA(1, 1), a1, 1, false);
            PG8_WAIT_L(8); PG8_BAR; PG8_WAIT_L(0); PG8_MMA(0, 0, At, B0); PG8_BAR; PG8_SCHED;
            PG8_LDB(B1, 0, 1); PG8_STAGE(PG8_SB(0, 0), b2, voffB);
            PG8_BAR; PG8_WAIT_L(0); PG8_MMA(0, 1, At, B1); PG8_BAR;
            PG8_LDA(At, 0, 1); PG8_STA(PG8_SA(0, 0), a2, 0, last);
            PG8_BAR; PG8_WAIT_L(0); PG8_MMA(1, 0, At, B0); PG8_BAR; PG8_SCHED;
            PG8_STAGE(PG8_SB(0, 1), b2 + hstepB, voffB);
            PG8_WAIT_V(6); PG8_BAR; PG8_MMA(1, 1, At, B1); PG8_BAR;
            PG8_LDB(B0, 1, 0); PG8_SCHED; PG8_LDA(At, 1, 0); PG8_STA(PG8_SA(0, 1), a2, 1, last);
            PG8_WAIT_L(8); PG8_BAR; PG8_WAIT_L(0); PG8_MMA(0, 0, At, B0); PG8_BAR; PG8_SCHED;
            PG8_LDB(B1, 1, 1); PG8_STAGE(PG8_SB(1, 0), b3, voffB);
            PG8_BAR; PG8_WAIT_L(0); PG8_MMA(0, 1, At, B1); PG8_BAR;
            PG8_LDA(At, 1, 1); PG8_STA(PG8_SA(1, 0), a3, 0, last);
            PG8_BAR; PG8_WAIT_L(0); PG8_MMA(1, 0, At, B0); PG8_BAR; PG8_SCHED;
            PG8_STAGE(PG8_SB(1, 1), b3 + hstepB, voffB);
            PG8_WAIT_V(6); PG8_BAR; PG8_MMA(1, 1, At, B1); PG8_BAR;
            }
        }
        if constexpr (ALIGN_EPI) { if (wr == 0) PG8_BAR; }
        E(acc, cur, wr, wc, fr, fq);
        if (!has_next) break;
#pragma unroll
        for (int a = 0; a < 2; ++a)
#pragma unroll
            for (int b = 0; b < 2; ++b)
#pragma unroll
                for (int m = 0; m < 4; ++m)
#pragma unroll
                    for (int n = 0; n < 2; ++n) acc[a][b][m][n] = (f32x4){0.f, 0.f, 0.f, 0.f};
        cur = nxt; cA = nA; cB = nB; ++ui;
        if constexpr (GATH) {
#pragma unroll
            for (int h = 0; h < 2; ++h)
#pragma unroll
                for (int i = 0; i < 2; ++i) vcu[h][i] = vnx[h][i]; }
        if constexpr (ALIGN_EPI) { if (wr == 1) PG8_BAR; }
    }
    PG8_WAIT_V(0);
    if constexpr (!ALIGN_EPI) { if (wr == 0) PG8_BAR; }
    PG8_BAR;
#undef PG8_SA
#undef PG8_SB
#undef PG8_STAGE
#undef PG8_STA
#undef PG8_LDA
#undef PG8_LDB
#undef PG8_MMA
#undef PG8_WAIT_V
#undef PG8_WAIT_L
#undef PG8_BAR
#undef PG8_SCHED
}
#ifdef GEMM_SIMPLE
#define GEMM_PHASE(lds, g, S, E) gemm_phase_simple(lds, g, S, E)
#else
#define GEMM_PHASE(lds, g, S, E) gemm_phase<decltype(E), decltype(S), true, true>(lds, g, S, E)
#endif

__device__ __forceinline__ float rstd_from_ssq(const float* ssq, int row) {
    const f32x4* p = (const f32x4*)(ssq + (size_t)row * 16); const f32x4 a = p[0], b = p[1], c = p[2], d = p[3];
    const float s = ((a[0] + a[1]) + (a[2] + a[3])) + ((b[0] + b[1]) + (b[2] + b[3])) + ((c[0] + c[1]) + (c[2] + c[3])) + ((d[0] + d[1]) + (d[2] + d[3]));
    return __builtin_amdgcn_rsqf(s * (1.0f / DM) + EPS);
}
__device__ __forceinline__ u32x4 pack8(const f32x4 v0, const f32x4 v1) { u32x4 w; w.x = cvt_pk_bf16(v0[0], v0[1]); w.y = cvt_pk_bf16(v0[2], v0[3]); w.z = cvt_pk_bf16(v1[0], v1[1]); w.w = cvt_pk_bf16(v1[2], v1[3]); return w; }

struct EpiProj {
    static constexpr bool PERM = true, LDSX = false, MIDK = false;
    bf16_t* base; const float* rope; float* ksum;
    __device__ __forceinline__ void operator()(f32x4 (&acc)[2][2][4][2], const Unit& u, int wr, int wc, int fr, int fq) const {
        const int type = u.pn >> 1, colt = (u.pn & 1) * 256;
        bf16_t* O = base + (size_t)type * NTOK * 512;
        const bool is_q = (type == 2), is_k = (type == 3);
        if ((is_q || is_k) && !(wc & 1)) {
#pragma unroll
            for (int ai = 0; ai < 2; ++ai)
#pragma unroll
                for (int m = 0; m < 4; ++m) {
                    const int row = u.pm * 256 + 128 * ai + 64 * wr + 16 * m + fr, pos = row & (SEQ - 1);
                    const float* rp = rope + pos * 16;
                    const f32x4 cs[2] = { *(const f32x4*)(rp), *(const f32x4*)(rp + 4) }, sn[2] = { *(const f32x4*)(rp + 8), *(const f32x4*)(rp + 12) };
#pragma unroll
                    for (int bj = 0; bj < 2; ++bj)
#pragma unroll
                        for (int n = 0; n < 2; ++n) {
                            const f32x4 mine = acc[ai][bj][m][n]; f32x4 oth;
#pragma unroll
                            for (int e = 0; e < 4; ++e) oth[e] = __shfl_xor(mine[e], 16);
                            f32x4 res = mine;
                            if (fq == 0) res = mine * cs[n] - oth * sn[n];
                            else if (fq == 1) res = mine * cs[n] + oth * sn[n];
                            acc[ai][bj][m][n] = res;
                        }
                }
        }
        const float sc = is_q ? QSCALE : 1.0f;
#pragma unroll
        for (int ai = 0; ai < 2; ++ai)
#pragma unroll
            for (int m = 0; m < 4; ++m) {
                const int row = u.pm * 256 + 128 * ai + 64 * wr + 16 * m + fr;
                bf16_t* rowp = O + (size_t)row * 512 + colt + 32 * wc + 8 * fq;
#pragma unroll
                for (int bj = 0; bj < 2; ++bj) *(u32x4*)(rowp + bj * 128) = pack8(acc[ai][bj][m][0] * sc, acc[ai][bj][m][1] * sc);
            }
        if (is_k) {
#pragma unroll
            for (int bj = 0; bj < 2; ++bj)
#pragma unroll
                for (int n = 0; n < 2; ++n)
#pragma unroll
                    for (int e = 0; e < 4; ++e) {
                        float s = 0.f;
#pragma unroll
                        for (int ai = 0; ai < 2; ++ai)
#pragma unroll
                            for (int m = 0; m < 4; ++m) s += acc[ai][bj][m][n][e];
                        s += __shfl_xor(s, 1); s += __shfl_xor(s, 2); s += __shfl_xor(s, 4); s += __shfl_xor(s, 8);
                        if (fr == 0) atomicAdd(ksum + (size_t)u.pm * 512 + colt + 128 * bj + 32 * wc + 8 * fq + 4 * n + e, s);
                    }
        }
    }
};
struct EpiStore {
    static constexpr bool PERM = true, LDSX = false, MIDK = false;
    bf16_t* O; int ldc;
    __device__ __forceinline__ void operator()(f32x4 (&acc)[2][2][4][2], const Unit& u, int wr, int wc, int fr, int fq) const {
#pragma unroll
        for (int ai = 0; ai < 2; ++ai)
#pragma unroll
            for (int m = 0; m < 4; ++m) {
                const int row = u.pm * 256 + 128 * ai + 64 * wr + 16 * m + fr;
                bf16_t* rowp = O + (size_t)row * ldc + u.pn * 256 + 32 * wc + 8 * fq;
#pragma unroll
                for (int bj = 0; bj < 2; ++bj) *(u32x4*)(rowp + bj * 128) = pack8(acc[ai][bj][m][0], acc[ai][bj][m][1]);
            }
    }
};
template <bool BASE_F32, bool KSPLIT> struct EpiResid {
    static constexpr bool PERM = false, LDSX = false, MIDK = KSPLIT;
    const void* base; bf16_t* hb; float* ssq; const float* ssql; const float* ssqa;
    __device__ __forceinline__ void stats(int row, int fq, float& rl, float& ra) const {
        const f32x4 pl = *(const f32x4*)(ssql + (size_t)row * 16 + 4 * fq); const f32x2 pa = *(const f32x2*)(ssqa + (size_t)row * 8 + 2 * fq);
        float sl = (pl[0] + pl[1]) + (pl[2] + pl[3]), sa = pa[0] + pa[1];
        sl += __shfl_xor(sl, 16); sl += __shfl_xor(sl, 32); sa += __shfl_xor(sa, 16); sa += __shfl_xor(sa, 32);
        rl = __builtin_amdgcn_rsqf(sl * (1.0f / 512.0f) + EPS); ra = __builtin_amdgcn_rsqf(sa * (1.0f / 512.0f) + EPS);
    }
    __device__ __forceinline__ void midk(f32x4 (&acc)[2][2][4][2], const Unit& u, int wr, int wc, int fr, int fq) const {
        asm volatile("" : "+v"(fr), "+v"(fq));
#pragma unroll
        for (int ai = 0; ai < 2; ++ai)
#pragma unroll
            for (int m = 0; m < 4; ++m) { float rl, ra; stats(u.pm * 256 + 128 * ai + 64 * wr + 16 * m + fr, fq, rl, ra); const float ratio = rl * __builtin_amdgcn_rcpf(ra);
#pragma unroll
                for (int bj = 0; bj < 2; ++bj)
#pragma unroll
                    for (int n = 0; n < 2; ++n) acc[ai][bj][m][n] *= ratio; }
    }
    __device__ __forceinline__ void operator()(f32x4 (&acc)[2][2][4][2], const Unit& u, int wr, int wc, int fr, int fq) const {
#pragma unroll
        for (int ai = 0; ai < 2; ++ai)
#pragma unroll
            for (int m = 0; m < 4; ++m) {
                const int row = u.pm * 256 + 128 * ai + 64 * wr + 16 * m + fr; float q = 0.f, osc = 1.0f;
                if constexpr (KSPLIT) { float rl; stats(row, fq, rl, osc); }
#pragma unroll
                for (int bj = 0; bj < 2; ++bj)
#pragma unroll
                    for (int n = 0; n < 2; ++n) {
                        const int col = u.pn * 256 + 128 * bj + 32 * wc + 16 * n + 4 * fq;
                        f32x4 bv;
                        if constexpr (BASE_F32) bv = *(const f32x4*)((const float*)base + (size_t)row * DM + col);
                        else { const u32x2 w = *(const u32x2*)((const bf16_t*)base + (size_t)row * LDH + col); bv = (f32x4){bflo(w.x), bfhi(w.x), bflo(w.y), bfhi(w.y)}; }
                        const f32x4 v = bv + acc[ai][bj][m][n] * osc;
                        q += (v[0] * v[0] + v[1] * v[1]) + (v[2] * v[2] + v[3] * v[3]);
                        u32x2 w; w.x = cvt_pk_bf16(v[0], v[1]); w.y = cvt_pk_bf16(v[2], v[3]); *(u32x2*)(hb + (size_t)row * LDH + col) = w;
                    }
                q += __shfl_xor(q, 16); q += __shfl_xor(q, 32);
                if (fq == 0) ssq[(size_t)row * 16 + u.pn * 4 + wc] = q;
            }
    }
};
struct EpiRowScale {
    static constexpr bool PERM = true, LDSX = false, MIDK = false;
    bf16_t* O; int ldc; const float* ssq; float cs;
    __device__ __forceinline__ void operator()(f32x4 (&acc)[2][2][4][2], const Unit& u, int wr, int wc, int fr, int fq) const {
#pragma unroll
        for (int ai = 0; ai < 2; ++ai)
#pragma unroll
            for (int m = 0; m < 4; ++m) {
                const int row = u.pm * 256 + 128 * ai + 64 * wr + 16 * m + fr; const float s = rstd_from_ssq(ssq, row) * cs;
                bf16_t* rowp = O + (size_t)row * ldc + u.pn * 256 + 32 * wc + 8 * fq;
#pragma unroll
                for (int bj = 0; bj < 2; ++bj) *(u32x4*)(rowp + bj * 128) = pack8(acc[ai][bj][m][0] * s, acc[ai][bj][m][1] * s);
            }
    }
};
#define XBAR() do { asm volatile("s_waitcnt lgkmcnt(0)" ::: "memory"); __builtin_amdgcn_s_barrier(); asm volatile("" ::: "memory"); } while (0)
struct EpiSoftmax {
    static constexpr bool PERM = true, LDSX = false, MIDK = false;
    bf16_t* O; int ldc; LAS unsigned char* xl; const float* ssq; float cs;
    __device__ __forceinline__ void operator()(f32x4 (&acc)[2][2][4][2], const Unit& u, int wr, int wc, int fr, int fq) const {
        LAS float* P = (LAS float*)xl;
        LAS float* Q = (LAS float*)(xl + 4096);
#pragma unroll
        for (int ai = 0; ai < 2; ++ai)
#pragma unroll
            for (int m = 0; m < 4; ++m) {
                float v = -INFINITY; const float sc = rstd_from_ssq(ssq, u.pm * 256 + 128 * ai + 64 * wr + 16 * m + fr) * cs;
#pragma unroll
                for (int bj = 0; bj < 2; ++bj)
#pragma unroll
                    for (int n = 0; n < 2; ++n) { const f32x4 x = acc[ai][bj][m][n] * sc; acc[ai][bj][m][n] = x; v = fmaxf(v, fmaxf(fmaxf(x[0], x[1]), fmaxf(x[2], x[3]))); }
                v = fmaxf(v, __shfl_xor(v, 16)); v = fmaxf(v, __shfl_xor(v, 32));
                if (fq == 0) P[(128 * ai + 64 * wr + 16 * m + fr) * 4 + wc] = v;
            }
        XBAR();
#pragma unroll
        for (int ai = 0; ai < 2; ++ai)
#pragma unroll
            for (int m = 0; m < 4; ++m) {
                const int r = 128 * ai + 64 * wr + 16 * m + fr;
                const float v = fmaxf(fmaxf(P[r * 4 + 0], P[r * 4 + 1]), fmaxf(P[r * 4 + 2], P[r * 4 + 3]));
                float s = 0.f;
#pragma unroll
                for (int bj = 0; bj < 2; ++bj)
#pragma unroll
                    for (int n = 0; n < 2; ++n) { f32x4 x = acc[ai][bj][m][n];
#pragma unroll
                        for (int e = 0; e < 4; ++e) { x[e] = __builtin_amdgcn_exp2f(x[e] - v); s += x[e]; }
                        acc[ai][bj][m][n] = x; }
                s += __shfl_xor(s, 16); s += __shfl_xor(s, 32);
                if (fq == 0) Q[r * 4 + wc] = s;
            }
        XBAR();
#pragma unroll
        for (int ai = 0; ai < 2; ++ai)
#pragma unroll
            for (int m = 0; m < 4; ++m) {
                const int r = 128 * ai + 64 * wr + 16 * m + fr;
                const float inv = 1.0f / ((Q[r * 4 + 0] + Q[r * 4 + 1]) + (Q[r * 4 + 2] + Q[r * 4 + 3]));
                bf16_t* rowp = O + (size_t)(u.pm * 256 + r) * ldc + u.pn * 256 + 32 * wc + 8 * fq;
#pragma unroll
                for (int bj = 0; bj < 2; ++bj) *(u32x4*)(rowp + bj * 128) = pack8(acc[ai][bj][m][0] * inv, acc[ai][bj][m][1] * inv);
            }
        XBAR();
    }
};
struct EpiGateUp {
    static constexpr bool PERM = true, LDSX = false, MIDK = false;
    bf16_t* O; const float* lrs;
    __device__ __forceinline__ void operator()(f32x4 (&acc)[2][2][4][2], const Unit& u, int wr, int wc, int fr, int fq) const {
#pragma unroll
        for (int ai = 0; ai < 2; ++ai)
#pragma unroll
            for (int m = 0; m < 4; ++m) {
                const int r = 128 * ai + 64 * wr + 16 * m + fr, row = u.pm * 256 + r; const float rs = (r < u.nvalid) ? lrs[u.lbase + r] : 0.f;
                f32x4 o[2];
#pragma unroll
                for (int n = 0; n < 2; ++n)
#pragma unroll
                    for (int e = 0; e < 4; ++e) { const float g = acc[ai][0][m][n][e] * rs, up = acc[ai][1][m][n][e] * rs; o[n][e] = g * sigmoidf_(g) * up; }
                *(u32x4*)(O + (size_t)row * DFF + u.pn * 128 + 32 * wc + 8 * fq) = pack8(o[0], o[1]);
            }
    }
};

struct Args { const float* in[27]; float* out; unsigned char* ws; int ph_lo, ph_hi; float invf[8]; };
struct Ctx { LAS unsigned char* lds; int tid, lane, wave, vcu, G; };

__device__ __forceinline__ void tr_item(const float* W, int ldw, int k0, int n0s, bf16_t* WT, int ldt, int r0d, const float* gain, LAS float* scr, int lane) {
    const int kr = lane >> 3, ch = lane & 7;
    f32x4 v[8];
#pragma unroll
    for (int i = 0; i < 8; ++i) v[i] = *(const f32x4*)(W + (size_t)(k0 + 8 * i + kr) * ldw + n0s + 4 * ch);
    const int c = lane & 7;
    f32x4 g0 = {1.f, 1.f, 1.f, 1.f}, g1 = {1.f, 1.f, 1.f, 1.f};
    if (gain) { g0 = *(const f32x4*)(gain + k0 + 8 * c); g1 = *(const f32x4*)(gain + k0 + 8 * c + 4); }
#pragma unroll
    for (int i = 0; i < 8; ++i) { LAS float* d = scr + (8 * i + kr) * 33 + 4 * ch; d[0] = v[i][0]; d[1] = v[i][1]; d[2] = v[i][2]; d[3] = v[i][3]; }
    LDS_WAIT(); asm volatile("" ::: "memory");
#pragma unroll
    for (int j = 0; j < 4; ++j) { const int n = (lane >> 3) + 8 * j; const LAS float* s = scr + (8 * c) * 33 + n;
        u32x4 o; o.x = cvt_pk_bf16(s[0 * 33] * g0[0], s[1 * 33] * g0[1]); o.y = cvt_pk_bf16(s[2 * 33] * g0[2], s[3 * 33] * g0[3]); o.z = cvt_pk_bf16(s[4 * 33] * g1[0], s[5 * 33] * g1[1]); o.w = cvt_pk_bf16(s[6 * 33] * g1[2], s[7 * 33] * g1[3]);
        *(u32x4*)(WT + (size_t)(r0d + n) * ldt + k0 + 8 * c) = o; }
    LDS_WAIT(); asm volatile("" ::: "memory");
}
__device__ __forceinline__ void rms_row_to_bf16(const float* xrow, const float* gain, bf16_t* orow, int lane) {
    const f32x4* xr = (const f32x4*)xrow + lane; const f32x4* gr = (const f32x4*)gain + lane;
    f32x4 v[4]; float s = 0.f;
#pragma unroll
    for (int j = 0; j < 4; ++j) { v[j] = xr[64 * j]; s += (v[j][0] * v[j][0] + v[j][1] * v[j][1]) + (v[j][2] * v[j][2] + v[j][3] * v[j][3]); }
    const float rstd = 1.0f / sqrtf(wave_sum(s) * (1.0f / DM) + EPS);
    u32x2* o8 = (u32x2*)orow + lane;
#pragma unroll
    for (int j = 0; j < 4; ++j) { const f32x4 g = gr[64 * j]; u32x2 w; w.x = cvt_pk_bf16(v[j][0] * rstd * g[0], v[j][1] * rstd * g[1]); w.y = cvt_pk_bf16(v[j][2] * rstd * g[2], v[j][3] * rstd * g[3]); o8[64 * j] = w; }
}

__device__ __forceinline__ void rms_row2_to_bf16(const float* xrow, const float* gain, bf16_t* orow, int lane) {
    const f32x4* xr = (const f32x4*)xrow + lane; const f32x4* gr = (const f32x4*)gain + lane;
    f32x4 v[2][4]; float s[2] = {0.f, 0.f};
#pragma unroll
    for (int r = 0; r < 2; ++r)
#pragma unroll
        for (int j = 0; j < 4; ++j) v[r][j] = xr[256 * r + 64 * j];
#pragma unroll
    for (int r = 0; r < 2; ++r)
#pragma unroll
        for (int j = 0; j < 4; ++j) s[r] += (v[r][j][0] * v[r][j][0] + v[r][j][1] * v[r][j][1]) + (v[r][j][2] * v[r][j][2] + v[r][j][3] * v[r][j][3]);
#pragma unroll
    for (int r = 0; r < 2; ++r) { const float rstd = 1.0f / sqrtf(wave_sum(s[r]) * (1.0f / DM) + EPS); u32x2* o8 = (u32x2*)(orow + (size_t)r * DM) + lane;
#pragma unroll
        for (int j = 0; j < 4; ++j) { const f32x4 g = gr[64 * j]; u32x2 w; w.x = cvt_pk_bf16(v[r][j][0] * rstd * g[0], v[r][j][1] * rstd * g[1]); w.y = cvt_pk_bf16(v[r][j][2] * rstd * g[2], v[r][j][3] * rstd * g[3]); o8[64 * j] = w; } }
}

__device__ __forceinline__ void ph_prologue(const Args& a, const Ctx& C) {
    unsigned char* ws = a.ws;
    LAS float* scr = (LAS float*)(C.lds + C.wave * 16384);
    const int gw = C.vcu * 8 + C.wave, NGW = C.G * 8, lane = C.lane;
    for (int it = gw; it < 16 * 80; it += NGW) { const int kb = it / 80, nb = it % 80; tr_item(a.in[3], DIN, 64 * kb, 32 * nb, (bf16_t*)(ws + WS_WIN), DM, 32 * nb, nullptr, scr, lane); }
    for (int it = gw; it < 16 * 64; it += NGW) { const int kb = it / 64, nb = it % 64;
        if (nb < 32) tr_item(a.in[17], 2 * DM, 64 * kb, 32 * nb, (bf16_t*)(ws + WS_WXK), DM, 32 * nb, nullptr, scr, lane);
        else tr_item(a.in[17], 2 * DM, 64 * kb, 32 * nb, (bf16_t*)(ws + WS_WXV), DM, 32 * (nb - 32), nullptr, scr, lane); }
    for (int it = gw; it < 16 * 32; it += NGW) { const int kb = it / 32, nb = it % 32;
        tr_item(a.in[13], DM, 64 * kb, 32 * nb, (bf16_t*)(ws + WS_WOUT), DM, 32 * nb, (kb < 8) ? a.in[11] : (a.in[12] - DLRU), scr, lane);
        tr_item(a.in[18], DM, 64 * kb, 32 * nb, (bf16_t*)(ws + WS_WXO), DM, 32 * nb, nullptr, scr, lane); }
    for (int it = gw; it < NEXP * 16 * 32; it += NGW) { const int e = it / 512, r = it % 512, kb = r / 32, nb = r % 32, j = nb >> 3, half = (nb >> 2) & 1, q = nb & 3;
        tr_item(a.in[24] + (size_t)e * DM * DM, DM, 64 * kb, half * 512 + j * 128 + q * 32, (bf16_t*)(ws + WS_WGU), DM, e * 1024 + j * 256 + half * 128 + q * 32, a.in[19], scr, lane); }
    for (int it = gw; it < NEXP * 8 * 32; it += NGW) { const int e = it / 256, r = it % 256, kb = r / 32, nb = r % 32;
        tr_item(a.in[25] + (size_t)e * DFF * DM, DM, 64 * kb, 32 * nb, (bf16_t*)(ws + WS_WDN), DFF, e * 1024 + 32 * nb, nullptr, scr, lane); }
    for (int r = gw; r < DM; r += NGW) { const float gk = a.in[14][r]; const f32x4* src = (const f32x4*)(a.in[16] + (size_t)r * DM) + lane; u32x2* dst = (u32x2*)((bf16_t*)(ws + WS_WXQ) + (size_t)r * DM) + lane;
#pragma unroll
        for (int j = 0; j < 4; ++j) { const f32x4 v = src[64 * j]; u32x2 w; w.x = cvt_pk_bf16(v[0] * gk, v[1] * gk); w.y = cvt_pk_bf16(v[2] * gk, v[3] * gk); dst[64 * j] = w; } }
    { bf16_t* WR = (bf16_t*)(ws + WS_WR); const int gt = C.vcu * 512 + C.tid, NT = C.G * 512;
      for (int i = gt; i < 48 * DM; i += NT) { const int r = i / DM, k = i % DM; float v = 0.f;
          if (r < 4) v = a.in[20][k * NGRP + r] * a.in[19][k]; else if (r < 36) v = a.in[22][k * NEXP + (r - 4)] * a.in[19][k];
          WR[i] = (bf16_t)(cvt_pk_bf16(v, 0.f) & 0xffffu); }
      float* rope = (float*)(ws + WS_ROPE);
      for (int i = gt; i < SEQ * 8; i += NT) { const int pos = i >> 3, j = i & 7; const float ang = (float)pos * a.invf[j];
          const double tw = 6.283185307179586476925286766559; const double ad = (double)ang; const double red = ad - tw * __builtin_rint(ad / tw); const float rf = (float)red;
          rope[pos * 16 + j] = __cosf(rf); rope[pos * 16 + 8 + j] = __sinf(rf); } }
    for (int m = 2 * gw; m < NTOK; m += 2 * NGW) rms_row2_to_bf16(a.in[0] + (size_t)m * DM, a.in[2], (bf16_t*)(ws + WS_B) + (size_t)m * DM, lane);
    for (int m = 2 * gw; m < NMEM; m += 2 * NGW) rms_row2_to_bf16(a.in[1] + (size_t)m * DM, a.in[15], (bf16_t*)(ws + WS_MEMN) + (size_t)m * DM, lane);
}

__device__ __forceinline__ float gelu_tanh(float x) { const float x2 = x * x; const float z2 = x * (-2.0f * 0.7978845608028654f * 1.4426950408889634f) * (1.0f + 0.044715f * x2);
    return x * __builtin_amdgcn_rcpf(1.0f + __builtin_amdgcn_exp2f(z2)); }
__device__ __forceinline__ float one_minus_exp(float x) {
    const float p = -x * (1.0f + x * (0.5f + x * (0.16666667f + x * (0.041666668f + x * 0.0083333338f))));
    const float e = 1.0f - __builtin_amdgcn_exp2f(x * 1.4426950408889634f);
    return (x > -0.25f) ? p : e;
}
__device__ __forceinline__ void lru_unit(const Args& a, const Ctx& C, int b, int blk, int half) {
    unsigned char* ws = a.ws;
    const bf16_t* XL = (const bf16_t*)(ws + WS_A); const bf16_t* GL = XL + (size_t)NTOK * 512; bf16_t* YC = (bf16_t*)(ws + WS_C); float* SSQL = (float*)(ws + WS_SSQL);
    const int tid = C.tid, lane = C.lane, wave = C.wave, fr = lane & 15, fq = lane >> 4;
    LAS float* XW = (LAS float*)(C.lds + wave * 5120);
    LAS bf16_t* GW = (LAS bf16_t*)(C.lds + wave * 5120 + 2304);
    LAS bf16_t* YW = (LAS bf16_t*)(C.lds + wave * 5120 + 3584);
    LAS float* WSUM = (LAS float*)(C.lds + 40960);
    LAS float* CW = (LAS float*)(C.lds + 45056);
    const int c0 = blk * 64, oc0 = c0 + half * 32;
    bf16x8 wfr[2][2][2];
#pragma unroll
    for (int gt = 0; gt < 2; ++gt) { const float* W = a.in[gt == 0 ? 6 : 8] + (size_t)blk * 64 * 64;
#pragma unroll
        for (int nt = 0; nt < 2; ++nt)
#pragma unroll
            for (int ks = 0; ks < 2; ++ks) { u32x4 w; float f[8];
#pragma unroll
                for (int j = 0; j < 8; ++j) f[j] = W[(32 * ks + 8 * fq + j) * 64 + half * 32 + 16 * nt + fr];
                w.x = cvt_pk_bf16(f[0], f[1]); w.y = cvt_pk_bf16(f[2], f[3]); w.z = cvt_pk_bf16(f[4], f[5]); w.w = cvt_pk_bf16(f[6], f[7]);
                wfr[gt][nt][ks] = __builtin_bit_cast(bf16x8, w); } }
    float brg[2], big[2], sp[2], hc[2] = {0.f, 0.f};
#pragma unroll
    for (int nt = 0; nt < 2; ++nt) { const int ch = oc0 + 16 * nt + fr; brg[nt] = a.in[7][ch] * -1.4426950408889634f; big[nt] = a.in[9][ch] * -1.4426950408889634f; const float lam = a.in[10][ch];
        sp[nt] = -8.0f * 1.4426950408889634f * ((lam > 15.f) ? __expf(-lam) : log1pf(__expf(-lam))); }
    if (tid < 320) { const int k = tid >> 6, c = tid & 63; CW[tid] = (k < 4) ? a.in[4][k * DLRU + c0 + c] : a.in[5][c0 + c]; }
    u32x4 xrs[2][4][2], grs[2];
    const bf16_t* xrow0 = XL + ((size_t)b * SEQ + 16 * wave + fr) * 512 + c0 + 8 * fq;
    const bf16_t* grow0 = GL + ((size_t)b * SEQ + 16 * wave + (lane >> 2)) * 512 + oc0 + 8 * (lane & 3);
    const int tloc = 16 * wave + fr;
#define LRU_PREFETCH(t0_, xr, gr) do { _Pragma("unroll") for (int k = 0; k < 4; ++k) { const int tt = (t0_) + tloc - 3 + k; \
        if (tt >= 0) { const bf16_t* xp = xrow0 + (ptrdiff_t)((t0_) - 3 + k) * 512; xr[k][0] = *(const u32x4*)xp; xr[k][1] = *(const u32x4*)(xp + 32); } else { xr[k][0] = (u32x4){0u, 0u, 0u, 0u}; xr[k][1] = (u32x4){0u, 0u, 0u, 0u}; } } \
        gr = *(const u32x4*)(grow0 + (size_t)(t0_) * 512); } while (0)
    LRU_PREFETCH(0, xrs[0], grs[0]); LRU_PREFETCH(128, xrs[1], grs[1]);
    __syncthreads();
    for (int ch2 = 0; ch2 < SEQ / 256; ++ch2) {
#pragma unroll
      for (int sub = 0; sub < 2; ++sub) { const int ch = 2 * ch2 + sub, t0 = ch * 128; auto& xr = xrs[sub]; auto& gr = grs[sub];
        bf16x8 af[2];
#pragma unroll
        for (int ks = 0; ks < 2; ++ks) { float accv[8];
            { const f32x4 b0 = *(const LAS f32x4*)(CW + 256 + 32 * ks + 8 * fq), b1 = *(const LAS f32x4*)(CW + 256 + 32 * ks + 8 * fq + 4);
              accv[0] = b0[0]; accv[1] = b0[1]; accv[2] = b0[2]; accv[3] = b0[3]; accv[4] = b1[0]; accv[5] = b1[1]; accv[6] = b1[2]; accv[7] = b1[3]; }
#pragma unroll
            for (int k = 0; k < 4; ++k) { const f32x4 w0 = *(const LAS f32x4*)(CW + 64 * k + 32 * ks + 8 * fq), w1 = *(const LAS f32x4*)(CW + 64 * k + 32 * ks + 8 * fq + 4); const u32x4 x = xr[k][ks];
                accv[0] += w0[0] * bflo(x.x); accv[1] += w0[1] * bfhi(x.x); accv[2] += w0[2] * bflo(x.y); accv[3] += w0[3] * bfhi(x.y);
                accv[4] += w1[0] * bflo(x.z); accv[5] += w1[1] * bfhi(x.z); accv[6] += w1[2] * bflo(x.w); accv[7] += w1[3] * bfhi(x.w); }
            u32x4 p; p.x = cvt_pk_bf16(accv[0], accv[1]); p.y = cvt_pk_bf16(accv[2], accv[3]); p.z = cvt_pk_bf16(accv[4], accv[5]); p.w = cvt_pk_bf16(accv[6], accv[7]);
            af[ks] = __builtin_bit_cast(bf16x8, p);
            if (ks == half) { *(LAS f32x4*)(XW + fr * 36 + 8 * fq) = (f32x4){accv[0], accv[1], accv[2], accv[3]}; *(LAS f32x4*)(XW + fr * 36 + 8 * fq + 4) = (f32x4){accv[4], accv[5], accv[6], accv[7]}; } }
        *(LAS u32x4*)(GW + (lane >> 2) * 40 + 8 * (lane & 3)) = gr;
        if (ch + 2 < SEQ / 128) LRU_PREFETCH(t0 + 256, xr, gr);
        LDS_WAIT(); asm volatile("" ::: "memory");
        float Hl[2][4], Al[2][4], Aex[2], Hex[2];
        { f32x4 ar[2] = {{0.f, 0.f, 0.f, 0.f}, {0.f, 0.f, 0.f, 0.f}}, ai_[2] = {{0.f, 0.f, 0.f, 0.f}, {0.f, 0.f, 0.f, 0.f}};
#pragma unroll
          for (int ks = 0; ks < 2; ++ks)
#pragma unroll
              for (int nt = 0; nt < 2; ++nt) { ar[nt] = __builtin_amdgcn_mfma_f32_16x16x32_bf16(af[ks], wfr[0][nt][ks], ar[nt], 0, 0, 0); ai_[nt] = __builtin_amdgcn_mfma_f32_16x16x32_bf16(af[ks], wfr[1][nt][ks], ai_[nt], 0, 0, 0); }
#pragma unroll
          for (int nt = 0; nt < 2; ++nt) {
              float hrun = 0.f, arun = 1.f;
#pragma unroll
              for (int r = 0; r < 4; ++r) { const int chn = 16 * nt + fr;
                  const float rg = __builtin_amdgcn_rcpf(1.0f + __builtin_amdgcn_exp2f(__builtin_fmaf(ar[nt][r], -1.4426950408889634f, brg[nt])));
                  const float ig = __builtin_amdgcn_rcpf(1.0f + __builtin_amdgcn_exp2f(__builtin_fmaf(ai_[nt][r], -1.4426950408889634f, big[nt])));
                  const float av = __builtin_amdgcn_exp2f(rg * sp[nt]); const float mult = __builtin_amdgcn_sqrtf(fmaxf(1.0f - av * av, 0.f));
                  const float uv = mult * ig * XW[(4 * fq + r) * 36 + chn];
                  hrun = av * hrun + uv; arun *= av; Hl[nt][r] = hrun; Al[nt][r] = arun; }
              const float A0 = __shfl(arun, fr), H0 = __shfl(hrun, fr), A1 = __shfl(arun, fr + 16), H1 = __shfl(hrun, fr + 16), A2 = __shfl(arun, fr + 32), H2 = __shfl(hrun, fr + 32), A3 = __shfl(arun, fr + 48), H3 = __shfl(hrun, fr + 48);
              const float h01 = A1 * H0 + H1, a01 = A1 * A0, h012 = A2 * h01 + H2, a012 = A2 * a01;
              Aex[nt] = (fq == 0) ? 1.f : (fq == 1) ? A0 : (fq == 2) ? a01 : a012;
              Hex[nt] = (fq == 0) ? 0.f : (fq == 1) ? H0 : (fq == 2) ? h01 : h012;
              if (fq == 0) *(LAS f32x2*)(WSUM + (((ch & 1) * 8 + wave) * 32 + 16 * nt + fr) * 2) = (f32x2){A3 * a012, A3 * h012 + H3}; } }
        __syncthreads();
        { float ssr[4] = {0.f, 0.f, 0.f, 0.f};
#pragma unroll
          for (int nt = 0; nt < 2; ++nt) { const int chn = 16 * nt + fr; float x = hc[nt], mine = 0.f;
#pragma unroll
              for (int w2 = 0; w2 < 8; ++w2) { const f32x2 sm = *(const LAS f32x2*)(WSUM + (((ch & 1) * 8 + w2) * 32 + chn) * 2); if (w2 == wave) mine = x; x = sm[0] * x + sm[1]; }
              hc[nt] = x;
              const float hstart = Aex[nt] * mine + Hex[nt];
#pragma unroll
              for (int r = 0; r < 4; ++r) { const int tl = 4 * fq + r; const float h = Al[nt][r] * hstart + Hl[nt][r];
                  const float y = h * gelu_tanh(bf2f(GW[tl * 40 + chn])); const unsigned yb = cvt_pk_bf16(y, 0.f) & 0xffffu; YW[tl * 40 + chn] = (bf16_t)yb;
                  const float yr = __uint_as_float(yb << 16); ssr[r] += yr * yr; } }
#pragma unroll
          for (int r = 0; r < 4; ++r) { float q = ssr[r]; q += __shfl_xor(q, 1); q += __shfl_xor(q, 2); q += __shfl_xor(q, 4); q += __shfl_xor(q, 8);
              if (fr == 0) SSQL[((size_t)b * SEQ + t0 + 16 * wave + 4 * fq + r) * 16 + blk * 2 + half] = q; } }
        LDS_WAIT(); asm volatile("" ::: "memory");
        *(u32x4*)(YC + ((size_t)b * SEQ + t0 + 16 * wave + (lane >> 2)) * DM + oc0 + 8 * (lane & 3)) = *(const LAS u32x4*)(YW + (lane >> 2) * 40 + 8 * (lane & 3));
      }
    }
#undef LRU_PREFETCH
    __syncthreads();
}

__device__ __forceinline__ void moba_unit_simple(const Args& a, const Ctx& C, int b, int h, int qb) {
    unsigned char* ws = a.ws;
    const bf16_t* Q = (const bf16_t*)(ws + WS_A) + (size_t)2 * NTOK * 512; const bf16_t* K = Q + (size_t)NTOK * 512; const bf16_t* V = K + (size_t)NTOK * 512;
    bf16_t* YA = (bf16_t*)(ws + WS_B) + (size_t)NTOK * 512; const float* KSUM = (const float*)(ws + WS_KSUM);
    const int q = C.tid & 255, hf = C.tid >> 8; const size_t row = (size_t)b * SEQ + qb * 256 + q;
    float qv[64];
    { const u32x4* qp = (const u32x4*)(Q + row * 512 + h * 64);
#pragma unroll
      for (int i = 0; i < 8; ++i) { const u32x4 w = qp[i]; qv[8 * i] = bflo(w.x); qv[8 * i + 1] = bfhi(w.x); qv[8 * i + 2] = bflo(w.y); qv[8 * i + 3] = bfhi(w.y); qv[8 * i + 4] = bflo(w.z); qv[8 * i + 5] = bfhi(w.z); qv[8 * i + 6] = bflo(w.w); qv[8 * i + 7] = bfhi(w.w); } }
    unsigned sel = 0u;
    { float g[8];
#pragma unroll
      for (int n = 0; n < 8; ++n) { g[n] = -INFINITY;
          if (n < qb) { const float* ks = KSUM + (size_t)(b * 8 + n) * 512 + h * 64; float s = 0.f;
#pragma unroll
              for (int d = 0; d < 64; ++d) s += qv[d] * ks[d];
              g[n] = s; } }
      const int npick = qb < 3 ? qb : 3;
      for (int p = 0; p < npick; ++p) { int best = -1; float bv = -INFINITY;
#pragma unroll
          for (int n = 0; n < 8; ++n) { const bool ok = (n < qb) && !((sel >> n) & 1u) && (best < 0 || g[n] > bv); if (ok) { best = n; bv = g[n]; } }
          if (best >= 0) sel |= 1u << best; } }
    float o[32], mrun = -1e30f, l = 0.f;
#pragma unroll
    for (int d = 0; d < 32; ++d) o[d] = 0.f;
    for (int n = 0; n <= qb; ++n) {
        const bool own = (n == qb); const bool use = own || ((sel >> n) & 1u);
        if (!__any(use)) continue;
        for (int j = 0; j < 256; ++j) {
            const bool valid = use && (!own || j <= q);
            if (!__any(valid)) continue;
            const size_t krow = (size_t)b * SEQ + n * 256 + j;
            const u32x4* kp = (const u32x4*)(K + krow * 512 + h * 64); float s = 0.f;
#pragma unroll
            for (int i = 0; i < 8; ++i) { const u32x4 w = kp[i];
                s += qv[8 * i] * bflo(w.x) + qv[8 * i + 1] * bfhi(w.x) + qv[8 * i + 2] * bflo(w.y) + qv[8 * i + 3] * bfhi(w.y) + qv[8 * i + 4] * bflo(w.z) + qv[8 * i + 5] * bfhi(w.z) + qv[8 * i + 6] * bflo(w.w) + qv[8 * i + 7] * bfhi(w.w); }
            if (valid) {
                const float mnew = fmaxf(mrun, s), f = __builtin_amdgcn_exp2f(mrun - mnew), p = __builtin_amdgcn_exp2f(s - mnew);
                l = l * f + p; mrun = mnew;
                const u32x4* vp = (const u32x4*)(V + krow * 512 + h * 64 + 32 * hf);
#pragma unroll
                for (int i = 0; i < 4; ++i) { const u32x4 w = vp[i];
                    o[8 * i] = o[8 * i] * f + p * bflo(w.x); o[8 * i + 1] = o[8 * i + 1] * f + p * bfhi(w.x); o[8 * i + 2] = o[8 * i + 2] * f + p * bflo(w.y); o[8 * i + 3] = o[8 * i + 3] * f + p * bfhi(w.y);
                    o[8 * i + 4] = o[8 * i + 4] * f + p * bflo(w.z); o[8 * i + 5] = o[8 * i + 5] * f + p * bfhi(w.z); o[8 * i + 6] = o[8 * i + 6] * f + p * bflo(w.w); o[8 * i + 7] = o[8 * i + 7] * f + p * bfhi(w.w); }
            }
        }
    }
    const float inv = 1.0f / l;
    u32x4* op = (u32x4*)(YA + row * 512 + h * 64 + 32 * hf);
#pragma unroll
    for (int i = 0; i < 4; ++i) { u32x4 w; w.x = cvt_pk_bf16(o[8 * i] * inv, o[8 * i + 1] * inv); w.y = cvt_pk_bf16(o[8 * i + 2] * inv, o[8 * i + 3] * inv); w.z = cvt_pk_bf16(o[8 * i + 4] * inv, o[8 * i + 5] * inv); w.w = cvt_pk_bf16(o[8 * i + 6] * inv, o[8 * i + 7] * inv); op[i] = w; }
}

__device__ __forceinline__ void ph_ymix(const Args& a, const Ctx& C) {
    const bf16_t* YL = (const bf16_t*)(a.ws + WS_B); const bf16_t* YA = YL + (size_t)NTOK * 512; bf16_t* YM = (bf16_t*)(a.ws + WS_C);
    const int gw = C.vcu * 8 + C.wave, NGW = C.G * 8, lane = C.lane;
    for (int m = gw; m < NTOK; m += NGW) {
#pragma unroll
        for (int part = 0; part < 2; ++part) {
            const u32x4 w = *((const u32x4*)((part ? YA : YL) + (size_t)m * 512) + lane);
            float v[8] = {bflo(w.x), bfhi(w.x), bflo(w.y), bfhi(w.y), bflo(w.z), bfhi(w.z), bflo(w.w), bfhi(w.w)}; float s = 0.f;
#pragma unroll
            for (int i = 0; i < 8; ++i) s += v[i] * v[i];
            const float rstd = 1.0f / sqrtf(wave_sum(s) * (1.0f / 512.0f) + EPS);
            u32x4 o; o.x = cvt_pk_bf16(v[0] * rstd, v[1] * rstd); o.y = cvt_pk_bf16(v[2] * rstd, v[3] * rstd); o.z = cvt_pk_bf16(v[4] * rstd, v[5] * rstd); o.w = cvt_pk_bf16(v[6] * rstd, v[7] * rstd);
            *((u32x4*)(YM + (size_t)m * DM + part * 512) + lane) = o;
        }
    }
}

__device__ __forceinline__ void ph_router(const Args& a, const Ctx& C) {
    unsigned char* ws = a.ws;
    const bf16_t* H2B = (const bf16_t*)a.out + DM; const bf16_t* WR = (const bf16_t*)(ws + WS_WR); const float* SSQ2 = (const float*)(ws + WS_SSQ2);
    unsigned* CNT = (unsigned*)(ws + WS_CTL) + CW_CNT;
    int* TOKE = (int*)(ws + WS_TOK + TOK_E); int* TOKR = (int*)(ws + WS_TOK + TOK_R); float* TOKG = (float*)(ws + WS_TOK + TOK_G); int* LTOK = (int*)(ws + WS_LTOK); float* LRS = (float*)(ws + WS_LRS);
    constexpr int WRS = 1032;
    LAS bf16_t* WRL = (LAS bf16_t*)C.lds;
    LAS float* LG = (LAS float*)(C.lds + 99072) + C.wave * (16 * 49);
    LAS unsigned* lcnt = (LAS unsigned*)(C.lds + 99072 + 25088); LAS unsigned* lbase = lcnt + 32;
    const int lane = C.lane, fr = lane & 15, fq = lane >> 4;
    for (int i = C.tid; i < 48 * 128; i += 512) { const int r = i >> 7, c8 = i & 127; *(LAS u32x4*)(WRL + r * WRS + 8 * c8) = *(const u32x4*)(WR + (size_t)r * DM + 8 * c8); }
    for (int pass = 0; (pass * C.G) * 128 < NTOK; ++pass) {
        const int blk = pass * C.G + C.vcu; const bool live = blk * 128 < NTOK;
        if (C.tid < 32) lcnt[C.tid] = 0u;
        __syncthreads();
        int E1 = 0, E2 = 0; unsigned r1 = 0, r2 = 0; float ga = 0.f, gb = 0.f, rstd_t = 0.f; const int tb = blk * 128 + 16 * C.wave;
        if (live) {
            f32x4 acc[3] = {{0.f, 0.f, 0.f, 0.f}, {0.f, 0.f, 0.f, 0.f}, {0.f, 0.f, 0.f, 0.f}};
            bf16x8 af[32];
#pragma unroll
            for (int ks = 0; ks < 32; ++ks) af[ks] = *(const bf16x8*)(H2B + (size_t)(tb + fr) * LDH + 32 * ks + 8 * fq);
#pragma unroll
            for (int ks = 0; ks < 32; ++ks) {
#pragma unroll
                for (int nt = 0; nt < 3; ++nt) { const bf16x8 bfg = *(const LAS bf16x8*)(WRL + (16 * nt + fr) * WRS + 32 * ks + 8 * fq); acc[nt] = __builtin_amdgcn_mfma_f32_16x16x32_bf16(af[ks], bfg, acc[nt], 0, 0, 0); } }
#pragma unroll
            for (int nt = 0; nt < 3; ++nt)
#pragma unroll
                for (int r = 0; r < 4; ++r) LG[(4 * fq + r) * 49 + 16 * nt + fr] = acc[nt][r];
            LDS_WAIT(); asm volatile("" ::: "memory");
            if (lane < 16) { const int t = tb + lane; const float rstd = rstd_from_ssq(SSQ2, t); rstd_t = rstd; const LAS float* lg = LG + lane * 49;
                float g[4]; int grp = 0;
#pragma unroll
                for (int i = 0; i < 4; ++i) g[i] = lg[i] * rstd + a.in[21][i];
#pragma unroll
                for (int i = 1; i < 4; ++i) if (g[i] > g[grp]) grp = i;
                float gs = 0.f;
#pragma unroll
                for (int i = 0; i < 4; ++i) gs += __expf(g[i] - g[grp]);
                const float gw_ = 1.0f / gs;
                float e[8];
#pragma unroll
                for (int i = 0; i < 8; ++i) e[i] = lg[4 + 8 * grp + i] * rstd + a.in[23][8 * grp + i];
                int i1 = 0;
#pragma unroll
                for (int i = 1; i < 8; ++i) if (e[i] > e[i1]) i1 = i;
                int i2 = (i1 == 0) ? 1 : 0;
#pragma unroll
                for (int i = 0; i < 8; ++i) if (i != i1 && i != i2 && e[i] > e[i2]) i2 = i;
                const float eb = __expf(e[i2] - e[i1]); ga = gw_ / (1.0f + eb); gb = gw_ * eb / (1.0f + eb);
                E1 = grp * 8 + i1; E2 = grp * 8 + i2;
                r1 = atomicAdd((unsigned*)&lcnt[E1], 1u); r2 = atomicAdd((unsigned*)&lcnt[E2], 1u);
            }
        }
        __syncthreads();
        if (C.tid < 32) lbase[C.tid] = lcnt[C.tid] ? __hip_atomic_fetch_add(CNT + C.tid, lcnt[C.tid], __ATOMIC_RELAXED, __HIP_MEMORY_SCOPE_AGENT) : 0u;
        __syncthreads();
        if (live && lane < 16) { const int t = tb + lane;
            const int k1 = (int)(lbase[E1] + r1), k2 = (int)(lbase[E2] + r2);
            TOKE[2 * t] = E1; TOKR[2 * t] = k1; TOKG[2 * t] = ga; LTOK[E1 * LCAP + k1] = t; LRS[E1 * LCAP + k1] = rstd_t;
            TOKE[2 * t + 1] = E2; TOKR[2 * t + 1] = k2; TOKG[2 * t + 1] = gb; LTOK[E2 * LCAP + k2] = t; LRS[E2 * LCAP + k2] = rstd_t; }
        __syncthreads();
    }
}
__device__ __forceinline__ void moe_table(const Args& a, const Ctx& C) {
    LAS int* ts = (LAS int*)(C.lds + MOE_OFF);
    if (C.tid == 0) { const unsigned* CNT = (const unsigned*)(a.ws + WS_CTL) + CW_CNT; int acc = 0;
        for (int e = 0; e < NEXP; ++e) { ts[e] = acc; const unsigned c = __hip_atomic_load(CNT + e, __ATOMIC_RELAXED, __HIP_MEMORY_SCOPE_AGENT); ts[33 + e] = (int)c; acc += (int)((c + 255u) >> 8); }
        ts[NEXP] = acc; }
    __syncthreads();
}
__device__ __forceinline__ void ph_final(const Args& a, const Ctx& C, float* outp) {
    unsigned char* ws = a.ws;
    const bf16_t* YB = (const bf16_t*)(ws + WS_A); const float* TOKG = (const float*)(ws + WS_TOK + TOK_G); const int* TOKE = (const int*)(ws + WS_TOK + TOK_E); const int* TOKR = (const int*)(ws + WS_TOK + TOK_R);
    const LAS int* ts = (const LAS int*)(C.lds + MOE_OFF);
    const bf16_t* H2B = (const bf16_t*)a.out + DM; const float* gf = a.in[26];
    const int gw = C.vcu * 8 + C.wave, NGW = C.G * 8, lane = C.lane;
    f32x4 gn[4];
#pragma unroll
    for (int q = 0; q < 4; ++q) gn[q] = *(const f32x4*)(gf + 512 * (q >> 1) + 8 * lane + 4 * (q & 1));
    const int nit = (NTOK + NGW - 1) / NGW;
    int dnx = 0; float gnx = 0.f;
#define FIN_IDX(ib) do { const int tt_ = gw + ((ib) + (lane >> 1)) * NGW; dnx = 0; gnx = 0.f; \
        if (lane < 8 && tt_ < NTOK) { const int e_ = TOKE[2 * tt_ + (lane & 1)]; dnx = ts[e_] * 256 + TOKR[2 * tt_ + (lane & 1)]; gnx = TOKG[2 * tt_ + (lane & 1)]; } } while (0)
    FIN_IDX(0);
    for (int ib = 0; ib < nit; ib += 4) {
        const int dcur = dnx; const float gcur = gnx;
        if (ib + 4 < nit) FIN_IDX(ib + 4);
        u32x4 hw[4][2], y0[4][2], y1[4][2];
#pragma unroll
        for (int j = 0; j < 4; ++j) { const int t = gw + (ib + j) * NGW; const int d0 = __builtin_amdgcn_readlane(dcur, 2 * j), d1 = __builtin_amdgcn_readlane(dcur, 2 * j + 1);
            if (t < NTOK) {
#pragma unroll
                for (int hf = 0; hf < 2; ++hf) { hw[j][hf] = *((const u32x4*)(H2B + (size_t)t * LDH + 512 * hf) + lane); y0[j][hf] = *((const u32x4*)(YB + (size_t)d0 * DM + 512 * hf) + lane); y1[j][hf] = *((const u32x4*)(YB + (size_t)d1 * DM + 512 * hf) + lane); } } }
#pragma unroll
        for (int j = 0; j < 4; ++j) { const int t = gw + (ib + j) * NGW;
            const float g0 = __builtin_bit_cast(float, __builtin_amdgcn_readlane(__builtin_bit_cast(int, gcur), 2 * j)), g1 = __builtin_bit_cast(float, __builtin_amdgcn_readlane(__builtin_bit_cast(int, gcur), 2 * j + 1));
            if (t < NTOK) { float v[16]; float s2 = 0.f;
#pragma unroll
                for (int hf = 0; hf < 2; ++hf)
#pragma unroll
                    for (int e = 0; e < 4; ++e) { const unsigned h = hw[j][hf][e], p = y0[j][hf][e], q = y1[j][hf][e];
                        const float lo = bflo(h) + g0 * bflo(p) + g1 * bflo(q), hi = bfhi(h) + g0 * bfhi(p) + g1 * bfhi(q); v[8 * hf + 2 * e] = lo; v[8 * hf + 2 * e + 1] = hi; s2 += lo * lo + hi * hi; }
                const float rstd = __builtin_amdgcn_rsqf(wave_sum(s2) * (1.0f / DM) + EPS);
#pragma unroll
                for (int q = 0; q < 4; ++q) { const f32x4 o = {v[4 * q] * rstd * gn[q][0], v[4 * q + 1] * rstd * gn[q][1], v[4 * q + 2] * rstd * gn[q][2], v[4 * q + 3] * rstd * gn[q][3]};
                    *(f32x4*)(outp + (size_t)t * DM + 512 * (q >> 1) + 8 * lane + 4 * (q & 1)) = o; } } }
    }
#undef FIN_IDX
}

#include <hip/hip_bf16.h>
#include <cmath>
namespace attn_body {
using bf16=__hip_bfloat16;
using bf16x8=__attribute__((ext_vector_type(8)))short;
using s16x4=__attribute__((ext_vector_type(4)))short;
using f32x16=__attribute__((ext_vector_type(16)))float;
using u32x4=__attribute__((ext_vector_type(4)))unsigned;
using f32x4_t=__attribute__((ext_vector_type(4)))float;
constexpr int BATCH=16,NHEAD=8,SEQ=2048,D=64,DM=NHEAD*D,DMO=1024;
constexpr int NW=8,QBLK=32,QB=QBLK*NW,KVBLK=64,NQB=SEQ/QB;
constexpr int ATTN_PITCH=DM, ATTN_UNIT_ROWS=QB;
__device__ __forceinline__ int crow(int r,int hi){return (r&3)+8*(r>>2)+4*hi;}
#define SBAR() __builtin_amdgcn_sched_barrier(0)
__device__ __forceinline__ void cmask(f32x16&p0,f32x16&p1,int jb,int qrel,int hi){
  const float NEG=-INFINITY; int kb=64*jb+4*hi; asm volatile("":"+v"(kb));
  #pragma unroll
  for(int r=0;r<16;++r){int kv=kb+(r&3)+8*(r>>2); if(kv>qrel)p0[r]=NEG; if(kv+32>qrel)p1[r]=NEG;}
}

constexpr int NSLOT=3, SLOTB=8192;
constexpr int LDS_K=0, LDS_V=NSLOT*SLOTB, LDS_WS=2*NSLOT*SLOTB, LDS_OST=LDS_WS+NW*64*4, LDS_BYTES=LDS_OST+NW*4096;
constexpr float C2=0.125f*1.4426950408889634f;
__device__ __forceinline__ void glds16(const char*sbase,unsigned voff,unsigned lds_dst){unsigned keep;
  asm volatile("s_nop 4\n\ts_mov_b32 %0, m0\n\ts_mov_b32 m0, %3\n\ts_nop 0\n\tglobal_load_lds_dwordx4 %1, %2\n\ts_mov_b32 m0, %0":"=&s"(keep):"v"(voff),"s"(sbase),"s"(lds_dst):"memory");}
__device__ __forceinline__ const char* uni_ptr(const void*p){const unsigned long long v=(unsigned long long)p;const unsigned lo=__builtin_amdgcn_readfirstlane((unsigned)v),hi=__builtin_amdgcn_readfirstlane((unsigned)(v>>32));return (const char*)(((unsigned long long)hi<<32)|lo);}
__device__ __forceinline__ float max3f(float a,float b,float c){float r;asm("v_max3_f32 %0, %1, %2, %3":"=v"(r):"v"(a),"v"(b),"v"(c));return r;}
__device__ __forceinline__ float max2f(float a,float b){float r;asm("v_max_f32_e32 %0, %1, %2":"=v"(r):"v"(a),"v"(b));return r;}
__device__ __forceinline__ float fadd_s(float a,float b){float r;asm("v_add_f32_e32 %0, %1, %2":"=v"(r):"v"(a),"v"(b));return r;}
__device__ __forceinline__ float fsub_s(float a,float b){float r;asm("v_sub_f32_e32 %0, %1, %2":"=v"(r):"v"(a),"v"(b));return r;}
typedef float f32x2_t __attribute__((ext_vector_type(2))); typedef __bf16 bf16x2_t __attribute__((ext_vector_type(2)));
__device__ __forceinline__ unsigned cvtpk_s(float lo,float hi){f32x2_t v={lo,hi};bf16x2_t b=__builtin_convertvector(v,bf16x2_t);return __builtin_bit_cast(unsigned,b);}
#define WAIT_BAR(N) asm volatile("s_waitcnt vmcnt(" #N ") lgkmcnt(0)\n\ts_barrier":::"memory")

__device__ __forceinline__ void qkt(f32x16&p0,f32x16&p1,const char*Kslot,const bf16x8*qr,const f32x16&negm,int r32,int hi){
  const char*kb=Kslot+hi*1024+r32*16;
  #pragma unroll
  for(int d0=0;d0<4;++d0){
    const bf16x8 b0=*reinterpret_cast<const bf16x8*>(kb+d0*2048);
    const bf16x8 b1=*reinterpret_cast<const bf16x8*>(kb+d0*2048+512);
    if(d0==0){p0=__builtin_amdgcn_mfma_f32_32x32x16_bf16(b0,qr[0],negm,0,0,0);p1=__builtin_amdgcn_mfma_f32_32x32x16_bf16(b1,qr[0],negm,0,0,0);}
    else{p0=__builtin_amdgcn_mfma_f32_32x32x16_bf16(b0,qr[d0],p0,0,0,0);p1=__builtin_amdgcn_mfma_f32_32x32x16_bf16(b1,qr[d0],p1,0,0,0);}}
}
typedef __attribute__((address_space(3))) const char* lds_cptr;
typedef short v4i16_t __attribute__((ext_vector_type(4)));
__device__ __forceinline__ void kload8(bf16x8*kf,lds_cptr kp){
  kf[0]=*(const __attribute__((address_space(3))) bf16x8*)(kp);      kf[1]=*(const __attribute__((address_space(3))) bf16x8*)(kp+512);
  kf[2]=*(const __attribute__((address_space(3))) bf16x8*)(kp+2048); kf[3]=*(const __attribute__((address_space(3))) bf16x8*)(kp+2560);
  kf[4]=*(const __attribute__((address_space(3))) bf16x8*)(kp+4096); kf[5]=*(const __attribute__((address_space(3))) bf16x8*)(kp+4608);
  kf[6]=*(const __attribute__((address_space(3))) bf16x8*)(kp+6144); kf[7]=*(const __attribute__((address_space(3))) bf16x8*)(kp+6656);
}
__device__ __forceinline__ void kload2(bf16x8*kf,lds_cptr kp,int j){ kf[2*j]=*(const __attribute__((address_space(3))) bf16x8*)(kp+j*2048); kf[2*j+1]=*(const __attribute__((address_space(3))) bf16x8*)(kp+j*2048+512); }
__device__ __forceinline__ s16x4 vtr(lds_cptr p){ return __builtin_bit_cast(s16x4,__builtin_amdgcn_ds_read_tr16_b64_v4i16((__attribute__((address_space(3))) v4i16_t*)p)); }
__device__ __forceinline__ float rowmax(const f32x16&p0,const f32x16&p1){
  float a=max3f(p0[0],p0[1],p1[0]),b=max3f(p0[2],p0[3],p1[1]);a=max3f(a,p1[2],p1[3]);
  #pragma unroll
  for(int r=4;r<16;r+=4){a=max3f(a,p0[r],p0[r+1]);b=max3f(b,p0[r+2],p0[r+3]);a=max3f(a,p1[r],p1[r+1]);b=max3f(b,p1[r+2],p1[r+3]);}
  const float m=max2f(a,b);
  auto rr=__builtin_amdgcn_permlane32_swap(__float_as_uint(m),__float_as_uint(m),false,false);
  return max2f(__uint_as_float(rr[0]),__uint_as_float(rr[1]));
}
__device__ __forceinline__ void pv(f32x16*o,int vb,bf16x8 pa0,bf16x8 pa1,bf16x8 pa2,bf16x8 pa3){
  #pragma unroll
  for(int d0=0;d0<2;++d0){s16x4 lo[4],hi[4];
    #pragma unroll
    for(int ks=0;ks<4;++ks){
      asm volatile("ds_read_b64_tr_b16 %0,%1 offset:%c2":"=&v"(lo[ks]):"v"(vb),"i"(d0*4096+ks*1024):"memory");
      asm volatile("ds_read_b64_tr_b16 %0,%1 offset:%c2":"=&v"(hi[ks]):"v"(vb),"i"(d0*4096+ks*1024+512):"memory");}
    asm volatile("s_waitcnt lgkmcnt(0)":::"memory");SBAR();
    #define PK(k) (bf16x8){lo[k][0],lo[k][1],lo[k][2],lo[k][3],hi[k][0],hi[k][1],hi[k][2],hi[k][3]}
    o[d0]=__builtin_amdgcn_mfma_f32_32x32x16_bf16(pa0,PK(0),o[d0],0,0,0);
    o[d0]=__builtin_amdgcn_mfma_f32_32x32x16_bf16(pa1,PK(1),o[d0],0,0,0);
    o[d0]=__builtin_amdgcn_mfma_f32_32x32x16_bf16(pa2,PK(2),o[d0],0,0,0);
    o[d0]=__builtin_amdgcn_mfma_f32_32x32x16_bf16(pa3,PK(3),o[d0],0,0,0);
    #undef PK
  }
}

#ifndef ATTN_STORE16
#define ATTN_STORE16(p,v) (*(u32x4*)(p)=(v))
#endif
template<int THRL> __device__ __forceinline__ void attn_unit(int b,int h,int qb,const bf16*Q,const bf16*__restrict__ K,const bf16*__restrict__ V,bf16*O,const float*__restrict__ KSUM,float*__restrict__ SSQA,char*shm){
  int tid=threadIdx.x; asm volatile("":"+v"(tid));
  const int lane=tid&63,r32=lane&31,hi=lane>>5; const int wid=__builtin_amdgcn_readfirstlane(tid>>6);
  const long rowbase=(long)b*SEQ; const int q0=qb*QB;
  const bf16*Qw=Q+(rowbase+q0+wid*QBLK)*DM+h*D;
  const bf16*Kh=K+rowbase*DM+h*D,*Vh=V+rowbase*DM+h*D;
  const unsigned lds0=(unsigned)(uintptr_t)shm;
  float*wsf=(float*)(shm+LDS_WS)+wid*64;
  const char*Khu=uni_ptr(Kh);const char*Vhu=uni_ptr(Vh);
  const unsigned kvo=(unsigned)(lane*DM+wid*8)*2u;
  const unsigned vvo=(unsigned)((16*(wid&3)+(lane>>2))*DM+(wid>>2)*32+(lane&3)*8)*2u;
  const unsigned kdst=lds0+LDS_K+wid*1024, vdst=lds0+LDS_V+wid*1024;
  #define DMA_K(t,slot) glds16(Khu+(size_t)(t)*(KVBLK*DM*2),kvo,(unsigned)__builtin_amdgcn_readfirstlane(kdst+(slot)))
  #define DMA_V(t,slot) glds16(Vhu+(size_t)(t)*(KVBLK*DM*2),vvo,(unsigned)__builtin_amdgcn_readfirstlane(vdst+(slot)))
  const int vb0=(int)(lds0+LDS_V)+((lane>>4)&1)*32+(lane&3)*8+(4*hi+((lane&15)>>2))*64;
  const char*Kbase=shm+LDS_K; bf16x8 kf[8];
  const lds_cptr shm3=(lds_cptr)shm; const lds_cptr kp0=shm3+LDS_K+hi*1024+r32*16; const lds_cptr vp0=shm3+LDS_V+((lane>>4)&1)*32+(lane&3)*8+(4*hi+((lane&15)>>2))*64;
  const int NT=(q0+QB)/KVBLK;
  DMA_K(0,0);DMA_V(0,0);DMA_K(1,SLOTB);
  bf16x8 qr[4];
  #pragma unroll
  for(int d0=0;d0<4;++d0)qr[d0]=*reinterpret_cast<const bf16x8*>(&Qw[(long)r32*DM+d0*16+hi*8]);
  unsigned selm=1u<<qb;
  { float g[8];
    #pragma unroll
    for(int n=0;n<8;++n){ g[n]=-INFINITY;
      if(n<qb){ const float*ks=KSUM+(long)(b*8+n)*DM+h*D+hi*8; float s=0.f;
        #pragma unroll
        for(int d0=0;d0<4;++d0){ const f32x4_t k0=*reinterpret_cast<const f32x4_t*>(ks+d0*16), k1=*reinterpret_cast<const f32x4_t*>(ks+d0*16+4);
          const u32x4 qw=__builtin_bit_cast(u32x4,qr[d0]);
          s+=__uint_as_float(qw[0]<<16)*k0[0]+__uint_as_float(qw[0]&0xffff0000u)*k0[1]+__uint_as_float(qw[1]<<16)*k0[2]+__uint_as_float(qw[1]&0xffff0000u)*k0[3]
            +__uint_as_float(qw[2]<<16)*k1[0]+__uint_as_float(qw[2]&0xffff0000u)*k1[1]+__uint_as_float(qw[3]<<16)*k1[2]+__uint_as_float(qw[3]&0xffff0000u)*k1[3]; }
        s+=__shfl_xor(s,32); g[n]=s; } }
    const int npick=qb<3?qb:3;
    for(int p=0;p<npick;++p){ int best=-1; float bv=-INFINITY;
      #pragma unroll
      for(int n=0;n<8;++n){ const bool ok=(n<qb)&&!((selm>>n)&1u)&&(best<0||g[n]>bv); if(ok){best=n;bv=g[n];} }
      if(best>=0)selm|=1u<<best; } }
  #define BMASK(P0,P1,t) do{ float bias_=((selm>>((t)>>2))&1u)?-mhat:-INFINITY; asm volatile("":"+v"(bias_)); _Pragma("unroll") for(int r=0;r<16;++r){P0[r]+=bias_;P1[r]+=bias_;} }while(0)
  float mhat=0.f,l_reg=0.f;f32x16 o[2];{float z0_=0.f;asm volatile("":"+v"(z0_));_Pragma("unroll") for(int r=0;r<16;++r){o[0][r]=z0_;o[1][r]=z0_;}}const f32x16 negm=f32x16{};
  const int qrel=wid*QBLK+r32;
  #define CMASK(P0,P1,t) do{int jb_=(t)-(NT-4); if(jb_>=0)cmask(P0,P1,jb_,qrel,hi);}while(0)
  bool resc=false;
  #define START(P0,P1) do{ const float rm=__builtin_fmaxf(rowmax(P0,P1),-100.0f); resc=false; \
    { const float dl=rm; mhat=fadd_s(mhat,dl); \
      _Pragma("unroll") for(int r=0;r<16;++r){P0[r]=fsub_s(P0[r],dl);P1[r]=fsub_s(P1[r],dl);} \
      } \
    _Pragma("unroll") for(int r=0;r<16;++r)P0[r]=__builtin_amdgcn_exp2f(P0[r]); }while(0)
  #define RESC() do{ if(resc){ asm volatile("s_waitcnt lgkmcnt(0)":::"memory"); \
      _Pragma("unroll") for(int d_=0;d_<2;++d_) _Pragma("unroll") for(int r=0;r<16;++r)o[d_][r]*=wsf[crow(r,hi)]; } }while(0)
  f32x16 pA0,pA1,pB0,pB1;
  int sl_prev=0,sl_cur=0,sl_next=SLOTB;
  #define ROT() do{sl_prev=sl_cur;sl_cur=sl_next;sl_next=(sl_next==(NSLOT-1)*SLOTB)?0:sl_next+SLOTB;}while(0)
  DMA_K(2,2*SLOTB);
  WAIT_BAR(3);
  qkt(pA0,pA1,Kbase,qr,negm,r32,hi);asm volatile("s_nop 15\n\ts_nop 7":"+v"(pA0),"+v"(pA1));CMASK(pA0,pA1,0);BMASK(pA0,pA1,0);
  START(pA0,pA1);
  _Pragma("unroll") for(int r=0;r<16;++r)pA1[r]=__builtin_amdgcn_exp2f(pA1[r]);
  WAIT_BAR(0);
  DMA_K(3,0);DMA_V(1,SLOTB);
  ROT();
  kload8(kf,kp0+sl_cur);
  WAIT_BAR(2);
  s16x4 vlo[8],vhi[8]; u32x4 pw0,pw1,pw2,pw3;
  #define PKW(P,B) cvtpk_s(P[B],P[B+1])
  #define PAF(k) __builtin_bit_cast(bf16x8,pw##k)
  #define VFR(i) (bf16x8){vlo[i][0],vlo[i][1],vlo[i][2],vlo[i][3],vhi[i][0],vhi[i][1],vhi[i][2],vhi[i][3]}
  #define PIN(x) asm volatile("":"+v"(x))
  #define MX3(a,b,c) __builtin_fmaxf(__builtin_fmaxf((a),(b)),(c))
  #define GAPA(MF,A0,A1,A2,A3,W0,W1,PW) do{ MF; sacc+=A0; sacc+=A1; sacc+=A2; sacc+=A3; PIN(sacc); W0; W1; PIN(PW); SBAR(); }while(0)
  #define EX(v) __builtin_amdgcn_exp2f(v)
  #define GAPB(MF,X,B) do{ MF; X[B]=EX(X[B]); X[B+1]=EX(X[B+1]); X[B+2]=EX(X[B+2]); X[B+3]=EX(X[B+3]); PIN(X); SBAR(); }while(0)
  #define VRD(i) do{ vlo[i]=vtr(vp_+(((i)>>2)*4096+((i)&3)*1024)); vhi[i]=vtr(vp_+(((i)>>2)*4096+((i)&3)*1024+512)); }while(0)
  #define KRD(G,j) do{ if(G){ kload2(kf,kp0+sl_next,j); SBAR(); } }while(0)
  #define STEP(C0,C1,P0,P1,t,GK,GV,GL) do{ SBAR(); \
    const lds_cptr vp_=vp0+sl_prev; \
    VRD(0); SBAR(); float sacc=(P0[0]+P0[1]); \
    GAPA(C0=__builtin_amdgcn_mfma_f32_32x32x16_bf16(kf[0],qr[0],negm,0,0,0), P0[2],P0[3],P0[4],P0[5],     pw0[0]=PKW(P0,0), pw0[1]=PKW(P0,2), pw0); \
    VRD(4); SBAR(); GAPA(C1=__builtin_amdgcn_mfma_f32_32x32x16_bf16(kf[1],qr[0],negm,0,0,0), P0[6],P0[7],P0[8],P0[9],     pw0[2]=PKW(P0,4), pw0[3]=PKW(P0,6), pw0); \
    VRD(1); SBAR(); GAPA(C0=__builtin_amdgcn_mfma_f32_32x32x16_bf16(kf[2],qr[1],C0,0,0,0),   P0[10],P0[11],P0[12],P0[13], pw1[0]=PKW(P0,8), pw1[1]=PKW(P0,10), pw1); \
    VRD(5); SBAR(); GAPA(C1=__builtin_amdgcn_mfma_f32_32x32x16_bf16(kf[3],qr[1],C1,0,0,0),   P0[14],P0[15],P1[0],P1[1],   pw1[2]=PKW(P0,12),pw1[3]=PKW(P0,14), pw1); \
    VRD(2); SBAR(); GAPA(C0=__builtin_amdgcn_mfma_f32_32x32x16_bf16(kf[4],qr[2],C0,0,0,0),   P1[2],P1[3],P1[4],P1[5],     pw2[0]=PKW(P1,0), pw2[1]=PKW(P1,2), pw2); \
    VRD(6); SBAR(); GAPA(C1=__builtin_amdgcn_mfma_f32_32x32x16_bf16(kf[5],qr[2],C1,0,0,0),   P1[6],P1[7],P1[8],P1[9],     pw2[2]=PKW(P1,4), pw2[3]=PKW(P1,6), pw2); \
    VRD(3); SBAR(); GAPA(C0=__builtin_amdgcn_mfma_f32_32x32x16_bf16(kf[6],qr[3],C0,0,0,0),   P1[10],P1[11],P1[12],P1[13], pw3[0]=PKW(P1,8), pw3[1]=PKW(P1,10), pw3); \
    VRD(7); SBAR(); GAPA(C1=__builtin_amdgcn_mfma_f32_32x32x16_bf16(kf[7],qr[3],C1,0,0,0),   P1[14],P1[15],0.f,0.f,       pw3[2]=PKW(P1,12),pw3[3]=PKW(P1,14), pw3); \
    l_reg+=sacc; \
    if(GK){DMA_K((t)+3,sl_cur);} if(GV){DMA_V((t)+1,sl_next);} \
    CMASK(C0,C1,t); BMASK(C0,C1,t); \
    { float a=MX3(C0[0],C0[1],C1[0]),b=MX3(C0[2],C0[3],C1[1]); a=MX3(a,C1[2],C1[3]); \
      _Pragma("unroll") for(int r=4;r<16;r+=4){a=MX3(a,C0[r],C0[r+1]);b=MX3(b,C0[r+2],C0[r+3]);a=MX3(a,C1[r],C1[r+1]);b=MX3(b,C1[r+2],C1[r+3]);} \
      float rm=__builtin_fmaxf(a,b); { auto rr=__builtin_amdgcn_permlane32_swap(__float_as_uint(rm),__float_as_uint(rm),false,false); rm=__builtin_fmaxf(__uint_as_float(rr[0]),__uint_as_float(rr[1])); } \
      resc=false; \
      if(__builtin_expect(__any(rm>(float)THRL),0)){ const float dl=__builtin_fmaxf(rm,0.f); mhat+=dl; \
        _Pragma("unroll") for(int r=0;r<16;++r){C0[r]-=dl;C1[r]-=dl;} \
        const float f=__builtin_amdgcn_exp2f(-dl); l_reg*=f; if(hi==0)wsf[r32]=f; resc=true; } } \
    SBAR(); \
    GAPB(o[0]=__builtin_amdgcn_mfma_f32_32x32x16_bf16(PAF(0),VFR(0),o[0],0,0,0), C0,0); \
    GAPB(o[1]=__builtin_amdgcn_mfma_f32_32x32x16_bf16(PAF(0),VFR(4),o[1],0,0,0), C0,4); \
    KRD(GL,0); GAPB(o[0]=__builtin_amdgcn_mfma_f32_32x32x16_bf16(PAF(1),VFR(1),o[0],0,0,0), C0,8); \
    KRD(GL,1); GAPB(o[1]=__builtin_amdgcn_mfma_f32_32x32x16_bf16(PAF(1),VFR(5),o[1],0,0,0), C0,12); \
    KRD(GL,2); GAPB(o[0]=__builtin_amdgcn_mfma_f32_32x32x16_bf16(PAF(2),VFR(2),o[0],0,0,0), C1,0); \
    KRD(GL,3); GAPB(o[1]=__builtin_amdgcn_mfma_f32_32x32x16_bf16(PAF(2),VFR(6),o[1],0,0,0), C1,4); \
    GAPB(o[0]=__builtin_amdgcn_mfma_f32_32x32x16_bf16(PAF(3),VFR(3),o[0],0,0,0), C1,8); \
    GAPB(o[1]=__builtin_amdgcn_mfma_f32_32x32x16_bf16(PAF(3),VFR(7),o[1],0,0,0), C1,12); \
    }while(0)
  int t=1;
  #undef CMASK
  #define CMASK(P0,P1,t) do{}while(0)
  for(;t+5<NT;t+=2){
    STEP(pB0,pB1,pA0,pA1,t,true,true,true);     WAIT_BAR(2); RESC(); ROT();
    STEP(pA0,pA1,pB0,pB1,t+1,true,true,true);   WAIT_BAR(2); RESC(); ROT();
  }
  #undef CMASK
  #define CMASK(P0,P1,t) do{int jb_=(t)-(NT-4); if(jb_>=0)cmask(P0,P1,jb_,qrel,hi);}while(0)
  #define ENDW(tt) do{ if((tt)+3<NT){WAIT_BAR(2);} else if((tt)+2<NT){WAIT_BAR(1);} else {WAIT_BAR(0);} }while(0)
  for(;t+1<NT;t+=2){
    STEP(pB0,pB1,pA0,pA1,t,(t+3<NT),(t+1<NT),(t+1<NT));       ENDW(t);   RESC(); ROT();
    STEP(pA0,pA1,pB0,pB1,t+1,(t+4<NT),(t+2<NT),(t+2<NT));     ENDW(t+1); RESC(); ROT();
  }
  STEP(pB0,pB1,pA0,pA1,NT-1,false,false,false); RESC();
  { float sacc=pB0[0]+pB0[1]; _Pragma("unroll") for(int r=2;r<16;++r)sacc+=pB0[r]; _Pragma("unroll") for(int r=0;r<16;++r)sacc+=pB1[r]; l_reg+=sacc;
    pw0=(u32x4){PKW(pB0,0),PKW(pB0,2),PKW(pB0,4),PKW(pB0,6)};pw1=(u32x4){PKW(pB0,8),PKW(pB0,10),PKW(pB0,12),PKW(pB0,14)};pw2=(u32x4){PKW(pB1,0),PKW(pB1,2),PKW(pB1,4),PKW(pB1,6)};pw3=(u32x4){PKW(pB1,8),PKW(pB1,10),PKW(pB1,12),PKW(pB1,14)};
    SBAR(); pv(o,vb0+sl_cur,PAF(0),PAF(1),PAF(2),PAF(3)); }
  #undef PKW
  #undef PAF
  #undef VFR
  #undef PIN
  #undef MX3
  #undef GAPA
  #undef GAPB
  #undef EX
  #undef VRD
  #undef KRD
  #undef STEP
  #undef ENDW
  {auto rr=__builtin_amdgcn_permlane32_swap(__float_as_uint(l_reg),__float_as_uint(l_reg),false,false);l_reg=__uint_as_float(rr[0])+__uint_as_float(rr[1]);}
  if(hi==0)wsf[32+r32]=l_reg;asm volatile("s_waitcnt lgkmcnt(0)":::"memory");
  float rli[16];
  #pragma unroll
  for(int r=0;r<16;++r)rli[r]=__builtin_amdgcn_rcpf(wsf[32+crow(r,hi)]);
  bf16*Ow=O+(rowbase+q0+wid*QBLK)*DMO+h*D;
  { bf16*stg=(bf16*)(shm+LDS_OST)+wid*2048;
    #pragma unroll
    for(int r=0;r<16;++r){const int orow=crow(r,hi);
      #pragma unroll
      for(int d0=0;d0<2;++d0)stg[orow*64+d0*32+r32]=__float2bfloat16(o[d0][r]*rli[r]);}
    asm volatile("s_waitcnt lgkmcnt(0)":::"memory");
    #pragma unroll
    for(int i=0;i<4;++i){const int row=i*8+(lane>>3),ch=lane&7; const u32x4 v=*(const u32x4*)(stg+row*64+ch*8); ATTN_STORE16(Ow+(long)row*DMO+ch*8,v);
      float q=0.f;
      #pragma unroll
      for(int e=0;e<4;++e){const float lo=__uint_as_float(v[e]<<16),hi2=__uint_as_float(v[e]&0xffff0000u);q+=lo*lo+hi2*hi2;}
      q+=__shfl_xor(q,1);q+=__shfl_xor(q,2);q+=__shfl_xor(q,4);
      if(ch==0)SSQA[(rowbase+q0+wid*QBLK+row)*8+h]=q;} }
  asm volatile("s_waitcnt lgkmcnt(0)\n\ts_barrier":::"memory");
  #undef BMASK
  #undef DMA_K
  #undef DMA_V
  #undef CMASK
  #undef START
  #undef RESC
  #undef ROT
}
constexpr int ATTN_LDS_BYTES=LDS_BYTES;
#undef SBAR
#undef WAIT_BAR
}

__global__ void __launch_bounds__(512, 2) mk_fwd(Args args) {
    extern __shared__ __attribute__((aligned(16))) unsigned char lds_raw[];
    Ctx C; C.lds = (LAS unsigned char*)lds_raw; C.tid = threadIdx.x; C.lane = C.tid & 63; C.wave = __builtin_amdgcn_readfirstlane(C.tid >> 6);
    C.G = gridDim.x; { const int bx = blockIdx.x; C.vcu = (C.G % 8 == 0) ? (bx % 8) * (C.G / 8) + bx / 8 : bx; }
    unsigned char* ws = args.ws;
    for (int u = C.tid; u < (LDS_BYTES - LDSCTL_OFF) / 4; u += 512) ((LAS unsigned*)(C.lds + LDSCTL_OFF))[u] = 0u;
    __syncthreads();
    XcdBarrier bar; bar.bar = (unsigned*)(ws + WS_CTL) + CW_BAR; bar.x = 0; bar.st = nullptr;
    if (N_LAUNCHES == 1) bar = xcd_barrier_post((unsigned*)(ws + WS_CTL) + CW_BAR, (volatile LAS unsigned*)(C.lds + MISC_OFF) + 8);
    const int lo = args.ph_lo, hi = args.ph_hi;
#ifndef PH_MASK
#define PH_MASK 0x3fff
#endif
#define IN(k) ((((PH_MASK) >> (k)) & 1) && lo <= (k) && (k) < hi)
#ifndef PROBE_REP
#define PROBE_REP -1
#endif
#define REP(k) for (int rep_ = 0; rep_ < ((PROBE_REP == (k)) ? 2 : 1); ++rep_)
#define REPBAR() do { if (rep_ > 0) xcd_barrier(bar); } while (0)
#define FRESH() do { int t_ = threadIdx.x; asm volatile("" : "+v"(t_)); C.tid = t_; C.lane = t_ & 63; C.wave = __builtin_amdgcn_readfirstlane(t_ >> 6); } while (0)
#define SEAM(k) do { if (IN(k) && IN((k) + 1)) xcd_barrier(bar); } while (0)
    const int cb = (int)blockIdx.x;

    if (IN(0)) REP(0) { REPBAR(); FRESH(); ph_prologue(args, C); SEAM(0); }
    if (IN(1)) REP(1) { REPBAR();
        { Gemm g{(const bf16_t*)(ws + WS_B), (const bf16_t*)(ws + WS_WIN), DM, DM, DM}; PlainOrder S; S.init(NTOK, DIN, C.G, cb, DM, DM);
          EpiProj E{(bf16_t*)(ws + WS_A), (const float*)(ws + WS_ROPE), (float*)(ws + WS_KSUM)}; GEMM_PHASE(C.lds, g, S, E); }
        { Gemm g{(const bf16_t*)(ws + WS_MEMN), (const bf16_t*)(ws + WS_WXK), DM, DM, DM}; PlainOrder S; S.init(NMEM, DM, C.G, cb, DM, DM);
          EpiStore E{(bf16_t*)(ws + WS_KM), DM}; GEMM_PHASE(C.lds, g, S, E); }
        { Gemm g{(const bf16_t*)(ws + WS_MEMN), (const bf16_t*)(ws + WS_WXV), DM, DM, DM}; PlainOrder S; S.init(NMEM, DM, C.G, (cb + C.G - 64 % C.G) % C.G, DM, DM);
          EpiStore E{(bf16_t*)(ws + WS_VMT), DM}; GEMM_PHASE(C.lds, g, S, E); }
        SEAM(1);
    }
    if (IN(2)) REP(2) { REPBAR(); FRESH();
        for (int lrep_ = 0; lrep_ < ((PROBE_REP == 102) ? 2 : 1); ++lrep_)
        for (int L = C.vcu; L < 256; L += C.G) lru_unit(args, C, L >> 4, (L >> 1) & 7, L & 1);
        for (int arep_ = 0; arep_ < ((PROBE_REP == 103) ? 2 : 1); ++arep_)
        for (int i = 0;; ++i) { const int aidx = i * C.G + C.vcu; if (aidx >= 1024) break; const int cc = aidx & 255, ii = aidx >> 8, bh = cc >> 1;
            const int qb = (cc & 1) ? ((ii == 0) ? 6 : (ii == 1) ? 1 : (ii == 2) ? 5 : 2) : ((ii == 0) ? 7 : (ii == 1) ? 0 : (ii == 2) ? 4 : 3);
#ifdef ATTN_SIMPLE
            moba_unit_simple(args, C, bh >> 3, bh & 7, qb); }
#else
            { const attn_body::bf16* Qp = (const attn_body::bf16*)(ws + WS_A) + (size_t)2 * NTOK * 512;
              attn_body::attn_unit<8>(bh >> 3, bh & 7, qb, Qp, Qp + (size_t)NTOK * 512, Qp + (size_t)2 * NTOK * 512, (attn_body::bf16*)(ws + WS_C) + 512, (const float*)(ws + WS_KSUM), (float*)(ws + WS_SSQA), (char*)lds_raw); } }
#endif
        SEAM(2);
    }
    if (IN(4)) REP(4) { REPBAR(); Gemm g{(const bf16_t*)(ws + WS_C), (const bf16_t*)(ws + WS_WOUT), DM, DM, DM}; PlainOrder S; S.init(NTOK, DM, C.G, cb, DM, DM);
        EpiResid<true, true> E{args.in[0], (bf16_t*)args.out, (float*)(ws + WS_SSQ1), (const float*)(ws + WS_SSQL), (const float*)(ws + WS_SSQA)}; GEMM_PHASE(C.lds, g, S, E);
        { Gemm g2{(const bf16_t*)(ws + WS_KM), (const bf16_t*)(ws + WS_WXQ), DM, DM, XHD}; XpreOrder S2{C.G, cb, 0}; EpiStore E2{(bf16_t*)(ws + WS_A), DM}; GEMM_PHASE(C.lds, g2, S2, E2); }
        { Gemm g3{(const bf16_t*)(ws + WS_WXO), (const bf16_t*)(ws + WS_VMT), DM, DM, XHD}; XpreOrder S3{C.G, cb, 1}; EpiStore E3{(bf16_t*)(ws + WS_A) + (size_t)32 * MiB / 2, DM}; GEMM_PHASE(C.lds, g3, S3, E3); }
        SEAM(4); }
    if (IN(5)) REP(5) { REPBAR(); Gemm g{(const bf16_t*)args.out, (const bf16_t*)(ws + WS_A), LDH, DM, DM}; XattnOrder S{C.G, cb, 0, LDH};
        EpiSoftmax E{(bf16_t*)(ws + WS_B), DM, C.lds + LDSCTL_OFF + 4096, (const float*)(ws + WS_SSQ1), XSCALE}; GEMM_PHASE(C.lds, g, S, E); SEAM(5); }
    if (IN(8)) REP(8) { REPBAR(); Gemm g{(const bf16_t*)(ws + WS_B), (const bf16_t*)(ws + WS_A) + (size_t)32 * MiB / 2, DM, DM, DM}; XattnOrder S{C.G, cb, 1, DM};
        EpiResid<false, false> E{(const bf16_t*)args.out, (bf16_t*)args.out + DM, (float*)(ws + WS_SSQ2), nullptr, nullptr}; GEMM_PHASE(C.lds, g, S, E); SEAM(8); }
    if (IN(9)) REP(9) { REPBAR(); FRESH(); ph_router(args, C); SEAM(9); }
    if (IN(11)) REP(11) { REPBAR(); FRESH(); moe_table(args, C); Gemm g{(const bf16_t*)args.out + DM, (const bf16_t*)(ws + WS_WGU), LDH, DM, DM};
        MoeOrder<true> S{(const LAS int*)(C.lds + MOE_OFF), C.G, cb, LDH, DM, (const int*)(ws + WS_LTOK)};
        EpiGateUp E{(bf16_t*)(ws + WS_B), (const float*)(ws + WS_LRS)}; GEMM_PHASE(C.lds, g, S, E); SEAM(11); }
    if (IN(12)) REP(12) { REPBAR(); FRESH(); moe_table(args, C); Gemm g{(const bf16_t*)(ws + WS_B), (const bf16_t*)(ws + WS_WDN), DFF, DFF, DFF};
        MoeOrder<false> S{(const LAS int*)(C.lds + MOE_OFF), C.G, cb, DFF, DFF, nullptr};
        EpiStore E{(bf16_t*)(ws + WS_A), DM}; GEMM_PHASE(C.lds, g, S, E); SEAM(12); }
    if (IN(13)) REP(13) { REPBAR(); FRESH(); moe_table(args, C); ph_final(args, C, (PROBE_REP == 13 && rep_ == 0) ? (float*)(ws + WS_B) : args.out); }
#undef IN
#undef FRESH
#undef SEAM
}

extern "C" void kernel_launch(void* const* d_in, const int* in_sizes, int n_in, void* d_out, int out_size, void* d_ws, size_t ws_size, hipStream_t stream) {
    static int grid = 0;
    if (grid == 0) {
        if (n_in != 27 || out_size != NTOK * DM || ws_size < WS_END) { fprintf(stderr, "kernel_launch: unexpected shapes (n_in %d out %d ws %zu)\n", n_in, out_size, ws_size); grid = -1; return; }
        int dev = 0, cus = 0, per_cu = 0;
        if (hipGetDevice(&dev) != hipSuccess || hipDeviceGetAttribute(&cus, hipDeviceAttributeMultiprocessorCount, dev) != hipSuccess) { grid = -1; return; }
        if (hipFuncSetAttribute((const void*)mk_fwd, hipFuncAttributeMaxDynamicSharedMemorySize, LDS_BYTES) != hipSuccess) { fprintf(stderr, "kernel_launch: hipFuncSetAttribute failed\n"); grid = -1; return; }
        if (hipOccupancyMaxActiveBlocksPerMultiprocessor(&per_cu, (const void*)mk_fwd, 512, LDS_BYTES) != hipSuccess || per_cu < 1) fprintf(stderr, "kernel_launch: occupancy query reports %d\n", per_cu);
        (void)hipGetLastError();
        grid = cus;
    }
    if (grid < 0) return;
    (void)hipMemsetAsync((char*)d_ws + WS_CTL, 0, CTL_ZERO_BYTES, stream);
    Args a{};
    for (int i = 0; i < 27; ++i) a.in[i] = (const float*)d_in[i];
    a.out = (float*)d_out; a.ws = (unsigned char*)d_ws;
    const float invf[8] = {1.0f, 0.1939227432012558f, 0.03760603070259094f, 0.007292664609849453f, 0.0014142135623842478f, 0.00027424818836152554f, 5.318296098266728e-05f, 1.0313386155758053e-05f};
    for (int i = 0; i < 8; ++i) a.invf[i] = invf[i];
    if (N_LAUNCHES == 1) { a.ph_lo = 0; a.ph_hi = N_PHASES; hipLaunchKernelGGL(mk_fwd, dim3(grid), dim3(512), LDS_BYTES, stream, a); }
    else for (int p = 0; p < N_PHASES; ++p) { a.ph_lo = p; a.ph_hi = p + 1; hipLaunchKernelGGL(mk_fwd, dim3(grid), dim3(512), LDS_BYTES, stream, a); }
}
```

```cpp
#include <hip/hip_runtime.h>
#include <cstdio>
#include <cstdint>

#define LAS __attribute__((address_space(3)))
#define GAS __attribute__((address_space(1)))
typedef unsigned short bf16_t;
typedef short bf16x8 __attribute__((ext_vector_type(8)));
typedef float f32x4 __attribute__((ext_vector_type(4)));
typedef float f32x2 __attribute__((ext_vector_type(2)));
typedef unsigned u32x4 __attribute__((ext_vector_type(4)));
typedef unsigned u32x2 __attribute__((ext_vector_type(2)));

#ifndef MK_N_LAUNCHES
#define MK_N_LAUNCHES 1
#endif
constexpr int N_PHASES = 14;
constexpr int N_LAUNCHES = MK_N_LAUNCHES;

constexpr int BATCH = 16, SEQ = 2048, DM = 1024, NTOK = BATCH * SEQ;
constexpr int DLRU = 512, DATT = 512, DIN = 2560, NHEAD = 8, HD = 64, NBLK = 8, MBLK = 256;
constexpr int MEMLEN = 256, NXH = 4, XHD = 256, NMEM = BATCH * MEMLEN;
constexpr int NEXP = 32, EPG = 8, NGRP = 4, DFF = 512;
constexpr float EPS = 1e-6f;
constexpr int WDN_SPLIT = 3072;
constexpr int MAXTILES = 288, LCAP = 65536, LDH = 2048;
constexpr float QSCALE = 0.125f * 1.4426950408889634f;
constexpr float XSCALE = 0.0625f * 1.4426950408889634f;

constexpr size_t MiB = 1u << 20;
constexpr size_t WS_CTL = 0, CTL_ZERO_BYTES = 1 * MiB;
constexpr int CW_TMO = 0, CW_BAR = 4096, CW_CNT = 8192;
constexpr size_t WS_KSUM = 512 * 1024;
constexpr size_t WS_WIN = 2 * MiB, WS_WXK = 7 * MiB, WS_WXV = 9 * MiB, WS_WOUT = 11 * MiB, WS_WXQ = 13 * MiB, WS_WXO = 15 * MiB;
constexpr size_t WS_WR = 17 * MiB, WS_ROPE = 18 * MiB, WS_SSQ1 = 19 * MiB, WS_SSQ2 = 21 * MiB, WS_TOK = 23 * MiB, WS_RSC = 24 * MiB;
constexpr size_t WS_MEMN = 25 * MiB, WS_KM = 33 * MiB, WS_VMT = 41 * MiB, WS_WGU = 49 * MiB, WS_WDN = 113 * MiB;
constexpr size_t WS_A = 145 * MiB, WS_B = 305 * MiB, WS_C = 385 * MiB, WS_SSQL = 449 * MiB, WS_SSQA = 451 * MiB, WS_LTOK = 452 * MiB, WS_LRS = 460 * MiB, WS_END = 468 * MiB;
constexpr size_t TOK_E = 0, TOK_R = 256 * 1024, TOK_G = 512 * 1024, TOK_D = 768 * 1024;

constexpr int RING_BYTES = 131072;
constexpr int LDSCTL_OFF = RING_BYTES, MISC_OFF = LDSCTL_OFF + 320, MOE_OFF = LDSCTL_OFF + 1024;
constexpr int LDS_BYTES = 147456;

__device__ __forceinline__ unsigned cvt_pk_bf16(float lo, float hi) { unsigned r; asm volatile("v_cvt_pk_bf16_f32 %0, %1, %2" : "=v"(r) : "v"(lo), "v"(hi)); return r; }
__device__ __forceinline__ float bflo(unsigned w) { return __uint_as_float(w << 16); }
__device__ __forceinline__ float bfhi(unsigned w) { return __uint_as_float(w & 0xffff0000u); }
__device__ __forceinline__ float bf2f(bf16_t b) { return __uint_as_float((unsigned)b << 16); }
__device__ __forceinline__ float wave_sum(float v) {
#pragma unroll
    for (int o = 1; o < 64; o <<= 1) v += __shfl_xor(v, o);
    return v;
}
#define LDS_WAIT() asm volatile("s_waitcnt lgkmcnt(0)" ::: "memory")
__device__ __forceinline__ float sigmoidf_(float x) { return __builtin_amdgcn_rcpf(1.0f + __builtin_amdgcn_exp2f(x * -1.4426950408889634f)); }

#define XB_TMO      128
#define XB_XCNT(j)  (256  + 64 * (j))
#define XB_XSUB(j)  (1280 + 64 * (j))
#define XB_XGEN(j)  (2304 + 64 * (j))
#define XB_TOP      3328
#define XB_TOPGEN   3392
#define XCD_BAR_WORDS 3456
#define XB_SPIN_CAP (1u << 18)
__device__ __forceinline__ unsigned xb_ld(unsigned* p)              { return __hip_atomic_load(p, __ATOMIC_RELAXED, __HIP_MEMORY_SCOPE_AGENT); }
__device__ __forceinline__ unsigned xb_add(unsigned* p, unsigned v) { return __hip_atomic_fetch_add(p, v, __ATOMIC_RELAXED, __HIP_MEMORY_SCOPE_AGENT); }
__device__ __forceinline__ unsigned xb_xcc_id() { return (unsigned)__builtin_amdgcn_s_getreg((3 << 11) | 20) & 0xFu; }
#define XB_SPIN(cond, bar) do { unsigned _sp = 0; while (cond) { __builtin_amdgcn_s_sleep(1); \
    if ((++_sp & 255u) == 0u) { if (xb_ld(&(bar)[XB_TMO])) break; if (_sp > XB_SPIN_CAP) { atomicAdd(&(bar)[XB_TMO], 1u); break; } } } } while (0)
struct XcdBarrier { unsigned* bar; unsigned x; volatile LAS unsigned* st; };
__device__ __forceinline__ XcdBarrier xcd_barrier_post(unsigned* bar, volatile LAS unsigned* st) {
    XcdBarrier b; b.bar = bar; b.x = xb_xcc_id(); b.st = st;
    if (threadIdx.x == 0) (void)xb_add(&bar[XB_XCNT(b.x)], 1u);
    return b;
}
__device__ __forceinline__ void xcd_barrier_complete(unsigned* bar, unsigned x, unsigned& nloc, unsigned& nx) {
    const unsigned G = gridDim.x * gridDim.y * gridDim.z;
    unsigned sum, cnt, mine, sp = 0u;
    for (;;) {
        sum = 0u; cnt = 0u; mine = 0u;
#pragma unroll
        for (unsigned j = 0; j < 16; ++j) { const unsigned c = xb_ld(&bar[XB_XCNT(j)]); sum += c; cnt += (c > 0u) ? 1u : 0u; mine = (j == x) ? c : mine; }
        if (sum == G) break;
        __builtin_amdgcn_s_sleep(1);
        if ((++sp & 255u) == 0u) { if (xb_ld(&bar[XB_TMO])) break; if (sp > XB_SPIN_CAP) { atomicAdd(&bar[XB_TMO], 1u); break; } }
    }
    nloc = mine > 0u ? mine : 1u; nx = cnt > 0u ? cnt : 1u;
}
__device__ __forceinline__ void xcd_barrier(const XcdBarrier& b) {
    asm volatile("s_waitcnt vmcnt(0)" ::: "memory");
    __syncthreads();
    if (threadIdx.x == 0) {
        unsigned* bar = b.bar;
        __builtin_amdgcn_s_waitcnt(0);
        unsigned nloc = b.st[0], nx = b.st[1];
        if (nloc == 0u) { xcd_barrier_complete(bar, b.x, nloc, nx); b.st[0] = nloc; b.st[1] = nx; }
        const unsigned old = xb_add(&bar[XB_XSUB(b.x)], 1u);
        const unsigned gen = old / nloc;
        if (old + 1u == (gen + 1u) * nloc) {
            __builtin_amdgcn_fence(__ATOMIC_RELEASE, "agent");
            asm volatile("s_waitcnt vmcnt(0)" ::: "memory");
            const unsigned og = xb_add(&bar[XB_TOP], 1u);
            const unsigned tg = og / nx;
            if (og + 1u == (tg + 1u) * nx) xb_add(&bar[XB_TOPGEN], 1u);
            else XB_SPIN(xb_ld(&bar[XB_TOPGEN]) == tg, bar);
            __builtin_amdgcn_fence(__ATOMIC_ACQUIRE, "agent");
            xb_add(&bar[XB_XGEN(b.x)], 1u);
            asm volatile("s_waitcnt vmcnt(0)" ::: "memory");
        } else {
            XB_SPIN(xb_ld(&bar[XB_XGEN(b.x)]) == gen, bar);
            __builtin_amdgcn_fence(__ATOMIC_ACQUIRE, "agent");
            asm volatile("s_waitcnt vmcnt(0)" ::: "memory");
        }
    }
    __syncthreads();
}

struct Unit { int pm, pn; size_t a_off, b_off; int lbase, nvalid; };
struct Gemm { const bf16_t* A; const bf16_t* Bt; int lda, ldb, K; };
__host__ __device__ __forceinline__ int perm32(int rho) { const int n = rho >> 4, i = rho & 15; return 8 * (i >> 2) + 4 * n + (i & 3); }

struct PlainOrder {     static constexpr bool GATHER = false;
    int nM, nN, nwg, G, c, lda, ldb;
    __device__ void init(int M, int N, int G_, int c_, int lda_, int ldb_) { nM = M / 256; nN = N / 256; nwg = nM * nN; G = G_; c = c_; lda = lda_; ldb = ldb_; }
    __device__ bool next(int i, Unit& u) const {
        const long L = (long)i * G + c; if (L >= nwg) return false;
        int wgid = (int)L; { const int q = nwg / 8, r = nwg % 8, xcd = wgid % 8, off = wgid / 8; wgid = (xcd < r ? xcd * (q + 1) : r * (q + 1) + (xcd - r) * q) + off; }
        const int nig = 8 * nN, gid = wgid / nig, fm = gid * 8, gsz = (nM - fm) < 8 ? (nM - fm) : 8;
        u.pm = fm + ((wgid % nig) % gsz); u.pn = (wgid % nig) / gsz;
        u.a_off = (size_t)u.pm * 256 * lda; u.b_off = (size_t)u.pn * 256 * ldb; return true;
    }
};
struct XpreOrder {
    static constexpr bool GATHER = false;
    int G, c, mode;
    __device__ bool next(int i, Unit& u) const {
        const int L = i * G + c; if (L >= 256) return false;
        const int b = L >> 4, x = (L >> 2) & 3, y = L & 3;
        if (mode == 0) { const int h = x, kt = y; u.pm = b * 4 + h; u.pn = kt; u.a_off = (size_t)b * MEMLEN * DM + h * XHD; u.b_off = (size_t)kt * 256 * DM + h * XHD; }
        else { const int nt = x, h = y; u.pm = b * 4 + nt; u.pn = h; u.a_off = (size_t)nt * 256 * DM + h * XHD; u.b_off = (size_t)b * MEMLEN * DM + h * XHD; }
        return true;
    }
};
struct XattnOrder {
    static constexpr bool GATHER = false;
    int G, c, mode, lda;
    __device__ bool next(int i, Unit& u) const {
        int L = i * G + c; if (L >= (NTOK / 256) * 4) return false;
        if (G == 256) { const int x = c & 7, idx = c >> 3; L = ((x + 8 * i) * 8 + (idx >> 2)) * 4 + (idx & 3); }
        u.pm = L >> 2; u.pn = L & 3; const int b = u.pm >> 3;
        u.a_off = (size_t)u.pm * 256 * lda;
        u.b_off = mode == 0 ? (size_t)(b * 4 + u.pn) * 256 * DM : (size_t)(b * 1024 + u.pn * 256) * DM;
        return true;
    }
};
template <bool GATH_> struct MoeOrder {
    static constexpr bool GATHER = GATH_;
    const LAS int* ts; int G, c, lda, ldb; const int* ltok;
    __device__ bool next(int i, Unit& u) const {
        const int L = i * G + c; if (L >= ts[NEXP] * 4) return false;
        const int T = L >> 2, j = L & 3; int e = 0; while (ts[e + 1] <= T) ++e;
        const int lt = T - ts[e];
        u.pm = T; u.pn = j; u.a_off = GATH_ ? (size_t)0 : (size_t)T * 256 * lda; u.b_off = ((size_t)e * 1024 + j * 256) * ldb;
        u.lbase = e * LCAP + lt * 256; u.nvalid = ts[33 + e] - lt * 256; return true;
    }
    __device__ __forceinline__ unsigned rowoff(const Unit& u, int r) const { return (r < u.nvalid) ? (unsigned)ltok[u.lbase + r] * (unsigned)(LDH * 2) : 0u; }
};

template <class Epi, class Sched>
__device__ __forceinline__ void gemm_phase_simple(LAS unsigned char* lds, const Gemm g, const Sched& S, const Epi& E) {
    int tid = threadIdx.x; asm volatile("" : "+v"(tid));
    const int wid = __builtin_amdgcn_readfirstlane(tid >> 6), lane = tid & 63, wr = wid >> 2, wc = wid & 3, fr = lane & 15, fq = lane >> 4;
    Unit u;
    for (int i = 0; S.next(i, u); ++i) {
        f32x4 acc[2][2][4][2];
#pragma unroll
        for (int a = 0; a < 2; ++a)
#pragma unroll
            for (int b = 0; b < 2; ++b)
#pragma unroll
                for (int m = 0; m < 4; ++m)
#pragma unroll
                    for (int n = 0; n < 2; ++n) acc[a][b][m][n] = (f32x4){0.f, 0.f, 0.f, 0.f};
        const char* Ab = (const char*)(g.A + u.a_off); const char* Bb = (const char*)(g.Bt + u.b_off);
        const int c0 = Epi::PERM ? perm32(fr) : fr, c1 = Epi::PERM ? perm32(16 + fr) : 16 + fr;
        unsigned ao[2][4], bo[2][2];
#pragma unroll
        for (int ai = 0; ai < 2; ++ai)
#pragma unroll
            for (int m = 0; m < 4; ++m) ao[ai][m] = (unsigned)((128 * ai + 64 * wr + 16 * m + fr) * g.lda + 8 * fq) * 2u;
#pragma unroll
        for (int bj = 0; bj < 2; ++bj) { bo[bj][0] = (unsigned)((128 * bj + 32 * wc + c0) * g.ldb + 8 * fq) * 2u; bo[bj][1] = (unsigned)((128 * bj + 32 * wc + c1) * g.ldb + 8 * fq) * 2u; }
#pragma unroll 1
        for (int k0 = 0; k0 < g.K; k0 += 32) {
            if constexpr (Epi::MIDK) { if (k0 == (g.K >> 1)) E.midk(acc, u, wr, wc, fr, fq); }
            const char* Ak = Ab + (size_t)k0 * 2; const char* Bk = Bb + (size_t)k0 * 2;
            bf16x8 bfr[2][2];
#pragma unroll
            for (int bj = 0; bj < 2; ++bj) { bfr[bj][0] = *(const bf16x8*)(Bk + bo[bj][0]); bfr[bj][1] = *(const bf16x8*)(Bk + bo[bj][1]); }
#pragma unroll
            for (int ai = 0; ai < 2; ++ai) {
                bf16x8 af[4];
#pragma unroll
                for (int m = 0; m < 4; ++m) af[m] = *(const bf16x8*)(Ak + ao[ai][m]);
#pragma unroll
                for (int bj = 0; bj < 2; ++bj)
#pragma unroll
                    for (int m = 0; m < 4; ++m)
#pragma unroll
                        for (int n = 0; n < 2; ++n) acc[ai][bj][m][n] = __builtin_amdgcn_mfma_f32_16x16x32_bf16(bfr[bj][n], af[m], acc[ai][bj][m][n], 0, 0, 0);
            }
        }
        E(acc, u, wr, wc, fr, fq);
    }
}

__host__ __device__ __forceinline__ int lds_byte(int r, int c) { const int st = (r >> 4) * 2 + (c >> 5), rr = r & 15, cc = c & 31, ob = rr * 64 + cc * 2; return st * 1024 + (ob ^ (((ob >> 9) & 1) << 5)); }
__host__ __device__ __forceinline__ void stage_rc(int b, int& R, int& C) { const int st = b / 1024, sb = b % 1024, swz = sb ^ (((sb >> 9) & 1) << 5); R = (st >> 1) * 16 + swz / 64; C = (st & 1) * 32 + (swz % 64) / 2; }
template <class Epi, class Sched, bool ALIGN_EPI = false, bool SP2 = false>
__device__ __forceinline__ void gemm_phase(LAS unsigned char* lds, const Gemm g, const Sched& S, const Epi& E) {
    constexpr int BK = 64, HALF = 128, HTB = HALF * BK * 2;
    int tid = threadIdx.x; asm volatile("" : "+v"(tid));
    const int wid = __builtin_amdgcn_readfirstlane(tid >> 6), lane = tid & 63, wr = wid >> 2, wc = wid & 3, fr = lane & 15, fq = lane >> 4;
    const int K = g.K, nt = K / BK;
    unsigned voffA[2], voffB[2];
#pragma unroll
    for (int i = 0; i < 2; ++i) { int R, C; stage_rc(tid * 16 + i * 8192, R, C); const int Rb = Epi::PERM ? ((R & ~31) + perm32(R & 31)) : R;
        voffA[i] = (unsigned)(R * g.lda + C) * 2u; voffB[i] = (unsigned)(Rb * g.ldb + C) * 2u; }
    constexpr bool GATH = Sched::GATHER;
    unsigned vcu[2][2] = {{0u, 0u}, {0u, 0u}}, vnx[2][2] = {{0u, 0u}, {0u, 0u}}; int gR[2] = {0, 0}; unsigned gC[2] = {0u, 0u};
    if constexpr (GATH) {
#pragma unroll
        for (int i = 0; i < 2; ++i) { int R, Cq; stage_rc(tid * 16 + i * 8192, R, Cq); gR[i] = R; gC[i] = (unsigned)Cq * 2u; } }
    const size_t kstep = (size_t)(BK * 2);
    const size_t hstepA = (size_t)HALF * g.lda * 2, hstepB = (size_t)HALF * g.ldb * 2;
    const unsigned ldsw = (unsigned)wid * 1024u;
    const int aoff = lds_byte(wr * 64 + fr, fq * 8), boff = lds_byte(wc * 32 + fr, fq * 8);
#define PG8_SA(b, h) (((b) * 2 + (h)) * HTB)
#define PG8_SB(b, h) ((4 + (b) * 2 + (h)) * HTB)
#define PG8_STAGE(bufoff, gbase, voff) do { _Pragma("unroll") for (int _i = 0; _i < 2; ++_i) \
        __builtin_amdgcn_global_load_lds((const unsigned*)((const char*)(gbase) + (voff)[_i]), (LAS unsigned*)(lds + (bufoff) + ldsw + _i * 8192), 16, 0, 0); } while (0)
#define PG8_STA(bufoff, ptr, h, nx) do { if constexpr (GATH) { const unsigned vsel_[2] = {(nx) ? vnx[h][0] : vcu[h][0], (nx) ? vnx[h][1] : vcu[h][1]}; PG8_STAGE(bufoff, ptr, vsel_); } \
        else { PG8_STAGE(bufoff, (ptr) + (h) * hstepA, voffA); } } while (0)
#define PG8_LDA(dst, b, h) do { _Pragma("unroll") for (int m = 0; m < 4; ++m) _Pragma("unroll") for (int k = 0; k < 2; ++k) dst[m][k] = *(const LAS bf16x8*)(lds + PG8_SA(b, h) + aoff + m * 2048 + k * 1024); } while (0)
#define PG8_LDB(dst, b, h) do { _Pragma("unroll") for (int n = 0; n < 2; ++n) _Pragma("unroll") for (int k = 0; k < 2; ++k) dst[n][k] = *(const LAS bf16x8*)(lds + PG8_SB(b, h) + boff + n * 2048 + k * 1024); } while (0)
#define PG8_MMA(ai, bj, At, Bt) do { __builtin_amdgcn_s_setprio(1); _Pragma("unroll") for (int m = 0; m < 4; ++m) _Pragma("unroll") for (int n = 0; n < 2; ++n) _Pragma("unroll") for (int k = 0; k < 2; ++k) \
        acc[ai][bj][m][n] = __builtin_amdgcn_mfma_f32_16x16x32_bf16(Bt[n][k], At[m][k], acc[ai][bj][m][n], 0, 0, 0); __builtin_amdgcn_s_setprio(0); } while (0)
#define PG8_WAIT_V(n) asm volatile("s_waitcnt vmcnt(" #n ")" ::: "memory")
#define PG8_WAIT_L(n) asm volatile("s_waitcnt lgkmcnt(" #n ")" ::: "memory")
#define PG8_BAR __builtin_amdgcn_s_barrier()
#define PG8_SCHED __builtin_amdgcn_sched_barrier(0)
    Unit cur, nxt; int ui = 0;
    if (!S.next(0, cur)) return;
    f32x4 acc[2][2][4][2];
#pragma unroll
    for (int a = 0; a < 2; ++a)
#pragma unroll
        for (int b = 0; b < 2; ++b)
#pragma unroll
            for (int m = 0; m < 4; ++m)
#pragma unroll
                for (int n = 0; n < 2; ++n) acc[a][b][m][n] = (f32x4){0.f, 0.f, 0.f, 0.f};
    bf16x8 At[4][2], B0[2][2], B1[2][2];
    const char* cA = (const char*)(g.A + cur.a_off); const char* cB = (const char*)(g.Bt + cur.b_off);
    if constexpr (GATH) {
#pragma unroll
        for (int h = 0; h < 2; ++h)
#pragma unroll
            for (int i = 0; i < 2; ++i) vcu[h][i] = S.rowoff(cur, h * HALF + gR[i]) + gC[i]; }
    if constexpr (SP2) {
        PG8_STAGE(PG8_SB(0, 0), cB, voffB); PG8_STAGE(PG8_SB(0, 1), cB + hstepB, voffB); PG8_STA(PG8_SA(0, 0), cA, 0, false); PG8_STA(PG8_SA(0, 1), cA, 1, false);
        if (wr == 1) PG8_BAR;
        PG8_WAIT_V(2); PG8_BAR;
        PG8_STAGE(PG8_SB(1, 0), cB + kstep, voffB); PG8_STA(PG8_SA(1, 0), cA + kstep, 0, false); PG8_STAGE(PG8_SB(1, 1), cB + hstepB + kstep, voffB);
        PG8_WAIT_V(6); PG8_BAR;
    } else {
        PG8_STAGE(PG8_SB(0, 0), cB, voffB); PG8_STA(PG8_SA(0, 0), cA, 0, false); PG8_STAGE(PG8_SB(0, 1), cB + hstepB, voffB); PG8_STA(PG8_SA(0, 1), cA, 1, false);
        if (wr == 1) PG8_BAR;
        PG8_WAIT_V(4); PG8_BAR;
        PG8_STAGE(PG8_SB(1, 0), cB + kstep, voffB); PG8_STA(PG8_SA(1, 0), cA + kstep, 0, false); PG8_STAGE(PG8_SB(1, 1), cB + hstepB + kstep, voffB);
        PG8_WAIT_V(6); PG8_BAR;
    }
    for (;;) {
        const bool has_next = S.next(ui + 1, nxt);
        const char* nA = has_next ? (const char*)(g.A + nxt.a_off) : cA; const char* nB = has_next ? (const char*)(g.Bt + nxt.b_off) : cB;
        if constexpr (GATH) {
#pragma unroll
            for (int h = 0; h < 2; ++h)
#pragma unroll
                for (int i = 0; i < 2; ++i) vnx[h][i] = has_next ? (S.rowoff(nxt, h * HALF + gR[i]) + gC[i]) : vcu[h][i]; }
#pragma unroll 1
        for (int t = 0; t < nt; t += 2) {
            if constexpr (Epi::MIDK) { if (t == (nt >> 1)) E.midk(acc, cur, wr, wc, fr, fq); }
            const bool last = (t == nt - 2);
            const char* a1 = cA + (size_t)(t + 1) * kstep;
            const char* a2 = last ? nA : cA + (size_t)(t + 2) * kstep; const char* b2 = last ? nB : cB + (size_t)(t + 2) * kstep;
            const char* a3 = a2 + kstep; const char* b3 = b2 + kstep;
            if constexpr (SP2) {
            PG8_LDB(B0, 0, 0); PG8_LDB(B1, 0, 1); PG8_SCHED; PG8_LDA(At, 0, 0); PG8_STA(PG8_SA(1, 1), a1, 1, false);
            PG8_WAIT_V(8); PG8_WAIT_L(0); PG8_BAR; PG8_MMA(0, 0, At, B0); PG8_MMA(0, 1, At, B1); PG8_BAR; PG8_SCHED;
            PG8_LDA(At, 0, 1); PG8_STAGE(PG8_SB(0, 0), b2, voffB); PG8_STAGE(PG8_SB(0, 1), b2 + hstepB, voffB); PG8_STA(PG8_SA(0, 0), a2, 0, last);
            PG8_WAIT_V(8); PG8_WAIT_L(0); PG8_BAR; PG8_MMA(1, 0, At, B0); PG8_MMA(1, 1, At, B1); PG8_BAR; PG8_SCHED;
            PG8_LDB(B0, 1, 0); PG8_LDB(B1, 1, 1); PG8_SCHED; PG8_LDA(At, 1, 0); PG8_STA(PG8_SA(0, 1), a2, 1, last);
            PG8_WAIT_V(8); PG8_WAIT_L(0); PG8_BAR; PG8_MMA(0, 0, At, B0); PG8_MMA(0, 1, At, B1); PG8_BAR; PG8_SCHED;
            PG8_LDA(At, 1, 1); PG8_STAGE(PG8_SB(1, 0), b3, voffB); PG8_STAGE(PG8_SB(1, 1), b3 + hstepB, voffB); PG8_STA(PG8_SA(1, 0), a3, 0, last);
            PG8_WAIT_V(8); PG8_WAIT_L(0); PG8_BAR; PG8_MMA(1, 0, At, B0); PG8_MMA(1, 1, At, B1); PG8_BAR; PG8_SCHED;
            } else {
            PG8_LDB(B0, 0, 0); PG8_SCHED; PG8_LDA(At, 0, 0); PG8_STA(PG8_SA(1, 1), a1, 1, false);
            PG8_WAIT_L(8); PG8_BAR; PG8_WAIT_L(0); PG8_MMA(0, 0, At, B0); PG8_BAR; PG8_SCHED;
            PG8_LDB(B1, 0, 1); PG8_STAGE(PG8_SB(0, 0), b2, voffB);
            PG8_BAR; PG8_WAIT_L(0); PG8_MMA(0, 1, At, B1); PG8_BAR;
            PG8_LDA(At, 0, 1); PG8_STA(PG8_SA(0, 0), a2, 0, last);
            PG8_BAR; PG8_WAIT_L(0); PG8_MMA(1, 0, At, B0); PG8_BAR; PG8_SCHED;
            PG8_STAGE(PG8_SB(0, 1), b2 + hstepB, voffB);
            PG8_WAIT_V(6); PG8_BAR; PG8_MMA(1, 1, At, B1); PG8_BAR;
            PG8_LDB(B0, 1, 0); PG8_SCHED; PG8_LDA(At, 1, 0); PG8_STA(PG8_SA(0, 1), a2, 1, last);
            PG8_WAIT_L(8); PG8_BAR; PG8_WAIT_L(0); PG8_MMA(0, 0, At, B0); PG8_BAR; PG8_SCHED;
            PG8_LDB(B1, 1, 1); PG8_STAGE(PG8_SB(1, 0), b3, voffB);
            PG8_BAR; PG8_WAIT_L(0); PG8_MMA(0, 1, At, B1); PG8_BAR;
            PG8_LDA(At, 1, 1); PG8_STA(PG8_SA(1, 0), a3, 0, last);
            PG8_BAR; PG8_WAIT_L(0); PG8_MMA(1, 0, At, B0); PG8_BAR; PG8_SCHED;
            PG8_STAGE(PG8_SB(1, 1), b3 + hstepB, voffB);
            PG8_WAIT_V(6); PG8_BAR; PG8_MMA(1, 1, At, B1); PG8_BAR;
            }
        }
        if constexpr (ALIGN_EPI) { if (wr == 0) PG8_BAR; }
        E(acc, cur, wr, wc, fr, fq);
        if (!has_next) break;
#pragma unroll
        for (int a = 0; a < 2; ++a)
#pragma unroll
            for (int b = 0; b < 2; ++b)
#pragma unroll
                for (int m = 0; m < 4; ++m)
#pragma unroll
                    for (int n = 0; n < 2; ++n) acc[a][b][m][n] = (f32x4){0.f, 0.f, 0.f, 0.f};
        cur = nxt; cA = nA; cB = nB; ++ui;
        if constexpr (GATH) {
#pragma unroll
            for (int h = 0; h < 2; ++h)
#pragma unroll
                for (int i = 0; i < 2; ++i) vcu[h][i] = vnx[h][i]; }
        if constexpr (ALIGN_EPI) { if (wr == 1) PG8_BAR; }
    }
    PG8_WAIT_V(0);
    if constexpr (!ALIGN_EPI) { if (wr == 0) PG8_BAR; }
    PG8_BAR;
#undef PG8_SA
#undef PG8_SB
#undef PG8_STAGE
#undef PG8_STA
#undef PG8_LDA
#undef PG8_LDB
#undef PG8_MMA
#undef PG8_WAIT_V
#undef PG8_WAIT_L
#undef PG8_BAR
#undef PG8_SCHED
}
#ifdef GEMM_SIMPLE
#define GEMM_PHASE(lds, g, S, E) gemm_phase_simple(lds, g, S, E)
#else
#define GEMM_PHASE(lds, g, S, E) gemm_phase<decltype(E), decltype(S), true, true>(lds, g, S, E)
#endif

__device__ __forceinline__ float rstd_from_ssq(const float* ssq, int row) {
    const f32x4* p = (const f32x4*)(ssq + (size_t)row * 16); const f32x4 a = p[0], b = p[1], c = p[2], d = p[3];
    const float s = ((a[0] + a[1]) + (a[2] + a[3])) + ((b[0] + b[1]) + (b[2] + b[3])) + ((c[0] + c[1]) + (c[2] + c[3])) + ((d[0] + d[1]) + (d[2] + d[3]));
    return __builtin_amdgcn_rsqf(s * (1.0f / DM) + EPS);
}
__device__ __forceinline__ u32x4 pack8(const f32x4 v0, const f32x4 v1) { u32x4 w; w.x = cvt_pk_bf16(v0[0], v0[1]); w.y = cvt_pk_bf16(v0[2], v0[3]); w.z = cvt_pk_bf16(v1[0], v1[1]); w.w = cvt_pk_bf16(v1[2], v1[3]); return w; }

struct EpiProj {
    static constexpr bool PERM = true, LDSX = false, MIDK = false;
    bf16_t* base; const float* rope; float* ksum;
    __device__ __forceinline__ void operator()(f32x4 (&acc)[2][2][4][2], const Unit& u, int wr, int wc, int fr, int fq) const {
        const int type = u.pn >> 1, colt = (u.pn & 1) * 256;
        bf16_t* O = base + (size_t)type * NTOK * 512;
        const bool is_q = (type == 2), is_k = (type == 3);
        if ((is_q || is_k) && !(wc & 1)) {
#pragma unroll
            for (int ai = 0; ai < 2; ++ai)
#pragma unroll
                for (int m = 0; m < 4; ++m) {
                    const int row = u.pm * 256 + 128 * ai + 64 * wr + 16 * m + fr, pos = row & (SEQ - 1);
                    const float* rp = rope + pos * 16;
                    const f32x4 cs[2] = { *(const f32x4*)(rp), *(const f32x4*)(rp + 4) }, sn[2] = { *(const f32x4*)(rp + 8), *(const f32x4*)(rp + 12) };
#pragma unroll
                    for (int bj = 0; bj < 2; ++bj)
#pragma unroll
                        for (int n = 0; n < 2; ++n) {
                            const f32x4 mine = acc[ai][bj][m][n]; f32x4 oth;
#pragma unroll
                            for (int e = 0; e < 4; ++e) oth[e] = __shfl_xor(mine[e], 16);
                            f32x4 res = mine;
                            if (fq == 0) res = mine * cs[n] - oth * sn[n];
                            else if (fq == 1) res = mine * cs[n] + oth * sn[n];
                            acc[ai][bj][m][n] = res;
                        }
                }
        }
        const float sc = is_q ? QSCALE : 1.0f;
#pragma unroll
        for (int ai = 0; ai < 2; ++ai)
#pragma unroll
            for (int m = 0; m < 4; ++m) {
                const int row = u.pm * 256 + 128 * ai + 64 * wr + 16 * m + fr;
                bf16_t* rowp = O + (size_t)row * 512 + colt + 32 * wc + 8 * fq;
#pragma unroll
                for (int bj = 0; bj < 2; ++bj) *(u32x4*)(rowp + bj * 128) = pack8(acc[ai][bj][m][0] * sc, acc[ai][bj][m][1] * sc);
            }
        if (is_k) {
#pragma unroll
            for (int bj = 0; bj < 2; ++bj)
#pragma unroll
                for (int n = 0; n < 2; ++n)
#pragma unroll
                    for (int e = 0; e < 4; ++e) {
                        float s = 0.f;
#pragma unroll
                        for (int ai = 0; ai < 2; ++ai)
#pragma unroll
                            for (int m = 0; m < 4; ++m) s += acc[ai][bj][m][n][e];
                        s += __shfl_xor(s, 1); s += __shfl_xor(s, 2); s += __shfl_xor(s, 4); s += __shfl_xor(s, 8);
                        if (fr == 0) atomicAdd(ksum + (size_t)u.pm * 512 + colt + 128 * bj + 32 * wc + 8 * fq + 4 * n + e, s);
                    }
        }
    }
};
struct EpiNull {
    static constexpr bool PERM = true, LDSX = false, MIDK = false;
    __device__ __forceinline__ void operator()(f32x4 (&acc)[2][2][4][2], const Unit& u, int wr, int wc, int fr, int fq) const { asm volatile("" :: "v"(acc[0][0][0][0][0]), "v"(acc[1][1][3][1][3])); }
};
struct EpiStore {
    static constexpr bool PERM = true, LDSX = false, MIDK = false;
    bf16_t* O; int ldc;
    __device__ __forceinline__ void operator()(f32x4 (&acc)[2][2][4][2], const Unit& u, int wr, int wc, int fr, int fq) const {
#pragma unroll
        for (int ai = 0; ai < 2; ++ai)
#pragma unroll
            for (int m = 0; m < 4; ++m) {
                const int row = u.pm * 256 + 128 * ai + 64 * wr + 16 * m + fr;
                bf16_t* rowp = O + (size_t)row * ldc + u.pn * 256 + 32 * wc + 8 * fq;
#pragma unroll
                for (int bj = 0; bj < 2; ++bj) *(u32x4*)(rowp + bj * 128) = pack8(acc[ai][bj][m][0], acc[ai][bj][m][1]);
            }
    }
};
template <bool BASE_F32, bool KSPLIT> struct EpiResid {
    static constexpr bool PERM = true, LDSX = false, MIDK = KSPLIT;
    const void* base; bf16_t* hb; float* ssq; const float* ssql; const float* ssqa;
    __device__ __forceinline__ void stats(int row, int fq, float& rl, float& ra) const {
        const f32x4 pl = *(const f32x4*)(ssql + (size_t)row * 16 + 4 * fq); const f32x2 pa = *(const f32x2*)(ssqa + (size_t)row * 8 + 2 * fq);
        float sl = (pl[0] + pl[1]) + (pl[2] + pl[3]), sa = pa[0] + pa[1];
        sl += __shfl_xor(sl, 16); sl += __shfl_xor(sl, 32); sa += __shfl_xor(sa, 16); sa += __shfl_xor(sa, 32);
        rl = __builtin_amdgcn_rsqf(sl * (1.0f / 512.0f) + EPS); ra = __builtin_amdgcn_rsqf(sa * (1.0f / 512.0f) + EPS);
    }
    __device__ __forceinline__ void midk(f32x4 (&acc)[2][2][4][2], const Unit& u, int wr, int wc, int fr, int fq) const {
        asm volatile("" : "+v"(fr), "+v"(fq));
#pragma unroll
        for (int ai = 0; ai < 2; ++ai)
#pragma unroll
            for (int m = 0; m < 4; ++m) { float rl, ra; stats(u.pm * 256 + 128 * ai + 64 * wr + 16 * m + fr, fq, rl, ra); const float ratio = rl * __builtin_amdgcn_rcpf(ra);
#pragma unroll
                for (int bj = 0; bj < 2; ++bj)
#pragma unroll
                    for (int n = 0; n < 2; ++n) acc[ai][bj][m][n] *= ratio; }
    }
    __device__ __forceinline__ void operator()(f32x4 (&acc)[2][2][4][2], const Unit& u, int wr, int wc, int fr, int fq) const {
#pragma unroll
        for (int ai = 0; ai < 2; ++ai)
#pragma unroll
            for (int m = 0; m < 4; ++m) {
                const int row = u.pm * 256 + 128 * ai + 64 * wr + 16 * m + fr; float q = 0.f, osc = 1.0f;
                if constexpr (KSPLIT) { float rl; stats(row, fq, rl, osc); }
#pragma unroll
                for (int bj = 0; bj < 2; ++bj) {
                    const int col = u.pn * 256 + 128 * bj + 32 * wc + 8 * fq;
                    f32x4 b0, b1;
                    if constexpr (BASE_F32) { b0 = *(const f32x4*)((const float*)base + (size_t)row * DM + col); b1 = *(const f32x4*)((const float*)base + (size_t)row * DM + col + 4); }
                    else { const u32x4 w = *(const u32x4*)((const bf16_t*)base + (size_t)row * LDH + col); b0 = (f32x4){bflo(w.x), bfhi(w.x), bflo(w.y), bfhi(w.y)}; b1 = (f32x4){bflo(w.z), bfhi(w.z), bflo(w.w), bfhi(w.w)}; }
                    const f32x4 v0 = b0 + acc[ai][bj][m][0] * osc, v1 = b1 + acc[ai][bj][m][1] * osc;
                    q += ((v0[0] * v0[0] + v0[1] * v0[1]) + (v0[2] * v0[2] + v0[3] * v0[3])) + ((v1[0] * v1[0] + v1[1] * v1[1]) + (v1[2] * v1[2] + v1[3] * v1[3]));
                    *(u32x4*)(hb + (size_t)row * LDH + col) = pack8(v0, v1);
                }
                q += __shfl_xor(q, 16); q += __shfl_xor(q, 32);
                if (fq == 0) ssq[(size_t)row * 16 + u.pn * 4 + wc] = q;
            }
    }
};
struct EpiRowScale {
    static constexpr bool PERM = true, LDSX = false, MIDK = false;
    bf16_t* O; int ldc; const float* ssq; float cs;
    __device__ __forceinline__ void operator()(f32x4 (&acc)[2][2][4][2], const Unit& u, int wr, int wc, int fr, int fq) const {
#pragma unroll
        for (int ai = 0; ai < 2; ++ai)
#pragma unroll
            for (int m = 0; m < 4; ++m) {
                const int row = u.pm * 256 + 128 * ai + 64 * wr + 16 * m + fr; const float s = rstd_from_ssq(ssq, row) * cs;
                bf16_t* rowp = O + (size_t)row * ldc + u.pn * 256 + 32 * wc + 8 * fq;
#pragma unroll
                for (int bj = 0; bj < 2; ++bj) *(u32x4*)(rowp + bj * 128) = pack8(acc[ai][bj][m][0] * s, acc[ai][bj][m][1] * s);
            }
    }
};
#define XBAR() do { asm volatile("s_waitcnt lgkmcnt(0)" ::: "memory"); __builtin_amdgcn_s_barrier(); asm volatile("" ::: "memory"); } while (0)
struct EpiSoftmax {
    static constexpr bool PERM = true, LDSX = false, MIDK = false;
    bf16_t* O; int ldc; LAS unsigned char* xl; const float* ssq; float cs;
    __device__ __forceinline__ void operator()(f32x4 (&acc)[2][2][4][2], const Unit& u, int wr, int wc, int fr, int fq) const {
        LAS float* P = (LAS float*)xl;
        LAS float* Q = (LAS float*)(xl + 4096);
#pragma unroll
        for (int ai = 0; ai < 2; ++ai)
#pragma unroll
            for (int m = 0; m < 4; ++m) {
                float v = -INFINITY; const float sc = rstd_from_ssq(ssq, u.pm * 256 + 128 * ai + 64 * wr + 16 * m + fr) * cs;
#pragma unroll
                for (int bj = 0; bj < 2; ++bj)
#pragma unroll
                    for (int n = 0; n < 2; ++n) { const f32x4 x = acc[ai][bj][m][n] * sc; acc[ai][bj][m][n] = x; v = fmaxf(v, fmaxf(fmaxf(x[0], x[1]), fmaxf(x[2], x[3]))); }
                v = fmaxf(v, __shfl_xor(v, 16)); v = fmaxf(v, __shfl_xor(v, 32));
                if (fq == 0) P[(128 * ai + 64 * wr + 16 * m + fr) * 4 + wc] = v;
            }
        XBAR();
#pragma unroll
        for (int ai = 0; ai < 2; ++ai)
#pragma unroll
            for (int m = 0; m < 4; ++m) {
                const int r = 128 * ai + 64 * wr + 16 * m + fr;
                const float v = fmaxf(fmaxf(P[r * 4 + 0], P[r * 4 + 1]), fmaxf(P[r * 4 + 2], P[r * 4 + 3]));
                float s = 0.f;
#pragma unroll
                for (int bj = 0; bj < 2; ++bj)
#pragma unroll
                    for (int n = 0; n < 2; ++n) { f32x4 x = acc[ai][bj][m][n];
#pragma unroll
                        for (int e = 0; e < 4; ++e) { x[e] = __builtin_amdgcn_exp2f(x[e] - v); s += x[e]; }
                        acc[ai][bj][m][n] = x; }
                s += __shfl_xor(s, 16); s += __shfl_xor(s, 32);
                if (fq == 0) Q[r * 4 + wc] = s;
            }
        XBAR();
#pragma unroll
        for (int ai = 0; ai < 2; ++ai)
#pragma unroll
            for (int m = 0; m < 4; ++m) {
                const int r = 128 * ai + 64 * wr + 16 * m + fr;
                const float inv = 1.0f / ((Q[r * 4 + 0] + Q[r * 4 + 1]) + (Q[r * 4 + 2] + Q[r * 4 + 3]));
                bf16_t* rowp = O + (size_t)(u.pm * 256 + r) * ldc + u.pn * 256 + 32 * wc + 8 * fq;
#pragma unroll
                for (int bj = 0; bj < 2; ++bj) *(u32x4*)(rowp + bj * 128) = pack8(acc[ai][bj][m][0] * inv, acc[ai][bj][m][1] * inv);
            }
        XBAR();
    }
};
struct EpiGateUp {
    static constexpr bool PERM = true, LDSX = false, MIDK = false;
    bf16_t* O; const float* lrs;
    __device__ __forceinline__ void operator()(f32x4 (&acc)[2][2][4][2], const Unit& u, int wr, int wc, int fr, int fq) const {
#pragma unroll
        for (int ai = 0; ai < 2; ++ai)
#pragma unroll
            for (int m = 0; m < 4; ++m) {
                const int r = 128 * ai + 64 * wr + 16 * m + fr, row = u.pm * 256 + r; const float rs = (r < u.nvalid) ? lrs[u.lbase + r] : 0.f;
                f32x4 o[2];
#pragma unroll
                for (int n = 0; n < 2; ++n)
#pragma unroll
                    for (int e = 0; e < 4; ++e) { const float g = acc[ai][0][m][n][e] * rs, up = acc[ai][1][m][n][e] * rs; o[n][e] = g * sigmoidf_(g) * up; }
                *(u32x4*)(O + (size_t)row * DFF + u.pn * 128 + 32 * wc + 8 * fq) = pack8(o[0], o[1]);
            }
    }
};

struct Args { const float* in[27]; float* out; unsigned char* ws; int ph_lo, ph_hi; float invf[8]; };
struct Ctx { LAS unsigned char* lds; int tid, lane, wave, vcu, G; };

__device__ __forceinline__ void tr_load(f32x4 (&v)[8], const float* W, int ldw, int k0, int n0s, int lane) {
    const int kr = lane >> 3, ch = lane & 7;
#pragma unroll
    for (int i = 0; i < 8; ++i) v[i] = *(const f32x4*)(W + (size_t)(k0 + 8 * i + kr) * ldw + n0s + 4 * ch);
}
__device__ __forceinline__ void tr_finish(const f32x4 (&v)[8], int k0, bf16_t* WT, int ldt, int r0d, const float* gain, LAS float* scr, int lane) {
    const int kr = lane >> 3, ch = lane & 7, c = lane & 7;
    f32x4 g0 = {1.f, 1.f, 1.f, 1.f}, g1 = {1.f, 1.f, 1.f, 1.f};
    if (gain) { g0 = *(const f32x4*)(gain + k0 + 8 * c); g1 = *(const f32x4*)(gain + k0 + 8 * c + 4); }
#pragma unroll
    for (int i = 0; i < 8; ++i) { LAS float* d = scr + (8 * i + kr) * 33 + 4 * ch; d[0] = v[i][0]; d[1] = v[i][1]; d[2] = v[i][2]; d[3] = v[i][3]; }
    LDS_WAIT(); asm volatile("" ::: "memory");
#pragma unroll
    for (int j = 0; j < 4; ++j) { const int n = (lane >> 3) + 8 * j; const LAS float* s = scr + (8 * c) * 33 + n;
        u32x4 o; o.x = cvt_pk_bf16(s[0 * 33] * g0[0], s[1 * 33] * g0[1]); o.y = cvt_pk_bf16(s[2 * 33] * g0[2], s[3 * 33] * g0[3]); o.z = cvt_pk_bf16(s[4 * 33] * g1[0], s[5 * 33] * g1[1]); o.w = cvt_pk_bf16(s[6 * 33] * g1[2], s[7 * 33] * g1[3]);
        *(u32x4*)(WT + (size_t)(r0d + n) * ldt + k0 + 8 * c) = o; }
    LDS_WAIT(); asm volatile("" ::: "memory");
}
__device__ __forceinline__ void tr_item(const float* W, int ldw, int k0, int n0s, bf16_t* WT, int ldt, int r0d, const float* gain, LAS float* scr, int lane) {
    f32x4 v[8]; tr_load(v, W, ldw, k0, n0s, lane); tr_finish(v, k0, WT, ldt, r0d, gain, scr, lane);
}
__device__ __forceinline__ void rms_row_to_bf16(const float* xrow, const float* gain, bf16_t* orow, int lane) {
    const f32x4* xr = (const f32x4*)xrow + lane; const f32x4* gr = (const f32x4*)gain + lane;
    f32x4 v[4]; float s = 0.f;
#pragma unroll
    for (int j = 0; j < 4; ++j) { v[j] = xr[64 * j]; s += (v[j][0] * v[j][0] + v[j][1] * v[j][1]) + (v[j][2] * v[j][2] + v[j][3] * v[j][3]); }
    const float rstd = 1.0f / sqrtf(wave_sum(s) * (1.0f / DM) + EPS);
    u32x2* o8 = (u32x2*)orow + lane;
#pragma unroll
    for (int j = 0; j < 4; ++j) { const f32x4 g = gr[64 * j]; u32x2 w; w.x = cvt_pk_bf16(v[j][0] * rstd * g[0], v[j][1] * rstd * g[1]); w.y = cvt_pk_bf16(v[j][2] * rstd * g[2], v[j][3] * rstd * g[3]); o8[64 * j] = w; }
}

__device__ __forceinline__ void rms_row2_to_bf16(const float* xrow, const float* gain, bf16_t* orow, int lane) {
    const f32x4* xr = (const f32x4*)xrow + lane; const f32x4* gr = (const f32x4*)gain + lane;
    f32x4 v[2][4]; float s[2] = {0.f, 0.f};
#pragma unroll
    for (int r = 0; r < 2; ++r)
#pragma unroll
        for (int j = 0; j < 4; ++j) v[r][j] = xr[256 * r + 64 * j];
#pragma unroll
    for (int r = 0; r < 2; ++r)
#pragma unroll
        for (int j = 0; j < 4; ++j) s[r] += (v[r][j][0] * v[r][j][0] + v[r][j][1] * v[r][j][1]) + (v[r][j][2] * v[r][j][2] + v[r][j][3] * v[r][j][3]);
#pragma unroll
    for (int r = 0; r < 2; ++r) { const float rstd = 1.0f / sqrtf(wave_sum(s[r]) * (1.0f / DM) + EPS); u32x2* o8 = (u32x2*)(orow + (size_t)r * DM) + lane;
#pragma unroll
        for (int j = 0; j < 4; ++j) { const f32x4 g = gr[64 * j]; u32x2 w; w.x = cvt_pk_bf16(v[r][j][0] * rstd * g[0], v[r][j][1] * rstd * g[1]); w.y = cvt_pk_bf16(v[r][j][2] * rstd * g[2], v[r][j][3] * rstd * g[3]); o8[64 * j] = w; } }
}

__device__ __forceinline__ void conv_wdn(const Args& a, const Ctx& C, int gw, int NGW, int it_lo, int NIT) {
    LAS float* scr = (LAS float*)(C.lds + C.wave * 16384); const int lane = C.lane;
    f32x4 va[8], vb[8];
#define WDN_LOAD(v, it) do { const int e_ = (it) / 256, r_ = (it) % 256; tr_load(v, a.in[25] + (size_t)e_ * DFF * DM, DM, 64 * (r_ / 32), 32 * (r_ % 32), lane); } while (0)
#define WDN_FIN(v, it) do { const int e_ = (it) / 256, r_ = (it) % 256; tr_finish(v, 64 * (r_ / 32), (bf16_t*)(a.ws + WS_WDN), DFF, e_ * 1024 + 32 * (r_ % 32), nullptr, scr, lane); } while (0)
    int it = it_lo + gw; if (it < NIT) WDN_LOAD(va, it);
    for (; it < NIT; it += 2 * NGW) {
        const int it1 = it + NGW, it2 = it + 2 * NGW;
        if (it1 < NIT) WDN_LOAD(vb, it1);
        WDN_FIN(va, it);
        if (it2 < NIT) WDN_LOAD(va, it2);
        if (it1 < NIT) WDN_FIN(vb, it1);
    }
#undef WDN_LOAD
#undef WDN_FIN
}
__device__ __forceinline__ void ph_prologue(const Args& a, const Ctx& C) {
    unsigned char* ws = a.ws;
    LAS float* scr = (LAS float*)(C.lds + C.wave * 16384);
    const int gw = C.vcu * 8 + C.wave, NGW = C.G * 8, lane = C.lane;
    for (int it = gw; it < 16 * 80; it += NGW) { const int kb = it / 80, nb = it % 80; tr_item(a.in[3], DIN, 64 * kb, 32 * nb, (bf16_t*)(ws + WS_WIN), DM, 32 * nb, nullptr, scr, lane); }
    for (int it = gw; it < 16 * 64; it += NGW) { const int kb = it / 64, nb = it % 64;
        if (nb < 32) tr_item(a.in[17], 2 * DM, 64 * kb, 32 * nb, (bf16_t*)(ws + WS_WXK), DM, 32 * nb, nullptr, scr, lane);
        else tr_item(a.in[17], 2 * DM, 64 * kb, 32 * nb, (bf16_t*)(ws + WS_WXV), DM, 32 * (nb - 32), nullptr, scr, lane); }
    for (int it = gw; it < 16 * 32; it += NGW) { const int kb = it / 32, nb = it % 32;
        tr_item(a.in[13], DM, 64 * kb, 32 * nb, (bf16_t*)(ws + WS_WOUT), DM, 32 * nb, (kb < 8) ? a.in[11] : (a.in[12] - DLRU), scr, lane);
        tr_item(a.in[18], DM, 64 * kb, 32 * nb, (bf16_t*)(ws + WS_WXO), DM, 32 * nb, nullptr, scr, lane); }
    for (int it = gw; it < NEXP * 16 * 32; it += NGW) { const int e = it / 512, r = it % 512, kb = r / 32, nb = r % 32, j = nb >> 3, half = (nb >> 2) & 1, q = nb & 3;
        tr_item(a.in[24] + (size_t)e * DM * DM, DM, 64 * kb, half * 512 + j * 128 + q * 32, (bf16_t*)(ws + WS_WGU), DM, e * 1024 + j * 256 + half * 128 + q * 32, a.in[19], scr, lane); }
    for (int r = gw; r < DM; r += NGW) { const float gk = a.in[14][r]; const f32x4* src = (const f32x4*)(a.in[16] + (size_t)r * DM) + lane; u32x2* dst = (u32x2*)((bf16_t*)(ws + WS_WXQ) + (size_t)r * DM) + lane;
#pragma unroll
        for (int j = 0; j < 4; ++j) { const f32x4 v = src[64 * j]; u32x2 w; w.x = cvt_pk_bf16(v[0] * gk, v[1] * gk); w.y = cvt_pk_bf16(v[2] * gk, v[3] * gk); dst[64 * j] = w; } }
    conv_wdn(a, C, gw, NGW, WDN_SPLIT, NEXP * 8 * 32);
    { bf16_t* WR = (bf16_t*)(ws + WS_WR); const int gt = C.vcu * 512 + C.tid, NT = C.G * 512;
      for (int i = gt; i < 48 * DM; i += NT) { const int r = i / DM, k = i % DM; float v = 0.f;
          if (r < 4) v = a.in[20][k * NGRP + r] * a.in[19][k]; else if (r < 36) v = a.in[22][k * NEXP + (r - 4)] * a.in[19][k];
          WR[i] = (bf16_t)(cvt_pk_bf16(v, 0.f) & 0xffffu); }
      float* rope = (float*)(ws + WS_ROPE);
      for (int i = gt; i < SEQ * 8; i += NT) { const int pos = i >> 3, j = i & 7; const float ang = (float)pos * a.invf[j];
          const double tw = 6.283185307179586476925286766559; const double ad = (double)ang; const double red = ad - tw * __builtin_rint(ad / tw); const float rf = (float)red;
          rope[pos * 16 + j] = __cosf(rf); rope[pos * 16 + 8 + j] = __sinf(rf); } }
    for (int m = 2 * gw; m < NTOK; m += 2 * NGW) rms_row2_to_bf16(a.in[0] + (size_t)m * DM, a.in[2], (bf16_t*)(ws + WS_B) + (size_t)m * DM, lane);
    for (int m = 2 * gw; m < NMEM; m += 2 * NGW) rms_row2_to_bf16(a.in[1] + (size_t)m * DM, a.in[15], (bf16_t*)(ws + WS_MEMN) + (size_t)m * DM, lane);
}

__device__ __forceinline__ float gelu_tanh(float x) { const float x2 = x * x; const float z2 = x * (-2.0f * 0.7978845608028654f * 1.4426950408889634f) * (1.0f + 0.044715f * x2);
    return x * __builtin_amdgcn_rcpf(1.0f + __builtin_amdgcn_exp2f(z2)); }
__device__ __forceinline__ float one_minus_exp(float x) {
    const float p = -x * (1.0f + x * (0.5f + x * (0.16666667f + x * (0.041666668f + x * 0.0083333338f))));
    const float e = 1.0f - __builtin_amdgcn_exp2f(x * 1.4426950408889634f);
    return (x > -0.25f) ? p : e;
}
__device__ __forceinline__ void lru_unit(const Args& a, const Ctx& C, int b, int blk, int half) {
    unsigned char* ws = a.ws;
    const bf16_t* XL = (const bf16_t*)(ws + WS_A); const bf16_t* GL = XL + (size_t)NTOK * 512; bf16_t* YC = (bf16_t*)(ws + WS_C); float* SSQL = (float*)(ws + WS_SSQL);
    const int tid = C.tid, lane = C.lane, wave = C.wave, fr = lane & 15, fq = lane >> 4;
    LAS float* XW = (LAS float*)(C.lds + wave * 5120);
    LAS bf16_t* GW = (LAS bf16_t*)(C.lds + wave * 5120 + 2304);
    LAS bf16_t* YW = (LAS bf16_t*)(C.lds + wave * 5120 + 3584);
    LAS float* WSUM = (LAS float*)(C.lds + 40960);
    LAS float* CW = (LAS float*)(C.lds + 45056);
    const int c0 = blk * 64, oc0 = c0 + half * 32;
    bf16x8 wfr[2][2][2];
#pragma unroll
    for (int gt = 0; gt < 2; ++gt) { const float* W = a.in[gt == 0 ? 6 : 8] + (size_t)blk * 64 * 64;
#pragma unroll
        for (int nt = 0; nt < 2; ++nt)
#pragma unroll
            for (int ks = 0; ks < 2; ++ks) { u32x4 w; float f[8];
#pragma unroll
                for (int j = 0; j < 8; ++j) f[j] = W[(32 * ks + 8 * fq + j) * 64 + half * 32 + 16 * nt + fr];
                w.x = cvt_pk_bf16(f[0], f[1]); w.y = cvt_pk_bf16(f[2], f[3]); w.z = cvt_pk_bf16(f[4], f[5]); w.w = cvt_pk_bf16(f[6], f[7]);
                wfr[gt][nt][ks] = __builtin_bit_cast(bf16x8, w); } }
    float brg[2], big[2], sp[2], hc[2] = {0.f, 0.f};
#pragma unroll
    for (int nt = 0; nt < 2; ++nt) { const int ch = oc0 + 16 * nt + fr; brg[nt] = a.in[7][ch] * -1.4426950408889634f; big[nt] = a.in[9][ch] * -1.4426950408889634f; const float lam = a.in[10][ch];
        sp[nt] = -8.0f * 1.4426950408889634f * ((lam > 15.f) ? __expf(-lam) : log1pf(__expf(-lam))); }
    if (tid < 320) { const int k = tid >> 6, c = tid & 63; CW[tid] = (k < 4) ? a.in[4][k * DLRU + c0 + c] : a.in[5][c0 + c]; }
    u32x4 xrs[2][4][2], grs[2];
    const bf16_t* xrow0 = XL + ((size_t)b * SEQ + 16 * wave + fr) * 512 + c0 + 8 * fq;
    const bf16_t* grow0 = GL + ((size_t)b * SEQ + 16 * wave + (lane >> 2)) * 512 + oc0 + 8 * (lane & 3);
    const int tloc = 16 * wave + fr;
#define LRU_PREFETCH(t0_, xr, gr) do { _Pragma("unroll") for (int k = 0; k < 4; ++k) { const int tt = (t0_) + tloc - 3 + k; \
        if (tt >= 0) { const bf16_t* xp = xrow0 + (ptrdiff_t)((t0_) - 3 + k) * 512; xr[k][0] = *(const u32x4*)xp; xr[k][1] = *(const u32x4*)(xp + 32); } else { xr[k][0] = (u32x4){0u, 0u, 0u, 0u}; xr[k][1] = (u32x4){0u, 0u, 0u, 0u}; } } \
        gr = *(const u32x4*)(grow0 + (size_t)(t0_) * 512); } while (0)
    LRU_PREFETCH(0, xrs[0], grs[0]); LRU_PREFETCH(128, xrs[1], grs[1]);
    __syncthreads();
    for (int ch2 = 0; ch2 < SEQ / 256; ++ch2) {
#pragma unroll
      for (int sub = 0; sub < 2; ++sub) { const int ch = 2 * ch2 + sub, t0 = ch * 128; auto& xr = xrs[sub]; auto& gr = grs[sub];
        bf16x8 af[2];
#pragma unroll
        for (int ks = 0; ks < 2; ++ks) { float accv[8];
            { const f32x4 b0 = *(const LAS f32x4*)(CW + 256 + 32 * ks + 8 * fq), b1 = *(const LAS f32x4*)(CW + 256 + 32 * ks + 8 * fq + 4);
              accv[0] = b0[0]; accv[1] = b0[1]; accv[2] = b0[2]; accv[3] = b0[3]; accv[4] = b1[0]; accv[5] = b1[1]; accv[6] = b1[2]; accv[7] = b1[3]; }
#pragma unroll
            for (int k = 0; k < 4; ++k) { const f32x4 w0 = *(const LAS f32x4*)(CW + 64 * k + 32 * ks + 8 * fq), w1 = *(const LAS f32x4*)(CW + 64 * k + 32 * ks + 8 * fq + 4); const u32x4 x = xr[k][ks];
                accv[0] += w0[0] * bflo(x.x); accv[1] += w0[1] * bfhi(x.x); accv[2] += w0[2] * bflo(x.y); accv[3] += w0[3] * bfhi(x.y);
                accv[4] += w1[0] * bflo(x.z); accv[5] += w1[1] * bfhi(x.z); accv[6] += w1[2] * bflo(x.w); accv[7] += w1[3] * bfhi(x.w); }
            u32x4 p; p.x = cvt_pk_bf16(accv[0], accv[1]); p.y = cvt_pk_bf16(accv[2], accv[3]); p.z = cvt_pk_bf16(accv[4], accv[5]); p.w = cvt_pk_bf16(accv[6], accv[7]);
            af[ks] = __builtin_bit_cast(bf16x8, p);
            if (ks == half) { *(LAS f32x4*)(XW + fr * 36 + 8 * fq) = (f32x4){accv[0], accv[1], accv[2], accv[3]}; *(LAS f32x4*)(XW + fr * 36 + 8 * fq + 4) = (f32x4){accv[4], accv[5], accv[6], accv[7]}; } }
        *(LAS u32x4*)(GW + (lane >> 2) * 40 + 8 * (lane & 3)) = gr;
        if (ch + 2 < SEQ / 128) LRU_PREFETCH(t0 + 256, xr, gr);
        LDS_WAIT(); asm volatile("" ::: "memory");
        float Hl[2][4], Al[2][4], Aex[2], Hex[2];
        { f32x4 ar[2] = {{0.f, 0.f, 0.f, 0.f}, {0.f, 0.f, 0.f, 0.f}}, ai_[2] = {{0.f, 0.f, 0.f, 0.f}, {0.f, 0.f, 0.f, 0.f}};
#pragma unroll
          for (int ks = 0; ks < 2; ++ks)
#pragma unroll
              for (int nt = 0; nt < 2; ++nt) { ar[nt] = __builtin_amdgcn_mfma_f32_16x16x32_bf16(af[ks], wfr[0][nt][ks], ar[nt], 0, 0, 0); ai_[nt] = __builtin_amdgcn_mfma_f32_16x16x32_bf16(af[ks], wfr[1][nt][ks], ai_[nt], 0, 0, 0); }
#pragma unroll
          for (int nt = 0; nt < 2; ++nt) {
              float hrun = 0.f, arun = 1.f;
#pragma unroll
              for (int r = 0; r < 4; ++r) { const int chn = 16 * nt + fr;
                  const float rg = __builtin_amdgcn_rcpf(1.0f + __builtin_amdgcn_exp2f(__builtin_fmaf(ar[nt][r], -1.4426950408889634f, brg[nt])));
                  const float ig = __builtin_amdgcn_rcpf(1.0f + __builtin_amdgcn_exp2f(__builtin_fmaf(ai_[nt][r], -1.4426950408889634f, big[nt])));
                  const float av = __builtin_amdgcn_exp2f(rg * sp[nt]); const float mult = __builtin_amdgcn_sqrtf(fmaxf(1.0f - av * av, 0.f));
                  const float uv = mult * ig * XW[(4 * fq + r) * 36 + chn];
                  hrun = av * hrun + uv; arun *= av; Hl[nt][r] = hrun; Al[nt][r] = arun; }
              const float A0 = __shfl(arun, fr), H0 = __shfl(hrun, fr), A1 = __shfl(arun, fr + 16), H1 = __shfl(hrun, fr + 16), A2 = __shfl(arun, fr + 32), H2 = __shfl(hrun, fr + 32), A3 = __shfl(arun, fr + 48), H3 = __shfl(hrun, fr + 48);
              const float h01 = A1 * H0 + H1, a01 = A1 * A0, h012 = A2 * h01 + H2, a012 = A2 * a01;
              Aex[nt] = (fq == 0) ? 1.f : (fq == 1) ? A0 : (fq == 2) ? a01 : a012;
              Hex[nt] = (fq == 0) ? 0.f : (fq == 1) ? H0 : (fq == 2) ? h01 : h012;
              if (fq == 0) *(LAS f32x2*)(WSUM + (((ch & 1) * 8 + wave) * 32 + 16 * nt + fr) * 2) = (f32x2){A3 * a012, A3 * h012 + H3}; } }
        __syncthreads();
        { float ssr[4] = {0.f, 0.f, 0.f, 0.f};
#pragma unroll
          for (int nt = 0; nt < 2; ++nt) { const int chn = 16 * nt + fr; float x = hc[nt], mine = 0.f;
#pragma unroll
              for (int w2 = 0; w2 < 8; ++w2) { const f32x2 sm = *(const LAS f32x2*)(WSUM + (((ch & 1) * 8 + w2) * 32 + chn) * 2); if (w2 == wave) mine = x; x = sm[0] * x + sm[1]; }
              hc[nt] = x;
              const float hstart = Aex[nt] * mine + Hex[nt];
#pragma unroll
              for (int r = 0; r < 4; ++r) { const int tl = 4 * fq + r; const float h = Al[nt][r] * hstart + Hl[nt][r];
                  const float y = h * gelu_tanh(bf2f(GW[tl * 40 + chn])); const unsigned yb = cvt_pk_bf16(y, 0.f) & 0xffffu; YW[tl * 40 + chn] = (bf16_t)yb;
                  const float yr = __uint_as_float(yb << 16); ssr[r] += yr * yr; } }
#pragma unroll
          for (int r = 0; r < 4; ++r) { float q = ssr[r]; q += __shfl_xor(q, 1); q += __shfl_xor(q, 2); q += __shfl_xor(q, 4); q += __shfl_xor(q, 8);
              if (fr == 0) SSQL[((size_t)b * SEQ + t0 + 16 * wave + 4 * fq + r) * 16 + blk * 2 + half] = q; } }
        LDS_WAIT(); asm volatile("" ::: "memory");
        *(u32x4*)(YC + ((size_t)b * SEQ + t0 + 16 * wave + (lane >> 2)) * DM + oc0 + 8 * (lane & 3)) = *(const LAS u32x4*)(YW + (lane >> 2) * 40 + 8 * (lane & 3));
      }
    }
#undef LRU_PREFETCH
    __syncthreads();
}

__device__ __forceinline__ void moba_unit_simple(const Args& a, const Ctx& C, int b, int h, int qb) {
    unsigned char* ws = a.ws;
    const bf16_t* Q = (const bf16_t*)(ws + WS_A) + (size_t)2 * NTOK * 512; const bf16_t* K = Q + (size_t)NTOK * 512; const bf16_t* V = K + (size_t)NTOK * 512;
    bf16_t* YA = (bf16_t*)(ws + WS_B) + (size_t)NTOK * 512; const float* KSUM = (const float*)(ws + WS_KSUM);
    const int q = C.tid & 255, hf = C.tid >> 8; const size_t row = (size_t)b * SEQ + qb * 256 + q;
    float qv[64];
    { const u32x4* qp = (const u32x4*)(Q + row * 512 + h * 64);
#pragma unroll
      for (int i = 0; i < 8; ++i) { const u32x4 w = qp[i]; qv[8 * i] = bflo(w.x); qv[8 * i + 1] = bfhi(w.x); qv[8 * i + 2] = bflo(w.y); qv[8 * i + 3] = bfhi(w.y); qv[8 * i + 4] = bflo(w.z); qv[8 * i + 5] = bfhi(w.z); qv[8 * i + 6] = bflo(w.w); qv[8 * i + 7] = bfhi(w.w); } }
    unsigned sel = 0u;
    { float g[8];
#pragma unroll
      for (int n = 0; n < 8; ++n) { g[n] = -INFINITY;
          if (n < qb) { const float* ks = KSUM + (size_t)(b * 8 + n) * 512 + h * 64; float s = 0.f;
#pragma unroll
              for (int d = 0; d < 64; ++d) s += qv[d] * ks[d];
              g[n] = s; } }
      const int npick = qb < 3 ? qb : 3;
      for (int p = 0; p < npick; ++p) { int best = -1; float bv = -INFINITY;
#pragma unroll
          for (int n = 0; n < 8; ++n) { const bool ok = (n < qb) && !((sel >> n) & 1u) && (best < 0 || g[n] > bv); if (ok) { best = n; bv = g[n]; } }
          if (best >= 0) sel |= 1u << best; } }
    float o[32], mrun = -1e30f, l = 0.f;
#pragma unroll
    for (int d = 0; d < 32; ++d) o[d] = 0.f;
    for (int n = 0; n <= qb; ++n) {
        const bool own = (n == qb); const bool use = own || ((sel >> n) & 1u);
        if (!__any(use)) continue;
        for (int j = 0; j < 256; ++j) {
            const bool valid = use && (!own || j <= q);
            if (!__any(valid)) continue;
            const size_t krow = (size_t)b * SEQ + n * 256 + j;
            const u32x4* kp = (const u32x4*)(K + krow * 512 + h * 64); float s = 0.f;
#pragma unroll
            for (int i = 0; i < 8; ++i) { const u32x4 w = kp[i];
                s += qv[8 * i] * bflo(w.x) + qv[8 * i + 1] * bfhi(w.x) + qv[8 * i + 2] * bflo(w.y) + qv[8 * i + 3] * bfhi(w.y) + qv[8 * i + 4] * bflo(w.z) + qv[8 * i + 5] * bfhi(w.z) + qv[8 * i + 6] * bflo(w.w) + qv[8 * i + 7] * bfhi(w.w); }
            if (valid) {
                const float mnew = fmaxf(mrun, s), f = __builtin_amdgcn_exp2f(mrun - mnew), p = __builtin_amdgcn_exp2f(s - mnew);
                l = l * f + p; mrun = mnew;
                const u32x4* vp = (const u32x4*)(V + krow * 512 + h * 64 + 32 * hf);
#pragma unroll
                for (int i = 0; i < 4; ++i) { const u32x4 w = vp[i];
                    o[8 * i] = o[8 * i] * f + p * bflo(w.x); o[8 * i + 1] = o[8 * i + 1] * f + p * bfhi(w.x); o[8 * i + 2] = o[8 * i + 2] * f + p * bflo(w.y); o[8 * i + 3] = o[8 * i + 3] * f + p * bfhi(w.y);
                    o[8 * i + 4] = o[8 * i + 4] * f + p * bflo(w.z); o[8 * i + 5] = o[8 * i + 5] * f + p * bfhi(w.z); o[8 * i + 6] = o[8 * i + 6] * f + p * bflo(w.w); o[8 * i + 7] = o[8 * i + 7] * f + p * bfhi(w.w); }
            }
        }
    }
    const float inv = 1.0f / l;
    u32x4* op = (u32x4*)(YA + row * 512 + h * 64 + 32 * hf);
#pragma unroll
    for (int i = 0; i < 4; ++i) { u32x4 w; w.x = cvt_pk_bf16(o[8 * i] * inv, o[8 * i + 1] * inv); w.y = cvt_pk_bf16(o[8 * i + 2] * inv, o[8 * i + 3] * inv); w.z = cvt_pk_bf16(o[8 * i + 4] * inv, o[8 * i + 5] * inv); w.w = cvt_pk_bf16(o[8 * i + 6] * inv, o[8 * i + 7] * inv); op[i] = w; }
}

__device__ __forceinline__ void ph_ymix(const Args& a, const Ctx& C) {
    const bf16_t* YL = (const bf16_t*)(a.ws + WS_B); const bf16_t* YA = YL + (size_t)NTOK * 512; bf16_t* YM = (bf16_t*)(a.ws + WS_C);
    const int gw = C.vcu * 8 + C.wave, NGW = C.G * 8, lane = C.lane;
    for (int m = gw; m < NTOK; m += NGW) {
#pragma unroll
        for (int part = 0; part < 2; ++part) {
            const u32x4 w = *((const u32x4*)((part ? YA : YL) + (size_t)m * 512) + lane);
            float v[8] = {bflo(w.x), bfhi(w.x), bflo(w.y), bfhi(w.y), bflo(w.z), bfhi(w.z), bflo(w.w), bfhi(w.w)}; float s = 0.f;
#pragma unroll
            for (int i = 0; i < 8; ++i) s += v[i] * v[i];
            const float rstd = 1.0f / sqrtf(wave_sum(s) * (1.0f / 512.0f) + EPS);
            u32x4 o; o.x = cvt_pk_bf16(v[0] * rstd, v[1] * rstd); o.y = cvt_pk_bf16(v[2] * rstd, v[3] * rstd); o.z = cvt_pk_bf16(v[4] * rstd, v[5] * rstd); o.w = cvt_pk_bf16(v[6] * rstd, v[7] * rstd);
            *((u32x4*)(YM + (size_t)m * DM + part * 512) + lane) = o;
        }
    }
}

__device__ __forceinline__ void ph_router(const Args& a, const Ctx& C) {
    unsigned char* ws = a.ws;
    const bf16_t* H2B = (const bf16_t*)a.out + DM; const bf16_t* WR = (const bf16_t*)(ws + WS_WR); const float* SSQ2 = (const float*)(ws + WS_SSQ2);
    unsigned* CNT = (unsigned*)(ws + WS_CTL) + CW_CNT;
    int* TOKE = (int*)(ws + WS_TOK + TOK_E); int* TOKR = (int*)(ws + WS_TOK + TOK_R); float* TOKG = (float*)(ws + WS_TOK + TOK_G); int* LTOK = (int*)(ws + WS_LTOK); float* LRS = (float*)(ws + WS_LRS);
    constexpr int WRS = 1032;
    LAS bf16_t* WRL = (LAS bf16_t*)C.lds;
    LAS float* LG = (LAS float*)(C.lds + 99072) + C.wave * (16 * 49);
    LAS unsigned* lcnt = (LAS unsigned*)(C.lds + 99072 + 25088); LAS unsigned* lbase = lcnt + 32;
    const int lane = C.lane, fr = lane & 15, fq = lane >> 4;
    for (int i = C.tid; i < 48 * 128; i += 512) { const int r = i >> 7, c8 = i & 127; *(LAS u32x4*)(WRL + r * WRS + 8 * c8) = *(const u32x4*)(WR + (size_t)r * DM + 8 * c8); }
    for (int pass = 0; (pass * C.G) * 128 < NTOK; ++pass) {
        const int blk = pass * C.G + C.vcu; const bool live = blk * 128 < NTOK;
        if (C.tid < 32) lcnt[C.tid] = 0u;
        __syncthreads();
        int E1 = 0, E2 = 0; unsigned r1 = 0, r2 = 0; float ga = 0.f, gb = 0.f, rstd_t = 0.f; const int tb = blk * 128 + 16 * C.wave;
        if (live) {
            f32x4 acc[3] = {{0.f, 0.f, 0.f, 0.f}, {0.f, 0.f, 0.f, 0.f}, {0.f, 0.f, 0.f, 0.f}};
            bf16x8 af[32];
#pragma unroll
            for (int ks = 0; ks < 32; ++ks) af[ks] = *(const bf16x8*)(H2B + (size_t)(tb + fr) * LDH + 32 * ks + 8 * fq);
#pragma unroll
            for (int ks = 0; ks < 32; ++ks) {
#pragma unroll
                for (int nt = 0; nt < 3; ++nt) { const bf16x8 bfg = *(const LAS bf16x8*)(WRL + (16 * nt + fr) * WRS + 32 * ks + 8 * fq); acc[nt] = __builtin_amdgcn_mfma_f32_16x16x32_bf16(af[ks], bfg, acc[nt], 0, 0, 0); } }
#pragma unroll
            for (int nt = 0; nt < 3; ++nt)
#pragma unroll
                for (int r = 0; r < 4; ++r) LG[(4 * fq + r) * 49 + 16 * nt + fr] = acc[nt][r];
            LDS_WAIT(); asm volatile("" ::: "memory");
            if (lane < 16) { const int t = tb + lane; const float rstd = rstd_from_ssq(SSQ2, t); rstd_t = rstd; const LAS float* lg = LG + lane * 49;
                float g[4]; int grp = 0;
#pragma unroll
                for (int i = 0; i < 4; ++i) g[i] = lg[i] * rstd + a.in[21][i];
#pragma unroll
                for (int i = 1; i < 4; ++i) if (g[i] > g[grp]) grp = i;
                float gs = 0.f;
#pragma unroll
                for (int i = 0; i < 4; ++i) gs += __expf(g[i] - g[grp]);
                const float gw_ = 1.0f / gs;
                float e[8];
#pragma unroll
                for (int i = 0; i < 8; ++i) e[i] = lg[4 + 8 * grp + i] * rstd + a.in[23][8 * grp + i];
                int i1 = 0;
#pragma unroll
                for (int i = 1; i < 8; ++i) if (e[i] > e[i1]) i1 = i;
                int i2 = (i1 == 0) ? 1 : 0;
#pragma unroll
                for (int i = 0; i < 8; ++i) if (i != i1 && i != i2 && e[i] > e[i2]) i2 = i;
                const float eb = __expf(e[i2] - e[i1]); ga = gw_ / (1.0f + eb); gb = gw_ * eb / (1.0f + eb);
                E1 = grp * 8 + i1; E2 = grp * 8 + i2;
                r1 = atomicAdd((unsigned*)&lcnt[E1], 1u); r2 = atomicAdd((unsigned*)&lcnt[E2], 1u);
            }
        }
        __syncthreads();
        if (C.tid < 32) lbase[C.tid] = lcnt[C.tid] ? __hip_atomic_fetch_add(CNT + C.tid, lcnt[C.tid], __ATOMIC_RELAXED, __HIP_MEMORY_SCOPE_AGENT) : 0u;
        __syncthreads();
        if (live && lane < 16) { const int t = tb + lane;
            const int k1 = (int)(lbase[E1] + r1), k2 = (int)(lbase[E2] + r2);
            TOKE[2 * t] = E1; TOKR[2 * t] = k1; TOKG[2 * t] = ga; LTOK[E1 * LCAP + k1] = t; LRS[E1 * LCAP + k1] = rstd_t;
            TOKE[2 * t + 1] = E2; TOKR[2 * t + 1] = k2; TOKG[2 * t + 1] = gb; LTOK[E2 * LCAP + k2] = t; LRS[E2 * LCAP + k2] = rstd_t; }
        __syncthreads();
    }
}
__device__ __forceinline__ void moe_table(const Args& a, const Ctx& C) {
    LAS int* ts = (LAS int*)(C.lds + MOE_OFF);
    if (C.tid == 0) { const unsigned* CNT = (const unsigned*)(a.ws + WS_CTL) + CW_CNT; int acc = 0;
        for (int e = 0; e < NEXP; ++e) { ts[e] = acc; const unsigned c = __hip_atomic_load(CNT + e, __ATOMIC_RELAXED, __HIP_MEMORY_SCOPE_AGENT); ts[33 + e] = (int)c; acc += (int)((c + 255u) >> 8); }
        ts[NEXP] = acc; }
    __syncthreads();
}
__device__ __forceinline__ void ph_final(const Args& a, const Ctx& C, float* outp) {
    unsigned char* ws = a.ws;
    const bf16_t* YB = (const bf16_t*)(ws + WS_A); const float* TOKG = (const float*)(ws + WS_TOK + TOK_G); const int* TOKE = (const int*)(ws + WS_TOK + TOK_E); const int* TOKR = (const int*)(ws + WS_TOK + TOK_R);
    const LAS int* ts = (const LAS int*)(C.lds + MOE_OFF);
    const bf16_t* H2B = (const bf16_t*)a.out + DM; const float* gf = a.in[26];
    const int gw = C.vcu * 8 + C.wave, NGW = C.G * 8, lane = C.lane;
    f32x4 gn[4];
#pragma unroll
    for (int q = 0; q < 4; ++q) gn[q] = *(const f32x4*)(gf + 512 * (q >> 1) + 8 * lane + 4 * (q & 1));
    const int nit = (NTOK + NGW - 1) / NGW;
    int dnx = 0; float gnx = 0.f;
#define FIN_IDX(ib) do { const int tt_ = gw + ((ib) + (lane >> 1)) * NGW; dnx = 0; gnx = 0.f; \
        if (lane < 8 && tt_ < NTOK) { const int e_ = TOKE[2 * tt_ + (lane & 1)]; dnx = ts[e_] * 256 + TOKR[2 * tt_ + (lane & 1)]; gnx = TOKG[2 * tt_ + (lane & 1)]; } } while (0)
    FIN_IDX(0);
    for (int ib = 0; ib < nit; ib += 4) {
        const int dcur = dnx; const float gcur = gnx;
        if (ib + 4 < nit) FIN_IDX(ib + 4);
        u32x4 hw[4][2], y0[4][2], y1[4][2];
#pragma unroll
        for (int j = 0; j < 4; ++j) { const int t = gw + (ib + j) * NGW; const int d0 = __builtin_amdgcn_readlane(dcur, 2 * j), d1 = __builtin_amdgcn_readlane(dcur, 2 * j + 1);
            if (t < NTOK) {
#pragma unroll
                for (int hf = 0; hf < 2; ++hf) { hw[j][hf] = *((const u32x4*)(H2B + (size_t)t * LDH + 512 * hf) + lane); y0[j][hf] = *((const u32x4*)(YB + (size_t)d0 * DM + 512 * hf) + lane); y1[j][hf] = *((const u32x4*)(YB + (size_t)d1 * DM + 512 * hf) + lane); } } }
#pragma unroll
        for (int j = 0; j < 4; ++j) { const int t = gw + (ib + j) * NGW;
            const float g0 = __builtin_bit_cast(float, __builtin_amdgcn_readlane(__builtin_bit_cast(int, gcur), 2 * j)), g1 = __builtin_bit_cast(float, __builtin_amdgcn_readlane(__builtin_bit_cast(int, gcur), 2 * j + 1));
            if (t < NTOK) { float v[16]; float s2 = 0.f;
#pragma unroll
                for (int hf = 0; hf < 2; ++hf)
#pragma unroll
                    for (int e = 0; e < 4; ++e) { const unsigned h = hw[j][hf][e], p = y0[j][hf][e], q = y1[j][hf][e];
                        const float lo = bflo(h) + g0 * bflo(p) + g1 * bflo(q), hi = bfhi(h) + g0 * bfhi(p) + g1 * bfhi(q); v[8 * hf + 2 * e] = lo; v[8 * hf + 2 * e + 1] = hi; s2 += lo * lo + hi * hi; }
                const float rstd = __builtin_amdgcn_rsqf(wave_sum(s2) * (1.0f / DM) + EPS);
#pragma unroll
                for (int q = 0; q < 4; ++q) { const f32x4 o = {v[4 * q] * rstd * gn[q][0], v[4 * q + 1] * rstd * gn[q][1], v[4 * q + 2] * rstd * gn[q][2], v[4 * q + 3] * rstd * gn[q][3]};
                    *(f32x4*)(outp + (size_t)t * DM + 512 * (q >> 1) + 8 * lane + 4 * (q & 1)) = o; } } }
    }
#undef FIN_IDX
}

#include <hip/hip_bf16.h>
#include <cmath>
namespace attn_body {
using bf16=__hip_bfloat16;
using bf16x8=__attribute__((ext_vector_type(8)))short;
using s16x4=__attribute__((ext_vector_type(4)))short;
using f32x16=__attribute__((ext_vector_type(16)))float;
using u32x4=__attribute__((ext_vector_type(4)))unsigned;
using f32x4_t=__attribute__((ext_vector_type(4)))float;
constexpr int BATCH=16,NHEAD=8,SEQ=2048,D=64,DM=NHEAD*D,DMO=1024;
constexpr int NW=8,QBLK=32,QB=QBLK*NW,KVBLK=64,NQB=SEQ/QB;
constexpr int ATTN_PITCH=DM, ATTN_UNIT_ROWS=QB;
__device__ __forceinline__ int crow(int r,int hi){return (r&3)+8*(r>>2)+4*hi;}
#define SBAR() __builtin_amdgcn_sched_barrier(0)
__device__ __forceinline__ void cmask(f32x16&p0,f32x16&p1,int jb,int qrel,int hi){
  const float NEG=-INFINITY; int kb=64*jb+4*hi; asm volatile("":"+v"(kb));
  #pragma unroll
  for(int r=0;r<16;++r){int kv=kb+(r&3)+8*(r>>2); if(kv>qrel)p0[r]=NEG; if(kv+32>qrel)p1[r]=NEG;}
}

constexpr int NSLOT=3, SLOTB=8192;
constexpr int LDS_K=0, LDS_V=NSLOT*SLOTB, LDS_WS=2*NSLOT*SLOTB, LDS_OST=LDS_WS+NW*64*4, LDS_BYTES=LDS_OST+NW*4096;
constexpr float C2=0.125f*1.4426950408889634f;
__device__ __forceinline__ void glds16(const char*sbase,unsigned voff,unsigned lds_dst){unsigned keep;
  asm volatile("s_nop 4\n\ts_mov_b32 %0, m0\n\ts_mov_b32 m0, %3\n\ts_nop 0\n\tglobal_load_lds_dwordx4 %1, %2\n\ts_mov_b32 m0, %0":"=&s"(keep):"v"(voff),"s"(sbase),"s"(lds_dst):"memory");}
__device__ __forceinline__ const char* uni_ptr(const void*p){const unsigned long long v=(unsigned long long)p;const unsigned lo=__builtin_amdgcn_readfirstlane((unsigned)v),hi=__builtin_amdgcn_readfirstlane((unsigned)(v>>32));return (const char*)(((unsigned long long)hi<<32)|lo);}
__device__ __forceinline__ float max3f(float a,float b,float c){float r;asm("v_max3_f32 %0, %1, %2, %3":"=v"(r):"v"(a),"v"(b),"v"(c));return r;}
__device__ __forceinline__ float max2f(float a,float b){float r;asm("v_max_f32_e32 %0, %1, %2":"=v"(r):"v"(a),"v"(b));return r;}
__device__ __forceinline__ float fadd_s(float a,float b){float r;asm("v_add_f32_e32 %0, %1, %2":"=v"(r):"v"(a),"v"(b));return r;}
__device__ __forceinline__ float fsub_s(float a,float b){float r;asm("v_sub_f32_e32 %0, %1, %2":"=v"(r):"v"(a),"v"(b));return r;}
typedef float f32x2_t __attribute__((ext_vector_type(2))); typedef __bf16 bf16x2_t __attribute__((ext_vector_type(2)));
__device__ __forceinline__ unsigned cvtpk_s(float lo,float hi){f32x2_t v={lo,hi};bf16x2_t b=__builtin_convertvector(v,bf16x2_t);return __builtin_bit_cast(unsigned,b);}
#define WAIT_BAR(N) asm volatile("s_waitcnt vmcnt(" #N ") lgkmcnt(0)\n\ts_barrier":::"memory")

__device__ __forceinline__ void qkt(f32x16&p0,f32x16&p1,const char*Kslot,const bf16x8*qr,const f32x16&negm,int r32,int hi){
  const char*kb=Kslot+hi*1024+r32*16;
  #pragma unroll
  for(int d0=0;d0<4;++d0){
    const bf16x8 b0=*reinterpret_cast<const bf16x8*>(kb+d0*2048);
    const bf16x8 b1=*reinterpret_cast<const bf16x8*>(kb+d0*2048+512);
    if(d0==0){p0=__builtin_amdgcn_mfma_f32_32x32x16_bf16(b0,qr[0],negm,0,0,0);p1=__builtin_amdgcn_mfma_f32_32x32x16_bf16(b1,qr[0],negm,0,0,0);}
    else{p0=__builtin_amdgcn_mfma_f32_32x32x16_bf16(b0,qr[d0],p0,0,0,0);p1=__builtin_amdgcn_mfma_f32_32x32x16_bf16(b1,qr[d0],p1,0,0,0);}}
}
typedef __attribute__((address_space(3))) const char* lds_cptr;
typedef short v4i16_t __attribute__((ext_vector_type(4)));
__device__ __forceinline__ void kload8(bf16x8*kf,lds_cptr kp){
  kf[0]=*(const __attribute__((address_space(3))) bf16x8*)(kp);      kf[1]=*(const __attribute__((address_space(3))) bf16x8*)(kp+512);
  kf[2]=*(const __attribute__((address_space(3))) bf16x8*)(kp+2048); kf[3]=*(const __attribute__((address_space(3))) bf16x8*)(kp+2560);
  kf[4]=*(const __attribute__((address_space(3))) bf16x8*)(kp+4096); kf[5]=*(const __attribute__((address_space(3))) bf16x8*)(kp+4608);
  kf[6]=*(const __attribute__((address_space(3))) bf16x8*)(kp+6144); kf[7]=*(const __attribute__((address_space(3))) bf16x8*)(kp+6656);
}
__device__ __forceinline__ void kload2(bf16x8*kf,lds_cptr kp,int j){ kf[2*j]=*(const __attribute__((address_space(3))) bf16x8*)(kp+j*2048); kf[2*j+1]=*(const __attribute__((address_space(3))) bf16x8*)(kp+j*2048+512); }
__device__ __forceinline__ s16x4 vtr(lds_cptr p){ return __builtin_bit_cast(s16x4,__builtin_amdgcn_ds_read_tr16_b64_v4i16((__attribute__((address_space(3))) v4i16_t*)p)); }
__device__ __forceinline__ float rowmax(const f32x16&p0,const f32x16&p1){
  float a=max3f(p0[0],p0[1],p1[0]),b=max3f(p0[2],p0[3],p1[1]);a=max3f(a,p1[2],p1[3]);
  #pragma unroll
  for(int r=4;r<16;r+=4){a=max3f(a,p0[r],p0[r+1]);b=max3f(b,p0[r+2],p0[r+3]);a=max3f(a,p1[r],p1[r+1]);b=max3f(b,p1[r+2],p1[r+3]);}
  const float m=max2f(a,b);
  auto rr=__builtin_amdgcn_permlane32_swap(__float_as_uint(m),__float_as_uint(m),false,false);
  return max2f(__uint_as_float(rr[0]),__uint_as_float(rr[1]));
}
__device__ __forceinline__ void pv(f32x16*o,int vb,bf16x8 pa0,bf16x8 pa1,bf16x8 pa2,bf16x8 pa3){
  #pragma unroll
  for(int d0=0;d0<2;++d0){s16x4 lo[4],hi[4];
    #pragma unroll
    for(int ks=0;ks<4;++ks){
      asm volatile("ds_read_b64_tr_b16 %0,%1 offset:%c2":"=&v"(lo[ks]):"v"(vb),"i"(d0*4096+ks*1024):"memory");
      asm volatile("ds_read_b64_tr_b16 %0,%1 offset:%c2":"=&v"(hi[ks]):"v"(vb),"i"(d0*4096+ks*1024+512):"memory");}
    asm volatile("s_waitcnt lgkmcnt(0)":::"memory");SBAR();
    #define PK(k) (bf16x8){lo[k][0],lo[k][1],lo[k][2],lo[k][3],hi[k][0],hi[k][1],hi[k][2],hi[k][3]}
    o[d0]=__builtin_amdgcn_mfma_f32_32x32x16_bf16(pa0,PK(0),o[d0],0,0,0);
    o[d0]=__builtin_amdgcn_mfma_f32_32x32x16_bf16(pa1,PK(1),o[d0],0,0,0);
    o[d0]=__builtin_amdgcn_mfma_f32_32x32x16_bf16(pa2,PK(2),o[d0],0,0,0);
    o[d0]=__builtin_amdgcn_mfma_f32_32x32x16_bf16(pa3,PK(3),o[d0],0,0,0);
    #undef PK
  }
}

#ifndef ATTN_STORE16
#define ATTN_STORE16(p,v) (*(u32x4*)(p)=(v))
#endif
template<int THRL> __device__ __forceinline__ void attn_unit(int b,int h,int qb,const bf16*Q,const bf16*__restrict__ K,const bf16*__restrict__ V,bf16*O,const float*__restrict__ KSUM,float*__restrict__ SSQA,char*shm){
  int tid=threadIdx.x; asm volatile("":"+v"(tid));
  const int lane=tid&63,r32=lane&31,hi=lane>>5; const int wid=__builtin_amdgcn_readfirstlane(tid>>6);
  const long rowbase=(long)b*SEQ; const int q0=qb*QB;
  const bf16*Qw=Q+(rowbase+q0+wid*QBLK)*DM+h*D;
  const bf16*Kh=K+rowbase*DM+h*D,*Vh=V+rowbase*DM+h*D;
  const unsigned lds0=(unsigned)(uintptr_t)shm;
  float*wsf=(float*)(shm+LDS_WS)+wid*64;
  const char*Khu=uni_ptr(Kh);const char*Vhu=uni_ptr(Vh);
  const unsigned kvo=(unsigned)(lane*DM+wid*8)*2u;
  const unsigned vvo=(unsigned)((16*(wid&3)+(lane>>2))*DM+(wid>>2)*32+(lane&3)*8)*2u;
  const unsigned kdst=lds0+LDS_K+wid*1024, vdst=lds0+LDS_V+wid*1024;
  #define DMA_K(t,slot) glds16(Khu+(size_t)(t)*(KVBLK*DM*2),kvo,(unsigned)__builtin_amdgcn_readfirstlane(kdst+(slot)))
  #define DMA_V(t,slot) glds16(Vhu+(size_t)(t)*(KVBLK*DM*2),vvo,(unsigned)__builtin_amdgcn_readfirstlane(vdst+(slot)))
  const int vb0=(int)(lds0+LDS_V)+((lane>>4)&1)*32+(lane&3)*8+(4*hi+((lane&15)>>2))*64;
  const char*Kbase=shm+LDS_K; bf16x8 kf[8];
  const lds_cptr shm3=(lds_cptr)shm; const lds_cptr kp0=shm3+LDS_K+hi*1024+r32*16; const lds_cptr vp0=shm3+LDS_V+((lane>>4)&1)*32+(lane&3)*8+(4*hi+((lane&15)>>2))*64;
  const int NT=(q0+QB)/KVBLK;
  DMA_K(0,0);DMA_V(0,0);DMA_K(1,SLOTB);
  bf16x8 qr[4];
  #pragma unroll
  for(int d0=0;d0<4;++d0)qr[d0]=*reinterpret_cast<const bf16x8*>(&Qw[(long)r32*DM+d0*16+hi*8]);
  unsigned selm=1u<<qb;
  { float g[8];
    #pragma unroll
    for(int n=0;n<8;++n){ g[n]=-INFINITY;
      if(n<qb){ const float*ks=KSUM+(long)(b*8+n)*DM+h*D+hi*8; float s=0.f;
        #pragma unroll
        for(int d0=0;d0<4;++d0){ const f32x4_t k0=*reinterpret_cast<const f32x4_t*>(ks+d0*16), k1=*reinterpret_cast<const f32x4_t*>(ks+d0*16+4);
          const u32x4 qw=__builtin_bit_cast(u32x4,qr[d0]);
          s+=__uint_as_float(qw[0]<<16)*k0[0]+__uint_as_float(qw[0]&0xffff0000u)*k0[1]+__uint_as_float(qw[1]<<16)*k0[2]+__uint_as_float(qw[1]&0xffff0000u)*k0[3]
            +__uint_as_float(qw[2]<<16)*k1[0]+__uint_as_float(qw[2]&0xffff0000u)*k1[1]+__uint_as_float(qw[3]<<16)*k1[2]+__uint_as_float(qw[3]&0xffff0000u)*k1[3]; }
        s+=__shfl_xor(s,32); g[n]=s; } }
    const int npick=qb<3?qb:3;
    for(int p=0;p<npick;++p){ int best=-1; float bv=-INFINITY;
      #pragma unroll
      for(int n=0;n<8;++n){ const bool ok=(n<qb)&&!((selm>>n)&1u)&&(best<0||g[n]>bv); if(ok){best=n;bv=g[n];} }
      if(best>=0)selm|=1u<<best; } }
  #define BMASK(P0,P1,t) do{ float bias_=((selm>>((t)>>2))&1u)?-mhat:-INFINITY; asm volatile("":"+v"(bias_)); _Pragma("unroll") for(int r=0;r<16;++r){P0[r]+=bias_;P1[r]+=bias_;} }while(0)
  float mhat=0.f,l_reg=0.f;f32x16 o[2];{float z0_=0.f;asm volatile("":"+v"(z0_));_Pragma("unroll") for(int r=0;r<16;++r){o[0][r]=z0_;o[1][r]=z0_;}}const f32x16 negm=f32x16{};
  const int qrel=wid*QBLK+r32;
  #define CMASK(P0,P1,t) do{int jb_=(t)-(NT-4); if(jb_>=0)cmask(P0,P1,jb_,qrel,hi);}while(0)
  bool resc=false;
  #define START(P0,P1) do{ const float rm=__builtin_fmaxf(rowmax(P0,P1),-100.0f); resc=false; \
    { const float dl=rm; mhat=fadd_s(mhat,dl); \
      _Pragma("unroll") for(int r=0;r<16;++r){P0[r]=fsub_s(P0[r],dl);P1[r]=fsub_s(P1[r],dl);} \
      } \
    _Pragma("unroll") for(int r=0;r<16;++r)P0[r]=__builtin_amdgcn_exp2f(P0[r]); }while(0)
  #define RESC() do{ if(resc){ asm volatile("s_waitcnt lgkmcnt(0)":::"memory"); \
      _Pragma("unroll") for(int d_=0;d_<2;++d_) _Pragma("unroll") for(int r=0;r<16;++r)o[d_][r]*=wsf[crow(r,hi)]; } }while(0)
  f32x16 pA0,pA1,pB0,pB1;
  int sl_prev=0,sl_cur=0,sl_next=SLOTB;
  #define ROT() do{sl_prev=sl_cur;sl_cur=sl_next;sl_next=(sl_next==(NSLOT-1)*SLOTB)?0:sl_next+SLOTB;}while(0)
  DMA_K(2,2*SLOTB);
  WAIT_BAR(3);
  qkt(pA0,pA1,Kbase,qr,negm,r32,hi);asm volatile("s_nop 15\n\ts_nop 7":"+v"(pA0),"+v"(pA1));CMASK(pA0,pA1,0);BMASK(pA0,pA1,0);
  START(pA0,pA1);
  _Pragma("unroll") for(int r=0;r<16;++r)pA1[r]=__builtin_amdgcn_exp2f(pA1[r]);
  WAIT_BAR(0);
  DMA_K(3,0);DMA_V(1,SLOTB);
  ROT();
  kload8(kf,kp0+sl_cur);
  WAIT_BAR(2);
  s16x4 vlo[8],vhi[8]; u32x4 pw0,pw1,pw2,pw3;
  #define PKW(P,B) cvtpk_s(P[B],P[B+1])
  #define PAF(k) __builtin_bit_cast(bf16x8,pw##k)
  #define VFR(i) (bf16x8){vlo[i][0],vlo[i][1],vlo[i][2],vlo[i][3],vhi[i][0],vhi[i][1],vhi[i][2],vhi[i][3]}
  #define PIN(x) asm volatile("":"+v"(x))
  #define MX3(a,b,c) __builtin_fmaxf(__builtin_fmaxf((a),(b)),(c))
  #define GAPA(MF,A0,A1,A2,A3,W0,W1,PW) do{ MF; sacc+=A0; sacc+=A1; sacc+=A2; sacc+=A3; PIN(sacc); W0; W1; PIN(PW); SBAR(); }while(0)
  #define EX(v) __builtin_amdgcn_exp2f(v)
  #define GAPB(MF,X,B) do{ MF; X[B]=EX(X[B]); X[B+1]=EX(X[B+1]); X[B+2]=EX(X[B+2]); X[B+3]=EX(X[B+3]); PIN(X); SBAR(); }while(0)
  #define VRD(i) do{ vlo[i]=vtr(vp_+(((i)>>2)*4096+((i)&3)*1024)); vhi[i]=vtr(vp_+(((i)>>2)*4096+((i)&3)*1024+512)); }while(0)
  #define KRD(G,j) do{ if(G){ kload2(kf,kp0+sl_next,j); SBAR(); } }while(0)
  #define STEP(C0,C1,P0,P1,t,GK,GV,GL) do{ SBAR(); \
    const lds_cptr vp_=vp0+sl_prev; \
    VRD(0); SBAR(); float sacc=(P0[0]+P0[1]); \
    GAPA(C0=__builtin_amdgcn_mfma_f32_32x32x16_bf16(kf[0],qr[0],negm,0,0,0), P0[2],P0[3],P0[4],P0[5],     pw0[0]=PKW(P0,0), pw0[1]=PKW(P0,2), pw0); \
    VRD(4); SBAR(); GAPA(C1=__builtin_amdgcn_mfma_f32_32x32x16_bf16(kf[1],qr[0],negm,0,0,0), P0[6],P0[7],P0[8],P0[9],     pw0[2]=PKW(P0,4), pw0[3]=PKW(P0,6), pw0); \
    VRD(1); SBAR(); GAPA(C0=__builtin_amdgcn_mfma_f32_32x32x16_bf16(kf[2],qr[1],C0,0,0,0),   P0[10],P0[11],P0[12],P0[13], pw1[0]=PKW(P0,8), pw1[1]=PKW(P0,10), pw1); \
    VRD(5); SBAR(); GAPA(C1=__builtin_amdgcn_mfma_f32_32x32x16_bf16(kf[3],qr[1],C1,0,0,0),   P0[14],P0[15],P1[0],P1[1],   pw1[2]=PKW(P0,12),pw1[3]=PKW(P0,14), pw1); \
    VRD(2); SBAR(); GAPA(C0=__builtin_amdgcn_mfma_f32_32x32x16_bf16(kf[4],qr[2],C0,0,0,0),   P1[2],P1[3],P1[4],P1[5],     pw2[0]=PKW(P1,0), pw2[1]=PKW(P1,2), pw2); \
    VRD(6); SBAR(); GAPA(C1=__builtin_amdgcn_mfma_f32_32x32x16_bf16(kf[5],qr[2],C1,0,0,0),   P1[6],P1[7],P1[8],P1[9],     pw2[2]=PKW(P1,4), pw2[3]=PKW(P1,6), pw2); \
    VRD(3); SBAR(); GAPA(C0=__builtin_amdgcn_mfma_f32_32x32x16_bf16(kf[6],qr[3],C0,0,0,0),   P1[10],P1[11],P1[12],P1[13], pw3[0]=PKW(P1,8), pw3[1]=PKW(P1,10), pw3); \
    VRD(7); SBAR(); GAPA(C1=__builtin_amdgcn_mfma_f32_32x32x16_bf16(kf[7],qr[3],C1,0,0,0),   P1[14],P1[15],0.f,0.f,       pw3[2]=PKW(P1,12),pw3[3]=PKW(P1,14), pw3); \
    l_reg+=sacc; \
    if(GK){DMA_K((t)+3,sl_cur);} if(GV){DMA_V((t)+1,sl_next);} \
    CMASK(C0,C1,t); BMASK(C0,C1,t); \
    { float a=MX3(C0[0],C0[1],C1[0]),b=MX3(C0[2],C0[3],C1[1]); a=MX3(a,C1[2],C1[3]); \
      _Pragma("unroll") for(int r=4;r<16;r+=4){a=MX3(a,C0[r],C0[r+1]);b=MX3(b,C0[r+2],C0[r+3]);a=MX3(a,C1[r],C1[r+1]);b=MX3(b,C1[r+2],C1[r+3]);} \
      float rm=__builtin_fmaxf(a,b); { auto rr=__builtin_amdgcn_permlane32_swap(__float_as_uint(rm),__float_as_uint(rm),false,false); rm=__builtin_fmaxf(__uint_as_float(rr[0]),__uint_as_float(rr[1])); } \
      resc=false; \
      if(__builtin_expect(__any(rm>(float)THRL),0)){ const float dl=__builtin_fmaxf(rm,0.f); mhat+=dl; \
        _Pragma("unroll") for(int r=0;r<16;++r){C0[r]-=dl;C1[r]-=dl;} \
        const float f=__builtin_amdgcn_exp2f(-dl); l_reg*=f; if(hi==0)wsf[r32]=f; resc=true; } } \
    SBAR(); \
    GAPB(o[0]=__builtin_amdgcn_mfma_f32_32x32x16_bf16(PAF(0),VFR(0),o[0],0,0,0), C0,0); \
    GAPB(o[1]=__builtin_amdgcn_mfma_f32_32x32x16_bf16(PAF(0),VFR(4),o[1],0,0,0), C0,4); \
    KRD(GL,0); GAPB(o[0]=__builtin_amdgcn_mfma_f32_32x32x16_bf16(PAF(1),VFR(1),o[0],0,0,0), C0,8); \
    KRD(GL,1); GAPB(o[1]=__builtin_amdgcn_mfma_f32_32x32x16_bf16(PAF(1),VFR(5),o[1],0,0,0), C0,12); \
    KRD(GL,2); GAPB(o[0]=__builtin_amdgcn_mfma_f32_32x32x16_bf16(PAF(2),VFR(2),o[0],0,0,0), C1,0); \
    KRD(GL,3); GAPB(o[1]=__builtin_amdgcn_mfma_f32_32x32x16_bf16(PAF(2),VFR(6),o[1],0,0,0), C1,4); \
    GAPB(o[0]=__builtin_amdgcn_mfma_f32_32x32x16_bf16(PAF(3),VFR(3),o[0],0,0,0), C1,8); \
    GAPB(o[1]=__builtin_amdgcn_mfma_f32_32x32x16_bf16(PAF(3),VFR(7),o[1],0,0,0), C1,12); \
    }while(0)
  int t=1;
  #undef CMASK
  #define CMASK(P0,P1,t) do{}while(0)
  for(;t+5<NT;t+=2){
    STEP(pB0,pB1,pA0,pA1,t,true,true,true);     WAIT_BAR(2); RESC(); ROT();
    STEP(pA0,pA1,pB0,pB1,t+1,true,true,true);   WAIT_BAR(2); RESC(); ROT();
  }
  #undef CMASK
  #define CMASK(P0,P1,t) do{int jb_=(t)-(NT-4); if(jb_>=0)cmask(P0,P1,jb_,qrel,hi);}while(0)
  #define ENDW(tt) do{ if((tt)+3<NT){WAIT_BAR(2);} else if((tt)+2<NT){WAIT_BAR(1);} else {WAIT_BAR(0);} }while(0)
  for(;t+1<NT;t+=2){
    STEP(pB0,pB1,pA0,pA1,t,(t+3<NT),(t+1<NT),(t+1<NT));       ENDW(t);   RESC(); ROT();
    STEP(pA0,pA1,pB0,pB1,t+1,(t+4<NT),(t+2<NT),(t+2<NT));     ENDW(t+1); RESC(); ROT();
  }
  STEP(pB0,pB1,pA0,pA1,NT-1,false,false,false); RESC();
  { float sacc=pB0[0]+pB0[1]; _Pragma("unroll") for(int r=2;r<16;++r)sacc+=pB0[r]; _Pragma("unroll") for(int r=0;r<16;++r)sacc+=pB1[r]; l_reg+=sacc;
    pw0=(u32x4){PKW(pB0,0),PKW(pB0,2),PKW(pB0,4),PKW(pB0,6)};pw1=(u32x4){PKW(pB0,8),PKW(pB0,10),PKW(pB0,12),PKW(pB0,14)};pw2=(u32x4){PKW(pB1,0),PKW(pB1,2),PKW(pB1,4),PKW(pB1,6)};pw3=(u32x4){PKW(pB1,8),PKW(pB1,10),PKW(pB1,12),PKW(pB1,14)};
    SBAR(); pv(o,vb0+sl_cur,PAF(0),PAF(1),PAF(2),PAF(3)); }
  #undef PKW
  #undef PAF
  #undef VFR
  #undef PIN
  #undef MX3
  #undef GAPA
  #undef GAPB
  #undef EX
  #undef VRD
  #undef KRD
  #undef STEP
  #undef ENDW
  {auto rr=__builtin_amdgcn_permlane32_swap(__float_as_uint(l_reg),__float_as_uint(l_reg),false,false);l_reg=__uint_as_float(rr[0])+__uint_as_float(rr[1]);}
  if(hi==0)wsf[32+r32]=l_reg;asm volatile("s_waitcnt lgkmcnt(0)":::"memory");
  float rli[16];
  #pragma unroll
  for(int r=0;r<16;++r)rli[r]=__builtin_amdgcn_rcpf(wsf[32+crow(r,hi)]);
  bf16*Ow=O+(rowbase+q0+wid*QBLK)*DMO+h*D;
  { bf16*stg=(bf16*)(shm+LDS_OST)+wid*2048;
    #pragma unroll
    for(int r=0;r<16;++r){const int orow=crow(r,hi);
      #pragma unroll
      for(int d0=0;d0<2;++d0)stg[orow*64+d0*32+r32]=__float2bfloat16(o[d0][r]*rli[r]);}
    asm volatile("s_waitcnt lgkmcnt(0)":::"memory");
    #pragma unroll
    for(int i=0;i<4;++i){const int row=i*8+(lane>>3),ch=lane&7; const u32x4 v=*(const u32x4*)(stg+row*64+ch*8); ATTN_STORE16(Ow+(long)row*DMO+ch*8,v);
      float q=0.f;
      #pragma unroll
      for(int e=0;e<4;++e){const float lo=__uint_as_float(v[e]<<16),hi2=__uint_as_float(v[e]&0xffff0000u);q+=lo*lo+hi2*hi2;}
      q+=__shfl_xor(q,1);q+=__shfl_xor(q,2);q+=__shfl_xor(q,4);
      if(ch==0)SSQA[(rowbase+q0+wid*QBLK+row)*8+h]=q;} }
  asm volatile("s_waitcnt lgkmcnt(0)\n\ts_barrier":::"memory");
  #undef BMASK
  #undef DMA_K
  #undef DMA_V
  #undef CMASK
  #undef START
  #undef RESC
  #undef ROT
}
constexpr int ATTN_LDS_BYTES=LDS_BYTES;
#undef SBAR
#undef WAIT_BAR
}

#ifndef STAG_TICKS
#define STAG_TICKS 100
#endif
__device__ __forceinline__ void stagger(int c, int ticks) {
    const unsigned long long t0 = __builtin_amdgcn_s_memrealtime(); const unsigned long long w = (unsigned long long)(((c >> 3) & 3) * ticks);
    while (__builtin_amdgcn_s_memrealtime() - t0 < w) __builtin_amdgcn_s_sleep(8);
}
__global__ void __launch_bounds__(512, 2) mk_fwd(Args args) {
    extern __shared__ __attribute__((aligned(16))) unsigned char lds_raw[];
    Ctx C; C.lds = (LAS unsigned char*)lds_raw; C.tid = threadIdx.x; C.lane = C.tid & 63; C.wave = __builtin_amdgcn_readfirstlane(C.tid >> 6);
    C.G = gridDim.x; { const int bx = blockIdx.x; C.vcu = (C.G % 8 == 0) ? (bx % 8) * (C.G / 8) + bx / 8 : bx; }
    unsigned char* ws = args.ws;
    for (int u = C.tid; u < (LDS_BYTES - LDSCTL_OFF) / 4; u += 512) ((LAS unsigned*)(C.lds + LDSCTL_OFF))[u] = 0u;
    __syncthreads();
    XcdBarrier bar; bar.bar = (unsigned*)(ws + WS_CTL) + CW_BAR; bar.x = 0; bar.st = nullptr;
    if (N_LAUNCHES == 1) bar = xcd_barrier_post((unsigned*)(ws + WS_CTL) + CW_BAR, (volatile LAS unsigned*)(C.lds + MISC_OFF) + 8);
    const int lo = args.ph_lo, hi = args.ph_hi;
#ifndef PH_MASK
#define PH_MASK 0x3fff
#endif
#define IN(k) ((((PH_MASK) >> (k)) & 1) && lo <= (k) && (k) < hi)
#ifndef PROBE_REP
#define PROBE_REP -1
#endif
#define REP(k) for (int rep_ = 0; rep_ < ((PROBE_REP == (k)) ? 2 : 1); ++rep_)
#define REPBAR() do { if (rep_ > 0) xcd_barrier(bar); } while (0)
#define FRESH() do { int t_ = threadIdx.x; asm volatile("" : "+v"(t_)); C.tid = t_; C.lane = t_ & 63; C.wave = __builtin_amdgcn_readfirstlane(t_ >> 6); } while (0)
#define SEAM(k) do { if (IN(k) && IN((k) + 1)) xcd_barrier(bar); } while (0)
    const int cb = (int)blockIdx.x;

    if (IN(0)) REP(0) { REPBAR(); FRESH(); ph_prologue(args, C); SEAM(0); }
    if (PROBE_REP == 200) { for (int xb_ = 0; xb_ < 8; ++xb_) xcd_barrier(bar); }
    if (IN(1)) REP(1) { REPBAR();
        { Gemm g{(const bf16_t*)(ws + WS_B), (const bf16_t*)(ws + WS_WIN), DM, DM, DM}; PlainOrder S; S.init(NTOK, DIN, C.G, cb, DM, DM);
          EpiProj E{(bf16_t*)(ws + WS_A), (const float*)(ws + WS_ROPE), (float*)(ws + WS_KSUM)}; GEMM_PHASE(C.lds, g, S, E); }
        { Gemm g{(const bf16_t*)(ws + WS_MEMN), (const bf16_t*)(ws + WS_WXK), DM, DM, DM}; PlainOrder S; S.init(NMEM, DM, C.G, cb, DM, DM);
          EpiStore E{(bf16_t*)(ws + WS_KM), DM}; GEMM_PHASE(C.lds, g, S, E); }
        { Gemm g{(const bf16_t*)(ws + WS_MEMN), (const bf16_t*)(ws + WS_WXV), DM, DM, DM}; PlainOrder S; S.init(NMEM, DM, C.G, (cb + C.G - 64 % C.G) % C.G, DM, DM);
          EpiStore E{(bf16_t*)(ws + WS_VMT), DM}; GEMM_PHASE(C.lds, g, S, E); }
        { FRESH(); if (C.G == 256) { if (cb >= 128) conv_wdn(args, C, (cb - 128) * 8 + C.wave, 128 * 8, 0, WDN_SPLIT); }
          else conv_wdn(args, C, C.vcu * 8 + C.wave, C.G * 8, 0, WDN_SPLIT); }
        SEAM(1);
    }
    if (IN(2)) REP(2) { REPBAR(); FRESH();
        for (int lrep_ = 0; lrep_ < ((PROBE_REP == 102) ? 2 : 1); ++lrep_)
        for (int L = C.vcu; L < 256; L += C.G) lru_unit(args, C, L >> 4, (L >> 1) & 7, L & 1);
        for (int arep_ = 0; arep_ < ((PROBE_REP == 103) ? 2 : 1); ++arep_)
        for (int i = 0;; ++i) { const int aidx = i * C.G + C.vcu; if (aidx >= 1024) break; const int cc = aidx & 255, ii = aidx >> 8, bh = cc >> 1;
            const int qb = (cc & 1) ? ((ii == 0) ? 6 : (ii == 1) ? 1 : (ii == 2) ? 5 : 2) : ((ii == 0) ? 7 : (ii == 1) ? 0 : (ii == 2) ? 4 : 3);
#ifdef ATTN_SIMPLE
            moba_unit_simple(args, C, bh >> 3, bh & 7, qb); }
#else
            { const attn_body::bf16* Qp = (const attn_body::bf16*)(ws + WS_A) + (size_t)2 * NTOK * 512;
              attn_body::attn_unit<8>(bh >> 3, bh & 7, qb, Qp, Qp + (size_t)NTOK * 512, Qp + (size_t)2 * NTOK * 512, (attn_body::bf16*)(ws + WS_C) + 512, (const float*)(ws + WS_KSUM), (float*)(ws + WS_SSQA), (char*)lds_raw); } }
#endif
        SEAM(2);
    }
    if (IN(4)) REP(4) { REPBAR(); Gemm g{(const bf16_t*)(ws + WS_C), (const bf16_t*)(ws + WS_WOUT), DM, DM, DM}; PlainOrder S; S.init(NTOK, DM, C.G, cb, DM, DM);
        EpiResid<true, true> E{args.in[0], (bf16_t*)args.out, (float*)(ws + WS_SSQ1), (const float*)(ws + WS_SSQL), (const float*)(ws + WS_SSQA)}; GEMM_PHASE(C.lds, g, S, E);
        { Gemm g2{(const bf16_t*)(ws + WS_KM), (const bf16_t*)(ws + WS_WXQ), DM, DM, XHD}; XpreOrder S2{C.G, cb, 0}; EpiStore E2{(bf16_t*)(ws + WS_A), DM}; GEMM_PHASE(C.lds, g2, S2, E2); }
        { Gemm g3{(const bf16_t*)(ws + WS_WXO), (const bf16_t*)(ws + WS_VMT), DM, DM, XHD}; XpreOrder S3{C.G, cb, 1}; EpiStore E3{(bf16_t*)(ws + WS_A) + (size_t)32 * MiB / 2, DM}; GEMM_PHASE(C.lds, g3, S3, E3); }
        SEAM(4); }
    if (IN(5)) REP(5) { REPBAR(); Gemm g{(const bf16_t*)args.out, (const bf16_t*)(ws + WS_A), LDH, DM, DM}; XattnOrder S{C.G, cb, 0, LDH};
        EpiSoftmax E{(bf16_t*)(ws + WS_B), DM, C.lds + LDSCTL_OFF + 4096, (const float*)(ws + WS_SSQ1), XSCALE}; GEMM_PHASE(C.lds, g, S, E); SEAM(5); }
    if (IN(8)) REP(8) { REPBAR(); Gemm g{(const bf16_t*)(ws + WS_B), (const bf16_t*)(ws + WS_A) + (size_t)32 * MiB / 2, DM, DM, DM}; XattnOrder S{C.G, cb, 1, DM};
        EpiResid<false, false> E{(const bf16_t*)args.out, (bf16_t*)args.out + DM, (float*)(ws + WS_SSQ2), nullptr, nullptr}; GEMM_PHASE(C.lds, g, S, E); SEAM(8); }
    if (IN(9)) REP(9) { REPBAR(); FRESH(); ph_router(args, C); SEAM(9); }
    if (IN(11)) REP(11) { REPBAR(); FRESH(); moe_table(args, C); Gemm g{(const bf16_t*)args.out + DM, (const bf16_t*)(ws + WS_WGU), LDH, DM, DM};
        MoeOrder<true> S{(const LAS int*)(C.lds + MOE_OFF), C.G, cb, LDH, DM, (const int*)(ws + WS_LTOK)};
        EpiGateUp E{(bf16_t*)(ws + WS_B), (const float*)(ws + WS_LRS)}; GEMM_PHASE(C.lds, g, S, E); SEAM(11); }
    if (IN(12)) REP(12) { REPBAR(); FRESH(); moe_table(args, C); Gemm g{(const bf16_t*)(ws + WS_B), (const bf16_t*)(ws + WS_WDN), DFF, DFF, DFF};
        MoeOrder<false> S{(const LAS int*)(C.lds + MOE_OFF), C.G, cb, DFF, DFF, nullptr};
        if (PROBE_REP == 312) { EpiNull EN{}; GEMM_PHASE(C.lds, g, S, EN); xcd_barrier(bar); }
        EpiStore E{(bf16_t*)(ws + WS_A), DM}; GEMM_PHASE(C.lds, g, S, E); SEAM(12); }
    if (IN(13)) REP(13) { REPBAR(); FRESH(); moe_table(args, C); ph_final(args, C, (PROBE_REP == 13 && rep_ == 0) ? (float*)(ws + WS_B) : args.out); }
#undef IN
#undef FRESH
#undef SEAM
}

extern "C" void kernel_launch(void* const* d_in, const int* in_sizes, int n_in, void* d_out, int out_size, void* d_ws, size_t ws_size, hipStream_t stream) {
    static int grid = 0;
    if (grid == 0) {
        if (n_in != 27 || out_size != NTOK * DM || ws_size < WS_END) { fprintf(stderr, "kernel_launch: unexpected shapes (n_in %d out %d ws %zu)\n", n_in, out_size, ws_size); grid = -1; return; }
        int dev = 0, cus = 0, per_cu = 0;
        if (hipGetDevice(&dev) != hipSuccess || hipDeviceGetAttribute(&cus, hipDeviceAttributeMultiprocessorCount, dev) != hipSuccess) { grid = -1; return; }
        if (hipFuncSetAttribute((const void*)mk_fwd, hipFuncAttributeMaxDynamicSharedMemorySize, LDS_BYTES) != hipSuccess) { fprintf(stderr, "kernel_launch: hipFuncSetAttribute failed\n"); grid = -1; return; }
        if (hipOccupancyMaxActiveBlocksPerMultiprocessor(&per_cu, (const void*)mk_fwd, 512, LDS_BYTES) != hipSuccess || per_cu < 1) fprintf(stderr, "kernel_launch: occupancy query reports %d\n", per_cu);
        (void)hipGetLastError();
        grid = cus;
    }
    if (grid < 0) return;
    (void)hipMemsetAsync((char*)d_ws + WS_CTL, 0, CTL_ZERO_BYTES, stream);
    Args a{};
    for (int i = 0; i < 27; ++i) a.in[i] = (const float*)d_in[i];
    a.out = (float*)d_out; a.ws = (unsigned char*)d_ws;
    const float invf[8] = {1.0f, 0.1939227432012558f, 0.03760603070259094f, 0.007292664609849453f, 0.0014142135623842478f, 0.00027424818836152554f, 5.318296098266728e-05f, 1.0313386155758053e-05f};
    for (int i = 0; i < 8; ++i) a.invf[i] = invf[i];
    if (N_LAUNCHES == 1) { a.ph_lo = 0; a.ph_hi = N_PHASES; hipLaunchKernelGGL(mk_fwd, dim3(grid), dim3(512), LDS_BYTES, stream, a); }
    else for (int p = 0; p < N_PHASES; ++p) { a.ph_lo = p; a.ph_hi = p + 1; hipLaunchKernelGGL(mk_fwd, dim3(grid), dim3(512), LDS_BYTES, stream, a); }
}
```

```cpp
#include <hip/hip_runtime.h>
#include <cstdio>
#include <cstdint>

#define LAS __attribute__((address_space(3)))
#define GAS __attribute__((address_space(1)))
typedef unsigned short bf16_t;
typedef short bf16x8 __attribute__((ext_vector_type(8)));
typedef float f32x4 __attribute__((ext_vector_type(4)));
typedef float f32x2 __attribute__((ext_vector_type(2)));
typedef unsigned u32x4 __attribute__((ext_vector_type(4)));
typedef unsigned u32x2 __attribute__((ext_vector_type(2)));

#ifndef MK_N_LAUNCHES
#define MK_N_LAUNCHES 1
#endif
constexpr int N_PHASES = 14;
constexpr int N_LAUNCHES = MK_N_LAUNCHES;

constexpr int BATCH = 16, SEQ = 2048, DM = 1024, NTOK = BATCH * SEQ;
constexpr int DLRU = 512, DATT = 512, DIN = 2560, NHEAD = 8, HD = 64, NBLK = 8, MBLK = 256;
constexpr int MEMLEN = 256, NXH = 4, XHD = 256, NMEM = BATCH * MEMLEN;
constexpr int NEXP = 32, EPG = 8, NGRP = 4, DFF = 512;
constexpr float EPS = 1e-6f;
constexpr float WGU_SC = 64.0f, WDN_SC = 32.0f, ACT_SC = 16.0f;
constexpr int WDN_SPLIT = 3072;
constexpr int MAXTILES = 288, LCAP = 65536, LDH = 2048;
constexpr float QSCALE = 0.125f * 1.4426950408889634f;
constexpr float XSCALE = 0.0625f * 1.4426950408889634f;

constexpr size_t MiB = 1u << 20;
constexpr size_t WS_CTL = 0, CTL_ZERO_BYTES = 1 * MiB;
constexpr int CW_TMO = 0, CW_BAR = 4096, CW_CNT = 8192;
constexpr size_t WS_KSUM = 512 * 1024;
constexpr size_t WS_WIN = 2 * MiB, WS_WXK = 7 * MiB, WS_WXV = 9 * MiB, WS_WOUT = 11 * MiB, WS_WXQ = 13 * MiB, WS_WXO = 15 * MiB;
constexpr size_t WS_WR = 17 * MiB, WS_ROPE = 18 * MiB, WS_SSQ1 = 19 * MiB, WS_SSQ2 = 21 * MiB, WS_TOK = 23 * MiB, WS_RSC = 24 * MiB;
constexpr size_t WS_MEMN = 25 * MiB, WS_KM = 33 * MiB, WS_VMT = 41 * MiB, WS_WGU = 49 * MiB, WS_WDN = 113 * MiB;
constexpr size_t WS_A = 145 * MiB, WS_B = 305 * MiB, WS_C = 385 * MiB, WS_SSQL = 449 * MiB, WS_SSQA = 451 * MiB, WS_LTOK = 452 * MiB, WS_LRS = 460 * MiB, WS_H2F8 = 468 * MiB, WS_END = 500 * MiB;
constexpr size_t TOK_E = 0, TOK_R = 256 * 1024, TOK_G = 512 * 1024, TOK_D = 768 * 1024;

constexpr int RING_BYTES = 131072;
constexpr int LDSCTL_OFF = RING_BYTES, MISC_OFF = LDSCTL_OFF + 320, MOE_OFF = LDSCTL_OFF + 1024;
constexpr int LDS_BYTES = 147456;

__device__ __forceinline__ unsigned cvt_pk_bf16(float lo, float hi) { unsigned r; asm volatile("v_cvt_pk_bf16_f32 %0, %1, %2" : "=v"(r) : "v"(lo), "v"(hi)); return r; }
__device__ __forceinline__ float bflo(unsigned w) { return __uint_as_float(w << 16); }
__device__ __forceinline__ float bfhi(unsigned w) { return __uint_as_float(w & 0xffff0000u); }
__device__ __forceinline__ float bf2f(bf16_t b) { return __uint_as_float((unsigned)b << 16); }
__device__ __forceinline__ float wave_sum(float v) {
#pragma unroll
    for (int o = 1; o < 64; o <<= 1) v += __shfl_xor(v, o);
    return v;
}
#define LDS_WAIT() asm volatile("s_waitcnt lgkmcnt(0)" ::: "memory")
__device__ __forceinline__ float sigmoidf_(float x) { return __builtin_amdgcn_rcpf(1.0f + __builtin_amdgcn_exp2f(x * -1.4426950408889634f)); }

#define XB_TMO      128
#define XB_XCNT(j)  (256  + 64 * (j))
#define XB_XSUB(j)  (1280 + 64 * (j))
#define XB_XGEN(j)  (2304 + 64 * (j))
#define XB_TOP      3328
#define XB_TOPGEN   3392
#define XCD_BAR_WORDS 3456
#define XB_SPIN_CAP (1u << 18)
__device__ __forceinline__ unsigned xb_ld(unsigned* p)              { return __hip_atomic_load(p, __ATOMIC_RELAXED, __HIP_MEMORY_SCOPE_AGENT); }
__device__ __forceinline__ unsigned xb_add(unsigned* p, unsigned v) { return __hip_atomic_fetch_add(p, v, __ATOMIC_RELAXED, __HIP_MEMORY_SCOPE_AGENT); }
__device__ __forceinline__ unsigned xb_xcc_id() { return (unsigned)__builtin_amdgcn_s_getreg((3 << 11) | 20) & 0xFu; }
#define XB_SPIN(cond, bar) do { unsigned _sp = 0; while (cond) { __builtin_amdgcn_s_sleep(1); \
    if ((++_sp & 255u) == 0u) { if (xb_ld(&(bar)[XB_TMO])) break; if (_sp > XB_SPIN_CAP) { atomicAdd(&(bar)[XB_TMO], 1u); break; } } } } while (0)
struct XcdBarrier { unsigned* bar; unsigned x; volatile LAS unsigned* st; };
__device__ __forceinline__ XcdBarrier xcd_barrier_post(unsigned* bar, volatile LAS unsigned* st) {
    XcdBarrier b; b.bar = bar; b.x = xb_xcc_id(); b.st = st;
    if (threadIdx.x == 0) (void)xb_add(&bar[XB_XCNT(b.x)], 1u);
    return b;
}
__device__ __forceinline__ void xcd_barrier_complete(unsigned* bar, unsigned x, unsigned& nloc, unsigned& nx) {
    const unsigned G = gridDim.x * gridDim.y * gridDim.z;
    unsigned sum, cnt, mine, sp = 0u;
    for (;;) {
        sum = 0u; cnt = 0u; mine = 0u;
#pragma unroll
        for (unsigned j = 0; j < 16; ++j) { const unsigned c = xb_ld(&bar[XB_XCNT(j)]); sum += c; cnt += (c > 0u) ? 1u : 0u; mine = (j == x) ? c : mine; }
        if (sum == G) break;
        __builtin_amdgcn_s_sleep(1);
        if ((++sp & 255u) == 0u) { if (xb_ld(&bar[XB_TMO])) break; if (sp > XB_SPIN_CAP) { atomicAdd(&bar[XB_TMO], 1u); break; } }
    }
    nloc = mine > 0u ? mine : 1u; nx = cnt > 0u ? cnt : 1u;
}
__device__ __forceinline__ void xcd_barrier(const XcdBarrier& b) {
    asm volatile("s_waitcnt vmcnt(0)" ::: "memory");
    __syncthreads();
    if (threadIdx.x == 0) {
        unsigned* bar = b.bar;
        __builtin_amdgcn_s_waitcnt(0);
        unsigned nloc = b.st[0], nx = b.st[1];
        if (nloc == 0u) { xcd_barrier_complete(bar, b.x, nloc, nx); b.st[0] = nloc; b.st[1] = nx; }
        const unsigned old = xb_add(&bar[XB_XSUB(b.x)], 1u);
        const unsigned gen = old / nloc;
        if (old + 1u == (gen + 1u) * nloc) {
            __builtin_amdgcn_fence(__ATOMIC_RELEASE, "agent");
            asm volatile("s_waitcnt vmcnt(0)" ::: "memory");
            const unsigned og = xb_add(&bar[XB_TOP], 1u);
            const unsigned tg = og / nx;
            if (og + 1u == (tg + 1u) * nx) xb_add(&bar[XB_TOPGEN], 1u);
            else XB_SPIN(xb_ld(&bar[XB_TOPGEN]) == tg, bar);
            __builtin_amdgcn_fence(__ATOMIC_ACQUIRE, "agent");
            xb_add(&bar[XB_XGEN(b.x)], 1u);
            asm volatile("s_waitcnt vmcnt(0)" ::: "memory");
        } else {
            XB_SPIN(xb_ld(&bar[XB_XGEN(b.x)]) == gen, bar);
            __builtin_amdgcn_fence(__ATOMIC_ACQUIRE, "agent");
            asm volatile("s_waitcnt vmcnt(0)" ::: "memory");
        }
    }
    __syncthreads();
}

struct Unit { int pm, pn; size_t a_off, b_off; int lbase, nvalid; };
struct Gemm { const bf16_t* A; const bf16_t* Bt; int lda, ldb, K; };
__host__ __device__ __forceinline__ int perm32(int rho) { const int n = rho >> 4, i = rho & 15; return 8 * (i >> 2) + 4 * n + (i & 3); }

struct PlainOrder {     static constexpr bool GATHER = false;
    int nM, nN, nwg, G, c, lda, ldb;
    __device__ void init(int M, int N, int G_, int c_, int lda_, int ldb_) { nM = M / 256; nN = N / 256; nwg = nM * nN; G = G_; c = c_; lda = lda_; ldb = ldb_; }
    __device__ bool next(int i, Unit& u) const {
        const long L = (long)i * G + c; if (L >= nwg) return false;
        int wgid = (int)L; { const int q = nwg / 8, r = nwg % 8, xcd = wgid % 8, off = wgid / 8; wgid = (xcd < r ? xcd * (q + 1) : r * (q + 1) + (xcd - r) * q) + off; }
        const int nig = 8 * nN, gid = wgid / nig, fm = gid * 8, gsz = (nM - fm) < 8 ? (nM - fm) : 8;
        u.pm = fm + ((wgid % nig) % gsz); u.pn = (wgid % nig) / gsz;
        u.a_off = (size_t)u.pm * 256 * lda; u.b_off = (size_t)u.pn * 256 * ldb; return true;
    }
};
struct XpreOrder {
    static constexpr bool GATHER = false;
    int G, c, mode;
    __device__ bool next(int i, Unit& u) const {
        const int L = i * G + c; if (L >= 256) return false;
        const int b = L >> 4, x = (L >> 2) & 3, y = L & 3;
        if (mode == 0) { const int h = x, kt = y; u.pm = b * 4 + h; u.pn = kt; u.a_off = (size_t)b * MEMLEN * DM + h * XHD; u.b_off = (size_t)kt * 256 * DM + h * XHD; }
        else { const int nt = x, h = y; u.pm = b * 4 + nt; u.pn = h; u.a_off = (size_t)nt * 256 * DM + h * XHD; u.b_off = (size_t)b * MEMLEN * DM + h * XHD; }
        return true;
    }
};
struct XattnOrder {
    static constexpr bool GATHER = false;
    int G, c, mode, lda;
    __device__ bool next(int i, Unit& u) const {
        int L = i * G + c; if (L >= (NTOK / 256) * 4) return false;
        if (G == 256) { const int x = c & 7, idx = c >> 3; L = ((x + 8 * i) * 8 + (idx >> 2)) * 4 + (idx & 3); }
        u.pm = L >> 2; u.pn = L & 3; const int b = u.pm >> 3;
        u.a_off = (size_t)u.pm * 256 * lda;
        u.b_off = mode == 0 ? (size_t)(b * 4 + u.pn) * 256 * DM : (size_t)(b * 1024 + u.pn * 256) * DM;
        return true;
    }
};
template <bool GATH_> struct MoeOrder {
    static constexpr bool GATHER = GATH_;
    const LAS int* ts; int G, c, lda, ldb; const int* ltok; unsigned rowbytes;
    __device__ bool next(int i, Unit& u) const {
        const int L = i * G + c; if (L >= ts[NEXP] * 4) return false;
        const int T = L >> 2, j = L & 3; int e = 0; while (ts[e + 1] <= T) ++e;
        const int lt = T - ts[e];
        u.pm = T; u.pn = j; u.a_off = GATH_ ? (size_t)0 : (size_t)T * 256 * lda; u.b_off = ((size_t)e * 1024 + j * 256) * ldb;
        u.lbase = e * LCAP + lt * 256; u.nvalid = ts[33 + e] - lt * 256; return true;
    }
    __device__ __forceinline__ unsigned rowoff(const Unit& u, int r) const { return (r < u.nvalid) ? (unsigned)ltok[u.lbase + r] * rowbytes : 0u; }
};

template <class Epi, class Sched>
__device__ __forceinline__ void gemm_phase_simple(LAS unsigned char* lds, const Gemm g, const Sched& S, const Epi& E) {
    int tid = threadIdx.x; asm volatile("" : "+v"(tid));
    const int wid = __builtin_amdgcn_readfirstlane(tid >> 6), lane = tid & 63, wr = wid >> 2, wc = wid & 3, fr = lane & 15, fq = lane >> 4;
    Unit u;
    for (int i = 0; S.next(i, u); ++i) {
        f32x4 acc[2][2][4][2];
#pragma unroll
        for (int a = 0; a < 2; ++a)
#pragma unroll
            for (int b = 0; b < 2; ++b)
#pragma unroll
                for (int m = 0; m < 4; ++m)
#pragma unroll
                    for (int n = 0; n < 2; ++n) acc[a][b][m][n] = (f32x4){0.f, 0.f, 0.f, 0.f};
        const char* Ab = (const char*)(g.A + u.a_off); const char* Bb = (const char*)(g.Bt + u.b_off);
        const int c0 = Epi::PERM ? perm32(fr) : fr, c1 = Epi::PERM ? perm32(16 + fr) : 16 + fr;
        unsigned ao[2][4], bo[2][2];
#pragma unroll
        for (int ai = 0; ai < 2; ++ai)
#pragma unroll
            for (int m = 0; m < 4; ++m) ao[ai][m] = (unsigned)((128 * ai + 64 * wr + 16 * m + fr) * g.lda + 8 * fq) * 2u;
#pragma unroll
        for (int bj = 0; bj < 2; ++bj) { bo[bj][0] = (unsigned)((128 * bj + 32 * wc + c0) * g.ldb + 8 * fq) * 2u; bo[bj][1] = (unsigned)((128 * bj + 32 * wc + c1) * g.ldb + 8 * fq) * 2u; }
#pragma unroll 1
        for (int k0 = 0; k0 < g.K; k0 += 32) {
            if constexpr (Epi::MIDK) { if (k0 == (g.K >> 1)) E.midk(acc, u, wr, wc, fr, fq); }
            const char* Ak = Ab + (size_t)k0 * 2; const char* Bk = Bb + (size_t)k0 * 2;
            bf16x8 bfr[2][2];
#pragma unroll
            for (int bj = 0; bj < 2; ++bj) { bfr[bj][0] = *(const bf16x8*)(Bk + bo[bj][0]); bfr[bj][1] = *(const bf16x8*)(Bk + bo[bj][1]); }
#pragma unroll
            for (int ai = 0; ai < 2; ++ai) {
                bf16x8 af[4];
#pragma unroll
                for (int m = 0; m < 4; ++m) af[m] = *(const bf16x8*)(Ak + ao[ai][m]);
#pragma unroll
                for (int bj = 0; bj < 2; ++bj)
#pragma unroll
                    for (int m = 0; m < 4; ++m)
#pragma unroll
                        for (int n = 0; n < 2; ++n) acc[ai][bj][m][n] = __builtin_amdgcn_mfma_f32_16x16x32_bf16(bfr[bj][n], af[m], acc[ai][bj][m][n], 0, 0, 0);
            }
        }
        E(acc, u, wr, wc, fr, fq);
    }
}

typedef int v8i __attribute__((ext_vector_type(8)));
typedef int v4i __attribute__((ext_vector_type(4)));
__device__ __forceinline__ v8i cat8(bf16x8 lo, bf16x8 hi) { const v4i a = __builtin_bit_cast(v4i, lo), b = __builtin_bit_cast(v4i, hi); return __builtin_shufflevector(a, b, 0, 1, 2, 3, 4, 5, 6, 7); }
template <int H> __device__ __forceinline__ bf16x8 half8(v8i v) { const v4i h = H ? __builtin_shufflevector(v, v, 4, 5, 6, 7) : __builtin_shufflevector(v, v, 0, 1, 2, 3); return __builtin_bit_cast(bf16x8, h); }
__device__ __forceinline__ unsigned pk4_fp8(float a, float b, float c, float d) { int w = __builtin_amdgcn_cvt_pk_fp8_f32(a, b, 0, false); w = __builtin_amdgcn_cvt_pk_fp8_f32(c, d, w, true); return (unsigned)w; }
__host__ __device__ __forceinline__ int lds_byte(int r, int c) { const int st = (r >> 4) * 2 + (c >> 5), rr = r & 15, cc = c & 31, ob = rr * 64 + cc * 2; return st * 1024 + (ob ^ (((ob >> 9) & 1) << 5)); }
__host__ __device__ __forceinline__ void stage_rc(int b, int& R, int& C) { const int st = b / 1024, sb = b % 1024, swz = sb ^ (((sb >> 9) & 1) << 5); R = (st >> 1) * 16 + swz / 64; C = (st & 1) * 32 + (swz % 64) / 2; }
template <class Epi, class Sched, bool ALIGN_EPI = false, bool SP2 = false, bool F8 = false>
__device__ __forceinline__ void gemm_phase(LAS unsigned char* lds, const Gemm g, const Sched& S, const Epi& E) {
    constexpr int BK = 64, HALF = 128, HTB = HALF * BK * 2;
    int tid = threadIdx.x; asm volatile("" : "+v"(tid));
    const int wid = __builtin_amdgcn_readfirstlane(tid >> 6), lane = tid & 63, wr = wid >> 2, wc = wid & 3, fr = lane & 15, fq = lane >> 4;
    const int K = g.K, nt = K / BK;
    unsigned voffA[2], voffB[2];
#pragma unroll
    for (int i = 0; i < 2; ++i) { int R, C; stage_rc(tid * 16 + i * 8192, R, C); const int Rb = Epi::PERM ? ((R & ~31) + perm32(R & 31)) : R;
        voffA[i] = (unsigned)(R * g.lda + C) * 2u; voffB[i] = (unsigned)(Rb * g.ldb + C) * 2u; }
    constexpr bool GATH = Sched::GATHER;
    unsigned vcu[2][2] = {{0u, 0u}, {0u, 0u}}, vnx[2][2] = {{0u, 0u}, {0u, 0u}}; int gR[2] = {0, 0}; unsigned gC[2] = {0u, 0u};
    if constexpr (GATH) {
#pragma unroll
        for (int i = 0; i < 2; ++i) { int R, Cq; stage_rc(tid * 16 + i * 8192, R, Cq); gR[i] = R; gC[i] = (unsigned)Cq * 2u; } }
    const size_t kstep = (size_t)(BK * 2);
    const size_t hstepA = (size_t)HALF * g.lda * 2, hstepB = (size_t)HALF * g.ldb * 2;
    const unsigned ldsw = (unsigned)wid * 1024u;
    const int aoff = lds_byte(wr * 64 + fr, F8 ? fq * 16 : fq * 8), boff = lds_byte(wc * 32 + fr, F8 ? fq * 16 : fq * 8);
    const int aoff1 = lds_byte(wr * 64 + fr, F8 ? fq * 16 + 8 : fq * 8 + 32) - aoff, boff1 = lds_byte(wc * 32 + fr, F8 ? fq * 16 + 8 : fq * 8 + 32) - boff;
#define PG8_SA(b, h) (((b) * 2 + (h)) * HTB)
#define PG8_SB(b, h) ((4 + (b) * 2 + (h)) * HTB)
#define PG8_STAGE(bufoff, gbase, voff) do { _Pragma("unroll") for (int _i = 0; _i < 2; ++_i) \
        __builtin_amdgcn_global_load_lds((const unsigned*)((const char*)(gbase) + (voff)[_i]), (LAS unsigned*)(lds + (bufoff) + ldsw + _i * 8192), 16, 0, 0); } while (0)
#define PG8_STA(bufoff, ptr, h, nx) do { if constexpr (GATH) { const unsigned vsel_[2] = {(nx) ? vnx[h][0] : vcu[h][0], (nx) ? vnx[h][1] : vcu[h][1]}; PG8_STAGE(bufoff, ptr, vsel_); } \
        else { PG8_STAGE(bufoff, (ptr) + (h) * hstepA, voffA); } } while (0)
#define PG8_LDA(dst, b, h) do { _Pragma("unroll") for (int m = 0; m < 4; ++m) dst[m] = cat8(*(const LAS bf16x8*)(lds + PG8_SA(b, h) + aoff + m * 2048), *(const LAS bf16x8*)(lds + PG8_SA(b, h) + aoff + m * 2048 + aoff1)); } while (0)
#define PG8_LDB(dst, b, h) do { _Pragma("unroll") for (int n = 0; n < 2; ++n) dst[n] = cat8(*(const LAS bf16x8*)(lds + PG8_SB(b, h) + boff + n * 2048), *(const LAS bf16x8*)(lds + PG8_SB(b, h) + boff + n * 2048 + boff1)); } while (0)
#define PG8_MMA(ai, bj, At, Bt) do { __builtin_amdgcn_s_setprio(1); \
        if constexpr (F8) { _Pragma("unroll") for (int m = 0; m < 4; ++m) _Pragma("unroll") for (int n = 0; n < 2; ++n) \
            asm volatile("v_mfma_scale_f32_16x16x128_f8f6f4 %0, %1, %2, %0, %3, %3 op_sel_hi:[0,0,0]" : "+v"(acc[ai][bj][m][n]) : "v"(Bt[n]), "v"(At[m]), "v"(sc127)); } \
        else { _Pragma("unroll") for (int m = 0; m < 4; ++m) _Pragma("unroll") for (int n = 0; n < 2; ++n) { \
            acc[ai][bj][m][n] = __builtin_amdgcn_mfma_f32_16x16x32_bf16(half8<0>(Bt[n]), half8<0>(At[m]), acc[ai][bj][m][n], 0, 0, 0); \
            acc[ai][bj][m][n] = __builtin_amdgcn_mfma_f32_16x16x32_bf16(half8<1>(Bt[n]), half8<1>(At[m]), acc[ai][bj][m][n], 0, 0, 0); } } \
        __builtin_amdgcn_s_setprio(0); } while (0)
#define PG8_WAIT_V(n) asm volatile("s_waitcnt vmcnt(" #n ")" ::: "memory")
#define PG8_WAIT_L(n) asm volatile("s_waitcnt lgkmcnt(" #n ")" ::: "memory")
#define PG8_BAR __builtin_amdgcn_s_barrier()
#define PG8_SCHED __builtin_amdgcn_sched_barrier(0)
    Unit cur, nxt; int ui = 0;
    if (!S.next(0, cur)) return;
    f32x4 acc[2][2][4][2];
#pragma unroll
    for (int a = 0; a < 2; ++a)
#pragma unroll
        for (int b = 0; b < 2; ++b)
#pragma unroll
            for (int m = 0; m < 4; ++m)
#pragma unroll
                for (int n = 0; n < 2; ++n) acc[a][b][m][n] = (f32x4){0.f, 0.f, 0.f, 0.f};
    int sc127 = 127; asm volatile("" : "+v"(sc127));
    v8i At[4], B0[2], B1[2];
    const char* cA = (const char*)(g.A + cur.a_off); const char* cB = (const char*)(g.Bt + cur.b_off);
    if constexpr (GATH) {
#pragma unroll
        for (int h = 0; h < 2; ++h)
#pragma unroll
            for (int i = 0; i < 2; ++i) vcu[h][i] = S.rowoff(cur, h * HALF + gR[i]) + gC[i]; }
    if constexpr (SP2) {
        PG8_STAGE(PG8_SB(0, 0), cB, voffB); PG8_STAGE(PG8_SB(0, 1), cB + hstepB, voffB); PG8_STA(PG8_SA(0, 0), cA, 0, false); PG8_STA(PG8_SA(0, 1), cA, 1, false);
        if (wr == 1) PG8_BAR;
        PG8_WAIT_V(2); PG8_BAR;
        PG8_STAGE(PG8_SB(1, 0), cB + kstep, voffB); PG8_STA(PG8_SA(1, 0), cA + kstep, 0, false); PG8_STAGE(PG8_SB(1, 1), cB + hstepB + kstep, voffB);
        PG8_WAIT_V(6); PG8_BAR;
    } else {
        PG8_STAGE(PG8_SB(0, 0), cB, voffB); PG8_STA(PG8_SA(0, 0), cA, 0, false); PG8_STAGE(PG8_SB(0, 1), cB + hstepB, voffB); PG8_STA(PG8_SA(0, 1), cA, 1, false);
        if (wr == 1) PG8_BAR;
        PG8_WAIT_V(4); PG8_BAR;
        PG8_STAGE(PG8_SB(1, 0), cB + kstep, voffB); PG8_STA(PG8_SA(1, 0), cA + kstep, 0, false); PG8_STAGE(PG8_SB(1, 1), cB + hstepB + kstep, voffB);
        PG8_WAIT_V(6); PG8_BAR;
    }
    for (;;) {
        const bool has_next = S.next(ui + 1, nxt);
        const char* nA = has_next ? (const char*)(g.A + nxt.a_off) : cA; const char* nB = has_next ? (const char*)(g.Bt + nxt.b_off) : cB;
        if constexpr (GATH) {
#pragma unroll
            for (int h = 0; h < 2; ++h)
#pragma unroll
                for (int i = 0; i < 2; ++i) vnx[h][i] = has_next ? (S.rowoff(nxt, h * HALF + gR[i]) + gC[i]) : vcu[h][i]; }
#pragma unroll 1
        for (int t = 0; t < nt; t += 2) {
            if constexpr (Epi::MIDK) { if (t == (nt >> 1)) E.midk(acc, cur, wr, wc, fr, fq); }
            const bool last = (t == nt - 2);
            const char* a1 = cA + (size_t)(t + 1) * kstep;
            const char* a2 = last ? nA : cA + (size_t)(t + 2) * kstep; const char* b2 = last ? nB : cB + (size_t)(t + 2) * kstep;
            const char* a3 = a2 + kstep; const char* b3 = b2 + kstep;
            if constexpr (SP2) {
            PG8_LDB(B0, 0, 0); PG8_LDB(B1, 0, 1); PG8_SCHED; PG8_LDA(At, 0, 0); PG8_STA(PG8_SA(1, 1), a1, 1, false);
            PG8_WAIT_V(8); PG8_WAIT_L(0); PG8_BAR; PG8_MMA(0, 0, At, B0); PG8_MMA(0, 1, At, B1); PG8_BAR; PG8_SCHED;
            PG8_LDA(At, 0, 1); PG8_STAGE(PG8_SB(0, 0), b2, voffB); PG8_STAGE(PG8_SB(0, 1), b2 + hstepB, voffB); PG8_STA(PG8_SA(0, 0), a2, 0, last);
            PG8_WAIT_V(8); PG8_WAIT_L(0); PG8_BAR; PG8_MMA(1, 0, At, B0); PG8_MMA(1, 1, At, B1); PG8_BAR; PG8_SCHED;
            PG8_LDB(B0, 1, 0); PG8_LDB(B1, 1, 1); PG8_SCHED; PG8_LDA(At, 1, 0); PG8_STA(PG8_SA(0, 1), a2, 1, last);
            PG8_WAIT_V(8); PG8_WAIT_L(0); PG8_BAR; PG8_MMA(0, 0, At, B0); PG8_MMA(0, 1, At, B1); PG8_BAR; PG8_SCHED;
            PG8_LDA(At, 1, 1); PG8_STAGE(PG8_SB(1, 0), b3, voffB); PG8_STAGE(PG8_SB(1, 1), b3 + hstepB, voffB); PG8_STA(PG8_SA(1, 0), a3, 0, last);
            PG8_WAIT_V(8); PG8_WAIT_L(0); PG8_BAR; PG8_MMA(1, 0, At, B0); PG8_MMA(1, 1, At, B1); PG8_BAR; PG8_SCHED;
            } else {
            PG8_LDB(B0, 0, 0); PG8_SCHED; PG8_LDA(At, 0, 0); PG8_STA(PG8_SA(1, 1), a1, 1, false);
            PG8_WAIT_L(8); PG8_BAR; PG8_WAIT_L(0); PG8_MMA(0, 0, At, B0); PG8_BAR; PG8_SCHED;
            PG8_LDB(B1, 0, 1); PG8_STAGE(PG8_SB(0, 0), b2, voffB);
            PG8_BAR; PG8_WAIT_L(0); PG8_MMA(0, 1, At, B1); PG8_BAR;
            PG8_LDA(At, 0, 1); PG8_STA(PG8_SA(0, 0), a2, 0, last);
            PG8_BAR; PG8_WAIT_L(0); PG8_MMA(1, 0, At, B0); PG8_BAR; PG8_SCHED;
            PG8_STAGE(PG8_SB(0, 1), b2 + hstepB, voffB);
            PG8_WAIT_V(6); PG8_BAR; PG8_MMA(1, 1, At, B1); PG8_BAR;
            PG8_LDB(B0, 1, 0); PG8_SCHED; PG8_LDA(At, 1, 0); PG8_STA(PG8_SA(0, 1), a2, 1, last);
            PG8_WAIT_L(8); PG8_BAR; PG8_WAIT_L(0); PG8_MMA(0, 0, At, B0); PG8_BAR; PG8_SCHED;
            PG8_LDB(B1, 1, 1); PG8_STAGE(PG8_SB(1, 0), b3, voffB);
            PG8_BAR; PG8_WAIT_L(0); PG8_MMA(0, 1, At, B1); PG8_BAR;
            PG8_LDA(At, 1, 1); PG8_STA(PG8_SA(1, 0), a3, 0, last);
            PG8_BAR; PG8_WAIT_L(0); PG8_MMA(1, 0, At, B0); PG8_BAR; PG8_SCHED;
            PG8_STAGE(PG8_SB(1, 1), b3 + hstepB, voffB);
            PG8_WAIT_V(6); PG8_BAR; PG8_MMA(1, 1, At, B1); PG8_BAR;
            }
        }
        if constexpr (ALIGN_EPI) { if (wr == 0) PG8_BAR; }
        if constexpr (F8) asm volatile("s_nop 15\n\ts_nop 15" ::: "memory");
        E(acc, cur, wr, wc, fr, fq);
        if (!has_next) break;
#pragma unroll
        for (int a = 0; a < 2; ++a)
#pragma unroll
            for (int b = 0; b < 2; ++b)
#pragma unroll
                for (int m = 0; m < 4; ++m)
#pragma unroll
                    for (int n = 0; n < 2; ++n) acc[a][b][m][n] = (f32x4){0.f, 0.f, 0.f, 0.f};
        cur = nxt; cA = nA; cB = nB; ++ui;
        if constexpr (GATH) {
#pragma unroll
            for (int h = 0; h < 2; ++h)
#pragma unroll
                for (int i = 0; i < 2; ++i) vcu[h][i] = vnx[h][i]; }
        if constexpr (ALIGN_EPI) { if (wr == 1) PG8_BAR; }
    }
    PG8_WAIT_V(0);
    if constexpr (!ALIGN_EPI) { if (wr == 0) PG8_BAR; }
    PG8_BAR;
#undef PG8_SA
#undef PG8_SB
#undef PG8_STAGE
#undef PG8_STA
#undef PG8_LDA
#undef PG8_LDB
#undef PG8_MMA
#undef PG8_WAIT_V
#undef PG8_WAIT_L
#undef PG8_BAR
#undef PG8_SCHED
}
#ifdef GEMM_SIMPLE
#define GEMM_PHASE(lds, g, S, E) gemm_phase_simple(lds, g, S, E)
#else
#define GEMM_PHASE(lds, g, S, E) gemm_phase<decltype(E), decltype(S), true, true>(lds, g, S, E)
#endif
#define GEMM_PHASE8(lds, g, S, E) gemm_phase<decltype(E), decltype(S), true, true, true>(lds, g, S, E)

__device__ __forceinline__ float rstd_from_ssq(const float* ssq, int row) {
    const f32x4* p = (const f32x4*)(ssq + (size_t)row * 16); const f32x4 a = p[0], b = p[1], c = p[2], d = p[3];
    const float s = ((a[0] + a[1]) + (a[2] + a[3])) + ((b[0] + b[1]) + (b[2] + b[3])) + ((c[0] + c[1]) + (c[2] + c[3])) + ((d[0] + d[1]) + (d[2] + d[3]));
    return __builtin_amdgcn_rsqf(s * (1.0f / DM) + EPS);
}
__device__ __forceinline__ u32x4 pack8(const f32x4 v0, const f32x4 v1) { u32x4 w; w.x = cvt_pk_bf16(v0[0], v0[1]); w.y = cvt_pk_bf16(v0[2], v0[3]); w.z = cvt_pk_bf16(v1[0], v1[1]); w.w = cvt_pk_bf16(v1[2], v1[3]); return w; }

struct EpiProj {
    static constexpr bool PERM = true, LDSX = false, MIDK = false;
    bf16_t* base; const float* rope; float* ksum;
    __device__ __forceinline__ void operator()(f32x4 (&acc)[2][2][4][2], const Unit& u, int wr, int wc, int fr, int fq) const {
        const int type = u.pn >> 1, colt = (u.pn & 1) * 256;
        bf16_t* O = base + (size_t)type * NTOK * 512;
        const bool is_q = (type == 2), is_k = (type == 3);
        if ((is_q || is_k) && !(wc & 1)) {
#pragma unroll
            for (int ai = 0; ai < 2; ++ai)
#pragma unroll
                for (int m = 0; m < 4; ++m) {
                    const int row = u.pm * 256 + 128 * ai + 64 * wr + 16 * m + fr, pos = row & (SEQ - 1);
                    const float* rp = rope + pos * 16;
                    const f32x4 cs[2] = { *(const f32x4*)(rp), *(const f32x4*)(rp + 4) }, sn[2] = { *(const f32x4*)(rp + 8), *(const f32x4*)(rp + 12) };
#pragma unroll
                    for (int bj = 0; bj < 2; ++bj)
#pragma unroll
                        for (int n = 0; n < 2; ++n) {
                            const f32x4 mine = acc[ai][bj][m][n]; f32x4 oth;
#pragma unroll
                            for (int e = 0; e < 4; ++e) oth[e] = __shfl_xor(mine[e], 16);
                            f32x4 res = mine;
                            if (fq == 0) res = mine * cs[n] - oth * sn[n];
                            else if (fq == 1) res = mine * cs[n] + oth * sn[n];
                            acc[ai][bj][m][n] = res;
                        }
                }
        }
        const float sc = is_q ? QSCALE : 1.0f;
#pragma unroll
        for (int ai = 0; ai < 2; ++ai)
#pragma unroll
            for (int m = 0; m < 4; ++m) {
                const int row = u.pm * 256 + 128 * ai + 64 * wr + 16 * m + fr;
                bf16_t* rowp = O + (size_t)row * 512 + colt + 32 * wc + 8 * fq;
#pragma unroll
                for (int bj = 0; bj < 2; ++bj) *(u32x4*)(rowp + bj * 128) = pack8(acc[ai][bj][m][0] * sc, acc[ai][bj][m][1] * sc);
            }
        if (is_k) {
#pragma unroll
            for (int bj = 0; bj < 2; ++bj)
#pragma unroll
                for (int n = 0; n < 2; ++n)
#pragma unroll
                    for (int e = 0; e < 4; ++e) {
                        float s = 0.f;
#pragma unroll
                        for (int ai = 0; ai < 2; ++ai)
#pragma unroll
                            for (int m = 0; m < 4; ++m) s += acc[ai][bj][m][n][e];
                        s += __shfl_xor(s, 1); s += __shfl_xor(s, 2); s += __shfl_xor(s, 4); s += __shfl_xor(s, 8);
                        if (fr == 0) atomicAdd(ksum + (size_t)u.pm * 512 + colt + 128 * bj + 32 * wc + 8 * fq + 4 * n + e, s);
                    }
        }
    }
};
struct EpiNull {
    static constexpr bool PERM = true, LDSX = false, MIDK = false;
    __device__ __forceinline__ void operator()(f32x4 (&acc)[2][2][4][2], const Unit& u, int wr, int wc, int fr, int fq) const { asm volatile("" :: "v"(acc[0][0][0][0][0]), "v"(acc[1][1][3][1][3])); }
};
struct EpiStore {
    static constexpr bool PERM = true, LDSX = false, MIDK = false;
    bf16_t* O; int ldc; float sc = 1.0f;
    __device__ __forceinline__ void operator()(f32x4 (&acc)[2][2][4][2], const Unit& u, int wr, int wc, int fr, int fq) const {
#pragma unroll
        for (int ai = 0; ai < 2; ++ai)
#pragma unroll
            for (int m = 0; m < 4; ++m) {
                const int row = u.pm * 256 + 128 * ai + 64 * wr + 16 * m + fr;
                bf16_t* rowp = O + (size_t)row * ldc + u.pn * 256 + 32 * wc + 8 * fq;
#pragma unroll
                for (int bj = 0; bj < 2; ++bj) *(u32x4*)(rowp + bj * 128) = pack8(acc[ai][bj][m][0] * sc, acc[ai][bj][m][1] * sc);
            }
    }
};
template <bool BASE_F32, bool KSPLIT> struct EpiResid {
    static constexpr bool PERM = true, LDSX = false, MIDK = KSPLIT;
    const void* base; bf16_t* hb; float* ssq; const float* ssql; const float* ssqa; unsigned char* h8;
    __device__ __forceinline__ void stats(int row, int fq, float& rl, float& ra) const {
        const f32x4 pl = *(const f32x4*)(ssql + (size_t)row * 16 + 4 * fq); const f32x2 pa = *(const f32x2*)(ssqa + (size_t)row * 8 + 2 * fq);
        float sl = (pl[0] + pl[1]) + (pl[2] + pl[3]), sa = pa[0] + pa[1];
        sl += __shfl_xor(sl, 16); sl += __shfl_xor(sl, 32); sa += __shfl_xor(sa, 16); sa += __shfl_xor(sa, 32);
        rl = __builtin_amdgcn_rsqf(sl * (1.0f / 512.0f) + EPS); ra = __builtin_amdgcn_rsqf(sa * (1.0f / 512.0f) + EPS);
    }
    __device__ __forceinline__ void midk(f32x4 (&acc)[2][2][4][2], const Unit& u, int wr, int wc, int fr, int fq) const {
        asm volatile("" : "+v"(fr), "+v"(fq));
#pragma unroll
        for (int ai = 0; ai < 2; ++ai)
#pragma unroll
            for (int m = 0; m < 4; ++m) { float rl, ra; stats(u.pm * 256 + 128 * ai + 64 * wr + 16 * m + fr, fq, rl, ra); const float ratio = rl * __builtin_amdgcn_rcpf(ra);
#pragma unroll
                for (int bj = 0; bj < 2; ++bj)
#pragma unroll
                    for (int n = 0; n < 2; ++n) acc[ai][bj][m][n] *= ratio; }
    }
    __device__ __forceinline__ void operator()(f32x4 (&acc)[2][2][4][2], const Unit& u, int wr, int wc, int fr, int fq) const {
#pragma unroll
        for (int ai = 0; ai < 2; ++ai)
#pragma unroll
            for (int m = 0; m < 4; ++m) {
                const int row = u.pm * 256 + 128 * ai + 64 * wr + 16 * m + fr; float q = 0.f, osc = 1.0f;
                if constexpr (KSPLIT) { float rl; stats(row, fq, rl, osc); }
#pragma unroll
                for (int bj = 0; bj < 2; ++bj) {
                    const int col = u.pn * 256 + 128 * bj + 32 * wc + 8 * fq;
                    f32x4 b0, b1;
                    if constexpr (BASE_F32) { b0 = *(const f32x4*)((const float*)base + (size_t)row * DM + col); b1 = *(const f32x4*)((const float*)base + (size_t)row * DM + col + 4); }
                    else { const u32x4 w = *(const u32x4*)((const bf16_t*)base + (size_t)row * LDH + col); b0 = (f32x4){bflo(w.x), bfhi(w.x), bflo(w.y), bfhi(w.y)}; b1 = (f32x4){bflo(w.z), bfhi(w.z), bflo(w.w), bfhi(w.w)}; }
                    const f32x4 v0 = b0 + acc[ai][bj][m][0] * osc, v1 = b1 + acc[ai][bj][m][1] * osc;
                    q += ((v0[0] * v0[0] + v0[1] * v0[1]) + (v0[2] * v0[2] + v0[3] * v0[3])) + ((v1[0] * v1[0] + v1[1] * v1[1]) + (v1[2] * v1[2] + v1[3] * v1[3]));
                    *(u32x4*)(hb + (size_t)row * LDH + col) = pack8(v0, v1);
                    if (h8) { u32x2 w8; w8.x = pk4_fp8(v0[0], v0[1], v0[2], v0[3]); w8.y = pk4_fp8(v1[0], v1[1], v1[2], v1[3]); *(u32x2*)(h8 + (size_t)row * DM + col) = w8; }
                }
                q += __shfl_xor(q, 16); q += __shfl_xor(q, 32);
                if (fq == 0) ssq[(size_t)row * 16 + u.pn * 4 + wc] = q;
            }
    }
};
struct EpiRowScale {
    static constexpr bool PERM = true, LDSX = false, MIDK = false;
    bf16_t* O; int ldc; const float* ssq; float cs;
    __device__ __forceinline__ void operator()(f32x4 (&acc)[2][2][4][2], const Unit& u, int wr, int wc, int fr, int fq) const {
#pragma unroll
        for (int ai = 0; ai < 2; ++ai)
#pragma unroll
            for (int m = 0; m < 4; ++m) {
                const int row = u.pm * 256 + 128 * ai + 64 * wr + 16 * m + fr; const float s = rstd_from_ssq(ssq, row) * cs;
                bf16_t* rowp = O + (size_t)row * ldc + u.pn * 256 + 32 * wc + 8 * fq;
#pragma unroll
                for (int bj = 0; bj < 2; ++bj) *(u32x4*)(rowp + bj * 128) = pack8(acc[ai][bj][m][0] * s, acc[ai][bj][m][1] * s);
            }
    }
};
#define XBAR() do { asm volatile("s_waitcnt lgkmcnt(0)" ::: "memory"); __builtin_amdgcn_s_barrier(); asm volatile("" ::: "memory"); } while (0)
struct EpiSoftmax {
    static constexpr bool PERM = true, LDSX = false, MIDK = false;
    bf16_t* O; int ldc; LAS unsigned char* xl; const float* ssq; float cs;
    __device__ __forceinline__ void operator()(f32x4 (&acc)[2][2][4][2], const Unit& u, int wr, int wc, int fr, int fq) const {
        LAS float* P = (LAS float*)xl;
        LAS float* Q = (LAS float*)(xl + 4096);
#pragma unroll
        for (int ai = 0; ai < 2; ++ai)
#pragma unroll
            for (int m = 0; m < 4; ++m) {
                float v = -INFINITY; const float sc = rstd_from_ssq(ssq, u.pm * 256 + 128 * ai + 64 * wr + 16 * m + fr) * cs;
#pragma unroll
                for (int bj = 0; bj < 2; ++bj)
#pragma unroll
                    for (int n = 0; n < 2; ++n) { const f32x4 x = acc[ai][bj][m][n] * sc; acc[ai][bj][m][n] = x; v = fmaxf(v, fmaxf(fmaxf(x[0], x[1]), fmaxf(x[2], x[3]))); }
                v = fmaxf(v, __shfl_xor(v, 16)); v = fmaxf(v, __shfl_xor(v, 32));
                if (fq == 0) P[(128 * ai + 64 * wr + 16 * m + fr) * 4 + wc] = v;
            }
        XBAR();
#pragma unroll
        for (int ai = 0; ai < 2; ++ai)
#pragma unroll
            for (int m = 0; m < 4; ++m) {
                const int r = 128 * ai + 64 * wr + 16 * m + fr;
                const float v = fmaxf(fmaxf(P[r * 4 + 0], P[r * 4 + 1]), fmaxf(P[r * 4 + 2], P[r * 4 + 3]));
                float s = 0.f;
#pragma unroll
                for (int bj = 0; bj < 2; ++bj)
#pragma unroll
                    for (int n = 0; n < 2; ++n) { f32x4 x = acc[ai][bj][m][n];
#pragma unroll
                        for (int e = 0; e < 4; ++e) { x[e] = __builtin_amdgcn_exp2f(x[e] - v); s += x[e]; }
                        acc[ai][bj][m][n] = x; }
                s += __shfl_xor(s, 16); s += __shfl_xor(s, 32);
                if (fq == 0) Q[r * 4 + wc] = s;
            }
        XBAR();
#pragma unroll
        for (int ai = 0; ai < 2; ++ai)
#pragma unroll
            for (int m = 0; m < 4; ++m) {
                const int r = 128 * ai + 64 * wr + 16 * m + fr;
                const float inv = 1.0f / ((Q[r * 4 + 0] + Q[r * 4 + 1]) + (Q[r * 4 + 2] + Q[r * 4 + 3]));
                bf16_t* rowp = O + (size_t)(u.pm * 256 + r) * ldc + u.pn * 256 + 32 * wc + 8 * fq;
#pragma unroll
                for (int bj = 0; bj < 2; ++bj) *(u32x4*)(rowp + bj * 128) = pack8(acc[ai][bj][m][0] * inv, acc[ai][bj][m][1] * inv);
            }
        XBAR();
    }
};
struct EpiGateUp {
    static constexpr bool PERM = true, LDSX = false, MIDK = false;
    unsigned char* O; const float* lrs;
    __device__ __forceinline__ void operator()(f32x4 (&acc)[2][2][4][2], const Unit& u, int wr, int wc, int fr, int fq) const {
#pragma unroll
        for (int ai = 0; ai < 2; ++ai)
#pragma unroll
            for (int m = 0; m < 4; ++m) {
                const int r = 128 * ai + 64 * wr + 16 * m + fr, row = u.pm * 256 + r; const float rs = (r < u.nvalid) ? lrs[u.lbase + r] * (1.0f / WGU_SC) : 0.f;
                f32x4 o[2];
#pragma unroll
                for (int n = 0; n < 2; ++n)
#pragma unroll
                    for (int e = 0; e < 4; ++e) { const float g = acc[ai][0][m][n][e] * rs, up = acc[ai][1][m][n][e] * rs; o[n][e] = g * sigmoidf_(g) * up * ACT_SC; }
                u32x2 w8; w8.x = pk4_fp8(o[0][0], o[0][1], o[0][2], o[0][3]); w8.y = pk4_fp8(o[1][0], o[1][1], o[1][2], o[1][3]);
                *(u32x2*)(O + (size_t)row * DFF + u.pn * 128 + 32 * wc + 8 * fq) = w8;
            }
    }
};

struct Args { const float* in[27]; float* out; unsigned char* ws; int ph_lo, ph_hi; float invf[8]; };
struct Ctx { LAS unsigned char* lds; int tid, lane, wave, vcu, G; };

__device__ __forceinline__ void tr_load(f32x4 (&v)[8], const float* W, int ldw, int k0, int n0s, int lane) {
    const int kr = lane >> 3, ch = lane & 7;
#pragma unroll
    for (int i = 0; i < 8; ++i) v[i] = *(const f32x4*)(W + (size_t)(k0 + 8 * i + kr) * ldw + n0s + 4 * ch);
}
__device__ __forceinline__ void tr_finish(const f32x4 (&v)[8], int k0, bf16_t* WT, int ldt, int r0d, const float* gain, LAS float* scr, int lane) {
    const int kr = lane >> 3, ch = lane & 7, c = lane & 7;
    f32x4 g0 = {1.f, 1.f, 1.f, 1.f}, g1 = {1.f, 1.f, 1.f, 1.f};
    if (gain) { g0 = *(const f32x4*)(gain + k0 + 8 * c); g1 = *(const f32x4*)(gain + k0 + 8 * c + 4); }
#pragma unroll
    for (int i = 0; i < 8; ++i) { LAS float* d = scr + (8 * i + kr) * 33 + 4 * ch; d[0] = v[i][0]; d[1] = v[i][1]; d[2] = v[i][2]; d[3] = v[i][3]; }
    LDS_WAIT(); asm volatile("" ::: "memory");
#pragma unroll
    for (int j = 0; j < 4; ++j) { const int n = (lane >> 3) + 8 * j; const LAS float* s = scr + (8 * c) * 33 + n;
        u32x4 o; o.x = cvt_pk_bf16(s[0 * 33] * g0[0], s[1 * 33] * g0[1]); o.y = cvt_pk_bf16(s[2 * 33] * g0[2], s[3 * 33] * g0[3]); o.z = cvt_pk_bf16(s[4 * 33] * g1[0], s[5 * 33] * g1[1]); o.w = cvt_pk_bf16(s[6 * 33] * g1[2], s[7 * 33] * g1[3]);
        *(u32x4*)(WT + (size_t)(r0d + n) * ldt + k0 + 8 * c) = o; }
    LDS_WAIT(); asm volatile("" ::: "memory");
}
__device__ __forceinline__ void tr_finish8(const f32x4 (&v)[8], int k0, unsigned char* WT8, int ldt, int r0d, const float* gain, float sc, LAS float* scr, int lane) {
    const int kr = lane >> 3, ch = lane & 7, c = lane & 7;
    f32x4 g0 = {sc, sc, sc, sc}, g1 = {sc, sc, sc, sc};
    if (gain) { g0 = *(const f32x4*)(gain + k0 + 8 * c) * sc; g1 = *(const f32x4*)(gain + k0 + 8 * c + 4) * sc; }
#pragma unroll
    for (int i = 0; i < 8; ++i) { LAS float* d = scr + (8 * i + kr) * 33 + 4 * ch; d[0] = v[i][0]; d[1] = v[i][1]; d[2] = v[i][2]; d[3] = v[i][3]; }
    LDS_WAIT(); asm volatile("" ::: "memory");
#pragma unroll
    for (int j = 0; j < 4; ++j) { const int n = (lane >> 3) + 8 * j; const LAS float* s = scr + (8 * c) * 33 + n;
        u32x2 o; o.x = pk4_fp8(s[0 * 33] * g0[0], s[1 * 33] * g0[1], s[2 * 33] * g0[2], s[3 * 33] * g0[3]); o.y = pk4_fp8(s[4 * 33] * g1[0], s[5 * 33] * g1[1], s[6 * 33] * g1[2], s[7 * 33] * g1[3]);
        *(u32x2*)(WT8 + (size_t)(r0d + n) * ldt + k0 + 8 * c) = o; }
    LDS_WAIT(); asm volatile("" ::: "memory");
}
__device__ __forceinline__ void tr_item(const float* W, int ldw, int k0, int n0s, bf16_t* WT, int ldt, int r0d, const float* gain, LAS float* scr, int lane) {
    f32x4 v[8]; tr_load(v, W, ldw, k0, n0s, lane); tr_finish(v, k0, WT, ldt, r0d, gain, scr, lane);
}
__device__ __forceinline__ void rms_row_to_bf16(const float* xrow, const float* gain, bf16_t* orow, int lane) {
    const f32x4* xr = (const f32x4*)xrow + lane; const f32x4* gr = (const f32x4*)gain + lane;
    f32x4 v[4]; float s = 0.f;
#pragma unroll
    for (int j = 0; j < 4; ++j) { v[j] = xr[64 * j]; s += (v[j][0] * v[j][0] + v[j][1] * v[j][1]) + (v[j][2] * v[j][2] + v[j][3] * v[j][3]); }
    const float rstd = 1.0f / sqrtf(wave_sum(s) * (1.0f / DM) + EPS);
    u32x2* o8 = (u32x2*)orow + lane;
#pragma unroll
    for (int j = 0; j < 4; ++j) { const f32x4 g = gr[64 * j]; u32x2 w; w.x = cvt_pk_bf16(v[j][0] * rstd * g[0], v[j][1] * rstd * g[1]); w.y = cvt_pk_bf16(v[j][2] * rstd * g[2], v[j][3] * rstd * g[3]); o8[64 * j] = w; }
}

__device__ __forceinline__ void rms_row2_to_bf16(const float* xrow, const float* gain, bf16_t* orow, int lane) {
    const f32x4* xr = (const f32x4*)xrow + lane; const f32x4* gr = (const f32x4*)gain + lane;
    f32x4 v[2][4]; float s[2] = {0.f, 0.f};
#pragma unroll
    for (int r = 0; r < 2; ++r)
#pragma unroll
        for (int j = 0; j < 4; ++j) v[r][j] = xr[256 * r + 64 * j];
#pragma unroll
    for (int r = 0; r < 2; ++r)
#pragma unroll
        for (int j = 0; j < 4; ++j) s[r] += (v[r][j][0] * v[r][j][0] + v[r][j][1] * v[r][j][1]) + (v[r][j][2] * v[r][j][2] + v[r][j][3] * v[r][j][3]);
#pragma unroll
    for (int r = 0; r < 2; ++r) { const float rstd = 1.0f / sqrtf(wave_sum(s[r]) * (1.0f / DM) + EPS); u32x2* o8 = (u32x2*)(orow + (size_t)r * DM) + lane;
#pragma unroll
        for (int j = 0; j < 4; ++j) { const f32x4 g = gr[64 * j]; u32x2 w; w.x = cvt_pk_bf16(v[r][j][0] * rstd * g[0], v[r][j][1] * rstd * g[1]); w.y = cvt_pk_bf16(v[r][j][2] * rstd * g[2], v[r][j][3] * rstd * g[3]); o8[64 * j] = w; } }
}

__device__ __forceinline__ void conv_wdn(const Args& a, const Ctx& C, int gw, int NGW, int it_lo, int NIT) {
    LAS float* scr = (LAS float*)(C.lds + C.wave * 16384); const int lane = C.lane;
    f32x4 va[8], vb[8];
#define WDN_LOAD(v, it) do { const int e_ = (it) / 256, r_ = (it) % 256; tr_load(v, a.in[25] + (size_t)e_ * DFF * DM, DM, 64 * (r_ / 32), 32 * (r_ % 32), lane); } while (0)
#define WDN_FIN(v, it) do { const int e_ = (it) / 256, r_ = (it) % 256; tr_finish8(v, 64 * (r_ / 32), a.ws + WS_WDN, DFF, e_ * 1024 + 32 * (r_ % 32), nullptr, WDN_SC, scr, lane); } while (0)
    int it = it_lo + gw; if (it < NIT) WDN_LOAD(va, it);
    for (; it < NIT; it += 2 * NGW) {
        const int it1 = it + NGW, it2 = it + 2 * NGW;
        if (it1 < NIT) WDN_LOAD(vb, it1);
        WDN_FIN(va, it);
        if (it2 < NIT) WDN_LOAD(va, it2);
        if (it1 < NIT) WDN_FIN(vb, it1);
    }
#undef WDN_LOAD
#undef WDN_FIN
}
__device__ __forceinline__ void ph_prologue(const Args& a, const Ctx& C) {
    unsigned char* ws = a.ws;
    LAS float* scr = (LAS float*)(C.lds + C.wave * 16384);
    const int gw = C.vcu * 8 + C.wave, NGW = C.G * 8, lane = C.lane;
    for (int it = gw; it < 16 * 80; it += NGW) { const int kb = it / 80, nb = it % 80; tr_item(a.in[3], DIN, 64 * kb, 32 * nb, (bf16_t*)(ws + WS_WIN), DM, 32 * nb, nullptr, scr, lane); }
    for (int it = gw; it < 16 * 64; it += NGW) { const int kb = it / 64, nb = it % 64;
        if (nb < 32) tr_item(a.in[17], 2 * DM, 64 * kb, 32 * nb, (bf16_t*)(ws + WS_WXK), DM, 32 * nb, nullptr, scr, lane);
        else tr_item(a.in[17], 2 * DM, 64 * kb, 32 * nb, (bf16_t*)(ws + WS_WXV), DM, 32 * (nb - 32), nullptr, scr, lane); }
    for (int it = gw; it < 16 * 32; it += NGW) { const int kb = it / 32, nb = it % 32;
        tr_item(a.in[13], DM, 64 * kb, 32 * nb, (bf16_t*)(ws + WS_WOUT), DM, 32 * nb, (kb < 8) ? a.in[11] : (a.in[12] - DLRU), scr, lane);
        tr_item(a.in[18], DM, 64 * kb, 32 * nb, (bf16_t*)(ws + WS_WXO), DM, 32 * nb, nullptr, scr, lane); }
    for (int it = gw; it < NEXP * 16 * 32; it += NGW) { const int e = it / 512, r = it % 512, kb = r / 32, nb = r % 32, j = nb >> 3, half = (nb >> 2) & 1, q = nb & 3;
        f32x4 v8_[8]; tr_load(v8_, a.in[24] + (size_t)e * DM * DM, DM, 64 * kb, half * 512 + j * 128 + q * 32, lane); tr_finish8(v8_, 64 * kb, ws + WS_WGU, DM, e * 1024 + j * 256 + half * 128 + q * 32, a.in[19], WGU_SC, scr, lane); }
    for (int r = gw; r < DM; r += NGW) { const float gk = a.in[14][r]; const f32x4* src = (const f32x4*)(a.in[16] + (size_t)r * DM) + lane; u32x2* dst = (u32x2*)((bf16_t*)(ws + WS_WXQ) + (size_t)r * DM) + lane;
#pragma unroll
        for (int j = 0; j < 4; ++j) { const f32x4 v = src[64 * j]; u32x2 w; w.x = cvt_pk_bf16(v[0] * gk, v[1] * gk); w.y = cvt_pk_bf16(v[2] * gk, v[3] * gk); dst[64 * j] = w; } }
    conv_wdn(a, C, gw, NGW, WDN_SPLIT, NEXP * 8 * 32);
    { bf16_t* WR = (bf16_t*)(ws + WS_WR); const int gt = C.vcu * 512 + C.tid, NT = C.G * 512;
      for (int i = gt; i < 48 * DM; i += NT) { const int r = i / DM, k = i % DM; float v = 0.f;
          if (r < 4) v = a.in[20][k * NGRP + r] * a.in[19][k]; else if (r < 36) v = a.in[22][k * NEXP + (r - 4)] * a.in[19][k];
          WR[i] = (bf16_t)(cvt_pk_bf16(v, 0.f) & 0xffffu); }
      float* rope = (float*)(ws + WS_ROPE);
      for (int i = gt; i < SEQ * 8; i += NT) { const int pos = i >> 3, j = i & 7; const float ang = (float)pos * a.invf[j];
          const double tw = 6.283185307179586476925286766559; const double ad = (double)ang; const double red = ad - tw * __builtin_rint(ad / tw); const float rf = (float)red;
          rope[pos * 16 + j] = __cosf(rf); rope[pos * 16 + 8 + j] = __sinf(rf); } }
    for (int m = 2 * gw; m < NTOK; m += 2 * NGW) rms_row2_to_bf16(a.in[0] + (size_t)m * DM, a.in[2], (bf16_t*)(ws + WS_B) + (size_t)m * DM, lane);
    for (int m = 2 * gw; m < NMEM; m += 2 * NGW) rms_row2_to_bf16(a.in[1] + (size_t)m * DM, a.in[15], (bf16_t*)(ws + WS_MEMN) + (size_t)m * DM, lane);
}

__device__ __forceinline__ float gelu_tanh(float x) { const float x2 = x * x; const float z2 = x * (-2.0f * 0.7978845608028654f * 1.4426950408889634f) * (1.0f + 0.044715f * x2);
    return x * __builtin_amdgcn_rcpf(1.0f + __builtin_amdgcn_exp2f(z2)); }
__device__ __forceinline__ float one_minus_exp(float x) {
    const float p = -x * (1.0f + x * (0.5f + x * (0.16666667f + x * (0.041666668f + x * 0.0083333338f))));
    const float e = 1.0f - __builtin_amdgcn_exp2f(x * 1.4426950408889634f);
    return (x > -0.25f) ? p : e;
}
__device__ __forceinline__ void lru_unit(const Args& a, const Ctx& C, int b, int blk, int half) {
    unsigned char* ws = a.ws;
    const bf16_t* XL = (const bf16_t*)(ws + WS_A); const bf16_t* GL = XL + (size_t)NTOK * 512; bf16_t* YC = (bf16_t*)(ws + WS_C); float* SSQL = (float*)(ws + WS_SSQL);
    const int tid = C.tid, lane = C.lane, wave = C.wave, fr = lane & 15, fq = lane >> 4;
    LAS float* XW = (LAS float*)(C.lds + wave * 5120);
    LAS bf16_t* GW = (LAS bf16_t*)(C.lds + wave * 5120 + 2304);
    LAS bf16_t* YW = (LAS bf16_t*)(C.lds + wave * 5120 + 3584);
    LAS float* WSUM = (LAS float*)(C.lds + 40960);
    LAS float* CW = (LAS float*)(C.lds + 45056);
    const int c0 = blk * 64, oc0 = c0 + half * 32;
    bf16x8 wfr[2][2][2];
#pragma unroll
    for (int gt = 0; gt < 2; ++gt) { const float* W = a.in[gt == 0 ? 6 : 8] + (size_t)blk * 64 * 64;
#pragma unroll
        for (int nt = 0; nt < 2; ++nt)
#pragma unroll
            for (int ks = 0; ks < 2; ++ks) { u32x4 w; float f[8];
#pragma unroll
                for (int j = 0; j < 8; ++j) f[j] = W[(32 * ks + 8 * fq + j) * 64 + half * 32 + 16 * nt + fr];
                w.x = cvt_pk_bf16(f[0], f[1]); w.y = cvt_pk_bf16(f[2], f[3]); w.z = cvt_pk_bf16(f[4], f[5]); w.w = cvt_pk_bf16(f[6], f[7]);
                wfr[gt][nt][ks] = __builtin_bit_cast(bf16x8, w); } }
    float brg[2], big[2], sp[2], hc[2] = {0.f, 0.f};
#pragma unroll
    for (int nt = 0; nt < 2; ++nt) { const int ch = oc0 + 16 * nt + fr; brg[nt] = a.in[7][ch] * -1.4426950408889634f; big[nt] = a.in[9][ch] * -1.4426950408889634f; const float lam = a.in[10][ch];
        sp[nt] = -8.0f * 1.4426950408889634f * ((lam > 15.f) ? __expf(-lam) : log1pf(__expf(-lam))); }
    if (tid < 320) { const int k = tid >> 6, c = tid & 63; CW[tid] = (k < 4) ? a.in[4][k * DLRU + c0 + c] : a.in[5][c0 + c]; }
    u32x4 xrs[2][4][2], grs[2];
    const bf16_t* xrow0 = XL + ((size_t)b * SEQ + 16 * wave + fr) * 512 + c0 + 8 * fq;
    const bf16_t* grow0 = GL + ((size_t)b * SEQ + 16 * wave + (lane >> 2)) * 512 + oc0 + 8 * (lane & 3);
    const int tloc = 16 * wave + fr;
#define LRU_PREFETCH(t0_, xr, gr) do { _Pragma("unroll") for (int k = 0; k < 4; ++k) { const int tt = (t0_) + tloc - 3 + k; \
        if (tt >= 0) { const bf16_t* xp = xrow0 + (ptrdiff_t)((t0_) - 3 + k) * 512; xr[k][0] = *(const u32x4*)xp; xr[k][1] = *(const u32x4*)(xp + 32); } else { xr[k][0] = (u32x4){0u, 0u, 0u, 0u}; xr[k][1] = (u32x4){0u, 0u, 0u, 0u}; } } \
        gr = *(const u32x4*)(grow0 + (size_t)(t0_) * 512); } while (0)
    LRU_PREFETCH(0, xrs[0], grs[0]); LRU_PREFETCH(128, xrs[1], grs[1]);
    __syncthreads();
    for (int ch2 = 0; ch2 < SEQ / 256; ++ch2) {
#pragma unroll
      for (int sub = 0; sub < 2; ++sub) { const int ch = 2 * ch2 + sub, t0 = ch * 128; auto& xr = xrs[sub]; auto& gr = grs[sub];
        bf16x8 af[2];
#pragma unroll
        for (int ks = 0; ks < 2; ++ks) { float accv[8];
            { const f32x4 b0 = *(const LAS f32x4*)(CW + 256 + 32 * ks + 8 * fq), b1 = *(const LAS f32x4*)(CW + 256 + 32 * ks + 8 * fq + 4);
              accv[0] = b0[0]; accv[1] = b0[1]; accv[2] = b0[2]; accv[3] = b0[3]; accv[4] = b1[0]; accv[5] = b1[1]; accv[6] = b1[2]; accv[7] = b1[3]; }
#pragma unroll
            for (int k = 0; k < 4; ++k) { const f32x4 w0 = *(const LAS f32x4*)(CW + 64 * k + 32 * ks + 8 * fq), w1 = *(const LAS f32x4*)(CW + 64 * k + 32 * ks + 8 * fq + 4); const u32x4 x = xr[k][ks];
                accv[0] += w0[0] * bflo(x.x); accv[1] += w0[1] * bfhi(x.x); accv[2] += w0[2] * bflo(x.y); accv[3] += w0[3] * bfhi(x.y);
                accv[4] += w1[0] * bflo(x.z); accv[5] += w1[1] * bfhi(x.z); accv[6] += w1[2] * bflo(x.w); accv[7] += w1[3] * bfhi(x.w); }
            u32x4 p; p.x = cvt_pk_bf16(accv[0], accv[1]); p.y = cvt_pk_bf16(accv[2], accv[3]); p.z = cvt_pk_bf16(accv[4], accv[5]); p.w = cvt_pk_bf16(accv[6], accv[7]);
            af[ks] = __builtin_bit_cast(bf16x8, p);
            if (ks == half) { *(LAS f32x4*)(XW + fr * 36 + 8 * fq) = (f32x4){accv[0], accv[1], accv[2], accv[3]}; *(LAS f32x4*)(XW + fr * 36 + 8 * fq + 4) = (f32x4){accv[4], accv[5], accv[6], accv[7]}; } }
        *(LAS u32x4*)(GW + (lane >> 2) * 40 + 8 * (lane & 3)) = gr;
        if (ch + 2 < SEQ / 128) LRU_PREFETCH(t0 + 256, xr, gr);
        LDS_WAIT(); asm volatile("" ::: "memory");
        float Hl[2][4], Al[2][4], Aex[2], Hex[2];
        { f32x4 ar[2] = {{0.f, 0.f, 0.f, 0.f}, {0.f, 0.f, 0.f, 0.f}}, ai_[2] = {{0.f, 0.f, 0.f, 0.f}, {0.f, 0.f, 0.f, 0.f}};
#pragma unroll
          for (int ks = 0; ks < 2; ++ks)
#pragma unroll
              for (int nt = 0; nt < 2; ++nt) { ar[nt] = __builtin_amdgcn_mfma_f32_16x16x32_bf16(af[ks], wfr[0][nt][ks], ar[nt], 0, 0, 0); ai_[nt] = __builtin_amdgcn_mfma_f32_16x16x32_bf16(af[ks], wfr[1][nt][ks], ai_[nt], 0, 0, 0); }
#pragma unroll
          for (int nt = 0; nt < 2; ++nt) {
              float hrun = 0.f, arun = 1.f;
#pragma unroll
              for (int r = 0; r < 4; ++r) { const int chn = 16 * nt + fr;
                  const float rg = __builtin_amdgcn_rcpf(1.0f + __builtin_amdgcn_exp2f(__builtin_fmaf(ar[nt][r], -1.4426950408889634f, brg[nt])));
                  const float ig = __builtin_amdgcn_rcpf(1.0f + __builtin_amdgcn_exp2f(__builtin_fmaf(ai_[nt][r], -1.4426950408889634f, big[nt])));
                  const float av = __builtin_amdgcn_exp2f(rg * sp[nt]); const float mult = __builtin_amdgcn_sqrtf(fmaxf(1.0f - av * av, 0.f));
                  const float uv = mult * ig * XW[(4 * fq + r) * 36 + chn];
                  hrun = av * hrun + uv; arun *= av; Hl[nt][r] = hrun; Al[nt][r] = arun; }
              const float A0 = __shfl(arun, fr), H0 = __shfl(hrun, fr), A1 = __shfl(arun, fr + 16), H1 = __shfl(hrun, fr + 16), A2 = __shfl(arun, fr + 32), H2 = __shfl(hrun, fr + 32), A3 = __shfl(arun, fr + 48), H3 = __shfl(hrun, fr + 48);
              const float h01 = A1 * H0 + H1, a01 = A1 * A0, h012 = A2 * h01 + H2, a012 = A2 * a01;
              Aex[nt] = (fq == 0) ? 1.f : (fq == 1) ? A0 : (fq == 2) ? a01 : a012;
              Hex[nt] = (fq == 0) ? 0.f : (fq == 1) ? H0 : (fq == 2) ? h01 : h012;
              if (fq == 0) *(LAS f32x2*)(WSUM + (((ch & 1) * 8 + wave) * 32 + 16 * nt + fr) * 2) = (f32x2){A3 * a012, A3 * h012 + H3}; } }
        __syncthreads();
        { float ssr[4] = {0.f, 0.f, 0.f, 0.f};
#pragma unroll
          for (int nt = 0; nt < 2; ++nt) { const int chn = 16 * nt + fr; float x = hc[nt], mine = 0.f;
#pragma unroll
              for (int w2 = 0; w2 < 8; ++w2) { const f32x2 sm = *(const LAS f32x2*)(WSUM + (((ch & 1) * 8 + w2) * 32 + chn) * 2); if (w2 == wave) mine = x; x = sm[0] * x + sm[1]; }
              hc[nt] = x;
              const float hstart = Aex[nt] * mine + Hex[nt];
#pragma unroll
              for (int r = 0; r < 4; ++r) { const int tl = 4 * fq + r; const float h = Al[nt][r] * hstart + Hl[nt][r];
                  const float y = h * gelu_tanh(bf2f(GW[tl * 40 + chn])); const unsigned yb = cvt_pk_bf16(y, 0.f) & 0xffffu; YW[tl * 40 + chn] = (bf16_t)yb;
                  const float yr = __uint_as_float(yb << 16); ssr[r] += yr * yr; } }
#pragma unroll
          for (int r = 0; r < 4; ++r) { float q = ssr[r]; q += __shfl_xor(q, 1); q += __shfl_xor(q, 2); q += __shfl_xor(q, 4); q += __shfl_xor(q, 8);
              if (fr == 0) SSQL[((size_t)b * SEQ + t0 + 16 * wave + 4 * fq + r) * 16 + blk * 2 + half] = q; } }
        LDS_WAIT(); asm volatile("" ::: "memory");
        *(u32x4*)(YC + ((size_t)b * SEQ + t0 + 16 * wave + (lane >> 2)) * DM + oc0 + 8 * (lane & 3)) = *(const LAS u32x4*)(YW + (lane >> 2) * 40 + 8 * (lane & 3));
      }
    }
#undef LRU_PREFETCH
    __syncthreads();
}

__device__ __forceinline__ void moba_unit_simple(const Args& a, const Ctx& C, int b, int h, int qb) {
    unsigned char* ws = a.ws;
    const bf16_t* Q = (const bf16_t*)(ws + WS_A) + (size_t)2 * NTOK * 512; const bf16_t* K = Q + (size_t)NTOK * 512; const bf16_t* V = K + (size_t)NTOK * 512;
    bf16_t* YA = (bf16_t*)(ws + WS_B) + (size_t)NTOK * 512; const float* KSUM = (const float*)(ws + WS_KSUM);
    const int q = C.tid & 255, hf = C.tid >> 8; const size_t row = (size_t)b * SEQ + qb * 256 + q;
    float qv[64];
    { const u32x4* qp = (const u32x4*)(Q + row * 512 + h * 64);
#pragma unroll
      for (int i = 0; i < 8; ++i) { const u32x4 w = qp[i]; qv[8 * i] = bflo(w.x); qv[8 * i + 1] = bfhi(w.x); qv[8 * i + 2] = bflo(w.y); qv[8 * i + 3] = bfhi(w.y); qv[8 * i + 4] = bflo(w.z); qv[8 * i + 5] = bfhi(w.z); qv[8 * i + 6] = bflo(w.w); qv[8 * i + 7] = bfhi(w.w); } }
    unsigned sel = 0u;
    { float g[8];
#pragma unroll
      for (int n = 0; n < 8; ++n) { g[n] = -INFINITY;
          if (n < qb) { const float* ks = KSUM + (size_t)(b * 8 + n) * 512 + h * 64; float s = 0.f;
#pragma unroll
              for (int d = 0; d < 64; ++d) s += qv[d] * ks[d];
              g[n] = s; } }
      const int npick = qb < 3 ? qb : 3;
      for (int p = 0; p < npick; ++p) { int best = -1; float bv = -INFINITY;
#pragma unroll
          for (int n = 0; n < 8; ++n) { const bool ok = (n < qb) && !((sel >> n) & 1u) && (best < 0 || g[n] > bv); if (ok) { best = n; bv = g[n]; } }
          if (best >= 0) sel |= 1u << best; } }
    float o[32], mrun = -1e30f, l = 0.f;
#pragma unroll
    for (int d = 0; d < 32; ++d) o[d] = 0.f;
    for (int n = 0; n <= qb; ++n) {
        const bool own = (n == qb); const bool use = own || ((sel >> n) & 1u);
        if (!__any(use)) continue;
        for (int j = 0; j < 256; ++j) {
            const bool valid = use && (!own || j <= q);
            if (!__any(valid)) continue;
            const size_t krow = (size_t)b * SEQ + n * 256 + j;
            const u32x4* kp = (const u32x4*)(K + krow * 512 + h * 64); float s = 0.f;
#pragma unroll
            for (int i = 0; i < 8; ++i) { const u32x4 w = kp[i];
                s += qv[8 * i] * bflo(w.x) + qv[8 * i + 1] * bfhi(w.x) + qv[8 * i + 2] * bflo(w.y) + qv[8 * i + 3] * bfhi(w.y) + qv[8 * i + 4] * bflo(w.z) + qv[8 * i + 5] * bfhi(w.z) + qv[8 * i + 6] * bflo(w.w) + qv[8 * i + 7] * bfhi(w.w); }
            if (valid) {
                const float mnew = fmaxf(mrun, s), f = __builtin_amdgcn_exp2f(mrun - mnew), p = __builtin_amdgcn_exp2f(s - mnew);
                l = l * f + p; mrun = mnew;
                const u32x4* vp = (const u32x4*)(V + krow * 512 + h * 64 + 32 * hf);
#pragma unroll
                for (int i = 0; i < 4; ++i) { const u32x4 w = vp[i];
                    o[8 * i] = o[8 * i] * f + p * bflo(w.x); o[8 * i + 1] = o[8 * i + 1] * f + p * bfhi(w.x); o[8 * i + 2] = o[8 * i + 2] * f + p * bflo(w.y); o[8 * i + 3] = o[8 * i + 3] * f + p * bfhi(w.y);
                    o[8 * i + 4] = o[8 * i + 4] * f + p * bflo(w.z); o[8 * i + 5] = o[8 * i + 5] * f + p * bfhi(w.z); o[8 * i + 6] = o[8 * i + 6] * f + p * bflo(w.w); o[8 * i + 7] = o[8 * i + 7] * f + p * bfhi(w.w); }
            }
        }
    }
    const float inv = 1.0f / l;
    u32x4* op = (u32x4*)(YA + row * 512 + h * 64 + 32 * hf);
#pragma unroll
    for (int i = 0; i < 4; ++i) { u32x4 w; w.x = cvt_pk_bf16(o[8 * i] * inv, o[8 * i + 1] * inv); w.y = cvt_pk_bf16(o[8 * i + 2] * inv, o[8 * i + 3] * inv); w.z = cvt_pk_bf16(o[8 * i + 4] * inv, o[8 * i + 5] * inv); w.w = cvt_pk_bf16(o[8 * i + 6] * inv, o[8 * i + 7] * inv); op[i] = w; }
}

__device__ __forceinline__ void ph_ymix(const Args& a, const Ctx& C) {
    const bf16_t* YL = (const bf16_t*)(a.ws + WS_B); const bf16_t* YA = YL + (size_t)NTOK * 512; bf16_t* YM = (bf16_t*)(a.ws + WS_C);
    const int gw = C.vcu * 8 + C.wave, NGW = C.G * 8, lane = C.lane;
    for (int m = gw; m < NTOK; m += NGW) {
#pragma unroll
        for (int part = 0; part < 2; ++part) {
            const u32x4 w = *((const u32x4*)((part ? YA : YL) + (size_t)m * 512) + lane);
            float v[8] = {bflo(w.x), bfhi(w.x), bflo(w.y), bfhi(w.y), bflo(w.z), bfhi(w.z), bflo(w.w), bfhi(w.w)}; float s = 0.f;
#pragma unroll
            for (int i = 0; i < 8; ++i) s += v[i] * v[i];
            const float rstd = 1.0f / sqrtf(wave_sum(s) * (1.0f / 512.0f) + EPS);
            u32x4 o; o.x = cvt_pk_bf16(v[0] * rstd, v[1] * rstd); o.y = cvt_pk_bf16(v[2] * rstd, v[3] * rstd); o.z = cvt_pk_bf16(v[4] * rstd, v[5] * rstd); o.w = cvt_pk_bf16(v[6] * rstd, v[7] * rstd);
            *((u32x4*)(YM + (size_t)m * DM + part * 512) + lane) = o;
        }
    }
}

__device__ __forceinline__ void ph_router(const Args& a, const Ctx& C) {
    unsigned char* ws = a.ws;
    const bf16_t* H2B = (const bf16_t*)a.out + DM; const bf16_t* WR = (const bf16_t*)(ws + WS_WR); const float* SSQ2 = (const float*)(ws + WS_SSQ2);
    unsigned* CNT = (unsigned*)(ws + WS_CTL) + CW_CNT;
    int* TOKE = (int*)(ws + WS_TOK + TOK_E); int* TOKR = (int*)(ws + WS_TOK + TOK_R); float* TOKG = (float*)(ws + WS_TOK + TOK_G); int* LTOK = (int*)(ws + WS_LTOK); float* LRS = (float*)(ws + WS_LRS);
    constexpr int WRS = 1032;
    LAS bf16_t* WRL = (LAS bf16_t*)C.lds;
    LAS float* LG = (LAS float*)(C.lds + 99072) + C.wave * (16 * 49);
    LAS unsigned* lcnt = (LAS unsigned*)(C.lds + 99072 + 25088); LAS unsigned* lbase = lcnt + 32;
    const int lane = C.lane, fr = lane & 15, fq = lane >> 4;
    for (int i = C.tid; i < 48 * 128; i += 512) { const int r = i >> 7, c8 = i & 127; *(LAS u32x4*)(WRL + r * WRS + 8 * c8) = *(const u32x4*)(WR + (size_t)r * DM + 8 * c8); }
    for (int pass = 0; (pass * C.G) * 128 < NTOK; ++pass) {
        const int blk = pass * C.G + C.vcu; const bool live = blk * 128 < NTOK;
        if (C.tid < 32) lcnt[C.tid] = 0u;
        __syncthreads();
        int E1 = 0, E2 = 0; unsigned r1 = 0, r2 = 0; float ga = 0.f, gb = 0.f, rstd_t = 0.f; const int tb = blk * 128 + 16 * C.wave;
        if (live) {
            f32x4 acc[3] = {{0.f, 0.f, 0.f, 0.f}, {0.f, 0.f, 0.f, 0.f}, {0.f, 0.f, 0.f, 0.f}};
            bf16x8 af[32];
#pragma unroll
            for (int ks = 0; ks < 32; ++ks) af[ks] = *(const bf16x8*)(H2B + (size_t)(tb + fr) * LDH + 32 * ks + 8 * fq);
#pragma unroll
            for (int ks = 0; ks < 32; ++ks) {
#pragma unroll
                for (int nt = 0; nt < 3; ++nt) { const bf16x8 bfg = *(const LAS bf16x8*)(WRL + (16 * nt + fr) * WRS + 32 * ks + 8 * fq); acc[nt] = __builtin_amdgcn_mfma_f32_16x16x32_bf16(af[ks], bfg, acc[nt], 0, 0, 0); } }
#pragma unroll
            for (int nt = 0; nt < 3; ++nt)
#pragma unroll
                for (int r = 0; r < 4; ++r) LG[(4 * fq + r) * 49 + 16 * nt + fr] = acc[nt][r];
            LDS_WAIT(); asm volatile("" ::: "memory");
            if (lane < 16) { const int t = tb + lane; const float rstd = rstd_from_ssq(SSQ2, t); rstd_t = rstd; const LAS float* lg = LG + lane * 49;
                float g[4]; int grp = 0;
#pragma unroll
                for (int i = 0; i < 4; ++i) g[i] = lg[i] * rstd + a.in[21][i];
#pragma unroll
                for (int i = 1; i < 4; ++i) if (g[i] > g[grp]) grp = i;
                float gs = 0.f;
#pragma unroll
                for (int i = 0; i < 4; ++i) gs += __expf(g[i] - g[grp]);
                const float gw_ = 1.0f / gs;
                float e[8];
#pragma unroll
                for (int i = 0; i < 8; ++i) e[i] = lg[4 + 8 * grp + i] * rstd + a.in[23][8 * grp + i];
                int i1 = 0;
#pragma unroll
                for (int i = 1; i < 8; ++i) if (e[i] > e[i1]) i1 = i;
                int i2 = (i1 == 0) ? 1 : 0;
#pragma unroll
                for (int i = 0; i < 8; ++i) if (i != i1 && i != i2 && e[i] > e[i2]) i2 = i;
                const float eb = __expf(e[i2] - e[i1]); ga = gw_ / (1.0f + eb); gb = gw_ * eb / (1.0f + eb);
                E1 = grp * 8 + i1; E2 = grp * 8 + i2;
                r1 = atomicAdd((unsigned*)&lcnt[E1], 1u); r2 = atomicAdd((unsigned*)&lcnt[E2], 1u);
            }
        }
        __syncthreads();
        if (C.tid < 32) lbase[C.tid] = lcnt[C.tid] ? __hip_atomic_fetch_add(CNT + C.tid, lcnt[C.tid], __ATOMIC_RELAXED, __HIP_MEMORY_SCOPE_AGENT) : 0u;
        __syncthreads();
        if (live && lane < 16) { const int t = tb + lane;
            const int k1 = (int)(lbase[E1] + r1), k2 = (int)(lbase[E2] + r2);
            TOKE[2 * t] = E1; TOKR[2 * t] = k1; TOKG[2 * t] = ga; LTOK[E1 * LCAP + k1] = t; LRS[E1 * LCAP + k1] = rstd_t;
            TOKE[2 * t + 1] = E2; TOKR[2 * t + 1] = k2; TOKG[2 * t + 1] = gb; LTOK[E2 * LCAP + k2] = t; LRS[E2 * LCAP + k2] = rstd_t; }
        __syncthreads();
    }
}
__device__ __forceinline__ void moe_table(const Args& a, const Ctx& C) {
    LAS int* ts = (LAS int*)(C.lds + MOE_OFF);
    if (C.tid == 0) { const unsigned* CNT = (const unsigned*)(a.ws + WS_CTL) + CW_CNT; int acc = 0;
        for (int e = 0; e < NEXP; ++e) { ts[e] = acc; const unsigned c = __hip_atomic_load(CNT + e, __ATOMIC_RELAXED, __HIP_MEMORY_SCOPE_AGENT); ts[33 + e] = (int)c; acc += (int)((c + 255u) >> 8); }
        ts[NEXP] = acc; }
    __syncthreads();
}
__device__ __forceinline__ void ph_final(const Args& a, const Ctx& C, float* outp) {
    unsigned char* ws = a.ws;
    const bf16_t* YB = (const bf16_t*)(ws + WS_A); const float* TOKG = (const float*)(ws + WS_TOK + TOK_G); const int* TOKE = (const int*)(ws + WS_TOK + TOK_E); const int* TOKR = (const int*)(ws + WS_TOK + TOK_R);
    const LAS int* ts = (const LAS int*)(C.lds + MOE_OFF);
    const bf16_t* H2B = (const bf16_t*)a.out + DM; const float* gf = a.in[26];
    const int gw = C.vcu * 8 + C.wave, NGW = C.G * 8, lane = C.lane;
    f32x4 gn[4];
#pragma unroll
    for (int q = 0; q < 4; ++q) gn[q] = *(const f32x4*)(gf + 512 * (q >> 1) + 8 * lane + 4 * (q & 1));
    const int nit = (NTOK + NGW - 1) / NGW;
    int dnx = 0; float gnx = 0.f;
#define FIN_IDX(ib) do { const int tt_ = gw + ((ib) + (lane >> 1)) * NGW; dnx = 0; gnx = 0.f; \
        if (lane < 8 && tt_ < NTOK) { const int e_ = TOKE[2 * tt_ + (lane & 1)]; dnx = ts[e_] * 256 + TOKR[2 * tt_ + (lane & 1)]; gnx = TOKG[2 * tt_ + (lane & 1)]; } } while (0)
    FIN_IDX(0);
    for (int ib = 0; ib < nit; ib += 4) {
        const int dcur = dnx; const float gcur = gnx;
        if (ib + 4 < nit) FIN_IDX(ib + 4);
        u32x4 hw[4][2], y0[4][2], y1[4][2];
#pragma unroll
        for (int j = 0; j < 4; ++j) { const int t = gw + (ib + j) * NGW; const int d0 = __builtin_amdgcn_readlane(dcur, 2 * j), d1 = __builtin_amdgcn_readlane(dcur, 2 * j + 1);
            if (t < NTOK) {
#pragma unroll
                for (int hf = 0; hf < 2; ++hf) { hw[j][hf] = *((const u32x4*)(H2B + (size_t)t * LDH + 512 * hf) + lane); y0[j][hf] = *((const u32x4*)(YB + (size_t)d0 * DM + 512 * hf) + lane); y1[j][hf] = *((const u32x4*)(YB + (size_t)d1 * DM + 512 * hf) + lane); } } }
#pragma unroll
        for (int j = 0; j < 4; ++j) { const int t = gw + (ib + j) * NGW;
            const float g0 = __builtin_bit_cast(float, __builtin_amdgcn_readlane(__builtin_bit_cast(int, gcur), 2 * j)), g1 = __builtin_bit_cast(float, __builtin_amdgcn_readlane(__builtin_bit_cast(int, gcur), 2 * j + 1));
            if (t < NTOK) { float v[16]; float s2 = 0.f;
#pragma unroll
                for (int hf = 0; hf < 2; ++hf)
#pragma unroll
                    for (int e = 0; e < 4; ++e) { const unsigned h = hw[j][hf][e], p = y0[j][hf][e], q = y1[j][hf][e];
                        const float lo = bflo(h) + g0 * bflo(p) + g1 * bflo(q), hi = bfhi(h) + g0 * bfhi(p) + g1 * bfhi(q); v[8 * hf + 2 * e] = lo; v[8 * hf + 2 * e + 1] = hi; s2 += lo * lo + hi * hi; }
                const float rstd = __builtin_amdgcn_rsqf(wave_sum(s2) * (1.0f / DM) + EPS);
#pragma unroll
                for (int q = 0; q < 4; ++q) { const f32x4 o = {v[4 * q] * rstd * gn[q][0], v[4 * q + 1] * rstd * gn[q][1], v[4 * q + 2] * rstd * gn[q][2], v[4 * q + 3] * rstd * gn[q][3]};
                    *(f32x4*)(outp + (size_t)t * DM + 512 * (q >> 1) + 8 * lane + 4 * (q & 1)) = o; } } }
    }
#undef FIN_IDX
}

#include <hip/hip_bf16.h>
#include <cmath>
namespace attn_body {
using bf16=__hip_bfloat16;
using bf16x8=__attribute__((ext_vector_type(8)))short;
using s16x4=__attribute__((ext_vector_type(4)))short;
using f32x16=__attribute__((ext_vector_type(16)))float;
using u32x4=__attribute__((ext_vector_type(4)))unsigned;
using f32x4_t=__attribute__((ext_vector_type(4)))float;
constexpr int BATCH=16,NHEAD=8,SEQ=2048,D=64,DM=NHEAD*D,DMO=1024;
constexpr int NW=8,QBLK=32,QB=QBLK*NW,KVBLK=64,NQB=SEQ/QB;
constexpr int ATTN_PITCH=DM, ATTN_UNIT_ROWS=QB;
__device__ __forceinline__ int crow(int r,int hi){return (r&3)+8*(r>>2)+4*hi;}
#define SBAR() __builtin_amdgcn_sched_barrier(0)
__device__ __forceinline__ void cmask(f32x16&p0,f32x16&p1,int jb,int qrel,int hi){
  const float NEG=-INFINITY; int kb=64*jb+4*hi; asm volatile("":"+v"(kb));
  #pragma unroll
  for(int r=0;r<16;++r){int kv=kb+(r&3)+8*(r>>2); if(kv>qrel)p0[r]=NEG; if(kv+32>qrel)p1[r]=NEG;}
}

constexpr int NSLOT=3, SLOTB=8192;
constexpr int LDS_K=0, LDS_V=NSLOT*SLOTB, LDS_WS=2*NSLOT*SLOTB, LDS_OST=LDS_WS+NW*64*4, LDS_BYTES=LDS_OST+NW*4096;
constexpr float C2=0.125f*1.4426950408889634f;
__device__ __forceinline__ void glds16(const char*sbase,unsigned voff,unsigned lds_dst){unsigned keep;
  asm volatile("s_nop 4\n\ts_mov_b32 %0, m0\n\ts_mov_b32 m0, %3\n\ts_nop 0\n\tglobal_load_lds_dwordx4 %1, %2\n\ts_mov_b32 m0, %0":"=&s"(keep):"v"(voff),"s"(sbase),"s"(lds_dst):"memory");}
__device__ __forceinline__ const char* uni_ptr(const void*p){const unsigned long long v=(unsigned long long)p;const unsigned lo=__builtin_amdgcn_readfirstlane((unsigned)v),hi=__builtin_amdgcn_readfirstlane((unsigned)(v>>32));return (const char*)(((unsigned long long)hi<<32)|lo);}
__device__ __forceinline__ float max3f(float a,float b,float c){float r;asm("v_max3_f32 %0, %1, %2, %3":"=v"(r):"v"(a),"v"(b),"v"(c));return r;}
__device__ __forceinline__ float max2f(float a,float b){float r;asm("v_max_f32_e32 %0, %1, %2":"=v"(r):"v"(a),"v"(b));return r;}
__device__ __forceinline__ float fadd_s(float a,float b){float r;asm("v_add_f32_e32 %0, %1, %2":"=v"(r):"v"(a),"v"(b));return r;}
__device__ __forceinline__ float fsub_s(float a,float b){float r;asm("v_sub_f32_e32 %0, %1, %2":"=v"(r):"v"(a),"v"(b));return r;}
typedef float f32x2_t __attribute__((ext_vector_type(2))); typedef __bf16 bf16x2_t __attribute__((ext_vector_type(2)));
__device__ __forceinline__ unsigned cvtpk_s(float lo,float hi){f32x2_t v={lo,hi};bf16x2_t b=__builtin_convertvector(v,bf16x2_t);return __builtin_bit_cast(unsigned,b);}
#define WAIT_BAR(N) asm volatile("s_waitcnt vmcnt(" #N ") lgkmcnt(0)\n\ts_barrier":::"memory")

__device__ __forceinline__ void qkt(f32x16&p0,f32x16&p1,const char*Kslot,const bf16x8*qr,const f32x16&negm,int r32,int hi){
  const char*kb=Kslot+hi*1024+r32*16;
  #pragma unroll
  for(int d0=0;d0<4;++d0){
    const bf16x8 b0=*reinterpret_cast<const bf16x8*>(kb+d0*2048);
    const bf16x8 b1=*reinterpret_cast<const bf16x8*>(kb+d0*2048+512);
    if(d0==0){p0=__builtin_amdgcn_mfma_f32_32x32x16_bf16(b0,qr[0],negm,0,0,0);p1=__builtin_amdgcn_mfma_f32_32x32x16_bf16(b1,qr[0],negm,0,0,0);}
    else{p0=__builtin_amdgcn_mfma_f32_32x32x16_bf16(b0,qr[d0],p0,0,0,0);p1=__builtin_amdgcn_mfma_f32_32x32x16_bf16(b1,qr[d0],p1,0,0,0);}}
}
typedef __attribute__((address_space(3))) const char* lds_cptr;
typedef short v4i16_t __attribute__((ext_vector_type(4)));
__device__ __forceinline__ void kload8(bf16x8*kf,lds_cptr kp){
  kf[0]=*(const __attribute__((address_space(3))) bf16x8*)(kp);      kf[1]=*(const __attribute__((address_space(3))) bf16x8*)(kp+512);
  kf[2]=*(const __attribute__((address_space(3))) bf16x8*)(kp+2048); kf[3]=*(const __attribute__((address_space(3))) bf16x8*)(kp+2560);
  kf[4]=*(const __attribute__((address_space(3))) bf16x8*)(kp+4096); kf[5]=*(const __attribute__((address_space(3))) bf16x8*)(kp+4608);
  kf[6]=*(const __attribute__((address_space(3))) bf16x8*)(kp+6144); kf[7]=*(const __attribute__((address_space(3))) bf16x8*)(kp+6656);
}
__device__ __forceinline__ void kload2(bf16x8*kf,lds_cptr kp,int j){ kf[2*j]=*(const __attribute__((address_space(3))) bf16x8*)(kp+j*2048); kf[2*j+1]=*(const __attribute__((address_space(3))) bf16x8*)(kp+j*2048+512); }
__device__ __forceinline__ s16x4 vtr(lds_cptr p){ return __builtin_bit_cast(s16x4,__builtin_amdgcn_ds_read_tr16_b64_v4i16((__attribute__((address_space(3))) v4i16_t*)p)); }
__device__ __forceinline__ float rowmax(const f32x16&p0,const f32x16&p1){
  float a=max3f(p0[0],p0[1],p1[0]),b=max3f(p0[2],p0[3],p1[1]);a=max3f(a,p1[2],p1[3]);
  #pragma unroll
  for(int r=4;r<16;r+=4){a=max3f(a,p0[r],p0[r+1]);b=max3f(b,p0[r+2],p0[r+3]);a=max3f(a,p1[r],p1[r+1]);b=max3f(b,p1[r+2],p1[r+3]);}
  const float m=max2f(a,b);
  auto rr=__builtin_amdgcn_permlane32_swap(__float_as_uint(m),__float_as_uint(m),false,false);
  return max2f(__uint_as_float(rr[0]),__uint_as_float(rr[1]));
}
__device__ __forceinline__ void pv(f32x16*o,int vb,bf16x8 pa0,bf16x8 pa1,bf16x8 pa2,bf16x8 pa3){
  #pragma unroll
  for(int d0=0;d0<2;++d0){s16x4 lo[4],hi[4];
    #pragma unroll
    for(int ks=0;ks<4;++ks){
      asm volatile("ds_read_b64_tr_b16 %0,%1 offset:%c2":"=&v"(lo[ks]):"v"(vb),"i"(d0*4096+ks*1024):"memory");
      asm volatile("ds_read_b64_tr_b16 %0,%1 offset:%c2":"=&v"(hi[ks]):"v"(vb),"i"(d0*4096+ks*1024+512):"memory");}
    asm volatile("s_waitcnt lgkmcnt(0)":::"memory");SBAR();
    #define PK(k) (bf16x8){lo[k][0],lo[k][1],lo[k][2],lo[k][3],hi[k][0],hi[k][1],hi[k][2],hi[k][3]}
    o[d0]=__builtin_amdgcn_mfma_f32_32x32x16_bf16(pa0,PK(0),o[d0],0,0,0);
    o[d0]=__builtin_amdgcn_mfma_f32_32x32x16_bf16(pa1,PK(1),o[d0],0,0,0);
    o[d0]=__builtin_amdgcn_mfma_f32_32x32x16_bf16(pa2,PK(2),o[d0],0,0,0);
    o[d0]=__builtin_amdgcn_mfma_f32_32x32x16_bf16(pa3,PK(3),o[d0],0,0,0);
    #undef PK
  }
}

#ifndef ATTN_STORE16
#define ATTN_STORE16(p,v) (*(u32x4*)(p)=(v))
#endif
template<int THRL> __device__ __forceinline__ void attn_unit(int b,int h,int qb,const bf16*Q,const bf16*__restrict__ K,const bf16*__restrict__ V,bf16*O,const float*__restrict__ KSUM,float*__restrict__ SSQA,char*shm){
  int tid=threadIdx.x; asm volatile("":"+v"(tid));
  const int lane=tid&63,r32=lane&31,hi=lane>>5; const int wid=__builtin_amdgcn_readfirstlane(tid>>6);
  const long rowbase=(long)b*SEQ; const int q0=qb*QB;
  const bf16*Qw=Q+(rowbase+q0+wid*QBLK)*DM+h*D;
  const bf16*Kh=K+rowbase*DM+h*D,*Vh=V+rowbase*DM+h*D;
  const unsigned lds0=(unsigned)(uintptr_t)shm;
  float*wsf=(float*)(shm+LDS_WS)+wid*64;
  const char*Khu=uni_ptr(Kh);const char*Vhu=uni_ptr(Vh);
  const unsigned kvo=(unsigned)(lane*DM+wid*8)*2u;
  const unsigned vvo=(unsigned)((16*(wid&3)+(lane>>2))*DM+(wid>>2)*32+(lane&3)*8)*2u;
  const unsigned kdst=lds0+LDS_K+wid*1024, vdst=lds0+LDS_V+wid*1024;
  #define DMA_K(t,slot) glds16(Khu+(size_t)(t)*(KVBLK*DM*2),kvo,(unsigned)__builtin_amdgcn_readfirstlane(kdst+(slot)))
  #define DMA_V(t,slot) glds16(Vhu+(size_t)(t)*(KVBLK*DM*2),vvo,(unsigned)__builtin_amdgcn_readfirstlane(vdst+(slot)))
  const int vb0=(int)(lds0+LDS_V)+((lane>>4)&1)*32+(lane&3)*8+(4*hi+((lane&15)>>2))*64;
  const char*Kbase=shm+LDS_K; bf16x8 kf[8];
  const lds_cptr shm3=(lds_cptr)shm; const lds_cptr kp0=shm3+LDS_K+hi*1024+r32*16; const lds_cptr vp0=shm3+LDS_V+((lane>>4)&1)*32+(lane&3)*8+(4*hi+((lane&15)>>2))*64;
  const int NT=(q0+QB)/KVBLK;
  DMA_K(0,0);DMA_V(0,0);DMA_K(1,SLOTB);
  bf16x8 qr[4];
  #pragma unroll
  for(int d0=0;d0<4;++d0)qr[d0]=*reinterpret_cast<const bf16x8*>(&Qw[(long)r32*DM+d0*16+hi*8]);
  unsigned selm=1u<<qb;
  { float g[8];
    #pragma unroll
    for(int n=0;n<8;++n){ g[n]=-INFINITY;
      if(n<qb){ const float*ks=KSUM+(long)(b*8+n)*DM+h*D+hi*8; float s=0.f;
        #pragma unroll
        for(int d0=0;d0<4;++d0){ const f32x4_t k0=*reinterpret_cast<const f32x4_t*>(ks+d0*16), k1=*reinterpret_cast<const f32x4_t*>(ks+d0*16+4);
          const u32x4 qw=__builtin_bit_cast(u32x4,qr[d0]);
          s+=__uint_as_float(qw[0]<<16)*k0[0]+__uint_as_float(qw[0]&0xffff0000u)*k0[1]+__uint_as_float(qw[1]<<16)*k0[2]+__uint_as_float(qw[1]&0xffff0000u)*k0[3]
            +__uint_as_float(qw[2]<<16)*k1[0]+__uint_as_float(qw[2]&0xffff0000u)*k1[1]+__uint_as_float(qw[3]<<16)*k1[2]+__uint_as_float(qw[3]&0xffff0000u)*k1[3]; }
        s+=__shfl_xor(s,32); g[n]=s; } }
    const int npick=qb<3?qb:3;
    for(int p=0;p<npick;++p){ int best=-1; float bv=-INFINITY;
      #pragma unroll
      for(int n=0;n<8;++n){ const bool ok=(n<qb)&&!((selm>>n)&1u)&&(best<0||g[n]>bv); if(ok){best=n;bv=g[n];} }
      if(best>=0)selm|=1u<<best; } }
  #define BMASK(P0,P1,t) do{ float bias_=((selm>>((t)>>2))&1u)?-mhat:-INFINITY; asm volatile("":"+v"(bias_)); _Pragma("unroll") for(int r=0;r<16;++r){P0[r]+=bias_;P1[r]+=bias_;} }while(0)
  float mhat=0.f,l_reg=0.f;f32x16 o[2];{float z0_=0.f;asm volatile("":"+v"(z0_));_Pragma("unroll") for(int r=0;r<16;++r){o[0][r]=z0_;o[1][r]=z0_;}}const f32x16 negm=f32x16{};
  const int qrel=wid*QBLK+r32;
  #define CMASK(P0,P1,t) do{int jb_=(t)-(NT-4); if(jb_>=0)cmask(P0,P1,jb_,qrel,hi);}while(0)
  bool resc=false;
  #define START(P0,P1) do{ const float rm=__builtin_fmaxf(rowmax(P0,P1),-100.0f); resc=false; \
    { const float dl=rm; mhat=fadd_s(mhat,dl); \
      _Pragma("unroll") for(int r=0;r<16;++r){P0[r]=fsub_s(P0[r],dl);P1[r]=fsub_s(P1[r],dl);} \
      } \
    _Pragma("unroll") for(int r=0;r<16;++r)P0[r]=__builtin_amdgcn_exp2f(P0[r]); }while(0)
  #define RESC() do{ if(resc){ asm volatile("s_waitcnt lgkmcnt(0)":::"memory"); \
      _Pragma("unroll") for(int d_=0;d_<2;++d_) _Pragma("unroll") for(int r=0;r<16;++r)o[d_][r]*=wsf[crow(r,hi)]; } }while(0)
  f32x16 pA0,pA1,pB0,pB1;
  int sl_prev=0,sl_cur=0,sl_next=SLOTB;
  #define ROT() do{sl_prev=sl_cur;sl_cur=sl_next;sl_next=(sl_next==(NSLOT-1)*SLOTB)?0:sl_next+SLOTB;}while(0)
  DMA_K(2,2*SLOTB);
  WAIT_BAR(3);
  qkt(pA0,pA1,Kbase,qr,negm,r32,hi);asm volatile("s_nop 15\n\ts_nop 7":"+v"(pA0),"+v"(pA1));CMASK(pA0,pA1,0);BMASK(pA0,pA1,0);
  START(pA0,pA1);
  _Pragma("unroll") for(int r=0;r<16;++r)pA1[r]=__builtin_amdgcn_exp2f(pA1[r]);
  WAIT_BAR(0);
  DMA_K(3,0);DMA_V(1,SLOTB);
  ROT();
  kload8(kf,kp0+sl_cur);
  WAIT_BAR(2);
  s16x4 vlo[8],vhi[8]; u32x4 pw0,pw1,pw2,pw3;
  #define PKW(P,B) cvtpk_s(P[B],P[B+1])
  #define PAF(k) __builtin_bit_cast(bf16x8,pw##k)
  #define VFR(i) (bf16x8){vlo[i][0],vlo[i][1],vlo[i][2],vlo[i][3],vhi[i][0],vhi[i][1],vhi[i][2],vhi[i][3]}
  #define PIN(x) asm volatile("":"+v"(x))
  #define MX3(a,b,c) __builtin_fmaxf(__builtin_fmaxf((a),(b)),(c))
  #define GAPA(MF,A0,A1,A2,A3,W0,W1,PW) do{ MF; sacc+=A0; sacc+=A1; sacc+=A2; sacc+=A3; PIN(sacc); W0; W1; PIN(PW); SBAR(); }while(0)
  #define EX(v) __builtin_amdgcn_exp2f(v)
  #define GAPB(MF,X,B) do{ MF; X[B]=EX(X[B]); X[B+1]=EX(X[B+1]); X[B+2]=EX(X[B+2]); X[B+3]=EX(X[B+3]); PIN(X); SBAR(); }while(0)
  #define VRD(i) do{ vlo[i]=vtr(vp_+(((i)>>2)*4096+((i)&3)*1024)); vhi[i]=vtr(vp_+(((i)>>2)*4096+((i)&3)*1024+512)); }while(0)
  #define KRD(G,j) do{ if(G){ kload2(kf,kp0+sl_next,j); SBAR(); } }while(0)
  #define STEP(C0,C1,P0,P1,t,GK,GV,GL) do{ SBAR(); \
    const lds_cptr vp_=vp0+sl_prev; \
    VRD(0); SBAR(); float sacc=(P0[0]+P0[1]); \
    GAPA(C0=__builtin_amdgcn_mfma_f32_32x32x16_bf16(kf[0],qr[0],negm,0,0,0), P0[2],P0[3],P0[4],P0[5],     pw0[0]=PKW(P0,0), pw0[1]=PKW(P0,2), pw0); \
    VRD(4); SBAR(); GAPA(C1=__builtin_amdgcn_mfma_f32_32x32x16_bf16(kf[1],qr[0],negm,0,0,0), P0[6],P0[7],P0[8],P0[9],     pw0[2]=PKW(P0,4), pw0[3]=PKW(P0,6), pw0); \
    VRD(1); SBAR(); GAPA(C0=__builtin_amdgcn_mfma_f32_32x32x16_bf16(kf[2],qr[1],C0,0,0,0),   P0[10],P0[11],P0[12],P0[13], pw1[0]=PKW(P0,8), pw1[1]=PKW(P0,10), pw1); \
    VRD(5); SBAR(); GAPA(C1=__builtin_amdgcn_mfma_f32_32x32x16_bf16(kf[3],qr[1],C1,0,0,0),   P0[14],P0[15],P1[0],P1[1],   pw1[2]=PKW(P0,12),pw1[3]=PKW(P0,14), pw1); \
    VRD(2); SBAR(); GAPA(C0=__builtin_amdgcn_mfma_f32_32x32x16_bf16(kf[4],qr[2],C0,0,0,0),   P1[2],P1[3],P1[4],P1[5],     pw2[0]=PKW(P1,0), pw2[1]=PKW(P1,2), pw2); \
    VRD(6); SBAR(); GAPA(C1=__builtin_amdgcn_mfma_f32_32x32x16_bf16(kf[5],qr[2],C1,0,0,0),   P1[6],P1[7],P1[8],P1[9],     pw2[2]=PKW(P1,4), pw2[3]=PKW(P1,6), pw2); \
    VRD(3); SBAR(); GAPA(C0=__builtin_amdgcn_mfma_f32_32x32x16_bf16(kf[6],qr[3],C0,0,0,0),   P1[10],P1[11],P1[12],P1[13], pw3[0]=PKW(P1,8), pw3[1]=PKW(P1,10), pw3); \
    VRD(7); SBAR(); GAPA(C1=__builtin_amdgcn_mfma_f32_32x32x16_bf16(kf[7],qr[3],C1,0,0,0),   P1[14],P1[15],0.f,0.f,       pw3[2]=PKW(P1,12),pw3[3]=PKW(P1,14), pw3); \
    l_reg+=sacc; \
    if(GK){DMA_K((t)+3,sl_cur);} if(GV){DMA_V((t)+1,sl_next);} \
    CMASK(C0,C1,t); BMASK(C0,C1,t); \
    { float a=MX3(C0[0],C0[1],C1[0]),b=MX3(C0[2],C0[3],C1[1]); a=MX3(a,C1[2],C1[3]); \
      _Pragma("unroll") for(int r=4;r<16;r+=4){a=MX3(a,C0[r],C0[r+1]);b=MX3(b,C0[r+2],C0[r+3]);a=MX3(a,C1[r],C1[r+1]);b=MX3(b,C1[r+2],C1[r+3]);} \
      float rm=__builtin_fmaxf(a,b); { auto rr=__builtin_amdgcn_permlane32_swap(__float_as_uint(rm),__float_as_uint(rm),false,false); rm=__builtin_fmaxf(__uint_as_float(rr[0]),__uint_as_float(rr[1])); } \
      resc=false; \
      if(__builtin_expect(__any(rm>(float)THRL),0)){ const float dl=__builtin_fmaxf(rm,0.f); mhat+=dl; \
        _Pragma("unroll") for(int r=0;r<16;++r){C0[r]-=dl;C1[r]-=dl;} \
        const float f=__builtin_amdgcn_exp2f(-dl); l_reg*=f; if(hi==0)wsf[r32]=f; resc=true; } } \
    SBAR(); \
    GAPB(o[0]=__builtin_amdgcn_mfma_f32_32x32x16_bf16(PAF(0),VFR(0),o[0],0,0,0), C0,0); \
    GAPB(o[1]=__builtin_amdgcn_mfma_f32_32x32x16_bf16(PAF(0),VFR(4),o[1],0,0,0), C0,4); \
    KRD(GL,0); GAPB(o[0]=__builtin_amdgcn_mfma_f32_32x32x16_bf16(PAF(1),VFR(1),o[0],0,0,0), C0,8); \
    KRD(GL,1); GAPB(o[1]=__builtin_amdgcn_mfma_f32_32x32x16_bf16(PAF(1),VFR(5),o[1],0,0,0), C0,12); \
    KRD(GL,2); GAPB(o[0]=__builtin_amdgcn_mfma_f32_32x32x16_bf16(PAF(2),VFR(2),o[0],0,0,0), C1,0); \
    KRD(GL,3); GAPB(o[1]=__builtin_amdgcn_mfma_f32_32x32x16_bf16(PAF(2),VFR(6),o[1],0,0,0), C1,4); \
    GAPB(o[0]=__builtin_amdgcn_mfma_f32_32x32x16_bf16(PAF(3),VFR(3),o[0],0,0,0), C1,8); \
    GAPB(o[1]=__builtin_amdgcn_mfma_f32_32x32x16_bf16(PAF(3),VFR(7),o[1],0,0,0), C1,12); \
    }while(0)
  int t=1;
  #undef CMASK
  #define CMASK(P0,P1,t) do{}while(0)
  for(;t+5<NT;t+=2){
    STEP(pB0,pB1,pA0,pA1,t,true,true,true);     WAIT_BAR(2); RESC(); ROT();
    STEP(pA0,pA1,pB0,pB1,t+1,true,true,true);   WAIT_BAR(2); RESC(); ROT();
  }
  #undef CMASK
  #define CMASK(P0,P1,t) do{int jb_=(t)-(NT-4); if(jb_>=0)cmask(P0,P1,jb_,qrel,hi);}while(0)
  #define ENDW(tt) do{ if((tt)+3<NT){WAIT_BAR(2);} else if((tt)+2<NT){WAIT_BAR(1);} else {WAIT_BAR(0);} }while(0)
  for(;t+1<NT;t+=2){
    STEP(pB0,pB1,pA0,pA1,t,(t+3<NT),(t+1<NT),(t+1<NT));       ENDW(t);   RESC(); ROT();
    STEP(pA0,pA1,pB0,pB1,t+1,(t+4<NT),(t+2<NT),(t+2<NT));     ENDW(t+1); RESC(); ROT();
  }
  STEP(pB0,pB1,pA0,pA1,NT-1,false,false,false); RESC();
  { float sacc=pB0[0]+pB0[1]; _Pragma("unroll") for(int r=2;r<16;++r)sacc+=pB0[r]; _Pragma("unroll") for(int r=0;r<16;++r)sacc+=pB1[r]; l_reg+=sacc;
    pw0=(u32x4){PKW(pB0,0),PKW(pB0,2),PKW(pB0,4),PKW(pB0,6)};pw1=(u32x4){PKW(pB0,8),PKW(pB0,10),PKW(pB0,12),PKW(pB0,14)};pw2=(u32x4){PKW(pB1,0),PKW(pB1,2),PKW(pB1,4),PKW(pB1,6)};pw3=(u32x4){PKW(pB1,8),PKW(pB1,10),PKW(pB1,12),PKW(pB1,14)};
    SBAR(); pv(o,vb0+sl_cur,PAF(0),PAF(1),PAF(2),PAF(3)); }
  #undef PKW
  #undef PAF
  #undef VFR
  #undef PIN
  #undef MX3
  #undef GAPA
  #undef GAPB
  #undef EX
  #undef VRD
  #undef KRD
  #undef STEP
  #undef ENDW
  {auto rr=__builtin_amdgcn_permlane32_swap(__float_as_uint(l_reg),__float_as_uint(l_reg),false,false);l_reg=__uint_as_float(rr[0])+__uint_as_float(rr[1]);}
  if(hi==0)wsf[32+r32]=l_reg;asm volatile("s_waitcnt lgkmcnt(0)":::"memory");
  float rli[16];
  #pragma unroll
  for(int r=0;r<16;++r)rli[r]=__builtin_amdgcn_rcpf(wsf[32+crow(r,hi)]);
  bf16*Ow=O+(rowbase+q0+wid*QBLK)*DMO+h*D;
  { bf16*stg=(bf16*)(shm+LDS_OST)+wid*2048;
    #pragma unroll
    for(int r=0;r<16;++r){const int orow=crow(r,hi);
      #pragma unroll
      for(int d0=0;d0<2;++d0)stg[orow*64+d0*32+r32]=__float2bfloat16(o[d0][r]*rli[r]);}
    asm volatile("s_waitcnt lgkmcnt(0)":::"memory");
    #pragma unroll
    for(int i=0;i<4;++i){const int row=i*8+(lane>>3),ch=lane&7; const u32x4 v=*(const u32x4*)(stg+row*64+ch*8); ATTN_STORE16(Ow+(long)row*DMO+ch*8,v);
      float q=0.f;
      #pragma unroll
      for(int e=0;e<4;++e){const float lo=__uint_as_float(v[e]<<16),hi2=__uint_as_float(v[e]&0xffff0000u);q+=lo*lo+hi2*hi2;}
      q+=__shfl_xor(q,1);q+=__shfl_xor(q,2);q+=__shfl_xor(q,4);
      if(ch==0)SSQA[(rowbase+q0+wid*QBLK+row)*8+h]=q;} }
  asm volatile("s_waitcnt lgkmcnt(0)\n\ts_barrier":::"memory");
  #undef BMASK
  #undef DMA_K
  #undef DMA_V
  #undef CMASK
  #undef START
  #undef RESC
  #undef ROT
}
constexpr int ATTN_LDS_BYTES=LDS_BYTES;
#undef SBAR
#undef WAIT_BAR
}

#ifndef STAG_TICKS
#define STAG_TICKS 100
#endif
__device__ __forceinline__ void stagger(int c, int ticks) {
    const unsigned long long t0 = __builtin_amdgcn_s_memrealtime(); const unsigned long long w = (unsigned long long)(((c >> 3) & 3) * ticks);
    while (__builtin_amdgcn_s_memrealtime() - t0 < w) __builtin_amdgcn_s_sleep(8);
}
__global__ void __launch_bounds__(512, 2) mk_fwd(Args args) {
    extern __shared__ __attribute__((aligned(16))) unsigned char lds_raw[];
    Ctx C; C.lds = (LAS unsigned char*)lds_raw; C.tid = threadIdx.x; C.lane = C.tid & 63; C.wave = __builtin_amdgcn_readfirstlane(C.tid >> 6);
    C.G = gridDim.x; { const int bx = blockIdx.x; C.vcu = (C.G % 8 == 0) ? (bx % 8) * (C.G / 8) + bx / 8 : bx; }
    unsigned char* ws = args.ws;
    for (int u = C.tid; u < (LDS_BYTES - LDSCTL_OFF) / 4; u += 512) ((LAS unsigned*)(C.lds + LDSCTL_OFF))[u] = 0u;
    __syncthreads();
    XcdBarrier bar; bar.bar = (unsigned*)(ws + WS_CTL) + CW_BAR; bar.x = 0; bar.st = nullptr;
    if (N_LAUNCHES == 1) bar = xcd_barrier_post((unsigned*)(ws + WS_CTL) + CW_BAR, (volatile LAS unsigned*)(C.lds + MISC_OFF) + 8);
    const int lo = args.ph_lo, hi = args.ph_hi;
#ifndef PH_MASK
#define PH_MASK 0x3fff
#endif
#define IN(k) ((((PH_MASK) >> (k)) & 1) && lo <= (k) && (k) < hi)
#ifndef PROBE_REP
#define PROBE_REP -1
#endif
#define REP(k) for (int rep_ = 0; rep_ < ((PROBE_REP == (k)) ? 2 : 1); ++rep_)
#define REPBAR() do { if (rep_ > 0) xcd_barrier(bar); } while (0)
#define FRESH() do { int t_ = threadIdx.x; asm volatile("" : "+v"(t_)); C.tid = t_; C.lane = t_ & 63; C.wave = __builtin_amdgcn_readfirstlane(t_ >> 6); } while (0)
#define SEAM(k) do { if (IN(k) && IN((k) + 1)) xcd_barrier(bar); } while (0)
    const int cb = (int)blockIdx.x;

    if (IN(0)) REP(0) { REPBAR(); FRESH(); ph_prologue(args, C); SEAM(0); }
    if (PROBE_REP == 200) { for (int xb_ = 0; xb_ < 8; ++xb_) xcd_barrier(bar); }
    if (IN(1)) REP(1) { REPBAR();
        { Gemm g{(const bf16_t*)(ws + WS_B), (const bf16_t*)(ws + WS_WIN), DM, DM, DM}; PlainOrder S; S.init(NTOK, DIN, C.G, cb, DM, DM);
          EpiProj E{(bf16_t*)(ws + WS_A), (const float*)(ws + WS_ROPE), (float*)(ws + WS_KSUM)}; GEMM_PHASE(C.lds, g, S, E); }
        { Gemm g{(const bf16_t*)(ws + WS_MEMN), (const bf16_t*)(ws + WS_WXK), DM, DM, DM}; PlainOrder S; S.init(NMEM, DM, C.G, cb, DM, DM);
          EpiStore E{(bf16_t*)(ws + WS_KM), DM}; GEMM_PHASE(C.lds, g, S, E); }
        { Gemm g{(const bf16_t*)(ws + WS_MEMN), (const bf16_t*)(ws + WS_WXV), DM, DM, DM}; PlainOrder S; S.init(NMEM, DM, C.G, (cb + C.G - 64 % C.G) % C.G, DM, DM);
          EpiStore E{(bf16_t*)(ws + WS_VMT), DM}; GEMM_PHASE(C.lds, g, S, E); }
        { FRESH(); if (C.G == 256) { if (cb >= 128) conv_wdn(args, C, (cb - 128) * 8 + C.wave, 128 * 8, 0, WDN_SPLIT); }
          else conv_wdn(args, C, C.vcu * 8 + C.wave, C.G * 8, 0, WDN_SPLIT); }
        SEAM(1);
    }
    if (IN(2)) REP(2) { REPBAR(); FRESH();
        for (int lrep_ = 0; lrep_ < ((PROBE_REP == 102) ? 2 : 1); ++lrep_)
        for (int L = C.vcu; L < 256; L += C.G) lru_unit(args, C, L >> 4, (L >> 1) & 7, L & 1);
        for (int arep_ = 0; arep_ < ((PROBE_REP == 103) ? 2 : 1); ++arep_)
        for (int i = 0;; ++i) { const int aidx = i * C.G + C.vcu; if (aidx >= 1024) break; const int cc = aidx & 255, ii = aidx >> 8, bh = cc >> 1;
            const int qb = (cc & 1) ? ((ii == 0) ? 6 : (ii == 1) ? 1 : (ii == 2) ? 5 : 2) : ((ii == 0) ? 7 : (ii == 1) ? 0 : (ii == 2) ? 4 : 3);
#ifdef ATTN_SIMPLE
            moba_unit_simple(args, C, bh >> 3, bh & 7, qb); }
#else
            { const attn_body::bf16* Qp = (const attn_body::bf16*)(ws + WS_A) + (size_t)2 * NTOK * 512;
              attn_body::attn_unit<8>(bh >> 3, bh & 7, qb, Qp, Qp + (size_t)NTOK * 512, Qp + (size_t)2 * NTOK * 512, (attn_body::bf16*)(ws + WS_C) + 512, (const float*)(ws + WS_KSUM), (float*)(ws + WS_SSQA), (char*)lds_raw); } }
#endif
        SEAM(2);
    }
    if (IN(4)) REP(4) { REPBAR(); Gemm g{(const bf16_t*)(ws + WS_C), (const bf16_t*)(ws + WS_WOUT), DM, DM, DM}; PlainOrder S; S.init(NTOK, DM, C.G, cb, DM, DM);
        EpiResid<true, true> E{args.in[0], (bf16_t*)args.out, (float*)(ws + WS_SSQ1), (const float*)(ws + WS_SSQL), (const float*)(ws + WS_SSQA), nullptr}; GEMM_PHASE(C.lds, g, S, E);
        { Gemm g2{(const bf16_t*)(ws + WS_KM), (const bf16_t*)(ws + WS_WXQ), DM, DM, XHD}; XpreOrder S2{C.G, cb, 0}; EpiStore E2{(bf16_t*)(ws + WS_A), DM}; GEMM_PHASE(C.lds, g2, S2, E2); }
        { Gemm g3{(const bf16_t*)(ws + WS_WXO), (const bf16_t*)(ws + WS_VMT), DM, DM, XHD}; XpreOrder S3{C.G, cb, 1}; EpiStore E3{(bf16_t*)(ws + WS_A) + (size_t)32 * MiB / 2, DM}; GEMM_PHASE(C.lds, g3, S3, E3); }
        SEAM(4); }
    if (IN(5)) REP(5) { REPBAR(); Gemm g{(const bf16_t*)args.out, (const bf16_t*)(ws + WS_A), LDH, DM, DM}; XattnOrder S{C.G, cb, 0, LDH};
        EpiSoftmax E{(bf16_t*)(ws + WS_B), DM, C.lds + LDSCTL_OFF + 4096, (const float*)(ws + WS_SSQ1), XSCALE}; GEMM_PHASE(C.lds, g, S, E); SEAM(5); }
    if (IN(8)) REP(8) { REPBAR(); Gemm g{(const bf16_t*)(ws + WS_B), (const bf16_t*)(ws + WS_A) + (size_t)32 * MiB / 2, DM, DM, DM}; XattnOrder S{C.G, cb, 1, DM};
        EpiResid<false, false> E{(const bf16_t*)args.out, (bf16_t*)args.out + DM, (float*)(ws + WS_SSQ2), nullptr, nullptr, ws + WS_H2F8}; GEMM_PHASE(C.lds, g, S, E); SEAM(8); }
    if (IN(9)) REP(9) { REPBAR(); FRESH(); ph_router(args, C); SEAM(9); }
    if (IN(11)) REP(11) { REPBAR(); FRESH(); moe_table(args, C); Gemm g{(const bf16_t*)(ws + WS_H2F8), (const bf16_t*)(ws + WS_WGU), DM / 2, DM / 2, DM / 2};
        MoeOrder<true> S{(const LAS int*)(C.lds + MOE_OFF), C.G, cb, DM / 2, DM / 2, (const int*)(ws + WS_LTOK), (unsigned)DM};
        EpiGateUp E{ws + WS_B, (const float*)(ws + WS_LRS)}; GEMM_PHASE8(C.lds, g, S, E); SEAM(11); }
    if (IN(12)) REP(12) { REPBAR(); FRESH(); moe_table(args, C); Gemm g{(const bf16_t*)(ws + WS_B), (const bf16_t*)(ws + WS_WDN), DFF / 2, DFF / 2, DFF / 2};
        MoeOrder<false> S{(const LAS int*)(C.lds + MOE_OFF), C.G, cb, DFF / 2, DFF / 2, nullptr, 0u};
        if (PROBE_REP == 312) { EpiNull EN{}; GEMM_PHASE8(C.lds, g, S, EN); xcd_barrier(bar); }
        EpiStore E{(bf16_t*)(ws + WS_A), DM, 1.0f / (WDN_SC * ACT_SC)}; GEMM_PHASE8(C.lds, g, S, E); SEAM(12); }
    if (IN(13)) REP(13) { REPBAR(); FRESH(); moe_table(args, C); ph_final(args, C, (PROBE_REP == 13 && rep_ == 0) ? (float*)(ws + WS_B) : args.out); }
#undef IN
#undef FRESH
#undef SEAM
}

extern "C" void kernel_launch(void* const* d_in, const int* in_sizes, int n_in, void* d_out, int out_size, void* d_ws, size_t ws_size, hipStream_t stream) {
    static int grid = 0;
    if (grid == 0) {
        if (n_in != 27 || out_size != NTOK * DM || ws_size < WS_END) { fprintf(stderr, "kernel_launch: unexpected shapes (n_in %d out %d ws %zu)\n", n_in, out_size, ws_size); grid = -1; return; }
        int dev = 0, cus = 0, per_cu = 0;
        if (hipGetDevice(&dev) != hipSuccess || hipDeviceGetAttribute(&cus, hipDeviceAttributeMultiprocessorCount, dev) != hipSuccess) { grid = -1; return; }
        if (hipFuncSetAttribute((const void*)mk_fwd, hipFuncAttributeMaxDynamicSharedMemorySize, LDS_BYTES) != hipSuccess) { fprintf(stderr, "kernel_launch: hipFuncSetAttribute failed\n"); grid = -1; return; }
        if (hipOccupancyMaxActiveBlocksPerMultiprocessor(&per_cu, (const void*)mk_fwd, 512, LDS_BYTES) != hipSuccess || per_cu < 1) fprintf(stderr, "kernel_launch: occupancy query reports %d\n", per_cu);
        (void)hipGetLastError();
        grid = cus;
    }
    if (grid < 0) return;
    (void)hipMemsetAsync((char*)d_ws + WS_CTL, 0, CTL_ZERO_BYTES, stream);
    Args a{};
    for (int i = 0; i < 27; ++i) a.in[i] = (const float*)d_in[i];
    a.out = (float*)d_out; a.ws = (unsigned char*)d_ws;
    const float invf[8] = {1.0f, 0.1939227432012558f, 0.03760603070259094f, 0.007292664609849453f, 0.0014142135623842478f, 0.00027424818836152554f, 5.318296098266728e-05f, 1.0313386155758053e-05f};
    for (int i = 0; i < 8; ++i) a.invf[i] = invf[i];
    if (N_LAUNCHES == 1) { a.ph_lo = 0; a.ph_hi = N_PHASES; hipLaunchKernelGGL(mk_fwd, dim3(grid), dim3(512), LDS_BYTES, stream, a); }
    else for (int p = 0; p < N_PHASES; ++p) { a.ph_lo = p; a.ph_hi = p + 1; hipLaunchKernelGGL(mk_fwd, dim3(grid), dim3(512), LDS_BYTES, stream, a); }
}
```

```cpp
#include <hip/hip_runtime.h>
#include <cstdio>
#include <cstdint>

#define LAS __attribute__((address_space(3)))
#define GAS __attribute__((address_space(1)))
typedef unsigned short bf16_t;
typedef short bf16x8 __attribute__((ext_vector_type(8)));
typedef float f32x4 __attribute__((ext_vector_type(4)));
typedef float f32x2 __attribute__((ext_vector_type(2)));
typedef unsigned u32x4 __attribute__((ext_vector_type(4)));
typedef unsigned u32x2 __attribute__((ext_vector_type(2)));

#ifndef MK_N_LAUNCHES
#define MK_N_LAUNCHES 1
#endif
constexpr int N_PHASES = 14;
constexpr int N_LAUNCHES = MK_N_LAUNCHES;

constexpr int BATCH = 16, SEQ = 2048, DM = 1024, NTOK = BATCH * SEQ;
constexpr int DLRU = 512, DATT = 512, DIN = 2560, NHEAD = 8, HD = 64, NBLK = 8, MBLK = 256;
constexpr int MEMLEN = 256, NXH = 4, XHD = 256, NMEM = BATCH * MEMLEN;
constexpr int NEXP = 32, EPG = 8, NGRP = 4, DFF = 512;
constexpr float EPS = 1e-6f;
constexpr float QKT_SC = 8.0f, VWT_SC = 8.0f, PX_SC = 256.0f;
constexpr float WGU_SC = 64.0f, WDN_SC = 32.0f, ACT_SC = 16.0f;
constexpr int WDN_SPLIT = 3072;
constexpr int MAXTILES = 288, LCAP = 65536, LDH = 2048;
constexpr float QSCALE = 0.125f * 1.4426950408889634f;
constexpr float XSCALE = 0.0625f * 1.4426950408889634f;

constexpr size_t MiB = 1u << 20;
constexpr size_t WS_CTL = 0, CTL_ZERO_BYTES = 1 * MiB;
constexpr int CW_TMO = 0, CW_BAR = 4096, CW_CNT = 8192;
constexpr size_t WS_KSUM = 512 * 1024;
constexpr size_t WS_WIN = 2 * MiB, WS_WXK = 7 * MiB, WS_WXV = 9 * MiB, WS_WOUT = 11 * MiB, WS_WXQ = 13 * MiB, WS_WXO = 15 * MiB;
constexpr size_t WS_WR = 17 * MiB, WS_ROPE = 18 * MiB, WS_SSQ1 = 19 * MiB, WS_SSQ2 = 21 * MiB, WS_TOK = 23 * MiB, WS_RSC = 24 * MiB;
constexpr size_t WS_MEMN = 25 * MiB, WS_KM = 33 * MiB, WS_VMT = 41 * MiB, WS_WGU = 49 * MiB, WS_WDN = 113 * MiB;
constexpr size_t WS_A = 145 * MiB, WS_B = 305 * MiB, WS_C = 385 * MiB, WS_SSQL = 449 * MiB, WS_SSQA = 451 * MiB, WS_LTOK = 452 * MiB, WS_LRS = 460 * MiB, WS_H2F8 = 468 * MiB, WS_END = 500 * MiB;
constexpr size_t TOK_E = 0, TOK_R = 256 * 1024, TOK_G = 512 * 1024, TOK_D = 768 * 1024;

constexpr int RING_BYTES = 131072;
constexpr int LDSCTL_OFF = RING_BYTES, MISC_OFF = LDSCTL_OFF + 320, MOE_OFF = LDSCTL_OFF + 1024;
constexpr int LDS_BYTES = 147456;

__device__ __forceinline__ unsigned cvt_pk_bf16(float lo, float hi) { unsigned r; asm volatile("v_cvt_pk_bf16_f32 %0, %1, %2" : "=v"(r) : "v"(lo), "v"(hi)); return r; }
__device__ __forceinline__ float bflo(unsigned w) { return __uint_as_float(w << 16); }
__device__ __forceinline__ float bfhi(unsigned w) { return __uint_as_float(w & 0xffff0000u); }
__device__ __forceinline__ float bf2f(bf16_t b) { return __uint_as_float((unsigned)b << 16); }
__device__ __forceinline__ float wave_sum(float v) {
#pragma unroll
    for (int o = 1; o < 64; o <<= 1) v += __shfl_xor(v, o);
    return v;
}
#define LDS_WAIT() asm volatile("s_waitcnt lgkmcnt(0)" ::: "memory")
__device__ __forceinline__ float sigmoidf_(float x) { return __builtin_amdgcn_rcpf(1.0f + __builtin_amdgcn_exp2f(x * -1.4426950408889634f)); }

#define XB_TMO      128
#define XB_XCNT(j)  (256  + 64 * (j))
#define XB_XSUB(j)  (1280 + 64 * (j))
#define XB_XGEN(j)  (2304 + 64 * (j))
#define XB_TOP      3328
#define XB_TOPGEN   3392
#define XCD_BAR_WORDS 3456
#define XB_SPIN_CAP (1u << 18)
__device__ __forceinline__ unsigned xb_ld(unsigned* p)              { return __hip_atomic_load(p, __ATOMIC_RELAXED, __HIP_MEMORY_SCOPE_AGENT); }
__device__ __forceinline__ unsigned xb_add(unsigned* p, unsigned v) { return __hip_atomic_fetch_add(p, v, __ATOMIC_RELAXED, __HIP_MEMORY_SCOPE_AGENT); }
__device__ __forceinline__ unsigned xb_xcc_id() { return (unsigned)__builtin_amdgcn_s_getreg((3 << 11) | 20) & 0xFu; }
#define XB_SPIN(cond, bar) do { unsigned _sp = 0; while (cond) { __builtin_amdgcn_s_sleep(1); \
    if ((++_sp & 255u) == 0u) { if (xb_ld(&(bar)[XB_TMO])) break; if (_sp > XB_SPIN_CAP) { atomicAdd(&(bar)[XB_TMO], 1u); break; } } } } while (0)
struct XcdBarrier { unsigned* bar; unsigned x; volatile LAS unsigned* st; };
__device__ __forceinline__ XcdBarrier xcd_barrier_post(unsigned* bar, volatile LAS unsigned* st) {
    XcdBarrier b; b.bar = bar; b.x = xb_xcc_id(); b.st = st;
    if (threadIdx.x == 0) (void)xb_add(&bar[XB_XCNT(b.x)], 1u);
    return b;
}
__device__ __forceinline__ void xcd_barrier_complete(unsigned* bar, unsigned x, unsigned& nloc, unsigned& nx) {
    const unsigned G = gridDim.x * gridDim.y * gridDim.z;
    unsigned sum, cnt, mine, sp = 0u;
    for (;;) {
        sum = 0u; cnt = 0u; mine = 0u;
#pragma unroll
        for (unsigned j = 0; j < 16; ++j) { const unsigned c = xb_ld(&bar[XB_XCNT(j)]); sum += c; cnt += (c > 0u) ? 1u : 0u; mine = (j == x) ? c : mine; }
        if (sum == G) break;
        __builtin_amdgcn_s_sleep(1);
        if ((++sp & 255u) == 0u) { if (xb_ld(&bar[XB_TMO])) break; if (sp > XB_SPIN_CAP) { atomicAdd(&bar[XB_TMO], 1u); break; } }
    }
    nloc = mine > 0u ? mine : 1u; nx = cnt > 0u ? cnt : 1u;
}
__device__ __forceinline__ void xcd_barrier(const XcdBarrier& b) {
    asm volatile("s_waitcnt vmcnt(0)" ::: "memory");
    __syncthreads();
    if (threadIdx.x == 0) {
        unsigned* bar = b.bar;
        __builtin_amdgcn_s_waitcnt(0);
        unsigned nloc = b.st[0], nx = b.st[1];
        if (nloc == 0u) { xcd_barrier_complete(bar, b.x, nloc, nx); b.st[0] = nloc; b.st[1] = nx; }
        const unsigned old = xb_add(&bar[XB_XSUB(b.x)], 1u);
        const unsigned gen = old / nloc;
        if (old + 1u == (gen + 1u) * nloc) {
            __builtin_amdgcn_fence(__ATOMIC_RELEASE, "agent");
            asm volatile("s_waitcnt vmcnt(0)" ::: "memory");
            const unsigned og = xb_add(&bar[XB_TOP], 1u);
            const unsigned tg = og / nx;
            if (og + 1u == (tg + 1u) * nx) xb_add(&bar[XB_TOPGEN], 1u);
            else XB_SPIN(xb_ld(&bar[XB_TOPGEN]) == tg, bar);
            __builtin_amdgcn_fence(__ATOMIC_ACQUIRE, "agent");
            xb_add(&bar[XB_XGEN(b.x)], 1u);
            asm volatile("s_waitcnt vmcnt(0)" ::: "memory");
        } else {
            XB_SPIN(xb_ld(&bar[XB_XGEN(b.x)]) == gen, bar);
            __builtin_amdgcn_fence(__ATOMIC_ACQUIRE, "agent");
            asm volatile("s_waitcnt vmcnt(0)" ::: "memory");
        }
    }
    __syncthreads();
}

struct Unit { int pm, pn; size_t a_off, b_off; int lbase, nvalid; };
struct Gemm { const bf16_t* A; const bf16_t* Bt; int lda, ldb, K; };
__host__ __device__ __forceinline__ int perm32(int rho) { const int n = rho >> 4, i = rho & 15; return 8 * (i >> 2) + 4 * n + (i & 3); }

struct PlainOrder {     static constexpr bool GATHER = false;
    int nM, nN, nwg, G, c, lda, ldb;
    __device__ void init(int M, int N, int G_, int c_, int lda_, int ldb_) { nM = M / 256; nN = N / 256; nwg = nM * nN; G = G_; c = c_; lda = lda_; ldb = ldb_; }
    __device__ bool next(int i, Unit& u) const {
        const long L = (long)i * G + c; if (L >= nwg) return false;
        int wgid = (int)L; { const int q = nwg / 8, r = nwg % 8, xcd = wgid % 8, off = wgid / 8; wgid = (xcd < r ? xcd * (q + 1) : r * (q + 1) + (xcd - r) * q) + off; }
        const int nig = 8 * nN, gid = wgid / nig, fm = gid * 8, gsz = (nM - fm) < 8 ? (nM - fm) : 8;
        u.pm = fm + ((wgid % nig) % gsz); u.pn = (wgid % nig) / gsz;
        u.a_off = (size_t)u.pm * 256 * lda; u.b_off = (size_t)u.pn * 256 * ldb; return true;
    }
};
struct XpreOrder {
    static constexpr bool GATHER = false;
    int G, c, mode;
    __device__ bool next(int i, Unit& u) const {
        const int L = i * G + c; if (L >= 256) return false;
        const int b = L >> 4, x = (L >> 2) & 3, y = L & 3;
        if (mode == 0) { const int h = x, kt = y; u.pm = b * 4 + h; u.pn = kt; u.a_off = (size_t)b * MEMLEN * DM + h * XHD; u.b_off = (size_t)kt * 256 * DM + h * XHD; }
        else { const int nt = x, h = y; u.pm = b * 4 + nt; u.pn = h; u.a_off = (size_t)nt * 256 * DM + h * XHD; u.b_off = (size_t)b * MEMLEN * DM + h * XHD; }
        return true;
    }
};
struct XattnOrder {
    static constexpr bool GATHER = false;
    int G, c, mode, lda, ldb;
    __device__ bool next(int i, Unit& u) const {
        int L = i * G + c; if (L >= (NTOK / 256) * 4) return false;
        if (G == 256) { const int x = c & 7, idx = c >> 3; L = ((x + 8 * i) * 8 + (idx >> 2)) * 4 + (idx & 3); }
        u.pm = L >> 2; u.pn = L & 3; const int b = u.pm >> 3;
        u.a_off = (size_t)u.pm * 256 * lda;
        u.b_off = mode == 0 ? (size_t)(b * 4 + u.pn) * 256 * ldb : (size_t)(b * 1024 + u.pn * 256) * ldb;
        return true;
    }
};
template <bool GATH_> struct MoeOrder {
    static constexpr bool GATHER = GATH_;
    const LAS int* ts; int G, c, lda, ldb; const int* ltok; unsigned rowbytes;
    __device__ bool next(int i, Unit& u) const {
        const int L = i * G + c; if (L >= ts[NEXP] * 4) return false;
        const int T = L >> 2, j = L & 3; int e = 0; while (ts[e + 1] <= T) ++e;
        const int lt = T - ts[e];
        u.pm = T; u.pn = j; u.a_off = GATH_ ? (size_t)0 : (size_t)T * 256 * lda; u.b_off = ((size_t)e * 1024 + j * 256) * ldb;
        u.lbase = e * LCAP + lt * 256; u.nvalid = ts[33 + e] - lt * 256; return true;
    }
    __device__ __forceinline__ unsigned rowoff(const Unit& u, int r) const { return (r < u.nvalid) ? (unsigned)ltok[u.lbase + r] * rowbytes : 0u; }
};

template <class Epi, class Sched>
__device__ __forceinline__ void gemm_phase_simple(LAS unsigned char* lds, const Gemm g, const Sched& S, const Epi& E) {
    int tid = threadIdx.x; asm volatile("" : "+v"(tid));
    const int wid = __builtin_amdgcn_readfirstlane(tid >> 6), lane = tid & 63, wr = wid >> 2, wc = wid & 3, fr = lane & 15, fq = lane >> 4;
    Unit u;
    for (int i = 0; S.next(i, u); ++i) {
        f32x4 acc[2][2][4][2];
#pragma unroll
        for (int a = 0; a < 2; ++a)
#pragma unroll
            for (int b = 0; b < 2; ++b)
#pragma unroll
                for (int m = 0; m < 4; ++m)
#pragma unroll
                    for (int n = 0; n < 2; ++n) acc[a][b][m][n] = (f32x4){0.f, 0.f, 0.f, 0.f};
        const char* Ab = (const char*)(g.A + u.a_off); const char* Bb = (const char*)(g.Bt + u.b_off);
        const int c0 = Epi::PERM ? perm32(fr) : fr, c1 = Epi::PERM ? perm32(16 + fr) : 16 + fr;
        unsigned ao[2][4], bo[2][2];
#pragma unroll
        for (int ai = 0; ai < 2; ++ai)
#pragma unroll
            for (int m = 0; m < 4; ++m) ao[ai][m] = (unsigned)((128 * ai + 64 * wr + 16 * m + fr) * g.lda + 8 * fq) * 2u;
#pragma unroll
        for (int bj = 0; bj < 2; ++bj) { bo[bj][0] = (unsigned)((128 * bj + 32 * wc + c0) * g.ldb + 8 * fq) * 2u; bo[bj][1] = (unsigned)((128 * bj + 32 * wc + c1) * g.ldb + 8 * fq) * 2u; }
#pragma unroll 1
        for (int k0 = 0; k0 < g.K; k0 += 32) {
            if constexpr (Epi::MIDK) { if (k0 == (g.K >> 1)) E.midk(acc, u, wr, wc, fr, fq); }
            const char* Ak = Ab + (size_t)k0 * 2; const char* Bk = Bb + (size_t)k0 * 2;
            bf16x8 bfr[2][2];
#pragma unroll
            for (int bj = 0; bj < 2; ++bj) { bfr[bj][0] = *(const bf16x8*)(Bk + bo[bj][0]); bfr[bj][1] = *(const bf16x8*)(Bk + bo[bj][1]); }
#pragma unroll
            for (int ai = 0; ai < 2; ++ai) {
                bf16x8 af[4];
#pragma unroll
                for (int m = 0; m < 4; ++m) af[m] = *(const bf16x8*)(Ak + ao[ai][m]);
#pragma unroll
                for (int bj = 0; bj < 2; ++bj)
#pragma unroll
                    for (int m = 0; m < 4; ++m)
#pragma unroll
                        for (int n = 0; n < 2; ++n) acc[ai][bj][m][n] = __builtin_amdgcn_mfma_f32_16x16x32_bf16(bfr[bj][n], af[m], acc[ai][bj][m][n], 0, 0, 0);
            }
        }
        E(acc, u, wr, wc, fr, fq);
    }
}

typedef int v8i __attribute__((ext_vector_type(8)));
typedef int v4i __attribute__((ext_vector_type(4)));
__device__ __forceinline__ v8i cat8(bf16x8 lo, bf16x8 hi) { const v4i a = __builtin_bit_cast(v4i, lo), b = __builtin_bit_cast(v4i, hi); return __builtin_shufflevector(a, b, 0, 1, 2, 3, 4, 5, 6, 7); }
template <int H> __device__ __forceinline__ bf16x8 half8(v8i v) { const v4i h = H ? __builtin_shufflevector(v, v, 4, 5, 6, 7) : __builtin_shufflevector(v, v, 0, 1, 2, 3); return __builtin_bit_cast(bf16x8, h); }
__device__ __forceinline__ unsigned pk4_fp8(float a, float b, float c, float d) { int w = __builtin_amdgcn_cvt_pk_fp8_f32(a, b, 0, false); w = __builtin_amdgcn_cvt_pk_fp8_f32(c, d, w, true); return (unsigned)w; }
__host__ __device__ __forceinline__ int lds_byte(int r, int c) { const int st = (r >> 4) * 2 + (c >> 5), rr = r & 15, cc = c & 31, ob = rr * 64 + cc * 2; return st * 1024 + (ob ^ (((ob >> 9) & 1) << 5)); }
__host__ __device__ __forceinline__ void stage_rc(int b, int& R, int& C) { const int st = b / 1024, sb = b % 1024, swz = sb ^ (((sb >> 9) & 1) << 5); R = (st >> 1) * 16 + swz / 64; C = (st & 1) * 32 + (swz % 64) / 2; }
template <class Epi, class Sched, bool ALIGN_EPI = false, bool SP2 = false, bool F8 = false>
__device__ __forceinline__ void gemm_phase(LAS unsigned char* lds, const Gemm g, const Sched& S, const Epi& E) {
    constexpr int BK = 64, HALF = 128, HTB = HALF * BK * 2;
    int tid = threadIdx.x; asm volatile("" : "+v"(tid));
    const int wid = __builtin_amdgcn_readfirstlane(tid >> 6), lane = tid & 63, wr = wid >> 2, wc = wid & 3, fr = lane & 15, fq = lane >> 4;
    const int K = g.K, nt = K / BK;
    unsigned voffA[2], voffB[2];
#pragma unroll
    for (int i = 0; i < 2; ++i) { int R, C; stage_rc(tid * 16 + i * 8192, R, C); const int Rb = Epi::PERM ? ((R & ~31) + perm32(R & 31)) : R;
        voffA[i] = (unsigned)(R * g.lda + C) * 2u; voffB[i] = (unsigned)(Rb * g.ldb + C) * 2u; }
    constexpr bool GATH = Sched::GATHER;
    unsigned vcu[2][2] = {{0u, 0u}, {0u, 0u}}, vnx[2][2] = {{0u, 0u}, {0u, 0u}}; int gR[2] = {0, 0}; unsigned gC[2] = {0u, 0u};
    if constexpr (GATH) {
#pragma unroll
        for (int i = 0; i < 2; ++i) { int R, Cq; stage_rc(tid * 16 + i * 8192, R, Cq); gR[i] = R; gC[i] = (unsigned)Cq * 2u; } }
    const size_t kstep = (size_t)(BK * 2);
    const size_t hstepA = (size_t)HALF * g.lda * 2, hstepB = (size_t)HALF * g.ldb * 2;
    const unsigned ldsw = (unsigned)wid * 1024u;
    const int aoff = lds_byte(wr * 64 + fr, F8 ? fq * 16 : fq * 8), boff = lds_byte(wc * 32 + fr, F8 ? fq * 16 : fq * 8);
    const int aoff1 = lds_byte(wr * 64 + fr, F8 ? fq * 16 + 8 : fq * 8 + 32) - aoff, boff1 = lds_byte(wc * 32 + fr, F8 ? fq * 16 + 8 : fq * 8 + 32) - boff;
#define PG8_SA(b, h) (((b) * 2 + (h)) * HTB)
#define PG8_SB(b, h) ((4 + (b) * 2 + (h)) * HTB)
#define PG8_STAGE(bufoff, gbase, voff) do { _Pragma("unroll") for (int _i = 0; _i < 2; ++_i) \
        __builtin_amdgcn_global_load_lds((const unsigned*)((const char*)(gbase) + (voff)[_i]), (LAS unsigned*)(lds + (bufoff) + ldsw + _i * 8192), 16, 0, 0); } while (0)
#define PG8_STA(bufoff, ptr, h, nx) do { if constexpr (GATH) { const unsigned vsel_[2] = {(nx) ? vnx[h][0] : vcu[h][0], (nx) ? vnx[h][1] : vcu[h][1]}; PG8_STAGE(bufoff, ptr, vsel_); } \
        else { PG8_STAGE(bufoff, (ptr) + (h) * hstepA, voffA); } } while (0)
#define PG8_LDA(dst, b, h) do { _Pragma("unroll") for (int m = 0; m < 4; ++m) dst[m] = cat8(*(const LAS bf16x8*)(lds + PG8_SA(b, h) + aoff + m * 2048), *(const LAS bf16x8*)(lds + PG8_SA(b, h) + aoff + m * 2048 + aoff1)); } while (0)
#define PG8_LDB(dst, b, h) do { _Pragma("unroll") for (int n = 0; n < 2; ++n) dst[n] = cat8(*(const LAS bf16x8*)(lds + PG8_SB(b, h) + boff + n * 2048), *(const LAS bf16x8*)(lds + PG8_SB(b, h) + boff + n * 2048 + boff1)); } while (0)
#define PG8_MMA(ai, bj, At, Bt) do { __builtin_amdgcn_s_setprio(1); \
        if constexpr (F8) { _Pragma("unroll") for (int m = 0; m < 4; ++m) _Pragma("unroll") for (int n = 0; n < 2; ++n) \
            asm volatile("s_nop 1\n\tv_mfma_scale_f32_16x16x128_f8f6f4 %0, %1, %2, %0, %3, %3 op_sel_hi:[0,0,0]" : "+v"(acc[ai][bj][m][n]) : "v"(Bt[n]), "v"(At[m]), "v"(sc127)); } \
        else { _Pragma("unroll") for (int m = 0; m < 4; ++m) _Pragma("unroll") for (int n = 0; n < 2; ++n) { \
            acc[ai][bj][m][n] = __builtin_amdgcn_mfma_f32_16x16x32_bf16(half8<0>(Bt[n]), half8<0>(At[m]), acc[ai][bj][m][n], 0, 0, 0); \
            acc[ai][bj][m][n] = __builtin_amdgcn_mfma_f32_16x16x32_bf16(half8<1>(Bt[n]), half8<1>(At[m]), acc[ai][bj][m][n], 0, 0, 0); } } \
        __builtin_amdgcn_s_setprio(0); } while (0)
#define PG8_WAIT_V(n) asm volatile("s_waitcnt vmcnt(" #n ")" ::: "memory")
#define PG8_WAIT_L(n) asm volatile("s_waitcnt lgkmcnt(" #n ")" ::: "memory")
#define PG8_BAR __builtin_amdgcn_s_barrier()
#define PG8_SCHED __builtin_amdgcn_sched_barrier(0)
    Unit cur, nxt; int ui = 0;
    if (!S.next(0, cur)) return;
    f32x4 acc[2][2][4][2];
#pragma unroll
    for (int a = 0; a < 2; ++a)
#pragma unroll
        for (int b = 0; b < 2; ++b)
#pragma unroll
            for (int m = 0; m < 4; ++m)
#pragma unroll
                for (int n = 0; n < 2; ++n) acc[a][b][m][n] = (f32x4){0.f, 0.f, 0.f, 0.f};
    int sc127 = 127; asm volatile("" : "+v"(sc127));
    v8i At[4], B0[2], B1[2];
    const char* cA = (const char*)(g.A + cur.a_off); const char* cB = (const char*)(g.Bt + cur.b_off);
    if constexpr (GATH) {
#pragma unroll
        for (int h = 0; h < 2; ++h)
#pragma unroll
            for (int i = 0; i < 2; ++i) vcu[h][i] = S.rowoff(cur, h * HALF + gR[i]) + gC[i]; }
    if constexpr (SP2) {
        PG8_STAGE(PG8_SB(0, 0), cB, voffB); PG8_STAGE(PG8_SB(0, 1), cB + hstepB, voffB); PG8_STA(PG8_SA(0, 0), cA, 0, false); PG8_STA(PG8_SA(0, 1), cA, 1, false);
        if (wr == 1) PG8_BAR;
        PG8_WAIT_V(2); PG8_BAR;
        PG8_STAGE(PG8_SB(1, 0), cB + kstep, voffB); PG8_STA(PG8_SA(1, 0), cA + kstep, 0, false); PG8_STAGE(PG8_SB(1, 1), cB + hstepB + kstep, voffB);
        PG8_WAIT_V(6); PG8_BAR;
    } else {
        PG8_STAGE(PG8_SB(0, 0), cB, voffB); PG8_STA(PG8_SA(0, 0), cA, 0, false); PG8_STAGE(PG8_SB(0, 1), cB + hstepB, voffB); PG8_STA(PG8_SA(0, 1), cA, 1, false);
        if (wr == 1) PG8_BAR;
        PG8_WAIT_V(4); PG8_BAR;
        PG8_STAGE(PG8_SB(1, 0), cB + kstep, voffB); PG8_STA(PG8_SA(1, 0), cA + kstep, 0, false); PG8_STAGE(PG8_SB(1, 1), cB + hstepB + kstep, voffB);
        PG8_WAIT_V(6); PG8_BAR;
    }
    for (;;) {
        const bool has_next = S.next(ui + 1, nxt);
        const char* nA = has_next ? (const char*)(g.A + nxt.a_off) : cA; const char* nB = has_next ? (const char*)(g.Bt + nxt.b_off) : cB;
        if constexpr (GATH) {
#pragma unroll
            for (int h = 0; h < 2; ++h)
#pragma unroll
                for (int i = 0; i < 2; ++i) vnx[h][i] = has_next ? (S.rowoff(nxt, h * HALF + gR[i]) + gC[i]) : vcu[h][i]; }
#pragma unroll 1
        for (int t = 0; t < nt; t += 2) {
            if constexpr (Epi::MIDK) { if (t == (nt >> 1)) E.midk(acc, cur, wr, wc, fr, fq); }
            const bool last = (t == nt - 2);
            const char* a1 = cA + (size_t)(t + 1) * kstep;
            const char* a2 = last ? nA : cA + (size_t)(t + 2) * kstep; const char* b2 = last ? nB : cB + (size_t)(t + 2) * kstep;
            const char* a3 = a2 + kstep; const char* b3 = b2 + kstep;
            if constexpr (SP2) {
            PG8_LDB(B0, 0, 0); PG8_LDB(B1, 0, 1); PG8_SCHED; PG8_LDA(At, 0, 0); PG8_STA(PG8_SA(1, 1), a1, 1, false);
            PG8_WAIT_V(8); PG8_WAIT_L(0); PG8_BAR; PG8_MMA(0, 0, At, B0); PG8_MMA(0, 1, At, B1); PG8_BAR; PG8_SCHED;
            PG8_LDA(At, 0, 1); PG8_STAGE(PG8_SB(0, 0), b2, voffB); PG8_STAGE(PG8_SB(0, 1), b2 + hstepB, voffB); PG8_STA(PG8_SA(0, 0), a2, 0, last);
            PG8_WAIT_V(8); PG8_WAIT_L(0); PG8_BAR; PG8_MMA(1, 0, At, B0); PG8_MMA(1, 1, At, B1); PG8_BAR; PG8_SCHED;
            PG8_LDB(B0, 1, 0); PG8_LDB(B1, 1, 1); PG8_SCHED; PG8_LDA(At, 1, 0); PG8_STA(PG8_SA(0, 1), a2, 1, last);
            PG8_WAIT_V(8); PG8_WAIT_L(0); PG8_BAR; PG8_MMA(0, 0, At, B0); PG8_MMA(0, 1, At, B1); PG8_BAR; PG8_SCHED;
            PG8_LDA(At, 1, 1); PG8_STAGE(PG8_SB(1, 0), b3, voffB); PG8_STAGE(PG8_SB(1, 1), b3 + hstepB, voffB); PG8_STA(PG8_SA(1, 0), a3, 0, last);
            PG8_WAIT_V(8); PG8_WAIT_L(0); PG8_BAR; PG8_MMA(1, 0, At, B0); PG8_MMA(1, 1, At, B1); PG8_BAR; PG8_SCHED;
            } else {
            PG8_LDB(B0, 0, 0); PG8_SCHED; PG8_LDA(At, 0, 0); PG8_STA(PG8_SA(1, 1), a1, 1, false);
            PG8_WAIT_L(8); PG8_BAR; PG8_WAIT_L(0); PG8_MMA(0, 0, At, B0); PG8_BAR; PG8_SCHED;
            PG8_LDB(B1, 0, 1); PG8_STAGE(PG8_SB(0, 0), b2, voffB);
            PG8_BAR; PG8_WAIT_L(0); PG8_MMA(0, 1, At, B1); PG8_BAR;
            PG8_LDA(At, 0, 1); PG8_STA(PG8_SA(0, 0), a2, 0, last);
            PG8_BAR; PG8_WAIT_L(0); PG8_MMA(1, 0, At, B0); PG8_BAR; PG8_SCHED;
            PG8_STAGE(PG8_SB(0, 1), b2 + hstepB, voffB);
            PG8_WAIT_V(6); PG8_BAR; PG8_MMA(1, 1, At, B1); PG8_BAR;
            PG8_LDB(B0, 1, 0); PG8_SCHED; PG8_LDA(At, 1, 0); PG8_STA(PG8_SA(0, 1), a2, 1, last);
            PG8_WAIT_L(8); PG8_BAR; PG8_WAIT_L(0); PG8_MMA(0, 0, At, B0); PG8_BAR; PG8_SCHED;
            PG8_LDB(B1, 1, 1); PG8_STAGE(PG8_SB(1, 0), b3, voffB);
            PG8_BAR; PG8_WAIT_L(0); PG8_MMA(0, 1, At, B1); PG8_BAR;
            PG8_LDA(At, 1, 1); PG8_STA(PG8_SA(1, 0), a3, 0, last);
            PG8_BAR; PG8_WAIT_L(0); PG8_MMA(1, 0, At, B0); PG8_BAR; PG8_SCHED;
            PG8_STAGE(PG8_SB(1, 1), b3 + hstepB, voffB);
            PG8_WAIT_V(6); PG8_BAR; PG8_MMA(1, 1, At, B1); PG8_BAR;
            }
        }
        if constexpr (ALIGN_EPI) { if (wr == 0) PG8_BAR; }
        if constexpr (F8) {
#pragma unroll
            for (int a = 0; a < 2; ++a)
#pragma unroll
                for (int b = 0; b < 2; ++b)
                    asm volatile("s_nop 15\n\ts_nop 7" : "+v"(acc[a][b][0][0]), "+v"(acc[a][b][0][1]), "+v"(acc[a][b][1][0]), "+v"(acc[a][b][1][1]), "+v"(acc[a][b][2][0]), "+v"(acc[a][b][2][1]), "+v"(acc[a][b][3][0]), "+v"(acc[a][b][3][1]));
        }
        E(acc, cur, wr, wc, fr, fq);
        if (!has_next) break;
#pragma unroll
        for (int a = 0; a < 2; ++a)
#pragma unroll
            for (int b = 0; b < 2; ++b)
#pragma unroll
                for (int m = 0; m < 4; ++m)
#pragma unroll
                    for (int n = 0; n < 2; ++n) acc[a][b][m][n] = (f32x4){0.f, 0.f, 0.f, 0.f};
        cur = nxt; cA = nA; cB = nB; ++ui;
        if constexpr (GATH) {
#pragma unroll
            for (int h = 0; h < 2; ++h)
#pragma unroll
                for (int i = 0; i < 2; ++i) vcu[h][i] = vnx[h][i]; }
        if constexpr (ALIGN_EPI) { if (wr == 1) PG8_BAR; }
    }
    PG8_WAIT_V(0);
    if constexpr (!ALIGN_EPI) { if (wr == 0) PG8_BAR; }
    PG8_BAR;
#undef PG8_SA
#undef PG8_SB
#undef PG8_STAGE
#undef PG8_STA
#undef PG8_LDA
#undef PG8_LDB
#undef PG8_MMA
#undef PG8_WAIT_V
#undef PG8_WAIT_L
#undef PG8_BAR
#undef PG8_SCHED
}
#ifdef GEMM_SIMPLE
#define GEMM_PHASE(lds, g, S, E) gemm_phase_simple(lds, g, S, E)
#else
#define GEMM_PHASE(lds, g, S, E) gemm_phase<decltype(E), decltype(S), true, true>(lds, g, S, E)
#endif
#define GEMM_PHASE8(lds, g, S, E) gemm_phase<decltype(E), decltype(S), true, true, true>(lds, g, S, E)

__device__ __forceinline__ float rstd_from_ssq(const float* ssq, int row) {
    const f32x4* p = (const f32x4*)(ssq + (size_t)row * 16); const f32x4 a = p[0], b = p[1], c = p[2], d = p[3];
    const float s = ((a[0] + a[1]) + (a[2] + a[3])) + ((b[0] + b[1]) + (b[2] + b[3])) + ((c[0] + c[1]) + (c[2] + c[3])) + ((d[0] + d[1]) + (d[2] + d[3]));
    return __builtin_amdgcn_rsqf(s * (1.0f / DM) + EPS);
}
__device__ __forceinline__ u32x4 pack8(const f32x4 v0, const f32x4 v1) { u32x4 w; w.x = cvt_pk_bf16(v0[0], v0[1]); w.y = cvt_pk_bf16(v0[2], v0[3]); w.z = cvt_pk_bf16(v1[0], v1[1]); w.w = cvt_pk_bf16(v1[2], v1[3]); return w; }

struct EpiProj {
    static constexpr bool PERM = true, LDSX = false, MIDK = false;
    bf16_t* base; const float* rope; float* ksum;
    __device__ __forceinline__ void operator()(f32x4 (&acc)[2][2][4][2], const Unit& u, int wr, int wc, int fr, int fq) const {
        const int type = u.pn >> 1, colt = (u.pn & 1) * 256;
        bf16_t* O = base + (size_t)type * NTOK * 512;
        const bool is_q = (type == 2), is_k = (type == 3);
        if ((is_q || is_k) && !(wc & 1)) {
#pragma unroll
            for (int ai = 0; ai < 2; ++ai)
#pragma unroll
                for (int m = 0; m < 4; ++m) {
                    const int row = u.pm * 256 + 128 * ai + 64 * wr + 16 * m + fr, pos = row & (SEQ - 1);
                    const float* rp = rope + pos * 16;
                    const f32x4 cs[2] = { *(const f32x4*)(rp), *(const f32x4*)(rp + 4) }, sn[2] = { *(const f32x4*)(rp + 8), *(const f32x4*)(rp + 12) };
#pragma unroll
                    for (int bj = 0; bj < 2; ++bj)
#pragma unroll
                        for (int n = 0; n < 2; ++n) {
                            const f32x4 mine = acc[ai][bj][m][n]; f32x4 oth;
#pragma unroll
                            for (int e = 0; e < 4; ++e) oth[e] = __shfl_xor(mine[e], 16);
                            f32x4 res = mine;
                            if (fq == 0) res = mine * cs[n] - oth * sn[n];
                            else if (fq == 1) res = mine * cs[n] + oth * sn[n];
                            acc[ai][bj][m][n] = res;
                        }
                }
        }
        const float sc = is_q ? QSCALE : 1.0f;
#pragma unroll
        for (int ai = 0; ai < 2; ++ai)
#pragma unroll
            for (int m = 0; m < 4; ++m) {
                const int row = u.pm * 256 + 128 * ai + 64 * wr + 16 * m + fr;
                bf16_t* rowp = O + (size_t)row * 512 + colt + 32 * wc + 8 * fq;
#pragma unroll
                for (int bj = 0; bj < 2; ++bj) *(u32x4*)(rowp + bj * 128) = pack8(acc[ai][bj][m][0] * sc, acc[ai][bj][m][1] * sc);
            }
        if (is_k) {
#pragma unroll
            for (int bj = 0; bj < 2; ++bj)
#pragma unroll
                for (int n = 0; n < 2; ++n)
#pragma unroll
                    for (int e = 0; e < 4; ++e) {
                        float s = 0.f;
#pragma unroll
                        for (int ai = 0; ai < 2; ++ai)
#pragma unroll
                            for (int m = 0; m < 4; ++m) s += acc[ai][bj][m][n][e];
                        s += __shfl_xor(s, 1); s += __shfl_xor(s, 2); s += __shfl_xor(s, 4); s += __shfl_xor(s, 8);
                        if (fr == 0) atomicAdd(ksum + (size_t)u.pm * 512 + colt + 128 * bj + 32 * wc + 8 * fq + 4 * n + e, s);
                    }
        }
    }
};
struct EpiNull {
    static constexpr bool PERM = true, LDSX = false, MIDK = false;
    __device__ __forceinline__ void operator()(f32x4 (&acc)[2][2][4][2], const Unit& u, int wr, int wc, int fr, int fq) const { asm volatile("" :: "v"(acc[0][0][0][0][0]), "v"(acc[1][1][3][1][3])); }
};
struct EpiStore {
    static constexpr bool PERM = true, LDSX = false, MIDK = false;
    bf16_t* O; int ldc; float sc = 1.0f;
    __device__ __forceinline__ void operator()(f32x4 (&acc)[2][2][4][2], const Unit& u, int wr, int wc, int fr, int fq) const {
#pragma unroll
        for (int ai = 0; ai < 2; ++ai)
#pragma unroll
            for (int m = 0; m < 4; ++m) {
                const int row = u.pm * 256 + 128 * ai + 64 * wr + 16 * m + fr;
                bf16_t* rowp = O + (size_t)row * ldc + u.pn * 256 + 32 * wc + 8 * fq;
#pragma unroll
                for (int bj = 0; bj < 2; ++bj) *(u32x4*)(rowp + bj * 128) = pack8(acc[ai][bj][m][0] * sc, acc[ai][bj][m][1] * sc);
            }
    }
};
struct EpiStore8 {
    static constexpr bool PERM = true, LDSX = false, MIDK = false;
    unsigned char* O; int ldc; float sc;
    __device__ __forceinline__ void operator()(f32x4 (&acc)[2][2][4][2], const Unit& u, int wr, int wc, int fr, int fq) const {
#pragma unroll
        for (int ai = 0; ai < 2; ++ai)
#pragma unroll
            for (int m = 0; m < 4; ++m) {
                const int row = u.pm * 256 + 128 * ai + 64 * wr + 16 * m + fr;
                unsigned char* rowp = O + (size_t)row * ldc + u.pn * 256 + 32 * wc + 8 * fq;
#pragma unroll
                for (int bj = 0; bj < 2; ++bj) { const f32x4 a0 = acc[ai][bj][m][0] * sc, a1 = acc[ai][bj][m][1] * sc; u32x2 w; w.x = pk4_fp8(a0[0], a0[1], a0[2], a0[3]); w.y = pk4_fp8(a1[0], a1[1], a1[2], a1[3]); *(u32x2*)(rowp + bj * 128) = w; }
            }
    }
};
template <bool BASE_F32, bool KSPLIT> struct EpiResid {
    static constexpr bool PERM = true, LDSX = false, MIDK = KSPLIT;
    const void* base; bf16_t* hb; float* ssq; const float* ssql; const float* ssqa; unsigned char* h8; float asc;
    __device__ __forceinline__ void stats(int row, int fq, float& rl, float& ra) const {
        const f32x4 pl = *(const f32x4*)(ssql + (size_t)row * 16 + 4 * fq); const f32x2 pa = *(const f32x2*)(ssqa + (size_t)row * 8 + 2 * fq);
        float sl = (pl[0] + pl[1]) + (pl[2] + pl[3]), sa = pa[0] + pa[1];
        sl += __shfl_xor(sl, 16); sl += __shfl_xor(sl, 32); sa += __shfl_xor(sa, 16); sa += __shfl_xor(sa, 32);
        rl = __builtin_amdgcn_rsqf(sl * (1.0f / 512.0f) + EPS); ra = __builtin_amdgcn_rsqf(sa * (1.0f / 512.0f) + EPS);
    }
    __device__ __forceinline__ void midk(f32x4 (&acc)[2][2][4][2], const Unit& u, int wr, int wc, int fr, int fq) const {
        asm volatile("" : "+v"(fr), "+v"(fq));
#pragma unroll
        for (int ai = 0; ai < 2; ++ai)
#pragma unroll
            for (int m = 0; m < 4; ++m) { float rl, ra; stats(u.pm * 256 + 128 * ai + 64 * wr + 16 * m + fr, fq, rl, ra); const float ratio = rl * __builtin_amdgcn_rcpf(ra);
#pragma unroll
                for (int bj = 0; bj < 2; ++bj)
#pragma unroll
                    for (int n = 0; n < 2; ++n) acc[ai][bj][m][n] *= ratio; }
    }
    __device__ __forceinline__ void operator()(f32x4 (&acc)[2][2][4][2], const Unit& u, int wr, int wc, int fr, int fq) const {
#pragma unroll
        for (int ai = 0; ai < 2; ++ai)
#pragma unroll
            for (int m = 0; m < 4; ++m) {
                const int row = u.pm * 256 + 128 * ai + 64 * wr + 16 * m + fr; float q = 0.f, osc = asc;
                if constexpr (KSPLIT) { float rl; stats(row, fq, rl, osc); osc *= asc; }
#pragma unroll
                for (int bj = 0; bj < 2; ++bj) {
                    const int col = u.pn * 256 + 128 * bj + 32 * wc + 8 * fq;
                    f32x4 b0, b1;
                    if constexpr (BASE_F32) { b0 = *(const f32x4*)((const float*)base + (size_t)row * DM + col); b1 = *(const f32x4*)((const float*)base + (size_t)row * DM + col + 4); }
                    else { const u32x4 w = *(const u32x4*)((const bf16_t*)base + (size_t)row * LDH + col); b0 = (f32x4){bflo(w.x), bfhi(w.x), bflo(w.y), bfhi(w.y)}; b1 = (f32x4){bflo(w.z), bfhi(w.z), bflo(w.w), bfhi(w.w)}; }
                    const f32x4 v0 = b0 + acc[ai][bj][m][0] * osc, v1 = b1 + acc[ai][bj][m][1] * osc;
                    q += ((v0[0] * v0[0] + v0[1] * v0[1]) + (v0[2] * v0[2] + v0[3] * v0[3])) + ((v1[0] * v1[0] + v1[1] * v1[1]) + (v1[2] * v1[2] + v1[3] * v1[3]));
                    *(u32x4*)(hb + (size_t)row * LDH + col) = pack8(v0, v1);
                    if (h8) { u32x2 w8; w8.x = pk4_fp8(v0[0], v0[1], v0[2], v0[3]); w8.y = pk4_fp8(v1[0], v1[1], v1[2], v1[3]); *(u32x2*)(h8 + (size_t)row * DM + col) = w8; }
                }
                q += __shfl_xor(q, 16); q += __shfl_xor(q, 32);
                if (fq == 0) ssq[(size_t)row * 16 + u.pn * 4 + wc] = q;
            }
    }
};
struct EpiRowScale {
    static constexpr bool PERM = true, LDSX = false, MIDK = false;
    bf16_t* O; int ldc; const float* ssq; float cs;
    __device__ __forceinline__ void operator()(f32x4 (&acc)[2][2][4][2], const Unit& u, int wr, int wc, int fr, int fq) const {
#pragma unroll
        for (int ai = 0; ai < 2; ++ai)
#pragma unroll
            for (int m = 0; m < 4; ++m) {
                const int row = u.pm * 256 + 128 * ai + 64 * wr + 16 * m + fr; const float s = rstd_from_ssq(ssq, row) * cs;
                bf16_t* rowp = O + (size_t)row * ldc + u.pn * 256 + 32 * wc + 8 * fq;
#pragma unroll
                for (int bj = 0; bj < 2; ++bj) *(u32x4*)(rowp + bj * 128) = pack8(acc[ai][bj][m][0] * s, acc[ai][bj][m][1] * s);
            }
    }
};
#define XBAR() do { asm volatile("s_waitcnt lgkmcnt(0)" ::: "memory"); __builtin_amdgcn_s_barrier(); asm volatile("" ::: "memory"); } while (0)
struct EpiSoftmax {
    static constexpr bool PERM = true, LDSX = false, MIDK = false;
    unsigned char* O; int ldc; LAS unsigned char* xl; const float* ssq; float cs;
    __device__ __forceinline__ void operator()(f32x4 (&acc)[2][2][4][2], const Unit& u, int wr, int wc, int fr, int fq) const {
        LAS float* P = (LAS float*)xl;
        LAS float* Q = (LAS float*)(xl + 4096);
#pragma unroll
        for (int ai = 0; ai < 2; ++ai)
#pragma unroll
            for (int m = 0; m < 4; ++m) {
                float v = -INFINITY; const float sc = rstd_from_ssq(ssq, u.pm * 256 + 128 * ai + 64 * wr + 16 * m + fr) * cs;
#pragma unroll
                for (int bj = 0; bj < 2; ++bj)
#pragma unroll
                    for (int n = 0; n < 2; ++n) { const f32x4 x = acc[ai][bj][m][n] * sc; acc[ai][bj][m][n] = x; v = fmaxf(v, fmaxf(fmaxf(x[0], x[1]), fmaxf(x[2], x[3]))); }
                v = fmaxf(v, __shfl_xor(v, 16)); v = fmaxf(v, __shfl_xor(v, 32));
                if (fq == 0) P[(128 * ai + 64 * wr + 16 * m + fr) * 4 + wc] = v;
            }
        XBAR();
#pragma unroll
        for (int ai = 0; ai < 2; ++ai)
#pragma unroll
            for (int m = 0; m < 4; ++m) {
                const int r = 128 * ai + 64 * wr + 16 * m + fr;
                const float v = fmaxf(fmaxf(P[r * 4 + 0], P[r * 4 + 1]), fmaxf(P[r * 4 + 2], P[r * 4 + 3]));
                float s = 0.f;
#pragma unroll
                for (int bj = 0; bj < 2; ++bj)
#pragma unroll
                    for (int n = 0; n < 2; ++n) { f32x4 x = acc[ai][bj][m][n];
#pragma unroll
                        for (int e = 0; e < 4; ++e) { x[e] = __builtin_amdgcn_exp2f(x[e] - v); s += x[e]; }
                        acc[ai][bj][m][n] = x; }
                s += __shfl_xor(s, 16); s += __shfl_xor(s, 32);
                if (fq == 0) Q[r * 4 + wc] = s;
            }
        XBAR();
#pragma unroll
        for (int ai = 0; ai < 2; ++ai)
#pragma unroll
            for (int m = 0; m < 4; ++m) {
                const int r = 128 * ai + 64 * wr + 16 * m + fr;
                const float inv = PX_SC * __builtin_amdgcn_rcpf((Q[r * 4 + 0] + Q[r * 4 + 1]) + (Q[r * 4 + 2] + Q[r * 4 + 3]));
                unsigned char* rowp = O + (size_t)(u.pm * 256 + r) * ldc + u.pn * 256 + 32 * wc + 8 * fq;
#pragma unroll
                for (int bj = 0; bj < 2; ++bj) { const f32x4 a0 = acc[ai][bj][m][0] * inv, a1 = acc[ai][bj][m][1] * inv; u32x2 w; w.x = pk4_fp8(a0[0], a0[1], a0[2], a0[3]); w.y = pk4_fp8(a1[0], a1[1], a1[2], a1[3]); *(u32x2*)(rowp + bj * 128) = w; }
            }
        XBAR();
    }
};
struct EpiGateUp {
    static constexpr bool PERM = true, LDSX = false, MIDK = false;
    unsigned char* O; const float* lrs;
    __device__ __forceinline__ void operator()(f32x4 (&acc)[2][2][4][2], const Unit& u, int wr, int wc, int fr, int fq) const {
#pragma unroll
        for (int ai = 0; ai < 2; ++ai)
#pragma unroll
            for (int m = 0; m < 4; ++m) {
                const int r = 128 * ai + 64 * wr + 16 * m + fr, row = u.pm * 256 + r; const float rs = (r < u.nvalid) ? lrs[u.lbase + r] * (1.0f / WGU_SC) : 0.f;
                f32x4 o[2];
#pragma unroll
                for (int n = 0; n < 2; ++n)
#pragma unroll
                    for (int e = 0; e < 4; ++e) { const float g = acc[ai][0][m][n][e] * rs, up = acc[ai][1][m][n][e] * rs; o[n][e] = g * sigmoidf_(g) * up * ACT_SC; }
                u32x2 w8; w8.x = pk4_fp8(o[0][0], o[0][1], o[0][2], o[0][3]); w8.y = pk4_fp8(o[1][0], o[1][1], o[1][2], o[1][3]);
                *(u32x2*)(O + (size_t)row * DFF + u.pn * 128 + 32 * wc + 8 * fq) = w8;
            }
    }
};

struct Args { const float* in[27]; float* out; unsigned char* ws; int ph_lo, ph_hi; float invf[8]; };
struct Ctx { LAS unsigned char* lds; int tid, lane, wave, vcu, G; };

__device__ __forceinline__ void tr_load(f32x4 (&v)[8], const float* W, int ldw, int k0, int n0s, int lane) {
    const int kr = lane >> 3, ch = lane & 7;
#pragma unroll
    for (int i = 0; i < 8; ++i) v[i] = *(const f32x4*)(W + (size_t)(k0 + 8 * i + kr) * ldw + n0s + 4 * ch);
}
__device__ __forceinline__ void tr_finish(const f32x4 (&v)[8], int k0, bf16_t* WT, int ldt, int r0d, const float* gain, LAS float* scr, int lane) {
    const int kr = lane >> 3, ch = lane & 7, c = lane & 7;
    f32x4 g0 = {1.f, 1.f, 1.f, 1.f}, g1 = {1.f, 1.f, 1.f, 1.f};
    if (gain) { g0 = *(const f32x4*)(gain + k0 + 8 * c); g1 = *(const f32x4*)(gain + k0 + 8 * c + 4); }
#pragma unroll
    for (int i = 0; i < 8; ++i) { LAS float* d = scr + (8 * i + kr) * 33 + 4 * ch; d[0] = v[i][0]; d[1] = v[i][1]; d[2] = v[i][2]; d[3] = v[i][3]; }
    LDS_WAIT(); asm volatile("" ::: "memory");
#pragma unroll
    for (int j = 0; j < 4; ++j) { const int n = (lane >> 3) + 8 * j; const LAS float* s = scr + (8 * c) * 33 + n;
        u32x4 o; o.x = cvt_pk_bf16(s[0 * 33] * g0[0], s[1 * 33] * g0[1]); o.y = cvt_pk_bf16(s[2 * 33] * g0[2], s[3 * 33] * g0[3]); o.z = cvt_pk_bf16(s[4 * 33] * g1[0], s[5 * 33] * g1[1]); o.w = cvt_pk_bf16(s[6 * 33] * g1[2], s[7 * 33] * g1[3]);
        *(u32x4*)(WT + (size_t)(r0d + n) * ldt + k0 + 8 * c) = o; }
    LDS_WAIT(); asm volatile("" ::: "memory");
}
__device__ __forceinline__ void tr_finish8(const f32x4 (&v)[8], int k0, unsigned char* WT8, int ldt, int r0d, const float* gain, float sc, LAS float* scr, int lane) {
    const int kr = lane >> 3, ch = lane & 7, c = lane & 7;
    f32x4 g0 = {sc, sc, sc, sc}, g1 = {sc, sc, sc, sc};
    if (gain) { g0 = *(const f32x4*)(gain + k0 + 8 * c) * sc; g1 = *(const f32x4*)(gain + k0 + 8 * c + 4) * sc; }
#pragma unroll
    for (int i = 0; i < 8; ++i) { LAS float* d = scr + (8 * i + kr) * 33 + 4 * ch; d[0] = v[i][0]; d[1] = v[i][1]; d[2] = v[i][2]; d[3] = v[i][3]; }
    LDS_WAIT(); asm volatile("" ::: "memory");
#pragma unroll
    for (int j = 0; j < 4; ++j) { const int n = (lane >> 3) + 8 * j; const LAS float* s = scr + (8 * c) * 33 + n;
        u32x2 o; o.x = pk4_fp8(s[0 * 33] * g0[0], s[1 * 33] * g0[1], s[2 * 33] * g0[2], s[3 * 33] * g0[3]); o.y = pk4_fp8(s[4 * 33] * g1[0], s[5 * 33] * g1[1], s[6 * 33] * g1[2], s[7 * 33] * g1[3]);
        *(u32x2*)(WT8 + (size_t)(r0d + n) * ldt + k0 + 8 * c) = o; }
    LDS_WAIT(); asm volatile("" ::: "memory");
}
__device__ __forceinline__ void tr_item(const float* W, int ldw, int k0, int n0s, bf16_t* WT, int ldt, int r0d, const float* gain, LAS float* scr, int lane) {
    f32x4 v[8]; tr_load(v, W, ldw, k0, n0s, lane); tr_finish(v, k0, WT, ldt, r0d, gain, scr, lane);
}
__device__ __forceinline__ void rms_row_to_bf16(const float* xrow, const float* gain, bf16_t* orow, int lane) {
    const f32x4* xr = (const f32x4*)xrow + lane; const f32x4* gr = (const f32x4*)gain + lane;
    f32x4 v[4]; float s = 0.f;
#pragma unroll
    for (int j = 0; j < 4; ++j) { v[j] = xr[64 * j]; s += (v[j][0] * v[j][0] + v[j][1] * v[j][1]) + (v[j][2] * v[j][2] + v[j][3] * v[j][3]); }
    const float rstd = 1.0f / sqrtf(wave_sum(s) * (1.0f / DM) + EPS);
    u32x2* o8 = (u32x2*)orow + lane;
#pragma unroll
    for (int j = 0; j < 4; ++j) { const f32x4 g = gr[64 * j]; u32x2 w; w.x = cvt_pk_bf16(v[j][0] * rstd * g[0], v[j][1] * rstd * g[1]); w.y = cvt_pk_bf16(v[j][2] * rstd * g[2], v[j][3] * rstd * g[3]); o8[64 * j] = w; }
}

__device__ __forceinline__ void rms_row2_to_bf16(const float* xrow, const float* gain, bf16_t* orow, int lane) {
    const f32x4* xr = (const f32x4*)xrow + lane; const f32x4* gr = (const f32x4*)gain + lane;
    f32x4 v[2][4]; float s[2] = {0.f, 0.f};
#pragma unroll
    for (int r = 0; r < 2; ++r)
#pragma unroll
        for (int j = 0; j < 4; ++j) v[r][j] = xr[256 * r + 64 * j];
#pragma unroll
    for (int r = 0; r < 2; ++r)
#pragma unroll
        for (int j = 0; j < 4; ++j) s[r] += (v[r][j][0] * v[r][j][0] + v[r][j][1] * v[r][j][1]) + (v[r][j][2] * v[r][j][2] + v[r][j][3] * v[r][j][3]);
#pragma unroll
    for (int r = 0; r < 2; ++r) { const float rstd = 1.0f / sqrtf(wave_sum(s[r]) * (1.0f / DM) + EPS); u32x2* o8 = (u32x2*)(orow + (size_t)r * DM) + lane;
#pragma unroll
        for (int j = 0; j < 4; ++j) { const f32x4 g = gr[64 * j]; u32x2 w; w.x = cvt_pk_bf16(v[r][j][0] * rstd * g[0], v[r][j][1] * rstd * g[1]); w.y = cvt_pk_bf16(v[r][j][2] * rstd * g[2], v[r][j][3] * rstd * g[3]); o8[64 * j] = w; } }
}

__device__ __forceinline__ void conv_wdn(const Args& a, const Ctx& C, int gw, int NGW, int it_lo, int NIT) {
    LAS float* scr = (LAS float*)(C.lds + C.wave * 16384); const int lane = C.lane;
    f32x4 va[8], vb[8];
#define WDN_LOAD(v, it) do { const int e_ = (it) / 256, r_ = (it) % 256; tr_load(v, a.in[25] + (size_t)e_ * DFF * DM, DM, 64 * (r_ / 32), 32 * (r_ % 32), lane); } while (0)
#define WDN_FIN(v, it) do { const int e_ = (it) / 256, r_ = (it) % 256; tr_finish8(v, 64 * (r_ / 32), a.ws + WS_WDN, DFF, e_ * 1024 + 32 * (r_ % 32), nullptr, WDN_SC, scr, lane); } while (0)
    int it = it_lo + gw; if (it < NIT) WDN_LOAD(va, it);
    for (; it < NIT; it += 2 * NGW) {
        const int it1 = it + NGW, it2 = it + 2 * NGW;
        if (it1 < NIT) WDN_LOAD(vb, it1);
        WDN_FIN(va, it);
        if (it2 < NIT) WDN_LOAD(va, it2);
        if (it1 < NIT) WDN_FIN(vb, it1);
    }
#undef WDN_LOAD
#undef WDN_FIN
}
__device__ __forceinline__ void ph_prologue(const Args& a, const Ctx& C) {
    unsigned char* ws = a.ws;
    LAS float* scr = (LAS float*)(C.lds + C.wave * 16384);
    const int gw = C.vcu * 8 + C.wave, NGW = C.G * 8, lane = C.lane;
    for (int it = gw; it < 16 * 80; it += NGW) { const int kb = it / 80, nb = it % 80; tr_item(a.in[3], DIN, 64 * kb, 32 * nb, (bf16_t*)(ws + WS_WIN), DM, 32 * nb, nullptr, scr, lane); }
    for (int it = gw; it < 16 * 64; it += NGW) { const int kb = it / 64, nb = it % 64;
        if (nb < 32) tr_item(a.in[17], 2 * DM, 64 * kb, 32 * nb, (bf16_t*)(ws + WS_WXK), DM, 32 * nb, nullptr, scr, lane);
        else tr_item(a.in[17], 2 * DM, 64 * kb, 32 * nb, (bf16_t*)(ws + WS_WXV), DM, 32 * (nb - 32), nullptr, scr, lane); }
    for (int it = gw; it < 16 * 32; it += NGW) { const int kb = it / 32, nb = it % 32;
        tr_item(a.in[13], DM, 64 * kb, 32 * nb, (bf16_t*)(ws + WS_WOUT), DM, 32 * nb, (kb < 8) ? a.in[11] : (a.in[12] - DLRU), scr, lane);
        tr_item(a.in[18], DM, 64 * kb, 32 * nb, (bf16_t*)(ws + WS_WXO), DM, 32 * nb, nullptr, scr, lane); }
    for (int it = gw; it < NEXP * 16 * 32; it += NGW) { const int e = it / 512, r = it % 512, kb = r / 32, nb = r % 32, j = nb >> 3, half = (nb >> 2) & 1, q = nb & 3;
        f32x4 v8_[8]; tr_load(v8_, a.in[24] + (size_t)e * DM * DM, DM, 64 * kb, half * 512 + j * 128 + q * 32, lane); tr_finish8(v8_, 64 * kb, ws + WS_WGU, DM, e * 1024 + j * 256 + half * 128 + q * 32, a.in[19], WGU_SC, scr, lane); }
    for (int r = gw; r < DM; r += NGW) { const float gk = a.in[14][r]; const f32x4* src = (const f32x4*)(a.in[16] + (size_t)r * DM) + lane; u32x2* dst = (u32x2*)((bf16_t*)(ws + WS_WXQ) + (size_t)r * DM) + lane;
#pragma unroll
        for (int j = 0; j < 4; ++j) { const f32x4 v = src[64 * j]; u32x2 w; w.x = cvt_pk_bf16(v[0] * gk, v[1] * gk); w.y = cvt_pk_bf16(v[2] * gk, v[3] * gk); dst[64 * j] = w; } }
    conv_wdn(a, C, gw, NGW, WDN_SPLIT, NEXP * 8 * 32);
    { bf16_t* WR = (bf16_t*)(ws + WS_WR); const int gt = C.vcu * 512 + C.tid, NT = C.G * 512;
      for (int i = gt; i < 48 * DM; i += NT) { const int r = i / DM, k = i % DM; float v = 0.f;
          if (r < 4) v = a.in[20][k * NGRP + r] * a.in[19][k]; else if (r < 36) v = a.in[22][k * NEXP + (r - 4)] * a.in[19][k];
          WR[i] = (bf16_t)(cvt_pk_bf16(v, 0.f) & 0xffffu); }
      float* rope = (float*)(ws + WS_ROPE);
      for (int i = gt; i < SEQ * 8; i += NT) { const int pos = i >> 3, j = i & 7; const float ang = (float)pos * a.invf[j];
          const double tw = 6.283185307179586476925286766559; const double ad = (double)ang; const double red = ad - tw * __builtin_rint(ad / tw); const float rf = (float)red;
          rope[pos * 16 + j] = __cosf(rf); rope[pos * 16 + 8 + j] = __sinf(rf); } }
    for (int m = 2 * gw; m < NTOK; m += 2 * NGW) rms_row2_to_bf16(a.in[0] + (size_t)m * DM, a.in[2], (bf16_t*)(ws + WS_B) + (size_t)m * DM, lane);
    for (int m = 2 * gw; m < NMEM; m += 2 * NGW) rms_row2_to_bf16(a.in[1] + (size_t)m * DM, a.in[15], (bf16_t*)(ws + WS_MEMN) + (size_t)m * DM, lane);
}

__device__ __forceinline__ float gelu_tanh(float x) { const float x2 = x * x; const float z2 = x * (-2.0f * 0.7978845608028654f * 1.4426950408889634f) * (1.0f + 0.044715f * x2);
    return x * __builtin_amdgcn_rcpf(1.0f + __builtin_amdgcn_exp2f(z2)); }
__device__ __forceinline__ float one_minus_exp(float x) {
    const float p = -x * (1.0f + x * (0.5f + x * (0.16666667f + x * (0.041666668f + x * 0.0083333338f))));
    const float e = 1.0f - __builtin_amdgcn_exp2f(x * 1.4426950408889634f);
    return (x > -0.25f) ? p : e;
}
__device__ __forceinline__ void lru_unit(const Args& a, const Ctx& C, int b, int blk, int half) {
    unsigned char* ws = a.ws;
    const bf16_t* XL = (const bf16_t*)(ws + WS_A); const bf16_t* GL = XL + (size_t)NTOK * 512; bf16_t* YC = (bf16_t*)(ws + WS_C); float* SSQL = (float*)(ws + WS_SSQL);
    const int tid = C.tid, lane = C.lane, wave = C.wave, fr = lane & 15, fq = lane >> 4;
    LAS float* XW = (LAS float*)(C.lds + wave * 5120);
    LAS bf16_t* GW = (LAS bf16_t*)(C.lds + wave * 5120 + 2304);
    LAS bf16_t* YW = (LAS bf16_t*)(C.lds + wave * 5120 + 3584);
    LAS float* WSUM = (LAS float*)(C.lds + 40960);
    LAS float* CW = (LAS float*)(C.lds + 45056);
    const int c0 = blk * 64, oc0 = c0 + half * 32;
    bf16x8 wfr[2][2][2];
#pragma unroll
    for (int gt = 0; gt < 2; ++gt) { const float* W = a.in[gt == 0 ? 6 : 8] + (size_t)blk * 64 * 64;
#pragma unroll
        for (int nt = 0; nt < 2; ++nt)
#pragma unroll
            for (int ks = 0; ks < 2; ++ks) { u32x4 w; float f[8];
#pragma unroll
                for (int j = 0; j < 8; ++j) f[j] = W[(32 * ks + 8 * fq + j) * 64 + half * 32 + 16 * nt + fr];
                w.x = cvt_pk_bf16(f[0], f[1]); w.y = cvt_pk_bf16(f[2], f[3]); w.z = cvt_pk_bf16(f[4], f[5]); w.w = cvt_pk_bf16(f[6], f[7]);
                wfr[gt][nt][ks] = __builtin_bit_cast(bf16x8, w); } }
    float brg[2], big[2], sp[2], hc[2] = {0.f, 0.f};
#pragma unroll
    for (int nt = 0; nt < 2; ++nt) { const int ch = oc0 + 16 * nt + fr; brg[nt] = a.in[7][ch] * -1.4426950408889634f; big[nt] = a.in[9][ch] * -1.4426950408889634f; const float lam = a.in[10][ch];
        sp[nt] = -8.0f * 1.4426950408889634f * ((lam > 15.f) ? __expf(-lam) : log1pf(__expf(-lam))); }
    if (tid < 320) { const int k = tid >> 6, c = tid & 63; CW[tid] = (k < 4) ? a.in[4][k * DLRU + c0 + c] : a.in[5][c0 + c]; }
    u32x4 xrs[2][4][2], grs[2];
    const bf16_t* xrow0 = XL + ((size_t)b * SEQ + 16 * wave + fr) * 512 + c0 + 8 * fq;
    const bf16_t* grow0 = GL + ((size_t)b * SEQ + 16 * wave + (lane >> 2)) * 512 + oc0 + 8 * (lane & 3);
    const int tloc = 16 * wave + fr;
#define LRU_PREFETCH(t0_, xr, gr) do { _Pragma("unroll") for (int k = 0; k < 4; ++k) { const int tt = (t0_) + tloc - 3 + k; \
        if (tt >= 0) { const bf16_t* xp = xrow0 + (ptrdiff_t)((t0_) - 3 + k) * 512; xr[k][0] = *(const u32x4*)xp; xr[k][1] = *(const u32x4*)(xp + 32); } else { xr[k][0] = (u32x4){0u, 0u, 0u, 0u}; xr[k][1] = (u32x4){0u, 0u, 0u, 0u}; } } \
        gr = *(const u32x4*)(grow0 + (size_t)(t0_) * 512); } while (0)
    LRU_PREFETCH(0, xrs[0], grs[0]); LRU_PREFETCH(128, xrs[1], grs[1]);
    __syncthreads();
    for (int ch2 = 0; ch2 < SEQ / 256; ++ch2) {
#pragma unroll
      for (int sub = 0; sub < 2; ++sub) { const int ch = 2 * ch2 + sub, t0 = ch * 128; auto& xr = xrs[sub]; auto& gr = grs[sub];
        bf16x8 af[2];
#pragma unroll
        for (int ks = 0; ks < 2; ++ks) { float accv[8];
            { const f32x4 b0 = *(const LAS f32x4*)(CW + 256 + 32 * ks + 8 * fq), b1 = *(const LAS f32x4*)(CW + 256 + 32 * ks + 8 * fq + 4);
              accv[0] = b0[0]; accv[1] = b0[1]; accv[2] = b0[2]; accv[3] = b0[3]; accv[4] = b1[0]; accv[5] = b1[1]; accv[6] = b1[2]; accv[7] = b1[3]; }
#pragma unroll
            for (int k = 0; k < 4; ++k) { const f32x4 w0 = *(const LAS f32x4*)(CW + 64 * k + 32 * ks + 8 * fq), w1 = *(const LAS f32x4*)(CW + 64 * k + 32 * ks + 8 * fq + 4); const u32x4 x = xr[k][ks];
                accv[0] += w0[0] * bflo(x.x); accv[1] += w0[1] * bfhi(x.x); accv[2] += w0[2] * bflo(x.y); accv[3] += w0[3] * bfhi(x.y);
                accv[4] += w1[0] * bflo(x.z); accv[5] += w1[1] * bfhi(x.z); accv[6] += w1[2] * bflo(x.w); accv[7] += w1[3] * bfhi(x.w); }
            u32x4 p; p.x = cvt_pk_bf16(accv[0], accv[1]); p.y = cvt_pk_bf16(accv[2], accv[3]); p.z = cvt_pk_bf16(accv[4], accv[5]); p.w = cvt_pk_bf16(accv[6], accv[7]);
            af[ks] = __builtin_bit_cast(bf16x8, p);
            if (ks == half) { *(LAS f32x4*)(XW + fr * 36 + 8 * fq) = (f32x4){accv[0], accv[1], accv[2], accv[3]}; *(LAS f32x4*)(XW + fr * 36 + 8 * fq + 4) = (f32x4){accv[4], accv[5], accv[6], accv[7]}; } }
        *(LAS u32x4*)(GW + (lane >> 2) * 40 + 8 * (lane & 3)) = gr;
        if (ch + 2 < SEQ / 128) LRU_PREFETCH(t0 + 256, xr, gr);
        LDS_WAIT(); asm volatile("" ::: "memory");
        float Hl[2][4], Al[2][4], Aex[2], Hex[2];
        { f32x4 ar[2] = {{0.f, 0.f, 0.f, 0.f}, {0.f, 0.f, 0.f, 0.f}}, ai_[2] = {{0.f, 0.f, 0.f, 0.f}, {0.f, 0.f, 0.f, 0.f}};
#pragma unroll
          for (int ks = 0; ks < 2; ++ks)
#pragma unroll
              for (int nt = 0; nt < 2; ++nt) { ar[nt] = __builtin_amdgcn_mfma_f32_16x16x32_bf16(af[ks], wfr[0][nt][ks], ar[nt], 0, 0, 0); ai_[nt] = __builtin_amdgcn_mfma_f32_16x16x32_bf16(af[ks], wfr[1][nt][ks], ai_[nt], 0, 0, 0); }
#pragma unroll
          for (int nt = 0; nt < 2; ++nt) {
              float hrun = 0.f, arun = 1.f;
#pragma unroll
              for (int r = 0; r < 4; ++r) { const int chn = 16 * nt + fr;
                  const float rg = __builtin_amdgcn_rcpf(1.0f + __builtin_amdgcn_exp2f(__builtin_fmaf(ar[nt][r], -1.4426950408889634f, brg[nt])));
                  const float ig = __builtin_amdgcn_rcpf(1.0f + __builtin_amdgcn_exp2f(__builtin_fmaf(ai_[nt][r], -1.4426950408889634f, big[nt])));
                  const float av = __builtin_amdgcn_exp2f(rg * sp[nt]); const float mult = __builtin_amdgcn_sqrtf(fmaxf(1.0f - av * av, 0.f));
                  const float uv = mult * ig * XW[(4 * fq + r) * 36 + chn];
                  hrun = av * hrun + uv; arun *= av; Hl[nt][r] = hrun; Al[nt][r] = arun; }
              const float A0 = __shfl(arun, fr), H0 = __shfl(hrun, fr), A1 = __shfl(arun, fr + 16), H1 = __shfl(hrun, fr + 16), A2 = __shfl(arun, fr + 32), H2 = __shfl(hrun, fr + 32), A3 = __shfl(arun, fr + 48), H3 = __shfl(hrun, fr + 48);
              const float h01 = A1 * H0 + H1, a01 = A1 * A0, h012 = A2 * h01 + H2, a012 = A2 * a01;
              Aex[nt] = (fq == 0) ? 1.f : (fq == 1) ? A0 : (fq == 2) ? a01 : a012;
              Hex[nt] = (fq == 0) ? 0.f : (fq == 1) ? H0 : (fq == 2) ? h01 : h012;
              if (fq == 0) *(LAS f32x2*)(WSUM + (((ch & 1) * 8 + wave) * 32 + 16 * nt + fr) * 2) = (f32x2){A3 * a012, A3 * h012 + H3}; } }
        __syncthreads();
        { float ssr[4] = {0.f, 0.f, 0.f, 0.f};
#pragma unroll
          for (int nt = 0; nt < 2; ++nt) { const int chn = 16 * nt + fr; float x = hc[nt], mine = 0.f;
#pragma unroll
              for (int w2 = 0; w2 < 8; ++w2) { const f32x2 sm = *(const LAS f32x2*)(WSUM + (((ch & 1) * 8 + w2) * 32 + chn) * 2); if (w2 == wave) mine = x; x = sm[0] * x + sm[1]; }
              hc[nt] = x;
              const float hstart = Aex[nt] * mine + Hex[nt];
#pragma unroll
              for (int r = 0; r < 4; ++r) { const int tl = 4 * fq + r; const float h = Al[nt][r] * hstart + Hl[nt][r];
                  const float y = h * gelu_tanh(bf2f(GW[tl * 40 + chn])); const unsigned yb = cvt_pk_bf16(y, 0.f) & 0xffffu; YW[tl * 40 + chn] = (bf16_t)yb;
                  const float yr = __uint_as_float(yb << 16); ssr[r] += yr * yr; } }
#pragma unroll
          for (int r = 0; r < 4; ++r) { float q = ssr[r]; q += __shfl_xor(q, 1); q += __shfl_xor(q, 2); q += __shfl_xor(q, 4); q += __shfl_xor(q, 8);
              if (fr == 0) SSQL[((size_t)b * SEQ + t0 + 16 * wave + 4 * fq + r) * 16 + blk * 2 + half] = q; } }
        LDS_WAIT(); asm volatile("" ::: "memory");
        *(u32x4*)(YC + ((size_t)b * SEQ + t0 + 16 * wave + (lane >> 2)) * DM + oc0 + 8 * (lane & 3)) = *(const LAS u32x4*)(YW + (lane >> 2) * 40 + 8 * (lane & 3));
      }
    }
#undef LRU_PREFETCH
    __syncthreads();
}

__device__ __forceinline__ void moba_unit_simple(const Args& a, const Ctx& C, int b, int h, int qb) {
    unsigned char* ws = a.ws;
    const bf16_t* Q = (const bf16_t*)(ws + WS_A) + (size_t)2 * NTOK * 512; const bf16_t* K = Q + (size_t)NTOK * 512; const bf16_t* V = K + (size_t)NTOK * 512;
    bf16_t* YA = (bf16_t*)(ws + WS_B) + (size_t)NTOK * 512; const float* KSUM = (const float*)(ws + WS_KSUM);
    const int q = C.tid & 255, hf = C.tid >> 8; const size_t row = (size_t)b * SEQ + qb * 256 + q;
    float qv[64];
    { const u32x4* qp = (const u32x4*)(Q + row * 512 + h * 64);
#pragma unroll
      for (int i = 0; i < 8; ++i) { const u32x4 w = qp[i]; qv[8 * i] = bflo(w.x); qv[8 * i + 1] = bfhi(w.x); qv[8 * i + 2] = bflo(w.y); qv[8 * i + 3] = bfhi(w.y); qv[8 * i + 4] = bflo(w.z); qv[8 * i + 5] = bfhi(w.z); qv[8 * i + 6] = bflo(w.w); qv[8 * i + 7] = bfhi(w.w); } }
    unsigned sel = 0u;
    { float g[8];
#pragma unroll
      for (int n = 0; n < 8; ++n) { g[n] = -INFINITY;
          if (n < qb) { const float* ks = KSUM + (size_t)(b * 8 + n) * 512 + h * 64; float s = 0.f;
#pragma unroll
              for (int d = 0; d < 64; ++d) s += qv[d] * ks[d];
              g[n] = s; } }
      const int npick = qb < 3 ? qb : 3;
      for (int p = 0; p < npick; ++p) { int best = -1; float bv = -INFINITY;
#pragma unroll
          for (int n = 0; n < 8; ++n) { const bool ok = (n < qb) && !((sel >> n) & 1u) && (best < 0 || g[n] > bv); if (ok) { best = n; bv = g[n]; } }
          if (best >= 0) sel |= 1u << best; } }
    float o[32], mrun = -1e30f, l = 0.f;
#pragma unroll
    for (int d = 0; d < 32; ++d) o[d] = 0.f;
    for (int n = 0; n <= qb; ++n) {
        const bool own = (n == qb); const bool use = own || ((sel >> n) & 1u);
        if (!__any(use)) continue;
        for (int j = 0; j < 256; ++j) {
            const bool valid = use && (!own || j <= q);
            if (!__any(valid)) continue;
            const size_t krow = (size_t)b * SEQ + n * 256 + j;
            const u32x4* kp = (const u32x4*)(K + krow * 512 + h * 64); float s = 0.f;
#pragma unroll
            for (int i = 0; i < 8; ++i) { const u32x4 w = kp[i];
                s += qv[8 * i] * bflo(w.x) + qv[8 * i + 1] * bfhi(w.x) + qv[8 * i + 2] * bflo(w.y) + qv[8 * i + 3] * bfhi(w.y) + qv[8 * i + 4] * bflo(w.z) + qv[8 * i + 5] * bfhi(w.z) + qv[8 * i + 6] * bflo(w.w) + qv[8 * i + 7] * bfhi(w.w); }
            if (valid) {
                const float mnew = fmaxf(mrun, s), f = __builtin_amdgcn_exp2f(mrun - mnew), p = __builtin_amdgcn_exp2f(s - mnew);
                l = l * f + p; mrun = mnew;
                const u32x4* vp = (const u32x4*)(V + krow * 512 + h * 64 + 32 * hf);
#pragma unroll
                for (int i = 0; i < 4; ++i) { const u32x4 w = vp[i];
                    o[8 * i] = o[8 * i] * f + p * bflo(w.x); o[8 * i + 1] = o[8 * i + 1] * f + p * bfhi(w.x); o[8 * i + 2] = o[8 * i + 2] * f + p * bflo(w.y); o[8 * i + 3] = o[8 * i + 3] * f + p * bfhi(w.y);
                    o[8 * i + 4] = o[8 * i + 4] * f + p * bflo(w.z); o[8 * i + 5] = o[8 * i + 5] * f + p * bfhi(w.z); o[8 * i + 6] = o[8 * i + 6] * f + p * bflo(w.w); o[8 * i + 7] = o[8 * i + 7] * f + p * bfhi(w.w); }
            }
        }
    }
    const float inv = 1.0f / l;
    u32x4* op = (u32x4*)(YA + row * 512 + h * 64 + 32 * hf);
#pragma unroll
    for (int i = 0; i < 4; ++i) { u32x4 w; w.x = cvt_pk_bf16(o[8 * i] * inv, o[8 * i + 1] * inv); w.y = cvt_pk_bf16(o[8 * i + 2] * inv, o[8 * i + 3] * inv); w.z = cvt_pk_bf16(o[8 * i + 4] * inv, o[8 * i + 5] * inv); w.w = cvt_pk_bf16(o[8 * i + 6] * inv, o[8 * i + 7] * inv); op[i] = w; }
}

__device__ __forceinline__ void ph_ymix(const Args& a, const Ctx& C) {
    const bf16_t* YL = (const bf16_t*)(a.ws + WS_B); const bf16_t* YA = YL + (size_t)NTOK * 512; bf16_t* YM = (bf16_t*)(a.ws + WS_C);
    const int gw = C.vcu * 8 + C.wave, NGW = C.G * 8, lane = C.lane;
    for (int m = gw; m < NTOK; m += NGW) {
#pragma unroll
        for (int part = 0; part < 2; ++part) {
            const u32x4 w = *((const u32x4*)((part ? YA : YL) + (size_t)m * 512) + lane);
            float v[8] = {bflo(w.x), bfhi(w.x), bflo(w.y), bfhi(w.y), bflo(w.z), bfhi(w.z), bflo(w.w), bfhi(w.w)}; float s = 0.f;
#pragma unroll
            for (int i = 0; i < 8; ++i) s += v[i] * v[i];
            const float rstd = 1.0f / sqrtf(wave_sum(s) * (1.0f / 512.0f) + EPS);
            u32x4 o; o.x = cvt_pk_bf16(v[0] * rstd, v[1] * rstd); o.y = cvt_pk_bf16(v[2] * rstd, v[3] * rstd); o.z = cvt_pk_bf16(v[4] * rstd, v[5] * rstd); o.w = cvt_pk_bf16(v[6] * rstd, v[7] * rstd);
            *((u32x4*)(YM + (size_t)m * DM + part * 512) + lane) = o;
        }
    }
}

__device__ __forceinline__ void ph_router(const Args& a, const Ctx& C) {
    unsigned char* ws = a.ws;
    const bf16_t* H2B = (const bf16_t*)a.out + DM; const bf16_t* WR = (const bf16_t*)(ws + WS_WR); const float* SSQ2 = (const float*)(ws + WS_SSQ2);
    unsigned* CNT = (unsigned*)(ws + WS_CTL) + CW_CNT;
    int* TOKE = (int*)(ws + WS_TOK + TOK_E); int* TOKR = (int*)(ws + WS_TOK + TOK_R); float* TOKG = (float*)(ws + WS_TOK + TOK_G); int* LTOK = (int*)(ws + WS_LTOK); float* LRS = (float*)(ws + WS_LRS);
    constexpr int WRS = 1032;
    LAS bf16_t* WRL = (LAS bf16_t*)C.lds;
    LAS float* LG = (LAS float*)(C.lds + 99072) + C.wave * (16 * 49);
    LAS unsigned* lcnt = (LAS unsigned*)(C.lds + 99072 + 25088); LAS unsigned* lbase = lcnt + 32;
    const int lane = C.lane, fr = lane & 15, fq = lane >> 4;
    for (int i = C.tid; i < 48 * 128; i += 512) { const int r = i >> 7, c8 = i & 127; *(LAS u32x4*)(WRL + r * WRS + 8 * c8) = *(const u32x4*)(WR + (size_t)r * DM + 8 * c8); }
    for (int pass = 0; (pass * C.G) * 128 < NTOK; ++pass) {
        const int blk = pass * C.G + C.vcu; const bool live = blk * 128 < NTOK;
        if (C.tid < 32) lcnt[C.tid] = 0u;
        __syncthreads();
        int E1 = 0, E2 = 0; unsigned r1 = 0, r2 = 0; float ga = 0.f, gb = 0.f, rstd_t = 0.f; const int tb = blk * 128 + 16 * C.wave;
        if (live) {
            f32x4 acc[3] = {{0.f, 0.f, 0.f, 0.f}, {0.f, 0.f, 0.f, 0.f}, {0.f, 0.f, 0.f, 0.f}};
            bf16x8 af[32];
#pragma unroll
            for (int ks = 0; ks < 32; ++ks) af[ks] = *(const bf16x8*)(H2B + (size_t)(tb + fr) * LDH + 32 * ks + 8 * fq);
#pragma unroll
            for (int ks = 0; ks < 32; ++ks) {
#pragma unroll
                for (int nt = 0; nt < 3; ++nt) { const bf16x8 bfg = *(const LAS bf16x8*)(WRL + (16 * nt + fr) * WRS + 32 * ks + 8 * fq); acc[nt] = __builtin_amdgcn_mfma_f32_16x16x32_bf16(af[ks], bfg, acc[nt], 0, 0, 0); } }
#pragma unroll
            for (int nt = 0; nt < 3; ++nt)
#pragma unroll
                for (int r = 0; r < 4; ++r) LG[(4 * fq + r) * 49 + 16 * nt + fr] = acc[nt][r];
            LDS_WAIT(); asm volatile("" ::: "memory");
            if (lane < 16) { const int t = tb + lane; const float rstd = rstd_from_ssq(SSQ2, t); rstd_t = rstd; const LAS float* lg = LG + lane * 49;
                float g[4]; int grp = 0;
#pragma unroll
                for (int i = 0; i < 4; ++i) g[i] = lg[i] * rstd + a.in[21][i];
#pragma unroll
                for (int i = 1; i < 4; ++i) if (g[i] > g[grp]) grp = i;
                float gs = 0.f;
#pragma unroll
                for (int i = 0; i < 4; ++i) gs += __expf(g[i] - g[grp]);
                const float gw_ = 1.0f / gs;
                float e[8];
#pragma unroll
                for (int i = 0; i < 8; ++i) e[i] = lg[4 + 8 * grp + i] * rstd + a.in[23][8 * grp + i];
                int i1 = 0;
#pragma unroll
                for (int i = 1; i < 8; ++i) if (e[i] > e[i1]) i1 = i;
                int i2 = (i1 == 0) ? 1 : 0;
#pragma unroll
                for (int i = 0; i < 8; ++i) if (i != i1 && i != i2 && e[i] > e[i2]) i2 = i;
                const float eb = __expf(e[i2] - e[i1]); ga = gw_ / (1.0f + eb); gb = gw_ * eb / (1.0f + eb);
                E1 = grp * 8 + i1; E2 = grp * 8 + i2;
                r1 = atomicAdd((unsigned*)&lcnt[E1], 1u); r2 = atomicAdd((unsigned*)&lcnt[E2], 1u);
            }
        }
        __syncthreads();
        if (C.tid < 32) lbase[C.tid] = lcnt[C.tid] ? __hip_atomic_fetch_add(CNT + C.tid, lcnt[C.tid], __ATOMIC_RELAXED, __HIP_MEMORY_SCOPE_AGENT) : 0u;
        __syncthreads();
        if (live && lane < 16) { const int t = tb + lane;
            const int k1 = (int)(lbase[E1] + r1), k2 = (int)(lbase[E2] + r2);
            TOKE[2 * t] = E1; TOKR[2 * t] = k1; TOKG[2 * t] = ga; LTOK[E1 * LCAP + k1] = t; LRS[E1 * LCAP + k1] = rstd_t;
            TOKE[2 * t + 1] = E2; TOKR[2 * t + 1] = k2; TOKG[2 * t + 1] = gb; LTOK[E2 * LCAP + k2] = t; LRS[E2 * LCAP + k2] = rstd_t; }
        __syncthreads();
    }
}
__device__ __forceinline__ void moe_table(const Args& a, const Ctx& C) {
    LAS int* ts = (LAS int*)(C.lds + MOE_OFF);
    if (C.tid == 0) { const unsigned* CNT = (const unsigned*)(a.ws + WS_CTL) + CW_CNT; int acc = 0;
        for (int e = 0; e < NEXP; ++e) { ts[e] = acc; const unsigned c = __hip_atomic_load(CNT + e, __ATOMIC_RELAXED, __HIP_MEMORY_SCOPE_AGENT); ts[33 + e] = (int)c; acc += (int)((c + 255u) >> 8); }
        ts[NEXP] = acc; }
    __syncthreads();
}
__device__ __forceinline__ void ph_final(const Args& a, const Ctx& C, float* outp) {
    unsigned char* ws = a.ws;
    const bf16_t* YB = (const bf16_t*)(ws + WS_A); const float* TOKG = (const float*)(ws + WS_TOK + TOK_G); const int* TOKE = (const int*)(ws + WS_TOK + TOK_E); const int* TOKR = (const int*)(ws + WS_TOK + TOK_R);
    const LAS int* ts = (const LAS int*)(C.lds + MOE_OFF);
    const bf16_t* H2B = (const bf16_t*)a.out + DM; const float* gf = a.in[26];
    const int gw = C.vcu * 8 + C.wave, NGW = C.G * 8, lane = C.lane;
    f32x4 gn[4];
#pragma unroll
    for (int q = 0; q < 4; ++q) gn[q] = *(const f32x4*)(gf + 512 * (q >> 1) + 8 * lane + 4 * (q & 1));
    const int nit = (NTOK + NGW - 1) / NGW;
    int dnx = 0; float gnx = 0.f;
#define FIN_IDX(ib) do { const int tt_ = gw + ((ib) + (lane >> 1)) * NGW; dnx = 0; gnx = 0.f; \
        if (lane < 8 && tt_ < NTOK) { const int e_ = TOKE[2 * tt_ + (lane & 1)]; dnx = ts[e_] * 256 + TOKR[2 * tt_ + (lane & 1)]; gnx = TOKG[2 * tt_ + (lane & 1)]; } } while (0)
    FIN_IDX(0);
    for (int ib = 0; ib < nit; ib += 4) {
        const int dcur = dnx; const float gcur = gnx;
        if (ib + 4 < nit) FIN_IDX(ib + 4);
        u32x4 hw[4][2], y0[4][2], y1[4][2];
#pragma unroll
        for (int j = 0; j < 4; ++j) { const int t = gw + (ib + j) * NGW; const int d0 = __builtin_amdgcn_readlane(dcur, 2 * j), d1 = __builtin_amdgcn_readlane(dcur, 2 * j + 1);
            if (t < NTOK) {
#pragma unroll
                for (int hf = 0; hf < 2; ++hf) { hw[j][hf] = *((const u32x4*)(H2B + (size_t)t * LDH + 512 * hf) + lane); y0[j][hf] = *((const u32x4*)(YB + (size_t)d0 * DM + 512 * hf) + lane); y1[j][hf] = *((const u32x4*)(YB + (size_t)d1 * DM + 512 * hf) + lane); } } }
#pragma unroll
        for (int j = 0; j < 4; ++j) { const int t = gw + (ib + j) * NGW;
            const float g0 = __builtin_bit_cast(float, __builtin_amdgcn_readlane(__builtin_bit_cast(int, gcur), 2 * j)), g1 = __builtin_bit_cast(float, __builtin_amdgcn_readlane(__builtin_bit_cast(int, gcur), 2 * j + 1));
            if (t < NTOK) { float v[16]; float s2 = 0.f;
#pragma unroll
                for (int hf = 0; hf < 2; ++hf)
#pragma unroll
                    for (int e = 0; e < 4; ++e) { const unsigned h = hw[j][hf][e], p = y0[j][hf][e], q = y1[j][hf][e];
                        const float lo = bflo(h) + g0 * bflo(p) + g1 * bflo(q), hi = bfhi(h) + g0 * bfhi(p) + g1 * bfhi(q); v[8 * hf + 2 * e] = lo; v[8 * hf + 2 * e + 1] = hi; s2 += lo * lo + hi * hi; }
                const float rstd = __builtin_amdgcn_rsqf(wave_sum(s2) * (1.0f / DM) + EPS);
#pragma unroll
                for (int q = 0; q < 4; ++q) { const f32x4 o = {v[4 * q] * rstd * gn[q][0], v[4 * q + 1] * rstd * gn[q][1], v[4 * q + 2] * rstd * gn[q][2], v[4 * q + 3] * rstd * gn[q][3]};
                    *(f32x4*)(outp + (size_t)t * DM + 512 * (q >> 1) + 8 * lane + 4 * (q & 1)) = o; } } }
    }
#undef FIN_IDX
}

#include <hip/hip_bf16.h>
#include <cmath>
namespace attn_body {
using bf16=__hip_bfloat16;
using bf16x8=__attribute__((ext_vector_type(8)))short;
using s16x4=__attribute__((ext_vector_type(4)))short;
using f32x16=__attribute__((ext_vector_type(16)))float;
using u32x4=__attribute__((ext_vector_type(4)))unsigned;
using f32x4_t=__attribute__((ext_vector_type(4)))float;
constexpr int BATCH=16,NHEAD=8,SEQ=2048,D=64,DM=NHEAD*D,DMO=1024;
constexpr int NW=8,QBLK=32,QB=QBLK*NW,KVBLK=64,NQB=SEQ/QB;
constexpr int ATTN_PITCH=DM, ATTN_UNIT_ROWS=QB;
__device__ __forceinline__ int crow(int r,int hi){return (r&3)+8*(r>>2)+4*hi;}
#define SBAR() __builtin_amdgcn_sched_barrier(0)
__device__ __forceinline__ void cmask(f32x16&p0,f32x16&p1,int jb,int qrel,int hi){
  const float NEG=-INFINITY; int kb=64*jb+4*hi; asm volatile("":"+v"(kb));
  #pragma unroll
  for(int r=0;r<16;++r){int kv=kb+(r&3)+8*(r>>2); if(kv>qrel)p0[r]=NEG; if(kv+32>qrel)p1[r]=NEG;}
}

constexpr int NSLOT=3, SLOTB=8192;
constexpr int LDS_K=0, LDS_V=NSLOT*SLOTB, LDS_WS=2*NSLOT*SLOTB, LDS_OST=LDS_WS+NW*64*4, LDS_BYTES=LDS_OST+NW*4096;
constexpr float C2=0.125f*1.4426950408889634f;
__device__ __forceinline__ void glds16(const char*sbase,unsigned voff,unsigned lds_dst){unsigned keep;
  asm volatile("s_nop 4\n\ts_mov_b32 %0, m0\n\ts_mov_b32 m0, %3\n\ts_nop 0\n\tglobal_load_lds_dwordx4 %1, %2\n\ts_mov_b32 m0, %0":"=&s"(keep):"v"(voff),"s"(sbase),"s"(lds_dst):"memory");}
__device__ __forceinline__ const char* uni_ptr(const void*p){const unsigned long long v=(unsigned long long)p;const unsigned lo=__builtin_amdgcn_readfirstlane((unsigned)v),hi=__builtin_amdgcn_readfirstlane((unsigned)(v>>32));return (const char*)(((unsigned long long)hi<<32)|lo);}
__device__ __forceinline__ float max3f(float a,float b,float c){float r;asm("v_max3_f32 %0, %1, %2, %3":"=v"(r):"v"(a),"v"(b),"v"(c));return r;}
__device__ __forceinline__ float max2f(float a,float b){float r;asm("v_max_f32_e32 %0, %1, %2":"=v"(r):"v"(a),"v"(b));return r;}
__device__ __forceinline__ float fadd_s(float a,float b){float r;asm("v_add_f32_e32 %0, %1, %2":"=v"(r):"v"(a),"v"(b));return r;}
__device__ __forceinline__ float fsub_s(float a,float b){float r;asm("v_sub_f32_e32 %0, %1, %2":"=v"(r):"v"(a),"v"(b));return r;}
typedef float f32x2_t __attribute__((ext_vector_type(2))); typedef __bf16 bf16x2_t __attribute__((ext_vector_type(2)));
__device__ __forceinline__ unsigned cvtpk_s(float lo,float hi){f32x2_t v={lo,hi};bf16x2_t b=__builtin_convertvector(v,bf16x2_t);return __builtin_bit_cast(unsigned,b);}
#define WAIT_BAR(N) asm volatile("s_waitcnt vmcnt(" #N ") lgkmcnt(0)\n\ts_barrier":::"memory")

__device__ __forceinline__ void qkt(f32x16&p0,f32x16&p1,const char*Kslot,const bf16x8*qr,const f32x16&negm,int r32,int hi){
  const char*kb=Kslot+hi*1024+r32*16;
  #pragma unroll
  for(int d0=0;d0<4;++d0){
    const bf16x8 b0=*reinterpret_cast<const bf16x8*>(kb+d0*2048);
    const bf16x8 b1=*reinterpret_cast<const bf16x8*>(kb+d0*2048+512);
    if(d0==0){p0=__builtin_amdgcn_mfma_f32_32x32x16_bf16(b0,qr[0],negm,0,0,0);p1=__builtin_amdgcn_mfma_f32_32x32x16_bf16(b1,qr[0],negm,0,0,0);}
    else{p0=__builtin_amdgcn_mfma_f32_32x32x16_bf16(b0,qr[d0],p0,0,0,0);p1=__builtin_amdgcn_mfma_f32_32x32x16_bf16(b1,qr[d0],p1,0,0,0);}}
}
typedef __attribute__((address_space(3))) const char* lds_cptr;
typedef short v4i16_t __attribute__((ext_vector_type(4)));
__device__ __forceinline__ void kload8(bf16x8*kf,lds_cptr kp){
  kf[0]=*(const __attribute__((address_space(3))) bf16x8*)(kp);      kf[1]=*(const __attribute__((address_space(3))) bf16x8*)(kp+512);
  kf[2]=*(const __attribute__((address_space(3))) bf16x8*)(kp+2048); kf[3]=*(const __attribute__((address_space(3))) bf16x8*)(kp+2560);
  kf[4]=*(const __attribute__((address_space(3))) bf16x8*)(kp+4096); kf[5]=*(const __attribute__((address_space(3))) bf16x8*)(kp+4608);
  kf[6]=*(const __attribute__((address_space(3))) bf16x8*)(kp+6144); kf[7]=*(const __attribute__((address_space(3))) bf16x8*)(kp+6656);
}
__device__ __forceinline__ void kload2(bf16x8*kf,lds_cptr kp,int j){ kf[2*j]=*(const __attribute__((address_space(3))) bf16x8*)(kp+j*2048); kf[2*j+1]=*(const __attribute__((address_space(3))) bf16x8*)(kp+j*2048+512); }
__device__ __forceinline__ s16x4 vtr(lds_cptr p){ return __builtin_bit_cast(s16x4,__builtin_amdgcn_ds_read_tr16_b64_v4i16((__attribute__((address_space(3))) v4i16_t*)p)); }
__device__ __forceinline__ float rowmax(const f32x16&p0,const f32x16&p1){
  float a=max3f(p0[0],p0[1],p1[0]),b=max3f(p0[2],p0[3],p1[1]);a=max3f(a,p1[2],p1[3]);
  #pragma unroll
  for(int r=4;r<16;r+=4){a=max3f(a,p0[r],p0[r+1]);b=max3f(b,p0[r+2],p0[r+3]);a=max3f(a,p1[r],p1[r+1]);b=max3f(b,p1[r+2],p1[r+3]);}
  const float m=max2f(a,b);
  auto rr=__builtin_amdgcn_permlane32_swap(__float_as_uint(m),__float_as_uint(m),false,false);
  return max2f(__uint_as_float(rr[0]),__uint_as_float(rr[1]));
}
__device__ __forceinline__ void pv(f32x16*o,int vb,bf16x8 pa0,bf16x8 pa1,bf16x8 pa2,bf16x8 pa3){
  #pragma unroll
  for(int d0=0;d0<2;++d0){s16x4 lo[4],hi[4];
    #pragma unroll
    for(int ks=0;ks<4;++ks){
      asm volatile("ds_read_b64_tr_b16 %0,%1 offset:%c2":"=&v"(lo[ks]):"v"(vb),"i"(d0*4096+ks*1024):"memory");
      asm volatile("ds_read_b64_tr_b16 %0,%1 offset:%c2":"=&v"(hi[ks]):"v"(vb),"i"(d0*4096+ks*1024+512):"memory");}
    asm volatile("s_waitcnt lgkmcnt(0)":::"memory");SBAR();
    #define PK(k) (bf16x8){lo[k][0],lo[k][1],lo[k][2],lo[k][3],hi[k][0],hi[k][1],hi[k][2],hi[k][3]}
    o[d0]=__builtin_amdgcn_mfma_f32_32x32x16_bf16(pa0,PK(0),o[d0],0,0,0);
    o[d0]=__builtin_amdgcn_mfma_f32_32x32x16_bf16(pa1,PK(1),o[d0],0,0,0);
    o[d0]=__builtin_amdgcn_mfma_f32_32x32x16_bf16(pa2,PK(2),o[d0],0,0,0);
    o[d0]=__builtin_amdgcn_mfma_f32_32x32x16_bf16(pa3,PK(3),o[d0],0,0,0);
    #undef PK
  }
}

#ifndef ATTN_STORE16
#define ATTN_STORE16(p,v) (*(u32x4*)(p)=(v))
#endif
template<int THRL> __device__ __forceinline__ void attn_unit(int b,int h,int qb,const bf16*Q,const bf16*__restrict__ K,const bf16*__restrict__ V,bf16*O,const float*__restrict__ KSUM,float*__restrict__ SSQA,char*shm){
  int tid=threadIdx.x; asm volatile("":"+v"(tid));
  const int lane=tid&63,r32=lane&31,hi=lane>>5; const int wid=__builtin_amdgcn_readfirstlane(tid>>6);
  const long rowbase=(long)b*SEQ; const int q0=qb*QB;
  const bf16*Qw=Q+(rowbase+q0+wid*QBLK)*DM+h*D;
  const bf16*Kh=K+rowbase*DM+h*D,*Vh=V+rowbase*DM+h*D;
  const unsigned lds0=(unsigned)(uintptr_t)shm;
  float*wsf=(float*)(shm+LDS_WS)+wid*64;
  const char*Khu=uni_ptr(Kh);const char*Vhu=uni_ptr(Vh);
  const unsigned kvo=(unsigned)(lane*DM+wid*8)*2u;
  const unsigned vvo=(unsigned)((16*(wid&3)+(lane>>2))*DM+(wid>>2)*32+(lane&3)*8)*2u;
  const unsigned kdst=lds0+LDS_K+wid*1024, vdst=lds0+LDS_V+wid*1024;
  #define DMA_K(t,slot) glds16(Khu+(size_t)(t)*(KVBLK*DM*2),kvo,(unsigned)__builtin_amdgcn_readfirstlane(kdst+(slot)))
  #define DMA_V(t,slot) glds16(Vhu+(size_t)(t)*(KVBLK*DM*2),vvo,(unsigned)__builtin_amdgcn_readfirstlane(vdst+(slot)))
  const int vb0=(int)(lds0+LDS_V)+((lane>>4)&1)*32+(lane&3)*8+(4*hi+((lane&15)>>2))*64;
  const char*Kbase=shm+LDS_K; bf16x8 kf[8];
  const lds_cptr shm3=(lds_cptr)shm; const lds_cptr kp0=shm3+LDS_K+hi*1024+r32*16; const lds_cptr vp0=shm3+LDS_V+((lane>>4)&1)*32+(lane&3)*8+(4*hi+((lane&15)>>2))*64;
  const int NT=(q0+QB)/KVBLK;
  DMA_K(0,0);DMA_V(0,0);DMA_K(1,SLOTB);
  bf16x8 qr[4];
  #pragma unroll
  for(int d0=0;d0<4;++d0)qr[d0]=*reinterpret_cast<const bf16x8*>(&Qw[(long)r32*DM+d0*16+hi*8]);
  unsigned selm=1u<<qb;
  { float g[8];
    #pragma unroll
    for(int n=0;n<8;++n){ g[n]=-INFINITY;
      if(n<qb){ const float*ks=KSUM+(long)(b*8+n)*DM+h*D+hi*8; float s=0.f;
        #pragma unroll
        for(int d0=0;d0<4;++d0){ const f32x4_t k0=*reinterpret_cast<const f32x4_t*>(ks+d0*16), k1=*reinterpret_cast<const f32x4_t*>(ks+d0*16+4);
          const u32x4 qw=__builtin_bit_cast(u32x4,qr[d0]);
          s+=__uint_as_float(qw[0]<<16)*k0[0]+__uint_as_float(qw[0]&0xffff0000u)*k0[1]+__uint_as_float(qw[1]<<16)*k0[2]+__uint_as_float(qw[1]&0xffff0000u)*k0[3]
            +__uint_as_float(qw[2]<<16)*k1[0]+__uint_as_float(qw[2]&0xffff0000u)*k1[1]+__uint_as_float(qw[3]<<16)*k1[2]+__uint_as_float(qw[3]&0xffff0000u)*k1[3]; }
        s+=__shfl_xor(s,32); g[n]=s; } }
    const int npick=qb<3?qb:3;
    for(int p=0;p<npick;++p){ int best=-1; float bv=-INFINITY;
      #pragma unroll
      for(int n=0;n<8;++n){ const bool ok=(n<qb)&&!((selm>>n)&1u)&&(best<0||g[n]>bv); if(ok){best=n;bv=g[n];} }
      if(best>=0)selm|=1u<<best; } }
  #define BMASK(P0,P1,t) do{ float bias_=((selm>>((t)>>2))&1u)?-mhat:-INFINITY; asm volatile("":"+v"(bias_)); _Pragma("unroll") for(int r=0;r<16;++r){P0[r]+=bias_;P1[r]+=bias_;} }while(0)
  float mhat=0.f,l_reg=0.f;f32x16 o[2];{float z0_=0.f;asm volatile("":"+v"(z0_));_Pragma("unroll") for(int r=0;r<16;++r){o[0][r]=z0_;o[1][r]=z0_;}}const f32x16 negm=f32x16{};
  const int qrel=wid*QBLK+r32;
  #define CMASK(P0,P1,t) do{int jb_=(t)-(NT-4); if(jb_>=0)cmask(P0,P1,jb_,qrel,hi);}while(0)
  bool resc=false;
  #define START(P0,P1) do{ const float rm=__builtin_fmaxf(rowmax(P0,P1),-100.0f); resc=false; \
    { const float dl=rm; mhat=fadd_s(mhat,dl); \
      _Pragma("unroll") for(int r=0;r<16;++r){P0[r]=fsub_s(P0[r],dl);P1[r]=fsub_s(P1[r],dl);} \
      } \
    _Pragma("unroll") for(int r=0;r<16;++r)P0[r]=__builtin_amdgcn_exp2f(P0[r]); }while(0)
  #define RESC() do{ if(resc){ asm volatile("s_waitcnt lgkmcnt(0)":::"memory"); \
      _Pragma("unroll") for(int d_=0;d_<2;++d_) _Pragma("unroll") for(int r=0;r<16;++r)o[d_][r]*=wsf[crow(r,hi)]; } }while(0)
  f32x16 pA0,pA1,pB0,pB1;
  int sl_prev=0,sl_cur=0,sl_next=SLOTB;
  #define ROT() do{sl_prev=sl_cur;sl_cur=sl_next;sl_next=(sl_next==(NSLOT-1)*SLOTB)?0:sl_next+SLOTB;}while(0)
  DMA_K(2,2*SLOTB);
  WAIT_BAR(3);
  qkt(pA0,pA1,Kbase,qr,negm,r32,hi);asm volatile("s_nop 15\n\ts_nop 7":"+v"(pA0),"+v"(pA1));CMASK(pA0,pA1,0);BMASK(pA0,pA1,0);
  START(pA0,pA1);
  _Pragma("unroll") for(int r=0;r<16;++r)pA1[r]=__builtin_amdgcn_exp2f(pA1[r]);
  WAIT_BAR(0);
  DMA_K(3,0);DMA_V(1,SLOTB);
  ROT();
  kload8(kf,kp0+sl_cur);
  WAIT_BAR(2);
  s16x4 vlo[8],vhi[8]; u32x4 pw0,pw1,pw2,pw3;
  #define PKW(P,B) cvtpk_s(P[B],P[B+1])
  #define PAF(k) __builtin_bit_cast(bf16x8,pw##k)
  #define VFR(i) (bf16x8){vlo[i][0],vlo[i][1],vlo[i][2],vlo[i][3],vhi[i][0],vhi[i][1],vhi[i][2],vhi[i][3]}
  #define PIN(x) asm volatile("":"+v"(x))
  #define MX3(a,b,c) __builtin_fmaxf(__builtin_fmaxf((a),(b)),(c))
  #define GAPA(MF,A0,A1,A2,A3,W0,W1,PW) do{ MF; sacc+=A0; sacc+=A1; sacc+=A2; sacc+=A3; PIN(sacc); W0; W1; PIN(PW); SBAR(); }while(0)
  #define EX(v) __builtin_amdgcn_exp2f(v)
  #define GAPB(MF,X,B) do{ MF; X[B]=EX(X[B]); X[B+1]=EX(X[B+1]); X[B+2]=EX(X[B+2]); X[B+3]=EX(X[B+3]); PIN(X); SBAR(); }while(0)
  #define VRD(i) do{ vlo[i]=vtr(vp_+(((i)>>2)*4096+((i)&3)*1024)); vhi[i]=vtr(vp_+(((i)>>2)*4096+((i)&3)*1024+512)); }while(0)
  #define KRD(G,j) do{ if(G){ kload2(kf,kp0+sl_next,j); SBAR(); } }while(0)
  #define STEP(C0,C1,P0,P1,t,GK,GV,GL) do{ SBAR(); \
    const lds_cptr vp_=vp0+sl_prev; \
    VRD(0); SBAR(); float sacc=(P0[0]+P0[1]); \
    GAPA(C0=__builtin_amdgcn_mfma_f32_32x32x16_bf16(kf[0],qr[0],negm,0,0,0), P0[2],P0[3],P0[4],P0[5],     pw0[0]=PKW(P0,0), pw0[1]=PKW(P0,2), pw0); \
    VRD(4); SBAR(); GAPA(C1=__builtin_amdgcn_mfma_f32_32x32x16_bf16(kf[1],qr[0],negm,0,0,0), P0[6],P0[7],P0[8],P0[9],     pw0[2]=PKW(P0,4), pw0[3]=PKW(P0,6), pw0); \
    VRD(1); SBAR(); GAPA(C0=__builtin_amdgcn_mfma_f32_32x32x16_bf16(kf[2],qr[1],C0,0,0,0),   P0[10],P0[11],P0[12],P0[13], pw1[0]=PKW(P0,8), pw1[1]=PKW(P0,10), pw1); \
    VRD(5); SBAR(); GAPA(C1=__builtin_amdgcn_mfma_f32_32x32x16_bf16(kf[3],qr[1],C1,0,0,0),   P0[14],P0[15],P1[0],P1[1],   pw1[2]=PKW(P0,12),pw1[3]=PKW(P0,14), pw1); \
    VRD(2); SBAR(); GAPA(C0=__builtin_amdgcn_mfma_f32_32x32x16_bf16(kf[4],qr[2],C0,0,0,0),   P1[2],P1[3],P1[4],P1[5],     pw2[0]=PKW(P1,0), pw2[1]=PKW(P1,2), pw2); \
    VRD(6); SBAR(); GAPA(C1=__builtin_amdgcn_mfma_f32_32x32x16_bf16(kf[5],qr[2],C1,0,0,0),   P1[6],P1[7],P1[8],P1[9],     pw2[2]=PKW(P1,4), pw2[3]=PKW(P1,6), pw2); \
    VRD(3); SBAR(); GAPA(C0=__builtin_amdgcn_mfma_f32_32x32x16_bf16(kf[6],qr[3],C0,0,0,0),   P1[10],P1[11],P1[12],P1[13], pw3[0]=PKW(P1,8), pw3[1]=PKW(P1,10), pw3); \
    VRD(7); SBAR(); GAPA(C1=__builtin_amdgcn_mfma_f32_32x32x16_bf16(kf[7],qr[3],C1,0,0,0),   P1[14],P1[15],0.f,0.f,       pw3[2]=PKW(P1,12),pw3[3]=PKW(P1,14), pw3); \
    l_reg+=sacc; \
    if(GK){DMA_K((t)+3,sl_cur);} if(GV){DMA_V((t)+1,sl_next);} \
    CMASK(C0,C1,t); BMASK(C0,C1,t); \
    { float a=MX3(C0[0],C0[1],C1[0]),b=MX3(C0[2],C0[3],C1[1]); a=MX3(a,C1[2],C1[3]); \
      _Pragma("unroll") for(int r=4;r<16;r+=4){a=MX3(a,C0[r],C0[r+1]);b=MX3(b,C0[r+2],C0[r+3]);a=MX3(a,C1[r],C1[r+1]);b=MX3(b,C1[r+2],C1[r+3]);} \
      float rm=__builtin_fmaxf(a,b); { auto rr=__builtin_amdgcn_permlane32_swap(__float_as_uint(rm),__float_as_uint(rm),false,false); rm=__builtin_fmaxf(__uint_as_float(rr[0]),__uint_as_float(rr[1])); } \
      resc=false; \
      if(__builtin_expect(__any(rm>(float)THRL),0)){ const float dl=__builtin_fmaxf(rm,0.f); mhat+=dl; \
        _Pragma("unroll") for(int r=0;r<16;++r){C0[r]-=dl;C1[r]-=dl;} \
        const float f=__builtin_amdgcn_exp2f(-dl); l_reg*=f; if(hi==0)wsf[r32]=f; resc=true; } } \
    SBAR(); \
    GAPB(o[0]=__builtin_amdgcn_mfma_f32_32x32x16_bf16(PAF(0),VFR(0),o[0],0,0,0), C0,0); \
    GAPB(o[1]=__builtin_amdgcn_mfma_f32_32x32x16_bf16(PAF(0),VFR(4),o[1],0,0,0), C0,4); \
    KRD(GL,0); GAPB(o[0]=__builtin_amdgcn_mfma_f32_32x32x16_bf16(PAF(1),VFR(1),o[0],0,0,0), C0,8); \
    KRD(GL,1); GAPB(o[1]=__builtin_amdgcn_mfma_f32_32x32x16_bf16(PAF(1),VFR(5),o[1],0,0,0), C0,12); \
    KRD(GL,2); GAPB(o[0]=__builtin_amdgcn_mfma_f32_32x32x16_bf16(PAF(2),VFR(2),o[0],0,0,0), C1,0); \
    KRD(GL,3); GAPB(o[1]=__builtin_amdgcn_mfma_f32_32x32x16_bf16(PAF(2),VFR(6),o[1],0,0,0), C1,4); \
    GAPB(o[0]=__builtin_amdgcn_mfma_f32_32x32x16_bf16(PAF(3),VFR(3),o[0],0,0,0), C1,8); \
    GAPB(o[1]=__builtin_amdgcn_mfma_f32_32x32x16_bf16(PAF(3),VFR(7),o[1],0,0,0), C1,12); \
    }while(0)
  int t=1;
  #undef CMASK
  #define CMASK(P0,P1,t) do{}while(0)
  for(;t+5<NT;t+=2){
    STEP(pB0,pB1,pA0,pA1,t,true,true,true);     WAIT_BAR(2); RESC(); ROT();
    STEP(pA0,pA1,pB0,pB1,t+1,true,true,true);   WAIT_BAR(2); RESC(); ROT();
  }
  #undef CMASK
  #define CMASK(P0,P1,t) do{int jb_=(t)-(NT-4); if(jb_>=0)cmask(P0,P1,jb_,qrel,hi);}while(0)
  #define ENDW(tt) do{ if((tt)+3<NT){WAIT_BAR(2);} else if((tt)+2<NT){WAIT_BAR(1);} else {WAIT_BAR(0);} }while(0)
  for(;t+1<NT;t+=2){
    STEP(pB0,pB1,pA0,pA1,t,(t+3<NT),(t+1<NT),(t+1<NT));       ENDW(t);   RESC(); ROT();
    STEP(pA0,pA1,pB0,pB1,t+1,(t+4<NT),(t+2<NT),(t+2<NT));     ENDW(t+1); RESC(); ROT();
  }
  STEP(pB0,pB1,pA0,pA1,NT-1,false,false,false); RESC();
  { float sacc=pB0[0]+pB0[1]; _Pragma("unroll") for(int r=2;r<16;++r)sacc+=pB0[r]; _Pragma("unroll") for(int r=0;r<16;++r)sacc+=pB1[r]; l_reg+=sacc;
    pw0=(u32x4){PKW(pB0,0),PKW(pB0,2),PKW(pB0,4),PKW(pB0,6)};pw1=(u32x4){PKW(pB0,8),PKW(pB0,10),PKW(pB0,12),PKW(pB0,14)};pw2=(u32x4){PKW(pB1,0),PKW(pB1,2),PKW(pB1,4),PKW(pB1,6)};pw3=(u32x4){PKW(pB1,8),PKW(pB1,10),PKW(pB1,12),PKW(pB1,14)};
    SBAR(); pv(o,vb0+sl_cur,PAF(0),PAF(1),PAF(2),PAF(3)); }
  #undef PKW
  #undef PAF
  #undef VFR
  #undef PIN
  #undef MX3
  #undef GAPA
  #undef GAPB
  #undef EX
  #undef VRD
  #undef KRD
  #undef STEP
  #undef ENDW
  {auto rr=__builtin_amdgcn_permlane32_swap(__float_as_uint(l_reg),__float_as_uint(l_reg),false,false);l_reg=__uint_as_float(rr[0])+__uint_as_float(rr[1]);}
  if(hi==0)wsf[32+r32]=l_reg;asm volatile("s_waitcnt lgkmcnt(0)":::"memory");
  float rli[16];
  #pragma unroll
  for(int r=0;r<16;++r)rli[r]=__builtin_amdgcn_rcpf(wsf[32+crow(r,hi)]);
  bf16*Ow=O+(rowbase+q0+wid*QBLK)*DMO+h*D;
  { bf16*stg=(bf16*)(shm+LDS_OST)+wid*2048;
    #pragma unroll
    for(int r=0;r<16;++r){const int orow=crow(r,hi);
      #pragma unroll
      for(int d0=0;d0<2;++d0)stg[orow*64+d0*32+r32]=__float2bfloat16(o[d0][r]*rli[r]);}
    asm volatile("s_waitcnt lgkmcnt(0)":::"memory");
    #pragma unroll
    for(int i=0;i<4;++i){const int row=i*8+(lane>>3),ch=lane&7; const u32x4 v=*(const u32x4*)(stg+row*64+ch*8); ATTN_STORE16(Ow+(long)row*DMO+ch*8,v);
      float q=0.f;
      #pragma unroll
      for(int e=0;e<4;++e){const float lo=__uint_as_float(v[e]<<16),hi2=__uint_as_float(v[e]&0xffff0000u);q+=lo*lo+hi2*hi2;}
      q+=__shfl_xor(q,1);q+=__shfl_xor(q,2);q+=__shfl_xor(q,4);
      if(ch==0)SSQA[(rowbase+q0+wid*QBLK+row)*8+h]=q;} }
  asm volatile("s_waitcnt lgkmcnt(0)\n\ts_barrier":::"memory");
  #undef BMASK
  #undef DMA_K
  #undef DMA_V
  #undef CMASK
  #undef START
  #undef RESC
  #undef ROT
}
constexpr int ATTN_LDS_BYTES=LDS_BYTES;
#undef SBAR
#undef WAIT_BAR
}

#ifndef STAG_TICKS
#define STAG_TICKS 100
#endif
__device__ __forceinline__ void stagger(int c, int ticks) {
    const unsigned long long t0 = __builtin_amdgcn_s_memrealtime(); const unsigned long long w = (unsigned long long)(((c >> 3) & 3) * ticks);
    while (__builtin_amdgcn_s_memrealtime() - t0 < w) __builtin_amdgcn_s_sleep(8);
}
__global__ void __launch_bounds__(512, 2) mk_fwd(Args args) {
    extern __shared__ __attribute__((aligned(16))) unsigned char lds_raw[];
    Ctx C; C.lds = (LAS unsigned char*)lds_raw; C.tid = threadIdx.x; C.lane = C.tid & 63; C.wave = __builtin_amdgcn_readfirstlane(C.tid >> 6);
    C.G = gridDim.x; { const int bx = blockIdx.x; C.vcu = (C.G % 8 == 0) ? (bx % 8) * (C.G / 8) + bx / 8 : bx; }
    unsigned char* ws = args.ws;
    for (int u = C.tid; u < (LDS_BYTES - LDSCTL_OFF) / 4; u += 512) ((LAS unsigned*)(C.lds + LDSCTL_OFF))[u] = 0u;
    __syncthreads();
    XcdBarrier bar; bar.bar = (unsigned*)(ws + WS_CTL) + CW_BAR; bar.x = 0; bar.st = nullptr;
    if (N_LAUNCHES == 1) bar = xcd_barrier_post((unsigned*)(ws + WS_CTL) + CW_BAR, (volatile LAS unsigned*)(C.lds + MISC_OFF) + 8);
    const int lo = args.ph_lo, hi = args.ph_hi;
#ifndef PH_MASK
#define PH_MASK 0x3fff
#endif
#define IN(k) ((((PH_MASK) >> (k)) & 1) && lo <= (k) && (k) < hi)
#ifndef PROBE_REP
#define PROBE_REP -1
#endif
#define REP(k) for (int rep_ = 0; rep_ < ((PROBE_REP == (k)) ? 2 : 1); ++rep_)
#define REPBAR() do { if (rep_ > 0) xcd_barrier(bar); } while (0)
#define FRESH() do { int t_ = threadIdx.x; asm volatile("" : "+v"(t_)); C.tid = t_; C.lane = t_ & 63; C.wave = __builtin_amdgcn_readfirstlane(t_ >> 6); } while (0)
#define SEAM(k) do { if (IN(k) && IN((k) + 1)) xcd_barrier(bar); } while (0)
    const int cb = (int)blockIdx.x;

    if (IN(0)) REP(0) { REPBAR(); FRESH(); ph_prologue(args, C); SEAM(0); }
    if (PROBE_REP == 200) { for (int xb_ = 0; xb_ < 8; ++xb_) xcd_barrier(bar); }
    if (IN(1)) REP(1) { REPBAR();
        { Gemm g{(const bf16_t*)(ws + WS_B), (const bf16_t*)(ws + WS_WIN), DM, DM, DM}; PlainOrder S; S.init(NTOK, DIN, C.G, cb, DM, DM);
          EpiProj E{(bf16_t*)(ws + WS_A), (const float*)(ws + WS_ROPE), (float*)(ws + WS_KSUM)}; GEMM_PHASE(C.lds, g, S, E); }
        { Gemm g{(const bf16_t*)(ws + WS_MEMN), (const bf16_t*)(ws + WS_WXK), DM, DM, DM}; PlainOrder S; S.init(NMEM, DM, C.G, cb, DM, DM);
          EpiStore E{(bf16_t*)(ws + WS_KM), DM}; GEMM_PHASE(C.lds, g, S, E); }
        { Gemm g{(const bf16_t*)(ws + WS_MEMN), (const bf16_t*)(ws + WS_WXV), DM, DM, DM}; PlainOrder S; S.init(NMEM, DM, C.G, (cb + C.G - 64 % C.G) % C.G, DM, DM);
          EpiStore E{(bf16_t*)(ws + WS_VMT), DM}; GEMM_PHASE(C.lds, g, S, E); }
        { FRESH(); if (C.G == 256) { if (cb >= 128) conv_wdn(args, C, (cb - 128) * 8 + C.wave, 128 * 8, 0, WDN_SPLIT); }
          else conv_wdn(args, C, C.vcu * 8 + C.wave, C.G * 8, 0, WDN_SPLIT); }
        SEAM(1);
    }
    if (IN(2)) REP(2) { REPBAR(); FRESH();
        for (int lrep_ = 0; lrep_ < ((PROBE_REP == 102) ? 2 : 1); ++lrep_)
        for (int L = C.vcu; L < 256; L += C.G) lru_unit(args, C, L >> 4, (L >> 1) & 7, L & 1);
        for (int arep_ = 0; arep_ < ((PROBE_REP == 103) ? 2 : 1); ++arep_)
        for (int i = 0;; ++i) { const int aidx = i * C.G + C.vcu; if (aidx >= 1024) break; const int cc = aidx & 255, ii = aidx >> 8, bh = cc >> 1;
            const int qb = (cc & 1) ? ((ii == 0) ? 6 : (ii == 1) ? 1 : (ii == 2) ? 5 : 2) : ((ii == 0) ? 7 : (ii == 1) ? 0 : (ii == 2) ? 4 : 3);
#ifdef ATTN_SIMPLE
            moba_unit_simple(args, C, bh >> 3, bh & 7, qb); }
#else
            { const attn_body::bf16* Qp = (const attn_body::bf16*)(ws + WS_A) + (size_t)2 * NTOK * 512;
              attn_body::attn_unit<8>(bh >> 3, bh & 7, qb, Qp, Qp + (size_t)NTOK * 512, Qp + (size_t)2 * NTOK * 512, (attn_body::bf16*)(ws + WS_C) + 512, (const float*)(ws + WS_KSUM), (float*)(ws + WS_SSQA), (char*)lds_raw); } }
#endif
        SEAM(2);
    }
    if (IN(4)) REP(4) { REPBAR(); Gemm g{(const bf16_t*)(ws + WS_C), (const bf16_t*)(ws + WS_WOUT), DM, DM, DM}; PlainOrder S; S.init(NTOK, DM, C.G, cb, DM, DM);
        EpiResid<true, true> E{args.in[0], (bf16_t*)args.out, (float*)(ws + WS_SSQ1), (const float*)(ws + WS_SSQL), (const float*)(ws + WS_SSQA), ws + WS_B, 1.0f};     GEMM_PHASE(C.lds, g, S, E);
        { Gemm g2{(const bf16_t*)(ws + WS_KM), (const bf16_t*)(ws + WS_WXQ), DM, DM, XHD}; XpreOrder S2{C.G, cb, 0}; EpiStore8 E2{ws + WS_A, DM, QKT_SC}; GEMM_PHASE(C.lds, g2, S2, E2); }
        { Gemm g3{(const bf16_t*)(ws + WS_WXO), (const bf16_t*)(ws + WS_VMT), DM, DM, XHD}; XpreOrder S3{C.G, cb, 1}; EpiStore8 E3{ws + WS_A + 32 * MiB, DM, VWT_SC}; GEMM_PHASE(C.lds, g3, S3, E3); }
        SEAM(4); }
    if (IN(5)) REP(5) { REPBAR(); Gemm g{(const bf16_t*)(ws + WS_B), (const bf16_t*)(ws + WS_A), DM / 2, DM / 2, DM / 2}; XattnOrder S{C.G, cb, 0, DM / 2, DM / 2};
        EpiSoftmax E{ws + WS_B + 32 * MiB, DM, C.lds + LDSCTL_OFF + 4096, (const float*)(ws + WS_SSQ1), XSCALE / QKT_SC}; GEMM_PHASE8(C.lds, g, S, E); SEAM(5); }
    if (IN(8)) REP(8) { REPBAR(); Gemm g{(const bf16_t*)(ws + WS_B + 32 * MiB), (const bf16_t*)(ws + WS_A + 32 * MiB), DM / 2, DM / 2, DM / 2}; XattnOrder S{C.G, cb, 1, DM / 2, DM / 2};
        EpiResid<false, false> E{(const bf16_t*)args.out, (bf16_t*)args.out + DM, (float*)(ws + WS_SSQ2), nullptr, nullptr, ws + WS_H2F8, 1.0f / (PX_SC * VWT_SC)}; GEMM_PHASE8(C.lds, g, S, E); SEAM(8); }
    if (IN(9)) REP(9) { REPBAR(); FRESH(); ph_router(args, C); SEAM(9); }
    if (IN(11)) REP(11) { REPBAR(); FRESH(); moe_table(args, C); Gemm g{(const bf16_t*)(ws + WS_H2F8), (const bf16_t*)(ws + WS_WGU), DM / 2, DM / 2, DM / 2};
        MoeOrder<true> S{(const LAS int*)(C.lds + MOE_OFF), C.G, cb, DM / 2, DM / 2, (const int*)(ws + WS_LTOK), (unsigned)DM};
        EpiGateUp E{ws + WS_B, (const float*)(ws + WS_LRS)}; GEMM_PHASE8(C.lds, g, S, E); SEAM(11); }
    if (IN(12)) REP(12) { REPBAR(); FRESH(); moe_table(args, C); Gemm g{(const bf16_t*)(ws + WS_B), (const bf16_t*)(ws + WS_WDN), DFF / 2, DFF / 2, DFF / 2};
        MoeOrder<false> S{(const LAS int*)(C.lds + MOE_OFF), C.G, cb, DFF / 2, DFF / 2, nullptr, 0u};
        if (PROBE_REP == 312) { EpiNull EN{}; GEMM_PHASE8(C.lds, g, S, EN); xcd_barrier(bar); }
        EpiStore E{(bf16_t*)(ws + WS_A), DM, 1.0f / (WDN_SC * ACT_SC)}; GEMM_PHASE8(C.lds, g, S, E); SEAM(12); }
    if (IN(13)) REP(13) { REPBAR(); FRESH(); moe_table(args, C); ph_final(args, C, (PROBE_REP == 13 && rep_ == 0) ? (float*)(ws + WS_B) : args.out); }
#undef IN
#undef FRESH
#undef SEAM
}

extern "C" void kernel_launch(void* const* d_in, const int* in_sizes, int n_in, void* d_out, int out_size, void* d_ws, size_t ws_size, hipStream_t stream) {
    static int grid = 0;
    if (grid == 0) {
        if (n_in != 27 || out_size != NTOK * DM || ws_size < WS_END) { fprintf(stderr, "kernel_launch: unexpected shapes (n_in %d out %d ws %zu)\n", n_in, out_size, ws_size); grid = -1; return; }
        int dev = 0, cus = 0, per_cu = 0;
        if (hipGetDevice(&dev) != hipSuccess || hipDeviceGetAttribute(&cus, hipDeviceAttributeMultiprocessorCount, dev) != hipSuccess) { grid = -1; return; }
        if (hipFuncSetAttribute((const void*)mk_fwd, hipFuncAttributeMaxDynamicSharedMemorySize, LDS_BYTES) != hipSuccess) { fprintf(stderr, "kernel_launch: hipFuncSetAttribute failed\n"); grid = -1; return; }
        if (hipOccupancyMaxActiveBlocksPerMultiprocessor(&per_cu, (const void*)mk_fwd, 512, LDS_BYTES) != hipSuccess || per_cu < 1) fprintf(stderr, "kernel_launch: occupancy query reports %d\n", per_cu);
        (void)hipGetLastError();
        grid = cus;
    }
    if (grid < 0) return;
    (void)hipMemsetAsync((char*)d_ws + WS_CTL, 0, CTL_ZERO_BYTES, stream);
    Args a{};
    for (int i = 0; i < 27; ++i) a.in[i] = (const float*)d_in[i];
    a.out = (float*)d_out; a.ws = (unsigned char*)d_ws;
    const float invf[8] = {1.0f, 0.1939227432012558f, 0.03760603070259094f, 0.007292664609849453f, 0.0014142135623842478f, 0.00027424818836152554f, 5.318296098266728e-05f, 1.0313386155758053e-05f};
    for (int i = 0; i < 8; ++i) a.invf[i] = invf[i];
    if (N_LAUNCHES == 1) { a.ph_lo = 0; a.ph_hi = N_PHASES; hipLaunchKernelGGL(mk_fwd, dim3(grid), dim3(512), LDS_BYTES, stream, a); }
    else for (int p = 0; p < N_PHASES; ++p) { a.ph_lo = p; a.ph_hi = p + 1; hipLaunchKernelGGL(mk_fwd, dim3(grid), dim3(512), LDS_BYTES, stream, a); }
}
```

```cpp
#include <hip/hip_runtime.h>
#include <cstdio>
#include <cstdint>

#define LAS __attribute__((address_space(3)))
#define GAS __attribute__((address_space(1)))
typedef unsigned short bf16_t;
typedef short bf16x8 __attribute__((ext_vector_type(8)));
typedef float f32x4 __attribute__((ext_vector_type(4)));
typedef float f32x2 __attribute__((ext_vector_type(2)));
typedef unsigned u32x4 __attribute__((ext_vector_type(4)));
typedef unsigned u32x2 __attribute__((ext_vector_type(2)));

#ifndef MK_N_LAUNCHES
#define MK_N_LAUNCHES 1
#endif
constexpr int N_PHASES = 14;
constexpr int N_LAUNCHES = MK_N_LAUNCHES;

constexpr int BATCH = 16, SEQ = 2048, DM = 1024, NTOK = BATCH * SEQ;
constexpr int DLRU = 512, DATT = 512, DIN = 2560, NHEAD = 8, HD = 64, NBLK = 8, MBLK = 256;
constexpr int MEMLEN = 256, NXH = 4, XHD = 256, NMEM = BATCH * MEMLEN;
constexpr int NEXP = 32, EPG = 8, NGRP = 4, DFF = 512;
constexpr float EPS = 1e-6f;
constexpr float QKT_SC = 8.0f, VWT_SC = 8.0f, PX_SC = 256.0f;
constexpr float WGU_SC = 64.0f, WDN_SC = 32.0f, ACT_SC = 16.0f, YB_SC = 16.0f;
constexpr int WDN_SPLIT = 3072;
constexpr int MAXTILES = 288, LCAP = 65536, LDH = 2048;
constexpr float QSCALE = 0.125f * 1.4426950408889634f;
constexpr float XSCALE = 0.0625f * 1.4426950408889634f;

constexpr size_t MiB = 1u << 20;
constexpr size_t WS_CTL = 0, CTL_ZERO_BYTES = 1 * MiB;
constexpr int CW_TMO = 0, CW_BAR = 4096, CW_CNT = 8192;
constexpr size_t WS_KSUM = 512 * 1024;
constexpr size_t WS_WIN = 2 * MiB, WS_WXK = 7 * MiB, WS_WXV = 9 * MiB, WS_WOUT = 11 * MiB, WS_WXQ = 13 * MiB, WS_WXO = 15 * MiB;
constexpr size_t WS_WR = 17 * MiB, WS_ROPE = 18 * MiB, WS_SSQ1 = 19 * MiB, WS_SSQ2 = 21 * MiB, WS_TOK = 23 * MiB, WS_RSC = 24 * MiB;
constexpr size_t WS_MEMN = 25 * MiB, WS_KM = 33 * MiB, WS_VMT = 41 * MiB, WS_WGU = 49 * MiB, WS_WDN = 113 * MiB;
constexpr size_t WS_A = 145 * MiB, WS_B = 305 * MiB, WS_C = 385 * MiB, WS_SSQL = 449 * MiB, WS_SSQA = 451 * MiB, WS_LTOK = 452 * MiB, WS_LRS = 460 * MiB, WS_H2F8 = 468 * MiB, WS_END = 500 * MiB;
constexpr size_t TOK_E = 0, TOK_R = 256 * 1024, TOK_G = 512 * 1024, TOK_D = 768 * 1024;

constexpr int RING_BYTES = 131072;
constexpr int LDSCTL_OFF = RING_BYTES, MISC_OFF = LDSCTL_OFF + 320, MOE_OFF = LDSCTL_OFF + 1024;
constexpr int LDS_BYTES = 147456;

__device__ __forceinline__ unsigned cvt_pk_bf16(float lo, float hi) { unsigned r; asm volatile("v_cvt_pk_bf16_f32 %0, %1, %2" : "=v"(r) : "v"(lo), "v"(hi)); return r; }
__device__ __forceinline__ float bflo(unsigned w) { return __uint_as_float(w << 16); }
__device__ __forceinline__ float bfhi(unsigned w) { return __uint_as_float(w & 0xffff0000u); }
__device__ __forceinline__ float bf2f(bf16_t b) { return __uint_as_float((unsigned)b << 16); }
__device__ __forceinline__ float wave_sum(float v) {
#pragma unroll
    for (int o = 1; o < 64; o <<= 1) v += __shfl_xor(v, o);
    return v;
}
#define LDS_WAIT() asm volatile("s_waitcnt lgkmcnt(0)" ::: "memory")
__device__ __forceinline__ float sigmoidf_(float x) { return __builtin_amdgcn_rcpf(1.0f + __builtin_amdgcn_exp2f(x * -1.4426950408889634f)); }

#define XB_TMO      128
#define XB_XCNT(j)  (256  + 64 * (j))
#define XB_XSUB(j)  (1280 + 64 * (j))
#define XB_XGEN(j)  (2304 + 64 * (j))
#define XB_TOP      3328
#define XB_TOPGEN   3392
#define XCD_BAR_WORDS 3456
#define XB_SPIN_CAP (1u << 18)
__device__ __forceinline__ unsigned xb_ld(unsigned* p)              { return __hip_atomic_load(p, __ATOMIC_RELAXED, __HIP_MEMORY_SCOPE_AGENT); }
__device__ __forceinline__ unsigned xb_add(unsigned* p, unsigned v) { return __hip_atomic_fetch_add(p, v, __ATOMIC_RELAXED, __HIP_MEMORY_SCOPE_AGENT); }
__device__ __forceinline__ unsigned xb_xcc_id() { return (unsigned)__builtin_amdgcn_s_getreg((3 << 11) | 20) & 0xFu; }
#define XB_SPIN(cond, bar) do { unsigned _sp = 0; while (cond) { __builtin_amdgcn_s_sleep(1); \
    if ((++_sp & 255u) == 0u) { if (xb_ld(&(bar)[XB_TMO])) break; if (_sp > XB_SPIN_CAP) { atomicAdd(&(bar)[XB_TMO], 1u); break; } } } } while (0)
struct XcdBarrier { unsigned* bar; unsigned x; volatile LAS unsigned* st; };
__device__ __forceinline__ XcdBarrier xcd_barrier_post(unsigned* bar, volatile LAS unsigned* st) {
    XcdBarrier b; b.bar = bar; b.x = xb_xcc_id(); b.st = st;
    if (threadIdx.x == 0) (void)xb_add(&bar[XB_XCNT(b.x)], 1u);
    return b;
}
__device__ __forceinline__ void xcd_barrier_complete(unsigned* bar, unsigned x, unsigned& nloc, unsigned& nx) {
    const unsigned G = gridDim.x * gridDim.y * gridDim.z;
    unsigned sum, cnt, mine, sp = 0u;
    for (;;) {
        sum = 0u; cnt = 0u; mine = 0u;
#pragma unroll
        for (unsigned j = 0; j < 16; ++j) { const unsigned c = xb_ld(&bar[XB_XCNT(j)]); sum += c; cnt += (c > 0u) ? 1u : 0u; mine = (j == x) ? c : mine; }
        if (sum == G) break;
        __builtin_amdgcn_s_sleep(1);
        if ((++sp & 255u) == 0u) { if (xb_ld(&bar[XB_TMO])) break; if (sp > XB_SPIN_CAP) { atomicAdd(&bar[XB_TMO], 1u); break; } }
    }
    nloc = mine > 0u ? mine : 1u; nx = cnt > 0u ? cnt : 1u;
}
__device__ __forceinline__ void xcd_barrier(const XcdBarrier& b) {
    asm volatile("s_waitcnt vmcnt(0)" ::: "memory");
    __syncthreads();
    if (threadIdx.x == 0) {
        unsigned* bar = b.bar;
        __builtin_amdgcn_s_waitcnt(0);
        unsigned nloc = b.st[0], nx = b.st[1];
        if (nloc == 0u) { xcd_barrier_complete(bar, b.x, nloc, nx); b.st[0] = nloc; b.st[1] = nx; }
        const unsigned old = xb_add(&bar[XB_XSUB(b.x)], 1u);
        const unsigned gen = old / nloc;
        if (old + 1u == (gen + 1u) * nloc) {
            __builtin_amdgcn_fence(__ATOMIC_RELEASE, "agent");
            asm volatile("s_waitcnt vmcnt(0)" ::: "memory");
            const unsigned og = xb_add(&bar[XB_TOP], 1u);
            const unsigned tg = og / nx;
            if (og + 1u == (tg + 1u) * nx) xb_add(&bar[XB_TOPGEN], 1u);
            else XB_SPIN(xb_ld(&bar[XB_TOPGEN]) == tg, bar);
            __builtin_amdgcn_fence(__ATOMIC_ACQUIRE, "agent");
            xb_add(&bar[XB_XGEN(b.x)], 1u);
            asm volatile("s_waitcnt vmcnt(0)" ::: "memory");
        } else {
            XB_SPIN(xb_ld(&bar[XB_XGEN(b.x)]) == gen, bar);
            __builtin_amdgcn_fence(__ATOMIC_ACQUIRE, "agent");
            asm volatile("s_waitcnt vmcnt(0)" ::: "memory");
        }
    }
    __syncthreads();
}

struct Unit { int pm, pn; size_t a_off, b_off; int lbase, nvalid; };
struct Gemm { const bf16_t* A; const bf16_t* Bt; int lda, ldb, K; };
__host__ __device__ __forceinline__ int perm32(int rho) { const int n = rho >> 4, i = rho & 15; return 8 * (i >> 2) + 4 * n + (i & 3); }

struct PlainOrder {     static constexpr bool GATHER = false;
    int nM, nN, nwg, G, c, lda, ldb;
    __device__ void init(int M, int N, int G_, int c_, int lda_, int ldb_) { nM = M / 256; nN = N / 256; nwg = nM * nN; G = G_; c = c_; lda = lda_; ldb = ldb_; }
    __device__ bool next(int i, Unit& u) const {
        const long L = (long)i * G + c; if (L >= nwg) return false;
        int wgid = (int)L; { const int q = nwg / 8, r = nwg % 8, xcd = wgid % 8, off = wgid / 8; wgid = (xcd < r ? xcd * (q + 1) : r * (q + 1) + (xcd - r) * q) + off; }
        const int nig = 8 * nN, gid = wgid / nig, fm = gid * 8, gsz = (nM - fm) < 8 ? (nM - fm) : 8;
        u.pm = fm + ((wgid % nig) % gsz); u.pn = (wgid % nig) / gsz;
        u.a_off = (size_t)u.pm * 256 * lda; u.b_off = (size_t)u.pn * 256 * ldb; return true;
    }
};
struct XpreOrder {
    static constexpr bool GATHER = false;
    int G, c, mode;
    __device__ bool next(int i, Unit& u) const {
        const int L = i * G + c; if (L >= 256) return false;
        const int b = L >> 4, x = (L >> 2) & 3, y = L & 3;
        if (mode == 0) { const int h = x, kt = y; u.pm = b * 4 + h; u.pn = kt; u.a_off = (size_t)b * MEMLEN * DM + h * XHD; u.b_off = (size_t)kt * 256 * DM + h * XHD; }
        else { const int nt = x, h = y; u.pm = b * 4 + nt; u.pn = h; u.a_off = (size_t)nt * 256 * DM + h * XHD; u.b_off = (size_t)b * MEMLEN * DM + h * XHD; }
        return true;
    }
};
struct XattnOrder {
    static constexpr bool GATHER = false;
    int G, c, mode, lda, ldb;
    __device__ bool next(int i, Unit& u) const {
        int L = i * G + c; if (L >= (NTOK / 256) * 4) return false;
        if (G == 256) { const int x = c & 7, idx = c >> 3; L = ((x + 8 * i) * 8 + (idx >> 2)) * 4 + (idx & 3); }
        u.pm = L >> 2; u.pn = L & 3; const int b = u.pm >> 3;
        u.a_off = (size_t)u.pm * 256 * lda;
        u.b_off = mode == 0 ? (size_t)(b * 4 + u.pn) * 256 * ldb : (size_t)(b * 1024 + u.pn * 256) * ldb;
        return true;
    }
};
template <bool GATH_> struct MoeOrder {
    static constexpr bool GATHER = GATH_;
    const LAS int* ts; int G, c, lda, ldb; const int* ltok; unsigned rowbytes;
    __device__ bool next(int i, Unit& u) const {
        const int L = i * G + c; if (L >= ts[NEXP] * 4) return false;
        const int T = L >> 2, j = L & 3; int e = 0; while (ts[e + 1] <= T) ++e;
        const int lt = T - ts[e];
        u.pm = T; u.pn = j; u.a_off = GATH_ ? (size_t)0 : (size_t)T * 256 * lda; u.b_off = ((size_t)e * 1024 + j * 256) * ldb;
        u.lbase = e * LCAP + lt * 256; u.nvalid = ts[33 + e] - lt * 256; return true;
    }
    __device__ __forceinline__ unsigned rowoff(const Unit& u, int r) const { return (r < u.nvalid) ? (unsigned)ltok[u.lbase + r] * rowbytes : 0u; }
};

template <class Epi, class Sched>
__device__ __forceinline__ void gemm_phase_simple(LAS unsigned char* lds, const Gemm g, const Sched& S, const Epi& E) {
    int tid = threadIdx.x; asm volatile("" : "+v"(tid));
    const int wid = __builtin_amdgcn_readfirstlane(tid >> 6), lane = tid & 63, wr = wid >> 2, wc = wid & 3, fr = lane & 15, fq = lane >> 4;
    Unit u;
    for (int i = 0; S.next(i, u); ++i) {
        f32x4 acc[2][2][4][2];
#pragma unroll
        for (int a = 0; a < 2; ++a)
#pragma unroll
            for (int b = 0; b < 2; ++b)
#pragma unroll
                for (int m = 0; m < 4; ++m)
#pragma unroll
                    for (int n = 0; n < 2; ++n) acc[a][b][m][n] = (f32x4){0.f, 0.f, 0.f, 0.f};
        const char* Ab = (const char*)(g.A + u.a_off); const char* Bb = (const char*)(g.Bt + u.b_off);
        const int c0 = Epi::PERM ? perm32(fr) : fr, c1 = Epi::PERM ? perm32(16 + fr) : 16 + fr;
        unsigned ao[2][4], bo[2][2];
#pragma unroll
        for (int ai = 0; ai < 2; ++ai)
#pragma unroll
            for (int m = 0; m < 4; ++m) ao[ai][m] = (unsigned)((128 * ai + 64 * wr + 16 * m + fr) * g.lda + 8 * fq) * 2u;
#pragma unroll
        for (int bj = 0; bj < 2; ++bj) { bo[bj][0] = (unsigned)((128 * bj + 32 * wc + c0) * g.ldb + 8 * fq) * 2u; bo[bj][1] = (unsigned)((128 * bj + 32 * wc + c1) * g.ldb + 8 * fq) * 2u; }
#pragma unroll 1
        for (int k0 = 0; k0 < g.K; k0 += 32) {
            if constexpr (Epi::MIDK) { if (k0 == (g.K >> 1)) E.midk(acc, u, wr, wc, fr, fq); }
            const char* Ak = Ab + (size_t)k0 * 2; const char* Bk = Bb + (size_t)k0 * 2;
            bf16x8 bfr[2][2];
#pragma unroll
            for (int bj = 0; bj < 2; ++bj) { bfr[bj][0] = *(const bf16x8*)(Bk + bo[bj][0]); bfr[bj][1] = *(const bf16x8*)(Bk + bo[bj][1]); }
#pragma unroll
            for (int ai = 0; ai < 2; ++ai) {
                bf16x8 af[4];
#pragma unroll
                for (int m = 0; m < 4; ++m) af[m] = *(const bf16x8*)(Ak + ao[ai][m]);
#pragma unroll
                for (int bj = 0; bj < 2; ++bj)
#pragma unroll
                    for (int m = 0; m < 4; ++m)
#pragma unroll
                        for (int n = 0; n < 2; ++n) acc[ai][bj][m][n] = __builtin_amdgcn_mfma_f32_16x16x32_bf16(bfr[bj][n], af[m], acc[ai][bj][m][n], 0, 0, 0);
            }
        }
        E(acc, u, wr, wc, fr, fq);
    }
}

typedef int v8i __attribute__((ext_vector_type(8)));
typedef int v4i __attribute__((ext_vector_type(4)));
__device__ __forceinline__ v8i cat8(bf16x8 lo, bf16x8 hi) { const v4i a = __builtin_bit_cast(v4i, lo), b = __builtin_bit_cast(v4i, hi); return __builtin_shufflevector(a, b, 0, 1, 2, 3, 4, 5, 6, 7); }
template <int H> __device__ __forceinline__ bf16x8 half8(v8i v) { const v4i h = H ? __builtin_shufflevector(v, v, 4, 5, 6, 7) : __builtin_shufflevector(v, v, 0, 1, 2, 3); return __builtin_bit_cast(bf16x8, h); }
__device__ __forceinline__ unsigned pk4_fp8(float a, float b, float c, float d) { int w = __builtin_amdgcn_cvt_pk_fp8_f32(a, b, 0, false); w = __builtin_amdgcn_cvt_pk_fp8_f32(c, d, w, true); return (unsigned)w; }
__host__ __device__ __forceinline__ int lds_byte(int r, int c) { const int st = (r >> 4) * 2 + (c >> 5), rr = r & 15, cc = c & 31, ob = rr * 64 + cc * 2; return st * 1024 + (ob ^ (((ob >> 9) & 1) << 5)); }
__host__ __device__ __forceinline__ void stage_rc(int b, int& R, int& C) { const int st = b / 1024, sb = b % 1024, swz = sb ^ (((sb >> 9) & 1) << 5); R = (st >> 1) * 16 + swz / 64; C = (st & 1) * 32 + (swz % 64) / 2; }
template <class Epi, class Sched, bool ALIGN_EPI = false, bool SP2 = false, bool F8 = false>
__device__ __forceinline__ void gemm_phase(LAS unsigned char* lds, const Gemm g, const Sched& S, const Epi& E) {
    constexpr int BK = 64, HALF = 128, HTB = HALF * BK * 2;
    int tid = threadIdx.x; asm volatile("" : "+v"(tid));
    const int wid = __builtin_amdgcn_readfirstlane(tid >> 6), lane = tid & 63, wr = wid >> 2, wc = wid & 3, fr = lane & 15, fq = lane >> 4;
    const int K = g.K, nt = K / BK;
    unsigned voffA[2], voffB[2];
#pragma unroll
    for (int i = 0; i < 2; ++i) { int R, C; stage_rc(tid * 16 + i * 8192, R, C); const int Rb = Epi::PERM ? ((R & ~31) + perm32(R & 31)) : R;
        voffA[i] = (unsigned)(R * g.lda + C) * 2u; voffB[i] = (unsigned)(Rb * g.ldb + C) * 2u; }
    constexpr bool GATH = Sched::GATHER;
    unsigned vcu[2][2] = {{0u, 0u}, {0u, 0u}}, vnx[2][2] = {{0u, 0u}, {0u, 0u}}; int gR[2] = {0, 0}; unsigned gC[2] = {0u, 0u};
    if constexpr (GATH) {
#pragma unroll
        for (int i = 0; i < 2; ++i) { int R, Cq; stage_rc(tid * 16 + i * 8192, R, Cq); gR[i] = R; gC[i] = (unsigned)Cq * 2u; } }
    const size_t kstep = (size_t)(BK * 2);
    const size_t hstepA = (size_t)HALF * g.lda * 2, hstepB = (size_t)HALF * g.ldb * 2;
    const unsigned ldsw = (unsigned)wid * 1024u;
    const int aoff = lds_byte(wr * 64 + fr, F8 ? fq * 16 : fq * 8), boff = lds_byte(wc * 32 + fr, F8 ? fq * 16 : fq * 8);
    const int aoff1 = lds_byte(wr * 64 + fr, F8 ? fq * 16 + 8 : fq * 8 + 32) - aoff, boff1 = lds_byte(wc * 32 + fr, F8 ? fq * 16 + 8 : fq * 8 + 32) - boff;
#define PG8_SA(b, h) (((b) * 2 + (h)) * HTB)
#define PG8_SB(b, h) ((4 + (b) * 2 + (h)) * HTB)
#define PG8_STAGE(bufoff, gbase, voff) do { _Pragma("unroll") for (int _i = 0; _i < 2; ++_i) \
        __builtin_amdgcn_global_load_lds((const unsigned*)((const char*)(gbase) + (voff)[_i]), (LAS unsigned*)(lds + (bufoff) + ldsw + _i * 8192), 16, 0, 0); } while (0)
#define PG8_STA(bufoff, ptr, h, nx) do { if constexpr (GATH) { const unsigned vsel_[2] = {(nx) ? vnx[h][0] : vcu[h][0], (nx) ? vnx[h][1] : vcu[h][1]}; PG8_STAGE(bufoff, ptr, vsel_); } \
        else { PG8_STAGE(bufoff, (ptr) + (h) * hstepA, voffA); } } while (0)
#define PG8_LDA(dst, b, h) do { _Pragma("unroll") for (int m = 0; m < 4; ++m) dst[m] = cat8(*(const LAS bf16x8*)(lds + PG8_SA(b, h) + aoff + m * 2048), *(const LAS bf16x8*)(lds + PG8_SA(b, h) + aoff + m * 2048 + aoff1)); } while (0)
#define PG8_LDB(dst, b, h) do { _Pragma("unroll") for (int n = 0; n < 2; ++n) dst[n] = cat8(*(const LAS bf16x8*)(lds + PG8_SB(b, h) + boff + n * 2048), *(const LAS bf16x8*)(lds + PG8_SB(b, h) + boff + n * 2048 + boff1)); } while (0)
#define PG8_MMA(ai, bj, At, Bt) do { __builtin_amdgcn_s_setprio(1); \
        if constexpr (F8) { _Pragma("unroll") for (int m = 0; m < 4; ++m) _Pragma("unroll") for (int n = 0; n < 2; ++n) \
            asm volatile("s_nop 1\n\tv_mfma_scale_f32_16x16x128_f8f6f4 %0, %1, %2, %0, %3, %3 op_sel_hi:[0,0,0]" : "+v"(acc[ai][bj][m][n]) : "v"(Bt[n]), "v"(At[m]), "v"(sc127)); } \
        else { _Pragma("unroll") for (int m = 0; m < 4; ++m) _Pragma("unroll") for (int n = 0; n < 2; ++n) { \
            acc[ai][bj][m][n] = __builtin_amdgcn_mfma_f32_16x16x32_bf16(half8<0>(Bt[n]), half8<0>(At[m]), acc[ai][bj][m][n], 0, 0, 0); \
            acc[ai][bj][m][n] = __builtin_amdgcn_mfma_f32_16x16x32_bf16(half8<1>(Bt[n]), half8<1>(At[m]), acc[ai][bj][m][n], 0, 0, 0); } } \
        __builtin_amdgcn_s_setprio(0); } while (0)
#define PG8_WAIT_V(n) asm volatile("s_waitcnt vmcnt(" #n ")" ::: "memory")
#define PG8_WAIT_L(n) asm volatile("s_waitcnt lgkmcnt(" #n ")" ::: "memory")
#define PG8_BAR __builtin_amdgcn_s_barrier()
#define PG8_SCHED __builtin_amdgcn_sched_barrier(0)
    Unit cur, nxt; int ui = 0;
    if (!S.next(0, cur)) return;
    f32x4 acc[2][2][4][2];
#pragma unroll
    for (int a = 0; a < 2; ++a)
#pragma unroll
        for (int b = 0; b < 2; ++b)
#pragma unroll
            for (int m = 0; m < 4; ++m)
#pragma unroll
                for (int n = 0; n < 2; ++n) acc[a][b][m][n] = (f32x4){0.f, 0.f, 0.f, 0.f};
    int sc127 = 127; asm volatile("" : "+v"(sc127));
    v8i At[4], B0[2], B1[2];
    const char* cA = (const char*)(g.A + cur.a_off); const char* cB = (const char*)(g.Bt + cur.b_off);
    if constexpr (GATH) {
#pragma unroll
        for (int h = 0; h < 2; ++h)
#pragma unroll
            for (int i = 0; i < 2; ++i) vcu[h][i] = S.rowoff(cur, h * HALF + gR[i]) + gC[i]; }
    if constexpr (SP2) {
        PG8_STAGE(PG8_SB(0, 0), cB, voffB); PG8_STAGE(PG8_SB(0, 1), cB + hstepB, voffB); PG8_STA(PG8_SA(0, 0), cA, 0, false); PG8_STA(PG8_SA(0, 1), cA, 1, false);
        if (wr == 1) PG8_BAR;
        PG8_WAIT_V(2); PG8_BAR;
        PG8_STAGE(PG8_SB(1, 0), cB + kstep, voffB); PG8_STA(PG8_SA(1, 0), cA + kstep, 0, false); PG8_STAGE(PG8_SB(1, 1), cB + hstepB + kstep, voffB);
        PG8_WAIT_V(6); PG8_BAR;
    } else {
        PG8_STAGE(PG8_SB(0, 0), cB, voffB); PG8_STA(PG8_SA(0, 0), cA, 0, false); PG8_STAGE(PG8_SB(0, 1), cB + hstepB, voffB); PG8_STA(PG8_SA(0, 1), cA, 1, false);
        if (wr == 1) PG8_BAR;
        PG8_WAIT_V(4); PG8_BAR;
        PG8_STAGE(PG8_SB(1, 0), cB + kstep, voffB); PG8_STA(PG8_SA(1, 0), cA + kstep, 0, false); PG8_STAGE(PG8_SB(1, 1), cB + hstepB + kstep, voffB);
        PG8_WAIT_V(6); PG8_BAR;
    }
    for (;;) {
        const bool has_next = S.next(ui + 1, nxt);
        const char* nA = has_next ? (const char*)(g.A + nxt.a_off) : cA; const char* nB = has_next ? (const char*)(g.Bt + nxt.b_off) : cB;
        if constexpr (GATH) {
#pragma unroll
            for (int h = 0; h < 2; ++h)
#pragma unroll
                for (int i = 0; i < 2; ++i) vnx[h][i] = has_next ? (S.rowoff(nxt, h * HALF + gR[i]) + gC[i]) : vcu[h][i]; }
#pragma unroll 1
        for (int t = 0; t < nt; t += 2) {
            if constexpr (Epi::MIDK) { if (t == (nt >> 1)) E.midk(acc, cur, wr, wc, fr, fq); }
            const bool last = (t == nt - 2);
            const char* a1 = cA + (size_t)(t + 1) * kstep;
            const char* a2 = last ? nA : cA + (size_t)(t + 2) * kstep; const char* b2 = last ? nB : cB + (size_t)(t + 2) * kstep;
            const char* a3 = a2 + kstep; const char* b3 = b2 + kstep;
            if constexpr (SP2) {
            PG8_LDB(B0, 0, 0); PG8_LDB(B1, 0, 1); PG8_SCHED; PG8_LDA(At, 0, 0); PG8_STA(PG8_SA(1, 1), a1, 1, false);
            PG8_WAIT_V(8); PG8_WAIT_L(0); PG8_BAR; PG8_MMA(0, 0, At, B0); PG8_MMA(0, 1, At, B1); PG8_BAR; PG8_SCHED;
            PG8_LDA(At, 0, 1); PG8_STAGE(PG8_SB(0, 0), b2, voffB); PG8_STAGE(PG8_SB(0, 1), b2 + hstepB, voffB); PG8_STA(PG8_SA(0, 0), a2, 0, last);
            PG8_WAIT_V(8); PG8_WAIT_L(0); PG8_BAR; PG8_MMA(1, 0, At, B0); PG8_MMA(1, 1, At, B1); PG8_BAR; PG8_SCHED;
            PG8_LDB(B0, 1, 0); PG8_LDB(B1, 1, 1); PG8_SCHED; PG8_LDA(At, 1, 0); PG8_STA(PG8_SA(0, 1), a2, 1, last);
            PG8_WAIT_V(8); PG8_WAIT_L(0); PG8_BAR; PG8_MMA(0, 0, At, B0); PG8_MMA(0, 1, At, B1); PG8_BAR; PG8_SCHED;
            PG8_LDA(At, 1, 1); PG8_STAGE(PG8_SB(1, 0), b3, voffB); PG8_STAGE(PG8_SB(1, 1), b3 + hstepB, voffB); PG8_STA(PG8_SA(1, 0), a3, 0, last);
            PG8_WAIT_V(8); PG8_WAIT_L(0); PG8_BAR; PG8_MMA(1, 0, At, B0); PG8_MMA(1, 1, At, B1); PG8_BAR; PG8_SCHED;
            } else {
            PG8_LDB(B0, 0, 0); PG8_SCHED; PG8_LDA(At, 0, 0); PG8_STA(PG8_SA(1, 1), a1, 1, false);
            PG8_WAIT_L(8); PG8_BAR; PG8_WAIT_L(0); PG8_MMA(0, 0, At, B0); PG8_BAR; PG8_SCHED;
            PG8_LDB(B1, 0, 1); PG8_STAGE(PG8_SB(0, 0), b2, voffB);
            PG8_BAR; PG8_WAIT_L(0); PG8_MMA(0, 1, At, B1); PG8_BAR;
            PG8_LDA(At, 0, 1); PG8_STA(PG8_SA(0, 0), a2, 0, last);
            PG8_BAR; PG8_WAIT_L(0); PG8_MMA(1, 0, At, B0); PG8_BAR; PG8_SCHED;
            PG8_STAGE(PG8_SB(0, 1), b2 + hstepB, voffB);
            PG8_WAIT_V(6); PG8_BAR; PG8_MMA(1, 1, At, B1); PG8_BAR;
            PG8_LDB(B0, 1, 0); PG8_SCHED; PG8_LDA(At, 1, 0); PG8_STA(PG8_SA(0, 1), a2, 1, last);
            PG8_WAIT_L(8); PG8_BAR; PG8_WAIT_L(0); PG8_MMA(0, 0, At, B0); PG8_BAR; PG8_SCHED;
            PG8_LDB(B1, 1, 1); PG8_STAGE(PG8_SB(1, 0), b3, voffB);
            PG8_BAR; PG8_WAIT_L(0); PG8_MMA(0, 1, At, B1); PG8_BAR;
            PG8_LDA(At, 1, 1); PG8_STA(PG8_SA(1, 0), a3, 0, last);
            PG8_BAR; PG8_WAIT_L(0); PG8_MMA(1, 0, At, B0); PG8_BAR; PG8_SCHED;
            PG8_STAGE(PG8_SB(1, 1), b3 + hstepB, voffB);
            PG8_WAIT_V(6); PG8_BAR; PG8_MMA(1, 1, At, B1); PG8_BAR;
            }
        }
        if constexpr (ALIGN_EPI) { if (wr == 0) PG8_BAR; }
        if constexpr (F8) {
#pragma unroll
            for (int a = 0; a < 2; ++a)
#pragma unroll
                for (int b = 0; b < 2; ++b)
                    asm volatile("s_nop 15\n\ts_nop 7" : "+v"(acc[a][b][0][0]), "+v"(acc[a][b][0][1]), "+v"(acc[a][b][1][0]), "+v"(acc[a][b][1][1]), "+v"(acc[a][b][2][0]), "+v"(acc[a][b][2][1]), "+v"(acc[a][b][3][0]), "+v"(acc[a][b][3][1]));
        }
        E(acc, cur, wr, wc, fr, fq);
        if (!has_next) break;
#pragma unroll
        for (int a = 0; a < 2; ++a)
#pragma unroll
            for (int b = 0; b < 2; ++b)
#pragma unroll
                for (int m = 0; m < 4; ++m)
#pragma unroll
                    for (int n = 0; n < 2; ++n) acc[a][b][m][n] = (f32x4){0.f, 0.f, 0.f, 0.f};
        cur = nxt; cA = nA; cB = nB; ++ui;
        if constexpr (GATH) {
#pragma unroll
            for (int h = 0; h < 2; ++h)
#pragma unroll
                for (int i = 0; i < 2; ++i) vcu[h][i] = vnx[h][i]; }
        if constexpr (ALIGN_EPI) { if (wr == 1) PG8_BAR; }
    }
    PG8_WAIT_V(0);
    if constexpr (!ALIGN_EPI) { if (wr == 0) PG8_BAR; }
    PG8_BAR;
#undef PG8_SA
#undef PG8_SB
#undef PG8_STAGE
#undef PG8_STA
#undef PG8_LDA
#undef PG8_LDB
#undef PG8_MMA
#undef PG8_WAIT_V
#undef PG8_WAIT_L
#undef PG8_BAR
#undef PG8_SCHED
}
#ifdef GEMM_SIMPLE
#define GEMM_PHASE(lds, g, S, E) gemm_phase_simple(lds, g, S, E)
#else
#define GEMM_PHASE(lds, g, S, E) gemm_phase<decltype(E), decltype(S), true, true>(lds, g, S, E)
#endif
#define GEMM_PHASE8(lds, g, S, E) gemm_phase<decltype(E), decltype(S), true, true, true>(lds, g, S, E)

__device__ __forceinline__ float rstd_from_ssq(const float* ssq, int row) {
    const f32x4* p = (const f32x4*)(ssq + (size_t)row * 16); const f32x4 a = p[0], b = p[1], c = p[2], d = p[3];
    const float s = ((a[0] + a[1]) + (a[2] + a[3])) + ((b[0] + b[1]) + (b[2] + b[3])) + ((c[0] + c[1]) + (c[2] + c[3])) + ((d[0] + d[1]) + (d[2] + d[3]));
    return __builtin_amdgcn_rsqf(s * (1.0f / DM) + EPS);
}
__device__ __forceinline__ u32x4 pack8(const f32x4 v0, const f32x4 v1) { u32x4 w; w.x = cvt_pk_bf16(v0[0], v0[1]); w.y = cvt_pk_bf16(v0[2], v0[3]); w.z = cvt_pk_bf16(v1[0], v1[1]); w.w = cvt_pk_bf16(v1[2], v1[3]); return w; }

struct EpiProj {
    static constexpr bool PERM = true, LDSX = false, MIDK = false;
    bf16_t* base; const float* rope; float* ksum;
    __device__ __forceinline__ void operator()(f32x4 (&acc)[2][2][4][2], const Unit& u, int wr, int wc, int fr, int fq) const {
        const int type = u.pn >> 1, colt = (u.pn & 1) * 256;
        bf16_t* O = base + (size_t)type * NTOK * 512;
        const bool is_q = (type == 2), is_k = (type == 3);
        if ((is_q || is_k) && !(wc & 1)) {
#pragma unroll
            for (int ai = 0; ai < 2; ++ai)
#pragma unroll
                for (int m = 0; m < 4; ++m) {
                    const int row = u.pm * 256 + 128 * ai + 64 * wr + 16 * m + fr, pos = row & (SEQ - 1);
                    const float* rp = rope + pos * 16;
                    const f32x4 cs[2] = { *(const f32x4*)(rp), *(const f32x4*)(rp + 4) }, sn[2] = { *(const f32x4*)(rp + 8), *(const f32x4*)(rp + 12) };
#pragma unroll
                    for (int bj = 0; bj < 2; ++bj)
#pragma unroll
                        for (int n = 0; n < 2; ++n) {
                            const f32x4 mine = acc[ai][bj][m][n]; f32x4 oth;
#pragma unroll
                            for (int e = 0; e < 4; ++e) oth[e] = __shfl_xor(mine[e], 16);
                            f32x4 res = mine;
                            if (fq == 0) res = mine * cs[n] - oth * sn[n];
                            else if (fq == 1) res = mine * cs[n] + oth * sn[n];
                            acc[ai][bj][m][n] = res;
                        }
                }
        }
        const float sc = is_q ? QSCALE : 1.0f;
#pragma unroll
        for (int ai = 0; ai < 2; ++ai)
#pragma unroll
            for (int m = 0; m < 4; ++m) {
                const int row = u.pm * 256 + 128 * ai + 64 * wr + 16 * m + fr;
                bf16_t* rowp = O + (size_t)row * 512 + colt + 32 * wc + 8 * fq;
#pragma unroll
                for (int bj = 0; bj < 2; ++bj) *(u32x4*)(rowp + bj * 128) = pack8(acc[ai][bj][m][0] * sc, acc[ai][bj][m][1] * sc);
            }
        if (is_k) {
#pragma unroll
            for (int bj = 0; bj < 2; ++bj)
#pragma unroll
                for (int n = 0; n < 2; ++n)
#pragma unroll
                    for (int e = 0; e < 4; ++e) {
                        float s = 0.f;
#pragma unroll
                        for (int ai = 0; ai < 2; ++ai)
#pragma unroll
                            for (int m = 0; m < 4; ++m) s += acc[ai][bj][m][n][e];
                        s += __shfl_xor(s, 1); s += __shfl_xor(s, 2); s += __shfl_xor(s, 4); s += __shfl_xor(s, 8);
                        if (fr == 0) atomicAdd(ksum + (size_t)u.pm * 512 + colt + 128 * bj + 32 * wc + 8 * fq + 4 * n + e, s);
                    }
        }
    }
};
struct EpiNull {
    static constexpr bool PERM = true, LDSX = false, MIDK = false;
    __device__ __forceinline__ void operator()(f32x4 (&acc)[2][2][4][2], const Unit& u, int wr, int wc, int fr, int fq) const { asm volatile("" :: "v"(acc[0][0][0][0][0]), "v"(acc[1][1][3][1][3])); }
};
struct EpiStore {
    static constexpr bool PERM = true, LDSX = false, MIDK = false;
    bf16_t* O; int ldc; float sc = 1.0f;
    __device__ __forceinline__ void operator()(f32x4 (&acc)[2][2][4][2], const Unit& u, int wr, int wc, int fr, int fq) const {
#pragma unroll
        for (int ai = 0; ai < 2; ++ai)
#pragma unroll
            for (int m = 0; m < 4; ++m) {
                const int row = u.pm * 256 + 128 * ai + 64 * wr + 16 * m + fr;
                bf16_t* rowp = O + (size_t)row * ldc + u.pn * 256 + 32 * wc + 8 * fq;
#pragma unroll
                for (int bj = 0; bj < 2; ++bj) *(u32x4*)(rowp + bj * 128) = pack8(acc[ai][bj][m][0] * sc, acc[ai][bj][m][1] * sc);
            }
    }
};
struct EpiStore8 {
    static constexpr bool PERM = true, LDSX = false, MIDK = false;
    unsigned char* O; int ldc; float sc;
    __device__ __forceinline__ void operator()(f32x4 (&acc)[2][2][4][2], const Unit& u, int wr, int wc, int fr, int fq) const {
#pragma unroll
        for (int ai = 0; ai < 2; ++ai)
#pragma unroll
            for (int m = 0; m < 4; ++m) {
                const int row = u.pm * 256 + 128 * ai + 64 * wr + 16 * m + fr;
                unsigned char* rowp = O + (size_t)row * ldc + u.pn * 256 + 32 * wc + 8 * fq;
#pragma unroll
                for (int bj = 0; bj < 2; ++bj) { const f32x4 a0 = acc[ai][bj][m][0] * sc, a1 = acc[ai][bj][m][1] * sc; u32x2 w; w.x = pk4_fp8(a0[0], a0[1], a0[2], a0[3]); w.y = pk4_fp8(a1[0], a1[1], a1[2], a1[3]); *(u32x2*)(rowp + bj * 128) = w; }
            }
    }
};
template <bool BASE_F32, bool KSPLIT> struct EpiResid {
    static constexpr bool PERM = true, LDSX = false, MIDK = KSPLIT;
    const void* base; bf16_t* hb; float* ssq; const float* ssql; const float* ssqa; unsigned char* h8; float asc;
    __device__ __forceinline__ void stats(int row, int fq, float& rl, float& ra) const {
        const f32x4 pl = *(const f32x4*)(ssql + (size_t)row * 16 + 4 * fq); const f32x2 pa = *(const f32x2*)(ssqa + (size_t)row * 8 + 2 * fq);
        float sl = (pl[0] + pl[1]) + (pl[2] + pl[3]), sa = pa[0] + pa[1];
        sl += __shfl_xor(sl, 16); sl += __shfl_xor(sl, 32); sa += __shfl_xor(sa, 16); sa += __shfl_xor(sa, 32);
        rl = __builtin_amdgcn_rsqf(sl * (1.0f / 512.0f) + EPS); ra = __builtin_amdgcn_rsqf(sa * (1.0f / 512.0f) + EPS);
    }
    __device__ __forceinline__ void midk(f32x4 (&acc)[2][2][4][2], const Unit& u, int wr, int wc, int fr, int fq) const {
        asm volatile("" : "+v"(fr), "+v"(fq));
#pragma unroll
        for (int ai = 0; ai < 2; ++ai)
#pragma unroll
            for (int m = 0; m < 4; ++m) { float rl, ra; stats(u.pm * 256 + 128 * ai + 64 * wr + 16 * m + fr, fq, rl, ra); const float ratio = rl * __builtin_amdgcn_rcpf(ra);
#pragma unroll
                for (int bj = 0; bj < 2; ++bj)
#pragma unroll
                    for (int n = 0; n < 2; ++n) acc[ai][bj][m][n] *= ratio; }
    }
    __device__ __forceinline__ void operator()(f32x4 (&acc)[2][2][4][2], const Unit& u, int wr, int wc, int fr, int fq) const {
#pragma unroll
        for (int ai = 0; ai < 2; ++ai)
#pragma unroll
            for (int m = 0; m < 4; ++m) {
                const int row = u.pm * 256 + 128 * ai + 64 * wr + 16 * m + fr; float q = 0.f, osc = asc;
                if constexpr (KSPLIT) { float rl; stats(row, fq, rl, osc); osc *= asc; }
#pragma unroll
                for (int bj = 0; bj < 2; ++bj) {
                    const int col = u.pn * 256 + 128 * bj + 32 * wc + 8 * fq;
                    f32x4 b0, b1;
                    if constexpr (BASE_F32) { b0 = *(const f32x4*)((const float*)base + (size_t)row * DM + col); b1 = *(const f32x4*)((const float*)base + (size_t)row * DM + col + 4); }
                    else { const u32x4 w = *(const u32x4*)((const bf16_t*)base + (size_t)row * LDH + col); b0 = (f32x4){bflo(w.x), bfhi(w.x), bflo(w.y), bfhi(w.y)}; b1 = (f32x4){bflo(w.z), bfhi(w.z), bflo(w.w), bfhi(w.w)}; }
                    const f32x4 v0 = b0 + acc[ai][bj][m][0] * osc, v1 = b1 + acc[ai][bj][m][1] * osc;
                    q += ((v0[0] * v0[0] + v0[1] * v0[1]) + (v0[2] * v0[2] + v0[3] * v0[3])) + ((v1[0] * v1[0] + v1[1] * v1[1]) + (v1[2] * v1[2] + v1[3] * v1[3]));
                    *(u32x4*)(hb + (size_t)row * LDH + col) = pack8(v0, v1);
                    if (h8) { u32x2 w8; w8.x = pk4_fp8(v0[0], v0[1], v0[2], v0[3]); w8.y = pk4_fp8(v1[0], v1[1], v1[2], v1[3]); *(u32x2*)(h8 + (size_t)row * DM + col) = w8; }
                }
                q += __shfl_xor(q, 16); q += __shfl_xor(q, 32);
                if (fq == 0) ssq[(size_t)row * 16 + u.pn * 4 + wc] = q;
            }
    }
};
struct EpiRowScale {
    static constexpr bool PERM = true, LDSX = false, MIDK = false;
    bf16_t* O; int ldc; const float* ssq; float cs;
    __device__ __forceinline__ void operator()(f32x4 (&acc)[2][2][4][2], const Unit& u, int wr, int wc, int fr, int fq) const {
#pragma unroll
        for (int ai = 0; ai < 2; ++ai)
#pragma unroll
            for (int m = 0; m < 4; ++m) {
                const int row = u.pm * 256 + 128 * ai + 64 * wr + 16 * m + fr; const float s = rstd_from_ssq(ssq, row) * cs;
                bf16_t* rowp = O + (size_t)row * ldc + u.pn * 256 + 32 * wc + 8 * fq;
#pragma unroll
                for (int bj = 0; bj < 2; ++bj) *(u32x4*)(rowp + bj * 128) = pack8(acc[ai][bj][m][0] * s, acc[ai][bj][m][1] * s);
            }
    }
};
#define XBAR() do { asm volatile("s_waitcnt lgkmcnt(0)" ::: "memory"); __builtin_amdgcn_s_barrier(); asm volatile("" ::: "memory"); } while (0)
struct EpiSoftmax {
    static constexpr bool PERM = true, LDSX = false, MIDK = false;
    unsigned char* O; int ldc; LAS unsigned char* xl; const float* ssq; float cs;
    __device__ __forceinline__ void operator()(f32x4 (&acc)[2][2][4][2], const Unit& u, int wr, int wc, int fr, int fq) const {
        LAS float* P = (LAS float*)xl;
        LAS float* Q = (LAS float*)(xl + 4096);
#pragma unroll
        for (int ai = 0; ai < 2; ++ai)
#pragma unroll
            for (int m = 0; m < 4; ++m) {
                float v = -INFINITY; const float sc = rstd_from_ssq(ssq, u.pm * 256 + 128 * ai + 64 * wr + 16 * m + fr) * cs;
#pragma unroll
                for (int bj = 0; bj < 2; ++bj)
#pragma unroll
                    for (int n = 0; n < 2; ++n) { const f32x4 x = acc[ai][bj][m][n] * sc; acc[ai][bj][m][n] = x; v = fmaxf(v, fmaxf(fmaxf(x[0], x[1]), fmaxf(x[2], x[3]))); }
                v = fmaxf(v, __shfl_xor(v, 16)); v = fmaxf(v, __shfl_xor(v, 32));
                if (fq == 0) P[(128 * ai + 64 * wr + 16 * m + fr) * 4 + wc] = v;
            }
        XBAR();
#pragma unroll
        for (int ai = 0; ai < 2; ++ai)
#pragma unroll
            for (int m = 0; m < 4; ++m) {
                const int r = 128 * ai + 64 * wr + 16 * m + fr;
                const float v = fmaxf(fmaxf(P[r * 4 + 0], P[r * 4 + 1]), fmaxf(P[r * 4 + 2], P[r * 4 + 3]));
                float s = 0.f;
#pragma unroll
                for (int bj = 0; bj < 2; ++bj)
#pragma unroll
                    for (int n = 0; n < 2; ++n) { f32x4 x = acc[ai][bj][m][n];
#pragma unroll
                        for (int e = 0; e < 4; ++e) { x[e] = __builtin_amdgcn_exp2f(x[e] - v); s += x[e]; }
                        acc[ai][bj][m][n] = x; }
                s += __shfl_xor(s, 16); s += __shfl_xor(s, 32);
                if (fq == 0) Q[r * 4 + wc] = s;
            }
        XBAR();
#pragma unroll
        for (int ai = 0; ai < 2; ++ai)
#pragma unroll
            for (int m = 0; m < 4; ++m) {
                const int r = 128 * ai + 64 * wr + 16 * m + fr;
                const float inv = PX_SC * __builtin_amdgcn_rcpf((Q[r * 4 + 0] + Q[r * 4 + 1]) + (Q[r * 4 + 2] + Q[r * 4 + 3]));
                unsigned char* rowp = O + (size_t)(u.pm * 256 + r) * ldc + u.pn * 256 + 32 * wc + 8 * fq;
#pragma unroll
                for (int bj = 0; bj < 2; ++bj) { const f32x4 a0 = acc[ai][bj][m][0] * inv, a1 = acc[ai][bj][m][1] * inv; u32x2 w; w.x = pk4_fp8(a0[0], a0[1], a0[2], a0[3]); w.y = pk4_fp8(a1[0], a1[1], a1[2], a1[3]); *(u32x2*)(rowp + bj * 128) = w; }
            }
        XBAR();
    }
};
struct EpiGateUp {
    static constexpr bool PERM = true, LDSX = false, MIDK = false;
    unsigned char* O; const float* lrs;
    __device__ __forceinline__ void operator()(f32x4 (&acc)[2][2][4][2], const Unit& u, int wr, int wc, int fr, int fq) const {
#pragma unroll
        for (int ai = 0; ai < 2; ++ai)
#pragma unroll
            for (int m = 0; m < 4; ++m) {
                const int r = 128 * ai + 64 * wr + 16 * m + fr, row = u.pm * 256 + r; const float rs = (r < u.nvalid) ? lrs[u.lbase + r] * (1.0f / WGU_SC) : 0.f;
                f32x4 o[2];
#pragma unroll
                for (int n = 0; n < 2; ++n)
#pragma unroll
                    for (int e = 0; e < 4; ++e) { const float g = acc[ai][0][m][n][e] * rs, up = acc[ai][1][m][n][e] * rs; o[n][e] = g * sigmoidf_(g) * up * ACT_SC; }
                u32x2 w8; w8.x = pk4_fp8(o[0][0], o[0][1], o[0][2], o[0][3]); w8.y = pk4_fp8(o[1][0], o[1][1], o[1][2], o[1][3]);
                *(u32x2*)(O + (size_t)row * DFF + u.pn * 128 + 32 * wc + 8 * fq) = w8;
            }
    }
};

struct Args { const float* in[27]; float* out; unsigned char* ws; int ph_lo, ph_hi; float invf[8]; };
struct Ctx { LAS unsigned char* lds; int tid, lane, wave, vcu, G; };

__device__ __forceinline__ void tr_load(f32x4 (&v)[8], const float* W, int ldw, int k0, int n0s, int lane) {
    const int kr = lane >> 3, ch = lane & 7;
#pragma unroll
    for (int i = 0; i < 8; ++i) v[i] = *(const f32x4*)(W + (size_t)(k0 + 8 * i + kr) * ldw + n0s + 4 * ch);
}
__device__ __forceinline__ void tr_finish(const f32x4 (&v)[8], int k0, bf16_t* WT, int ldt, int r0d, const float* gain, LAS float* scr, int lane) {
    const int kr = lane >> 3, ch = lane & 7, c = lane & 7;
    f32x4 g0 = {1.f, 1.f, 1.f, 1.f}, g1 = {1.f, 1.f, 1.f, 1.f};
    if (gain) { g0 = *(const f32x4*)(gain + k0 + 8 * c); g1 = *(const f32x4*)(gain + k0 + 8 * c + 4); }
#pragma unroll
    for (int i = 0; i < 8; ++i) { LAS float* d = scr + (8 * i + kr) * 33 + 4 * ch; d[0] = v[i][0]; d[1] = v[i][1]; d[2] = v[i][2]; d[3] = v[i][3]; }
    LDS_WAIT(); asm volatile("" ::: "memory");
#pragma unroll
    for (int j = 0; j < 4; ++j) { const int n = (lane >> 3) + 8 * j; const LAS float* s = scr + (8 * c) * 33 + n;
        u32x4 o; o.x = cvt_pk_bf16(s[0 * 33] * g0[0], s[1 * 33] * g0[1]); o.y = cvt_pk_bf16(s[2 * 33] * g0[2], s[3 * 33] * g0[3]); o.z = cvt_pk_bf16(s[4 * 33] * g1[0], s[5 * 33] * g1[1]); o.w = cvt_pk_bf16(s[6 * 33] * g1[2], s[7 * 33] * g1[3]);
        *(u32x4*)(WT + (size_t)(r0d + n) * ldt + k0 + 8 * c) = o; }
    LDS_WAIT(); asm volatile("" ::: "memory");
}
__device__ __forceinline__ void tr_finish8(const f32x4 (&v)[8], int k0, unsigned char* WT8, int ldt, int r0d, const float* gain, float sc, LAS float* scr, int lane) {
    const int kr = lane >> 3, ch = lane & 7, c = lane & 7;
    f32x4 g0 = {sc, sc, sc, sc}, g1 = {sc, sc, sc, sc};
    if (gain) { g0 = *(const f32x4*)(gain + k0 + 8 * c) * sc; g1 = *(const f32x4*)(gain + k0 + 8 * c + 4) * sc; }
#pragma unroll
    for (int i = 0; i < 8; ++i) { LAS float* d = scr + (8 * i + kr) * 33 + 4 * ch; d[0] = v[i][0]; d[1] = v[i][1]; d[2] = v[i][2]; d[3] = v[i][3]; }
    LDS_WAIT(); asm volatile("" ::: "memory");
#pragma unroll
    for (int j = 0; j < 4; ++j) { const int n = (lane >> 3) + 8 * j; const LAS float* s = scr + (8 * c) * 33 + n;
        u32x2 o; o.x = pk4_fp8(s[0 * 33] * g0[0], s[1 * 33] * g0[1], s[2 * 33] * g0[2], s[3 * 33] * g0[3]); o.y = pk4_fp8(s[4 * 33] * g1[0], s[5 * 33] * g1[1], s[6 * 33] * g1[2], s[7 * 33] * g1[3]);
        *(u32x2*)(WT8 + (size_t)(r0d + n) * ldt + k0 + 8 * c) = o; }
    LDS_WAIT(); asm volatile("" ::: "memory");
}
__device__ __forceinline__ void tr_item(const float* W, int ldw, int k0, int n0s, bf16_t* WT, int ldt, int r0d, const float* gain, LAS float* scr, int lane) {
    f32x4 v[8]; tr_load(v, W, ldw, k0, n0s, lane); tr_finish(v, k0, WT, ldt, r0d, gain, scr, lane);
}
__device__ __forceinline__ void rms_row_to_bf16(const float* xrow, const float* gain, bf16_t* orow, int lane) {
    const f32x4* xr = (const f32x4*)xrow + lane; const f32x4* gr = (const f32x4*)gain + lane;
    f32x4 v[4]; float s = 0.f;
#pragma unroll
    for (int j = 0; j < 4; ++j) { v[j] = xr[64 * j]; s += (v[j][0] * v[j][0] + v[j][1] * v[j][1]) + (v[j][2] * v[j][2] + v[j][3] * v[j][3]); }
    const float rstd = 1.0f / sqrtf(wave_sum(s) * (1.0f / DM) + EPS);
    u32x2* o8 = (u32x2*)orow + lane;
#pragma unroll
    for (int j = 0; j < 4; ++j) { const f32x4 g = gr[64 * j]; u32x2 w; w.x = cvt_pk_bf16(v[j][0] * rstd * g[0], v[j][1] * rstd * g[1]); w.y = cvt_pk_bf16(v[j][2] * rstd * g[2], v[j][3] * rstd * g[3]); o8[64 * j] = w; }
}

__device__ __forceinline__ void rms_row2_to_bf16(const float* xrow, const float* gain, bf16_t* orow, int lane) {
    const f32x4* xr = (const f32x4*)xrow + lane; const f32x4* gr = (const f32x4*)gain + lane;
    f32x4 v[2][4]; float s[2] = {0.f, 0.f};
#pragma unroll
    for (int r = 0; r < 2; ++r)
#pragma unroll
        for (int j = 0; j < 4; ++j) v[r][j] = xr[256 * r + 64 * j];
#pragma unroll
    for (int r = 0; r < 2; ++r)
#pragma unroll
        for (int j = 0; j < 4; ++j) s[r] += (v[r][j][0] * v[r][j][0] + v[r][j][1] * v[r][j][1]) + (v[r][j][2] * v[r][j][2] + v[r][j][3] * v[r][j][3]);
#pragma unroll
    for (int r = 0; r < 2; ++r) { const float rstd = 1.0f / sqrtf(wave_sum(s[r]) * (1.0f / DM) + EPS); u32x2* o8 = (u32x2*)(orow + (size_t)r * DM) + lane;
#pragma unroll
        for (int j = 0; j < 4; ++j) { const f32x4 g = gr[64 * j]; u32x2 w; w.x = cvt_pk_bf16(v[r][j][0] * rstd * g[0], v[r][j][1] * rstd * g[1]); w.y = cvt_pk_bf16(v[r][j][2] * rstd * g[2], v[r][j][3] * rstd * g[3]); o8[64 * j] = w; } }
}

__device__ __forceinline__ void conv_wdn(const Args& a, const Ctx& C, int gw, int NGW, int it_lo, int NIT) {
    LAS float* scr = (LAS float*)(C.lds + C.wave * 16384); const int lane = C.lane;
    f32x4 va[8], vb[8];
#define WDN_LOAD(v, it) do { const int e_ = (it) / 256, r_ = (it) % 256; tr_load(v, a.in[25] + (size_t)e_ * DFF * DM, DM, 64 * (r_ / 32), 32 * (r_ % 32), lane); } while (0)
#define WDN_FIN(v, it) do { const int e_ = (it) / 256, r_ = (it) % 256; tr_finish8(v, 64 * (r_ / 32), a.ws + WS_WDN, DFF, e_ * 1024 + 32 * (r_ % 32), nullptr, WDN_SC, scr, lane); } while (0)
    int it = it_lo + gw; if (it < NIT) WDN_LOAD(va, it);
    for (; it < NIT; it += 2 * NGW) {
        const int it1 = it + NGW, it2 = it + 2 * NGW;
        if (it1 < NIT) WDN_LOAD(vb, it1);
        WDN_FIN(va, it);
        if (it2 < NIT) WDN_LOAD(va, it2);
        if (it1 < NIT) WDN_FIN(vb, it1);
    }
#undef WDN_LOAD
#undef WDN_FIN
}
__device__ __forceinline__ void ph_prologue(const Args& a, const Ctx& C) {
    unsigned char* ws = a.ws;
    LAS float* scr = (LAS float*)(C.lds + C.wave * 16384);
    const int gw = C.vcu * 8 + C.wave, NGW = C.G * 8, lane = C.lane;
    for (int it = gw; it < 16 * 80; it += NGW) { const int kb = it / 80, nb = it % 80; tr_item(a.in[3], DIN, 64 * kb, 32 * nb, (bf16_t*)(ws + WS_WIN), DM, 32 * nb, nullptr, scr, lane); }
    for (int it = gw; it < 16 * 64; it += NGW) { const int kb = it / 64, nb = it % 64;
        if (nb < 32) tr_item(a.in[17], 2 * DM, 64 * kb, 32 * nb, (bf16_t*)(ws + WS_WXK), DM, 32 * nb, nullptr, scr, lane);
        else tr_item(a.in[17], 2 * DM, 64 * kb, 32 * nb, (bf16_t*)(ws + WS_WXV), DM, 32 * (nb - 32), nullptr, scr, lane); }
    for (int it = gw; it < 16 * 32; it += NGW) { const int kb = it / 32, nb = it % 32;
        tr_item(a.in[13], DM, 64 * kb, 32 * nb, (bf16_t*)(ws + WS_WOUT), DM, 32 * nb, (kb < 8) ? a.in[11] : (a.in[12] - DLRU), scr, lane);
        tr_item(a.in[18], DM, 64 * kb, 32 * nb, (bf16_t*)(ws + WS_WXO), DM, 32 * nb, nullptr, scr, lane); }
    for (int it = gw; it < NEXP * 16 * 32; it += NGW) { const int e = it / 512, r = it % 512, kb = r / 32, nb = r % 32, j = nb >> 3, half = (nb >> 2) & 1, q = nb & 3;
        f32x4 v8_[8]; tr_load(v8_, a.in[24] + (size_t)e * DM * DM, DM, 64 * kb, half * 512 + j * 128 + q * 32, lane); tr_finish8(v8_, 64 * kb, ws + WS_WGU, DM, e * 1024 + j * 256 + half * 128 + q * 32, a.in[19], WGU_SC, scr, lane); }
    for (int r = gw; r < DM; r += NGW) { const float gk = a.in[14][r]; const f32x4* src = (const f32x4*)(a.in[16] + (size_t)r * DM) + lane; u32x2* dst = (u32x2*)((bf16_t*)(ws + WS_WXQ) + (size_t)r * DM) + lane;
#pragma unroll
        for (int j = 0; j < 4; ++j) { const f32x4 v = src[64 * j]; u32x2 w; w.x = cvt_pk_bf16(v[0] * gk, v[1] * gk); w.y = cvt_pk_bf16(v[2] * gk, v[3] * gk); dst[64 * j] = w; } }
    conv_wdn(a, C, gw, NGW, WDN_SPLIT, NEXP * 8 * 32);
    { bf16_t* WR = (bf16_t*)(ws + WS_WR); const int gt = C.vcu * 512 + C.tid, NT = C.G * 512;
      for (int i = gt; i < 48 * DM; i += NT) { const int r = i / DM, k = i % DM; float v = 0.f;
          if (r < 4) v = a.in[20][k * NGRP + r] * a.in[19][k]; else if (r < 36) v = a.in[22][k * NEXP + (r - 4)] * a.in[19][k];
          WR[i] = (bf16_t)(cvt_pk_bf16(v, 0.f) & 0xffffu); }
      float* rope = (float*)(ws + WS_ROPE);
      for (int i = gt; i < SEQ * 8; i += NT) { const int pos = i >> 3, j = i & 7; const float ang = (float)pos * a.invf[j];
          const double tw = 6.283185307179586476925286766559; const double ad = (double)ang; const double red = ad - tw * __builtin_rint(ad / tw); const float rf = (float)red;
          rope[pos * 16 + j] = __cosf(rf); rope[pos * 16 + 8 + j] = __sinf(rf); } }
    for (int m = 2 * gw; m < NTOK; m += 2 * NGW) rms_row2_to_bf16(a.in[0] + (size_t)m * DM, a.in[2], (bf16_t*)(ws + WS_B) + (size_t)m * DM, lane);
    for (int m = 2 * gw; m < NMEM; m += 2 * NGW) rms_row2_to_bf16(a.in[1] + (size_t)m * DM, a.in[15], (bf16_t*)(ws + WS_MEMN) + (size_t)m * DM, lane);
}

__device__ __forceinline__ float gelu_tanh(float x) { const float x2 = x * x; const float z2 = x * (-2.0f * 0.7978845608028654f * 1.4426950408889634f) * (1.0f + 0.044715f * x2);
    return x * __builtin_amdgcn_rcpf(1.0f + __builtin_amdgcn_exp2f(z2)); }
__device__ __forceinline__ float one_minus_exp(float x) {
    const float p = -x * (1.0f + x * (0.5f + x * (0.16666667f + x * (0.041666668f + x * 0.0083333338f))));
    const float e = 1.0f - __builtin_amdgcn_exp2f(x * 1.4426950408889634f);
    return (x > -0.25f) ? p : e;
}
__device__ __forceinline__ void lru_unit(const Args& a, const Ctx& C, int b, int blk, int half) {
    unsigned char* ws = a.ws;
    const bf16_t* XL = (const bf16_t*)(ws + WS_A); const bf16_t* GL = XL + (size_t)NTOK * 512; bf16_t* YC = (bf16_t*)(ws + WS_C); float* SSQL = (float*)(ws + WS_SSQL);
    const int tid = C.tid, lane = C.lane, wave = C.wave, fr = lane & 15, fq = lane >> 4;
    LAS float* XW = (LAS float*)(C.lds + wave * 5120);
    LAS bf16_t* GW = (LAS bf16_t*)(C.lds + wave * 5120 + 2304);
    LAS bf16_t* YW = (LAS bf16_t*)(C.lds + wave * 5120 + 3584);
    LAS float* WSUM = (LAS float*)(C.lds + 40960);
    LAS float* CW = (LAS float*)(C.lds + 45056);
    const int c0 = blk * 64, oc0 = c0 + half * 32;
    bf16x8 wfr[2][2][2];
#pragma unroll
    for (int gt = 0; gt < 2; ++gt) { const float* W = a.in[gt == 0 ? 6 : 8] + (size_t)blk * 64 * 64;
#pragma unroll
        for (int nt = 0; nt < 2; ++nt)
#pragma unroll
            for (int ks = 0; ks < 2; ++ks) { u32x4 w; float f[8];
#pragma unroll
                for (int j = 0; j < 8; ++j) f[j] = W[(32 * ks + 8 * fq + j) * 64 + half * 32 + 16 * nt + fr];
                w.x = cvt_pk_bf16(f[0], f[1]); w.y = cvt_pk_bf16(f[2], f[3]); w.z = cvt_pk_bf16(f[4], f[5]); w.w = cvt_pk_bf16(f[6], f[7]);
                wfr[gt][nt][ks] = __builtin_bit_cast(bf16x8, w); } }
    float brg[2], big[2], sp[2], hc[2] = {0.f, 0.f};
#pragma unroll
    for (int nt = 0; nt < 2; ++nt) { const int ch = oc0 + 16 * nt + fr; brg[nt] = a.in[7][ch] * -1.4426950408889634f; big[nt] = a.in[9][ch] * -1.4426950408889634f; const float lam = a.in[10][ch];
        sp[nt] = -8.0f * 1.4426950408889634f * ((lam > 15.f) ? __expf(-lam) : log1pf(__expf(-lam))); }
    if (tid < 320) { const int k = tid >> 6, c = tid & 63; CW[tid] = (k < 4) ? a.in[4][k * DLRU + c0 + c] : a.in[5][c0 + c]; }
    u32x4 xrs[2][4][2], grs[2];
    const bf16_t* xrow0 = XL + ((size_t)b * SEQ + 16 * wave + fr) * 512 + c0 + 8 * fq;
    const bf16_t* grow0 = GL + ((size_t)b * SEQ + 16 * wave + (lane >> 2)) * 512 + oc0 + 8 * (lane & 3);
    const int tloc = 16 * wave + fr;
#define LRU_PREFETCH(t0_, xr, gr) do { _Pragma("unroll") for (int k = 0; k < 4; ++k) { const int tt = (t0_) + tloc - 3 + k; \
        if (tt >= 0) { const bf16_t* xp = xrow0 + (ptrdiff_t)((t0_) - 3 + k) * 512; xr[k][0] = *(const u32x4*)xp; xr[k][1] = *(const u32x4*)(xp + 32); } else { xr[k][0] = (u32x4){0u, 0u, 0u, 0u}; xr[k][1] = (u32x4){0u, 0u, 0u, 0u}; } } \
        gr = *(const u32x4*)(grow0 + (size_t)(t0_) * 512); } while (0)
    LRU_PREFETCH(0, xrs[0], grs[0]); LRU_PREFETCH(128, xrs[1], grs[1]);
    __syncthreads();
    for (int ch2 = 0; ch2 < SEQ / 256; ++ch2) {
#pragma unroll
      for (int sub = 0; sub < 2; ++sub) { const int ch = 2 * ch2 + sub, t0 = ch * 128; auto& xr = xrs[sub]; auto& gr = grs[sub];
        bf16x8 af[2];
#pragma unroll
        for (int ks = 0; ks < 2; ++ks) { float accv[8];
            { const f32x4 b0 = *(const LAS f32x4*)(CW + 256 + 32 * ks + 8 * fq), b1 = *(const LAS f32x4*)(CW + 256 + 32 * ks + 8 * fq + 4);
              accv[0] = b0[0]; accv[1] = b0[1]; accv[2] = b0[2]; accv[3] = b0[3]; accv[4] = b1[0]; accv[5] = b1[1]; accv[6] = b1[2]; accv[7] = b1[3]; }
#pragma unroll
            for (int k = 0; k < 4; ++k) { const f32x4 w0 = *(const LAS f32x4*)(CW + 64 * k + 32 * ks + 8 * fq), w1 = *(const LAS f32x4*)(CW + 64 * k + 32 * ks + 8 * fq + 4); const u32x4 x = xr[k][ks];
                accv[0] += w0[0] * bflo(x.x); accv[1] += w0[1] * bfhi(x.x); accv[2] += w0[2] * bflo(x.y); accv[3] += w0[3] * bfhi(x.y);
                accv[4] += w1[0] * bflo(x.z); accv[5] += w1[1] * bfhi(x.z); accv[6] += w1[2] * bflo(x.w); accv[7] += w1[3] * bfhi(x.w); }
            u32x4 p; p.x = cvt_pk_bf16(accv[0], accv[1]); p.y = cvt_pk_bf16(accv[2], accv[3]); p.z = cvt_pk_bf16(accv[4], accv[5]); p.w = cvt_pk_bf16(accv[6], accv[7]);
            af[ks] = __builtin_bit_cast(bf16x8, p);
            if (ks == half) { *(LAS f32x4*)(XW + fr * 36 + 8 * fq) = (f32x4){accv[0], accv[1], accv[2], accv[3]}; *(LAS f32x4*)(XW + fr * 36 + 8 * fq + 4) = (f32x4){accv[4], accv[5], accv[6], accv[7]}; } }
        *(LAS u32x4*)(GW + (lane >> 2) * 40 + 8 * (lane & 3)) = gr;
        if (ch + 2 < SEQ / 128) LRU_PREFETCH(t0 + 256, xr, gr);
        LDS_WAIT(); asm volatile("" ::: "memory");
        float Hl[2][4], Al[2][4], Aex[2], Hex[2];
        { f32x4 ar[2] = {{0.f, 0.f, 0.f, 0.f}, {0.f, 0.f, 0.f, 0.f}}, ai_[2] = {{0.f, 0.f, 0.f, 0.f}, {0.f, 0.f, 0.f, 0.f}};
#pragma unroll
          for (int ks = 0; ks < 2; ++ks)
#pragma unroll
              for (int nt = 0; nt < 2; ++nt) { ar[nt] = __builtin_amdgcn_mfma_f32_16x16x32_bf16(af[ks], wfr[0][nt][ks], ar[nt], 0, 0, 0); ai_[nt] = __builtin_amdgcn_mfma_f32_16x16x32_bf16(af[ks], wfr[1][nt][ks], ai_[nt], 0, 0, 0); }
#pragma unroll
          for (int nt = 0; nt < 2; ++nt) {
              float hrun = 0.f, arun = 1.f;
#pragma unroll
              for (int r = 0; r < 4; ++r) { const int chn = 16 * nt + fr;
                  const float rg = __builtin_amdgcn_rcpf(1.0f + __builtin_amdgcn_exp2f(__builtin_fmaf(ar[nt][r], -1.4426950408889634f, brg[nt])));
                  const float ig = __builtin_amdgcn_rcpf(1.0f + __builtin_amdgcn_exp2f(__builtin_fmaf(ai_[nt][r], -1.4426950408889634f, big[nt])));
                  const float av = __builtin_amdgcn_exp2f(rg * sp[nt]); const float mult = __builtin_amdgcn_sqrtf(fmaxf(1.0f - av * av, 0.f));
                  const float uv = mult * ig * XW[(4 * fq + r) * 36 + chn];
                  hrun = av * hrun + uv; arun *= av; Hl[nt][r] = hrun; Al[nt][r] = arun; }
              const float A0 = __shfl(arun, fr), H0 = __shfl(hrun, fr), A1 = __shfl(arun, fr + 16), H1 = __shfl(hrun, fr + 16), A2 = __shfl(arun, fr + 32), H2 = __shfl(hrun, fr + 32), A3 = __shfl(arun, fr + 48), H3 = __shfl(hrun, fr + 48);
              const float h01 = A1 * H0 + H1, a01 = A1 * A0, h012 = A2 * h01 + H2, a012 = A2 * a01;
              Aex[nt] = (fq == 0) ? 1.f : (fq == 1) ? A0 : (fq == 2) ? a01 : a012;
              Hex[nt] = (fq == 0) ? 0.f : (fq == 1) ? H0 : (fq == 2) ? h01 : h012;
              if (fq == 0) *(LAS f32x2*)(WSUM + (((ch & 1) * 8 + wave) * 32 + 16 * nt + fr) * 2) = (f32x2){A3 * a012, A3 * h012 + H3}; } }
        __syncthreads();
        { float ssr[4] = {0.f, 0.f, 0.f, 0.f};
#pragma unroll
          for (int nt = 0; nt < 2; ++nt) { const int chn = 16 * nt + fr; float x = hc[nt], mine = 0.f;
#pragma unroll
              for (int w2 = 0; w2 < 8; ++w2) { const f32x2 sm = *(const LAS f32x2*)(WSUM + (((ch & 1) * 8 + w2) * 32 + chn) * 2); if (w2 == wave) mine = x; x = sm[0] * x + sm[1]; }
              hc[nt] = x;
              const float hstart = Aex[nt] * mine + Hex[nt];
#pragma unroll
              for (int r = 0; r < 4; ++r) { const int tl = 4 * fq + r; const float h = Al[nt][r] * hstart + Hl[nt][r];
                  const float y = h * gelu_tanh(bf2f(GW[tl * 40 + chn])); const unsigned yb = cvt_pk_bf16(y, 0.f) & 0xffffu; YW[tl * 40 + chn] = (bf16_t)yb;
                  const float yr = __uint_as_float(yb << 16); ssr[r] += yr * yr; } }
#pragma unroll
          for (int r = 0; r < 4; ++r) { float q = ssr[r]; q += __shfl_xor(q, 1); q += __shfl_xor(q, 2); q += __shfl_xor(q, 4); q += __shfl_xor(q, 8);
              if (fr == 0) SSQL[((size_t)b * SEQ + t0 + 16 * wave + 4 * fq + r) * 16 + blk * 2 + half] = q; } }
        LDS_WAIT(); asm volatile("" ::: "memory");
        *(u32x4*)(YC + ((size_t)b * SEQ + t0 + 16 * wave + (lane >> 2)) * DM + oc0 + 8 * (lane & 3)) = *(const LAS u32x4*)(YW + (lane >> 2) * 40 + 8 * (lane & 3));
      }
    }
#undef LRU_PREFETCH
    __syncthreads();
}

__device__ __forceinline__ void moba_unit_simple(const Args& a, const Ctx& C, int b, int h, int qb) {
    unsigned char* ws = a.ws;
    const bf16_t* Q = (const bf16_t*)(ws + WS_A) + (size_t)2 * NTOK * 512; const bf16_t* K = Q + (size_t)NTOK * 512; const bf16_t* V = K + (size_t)NTOK * 512;
    bf16_t* YA = (bf16_t*)(ws + WS_B) + (size_t)NTOK * 512; const float* KSUM = (const float*)(ws + WS_KSUM);
    const int q = C.tid & 255, hf = C.tid >> 8; const size_t row = (size_t)b * SEQ + qb * 256 + q;
    float qv[64];
    { const u32x4* qp = (const u32x4*)(Q + row * 512 + h * 64);
#pragma unroll
      for (int i = 0; i < 8; ++i) { const u32x4 w = qp[i]; qv[8 * i] = bflo(w.x); qv[8 * i + 1] = bfhi(w.x); qv[8 * i + 2] = bflo(w.y); qv[8 * i + 3] = bfhi(w.y); qv[8 * i + 4] = bflo(w.z); qv[8 * i + 5] = bfhi(w.z); qv[8 * i + 6] = bflo(w.w); qv[8 * i + 7] = bfhi(w.w); } }
    unsigned sel = 0u;
    { float g[8];
#pragma unroll
      for (int n = 0; n < 8; ++n) { g[n] = -INFINITY;
          if (n < qb) { const float* ks = KSUM + (size_t)(b * 8 + n) * 512 + h * 64; float s = 0.f;
#pragma unroll
              for (int d = 0; d < 64; ++d) s += qv[d] * ks[d];
              g[n] = s; } }
      const int npick = qb < 3 ? qb : 3;
      for (int p = 0; p < npick; ++p) { int best = -1; float bv = -INFINITY;
#pragma unroll
          for (int n = 0; n < 8; ++n) { const bool ok = (n < qb) && !((sel >> n) & 1u) && (best < 0 || g[n] > bv); if (ok) { best = n; bv = g[n]; } }
          if (best >= 0) sel |= 1u << best; } }
    float o[32], mrun = -1e30f, l = 0.f;
#pragma unroll
    for (int d = 0; d < 32; ++d) o[d] = 0.f;
    for (int n = 0; n <= qb; ++n) {
        const bool own = (n == qb); const bool use = own || ((sel >> n) & 1u);
        if (!__any(use)) continue;
        for (int j = 0; j < 256; ++j) {
            const bool valid = use && (!own || j <= q);
            if (!__any(valid)) continue;
            const size_t krow = (size_t)b * SEQ + n * 256 + j;
            const u32x4* kp = (const u32x4*)(K + krow * 512 + h * 64); float s = 0.f;
#pragma unroll
            for (int i = 0; i < 8; ++i) { const u32x4 w = kp[i];
                s += qv[8 * i] * bflo(w.x) + qv[8 * i + 1] * bfhi(w.x) + qv[8 * i + 2] * bflo(w.y) + qv[8 * i + 3] * bfhi(w.y) + qv[8 * i + 4] * bflo(w.z) + qv[8 * i + 5] * bfhi(w.z) + qv[8 * i + 6] * bflo(w.w) + qv[8 * i + 7] * bfhi(w.w); }
            if (valid) {
                const float mnew = fmaxf(mrun, s), f = __builtin_amdgcn_exp2f(mrun - mnew), p = __builtin_amdgcn_exp2f(s - mnew);
                l = l * f + p; mrun = mnew;
                const u32x4* vp = (const u32x4*)(V + krow * 512 + h * 64 + 32 * hf);
#pragma unroll
                for (int i = 0; i < 4; ++i) { const u32x4 w = vp[i];
                    o[8 * i] = o[8 * i] * f + p * bflo(w.x); o[8 * i + 1] = o[8 * i + 1] * f + p * bfhi(w.x); o[8 * i + 2] = o[8 * i + 2] * f + p * bflo(w.y); o[8 * i + 3] = o[8 * i + 3] * f + p * bfhi(w.y);
                    o[8 * i + 4] = o[8 * i + 4] * f + p * bflo(w.z); o[8 * i + 5] = o[8 * i + 5] * f + p * bfhi(w.z); o[8 * i + 6] = o[8 * i + 6] * f + p * bflo(w.w); o[8 * i + 7] = o[8 * i + 7] * f + p * bfhi(w.w); }
            }
        }
    }
    const float inv = 1.0f / l;
    u32x4* op = (u32x4*)(YA + row * 512 + h * 64 + 32 * hf);
#pragma unroll
    for (int i = 0; i < 4; ++i) { u32x4 w; w.x = cvt_pk_bf16(o[8 * i] * inv, o[8 * i + 1] * inv); w.y = cvt_pk_bf16(o[8 * i + 2] * inv, o[8 * i + 3] * inv); w.z = cvt_pk_bf16(o[8 * i + 4] * inv, o[8 * i + 5] * inv); w.w = cvt_pk_bf16(o[8 * i + 6] * inv, o[8 * i + 7] * inv); op[i] = w; }
}

__device__ __forceinline__ void ph_ymix(const Args& a, const Ctx& C) {
    const bf16_t* YL = (const bf16_t*)(a.ws + WS_B); const bf16_t* YA = YL + (size_t)NTOK * 512; bf16_t* YM = (bf16_t*)(a.ws + WS_C);
    const int gw = C.vcu * 8 + C.wave, NGW = C.G * 8, lane = C.lane;
    for (int m = gw; m < NTOK; m += NGW) {
#pragma unroll
        for (int part = 0; part < 2; ++part) {
            const u32x4 w = *((const u32x4*)((part ? YA : YL) + (size_t)m * 512) + lane);
            float v[8] = {bflo(w.x), bfhi(w.x), bflo(w.y), bfhi(w.y), bflo(w.z), bfhi(w.z), bflo(w.w), bfhi(w.w)}; float s = 0.f;
#pragma unroll
            for (int i = 0; i < 8; ++i) s += v[i] * v[i];
            const float rstd = 1.0f / sqrtf(wave_sum(s) * (1.0f / 512.0f) + EPS);
            u32x4 o; o.x = cvt_pk_bf16(v[0] * rstd, v[1] * rstd); o.y = cvt_pk_bf16(v[2] * rstd, v[3] * rstd); o.z = cvt_pk_bf16(v[4] * rstd, v[5] * rstd); o.w = cvt_pk_bf16(v[6] * rstd, v[7] * rstd);
            *((u32x4*)(YM + (size_t)m * DM + part * 512) + lane) = o;
        }
    }
}

__device__ __forceinline__ void ph_router(const Args& a, const Ctx& C) {
    unsigned char* ws = a.ws;
    const bf16_t* H2B = (const bf16_t*)a.out + DM; const bf16_t* WR = (const bf16_t*)(ws + WS_WR); const float* SSQ2 = (const float*)(ws + WS_SSQ2);
    unsigned* CNT = (unsigned*)(ws + WS_CTL) + CW_CNT;
    int* TOKE = (int*)(ws + WS_TOK + TOK_E); int* TOKR = (int*)(ws + WS_TOK + TOK_R); float* TOKG = (float*)(ws + WS_TOK + TOK_G); int* LTOK = (int*)(ws + WS_LTOK); float* LRS = (float*)(ws + WS_LRS);
    constexpr int WRS = 1032;
    LAS bf16_t* WRL = (LAS bf16_t*)C.lds;
    LAS float* LG = (LAS float*)(C.lds + 99072) + C.wave * (16 * 49);
    LAS unsigned* lcnt = (LAS unsigned*)(C.lds + 99072 + 25088); LAS unsigned* lbase = lcnt + 32;
    const int lane = C.lane, fr = lane & 15, fq = lane >> 4;
    for (int i = C.tid; i < 48 * 128; i += 512) { const int r = i >> 7, c8 = i & 127; *(LAS u32x4*)(WRL + r * WRS + 8 * c8) = *(const u32x4*)(WR + (size_t)r * DM + 8 * c8); }
    for (int pass = 0; (pass * C.G) * 128 < NTOK; ++pass) {
        const int blk = pass * C.G + C.vcu; const bool live = blk * 128 < NTOK;
        if (C.tid < 32) lcnt[C.tid] = 0u;
        __syncthreads();
        int E1 = 0, E2 = 0; unsigned r1 = 0, r2 = 0; float ga = 0.f, gb = 0.f, rstd_t = 0.f; const int tb = blk * 128 + 16 * C.wave;
        if (live) {
            f32x4 acc[3] = {{0.f, 0.f, 0.f, 0.f}, {0.f, 0.f, 0.f, 0.f}, {0.f, 0.f, 0.f, 0.f}};
            bf16x8 af[32];
#pragma unroll
            for (int ks = 0; ks < 32; ++ks) af[ks] = *(const bf16x8*)(H2B + (size_t)(tb + fr) * LDH + 32 * ks + 8 * fq);
#pragma unroll
            for (int ks = 0; ks < 32; ++ks) {
#pragma unroll
                for (int nt = 0; nt < 3; ++nt) { const bf16x8 bfg = *(const LAS bf16x8*)(WRL + (16 * nt + fr) * WRS + 32 * ks + 8 * fq); acc[nt] = __builtin_amdgcn_mfma_f32_16x16x32_bf16(af[ks], bfg, acc[nt], 0, 0, 0); } }
#pragma unroll
            for (int nt = 0; nt < 3; ++nt)
#pragma unroll
                for (int r = 0; r < 4; ++r) LG[(4 * fq + r) * 49 + 16 * nt + fr] = acc[nt][r];
            LDS_WAIT(); asm volatile("" ::: "memory");
            if (lane < 16) { const int t = tb + lane; const float rstd = rstd_from_ssq(SSQ2, t); rstd_t = rstd; const LAS float* lg = LG + lane * 49;
                float g[4]; int grp = 0;
#pragma unroll
                for (int i = 0; i < 4; ++i) g[i] = lg[i] * rstd + a.in[21][i];
#pragma unroll
                for (int i = 1; i < 4; ++i) if (g[i] > g[grp]) grp = i;
                float gs = 0.f;
#pragma unroll
                for (int i = 0; i < 4; ++i) gs += __expf(g[i] - g[grp]);
                const float gw_ = 1.0f / gs;
                float e[8];
#pragma unroll
                for (int i = 0; i < 8; ++i) e[i] = lg[4 + 8 * grp + i] * rstd + a.in[23][8 * grp + i];
                int i1 = 0;
#pragma unroll
                for (int i = 1; i < 8; ++i) if (e[i] > e[i1]) i1 = i;
                int i2 = (i1 == 0) ? 1 : 0;
#pragma unroll
                for (int i = 0; i < 8; ++i) if (i != i1 && i != i2 && e[i] > e[i2]) i2 = i;
                const float eb = __expf(e[i2] - e[i1]); ga = gw_ / (1.0f + eb); gb = gw_ * eb / (1.0f + eb);
                E1 = grp * 8 + i1; E2 = grp * 8 + i2;
                r1 = atomicAdd((unsigned*)&lcnt[E1], 1u); r2 = atomicAdd((unsigned*)&lcnt[E2], 1u);
            }
        }
        __syncthreads();
        if (C.tid < 32) lbase[C.tid] = lcnt[C.tid] ? __hip_atomic_fetch_add(CNT + C.tid, lcnt[C.tid], __ATOMIC_RELAXED, __HIP_MEMORY_SCOPE_AGENT) : 0u;
        __syncthreads();
        if (live && lane < 16) { const int t = tb + lane;
            const int k1 = (int)(lbase[E1] + r1), k2 = (int)(lbase[E2] + r2);
            TOKE[2 * t] = E1; TOKR[2 * t] = k1; TOKG[2 * t] = ga; LTOK[E1 * LCAP + k1] = t; LRS[E1 * LCAP + k1] = rstd_t;
            TOKE[2 * t + 1] = E2; TOKR[2 * t + 1] = k2; TOKG[2 * t + 1] = gb; LTOK[E2 * LCAP + k2] = t; LRS[E2 * LCAP + k2] = rstd_t; }
        __syncthreads();
    }
}
__device__ __forceinline__ void moe_table(const Args& a, const Ctx& C) {
    LAS int* ts = (LAS int*)(C.lds + MOE_OFF);
    if (C.tid == 0) { const unsigned* CNT = (const unsigned*)(a.ws + WS_CTL) + CW_CNT; int acc = 0;
        for (int e = 0; e < NEXP; ++e) { ts[e] = acc; const unsigned c = __hip_atomic_load(CNT + e, __ATOMIC_RELAXED, __HIP_MEMORY_SCOPE_AGENT); ts[33 + e] = (int)c; acc += (int)((c + 255u) >> 8); }
        ts[NEXP] = acc; }
    __syncthreads();
}
__device__ __forceinline__ void ph_final(const Args& a, const Ctx& C, float* outp) {
    unsigned char* ws = a.ws;
    const unsigned char* YB = ws + WS_A; const float* TOKG = (const float*)(ws + WS_TOK + TOK_G); const int* TOKE = (const int*)(ws + WS_TOK + TOK_E); const int* TOKR = (const int*)(ws + WS_TOK + TOK_R);
    const LAS int* ts = (const LAS int*)(C.lds + MOE_OFF);
    const bf16_t* H2B = (const bf16_t*)a.out + DM; const float* gf = a.in[26];
    const int gw = C.vcu * 8 + C.wave, NGW = C.G * 8, lane = C.lane;
    f32x4 gn[4];
#pragma unroll
    for (int q = 0; q < 4; ++q) gn[q] = *(const f32x4*)(gf + 512 * (q >> 1) + 8 * lane + 4 * (q & 1));
    const int nit = (NTOK + NGW - 1) / NGW;
    int dnx = 0; float gnx = 0.f;
#define FIN_IDX(ib) do { const int tt_ = gw + ((ib) + (lane >> 1)) * NGW; dnx = 0; gnx = 0.f; \
        if (lane < 8 && tt_ < NTOK) { const int e_ = TOKE[2 * tt_ + (lane & 1)]; dnx = ts[e_] * 256 + TOKR[2 * tt_ + (lane & 1)]; gnx = TOKG[2 * tt_ + (lane & 1)]; } } while (0)
    FIN_IDX(0);
    for (int ib = 0; ib < nit; ib += 4) {
        const int dcur = dnx; const float gcur = gnx;
        if (ib + 4 < nit) FIN_IDX(ib + 4);
        u32x4 hw[4][2]; u32x2 y0[4][2], y1[4][2];
#pragma unroll
        for (int j = 0; j < 4; ++j) { const int t = gw + (ib + j) * NGW; const int d0 = __builtin_amdgcn_readlane(dcur, 2 * j), d1 = __builtin_amdgcn_readlane(dcur, 2 * j + 1);
            if (t < NTOK) {
#pragma unroll
                for (int hf = 0; hf < 2; ++hf) { hw[j][hf] = *((const u32x4*)(H2B + (size_t)t * LDH + 512 * hf) + lane); y0[j][hf] = *((const u32x2*)(YB + (size_t)d0 * DM + 512 * hf) + lane); y1[j][hf] = *((const u32x2*)(YB + (size_t)d1 * DM + 512 * hf) + lane); } } }
#pragma unroll
        for (int j = 0; j < 4; ++j) { const int t = gw + (ib + j) * NGW;
            const float g0 = __builtin_bit_cast(float, __builtin_amdgcn_readlane(__builtin_bit_cast(int, gcur), 2 * j)) * (1.0f / YB_SC), g1 = __builtin_bit_cast(float, __builtin_amdgcn_readlane(__builtin_bit_cast(int, gcur), 2 * j + 1)) * (1.0f / YB_SC);
            if (t < NTOK) { float v[16]; float s2 = 0.f;
#pragma unroll
                for (int hf = 0; hf < 2; ++hf)
#pragma unroll
                    for (int w = 0; w < 2; ++w) { const int yw0 = (int)y0[j][hf][w], yw1 = (int)y1[j][hf][w];
                        const f32x2 pa = __builtin_amdgcn_cvt_pk_f32_fp8(yw0, false), pb = __builtin_amdgcn_cvt_pk_f32_fp8(yw0, true), qa = __builtin_amdgcn_cvt_pk_f32_fp8(yw1, false), qb = __builtin_amdgcn_cvt_pk_f32_fp8(yw1, true);
                        const unsigned ha = hw[j][hf][2 * w], hb = hw[j][hf][2 * w + 1];
                        const float e0 = bflo(ha) + g0 * pa[0] + g1 * qa[0], e1 = bfhi(ha) + g0 * pa[1] + g1 * qa[1], e2 = bflo(hb) + g0 * pb[0] + g1 * qb[0], e3 = bfhi(hb) + g0 * pb[1] + g1 * qb[1];
                        v[8 * hf + 4 * w] = e0; v[8 * hf + 4 * w + 1] = e1; v[8 * hf + 4 * w + 2] = e2; v[8 * hf + 4 * w + 3] = e3; s2 += (e0 * e0 + e1 * e1) + (e2 * e2 + e3 * e3); }
                const float rstd = __builtin_amdgcn_rsqf(wave_sum(s2) * (1.0f / DM) + EPS);
#pragma unroll
                for (int q = 0; q < 4; ++q) { const f32x4 o = {v[4 * q] * rstd * gn[q][0], v[4 * q + 1] * rstd * gn[q][1], v[4 * q + 2] * rstd * gn[q][2], v[4 * q + 3] * rstd * gn[q][3]};
                    *(f32x4*)(outp + (size_t)t * DM + 512 * (q >> 1) + 8 * lane + 4 * (q & 1)) = o; } } }
    }
#undef FIN_IDX
}

#include <hip/hip_bf16.h>
#include <cmath>
namespace attn_body {
using bf16=__hip_bfloat16;
using bf16x8=__attribute__((ext_vector_type(8)))short;
using s16x4=__attribute__((ext_vector_type(4)))short;
using f32x16=__attribute__((ext_vector_type(16)))float;
using u32x4=__attribute__((ext_vector_type(4)))unsigned;
using f32x4_t=__attribute__((ext_vector_type(4)))float;
constexpr int BATCH=16,NHEAD=8,SEQ=2048,D=64,DM=NHEAD*D,DMO=1024;
constexpr int NW=8,QBLK=32,QB=QBLK*NW,KVBLK=64,NQB=SEQ/QB;
constexpr int ATTN_PITCH=DM, ATTN_UNIT_ROWS=QB;
__device__ __forceinline__ int crow(int r,int hi){return (r&3)+8*(r>>2)+4*hi;}
#define SBAR() __builtin_amdgcn_sched_barrier(0)
__device__ __forceinline__ void cmask(f32x16&p0,f32x16&p1,int jb,int qrel,int hi){
  const float NEG=-INFINITY; int kb=64*jb+4*hi; asm volatile("":"+v"(kb));
  #pragma unroll
  for(int r=0;r<16;++r){int kv=kb+(r&3)+8*(r>>2); if(kv>qrel)p0[r]=NEG; if(kv+32>qrel)p1[r]=NEG;}
}

constexpr int NSLOT=3, SLOTB=8192;
constexpr int LDS_K=0, LDS_V=NSLOT*SLOTB, LDS_WS=2*NSLOT*SLOTB, LDS_OST=LDS_WS+NW*64*4, LDS_BYTES=LDS_OST+NW*4096;
constexpr float C2=0.125f*1.4426950408889634f;
__device__ __forceinline__ void glds16(const char*sbase,unsigned voff,unsigned lds_dst){unsigned keep;
  asm volatile("s_nop 4\n\ts_mov_b32 %0, m0\n\ts_mov_b32 m0, %3\n\ts_nop 0\n\tglobal_load_lds_dwordx4 %1, %2\n\ts_mov_b32 m0, %0":"=&s"(keep):"v"(voff),"s"(sbase),"s"(lds_dst):"memory");}
__device__ __forceinline__ const char* uni_ptr(const void*p){const unsigned long long v=(unsigned long long)p;const unsigned lo=__builtin_amdgcn_readfirstlane((unsigned)v),hi=__builtin_amdgcn_readfirstlane((unsigned)(v>>32));return (const char*)(((unsigned long long)hi<<32)|lo);}
__device__ __forceinline__ float max3f(float a,float b,float c){float r;asm("v_max3_f32 %0, %1, %2, %3":"=v"(r):"v"(a),"v"(b),"v"(c));return r;}
__device__ __forceinline__ float max2f(float a,float b){float r;asm("v_max_f32_e32 %0, %1, %2":"=v"(r):"v"(a),"v"(b));return r;}
__device__ __forceinline__ float fadd_s(float a,float b){float r;asm("v_add_f32_e32 %0, %1, %2":"=v"(r):"v"(a),"v"(b));return r;}
__device__ __forceinline__ float fsub_s(float a,float b){float r;asm("v_sub_f32_e32 %0, %1, %2":"=v"(r):"v"(a),"v"(b));return r;}
typedef float f32x2_t __attribute__((ext_vector_type(2))); typedef __bf16 bf16x2_t __attribute__((ext_vector_type(2)));
__device__ __forceinline__ unsigned cvtpk_s(float lo,float hi){f32x2_t v={lo,hi};bf16x2_t b=__builtin_convertvector(v,bf16x2_t);return __builtin_bit_cast(unsigned,b);}
#define WAIT_BAR(N) asm volatile("s_waitcnt vmcnt(" #N ") lgkmcnt(0)\n\ts_barrier":::"memory")

__device__ __forceinline__ void qkt(f32x16&p0,f32x16&p1,const char*Kslot,const bf16x8*qr,const f32x16&negm,int r32,int hi){
  const char*kb=Kslot+hi*1024+r32*16;
  #pragma unroll
  for(int d0=0;d0<4;++d0){
    const bf16x8 b0=*reinterpret_cast<const bf16x8*>(kb+d0*2048);
    const bf16x8 b1=*reinterpret_cast<const bf16x8*>(kb+d0*2048+512);
    if(d0==0){p0=__builtin_amdgcn_mfma_f32_32x32x16_bf16(b0,qr[0],negm,0,0,0);p1=__builtin_amdgcn_mfma_f32_32x32x16_bf16(b1,qr[0],negm,0,0,0);}
    else{p0=__builtin_amdgcn_mfma_f32_32x32x16_bf16(b0,qr[d0],p0,0,0,0);p1=__builtin_amdgcn_mfma_f32_32x32x16_bf16(b1,qr[d0],p1,0,0,0);}}
}
typedef __attribute__((address_space(3))) const char* lds_cptr;
typedef short v4i16_t __attribute__((ext_vector_type(4)));
__device__ __forceinline__ void kload8(bf16x8*kf,lds_cptr kp){
  kf[0]=*(const __attribute__((address_space(3))) bf16x8*)(kp);      kf[1]=*(const __attribute__((address_space(3))) bf16x8*)(kp+512);
  kf[2]=*(const __attribute__((address_space(3))) bf16x8*)(kp+2048); kf[3]=*(const __attribute__((address_space(3))) bf16x8*)(kp+2560);
  kf[4]=*(const __attribute__((address_space(3))) bf16x8*)(kp+4096); kf[5]=*(const __attribute__((address_space(3))) bf16x8*)(kp+4608);
  kf[6]=*(const __attribute__((address_space(3))) bf16x8*)(kp+6144); kf[7]=*(const __attribute__((address_space(3))) bf16x8*)(kp+6656);
}
__device__ __forceinline__ void kload2(bf16x8*kf,lds_cptr kp,int j){ kf[2*j]=*(const __attribute__((address_space(3))) bf16x8*)(kp+j*2048); kf[2*j+1]=*(const __attribute__((address_space(3))) bf16x8*)(kp+j*2048+512); }
__device__ __forceinline__ s16x4 vtr(lds_cptr p){ return __builtin_bit_cast(s16x4,__builtin_amdgcn_ds_read_tr16_b64_v4i16((__attribute__((address_space(3))) v4i16_t*)p)); }
__device__ __forceinline__ float rowmax(const f32x16&p0,const f32x16&p1){
  float a=max3f(p0[0],p0[1],p1[0]),b=max3f(p0[2],p0[3],p1[1]);a=max3f(a,p1[2],p1[3]);
  #pragma unroll
  for(int r=4;r<16;r+=4){a=max3f(a,p0[r],p0[r+1]);b=max3f(b,p0[r+2],p0[r+3]);a=max3f(a,p1[r],p1[r+1]);b=max3f(b,p1[r+2],p1[r+3]);}
  const float m=max2f(a,b);
  auto rr=__builtin_amdgcn_permlane32_swap(__float_as_uint(m),__float_as_uint(m),false,false);
  return max2f(__uint_as_float(rr[0]),__uint_as_float(rr[1]));
}
__device__ __forceinline__ void pv(f32x16*o,int vb,bf16x8 pa0,bf16x8 pa1,bf16x8 pa2,bf16x8 pa3){
  #pragma unroll
  for(int d0=0;d0<2;++d0){s16x4 lo[4],hi[4];
    #pragma unroll
    for(int ks=0;ks<4;++ks){
      asm volatile("ds_read_b64_tr_b16 %0,%1 offset:%c2":"=&v"(lo[ks]):"v"(vb),"i"(d0*4096+ks*1024):"memory");
      asm volatile("ds_read_b64_tr_b16 %0,%1 offset:%c2":"=&v"(hi[ks]):"v"(vb),"i"(d0*4096+ks*1024+512):"memory");}
    asm volatile("s_waitcnt lgkmcnt(0)":::"memory");SBAR();
    #define PK(k) (bf16x8){lo[k][0],lo[k][1],lo[k][2],lo[k][3],hi[k][0],hi[k][1],hi[k][2],hi[k][3]}
    o[d0]=__builtin_amdgcn_mfma_f32_32x32x16_bf16(pa0,PK(0),o[d0],0,0,0);
    o[d0]=__builtin_amdgcn_mfma_f32_32x32x16_bf16(pa1,PK(1),o[d0],0,0,0);
    o[d0]=__builtin_amdgcn_mfma_f32_32x32x16_bf16(pa2,PK(2),o[d0],0,0,0);
    o[d0]=__builtin_amdgcn_mfma_f32_32x32x16_bf16(pa3,PK(3),o[d0],0,0,0);
    #undef PK
  }
}

#ifndef ATTN_STORE16
#define ATTN_STORE16(p,v) (*(u32x4*)(p)=(v))
#endif
template<int THRL> __device__ __forceinline__ void attn_unit(int b,int h,int qb,const bf16*Q,const bf16*__restrict__ K,const bf16*__restrict__ V,bf16*O,const float*__restrict__ KSUM,float*__restrict__ SSQA,char*shm){
  int tid=threadIdx.x; asm volatile("":"+v"(tid));
  const int lane=tid&63,r32=lane&31,hi=lane>>5; const int wid=__builtin_amdgcn_readfirstlane(tid>>6);
  const long rowbase=(long)b*SEQ; const int q0=qb*QB;
  const bf16*Qw=Q+(rowbase+q0+wid*QBLK)*DM+h*D;
  const bf16*Kh=K+rowbase*DM+h*D,*Vh=V+rowbase*DM+h*D;
  const unsigned lds0=(unsigned)(uintptr_t)shm;
  float*wsf=(float*)(shm+LDS_WS)+wid*64;
  const char*Khu=uni_ptr(Kh);const char*Vhu=uni_ptr(Vh);
  const unsigned kvo=(unsigned)(lane*DM+wid*8)*2u;
  const unsigned vvo=(unsigned)((16*(wid&3)+(lane>>2))*DM+(wid>>2)*32+(lane&3)*8)*2u;
  const unsigned kdst=lds0+LDS_K+wid*1024, vdst=lds0+LDS_V+wid*1024;
  #define DMA_K(t,slot) glds16(Khu+(size_t)(t)*(KVBLK*DM*2),kvo,(unsigned)__builtin_amdgcn_readfirstlane(kdst+(slot)))
  #define DMA_V(t,slot) glds16(Vhu+(size_t)(t)*(KVBLK*DM*2),vvo,(unsigned)__builtin_amdgcn_readfirstlane(vdst+(slot)))
  const int vb0=(int)(lds0+LDS_V)+((lane>>4)&1)*32+(lane&3)*8+(4*hi+((lane&15)>>2))*64;
  const char*Kbase=shm+LDS_K; bf16x8 kf[8];
  const lds_cptr shm3=(lds_cptr)shm; const lds_cptr kp0=shm3+LDS_K+hi*1024+r32*16; const lds_cptr vp0=shm3+LDS_V+((lane>>4)&1)*32+(lane&3)*8+(4*hi+((lane&15)>>2))*64;
  const int NT=(q0+QB)/KVBLK;
  DMA_K(0,0);DMA_V(0,0);DMA_K(1,SLOTB);
  bf16x8 qr[4];
  #pragma unroll
  for(int d0=0;d0<4;++d0)qr[d0]=*reinterpret_cast<const bf16x8*>(&Qw[(long)r32*DM+d0*16+hi*8]);
  unsigned selm=1u<<qb;
  { float g[8];
    #pragma unroll
    for(int n=0;n<8;++n){ g[n]=-INFINITY;
      if(n<qb){ const float*ks=KSUM+(long)(b*8+n)*DM+h*D+hi*8; float s=0.f;
        #pragma unroll
        for(int d0=0;d0<4;++d0){ const f32x4_t k0=*reinterpret_cast<const f32x4_t*>(ks+d0*16), k1=*reinterpret_cast<const f32x4_t*>(ks+d0*16+4);
          const u32x4 qw=__builtin_bit_cast(u32x4,qr[d0]);
          s+=__uint_as_float(qw[0]<<16)*k0[0]+__uint_as_float(qw[0]&0xffff0000u)*k0[1]+__uint_as_float(qw[1]<<16)*k0[2]+__uint_as_float(qw[1]&0xffff0000u)*k0[3]
            +__uint_as_float(qw[2]<<16)*k1[0]+__uint_as_float(qw[2]&0xffff0000u)*k1[1]+__uint_as_float(qw[3]<<16)*k1[2]+__uint_as_float(qw[3]&0xffff0000u)*k1[3]; }
        s+=__shfl_xor(s,32); g[n]=s; } }
    const int npick=qb<3?qb:3;
    for(int p=0;p<npick;++p){ int best=-1; float bv=-INFINITY;
      #pragma unroll
      for(int n=0;n<8;++n){ const bool ok=(n<qb)&&!((selm>>n)&1u)&&(best<0||g[n]>bv); if(ok){best=n;bv=g[n];} }
      if(best>=0)selm|=1u<<best; } }
  #define BMASK(P0,P1,t) do{ float bias_=((selm>>((t)>>2))&1u)?-mhat:-INFINITY; asm volatile("":"+v"(bias_)); _Pragma("unroll") for(int r=0;r<16;++r){P0[r]+=bias_;P1[r]+=bias_;} }while(0)
  float mhat=0.f,l_reg=0.f;f32x16 o[2];{float z0_=0.f;asm volatile("":"+v"(z0_));_Pragma("unroll") for(int r=0;r<16;++r){o[0][r]=z0_;o[1][r]=z0_;}}const f32x16 negm=f32x16{};
  const int qrel=wid*QBLK+r32;
  #define CMASK(P0,P1,t) do{int jb_=(t)-(NT-4); if(jb_>=0)cmask(P0,P1,jb_,qrel,hi);}while(0)
  bool resc=false;
  #define START(P0,P1) do{ const float rm=__builtin_fmaxf(rowmax(P0,P1),-100.0f); resc=false; \
    { const float dl=rm; mhat=fadd_s(mhat,dl); \
      _Pragma("unroll") for(int r=0;r<16;++r){P0[r]=fsub_s(P0[r],dl);P1[r]=fsub_s(P1[r],dl);} \
      } \
    _Pragma("unroll") for(int r=0;r<16;++r)P0[r]=__builtin_amdgcn_exp2f(P0[r]); }while(0)
  #define RESC() do{ if(resc){ asm volatile("s_waitcnt lgkmcnt(0)":::"memory"); \
      _Pragma("unroll") for(int d_=0;d_<2;++d_) _Pragma("unroll") for(int r=0;r<16;++r)o[d_][r]*=wsf[crow(r,hi)]; } }while(0)
  f32x16 pA0,pA1,pB0,pB1;
  int sl_prev=0,sl_cur=0,sl_next=SLOTB;
  #define ROT() do{sl_prev=sl_cur;sl_cur=sl_next;sl_next=(sl_next==(NSLOT-1)*SLOTB)?0:sl_next+SLOTB;}while(0)
  DMA_K(2,2*SLOTB);
  WAIT_BAR(3);
  qkt(pA0,pA1,Kbase,qr,negm,r32,hi);asm volatile("s_nop 15\n\ts_nop 7":"+v"(pA0),"+v"(pA1));CMASK(pA0,pA1,0);BMASK(pA0,pA1,0);
  START(pA0,pA1);
  _Pragma("unroll") for(int r=0;r<16;++r)pA1[r]=__builtin_amdgcn_exp2f(pA1[r]);
  WAIT_BAR(0);
  DMA_K(3,0);DMA_V(1,SLOTB);
  ROT();
  kload8(kf,kp0+sl_cur);
  WAIT_BAR(2);
  s16x4 vlo[8],vhi[8]; u32x4 pw0,pw1,pw2,pw3;
  #define PKW(P,B) cvtpk_s(P[B],P[B+1])
  #define PAF(k) __builtin_bit_cast(bf16x8,pw##k)
  #define VFR(i) (bf16x8){vlo[i][0],vlo[i][1],vlo[i][2],vlo[i][3],vhi[i][0],vhi[i][1],vhi[i][2],vhi[i][3]}
  #define PIN(x) asm volatile("":"+v"(x))
  #define MX3(a,b,c) __builtin_fmaxf(__builtin_fmaxf((a),(b)),(c))
  #define GAPA(MF,A0,A1,A2,A3,W0,W1,PW) do{ MF; sacc+=A0; sacc+=A1; sacc+=A2; sacc+=A3; PIN(sacc); W0; W1; PIN(PW); SBAR(); }while(0)
  #define EX(v) __builtin_amdgcn_exp2f(v)
  #define GAPB(MF,X,B) do{ MF; X[B]=EX(X[B]); X[B+1]=EX(X[B+1]); X[B+2]=EX(X[B+2]); X[B+3]=EX(X[B+3]); PIN(X); SBAR(); }while(0)
  #define VRD(i) do{ vlo[i]=vtr(vp_+(((i)>>2)*4096+((i)&3)*1024)); vhi[i]=vtr(vp_+(((i)>>2)*4096+((i)&3)*1024+512)); }while(0)
  #define KRD(G,j) do{ if(G){ kload2(kf,kp0+sl_next,j); SBAR(); } }while(0)
  #define STEP(C0,C1,P0,P1,t,GK,GV,GL) do{ SBAR(); \
    const lds_cptr vp_=vp0+sl_prev; \
    VRD(0); SBAR(); float sacc=(P0[0]+P0[1]); \
    GAPA(C0=__builtin_amdgcn_mfma_f32_32x32x16_bf16(kf[0],qr[0],negm,0,0,0), P0[2],P0[3],P0[4],P0[5],     pw0[0]=PKW(P0,0), pw0[1]=PKW(P0,2), pw0); \
    VRD(4); SBAR(); GAPA(C1=__builtin_amdgcn_mfma_f32_32x32x16_bf16(kf[1],qr[0],negm,0,0,0), P0[6],P0[7],P0[8],P0[9],     pw0[2]=PKW(P0,4), pw0[3]=PKW(P0,6), pw0); \
    VRD(1); SBAR(); GAPA(C0=__builtin_amdgcn_mfma_f32_32x32x16_bf16(kf[2],qr[1],C0,0,0,0),   P0[10],P0[11],P0[12],P0[13], pw1[0]=PKW(P0,8), pw1[1]=PKW(P0,10), pw1); \
    VRD(5); SBAR(); GAPA(C1=__builtin_amdgcn_mfma_f32_32x32x16_bf16(kf[3],qr[1],C1,0,0,0),   P0[14],P0[15],P1[0],P1[1],   pw1[2]=PKW(P0,12),pw1[3]=PKW(P0,14), pw1); \
    VRD(2); SBAR(); GAPA(C0=__builtin_amdgcn_mfma_f32_32x32x16_bf16(kf[4],qr[2],C0,0,0,0),   P1[2],P1[3],P1[4],P1[5],     pw2[0]=PKW(P1,0), pw2[1]=PKW(P1,2), pw2); \
    VRD(6); SBAR(); GAPA(C1=__builtin_amdgcn_mfma_f32_32x32x16_bf16(kf[5],qr[2],C1,0,0,0),   P1[6],P1[7],P1[8],P1[9],     pw2[2]=PKW(P1,4), pw2[3]=PKW(P1,6), pw2); \
    VRD(3); SBAR(); GAPA(C0=__builtin_amdgcn_mfma_f32_32x32x16_bf16(kf[6],qr[3],C0,0,0,0),   P1[10],P1[11],P1[12],P1[13], pw3[0]=PKW(P1,8), pw3[1]=PKW(P1,10), pw3); \
    VRD(7); SBAR(); GAPA(C1=__builtin_amdgcn_mfma_f32_32x32x16_bf16(kf[7],qr[3],C1,0,0,0),   P1[14],P1[15],0.f,0.f,       pw3[2]=PKW(P1,12),pw3[3]=PKW(P1,14), pw3); \
    l_reg+=sacc; \
    if(GK){DMA_K((t)+3,sl_cur);} if(GV){DMA_V((t)+1,sl_next);} \
    CMASK(C0,C1,t); BMASK(C0,C1,t); \
    { float a=MX3(C0[0],C0[1],C1[0]),b=MX3(C0[2],C0[3],C1[1]); a=MX3(a,C1[2],C1[3]); \
      _Pragma("unroll") for(int r=4;r<16;r+=4){a=MX3(a,C0[r],C0[r+1]);b=MX3(b,C0[r+2],C0[r+3]);a=MX3(a,C1[r],C1[r+1]);b=MX3(b,C1[r+2],C1[r+3]);} \
      float rm=__builtin_fmaxf(a,b); { auto rr=__builtin_amdgcn_permlane32_swap(__float_as_uint(rm),__float_as_uint(rm),false,false); rm=__builtin_fmaxf(__uint_as_float(rr[0]),__uint_as_float(rr[1])); } \
      resc=false; \
      if(__builtin_expect(__any(rm>(float)THRL),0)){ const float dl=__builtin_fmaxf(rm,0.f); mhat+=dl; \
        _Pragma("unroll") for(int r=0;r<16;++r){C0[r]-=dl;C1[r]-=dl;} \
        const float f=__builtin_amdgcn_exp2f(-dl); l_reg*=f; if(hi==0)wsf[r32]=f; resc=true; } } \
    SBAR(); \
    GAPB(o[0]=__builtin_amdgcn_mfma_f32_32x32x16_bf16(PAF(0),VFR(0),o[0],0,0,0), C0,0); \
    GAPB(o[1]=__builtin_amdgcn_mfma_f32_32x32x16_bf16(PAF(0),VFR(4),o[1],0,0,0), C0,4); \
    KRD(GL,0); GAPB(o[0]=__builtin_amdgcn_mfma_f32_32x32x16_bf16(PAF(1),VFR(1),o[0],0,0,0), C0,8); \
    KRD(GL,1); GAPB(o[1]=__builtin_amdgcn_mfma_f32_32x32x16_bf16(PAF(1),VFR(5),o[1],0,0,0), C0,12); \
    KRD(GL,2); GAPB(o[0]=__builtin_amdgcn_mfma_f32_32x32x16_bf16(PAF(2),VFR(2),o[0],0,0,0), C1,0); \
    KRD(GL,3); GAPB(o[1]=__builtin_amdgcn_mfma_f32_32x32x16_bf16(PAF(2),VFR(6),o[1],0,0,0), C1,4); \
    GAPB(o[0]=__builtin_amdgcn_mfma_f32_32x32x16_bf16(PAF(3),VFR(3),o[0],0,0,0), C1,8); \
    GAPB(o[1]=__builtin_amdgcn_mfma_f32_32x32x16_bf16(PAF(3),VFR(7),o[1],0,0,0), C1,12); \
    }while(0)
  int t=1;
  #undef CMASK
  #define CMASK(P0,P1,t) do{}while(0)
  for(;t+5<NT;t+=2){
    STEP(pB0,pB1,pA0,pA1,t,true,true,true);     WAIT_BAR(2); RESC(); ROT();
    STEP(pA0,pA1,pB0,pB1,t+1,true,true,true);   WAIT_BAR(2); RESC(); ROT();
  }
  #undef CMASK
  #define CMASK(P0,P1,t) do{int jb_=(t)-(NT-4); if(jb_>=0)cmask(P0,P1,jb_,qrel,hi);}while(0)
  #define ENDW(tt) do{ if((tt)+3<NT){WAIT_BAR(2);} else if((tt)+2<NT){WAIT_BAR(1);} else {WAIT_BAR(0);} }while(0)
  for(;t+1<NT;t+=2){
    STEP(pB0,pB1,pA0,pA1,t,(t+3<NT),(t+1<NT),(t+1<NT));       ENDW(t);   RESC(); ROT();
    STEP(pA0,pA1,pB0,pB1,t+1,(t+4<NT),(t+2<NT),(t+2<NT));     ENDW(t+1); RESC(); ROT();
  }
  STEP(pB0,pB1,pA0,pA1,NT-1,false,false,false); RESC();
  { float sacc=pB0[0]+pB0[1]; _Pragma("unroll") for(int r=2;r<16;++r)sacc+=pB0[r]; _Pragma("unroll") for(int r=0;r<16;++r)sacc+=pB1[r]; l_reg+=sacc;
    pw0=(u32x4){PKW(pB0,0),PKW(pB0,2),PKW(pB0,4),PKW(pB0,6)};pw1=(u32x4){PKW(pB0,8),PKW(pB0,10),PKW(pB0,12),PKW(pB0,14)};pw2=(u32x4){PKW(pB1,0),PKW(pB1,2),PKW(pB1,4),PKW(pB1,6)};pw3=(u32x4){PKW(pB1,8),PKW(pB1,10),PKW(pB1,12),PKW(pB1,14)};
    SBAR(); pv(o,vb0+sl_cur,PAF(0),PAF(1),PAF(2),PAF(3)); }
  #undef PKW
  #undef PAF
  #undef VFR
  #undef PIN
  #undef MX3
  #undef GAPA
  #undef GAPB
  #undef EX
  #undef VRD
  #undef KRD
  #undef STEP
  #undef ENDW
  {auto rr=__builtin_amdgcn_permlane32_swap(__float_as_uint(l_reg),__float_as_uint(l_reg),false,false);l_reg=__uint_as_float(rr[0])+__uint_as_float(rr[1]);}
  if(hi==0)wsf[32+r32]=l_reg;asm volatile("s_waitcnt lgkmcnt(0)":::"memory");
  float rli[16];
  #pragma unroll
  for(int r=0;r<16;++r)rli[r]=__builtin_amdgcn_rcpf(wsf[32+crow(r,hi)]);
  bf16*Ow=O+(rowbase+q0+wid*QBLK)*DMO+h*D;
  { bf16*stg=(bf16*)(shm+LDS_OST)+wid*2048;
    #pragma unroll
    for(int r=0;r<16;++r){const int orow=crow(r,hi);
      #pragma unroll
      for(int d0=0;d0<2;++d0)stg[orow*64+d0*32+r32]=__float2bfloat16(o[d0][r]*rli[r]);}
    asm volatile("s_waitcnt lgkmcnt(0)":::"memory");
    #pragma unroll
    for(int i=0;i<4;++i){const int row=i*8+(lane>>3),ch=lane&7; const u32x4 v=*(const u32x4*)(stg+row*64+ch*8); ATTN_STORE16(Ow+(long)row*DMO+ch*8,v);
      float q=0.f;
      #pragma unroll
      for(int e=0;e<4;++e){const float lo=__uint_as_float(v[e]<<16),hi2=__uint_as_float(v[e]&0xffff0000u);q+=lo*lo+hi2*hi2;}
      q+=__shfl_xor(q,1);q+=__shfl_xor(q,2);q+=__shfl_xor(q,4);
      if(ch==0)SSQA[(rowbase+q0+wid*QBLK+row)*8+h]=q;} }
  asm volatile("s_waitcnt lgkmcnt(0)\n\ts_barrier":::"memory");
  #undef BMASK
  #undef DMA_K
  #undef DMA_V
  #undef CMASK
  #undef START
  #undef RESC
  #undef ROT
}
constexpr int ATTN_LDS_BYTES=LDS_BYTES;
#undef SBAR
#undef WAIT_BAR
}

#ifndef STAG_TICKS
#define STAG_TICKS 100
#endif
__device__ __forceinline__ void stagger(int c, int ticks) {
    const unsigned long long t0 = __builtin_amdgcn_s_memrealtime(); const unsigned long long w = (unsigned long long)(((c >> 3) & 3) * ticks);
    while (__builtin_amdgcn_s_memrealtime() - t0 < w) __builtin_amdgcn_s_sleep(8);
}
__global__ void __launch_bounds__(512, 2) mk_fwd(Args args) {
    extern __shared__ __attribute__((aligned(16))) unsigned char lds_raw[];
    Ctx C; C.lds = (LAS unsigned char*)lds_raw; C.tid = threadIdx.x; C.lane = C.tid & 63; C.wave = __builtin_amdgcn_readfirstlane(C.tid >> 6);
    C.G = gridDim.x; { const int bx = blockIdx.x; C.vcu = (C.G % 8 == 0) ? (bx % 8) * (C.G / 8) + bx / 8 : bx; }
    unsigned char* ws = args.ws;
    for (int u = C.tid; u < (LDS_BYTES - LDSCTL_OFF) / 4; u += 512) ((LAS unsigned*)(C.lds + LDSCTL_OFF))[u] = 0u;
    __syncthreads();
    XcdBarrier bar; bar.bar = (unsigned*)(ws + WS_CTL) + CW_BAR; bar.x = 0; bar.st = nullptr;
    if (N_LAUNCHES == 1) bar = xcd_barrier_post((unsigned*)(ws + WS_CTL) + CW_BAR, (volatile LAS unsigned*)(C.lds + MISC_OFF) + 8);
    const int lo = args.ph_lo, hi = args.ph_hi;
#ifndef PH_MASK
#define PH_MASK 0x3fff
#endif
#define IN(k) ((((PH_MASK) >> (k)) & 1) && lo <= (k) && (k) < hi)
#ifndef PROBE_REP
#define PROBE_REP -1
#endif
#define REP(k) for (int rep_ = 0; rep_ < ((PROBE_REP == (k)) ? 2 : 1); ++rep_)
#define REPBAR() do { if (rep_ > 0) xcd_barrier(bar); } while (0)
#define FRESH() do { int t_ = threadIdx.x; asm volatile("" : "+v"(t_)); C.tid = t_; C.lane = t_ & 63; C.wave = __builtin_amdgcn_readfirstlane(t_ >> 6); } while (0)
#define SEAM(k) do { if (IN(k) && IN((k) + 1)) xcd_barrier(bar); } while (0)
    const int cb = (int)blockIdx.x;

    if (IN(0)) REP(0) { REPBAR(); FRESH(); ph_prologue(args, C); SEAM(0); }
    if (PROBE_REP == 200) { for (int xb_ = 0; xb_ < 8; ++xb_) xcd_barrier(bar); }
    if (IN(1)) REP(1) { REPBAR();
        { Gemm g{(const bf16_t*)(ws + WS_B), (const bf16_t*)(ws + WS_WIN), DM, DM, DM}; PlainOrder S; S.init(NTOK, DIN, C.G, cb, DM, DM);
          EpiProj E{(bf16_t*)(ws + WS_A), (const float*)(ws + WS_ROPE), (float*)(ws + WS_KSUM)}; GEMM_PHASE(C.lds, g, S, E); }
        { Gemm g{(const bf16_t*)(ws + WS_MEMN), (const bf16_t*)(ws + WS_WXK), DM, DM, DM}; PlainOrder S; S.init(NMEM, DM, C.G, cb, DM, DM);
          EpiStore E{(bf16_t*)(ws + WS_KM), DM}; GEMM_PHASE(C.lds, g, S, E); }
        { Gemm g{(const bf16_t*)(ws + WS_MEMN), (const bf16_t*)(ws + WS_WXV), DM, DM, DM}; PlainOrder S; S.init(NMEM, DM, C.G, (cb + C.G - 64 % C.G) % C.G, DM, DM);
          EpiStore E{(bf16_t*)(ws + WS_VMT), DM}; GEMM_PHASE(C.lds, g, S, E); }
        { FRESH(); if (C.G == 256) { if (cb >= 128) conv_wdn(args, C, (cb - 128) * 8 + C.wave, 128 * 8, 0, WDN_SPLIT); }
          else conv_wdn(args, C, C.vcu * 8 + C.wave, C.G * 8, 0, WDN_SPLIT); }
        SEAM(1);
    }
    if (IN(2)) REP(2) { REPBAR(); FRESH();
        for (int lrep_ = 0; lrep_ < ((PROBE_REP == 102) ? 2 : 1); ++lrep_)
        for (int L = C.vcu; L < 256; L += C.G) lru_unit(args, C, L >> 4, (L >> 1) & 7, L & 1);
        for (int arep_ = 0; arep_ < ((PROBE_REP == 103) ? 2 : 1); ++arep_)
        for (int i = 0;; ++i) { const int aidx = i * C.G + C.vcu; if (aidx >= 1024) break; const int cc = aidx & 255, ii = aidx >> 8, bh = cc >> 1;
            const int qb = (cc & 1) ? ((ii == 0) ? 6 : (ii == 1) ? 1 : (ii == 2) ? 5 : 2) : ((ii == 0) ? 7 : (ii == 1) ? 0 : (ii == 2) ? 4 : 3);
#ifdef ATTN_SIMPLE
            moba_unit_simple(args, C, bh >> 3, bh & 7, qb); }
#else
            { const attn_body::bf16* Qp = (const attn_body::bf16*)(ws + WS_A) + (size_t)2 * NTOK * 512;
              attn_body::attn_unit<8>(bh >> 3, bh & 7, qb, Qp, Qp + (size_t)NTOK * 512, Qp + (size_t)2 * NTOK * 512, (attn_body::bf16*)(ws + WS_C) + 512, (const float*)(ws + WS_KSUM), (float*)(ws + WS_SSQA), (char*)lds_raw); } }
#endif
        SEAM(2);
    }
    if (IN(4)) REP(4) { REPBAR(); Gemm g{(const bf16_t*)(ws + WS_C), (const bf16_t*)(ws + WS_WOUT), DM, DM, DM}; PlainOrder S; S.init(NTOK, DM, C.G, cb, DM, DM);
        EpiResid<true, true> E{args.in[0], (bf16_t*)args.out, (float*)(ws + WS_SSQ1), (const float*)(ws + WS_SSQL), (const float*)(ws + WS_SSQA), ws + WS_B, 1.0f};     GEMM_PHASE(C.lds, g, S, E);
        { Gemm g2{(const bf16_t*)(ws + WS_KM), (const bf16_t*)(ws + WS_WXQ), DM, DM, XHD}; XpreOrder S2{C.G, cb, 0}; EpiStore8 E2{ws + WS_A, DM, QKT_SC}; GEMM_PHASE(C.lds, g2, S2, E2); }
        { Gemm g3{(const bf16_t*)(ws + WS_WXO), (const bf16_t*)(ws + WS_VMT), DM, DM, XHD}; XpreOrder S3{C.G, cb, 1}; EpiStore8 E3{ws + WS_A + 32 * MiB, DM, VWT_SC}; GEMM_PHASE(C.lds, g3, S3, E3); }
        SEAM(4); }
    if (IN(5)) REP(5) { REPBAR(); Gemm g{(const bf16_t*)(ws + WS_B), (const bf16_t*)(ws + WS_A), DM / 2, DM / 2, DM / 2}; XattnOrder S{C.G, cb, 0, DM / 2, DM / 2};
        EpiSoftmax E{ws + WS_B + 32 * MiB, DM, C.lds + LDSCTL_OFF + 4096, (const float*)(ws + WS_SSQ1), XSCALE / QKT_SC}; GEMM_PHASE8(C.lds, g, S, E); SEAM(5); }
    if (IN(8)) REP(8) { REPBAR(); Gemm g{(const bf16_t*)(ws + WS_B + 32 * MiB), (const bf16_t*)(ws + WS_A + 32 * MiB), DM / 2, DM / 2, DM / 2}; XattnOrder S{C.G, cb, 1, DM / 2, DM / 2};
        EpiResid<false, false> E{(const bf16_t*)args.out, (bf16_t*)args.out + DM, (float*)(ws + WS_SSQ2), nullptr, nullptr, ws + WS_H2F8, 1.0f / (PX_SC * VWT_SC)}; GEMM_PHASE8(C.lds, g, S, E); SEAM(8); }
    if (IN(9)) REP(9) { REPBAR(); FRESH(); ph_router(args, C); SEAM(9); }
    if (IN(11)) REP(11) { REPBAR(); FRESH(); moe_table(args, C); Gemm g{(const bf16_t*)(ws + WS_H2F8), (const bf16_t*)(ws + WS_WGU), DM / 2, DM / 2, DM / 2};
        MoeOrder<true> S{(const LAS int*)(C.lds + MOE_OFF), C.G, cb, DM / 2, DM / 2, (const int*)(ws + WS_LTOK), (unsigned)DM};
        EpiGateUp E{ws + WS_B, (const float*)(ws + WS_LRS)}; GEMM_PHASE8(C.lds, g, S, E); SEAM(11); }
    if (IN(12)) REP(12) { REPBAR(); FRESH(); moe_table(args, C); Gemm g{(const bf16_t*)(ws + WS_B), (const bf16_t*)(ws + WS_WDN), DFF / 2, DFF / 2, DFF / 2};
        MoeOrder<false> S{(const LAS int*)(C.lds + MOE_OFF), C.G, cb, DFF / 2, DFF / 2, nullptr, 0u};
        if (PROBE_REP == 312) { EpiNull EN{}; GEMM_PHASE8(C.lds, g, S, EN); xcd_barrier(bar); }
        EpiStore8 E{ws + WS_A, DM, YB_SC / (WDN_SC * ACT_SC)}; GEMM_PHASE8(C.lds, g, S, E); SEAM(12); }
    if (IN(13)) REP(13) { REPBAR(); FRESH(); moe_table(args, C); ph_final(args, C, (PROBE_REP == 13 && rep_ == 0) ? (float*)(ws + WS_B) : args.out); }
#undef IN
#undef FRESH
#undef SEAM
}

extern "C" void kernel_launch(void* const* d_in, const int* in_sizes, int n_in, void* d_out, int out_size, void* d_ws, size_t ws_size, hipStream_t stream) {
    static int grid = 0;
    if (grid == 0) {
        if (n_in != 27 || out_size != NTOK * DM || ws_size < WS_END) { fprintf(stderr, "kernel_launch: unexpected shapes (n_in %d out %d ws %zu)\n", n_in, out_size, ws_size); grid = -1; return; }
        int dev = 0, cus = 0, per_cu = 0;
        if (hipGetDevice(&dev) != hipSuccess || hipDeviceGetAttribute(&cus, hipDeviceAttributeMultiprocessorCount, dev) != hipSuccess) { grid = -1; return; }
        if (hipFuncSetAttribute((const void*)mk_fwd, hipFuncAttributeMaxDynamicSharedMemorySize, LDS_BYTES) != hipSuccess) { fprintf(stderr, "kernel_launch: hipFuncSetAttribute failed\n"); grid = -1; return; }
        if (hipOccupancyMaxActiveBlocksPerMultiprocessor(&per_cu, (const void*)mk_fwd, 512, LDS_BYTES) != hipSuccess || per_cu < 1) fprintf(stderr, "kernel_launch: occupancy query reports %d\n", per_cu);
        (void)hipGetLastError();
        grid = cus;
    }
    if (grid < 0) return;
    (void)hipMemsetAsync((char*)d_ws + WS_CTL, 0, CTL_ZERO_BYTES, stream);
    Args a{};
    for (int i = 0; i < 27; ++i) a.in[i] = (const float*)d_in[i];
    a.out = (float*)d_out; a.ws = (unsigned char*)d_ws;
    const float invf[8] = {1.0f, 0.1939227432012558f, 0.03760603070259094f, 0.007292664609849453f, 0.0014142135623842478f, 0.00027424818836152554f, 5.318296098266728e-05f, 1.0313386155758053e-05f};
    for (int i = 0; i < 8; ++i) a.invf[i] = invf[i];
    if (N_LAUNCHES == 1) { a.ph_lo = 0; a.ph_hi = N_PHASES; hipLaunchKernelGGL(mk_fwd, dim3(grid), dim3(512), LDS_BYTES, stream, a); }
    else for (int p = 0; p < N_PHASES; ++p) { a.ph_lo = p; a.ph_hi = p + 1; hipLaunchKernelGGL(mk_fwd, dim3(grid), dim3(512), LDS_BYTES, stream, a); }
}
```

```cpp
#include <hip/hip_runtime.h>
#include <cstdio>
#include <cstdint>

#define LAS __attribute__((address_space(3)))
#define GAS __attribute__((address_space(1)))
typedef unsigned short bf16_t;
typedef short bf16x8 __attribute__((ext_vector_type(8)));
typedef float f32x4 __attribute__((ext_vector_type(4)));
typedef float f32x2 __attribute__((ext_vector_type(2)));
typedef unsigned u32x4 __attribute__((ext_vector_type(4)));
typedef unsigned u32x2 __attribute__((ext_vector_type(2)));

#ifndef MK_N_LAUNCHES
#define MK_N_LAUNCHES 1
#endif
constexpr int N_PHASES = 14;
constexpr int N_LAUNCHES = MK_N_LAUNCHES;

constexpr int BATCH = 16, SEQ = 2048, DM = 1024, NTOK = BATCH * SEQ;
constexpr int DLRU = 512, DATT = 512, DIN = 2560, NHEAD = 8, HD = 64, NBLK = 8, MBLK = 256;
constexpr int MEMLEN = 256, NXH = 4, XHD = 256, NMEM = BATCH * MEMLEN;
constexpr int NEXP = 32, EPG = 8, NGRP = 4, DFF = 512;
constexpr float EPS = 1e-6f;
constexpr float QKT_SC = 8.0f, VWT_SC = 8.0f, PX_SC = 256.0f;
constexpr float WGU_SC = 64.0f, WDN_SC = 32.0f, ACT_SC = 16.0f, YB_SC = 16.0f;
constexpr int WDN_SPLIT = 3072;
constexpr int MAXTILES = 288, LCAP = 65536, LDH = 2048;
constexpr float QSCALE = 0.125f * 1.4426950408889634f;
constexpr float XSCALE = 0.0625f * 1.4426950408889634f;

constexpr size_t MiB = 1u << 20;
constexpr size_t WS_CTL = 0, CTL_ZERO_BYTES = 1 * MiB;
constexpr int CW_TMO = 0, CW_BAR = 4096, CW_CNT = 8192;
constexpr size_t WS_KSUM = 512 * 1024;
constexpr size_t WS_WIN = 2 * MiB, WS_WXK = 7 * MiB, WS_WXV = 9 * MiB, WS_WOUT = 11 * MiB, WS_WXQ = 13 * MiB, WS_WXO = 15 * MiB;
constexpr size_t WS_WR = 17 * MiB, WS_ROPE = 18 * MiB, WS_SSQ1 = 19 * MiB, WS_SSQ2 = 21 * MiB, WS_TOK = 23 * MiB, WS_RSC = 24 * MiB;
constexpr size_t WS_MEMN = 25 * MiB, WS_KM = 33 * MiB, WS_VMT = 41 * MiB, WS_WGU = 49 * MiB, WS_WDN = 113 * MiB;
constexpr size_t WS_A = 145 * MiB, WS_B = 305 * MiB, WS_C = 385 * MiB, WS_SSQL = 449 * MiB, WS_SSQA = 451 * MiB, WS_LTOK = 452 * MiB, WS_LRS = 460 * MiB, WS_H2F8 = 468 * MiB, WS_END = 500 * MiB;
constexpr size_t TOK_E = 0, TOK_R = 256 * 1024, TOK_G = 512 * 1024, TOK_D = 768 * 1024;

constexpr int RING_BYTES = 131072;
constexpr int LDSCTL_OFF = RING_BYTES, MISC_OFF = LDSCTL_OFF + 320, MOE_OFF = LDSCTL_OFF + 1024;
constexpr int LDS_BYTES = 147456;

__device__ __forceinline__ unsigned cvt_pk_bf16(float lo, float hi) { unsigned r; asm volatile("v_cvt_pk_bf16_f32 %0, %1, %2" : "=v"(r) : "v"(lo), "v"(hi)); return r; }
__device__ __forceinline__ float bflo(unsigned w) { return __uint_as_float(w << 16); }
__device__ __forceinline__ float bfhi(unsigned w) { return __uint_as_float(w & 0xffff0000u); }
__device__ __forceinline__ float bf2f(bf16_t b) { return __uint_as_float((unsigned)b << 16); }
__device__ __forceinline__ float wave_sum(float v) {
#pragma unroll
    for (int o = 1; o < 64; o <<= 1) v += __shfl_xor(v, o);
    return v;
}
#define LDS_WAIT() asm volatile("s_waitcnt lgkmcnt(0)" ::: "memory")
__device__ __forceinline__ float sigmoidf_(float x) { return __builtin_amdgcn_rcpf(1.0f + __builtin_amdgcn_exp2f(x * -1.4426950408889634f)); }

#define XB_TMO      128
#define XB_XCNT(j)  (256  + 64 * (j))
#define XB_XSUB(j)  (1280 + 64 * (j))
#define XB_XGEN(j)  (2304 + 64 * (j))
#define XB_TOP      3328
#define XB_TOPGEN   3392
#define XCD_BAR_WORDS 3456
#define XB_SPIN_CAP (1u << 18)
__device__ __forceinline__ unsigned xb_ld(unsigned* p)              { return __hip_atomic_load(p, __ATOMIC_RELAXED, __HIP_MEMORY_SCOPE_AGENT); }
__device__ __forceinline__ unsigned xb_add(unsigned* p, unsigned v) { return __hip_atomic_fetch_add(p, v, __ATOMIC_RELAXED, __HIP_MEMORY_SCOPE_AGENT); }
__device__ __forceinline__ unsigned xb_xcc_id() { return (unsigned)__builtin_amdgcn_s_getreg((3 << 11) | 20) & 0xFu; }
#define XB_SPIN(cond, bar) do { unsigned _sp = 0; while (cond) { __builtin_amdgcn_s_sleep(1); \
    if ((++_sp & 255u) == 0u) { if (xb_ld(&(bar)[XB_TMO])) break; if (_sp > XB_SPIN_CAP) { atomicAdd(&(bar)[XB_TMO], 1u); break; } } } } while (0)
struct XcdBarrier { unsigned* bar; unsigned x; volatile LAS unsigned* st; };
__device__ __forceinline__ XcdBarrier xcd_barrier_post(unsigned* bar, volatile LAS unsigned* st) {
    XcdBarrier b; b.bar = bar; b.x = xb_xcc_id(); b.st = st;
    if (threadIdx.x == 0) (void)xb_add(&bar[XB_XCNT(b.x)], 1u);
    return b;
}
__device__ __forceinline__ void xcd_barrier_complete(unsigned* bar, unsigned x, unsigned& nloc, unsigned& nx) {
    const unsigned G = gridDim.x * gridDim.y * gridDim.z;
    unsigned sum, cnt, mine, sp = 0u;
    for (;;) {
        sum = 0u; cnt = 0u; mine = 0u;
#pragma unroll
        for (unsigned j = 0; j < 16; ++j) { const unsigned c = xb_ld(&bar[XB_XCNT(j)]); sum += c; cnt += (c > 0u) ? 1u : 0u; mine = (j == x) ? c : mine; }
        if (sum == G) break;
        __builtin_amdgcn_s_sleep(1);
        if ((++sp & 255u) == 0u) { if (xb_ld(&bar[XB_TMO])) break; if (sp > XB_SPIN_CAP) { atomicAdd(&bar[XB_TMO], 1u); break; } }
    }
    nloc = mine > 0u ? mine : 1u; nx = cnt > 0u ? cnt : 1u;
}
__device__ __forceinline__ void xcd_barrier(const XcdBarrier& b) {
    asm volatile("s_waitcnt vmcnt(0)" ::: "memory");
    __syncthreads();
    if (threadIdx.x == 0) {
        unsigned* bar = b.bar;
        __builtin_amdgcn_s_waitcnt(0);
        unsigned nloc = b.st[0], nx = b.st[1];
        if (nloc == 0u) { xcd_barrier_complete(bar, b.x, nloc, nx); b.st[0] = nloc; b.st[1] = nx; }
        const unsigned old = xb_add(&bar[XB_XSUB(b.x)], 1u);
        const unsigned gen = old / nloc;
        if (old + 1u == (gen + 1u) * nloc) {
            __builtin_amdgcn_fence(__ATOMIC_RELEASE, "agent");
            asm volatile("s_waitcnt vmcnt(0)" ::: "memory");
            const unsigned og = xb_add(&bar[XB_TOP], 1u);
            const unsigned tg = og / nx;
            if (og + 1u == (tg + 1u) * nx) xb_add(&bar[XB_TOPGEN], 1u);
            else XB_SPIN(xb_ld(&bar[XB_TOPGEN]) == tg, bar);
            __builtin_amdgcn_fence(__ATOMIC_ACQUIRE, "agent");
            xb_add(&bar[XB_XGEN(b.x)], 1u);
            asm volatile("s_waitcnt vmcnt(0)" ::: "memory");
        } else {
            XB_SPIN(xb_ld(&bar[XB_XGEN(b.x)]) == gen, bar);
            __builtin_amdgcn_fence(__ATOMIC_ACQUIRE, "agent");
            asm volatile("s_waitcnt vmcnt(0)" ::: "memory");
        }
    }
    __syncthreads();
}

struct Unit { int pm, pn; size_t a_off, b_off; int lbase, nvalid; };
struct Gemm { const bf16_t* A; const bf16_t* Bt; int lda, ldb, K; };
__host__ __device__ __forceinline__ int perm32(int rho) { const int n = rho >> 4, i = rho & 15; return 8 * (i >> 2) + 4 * n + (i & 3); }

struct PlainOrder {     static constexpr bool GATHER = false;
    int nM, nN, nwg, G, c, lda, ldb;
    __device__ void init(int M, int N, int G_, int c_, int lda_, int ldb_) { nM = M / 256; nN = N / 256; nwg = nM * nN; G = G_; c = c_; lda = lda_; ldb = ldb_; }
    __device__ bool next(int i, Unit& u) const {
        const long L = (long)i * G + c; if (L >= nwg) return false;
        int wgid = (int)L; { const int q = nwg / 8, r = nwg % 8, xcd = wgid % 8, off = wgid / 8; wgid = (xcd < r ? xcd * (q + 1) : r * (q + 1) + (xcd - r) * q) + off; }
        const int nig = 8 * nN, gid = wgid / nig, fm = gid * 8, gsz = (nM - fm) < 8 ? (nM - fm) : 8;
        u.pm = fm + ((wgid % nig) % gsz); u.pn = (wgid % nig) / gsz;
        u.a_off = (size_t)u.pm * 256 * lda; u.b_off = (size_t)u.pn * 256 * ldb; return true;
    }
};
struct XpreOrder {
    static constexpr bool GATHER = false;
    int G, c, mode;
    __device__ bool next(int i, Unit& u) const {
        const int L = i * G + c; if (L >= 256) return false;
        const int b = L >> 4, x = (L >> 2) & 3, y = L & 3;
        if (mode == 0) { const int h = x, kt = y; u.pm = b * 4 + h; u.pn = kt; u.a_off = (size_t)b * MEMLEN * DM + h * XHD; u.b_off = (size_t)kt * 256 * DM + h * XHD; }
        else { const int nt = x, h = y; u.pm = b * 4 + nt; u.pn = h; u.a_off = (size_t)nt * 256 * DM + h * XHD; u.b_off = (size_t)b * MEMLEN * DM + h * XHD; }
        return true;
    }
};
struct XattnOrder {
    static constexpr bool GATHER = false;
    int G, c, mode, lda, ldb;
    __device__ bool next(int i, Unit& u) const {
        int L = i * G + c; if (L >= (NTOK / 256) * 4) return false;
        if (G == 256) { const int x = c & 7, idx = c >> 3; L = ((x + 8 * i) * 8 + (idx >> 2)) * 4 + (idx & 3); }
        u.pm = L >> 2; u.pn = L & 3; const int b = u.pm >> 3;
        u.a_off = (size_t)u.pm * 256 * lda;
        u.b_off = mode == 0 ? (size_t)(b * 4 + u.pn) * 256 * ldb : (size_t)(b * 1024 + u.pn * 256) * ldb;
        return true;
    }
};
template <bool GATH_> struct MoeOrder {
    static constexpr bool GATHER = GATH_;
    const LAS int* ts; int G, c, lda, ldb; const int* ltok; unsigned rowbytes;
    __device__ bool next(int i, Unit& u) const {
        const int L = i * G + c; if (L >= ts[NEXP] * 4) return false;
        const int T = L >> 2, j = L & 3; int e = 0; while (ts[e + 1] <= T) ++e;
        const int lt = T - ts[e];
        u.pm = T; u.pn = j; u.a_off = GATH_ ? (size_t)0 : (size_t)T * 256 * lda; u.b_off = ((size_t)e * 1024 + j * 256) * ldb;
        u.lbase = e * LCAP + lt * 256; u.nvalid = ts[33 + e] - lt * 256; return true;
    }
    __device__ __forceinline__ unsigned rowoff(const Unit& u, int r) const { return (r < u.nvalid) ? (unsigned)ltok[u.lbase + r] * rowbytes : 0u; }
};

template <class Epi, class Sched>
__device__ __forceinline__ void gemm_phase_simple(LAS unsigned char* lds, const Gemm g, const Sched& S, const Epi& E) {
    int tid = threadIdx.x; asm volatile("" : "+v"(tid));
    const int wid = __builtin_amdgcn_readfirstlane(tid >> 6), lane = tid & 63, wr = wid >> 2, wc = wid & 3, fr = lane & 15, fq = lane >> 4;
    Unit u;
    for (int i = 0; S.next(i, u); ++i) {
        f32x4 acc[2][2][4][2];
#pragma unroll
        for (int a = 0; a < 2; ++a)
#pragma unroll
            for (int b = 0; b < 2; ++b)
#pragma unroll
                for (int m = 0; m < 4; ++m)
#pragma unroll
                    for (int n = 0; n < 2; ++n) acc[a][b][m][n] = (f32x4){0.f, 0.f, 0.f, 0.f};
        const char* Ab = (const char*)(g.A + u.a_off); const char* Bb = (const char*)(g.Bt + u.b_off);
        const int c0 = Epi::PERM ? perm32(fr) : fr, c1 = Epi::PERM ? perm32(16 + fr) : 16 + fr;
        unsigned ao[2][4], bo[2][2];
#pragma unroll
        for (int ai = 0; ai < 2; ++ai)
#pragma unroll
            for (int m = 0; m < 4; ++m) ao[ai][m] = (unsigned)((128 * ai + 64 * wr + 16 * m + fr) * g.lda + 8 * fq) * 2u;
#pragma unroll
        for (int bj = 0; bj < 2; ++bj) { bo[bj][0] = (unsigned)((128 * bj + 32 * wc + c0) * g.ldb + 8 * fq) * 2u; bo[bj][1] = (unsigned)((128 * bj + 32 * wc + c1) * g.ldb + 8 * fq) * 2u; }
#pragma unroll 1
        for (int k0 = 0; k0 < g.K; k0 += 32) {
            if constexpr (Epi::MIDK) { if (k0 == (g.K >> 1)) E.midk(acc, u, wr, wc, fr, fq); }
            const char* Ak = Ab + (size_t)k0 * 2; const char* Bk = Bb + (size_t)k0 * 2;
            bf16x8 bfr[2][2];
#pragma unroll
            for (int bj = 0; bj < 2; ++bj) { bfr[bj][0] = *(const bf16x8*)(Bk + bo[bj][0]); bfr[bj][1] = *(const bf16x8*)(Bk + bo[bj][1]); }
#pragma unroll
            for (int ai = 0; ai < 2; ++ai) {
                bf16x8 af[4];
#pragma unroll
                for (int m = 0; m < 4; ++m) af[m] = *(const bf16x8*)(Ak + ao[ai][m]);
#pragma unroll
                for (int bj = 0; bj < 2; ++bj)
#pragma unroll
                    for (int m = 0; m < 4; ++m)
#pragma unroll
                        for (int n = 0; n < 2; ++n) acc[ai][bj][m][n] = __builtin_amdgcn_mfma_f32_16x16x32_bf16(bfr[bj][n], af[m], acc[ai][bj][m][n], 0, 0, 0);
            }
        }
        E(acc, u, wr, wc, fr, fq);
    }
}

typedef int v8i __attribute__((ext_vector_type(8)));
typedef int v4i __attribute__((ext_vector_type(4)));
__device__ __forceinline__ v8i cat8(bf16x8 lo, bf16x8 hi) { const v4i a = __builtin_bit_cast(v4i, lo), b = __builtin_bit_cast(v4i, hi); return __builtin_shufflevector(a, b, 0, 1, 2, 3, 4, 5, 6, 7); }
template <int H> __device__ __forceinline__ bf16x8 half8(v8i v) { const v4i h = H ? __builtin_shufflevector(v, v, 4, 5, 6, 7) : __builtin_shufflevector(v, v, 0, 1, 2, 3); return __builtin_bit_cast(bf16x8, h); }
__device__ __forceinline__ unsigned pk4_fp8(float a, float b, float c, float d) { int w = __builtin_amdgcn_cvt_pk_fp8_f32(a, b, 0, false); w = __builtin_amdgcn_cvt_pk_fp8_f32(c, d, w, true); return (unsigned)w; }
__host__ __device__ __forceinline__ int lds_byte(int r, int c) { const int st = (r >> 4) * 2 + (c >> 5), rr = r & 15, cc = c & 31, ob = rr * 64 + cc * 2; return st * 1024 + (ob ^ (((ob >> 9) & 1) << 5)); }
__host__ __device__ __forceinline__ void stage_rc(int b, int& R, int& C) { const int st = b / 1024, sb = b % 1024, swz = sb ^ (((sb >> 9) & 1) << 5); R = (st >> 1) * 16 + swz / 64; C = (st & 1) * 32 + (swz % 64) / 2; }
template <class Epi, class Sched, bool ALIGN_EPI = false, bool SP2 = false, bool F8 = false>
__device__ __forceinline__ void gemm_phase(LAS unsigned char* lds, const Gemm g, const Sched& S, const Epi& E) {
    constexpr int BK = 64, HALF = 128, HTB = HALF * BK * 2;
    int tid = threadIdx.x; asm volatile("" : "+v"(tid));
    const int wid = __builtin_amdgcn_readfirstlane(tid >> 6), lane = tid & 63, wr = wid >> 2, wc = wid & 3, fr = lane & 15, fq = lane >> 4;
    const int K = g.K, nt = K / BK;
    unsigned voffA[2], voffB[2];
#pragma unroll
    for (int i = 0; i < 2; ++i) { int R, C; stage_rc(tid * 16 + i * 8192, R, C); const int Rb = Epi::PERM ? ((R & ~31) + perm32(R & 31)) : R;
        voffA[i] = (unsigned)(R * g.lda + C) * 2u; voffB[i] = (unsigned)(Rb * g.ldb + C) * 2u; }
    constexpr bool GATH = Sched::GATHER;
    unsigned vcu[2][2] = {{0u, 0u}, {0u, 0u}}, vnx[2][2] = {{0u, 0u}, {0u, 0u}}; int gR[2] = {0, 0}; unsigned gC[2] = {0u, 0u};
    if constexpr (GATH) {
#pragma unroll
        for (int i = 0; i < 2; ++i) { int R, Cq; stage_rc(tid * 16 + i * 8192, R, Cq); gR[i] = R; gC[i] = (unsigned)Cq * 2u; } }
    const size_t kstep = (size_t)(BK * 2);
    const size_t hstepA = (size_t)HALF * g.lda * 2, hstepB = (size_t)HALF * g.ldb * 2;
    const unsigned ldsw = (unsigned)wid * 1024u;
    const int aoff = lds_byte(wr * 64 + fr, F8 ? fq * 16 : fq * 8), boff = lds_byte(wc * 32 + fr, F8 ? fq * 16 : fq * 8);
    const int aoff1 = lds_byte(wr * 64 + fr, F8 ? fq * 16 + 8 : fq * 8 + 32) - aoff, boff1 = lds_byte(wc * 32 + fr, F8 ? fq * 16 + 8 : fq * 8 + 32) - boff;
#define PG8_SA(b, h) (((b) * 2 + (h)) * HTB)
#define PG8_SB(b, h) ((4 + (b) * 2 + (h)) * HTB)
#define PG8_STAGE(bufoff, gbase, voff) do { _Pragma("unroll") for (int _i = 0; _i < 2; ++_i) \
        __builtin_amdgcn_global_load_lds((const unsigned*)((const char*)(gbase) + (voff)[_i]), (LAS unsigned*)(lds + (bufoff) + ldsw + _i * 8192), 16, 0, 0); } while (0)
#define PG8_STA(bufoff, ptr, h, nx) do { if constexpr (GATH) { const unsigned vsel_[2] = {(nx) ? vnx[h][0] : vcu[h][0], (nx) ? vnx[h][1] : vcu[h][1]}; PG8_STAGE(bufoff, ptr, vsel_); } \
        else { PG8_STAGE(bufoff, (ptr) + (h) * hstepA, voffA); } } while (0)
#define PG8_LDA(dst, b, h) do { _Pragma("unroll") for (int m = 0; m < 4; ++m) dst[m] = cat8(*(const LAS bf16x8*)(lds + PG8_SA(b, h) + aoff + m * 2048), *(const LAS bf16x8*)(lds + PG8_SA(b, h) + aoff + m * 2048 + aoff1)); } while (0)
#define PG8_LDB(dst, b, h) do { _Pragma("unroll") for (int n = 0; n < 2; ++n) dst[n] = cat8(*(const LAS bf16x8*)(lds + PG8_SB(b, h) + boff + n * 2048), *(const LAS bf16x8*)(lds + PG8_SB(b, h) + boff + n * 2048 + boff1)); } while (0)
#define PG8_MMA(ai, bj, At, Bt) do { __builtin_amdgcn_s_setprio(1); \
        if constexpr (F8) { _Pragma("unroll") for (int m = 0; m < 4; ++m) _Pragma("unroll") for (int n = 0; n < 2; ++n) \
            asm volatile("s_nop 1\n\tv_mfma_scale_f32_16x16x128_f8f6f4 %0, %1, %2, %0, %3, %3 op_sel_hi:[0,0,0]" : "+v"(acc[ai][bj][m][n]) : "v"(Bt[n]), "v"(At[m]), "v"(sc127)); } \
        else { _Pragma("unroll") for (int m = 0; m < 4; ++m) _Pragma("unroll") for (int n = 0; n < 2; ++n) { \
            acc[ai][bj][m][n] = __builtin_amdgcn_mfma_f32_16x16x32_bf16(half8<0>(Bt[n]), half8<0>(At[m]), acc[ai][bj][m][n], 0, 0, 0); \
            acc[ai][bj][m][n] = __builtin_amdgcn_mfma_f32_16x16x32_bf16(half8<1>(Bt[n]), half8<1>(At[m]), acc[ai][bj][m][n], 0, 0, 0); } } \
        __builtin_amdgcn_s_setprio(0); } while (0)
#define PG8_WAIT_V(n) asm volatile("s_waitcnt vmcnt(" #n ")" ::: "memory")
#define PG8_WAIT_L(n) asm volatile("s_waitcnt lgkmcnt(" #n ")" ::: "memory")
#define PG8_BAR __builtin_amdgcn_s_barrier()
#define PG8_SCHED __builtin_amdgcn_sched_barrier(0)
    Unit cur, nxt; int ui = 0;
    if (!S.next(0, cur)) return;
    f32x4 acc[2][2][4][2];
#pragma unroll
    for (int a = 0; a < 2; ++a)
#pragma unroll
        for (int b = 0; b < 2; ++b)
#pragma unroll
            for (int m = 0; m < 4; ++m)
#pragma unroll
                for (int n = 0; n < 2; ++n) acc[a][b][m][n] = (f32x4){0.f, 0.f, 0.f, 0.f};
    int sc127 = 127; asm volatile("" : "+v"(sc127));
    v8i At[4], B0[2], B1[2];
    const char* cA = (const char*)(g.A + cur.a_off); const char* cB = (const char*)(g.Bt + cur.b_off);
    if constexpr (GATH) {
#pragma unroll
        for (int h = 0; h < 2; ++h)
#pragma unroll
            for (int i = 0; i < 2; ++i) vcu[h][i] = S.rowoff(cur, h * HALF + gR[i]) + gC[i]; }
    if constexpr (SP2) {
        PG8_STAGE(PG8_SB(0, 0), cB, voffB); PG8_STAGE(PG8_SB(0, 1), cB + hstepB, voffB); PG8_STA(PG8_SA(0, 0), cA, 0, false); PG8_STA(PG8_SA(0, 1), cA, 1, false);
        if (wr == 1) PG8_BAR;
        PG8_WAIT_V(2); PG8_BAR;
        PG8_STAGE(PG8_SB(1, 0), cB + kstep, voffB); PG8_STA(PG8_SA(1, 0), cA + kstep, 0, false); PG8_STAGE(PG8_SB(1, 1), cB + hstepB + kstep, voffB);
        PG8_WAIT_V(6); PG8_BAR;
    } else {
        PG8_STAGE(PG8_SB(0, 0), cB, voffB); PG8_STA(PG8_SA(0, 0), cA, 0, false); PG8_STAGE(PG8_SB(0, 1), cB + hstepB, voffB); PG8_STA(PG8_SA(0, 1), cA, 1, false);
        if (wr == 1) PG8_BAR;
        PG8_WAIT_V(4); PG8_BAR;
        PG8_STAGE(PG8_SB(1, 0), cB + kstep, voffB); PG8_STA(PG8_SA(1, 0), cA + kstep, 0, false); PG8_STAGE(PG8_SB(1, 1), cB + hstepB + kstep, voffB);
        PG8_WAIT_V(6); PG8_BAR;
    }
    for (;;) {
        const bool has_next = S.next(ui + 1, nxt);
        const char* nA = has_next ? (const char*)(g.A + nxt.a_off) : cA; const char* nB = has_next ? (const char*)(g.Bt + nxt.b_off) : cB;
        if constexpr (GATH) {
#pragma unroll
            for (int h = 0; h < 2; ++h)
#pragma unroll
                for (int i = 0; i < 2; ++i) vnx[h][i] = has_next ? (S.rowoff(nxt, h * HALF + gR[i]) + gC[i]) : vcu[h][i]; }
#pragma unroll 1
        for (int t = 0; t < nt; t += 2) {
            if constexpr (Epi::MIDK) { if (t == (nt >> 1)) E.midk(acc, cur, wr, wc, fr, fq); }
            const bool last = (t == nt - 2);
            const char* a1 = cA + (size_t)(t + 1) * kstep;
            const char* a2 = last ? nA : cA + (size_t)(t + 2) * kstep; const char* b2 = last ? nB : cB + (size_t)(t + 2) * kstep;
            const char* a3 = a2 + kstep; const char* b3 = b2 + kstep;
            if constexpr (SP2) {
            PG8_LDB(B0, 0, 0); PG8_LDB(B1, 0, 1); PG8_SCHED; PG8_LDA(At, 0, 0); PG8_STA(PG8_SA(1, 1), a1, 1, false);
            PG8_WAIT_V(8); PG8_WAIT_L(0); PG8_BAR; PG8_MMA(0, 0, At, B0); PG8_MMA(0, 1, At, B1); PG8_BAR; PG8_SCHED;
            PG8_LDA(At, 0, 1); PG8_STAGE(PG8_SB(0, 0), b2, voffB); PG8_STAGE(PG8_SB(0, 1), b2 + hstepB, voffB); PG8_STA(PG8_SA(0, 0), a2, 0, last);
            PG8_WAIT_V(8); PG8_WAIT_L(0); PG8_BAR; PG8_MMA(1, 0, At, B0); PG8_MMA(1, 1, At, B1); PG8_BAR; PG8_SCHED;
            PG8_LDB(B0, 1, 0); PG8_LDB(B1, 1, 1); PG8_SCHED; PG8_LDA(At, 1, 0); PG8_STA(PG8_SA(0, 1), a2, 1, last);
            PG8_WAIT_V(8); PG8_WAIT_L(0); PG8_BAR; PG8_MMA(0, 0, At, B0); PG8_MMA(0, 1, At, B1); PG8_BAR; PG8_SCHED;
            PG8_LDA(At, 1, 1); PG8_STAGE(PG8_SB(1, 0), b3, voffB); PG8_STAGE(PG8_SB(1, 1), b3 + hstepB, voffB); PG8_STA(PG8_SA(1, 0), a3, 0, last);
            PG8_WAIT_V(8); PG8_WAIT_L(0); PG8_BAR; PG8_MMA(1, 0, At, B0); PG8_MMA(1, 1, At, B1); PG8_BAR; PG8_SCHED;
            } else {
            PG8_LDB(B0, 0, 0); PG8_SCHED; PG8_LDA(At, 0, 0); PG8_STA(PG8_SA(1, 1), a1, 1, false);
            PG8_WAIT_L(8); PG8_BAR; PG8_WAIT_L(0); PG8_MMA(0, 0, At, B0); PG8_BAR; PG8_SCHED;
            PG8_LDB(B1, 0, 1); PG8_STAGE(PG8_SB(0, 0), b2, voffB);
            PG8_BAR; PG8_WAIT_L(0); PG8_MMA(0, 1, At, B1); PG8_BAR;
            PG8_LDA(At, 0, 1); PG8_STA(PG8_SA(0, 0), a2, 0, last);
            PG8_BAR; PG8_WAIT_L(0); PG8_MMA(1, 0, At, B0); PG8_BAR; PG8_SCHED;
            PG8_STAGE(PG8_SB(0, 1), b2 + hstepB, voffB);
            PG8_WAIT_V(6); PG8_BAR; PG8_MMA(1, 1, At, B1); PG8_BAR;
            PG8_LDB(B0, 1, 0); PG8_SCHED; PG8_LDA(At, 1, 0); PG8_STA(PG8_SA(0, 1), a2, 1, last);
            PG8_WAIT_L(8); PG8_BAR; PG8_WAIT_L(0); PG8_MMA(0, 0, At, B0); PG8_BAR; PG8_SCHED;
            PG8_LDB(B1, 1, 1); PG8_STAGE(PG8_SB(1, 0), b3, voffB);
            PG8_BAR; PG8_WAIT_L(0); PG8_MMA(0, 1, At, B1); PG8_BAR;
            PG8_LDA(At, 1, 1); PG8_STA(PG8_SA(1, 0), a3, 0, last);
            PG8_BAR; PG8_WAIT_L(0); PG8_MMA(1, 0, At, B0); PG8_BAR; PG8_SCHED;
            PG8_STAGE(PG8_SB(1, 1), b3 + hstepB, voffB);
            PG8_WAIT_V(6); PG8_BAR; PG8_MMA(1, 1, At, B1); PG8_BAR;
            }
        }
        if constexpr (ALIGN_EPI) { if (wr == 0) PG8_BAR; }
        if constexpr (F8) {
#pragma unroll
            for (int a = 0; a < 2; ++a)
#pragma unroll
                for (int b = 0; b < 2; ++b)
                    asm volatile("s_nop 15\n\ts_nop 7" : "+v"(acc[a][b][0][0]), "+v"(acc[a][b][0][1]), "+v"(acc[a][b][1][0]), "+v"(acc[a][b][1][1]), "+v"(acc[a][b][2][0]), "+v"(acc[a][b][2][1]), "+v"(acc[a][b][3][0]), "+v"(acc[a][b][3][1]));
        }
        E(acc, cur, wr, wc, fr, fq);
        if (!has_next) break;
#pragma unroll
        for (int a = 0; a < 2; ++a)
#pragma unroll
            for (int b = 0; b < 2; ++b)
#pragma unroll
                for (int m = 0; m < 4; ++m)
#pragma unroll
                    for (int n = 0; n < 2; ++n) acc[a][b][m][n] = (f32x4){0.f, 0.f, 0.f, 0.f};
        cur = nxt; cA = nA; cB = nB; ++ui;
        if constexpr (GATH) {
#pragma unroll
            for (int h = 0; h < 2; ++h)
#pragma unroll
                for (int i = 0; i < 2; ++i) vcu[h][i] = vnx[h][i]; }
        if constexpr (ALIGN_EPI) { if (wr == 1) PG8_BAR; }
    }
    PG8_WAIT_V(0);
    if constexpr (!ALIGN_EPI) { if (wr == 0) PG8_BAR; }
    PG8_BAR;
#undef PG8_SA
#undef PG8_SB
#undef PG8_STAGE
#undef PG8_STA
#undef PG8_LDA
#undef PG8_LDB
#undef PG8_MMA
#undef PG8_WAIT_V
#undef PG8_WAIT_L
#undef PG8_BAR
#undef PG8_SCHED
}
#ifdef GEMM_SIMPLE
#define GEMM_PHASE(lds, g, S, E) gemm_phase_simple(lds, g, S, E)
#else
#define GEMM_PHASE(lds, g, S, E) gemm_phase<decltype(E), decltype(S), true, true>(lds, g, S, E)
#endif
#define GEMM_PHASE8(lds, g, S, E) gemm_phase<decltype(E), decltype(S), true, true, true>(lds, g, S, E)

__device__ __forceinline__ float rstd_from_ssq(const float* ssq, int row) {
    const f32x4* p = (const f32x4*)(ssq + (size_t)row * 16); const f32x4 a = p[0], b = p[1], c = p[2], d = p[3];
    const float s = ((a[0] + a[1]) + (a[2] + a[3])) + ((b[0] + b[1]) + (b[2] + b[3])) + ((c[0] + c[1]) + (c[2] + c[3])) + ((d[0] + d[1]) + (d[2] + d[3]));
    return __builtin_amdgcn_rsqf(s * (1.0f / DM) + EPS);
}
__device__ __forceinline__ u32x4 pack8(const f32x4 v0, const f32x4 v1) { u32x4 w; w.x = cvt_pk_bf16(v0[0], v0[1]); w.y = cvt_pk_bf16(v0[2], v0[3]); w.z = cvt_pk_bf16(v1[0], v1[1]); w.w = cvt_pk_bf16(v1[2], v1[3]); return w; }

struct EpiProj {
    static constexpr bool PERM = true, LDSX = false, MIDK = false;
    bf16_t* base; const float* rope; float* ksum;
    __device__ __forceinline__ void operator()(f32x4 (&acc)[2][2][4][2], const Unit& u, int wr, int wc, int fr, int fq) const {
        const int type = u.pn >> 1, colt = (u.pn & 1) * 256;
        bf16_t* O = base + (size_t)type * NTOK * 512;
        const bool is_q = (type == 2), is_k = (type == 3);
        if ((is_q || is_k) && !(wc & 1)) {
#pragma unroll
            for (int ai = 0; ai < 2; ++ai)
#pragma unroll
                for (int m = 0; m < 4; ++m) {
                    const int row = u.pm * 256 + 128 * ai + 64 * wr + 16 * m + fr, pos = row & (SEQ - 1);
                    const float* rp = rope + pos * 16;
                    const f32x4 cs[2] = { *(const f32x4*)(rp), *(const f32x4*)(rp + 4) }, sn[2] = { *(const f32x4*)(rp + 8), *(const f32x4*)(rp + 12) };
#pragma unroll
                    for (int bj = 0; bj < 2; ++bj)
#pragma unroll
                        for (int n = 0; n < 2; ++n) {
                            const f32x4 mine = acc[ai][bj][m][n]; f32x4 oth;
#pragma unroll
                            for (int e = 0; e < 4; ++e) oth[e] = __shfl_xor(mine[e], 16);
                            f32x4 res = mine;
                            if (fq == 0) res = mine * cs[n] - oth * sn[n];
                            else if (fq == 1) res = mine * cs[n] + oth * sn[n];
                            acc[ai][bj][m][n] = res;
                        }
                }
        }
        const float sc = is_q ? QSCALE : 1.0f;
#pragma unroll
        for (int ai = 0; ai < 2; ++ai)
#pragma unroll
            for (int m = 0; m < 4; ++m) {
                const int row = u.pm * 256 + 128 * ai + 64 * wr + 16 * m + fr;
                bf16_t* rowp = O + (size_t)row * 512 + colt + 32 * wc + 8 * fq;
#pragma unroll
                for (int bj = 0; bj < 2; ++bj) *(u32x4*)(rowp + bj * 128) = pack8(acc[ai][bj][m][0] * sc, acc[ai][bj][m][1] * sc);
            }
        if (is_k) {
#pragma unroll
            for (int bj = 0; bj < 2; ++bj)
#pragma unroll
                for (int n = 0; n < 2; ++n)
#pragma unroll
                    for (int e = 0; e < 4; ++e) {
                        float s = 0.f;
#pragma unroll
                        for (int ai = 0; ai < 2; ++ai)
#pragma unroll
                            for (int m = 0; m < 4; ++m) s += acc[ai][bj][m][n][e];
                        s += __shfl_xor(s, 1); s += __shfl_xor(s, 2); s += __shfl_xor(s, 4); s += __shfl_xor(s, 8);
                        if (fr == 0) atomicAdd(ksum + (size_t)u.pm * 512 + colt + 128 * bj + 32 * wc + 8 * fq + 4 * n + e, s);
                    }
        }
    }
};
struct EpiNull {
    static constexpr bool PERM = true, LDSX = false, MIDK = false;
    __device__ __forceinline__ void operator()(f32x4 (&acc)[2][2][4][2], const Unit& u, int wr, int wc, int fr, int fq) const { asm volatile("" :: "v"(acc[0][0][0][0][0]), "v"(acc[1][1][3][1][3])); }
};
struct EpiStore {
    static constexpr bool PERM = true, LDSX = false, MIDK = false;
    bf16_t* O; int ldc; float sc = 1.0f;
    __device__ __forceinline__ void operator()(f32x4 (&acc)[2][2][4][2], const Unit& u, int wr, int wc, int fr, int fq) const {
#pragma unroll
        for (int ai = 0; ai < 2; ++ai)
#pragma unroll
            for (int m = 0; m < 4; ++m) {
                const int row = u.pm * 256 + 128 * ai + 64 * wr + 16 * m + fr;
                bf16_t* rowp = O + (size_t)row * ldc + u.pn * 256 + 32 * wc + 8 * fq;
#pragma unroll
                for (int bj = 0; bj < 2; ++bj) *(u32x4*)(rowp + bj * 128) = pack8(acc[ai][bj][m][0] * sc, acc[ai][bj][m][1] * sc);
            }
    }
};
struct EpiStore8 {
    static constexpr bool PERM = true, LDSX = false, MIDK = false;
    unsigned char* O; int ldc; float sc;
    __device__ __forceinline__ void operator()(f32x4 (&acc)[2][2][4][2], const Unit& u, int wr, int wc, int fr, int fq) const {
#pragma unroll
        for (int ai = 0; ai < 2; ++ai)
#pragma unroll
            for (int m = 0; m < 4; ++m) {
                const int row = u.pm * 256 + 128 * ai + 64 * wr + 16 * m + fr;
                unsigned char* rowp = O + (size_t)row * ldc + u.pn * 256 + 32 * wc + 8 * fq;
#pragma unroll
                for (int bj = 0; bj < 2; ++bj) { const f32x4 a0 = acc[ai][bj][m][0] * sc, a1 = acc[ai][bj][m][1] * sc; u32x2 w; w.x = pk4_fp8(a0[0], a0[1], a0[2], a0[3]); w.y = pk4_fp8(a1[0], a1[1], a1[2], a1[3]); *(u32x2*)(rowp + bj * 128) = w; }
            }
    }
};
template <bool BASE_F32, bool KSPLIT> struct EpiResid {
    static constexpr bool PERM = true, LDSX = false, MIDK = KSPLIT;
    const void* base; bf16_t* hb; float* ssq; const float* ssql; const float* ssqa; unsigned char* h8; float asc; const float* rs0 = nullptr; const float* gmix = nullptr;
    __device__ __forceinline__ void stats(int row, int fq, float& rl, float& ra) const {
        const f32x4 pl = *(const f32x4*)(ssql + (size_t)row * 16 + 4 * fq); const f32x2 pa = *(const f32x2*)(ssqa + (size_t)row * 8 + 2 * fq);
        float sl = (pl[0] + pl[1]) + (pl[2] + pl[3]), sa = pa[0] + pa[1];
        sl += __shfl_xor(sl, 16); sl += __shfl_xor(sl, 32); sa += __shfl_xor(sa, 16); sa += __shfl_xor(sa, 32);
        rl = __builtin_amdgcn_rsqf(sl * (1.0f / 512.0f) + EPS); ra = __builtin_amdgcn_rsqf(sa * (1.0f / 512.0f) + EPS);
    }
    __device__ __forceinline__ void midk(f32x4 (&acc)[2][2][4][2], const Unit& u, int wr, int wc, int fr, int fq) const {
        asm volatile("" : "+v"(fr), "+v"(fq));
#pragma unroll
        for (int ai = 0; ai < 2; ++ai)
#pragma unroll
            for (int m = 0; m < 4; ++m) { float rl, ra; stats(u.pm * 256 + 128 * ai + 64 * wr + 16 * m + fr, fq, rl, ra); const float ratio = rl * __builtin_amdgcn_rcpf(ra);
#pragma unroll
                for (int bj = 0; bj < 2; ++bj)
#pragma unroll
                    for (int n = 0; n < 2; ++n) acc[ai][bj][m][n] *= ratio; }
    }
    __device__ __forceinline__ void operator()(f32x4 (&acc)[2][2][4][2], const Unit& u, int wr, int wc, int fr, int fq) const {
        f32x4 ginv[2][2];
        if constexpr (BASE_F32) {
#pragma unroll
            for (int bj = 0; bj < 2; ++bj)
#pragma unroll
                for (int n = 0; n < 2; ++n) { const f32x4 g = *(const f32x4*)(gmix + u.pn * 256 + 128 * bj + 32 * wc + 8 * fq + 4 * n);
                    ginv[bj][n] = (f32x4){__builtin_amdgcn_rcpf(g[0]), __builtin_amdgcn_rcpf(g[1]), __builtin_amdgcn_rcpf(g[2]), __builtin_amdgcn_rcpf(g[3])}; } }
#pragma unroll
        for (int ai = 0; ai < 2; ++ai)
#pragma unroll
            for (int m = 0; m < 4; ++m) {
                const int row = u.pm * 256 + 128 * ai + 64 * wr + 16 * m + fr; float q = 0.f, osc = asc, irs = 1.0f;
                if constexpr (KSPLIT) { float rl; stats(row, fq, rl, osc); osc *= asc; }
                if constexpr (BASE_F32) irs = __builtin_amdgcn_rcpf(rs0[row]);
#pragma unroll
                for (int bj = 0; bj < 2; ++bj) {
                    const int col = u.pn * 256 + 128 * bj + 32 * wc + 8 * fq;
                    f32x4 b0, b1;
                    if constexpr (BASE_F32) { const u32x4 w = *(const u32x4*)((const bf16_t*)base + (size_t)row * DM + col);
                        b0 = (f32x4){bflo(w.x), bfhi(w.x), bflo(w.y), bfhi(w.y)} * (ginv[bj][0] * irs); b1 = (f32x4){bflo(w.z), bfhi(w.z), bflo(w.w), bfhi(w.w)} * (ginv[bj][1] * irs); }
                    else { const u32x4 w = *(const u32x4*)((const bf16_t*)base + (size_t)row * LDH + col); b0 = (f32x4){bflo(w.x), bfhi(w.x), bflo(w.y), bfhi(w.y)}; b1 = (f32x4){bflo(w.z), bfhi(w.z), bflo(w.w), bfhi(w.w)}; }
                    const f32x4 v0 = b0 + acc[ai][bj][m][0] * osc, v1 = b1 + acc[ai][bj][m][1] * osc;
                    q += ((v0[0] * v0[0] + v0[1] * v0[1]) + (v0[2] * v0[2] + v0[3] * v0[3])) + ((v1[0] * v1[0] + v1[1] * v1[1]) + (v1[2] * v1[2] + v1[3] * v1[3]));
                    *(u32x4*)(hb + (size_t)row * LDH + col) = pack8(v0, v1);
                    if (h8) { u32x2 w8; w8.x = pk4_fp8(v0[0], v0[1], v0[2], v0[3]); w8.y = pk4_fp8(v1[0], v1[1], v1[2], v1[3]); *(u32x2*)(h8 + (size_t)row * DM + col) = w8; }
                }
                q += __shfl_xor(q, 16); q += __shfl_xor(q, 32);
                if (fq == 0) ssq[(size_t)row * 16 + u.pn * 4 + wc] = q;
            }
    }
};
struct EpiRowScale {
    static constexpr bool PERM = true, LDSX = false, MIDK = false;
    bf16_t* O; int ldc; const float* ssq; float cs;
    __device__ __forceinline__ void operator()(f32x4 (&acc)[2][2][4][2], const Unit& u, int wr, int wc, int fr, int fq) const {
#pragma unroll
        for (int ai = 0; ai < 2; ++ai)
#pragma unroll
            for (int m = 0; m < 4; ++m) {
                const int row = u.pm * 256 + 128 * ai + 64 * wr + 16 * m + fr; const float s = rstd_from_ssq(ssq, row) * cs;
                bf16_t* rowp = O + (size_t)row * ldc + u.pn * 256 + 32 * wc + 8 * fq;
#pragma unroll
                for (int bj = 0; bj < 2; ++bj) *(u32x4*)(rowp + bj * 128) = pack8(acc[ai][bj][m][0] * s, acc[ai][bj][m][1] * s);
            }
    }
};
#define XBAR() do { asm volatile("s_waitcnt lgkmcnt(0)" ::: "memory"); __builtin_amdgcn_s_barrier(); asm volatile("" ::: "memory"); } while (0)
struct EpiSoftmax {
    static constexpr bool PERM = true, LDSX = false, MIDK = false;
    unsigned char* O; int ldc; LAS unsigned char* xl; const float* ssq; float cs;
    __device__ __forceinline__ void operator()(f32x4 (&acc)[2][2][4][2], const Unit& u, int wr, int wc, int fr, int fq) const {
        LAS float* P = (LAS float*)xl;
        LAS float* Q = (LAS float*)(xl + 4096);
#pragma unroll
        for (int ai = 0; ai < 2; ++ai)
#pragma unroll
            for (int m = 0; m < 4; ++m) {
                float v = -INFINITY; const float sc = rstd_from_ssq(ssq, u.pm * 256 + 128 * ai + 64 * wr + 16 * m + fr) * cs;
#pragma unroll
                for (int bj = 0; bj < 2; ++bj)
#pragma unroll
                    for (int n = 0; n < 2; ++n) { const f32x4 x = acc[ai][bj][m][n] * sc; acc[ai][bj][m][n] = x; v = fmaxf(v, fmaxf(fmaxf(x[0], x[1]), fmaxf(x[2], x[3]))); }
                v = fmaxf(v, __shfl_xor(v, 16)); v = fmaxf(v, __shfl_xor(v, 32));
                if (fq == 0) P[(128 * ai + 64 * wr + 16 * m + fr) * 4 + wc] = v;
            }
        XBAR();
#pragma unroll
        for (int ai = 0; ai < 2; ++ai)
#pragma unroll
            for (int m = 0; m < 4; ++m) {
                const int r = 128 * ai + 64 * wr + 16 * m + fr;
                const float v = fmaxf(fmaxf(P[r * 4 + 0], P[r * 4 + 1]), fmaxf(P[r * 4 + 2], P[r * 4 + 3]));
                float s = 0.f;
#pragma unroll
                for (int bj = 0; bj < 2; ++bj)
#pragma unroll
                    for (int n = 0; n < 2; ++n) { f32x4 x = acc[ai][bj][m][n];
#pragma unroll
                        for (int e = 0; e < 4; ++e) { x[e] = __builtin_amdgcn_exp2f(x[e] - v); s += x[e]; }
                        acc[ai][bj][m][n] = x; }
                s += __shfl_xor(s, 16); s += __shfl_xor(s, 32);
                if (fq == 0) Q[r * 4 + wc] = s;
            }
        XBAR();
#pragma unroll
        for (int ai = 0; ai < 2; ++ai)
#pragma unroll
            for (int m = 0; m < 4; ++m) {
                const int r = 128 * ai + 64 * wr + 16 * m + fr;
                const float inv = PX_SC * __builtin_amdgcn_rcpf((Q[r * 4 + 0] + Q[r * 4 + 1]) + (Q[r * 4 + 2] + Q[r * 4 + 3]));
                unsigned char* rowp = O + (size_t)(u.pm * 256 + r) * ldc + u.pn * 256 + 32 * wc + 8 * fq;
#pragma unroll
                for (int bj = 0; bj < 2; ++bj) { const f32x4 a0 = acc[ai][bj][m][0] * inv, a1 = acc[ai][bj][m][1] * inv; u32x2 w; w.x = pk4_fp8(a0[0], a0[1], a0[2], a0[3]); w.y = pk4_fp8(a1[0], a1[1], a1[2], a1[3]); *(u32x2*)(rowp + bj * 128) = w; }
            }
        XBAR();
    }
};
struct EpiGateUp {
    static constexpr bool PERM = true, LDSX = false, MIDK = false;
    unsigned char* O; const float* lrs;
    __device__ __forceinline__ void operator()(f32x4 (&acc)[2][2][4][2], const Unit& u, int wr, int wc, int fr, int fq) const {
#pragma unroll
        for (int ai = 0; ai < 2; ++ai)
#pragma unroll
            for (int m = 0; m < 4; ++m) {
                const int r = 128 * ai + 64 * wr + 16 * m + fr, row = u.pm * 256 + r; const float rs = (r < u.nvalid) ? lrs[u.lbase + r] * (1.0f / WGU_SC) : 0.f;
                f32x4 o[2];
#pragma unroll
                for (int n = 0; n < 2; ++n)
#pragma unroll
                    for (int e = 0; e < 4; ++e) { const float g = acc[ai][0][m][n][e] * rs, up = acc[ai][1][m][n][e] * rs; o[n][e] = g * sigmoidf_(g) * up * ACT_SC; }
                u32x2 w8; w8.x = pk4_fp8(o[0][0], o[0][1], o[0][2], o[0][3]); w8.y = pk4_fp8(o[1][0], o[1][1], o[1][2], o[1][3]);
                *(u32x2*)(O + (size_t)row * DFF + u.pn * 128 + 32 * wc + 8 * fq) = w8;
            }
    }
};

struct Args { const float* in[27]; float* out; unsigned char* ws; int ph_lo, ph_hi; float invf[8]; };
struct Ctx { LAS unsigned char* lds; int tid, lane, wave, vcu, G; };

__device__ __forceinline__ void tr_load(f32x4 (&v)[8], const float* W, int ldw, int k0, int n0s, int lane) {
    const int kr = lane >> 3, ch = lane & 7;
#pragma unroll
    for (int i = 0; i < 8; ++i) v[i] = *(const f32x4*)(W + (size_t)(k0 + 8 * i + kr) * ldw + n0s + 4 * ch);
}
__device__ __forceinline__ void tr_finish(const f32x4 (&v)[8], int k0, bf16_t* WT, int ldt, int r0d, const float* gain, LAS float* scr, int lane) {
    const int kr = lane >> 3, ch = lane & 7, c = lane & 7;
    f32x4 g0 = {1.f, 1.f, 1.f, 1.f}, g1 = {1.f, 1.f, 1.f, 1.f};
    if (gain) { g0 = *(const f32x4*)(gain + k0 + 8 * c); g1 = *(const f32x4*)(gain + k0 + 8 * c + 4); }
#pragma unroll
    for (int i = 0; i < 8; ++i) { LAS float* d = scr + (8 * i + kr) * 33 + 4 * ch; d[0] = v[i][0]; d[1] = v[i][1]; d[2] = v[i][2]; d[3] = v[i][3]; }
    LDS_WAIT(); asm volatile("" ::: "memory");
#pragma unroll
    for (int j = 0; j < 4; ++j) { const int n = (lane >> 3) + 8 * j; const LAS float* s = scr + (8 * c) * 33 + n;
        u32x4 o; o.x = cvt_pk_bf16(s[0 * 33] * g0[0], s[1 * 33] * g0[1]); o.y = cvt_pk_bf16(s[2 * 33] * g0[2], s[3 * 33] * g0[3]); o.z = cvt_pk_bf16(s[4 * 33] * g1[0], s[5 * 33] * g1[1]); o.w = cvt_pk_bf16(s[6 * 33] * g1[2], s[7 * 33] * g1[3]);
        *(u32x4*)(WT + (size_t)(r0d + n) * ldt + k0 + 8 * c) = o; }
    LDS_WAIT(); asm volatile("" ::: "memory");
}
__device__ __forceinline__ void tr_finish8(const f32x4 (&v)[8], int k0, unsigned char* WT8, int ldt, int r0d, const float* gain, float sc, LAS float* scr, int lane) {
    const int kr = lane >> 3, ch = lane & 7, c = lane & 7;
    f32x4 g0 = {sc, sc, sc, sc}, g1 = {sc, sc, sc, sc};
    if (gain) { g0 = *(const f32x4*)(gain + k0 + 8 * c) * sc; g1 = *(const f32x4*)(gain + k0 + 8 * c + 4) * sc; }
#pragma unroll
    for (int i = 0; i < 8; ++i) { LAS float* d = scr + (8 * i + kr) * 33 + 4 * ch; d[0] = v[i][0]; d[1] = v[i][1]; d[2] = v[i][2]; d[3] = v[i][3]; }
    LDS_WAIT(); asm volatile("" ::: "memory");
#pragma unroll
    for (int j = 0; j < 4; ++j) { const int n = (lane >> 3) + 8 * j; const LAS float* s = scr + (8 * c) * 33 + n;
        u32x2 o; o.x = pk4_fp8(s[0 * 33] * g0[0], s[1 * 33] * g0[1], s[2 * 33] * g0[2], s[3 * 33] * g0[3]); o.y = pk4_fp8(s[4 * 33] * g1[0], s[5 * 33] * g1[1], s[6 * 33] * g1[2], s[7 * 33] * g1[3]);
        *(u32x2*)(WT8 + (size_t)(r0d + n) * ldt + k0 + 8 * c) = o; }
    LDS_WAIT(); asm volatile("" ::: "memory");
}
__device__ __forceinline__ void tr_item(const float* W, int ldw, int k0, int n0s, bf16_t* WT, int ldt, int r0d, const float* gain, LAS float* scr, int lane) {
    f32x4 v[8]; tr_load(v, W, ldw, k0, n0s, lane); tr_finish(v, k0, WT, ldt, r0d, gain, scr, lane);
}
__device__ __forceinline__ void rms_row_to_bf16(const float* xrow, const float* gain, bf16_t* orow, int lane) {
    const f32x4* xr = (const f32x4*)xrow + lane; const f32x4* gr = (const f32x4*)gain + lane;
    f32x4 v[4]; float s = 0.f;
#pragma unroll
    for (int j = 0; j < 4; ++j) { v[j] = xr[64 * j]; s += (v[j][0] * v[j][0] + v[j][1] * v[j][1]) + (v[j][2] * v[j][2] + v[j][3] * v[j][3]); }
    const float rstd = 1.0f / sqrtf(wave_sum(s) * (1.0f / DM) + EPS);
    u32x2* o8 = (u32x2*)orow + lane;
#pragma unroll
    for (int j = 0; j < 4; ++j) { const f32x4 g = gr[64 * j]; u32x2 w; w.x = cvt_pk_bf16(v[j][0] * rstd * g[0], v[j][1] * rstd * g[1]); w.y = cvt_pk_bf16(v[j][2] * rstd * g[2], v[j][3] * rstd * g[3]); o8[64 * j] = w; }
}

__device__ __forceinline__ void rms_row2_to_bf16(const float* xrow, const float* gain, bf16_t* orow, int lane, float* rstd_out = nullptr) {
    const f32x4* xr = (const f32x4*)xrow + lane; const f32x4* gr = (const f32x4*)gain + lane;
    f32x4 v[2][4]; float s[2] = {0.f, 0.f};
#pragma unroll
    for (int r = 0; r < 2; ++r)
#pragma unroll
        for (int j = 0; j < 4; ++j) v[r][j] = xr[256 * r + 64 * j];
#pragma unroll
    for (int r = 0; r < 2; ++r)
#pragma unroll
        for (int j = 0; j < 4; ++j) s[r] += (v[r][j][0] * v[r][j][0] + v[r][j][1] * v[r][j][1]) + (v[r][j][2] * v[r][j][2] + v[r][j][3] * v[r][j][3]);
#pragma unroll
    for (int r = 0; r < 2; ++r) { const float rstd = 1.0f / sqrtf(wave_sum(s[r]) * (1.0f / DM) + EPS); u32x2* o8 = (u32x2*)(orow + (size_t)r * DM) + lane; if (rstd_out && lane == 0) rstd_out[r] = rstd;
#pragma unroll
        for (int j = 0; j < 4; ++j) { const f32x4 g = gr[64 * j]; u32x2 w; w.x = cvt_pk_bf16(v[r][j][0] * rstd * g[0], v[r][j][1] * rstd * g[1]); w.y = cvt_pk_bf16(v[r][j][2] * rstd * g[2], v[r][j][3] * rstd * g[3]); o8[64 * j] = w; } }
}

__device__ __forceinline__ void conv_wdn(const Args& a, const Ctx& C, int gw, int NGW, int it_lo, int NIT) {
    LAS float* scr = (LAS float*)(C.lds + C.wave * 16384); const int lane = C.lane;
    f32x4 va[8], vb[8];
#define WDN_LOAD(v, it) do { const int e_ = (it) / 256, r_ = (it) % 256; tr_load(v, a.in[25] + (size_t)e_ * DFF * DM, DM, 64 * (r_ / 32), 32 * (r_ % 32), lane); } while (0)
#define WDN_FIN(v, it) do { const int e_ = (it) / 256, r_ = (it) % 256; tr_finish8(v, 64 * (r_ / 32), a.ws + WS_WDN, DFF, e_ * 1024 + 32 * (r_ % 32), nullptr, WDN_SC, scr, lane); } while (0)
    int it = it_lo + gw; if (it < NIT) WDN_LOAD(va, it);
    for (; it < NIT; it += 2 * NGW) {
        const int it1 = it + NGW, it2 = it + 2 * NGW;
        if (it1 < NIT) WDN_LOAD(vb, it1);
        WDN_FIN(va, it);
        if (it2 < NIT) WDN_LOAD(va, it2);
        if (it1 < NIT) WDN_FIN(vb, it1);
    }
#undef WDN_LOAD
#undef WDN_FIN
}
__device__ __forceinline__ void ph_prologue(const Args& a, const Ctx& C) {
    unsigned char* ws = a.ws;
    LAS float* scr = (LAS float*)(C.lds + C.wave * 16384);
    const int gw = C.vcu * 8 + C.wave, NGW = C.G * 8, lane = C.lane;
    for (int it = gw; it < 16 * 80; it += NGW) { const int kb = it / 80, nb = it % 80; tr_item(a.in[3], DIN, 64 * kb, 32 * nb, (bf16_t*)(ws + WS_WIN), DM, 32 * nb, nullptr, scr, lane); }
    for (int it = gw; it < 16 * 64; it += NGW) { const int kb = it / 64, nb = it % 64;
        if (nb < 32) tr_item(a.in[17], 2 * DM, 64 * kb, 32 * nb, (bf16_t*)(ws + WS_WXK), DM, 32 * nb, nullptr, scr, lane);
        else tr_item(a.in[17], 2 * DM, 64 * kb, 32 * nb, (bf16_t*)(ws + WS_WXV), DM, 32 * (nb - 32), nullptr, scr, lane); }
    for (int it = gw; it < 16 * 32; it += NGW) { const int kb = it / 32, nb = it % 32;
        tr_item(a.in[13], DM, 64 * kb, 32 * nb, (bf16_t*)(ws + WS_WOUT), DM, 32 * nb, (kb < 8) ? a.in[11] : (a.in[12] - DLRU), scr, lane);
        tr_item(a.in[18], DM, 64 * kb, 32 * nb, (bf16_t*)(ws + WS_WXO), DM, 32 * nb, nullptr, scr, lane); }
    for (int it = gw; it < NEXP * 16 * 32; it += NGW) { const int e = it / 512, r = it % 512, kb = r / 32, nb = r % 32, j = nb >> 3, half = (nb >> 2) & 1, q = nb & 3;
        f32x4 v8_[8]; tr_load(v8_, a.in[24] + (size_t)e * DM * DM, DM, 64 * kb, half * 512 + j * 128 + q * 32, lane); tr_finish8(v8_, 64 * kb, ws + WS_WGU, DM, e * 1024 + j * 256 + half * 128 + q * 32, a.in[19], WGU_SC, scr, lane); }
    for (int r = gw; r < DM; r += NGW) { const float gk = a.in[14][r]; const f32x4* src = (const f32x4*)(a.in[16] + (size_t)r * DM) + lane; u32x2* dst = (u32x2*)((bf16_t*)(ws + WS_WXQ) + (size_t)r * DM) + lane;
#pragma unroll
        for (int j = 0; j < 4; ++j) { const f32x4 v = src[64 * j]; u32x2 w; w.x = cvt_pk_bf16(v[0] * gk, v[1] * gk); w.y = cvt_pk_bf16(v[2] * gk, v[3] * gk); dst[64 * j] = w; } }
    conv_wdn(a, C, gw, NGW, WDN_SPLIT, NEXP * 8 * 32);
    { bf16_t* WR = (bf16_t*)(ws + WS_WR); const int gt = C.vcu * 512 + C.tid, NT = C.G * 512;
      for (int i = gt; i < 48 * DM; i += NT) { const int r = i / DM, k = i % DM; float v = 0.f;
          if (r < 4) v = a.in[20][k * NGRP + r] * a.in[19][k]; else if (r < 36) v = a.in[22][k * NEXP + (r - 4)] * a.in[19][k];
          WR[i] = (bf16_t)(cvt_pk_bf16(v, 0.f) & 0xffffu); }
      float* rope = (float*)(ws + WS_ROPE);
      for (int i = gt; i < SEQ * 8; i += NT) { const int pos = i >> 3, j = i & 7; const float ang = (float)pos * a.invf[j];
          const double tw = 6.283185307179586476925286766559; const double ad = (double)ang; const double red = ad - tw * __builtin_rint(ad / tw); const float rf = (float)red;
          rope[pos * 16 + j] = __cosf(rf); rope[pos * 16 + 8 + j] = __sinf(rf); } }
    for (int m = 2 * gw; m < NTOK; m += 2 * NGW) rms_row2_to_bf16(a.in[0] + (size_t)m * DM, a.in[2], (bf16_t*)(ws + WS_B) + (size_t)m * DM, lane, (float*)(ws + WS_TOK + TOK_D) + m);
    for (int m = 2 * gw; m < NMEM; m += 2 * NGW) rms_row2_to_bf16(a.in[1] + (size_t)m * DM, a.in[15], (bf16_t*)(ws + WS_MEMN) + (size_t)m * DM, lane);
}

__device__ __forceinline__ float gelu_tanh(float x) { const float x2 = x * x; const float z2 = x * (-2.0f * 0.7978845608028654f * 1.4426950408889634f) * (1.0f + 0.044715f * x2);
    return x * __builtin_amdgcn_rcpf(1.0f + __builtin_amdgcn_exp2f(z2)); }
__device__ __forceinline__ float one_minus_exp(float x) {
    const float p = -x * (1.0f + x * (0.5f + x * (0.16666667f + x * (0.041666668f + x * 0.0083333338f))));
    const float e = 1.0f - __builtin_amdgcn_exp2f(x * 1.4426950408889634f);
    return (x > -0.25f) ? p : e;
}
__device__ __forceinline__ void lru_unit(const Args& a, const Ctx& C, int b, int blk, int half) {
    unsigned char* ws = a.ws;
    const bf16_t* XL = (const bf16_t*)(ws + WS_A); const bf16_t* GL = XL + (size_t)NTOK * 512; bf16_t* YC = (bf16_t*)(ws + WS_C); float* SSQL = (float*)(ws + WS_SSQL);
    const int tid = C.tid, lane = C.lane, wave = C.wave, fr = lane & 15, fq = lane >> 4;
    LAS float* XW = (LAS float*)(C.lds + wave * 5120);
    LAS bf16_t* GW = (LAS bf16_t*)(C.lds + wave * 5120 + 2304);
    LAS bf16_t* YW = (LAS bf16_t*)(C.lds + wave * 5120 + 3584);
    LAS float* WSUM = (LAS float*)(C.lds + 40960);
    LAS float* CW = (LAS float*)(C.lds + 45056);
    const int c0 = blk * 64, oc0 = c0 + half * 32;
    bf16x8 wfr[2][2][2];
#pragma unroll
    for (int gt = 0; gt < 2; ++gt) { const float* W = a.in[gt == 0 ? 6 : 8] + (size_t)blk * 64 * 64;
#pragma unroll
        for (int nt = 0; nt < 2; ++nt)
#pragma unroll
            for (int ks = 0; ks < 2; ++ks) { u32x4 w; float f[8];
#pragma unroll
                for (int j = 0; j < 8; ++j) f[j] = W[(32 * ks + 8 * fq + j) * 64 + half * 32 + 16 * nt + fr];
                w.x = cvt_pk_bf16(f[0], f[1]); w.y = cvt_pk_bf16(f[2], f[3]); w.z = cvt_pk_bf16(f[4], f[5]); w.w = cvt_pk_bf16(f[6], f[7]);
                wfr[gt][nt][ks] = __builtin_bit_cast(bf16x8, w); } }
    float brg[2], big[2], sp[2], hc[2] = {0.f, 0.f};
#pragma unroll
    for (int nt = 0; nt < 2; ++nt) { const int ch = oc0 + 16 * nt + fr; brg[nt] = a.in[7][ch] * -1.4426950408889634f; big[nt] = a.in[9][ch] * -1.4426950408889634f; const float lam = a.in[10][ch];
        sp[nt] = -8.0f * 1.4426950408889634f * ((lam > 15.f) ? __expf(-lam) : log1pf(__expf(-lam))); }
    if (tid < 320) { const int k = tid >> 6, c = tid & 63; CW[tid] = (k < 4) ? a.in[4][k * DLRU + c0 + c] : a.in[5][c0 + c]; }
    u32x4 xrs[2][4][2], grs[2];
    const bf16_t* xrow0 = XL + ((size_t)b * SEQ + 16 * wave + fr) * 512 + c0 + 8 * fq;
    const bf16_t* grow0 = GL + ((size_t)b * SEQ + 16 * wave + (lane >> 2)) * 512 + oc0 + 8 * (lane & 3);
    const int tloc = 16 * wave + fr;
#define LRU_PREFETCH(t0_, xr, gr) do { _Pragma("unroll") for (int k = 0; k < 4; ++k) { const int tt = (t0_) + tloc - 3 + k; \
        if (tt >= 0) { const bf16_t* xp = xrow0 + (ptrdiff_t)((t0_) - 3 + k) * 512; xr[k][0] = *(const u32x4*)xp; xr[k][1] = *(const u32x4*)(xp + 32); } else { xr[k][0] = (u32x4){0u, 0u, 0u, 0u}; xr[k][1] = (u32x4){0u, 0u, 0u, 0u}; } } \
        gr = *(const u32x4*)(grow0 + (size_t)(t0_) * 512); } while (0)
    LRU_PREFETCH(0, xrs[0], grs[0]); LRU_PREFETCH(128, xrs[1], grs[1]);
    __syncthreads();
    for (int ch2 = 0; ch2 < SEQ / 256; ++ch2) {
#pragma unroll
      for (int sub = 0; sub < 2; ++sub) { const int ch = 2 * ch2 + sub, t0 = ch * 128; auto& xr = xrs[sub]; auto& gr = grs[sub];
        bf16x8 af[2];
#pragma unroll
        for (int ks = 0; ks < 2; ++ks) { float accv[8];
            { const f32x4 b0 = *(const LAS f32x4*)(CW + 256 + 32 * ks + 8 * fq), b1 = *(const LAS f32x4*)(CW + 256 + 32 * ks + 8 * fq + 4);
              accv[0] = b0[0]; accv[1] = b0[1]; accv[2] = b0[2]; accv[3] = b0[3]; accv[4] = b1[0]; accv[5] = b1[1]; accv[6] = b1[2]; accv[7] = b1[3]; }
#pragma unroll
            for (int k = 0; k < 4; ++k) { const f32x4 w0 = *(const LAS f32x4*)(CW + 64 * k + 32 * ks + 8 * fq), w1 = *(const LAS f32x4*)(CW + 64 * k + 32 * ks + 8 * fq + 4); const u32x4 x = xr[k][ks];
                accv[0] += w0[0] * bflo(x.x); accv[1] += w0[1] * bfhi(x.x); accv[2] += w0[2] * bflo(x.y); accv[3] += w0[3] * bfhi(x.y);
                accv[4] += w1[0] * bflo(x.z); accv[5] += w1[1] * bfhi(x.z); accv[6] += w1[2] * bflo(x.w); accv[7] += w1[3] * bfhi(x.w); }
            u32x4 p; p.x = cvt_pk_bf16(accv[0], accv[1]); p.y = cvt_pk_bf16(accv[2], accv[3]); p.z = cvt_pk_bf16(accv[4], accv[5]); p.w = cvt_pk_bf16(accv[6], accv[7]);
            af[ks] = __builtin_bit_cast(bf16x8, p);
            if (ks == half) { *(LAS f32x4*)(XW + fr * 36 + 8 * fq) = (f32x4){accv[0], accv[1], accv[2], accv[3]}; *(LAS f32x4*)(XW + fr * 36 + 8 * fq + 4) = (f32x4){accv[4], accv[5], accv[6], accv[7]}; } }
        *(LAS u32x4*)(GW + (lane >> 2) * 40 + 8 * (lane & 3)) = gr;
        if (ch + 2 < SEQ / 128) LRU_PREFETCH(t0 + 256, xr, gr);
        LDS_WAIT(); asm volatile("" ::: "memory");
        float Hl[2][4], Al[2][4], Aex[2], Hex[2];
        { f32x4 ar[2] = {{0.f, 0.f, 0.f, 0.f}, {0.f, 0.f, 0.f, 0.f}}, ai_[2] = {{0.f, 0.f, 0.f, 0.f}, {0.f, 0.f, 0.f, 0.f}};
#pragma unroll
          for (int ks = 0; ks < 2; ++ks)
#pragma unroll
              for (int nt = 0; nt < 2; ++nt) { ar[nt] = __builtin_amdgcn_mfma_f32_16x16x32_bf16(af[ks], wfr[0][nt][ks], ar[nt], 0, 0, 0); ai_[nt] = __builtin_amdgcn_mfma_f32_16x16x32_bf16(af[ks], wfr[1][nt][ks], ai_[nt], 0, 0, 0); }
#pragma unroll
          for (int nt = 0; nt < 2; ++nt) {
              float hrun = 0.f, arun = 1.f;
#pragma unroll
              for (int r = 0; r < 4; ++r) { const int chn = 16 * nt + fr;
                  const float rg = __builtin_amdgcn_rcpf(1.0f + __builtin_amdgcn_exp2f(__builtin_fmaf(ar[nt][r], -1.4426950408889634f, brg[nt])));
                  const float ig = __builtin_amdgcn_rcpf(1.0f + __builtin_amdgcn_exp2f(__builtin_fmaf(ai_[nt][r], -1.4426950408889634f, big[nt])));
                  const float av = __builtin_amdgcn_exp2f(rg * sp[nt]); const float mult = __builtin_amdgcn_sqrtf(fmaxf(1.0f - av * av, 0.f));
                  const float uv = mult * ig * XW[(4 * fq + r) * 36 + chn];
                  hrun = av * hrun + uv; arun *= av; Hl[nt][r] = hrun; Al[nt][r] = arun; }
              const float A0 = __shfl(arun, fr), H0 = __shfl(hrun, fr), A1 = __shfl(arun, fr + 16), H1 = __shfl(hrun, fr + 16), A2 = __shfl(arun, fr + 32), H2 = __shfl(hrun, fr + 32), A3 = __shfl(arun, fr + 48), H3 = __shfl(hrun, fr + 48);
              const float h01 = A1 * H0 + H1, a01 = A1 * A0, h012 = A2 * h01 + H2, a012 = A2 * a01;
              Aex[nt] = (fq == 0) ? 1.f : (fq == 1) ? A0 : (fq == 2) ? a01 : a012;
              Hex[nt] = (fq == 0) ? 0.f : (fq == 1) ? H0 : (fq == 2) ? h01 : h012;
              if (fq == 0) *(LAS f32x2*)(WSUM + (((ch & 1) * 8 + wave) * 32 + 16 * nt + fr) * 2) = (f32x2){A3 * a012, A3 * h012 + H3}; } }
        __syncthreads();
        { float ssr[4] = {0.f, 0.f, 0.f, 0.f};
#pragma unroll
          for (int nt = 0; nt < 2; ++nt) { const int chn = 16 * nt + fr; float x = hc[nt], mine = 0.f;
#pragma unroll
              for (int w2 = 0; w2 < 8; ++w2) { const f32x2 sm = *(const LAS f32x2*)(WSUM + (((ch & 1) * 8 + w2) * 32 + chn) * 2); if (w2 == wave) mine = x; x = sm[0] * x + sm[1]; }
              hc[nt] = x;
              const float hstart = Aex[nt] * mine + Hex[nt];
#pragma unroll
              for (int r = 0; r < 4; ++r) { const int tl = 4 * fq + r; const float h = Al[nt][r] * hstart + Hl[nt][r];
                  const float y = h * gelu_tanh(bf2f(GW[tl * 40 + chn])); const unsigned yb = cvt_pk_bf16(y, 0.f) & 0xffffu; YW[tl * 40 + chn] = (bf16_t)yb;
                  const float yr = __uint_as_float(yb << 16); ssr[r] += yr * yr; } }
#pragma unroll
          for (int r = 0; r < 4; ++r) { float q = ssr[r]; q += __shfl_xor(q, 1); q += __shfl_xor(q, 2); q += __shfl_xor(q, 4); q += __shfl_xor(q, 8);
              if (fr == 0) SSQL[((size_t)b * SEQ + t0 + 16 * wave + 4 * fq + r) * 16 + blk * 2 + half] = q; } }
        LDS_WAIT(); asm volatile("" ::: "memory");
        *(u32x4*)(YC + ((size_t)b * SEQ + t0 + 16 * wave + (lane >> 2)) * DM + oc0 + 8 * (lane & 3)) = *(const LAS u32x4*)(YW + (lane >> 2) * 40 + 8 * (lane & 3));
      }
    }
#undef LRU_PREFETCH
    __syncthreads();
}

__device__ __forceinline__ void moba_unit_simple(const Args& a, const Ctx& C, int b, int h, int qb) {
    unsigned char* ws = a.ws;
    const bf16_t* Q = (const bf16_t*)(ws + WS_A) + (size_t)2 * NTOK * 512; const bf16_t* K = Q + (size_t)NTOK * 512; const bf16_t* V = K + (size_t)NTOK * 512;
    bf16_t* YA = (bf16_t*)(ws + WS_B) + (size_t)NTOK * 512; const float* KSUM = (const float*)(ws + WS_KSUM);
    const int q = C.tid & 255, hf = C.tid >> 8; const size_t row = (size_t)b * SEQ + qb * 256 + q;
    float qv[64];
    { const u32x4* qp = (const u32x4*)(Q + row * 512 + h * 64);
#pragma unroll
      for (int i = 0; i < 8; ++i) { const u32x4 w = qp[i]; qv[8 * i] = bflo(w.x); qv[8 * i + 1] = bfhi(w.x); qv[8 * i + 2] = bflo(w.y); qv[8 * i + 3] = bfhi(w.y); qv[8 * i + 4] = bflo(w.z); qv[8 * i + 5] = bfhi(w.z); qv[8 * i + 6] = bflo(w.w); qv[8 * i + 7] = bfhi(w.w); } }
    unsigned sel = 0u;
    { float g[8];
#pragma unroll
      for (int n = 0; n < 8; ++n) { g[n] = -INFINITY;
          if (n < qb) { const float* ks = KSUM + (size_t)(b * 8 + n) * 512 + h * 64; float s = 0.f;
#pragma unroll
              for (int d = 0; d < 64; ++d) s += qv[d] * ks[d];
              g[n] = s; } }
      const int npick = qb < 3 ? qb : 3;
      for (int p = 0; p < npick; ++p) { int best = -1; float bv = -INFINITY;
#pragma unroll
          for (int n = 0; n < 8; ++n) { const bool ok = (n < qb) && !((sel >> n) & 1u) && (best < 0 || g[n] > bv); if (ok) { best = n; bv = g[n]; } }
          if (best >= 0) sel |= 1u << best; } }
    float o[32], mrun = -1e30f, l = 0.f;
#pragma unroll
    for (int d = 0; d < 32; ++d) o[d] = 0.f;
    for (int n = 0; n <= qb; ++n) {
        const bool own = (n == qb); const bool use = own || ((sel >> n) & 1u);
        if (!__any(use)) continue;
        for (int j = 0; j < 256; ++j) {
            const bool valid = use && (!own || j <= q);
            if (!__any(valid)) continue;
            const size_t krow = (size_t)b * SEQ + n * 256 + j;
            const u32x4* kp = (const u32x4*)(K + krow * 512 + h * 64); float s = 0.f;
#pragma unroll
            for (int i = 0; i < 8; ++i) { const u32x4 w = kp[i];
                s += qv[8 * i] * bflo(w.x) + qv[8 * i + 1] * bfhi(w.x) + qv[8 * i + 2] * bflo(w.y) + qv[8 * i + 3] * bfhi(w.y) + qv[8 * i + 4] * bflo(w.z) + qv[8 * i + 5] * bfhi(w.z) + qv[8 * i + 6] * bflo(w.w) + qv[8 * i + 7] * bfhi(w.w); }
            if (valid) {
                const float mnew = fmaxf(mrun, s), f = __builtin_amdgcn_exp2f(mrun - mnew), p = __builtin_amdgcn_exp2f(s - mnew);
                l = l * f + p; mrun = mnew;
                const u32x4* vp = (const u32x4*)(V + krow * 512 + h * 64 + 32 * hf);
#pragma unroll
                for (int i = 0; i < 4; ++i) { const u32x4 w = vp[i];
                    o[8 * i] = o[8 * i] * f + p * bflo(w.x); o[8 * i + 1] = o[8 * i + 1] * f + p * bfhi(w.x); o[8 * i + 2] = o[8 * i + 2] * f + p * bflo(w.y); o[8 * i + 3] = o[8 * i + 3] * f + p * bfhi(w.y);
                    o[8 * i + 4] = o[8 * i + 4] * f + p * bflo(w.z); o[8 * i + 5] = o[8 * i + 5] * f + p * bfhi(w.z); o[8 * i + 6] = o[8 * i + 6] * f + p * bflo(w.w); o[8 * i + 7] = o[8 * i + 7] * f + p * bfhi(w.w); }
            }
        }
    }
    const float inv = 1.0f / l;
    u32x4* op = (u32x4*)(YA + row * 512 + h * 64 + 32 * hf);
#pragma unroll
    for (int i = 0; i < 4; ++i) { u32x4 w; w.x = cvt_pk_bf16(o[8 * i] * inv, o[8 * i + 1] * inv); w.y = cvt_pk_bf16(o[8 * i + 2] * inv, o[8 * i + 3] * inv); w.z = cvt_pk_bf16(o[8 * i + 4] * inv, o[8 * i + 5] * inv); w.w = cvt_pk_bf16(o[8 * i + 6] * inv, o[8 * i + 7] * inv); op[i] = w; }
}

__device__ __forceinline__ void ph_ymix(const Args& a, const Ctx& C) {
    const bf16_t* YL = (const bf16_t*)(a.ws + WS_B); const bf16_t* YA = YL + (size_t)NTOK * 512; bf16_t* YM = (bf16_t*)(a.ws + WS_C);
    const int gw = C.vcu * 8 + C.wave, NGW = C.G * 8, lane = C.lane;
    for (int m = gw; m < NTOK; m += NGW) {
#pragma unroll
        for (int part = 0; part < 2; ++part) {
            const u32x4 w = *((const u32x4*)((part ? YA : YL) + (size_t)m * 512) + lane);
            float v[8] = {bflo(w.x), bfhi(w.x), bflo(w.y), bfhi(w.y), bflo(w.z), bfhi(w.z), bflo(w.w), bfhi(w.w)}; float s = 0.f;
#pragma unroll
            for (int i = 0; i < 8; ++i) s += v[i] * v[i];
            const float rstd = 1.0f / sqrtf(wave_sum(s) * (1.0f / 512.0f) + EPS);
            u32x4 o; o.x = cvt_pk_bf16(v[0] * rstd, v[1] * rstd); o.y = cvt_pk_bf16(v[2] * rstd, v[3] * rstd); o.z = cvt_pk_bf16(v[4] * rstd, v[5] * rstd); o.w = cvt_pk_bf16(v[6] * rstd, v[7] * rstd);
            *((u32x4*)(YM + (size_t)m * DM + part * 512) + lane) = o;
        }
    }
}

__device__ __forceinline__ void ph_router(const Args& a, const Ctx& C) {
    unsigned char* ws = a.ws;
    const bf16_t* H2B = (const bf16_t*)a.out + DM; const bf16_t* WR = (const bf16_t*)(ws + WS_WR); const float* SSQ2 = (const float*)(ws + WS_SSQ2);
    unsigned* CNT = (unsigned*)(ws + WS_CTL) + CW_CNT;
    int* TOKE = (int*)(ws + WS_TOK + TOK_E); int* TOKR = (int*)(ws + WS_TOK + TOK_R); float* TOKG = (float*)(ws + WS_TOK + TOK_G); int* LTOK = (int*)(ws + WS_LTOK); float* LRS = (float*)(ws + WS_LRS);
    constexpr int WRS = 1032;
    LAS bf16_t* WRL = (LAS bf16_t*)C.lds;
    LAS float* LG = (LAS float*)(C.lds + 99072) + C.wave * (16 * 49);
    LAS unsigned* lcnt = (LAS unsigned*)(C.lds + 99072 + 25088); LAS unsigned* lbase = lcnt + 32;
    const int lane = C.lane, fr = lane & 15, fq = lane >> 4;
    for (int i = C.tid; i < 48 * 128; i += 512) { const int r = i >> 7, c8 = i & 127; *(LAS u32x4*)(WRL + r * WRS + 8 * c8) = *(const u32x4*)(WR + (size_t)r * DM + 8 * c8); }
    for (int pass = 0; (pass * C.G) * 128 < NTOK; ++pass) {
        const int blk = pass * C.G + C.vcu; const bool live = blk * 128 < NTOK;
        if (C.tid < 32) lcnt[C.tid] = 0u;
        __syncthreads();
        int E1 = 0, E2 = 0; unsigned r1 = 0, r2 = 0; float ga = 0.f, gb = 0.f, rstd_t = 0.f; const int tb = blk * 128 + 16 * C.wave;
        if (live) {
            f32x4 acc[3] = {{0.f, 0.f, 0.f, 0.f}, {0.f, 0.f, 0.f, 0.f}, {0.f, 0.f, 0.f, 0.f}};
            bf16x8 af[32];
#pragma unroll
            for (int ks = 0; ks < 32; ++ks) af[ks] = *(const bf16x8*)(H2B + (size_t)(tb + fr) * LDH + 32 * ks + 8 * fq);
#pragma unroll
            for (int ks = 0; ks < 32; ++ks) {
#pragma unroll
                for (int nt = 0; nt < 3; ++nt) { const bf16x8 bfg = *(const LAS bf16x8*)(WRL + (16 * nt + fr) * WRS + 32 * ks + 8 * fq); acc[nt] = __builtin_amdgcn_mfma_f32_16x16x32_bf16(af[ks], bfg, acc[nt], 0, 0, 0); } }
#pragma unroll
            for (int nt = 0; nt < 3; ++nt)
#pragma unroll
                for (int r = 0; r < 4; ++r) LG[(4 * fq + r) * 49 + 16 * nt + fr] = acc[nt][r];
            LDS_WAIT(); asm volatile("" ::: "memory");
            if (lane < 16) { const int t = tb + lane; const float rstd = rstd_from_ssq(SSQ2, t); rstd_t = rstd; const LAS float* lg = LG + lane * 49;
                float g[4]; int grp = 0;
#pragma unroll
                for (int i = 0; i < 4; ++i) g[i] = lg[i] * rstd + a.in[21][i];
#pragma unroll
                for (int i = 1; i < 4; ++i) if (g[i] > g[grp]) grp = i;
                float gs = 0.f;
#pragma unroll
                for (int i = 0; i < 4; ++i) gs += __expf(g[i] - g[grp]);
                const float gw_ = 1.0f / gs;
                float e[8];
#pragma unroll
                for (int i = 0; i < 8; ++i) e[i] = lg[4 + 8 * grp + i] * rstd + a.in[23][8 * grp + i];
                int i1 = 0;
#pragma unroll
                for (int i = 1; i < 8; ++i) if (e[i] > e[i1]) i1 = i;
                int i2 = (i1 == 0) ? 1 : 0;
#pragma unroll
                for (int i = 0; i < 8; ++i) if (i != i1 && i != i2 && e[i] > e[i2]) i2 = i;
                const float eb = __expf(e[i2] - e[i1]); ga = gw_ / (1.0f + eb); gb = gw_ * eb / (1.0f + eb);
                E1 = grp * 8 + i1; E2 = grp * 8 + i2;
                r1 = atomicAdd((unsigned*)&lcnt[E1], 1u); r2 = atomicAdd((unsigned*)&lcnt[E2], 1u);
            }
        }
        __syncthreads();
        if (C.tid < 32) lbase[C.tid] = lcnt[C.tid] ? __hip_atomic_fetch_add(CNT + C.tid, lcnt[C.tid], __ATOMIC_RELAXED, __HIP_MEMORY_SCOPE_AGENT) : 0u;
        __syncthreads();
        if (live && lane < 16) { const int t = tb + lane;
            const int k1 = (int)(lbase[E1] + r1), k2 = (int)(lbase[E2] + r2);
            TOKE[2 * t] = E1; TOKR[2 * t] = k1; TOKG[2 * t] = ga; LTOK[E1 * LCAP + k1] = t; LRS[E1 * LCAP + k1] = rstd_t;
            TOKE[2 * t + 1] = E2; TOKR[2 * t + 1] = k2; TOKG[2 * t + 1] = gb; LTOK[E2 * LCAP + k2] = t; LRS[E2 * LCAP + k2] = rstd_t; }
        __syncthreads();
    }
}
__device__ __forceinline__ void moe_table(const Args& a, const Ctx& C) {
    LAS int* ts = (LAS int*)(C.lds + MOE_OFF);
    if (C.tid == 0) { const unsigned* CNT = (const unsigned*)(a.ws + WS_CTL) + CW_CNT; int acc = 0;
        for (int e = 0; e < NEXP; ++e) { ts[e] = acc; const unsigned c = __hip_atomic_load(CNT + e, __ATOMIC_RELAXED, __HIP_MEMORY_SCOPE_AGENT); ts[33 + e] = (int)c; acc += (int)((c + 255u) >> 8); }
        ts[NEXP] = acc; }
    __syncthreads();
}
__device__ __forceinline__ void ph_final(const Args& a, const Ctx& C, float* outp) {
    unsigned char* ws = a.ws;
    const unsigned char* YB = ws + WS_A; const float* TOKG = (const float*)(ws + WS_TOK + TOK_G); const int* TOKE = (const int*)(ws + WS_TOK + TOK_E); const int* TOKR = (const int*)(ws + WS_TOK + TOK_R);
    const LAS int* ts = (const LAS int*)(C.lds + MOE_OFF);
    const bf16_t* H2B = (const bf16_t*)a.out + DM; const float* gf = a.in[26];
    const int gw = C.vcu * 8 + C.wave, NGW = C.G * 8, lane = C.lane;
    f32x4 gn[4];
#pragma unroll
    for (int q = 0; q < 4; ++q) gn[q] = *(const f32x4*)(gf + 512 * (q >> 1) + 8 * lane + 4 * (q & 1));
    const int nit = (NTOK + NGW - 1) / NGW;
    int dnx = 0; float gnx = 0.f;
#define FIN_IDX(ib) do { const int tt_ = gw + ((ib) + (lane >> 1)) * NGW; dnx = 0; gnx = 0.f; \
        if (lane < 8 && tt_ < NTOK) { const int e_ = TOKE[2 * tt_ + (lane & 1)]; dnx = ts[e_] * 256 + TOKR[2 * tt_ + (lane & 1)]; gnx = TOKG[2 * tt_ + (lane & 1)]; } } while (0)
    FIN_IDX(0);
    for (int ib = 0; ib < nit; ib += 4) {
        const int dcur = dnx; const float gcur = gnx;
        if (ib + 4 < nit) FIN_IDX(ib + 4);
        u32x4 hw[4][2]; u32x2 y0[4][2], y1[4][2];
#pragma unroll
        for (int j = 0; j < 4; ++j) { const int t = gw + (ib + j) * NGW; const int d0 = __builtin_amdgcn_readlane(dcur, 2 * j), d1 = __builtin_amdgcn_readlane(dcur, 2 * j + 1);
            if (t < NTOK) {
#pragma unroll
                for (int hf = 0; hf < 2; ++hf) { hw[j][hf] = *((const u32x4*)(H2B + (size_t)t * LDH + 512 * hf) + lane); y0[j][hf] = *((const u32x2*)(YB + (size_t)d0 * DM + 512 * hf) + lane); y1[j][hf] = *((const u32x2*)(YB + (size_t)d1 * DM + 512 * hf) + lane); } } }
#pragma unroll
        for (int j = 0; j < 4; ++j) { const int t = gw + (ib + j) * NGW;
            const float g0 = __builtin_bit_cast(float, __builtin_amdgcn_readlane(__builtin_bit_cast(int, gcur), 2 * j)) * (1.0f / YB_SC), g1 = __builtin_bit_cast(float, __builtin_amdgcn_readlane(__builtin_bit_cast(int, gcur), 2 * j + 1)) * (1.0f / YB_SC);
            if (t < NTOK) { float v[16]; float s2 = 0.f;
#pragma unroll
                for (int hf = 0; hf < 2; ++hf)
#pragma unroll
                    for (int w = 0; w < 2; ++w) { const int yw0 = (int)y0[j][hf][w], yw1 = (int)y1[j][hf][w];
                        const f32x2 pa = __builtin_amdgcn_cvt_pk_f32_fp8(yw0, false), pb = __builtin_amdgcn_cvt_pk_f32_fp8(yw0, true), qa = __builtin_amdgcn_cvt_pk_f32_fp8(yw1, false), qb = __builtin_amdgcn_cvt_pk_f32_fp8(yw1, true);
                        const unsigned ha = hw[j][hf][2 * w], hb = hw[j][hf][2 * w + 1];
                        const float e0 = bflo(ha) + g0 * pa[0] + g1 * qa[0], e1 = bfhi(ha) + g0 * pa[1] + g1 * qa[1], e2 = bflo(hb) + g0 * pb[0] + g1 * qb[0], e3 = bfhi(hb) + g0 * pb[1] + g1 * qb[1];
                        v[8 * hf + 4 * w] = e0; v[8 * hf + 4 * w + 1] = e1; v[8 * hf + 4 * w + 2] = e2; v[8 * hf + 4 * w + 3] = e3; s2 += (e0 * e0 + e1 * e1) + (e2 * e2 + e3 * e3); }
                const float rstd = __builtin_amdgcn_rsqf(wave_sum(s2) * (1.0f / DM) + EPS);
#pragma unroll
                for (int q = 0; q < 4; ++q) { const f32x4 o = {v[4 * q] * rstd * gn[q][0], v[4 * q + 1] * rstd * gn[q][1], v[4 * q + 2] * rstd * gn[q][2], v[4 * q + 3] * rstd * gn[q][3]};
                    *(f32x4*)(outp + (size_t)t * DM + 512 * (q >> 1) + 8 * lane + 4 * (q & 1)) = o; } } }
    }
#undef FIN_IDX
}

#include <hip/hip_bf16.h>
#include <cmath>
namespace attn_body {
using bf16=__hip_bfloat16;
using bf16x8=__attribute__((ext_vector_type(8)))short;
using s16x4=__attribute__((ext_vector_type(4)))short;
using f32x16=__attribute__((ext_vector_type(16)))float;
using u32x4=__attribute__((ext_vector_type(4)))unsigned;
using f32x4_t=__attribute__((ext_vector_type(4)))float;
constexpr int BATCH=16,NHEAD=8,SEQ=2048,D=64,DM=NHEAD*D,DMO=1024;
constexpr int NW=8,QBLK=32,QB=QBLK*NW,KVBLK=64,NQB=SEQ/QB;
constexpr int ATTN_PITCH=DM, ATTN_UNIT_ROWS=QB;
__device__ __forceinline__ int crow(int r,int hi){return (r&3)+8*(r>>2)+4*hi;}
#define SBAR() __builtin_amdgcn_sched_barrier(0)
__device__ __forceinline__ void cmask(f32x16&p0,f32x16&p1,int jb,int qrel,int hi){
  const float NEG=-INFINITY; int kb=64*jb+4*hi; asm volatile("":"+v"(kb));
  #pragma unroll
  for(int r=0;r<16;++r){int kv=kb+(r&3)+8*(r>>2); if(kv>qrel)p0[r]=NEG; if(kv+32>qrel)p1[r]=NEG;}
}

constexpr int NSLOT=3, SLOTB=8192;
constexpr int LDS_K=0, LDS_V=NSLOT*SLOTB, LDS_WS=2*NSLOT*SLOTB, LDS_OST=LDS_WS+NW*64*4, LDS_BYTES=LDS_OST+NW*4096;
constexpr float C2=0.125f*1.4426950408889634f;
__device__ __forceinline__ void glds16(const char*sbase,unsigned voff,unsigned lds_dst){unsigned keep;
  asm volatile("s_nop 4\n\ts_mov_b32 %0, m0\n\ts_mov_b32 m0, %3\n\ts_nop 0\n\tglobal_load_lds_dwordx4 %1, %2\n\ts_mov_b32 m0, %0":"=&s"(keep):"v"(voff),"s"(sbase),"s"(lds_dst):"memory");}
__device__ __forceinline__ const char* uni_ptr(const void*p){const unsigned long long v=(unsigned long long)p;const unsigned lo=__builtin_amdgcn_readfirstlane((unsigned)v),hi=__builtin_amdgcn_readfirstlane((unsigned)(v>>32));return (const char*)(((unsigned long long)hi<<32)|lo);}
__device__ __forceinline__ float max3f(float a,float b,float c){float r;asm("v_max3_f32 %0, %1, %2, %3":"=v"(r):"v"(a),"v"(b),"v"(c));return r;}
__device__ __forceinline__ float max2f(float a,float b){float r;asm("v_max_f32_e32 %0, %1, %2":"=v"(r):"v"(a),"v"(b));return r;}
__device__ __forceinline__ float fadd_s(float a,float b){float r;asm("v_add_f32_e32 %0, %1, %2":"=v"(r):"v"(a),"v"(b));return r;}
__device__ __forceinline__ float fsub_s(float a,float b){float r;asm("v_sub_f32_e32 %0, %1, %2":"=v"(r):"v"(a),"v"(b));return r;}
typedef float f32x2_t __attribute__((ext_vector_type(2))); typedef __bf16 bf16x2_t __attribute__((ext_vector_type(2)));
__device__ __forceinline__ unsigned cvtpk_s(float lo,float hi){f32x2_t v={lo,hi};bf16x2_t b=__builtin_convertvector(v,bf16x2_t);return __builtin_bit_cast(unsigned,b);}
#define WAIT_BAR(N) asm volatile("s_waitcnt vmcnt(" #N ") lgkmcnt(0)\n\ts_barrier":::"memory")

__device__ __forceinline__ void qkt(f32x16&p0,f32x16&p1,const char*Kslot,const bf16x8*qr,const f32x16&negm,int r32,int hi){
  const char*kb=Kslot+hi*1024+r32*16;
  #pragma unroll
  for(int d0=0;d0<4;++d0){
    const bf16x8 b0=*reinterpret_cast<const bf16x8*>(kb+d0*2048);
    const bf16x8 b1=*reinterpret_cast<const bf16x8*>(kb+d0*2048+512);
    if(d0==0){p0=__builtin_amdgcn_mfma_f32_32x32x16_bf16(b0,qr[0],negm,0,0,0);p1=__builtin_amdgcn_mfma_f32_32x32x16_bf16(b1,qr[0],negm,0,0,0);}
    else{p0=__builtin_amdgcn_mfma_f32_32x32x16_bf16(b0,qr[d0],p0,0,0,0);p1=__builtin_amdgcn_mfma_f32_32x32x16_bf16(b1,qr[d0],p1,0,0,0);}}
}
typedef __attribute__((address_space(3))) const char* lds_cptr;
typedef short v4i16_t __attribute__((ext_vector_type(4)));
__device__ __forceinline__ void kload8(bf16x8*kf,lds_cptr kp){
  kf[0]=*(const __attribute__((address_space(3))) bf16x8*)(kp);      kf[1]=*(const __attribute__((address_space(3))) bf16x8*)(kp+512);
  kf[2]=*(const __attribute__((address_space(3))) bf16x8*)(kp+2048); kf[3]=*(const __attribute__((address_space(3))) bf16x8*)(kp+2560);
  kf[4]=*(const __attribute__((address_space(3))) bf16x8*)(kp+4096); kf[5]=*(const __attribute__((address_space(3))) bf16x8*)(kp+4608);
  kf[6]=*(const __attribute__((address_space(3))) bf16x8*)(kp+6144); kf[7]=*(const __attribute__((address_space(3))) bf16x8*)(kp+6656);
}
__device__ __forceinline__ void kload2(bf16x8*kf,lds_cptr kp,int j){ kf[2*j]=*(const __attribute__((address_space(3))) bf16x8*)(kp+j*2048); kf[2*j+1]=*(const __attribute__((address_space(3))) bf16x8*)(kp+j*2048+512); }
__device__ __forceinline__ s16x4 vtr(lds_cptr p){ return __builtin_bit_cast(s16x4,__builtin_amdgcn_ds_read_tr16_b64_v4i16((__attribute__((address_space(3))) v4i16_t*)p)); }
__device__ __forceinline__ float rowmax(const f32x16&p0,const f32x16&p1){
  float a=max3f(p0[0],p0[1],p1[0]),b=max3f(p0[2],p0[3],p1[1]);a=max3f(a,p1[2],p1[3]);
  #pragma unroll
  for(int r=4;r<16;r+=4){a=max3f(a,p0[r],p0[r+1]);b=max3f(b,p0[r+2],p0[r+3]);a=max3f(a,p1[r],p1[r+1]);b=max3f(b,p1[r+2],p1[r+3]);}
  const float m=max2f(a,b);
  auto rr=__builtin_amdgcn_permlane32_swap(__float_as_uint(m),__float_as_uint(m),false,false);
  return max2f(__uint_as_float(rr[0]),__uint_as_float(rr[1]));
}
__device__ __forceinline__ void pv(f32x16*o,int vb,bf16x8 pa0,bf16x8 pa1,bf16x8 pa2,bf16x8 pa3){
  #pragma unroll
  for(int d0=0;d0<2;++d0){s16x4 lo[4],hi[4];
    #pragma unroll
    for(int ks=0;ks<4;++ks){
      asm volatile("ds_read_b64_tr_b16 %0,%1 offset:%c2":"=&v"(lo[ks]):"v"(vb),"i"(d0*4096+ks*1024):"memory");
      asm volatile("ds_read_b64_tr_b16 %0,%1 offset:%c2":"=&v"(hi[ks]):"v"(vb),"i"(d0*4096+ks*1024+512):"memory");}
    asm volatile("s_waitcnt lgkmcnt(0)":::"memory");SBAR();
    #define PK(k) (bf16x8){lo[k][0],lo[k][1],lo[k][2],lo[k][3],hi[k][0],hi[k][1],hi[k][2],hi[k][3]}
    o[d0]=__builtin_amdgcn_mfma_f32_32x32x16_bf16(pa0,PK(0),o[d0],0,0,0);
    o[d0]=__builtin_amdgcn_mfma_f32_32x32x16_bf16(pa1,PK(1),o[d0],0,0,0);
    o[d0]=__builtin_amdgcn_mfma_f32_32x32x16_bf16(pa2,PK(2),o[d0],0,0,0);
    o[d0]=__builtin_amdgcn_mfma_f32_32x32x16_bf16(pa3,PK(3),o[d0],0,0,0);
    #undef PK
  }
}

#ifndef ATTN_STORE16
#define ATTN_STORE16(p,v) (*(u32x4*)(p)=(v))
#endif
template<int THRL> __device__ __forceinline__ void attn_unit(int b,int h,int qb,const bf16*Q,const bf16*__restrict__ K,const bf16*__restrict__ V,bf16*O,const float*__restrict__ KSUM,float*__restrict__ SSQA,char*shm){
  int tid=threadIdx.x; asm volatile("":"+v"(tid));
  const int lane=tid&63,r32=lane&31,hi=lane>>5; const int wid=__builtin_amdgcn_readfirstlane(tid>>6);
  const long rowbase=(long)b*SEQ; const int q0=qb*QB;
  const bf16*Qw=Q+(rowbase+q0+wid*QBLK)*DM+h*D;
  const bf16*Kh=K+rowbase*DM+h*D,*Vh=V+rowbase*DM+h*D;
  const unsigned lds0=(unsigned)(uintptr_t)shm;
  float*wsf=(float*)(shm+LDS_WS)+wid*64;
  const char*Khu=uni_ptr(Kh);const char*Vhu=uni_ptr(Vh);
  const unsigned kvo=(unsigned)(lane*DM+wid*8)*2u;
  const unsigned vvo=(unsigned)((16*(wid&3)+(lane>>2))*DM+(wid>>2)*32+(lane&3)*8)*2u;
  const unsigned kdst=lds0+LDS_K+wid*1024, vdst=lds0+LDS_V+wid*1024;
  #define DMA_K(t,slot) glds16(Khu+(size_t)(t)*(KVBLK*DM*2),kvo,(unsigned)__builtin_amdgcn_readfirstlane(kdst+(slot)))
  #define DMA_V(t,slot) glds16(Vhu+(size_t)(t)*(KVBLK*DM*2),vvo,(unsigned)__builtin_amdgcn_readfirstlane(vdst+(slot)))
  const int vb0=(int)(lds0+LDS_V)+((lane>>4)&1)*32+(lane&3)*8+(4*hi+((lane&15)>>2))*64;
  const char*Kbase=shm+LDS_K; bf16x8 kf[8];
  const lds_cptr shm3=(lds_cptr)shm; const lds_cptr kp0=shm3+LDS_K+hi*1024+r32*16; const lds_cptr vp0=shm3+LDS_V+((lane>>4)&1)*32+(lane&3)*8+(4*hi+((lane&15)>>2))*64;
  const int NT=(q0+QB)/KVBLK;
  DMA_K(0,0);DMA_V(0,0);DMA_K(1,SLOTB);
  bf16x8 qr[4];
  #pragma unroll
  for(int d0=0;d0<4;++d0)qr[d0]=*reinterpret_cast<const bf16x8*>(&Qw[(long)r32*DM+d0*16+hi*8]);
  unsigned selm=1u<<qb;
  { float g[8];
    #pragma unroll
    for(int n=0;n<8;++n){ g[n]=-INFINITY;
      if(n<qb){ const float*ks=KSUM+(long)(b*8+n)*DM+h*D+hi*8; float s=0.f;
        #pragma unroll
        for(int d0=0;d0<4;++d0){ const f32x4_t k0=*reinterpret_cast<const f32x4_t*>(ks+d0*16), k1=*reinterpret_cast<const f32x4_t*>(ks+d0*16+4);
          const u32x4 qw=__builtin_bit_cast(u32x4,qr[d0]);
          s+=__uint_as_float(qw[0]<<16)*k0[0]+__uint_as_float(qw[0]&0xffff0000u)*k0[1]+__uint_as_float(qw[1]<<16)*k0[2]+__uint_as_float(qw[1]&0xffff0000u)*k0[3]
            +__uint_as_float(qw[2]<<16)*k1[0]+__uint_as_float(qw[2]&0xffff0000u)*k1[1]+__uint_as_float(qw[3]<<16)*k1[2]+__uint_as_float(qw[3]&0xffff0000u)*k1[3]; }
        s+=__shfl_xor(s,32); g[n]=s; } }
    const int npick=qb<3?qb:3;
    for(int p=0;p<npick;++p){ int best=-1; float bv=-INFINITY;
      #pragma unroll
      for(int n=0;n<8;++n){ const bool ok=(n<qb)&&!((selm>>n)&1u)&&(best<0||g[n]>bv); if(ok){best=n;bv=g[n];} }
      if(best>=0)selm|=1u<<best; } }
  #define BMASK(P0,P1,t) do{ float bias_=((selm>>((t)>>2))&1u)?-mhat:-INFINITY; asm volatile("":"+v"(bias_)); _Pragma("unroll") for(int r=0;r<16;++r){P0[r]+=bias_;P1[r]+=bias_;} }while(0)
  float mhat=0.f,l_reg=0.f;f32x16 o[2];{float z0_=0.f;asm volatile("":"+v"(z0_));_Pragma("unroll") for(int r=0;r<16;++r){o[0][r]=z0_;o[1][r]=z0_;}}const f32x16 negm=f32x16{};
  const int qrel=wid*QBLK+r32;
  #define CMASK(P0,P1,t) do{int jb_=(t)-(NT-4); if(jb_>=0)cmask(P0,P1,jb_,qrel,hi);}while(0)
  bool resc=false;
  #define START(P0,P1) do{ const float rm=__builtin_fmaxf(rowmax(P0,P1),-100.0f); resc=false; \
    { const float dl=rm; mhat=fadd_s(mhat,dl); \
      _Pragma("unroll") for(int r=0;r<16;++r){P0[r]=fsub_s(P0[r],dl);P1[r]=fsub_s(P1[r],dl);} \
      } \
    _Pragma("unroll") for(int r=0;r<16;++r)P0[r]=__builtin_amdgcn_exp2f(P0[r]); }while(0)
  #define RESC() do{ if(resc){ asm volatile("s_waitcnt lgkmcnt(0)":::"memory"); \
      _Pragma("unroll") for(int d_=0;d_<2;++d_) _Pragma("unroll") for(int r=0;r<16;++r)o[d_][r]*=wsf[crow(r,hi)]; } }while(0)
  f32x16 pA0,pA1,pB0,pB1;
  int sl_prev=0,sl_cur=0,sl_next=SLOTB;
  #define ROT() do{sl_prev=sl_cur;sl_cur=sl_next;sl_next=(sl_next==(NSLOT-1)*SLOTB)?0:sl_next+SLOTB;}while(0)
  DMA_K(2,2*SLOTB);
  WAIT_BAR(3);
  qkt(pA0,pA1,Kbase,qr,negm,r32,hi);asm volatile("s_nop 15\n\ts_nop 7":"+v"(pA0),"+v"(pA1));CMASK(pA0,pA1,0);BMASK(pA0,pA1,0);
  START(pA0,pA1);
  _Pragma("unroll") for(int r=0;r<16;++r)pA1[r]=__builtin_amdgcn_exp2f(pA1[r]);
  WAIT_BAR(0);
  DMA_K(3,0);DMA_V(1,SLOTB);
  ROT();
  kload8(kf,kp0+sl_cur);
  WAIT_BAR(2);
  s16x4 vlo[8],vhi[8]; u32x4 pw0,pw1,pw2,pw3;
  #define PKW(P,B) cvtpk_s(P[B],P[B+1])
  #define PAF(k) __builtin_bit_cast(bf16x8,pw##k)
  #define VFR(i) (bf16x8){vlo[i][0],vlo[i][1],vlo[i][2],vlo[i][3],vhi[i][0],vhi[i][1],vhi[i][2],vhi[i][3]}
  #define PIN(x) asm volatile("":"+v"(x))
  #define MX3(a,b,c) __builtin_fmaxf(__builtin_fmaxf((a),(b)),(c))
  #define GAPA(MF,A0,A1,A2,A3,W0,W1,PW) do{ MF; sacc+=A0; sacc+=A1; sacc+=A2; sacc+=A3; PIN(sacc); W0; W1; PIN(PW); SBAR(); }while(0)
  #define EX(v) __builtin_amdgcn_exp2f(v)
  #define GAPB(MF,X,B) do{ MF; X[B]=EX(X[B]); X[B+1]=EX(X[B+1]); X[B+2]=EX(X[B+2]); X[B+3]=EX(X[B+3]); PIN(X); SBAR(); }while(0)
  #define VRD(i) do{ vlo[i]=vtr(vp_+(((i)>>2)*4096+((i)&3)*1024)); vhi[i]=vtr(vp_+(((i)>>2)*4096+((i)&3)*1024+512)); }while(0)
  #define KRD(G,j) do{ if(G){ kload2(kf,kp0+sl_next,j); SBAR(); } }while(0)
  #define STEP(C0,C1,P0,P1,t,GK,GV,GL) do{ SBAR(); \
    const lds_cptr vp_=vp0+sl_prev; \
    VRD(0); SBAR(); float sacc=(P0[0]+P0[1]); \
    GAPA(C0=__builtin_amdgcn_mfma_f32_32x32x16_bf16(kf[0],qr[0],negm,0,0,0), P0[2],P0[3],P0[4],P0[5],     pw0[0]=PKW(P0,0), pw0[1]=PKW(P0,2), pw0); \
    VRD(4); SBAR(); GAPA(C1=__builtin_amdgcn_mfma_f32_32x32x16_bf16(kf[1],qr[0],negm,0,0,0), P0[6],P0[7],P0[8],P0[9],     pw0[2]=PKW(P0,4), pw0[3]=PKW(P0,6), pw0); \
    VRD(1); SBAR(); GAPA(C0=__builtin_amdgcn_mfma_f32_32x32x16_bf16(kf[2],qr[1],C0,0,0,0),   P0[10],P0[11],P0[12],P0[13], pw1[0]=PKW(P0,8), pw1[1]=PKW(P0,10), pw1); \
    VRD(5); SBAR(); GAPA(C1=__builtin_amdgcn_mfma_f32_32x32x16_bf16(kf[3],qr[1],C1,0,0,0),   P0[14],P0[15],P1[0],P1[1],   pw1[2]=PKW(P0,12),pw1[3]=PKW(P0,14), pw1); \
    VRD(2); SBAR(); GAPA(C0=__builtin_amdgcn_mfma_f32_32x32x16_bf16(kf[4],qr[2],C0,0,0,0),   P1[2],P1[3],P1[4],P1[5],     pw2[0]=PKW(P1,0), pw2[1]=PKW(P1,2), pw2); \
    VRD(6); SBAR(); GAPA(C1=__builtin_amdgcn_mfma_f32_32x32x16_bf16(kf[5],qr[2],C1,0,0,0),   P1[6],P1[7],P1[8],P1[9],     pw2[2]=PKW(P1,4), pw2[3]=PKW(P1,6), pw2); \
    VRD(3); SBAR(); GAPA(C0=__builtin_amdgcn_mfma_f32_32x32x16_bf16(kf[6],qr[3],C0,0,0,0),   P1[10],P1[11],P1[12],P1[13], pw3[0]=PKW(P1,8), pw3[1]=PKW(P1,10), pw3); \
    VRD(7); SBAR(); GAPA(C1=__builtin_amdgcn_mfma_f32_32x32x16_bf16(kf[7],qr[3],C1,0,0,0),   P1[14],P1[15],0.f,0.f,       pw3[2]=PKW(P1,12),pw3[3]=PKW(P1,14), pw3); \
    l_reg+=sacc; \
    if(GK){DMA_K((t)+3,sl_cur);} if(GV){DMA_V((t)+1,sl_next);} \
    CMASK(C0,C1,t); BMASK(C0,C1,t); \
    { float a=MX3(C0[0],C0[1],C1[0]),b=MX3(C0[2],C0[3],C1[1]); a=MX3(a,C1[2],C1[3]); \
      _Pragma("unroll") for(int r=4;r<16;r+=4){a=MX3(a,C0[r],C0[r+1]);b=MX3(b,C0[r+2],C0[r+3]);a=MX3(a,C1[r],C1[r+1]);b=MX3(b,C1[r+2],C1[r+3]);} \
      float rm=__builtin_fmaxf(a,b); { auto rr=__builtin_amdgcn_permlane32_swap(__float_as_uint(rm),__float_as_uint(rm),false,false); rm=__builtin_fmaxf(__uint_as_float(rr[0]),__uint_as_float(rr[1])); } \
      resc=false; \
      if(__builtin_expect(__any(rm>(float)THRL),0)){ const float dl=__builtin_fmaxf(rm,0.f); mhat+=dl; \
        _Pragma("unroll") for(int r=0;r<16;++r){C0[r]-=dl;C1[r]-=dl;} \
        const float f=__builtin_amdgcn_exp2f(-dl); l_reg*=f; if(hi==0)wsf[r32]=f; resc=true; } } \
    SBAR(); \
    GAPB(o[0]=__builtin_amdgcn_mfma_f32_32x32x16_bf16(PAF(0),VFR(0),o[0],0,0,0), C0,0); \
    GAPB(o[1]=__builtin_amdgcn_mfma_f32_32x32x16_bf16(PAF(0),VFR(4),o[1],0,0,0), C0,4); \
    KRD(GL,0); GAPB(o[0]=__builtin_amdgcn_mfma_f32_32x32x16_bf16(PAF(1),VFR(1),o[0],0,0,0), C0,8); \
    KRD(GL,1); GAPB(o[1]=__builtin_amdgcn_mfma_f32_32x32x16_bf16(PAF(1),VFR(5),o[1],0,0,0), C0,12); \
    KRD(GL,2); GAPB(o[0]=__builtin_amdgcn_mfma_f32_32x32x16_bf16(PAF(2),VFR(2),o[0],0,0,0), C1,0); \
    KRD(GL,3); GAPB(o[1]=__builtin_amdgcn_mfma_f32_32x32x16_bf16(PAF(2),VFR(6),o[1],0,0,0), C1,4); \
    GAPB(o[0]=__builtin_amdgcn_mfma_f32_32x32x16_bf16(PAF(3),VFR(3),o[0],0,0,0), C1,8); \
    GAPB(o[1]=__builtin_amdgcn_mfma_f32_32x32x16_bf16(PAF(3),VFR(7),o[1],0,0,0), C1,12); \
    }while(0)
  int t=1;
  #undef CMASK
  #define CMASK(P0,P1,t) do{}while(0)
  for(;t+5<NT;t+=2){
    STEP(pB0,pB1,pA0,pA1,t,true,true,true);     WAIT_BAR(2); RESC(); ROT();
    STEP(pA0,pA1,pB0,pB1,t+1,true,true,true);   WAIT_BAR(2); RESC(); ROT();
  }
  #undef CMASK
  #define CMASK(P0,P1,t) do{int jb_=(t)-(NT-4); if(jb_>=0)cmask(P0,P1,jb_,qrel,hi);}while(0)
  #define ENDW(tt) do{ if((tt)+3<NT){WAIT_BAR(2);} else if((tt)+2<NT){WAIT_BAR(1);} else {WAIT_BAR(0);} }while(0)
  for(;t+1<NT;t+=2){
    STEP(pB0,pB1,pA0,pA1,t,(t+3<NT),(t+1<NT),(t+1<NT));       ENDW(t);   RESC(); ROT();
    STEP(pA0,pA1,pB0,pB1,t+1,(t+4<NT),(t+2<NT),(t+2<NT));     ENDW(t+1); RESC(); ROT();
  }
  STEP(pB0,pB1,pA0,pA1,NT-1,false,false,false); RESC();
  { float sacc=pB0[0]+pB0[1]; _Pragma("unroll") for(int r=2;r<16;++r)sacc+=pB0[r]; _Pragma("unroll") for(int r=0;r<16;++r)sacc+=pB1[r]; l_reg+=sacc;
    pw0=(u32x4){PKW(pB0,0),PKW(pB0,2),PKW(pB0,4),PKW(pB0,6)};pw1=(u32x4){PKW(pB0,8),PKW(pB0,10),PKW(pB0,12),PKW(pB0,14)};pw2=(u32x4){PKW(pB1,0),PKW(pB1,2),PKW(pB1,4),PKW(pB1,6)};pw3=(u32x4){PKW(pB1,8),PKW(pB1,10),PKW(pB1,12),PKW(pB1,14)};
    SBAR(); pv(o,vb0+sl_cur,PAF(0),PAF(1),PAF(2),PAF(3)); }
  #undef PKW
  #undef PAF
  #undef VFR
  #undef PIN
  #undef MX3
  #undef GAPA
  #undef GAPB
  #undef EX
  #undef VRD
  #undef KRD
  #undef STEP
  #undef ENDW
  {auto rr=__builtin_amdgcn_permlane32_swap(__float_as_uint(l_reg),__float_as_uint(l_reg),false,false);l_reg=__uint_as_float(rr[0])+__uint_as_float(rr[1]);}
  if(hi==0)wsf[32+r32]=l_reg;asm volatile("s_waitcnt lgkmcnt(0)":::"memory");
  float rli[16];
  #pragma unroll
  for(int r=0;r<16;++r)rli[r]=__builtin_amdgcn_rcpf(wsf[32+crow(r,hi)]);
  bf16*Ow=O+(rowbase+q0+wid*QBLK)*DMO+h*D;
  { bf16*stg=(bf16*)(shm+LDS_OST)+wid*2048;
    #pragma unroll
    for(int r=0;r<16;++r){const int orow=crow(r,hi);
      #pragma unroll
      for(int d0=0;d0<2;++d0)stg[orow*64+d0*32+r32]=__float2bfloat16(o[d0][r]*rli[r]);}
    asm volatile("s_waitcnt lgkmcnt(0)":::"memory");
    #pragma unroll
    for(int i=0;i<4;++i){const int row=i*8+(lane>>3),ch=lane&7; const u32x4 v=*(const u32x4*)(stg+row*64+ch*8); ATTN_STORE16(Ow+(long)row*DMO+ch*8,v);
      float q=0.f;
      #pragma unroll
      for(int e=0;e<4;++e){const float lo=__uint_as_float(v[e]<<16),hi2=__uint_as_float(v[e]&0xffff0000u);q+=lo*lo+hi2*hi2;}
      q+=__shfl_xor(q,1);q+=__shfl_xor(q,2);q+=__shfl_xor(q,4);
      if(ch==0)SSQA[(rowbase+q0+wid*QBLK+row)*8+h]=q;} }
  asm volatile("s_waitcnt lgkmcnt(0)\n\ts_barrier":::"memory");
  #undef BMASK
  #undef DMA_K
  #undef DMA_V
  #undef CMASK
  #undef START
  #undef RESC
  #undef ROT
}
constexpr int ATTN_LDS_BYTES=LDS_BYTES;
#undef SBAR
#undef WAIT_BAR
}

#ifndef STAG_TICKS
#define STAG_TICKS 100
#endif
__device__ __forceinline__ void stagger(int c, int ticks) {
    const unsigned long long t0 = __builtin_amdgcn_s_memrealtime(); const unsigned long long w = (unsigned long long)(((c >> 3) & 3) * ticks);
    while (__builtin_amdgcn_s_memrealtime() - t0 < w) __builtin_amdgcn_s_sleep(8);
}
__global__ void __launch_bounds__(512, 2) mk_fwd(Args args) {
    extern __shared__ __attribute__((aligned(16))) unsigned char lds_raw[];
    Ctx C; C.lds = (LAS unsigned char*)lds_raw; C.tid = threadIdx.x; C.lane = C.tid & 63; C.wave = __builtin_amdgcn_readfirstlane(C.tid >> 6);
    C.G = gridDim.x; { const int bx = blockIdx.x; C.vcu = (C.G % 8 == 0) ? (bx % 8) * (C.G / 8) + bx / 8 : bx; }
    unsigned char* ws = args.ws;
    for (int u = C.tid; u < (LDS_BYTES - LDSCTL_OFF) / 4; u += 512) ((LAS unsigned*)(C.lds + LDSCTL_OFF))[u] = 0u;
    __syncthreads();
    XcdBarrier bar; bar.bar = (unsigned*)(ws + WS_CTL) + CW_BAR; bar.x = 0; bar.st = nullptr;
    if (N_LAUNCHES == 1) bar = xcd_barrier_post((unsigned*)(ws + WS_CTL) + CW_BAR, (volatile LAS unsigned*)(C.lds + MISC_OFF) + 8);
    const int lo = args.ph_lo, hi = args.ph_hi;
#ifndef PH_MASK
#define PH_MASK 0x3fff
#endif
#define IN(k) ((((PH_MASK) >> (k)) & 1) && lo <= (k) && (k) < hi)
#ifndef PROBE_REP
#define PROBE_REP -1
#endif
#define REP(k) for (int rep_ = 0; rep_ < ((PROBE_REP == (k)) ? 2 : 1); ++rep_)
#define REPBAR() do { if (rep_ > 0) xcd_barrier(bar); } while (0)
#define FRESH() do { int t_ = threadIdx.x; asm volatile("" : "+v"(t_)); C.tid = t_; C.lane = t_ & 63; C.wave = __builtin_amdgcn_readfirstlane(t_ >> 6); } while (0)
#define SEAM(k) do { if (IN(k) && IN((k) + 1)) xcd_barrier(bar); } while (0)
    const int cb = (int)blockIdx.x;

    if (IN(0)) REP(0) { REPBAR(); FRESH(); ph_prologue(args, C); SEAM(0); }
    if (PROBE_REP == 200) { for (int xb_ = 0; xb_ < 8; ++xb_) xcd_barrier(bar); }
    if (IN(1)) REP(1) { REPBAR();
        { Gemm g{(const bf16_t*)(ws + WS_B), (const bf16_t*)(ws + WS_WIN), DM, DM, DM}; PlainOrder S; S.init(NTOK, DIN, C.G, cb, DM, DM);
          EpiProj E{(bf16_t*)(ws + WS_A), (const float*)(ws + WS_ROPE), (float*)(ws + WS_KSUM)}; GEMM_PHASE(C.lds, g, S, E); }
        { Gemm g{(const bf16_t*)(ws + WS_MEMN), (const bf16_t*)(ws + WS_WXK), DM, DM, DM}; PlainOrder S; S.init(NMEM, DM, C.G, cb, DM, DM);
          EpiStore E{(bf16_t*)(ws + WS_KM), DM}; GEMM_PHASE(C.lds, g, S, E); }
        { Gemm g{(const bf16_t*)(ws + WS_MEMN), (const bf16_t*)(ws + WS_WXV), DM, DM, DM}; PlainOrder S; S.init(NMEM, DM, C.G, (cb + C.G - 64 % C.G) % C.G, DM, DM);
          EpiStore E{(bf16_t*)(ws + WS_VMT), DM}; GEMM_PHASE(C.lds, g, S, E); }
        { FRESH(); if (C.G == 256) { if (cb >= 128) conv_wdn(args, C, (cb - 128) * 8 + C.wave, 128 * 8, 0, WDN_SPLIT); }
          else conv_wdn(args, C, C.vcu * 8 + C.wave, C.G * 8, 0, WDN_SPLIT); }
        SEAM(1);
    }
    if (IN(2)) REP(2) { REPBAR(); FRESH();
        for (int lrep_ = 0; lrep_ < ((PROBE_REP == 102) ? 2 : 1); ++lrep_)
        for (int L = C.vcu; L < 256; L += C.G) lru_unit(args, C, L >> 4, (L >> 1) & 7, L & 1);
        for (int arep_ = 0; arep_ < ((PROBE_REP == 103) ? 2 : 1); ++arep_)
        for (int i = 0;; ++i) { const int aidx = i * C.G + C.vcu; if (aidx >= 1024) break; const int cc = aidx & 255, ii = aidx >> 8, bh = cc >> 1;
            const int qb = (cc & 1) ? ((ii == 0) ? 6 : (ii == 1) ? 1 : (ii == 2) ? 5 : 2) : ((ii == 0) ? 7 : (ii == 1) ? 0 : (ii == 2) ? 4 : 3);
#ifdef ATTN_SIMPLE
            moba_unit_simple(args, C, bh >> 3, bh & 7, qb); }
#else
            { const attn_body::bf16* Qp = (const attn_body::bf16*)(ws + WS_A) + (size_t)2 * NTOK * 512;
              attn_body::attn_unit<8>(bh >> 3, bh & 7, qb, Qp, Qp + (size_t)NTOK * 512, Qp + (size_t)2 * NTOK * 512, (attn_body::bf16*)(ws + WS_C) + 512, (const float*)(ws + WS_KSUM), (float*)(ws + WS_SSQA), (char*)lds_raw); } }
#endif
        SEAM(2);
    }
    if (IN(4)) REP(4) { REPBAR(); Gemm g{(const bf16_t*)(ws + WS_C), (const bf16_t*)(ws + WS_WOUT), DM, DM, DM}; PlainOrder S; S.init(NTOK, DM, C.G, cb, DM, DM);
        EpiResid<true, true> E{(const bf16_t*)(ws + WS_B), (bf16_t*)args.out, (float*)(ws + WS_SSQ1), (const float*)(ws + WS_SSQL), (const float*)(ws + WS_SSQA), ws + WS_A + 64 * MiB, 1.0f, (const float*)(ws + WS_TOK + TOK_D), args.in[2]};     GEMM_PHASE(C.lds, g, S, E);
        { Gemm g2{(const bf16_t*)(ws + WS_KM), (const bf16_t*)(ws + WS_WXQ), DM, DM, XHD}; XpreOrder S2{C.G, cb, 0}; EpiStore8 E2{ws + WS_A, DM, QKT_SC}; GEMM_PHASE(C.lds, g2, S2, E2); }
        { Gemm g3{(const bf16_t*)(ws + WS_WXO), (const bf16_t*)(ws + WS_VMT), DM, DM, XHD}; XpreOrder S3{C.G, cb, 1}; EpiStore8 E3{ws + WS_A + 32 * MiB, DM, VWT_SC}; GEMM_PHASE(C.lds, g3, S3, E3); }
        SEAM(4); }
    if (IN(5)) REP(5) { REPBAR(); Gemm g{(const bf16_t*)(ws + WS_A + 64 * MiB), (const bf16_t*)(ws + WS_A), DM / 2, DM / 2, DM / 2}; XattnOrder S{C.G, cb, 0, DM / 2, DM / 2};
        EpiSoftmax E{ws + WS_A + 96 * MiB, DM, C.lds + LDSCTL_OFF + 4096, (const float*)(ws + WS_SSQ1), XSCALE / QKT_SC}; GEMM_PHASE8(C.lds, g, S, E); SEAM(5); }
    if (IN(8)) REP(8) { REPBAR(); Gemm g{(const bf16_t*)(ws + WS_A + 96 * MiB), (const bf16_t*)(ws + WS_A + 32 * MiB), DM / 2, DM / 2, DM / 2}; XattnOrder S{C.G, cb, 1, DM / 2, DM / 2};
        EpiResid<false, false> E{(const bf16_t*)args.out, (bf16_t*)args.out + DM, (float*)(ws + WS_SSQ2), nullptr, nullptr, ws + WS_H2F8, 1.0f / (PX_SC * VWT_SC)}; GEMM_PHASE8(C.lds, g, S, E); SEAM(8); }
    if (IN(9)) REP(9) { REPBAR(); FRESH(); ph_router(args, C); SEAM(9); }
    if (IN(11)) REP(11) { REPBAR(); FRESH(); moe_table(args, C); Gemm g{(const bf16_t*)(ws + WS_H2F8), (const bf16_t*)(ws + WS_WGU), DM / 2, DM / 2, DM / 2};
        MoeOrder<true> S{(const LAS int*)(C.lds + MOE_OFF), C.G, cb, DM / 2, DM / 2, (const int*)(ws + WS_LTOK), (unsigned)DM};
        EpiGateUp E{ws + WS_B, (const float*)(ws + WS_LRS)}; GEMM_PHASE8(C.lds, g, S, E); SEAM(11); }
    if (IN(12)) REP(12) { REPBAR(); FRESH(); moe_table(args, C); Gemm g{(const bf16_t*)(ws + WS_B), (const bf16_t*)(ws + WS_WDN), DFF / 2, DFF / 2, DFF / 2};
        MoeOrder<false> S{(const LAS int*)(C.lds + MOE_OFF), C.G, cb, DFF / 2, DFF / 2, nullptr, 0u};
        if (PROBE_REP == 312) { EpiNull EN{}; GEMM_PHASE8(C.lds, g, S, EN); xcd_barrier(bar); }
        EpiStore8 E{ws + WS_A, DM, YB_SC / (WDN_SC * ACT_SC)}; GEMM_PHASE8(C.lds, g, S, E); SEAM(12); }
    if (IN(13)) REP(13) { REPBAR(); FRESH(); moe_table(args, C); ph_final(args, C, (PROBE_REP == 13 && rep_ == 0) ? (float*)(ws + WS_B) : args.out); }
#undef IN
#undef FRESH
#undef SEAM
}

extern "C" void kernel_launch(void* const* d_in, const int* in_sizes, int n_in, void* d_out, int out_size, void* d_ws, size_t ws_size, hipStream_t stream) {
    static int grid = 0;
    if (grid == 0) {
        if (n_in != 27 || out_size != NTOK * DM || ws_size < WS_END) { fprintf(stderr, "kernel_launch: unexpected shapes (n_in %d out %d ws %zu)\n", n_in, out_size, ws_size); grid = -1; return; }
        int dev = 0, cus = 0, per_cu = 0;
        if (hipGetDevice(&dev) != hipSuccess || hipDeviceGetAttribute(&cus, hipDeviceAttributeMultiprocessorCount, dev) != hipSuccess) { grid = -1; return; }
        if (hipFuncSetAttribute((const void*)mk_fwd, hipFuncAttributeMaxDynamicSharedMemorySize, LDS_BYTES) != hipSuccess) { fprintf(stderr, "kernel_launch: hipFuncSetAttribute failed\n"); grid = -1; return; }
        if (hipOccupancyMaxActiveBlocksPerMultiprocessor(&per_cu, (const void*)mk_fwd, 512, LDS_BYTES) != hipSuccess || per_cu < 1) fprintf(stderr, "kernel_launch: occupancy query reports %d\n", per_cu);
        (void)hipGetLastError();
        grid = cus;
    }
    if (grid < 0) return;
    (void)hipMemsetAsync((char*)d_ws + WS_CTL, 0, CTL_ZERO_BYTES, stream);
    Args a{};
    for (int i = 0; i < 27; ++i) a.in[i] = (const float*)d_in[i];
    a.out = (float*)d_out; a.ws = (unsigned char*)d_ws;
    const float invf[8] = {1.0f, 0.1939227432012558f, 0.03760603070259094f, 0.007292664609849453f, 0.0014142135623842478f, 0.00027424818836152554f, 5.318296098266728e-05f, 1.0313386155758053e-05f};
    for (int i = 0; i < 8; ++i) a.invf[i] = invf[i];
    if (N_LAUNCHES == 1) { a.ph_lo = 0; a.ph_hi = N_PHASES; hipLaunchKernelGGL(mk_fwd, dim3(grid), dim3(512), LDS_BYTES, stream, a); }
    else for (int p = 0; p < N_PHASES; ++p) { a.ph_lo = p; a.ph_hi = p + 1; hipLaunchKernelGGL(mk_fwd, dim3(grid), dim3(512), LDS_BYTES, stream, a); }
}
```

```cpp
#include <hip/hip_runtime.h>
#include <cstdio>
#include <cstdint>

#define LAS __attribute__((address_space(3)))
#define GAS __attribute__((address_space(1)))
typedef unsigned short bf16_t;
typedef short bf16x8 __attribute__((ext_vector_type(8)));
typedef float f32x4 __attribute__((ext_vector_type(4)));
typedef float f32x2 __attribute__((ext_vector_type(2)));
typedef unsigned u32x4 __attribute__((ext_vector_type(4)));
typedef unsigned u32x2 __attribute__((ext_vector_type(2)));

#ifndef MK_N_LAUNCHES
#define MK_N_LAUNCHES 1
#endif
constexpr int N_PHASES = 14;
constexpr int N_LAUNCHES = MK_N_LAUNCHES;

constexpr int BATCH = 16, SEQ = 2048, DM = 1024, NTOK = BATCH * SEQ;
constexpr int DLRU = 512, DATT = 512, DIN = 2560, NHEAD = 8, HD = 64, NBLK = 8, MBLK = 256;
constexpr int MEMLEN = 256, NXH = 4, XHD = 256, NMEM = BATCH * MEMLEN;
constexpr int NEXP = 32, EPG = 8, NGRP = 4, DFF = 512;
constexpr float EPS = 1e-6f;
constexpr float QKT_SC = 8.0f, VWT_SC = 8.0f, PX_SC = 256.0f;
constexpr float WGU_SC = 64.0f, WDN_SC = 32.0f, ACT_SC = 16.0f, YB_SC = 16.0f;
constexpr int WDN_SPLIT = 3072;
constexpr int MAXTILES = 288, LCAP = 65536, LDH = 2048;
constexpr float QSCALE = 0.125f * 1.4426950408889634f;
constexpr float XSCALE = 0.0625f * 1.4426950408889634f;

constexpr size_t MiB = 1u << 20;
constexpr size_t WS_CTL = 0, CTL_ZERO_BYTES = 1 * MiB;
constexpr int CW_TMO = 0, CW_BAR = 4096, CW_CNT = 8192;
constexpr size_t WS_KSUM = 512 * 1024;
constexpr size_t WS_WIN = 2 * MiB, WS_WXK = 7 * MiB, WS_WXV = 9 * MiB, WS_WOUT = 11 * MiB, WS_WXQ = 13 * MiB, WS_WXO = 15 * MiB;
constexpr size_t WS_WR = 17 * MiB, WS_ROPE = 18 * MiB, WS_SSQ1 = 19 * MiB, WS_SSQ2 = 21 * MiB, WS_TOK = 23 * MiB, WS_RSC = 24 * MiB;
constexpr size_t WS_MEMN = 25 * MiB, WS_KM = 33 * MiB, WS_VMT = 41 * MiB, WS_WGU = 49 * MiB, WS_WDN = 113 * MiB;
constexpr size_t WS_A = 145 * MiB, WS_B = 305 * MiB, WS_C = 385 * MiB, WS_SSQL = 449 * MiB, WS_SSQA = 451 * MiB, WS_LTOK = 452 * MiB, WS_LRS = 460 * MiB, WS_H2F8 = 468 * MiB, WS_END = 500 * MiB;
constexpr size_t TOK_E = 0, TOK_R = 256 * 1024, TOK_G = 512 * 1024, TOK_D = 768 * 1024;

constexpr int RING_BYTES = 131072;
constexpr int LDSCTL_OFF = RING_BYTES, MISC_OFF = LDSCTL_OFF + 320, MOE_OFF = LDSCTL_OFF + 1024;
constexpr int LDS_BYTES = 147456;

__device__ __forceinline__ unsigned cvt_pk_bf16(float lo, float hi) { unsigned r; asm volatile("v_cvt_pk_bf16_f32 %0, %1, %2" : "=v"(r) : "v"(lo), "v"(hi)); return r; }
__device__ __forceinline__ float bflo(unsigned w) { return __uint_as_float(w << 16); }
__device__ __forceinline__ float bfhi(unsigned w) { return __uint_as_float(w & 0xffff0000u); }
__device__ __forceinline__ float bf2f(bf16_t b) { return __uint_as_float((unsigned)b << 16); }
__device__ __forceinline__ float wave_sum(float v) {
#pragma unroll
    for (int o = 1; o < 64; o <<= 1) v += __shfl_xor(v, o);
    return v;
}
#define LDS_WAIT() asm volatile("s_waitcnt lgkmcnt(0)" ::: "memory")
__device__ __forceinline__ float sigmoidf_(float x) { return __builtin_amdgcn_rcpf(1.0f + __builtin_amdgcn_exp2f(x * -1.4426950408889634f)); }

#define XB_TMO      128
#define XB_XCNT(j)  (256  + 64 * (j))
#define XB_XSUB(j)  (1280 + 64 * (j))
#define XB_XGEN(j)  (2304 + 64 * (j))
#define XB_TOP      3328
#define XB_TOPGEN   3392
#define XCD_BAR_WORDS 3456
#define XB_SPIN_CAP (1u << 18)
__device__ __forceinline__ unsigned xb_ld(unsigned* p)              { return __hip_atomic_load(p, __ATOMIC_RELAXED, __HIP_MEMORY_SCOPE_AGENT); }
__device__ __forceinline__ unsigned xb_add(unsigned* p, unsigned v) { return __hip_atomic_fetch_add(p, v, __ATOMIC_RELAXED, __HIP_MEMORY_SCOPE_AGENT); }
__device__ __forceinline__ unsigned xb_xcc_id() { return (unsigned)__builtin_amdgcn_s_getreg((3 << 11) | 20) & 0xFu; }
#define XB_SPIN(cond, bar) do { unsigned _sp = 0; while (cond) { __builtin_amdgcn_s_sleep(1); \
    if ((++_sp & 255u) == 0u) { if (xb_ld(&(bar)[XB_TMO])) break; if (_sp > XB_SPIN_CAP) { atomicAdd(&(bar)[XB_TMO], 1u); break; } } } } while (0)
struct XcdBarrier { unsigned* bar; unsigned x; volatile LAS unsigned* st; };
__device__ __forceinline__ XcdBarrier xcd_barrier_post(unsigned* bar, volatile LAS unsigned* st) {
    XcdBarrier b; b.bar = bar; b.x = xb_xcc_id(); b.st = st;
    if (threadIdx.x == 0) (void)xb_add(&bar[XB_XCNT(b.x)], 1u);
    return b;
}
__device__ __forceinline__ void xcd_barrier_complete(unsigned* bar, unsigned x, unsigned& nloc, unsigned& nx) {
    const unsigned G = gridDim.x * gridDim.y * gridDim.z;
    unsigned sum, cnt, mine, sp = 0u;
    for (;;) {
        sum = 0u; cnt = 0u; mine = 0u;
#pragma unroll
        for (unsigned j = 0; j < 16; ++j) { const unsigned c = xb_ld(&bar[XB_XCNT(j)]); sum += c; cnt += (c > 0u) ? 1u : 0u; mine = (j == x) ? c : mine; }
        if (sum == G) break;
        __builtin_amdgcn_s_sleep(1);
        if ((++sp & 255u) == 0u) { if (xb_ld(&bar[XB_TMO])) break; if (sp > XB_SPIN_CAP) { atomicAdd(&bar[XB_TMO], 1u); break; } }
    }
    nloc = mine > 0u ? mine : 1u; nx = cnt > 0u ? cnt : 1u;
}
__device__ __forceinline__ void xcd_barrier(const XcdBarrier& b) {
    asm volatile("s_waitcnt vmcnt(0)" ::: "memory");
    __syncthreads();
    if (threadIdx.x == 0) {
        unsigned* bar = b.bar;
        __builtin_amdgcn_s_waitcnt(0);
        unsigned nloc = b.st[0], nx = b.st[1];
        if (nloc == 0u) { xcd_barrier_complete(bar, b.x, nloc, nx); b.st[0] = nloc; b.st[1] = nx; }
        const unsigned old = xb_add(&bar[XB_XSUB(b.x)], 1u);
        const unsigned gen = old / nloc;
        if (old + 1u == (gen + 1u) * nloc) {
            __builtin_amdgcn_fence(__ATOMIC_RELEASE, "agent");
            asm volatile("s_waitcnt vmcnt(0)" ::: "memory");
            const unsigned og = xb_add(&bar[XB_TOP], 1u);
            const unsigned tg = og / nx;
            if (og + 1u == (tg + 1u) * nx) xb_add(&bar[XB_TOPGEN], 1u);
            else XB_SPIN(xb_ld(&bar[XB_TOPGEN]) == tg, bar);
            __builtin_amdgcn_fence(__ATOMIC_ACQUIRE, "agent");
            xb_add(&bar[XB_XGEN(b.x)], 1u);
            asm volatile("s_waitcnt vmcnt(0)" ::: "memory");
        } else {
            XB_SPIN(xb_ld(&bar[XB_XGEN(b.x)]) == gen, bar);
            __builtin_amdgcn_fence(__ATOMIC_ACQUIRE, "agent");
            asm volatile("s_waitcnt vmcnt(0)" ::: "memory");
        }
    }
    __syncthreads();
}

struct Unit { int pm, pn; size_t a_off, b_off; int lbase, nvalid; };
struct Gemm { const bf16_t* A; const bf16_t* Bt; int lda, ldb, K; };
__host__ __device__ __forceinline__ int perm32(int rho) { const int n = rho >> 4, i = rho & 15; return 8 * (i >> 2) + 4 * n + (i & 3); }

struct PlainOrder {     static constexpr bool GATHER = false;
    int nM, nN, nwg, G, c, lda, ldb;
    __device__ void init(int M, int N, int G_, int c_, int lda_, int ldb_) { nM = M / 256; nN = N / 256; nwg = nM * nN; G = G_; c = c_; lda = lda_; ldb = ldb_; }
    __device__ bool next(int i, Unit& u) const {
        const long L = (long)i * G + c; if (L >= nwg) return false;
        int wgid = (int)L; { const int q = nwg / 8, r = nwg % 8, xcd = wgid % 8, off = wgid / 8; wgid = (xcd < r ? xcd * (q + 1) : r * (q + 1) + (xcd - r) * q) + off; }
        const int nig = 8 * nN, gid = wgid / nig, fm = gid * 8, gsz = (nM - fm) < 8 ? (nM - fm) : 8;
        u.pm = fm + ((wgid % nig) % gsz); u.pn = (wgid % nig) / gsz;
        u.a_off = (size_t)u.pm * 256 * lda; u.b_off = (size_t)u.pn * 256 * ldb; return true;
    }
};
struct XpreOrder {
    static constexpr bool GATHER = false;
    int G, c, mode;
    __device__ bool next(int i, Unit& u) const {
        const int L = i * G + c; if (L >= 256) return false;
        const int b = L >> 4, x = (L >> 2) & 3, y = L & 3;
        if (mode == 0) { const int h = x, kt = y; u.pm = b * 4 + h; u.pn = kt; u.a_off = (size_t)b * MEMLEN * DM + h * XHD; u.b_off = (size_t)kt * 256 * DM + h * XHD; }
        else { const int nt = x, h = y; u.pm = b * 4 + nt; u.pn = h; u.a_off = (size_t)nt * 256 * DM + h * XHD; u.b_off = (size_t)b * MEMLEN * DM + h * XHD; }
        return true;
    }
};
struct XattnOrder {
    static constexpr bool GATHER = false;
    int G, c, mode, lda, ldb;
    __device__ bool next(int i, Unit& u) const {
        int L = i * G + c; if (L >= (NTOK / 256) * 4) return false;
        if (G == 256) { const int x = c & 7, idx = c >> 3; L = ((x + 8 * i) * 8 + (idx >> 2)) * 4 + (idx & 3); }
        u.pm = L >> 2; u.pn = L & 3; const int b = u.pm >> 3;
        u.a_off = (size_t)u.pm * 256 * lda;
        u.b_off = mode == 0 ? (size_t)(b * 4 + u.pn) * 256 * ldb : (size_t)(b * 1024 + u.pn * 256) * ldb;
        return true;
    }
};
template <bool GATH_> struct MoeOrder {
    static constexpr bool GATHER = GATH_;
    const LAS int* ts; int G, c, lda, ldb; const int* ltok; unsigned rowbytes;
    __device__ bool next(int i, Unit& u) const {
        const int L = i * G + c; if (L >= ts[NEXP] * 4) return false;
        const int T = L >> 2, j = L & 3; int e = 0; while (ts[e + 1] <= T) ++e;
        const int lt = T - ts[e];
        u.pm = T; u.pn = j; u.a_off = GATH_ ? (size_t)0 : (size_t)T * 256 * lda; u.b_off = ((size_t)e * 1024 + j * 256) * ldb;
        u.lbase = e * LCAP + lt * 256; u.nvalid = ts[33 + e] - lt * 256; return true;
    }
    __device__ __forceinline__ unsigned rowoff(const Unit& u, int r) const { return (r < u.nvalid) ? (unsigned)ltok[u.lbase + r] * rowbytes : 0u; }
};

template <class Epi, class Sched>
__device__ __forceinline__ void gemm_phase_simple(LAS unsigned char* lds, const Gemm g, const Sched& S, const Epi& E) {
    int tid = threadIdx.x; asm volatile("" : "+v"(tid));
    const int wid = __builtin_amdgcn_readfirstlane(tid >> 6), lane = tid & 63, wr = wid >> 2, wc = wid & 3, fr = lane & 15, fq = lane >> 4;
    Unit u;
    for (int i = 0; S.next(i, u); ++i) {
        f32x4 acc[2][2][4][2];
#pragma unroll
        for (int a = 0; a < 2; ++a)
#pragma unroll
            for (int b = 0; b < 2; ++b)
#pragma unroll
                for (int m = 0; m < 4; ++m)
#pragma unroll
                    for (int n = 0; n < 2; ++n) acc[a][b][m][n] = (f32x4){0.f, 0.f, 0.f, 0.f};
        const char* Ab = (const char*)(g.A + u.a_off); const char* Bb = (const char*)(g.Bt + u.b_off);
        const int c0 = Epi::PERM ? perm32(fr) : fr, c1 = Epi::PERM ? perm32(16 + fr) : 16 + fr;
        unsigned ao[2][4], bo[2][2];
#pragma unroll
        for (int ai = 0; ai < 2; ++ai)
#pragma unroll
            for (int m = 0; m < 4; ++m) ao[ai][m] = (unsigned)((128 * ai + 64 * wr + 16 * m + fr) * g.lda + 8 * fq) * 2u;
#pragma unroll
        for (int bj = 0; bj < 2; ++bj) { bo[bj][0] = (unsigned)((128 * bj + 32 * wc + c0) * g.ldb + 8 * fq) * 2u; bo[bj][1] = (unsigned)((128 * bj + 32 * wc + c1) * g.ldb + 8 * fq) * 2u; }
#pragma unroll 1
        for (int k0 = 0; k0 < g.K; k0 += 32) {
            if constexpr (Epi::MIDK) { if (k0 == (g.K >> 1)) E.midk(acc, u, wr, wc, fr, fq); }
            const char* Ak = Ab + (size_t)k0 * 2; const char* Bk = Bb + (size_t)k0 * 2;
            bf16x8 bfr[2][2];
#pragma unroll
            for (int bj = 0; bj < 2; ++bj) { bfr[bj][0] = *(const bf16x8*)(Bk + bo[bj][0]); bfr[bj][1] = *(const bf16x8*)(Bk + bo[bj][1]); }
#pragma unroll
            for (int ai = 0; ai < 2; ++ai) {
                bf16x8 af[4];
#pragma unroll
                for (int m = 0; m < 4; ++m) af[m] = *(const bf16x8*)(Ak + ao[ai][m]);
#pragma unroll
                for (int bj = 0; bj < 2; ++bj)
#pragma unroll
                    for (int m = 0; m < 4; ++m)
#pragma unroll
                        for (int n = 0; n < 2; ++n) acc[ai][bj][m][n] = __builtin_amdgcn_mfma_f32_16x16x32_bf16(bfr[bj][n], af[m], acc[ai][bj][m][n], 0, 0, 0);
            }
        }
        E(acc, u, wr, wc, fr, fq);
    }
}

typedef int v8i __attribute__((ext_vector_type(8)));
typedef int v4i __attribute__((ext_vector_type(4)));
__device__ __forceinline__ v8i cat8(bf16x8 lo, bf16x8 hi) { const v4i a = __builtin_bit_cast(v4i, lo), b = __builtin_bit_cast(v4i, hi); return __builtin_shufflevector(a, b, 0, 1, 2, 3, 4, 5, 6, 7); }
template <int H> __device__ __forceinline__ bf16x8 half8(v8i v) { const v4i h = H ? __builtin_shufflevector(v, v, 4, 5, 6, 7) : __builtin_shufflevector(v, v, 0, 1, 2, 3); return __builtin_bit_cast(bf16x8, h); }
__device__ __forceinline__ unsigned pk4_fp8(float a, float b, float c, float d) { int w = __builtin_amdgcn_cvt_pk_fp8_f32(a, b, 0, false); w = __builtin_amdgcn_cvt_pk_fp8_f32(c, d, w, true); return (unsigned)w; }
__host__ __device__ __forceinline__ int lds_byte(int r, int c) { const int st = (r >> 4) * 2 + (c >> 5), rr = r & 15, cc = c & 31, ob = rr * 64 + cc * 2; return st * 1024 + (ob ^ (((ob >> 9) & 1) << 5)); }
__host__ __device__ __forceinline__ void stage_rc(int b, int& R, int& C) { const int st = b / 1024, sb = b % 1024, swz = sb ^ (((sb >> 9) & 1) << 5); R = (st >> 1) * 16 + swz / 64; C = (st & 1) * 32 + (swz % 64) / 2; }
template <class Epi, class Sched, bool ALIGN_EPI = false, bool SP2 = false, bool F8 = false>
__device__ __forceinline__ void gemm_phase(LAS unsigned char* lds, const Gemm g, const Sched& S, const Epi& E) {
    constexpr int BK = 64, HALF = 128, HTB = HALF * BK * 2;
    int tid = threadIdx.x; asm volatile("" : "+v"(tid));
    const int wid = __builtin_amdgcn_readfirstlane(tid >> 6), lane = tid & 63, wr = wid >> 2, wc = wid & 3, fr = lane & 15, fq = lane >> 4;
    const int K = g.K, nt = K / BK;
    unsigned voffA[2], voffB[2];
#pragma unroll
    for (int i = 0; i < 2; ++i) { int R, C; stage_rc(tid * 16 + i * 8192, R, C); const int Rb = Epi::PERM ? ((R & ~31) + perm32(R & 31)) : R;
        voffA[i] = (unsigned)(R * g.lda + C) * 2u; voffB[i] = (unsigned)(Rb * g.ldb + C) * 2u; }
    constexpr bool GATH = Sched::GATHER;
    unsigned vcu[2][2] = {{0u, 0u}, {0u, 0u}}, vnx[2][2] = {{0u, 0u}, {0u, 0u}}; int gR[2] = {0, 0}; unsigned gC[2] = {0u, 0u};
    if constexpr (GATH) {
#pragma unroll
        for (int i = 0; i < 2; ++i) { int R, Cq; stage_rc(tid * 16 + i * 8192, R, Cq); gR[i] = R; gC[i] = (unsigned)Cq * 2u; } }
    const size_t kstep = (size_t)(BK * 2);
    const size_t hstepA = (size_t)HALF * g.lda * 2, hstepB = (size_t)HALF * g.ldb * 2;
    const unsigned ldsw = (unsigned)wid * 1024u;
    const int aoff = lds_byte(wr * 64 + fr, F8 ? fq * 16 : fq * 8), boff = lds_byte(wc * 32 + fr, F8 ? fq * 16 : fq * 8);
    const int aoff1 = lds_byte(wr * 64 + fr, F8 ? fq * 16 + 8 : fq * 8 + 32) - aoff, boff1 = lds_byte(wc * 32 + fr, F8 ? fq * 16 + 8 : fq * 8 + 32) - boff;
#define PG8_SA(b, h) (((b) * 2 + (h)) * HTB)
#define PG8_SB(b, h) ((4 + (b) * 2 + (h)) * HTB)
#define PG8_STAGE(bufoff, gbase, voff) do { _Pragma("unroll") for (int _i = 0; _i < 2; ++_i) \
        __builtin_amdgcn_global_load_lds((const unsigned*)((const char*)(gbase) + (voff)[_i]), (LAS unsigned*)(lds + (bufoff) + ldsw + _i * 8192), 16, 0, 0); } while (0)
#define PG8_STA(bufoff, ptr, h, nx) do { if constexpr (GATH) { const unsigned vsel_[2] = {(nx) ? vnx[h][0] : vcu[h][0], (nx) ? vnx[h][1] : vcu[h][1]}; PG8_STAGE(bufoff, ptr, vsel_); } \
        else { PG8_STAGE(bufoff, (ptr) + (h) * hstepA, voffA); } } while (0)
#define PG8_LDA(dst, b, h) do { _Pragma("unroll") for (int m = 0; m < 4; ++m) dst[m] = cat8(*(const LAS bf16x8*)(lds + PG8_SA(b, h) + aoff + m * 2048), *(const LAS bf16x8*)(lds + PG8_SA(b, h) + aoff + m * 2048 + aoff1)); } while (0)
#define PG8_LDB(dst, b, h) do { _Pragma("unroll") for (int n = 0; n < 2; ++n) dst[n] = cat8(*(const LAS bf16x8*)(lds + PG8_SB(b, h) + boff + n * 2048), *(const LAS bf16x8*)(lds + PG8_SB(b, h) + boff + n * 2048 + boff1)); } while (0)
#define PG8_MMA(ai, bj, At, Bt) do { __builtin_amdgcn_s_setprio(1); \
        if constexpr (F8) { _Pragma("unroll") for (int m = 0; m < 4; ++m) _Pragma("unroll") for (int n = 0; n < 2; ++n) \
            asm volatile("s_nop 1\n\tv_mfma_scale_f32_16x16x128_f8f6f4 %0, %1, %2, %0, %3, %3 op_sel_hi:[0,0,0]" : "+v"(acc[ai][bj][m][n]) : "v"(Bt[n]), "v"(At[m]), "v"(sc127)); } \
        else { _Pragma("unroll") for (int m = 0; m < 4; ++m) _Pragma("unroll") for (int n = 0; n < 2; ++n) { \
            acc[ai][bj][m][n] = __builtin_amdgcn_mfma_f32_16x16x32_bf16(half8<0>(Bt[n]), half8<0>(At[m]), acc[ai][bj][m][n], 0, 0, 0); \
            acc[ai][bj][m][n] = __builtin_amdgcn_mfma_f32_16x16x32_bf16(half8<1>(Bt[n]), half8<1>(At[m]), acc[ai][bj][m][n], 0, 0, 0); } } \
        __builtin_amdgcn_s_setprio(0); } while (0)
#define PG8_WAIT_V(n) asm volatile("s_waitcnt vmcnt(" #n ")" ::: "memory")
#define PG8_WAIT_L(n) asm volatile("s_waitcnt lgkmcnt(" #n ")" ::: "memory")
#define PG8_BAR __builtin_amdgcn_s_barrier()
#define PG8_SCHED __builtin_amdgcn_sched_barrier(0)
    Unit cur, nxt; int ui = 0;
    if (!S.next(0, cur)) return;
    f32x4 acc[2][2][4][2];
#pragma unroll
    for (int a = 0; a < 2; ++a)
#pragma unroll
        for (int b = 0; b < 2; ++b)
#pragma unroll
            for (int m = 0; m < 4; ++m)
#pragma unroll
                for (int n = 0; n < 2; ++n) acc[a][b][m][n] = (f32x4){0.f, 0.f, 0.f, 0.f};
    int sc127 = 127; asm volatile("" : "+v"(sc127));
    v8i At[4], B0[2], B1[2];
    const char* cA = (const char*)(g.A + cur.a_off); const char* cB = (const char*)(g.Bt + cur.b_off);
    if constexpr (GATH) {
#pragma unroll
        for (int h = 0; h < 2; ++h)
#pragma unroll
            for (int i = 0; i < 2; ++i) vcu[h][i] = S.rowoff(cur, h * HALF + gR[i]) + gC[i]; }
    if constexpr (SP2) {
        PG8_STAGE(PG8_SB(0, 0), cB, voffB); PG8_STAGE(PG8_SB(0, 1), cB + hstepB, voffB); PG8_STA(PG8_SA(0, 0), cA, 0, false); PG8_STA(PG8_SA(0, 1), cA, 1, false);
        if (wr == 1) PG8_BAR;
        PG8_WAIT_V(2); PG8_BAR;
        PG8_STAGE(PG8_SB(1, 0), cB + kstep, voffB); PG8_STA(PG8_SA(1, 0), cA + kstep, 0, false); PG8_STAGE(PG8_SB(1, 1), cB + hstepB + kstep, voffB);
        PG8_WAIT_V(6); PG8_BAR;
    } else {
        PG8_STAGE(PG8_SB(0, 0), cB, voffB); PG8_STA(PG8_SA(0, 0), cA, 0, false); PG8_STAGE(PG8_SB(0, 1), cB + hstepB, voffB); PG8_STA(PG8_SA(0, 1), cA, 1, false);
        if (wr == 1) PG8_BAR;
        PG8_WAIT_V(4); PG8_BAR;
        PG8_STAGE(PG8_SB(1, 0), cB + kstep, voffB); PG8_STA(PG8_SA(1, 0), cA + kstep, 0, false); PG8_STAGE(PG8_SB(1, 1), cB + hstepB + kstep, voffB);
        PG8_WAIT_V(6); PG8_BAR;
    }
    for (;;) {
        const bool has_next = S.next(ui + 1, nxt);
        const char* nA = has_next ? (const char*)(g.A + nxt.a_off) : cA; const char* nB = has_next ? (const char*)(g.Bt + nxt.b_off) : cB;
        if constexpr (GATH) {
#pragma unroll
            for (int h = 0; h < 2; ++h)
#pragma unroll
                for (int i = 0; i < 2; ++i) vnx[h][i] = has_next ? (S.rowoff(nxt, h * HALF + gR[i]) + gC[i]) : vcu[h][i]; }
#pragma unroll 1
        for (int t = 0; t < nt; t += 2) {
            if constexpr (Epi::MIDK) { if (t == (nt >> 1)) E.midk(acc, cur, wr, wc, fr, fq); }
            const bool last = (t == nt - 2);
            const char* a1 = cA + (size_t)(t + 1) * kstep;
            const char* a2 = last ? nA : cA + (size_t)(t + 2) * kstep; const char* b2 = last ? nB : cB + (size_t)(t + 2) * kstep;
            const char* a3 = a2 + kstep; const char* b3 = b2 + kstep;
            if constexpr (SP2) {
            PG8_LDB(B0, 0, 0); PG8_LDB(B1, 0, 1); PG8_SCHED; PG8_LDA(At, 0, 0); PG8_STA(PG8_SA(1, 1), a1, 1, false);
            PG8_WAIT_V(8); PG8_WAIT_L(0); PG8_BAR; PG8_MMA(0, 0, At, B0); PG8_MMA(0, 1, At, B1); PG8_BAR; PG8_SCHED;
            PG8_LDA(At, 0, 1); PG8_STAGE(PG8_SB(0, 0), b2, voffB); PG8_STAGE(PG8_SB(0, 1), b2 + hstepB, voffB); PG8_STA(PG8_SA(0, 0), a2, 0, last);
            PG8_WAIT_V(8); PG8_WAIT_L(0); PG8_BAR; PG8_MMA(1, 0, At, B0); PG8_MMA(1, 1, At, B1); PG8_BAR; PG8_SCHED;
            PG8_LDB(B0, 1, 0); PG8_LDB(B1, 1, 1); PG8_SCHED; PG8_LDA(At, 1, 0); PG8_STA(PG8_SA(0, 1), a2, 1, last);
            PG8_WAIT_V(8); PG8_WAIT_L(0); PG8_BAR; PG8_MMA(0, 0, At, B0); PG8_MMA(0, 1, At, B1); PG8_BAR; PG8_SCHED;
            PG8_LDA(At, 1, 1); PG8_STAGE(PG8_SB(1, 0), b3, voffB); PG8_STAGE(PG8_SB(1, 1), b3 + hstepB, voffB); PG8_STA(PG8_SA(1, 0), a3, 0, last);
            PG8_WAIT_V(8); PG8_WAIT_L(0); PG8_BAR; PG8_MMA(1, 0, At, B0); PG8_MMA(1, 1, At, B1); PG8_BAR; PG8_SCHED;
            } else {
            PG8_LDB(B0, 0, 0); PG8_SCHED; PG8_LDA(At, 0, 0); PG8_STA(PG8_SA(1, 1), a1, 1, false);
            PG8_WAIT_L(8); PG8_BAR; PG8_WAIT_L(0); PG8_MMA(0, 0, At, B0); PG8_BAR; PG8_SCHED;
            PG8_LDB(B1, 0, 1); PG8_STAGE(PG8_SB(0, 0), b2, voffB);
            PG8_BAR; PG8_WAIT_L(0); PG8_MMA(0, 1, At, B1); PG8_BAR;
            PG8_LDA(At, 0, 1); PG8_STA(PG8_SA(0, 0), a2, 0, last);
            PG8_BAR; PG8_WAIT_L(0); PG8_MMA(1, 0, At, B0); PG8_BAR; PG8_SCHED;
            PG8_STAGE(PG8_SB(0, 1), b2 + hstepB, voffB);
            PG8_WAIT_V(6); PG8_BAR; PG8_MMA(1, 1, At, B1); PG8_BAR;
            PG8_LDB(B0, 1, 0); PG8_SCHED; PG8_LDA(At, 1, 0); PG8_STA(PG8_SA(0, 1), a2, 1, last);
            PG8_WAIT_L(8); PG8_BAR; PG8_WAIT_L(0); PG8_MMA(0, 0, At, B0); PG8_BAR; PG8_SCHED;
            PG8_LDB(B1, 1, 1); PG8_STAGE(PG8_SB(1, 0), b3, voffB);
            PG8_BAR; PG8_WAIT_L(0); PG8_MMA(0, 1, At, B1); PG8_BAR;
            PG8_LDA(At, 1, 1); PG8_STA(PG8_SA(1, 0), a3, 0, last);
            PG8_BAR; PG8_WAIT_L(0); PG8_MMA(1, 0, At, B0); PG8_BAR; PG8_SCHED;
            PG8_STAGE(PG8_SB(1, 1), b3 + hstepB, voffB);
            PG8_WAIT_V(6); PG8_BAR; PG8_MMA(1, 1, At, B1); PG8_BAR;
            }
        }
        if constexpr (ALIGN_EPI) { if (wr == 0) PG8_BAR; }
        if constexpr (F8) {
#pragma unroll
            for (int a = 0; a < 2; ++a)
#pragma unroll
                for (int b = 0; b < 2; ++b)
                    asm volatile("s_nop 15\n\ts_nop 7" : "+v"(acc[a][b][0][0]), "+v"(acc[a][b][0][1]), "+v"(acc[a][b][1][0]), "+v"(acc[a][b][1][1]), "+v"(acc[a][b][2][0]), "+v"(acc[a][b][2][1]), "+v"(acc[a][b][3][0]), "+v"(acc[a][b][3][1]));
        }
        E(acc, cur, wr, wc, fr, fq);
        if (!has_next) break;
#pragma unroll
        for (int a = 0; a < 2; ++a)
#pragma unroll
            for (int b = 0; b < 2; ++b)
#pragma unroll
                for (int m = 0; m < 4; ++m)
#pragma unroll
                    for (int n = 0; n < 2; ++n) acc[a][b][m][n] = (f32x4){0.f, 0.f, 0.f, 0.f};
        cur = nxt; cA = nA; cB = nB; ++ui;
        if constexpr (GATH) {
#pragma unroll
            for (int h = 0; h < 2; ++h)
#pragma unroll
                for (int i = 0; i < 2; ++i) vcu[h][i] = vnx[h][i]; }
        if constexpr (ALIGN_EPI) { if (wr == 1) PG8_BAR; }
    }
    PG8_WAIT_V(0);
    if constexpr (!ALIGN_EPI) { if (wr == 0) PG8_BAR; }
    PG8_BAR;
#undef PG8_SA
#undef PG8_SB
#undef PG8_STAGE
#undef PG8_STA
#undef PG8_LDA
#undef PG8_LDB
#undef PG8_MMA
#undef PG8_WAIT_V
#undef PG8_WAIT_L
#undef PG8_BAR
#undef PG8_SCHED
}
#ifdef GEMM_SIMPLE
#define GEMM_PHASE(lds, g, S, E) gemm_phase_simple(lds, g, S, E)
#else
#define GEMM_PHASE(lds, g, S, E) gemm_phase<decltype(E), decltype(S), true, true>(lds, g, S, E)
#endif
#define GEMM_PHASE8(lds, g, S, E) gemm_phase<decltype(E), decltype(S), true, true, true>(lds, g, S, E)

__device__ __forceinline__ float rstd_from_ssq(const float* ssq, int row) {
    const f32x4* p = (const f32x4*)(ssq + (size_t)row * 16); const f32x4 a = p[0], b = p[1], c = p[2], d = p[3];
    const float s = ((a[0] + a[1]) + (a[2] + a[3])) + ((b[0] + b[1]) + (b[2] + b[3])) + ((c[0] + c[1]) + (c[2] + c[3])) + ((d[0] + d[1]) + (d[2] + d[3]));
    return __builtin_amdgcn_rsqf(s * (1.0f / DM) + EPS);
}
__device__ __forceinline__ u32x4 pack8(const f32x4 v0, const f32x4 v1) { u32x4 w; w.x = cvt_pk_bf16(v0[0], v0[1]); w.y = cvt_pk_bf16(v0[2], v0[3]); w.z = cvt_pk_bf16(v1[0], v1[1]); w.w = cvt_pk_bf16(v1[2], v1[3]); return w; }

struct EpiProj {
    static constexpr bool PERM = true, LDSX = false, MIDK = false;
    bf16_t* base; const float* rope; float* ksum;
    __device__ __forceinline__ void operator()(f32x4 (&acc)[2][2][4][2], const Unit& u, int wr, int wc, int fr, int fq) const {
        const int type = u.pn >> 1, colt = (u.pn & 1) * 256;
        bf16_t* O = base + (size_t)type * NTOK * 512;
        const bool is_q = (type == 2), is_k = (type == 3);
        if ((is_q || is_k) && !(wc & 1)) {
#pragma unroll
            for (int ai = 0; ai < 2; ++ai)
#pragma unroll
                for (int m = 0; m < 4; ++m) {
                    const int row = u.pm * 256 + 128 * ai + 64 * wr + 16 * m + fr, pos = row & (SEQ - 1);
                    const float* rp = rope + pos * 16;
                    const f32x4 cs[2] = { *(const f32x4*)(rp), *(const f32x4*)(rp + 4) }, sn[2] = { *(const f32x4*)(rp + 8), *(const f32x4*)(rp + 12) };
#pragma unroll
                    for (int bj = 0; bj < 2; ++bj)
#pragma unroll
                        for (int n = 0; n < 2; ++n) {
                            const f32x4 mine = acc[ai][bj][m][n]; f32x4 oth;
#pragma unroll
                            for (int e = 0; e < 4; ++e) oth[e] = __shfl_xor(mine[e], 16);
                            f32x4 res = mine;
                            if (fq == 0) res = mine * cs[n] - oth * sn[n];
                            else if (fq == 1) res = mine * cs[n] + oth * sn[n];
                            acc[ai][bj][m][n] = res;
                        }
                }
        }
        const float sc = is_q ? QSCALE : 1.0f;
#pragma unroll
        for (int ai = 0; ai < 2; ++ai)
#pragma unroll
            for (int m = 0; m < 4; ++m) {
                const int row = u.pm * 256 + 128 * ai + 64 * wr + 16 * m + fr;
                bf16_t* rowp = O + (size_t)row * 512 + colt + 32 * wc + 8 * fq;
#pragma unroll
                for (int bj = 0; bj < 2; ++bj) *(u32x4*)(rowp + bj * 128) = pack8(acc[ai][bj][m][0] * sc, acc[ai][bj][m][1] * sc);
            }
        if (is_k) {
#pragma unroll
            for (int bj = 0; bj < 2; ++bj)
#pragma unroll
                for (int n = 0; n < 2; ++n)
#pragma unroll
                    for (int e = 0; e < 4; ++e) {
                        float s = 0.f;
#pragma unroll
                        for (int ai = 0; ai < 2; ++ai)
#pragma unroll
                            for (int m = 0; m < 4; ++m) s += acc[ai][bj][m][n][e];
                        s += __shfl_xor(s, 1); s += __shfl_xor(s, 2); s += __shfl_xor(s, 4); s += __shfl_xor(s, 8);
                        if (fr == 0) atomicAdd(ksum + (size_t)u.pm * 512 + colt + 128 * bj + 32 * wc + 8 * fq + 4 * n + e, s);
                    }
        }
    }
};
struct EpiNull {
    static constexpr bool PERM = true, LDSX = false, MIDK = false;
    __device__ __forceinline__ void operator()(f32x4 (&acc)[2][2][4][2], const Unit& u, int wr, int wc, int fr, int fq) const {
        f32x4 t = {0.f, 0.f, 0.f, 0.f};
#pragma unroll
        for (int a = 0; a < 2; ++a)
#pragma unroll
            for (int b = 0; b < 2; ++b)
#pragma unroll
                for (int m = 0; m < 4; ++m)
#pragma unroll
                    for (int n = 0; n < 2; ++n) t += acc[a][b][m][n];
        asm volatile("" :: "v"(t)); }
};
struct EpiStore {
    static constexpr bool PERM = true, LDSX = false, MIDK = false;
    bf16_t* O; int ldc; float sc = 1.0f;
    __device__ __forceinline__ void operator()(f32x4 (&acc)[2][2][4][2], const Unit& u, int wr, int wc, int fr, int fq) const {
#pragma unroll
        for (int ai = 0; ai < 2; ++ai)
#pragma unroll
            for (int m = 0; m < 4; ++m) {
                const int row = u.pm * 256 + 128 * ai + 64 * wr + 16 * m + fr;
                bf16_t* rowp = O + (size_t)row * ldc + u.pn * 256 + 32 * wc + 8 * fq;
#pragma unroll
                for (int bj = 0; bj < 2; ++bj) *(u32x4*)(rowp + bj * 128) = pack8(acc[ai][bj][m][0] * sc, acc[ai][bj][m][1] * sc);
            }
    }
};
struct EpiStore8 {
    static constexpr bool PERM = true, LDSX = false, MIDK = false;
    unsigned char* O; int ldc; float sc;
    __device__ __forceinline__ void operator()(f32x4 (&acc)[2][2][4][2], const Unit& u, int wr, int wc, int fr, int fq) const {
#pragma unroll
        for (int ai = 0; ai < 2; ++ai)
#pragma unroll
            for (int m = 0; m < 4; ++m) {
                const int row = u.pm * 256 + 128 * ai + 64 * wr + 16 * m + fr;
                unsigned char* rowp = O + (size_t)row * ldc + u.pn * 256 + 32 * wc + 8 * fq;
#pragma unroll
                for (int bj = 0; bj < 2; ++bj) { const f32x4 a0 = acc[ai][bj][m][0] * sc, a1 = acc[ai][bj][m][1] * sc; u32x2 w; w.x = pk4_fp8(a0[0], a0[1], a0[2], a0[3]); w.y = pk4_fp8(a1[0], a1[1], a1[2], a1[3]); *(u32x2*)(rowp + bj * 128) = w; }
            }
    }
};
template <bool BASE_F32, bool KSPLIT> struct EpiResid {
    static constexpr bool PERM = true, LDSX = false, MIDK = KSPLIT;
    const void* base; bf16_t* hb; float* ssq; const float* ssql; const float* ssqa; unsigned char* h8; float asc; const float* rs0 = nullptr; const float* gmix = nullptr;
    __device__ __forceinline__ void stats(int row, int fq, float& rl, float& ra) const {
        const f32x4 pl = *(const f32x4*)(ssql + (size_t)row * 16 + 4 * fq); const f32x2 pa = *(const f32x2*)(ssqa + (size_t)row * 8 + 2 * fq);
        float sl = (pl[0] + pl[1]) + (pl[2] + pl[3]), sa = pa[0] + pa[1];
        sl += __shfl_xor(sl, 16); sl += __shfl_xor(sl, 32); sa += __shfl_xor(sa, 16); sa += __shfl_xor(sa, 32);
        rl = __builtin_amdgcn_rsqf(sl * (1.0f / 512.0f) + EPS); ra = __builtin_amdgcn_rsqf(sa * (1.0f / 512.0f) + EPS);
    }
    __device__ __forceinline__ void midk(f32x4 (&acc)[2][2][4][2], const Unit& u, int wr, int wc, int fr, int fq) const {
        asm volatile("" : "+v"(fr), "+v"(fq));
#pragma unroll
        for (int ai = 0; ai < 2; ++ai)
#pragma unroll
            for (int m = 0; m < 4; ++m) { float rl, ra; stats(u.pm * 256 + 128 * ai + 64 * wr + 16 * m + fr, fq, rl, ra); const float ratio = rl * __builtin_amdgcn_rcpf(ra);
#pragma unroll
                for (int bj = 0; bj < 2; ++bj)
#pragma unroll
                    for (int n = 0; n < 2; ++n) acc[ai][bj][m][n] *= ratio; }
    }
    __device__ __forceinline__ void operator()(f32x4 (&acc)[2][2][4][2], const Unit& u, int wr, int wc, int fr, int fq) const {
        f32x4 ginv[2][2];
        if constexpr (BASE_F32) {
#pragma unroll
            for (int bj = 0; bj < 2; ++bj)
#pragma unroll
                for (int n = 0; n < 2; ++n) { const f32x4 g = *(const f32x4*)(gmix + u.pn * 256 + 128 * bj + 32 * wc + 8 * fq + 4 * n);
                    ginv[bj][n] = (f32x4){__builtin_amdgcn_rcpf(g[0]), __builtin_amdgcn_rcpf(g[1]), __builtin_amdgcn_rcpf(g[2]), __builtin_amdgcn_rcpf(g[3])}; } }
#pragma unroll
        for (int ai = 0; ai < 2; ++ai)
#pragma unroll
            for (int m = 0; m < 4; ++m) {
                const int row = u.pm * 256 + 128 * ai + 64 * wr + 16 * m + fr; float q = 0.f, osc = asc, irs = 1.0f;
                if constexpr (KSPLIT) { float rl; stats(row, fq, rl, osc); osc *= asc; }
                if constexpr (BASE_F32) irs = __builtin_amdgcn_rcpf(rs0[row]);
#pragma unroll
                for (int bj = 0; bj < 2; ++bj) {
                    const int col = u.pn * 256 + 128 * bj + 32 * wc + 8 * fq;
                    f32x4 b0, b1;
                    if constexpr (BASE_F32) { const u32x4 w = *(const u32x4*)((const bf16_t*)base + (size_t)row * DM + col);
                        b0 = (f32x4){bflo(w.x), bfhi(w.x), bflo(w.y), bfhi(w.y)} * (ginv[bj][0] * irs); b1 = (f32x4){bflo(w.z), bfhi(w.z), bflo(w.w), bfhi(w.w)} * (ginv[bj][1] * irs); }
                    else { const u32x4 w = *(const u32x4*)((const bf16_t*)base + (size_t)row * LDH + col); b0 = (f32x4){bflo(w.x), bfhi(w.x), bflo(w.y), bfhi(w.y)}; b1 = (f32x4){bflo(w.z), bfhi(w.z), bflo(w.w), bfhi(w.w)}; }
                    const f32x4 v0 = b0 + acc[ai][bj][m][0] * osc, v1 = b1 + acc[ai][bj][m][1] * osc;
                    q += ((v0[0] * v0[0] + v0[1] * v0[1]) + (v0[2] * v0[2] + v0[3] * v0[3])) + ((v1[0] * v1[0] + v1[1] * v1[1]) + (v1[2] * v1[2] + v1[3] * v1[3]));
                    *(u32x4*)(hb + (size_t)row * LDH + col) = pack8(v0, v1);
                    if (h8) { u32x2 w8; w8.x = pk4_fp8(v0[0], v0[1], v0[2], v0[3]); w8.y = pk4_fp8(v1[0], v1[1], v1[2], v1[3]); *(u32x2*)(h8 + (size_t)row * DM + col) = w8; }
                }
                q += __shfl_xor(q, 16); q += __shfl_xor(q, 32);
                if (fq == 0) ssq[(size_t)row * 16 + u.pn * 4 + wc] = q;
            }
    }
};
struct EpiRowScale {
    static constexpr bool PERM = true, LDSX = false, MIDK = false;
    bf16_t* O; int ldc; const float* ssq; float cs;
    __device__ __forceinline__ void operator()(f32x4 (&acc)[2][2][4][2], const Unit& u, int wr, int wc, int fr, int fq) const {
#pragma unroll
        for (int ai = 0; ai < 2; ++ai)
#pragma unroll
            for (int m = 0; m < 4; ++m) {
                const int row = u.pm * 256 + 128 * ai + 64 * wr + 16 * m + fr; const float s = rstd_from_ssq(ssq, row) * cs;
                bf16_t* rowp = O + (size_t)row * ldc + u.pn * 256 + 32 * wc + 8 * fq;
#pragma unroll
                for (int bj = 0; bj < 2; ++bj) *(u32x4*)(rowp + bj * 128) = pack8(acc[ai][bj][m][0] * s, acc[ai][bj][m][1] * s);
            }
    }
};
#define XBAR() do { asm volatile("s_waitcnt lgkmcnt(0)" ::: "memory"); __builtin_amdgcn_s_barrier(); asm volatile("" ::: "memory"); } while (0)
struct EpiSoftmax {
    static constexpr bool PERM = true, LDSX = false, MIDK = false;
    unsigned char* O; int ldc; LAS unsigned char* xl; const float* ssq; float cs;
    __device__ __forceinline__ void operator()(f32x4 (&acc)[2][2][4][2], const Unit& u, int wr, int wc, int fr, int fq) const {
        LAS float* P = (LAS float*)xl;
        LAS float* Q = (LAS float*)(xl + 4096);
#pragma unroll
        for (int ai = 0; ai < 2; ++ai)
#pragma unroll
            for (int m = 0; m < 4; ++m) {
                float v = -INFINITY; const float sc = rstd_from_ssq(ssq, u.pm * 256 + 128 * ai + 64 * wr + 16 * m + fr) * cs;
#pragma unroll
                for (int bj = 0; bj < 2; ++bj)
#pragma unroll
                    for (int n = 0; n < 2; ++n) { const f32x4 x = acc[ai][bj][m][n] * sc; acc[ai][bj][m][n] = x; v = fmaxf(v, fmaxf(fmaxf(x[0], x[1]), fmaxf(x[2], x[3]))); }
                v = fmaxf(v, __shfl_xor(v, 16)); v = fmaxf(v, __shfl_xor(v, 32));
                if (fq == 0) P[(128 * ai + 64 * wr + 16 * m + fr) * 4 + wc] = v;
            }
        XBAR();
#pragma unroll
        for (int ai = 0; ai < 2; ++ai)
#pragma unroll
            for (int m = 0; m < 4; ++m) {
                const int r = 128 * ai + 64 * wr + 16 * m + fr;
                const float v = fmaxf(fmaxf(P[r * 4 + 0], P[r * 4 + 1]), fmaxf(P[r * 4 + 2], P[r * 4 + 3]));
                float s = 0.f;
#pragma unroll
                for (int bj = 0; bj < 2; ++bj)
#pragma unroll
                    for (int n = 0; n < 2; ++n) { f32x4 x = acc[ai][bj][m][n];
#pragma unroll
                        for (int e = 0; e < 4; ++e) { x[e] = __builtin_amdgcn_exp2f(x[e] - v); s += x[e]; }
                        acc[ai][bj][m][n] = x; }
                s += __shfl_xor(s, 16); s += __shfl_xor(s, 32);
                if (fq == 0) Q[r * 4 + wc] = s;
            }
        XBAR();
#pragma unroll
        for (int ai = 0; ai < 2; ++ai)
#pragma unroll
            for (int m = 0; m < 4; ++m) {
                const int r = 128 * ai + 64 * wr + 16 * m + fr;
                const float inv = PX_SC * __builtin_amdgcn_rcpf((Q[r * 4 + 0] + Q[r * 4 + 1]) + (Q[r * 4 + 2] + Q[r * 4 + 3]));
                unsigned char* rowp = O + (size_t)(u.pm * 256 + r) * ldc + u.pn * 256 + 32 * wc + 8 * fq;
#pragma unroll
                for (int bj = 0; bj < 2; ++bj) { const f32x4 a0 = acc[ai][bj][m][0] * inv, a1 = acc[ai][bj][m][1] * inv; u32x2 w; w.x = pk4_fp8(a0[0], a0[1], a0[2], a0[3]); w.y = pk4_fp8(a1[0], a1[1], a1[2], a1[3]); *(u32x2*)(rowp + bj * 128) = w; }
            }
        XBAR();
    }
};
struct EpiGateUp {
    static constexpr bool PERM = true, LDSX = false, MIDK = false;
    unsigned char* O; const float* lrs;
    __device__ __forceinline__ void operator()(f32x4 (&acc)[2][2][4][2], const Unit& u, int wr, int wc, int fr, int fq) const {
#pragma unroll
        for (int ai = 0; ai < 2; ++ai)
#pragma unroll
            for (int m = 0; m < 4; ++m) {
                const int r = 128 * ai + 64 * wr + 16 * m + fr, row = u.pm * 256 + r; const float rs = (r < u.nvalid) ? lrs[u.lbase + r] * (1.0f / WGU_SC) : 0.f;
                f32x4 o[2];
#pragma unroll
                for (int n = 0; n < 2; ++n)
#pragma unroll
                    for (int e = 0; e < 4; ++e) { const float g = acc[ai][0][m][n][e] * rs, up = acc[ai][1][m][n][e] * rs; o[n][e] = g * sigmoidf_(g) * up * ACT_SC; }
                u32x2 w8; w8.x = pk4_fp8(o[0][0], o[0][1], o[0][2], o[0][3]); w8.y = pk4_fp8(o[1][0], o[1][1], o[1][2], o[1][3]);
                *(u32x2*)(O + (size_t)row * DFF + u.pn * 128 + 32 * wc + 8 * fq) = w8;
            }
    }
};

struct Args { const float* in[27]; float* out; unsigned char* ws; int ph_lo, ph_hi; float invf[8]; };
struct Ctx { LAS unsigned char* lds; int tid, lane, wave, vcu, G; };

__device__ __forceinline__ void tr_load(f32x4 (&v)[8], const float* W, int ldw, int k0, int n0s, int lane) {
    const int kr = lane >> 3, ch = lane & 7;
#pragma unroll
    for (int i = 0; i < 8; ++i) v[i] = *(const f32x4*)(W + (size_t)(k0 + 8 * i + kr) * ldw + n0s + 4 * ch);
}
__device__ __forceinline__ void tr_finish(const f32x4 (&v)[8], int k0, bf16_t* WT, int ldt, int r0d, const float* gain, LAS float* scr, int lane) {
    const int kr = lane >> 3, ch = lane & 7, c = lane & 7;
    f32x4 g0 = {1.f, 1.f, 1.f, 1.f}, g1 = {1.f, 1.f, 1.f, 1.f};
    if (gain) { g0 = *(const f32x4*)(gain + k0 + 8 * c); g1 = *(const f32x4*)(gain + k0 + 8 * c + 4); }
#pragma unroll
    for (int i = 0; i < 8; ++i) { LAS float* d = scr + (8 * i + kr) * 33 + 4 * ch; d[0] = v[i][0]; d[1] = v[i][1]; d[2] = v[i][2]; d[3] = v[i][3]; }
    LDS_WAIT(); asm volatile("" ::: "memory");
#pragma unroll
    for (int j = 0; j < 4; ++j) { const int n = (lane >> 3) + 8 * j; const LAS float* s = scr + (8 * c) * 33 + n;
        u32x4 o; o.x = cvt_pk_bf16(s[0 * 33] * g0[0], s[1 * 33] * g0[1]); o.y = cvt_pk_bf16(s[2 * 33] * g0[2], s[3 * 33] * g0[3]); o.z = cvt_pk_bf16(s[4 * 33] * g1[0], s[5 * 33] * g1[1]); o.w = cvt_pk_bf16(s[6 * 33] * g1[2], s[7 * 33] * g1[3]);
        *(u32x4*)(WT + (size_t)(r0d + n) * ldt + k0 + 8 * c) = o; }
    LDS_WAIT(); asm volatile("" ::: "memory");
}
__device__ __forceinline__ void tr_finish8(const f32x4 (&v)[8], int k0, unsigned char* WT8, int ldt, int r0d, const float* gain, float sc, LAS float* scr, int lane) {
    const int kr = lane >> 3, ch = lane & 7, c = lane & 7;
    f32x4 g0 = {sc, sc, sc, sc}, g1 = {sc, sc, sc, sc};
    if (gain) { g0 = *(const f32x4*)(gain + k0 + 8 * c) * sc; g1 = *(const f32x4*)(gain + k0 + 8 * c + 4) * sc; }
#pragma unroll
    for (int i = 0; i < 8; ++i) { LAS float* d = scr + (8 * i + kr) * 33 + 4 * ch; d[0] = v[i][0]; d[1] = v[i][1]; d[2] = v[i][2]; d[3] = v[i][3]; }
    LDS_WAIT(); asm volatile("" ::: "memory");
#pragma unroll
    for (int j = 0; j < 4; ++j) { const int n = (lane >> 3) + 8 * j; const LAS float* s = scr + (8 * c) * 33 + n;
        u32x2 o; o.x = pk4_fp8(s[0 * 33] * g0[0], s[1 * 33] * g0[1], s[2 * 33] * g0[2], s[3 * 33] * g0[3]); o.y = pk4_fp8(s[4 * 33] * g1[0], s[5 * 33] * g1[1], s[6 * 33] * g1[2], s[7 * 33] * g1[3]);
        *(u32x2*)(WT8 + (size_t)(r0d + n) * ldt + k0 + 8 * c) = o; }
    LDS_WAIT(); asm volatile("" ::: "memory");
}
__device__ __forceinline__ void tr_item(const float* W, int ldw, int k0, int n0s, bf16_t* WT, int ldt, int r0d, const float* gain, LAS float* scr, int lane) {
    f32x4 v[8]; tr_load(v, W, ldw, k0, n0s, lane); tr_finish(v, k0, WT, ldt, r0d, gain, scr, lane);
}
__device__ __forceinline__ void rms_row_to_bf16(const float* xrow, const float* gain, bf16_t* orow, int lane) {
    const f32x4* xr = (const f32x4*)xrow + lane; const f32x4* gr = (const f32x4*)gain + lane;
    f32x4 v[4]; float s = 0.f;
#pragma unroll
    for (int j = 0; j < 4; ++j) { v[j] = xr[64 * j]; s += (v[j][0] * v[j][0] + v[j][1] * v[j][1]) + (v[j][2] * v[j][2] + v[j][3] * v[j][3]); }
    const float rstd = 1.0f / sqrtf(wave_sum(s) * (1.0f / DM) + EPS);
    u32x2* o8 = (u32x2*)orow + lane;
#pragma unroll
    for (int j = 0; j < 4; ++j) { const f32x4 g = gr[64 * j]; u32x2 w; w.x = cvt_pk_bf16(v[j][0] * rstd * g[0], v[j][1] * rstd * g[1]); w.y = cvt_pk_bf16(v[j][2] * rstd * g[2], v[j][3] * rstd * g[3]); o8[64 * j] = w; }
}

__device__ __forceinline__ void rms_row2_to_bf16(const float* xrow, const float* gain, bf16_t* orow, int lane, float* rstd_out = nullptr) {
    const f32x4* xr = (const f32x4*)xrow + lane; const f32x4* gr = (const f32x4*)gain + lane;
    f32x4 v[2][4]; float s[2] = {0.f, 0.f};
#pragma unroll
    for (int r = 0; r < 2; ++r)
#pragma unroll
        for (int j = 0; j < 4; ++j) v[r][j] = xr[256 * r + 64 * j];
#pragma unroll
    for (int r = 0; r < 2; ++r)
#pragma unroll
        for (int j = 0; j < 4; ++j) s[r] += (v[r][j][0] * v[r][j][0] + v[r][j][1] * v[r][j][1]) + (v[r][j][2] * v[r][j][2] + v[r][j][3] * v[r][j][3]);
#pragma unroll
    for (int r = 0; r < 2; ++r) { const float rstd = 1.0f / sqrtf(wave_sum(s[r]) * (1.0f / DM) + EPS); u32x2* o8 = (u32x2*)(orow + (size_t)r * DM) + lane; if (rstd_out && lane == 0) rstd_out[r] = rstd;
#pragma unroll
        for (int j = 0; j < 4; ++j) { const f32x4 g = gr[64 * j]; u32x2 w; w.x = cvt_pk_bf16(v[r][j][0] * rstd * g[0], v[r][j][1] * rstd * g[1]); w.y = cvt_pk_bf16(v[r][j][2] * rstd * g[2], v[r][j][3] * rstd * g[3]); o8[64 * j] = w; } }
}

__device__ __forceinline__ void conv_wdn(const Args& a, const Ctx& C, int gw, int NGW, int it_lo, int NIT) {
    LAS float* scr = (LAS float*)(C.lds + C.wave * 16384); const int lane = C.lane;
    f32x4 va[8], vb[8];
#define WDN_LOAD(v, it) do { const int e_ = (it) / 256, r_ = (it) % 256; tr_load(v, a.in[25] + (size_t)e_ * DFF * DM, DM, 64 * (r_ / 32), 32 * (r_ % 32), lane); } while (0)
#define WDN_FIN(v, it) do { const int e_ = (it) / 256, r_ = (it) % 256; tr_finish8(v, 64 * (r_ / 32), a.ws + WS_WDN, DFF, e_ * 1024 + 32 * (r_ % 32), nullptr, WDN_SC, scr, lane); } while (0)
    int it = it_lo + gw; if (it < NIT) WDN_LOAD(va, it);
    for (; it < NIT; it += 2 * NGW) {
        const int it1 = it + NGW, it2 = it + 2 * NGW;
        if (it1 < NIT) WDN_LOAD(vb, it1);
        WDN_FIN(va, it);
        if (it2 < NIT) WDN_LOAD(va, it2);
        if (it1 < NIT) WDN_FIN(vb, it1);
    }
#undef WDN_LOAD
#undef WDN_FIN
}
__device__ __forceinline__ void ph_prologue(const Args& a, const Ctx& C) {
    unsigned char* ws = a.ws;
    LAS float* scr = (LAS float*)(C.lds + C.wave * 16384);
    const int gw = C.vcu * 8 + C.wave, NGW = C.G * 8, lane = C.lane;
    for (int it = gw; it < 16 * 80; it += NGW) { const int kb = it / 80, nb = it % 80; tr_item(a.in[3], DIN, 64 * kb, 32 * nb, (bf16_t*)(ws + WS_WIN), DM, 32 * nb, nullptr, scr, lane); }
    for (int it = gw; it < 16 * 64; it += NGW) { const int kb = it / 64, nb = it % 64;
        if (nb < 32) tr_item(a.in[17], 2 * DM, 64 * kb, 32 * nb, (bf16_t*)(ws + WS_WXK), DM, 32 * nb, nullptr, scr, lane);
        else tr_item(a.in[17], 2 * DM, 64 * kb, 32 * nb, (bf16_t*)(ws + WS_WXV), DM, 32 * (nb - 32), nullptr, scr, lane); }
    for (int it = gw; it < 16 * 32; it += NGW) { const int kb = it / 32, nb = it % 32;
        tr_item(a.in[13], DM, 64 * kb, 32 * nb, (bf16_t*)(ws + WS_WOUT), DM, 32 * nb, (kb < 8) ? a.in[11] : (a.in[12] - DLRU), scr, lane);
        tr_item(a.in[18], DM, 64 * kb, 32 * nb, (bf16_t*)(ws + WS_WXO), DM, 32 * nb, nullptr, scr, lane); }
    for (int r = gw; r < DM; r += NGW) { const float gk = a.in[14][r]; const f32x4* src = (const f32x4*)(a.in[16] + (size_t)r * DM) + lane; u32x2* dst = (u32x2*)((bf16_t*)(ws + WS_WXQ) + (size_t)r * DM) + lane;
#pragma unroll
        for (int j = 0; j < 4; ++j) { const f32x4 v = src[64 * j]; u32x2 w; w.x = cvt_pk_bf16(v[0] * gk, v[1] * gk); w.y = cvt_pk_bf16(v[2] * gk, v[3] * gk); dst[64 * j] = w; } }
    { bf16_t* WR = (bf16_t*)(ws + WS_WR); const int gt = C.vcu * 512 + C.tid, NT = C.G * 512;
      for (int i = gt; i < 48 * DM; i += NT) { const int r = i / DM, k = i % DM; float v = 0.f;
          if (r < 4) v = a.in[20][k * NGRP + r] * a.in[19][k]; else if (r < 36) v = a.in[22][k * NEXP + (r - 4)] * a.in[19][k];
          WR[i] = (bf16_t)(cvt_pk_bf16(v, 0.f) & 0xffffu); }
      float* rope = (float*)(ws + WS_ROPE);
      for (int i = gt; i < SEQ * 8; i += NT) { const int pos = i >> 3, j = i & 7; const float ang = (float)pos * a.invf[j];
          const double tw = 6.283185307179586476925286766559; const double ad = (double)ang; const double red = ad - tw * __builtin_rint(ad / tw); const float rf = (float)red;
          rope[pos * 16 + j] = __cosf(rf); rope[pos * 16 + 8 + j] = __sinf(rf); } }
    for (int m = 2 * gw; m < NTOK; m += 2 * NGW) rms_row2_to_bf16(a.in[0] + (size_t)m * DM, a.in[2], (bf16_t*)(ws + WS_B) + (size_t)m * DM, lane, (float*)(ws + WS_TOK + TOK_D) + m);
    for (int m = 2 * gw; m < NMEM; m += 2 * NGW) rms_row2_to_bf16(a.in[1] + (size_t)m * DM, a.in[15], (bf16_t*)(ws + WS_MEMN) + (size_t)m * DM, lane);
}

__device__ __forceinline__ float gelu_tanh(float x) { const float x2 = x * x; const float z2 = x * (-2.0f * 0.7978845608028654f * 1.4426950408889634f) * (1.0f + 0.044715f * x2);
    return x * __builtin_amdgcn_rcpf(1.0f + __builtin_amdgcn_exp2f(z2)); }
__device__ __forceinline__ bool moe_item_load(f32x4 (&v)[8], const Args& a, int s, int lane) {
    if (s < NEXP * 512) { const int e = s / 512, r = s % 512, kb = r / 32, nb = r % 32, j = nb >> 3, half = (nb >> 2) & 1, q = nb & 3;
        tr_load(v, a.in[24] + (size_t)e * DM * DM, DM, 64 * kb, half * 512 + j * 128 + q * 32, lane); return true; }
    const int it = s - NEXP * 512 + WDN_SPLIT; if (it >= NEXP * 256) return false;
    const int e = it / 256, r = it % 256; tr_load(v, a.in[25] + (size_t)e * DFF * DM, DM, 64 * (r / 32), 32 * (r % 32), lane); return true;
}
__device__ __forceinline__ void moe_item_finish(const f32x4 (&v)[8], const Args& a, int s, LAS float* scr, int lane) {
    if (s < NEXP * 512) { const int e = s / 512, r = s % 512, kb = r / 32, nb = r % 32, j = nb >> 3, half = (nb >> 2) & 1, q = nb & 3;
        tr_finish8(v, 64 * kb, a.ws + WS_WGU, DM, e * 1024 + j * 256 + half * 128 + q * 32, a.in[19], WGU_SC, scr, lane); return; }
    const int it = s - NEXP * 512 + WDN_SPLIT; const int e = it / 256, r = it % 256;
    tr_finish8(v, 64 * (r / 32), a.ws + WS_WDN, DFF, e * 1024 + 32 * (r % 32), nullptr, WDN_SC, scr, lane);
}
__device__ __forceinline__ float one_minus_exp(float x) {
    const float p = -x * (1.0f + x * (0.5f + x * (0.16666667f + x * (0.041666668f + x * 0.0083333338f))));
    const float e = 1.0f - __builtin_amdgcn_exp2f(x * 1.4426950408889634f);
    return (x > -0.25f) ? p : e;
}
__device__ __forceinline__ void lru_unit(const Args& a, const Ctx& C, int b, int blk, int half, int L) {
    unsigned char* ws = a.ws;
    const bf16_t* XL = (const bf16_t*)(ws + WS_A); const bf16_t* GL = XL + (size_t)NTOK * 512; bf16_t* YC = (bf16_t*)(ws + WS_C); float* SSQL = (float*)(ws + WS_SSQL);
    const int tid = C.tid, lane = C.lane, wave = C.wave, fr = lane & 15, fq = lane >> 4;
    LAS float* cscr = (LAS float*)(C.lds + 46336 + wave * 8448);
    LAS float* XW = (LAS float*)(C.lds + wave * 5120);
    LAS bf16_t* GW = (LAS bf16_t*)(C.lds + wave * 5120 + 2304);
    LAS bf16_t* YW = (LAS bf16_t*)(C.lds + wave * 5120 + 3584);
    LAS float* WSUM = (LAS float*)(C.lds + 40960);
    LAS float* CW = (LAS float*)(C.lds + 45056);
    const int c0 = blk * 64, oc0 = c0 + half * 32;
    bf16x8 wfr[2][2][2];
#pragma unroll
    for (int gt = 0; gt < 2; ++gt) { const float* W = a.in[gt == 0 ? 6 : 8] + (size_t)blk * 64 * 64;
#pragma unroll
        for (int nt = 0; nt < 2; ++nt)
#pragma unroll
            for (int ks = 0; ks < 2; ++ks) { u32x4 w; float f[8];
#pragma unroll
                for (int j = 0; j < 8; ++j) f[j] = W[(32 * ks + 8 * fq + j) * 64 + half * 32 + 16 * nt + fr];
                w.x = cvt_pk_bf16(f[0], f[1]); w.y = cvt_pk_bf16(f[2], f[3]); w.z = cvt_pk_bf16(f[4], f[5]); w.w = cvt_pk_bf16(f[6], f[7]);
                wfr[gt][nt][ks] = __builtin_bit_cast(bf16x8, w); } }
    LAS bf16x8* WF = (LAS bf16x8*)(C.lds + 113920);
    if (wave == 0) {
#pragma unroll
        for (int gt = 0; gt < 2; ++gt)
#pragma unroll
            for (int nt = 0; nt < 2; ++nt)
#pragma unroll
                for (int ks = 0; ks < 2; ++ks) WF[((gt * 2 + nt) * 2 + ks) * 64 + lane] = wfr[gt][nt][ks]; }
    float brg[2], big[2], sp[2], hc[2] = {0.f, 0.f};
#pragma unroll
    for (int nt = 0; nt < 2; ++nt) { const int ch = oc0 + 16 * nt + fr; brg[nt] = a.in[7][ch] * -1.4426950408889634f; big[nt] = a.in[9][ch] * -1.4426950408889634f; const float lam = a.in[10][ch];
        sp[nt] = -8.0f * 1.4426950408889634f * ((lam > 15.f) ? __expf(-lam) : log1pf(__expf(-lam))); }
    if (tid < 320) { const int k = tid >> 6, c = tid & 63; CW[tid] = (k < 4) ? a.in[4][k * DLRU + c0 + c] : a.in[5][c0 + c]; }
    u32x4 xr1[4][2], gr1;
    const bf16_t* xrow0 = XL + ((size_t)b * SEQ + 16 * wave + fr) * 512 + c0 + 8 * fq;
    const bf16_t* grow0 = GL + ((size_t)b * SEQ + 16 * wave + (lane >> 2)) * 512 + oc0 + 8 * (lane & 3);
    const int tloc = 16 * wave + fr;
#define LRU_PREFETCH(t0_, xr, gr) do { _Pragma("unroll") for (int k = 0; k < 4; ++k) { const int tt = (t0_) + tloc - 3 + k; \
        if (tt >= 0) { const bf16_t* xp = xrow0 + (ptrdiff_t)((t0_) - 3 + k) * 512; xr[k][0] = *(const u32x4*)xp; xr[k][1] = *(const u32x4*)(xp + 32); } else { xr[k][0] = (u32x4){0u, 0u, 0u, 0u}; xr[k][1] = (u32x4){0u, 0u, 0u, 0u}; } } \
        gr = *(const u32x4*)(grow0 + (size_t)(t0_) * 512); } while (0)
    LRU_PREFETCH(0, xr1, gr1);
    __syncthreads();
    for (int ch2 = 0; ch2 < SEQ / 256; ++ch2) {
#pragma unroll
      for (int sub = 0; sub < 2; ++sub) { const int ch = 2 * ch2 + sub, t0 = ch * 128; auto& xr = xr1; auto& gr = gr1;
        f32x4 cv[8]; const int cslot = sub * (NEXP * 512) + (ch2 * 256 + L) * 8 + wave; const bool chas = moe_item_load(cv, a, cslot, lane);
        bf16x8 af[2];
#pragma unroll
        for (int ks = 0; ks < 2; ++ks) { float accv[8];
            { const f32x4 b0 = *(const LAS f32x4*)(CW + 256 + 32 * ks + 8 * fq), b1 = *(const LAS f32x4*)(CW + 256 + 32 * ks + 8 * fq + 4);
              accv[0] = b0[0]; accv[1] = b0[1]; accv[2] = b0[2]; accv[3] = b0[3]; accv[4] = b1[0]; accv[5] = b1[1]; accv[6] = b1[2]; accv[7] = b1[3]; }
#pragma unroll
            for (int k = 0; k < 4; ++k) { const f32x4 w0 = *(const LAS f32x4*)(CW + 64 * k + 32 * ks + 8 * fq), w1 = *(const LAS f32x4*)(CW + 64 * k + 32 * ks + 8 * fq + 4); const u32x4 x = xr[k][ks];
                accv[0] += w0[0] * bflo(x.x); accv[1] += w0[1] * bfhi(x.x); accv[2] += w0[2] * bflo(x.y); accv[3] += w0[3] * bfhi(x.y);
                accv[4] += w1[0] * bflo(x.z); accv[5] += w1[1] * bfhi(x.z); accv[6] += w1[2] * bflo(x.w); accv[7] += w1[3] * bfhi(x.w); }
            u32x4 p; p.x = cvt_pk_bf16(accv[0], accv[1]); p.y = cvt_pk_bf16(accv[2], accv[3]); p.z = cvt_pk_bf16(accv[4], accv[5]); p.w = cvt_pk_bf16(accv[6], accv[7]);
            af[ks] = __builtin_bit_cast(bf16x8, p);
            if (ks == half) { *(LAS f32x4*)(XW + fr * 36 + 8 * fq) = (f32x4){accv[0], accv[1], accv[2], accv[3]}; *(LAS f32x4*)(XW + fr * 36 + 8 * fq + 4) = (f32x4){accv[4], accv[5], accv[6], accv[7]}; } }
        *(LAS u32x4*)(GW + (lane >> 2) * 40 + 8 * (lane & 3)) = gr;
        if (ch + 1 < SEQ / 128) LRU_PREFETCH(t0 + 128, xr, gr);
        LDS_WAIT(); asm volatile("" ::: "memory");
        float Hl[2][4], Al[2][4], Aex[2], Hex[2];
        { f32x4 ar[2] = {{0.f, 0.f, 0.f, 0.f}, {0.f, 0.f, 0.f, 0.f}}, ai_[2] = {{0.f, 0.f, 0.f, 0.f}, {0.f, 0.f, 0.f, 0.f}};
#pragma unroll
          for (int ks = 0; ks < 2; ++ks)
#pragma unroll
              for (int nt = 0; nt < 2; ++nt) { ar[nt] = __builtin_amdgcn_mfma_f32_16x16x32_bf16(af[ks], WF[((0 * 2 + nt) * 2 + ks) * 64 + lane], ar[nt], 0, 0, 0); ai_[nt] = __builtin_amdgcn_mfma_f32_16x16x32_bf16(af[ks], WF[((1 * 2 + nt) * 2 + ks) * 64 + lane], ai_[nt], 0, 0, 0); }
#pragma unroll
          for (int nt = 0; nt < 2; ++nt) {
              float hrun = 0.f, arun = 1.f;
#pragma unroll
              for (int r = 0; r < 4; ++r) { const int chn = 16 * nt + fr;
                  const float rg = __builtin_amdgcn_rcpf(1.0f + __builtin_amdgcn_exp2f(__builtin_fmaf(ar[nt][r], -1.4426950408889634f, brg[nt])));
                  const float ig = __builtin_amdgcn_rcpf(1.0f + __builtin_amdgcn_exp2f(__builtin_fmaf(ai_[nt][r], -1.4426950408889634f, big[nt])));
                  const float av = __builtin_amdgcn_exp2f(rg * sp[nt]); const float mult = __builtin_amdgcn_sqrtf(fmaxf(1.0f - av * av, 0.f));
                  const float uv = mult * ig * XW[(4 * fq + r) * 36 + chn];
                  hrun = av * hrun + uv; arun *= av; Hl[nt][r] = hrun; Al[nt][r] = arun; }
              const float A0 = __shfl(arun, fr), H0 = __shfl(hrun, fr), A1 = __shfl(arun, fr + 16), H1 = __shfl(hrun, fr + 16), A2 = __shfl(arun, fr + 32), H2 = __shfl(hrun, fr + 32), A3 = __shfl(arun, fr + 48), H3 = __shfl(hrun, fr + 48);
              const float h01 = A1 * H0 + H1, a01 = A1 * A0, h012 = A2 * h01 + H2, a012 = A2 * a01;
              Aex[nt] = (fq == 0) ? 1.f : (fq == 1) ? A0 : (fq == 2) ? a01 : a012;
              Hex[nt] = (fq == 0) ? 0.f : (fq == 1) ? H0 : (fq == 2) ? h01 : h012;
              if (fq == 0) *(LAS f32x2*)(WSUM + (((ch & 1) * 8 + wave) * 32 + 16 * nt + fr) * 2) = (f32x2){A3 * a012, A3 * h012 + H3}; } }
        __syncthreads();
        { float ssr[4] = {0.f, 0.f, 0.f, 0.f};
#pragma unroll
          for (int nt = 0; nt < 2; ++nt) { const int chn = 16 * nt + fr; float x = hc[nt], mine = 0.f;
#pragma unroll
              for (int w2 = 0; w2 < 8; ++w2) { const f32x2 sm = *(const LAS f32x2*)(WSUM + (((ch & 1) * 8 + w2) * 32 + chn) * 2); if (w2 == wave) mine = x; x = sm[0] * x + sm[1]; }
              hc[nt] = x;
              const float hstart = Aex[nt] * mine + Hex[nt];
#pragma unroll
              for (int r = 0; r < 4; ++r) { const int tl = 4 * fq + r; const float h = Al[nt][r] * hstart + Hl[nt][r];
                  const float y = h * gelu_tanh(bf2f(GW[tl * 40 + chn])); const unsigned yb = cvt_pk_bf16(y, 0.f) & 0xffffu; YW[tl * 40 + chn] = (bf16_t)yb;
                  const float yr = __uint_as_float(yb << 16); ssr[r] += yr * yr; } }
#pragma unroll
          for (int r = 0; r < 4; ++r) { float q = ssr[r]; q += __shfl_xor(q, 1); q += __shfl_xor(q, 2); q += __shfl_xor(q, 4); q += __shfl_xor(q, 8);
              if (fr == 0) SSQL[((size_t)b * SEQ + t0 + 16 * wave + 4 * fq + r) * 16 + blk * 2 + half] = q; } }
        LDS_WAIT(); asm volatile("" ::: "memory");
        *(u32x4*)(YC + ((size_t)b * SEQ + t0 + 16 * wave + (lane >> 2)) * DM + oc0 + 8 * (lane & 3)) = *(const LAS u32x4*)(YW + (lane >> 2) * 40 + 8 * (lane & 3));
        if (chas) moe_item_finish(cv, a, cslot, cscr, lane);
      }
    }
#undef LRU_PREFETCH
    __syncthreads();
}

__device__ __forceinline__ void moba_unit_simple(const Args& a, const Ctx& C, int b, int h, int qb) {
    unsigned char* ws = a.ws;
    const bf16_t* Q = (const bf16_t*)(ws + WS_A) + (size_t)2 * NTOK * 512; const bf16_t* K = Q + (size_t)NTOK * 512; const bf16_t* V = K + (size_t)NTOK * 512;
    bf16_t* YA = (bf16_t*)(ws + WS_B) + (size_t)NTOK * 512; const float* KSUM = (const float*)(ws + WS_KSUM);
    const int q = C.tid & 255, hf = C.tid >> 8; const size_t row = (size_t)b * SEQ + qb * 256 + q;
    float qv[64];
    { const u32x4* qp = (const u32x4*)(Q + row * 512 + h * 64);
#pragma unroll
      for (int i = 0; i < 8; ++i) { const u32x4 w = qp[i]; qv[8 * i] = bflo(w.x); qv[8 * i + 1] = bfhi(w.x); qv[8 * i + 2] = bflo(w.y); qv[8 * i + 3] = bfhi(w.y); qv[8 * i + 4] = bflo(w.z); qv[8 * i + 5] = bfhi(w.z); qv[8 * i + 6] = bflo(w.w); qv[8 * i + 7] = bfhi(w.w); } }
    unsigned sel = 0u;
    { float g[8];
#pragma unroll
      for (int n = 0; n < 8; ++n) { g[n] = -INFINITY;
          if (n < qb) { const float* ks = KSUM + (size_t)(b * 8 + n) * 512 + h * 64; float s = 0.f;
#pragma unroll
              for (int d = 0; d < 64; ++d) s += qv[d] * ks[d];
              g[n] = s; } }
      const int npick = qb < 3 ? qb : 3;
      for (int p = 0; p < npick; ++p) { int best = -1; float bv = -INFINITY;
#pragma unroll
          for (int n = 0; n < 8; ++n) { const bool ok = (n < qb) && !((sel >> n) & 1u) && (best < 0 || g[n] > bv); if (ok) { best = n; bv = g[n]; } }
          if (best >= 0) sel |= 1u << best; } }
    float o[32], mrun = -1e30f, l = 0.f;
#pragma unroll
    for (int d = 0; d < 32; ++d) o[d] = 0.f;
    for (int n = 0; n <= qb; ++n) {
        const bool own = (n == qb); const bool use = own || ((sel >> n) & 1u);
        if (!__any(use)) continue;
        for (int j = 0; j < 256; ++j) {
            const bool valid = use && (!own || j <= q);
            if (!__any(valid)) continue;
            const size_t krow = (size_t)b * SEQ + n * 256 + j;
            const u32x4* kp = (const u32x4*)(K + krow * 512 + h * 64); float s = 0.f;
#pragma unroll
            for (int i = 0; i < 8; ++i) { const u32x4 w = kp[i];
                s += qv[8 * i] * bflo(w.x) + qv[8 * i + 1] * bfhi(w.x) + qv[8 * i + 2] * bflo(w.y) + qv[8 * i + 3] * bfhi(w.y) + qv[8 * i + 4] * bflo(w.z) + qv[8 * i + 5] * bfhi(w.z) + qv[8 * i + 6] * bflo(w.w) + qv[8 * i + 7] * bfhi(w.w); }
            if (valid) {
                const float mnew = fmaxf(mrun, s), f = __builtin_amdgcn_exp2f(mrun - mnew), p = __builtin_amdgcn_exp2f(s - mnew);
                l = l * f + p; mrun = mnew;
                const u32x4* vp = (const u32x4*)(V + krow * 512 + h * 64 + 32 * hf);
#pragma unroll
                for (int i = 0; i < 4; ++i) { const u32x4 w = vp[i];
                    o[8 * i] = o[8 * i] * f + p * bflo(w.x); o[8 * i + 1] = o[8 * i + 1] * f + p * bfhi(w.x); o[8 * i + 2] = o[8 * i + 2] * f + p * bflo(w.y); o[8 * i + 3] = o[8 * i + 3] * f + p * bfhi(w.y);
                    o[8 * i + 4] = o[8 * i + 4] * f + p * bflo(w.z); o[8 * i + 5] = o[8 * i + 5] * f + p * bfhi(w.z); o[8 * i + 6] = o[8 * i + 6] * f + p * bflo(w.w); o[8 * i + 7] = o[8 * i + 7] * f + p * bfhi(w.w); }
            }
        }
    }
    const float inv = 1.0f / l;
    u32x4* op = (u32x4*)(YA + row * 512 + h * 64 + 32 * hf);
#pragma unroll
    for (int i = 0; i < 4; ++i) { u32x4 w; w.x = cvt_pk_bf16(o[8 * i] * inv, o[8 * i + 1] * inv); w.y = cvt_pk_bf16(o[8 * i + 2] * inv, o[8 * i + 3] * inv); w.z = cvt_pk_bf16(o[8 * i + 4] * inv, o[8 * i + 5] * inv); w.w = cvt_pk_bf16(o[8 * i + 6] * inv, o[8 * i + 7] * inv); op[i] = w; }
}

__device__ __forceinline__ void ph_ymix(const Args& a, const Ctx& C) {
    const bf16_t* YL = (const bf16_t*)(a.ws + WS_B); const bf16_t* YA = YL + (size_t)NTOK * 512; bf16_t* YM = (bf16_t*)(a.ws + WS_C);
    const int gw = C.vcu * 8 + C.wave, NGW = C.G * 8, lane = C.lane;
    for (int m = gw; m < NTOK; m += NGW) {
#pragma unroll
        for (int part = 0; part < 2; ++part) {
            const u32x4 w = *((const u32x4*)((part ? YA : YL) + (size_t)m * 512) + lane);
            float v[8] = {bflo(w.x), bfhi(w.x), bflo(w.y), bfhi(w.y), bflo(w.z), bfhi(w.z), bflo(w.w), bfhi(w.w)}; float s = 0.f;
#pragma unroll
            for (int i = 0; i < 8; ++i) s += v[i] * v[i];
            const float rstd = 1.0f / sqrtf(wave_sum(s) * (1.0f / 512.0f) + EPS);
            u32x4 o; o.x = cvt_pk_bf16(v[0] * rstd, v[1] * rstd); o.y = cvt_pk_bf16(v[2] * rstd, v[3] * rstd); o.z = cvt_pk_bf16(v[4] * rstd, v[5] * rstd); o.w = cvt_pk_bf16(v[6] * rstd, v[7] * rstd);
            *((u32x4*)(YM + (size_t)m * DM + part * 512) + lane) = o;
        }
    }
}

__device__ __forceinline__ void ph_router(const Args& a, const Ctx& C) {
    unsigned char* ws = a.ws;
    const bf16_t* H2B = (const bf16_t*)a.out + DM; const bf16_t* WR = (const bf16_t*)(ws + WS_WR); const float* SSQ2 = (const float*)(ws + WS_SSQ2);
    unsigned* CNT = (unsigned*)(ws + WS_CTL) + CW_CNT;
    int* TOKE = (int*)(ws + WS_TOK + TOK_E); int* TOKR = (int*)(ws + WS_TOK + TOK_R); float* TOKG = (float*)(ws + WS_TOK + TOK_G); int* LTOK = (int*)(ws + WS_LTOK); float* LRS = (float*)(ws + WS_LRS);
    constexpr int WRS = 1032;
    LAS bf16_t* WRL = (LAS bf16_t*)C.lds;
    LAS float* LG = (LAS float*)(C.lds + 99072) + C.wave * (16 * 49);
    LAS unsigned* lcnt = (LAS unsigned*)(C.lds + 99072 + 25088); LAS unsigned* lbase = lcnt + 32;
    const int lane = C.lane, fr = lane & 15, fq = lane >> 4;
    for (int i = C.tid; i < 48 * 128; i += 512) { const int r = i >> 7, c8 = i & 127; *(LAS u32x4*)(WRL + r * WRS + 8 * c8) = *(const u32x4*)(WR + (size_t)r * DM + 8 * c8); }
    for (int pass = 0; (pass * C.G) * 128 < NTOK; ++pass) {
        const int blk = pass * C.G + C.vcu; const bool live = blk * 128 < NTOK;
        if (C.tid < 32) lcnt[C.tid] = 0u;
        __syncthreads();
        int E1 = 0, E2 = 0; unsigned r1 = 0, r2 = 0; float ga = 0.f, gb = 0.f, rstd_t = 0.f; const int tb = blk * 128 + 16 * C.wave;
        if (live) {
            f32x4 acc[3] = {{0.f, 0.f, 0.f, 0.f}, {0.f, 0.f, 0.f, 0.f}, {0.f, 0.f, 0.f, 0.f}};
            bf16x8 af[32];
#pragma unroll
            for (int ks = 0; ks < 32; ++ks) af[ks] = *(const bf16x8*)(H2B + (size_t)(tb + fr) * LDH + 32 * ks + 8 * fq);
#pragma unroll
            for (int ks = 0; ks < 32; ++ks) {
#pragma unroll
                for (int nt = 0; nt < 3; ++nt) { const bf16x8 bfg = *(const LAS bf16x8*)(WRL + (16 * nt + fr) * WRS + 32 * ks + 8 * fq); acc[nt] = __builtin_amdgcn_mfma_f32_16x16x32_bf16(af[ks], bfg, acc[nt], 0, 0, 0); } }
#pragma unroll
            for (int nt = 0; nt < 3; ++nt)
#pragma unroll
                for (int r = 0; r < 4; ++r) LG[(4 * fq + r) * 49 + 16 * nt + fr] = acc[nt][r];
            LDS_WAIT(); asm volatile("" ::: "memory");
            if (lane < 16) { const int t = tb + lane; const float rstd = rstd_from_ssq(SSQ2, t); rstd_t = rstd; const LAS float* lg = LG + lane * 49;
                float g[4]; int grp = 0;
#pragma unroll
                for (int i = 0; i < 4; ++i) g[i] = lg[i] * rstd + a.in[21][i];
#pragma unroll
                for (int i = 1; i < 4; ++i) if (g[i] > g[grp]) grp = i;
                float gs = 0.f;
#pragma unroll
                for (int i = 0; i < 4; ++i) gs += __expf(g[i] - g[grp]);
                const float gw_ = 1.0f / gs;
                float e[8];
#pragma unroll
                for (int i = 0; i < 8; ++i) e[i] = lg[4 + 8 * grp + i] * rstd + a.in[23][8 * grp + i];
                int i1 = 0;
#pragma unroll
                for (int i = 1; i < 8; ++i) if (e[i] > e[i1]) i1 = i;
                int i2 = (i1 == 0) ? 1 : 0;
#pragma unroll
                for (int i = 0; i < 8; ++i) if (i != i1 && i != i2 && e[i] > e[i2]) i2 = i;
                const float eb = __expf(e[i2] - e[i1]); ga = gw_ / (1.0f + eb); gb = gw_ * eb / (1.0f + eb);
                E1 = grp * 8 + i1; E2 = grp * 8 + i2;
                r1 = atomicAdd((unsigned*)&lcnt[E1], 1u); r2 = atomicAdd((unsigned*)&lcnt[E2], 1u);
            }
        }
        __syncthreads();
        if (C.tid < 32) lbase[C.tid] = lcnt[C.tid] ? __hip_atomic_fetch_add(CNT + C.tid, lcnt[C.tid], __ATOMIC_RELAXED, __HIP_MEMORY_SCOPE_AGENT) : 0u;
        __syncthreads();
        if (live && lane < 16) { const int t = tb + lane;
            const int k1 = (int)(lbase[E1] + r1), k2 = (int)(lbase[E2] + r2);
            TOKE[2 * t] = E1; TOKR[2 * t] = k1; TOKG[2 * t] = ga; LTOK[E1 * LCAP + k1] = t; LRS[E1 * LCAP + k1] = rstd_t;
            TOKE[2 * t + 1] = E2; TOKR[2 * t + 1] = k2; TOKG[2 * t + 1] = gb; LTOK[E2 * LCAP + k2] = t; LRS[E2 * LCAP + k2] = rstd_t; }
        __syncthreads();
    }
}
__device__ __forceinline__ void moe_table(const Args& a, const Ctx& C) {
    LAS int* ts = (LAS int*)(C.lds + MOE_OFF);
    if (C.tid == 0) { const unsigned* CNT = (const unsigned*)(a.ws + WS_CTL) + CW_CNT; int acc = 0;
        for (int e = 0; e < NEXP; ++e) { ts[e] = acc; const unsigned c = __hip_atomic_load(CNT + e, __ATOMIC_RELAXED, __HIP_MEMORY_SCOPE_AGENT); ts[33 + e] = (int)c; acc += (int)((c + 255u) >> 8); }
        ts[NEXP] = acc; }
    __syncthreads();
}
__device__ __forceinline__ void ph_final(const Args& a, const Ctx& C, float* outp) {
    unsigned char* ws = a.ws;
    const unsigned char* YB = ws + WS_A; const float* TOKG = (const float*)(ws + WS_TOK + TOK_G); const int* TOKE = (const int*)(ws + WS_TOK + TOK_E); const int* TOKR = (const int*)(ws + WS_TOK + TOK_R);
    const LAS int* ts = (const LAS int*)(C.lds + MOE_OFF);
    const bf16_t* H2B = (const bf16_t*)a.out + DM; const float* gf = a.in[26];
    const int gw = C.vcu * 8 + C.wave, NGW = C.G * 8, lane = C.lane;
    f32x4 gn[4];
#pragma unroll
    for (int q = 0; q < 4; ++q) gn[q] = *(const f32x4*)(gf + 512 * (q >> 1) + 8 * lane + 4 * (q & 1));
    const int nit = (NTOK + NGW - 1) / NGW;
    int dnx = 0; float gnx = 0.f;
#define FIN_IDX(ib) do { const int tt_ = gw + ((ib) + (lane >> 1)) * NGW; dnx = 0; gnx = 0.f; \
        if (lane < 8 && tt_ < NTOK) { const int e_ = TOKE[2 * tt_ + (lane & 1)]; dnx = ts[e_] * 256 + TOKR[2 * tt_ + (lane & 1)]; gnx = TOKG[2 * tt_ + (lane & 1)]; } } while (0)
    FIN_IDX(0);
    for (int ib = 0; ib < nit; ib += 4) {
        const int dcur = dnx; const float gcur = gnx;
        if (ib + 4 < nit) FIN_IDX(ib + 4);
        u32x4 hw[4][2]; u32x2 y0[4][2], y1[4][2];
#pragma unroll
        for (int j = 0; j < 4; ++j) { const int t = gw + (ib + j) * NGW; const int d0 = __builtin_amdgcn_readlane(dcur, 2 * j), d1 = __builtin_amdgcn_readlane(dcur, 2 * j + 1);
            if (t < NTOK) {
#pragma unroll
                for (int hf = 0; hf < 2; ++hf) { hw[j][hf] = *((const u32x4*)(H2B + (size_t)t * LDH + 512 * hf) + lane); y0[j][hf] = *((const u32x2*)(YB + (size_t)d0 * DM + 512 * hf) + lane); y1[j][hf] = *((const u32x2*)(YB + (size_t)d1 * DM + 512 * hf) + lane); } } }
#pragma unroll
        for (int j = 0; j < 4; ++j) { const int t = gw + (ib + j) * NGW;
            const float g0 = __builtin_bit_cast(float, __builtin_amdgcn_readlane(__builtin_bit_cast(int, gcur), 2 * j)) * (1.0f / YB_SC), g1 = __builtin_bit_cast(float, __builtin_amdgcn_readlane(__builtin_bit_cast(int, gcur), 2 * j + 1)) * (1.0f / YB_SC);
            if (t < NTOK) { float v[16]; float s2 = 0.f;
#pragma unroll
                for (int hf = 0; hf < 2; ++hf)
#pragma unroll
                    for (int w = 0; w < 2; ++w) { const int yw0 = (int)y0[j][hf][w], yw1 = (int)y1[j][hf][w];
                        const f32x2 pa = __builtin_amdgcn_cvt_pk_f32_fp8(yw0, false), pb = __builtin_amdgcn_cvt_pk_f32_fp8(yw0, true), qa = __builtin_amdgcn_cvt_pk_f32_fp8(yw1, false), qb = __builtin_amdgcn_cvt_pk_f32_fp8(yw1, true);
                        const unsigned ha = hw[j][hf][2 * w], hb = hw[j][hf][2 * w + 1];
                        const float e0 = bflo(ha) + g0 * pa[0] + g1 * qa[0], e1 = bfhi(ha) + g0 * pa[1] + g1 * qa[1], e2 = bflo(hb) + g0 * pb[0] + g1 * qb[0], e3 = bfhi(hb) + g0 * pb[1] + g1 * qb[1];
                        v[8 * hf + 4 * w] = e0; v[8 * hf + 4 * w + 1] = e1; v[8 * hf + 4 * w + 2] = e2; v[8 * hf + 4 * w + 3] = e3; s2 += (e0 * e0 + e1 * e1) + (e2 * e2 + e3 * e3); }
                const float rstd = __builtin_amdgcn_rsqf(wave_sum(s2) * (1.0f / DM) + EPS);
#pragma unroll
                for (int q = 0; q < 4; ++q) { const f32x4 o = {v[4 * q] * rstd * gn[q][0], v[4 * q + 1] * rstd * gn[q][1], v[4 * q + 2] * rstd * gn[q][2], v[4 * q + 3] * rstd * gn[q][3]};
                    *(f32x4*)(outp + (size_t)t * DM + 512 * (q >> 1) + 8 * lane + 4 * (q & 1)) = o; } } }
    }
#undef FIN_IDX
}

#include <hip/hip_bf16.h>
#include <cmath>
namespace attn_body {
using bf16=__hip_bfloat16;
using bf16x8=__attribute__((ext_vector_type(8)))short;
using s16x4=__attribute__((ext_vector_type(4)))short;
using f32x16=__attribute__((ext_vector_type(16)))float;
using u32x4=__attribute__((ext_vector_type(4)))unsigned;
using f32x4_t=__attribute__((ext_vector_type(4)))float;
constexpr int BATCH=16,NHEAD=8,SEQ=2048,D=64,DM=NHEAD*D,DMO=1024;
constexpr int NW=8,QBLK=32,QB=QBLK*NW,KVBLK=64,NQB=SEQ/QB;
constexpr int ATTN_PITCH=DM, ATTN_UNIT_ROWS=QB;
__device__ __forceinline__ int crow(int r,int hi){return (r&3)+8*(r>>2)+4*hi;}
#define SBAR() __builtin_amdgcn_sched_barrier(0)
__device__ __forceinline__ void cmask(f32x16&p0,f32x16&p1,int jb,int qrel,int hi){
  const float NEG=-INFINITY; int kb=64*jb+4*hi; asm volatile("":"+v"(kb));
  #pragma unroll
  for(int r=0;r<16;++r){int kv=kb+(r&3)+8*(r>>2); if(kv>qrel)p0[r]=NEG; if(kv+32>qrel)p1[r]=NEG;}
}

constexpr int NSLOT=3, SLOTB=8192;
constexpr int LDS_K=0, LDS_V=NSLOT*SLOTB, LDS_WS=2*NSLOT*SLOTB, LDS_OST=LDS_WS+NW*64*4, LDS_BYTES=LDS_OST+NW*4096;
constexpr float C2=0.125f*1.4426950408889634f;
__device__ __forceinline__ void glds16(const char*sbase,unsigned voff,unsigned lds_dst){unsigned keep;
  asm volatile("s_nop 4\n\ts_mov_b32 %0, m0\n\ts_mov_b32 m0, %3\n\ts_nop 0\n\tglobal_load_lds_dwordx4 %1, %2\n\ts_mov_b32 m0, %0":"=&s"(keep):"v"(voff),"s"(sbase),"s"(lds_dst):"memory");}
__device__ __forceinline__ const char* uni_ptr(const void*p){const unsigned long long v=(unsigned long long)p;const unsigned lo=__builtin_amdgcn_readfirstlane((unsigned)v),hi=__builtin_amdgcn_readfirstlane((unsigned)(v>>32));return (const char*)(((unsigned long long)hi<<32)|lo);}
__device__ __forceinline__ float max3f(float a,float b,float c){float r;asm("v_max3_f32 %0, %1, %2, %3":"=v"(r):"v"(a),"v"(b),"v"(c));return r;}
__device__ __forceinline__ float max2f(float a,float b){float r;asm("v_max_f32_e32 %0, %1, %2":"=v"(r):"v"(a),"v"(b));return r;}
__device__ __forceinline__ float fadd_s(float a,float b){float r;asm("v_add_f32_e32 %0, %1, %2":"=v"(r):"v"(a),"v"(b));return r;}
__device__ __forceinline__ float fsub_s(float a,float b){float r;asm("v_sub_f32_e32 %0, %1, %2":"=v"(r):"v"(a),"v"(b));return r;}
typedef float f32x2_t __attribute__((ext_vector_type(2))); typedef __bf16 bf16x2_t __attribute__((ext_vector_type(2)));
__device__ __forceinline__ unsigned cvtpk_s(float lo,float hi){f32x2_t v={lo,hi};bf16x2_t b=__builtin_convertvector(v,bf16x2_t);return __builtin_bit_cast(unsigned,b);}
#define WAIT_BAR(N) asm volatile("s_waitcnt vmcnt(" #N ") lgkmcnt(0)\n\ts_barrier":::"memory")

__device__ __forceinline__ void qkt(f32x16&p0,f32x16&p1,const char*Kslot,const bf16x8*qr,const f32x16&negm,int r32,int hi){
  const char*kb=Kslot+hi*1024+r32*16;
  #pragma unroll
  for(int d0=0;d0<4;++d0){
    const bf16x8 b0=*reinterpret_cast<const bf16x8*>(kb+d0*2048);
    const bf16x8 b1=*reinterpret_cast<const bf16x8*>(kb+d0*2048+512);
    if(d0==0){p0=__builtin_amdgcn_mfma_f32_32x32x16_bf16(b0,qr[0],negm,0,0,0);p1=__builtin_amdgcn_mfma_f32_32x32x16_bf16(b1,qr[0],negm,0,0,0);}
    else{p0=__builtin_amdgcn_mfma_f32_32x32x16_bf16(b0,qr[d0],p0,0,0,0);p1=__builtin_amdgcn_mfma_f32_32x32x16_bf16(b1,qr[d0],p1,0,0,0);}}
}
typedef __attribute__((address_space(3))) const char* lds_cptr;
typedef short v4i16_t __attribute__((ext_vector_type(4)));
__device__ __forceinline__ void kload8(bf16x8*kf,lds_cptr kp){
  kf[0]=*(const __attribute__((address_space(3))) bf16x8*)(kp);      kf[1]=*(const __attribute__((address_space(3))) bf16x8*)(kp+512);
  kf[2]=*(const __attribute__((address_space(3))) bf16x8*)(kp+2048); kf[3]=*(const __attribute__((address_space(3))) bf16x8*)(kp+2560);
  kf[4]=*(const __attribute__((address_space(3))) bf16x8*)(kp+4096); kf[5]=*(const __attribute__((address_space(3))) bf16x8*)(kp+4608);
  kf[6]=*(const __attribute__((address_space(3))) bf16x8*)(kp+6144); kf[7]=*(const __attribute__((address_space(3))) bf16x8*)(kp+6656);
}
__device__ __forceinline__ void kload2(bf16x8*kf,lds_cptr kp,int j){ kf[2*j]=*(const __attribute__((address_space(3))) bf16x8*)(kp+j*2048); kf[2*j+1]=*(const __attribute__((address_space(3))) bf16x8*)(kp+j*2048+512); }
__device__ __forceinline__ s16x4 vtr(lds_cptr p){ return __builtin_bit_cast(s16x4,__builtin_amdgcn_ds_read_tr16_b64_v4i16((__attribute__((address_space(3))) v4i16_t*)p)); }
__device__ __forceinline__ float rowmax(const f32x16&p0,const f32x16&p1){
  float a=max3f(p0[0],p0[1],p1[0]),b=max3f(p0[2],p0[3],p1[1]);a=max3f(a,p1[2],p1[3]);
  #pragma unroll
  for(int r=4;r<16;r+=4){a=max3f(a,p0[r],p0[r+1]);b=max3f(b,p0[r+2],p0[r+3]);a=max3f(a,p1[r],p1[r+1]);b=max3f(b,p1[r+2],p1[r+3]);}
  const float m=max2f(a,b);
  auto rr=__builtin_amdgcn_permlane32_swap(__float_as_uint(m),__float_as_uint(m),false,false);
  return max2f(__uint_as_float(rr[0]),__uint_as_float(rr[1]));
}
__device__ __forceinline__ void pv(f32x16*o,int vb,bf16x8 pa0,bf16x8 pa1,bf16x8 pa2,bf16x8 pa3){
  #pragma unroll
  for(int d0=0;d0<2;++d0){s16x4 lo[4],hi[4];
    #pragma unroll
    for(int ks=0;ks<4;++ks){
      asm volatile("ds_read_b64_tr_b16 %0,%1 offset:%c2":"=&v"(lo[ks]):"v"(vb),"i"(d0*4096+ks*1024):"memory");
      asm volatile("ds_read_b64_tr_b16 %0,%1 offset:%c2":"=&v"(hi[ks]):"v"(vb),"i"(d0*4096+ks*1024+512):"memory");}
    asm volatile("s_waitcnt lgkmcnt(0)":::"memory");SBAR();
    #define PK(k) (bf16x8){lo[k][0],lo[k][1],lo[k][2],lo[k][3],hi[k][0],hi[k][1],hi[k][2],hi[k][3]}
    o[d0]=__builtin_amdgcn_mfma_f32_32x32x16_bf16(pa0,PK(0),o[d0],0,0,0);
    o[d0]=__builtin_amdgcn_mfma_f32_32x32x16_bf16(pa1,PK(1),o[d0],0,0,0);
    o[d0]=__builtin_amdgcn_mfma_f32_32x32x16_bf16(pa2,PK(2),o[d0],0,0,0);
    o[d0]=__builtin_amdgcn_mfma_f32_32x32x16_bf16(pa3,PK(3),o[d0],0,0,0);
    #undef PK
  }
}

#ifndef ATTN_STORE16
#define ATTN_STORE16(p,v) (*(u32x4*)(p)=(v))
#endif
template<int THRL> __device__ __forceinline__ void attn_unit(int b,int h,int qb,const bf16*Q,const bf16*__restrict__ K,const bf16*__restrict__ V,bf16*O,const float*__restrict__ KSUM,float*__restrict__ SSQA,char*shm){
  int tid=threadIdx.x; asm volatile("":"+v"(tid));
  const int lane=tid&63,r32=lane&31,hi=lane>>5; const int wid=__builtin_amdgcn_readfirstlane(tid>>6);
  const long rowbase=(long)b*SEQ; const int q0=qb*QB;
  const bf16*Qw=Q+(rowbase+q0+wid*QBLK)*DM+h*D;
  const bf16*Kh=K+rowbase*DM+h*D,*Vh=V+rowbase*DM+h*D;
  const unsigned lds0=(unsigned)(uintptr_t)shm;
  float*wsf=(float*)(shm+LDS_WS)+wid*64;
  const char*Khu=uni_ptr(Kh);const char*Vhu=uni_ptr(Vh);
  const unsigned kvo=(unsigned)(lane*DM+wid*8)*2u;
  const unsigned vvo=(unsigned)((16*(wid&3)+(lane>>2))*DM+(wid>>2)*32+(lane&3)*8)*2u;
  const unsigned kdst=lds0+LDS_K+wid*1024, vdst=lds0+LDS_V+wid*1024;
  #define DMA_K(t,slot) glds16(Khu+(size_t)(t)*(KVBLK*DM*2),kvo,(unsigned)__builtin_amdgcn_readfirstlane(kdst+(slot)))
  #define DMA_V(t,slot) glds16(Vhu+(size_t)(t)*(KVBLK*DM*2),vvo,(unsigned)__builtin_amdgcn_readfirstlane(vdst+(slot)))
  const int vb0=(int)(lds0+LDS_V)+((lane>>4)&1)*32+(lane&3)*8+(4*hi+((lane&15)>>2))*64;
  const char*Kbase=shm+LDS_K; bf16x8 kf[8];
  const lds_cptr shm3=(lds_cptr)shm; const lds_cptr kp0=shm3+LDS_K+hi*1024+r32*16; const lds_cptr vp0=shm3+LDS_V+((lane>>4)&1)*32+(lane&3)*8+(4*hi+((lane&15)>>2))*64;
  const int NT=(q0+QB)/KVBLK;
  DMA_K(0,0);DMA_V(0,0);DMA_K(1,SLOTB);
  bf16x8 qr[4];
  #pragma unroll
  for(int d0=0;d0<4;++d0)qr[d0]=*reinterpret_cast<const bf16x8*>(&Qw[(long)r32*DM+d0*16+hi*8]);
  unsigned selm=1u<<qb;
  { float g[8];
    #pragma unroll
    for(int n=0;n<8;++n){ g[n]=-INFINITY;
      if(n<qb){ const float*ks=KSUM+(long)(b*8+n)*DM+h*D+hi*8; float s=0.f;
        #pragma unroll
        for(int d0=0;d0<4;++d0){ const f32x4_t k0=*reinterpret_cast<const f32x4_t*>(ks+d0*16), k1=*reinterpret_cast<const f32x4_t*>(ks+d0*16+4);
          const u32x4 qw=__builtin_bit_cast(u32x4,qr[d0]);
          s+=__uint_as_float(qw[0]<<16)*k0[0]+__uint_as_float(qw[0]&0xffff0000u)*k0[1]+__uint_as_float(qw[1]<<16)*k0[2]+__uint_as_float(qw[1]&0xffff0000u)*k0[3]
            +__uint_as_float(qw[2]<<16)*k1[0]+__uint_as_float(qw[2]&0xffff0000u)*k1[1]+__uint_as_float(qw[3]<<16)*k1[2]+__uint_as_float(qw[3]&0xffff0000u)*k1[3]; }
        s+=__shfl_xor(s,32); g[n]=s; } }
    const int npick=qb<3?qb:3;
    for(int p=0;p<npick;++p){ int best=-1; float bv=-INFINITY;
      #pragma unroll
      for(int n=0;n<8;++n){ const bool ok=(n<qb)&&!((selm>>n)&1u)&&(best<0||g[n]>bv); if(ok){best=n;bv=g[n];} }
      if(best>=0)selm|=1u<<best; } }
  #define BMASK(P0,P1,t) do{ float bias_=((selm>>((t)>>2))&1u)?-mhat:-INFINITY; asm volatile("":"+v"(bias_)); _Pragma("unroll") for(int r=0;r<16;++r){P0[r]+=bias_;P1[r]+=bias_;} }while(0)
  float mhat=0.f,l_reg=0.f;f32x16 o[2];{float z0_=0.f;asm volatile("":"+v"(z0_));_Pragma("unroll") for(int r=0;r<16;++r){o[0][r]=z0_;o[1][r]=z0_;}}const f32x16 negm=f32x16{};
  const int qrel=wid*QBLK+r32;
  #define CMASK(P0,P1,t) do{int jb_=(t)-(NT-4); if(jb_>=0)cmask(P0,P1,jb_,qrel,hi);}while(0)
  bool resc=false;
  #define START(P0,P1) do{ const float rm=__builtin_fmaxf(rowmax(P0,P1),-100.0f); resc=false; \
    { const float dl=rm; mhat=fadd_s(mhat,dl); \
      _Pragma("unroll") for(int r=0;r<16;++r){P0[r]=fsub_s(P0[r],dl);P1[r]=fsub_s(P1[r],dl);} \
      } \
    _Pragma("unroll") for(int r=0;r<16;++r)P0[r]=__builtin_amdgcn_exp2f(P0[r]); }while(0)
  #define RESC() do{ if(resc){ asm volatile("s_waitcnt lgkmcnt(0)":::"memory"); \
      _Pragma("unroll") for(int d_=0;d_<2;++d_) _Pragma("unroll") for(int r=0;r<16;++r)o[d_][r]*=wsf[crow(r,hi)]; } }while(0)
  f32x16 pA0,pA1,pB0,pB1;
  int sl_prev=0,sl_cur=0,sl_next=SLOTB;
  #define ROT() do{sl_prev=sl_cur;sl_cur=sl_next;sl_next=(sl_next==(NSLOT-1)*SLOTB)?0:sl_next+SLOTB;}while(0)
  DMA_K(2,2*SLOTB);
  WAIT_BAR(3);
  qkt(pA0,pA1,Kbase,qr,negm,r32,hi);asm volatile("s_nop 15\n\ts_nop 7":"+v"(pA0),"+v"(pA1));CMASK(pA0,pA1,0);BMASK(pA0,pA1,0);
  START(pA0,pA1);
  _Pragma("unroll") for(int r=0;r<16;++r)pA1[r]=__builtin_amdgcn_exp2f(pA1[r]);
  WAIT_BAR(0);
  DMA_K(3,0);DMA_V(1,SLOTB);
  ROT();
  kload8(kf,kp0+sl_cur);
  WAIT_BAR(2);
  s16x4 vlo[8],vhi[8]; u32x4 pw0,pw1,pw2,pw3;
  #define PKW(P,B) cvtpk_s(P[B],P[B+1])
  #define PAF(k) __builtin_bit_cast(bf16x8,pw##k)
  #define VFR(i) (bf16x8){vlo[i][0],vlo[i][1],vlo[i][2],vlo[i][3],vhi[i][0],vhi[i][1],vhi[i][2],vhi[i][3]}
  #define PIN(x) asm volatile("":"+v"(x))
  #define MX3(a,b,c) __builtin_fmaxf(__builtin_fmaxf((a),(b)),(c))
  #define GAPA(MF,A0,A1,A2,A3,W0,W1,PW) do{ MF; sacc+=A0; sacc+=A1; sacc+=A2; sacc+=A3; PIN(sacc); W0; W1; PIN(PW); SBAR(); }while(0)
  #define EX(v) __builtin_amdgcn_exp2f(v)
  #define GAPB(MF,X,B) do{ MF; X[B]=EX(X[B]); X[B+1]=EX(X[B+1]); X[B+2]=EX(X[B+2]); X[B+3]=EX(X[B+3]); PIN(X); SBAR(); }while(0)
  #define VRD(i) do{ vlo[i]=vtr(vp_+(((i)>>2)*4096+((i)&3)*1024)); vhi[i]=vtr(vp_+(((i)>>2)*4096+((i)&3)*1024+512)); }while(0)
  #define KRD(G,j) do{ if(G){ kload2(kf,kp0+sl_next,j); SBAR(); } }while(0)
  #define STEP(C0,C1,P0,P1,t,GK,GV,GL) do{ SBAR(); \
    const lds_cptr vp_=vp0+sl_prev; \
    VRD(0); SBAR(); float sacc=(P0[0]+P0[1]); \
    GAPA(C0=__builtin_amdgcn_mfma_f32_32x32x16_bf16(kf[0],qr[0],negm,0,0,0), P0[2],P0[3],P0[4],P0[5],     pw0[0]=PKW(P0,0), pw0[1]=PKW(P0,2), pw0); \
    VRD(4); SBAR(); GAPA(C1=__builtin_amdgcn_mfma_f32_32x32x16_bf16(kf[1],qr[0],negm,0,0,0), P0[6],P0[7],P0[8],P0[9],     pw0[2]=PKW(P0,4), pw0[3]=PKW(P0,6), pw0); \
    VRD(1); SBAR(); GAPA(C0=__builtin_amdgcn_mfma_f32_32x32x16_bf16(kf[2],qr[1],C0,0,0,0),   P0[10],P0[11],P0[12],P0[13], pw1[0]=PKW(P0,8), pw1[1]=PKW(P0,10), pw1); \
    VRD(5); SBAR(); GAPA(C1=__builtin_amdgcn_mfma_f32_32x32x16_bf16(kf[3],qr[1],C1,0,0,0),   P0[14],P0[15],P1[0],P1[1],   pw1[2]=PKW(P0,12),pw1[3]=PKW(P0,14), pw1); \
    VRD(2); SBAR(); GAPA(C0=__builtin_amdgcn_mfma_f32_32x32x16_bf16(kf[4],qr[2],C0,0,0,0),   P1[2],P1[3],P1[4],P1[5],     pw2[0]=PKW(P1,0), pw2[1]=PKW(P1,2), pw2); \
    VRD(6); SBAR(); GAPA(C1=__builtin_amdgcn_mfma_f32_32x32x16_bf16(kf[5],qr[2],C1,0,0,0),   P1[6],P1[7],P1[8],P1[9],     pw2[2]=PKW(P1,4), pw2[3]=PKW(P1,6), pw2); \
    VRD(3); SBAR(); GAPA(C0=__builtin_amdgcn_mfma_f32_32x32x16_bf16(kf[6],qr[3],C0,0,0,0),   P1[10],P1[11],P1[12],P1[13], pw3[0]=PKW(P1,8), pw3[1]=PKW(P1,10), pw3); \
    VRD(7); SBAR(); GAPA(C1=__builtin_amdgcn_mfma_f32_32x32x16_bf16(kf[7],qr[3],C1,0,0,0),   P1[14],P1[15],0.f,0.f,       pw3[2]=PKW(P1,12),pw3[3]=PKW(P1,14), pw3); \
    l_reg+=sacc; \
    if(GK){DMA_K((t)+3,sl_cur);} if(GV){DMA_V((t)+1,sl_next);} \
    CMASK(C0,C1,t); BMASK(C0,C1,t); \
    { float a=MX3(C0[0],C0[1],C1[0]),b=MX3(C0[2],C0[3],C1[1]); a=MX3(a,C1[2],C1[3]); \
      _Pragma("unroll") for(int r=4;r<16;r+=4){a=MX3(a,C0[r],C0[r+1]);b=MX3(b,C0[r+2],C0[r+3]);a=MX3(a,C1[r],C1[r+1]);b=MX3(b,C1[r+2],C1[r+3]);} \
      float rm=__builtin_fmaxf(a,b); { auto rr=__builtin_amdgcn_permlane32_swap(__float_as_uint(rm),__float_as_uint(rm),false,false); rm=__builtin_fmaxf(__uint_as_float(rr[0]),__uint_as_float(rr[1])); } \
      resc=false; \
      if(__builtin_expect(__any(rm>(float)THRL),0)){ const float dl=__builtin_fmaxf(rm,0.f); mhat+=dl; \
        _Pragma("unroll") for(int r=0;r<16;++r){C0[r]-=dl;C1[r]-=dl;} \
        const float f=__builtin_amdgcn_exp2f(-dl); l_reg*=f; if(hi==0)wsf[r32]=f; resc=true; } } \
    SBAR(); \
    GAPB(o[0]=__builtin_amdgcn_mfma_f32_32x32x16_bf16(PAF(0),VFR(0),o[0],0,0,0), C0,0); \
    GAPB(o[1]=__builtin_amdgcn_mfma_f32_32x32x16_bf16(PAF(0),VFR(4),o[1],0,0,0), C0,4); \
    KRD(GL,0); GAPB(o[0]=__builtin_amdgcn_mfma_f32_32x32x16_bf16(PAF(1),VFR(1),o[0],0,0,0), C0,8); \
    KRD(GL,1); GAPB(o[1]=__builtin_amdgcn_mfma_f32_32x32x16_bf16(PAF(1),VFR(5),o[1],0,0,0), C0,12); \
    KRD(GL,2); GAPB(o[0]=__builtin_amdgcn_mfma_f32_32x32x16_bf16(PAF(2),VFR(2),o[0],0,0,0), C1,0); \
    KRD(GL,3); GAPB(o[1]=__builtin_amdgcn_mfma_f32_32x32x16_bf16(PAF(2),VFR(6),o[1],0,0,0), C1,4); \
    GAPB(o[0]=__builtin_amdgcn_mfma_f32_32x32x16_bf16(PAF(3),VFR(3),o[0],0,0,0), C1,8); \
    GAPB(o[1]=__builtin_amdgcn_mfma_f32_32x32x16_bf16(PAF(3),VFR(7),o[1],0,0,0), C1,12); \
    }while(0)
  int t=1;
  #undef CMASK
  #define CMASK(P0,P1,t) do{}while(0)
  for(;t+5<NT;t+=2){
    STEP(pB0,pB1,pA0,pA1,t,true,true,true);     WAIT_BAR(2); RESC(); ROT();
    STEP(pA0,pA1,pB0,pB1,t+1,true,true,true);   WAIT_BAR(2); RESC(); ROT();
  }
  #undef CMASK
  #define CMASK(P0,P1,t) do{int jb_=(t)-(NT-4); if(jb_>=0)cmask(P0,P1,jb_,qrel,hi);}while(0)
  #define ENDW(tt) do{ if((tt)+3<NT){WAIT_BAR(2);} else if((tt)+2<NT){WAIT_BAR(1);} else {WAIT_BAR(0);} }while(0)
  for(;t+1<NT;t+=2){
    STEP(pB0,pB1,pA0,pA1,t,(t+3<NT),(t+1<NT),(t+1<NT));       ENDW(t);   RESC(); ROT();
    STEP(pA0,pA1,pB0,pB1,t+1,(t+4<NT),(t+2<NT),(t+2<NT));     ENDW(t+1); RESC(); ROT();
  }
  STEP(pB0,pB1,pA0,pA1,NT-1,false,false,false); RESC();
  { float sacc=pB0[0]+pB0[1]; _Pragma("unroll") for(int r=2;r<16;++r)sacc+=pB0[r]; _Pragma("unroll") for(int r=0;r<16;++r)sacc+=pB1[r]; l_reg+=sacc;
    pw0=(u32x4){PKW(pB0,0),PKW(pB0,2),PKW(pB0,4),PKW(pB0,6)};pw1=(u32x4){PKW(pB0,8),PKW(pB0,10),PKW(pB0,12),PKW(pB0,14)};pw2=(u32x4){PKW(pB1,0),PKW(pB1,2),PKW(pB1,4),PKW(pB1,6)};pw3=(u32x4){PKW(pB1,8),PKW(pB1,10),PKW(pB1,12),PKW(pB1,14)};
    SBAR(); pv(o,vb0+sl_cur,PAF(0),PAF(1),PAF(2),PAF(3)); }
  #undef PKW
  #undef PAF
  #undef VFR
  #undef PIN
  #undef MX3
  #undef GAPA
  #undef GAPB
  #undef EX
  #undef VRD
  #undef KRD
  #undef STEP
  #undef ENDW
  {auto rr=__builtin_amdgcn_permlane32_swap(__float_as_uint(l_reg),__float_as_uint(l_reg),false,false);l_reg=__uint_as_float(rr[0])+__uint_as_float(rr[1]);}
  if(hi==0)wsf[32+r32]=l_reg;asm volatile("s_waitcnt lgkmcnt(0)":::"memory");
  float rli[16];
  #pragma unroll
  for(int r=0;r<16;++r)rli[r]=__builtin_amdgcn_rcpf(wsf[32+crow(r,hi)]);
  bf16*Ow=O+(rowbase+q0+wid*QBLK)*DMO+h*D;
  { bf16*stg=(bf16*)(shm+LDS_OST)+wid*2048;
    #pragma unroll
    for(int r=0;r<16;++r){const int orow=crow(r,hi);
      #pragma unroll
      for(int d0=0;d0<2;++d0)stg[orow*64+d0*32+r32]=__float2bfloat16(o[d0][r]*rli[r]);}
    asm volatile("s_waitcnt lgkmcnt(0)":::"memory");
    #pragma unroll
    for(int i=0;i<4;++i){const int row=i*8+(lane>>3),ch=lane&7; const u32x4 v=*(const u32x4*)(stg+row*64+ch*8); ATTN_STORE16(Ow+(long)row*DMO+ch*8,v);
      float q=0.f;
      #pragma unroll
      for(int e=0;e<4;++e){const float lo=__uint_as_float(v[e]<<16),hi2=__uint_as_float(v[e]&0xffff0000u);q+=lo*lo+hi2*hi2;}
      q+=__shfl_xor(q,1);q+=__shfl_xor(q,2);q+=__shfl_xor(q,4);
      if(ch==0)SSQA[(rowbase+q0+wid*QBLK+row)*8+h]=q;} }
  asm volatile("s_waitcnt lgkmcnt(0)\n\ts_barrier":::"memory");
  #undef BMASK
  #undef DMA_K
  #undef DMA_V
  #undef CMASK
  #undef START
  #undef RESC
  #undef ROT
}
constexpr int ATTN_LDS_BYTES=LDS_BYTES;
#undef SBAR
#undef WAIT_BAR
}

#ifndef STAG_TICKS
#define STAG_TICKS 100
#endif
__device__ __forceinline__ void stagger(int c, int ticks) {
    const unsigned long long t0 = __builtin_amdgcn_s_memrealtime(); const unsigned long long w = (unsigned long long)(((c >> 3) & 3) * ticks);
    while (__builtin_amdgcn_s_memrealtime() - t0 < w) __builtin_amdgcn_s_sleep(8);
}
__global__ void __launch_bounds__(512, 2) mk_fwd(Args args) {
    extern __shared__ __attribute__((aligned(16))) unsigned char lds_raw[];
    Ctx C; C.lds = (LAS unsigned char*)lds_raw; C.tid = threadIdx.x; C.lane = C.tid & 63; C.wave = __builtin_amdgcn_readfirstlane(C.tid >> 6);
    C.G = gridDim.x; { const int bx = blockIdx.x; C.vcu = (C.G % 8 == 0) ? (bx % 8) * (C.G / 8) + bx / 8 : bx; }
    unsigned char* ws = args.ws;
    for (int u = C.tid; u < (LDS_BYTES - LDSCTL_OFF) / 4; u += 512) ((LAS unsigned*)(C.lds + LDSCTL_OFF))[u] = 0u;
    __syncthreads();
    XcdBarrier bar; bar.bar = (unsigned*)(ws + WS_CTL) + CW_BAR; bar.x = 0; bar.st = nullptr;
    if (N_LAUNCHES == 1) bar = xcd_barrier_post((unsigned*)(ws + WS_CTL) + CW_BAR, (volatile LAS unsigned*)(C.lds + MISC_OFF) + 8);
    const int lo = args.ph_lo, hi = args.ph_hi;
#ifndef PH_MASK
#define PH_MASK 0x3fff
#endif
#define IN(k) ((((PH_MASK) >> (k)) & 1) && lo <= (k) && (k) < hi)
#ifndef PROBE_REP
#define PROBE_REP -1
#endif
#define REP(k) for (int rep_ = 0; rep_ < ((PROBE_REP == (k)) ? 2 : 1); ++rep_)
#define REPBAR() do { if (rep_ > 0) xcd_barrier(bar); } while (0)
#define FRESH() do { int t_ = threadIdx.x; asm volatile("" : "+v"(t_)); C.tid = t_; C.lane = t_ & 63; C.wave = __builtin_amdgcn_readfirstlane(t_ >> 6); } while (0)
#define SEAM(k) do { if (IN(k) && IN((k) + 1)) xcd_barrier(bar); } while (0)
    const int cb = (int)blockIdx.x;

    if (IN(0)) REP(0) { REPBAR(); FRESH(); ph_prologue(args, C); SEAM(0); }
    if (PROBE_REP == 200) { for (int xb_ = 0; xb_ < 8; ++xb_) xcd_barrier(bar); }
    if (IN(1)) REP(1) { REPBAR();
        { Gemm g{(const bf16_t*)(ws + WS_B), (const bf16_t*)(ws + WS_WIN), DM, DM, DM}; PlainOrder S; S.init(NTOK, DIN, C.G, cb, DM, DM);
          if (PROBE_REP == 301) { EpiNull EN{}; GEMM_PHASE(C.lds, g, S, EN); xcd_barrier(bar); }
          EpiProj E{(bf16_t*)(ws + WS_A), (const float*)(ws + WS_ROPE), (float*)(ws + WS_KSUM)}; GEMM_PHASE(C.lds, g, S, E); }
        { Gemm g{(const bf16_t*)(ws + WS_MEMN), (const bf16_t*)(ws + WS_WXK), DM, DM, DM}; PlainOrder S; S.init(NMEM, DM, C.G, cb, DM, DM);
          EpiStore E{(bf16_t*)(ws + WS_KM), DM}; GEMM_PHASE(C.lds, g, S, E); }
        { Gemm g{(const bf16_t*)(ws + WS_MEMN), (const bf16_t*)(ws + WS_WXV), DM, DM, DM}; PlainOrder S; S.init(NMEM, DM, C.G, (cb + C.G - 64 % C.G) % C.G, DM, DM);
          EpiStore E{(bf16_t*)(ws + WS_VMT), DM}; GEMM_PHASE(C.lds, g, S, E); }
        { FRESH(); if (C.G == 256) { if (cb >= 128) conv_wdn(args, C, (cb - 128) * 8 + C.wave, 128 * 8, 0, WDN_SPLIT); }
          else conv_wdn(args, C, C.vcu * 8 + C.wave, C.G * 8, 0, WDN_SPLIT); }
        SEAM(1);
    }
    if (IN(2)) REP(2) { REPBAR(); FRESH();
        for (int lrep_ = 0; lrep_ < ((PROBE_REP == 102) ? 2 : 1); ++lrep_)
        for (int L = C.vcu; L < 256; L += C.G) lru_unit(args, C, L >> 4, (L >> 1) & 7, L & 1, L);
        for (int arep_ = 0; arep_ < ((PROBE_REP == 103) ? 2 : 1); ++arep_)
        for (int i = 0;; ++i) { const int aidx = i * C.G + C.vcu; if (aidx >= 1024) break; const int cc = aidx & 255, ii = aidx >> 8, bh = cc >> 1;
            const int qb = (cc & 1) ? ((ii == 0) ? 6 : (ii == 1) ? 1 : (ii == 2) ? 5 : 2) : ((ii == 0) ? 7 : (ii == 1) ? 0 : (ii == 2) ? 4 : 3);
#ifdef ATTN_SIMPLE
            moba_unit_simple(args, C, bh >> 3, bh & 7, qb); }
#else
            { const attn_body::bf16* Qp = (const attn_body::bf16*)(ws + WS_A) + (size_t)2 * NTOK * 512;
              attn_body::attn_unit<8>(bh >> 3, bh & 7, qb, Qp, Qp + (size_t)NTOK * 512, Qp + (size_t)2 * NTOK * 512, (attn_body::bf16*)(ws + WS_C) + 512, (const float*)(ws + WS_KSUM), (float*)(ws + WS_SSQA), (char*)lds_raw); } }
#endif
        SEAM(2);
    }
    if (IN(4)) REP(4) { REPBAR(); Gemm g{(const bf16_t*)(ws + WS_C), (const bf16_t*)(ws + WS_WOUT), DM, DM, DM}; PlainOrder S; S.init(NTOK, DM, C.G, cb, DM, DM);
        EpiResid<true, true> E{(const bf16_t*)(ws + WS_B), (bf16_t*)args.out, (float*)(ws + WS_SSQ1), (const float*)(ws + WS_SSQL), (const float*)(ws + WS_SSQA), ws + WS_A + 64 * MiB, 1.0f, (const float*)(ws + WS_TOK + TOK_D), args.in[2]};     GEMM_PHASE(C.lds, g, S, E);
        { Gemm g2{(const bf16_t*)(ws + WS_KM), (const bf16_t*)(ws + WS_WXQ), DM, DM, XHD}; XpreOrder S2{C.G, cb, 0}; EpiStore8 E2{ws + WS_A, DM, QKT_SC}; GEMM_PHASE(C.lds, g2, S2, E2); }
        { Gemm g3{(const bf16_t*)(ws + WS_WXO), (const bf16_t*)(ws + WS_VMT), DM, DM, XHD}; XpreOrder S3{C.G, cb, 1}; EpiStore8 E3{ws + WS_A + 32 * MiB, DM, VWT_SC}; GEMM_PHASE(C.lds, g3, S3, E3); }
        SEAM(4); }
    if (IN(5)) REP(5) { REPBAR(); Gemm g{(const bf16_t*)(ws + WS_A + 64 * MiB), (const bf16_t*)(ws + WS_A), DM / 2, DM / 2, DM / 2}; XattnOrder S{C.G, cb, 0, DM / 2, DM / 2};
        EpiSoftmax E{ws + WS_A + 96 * MiB, DM, C.lds + LDSCTL_OFF + 4096, (const float*)(ws + WS_SSQ1), XSCALE / QKT_SC}; GEMM_PHASE8(C.lds, g, S, E); SEAM(5); }
    if (IN(8)) REP(8) { REPBAR(); Gemm g{(const bf16_t*)(ws + WS_A + 96 * MiB), (const bf16_t*)(ws + WS_A + 32 * MiB), DM / 2, DM / 2, DM / 2}; XattnOrder S{C.G, cb, 1, DM / 2, DM / 2};
        EpiResid<false, false> E{(const bf16_t*)args.out, (bf16_t*)args.out + DM, (float*)(ws + WS_SSQ2), nullptr, nullptr, ws + WS_H2F8, 1.0f / (PX_SC * VWT_SC)}; GEMM_PHASE8(C.lds, g, S, E); SEAM(8); }
    if (IN(9)) REP(9) { REPBAR(); FRESH(); ph_router(args, C); SEAM(9); }
    if (IN(11)) REP(11) { REPBAR(); FRESH(); moe_table(args, C); Gemm g{(const bf16_t*)(ws + WS_H2F8), (const bf16_t*)(ws + WS_WGU), DM / 2, DM / 2, DM / 2};
        MoeOrder<true> S{(const LAS int*)(C.lds + MOE_OFF), C.G, cb, DM / 2, DM / 2, (const int*)(ws + WS_LTOK), (unsigned)DM};
        EpiGateUp E{ws + WS_B, (const float*)(ws + WS_LRS)}; GEMM_PHASE8(C.lds, g, S, E); SEAM(11); }
    if (IN(12)) REP(12) { REPBAR(); FRESH(); moe_table(args, C); Gemm g{(const bf16_t*)(ws + WS_B), (const bf16_t*)(ws + WS_WDN), DFF / 2, DFF / 2, DFF / 2};
        MoeOrder<false> S{(const LAS int*)(C.lds + MOE_OFF), C.G, cb, DFF / 2, DFF / 2, nullptr, 0u};
        if (PROBE_REP == 312) { EpiNull EN{}; GEMM_PHASE8(C.lds, g, S, EN); xcd_barrier(bar); }
        EpiStore8 E{ws + WS_A, DM, YB_SC / (WDN_SC * ACT_SC)}; GEMM_PHASE8(C.lds, g, S, E); SEAM(12); }
    if (IN(13)) REP(13) { REPBAR(); FRESH(); moe_table(args, C); ph_final(args, C, (PROBE_REP == 13 && rep_ == 0) ? (float*)(ws + WS_B) : args.out); }
#undef IN
#undef FRESH
#undef SEAM
}

extern "C" void kernel_launch(void* const* d_in, const int* in_sizes, int n_in, void* d_out, int out_size, void* d_ws, size_t ws_size, hipStream_t stream) {
    static int grid = 0;
    if (grid == 0) {
        if (n_in != 27 || out_size != NTOK * DM || ws_size < WS_END) { fprintf(stderr, "kernel_launch: unexpected shapes (n_in %d out %d ws %zu)\n", n_in, out_size, ws_size); grid = -1; return; }
        int dev = 0, cus = 0, per_cu = 0;
        if (hipGetDevice(&dev) != hipSuccess || hipDeviceGetAttribute(&cus, hipDeviceAttributeMultiprocessorCount, dev) != hipSuccess) { grid = -1; return; }
        if (hipFuncSetAttribute((const void*)mk_fwd, hipFuncAttributeMaxDynamicSharedMemorySize, LDS_BYTES) != hipSuccess) { fprintf(stderr, "kernel_launch: hipFuncSetAttribute failed\n"); grid = -1; return; }
        if (hipOccupancyMaxActiveBlocksPerMultiprocessor(&per_cu, (const void*)mk_fwd, 512, LDS_BYTES) != hipSuccess || per_cu < 1) fprintf(stderr, "kernel_launch: occupancy query reports %d\n", per_cu);
        (void)hipGetLastError();
        grid = cus;
    }
    if (grid < 0) return;
    (void)hipMemsetAsync((char*)d_ws + WS_CTL, 0, CTL_ZERO_BYTES, stream);
    Args a{};
    for (int i = 0; i < 27; ++i) a.in[i] = (const float*)d_in[i];
    a.out = (float*)d_out; a.ws = (unsigned char*)d_ws;
    const float invf[8] = {1.0f, 0.1939227432012558f, 0.03760603070259094f, 0.007292664609849453f, 0.0014142135623842478f, 0.00027424818836152554f, 5.318296098266728e-05f, 1.0313386155758053e-05f};
    for (int i = 0; i < 8; ++i) a.invf[i] = invf[i];
    if (N_LAUNCHES == 1) { a.ph_lo = 0; a.ph_hi = N_PHASES; hipLaunchKernelGGL(mk_fwd, dim3(grid), dim3(512), LDS_BYTES, stream, a); }
    else for (int p = 0; p < N_PHASES; ++p) { a.ph_lo = p; a.ph_hi = p + 1; hipLaunchKernelGGL(mk_fwd, dim3(grid), dim3(512), LDS_BYTES, stream, a); }
}
```

```cpp
#include <hip/hip_runtime.h>
#include <cstdio>
#include <cstdint>

#define LAS __attribute__((address_space(3)))
#define GAS __attribute__((address_space(1)))
typedef unsigned short bf16_t;
typedef short bf16x8 __attribute__((ext_vector_type(8)));
typedef float f32x4 __attribute__((ext_vector_type(4)));
typedef float f32x2 __attribute__((ext_vector_type(2)));
typedef unsigned u32x4 __attribute__((ext_vector_type(4)));
typedef unsigned u32x2 __attribute__((ext_vector_type(2)));

#ifndef MK_N_LAUNCHES
#define MK_N_LAUNCHES 1
#endif
constexpr int N_PHASES = 14;
constexpr int N_LAUNCHES = MK_N_LAUNCHES;

constexpr int BATCH = 16, SEQ = 2048, DM = 1024, NTOK = BATCH * SEQ;
constexpr int DLRU = 512, DATT = 512, DIN = 2560, NHEAD = 8, HD = 64, NBLK = 8, MBLK = 256;
constexpr int MEMLEN = 256, NXH = 4, XHD = 256, NMEM = BATCH * MEMLEN;
constexpr int NEXP = 32, EPG = 8, NGRP = 4, DFF = 512;
constexpr float EPS = 1e-6f;
constexpr float QKT_SC = 8.0f, VWT_SC = 8.0f, PX_SC = 256.0f;
constexpr float WGU_SC = 64.0f, WDN_SC = 32.0f, ACT_SC = 16.0f, YB_SC = 16.0f;
constexpr int WDN_SPLIT = 3072;
constexpr int MAXTILES = 288, LCAP = 65536, LDH = 2048;
constexpr float QSCALE = 0.125f * 1.4426950408889634f;
constexpr float XSCALE = 0.0625f * 1.4426950408889634f;

constexpr size_t MiB = 1u << 20;
constexpr size_t WS_CTL = 0, CTL_ZERO_BYTES = 1 * MiB;
constexpr int CW_TMO = 0, CW_BAR = 4096, CW_CNT = 8192;
constexpr size_t WS_KSUM = 512 * 1024;
constexpr size_t WS_WIN = 2 * MiB, WS_WXK = 7 * MiB, WS_WXV = 9 * MiB, WS_WOUT = 11 * MiB, WS_WXQ = 13 * MiB, WS_WXO = 15 * MiB;
constexpr size_t WS_WR = 17 * MiB, WS_ROPE = 18 * MiB, WS_SSQ1 = 19 * MiB, WS_SSQ2 = 21 * MiB, WS_TOK = 23 * MiB, WS_RSC = 24 * MiB;
constexpr size_t WS_MEMN = 25 * MiB, WS_KM = 33 * MiB, WS_VMT = 41 * MiB, WS_WGU = 49 * MiB, WS_WDN = 113 * MiB;
constexpr size_t WS_A = 145 * MiB, WS_B = 305 * MiB, WS_C = 385 * MiB, WS_SSQL = 449 * MiB, WS_SSQA = 451 * MiB, WS_LTOK = 452 * MiB, WS_LRS = 460 * MiB, WS_H2F8 = 468 * MiB, WS_END = 500 * MiB;
constexpr size_t TOK_E = 0, TOK_R = 256 * 1024, TOK_G = 512 * 1024, TOK_D = 768 * 1024;

constexpr int RING_BYTES = 131072;
constexpr int LDSCTL_OFF = RING_BYTES, MISC_OFF = LDSCTL_OFF + 320, MOE_OFF = LDSCTL_OFF + 1024;
constexpr int LDS_BYTES = 147456;

__device__ __forceinline__ unsigned cvt_pk_bf16(float lo, float hi) { unsigned r; asm volatile("v_cvt_pk_bf16_f32 %0, %1, %2" : "=v"(r) : "v"(lo), "v"(hi)); return r; }
__device__ __forceinline__ float bflo(unsigned w) { return __uint_as_float(w << 16); }
__device__ __forceinline__ float bfhi(unsigned w) { return __uint_as_float(w & 0xffff0000u); }
__device__ __forceinline__ float bf2f(bf16_t b) { return __uint_as_float((unsigned)b << 16); }
__device__ __forceinline__ float wave_sum(float v) {
#pragma unroll
    for (int o = 1; o < 64; o <<= 1) v += __shfl_xor(v, o);
    return v;
}
#define LDS_WAIT() asm volatile("s_waitcnt lgkmcnt(0)" ::: "memory")
__device__ __forceinline__ float sigmoidf_(float x) { return __builtin_amdgcn_rcpf(1.0f + __builtin_amdgcn_exp2f(x * -1.4426950408889634f)); }

#define XB_TMO      128
#define XB_XCNT(j)  (256  + 64 * (j))
#define XB_XSUB(j)  (1280 + 64 * (j))
#define XB_XGEN(j)  (2304 + 64 * (j))
#define XB_TOP      3328
#define XB_TOPGEN   3392
#define XCD_BAR_WORDS 3456
#define XB_SPIN_CAP (1u << 18)
__device__ __forceinline__ unsigned xb_ld(unsigned* p)              { return __hip_atomic_load(p, __ATOMIC_RELAXED, __HIP_MEMORY_SCOPE_AGENT); }
__device__ __forceinline__ unsigned xb_add(unsigned* p, unsigned v) { return __hip_atomic_fetch_add(p, v, __ATOMIC_RELAXED, __HIP_MEMORY_SCOPE_AGENT); }
__device__ __forceinline__ unsigned xb_xcc_id() { return (unsigned)__builtin_amdgcn_s_getreg((3 << 11) | 20) & 0xFu; }
#define XB_SPIN(cond, bar) do { unsigned _sp = 0; while (cond) { __builtin_amdgcn_s_sleep(1); \
    if ((++_sp & 255u) == 0u) { if (xb_ld(&(bar)[XB_TMO])) break; if (_sp > XB_SPIN_CAP) { atomicAdd(&(bar)[XB_TMO], 1u); break; } } } } while (0)
struct XcdBarrier { unsigned* bar; unsigned x; volatile LAS unsigned* st; };
__device__ __forceinline__ XcdBarrier xcd_barrier_post(unsigned* bar, volatile LAS unsigned* st) {
    XcdBarrier b; b.bar = bar; b.x = xb_xcc_id(); b.st = st;
    if (threadIdx.x == 0) (void)xb_add(&bar[XB_XCNT(b.x)], 1u);
    return b;
}
__device__ __forceinline__ void xcd_barrier_complete(unsigned* bar, unsigned x, unsigned& nloc, unsigned& nx) {
    const unsigned G = gridDim.x * gridDim.y * gridDim.z;
    unsigned sum, cnt, mine, sp = 0u;
    for (;;) {
        sum = 0u; cnt = 0u; mine = 0u;
#pragma unroll
        for (unsigned j = 0; j < 16; ++j) { const unsigned c = xb_ld(&bar[XB_XCNT(j)]); sum += c; cnt += (c > 0u) ? 1u : 0u; mine = (j == x) ? c : mine; }
        if (sum == G) break;
        __builtin_amdgcn_s_sleep(1);
        if ((++sp & 255u) == 0u) { if (xb_ld(&bar[XB_TMO])) break; if (sp > XB_SPIN_CAP) { atomicAdd(&bar[XB_TMO], 1u); break; } }
    }
    nloc = mine > 0u ? mine : 1u; nx = cnt > 0u ? cnt : 1u;
}
__device__ __forceinline__ void xcd_barrier(const XcdBarrier& b) {
    asm volatile("s_waitcnt vmcnt(0)" ::: "memory");
    __syncthreads();
    if (threadIdx.x == 0) {
        unsigned* bar = b.bar;
        __builtin_amdgcn_s_waitcnt(0);
        unsigned nloc = b.st[0], nx = b.st[1];
        if (nloc == 0u) { xcd_barrier_complete(bar, b.x, nloc, nx); b.st[0] = nloc; b.st[1] = nx; }
        const unsigned old = xb_add(&bar[XB_XSUB(b.x)], 1u);
        const unsigned gen = old / nloc;
        if (old + 1u == (gen + 1u) * nloc) {
            __builtin_amdgcn_fence(__ATOMIC_RELEASE, "agent");
            asm volatile("s_waitcnt vmcnt(0)" ::: "memory");
            const unsigned og = xb_add(&bar[XB_TOP], 1u);
            const unsigned tg = og / nx;
            if (og + 1u == (tg + 1u) * nx) xb_add(&bar[XB_TOPGEN], 1u);
            else XB_SPIN(xb_ld(&bar[XB_TOPGEN]) == tg, bar);
            __builtin_amdgcn_fence(__ATOMIC_ACQUIRE, "agent");
            xb_add(&bar[XB_XGEN(b.x)], 1u);
            asm volatile("s_waitcnt vmcnt(0)" ::: "memory");
        } else {
            XB_SPIN(xb_ld(&bar[XB_XGEN(b.x)]) == gen, bar);
            __builtin_amdgcn_fence(__ATOMIC_ACQUIRE, "agent");
            asm volatile("s_waitcnt vmcnt(0)" ::: "memory");
        }
    }
    __syncthreads();
}

struct Unit { int pm, pn; size_t a_off, b_off; int lbase, nvalid; };
struct Gemm { const bf16_t* A; const bf16_t* Bt; int lda, ldb, K; };
__host__ __device__ __forceinline__ int perm32(int rho) { const int n = rho >> 4, i = rho & 15; return 8 * (i >> 2) + 4 * n + (i & 3); }

struct PlainOrder {     static constexpr bool GATHER = false;
    int nM, nN, nwg, G, c, lda, ldb;
    __device__ void init(int M, int N, int G_, int c_, int lda_, int ldb_) { nM = M / 256; nN = N / 256; nwg = nM * nN; G = G_; c = c_; lda = lda_; ldb = ldb_; }
    __device__ bool next(int i, Unit& u) const {
        const long L = (long)i * G + c; if (L >= nwg) return false;
        int wgid = (int)L; { const int q = nwg / 8, r = nwg % 8, xcd = wgid % 8, off = wgid / 8; wgid = (xcd < r ? xcd * (q + 1) : r * (q + 1) + (xcd - r) * q) + off; }
        const int nig = 8 * nN, gid = wgid / nig, fm = gid * 8, gsz = (nM - fm) < 8 ? (nM - fm) : 8;
        u.pm = fm + ((wgid % nig) % gsz); u.pn = (wgid % nig) / gsz;
        u.a_off = (size_t)u.pm * 256 * lda; u.b_off = (size_t)u.pn * 256 * ldb; return true;
    }
};
struct XpreOrder {
    static constexpr bool GATHER = false;
    int G, c, mode;
    __device__ bool next(int i, Unit& u) const {
        const int L = i * G + c; if (L >= 256) return false;
        const int b = L >> 4, x = (L >> 2) & 3, y = L & 3;
        if (mode == 0) { const int h = x, kt = y; u.pm = b * 4 + h; u.pn = kt; u.a_off = (size_t)b * MEMLEN * DM + h * XHD; u.b_off = (size_t)kt * 256 * DM + h * XHD; }
        else { const int nt = x, h = y; u.pm = b * 4 + nt; u.pn = h; u.a_off = (size_t)nt * 256 * DM + h * XHD; u.b_off = (size_t)b * MEMLEN * DM + h * XHD; }
        return true;
    }
};
struct XattnOrder {
    static constexpr bool GATHER = false;
    int G, c, mode, lda, ldb;
    __device__ bool next(int i, Unit& u) const {
        int L = i * G + c; if (L >= (NTOK / 256) * 4) return false;
        if (G == 256) { const int x = c & 7, idx = c >> 3; L = ((x + 8 * i) * 8 + (idx >> 2)) * 4 + (idx & 3); }
        u.pm = L >> 2; u.pn = L & 3; const int b = u.pm >> 3;
        u.a_off = (size_t)u.pm * 256 * lda;
        u.b_off = mode == 0 ? (size_t)(b * 4 + u.pn) * 256 * ldb : (size_t)(b * 1024 + u.pn * 256) * ldb;
        return true;
    }
};
template <bool GATH_> struct MoeOrder {
    static constexpr bool GATHER = GATH_;
    const LAS int* ts; int G, c, lda, ldb; const int* ltok; unsigned rowbytes;
    __device__ bool next(int i, Unit& u) const {
        const int L = i * G + c; if (L >= ts[NEXP] * 4) return false;
        const int T = L >> 2, j = L & 3; int e = 0; while (ts[e + 1] <= T) ++e;
        const int lt = T - ts[e];
        u.pm = T; u.pn = j; u.a_off = GATH_ ? (size_t)0 : (size_t)T * 256 * lda; u.b_off = ((size_t)e * 1024 + j * 256) * ldb;
        u.lbase = e * LCAP + lt * 256; u.nvalid = ts[33 + e] - lt * 256; return true;
    }
    __device__ __forceinline__ unsigned rowoff(const Unit& u, int r) const { return (r < u.nvalid) ? (unsigned)ltok[u.lbase + r] * rowbytes : 0u; }
};

template <class Epi, class Sched>
__device__ __forceinline__ void gemm_phase_simple(LAS unsigned char* lds, const Gemm g, const Sched& S, const Epi& E) {
    int tid = threadIdx.x; asm volatile("" : "+v"(tid));
    const int wid = __builtin_amdgcn_readfirstlane(tid >> 6), lane = tid & 63, wr = wid >> 2, wc = wid & 3, fr = lane & 15, fq = lane >> 4;
    Unit u;
    for (int i = 0; S.next(i, u); ++i) {
        f32x4 acc[2][2][4][2];
#pragma unroll
        for (int a = 0; a < 2; ++a)
#pragma unroll
            for (int b = 0; b < 2; ++b)
#pragma unroll
                for (int m = 0; m < 4; ++m)
#pragma unroll
                    for (int n = 0; n < 2; ++n) acc[a][b][m][n] = (f32x4){0.f, 0.f, 0.f, 0.f};
        const char* Ab = (const char*)(g.A + u.a_off); const char* Bb = (const char*)(g.Bt + u.b_off);
        const int c0 = Epi::PERM ? perm32(fr) : fr, c1 = Epi::PERM ? perm32(16 + fr) : 16 + fr;
        unsigned ao[2][4], bo[2][2];
#pragma unroll
        for (int ai = 0; ai < 2; ++ai)
#pragma unroll
            for (int m = 0; m < 4; ++m) ao[ai][m] = (unsigned)((128 * ai + 64 * wr + 16 * m + fr) * g.lda + 8 * fq) * 2u;
#pragma unroll
        for (int bj = 0; bj < 2; ++bj) { bo[bj][0] = (unsigned)((128 * bj + 32 * wc + c0) * g.ldb + 8 * fq) * 2u; bo[bj][1] = (unsigned)((128 * bj + 32 * wc + c1) * g.ldb + 8 * fq) * 2u; }
#pragma unroll 1
        for (int k0 = 0; k0 < g.K; k0 += 32) {
            if constexpr (Epi::MIDK) { if (k0 == (g.K >> 1)) E.midk(acc, u, wr, wc, fr, fq); }
            const char* Ak = Ab + (size_t)k0 * 2; const char* Bk = Bb + (size_t)k0 * 2;
            bf16x8 bfr[2][2];
#pragma unroll
            for (int bj = 0; bj < 2; ++bj) { bfr[bj][0] = *(const bf16x8*)(Bk + bo[bj][0]); bfr[bj][1] = *(const bf16x8*)(Bk + bo[bj][1]); }
#pragma unroll
            for (int ai = 0; ai < 2; ++ai) {
                bf16x8 af[4];
#pragma unroll
                for (int m = 0; m < 4; ++m) af[m] = *(const bf16x8*)(Ak + ao[ai][m]);
#pragma unroll
                for (int bj = 0; bj < 2; ++bj)
#pragma unroll
                    for (int m = 0; m < 4; ++m)
#pragma unroll
                        for (int n = 0; n < 2; ++n) acc[ai][bj][m][n] = __builtin_amdgcn_mfma_f32_16x16x32_bf16(bfr[bj][n], af[m], acc[ai][bj][m][n], 0, 0, 0);
            }
        }
        E(acc, u, wr, wc, fr, fq);
    }
}

typedef int v8i __attribute__((ext_vector_type(8)));
typedef int v4i __attribute__((ext_vector_type(4)));
__device__ __forceinline__ v8i cat8(bf16x8 lo, bf16x8 hi) { const v4i a = __builtin_bit_cast(v4i, lo), b = __builtin_bit_cast(v4i, hi); return __builtin_shufflevector(a, b, 0, 1, 2, 3, 4, 5, 6, 7); }
template <int H> __device__ __forceinline__ bf16x8 half8(v8i v) { const v4i h = H ? __builtin_shufflevector(v, v, 4, 5, 6, 7) : __builtin_shufflevector(v, v, 0, 1, 2, 3); return __builtin_bit_cast(bf16x8, h); }
__device__ __forceinline__ unsigned pk4_fp8(float a, float b, float c, float d) { int w = __builtin_amdgcn_cvt_pk_fp8_f32(a, b, 0, false); w = __builtin_amdgcn_cvt_pk_fp8_f32(c, d, w, true); return (unsigned)w; }
__host__ __device__ __forceinline__ int lds_byte(int r, int c) { const int st = (r >> 4) * 2 + (c >> 5), rr = r & 15, cc = c & 31, ob = rr * 64 + cc * 2; return st * 1024 + (ob ^ (((ob >> 9) & 1) << 5)); }
__host__ __device__ __forceinline__ void stage_rc(int b, int& R, int& C) { const int st = b / 1024, sb = b % 1024, swz = sb ^ (((sb >> 9) & 1) << 5); R = (st >> 1) * 16 + swz / 64; C = (st & 1) * 32 + (swz % 64) / 2; }
template <class Epi, class Sched, bool ALIGN_EPI = false, bool SP2 = false, bool F8 = false, bool SKIPW = true>
__device__ __forceinline__ void gemm_phase(LAS unsigned char* lds, const Gemm g, const Sched& S, const Epi& E) {
    constexpr int BK = 64, HALF = 128, HTB = HALF * BK * 2;
    int tid = threadIdx.x; asm volatile("" : "+v"(tid));
    const int wid = __builtin_amdgcn_readfirstlane(tid >> 6), lane = tid & 63, wr = wid >> 2, wc = wid & 3, fr = lane & 15, fq = lane >> 4;
    const int K = g.K, nt = K / BK;
    unsigned voffA[2], voffB[2];
#pragma unroll
    for (int i = 0; i < 2; ++i) { int R, C; stage_rc(tid * 16 + i * 8192, R, C); const int Rb = Epi::PERM ? ((R & ~31) + perm32(R & 31)) : R;
        voffA[i] = (unsigned)(R * g.lda + C) * 2u; voffB[i] = (unsigned)(Rb * g.ldb + C) * 2u; }
    constexpr bool GATH = Sched::GATHER;
    unsigned vcu[2][2] = {{0u, 0u}, {0u, 0u}}, vnx[2][2] = {{0u, 0u}, {0u, 0u}}; int gR[2] = {0, 0}; unsigned gC[2] = {0u, 0u};
    if constexpr (GATH) {
#pragma unroll
        for (int i = 0; i < 2; ++i) { int R, Cq; stage_rc(tid * 16 + i * 8192, R, Cq); gR[i] = R; gC[i] = (unsigned)Cq * 2u; } }
    const size_t kstep = (size_t)(BK * 2);
    const size_t hstepA = (size_t)HALF * g.lda * 2, hstepB = (size_t)HALF * g.ldb * 2;
    const unsigned ldsw = (unsigned)wid * 1024u;
    const int aoff = lds_byte(wr * 64 + fr, F8 ? fq * 16 : fq * 8), boff = lds_byte(wc * 32 + fr, F8 ? fq * 16 : fq * 8);
    const int aoff1 = lds_byte(wr * 64 + fr, F8 ? fq * 16 + 8 : fq * 8 + 32) - aoff, boff1 = lds_byte(wc * 32 + fr, F8 ? fq * 16 + 8 : fq * 8 + 32) - boff;
#define PG8_SA(b, h) (((b) * 2 + (h)) * HTB)
#define PG8_SB(b, h) ((4 + (b) * 2 + (h)) * HTB)
#define PG8_STAGE(bufoff, gbase, voff) do { _Pragma("unroll") for (int _i = 0; _i < 2; ++_i) \
        __builtin_amdgcn_global_load_lds((const unsigned*)((const char*)(gbase) + (voff)[_i]), (LAS unsigned*)(lds + (bufoff) + ldsw + _i * 8192), 16, 0, 0); } while (0)
#define PG8_STA(bufoff, ptr, h, nx) do { if constexpr (GATH) { const unsigned vsel_[2] = {(nx) ? vnx[h][0] : vcu[h][0], (nx) ? vnx[h][1] : vcu[h][1]}; PG8_STAGE(bufoff, ptr, vsel_); } \
        else { PG8_STAGE(bufoff, (ptr) + (h) * hstepA, voffA); } } while (0)
#define PG8_LDA(dst, b, h) do { _Pragma("unroll") for (int m = 0; m < 4; ++m) dst[m] = cat8(*(const LAS bf16x8*)(lds + PG8_SA(b, h) + aoff + m * 2048), *(const LAS bf16x8*)(lds + PG8_SA(b, h) + aoff + m * 2048 + aoff1)); } while (0)
#define PG8_LDB(dst, b, h) do { _Pragma("unroll") for (int n = 0; n < 2; ++n) dst[n] = cat8(*(const LAS bf16x8*)(lds + PG8_SB(b, h) + boff + n * 2048), *(const LAS bf16x8*)(lds + PG8_SB(b, h) + boff + n * 2048 + boff1)); } while (0)
#define PG8_MMA(ai, bj, At, Bt) do { __builtin_amdgcn_s_setprio(1); \
        if constexpr (F8) { _Pragma("unroll") for (int m = 0; m < 4; ++m) _Pragma("unroll") for (int n = 0; n < 2; ++n) \
            asm volatile("s_nop 1\n\tv_mfma_scale_f32_16x16x128_f8f6f4 %0, %1, %2, %0, %3, %3 op_sel_hi:[0,0,0]" : "+v"(acc[ai][bj][m][n]) : "v"(Bt[n]), "v"(At[m]), "v"(sc127)); } \
        else { _Pragma("unroll") for (int m = 0; m < 4; ++m) _Pragma("unroll") for (int n = 0; n < 2; ++n) { \
            acc[ai][bj][m][n] = __builtin_amdgcn_mfma_f32_16x16x32_bf16(half8<0>(Bt[n]), half8<0>(At[m]), acc[ai][bj][m][n], 0, 0, 0); \
            acc[ai][bj][m][n] = __builtin_amdgcn_mfma_f32_16x16x32_bf16(half8<1>(Bt[n]), half8<1>(At[m]), acc[ai][bj][m][n], 0, 0, 0); } } \
        __builtin_amdgcn_s_setprio(0); } while (0)
#define PG8_WAIT_V(n) asm volatile("s_waitcnt vmcnt(" #n ")" ::: "memory")
#define PG8_WAIT_L(n) asm volatile("s_waitcnt lgkmcnt(" #n ")" ::: "memory")
#define PG8_BAR __builtin_amdgcn_s_barrier()
#define PG8_SCHED __builtin_amdgcn_sched_barrier(0)
    Unit cur, nxt; int ui = 0;
    if (!S.next(0, cur)) return;
    f32x4 acc[2][2][4][2];
#pragma unroll
    for (int a = 0; a < 2; ++a)
#pragma unroll
        for (int b = 0; b < 2; ++b)
#pragma unroll
            for (int m = 0; m < 4; ++m)
#pragma unroll
                for (int n = 0; n < 2; ++n) acc[a][b][m][n] = (f32x4){0.f, 0.f, 0.f, 0.f};
    int sc127 = 127; asm volatile("" : "+v"(sc127));
    v8i At[4], B0[2], B1[2];
    const char* cA = (const char*)(g.A + cur.a_off); const char* cB = (const char*)(g.Bt + cur.b_off);
    if constexpr (GATH) {
#pragma unroll
        for (int h = 0; h < 2; ++h)
#pragma unroll
            for (int i = 0; i < 2; ++i) vcu[h][i] = S.rowoff(cur, h * HALF + gR[i]) + gC[i]; }
    if constexpr (SP2) {
        PG8_STAGE(PG8_SB(0, 0), cB, voffB); PG8_STAGE(PG8_SB(0, 1), cB + hstepB, voffB); PG8_STA(PG8_SA(0, 0), cA, 0, false); PG8_STA(PG8_SA(0, 1), cA, 1, false);
        if (wr == 1) PG8_BAR;
        PG8_WAIT_V(2); PG8_BAR;
        PG8_STAGE(PG8_SB(1, 0), cB + kstep, voffB); PG8_STA(PG8_SA(1, 0), cA + kstep, 0, false); PG8_STAGE(PG8_SB(1, 1), cB + hstepB + kstep, voffB);
        PG8_WAIT_V(6); PG8_BAR;
    } else {
        PG8_STAGE(PG8_SB(0, 0), cB, voffB); PG8_STA(PG8_SA(0, 0), cA, 0, false); PG8_STAGE(PG8_SB(0, 1), cB + hstepB, voffB); PG8_STA(PG8_SA(0, 1), cA, 1, false);
        if (wr == 1) PG8_BAR;
        PG8_WAIT_V(4); PG8_BAR;
        PG8_STAGE(PG8_SB(1, 0), cB + kstep, voffB); PG8_STA(PG8_SA(1, 0), cA + kstep, 0, false); PG8_STAGE(PG8_SB(1, 1), cB + hstepB + kstep, voffB);
        PG8_WAIT_V(6); PG8_BAR;
    }
    for (;;) {
        const bool has_next = S.next(ui + 1, nxt);
        const char* nA = has_next ? (const char*)(g.A + nxt.a_off) : cA; const char* nB = has_next ? (const char*)(g.Bt + nxt.b_off) : cB;
        if constexpr (GATH) {
#pragma unroll
            for (int h = 0; h < 2; ++h)
#pragma unroll
                for (int i = 0; i < 2; ++i) vnx[h][i] = has_next ? (S.rowoff(nxt, h * HALF + gR[i]) + gC[i]) : vcu[h][i]; }
#pragma unroll 1
        for (int t = 0; t < nt; t += 2) {
            if constexpr (Epi::MIDK) { if (t == (nt >> 1)) E.midk(acc, cur, wr, wc, fr, fq); }
            const bool last = (t == nt - 2); const bool skipw = SKIPW && SP2 && (t == 0) && (ui > 0);
            const char* a1 = cA + (size_t)(t + 1) * kstep;
            const char* a2 = last ? nA : cA + (size_t)(t + 2) * kstep; const char* b2 = last ? nB : cB + (size_t)(t + 2) * kstep;
            const char* a3 = a2 + kstep; const char* b3 = b2 + kstep;
            if constexpr (SP2) {
            PG8_LDB(B0, 0, 0); PG8_LDB(B1, 0, 1); PG8_SCHED; PG8_LDA(At, 0, 0); PG8_STA(PG8_SA(1, 1), a1, 1, false);
            if (!skipw) PG8_WAIT_V(8); PG8_WAIT_L(0); PG8_BAR; PG8_MMA(0, 0, At, B0); PG8_MMA(0, 1, At, B1); PG8_BAR; PG8_SCHED;
            PG8_LDA(At, 0, 1); PG8_STAGE(PG8_SB(0, 0), b2, voffB); PG8_STAGE(PG8_SB(0, 1), b2 + hstepB, voffB); PG8_STA(PG8_SA(0, 0), a2, 0, last);
            if (!skipw) PG8_WAIT_V(8); PG8_WAIT_L(0); PG8_BAR; PG8_MMA(1, 0, At, B0); PG8_MMA(1, 1, At, B1); PG8_BAR; PG8_SCHED;
            PG8_LDB(B0, 1, 0); PG8_LDB(B1, 1, 1); PG8_SCHED; PG8_LDA(At, 1, 0); PG8_STA(PG8_SA(0, 1), a2, 1, last);
            PG8_WAIT_V(8); PG8_WAIT_L(0); PG8_BAR; PG8_MMA(0, 0, At, B0); PG8_MMA(0, 1, At, B1); PG8_BAR; PG8_SCHED;
            PG8_LDA(At, 1, 1); PG8_STAGE(PG8_SB(1, 0), b3, voffB); PG8_STAGE(PG8_SB(1, 1), b3 + hstepB, voffB); PG8_STA(PG8_SA(1, 0), a3, 0, last);
            PG8_WAIT_V(8); PG8_WAIT_L(0); PG8_BAR; PG8_MMA(1, 0, At, B0); PG8_MMA(1, 1, At, B1); PG8_BAR; PG8_SCHED;
            } else {
            PG8_LDB(B0, 0, 0); PG8_SCHED; PG8_LDA(At, 0, 0); PG8_STA(PG8_SA(1, 1), a1, 1, false);
            PG8_WAIT_L(8); PG8_BAR; PG8_WAIT_L(0); PG8_MMA(0, 0, At, B0); PG8_BAR; PG8_SCHED;
            PG8_LDB(B1, 0, 1); PG8_STAGE(PG8_SB(0, 0), b2, voffB);
            PG8_BAR; PG8_WAIT_L(0); PG8_MMA(0, 1, At, B1); PG8_BAR;
            PG8_LDA(At, 0, 1); PG8_STA(PG8_SA(0, 0), a2, 0, last);
            PG8_BAR; PG8_WAIT_L(0); PG8_MMA(1, 0, At, B0); PG8_BAR; PG8_SCHED;
            PG8_STAGE(PG8_SB(0, 1), b2 + hstepB, voffB);
            PG8_WAIT_V(6); PG8_BAR; PG8_MMA(1, 1, At, B1); PG8_BAR;
            PG8_LDB(B0, 1, 0); PG8_SCHED; PG8_LDA(At, 1, 0); PG8_STA(PG8_SA(0, 1), a2, 1, last);
            PG8_WAIT_L(8); PG8_BAR; PG8_WAIT_L(0); PG8_MMA(0, 0, At, B0); PG8_BAR; PG8_SCHED;
            PG8_LDB(B1, 1, 1); PG8_STAGE(PG8_SB(1, 0), b3, voffB);
            PG8_BAR; PG8_WAIT_L(0); PG8_MMA(0, 1, At, B1); PG8_BAR;
            PG8_LDA(At, 1, 1); PG8_STA(PG8_SA(1, 0), a3, 0, last);
            PG8_BAR; PG8_WAIT_L(0); PG8_MMA(1, 0, At, B0); PG8_BAR; PG8_SCHED;
            PG8_STAGE(PG8_SB(1, 1), b3 + hstepB, voffB);
            PG8_WAIT_V(6); PG8_BAR; PG8_MMA(1, 1, At, B1); PG8_BAR;
            }
        }
        if constexpr (ALIGN_EPI) { if (wr == 0) PG8_BAR; }
        if constexpr (F8) {
#pragma unroll
            for (int a = 0; a < 2; ++a)
#pragma unroll
                for (int b = 0; b < 2; ++b)
                    asm volatile("s_nop 15\n\ts_nop 7" : "+v"(acc[a][b][0][0]), "+v"(acc[a][b][0][1]), "+v"(acc[a][b][1][0]), "+v"(acc[a][b][1][1]), "+v"(acc[a][b][2][0]), "+v"(acc[a][b][2][1]), "+v"(acc[a][b][3][0]), "+v"(acc[a][b][3][1]));
        }
        if constexpr (SP2 && SKIPW) PG8_WAIT_V(0);
        E(acc, cur, wr, wc, fr, fq);
        if (!has_next) break;
#pragma unroll
        for (int a = 0; a < 2; ++a)
#pragma unroll
            for (int b = 0; b < 2; ++b)
#pragma unroll
                for (int m = 0; m < 4; ++m)
#pragma unroll
                    for (int n = 0; n < 2; ++n) acc[a][b][m][n] = (f32x4){0.f, 0.f, 0.f, 0.f};
        cur = nxt; cA = nA; cB = nB; ++ui;
        if constexpr (GATH) {
#pragma unroll
            for (int h = 0; h < 2; ++h)
#pragma unroll
                for (int i = 0; i < 2; ++i) vcu[h][i] = vnx[h][i]; }
        if constexpr (ALIGN_EPI) { if (wr == 1) PG8_BAR; }
    }
    PG8_WAIT_V(0);
    if constexpr (!ALIGN_EPI) { if (wr == 0) PG8_BAR; }
    PG8_BAR;
#undef PG8_SA
#undef PG8_SB
#undef PG8_STAGE
#undef PG8_STA
#undef PG8_LDA
#undef PG8_LDB
#undef PG8_MMA
#undef PG8_WAIT_V
#undef PG8_WAIT_L
#undef PG8_BAR
#undef PG8_SCHED
}
#ifdef GEMM_SIMPLE
#define GEMM_PHASE(lds, g, S, E) gemm_phase_simple(lds, g, S, E)
#else
#define GEMM_PHASE(lds, g, S, E) gemm_phase<decltype(E), decltype(S), true, true>(lds, g, S, E)
#endif
#define GEMM_PHASE8(lds, g, S, E) gemm_phase<decltype(E), decltype(S), true, true, true>(lds, g, S, E)
#define GEMM_PHASE8N(lds, g, S, E) gemm_phase<decltype(E), decltype(S), true, true, true, false>(lds, g, S, E)

__device__ __forceinline__ float rstd_from_ssq_q(const float* ssq, int row, int fq) {
    const f32x4 a = *(const f32x4*)(ssq + (size_t)row * 16 + 4 * fq); float s = (a[0] + a[1]) + (a[2] + a[3]);
    s += __shfl_xor(s, 16); s += __shfl_xor(s, 32);
    return __builtin_amdgcn_rsqf(s * (1.0f / DM) + EPS);
}
__device__ __forceinline__ float rstd_from_ssq(const float* ssq, int row) {
    const f32x4* p = (const f32x4*)(ssq + (size_t)row * 16); const f32x4 a = p[0], b = p[1], c = p[2], d = p[3];
    const float s = ((a[0] + a[1]) + (a[2] + a[3])) + ((b[0] + b[1]) + (b[2] + b[3])) + ((c[0] + c[1]) + (c[2] + c[3])) + ((d[0] + d[1]) + (d[2] + d[3]));
    return __builtin_amdgcn_rsqf(s * (1.0f / DM) + EPS);
}
__device__ __forceinline__ u32x4 pack8(const f32x4 v0, const f32x4 v1) { u32x4 w; w.x = cvt_pk_bf16(v0[0], v0[1]); w.y = cvt_pk_bf16(v0[2], v0[3]); w.z = cvt_pk_bf16(v1[0], v1[1]); w.w = cvt_pk_bf16(v1[2], v1[3]); return w; }

struct EpiProj {
    static constexpr bool PERM = true, LDSX = false, MIDK = false;
    bf16_t* base; const float* rope; float* ksum;
    __device__ __forceinline__ void operator()(f32x4 (&acc)[2][2][4][2], const Unit& u, int wr, int wc, int fr, int fq) const {
        const int type = u.pn >> 1, colt = (u.pn & 1) * 256;
        bf16_t* O = base + (size_t)type * NTOK * 512;
        const bool is_q = (type == 2), is_k = (type == 3);
        if ((is_q || is_k) && !(wc & 1)) {
#pragma unroll
            for (int ai = 0; ai < 2; ++ai)
#pragma unroll
                for (int m = 0; m < 4; ++m) {
                    const int row = u.pm * 256 + 128 * ai + 64 * wr + 16 * m + fr, pos = row & (SEQ - 1);
                    const float* rp = rope + pos * 16;
                    const f32x4 cs[2] = { *(const f32x4*)(rp), *(const f32x4*)(rp + 4) }, sn[2] = { *(const f32x4*)(rp + 8), *(const f32x4*)(rp + 12) };
#pragma unroll
                    for (int bj = 0; bj < 2; ++bj)
#pragma unroll
                        for (int n = 0; n < 2; ++n) {
                            const f32x4 mine = acc[ai][bj][m][n]; f32x4 oth;
#pragma unroll
                            for (int e = 0; e < 4; ++e) oth[e] = __shfl_xor(mine[e], 16);
                            f32x4 res = mine;
                            if (fq == 0) res = mine * cs[n] - oth * sn[n];
                            else if (fq == 1) res = mine * cs[n] + oth * sn[n];
                            acc[ai][bj][m][n] = res;
                        }
                }
        }
        const float sc = is_q ? QSCALE : 1.0f;
#pragma unroll
        for (int ai = 0; ai < 2; ++ai)
#pragma unroll
            for (int m = 0; m < 4; ++m) {
                const int row = u.pm * 256 + 128 * ai + 64 * wr + 16 * m + fr;
                bf16_t* rowp = O + (size_t)row * 512 + colt + 32 * wc + 8 * fq;
#pragma unroll
                for (int bj = 0; bj < 2; ++bj) *(u32x4*)(rowp + bj * 128) = pack8(acc[ai][bj][m][0] * sc, acc[ai][bj][m][1] * sc);
            }
        if (is_k) {
#pragma unroll
            for (int bj = 0; bj < 2; ++bj)
#pragma unroll
                for (int n = 0; n < 2; ++n)
#pragma unroll
                    for (int e = 0; e < 4; ++e) {
                        float s = 0.f;
#pragma unroll
                        for (int ai = 0; ai < 2; ++ai)
#pragma unroll
                            for (int m = 0; m < 4; ++m) s += acc[ai][bj][m][n][e];
                        s += __shfl_xor(s, 1); s += __shfl_xor(s, 2); s += __shfl_xor(s, 4); s += __shfl_xor(s, 8);
                        if (fr == 0) atomicAdd(ksum + (size_t)u.pm * 512 + colt + 128 * bj + 32 * wc + 8 * fq + 4 * n + e, s);
                    }
        }
    }
};
struct EpiNull {
    static constexpr bool PERM = true, LDSX = false, MIDK = false;
    __device__ __forceinline__ void operator()(f32x4 (&acc)[2][2][4][2], const Unit& u, int wr, int wc, int fr, int fq) const {
        f32x4 t = {0.f, 0.f, 0.f, 0.f};
#pragma unroll
        for (int a = 0; a < 2; ++a)
#pragma unroll
            for (int b = 0; b < 2; ++b)
#pragma unroll
                for (int m = 0; m < 4; ++m)
#pragma unroll
                    for (int n = 0; n < 2; ++n) t += acc[a][b][m][n];
        asm volatile("" :: "v"(t)); }
};
struct EpiStore {
    static constexpr bool PERM = true, LDSX = false, MIDK = false;
    bf16_t* O; int ldc; float sc = 1.0f;
    __device__ __forceinline__ void operator()(f32x4 (&acc)[2][2][4][2], const Unit& u, int wr, int wc, int fr, int fq) const {
#pragma unroll
        for (int ai = 0; ai < 2; ++ai)
#pragma unroll
            for (int m = 0; m < 4; ++m) {
                const int row = u.pm * 256 + 128 * ai + 64 * wr + 16 * m + fr;
                bf16_t* rowp = O + (size_t)row * ldc + u.pn * 256 + 32 * wc + 8 * fq;
#pragma unroll
                for (int bj = 0; bj < 2; ++bj) *(u32x4*)(rowp + bj * 128) = pack8(acc[ai][bj][m][0] * sc, acc[ai][bj][m][1] * sc);
            }
    }
};
struct EpiStore8 {
    static constexpr bool PERM = true, LDSX = false, MIDK = false;
    unsigned char* O; int ldc; float sc;
    __device__ __forceinline__ void operator()(f32x4 (&acc)[2][2][4][2], const Unit& u, int wr, int wc, int fr, int fq) const {
#pragma unroll
        for (int ai = 0; ai < 2; ++ai)
#pragma unroll
            for (int m = 0; m < 4; ++m) {
                const int row = u.pm * 256 + 128 * ai + 64 * wr + 16 * m + fr;
                unsigned char* rowp = O + (size_t)row * ldc + u.pn * 256 + 32 * wc + 8 * fq;
#pragma unroll
                for (int bj = 0; bj < 2; ++bj) { const f32x4 a0 = acc[ai][bj][m][0] * sc, a1 = acc[ai][bj][m][1] * sc; u32x2 w; w.x = pk4_fp8(a0[0], a0[1], a0[2], a0[3]); w.y = pk4_fp8(a1[0], a1[1], a1[2], a1[3]); *(u32x2*)(rowp + bj * 128) = w; }
            }
    }
};
template <bool BASE_F32, bool KSPLIT> struct EpiResid {
    static constexpr bool PERM = true, LDSX = false, MIDK = KSPLIT;
    const void* base; bf16_t* hb; float* ssq; const float* ssql; const float* ssqa; unsigned char* h8; float asc; const float* rs0 = nullptr; const float* gmix = nullptr;
    __device__ __forceinline__ void stats(int row, int fq, float& rl, float& ra) const {
        const f32x4 pl = *(const f32x4*)(ssql + (size_t)row * 16 + 4 * fq); const f32x2 pa = *(const f32x2*)(ssqa + (size_t)row * 8 + 2 * fq);
        float sl = (pl[0] + pl[1]) + (pl[2] + pl[3]), sa = pa[0] + pa[1];
        sl += __shfl_xor(sl, 16); sl += __shfl_xor(sl, 32); sa += __shfl_xor(sa, 16); sa += __shfl_xor(sa, 32);
        rl = __builtin_amdgcn_rsqf(sl * (1.0f / 512.0f) + EPS); ra = __builtin_amdgcn_rsqf(sa * (1.0f / 512.0f) + EPS);
    }
    __device__ __forceinline__ void midk(f32x4 (&acc)[2][2][4][2], const Unit& u, int wr, int wc, int fr, int fq) const {
        asm volatile("" : "+v"(fr), "+v"(fq));
#pragma unroll
        for (int ai = 0; ai < 2; ++ai)
#pragma unroll
            for (int m = 0; m < 4; ++m) { float rl, ra; stats(u.pm * 256 + 128 * ai + 64 * wr + 16 * m + fr, fq, rl, ra); const float ratio = rl * __builtin_amdgcn_rcpf(ra);
#pragma unroll
                for (int bj = 0; bj < 2; ++bj)
#pragma unroll
                    for (int n = 0; n < 2; ++n) acc[ai][bj][m][n] *= ratio; }
    }
    __device__ __forceinline__ void operator()(f32x4 (&acc)[2][2][4][2], const Unit& u, int wr, int wc, int fr, int fq) const {
        f32x4 ginv[2][2];
        if constexpr (BASE_F32) {
#pragma unroll
            for (int bj = 0; bj < 2; ++bj)
#pragma unroll
                for (int n = 0; n < 2; ++n) { const f32x4 g = *(const f32x4*)(gmix + u.pn * 256 + 128 * bj + 32 * wc + 8 * fq + 4 * n);
                    ginv[bj][n] = (f32x4){__builtin_amdgcn_rcpf(g[0]), __builtin_amdgcn_rcpf(g[1]), __builtin_amdgcn_rcpf(g[2]), __builtin_amdgcn_rcpf(g[3])}; } }
#pragma unroll
        for (int ai = 0; ai < 2; ++ai)
#pragma unroll
            for (int m = 0; m < 4; ++m) {
                const int row = u.pm * 256 + 128 * ai + 64 * wr + 16 * m + fr; float q = 0.f, osc = asc, irs = 1.0f;
                if constexpr (KSPLIT) { float rl; stats(row, fq, rl, osc); osc *= asc; }
                if constexpr (BASE_F32) irs = __builtin_amdgcn_rcpf(rs0[row]);
#pragma unroll
                for (int bj = 0; bj < 2; ++bj) {
                    const int col = u.pn * 256 + 128 * bj + 32 * wc + 8 * fq;
                    f32x4 b0, b1;
                    if constexpr (BASE_F32) { const u32x4 w = *(const u32x4*)((const bf16_t*)base + (size_t)row * DM + col);
                        b0 = (f32x4){bflo(w.x), bfhi(w.x), bflo(w.y), bfhi(w.y)} * (ginv[bj][0] * irs); b1 = (f32x4){bflo(w.z), bfhi(w.z), bflo(w.w), bfhi(w.w)} * (ginv[bj][1] * irs); }
                    else { const u32x4 w = *(const u32x4*)((const bf16_t*)base + (size_t)row * LDH + col); b0 = (f32x4){bflo(w.x), bfhi(w.x), bflo(w.y), bfhi(w.y)}; b1 = (f32x4){bflo(w.z), bfhi(w.z), bflo(w.w), bfhi(w.w)}; }
                    const f32x4 v0 = b0 + acc[ai][bj][m][0] * osc, v1 = b1 + acc[ai][bj][m][1] * osc;
                    q += ((v0[0] * v0[0] + v0[1] * v0[1]) + (v0[2] * v0[2] + v0[3] * v0[3])) + ((v1[0] * v1[0] + v1[1] * v1[1]) + (v1[2] * v1[2] + v1[3] * v1[3]));
                    *(u32x4*)(hb + (size_t)row * LDH + col) = pack8(v0, v1);
                    if (h8) { u32x2 w8; w8.x = pk4_fp8(v0[0], v0[1], v0[2], v0[3]); w8.y = pk4_fp8(v1[0], v1[1], v1[2], v1[3]); *(u32x2*)(h8 + (size_t)row * DM + col) = w8; }
                }
                q += __shfl_xor(q, 16); q += __shfl_xor(q, 32);
                if (fq == 0) ssq[(size_t)row * 16 + u.pn * 4 + wc] = q;
            }
    }
};
struct EpiRowScale {
    static constexpr bool PERM = true, LDSX = false, MIDK = false;
    bf16_t* O; int ldc; const float* ssq; float cs;
    __device__ __forceinline__ void operator()(f32x4 (&acc)[2][2][4][2], const Unit& u, int wr, int wc, int fr, int fq) const {
#pragma unroll
        for (int ai = 0; ai < 2; ++ai)
#pragma unroll
            for (int m = 0; m < 4; ++m) {
                const int row = u.pm * 256 + 128 * ai + 64 * wr + 16 * m + fr; const float s = rstd_from_ssq(ssq, row) * cs;
                bf16_t* rowp = O + (size_t)row * ldc + u.pn * 256 + 32 * wc + 8 * fq;
#pragma unroll
                for (int bj = 0; bj < 2; ++bj) *(u32x4*)(rowp + bj * 128) = pack8(acc[ai][bj][m][0] * s, acc[ai][bj][m][1] * s);
            }
    }
};
#define XBAR() do { asm volatile("s_waitcnt lgkmcnt(0)" ::: "memory"); __builtin_amdgcn_s_barrier(); asm volatile("" ::: "memory"); } while (0)
struct EpiSoftmax {
    static constexpr bool PERM = true, LDSX = false, MIDK = false;
    unsigned char* O; int ldc; LAS unsigned char* xl; const float* ssq; float cs;
    __device__ __forceinline__ void operator()(f32x4 (&acc)[2][2][4][2], const Unit& u, int wr, int wc, int fr, int fq) const {
        LAS float* P = (LAS float*)xl;
        LAS float* Q = (LAS float*)(xl + 4096);
#pragma unroll
        for (int ai = 0; ai < 2; ++ai)
#pragma unroll
            for (int m = 0; m < 4; ++m) {
                float v = -INFINITY; const float sc = rstd_from_ssq(ssq, u.pm * 256 + 128 * ai + 64 * wr + 16 * m + fr) * cs;
#pragma unroll
                for (int bj = 0; bj < 2; ++bj)
#pragma unroll
                    for (int n = 0; n < 2; ++n) { const f32x4 x = acc[ai][bj][m][n] * sc; acc[ai][bj][m][n] = x; v = fmaxf(v, fmaxf(fmaxf(x[0], x[1]), fmaxf(x[2], x[3]))); }
                v = fmaxf(v, __shfl_xor(v, 16)); v = fmaxf(v, __shfl_xor(v, 32));
                if (fq == 0) P[(128 * ai + 64 * wr + 16 * m + fr) * 4 + wc] = v;
            }
        XBAR();
#pragma unroll
        for (int ai = 0; ai < 2; ++ai)
#pragma unroll
            for (int m = 0; m < 4; ++m) {
                const int r = 128 * ai + 64 * wr + 16 * m + fr;
                const float v = fmaxf(fmaxf(P[r * 4 + 0], P[r * 4 + 1]), fmaxf(P[r * 4 + 2], P[r * 4 + 3]));
                float s = 0.f;
#pragma unroll
                for (int bj = 0; bj < 2; ++bj)
#pragma unroll
                    for (int n = 0; n < 2; ++n) { f32x4 x = acc[ai][bj][m][n];
#pragma unroll
                        for (int e = 0; e < 4; ++e) { x[e] = __builtin_amdgcn_exp2f(x[e] - v); s += x[e]; }
                        acc[ai][bj][m][n] = x; }
                s += __shfl_xor(s, 16); s += __shfl_xor(s, 32);
                if (fq == 0) Q[r * 4 + wc] = s;
            }
        XBAR();
#pragma unroll
        for (int ai = 0; ai < 2; ++ai)
#pragma unroll
            for (int m = 0; m < 4; ++m) {
                const int r = 128 * ai + 64 * wr + 16 * m + fr;
                const float inv = PX_SC * __builtin_amdgcn_rcpf((Q[r * 4 + 0] + Q[r * 4 + 1]) + (Q[r * 4 + 2] + Q[r * 4 + 3]));
                unsigned char* rowp = O + (size_t)(u.pm * 256 + r) * ldc + u.pn * 256 + 32 * wc + 8 * fq;
#pragma unroll
                for (int bj = 0; bj < 2; ++bj) { const f32x4 a0 = acc[ai][bj][m][0] * inv, a1 = acc[ai][bj][m][1] * inv; u32x2 w; w.x = pk4_fp8(a0[0], a0[1], a0[2], a0[3]); w.y = pk4_fp8(a1[0], a1[1], a1[2], a1[3]); *(u32x2*)(rowp + bj * 128) = w; }
            }
        XBAR();
    }
};
struct EpiGateUp {
    static constexpr bool PERM = true, LDSX = false, MIDK = false;
    unsigned char* O; const float* lrs;
    __device__ __forceinline__ void operator()(f32x4 (&acc)[2][2][4][2], const Unit& u, int wr, int wc, int fr, int fq) const {
#pragma unroll
        for (int ai = 0; ai < 2; ++ai)
#pragma unroll
            for (int m = 0; m < 4; ++m) {
                const int r = 128 * ai + 64 * wr + 16 * m + fr, row = u.pm * 256 + r; const float rs = (r < u.nvalid) ? lrs[u.lbase + r] * (1.0f / WGU_SC) : 0.f;
                f32x4 o[2];
#pragma unroll
                for (int n = 0; n < 2; ++n)
#pragma unroll
                    for (int e = 0; e < 4; ++e) { const float g = acc[ai][0][m][n][e] * rs, up = acc[ai][1][m][n][e] * rs; o[n][e] = g * sigmoidf_(g) * up * ACT_SC; }
                u32x2 w8; w8.x = pk4_fp8(o[0][0], o[0][1], o[0][2], o[0][3]); w8.y = pk4_fp8(o[1][0], o[1][1], o[1][2], o[1][3]);
                *(u32x2*)(O + (size_t)row * DFF + u.pn * 128 + 32 * wc + 8 * fq) = w8;
            }
    }
};

struct Args { const float* in[27]; float* out; unsigned char* ws; int ph_lo, ph_hi; float invf[8]; };
struct Ctx { LAS unsigned char* lds; int tid, lane, wave, vcu, G; };

__device__ __forceinline__ void tr_load(f32x4 (&v)[8], const float* W, int ldw, int k0, int n0s, int lane) {
    const int kr = lane >> 3, ch = lane & 7;
#pragma unroll
    for (int i = 0; i < 8; ++i) v[i] = *(const f32x4*)(W + (size_t)(k0 + 8 * i + kr) * ldw + n0s + 4 * ch);
}
__device__ __forceinline__ void tr_finish(const f32x4 (&v)[8], int k0, bf16_t* WT, int ldt, int r0d, const float* gain, LAS float* scr, int lane) {
    const int kr = lane >> 3, ch = lane & 7, c = lane & 7;
    f32x4 g0 = {1.f, 1.f, 1.f, 1.f}, g1 = {1.f, 1.f, 1.f, 1.f};
    if (gain) { g0 = *(const f32x4*)(gain + k0 + 8 * c); g1 = *(const f32x4*)(gain + k0 + 8 * c + 4); }
#pragma unroll
    for (int i = 0; i < 8; ++i) { LAS float* d = scr + (8 * i + kr) * 33 + 4 * ch; d[0] = v[i][0]; d[1] = v[i][1]; d[2] = v[i][2]; d[3] = v[i][3]; }
    LDS_WAIT(); asm volatile("" ::: "memory");
#pragma unroll
    for (int j = 0; j < 4; ++j) { const int n = (lane >> 3) + 8 * j; const LAS float* s = scr + (8 * c) * 33 + n;
        u32x4 o; o.x = cvt_pk_bf16(s[0 * 33] * g0[0], s[1 * 33] * g0[1]); o.y = cvt_pk_bf16(s[2 * 33] * g0[2], s[3 * 33] * g0[3]); o.z = cvt_pk_bf16(s[4 * 33] * g1[0], s[5 * 33] * g1[1]); o.w = cvt_pk_bf16(s[6 * 33] * g1[2], s[7 * 33] * g1[3]);
        *(u32x4*)(WT + (size_t)(r0d + n) * ldt + k0 + 8 * c) = o; }
    LDS_WAIT(); asm volatile("" ::: "memory");
}
__device__ __forceinline__ void tr_finish8(const f32x4 (&v)[8], int k0, unsigned char* WT8, int ldt, int r0d, const float* gain, float sc, LAS float* scr, int lane) {
    const int kr = lane >> 3, ch = lane & 7, c = lane & 7;
    f32x4 g0 = {sc, sc, sc, sc}, g1 = {sc, sc, sc, sc};
    if (gain) { g0 = *(const f32x4*)(gain + k0 + 8 * c) * sc; g1 = *(const f32x4*)(gain + k0 + 8 * c + 4) * sc; }
#pragma unroll
    for (int i = 0; i < 8; ++i) { LAS float* d = scr + (8 * i + kr) * 33 + 4 * ch; d[0] = v[i][0]; d[1] = v[i][1]; d[2] = v[i][2]; d[3] = v[i][3]; }
    LDS_WAIT(); asm volatile("" ::: "memory");
#pragma unroll
    for (int j = 0; j < 4; ++j) { const int n = (lane >> 3) + 8 * j; const LAS float* s = scr + (8 * c) * 33 + n;
        u32x2 o; o.x = pk4_fp8(s[0 * 33] * g0[0], s[1 * 33] * g0[1], s[2 * 33] * g0[2], s[3 * 33] * g0[3]); o.y = pk4_fp8(s[4 * 33] * g1[0], s[5 * 33] * g1[1], s[6 * 33] * g1[2], s[7 * 33] * g1[3]);
        *(u32x2*)(WT8 + (size_t)(r0d + n) * ldt + k0 + 8 * c) = o; }
    LDS_WAIT(); asm volatile("" ::: "memory");
}
__device__ __forceinline__ void tr_item(const float* W, int ldw, int k0, int n0s, bf16_t* WT, int ldt, int r0d, const float* gain, LAS float* scr, int lane) {
    f32x4 v[8]; tr_load(v, W, ldw, k0, n0s, lane); tr_finish(v, k0, WT, ldt, r0d, gain, scr, lane);
}
__device__ __forceinline__ void rms_row_to_bf16(const float* xrow, const float* gain, bf16_t* orow, int lane) {
    const f32x4* xr = (const f32x4*)xrow + lane; const f32x4* gr = (const f32x4*)gain + lane;
    f32x4 v[4]; float s = 0.f;
#pragma unroll
    for (int j = 0; j < 4; ++j) { v[j] = xr[64 * j]; s += (v[j][0] * v[j][0] + v[j][1] * v[j][1]) + (v[j][2] * v[j][2] + v[j][3] * v[j][3]); }
    const float rstd = 1.0f / sqrtf(wave_sum(s) * (1.0f / DM) + EPS);
    u32x2* o8 = (u32x2*)orow + lane;
#pragma unroll
    for (int j = 0; j < 4; ++j) { const f32x4 g = gr[64 * j]; u32x2 w; w.x = cvt_pk_bf16(v[j][0] * rstd * g[0], v[j][1] * rstd * g[1]); w.y = cvt_pk_bf16(v[j][2] * rstd * g[2], v[j][3] * rstd * g[3]); o8[64 * j] = w; }
}

__device__ __forceinline__ void rms_row2_to_bf16(const float* xrow, const float* gain, bf16_t* orow, int lane, float* rstd_out = nullptr) {
    const f32x4* xr = (const f32x4*)xrow + lane; const f32x4* gr = (const f32x4*)gain + lane;
    f32x4 v[2][4]; float s[2] = {0.f, 0.f};
#pragma unroll
    for (int r = 0; r < 2; ++r)
#pragma unroll
        for (int j = 0; j < 4; ++j) v[r][j] = xr[256 * r + 64 * j];
#pragma unroll
    for (int r = 0; r < 2; ++r)
#pragma unroll
        for (int j = 0; j < 4; ++j) s[r] += (v[r][j][0] * v[r][j][0] + v[r][j][1] * v[r][j][1]) + (v[r][j][2] * v[r][j][2] + v[r][j][3] * v[r][j][3]);
#pragma unroll
    for (int r = 0; r < 2; ++r) { const float rstd = 1.0f / sqrtf(wave_sum(s[r]) * (1.0f / DM) + EPS); u32x2* o8 = (u32x2*)(orow + (size_t)r * DM) + lane; if (rstd_out && lane == 0) rstd_out[r] = rstd;
#pragma unroll
        for (int j = 0; j < 4; ++j) { const f32x4 g = gr[64 * j]; u32x2 w; w.x = cvt_pk_bf16(v[r][j][0] * rstd * g[0], v[r][j][1] * rstd * g[1]); w.y = cvt_pk_bf16(v[r][j][2] * rstd * g[2], v[r][j][3] * rstd * g[3]); o8[64 * j] = w; } }
}

__device__ __forceinline__ void conv_wdn(const Args& a, const Ctx& C, int gw, int NGW, int it_lo, int NIT) {
    LAS float* scr = (LAS float*)(C.lds + C.wave * 16384); const int lane = C.lane;
    f32x4 va[8], vb[8];
#define WDN_LOAD(v, it) do { const int e_ = (it) / 256, r_ = (it) % 256; tr_load(v, a.in[25] + (size_t)e_ * DFF * DM, DM, 64 * (r_ / 32), 32 * (r_ % 32), lane); } while (0)
#define WDN_FIN(v, it) do { const int e_ = (it) / 256, r_ = (it) % 256; tr_finish8(v, 64 * (r_ / 32), a.ws + WS_WDN, DFF, e_ * 1024 + 32 * (r_ % 32), nullptr, WDN_SC, scr, lane); } while (0)
    int it = it_lo + gw; if (it < NIT) WDN_LOAD(va, it);
    for (; it < NIT; it += 2 * NGW) {
        const int it1 = it + NGW, it2 = it + 2 * NGW;
        if (it1 < NIT) WDN_LOAD(vb, it1);
        WDN_FIN(va, it);
        if (it2 < NIT) WDN_LOAD(va, it2);
        if (it1 < NIT) WDN_FIN(vb, it1);
    }
#undef WDN_LOAD
#undef WDN_FIN
}
__device__ __forceinline__ void ph_prologue(const Args& a, const Ctx& C) {
    unsigned char* ws = a.ws;
    LAS float* scr = (LAS float*)(C.lds + C.wave * 16384);
    const int gw = C.vcu * 8 + C.wave, NGW = C.G * 8, lane = C.lane;
    for (int it = gw; it < 16 * 80; it += NGW) { const int kb = it / 80, nb = it % 80; tr_item(a.in[3], DIN, 64 * kb, 32 * nb, (bf16_t*)(ws + WS_WIN), DM, 32 * nb, nullptr, scr, lane); }
    for (int it = gw; it < 16 * 64; it += NGW) { const int kb = it / 64, nb = it % 64;
        if (nb < 32) tr_item(a.in[17], 2 * DM, 64 * kb, 32 * nb, (bf16_t*)(ws + WS_WXK), DM, 32 * nb, nullptr, scr, lane);
        else tr_item(a.in[17], 2 * DM, 64 * kb, 32 * nb, (bf16_t*)(ws + WS_WXV), DM, 32 * (nb - 32), nullptr, scr, lane); }
    for (int it = gw; it < 16 * 32; it += NGW) { const int kb = it / 32, nb = it % 32;
        tr_item(a.in[13], DM, 64 * kb, 32 * nb, (bf16_t*)(ws + WS_WOUT), DM, 32 * nb, (kb < 8) ? a.in[11] : (a.in[12] - DLRU), scr, lane);
        tr_item(a.in[18], DM, 64 * kb, 32 * nb, (bf16_t*)(ws + WS_WXO), DM, 32 * nb, nullptr, scr, lane); }
    for (int r = gw; r < DM; r += NGW) { const float gk = a.in[14][r]; const f32x4* src = (const f32x4*)(a.in[16] + (size_t)r * DM) + lane; u32x2* dst = (u32x2*)((bf16_t*)(ws + WS_WXQ) + (size_t)r * DM) + lane;
#pragma unroll
        for (int j = 0; j < 4; ++j) { const f32x4 v = src[64 * j]; u32x2 w; w.x = cvt_pk_bf16(v[0] * gk, v[1] * gk); w.y = cvt_pk_bf16(v[2] * gk, v[3] * gk); dst[64 * j] = w; } }
    { bf16_t* WR = (bf16_t*)(ws + WS_WR); const int gt = C.vcu * 512 + C.tid, NT = C.G * 512;
      for (int i = gt; i < 48 * DM; i += NT) { const int r = i / DM, k = i % DM; float v = 0.f;
          if (r < 4) v = a.in[20][k * NGRP + r] * a.in[19][k]; else if (r < 36) v = a.in[22][k * NEXP + (r - 4)] * a.in[19][k];
          WR[i] = (bf16_t)(cvt_pk_bf16(v, 0.f) & 0xffffu); }
      float* rope = (float*)(ws + WS_ROPE);
      for (int i = gt; i < SEQ * 8; i += NT) { const int pos = i >> 3, j = i & 7; const float ang = (float)pos * a.invf[j];
          const double tw = 6.283185307179586476925286766559; const double ad = (double)ang; const double red = ad - tw * __builtin_rint(ad / tw); const float rf = (float)red;
          rope[pos * 16 + j] = __cosf(rf); rope[pos * 16 + 8 + j] = __sinf(rf); } }
    for (int m = 2 * gw; m < NTOK; m += 2 * NGW) rms_row2_to_bf16(a.in[0] + (size_t)m * DM, a.in[2], (bf16_t*)(ws + WS_B) + (size_t)m * DM, lane, (float*)(ws + WS_TOK + TOK_D) + m);
    for (int m = 2 * gw; m < NMEM; m += 2 * NGW) rms_row2_to_bf16(a.in[1] + (size_t)m * DM, a.in[15], (bf16_t*)(ws + WS_MEMN) + (size_t)m * DM, lane);
}

__device__ __forceinline__ float gelu_tanh(float x) { const float x2 = x * x; const float z2 = x * (-2.0f * 0.7978845608028654f * 1.4426950408889634f) * (1.0f + 0.044715f * x2);
    return x * __builtin_amdgcn_rcpf(1.0f + __builtin_amdgcn_exp2f(z2)); }
__device__ __forceinline__ bool moe_item_load(f32x4 (&v)[8], const Args& a, int s, int lane) {
    if (s < NEXP * 512) { const int e = s / 512, r = s % 512, kb = r / 32, nb = r % 32, j = nb >> 3, half = (nb >> 2) & 1, q = nb & 3;
        tr_load(v, a.in[24] + (size_t)e * DM * DM, DM, 64 * kb, half * 512 + j * 128 + q * 32, lane); return true; }
    const int it = s - NEXP * 512 + WDN_SPLIT; if (it >= NEXP * 256) return false;
    const int e = it / 256, r = it % 256; tr_load(v, a.in[25] + (size_t)e * DFF * DM, DM, 64 * (r / 32), 32 * (r % 32), lane); return true;
}
__device__ __forceinline__ void moe_item_finish(const f32x4 (&v)[8], const Args& a, int s, LAS float* scr, int lane) {
    if (s < NEXP * 512) { const int e = s / 512, r = s % 512, kb = r / 32, nb = r % 32, j = nb >> 3, half = (nb >> 2) & 1, q = nb & 3;
        tr_finish8(v, 64 * kb, a.ws + WS_WGU, DM, e * 1024 + j * 256 + half * 128 + q * 32, a.in[19], WGU_SC, scr, lane); return; }
    const int it = s - NEXP * 512 + WDN_SPLIT; const int e = it / 256, r = it % 256;
    tr_finish8(v, 64 * (r / 32), a.ws + WS_WDN, DFF, e * 1024 + 32 * (r % 32), nullptr, WDN_SC, scr, lane);
}
__device__ __forceinline__ float one_minus_exp(float x) {
    const float p = -x * (1.0f + x * (0.5f + x * (0.16666667f + x * (0.041666668f + x * 0.0083333338f))));
    const float e = 1.0f - __builtin_amdgcn_exp2f(x * 1.4426950408889634f);
    return (x > -0.25f) ? p : e;
}
__device__ __forceinline__ void lru_unit(const Args& a, const Ctx& C, int b, int blk, int half, int L) {
    unsigned char* ws = a.ws;
    const bf16_t* XL = (const bf16_t*)(ws + WS_A); const bf16_t* GL = XL + (size_t)NTOK * 512; bf16_t* YC = (bf16_t*)(ws + WS_C); float* SSQL = (float*)(ws + WS_SSQL);
    const int tid = C.tid, lane = C.lane, wave = C.wave, fr = lane & 15, fq = lane >> 4;
    LAS float* cscr = (LAS float*)(C.lds + 46336 + wave * 8448);
    LAS float* XW = (LAS float*)(C.lds + wave * 5120);
    LAS bf16_t* GW = (LAS bf16_t*)(C.lds + wave * 5120 + 2304);
    LAS bf16_t* YW = (LAS bf16_t*)(C.lds + wave * 5120 + 3584);
    LAS float* WSUM = (LAS float*)(C.lds + 40960);
    LAS float* CW = (LAS float*)(C.lds + 45056);
    const int c0 = blk * 64, oc0 = c0 + half * 32;
    bf16x8 wfr[2][2][2];
#pragma unroll
    for (int gt = 0; gt < 2; ++gt) { const float* W = a.in[gt == 0 ? 6 : 8] + (size_t)blk * 64 * 64;
#pragma unroll
        for (int nt = 0; nt < 2; ++nt)
#pragma unroll
            for (int ks = 0; ks < 2; ++ks) { u32x4 w; float f[8];
#pragma unroll
                for (int j = 0; j < 8; ++j) f[j] = W[(32 * ks + 8 * fq + j) * 64 + half * 32 + 16 * nt + fr];
                w.x = cvt_pk_bf16(f[0], f[1]); w.y = cvt_pk_bf16(f[2], f[3]); w.z = cvt_pk_bf16(f[4], f[5]); w.w = cvt_pk_bf16(f[6], f[7]);
                wfr[gt][nt][ks] = __builtin_bit_cast(bf16x8, w); } }
    LAS bf16x8* WF = (LAS bf16x8*)(C.lds + 113920);
    if (wave == 0) {
#pragma unroll
        for (int gt = 0; gt < 2; ++gt)
#pragma unroll
            for (int nt = 0; nt < 2; ++nt)
#pragma unroll
                for (int ks = 0; ks < 2; ++ks) WF[((gt * 2 + nt) * 2 + ks) * 64 + lane] = wfr[gt][nt][ks]; }
    float brg[2], big[2], sp[2], hc[2] = {0.f, 0.f};
#pragma unroll
    for (int nt = 0; nt < 2; ++nt) { const int ch = oc0 + 16 * nt + fr; brg[nt] = a.in[7][ch] * -1.4426950408889634f; big[nt] = a.in[9][ch] * -1.4426950408889634f; const float lam = a.in[10][ch];
        sp[nt] = -8.0f * 1.4426950408889634f * ((lam > 15.f) ? __expf(-lam) : log1pf(__expf(-lam))); }
    if (tid < 320) { const int k = tid >> 6, c = tid & 63; CW[tid] = (k < 4) ? a.in[4][k * DLRU + c0 + c] : a.in[5][c0 + c]; }
    u32x4 xr1[4][2], gr1;
    const bf16_t* xrow0 = XL + ((size_t)b * SEQ + 16 * wave + fr) * 512 + c0 + 8 * fq;
    const bf16_t* grow0 = GL + ((size_t)b * SEQ + 16 * wave + (lane >> 2)) * 512 + oc0 + 8 * (lane & 3);
    const int tloc = 16 * wave + fr;
#define LRU_PREFETCH(t0_, xr, gr) do { _Pragma("unroll") for (int k = 0; k < 4; ++k) { const int tt = (t0_) + tloc - 3 + k; \
        if (tt >= 0) { const bf16_t* xp = xrow0 + (ptrdiff_t)((t0_) - 3 + k) * 512; xr[k][0] = *(const u32x4*)xp; xr[k][1] = *(const u32x4*)(xp + 32); } else { xr[k][0] = (u32x4){0u, 0u, 0u, 0u}; xr[k][1] = (u32x4){0u, 0u, 0u, 0u}; } } \
        gr = *(const u32x4*)(grow0 + (size_t)(t0_) * 512); } while (0)
    LRU_PREFETCH(0, xr1, gr1);
    __syncthreads();
    for (int ch2 = 0; ch2 < SEQ / 256; ++ch2) {
#pragma unroll
      for (int sub = 0; sub < 2; ++sub) { const int ch = 2 * ch2 + sub, t0 = ch * 128; auto& xr = xr1; auto& gr = gr1;
        f32x4 cv[8]; const int cslot = sub * (NEXP * 512) + (ch2 * 256 + L) * 8 + wave; const bool chas = moe_item_load(cv, a, cslot, lane);
        bf16x8 af[2];
#pragma unroll
        for (int ks = 0; ks < 2; ++ks) { float accv[8];
            { const f32x4 b0 = *(const LAS f32x4*)(CW + 256 + 32 * ks + 8 * fq), b1 = *(const LAS f32x4*)(CW + 256 + 32 * ks + 8 * fq + 4);
              accv[0] = b0[0]; accv[1] = b0[1]; accv[2] = b0[2]; accv[3] = b0[3]; accv[4] = b1[0]; accv[5] = b1[1]; accv[6] = b1[2]; accv[7] = b1[3]; }
#pragma unroll
            for (int k = 0; k < 4; ++k) { const f32x4 w0 = *(const LAS f32x4*)(CW + 64 * k + 32 * ks + 8 * fq), w1 = *(const LAS f32x4*)(CW + 64 * k + 32 * ks + 8 * fq + 4); const u32x4 x = xr[k][ks];
                accv[0] += w0[0] * bflo(x.x); accv[1] += w0[1] * bfhi(x.x); accv[2] += w0[2] * bflo(x.y); accv[3] += w0[3] * bfhi(x.y);
                accv[4] += w1[0] * bflo(x.z); accv[5] += w1[1] * bfhi(x.z); accv[6] += w1[2] * bflo(x.w); accv[7] += w1[3] * bfhi(x.w); }
            u32x4 p; p.x = cvt_pk_bf16(accv[0], accv[1]); p.y = cvt_pk_bf16(accv[2], accv[3]); p.z = cvt_pk_bf16(accv[4], accv[5]); p.w = cvt_pk_bf16(accv[6], accv[7]);
            af[ks] = __builtin_bit_cast(bf16x8, p);
            if (ks == half) { *(LAS f32x4*)(XW + fr * 36 + 8 * fq) = (f32x4){accv[0], accv[1], accv[2], accv[3]}; *(LAS f32x4*)(XW + fr * 36 + 8 * fq + 4) = (f32x4){accv[4], accv[5], accv[6], accv[7]}; } }
        *(LAS u32x4*)(GW + (lane >> 2) * 40 + 8 * (lane & 3)) = gr;
        if (ch + 1 < SEQ / 128) LRU_PREFETCH(t0 + 128, xr, gr);
        LDS_WAIT(); asm volatile("" ::: "memory");
        float Hl[2][4], Al[2][4], Aex[2], Hex[2];
        { f32x4 ar[2] = {{0.f, 0.f, 0.f, 0.f}, {0.f, 0.f, 0.f, 0.f}}, ai_[2] = {{0.f, 0.f, 0.f, 0.f}, {0.f, 0.f, 0.f, 0.f}};
#pragma unroll
          for (int ks = 0; ks < 2; ++ks)
#pragma unroll
              for (int nt = 0; nt < 2; ++nt) { ar[nt] = __builtin_amdgcn_mfma_f32_16x16x32_bf16(af[ks], WF[((0 * 2 + nt) * 2 + ks) * 64 + lane], ar[nt], 0, 0, 0); ai_[nt] = __builtin_amdgcn_mfma_f32_16x16x32_bf16(af[ks], WF[((1 * 2 + nt) * 2 + ks) * 64 + lane], ai_[nt], 0, 0, 0); }
#pragma unroll
          for (int nt = 0; nt < 2; ++nt) {
              float hrun = 0.f, arun = 1.f;
#pragma unroll
              for (int r = 0; r < 4; ++r) { const int chn = 16 * nt + fr;
                  const float rg = __builtin_amdgcn_rcpf(1.0f + __builtin_amdgcn_exp2f(__builtin_fmaf(ar[nt][r], -1.4426950408889634f, brg[nt])));
                  const float ig = __builtin_amdgcn_rcpf(1.0f + __builtin_amdgcn_exp2f(__builtin_fmaf(ai_[nt][r], -1.4426950408889634f, big[nt])));
                  const float av = __builtin_amdgcn_exp2f(rg * sp[nt]); const float mult = __builtin_amdgcn_sqrtf(fmaxf(1.0f - av * av, 0.f));
                  const float uv = mult * ig * XW[(4 * fq + r) * 36 + chn];
                  hrun = av * hrun + uv; arun *= av; Hl[nt][r] = hrun; Al[nt][r] = arun; }
              const float A0 = __shfl(arun, fr), H0 = __shfl(hrun, fr), A1 = __shfl(arun, fr + 16), H1 = __shfl(hrun, fr + 16), A2 = __shfl(arun, fr + 32), H2 = __shfl(hrun, fr + 32), A3 = __shfl(arun, fr + 48), H3 = __shfl(hrun, fr + 48);
              const float h01 = A1 * H0 + H1, a01 = A1 * A0, h012 = A2 * h01 + H2, a012 = A2 * a01;
              Aex[nt] = (fq == 0) ? 1.f : (fq == 1) ? A0 : (fq == 2) ? a01 : a012;
              Hex[nt] = (fq == 0) ? 0.f : (fq == 1) ? H0 : (fq == 2) ? h01 : h012;
              if (fq == 0) *(LAS f32x2*)(WSUM + (((ch & 1) * 8 + wave) * 32 + 16 * nt + fr) * 2) = (f32x2){A3 * a012, A3 * h012 + H3}; } }
        __syncthreads();
        { float ssr[4] = {0.f, 0.f, 0.f, 0.f};
#pragma unroll
          for (int nt = 0; nt < 2; ++nt) { const int chn = 16 * nt + fr; float x = hc[nt], mine = 0.f;
#pragma unroll
              for (int w2 = 0; w2 < 8; ++w2) { const f32x2 sm = *(const LAS f32x2*)(WSUM + (((ch & 1) * 8 + w2) * 32 + chn) * 2); if (w2 == wave) mine = x; x = sm[0] * x + sm[1]; }
              hc[nt] = x;
              const float hstart = Aex[nt] * mine + Hex[nt];
#pragma unroll
              for (int r = 0; r < 4; ++r) { const int tl = 4 * fq + r; const float h = Al[nt][r] * hstart + Hl[nt][r];
                  const float y = h * gelu_tanh(bf2f(GW[tl * 40 + chn])); const unsigned yb = cvt_pk_bf16(y, 0.f) & 0xffffu; YW[tl * 40 + chn] = (bf16_t)yb;
                  const float yr = __uint_as_float(yb << 16); ssr[r] += yr * yr; } }
#pragma unroll
          for (int r = 0; r < 4; ++r) { float q = ssr[r]; q += __shfl_xor(q, 1); q += __shfl_xor(q, 2); q += __shfl_xor(q, 4); q += __shfl_xor(q, 8);
              if (fr == 0) SSQL[((size_t)b * SEQ + t0 + 16 * wave + 4 * fq + r) * 16 + blk * 2 + half] = q; } }
        LDS_WAIT(); asm volatile("" ::: "memory");
        *(u32x4*)(YC + ((size_t)b * SEQ + t0 + 16 * wave + (lane >> 2)) * DM + oc0 + 8 * (lane & 3)) = *(const LAS u32x4*)(YW + (lane >> 2) * 40 + 8 * (lane & 3));
        if (chas) moe_item_finish(cv, a, cslot, cscr, lane);
      }
    }
#undef LRU_PREFETCH
    __syncthreads();
}

__device__ __forceinline__ void moba_unit_simple(const Args& a, const Ctx& C, int b, int h, int qb) {
    unsigned char* ws = a.ws;
    const bf16_t* Q = (const bf16_t*)(ws + WS_A) + (size_t)2 * NTOK * 512; const bf16_t* K = Q + (size_t)NTOK * 512; const bf16_t* V = K + (size_t)NTOK * 512;
    bf16_t* YA = (bf16_t*)(ws + WS_B) + (size_t)NTOK * 512; const float* KSUM = (const float*)(ws + WS_KSUM);
    const int q = C.tid & 255, hf = C.tid >> 8; const size_t row = (size_t)b * SEQ + qb * 256 + q;
    float qv[64];
    { const u32x4* qp = (const u32x4*)(Q + row * 512 + h * 64);
#pragma unroll
      for (int i = 0; i < 8; ++i) { const u32x4 w = qp[i]; qv[8 * i] = bflo(w.x); qv[8 * i + 1] = bfhi(w.x); qv[8 * i + 2] = bflo(w.y); qv[8 * i + 3] = bfhi(w.y); qv[8 * i + 4] = bflo(w.z); qv[8 * i + 5] = bfhi(w.z); qv[8 * i + 6] = bflo(w.w); qv[8 * i + 7] = bfhi(w.w); } }
    unsigned sel = 0u;
    { float g[8];
#pragma unroll
      for (int n = 0; n < 8; ++n) { g[n] = -INFINITY;
          if (n < qb) { const float* ks = KSUM + (size_t)(b * 8 + n) * 512 + h * 64; float s = 0.f;
#pragma unroll
              for (int d = 0; d < 64; ++d) s += qv[d] * ks[d];
              g[n] = s; } }
      const int npick = qb < 3 ? qb : 3;
      for (int p = 0; p < npick; ++p) { int best = -1; float bv = -INFINITY;
#pragma unroll
          for (int n = 0; n < 8; ++n) { const bool ok = (n < qb) && !((sel >> n) & 1u) && (best < 0 || g[n] > bv); if (ok) { best = n; bv = g[n]; } }
          if (best >= 0) sel |= 1u << best; } }
    float o[32], mrun = -1e30f, l = 0.f;
#pragma unroll
    for (int d = 0; d < 32; ++d) o[d] = 0.f;
    for (int n = 0; n <= qb; ++n) {
        const bool own = (n == qb); const bool use = own || ((sel >> n) & 1u);
        if (!__any(use)) continue;
        for (int j = 0; j < 256; ++j) {
            const bool valid = use && (!own || j <= q);
            if (!__any(valid)) continue;
            const size_t krow = (size_t)b * SEQ + n * 256 + j;
            const u32x4* kp = (const u32x4*)(K + krow * 512 + h * 64); float s = 0.f;
#pragma unroll
            for (int i = 0; i < 8; ++i) { const u32x4 w = kp[i];
                s += qv[8 * i] * bflo(w.x) + qv[8 * i + 1] * bfhi(w.x) + qv[8 * i + 2] * bflo(w.y) + qv[8 * i + 3] * bfhi(w.y) + qv[8 * i + 4] * bflo(w.z) + qv[8 * i + 5] * bfhi(w.z) + qv[8 * i + 6] * bflo(w.w) + qv[8 * i + 7] * bfhi(w.w); }
            if (valid) {
                const float mnew = fmaxf(mrun, s), f = __builtin_amdgcn_exp2f(mrun - mnew), p = __builtin_amdgcn_exp2f(s - mnew);
                l = l * f + p; mrun = mnew;
                const u32x4* vp = (const u32x4*)(V + krow * 512 + h * 64 + 32 * hf);
#pragma unroll
                for (int i = 0; i < 4; ++i) { const u32x4 w = vp[i];
                    o[8 * i] = o[8 * i] * f + p * bflo(w.x); o[8 * i + 1] = o[8 * i + 1] * f + p * bfhi(w.x); o[8 * i + 2] = o[8 * i + 2] * f + p * bflo(w.y); o[8 * i + 3] = o[8 * i + 3] * f + p * bfhi(w.y);
                    o[8 * i + 4] = o[8 * i + 4] * f + p * bflo(w.z); o[8 * i + 5] = o[8 * i + 5] * f + p * bfhi(w.z); o[8 * i + 6] = o[8 * i + 6] * f + p * bflo(w.w); o[8 * i + 7] = o[8 * i + 7] * f + p * bfhi(w.w); }
            }
        }
    }
    const float inv = 1.0f / l;
    u32x4* op = (u32x4*)(YA + row * 512 + h * 64 + 32 * hf);
#pragma unroll
    for (int i = 0; i < 4; ++i) { u32x4 w; w.x = cvt_pk_bf16(o[8 * i] * inv, o[8 * i + 1] * inv); w.y = cvt_pk_bf16(o[8 * i + 2] * inv, o[8 * i + 3] * inv); w.z = cvt_pk_bf16(o[8 * i + 4] * inv, o[8 * i + 5] * inv); w.w = cvt_pk_bf16(o[8 * i + 6] * inv, o[8 * i + 7] * inv); op[i] = w; }
}

__device__ __forceinline__ void ph_ymix(const Args& a, const Ctx& C) {
    const bf16_t* YL = (const bf16_t*)(a.ws + WS_B); const bf16_t* YA = YL + (size_t)NTOK * 512; bf16_t* YM = (bf16_t*)(a.ws + WS_C);
    const int gw = C.vcu * 8 + C.wave, NGW = C.G * 8, lane = C.lane;
    for (int m = gw; m < NTOK; m += NGW) {
#pragma unroll
        for (int part = 0; part < 2; ++part) {
            const u32x4 w = *((const u32x4*)((part ? YA : YL) + (size_t)m * 512) + lane);
            float v[8] = {bflo(w.x), bfhi(w.x), bflo(w.y), bfhi(w.y), bflo(w.z), bfhi(w.z), bflo(w.w), bfhi(w.w)}; float s = 0.f;
#pragma unroll
            for (int i = 0; i < 8; ++i) s += v[i] * v[i];
            const float rstd = 1.0f / sqrtf(wave_sum(s) * (1.0f / 512.0f) + EPS);
            u32x4 o; o.x = cvt_pk_bf16(v[0] * rstd, v[1] * rstd); o.y = cvt_pk_bf16(v[2] * rstd, v[3] * rstd); o.z = cvt_pk_bf16(v[4] * rstd, v[5] * rstd); o.w = cvt_pk_bf16(v[6] * rstd, v[7] * rstd);
            *((u32x4*)(YM + (size_t)m * DM + part * 512) + lane) = o;
        }
    }
}

__device__ __forceinline__ void ph_router(const Args& a, const Ctx& C) {
    unsigned char* ws = a.ws;
    const bf16_t* H2B = (const bf16_t*)a.out + DM; const bf16_t* WR = (const bf16_t*)(ws + WS_WR); const float* SSQ2 = (const float*)(ws + WS_SSQ2);
    unsigned* CNT = (unsigned*)(ws + WS_CTL) + CW_CNT;
    int* TOKE = (int*)(ws + WS_TOK + TOK_E); int* TOKR = (int*)(ws + WS_TOK + TOK_R); float* TOKG = (float*)(ws + WS_TOK + TOK_G); int* LTOK = (int*)(ws + WS_LTOK); float* LRS = (float*)(ws + WS_LRS);
    constexpr int WRS = 1032;
    LAS bf16_t* WRL = (LAS bf16_t*)C.lds;
    LAS float* LG = (LAS float*)(C.lds + 99072) + C.wave * (16 * 49);
    LAS unsigned* lcnt = (LAS unsigned*)(C.lds + 99072 + 25088); LAS unsigned* lbase = lcnt + 32;
    const int lane = C.lane, fr = lane & 15, fq = lane >> 4;
    for (int i = C.tid; i < 48 * 128; i += 512) { const int r = i >> 7, c8 = i & 127; *(LAS u32x4*)(WRL + r * WRS + 8 * c8) = *(const u32x4*)(WR + (size_t)r * DM + 8 * c8); }
    for (int pass = 0; (pass * C.G) * 128 < NTOK; ++pass) {
        const int blk = pass * C.G + C.vcu; const bool live = blk * 128 < NTOK;
        if (C.tid < 32) lcnt[C.tid] = 0u;
        __syncthreads();
        int E1 = 0, E2 = 0; unsigned r1 = 0, r2 = 0; float ga = 0.f, gb = 0.f, rstd_t = 0.f; const int tb = blk * 128 + 16 * C.wave;
        if (live) {
            f32x4 acc[3] = {{0.f, 0.f, 0.f, 0.f}, {0.f, 0.f, 0.f, 0.f}, {0.f, 0.f, 0.f, 0.f}};
            bf16x8 af[32];
#pragma unroll
            for (int ks = 0; ks < 32; ++ks) af[ks] = *(const bf16x8*)(H2B + (size_t)(tb + fr) * LDH + 32 * ks + 8 * fq);
#pragma unroll
            for (int ks = 0; ks < 32; ++ks) {
#pragma unroll
                for (int nt = 0; nt < 3; ++nt) { const bf16x8 bfg = *(const LAS bf16x8*)(WRL + (16 * nt + fr) * WRS + 32 * ks + 8 * fq); acc[nt] = __builtin_amdgcn_mfma_f32_16x16x32_bf16(af[ks], bfg, acc[nt], 0, 0, 0); } }
#pragma unroll
            for (int nt = 0; nt < 3; ++nt)
#pragma unroll
                for (int r = 0; r < 4; ++r) LG[(4 * fq + r) * 49 + 16 * nt + fr] = acc[nt][r];
            LDS_WAIT(); asm volatile("" ::: "memory");
            if (lane < 16) { const int t = tb + lane; const float rstd = rstd_from_ssq(SSQ2, t); rstd_t = rstd; const LAS float* lg = LG + lane * 49;
                float g[4]; int grp = 0;
#pragma unroll
                for (int i = 0; i < 4; ++i) g[i] = lg[i] * rstd + a.in[21][i];
#pragma unroll
                for (int i = 1; i < 4; ++i) if (g[i] > g[grp]) grp = i;
                float gs = 0.f;
#pragma unroll
                for (int i = 0; i < 4; ++i) gs += __expf(g[i] - g[grp]);
                const float gw_ = 1.0f / gs;
                float e[8];
#pragma unroll
                for (int i = 0; i < 8; ++i) e[i] = lg[4 + 8 * grp + i] * rstd + a.in[23][8 * grp + i];
                int i1 = 0;
#pragma unroll
                for (int i = 1; i < 8; ++i) if (e[i] > e[i1]) i1 = i;
                int i2 = (i1 == 0) ? 1 : 0;
#pragma unroll
                for (int i = 0; i < 8; ++i) if (i != i1 && i != i2 && e[i] > e[i2]) i2 = i;
                const float eb = __expf(e[i2] - e[i1]); ga = gw_ / (1.0f + eb); gb = gw_ * eb / (1.0f + eb);
                E1 = grp * 8 + i1; E2 = grp * 8 + i2;
                r1 = atomicAdd((unsigned*)&lcnt[E1], 1u); r2 = atomicAdd((unsigned*)&lcnt[E2], 1u);
            }
        }
        __syncthreads();
        if (C.tid < 32) lbase[C.tid] = lcnt[C.tid] ? __hip_atomic_fetch_add(CNT + C.tid, lcnt[C.tid], __ATOMIC_RELAXED, __HIP_MEMORY_SCOPE_AGENT) : 0u;
        __syncthreads();
        if (live && lane < 16) { const int t = tb + lane;
            const int k1 = (int)(lbase[E1] + r1), k2 = (int)(lbase[E2] + r2);
            TOKE[2 * t] = E1; TOKR[2 * t] = k1; TOKG[2 * t] = ga; LTOK[E1 * LCAP + k1] = t; LRS[E1 * LCAP + k1] = rstd_t;
            TOKE[2 * t + 1] = E2; TOKR[2 * t + 1] = k2; TOKG[2 * t + 1] = gb; LTOK[E2 * LCAP + k2] = t; LRS[E2 * LCAP + k2] = rstd_t; }
        __syncthreads();
    }
}
__device__ __forceinline__ void moe_table(const Args& a, const Ctx& C) {
    LAS int* ts = (LAS int*)(C.lds + MOE_OFF);
    if (C.tid == 0) { const unsigned* CNT = (const unsigned*)(a.ws + WS_CTL) + CW_CNT; int acc = 0;
        for (int e = 0; e < NEXP; ++e) { ts[e] = acc; const unsigned c = __hip_atomic_load(CNT + e, __ATOMIC_RELAXED, __HIP_MEMORY_SCOPE_AGENT); ts[33 + e] = (int)c; acc += (int)((c + 255u) >> 8); }
        ts[NEXP] = acc; }
    __syncthreads();
}
__device__ __forceinline__ void ph_final(const Args& a, const Ctx& C, float* outp) {
    unsigned char* ws = a.ws;
    const unsigned char* YB = ws + WS_A; const float* TOKG = (const float*)(ws + WS_TOK + TOK_G); const int* TOKE = (const int*)(ws + WS_TOK + TOK_E); const int* TOKR = (const int*)(ws + WS_TOK + TOK_R);
    const LAS int* ts = (const LAS int*)(C.lds + MOE_OFF);
    const bf16_t* H2B = (const bf16_t*)a.out + DM; const float* gf = a.in[26];
    const int gw = C.vcu * 8 + C.wave, NGW = C.G * 8, lane = C.lane;
    f32x4 gn[4];
#pragma unroll
    for (int q = 0; q < 4; ++q) gn[q] = *(const f32x4*)(gf + 512 * (q >> 1) + 8 * lane + 4 * (q & 1));
    const int nit = (NTOK + NGW - 1) / NGW;
    int dnx = 0; float gnx = 0.f;
#define FIN_IDX(ib) do { const int tt_ = gw + ((ib) + (lane >> 1)) * NGW; dnx = 0; gnx = 0.f; \
        if (lane < 8 && tt_ < NTOK) { const int e_ = TOKE[2 * tt_ + (lane & 1)]; dnx = ts[e_] * 256 + TOKR[2 * tt_ + (lane & 1)]; gnx = TOKG[2 * tt_ + (lane & 1)]; } } while (0)
    FIN_IDX(0);
    for (int ib = 0; ib < nit; ib += 4) {
        const int dcur = dnx; const float gcur = gnx;
        if (ib + 4 < nit) FIN_IDX(ib + 4);
        u32x4 hw[4][2]; u32x2 y0[4][2], y1[4][2];
#pragma unroll
        for (int j = 0; j < 4; ++j) { const int t = gw + (ib + j) * NGW; const int d0 = __builtin_amdgcn_readlane(dcur, 2 * j), d1 = __builtin_amdgcn_readlane(dcur, 2 * j + 1);
            if (t < NTOK) {
#pragma unroll
                for (int hf = 0; hf < 2; ++hf) { hw[j][hf] = *((const u32x4*)(H2B + (size_t)t * LDH + 512 * hf) + lane); y0[j][hf] = *((const u32x2*)(YB + (size_t)d0 * DM + 512 * hf) + lane); y1[j][hf] = *((const u32x2*)(YB + (size_t)d1 * DM + 512 * hf) + lane); } } }
#pragma unroll
        for (int j = 0; j < 4; ++j) { const int t = gw + (ib + j) * NGW;
            const float g0 = __builtin_bit_cast(float, __builtin_amdgcn_readlane(__builtin_bit_cast(int, gcur), 2 * j)) * (1.0f / YB_SC), g1 = __builtin_bit_cast(float, __builtin_amdgcn_readlane(__builtin_bit_cast(int, gcur), 2 * j + 1)) * (1.0f / YB_SC);
            if (t < NTOK) { float v[16]; float s2 = 0.f;
#pragma unroll
                for (int hf = 0; hf < 2; ++hf)
#pragma unroll
                    for (int w = 0; w < 2; ++w) { const int yw0 = (int)y0[j][hf][w], yw1 = (int)y1[j][hf][w];
                        const f32x2 pa = __builtin_amdgcn_cvt_pk_f32_fp8(yw0, false), pb = __builtin_amdgcn_cvt_pk_f32_fp8(yw0, true), qa = __builtin_amdgcn_cvt_pk_f32_fp8(yw1, false), qb = __builtin_amdgcn_cvt_pk_f32_fp8(yw1, true);
                        const unsigned ha = hw[j][hf][2 * w], hb = hw[j][hf][2 * w + 1];
                        const float e0 = bflo(ha) + g0 * pa[0] + g1 * qa[0], e1 = bfhi(ha) + g0 * pa[1] + g1 * qa[1], e2 = bflo(hb) + g0 * pb[0] + g1 * qb[0], e3 = bfhi(hb) + g0 * pb[1] + g1 * qb[1];
                        v[8 * hf + 4 * w] = e0; v[8 * hf + 4 * w + 1] = e1; v[8 * hf + 4 * w + 2] = e2; v[8 * hf + 4 * w + 3] = e3; s2 += (e0 * e0 + e1 * e1) + (e2 * e2 + e3 * e3); }
                const float rstd = __builtin_amdgcn_rsqf(wave_sum(s2) * (1.0f / DM) + EPS);
#pragma unroll
                for (int q = 0; q < 4; ++q) { const f32x4 o = {v[4 * q] * rstd * gn[q][0], v[4 * q + 1] * rstd * gn[q][1], v[4 * q + 2] * rstd * gn[q][2], v[4 * q + 3] * rstd * gn[q][3]};
                    *(f32x4*)(outp + (size_t)t * DM + 512 * (q >> 1) + 8 * lane + 4 * (q & 1)) = o; } } }
    }
#undef FIN_IDX
}

#include <hip/hip_bf16.h>
#include <cmath>
namespace attn_body {
using bf16=__hip_bfloat16;
using bf16x8=__attribute__((ext_vector_type(8)))short;
using s16x4=__attribute__((ext_vector_type(4)))short;
using f32x16=__attribute__((ext_vector_type(16)))float;
using u32x4=__attribute__((ext_vector_type(4)))unsigned;
using f32x4_t=__attribute__((ext_vector_type(4)))float;
constexpr int BATCH=16,NHEAD=8,SEQ=2048,D=64,DM=NHEAD*D,DMO=1024;
constexpr int NW=8,QBLK=32,QB=QBLK*NW,KVBLK=64,NQB=SEQ/QB;
constexpr int ATTN_PITCH=DM, ATTN_UNIT_ROWS=QB;
__device__ __forceinline__ int crow(int r,int hi){return (r&3)+8*(r>>2)+4*hi;}
#define SBAR() __builtin_amdgcn_sched_barrier(0)
__device__ __forceinline__ void cmask(f32x16&p0,f32x16&p1,int jb,int qrel,int hi){
  const float NEG=-INFINITY; int kb=64*jb+4*hi; asm volatile("":"+v"(kb));
  #pragma unroll
  for(int r=0;r<16;++r){int kv=kb+(r&3)+8*(r>>2); if(kv>qrel)p0[r]=NEG; if(kv+32>qrel)p1[r]=NEG;}
}

constexpr int NSLOT=3, SLOTB=8192;
constexpr int LDS_K=0, LDS_V=NSLOT*SLOTB, LDS_WS=2*NSLOT*SLOTB, LDS_OST=LDS_WS+NW*64*4, LDS_BYTES=LDS_OST+NW*4096;
constexpr float C2=0.125f*1.4426950408889634f;
__device__ __forceinline__ void glds16(const char*sbase,unsigned voff,unsigned lds_dst){unsigned keep;
  asm volatile("s_nop 4\n\ts_mov_b32 %0, m0\n\ts_mov_b32 m0, %3\n\ts_nop 0\n\tglobal_load_lds_dwordx4 %1, %2\n\ts_mov_b32 m0, %0":"=&s"(keep):"v"(voff),"s"(sbase),"s"(lds_dst):"memory");}
__device__ __forceinline__ const char* uni_ptr(const void*p){const unsigned long long v=(unsigned long long)p;const unsigned lo=__builtin_amdgcn_readfirstlane((unsigned)v),hi=__builtin_amdgcn_readfirstlane((unsigned)(v>>32));return (const char*)(((unsigned long long)hi<<32)|lo);}
__device__ __forceinline__ float max3f(float a,float b,float c){float r;asm("v_max3_f32 %0, %1, %2, %3":"=v"(r):"v"(a),"v"(b),"v"(c));return r;}
__device__ __forceinline__ float max2f(float a,float b){float r;asm("v_max_f32_e32 %0, %1, %2":"=v"(r):"v"(a),"v"(b));return r;}
__device__ __forceinline__ float fadd_s(float a,float b){float r;asm("v_add_f32_e32 %0, %1, %2":"=v"(r):"v"(a),"v"(b));return r;}
__device__ __forceinline__ float fsub_s(float a,float b){float r;asm("v_sub_f32_e32 %0, %1, %2":"=v"(r):"v"(a),"v"(b));return r;}
typedef float f32x2_t __attribute__((ext_vector_type(2))); typedef __bf16 bf16x2_t __attribute__((ext_vector_type(2)));
__device__ __forceinline__ unsigned cvtpk_s(float lo,float hi){f32x2_t v={lo,hi};bf16x2_t b=__builtin_convertvector(v,bf16x2_t);return __builtin_bit_cast(unsigned,b);}
#define WAIT_BAR(N) asm volatile("s_waitcnt vmcnt(" #N ") lgkmcnt(0)\n\ts_barrier":::"memory")

__device__ __forceinline__ void qkt(f32x16&p0,f32x16&p1,const char*Kslot,const bf16x8*qr,const f32x16&negm,int r32,int hi){
  const char*kb=Kslot+hi*1024+r32*16;
  #pragma unroll
  for(int d0=0;d0<4;++d0){
    const bf16x8 b0=*reinterpret_cast<const bf16x8*>(kb+d0*2048);
    const bf16x8 b1=*reinterpret_cast<const bf16x8*>(kb+d0*2048+512);
    if(d0==0){p0=__builtin_amdgcn_mfma_f32_32x32x16_bf16(b0,qr[0],negm,0,0,0);p1=__builtin_amdgcn_mfma_f32_32x32x16_bf16(b1,qr[0],negm,0,0,0);}
    else{p0=__builtin_amdgcn_mfma_f32_32x32x16_bf16(b0,qr[d0],p0,0,0,0);p1=__builtin_amdgcn_mfma_f32_32x32x16_bf16(b1,qr[d0],p1,0,0,0);}}
}
typedef __attribute__((address_space(3))) const char* lds_cptr;
typedef short v4i16_t __attribute__((ext_vector_type(4)));
__device__ __forceinline__ void kload8(bf16x8*kf,lds_cptr kp){
  kf[0]=*(const __attribute__((address_space(3))) bf16x8*)(kp);      kf[1]=*(const __attribute__((address_space(3))) bf16x8*)(kp+512);
  kf[2]=*(const __attribute__((address_space(3))) bf16x8*)(kp+2048); kf[3]=*(const __attribute__((address_space(3))) bf16x8*)(kp+2560);
  kf[4]=*(const __attribute__((address_space(3))) bf16x8*)(kp+4096); kf[5]=*(const __attribute__((address_space(3))) bf16x8*)(kp+4608);
  kf[6]=*(const __attribute__((address_space(3))) bf16x8*)(kp+6144); kf[7]=*(const __attribute__((address_space(3))) bf16x8*)(kp+6656);
}
__device__ __forceinline__ void kload2(bf16x8*kf,lds_cptr kp,int j){ kf[2*j]=*(const __attribute__((address_space(3))) bf16x8*)(kp+j*2048); kf[2*j+1]=*(const __attribute__((address_space(3))) bf16x8*)(kp+j*2048+512); }
__device__ __forceinline__ s16x4 vtr(lds_cptr p){ return __builtin_bit_cast(s16x4,__builtin_amdgcn_ds_read_tr16_b64_v4i16((__attribute__((address_space(3))) v4i16_t*)p)); }
__device__ __forceinline__ float rowmax(const f32x16&p0,const f32x16&p1){
  float a=max3f(p0[0],p0[1],p1[0]),b=max3f(p0[2],p0[3],p1[1]);a=max3f(a,p1[2],p1[3]);
  #pragma unroll
  for(int r=4;r<16;r+=4){a=max3f(a,p0[r],p0[r+1]);b=max3f(b,p0[r+2],p0[r+3]);a=max3f(a,p1[r],p1[r+1]);b=max3f(b,p1[r+2],p1[r+3]);}
  const float m=max2f(a,b);
  auto rr=__builtin_amdgcn_permlane32_swap(__float_as_uint(m),__float_as_uint(m),false,false);
  return max2f(__uint_as_float(rr[0]),__uint_as_float(rr[1]));
}
__device__ __forceinline__ void pv(f32x16*o,int vb,bf16x8 pa0,bf16x8 pa1,bf16x8 pa2,bf16x8 pa3){
  #pragma unroll
  for(int d0=0;d0<2;++d0){s16x4 lo[4],hi[4];
    #pragma unroll
    for(int ks=0;ks<4;++ks){
      asm volatile("ds_read_b64_tr_b16 %0,%1 offset:%c2":"=&v"(lo[ks]):"v"(vb),"i"(d0*4096+ks*1024):"memory");
      asm volatile("ds_read_b64_tr_b16 %0,%1 offset:%c2":"=&v"(hi[ks]):"v"(vb),"i"(d0*4096+ks*1024+512):"memory");}
    asm volatile("s_waitcnt lgkmcnt(0)":::"memory");SBAR();
    #define PK(k) (bf16x8){lo[k][0],lo[k][1],lo[k][2],lo[k][3],hi[k][0],hi[k][1],hi[k][2],hi[k][3]}
    o[d0]=__builtin_amdgcn_mfma_f32_32x32x16_bf16(pa0,PK(0),o[d0],0,0,0);
    o[d0]=__builtin_amdgcn_mfma_f32_32x32x16_bf16(pa1,PK(1),o[d0],0,0,0);
    o[d0]=__builtin_amdgcn_mfma_f32_32x32x16_bf16(pa2,PK(2),o[d0],0,0,0);
    o[d0]=__builtin_amdgcn_mfma_f32_32x32x16_bf16(pa3,PK(3),o[d0],0,0,0);
    #undef PK
  }
}

#ifndef ATTN_STORE16
#define ATTN_STORE16(p,v) (*(u32x4*)(p)=(v))
#endif
template<int THRL> __device__ __forceinline__ void attn_unit(int b,int h,int qb,const bf16*Q,const bf16*__restrict__ K,const bf16*__restrict__ V,bf16*O,const float*__restrict__ KSUM,float*__restrict__ SSQA,char*shm){
  int tid=threadIdx.x; asm volatile("":"+v"(tid));
  const int lane=tid&63,r32=lane&31,hi=lane>>5; const int wid=__builtin_amdgcn_readfirstlane(tid>>6);
  const long rowbase=(long)b*SEQ; const int q0=qb*QB;
  const bf16*Qw=Q+(rowbase+q0+wid*QBLK)*DM+h*D;
  const bf16*Kh=K+rowbase*DM+h*D,*Vh=V+rowbase*DM+h*D;
  const unsigned lds0=(unsigned)(uintptr_t)shm;
  float*wsf=(float*)(shm+LDS_WS)+wid*64;
  const char*Khu=uni_ptr(Kh);const char*Vhu=uni_ptr(Vh);
  const unsigned kvo=(unsigned)(lane*DM+wid*8)*2u;
  const unsigned vvo=(unsigned)((16*(wid&3)+(lane>>2))*DM+(wid>>2)*32+(lane&3)*8)*2u;
  const unsigned kdst=lds0+LDS_K+wid*1024, vdst=lds0+LDS_V+wid*1024;
  #define DMA_K(t,slot) glds16(Khu+(size_t)(t)*(KVBLK*DM*2),kvo,(unsigned)__builtin_amdgcn_readfirstlane(kdst+(slot)))
  #define DMA_V(t,slot) glds16(Vhu+(size_t)(t)*(KVBLK*DM*2),vvo,(unsigned)__builtin_amdgcn_readfirstlane(vdst+(slot)))
  const int vb0=(int)(lds0+LDS_V)+((lane>>4)&1)*32+(lane&3)*8+(4*hi+((lane&15)>>2))*64;
  const char*Kbase=shm+LDS_K; bf16x8 kf[8];
  const lds_cptr shm3=(lds_cptr)shm; const lds_cptr kp0=shm3+LDS_K+hi*1024+r32*16; const lds_cptr vp0=shm3+LDS_V+((lane>>4)&1)*32+(lane&3)*8+(4*hi+((lane&15)>>2))*64;
  const int NT=(q0+QB)/KVBLK;
  DMA_K(0,0);DMA_V(0,0);DMA_K(1,SLOTB);
  bf16x8 qr[4];
  #pragma unroll
  for(int d0=0;d0<4;++d0)qr[d0]=*reinterpret_cast<const bf16x8*>(&Qw[(long)r32*DM+d0*16+hi*8]);
  unsigned selm=1u<<qb;
  { float g[8];
    #pragma unroll
    for(int n=0;n<8;++n){ g[n]=-INFINITY;
      if(n<qb){ const float*ks=KSUM+(long)(b*8+n)*DM+h*D+hi*8; float s=0.f;
        #pragma unroll
        for(int d0=0;d0<4;++d0){ const f32x4_t k0=*reinterpret_cast<const f32x4_t*>(ks+d0*16), k1=*reinterpret_cast<const f32x4_t*>(ks+d0*16+4);
          const u32x4 qw=__builtin_bit_cast(u32x4,qr[d0]);
          s+=__uint_as_float(qw[0]<<16)*k0[0]+__uint_as_float(qw[0]&0xffff0000u)*k0[1]+__uint_as_float(qw[1]<<16)*k0[2]+__uint_as_float(qw[1]&0xffff0000u)*k0[3]
            +__uint_as_float(qw[2]<<16)*k1[0]+__uint_as_float(qw[2]&0xffff0000u)*k1[1]+__uint_as_float(qw[3]<<16)*k1[2]+__uint_as_float(qw[3]&0xffff0000u)*k1[3]; }
        s+=__shfl_xor(s,32); g[n]=s; } }
    const int npick=qb<3?qb:3;
    for(int p=0;p<npick;++p){ int best=-1; float bv=-INFINITY;
      #pragma unroll
      for(int n=0;n<8;++n){ const bool ok=(n<qb)&&!((selm>>n)&1u)&&(best<0||g[n]>bv); if(ok){best=n;bv=g[n];} }
      if(best>=0)selm|=1u<<best; } }
  #define BMASK(P0,P1,t) do{ float bias_=((selm>>((t)>>2))&1u)?-mhat:-INFINITY; asm volatile("":"+v"(bias_)); _Pragma("unroll") for(int r=0;r<16;++r){P0[r]+=bias_;P1[r]+=bias_;} }while(0)
  float mhat=0.f,l_reg=0.f;f32x16 o[2];{float z0_=0.f;asm volatile("":"+v"(z0_));_Pragma("unroll") for(int r=0;r<16;++r){o[0][r]=z0_;o[1][r]=z0_;}}const f32x16 negm=f32x16{};
  const int qrel=wid*QBLK+r32;
  #define CMASK(P0,P1,t) do{int jb_=(t)-(NT-4); if(jb_>=0)cmask(P0,P1,jb_,qrel,hi);}while(0)
  bool resc=false;
  #define START(P0,P1) do{ const float rm=__builtin_fmaxf(rowmax(P0,P1),-100.0f); resc=false; \
    { const float dl=rm; mhat=fadd_s(mhat,dl); \
      _Pragma("unroll") for(int r=0;r<16;++r){P0[r]=fsub_s(P0[r],dl);P1[r]=fsub_s(P1[r],dl);} \
      } \
    _Pragma("unroll") for(int r=0;r<16;++r)P0[r]=__builtin_amdgcn_exp2f(P0[r]); }while(0)
  #define RESC() do{ if(resc){ asm volatile("s_waitcnt lgkmcnt(0)":::"memory"); \
      _Pragma("unroll") for(int d_=0;d_<2;++d_) _Pragma("unroll") for(int r=0;r<16;++r)o[d_][r]*=wsf[crow(r,hi)]; } }while(0)
  f32x16 pA0,pA1,pB0,pB1;
  int sl_prev=0,sl_cur=0,sl_next=SLOTB;
  #define ROT() do{sl_prev=sl_cur;sl_cur=sl_next;sl_next=(sl_next==(NSLOT-1)*SLOTB)?0:sl_next+SLOTB;}while(0)
  DMA_K(2,2*SLOTB);
  WAIT_BAR(3);
  qkt(pA0,pA1,Kbase,qr,negm,r32,hi);asm volatile("s_nop 15\n\ts_nop 7":"+v"(pA0),"+v"(pA1));CMASK(pA0,pA1,0);BMASK(pA0,pA1,0);
  START(pA0,pA1);
  _Pragma("unroll") for(int r=0;r<16;++r)pA1[r]=__builtin_amdgcn_exp2f(pA1[r]);
  WAIT_BAR(0);
  DMA_K(3,0);DMA_V(1,SLOTB);
  ROT();
  kload8(kf,kp0+sl_cur);
  WAIT_BAR(2);
  s16x4 vlo[8],vhi[8]; u32x4 pw0,pw1,pw2,pw3;
  #define PKW(P,B) cvtpk_s(P[B],P[B+1])
  #define PAF(k) __builtin_bit_cast(bf16x8,pw##k)
  #define VFR(i) (bf16x8){vlo[i][0],vlo[i][1],vlo[i][2],vlo[i][3],vhi[i][0],vhi[i][1],vhi[i][2],vhi[i][3]}
  #define PIN(x) asm volatile("":"+v"(x))
  #define MX3(a,b,c) __builtin_fmaxf(__builtin_fmaxf((a),(b)),(c))
  #define GAPA(MF,A0,A1,A2,A3,W0,W1,PW) do{ MF; sacc+=A0; sacc+=A1; sacc+=A2; sacc+=A3; PIN(sacc); W0; W1; PIN(PW); SBAR(); }while(0)
  #define EX(v) __builtin_amdgcn_exp2f(v)
  #define GAPB(MF,X,B) do{ MF; X[B]=EX(X[B]); X[B+1]=EX(X[B+1]); X[B+2]=EX(X[B+2]); X[B+3]=EX(X[B+3]); PIN(X); SBAR(); }while(0)
  #define VRD(i) do{ vlo[i]=vtr(vp_+(((i)>>2)*4096+((i)&3)*1024)); vhi[i]=vtr(vp_+(((i)>>2)*4096+((i)&3)*1024+512)); }while(0)
  #define KRD(G,j) do{ if(G){ kload2(kf,kp0+sl_next,j); SBAR(); } }while(0)
  #define STEP(C0,C1,P0,P1,t,GK,GV,GL) do{ SBAR(); \
    const lds_cptr vp_=vp0+sl_prev; \
    VRD(0); SBAR(); float sacc=(P0[0]+P0[1]); \
    GAPA(C0=__builtin_amdgcn_mfma_f32_32x32x16_bf16(kf[0],qr[0],negm,0,0,0), P0[2],P0[3],P0[4],P0[5],     pw0[0]=PKW(P0,0), pw0[1]=PKW(P0,2), pw0); \
    VRD(4); SBAR(); GAPA(C1=__builtin_amdgcn_mfma_f32_32x32x16_bf16(kf[1],qr[0],negm,0,0,0), P0[6],P0[7],P0[8],P0[9],     pw0[2]=PKW(P0,4), pw0[3]=PKW(P0,6), pw0); \
    VRD(1); SBAR(); GAPA(C0=__builtin_amdgcn_mfma_f32_32x32x16_bf16(kf[2],qr[1],C0,0,0,0),   P0[10],P0[11],P0[12],P0[13], pw1[0]=PKW(P0,8), pw1[1]=PKW(P0,10), pw1); \
    VRD(5); SBAR(); GAPA(C1=__builtin_amdgcn_mfma_f32_32x32x16_bf16(kf[3],qr[1],C1,0,0,0),   P0[14],P0[15],P1[0],P1[1],   pw1[2]=PKW(P0,12),pw1[3]=PKW(P0,14), pw1); \
    VRD(2); SBAR(); GAPA(C0=__builtin_amdgcn_mfma_f32_32x32x16_bf16(kf[4],qr[2],C0,0,0,0),   P1[2],P1[3],P1[4],P1[5],     pw2[0]=PKW(P1,0), pw2[1]=PKW(P1,2), pw2); \
    VRD(6); SBAR(); GAPA(C1=__builtin_amdgcn_mfma_f32_32x32x16_bf16(kf[5],qr[2],C1,0,0,0),   P1[6],P1[7],P1[8],P1[9],     pw2[2]=PKW(P1,4), pw2[3]=PKW(P1,6), pw2); \
    VRD(3); SBAR(); GAPA(C0=__builtin_amdgcn_mfma_f32_32x32x16_bf16(kf[6],qr[3],C0,0,0,0),   P1[10],P1[11],P1[12],P1[13], pw3[0]=PKW(P1,8), pw3[1]=PKW(P1,10), pw3); \
    VRD(7); SBAR(); GAPA(C1=__builtin_amdgcn_mfma_f32_32x32x16_bf16(kf[7],qr[3],C1,0,0,0),   P1[14],P1[15],0.f,0.f,       pw3[2]=PKW(P1,12),pw3[3]=PKW(P1,14), pw3); \
    l_reg+=sacc; \
    if(GK){DMA_K((t)+3,sl_cur);} if(GV){DMA_V((t)+1,sl_next);} \
    CMASK(C0,C1,t); BMASK(C0,C1,t); \
    { float a=MX3(C0[0],C0[1],C1[0]),b=MX3(C0[2],C0[3],C1[1]); a=MX3(a,C1[2],C1[3]); \
      _Pragma("unroll") for(int r=4;r<16;r+=4){a=MX3(a,C0[r],C0[r+1]);b=MX3(b,C0[r+2],C0[r+3]);a=MX3(a,C1[r],C1[r+1]);b=MX3(b,C1[r+2],C1[r+3]);} \
      float rm=__builtin_fmaxf(a,b); { auto rr=__builtin_amdgcn_permlane32_swap(__float_as_uint(rm),__float_as_uint(rm),false,false); rm=__builtin_fmaxf(__uint_as_float(rr[0]),__uint_as_float(rr[1])); } \
      resc=false; \
      if(__builtin_expect(__any(rm>(float)THRL),0)){ const float dl=__builtin_fmaxf(rm,0.f); mhat+=dl; \
        _Pragma("unroll") for(int r=0;r<16;++r){C0[r]-=dl;C1[r]-=dl;} \
        const float f=__builtin_amdgcn_exp2f(-dl); l_reg*=f; if(hi==0)wsf[r32]=f; resc=true; } } \
    SBAR(); \
    GAPB(o[0]=__builtin_amdgcn_mfma_f32_32x32x16_bf16(PAF(0),VFR(0),o[0],0,0,0), C0,0); \
    GAPB(o[1]=__builtin_amdgcn_mfma_f32_32x32x16_bf16(PAF(0),VFR(4),o[1],0,0,0), C0,4); \
    KRD(GL,0); GAPB(o[0]=__builtin_amdgcn_mfma_f32_32x32x16_bf16(PAF(1),VFR(1),o[0],0,0,0), C0,8); \
    KRD(GL,1); GAPB(o[1]=__builtin_amdgcn_mfma_f32_32x32x16_bf16(PAF(1),VFR(5),o[1],0,0,0), C0,12); \
    KRD(GL,2); GAPB(o[0]=__builtin_amdgcn_mfma_f32_32x32x16_bf16(PAF(2),VFR(2),o[0],0,0,0), C1,0); \
    KRD(GL,3); GAPB(o[1]=__builtin_amdgcn_mfma_f32_32x32x16_bf16(PAF(2),VFR(6),o[1],0,0,0), C1,4); \
    GAPB(o[0]=__builtin_amdgcn_mfma_f32_32x32x16_bf16(PAF(3),VFR(3),o[0],0,0,0), C1,8); \
    GAPB(o[1]=__builtin_amdgcn_mfma_f32_32x32x16_bf16(PAF(3),VFR(7),o[1],0,0,0), C1,12); \
    }while(0)
  int t=1;
  #undef CMASK
  #define CMASK(P0,P1,t) do{}while(0)
  for(;t+5<NT;t+=2){
    STEP(pB0,pB1,pA0,pA1,t,true,true,true);     WAIT_BAR(2); RESC(); ROT();
    STEP(pA0,pA1,pB0,pB1,t+1,true,true,true);   WAIT_BAR(2); RESC(); ROT();
  }
  #undef CMASK
  #define CMASK(P0,P1,t) do{int jb_=(t)-(NT-4); if(jb_>=0)cmask(P0,P1,jb_,qrel,hi);}while(0)
  #define ENDW(tt) do{ if((tt)+3<NT){WAIT_BAR(2);} else if((tt)+2<NT){WAIT_BAR(1);} else {WAIT_BAR(0);} }while(0)
  for(;t+1<NT;t+=2){
    STEP(pB0,pB1,pA0,pA1,t,(t+3<NT),(t+1<NT),(t+1<NT));       ENDW(t);   RESC(); ROT();
    STEP(pA0,pA1,pB0,pB1,t+1,(t+4<NT),(t+2<NT),(t+2<NT));     ENDW(t+1); RESC(); ROT();
  }
  STEP(pB0,pB1,pA0,pA1,NT-1,false,false,false); RESC();
  { float sacc=pB0[0]+pB0[1]; _Pragma("unroll") for(int r=2;r<16;++r)sacc+=pB0[r]; _Pragma("unroll") for(int r=0;r<16;++r)sacc+=pB1[r]; l_reg+=sacc;
    pw0=(u32x4){PKW(pB0,0),PKW(pB0,2),PKW(pB0,4),PKW(pB0,6)};pw1=(u32x4){PKW(pB0,8),PKW(pB0,10),PKW(pB0,12),PKW(pB0,14)};pw2=(u32x4){PKW(pB1,0),PKW(pB1,2),PKW(pB1,4),PKW(pB1,6)};pw3=(u32x4){PKW(pB1,8),PKW(pB1,10),PKW(pB1,12),PKW(pB1,14)};
    SBAR(); pv(o,vb0+sl_cur,PAF(0),PAF(1),PAF(2),PAF(3)); }
  #undef PKW
  #undef PAF
  #undef VFR
  #undef PIN
  #undef MX3
  #undef GAPA
  #undef GAPB
  #undef EX
  #undef VRD
  #undef KRD
  #undef STEP
  #undef ENDW
  {auto rr=__builtin_amdgcn_permlane32_swap(__float_as_uint(l_reg),__float_as_uint(l_reg),false,false);l_reg=__uint_as_float(rr[0])+__uint_as_float(rr[1]);}
  if(hi==0)wsf[32+r32]=l_reg;asm volatile("s_waitcnt lgkmcnt(0)":::"memory");
  float rli[16];
  #pragma unroll
  for(int r=0;r<16;++r)rli[r]=__builtin_amdgcn_rcpf(wsf[32+crow(r,hi)]);
  bf16*Ow=O+(rowbase+q0+wid*QBLK)*DMO+h*D;
  { bf16*stg=(bf16*)(shm+LDS_OST)+wid*2048;
    #pragma unroll
    for(int r=0;r<16;++r){const int orow=crow(r,hi);
      #pragma unroll
      for(int d0=0;d0<2;++d0)stg[orow*64+d0*32+r32]=__float2bfloat16(o[d0][r]*rli[r]);}
    asm volatile("s_waitcnt lgkmcnt(0)":::"memory");
    #pragma unroll
    for(int i=0;i<4;++i){const int row=i*8+(lane>>3),ch=lane&7; const u32x4 v=*(const u32x4*)(stg+row*64+ch*8); ATTN_STORE16(Ow+(long)row*DMO+ch*8,v);
      float q=0.f;
      #pragma unroll
      for(int e=0;e<4;++e){const float lo=__uint_as_float(v[e]<<16),hi2=__uint_as_float(v[e]&0xffff0000u);q+=lo*lo+hi2*hi2;}
      q+=__shfl_xor(q,1);q+=__shfl_xor(q,2);q+=__shfl_xor(q,4);
      if(ch==0)SSQA[(rowbase+q0+wid*QBLK+row)*8+h]=q;} }
  asm volatile("s_waitcnt lgkmcnt(0)\n\ts_barrier":::"memory");
  #undef BMASK
  #undef DMA_K
  #undef DMA_V
  #undef CMASK
  #undef START
  #undef RESC
  #undef ROT
}
constexpr int ATTN_LDS_BYTES=LDS_BYTES;
#undef SBAR
#undef WAIT_BAR
}

#ifndef STAG_TICKS
#define STAG_TICKS 100
#endif
__device__ __forceinline__ void stagger(int c, int ticks) {
    const unsigned long long t0 = __builtin_amdgcn_s_memrealtime(); const unsigned long long w = (unsigned long long)(((c >> 3) & 3) * ticks);
    while (__builtin_amdgcn_s_memrealtime() - t0 < w) __builtin_amdgcn_s_sleep(8);
}
__global__ void __launch_bounds__(512, 2) mk_fwd(Args args) {
    extern __shared__ __attribute__((aligned(16))) unsigned char lds_raw[];
    Ctx C; C.lds = (LAS unsigned char*)lds_raw; C.tid = threadIdx.x; C.lane = C.tid & 63; C.wave = __builtin_amdgcn_readfirstlane(C.tid >> 6);
    C.G = gridDim.x; { const int bx = blockIdx.x; C.vcu = (C.G % 8 == 0) ? (bx % 8) * (C.G / 8) + bx / 8 : bx; }
    unsigned char* ws = args.ws;
    for (int u = C.tid; u < (LDS_BYTES - LDSCTL_OFF) / 4; u += 512) ((LAS unsigned*)(C.lds + LDSCTL_OFF))[u] = 0u;
    __syncthreads();
    XcdBarrier bar; bar.bar = (unsigned*)(ws + WS_CTL) + CW_BAR; bar.x = 0; bar.st = nullptr;
    if (N_LAUNCHES == 1) bar = xcd_barrier_post((unsigned*)(ws + WS_CTL) + CW_BAR, (volatile LAS unsigned*)(C.lds + MISC_OFF) + 8);
    const int lo = args.ph_lo, hi = args.ph_hi;
#ifndef PH_MASK
#define PH_MASK 0x3fff
#endif
#define IN(k) ((((PH_MASK) >> (k)) & 1) && lo <= (k) && (k) < hi)
#ifndef PROBE_REP
#define PROBE_REP -1
#endif
#define REP(k) for (int rep_ = 0; rep_ < ((PROBE_REP == (k)) ? 2 : 1); ++rep_)
#define REPBAR() do { if (rep_ > 0) xcd_barrier(bar); } while (0)
#define FRESH() do { int t_ = threadIdx.x; asm volatile("" : "+v"(t_)); C.tid = t_; C.lane = t_ & 63; C.wave = __builtin_amdgcn_readfirstlane(t_ >> 6); } while (0)
#define SEAM(k) do { if (IN(k) && IN((k) + 1)) xcd_barrier(bar); } while (0)
    const int cb = (int)blockIdx.x;

    if (IN(0)) REP(0) { REPBAR(); FRESH(); ph_prologue(args, C); SEAM(0); }
    if (PROBE_REP == 200) { for (int xb_ = 0; xb_ < 8; ++xb_) xcd_barrier(bar); }
    if (IN(1)) REP(1) { REPBAR();
        { Gemm g{(const bf16_t*)(ws + WS_B), (const bf16_t*)(ws + WS_WIN), DM, DM, DM}; PlainOrder S; S.init(NTOK, DIN, C.G, cb, DM, DM);
          if (PROBE_REP == 301) { EpiNull EN{}; GEMM_PHASE(C.lds, g, S, EN); xcd_barrier(bar); }
          EpiProj E{(bf16_t*)(ws + WS_A), (const float*)(ws + WS_ROPE), (float*)(ws + WS_KSUM)}; GEMM_PHASE(C.lds, g, S, E); }
        { Gemm g{(const bf16_t*)(ws + WS_MEMN), (const bf16_t*)(ws + WS_WXK), DM, DM, DM}; PlainOrder S; S.init(NMEM, DM, C.G, cb, DM, DM);
          EpiStore E{(bf16_t*)(ws + WS_KM), DM}; GEMM_PHASE(C.lds, g, S, E); }
        { Gemm g{(const bf16_t*)(ws + WS_MEMN), (const bf16_t*)(ws + WS_WXV), DM, DM, DM}; PlainOrder S; S.init(NMEM, DM, C.G, (cb + C.G - 64 % C.G) % C.G, DM, DM);
          EpiStore E{(bf16_t*)(ws + WS_VMT), DM}; GEMM_PHASE(C.lds, g, S, E); }
        { FRESH(); if (C.G == 256) { if (cb >= 128) conv_wdn(args, C, (cb - 128) * 8 + C.wave, 128 * 8, 0, WDN_SPLIT); }
          else conv_wdn(args, C, C.vcu * 8 + C.wave, C.G * 8, 0, WDN_SPLIT); }
        SEAM(1);
    }
    if (IN(2)) REP(2) { REPBAR(); FRESH();
        for (int lrep_ = 0; lrep_ < ((PROBE_REP == 102) ? 2 : 1); ++lrep_)
        for (int L = C.vcu; L < 256; L += C.G) lru_unit(args, C, L >> 4, (L >> 1) & 7, L & 1, L);
        for (int arep_ = 0; arep_ < ((PROBE_REP == 103) ? 2 : 1); ++arep_)
        for (int i = 0;; ++i) { const int aidx = i * C.G + C.vcu; if (aidx >= 1024) break; const int cc = aidx & 255, ii = aidx >> 8, bh = cc >> 1;
            const int qb = (cc & 1) ? ((ii == 0) ? 6 : (ii == 1) ? 1 : (ii == 2) ? 5 : 2) : ((ii == 0) ? 7 : (ii == 1) ? 0 : (ii == 2) ? 4 : 3);
#ifdef ATTN_SIMPLE
            moba_unit_simple(args, C, bh >> 3, bh & 7, qb); }
#else
            { const attn_body::bf16* Qp = (const attn_body::bf16*)(ws + WS_A) + (size_t)2 * NTOK * 512;
              attn_body::attn_unit<8>(bh >> 3, bh & 7, qb, Qp, Qp + (size_t)NTOK * 512, Qp + (size_t)2 * NTOK * 512, (attn_body::bf16*)(ws + WS_C) + 512, (const float*)(ws + WS_KSUM), (float*)(ws + WS_SSQA), (char*)lds_raw); } }
#endif
        SEAM(2);
    }
    if (IN(4)) REP(4) { REPBAR(); Gemm g{(const bf16_t*)(ws + WS_C), (const bf16_t*)(ws + WS_WOUT), DM, DM, DM}; PlainOrder S; S.init(NTOK, DM, C.G, cb, DM, DM);
        EpiResid<true, true> E{(const bf16_t*)(ws + WS_B), (bf16_t*)args.out, (float*)(ws + WS_SSQ1), (const float*)(ws + WS_SSQL), (const float*)(ws + WS_SSQA), ws + WS_A + 64 * MiB, 1.0f, (const float*)(ws + WS_TOK + TOK_D), args.in[2]};     GEMM_PHASE(C.lds, g, S, E);
        { Gemm g2{(const bf16_t*)(ws + WS_KM), (const bf16_t*)(ws + WS_WXQ), DM, DM, XHD}; XpreOrder S2{C.G, cb, 0}; EpiStore8 E2{ws + WS_A, DM, QKT_SC}; GEMM_PHASE(C.lds, g2, S2, E2); }
        { Gemm g3{(const bf16_t*)(ws + WS_WXO), (const bf16_t*)(ws + WS_VMT), DM, DM, XHD}; XpreOrder S3{C.G, cb, 1}; EpiStore8 E3{ws + WS_A + 32 * MiB, DM, VWT_SC}; GEMM_PHASE(C.lds, g3, S3, E3); }
        SEAM(4); }
    if (IN(5)) REP(5) { REPBAR(); Gemm g{(const bf16_t*)(ws + WS_A + 64 * MiB), (const bf16_t*)(ws + WS_A), DM / 2, DM / 2, DM / 2}; XattnOrder S{C.G, cb, 0, DM / 2, DM / 2};
        EpiSoftmax E{ws + WS_A + 96 * MiB, DM, C.lds + LDSCTL_OFF + 4096, (const float*)(ws + WS_SSQ1), XSCALE / QKT_SC}; GEMM_PHASE8N(C.lds, g, S, E); SEAM(5); }
    if (IN(8)) REP(8) { REPBAR(); Gemm g{(const bf16_t*)(ws + WS_A + 96 * MiB), (const bf16_t*)(ws + WS_A + 32 * MiB), DM / 2, DM / 2, DM / 2}; XattnOrder S{C.G, cb, 1, DM / 2, DM / 2};
        EpiResid<false, false> E{(const bf16_t*)args.out, (bf16_t*)args.out + DM, (float*)(ws + WS_SSQ2), nullptr, nullptr, ws + WS_H2F8, 1.0f / (PX_SC * VWT_SC)}; GEMM_PHASE8(C.lds, g, S, E); SEAM(8); }
    if (IN(9)) REP(9) { REPBAR(); FRESH(); ph_router(args, C); SEAM(9); }
    if (IN(11)) REP(11) { REPBAR(); FRESH(); moe_table(args, C); Gemm g{(const bf16_t*)(ws + WS_H2F8), (const bf16_t*)(ws + WS_WGU), DM / 2, DM / 2, DM / 2};
        MoeOrder<true> S{(const LAS int*)(C.lds + MOE_OFF), C.G, cb, DM / 2, DM / 2, (const int*)(ws + WS_LTOK), (unsigned)DM};
        EpiGateUp E{ws + WS_B, (const float*)(ws + WS_LRS)}; GEMM_PHASE8(C.lds, g, S, E); SEAM(11); }
    if (IN(12)) REP(12) { REPBAR(); FRESH(); moe_table(args, C); Gemm g{(const bf16_t*)(ws + WS_B), (const bf16_t*)(ws + WS_WDN), DFF / 2, DFF / 2, DFF / 2};
        MoeOrder<false> S{(const LAS int*)(C.lds + MOE_OFF), C.G, cb, DFF / 2, DFF / 2, nullptr, 0u};
        if (PROBE_REP == 312) { EpiNull EN{}; GEMM_PHASE8(C.lds, g, S, EN); xcd_barrier(bar); }
        EpiStore8 E{ws + WS_A, DM, YB_SC / (WDN_SC * ACT_SC)}; GEMM_PHASE8(C.lds, g, S, E); SEAM(12); }
    if (IN(13)) REP(13) { REPBAR(); FRESH(); moe_table(args, C); ph_final(args, C, (PROBE_REP == 13 && rep_ == 0) ? (float*)(ws + WS_B) : args.out); }
#undef IN
#undef FRESH
#undef SEAM
}

extern "C" void kernel_launch(void* const* d_in, const int* in_sizes, int n_in, void* d_out, int out_size, void* d_ws, size_t ws_size, hipStream_t stream) {
    static int grid = 0;
    if (grid == 0) {
        if (n_in != 27 || out_size != NTOK * DM || ws_size < WS_END) { fprintf(stderr, "kernel_launch: unexpected shapes (n_in %d out %d ws %zu)\n", n_in, out_size, ws_size); grid = -1; return; }
        int dev = 0, cus = 0, per_cu = 0;
        if (hipGetDevice(&dev) != hipSuccess || hipDeviceGetAttribute(&cus, hipDeviceAttributeMultiprocessorCount, dev) != hipSuccess) { grid = -1; return; }
        if (hipFuncSetAttribute((const void*)mk_fwd, hipFuncAttributeMaxDynamicSharedMemorySize, LDS_BYTES) != hipSuccess) { fprintf(stderr, "kernel_launch: hipFuncSetAttribute failed\n"); grid = -1; return; }
        if (hipOccupancyMaxActiveBlocksPerMultiprocessor(&per_cu, (const void*)mk_fwd, 512, LDS_BYTES) != hipSuccess || per_cu < 1) fprintf(stderr, "kernel_launch: occupancy query reports %d\n", per_cu);
        (void)hipGetLastError();
        grid = cus;
    }
    if (grid < 0) return;
    (void)hipMemsetAsync((char*)d_ws + WS_CTL, 0, CTL_ZERO_BYTES, stream);
    Args a{};
    for (int i = 0; i < 27; ++i) a.in[i] = (const float*)d_in[i];
    a.out = (float*)d_out; a.ws = (unsigned char*)d_ws;
    const float invf[8] = {1.0f, 0.1939227432012558f, 0.03760603070259094f, 0.007292664609849453f, 0.0014142135623842478f, 0.00027424818836152554f, 5.318296098266728e-05f, 1.0313386155758053e-05f};
    for (int i = 0; i < 8; ++i) a.invf[i] = invf[i];
    if (N_LAUNCHES == 1) { a.ph_lo = 0; a.ph_hi = N_PHASES; hipLaunchKernelGGL(mk_fwd, dim3(grid), dim3(512), LDS_BYTES, stream, a); }
    else for (int p = 0; p < N_PHASES; ++p) { a.ph_lo = p; a.ph_hi = p + 1; hipLaunchKernelGGL(mk_fwd, dim3(grid), dim3(512), LDS_BYTES, stream, a); }
}
```

```cpp
#include <hip/hip_runtime.h>
#include <cstdio>
#include <cstdint>

#define LAS __attribute__((address_space(3)))
#define GAS __attribute__((address_space(1)))
typedef unsigned short bf16_t;
typedef short bf16x8 __attribute__((ext_vector_type(8)));
typedef float f32x4 __attribute__((ext_vector_type(4)));
typedef float f32x2 __attribute__((ext_vector_type(2)));
typedef unsigned u32x4 __attribute__((ext_vector_type(4)));
typedef unsigned u32x2 __attribute__((ext_vector_type(2)));

#ifndef MK_N_LAUNCHES
#define MK_N_LAUNCHES 1
#endif
constexpr int N_PHASES = 14;
constexpr int N_LAUNCHES = MK_N_LAUNCHES;

constexpr int BATCH = 16, SEQ = 2048, DM = 1024, NTOK = BATCH * SEQ;
constexpr int DLRU = 512, DATT = 512, DIN = 2560, NHEAD = 8, HD = 64, NBLK = 8, MBLK = 256;
constexpr int MEMLEN = 256, NXH = 4, XHD = 256, NMEM = BATCH * MEMLEN;
constexpr int NEXP = 32, EPG = 8, NGRP = 4, DFF = 512;
constexpr float EPS = 1e-6f;
constexpr float QKT_SC = 8.0f, VWT_SC = 8.0f, PX_SC = 256.0f;
constexpr float WGU_SC = 64.0f, WDN_SC = 32.0f, ACT_SC = 16.0f, YB_SC = 16.0f;
constexpr int WDN_SPLIT = 3072;
constexpr int MAXTILES = 288, LCAP = 65536, LDH = 2048;
constexpr float QSCALE = 0.125f * 1.4426950408889634f;
constexpr float XSCALE = 0.0625f * 1.4426950408889634f;

constexpr size_t MiB = 1u << 20;
constexpr size_t WS_CTL = 0, CTL_ZERO_BYTES = 1 * MiB;
constexpr int CW_TMO = 0, CW_BAR = 4096, CW_CNT = 8192;
constexpr size_t WS_KSUM = 512 * 1024;
constexpr size_t WS_WIN = 2 * MiB, WS_WXK = 7 * MiB, WS_WXV = 9 * MiB, WS_WOUT = 11 * MiB, WS_WXQ = 13 * MiB, WS_WXO = 15 * MiB;
constexpr size_t WS_WR = 17 * MiB, WS_ROPE = 18 * MiB, WS_SSQ1 = 19 * MiB, WS_SSQ2 = 21 * MiB, WS_TOK = 23 * MiB, WS_RSC = 24 * MiB;
constexpr size_t WS_MEMN = 25 * MiB, WS_KM = 33 * MiB, WS_VMT = 41 * MiB, WS_WGU = 49 * MiB, WS_WDN = 113 * MiB;
constexpr size_t WS_A = 145 * MiB, WS_B = 305 * MiB, WS_C = 385 * MiB, WS_SSQL = 449 * MiB, WS_SSQA = 451 * MiB, WS_LTOK = 452 * MiB, WS_LRS = 460 * MiB, WS_H2F8 = 468 * MiB, WS_END = 500 * MiB;
constexpr size_t TOK_E = 0, TOK_R = 256 * 1024, TOK_G = 512 * 1024, TOK_D = 768 * 1024;

constexpr int RING_BYTES = 131072;
constexpr int LDSCTL_OFF = RING_BYTES, MISC_OFF = LDSCTL_OFF + 320, MOE_OFF = LDSCTL_OFF + 1024;
constexpr int LDS_BYTES = 147456;

__device__ __forceinline__ unsigned cvt_pk_bf16(float lo, float hi) { unsigned r; asm volatile("v_cvt_pk_bf16_f32 %0, %1, %2" : "=v"(r) : "v"(lo), "v"(hi)); return r; }
__device__ __forceinline__ float bflo(unsigned w) { return __uint_as_float(w << 16); }
__device__ __forceinline__ float bfhi(unsigned w) { return __uint_as_float(w & 0xffff0000u); }
__device__ __forceinline__ float bf2f(bf16_t b) { return __uint_as_float((unsigned)b << 16); }
__device__ __forceinline__ float wave_sum(float v) {
#pragma unroll
    for (int o = 1; o < 64; o <<= 1) v += __shfl_xor(v, o);
    return v;
}
#define LDS_WAIT() asm volatile("s_waitcnt lgkmcnt(0)" ::: "memory")
__device__ __forceinline__ float sigmoidf_(float x) { return __builtin_amdgcn_rcpf(1.0f + __builtin_amdgcn_exp2f(x * -1.4426950408889634f)); }

#define XB_TMO      128
#define XB_XCNT(j)  (256  + 64 * (j))
#define XB_XSUB(j)  (1280 + 64 * (j))
#define XB_XGEN(j)  (2304 + 64 * (j))
#define XB_TOP      3328
#define XB_TOPGEN   3392
#define XCD_BAR_WORDS 3456
#define XB_SPIN_CAP (1u << 18)
__device__ __forceinline__ unsigned xb_ld(unsigned* p)              { return __hip_atomic_load(p, __ATOMIC_RELAXED, __HIP_MEMORY_SCOPE_AGENT); }
__device__ __forceinline__ unsigned xb_add(unsigned* p, unsigned v) { return __hip_atomic_fetch_add(p, v, __ATOMIC_RELAXED, __HIP_MEMORY_SCOPE_AGENT); }
__device__ __forceinline__ unsigned xb_xcc_id() { return (unsigned)__builtin_amdgcn_s_getreg((3 << 11) | 20) & 0xFu; }
#define XB_SPIN(cond, bar) do { unsigned _sp = 0; while (cond) { __builtin_amdgcn_s_sleep(1); \
    if ((++_sp & 255u) == 0u) { if (xb_ld(&(bar)[XB_TMO])) break; if (_sp > XB_SPIN_CAP) { atomicAdd(&(bar)[XB_TMO], 1u); break; } } } } while (0)
struct XcdBarrier { unsigned* bar; unsigned x; volatile LAS unsigned* st; };
__device__ __forceinline__ XcdBarrier xcd_barrier_post(unsigned* bar, volatile LAS unsigned* st) {
    XcdBarrier b; b.bar = bar; b.x = xb_xcc_id(); b.st = st;
    if (threadIdx.x == 0) (void)xb_add(&bar[XB_XCNT(b.x)], 1u);
    return b;
}
__device__ __forceinline__ void xcd_barrier_complete(unsigned* bar, unsigned x, unsigned& nloc, unsigned& nx) {
    const unsigned G = gridDim.x * gridDim.y * gridDim.z;
    unsigned sum, cnt, mine, sp = 0u;
    for (;;) {
        sum = 0u; cnt = 0u; mine = 0u;
#pragma unroll
        for (unsigned j = 0; j < 16; ++j) { const unsigned c = xb_ld(&bar[XB_XCNT(j)]); sum += c; cnt += (c > 0u) ? 1u : 0u; mine = (j == x) ? c : mine; }
        if (sum == G) break;
        __builtin_amdgcn_s_sleep(1);
        if ((++sp & 255u) == 0u) { if (xb_ld(&bar[XB_TMO])) break; if (sp > XB_SPIN_CAP) { atomicAdd(&bar[XB_TMO], 1u); break; } }
    }
    nloc = mine > 0u ? mine : 1u; nx = cnt > 0u ? cnt : 1u;
}
__device__ __forceinline__ void xcd_barrier(const XcdBarrier& b) {
    asm volatile("s_waitcnt vmcnt(0)" ::: "memory");
    __syncthreads();
    if (threadIdx.x == 0) {
        unsigned* bar = b.bar;
        __builtin_amdgcn_s_waitcnt(0);
        unsigned nloc = b.st[0], nx = b.st[1];
        if (nloc == 0u) { xcd_barrier_complete(bar, b.x, nloc, nx); b.st[0] = nloc; b.st[1] = nx; }
        const unsigned old = xb_add(&bar[XB_XSUB(b.x)], 1u);
        const unsigned gen = old / nloc;
        if (old + 1u == (gen + 1u) * nloc) {
            __builtin_amdgcn_fence(__ATOMIC_RELEASE, "agent");
            asm volatile("s_waitcnt vmcnt(0)" ::: "memory");
            const unsigned og = xb_add(&bar[XB_TOP], 1u);
            const unsigned tg = og / nx;
            if (og + 1u == (tg + 1u) * nx) xb_add(&bar[XB_TOPGEN], 1u);
            else XB_SPIN(xb_ld(&bar[XB_TOPGEN]) == tg, bar);
            __builtin_amdgcn_fence(__ATOMIC_ACQUIRE, "agent");
            xb_add(&bar[XB_XGEN(b.x)], 1u);
            asm volatile("s_waitcnt vmcnt(0)" ::: "memory");
        } else {
            XB_SPIN(xb_ld(&bar[XB_XGEN(b.x)]) == gen, bar);
            __builtin_amdgcn_fence(__ATOMIC_ACQUIRE, "agent");
            asm volatile("s_waitcnt vmcnt(0)" ::: "memory");
        }
    }
    __syncthreads();
}

struct Unit { int pm, pn; size_t a_off, b_off; int lbase, nvalid; };
struct Gemm { const bf16_t* A; const bf16_t* Bt; int lda, ldb, K; };
__host__ __device__ __forceinline__ int perm32(int rho) { const int n = rho >> 4, i = rho & 15; return 8 * (i >> 2) + 4 * n + (i & 3); }

struct PlainOrder {     static constexpr bool GATHER = false;
    int nM, nN, nwg, G, c, lda, ldb;
    __device__ void init(int M, int N, int G_, int c_, int lda_, int ldb_) { nM = M / 256; nN = N / 256; nwg = nM * nN; G = G_; c = c_; lda = lda_; ldb = ldb_; }
    __device__ bool next(int i, Unit& u) const {
        const long L = (long)i * G + c; if (L >= nwg) return false;
        int wgid = (int)L; { const int q = nwg / 8, r = nwg % 8, xcd = wgid % 8, off = wgid / 8; wgid = (xcd < r ? xcd * (q + 1) : r * (q + 1) + (xcd - r) * q) + off; }
        const int nig = 8 * nN, gid = wgid / nig, fm = gid * 8, gsz = (nM - fm) < 8 ? (nM - fm) : 8;
        u.pm = fm + ((wgid % nig) % gsz); u.pn = (wgid % nig) / gsz;
        u.a_off = (size_t)u.pm * 256 * lda; u.b_off = (size_t)u.pn * 256 * ldb; return true;
    }
};
struct XpreOrder {
    static constexpr bool GATHER = false;
    int G, c, mode;
    __device__ bool next(int i, Unit& u) const {
        const int L = i * G + c; if (L >= 256) return false;
        const int b = L >> 4, x = (L >> 2) & 3, y = L & 3;
        if (mode == 0) { const int h = x, kt = y; u.pm = b * 4 + h; u.pn = kt; u.a_off = (size_t)b * MEMLEN * DM + h * XHD; u.b_off = (size_t)kt * 256 * DM + h * XHD; }
        else { const int nt = x, h = y; u.pm = b * 4 + nt; u.pn = h; u.a_off = (size_t)nt * 256 * DM + h * XHD; u.b_off = (size_t)b * MEMLEN * DM + h * XHD; }
        return true;
    }
};
struct XattnOrder {
    static constexpr bool GATHER = false;
    int G, c, mode, lda, ldb;
    __device__ bool next(int i, Unit& u) const {
        int L = i * G + c; if (L >= (NTOK / 256) * 4) return false;
        if (G == 256) { const int x = c & 7, idx = c >> 3; L = ((x + 8 * i) * 8 + (idx >> 2)) * 4 + (idx & 3); }
        u.pm = L >> 2; u.pn = L & 3; const int b = u.pm >> 3;
        u.a_off = (size_t)u.pm * 256 * lda;
        u.b_off = mode == 0 ? (size_t)(b * 4 + u.pn) * 256 * ldb : (size_t)(b * 1024 + u.pn * 256) * ldb;
        return true;
    }
};
template <bool GATH_> struct MoeOrder {
    static constexpr bool GATHER = GATH_;
    const LAS int* ts; int G, c, lda, ldb; const int* ltok; unsigned rowbytes;
    __device__ bool next(int i, Unit& u) const {
        const int L = i * G + c; if (L >= ts[NEXP] * 4) return false;
        const int T = L >> 2, j = L & 3; int e = 0; while (ts[e + 1] <= T) ++e;
        const int lt = T - ts[e];
        u.pm = T; u.pn = j; u.a_off = GATH_ ? (size_t)0 : (size_t)T * 256 * lda; u.b_off = ((size_t)e * 1024 + j * 256) * ldb;
        u.lbase = e * LCAP + lt * 256; u.nvalid = ts[33 + e] - lt * 256; return true;
    }
    __device__ __forceinline__ unsigned rowoff(const Unit& u, int r) const { return (r < u.nvalid) ? (unsigned)ltok[u.lbase + r] * rowbytes : 0u; }
};


typedef int v8i __attribute__((ext_vector_type(8)));
typedef int v4i __attribute__((ext_vector_type(4)));
__device__ __forceinline__ v8i cat8(bf16x8 lo, bf16x8 hi) { const v4i a = __builtin_bit_cast(v4i, lo), b = __builtin_bit_cast(v4i, hi); return __builtin_shufflevector(a, b, 0, 1, 2, 3, 4, 5, 6, 7); }
template <int H> __device__ __forceinline__ bf16x8 half8(v8i v) { const v4i h = H ? __builtin_shufflevector(v, v, 4, 5, 6, 7) : __builtin_shufflevector(v, v, 0, 1, 2, 3); return __builtin_bit_cast(bf16x8, h); }
__device__ __forceinline__ unsigned pk4_fp8(float a, float b, float c, float d) { int w = __builtin_amdgcn_cvt_pk_fp8_f32(a, b, 0, false); w = __builtin_amdgcn_cvt_pk_fp8_f32(c, d, w, true); return (unsigned)w; }
__host__ __device__ __forceinline__ int lds_byte(int r, int c) { const int st = (r >> 4) * 2 + (c >> 5), rr = r & 15, cc = c & 31, ob = rr * 64 + cc * 2; return st * 1024 + (ob ^ (((ob >> 9) & 1) << 5)); }
__host__ __device__ __forceinline__ void stage_rc(int b, int& R, int& C) { const int st = b / 1024, sb = b % 1024, swz = sb ^ (((sb >> 9) & 1) << 5); R = (st >> 1) * 16 + swz / 64; C = (st & 1) * 32 + (swz % 64) / 2; }
template <class Epi, class Sched, bool ALIGN_EPI = false, bool SP2 = false, bool F8 = false, bool SKIPW = true>
__device__ __forceinline__ void gemm_phase(LAS unsigned char* lds, const Gemm g, const Sched& S, const Epi& E) {
    constexpr int BK = 64, HALF = 128, HTB = HALF * BK * 2;
    int tid = threadIdx.x; asm volatile("" : "+v"(tid));
    const int wid = __builtin_amdgcn_readfirstlane(tid >> 6), lane = tid & 63, wr = wid >> 2, wc = wid & 3, fr = lane & 15, fq = lane >> 4;
    const int K = g.K, nt = K / BK;
    unsigned voffA[2], voffB[2];
#pragma unroll
    for (int i = 0; i < 2; ++i) { int R, C; stage_rc(tid * 16 + i * 8192, R, C); const int Rb = Epi::PERM ? ((R & ~31) + perm32(R & 31)) : R;
        voffA[i] = (unsigned)(R * g.lda + C) * 2u; voffB[i] = (unsigned)(Rb * g.ldb + C) * 2u; }
    constexpr bool GATH = Sched::GATHER;
    unsigned vcu[2][2] = {{0u, 0u}, {0u, 0u}}, vnx[2][2] = {{0u, 0u}, {0u, 0u}}; int gR[2] = {0, 0}; unsigned gC[2] = {0u, 0u};
    if constexpr (GATH) {
#pragma unroll
        for (int i = 0; i < 2; ++i) { int R, Cq; stage_rc(tid * 16 + i * 8192, R, Cq); gR[i] = R; gC[i] = (unsigned)Cq * 2u; } }
    const size_t kstep = (size_t)(BK * 2);
    const size_t hstepA = (size_t)HALF * g.lda * 2, hstepB = (size_t)HALF * g.ldb * 2;
    const unsigned ldsw = (unsigned)wid * 1024u;
    const int aoff = lds_byte(wr * 64 + fr, F8 ? fq * 16 : fq * 8), boff = lds_byte(wc * 32 + fr, F8 ? fq * 16 : fq * 8);
    const int aoff1 = lds_byte(wr * 64 + fr, F8 ? fq * 16 + 8 : fq * 8 + 32) - aoff, boff1 = lds_byte(wc * 32 + fr, F8 ? fq * 16 + 8 : fq * 8 + 32) - boff;
#define PG8_SA(b, h) (((b) * 2 + (h)) * HTB)
#define PG8_SB(b, h) ((4 + (b) * 2 + (h)) * HTB)
#define PG8_STAGE(bufoff, gbase, voff) do { _Pragma("unroll") for (int _i = 0; _i < 2; ++_i) \
        __builtin_amdgcn_global_load_lds((const unsigned*)((const char*)(gbase) + (voff)[_i]), (LAS unsigned*)(lds + (bufoff) + ldsw + _i * 8192), 16, 0, 0); } while (0)
#define PG8_STA(bufoff, ptr, h, nx) do { if constexpr (GATH) { const unsigned vsel_[2] = {(nx) ? vnx[h][0] : vcu[h][0], (nx) ? vnx[h][1] : vcu[h][1]}; PG8_STAGE(bufoff, ptr, vsel_); } \
        else { PG8_STAGE(bufoff, (ptr) + (h) * hstepA, voffA); } } while (0)
#define PG8_LDA(dst, b, h) do { _Pragma("unroll") for (int m = 0; m < 4; ++m) dst[m] = cat8(*(const LAS bf16x8*)(lds + PG8_SA(b, h) + aoff + m * 2048), *(const LAS bf16x8*)(lds + PG8_SA(b, h) + aoff + m * 2048 + aoff1)); } while (0)
#define PG8_LDB(dst, b, h) do { _Pragma("unroll") for (int n = 0; n < 2; ++n) dst[n] = cat8(*(const LAS bf16x8*)(lds + PG8_SB(b, h) + boff + n * 2048), *(const LAS bf16x8*)(lds + PG8_SB(b, h) + boff + n * 2048 + boff1)); } while (0)
#define PG8_MMA(ai, bj, At, Bt) do { __builtin_amdgcn_s_setprio(1); \
        if constexpr (F8) { _Pragma("unroll") for (int m = 0; m < 4; ++m) _Pragma("unroll") for (int n = 0; n < 2; ++n) \
            asm volatile("s_nop 1\n\tv_mfma_scale_f32_16x16x128_f8f6f4 %0, %1, %2, %0, %3, %3 op_sel_hi:[0,0,0]" : "+v"(acc[ai][bj][m][n]) : "v"(Bt[n]), "v"(At[m]), "v"(sc127)); } \
        else { _Pragma("unroll") for (int m = 0; m < 4; ++m) _Pragma("unroll") for (int n = 0; n < 2; ++n) { \
            acc[ai][bj][m][n] = __builtin_amdgcn_mfma_f32_16x16x32_bf16(half8<0>(Bt[n]), half8<0>(At[m]), acc[ai][bj][m][n], 0, 0, 0); \
            acc[ai][bj][m][n] = __builtin_amdgcn_mfma_f32_16x16x32_bf16(half8<1>(Bt[n]), half8<1>(At[m]), acc[ai][bj][m][n], 0, 0, 0); } } \
        __builtin_amdgcn_s_setprio(0); } while (0)
#define PG8_WAIT_V(n) asm volatile("s_waitcnt vmcnt(" #n ")" ::: "memory")
#define PG8_WAIT_L(n) asm volatile("s_waitcnt lgkmcnt(" #n ")" ::: "memory")
#define PG8_BAR __builtin_amdgcn_s_barrier()
#define PG8_SCHED __builtin_amdgcn_sched_barrier(0)
    Unit cur, nxt; int ui = 0;
    if (!S.next(0, cur)) return;
    f32x4 acc[2][2][4][2];
#pragma unroll
    for (int a = 0; a < 2; ++a)
#pragma unroll
        for (int b = 0; b < 2; ++b)
#pragma unroll
            for (int m = 0; m < 4; ++m)
#pragma unroll
                for (int n = 0; n < 2; ++n) acc[a][b][m][n] = (f32x4){0.f, 0.f, 0.f, 0.f};
    int sc127 = 127; asm volatile("" : "+v"(sc127));
    v8i At[4], B0[2], B1[2];
    const char* cA = (const char*)(g.A + cur.a_off); const char* cB = (const char*)(g.Bt + cur.b_off);
    if constexpr (GATH) {
#pragma unroll
        for (int h = 0; h < 2; ++h)
#pragma unroll
            for (int i = 0; i < 2; ++i) vcu[h][i] = S.rowoff(cur, h * HALF + gR[i]) + gC[i]; }
    if constexpr (SP2) {
        PG8_STAGE(PG8_SB(0, 0), cB, voffB); PG8_STAGE(PG8_SB(0, 1), cB + hstepB, voffB); PG8_STA(PG8_SA(0, 0), cA, 0, false); PG8_STA(PG8_SA(0, 1), cA, 1, false);
        if (wr == 1) PG8_BAR;
        PG8_WAIT_V(2); PG8_BAR;
        PG8_STAGE(PG8_SB(1, 0), cB + kstep, voffB); PG8_STA(PG8_SA(1, 0), cA + kstep, 0, false); PG8_STAGE(PG8_SB(1, 1), cB + hstepB + kstep, voffB);
        PG8_WAIT_V(6); PG8_BAR;
    } else {
        PG8_STAGE(PG8_SB(0, 0), cB, voffB); PG8_STA(PG8_SA(0, 0), cA, 0, false); PG8_STAGE(PG8_SB(0, 1), cB + hstepB, voffB); PG8_STA(PG8_SA(0, 1), cA, 1, false);
        if (wr == 1) PG8_BAR;
        PG8_WAIT_V(4); PG8_BAR;
        PG8_STAGE(PG8_SB(1, 0), cB + kstep, voffB); PG8_STA(PG8_SA(1, 0), cA + kstep, 0, false); PG8_STAGE(PG8_SB(1, 1), cB + hstepB + kstep, voffB);
        PG8_WAIT_V(6); PG8_BAR;
    }
    for (;;) {
        const bool has_next = S.next(ui + 1, nxt);
        const char* nA = has_next ? (const char*)(g.A + nxt.a_off) : cA; const char* nB = has_next ? (const char*)(g.Bt + nxt.b_off) : cB;
        if constexpr (GATH) {
#pragma unroll
            for (int h = 0; h < 2; ++h)
#pragma unroll
                for (int i = 0; i < 2; ++i) vnx[h][i] = has_next ? (S.rowoff(nxt, h * HALF + gR[i]) + gC[i]) : vcu[h][i]; }
#pragma unroll 1
        for (int t = 0; t < nt; t += 2) {
            if constexpr (Epi::MIDK) { if (t == (nt >> 1)) E.midk(acc, cur, wr, wc, fr, fq); }
            const bool last = (t == nt - 2); const bool skipw = SKIPW && SP2 && (t == 0) && (ui > 0);
            const char* a1 = cA + (size_t)(t + 1) * kstep;
            const char* a2 = last ? nA : cA + (size_t)(t + 2) * kstep; const char* b2 = last ? nB : cB + (size_t)(t + 2) * kstep;
            const char* a3 = a2 + kstep; const char* b3 = b2 + kstep;
            if constexpr (SP2) {
            PG8_LDB(B0, 0, 0); PG8_LDB(B1, 0, 1); PG8_SCHED; PG8_LDA(At, 0, 0); PG8_STA(PG8_SA(1, 1), a1, 1, false);
            if (!skipw) PG8_WAIT_V(8); PG8_WAIT_L(0); PG8_BAR; PG8_MMA(0, 0, At, B0); PG8_MMA(0, 1, At, B1); PG8_BAR; PG8_SCHED;
            PG8_LDA(At, 0, 1); PG8_STAGE(PG8_SB(0, 0), b2, voffB); PG8_STAGE(PG8_SB(0, 1), b2 + hstepB, voffB); PG8_STA(PG8_SA(0, 0), a2, 0, last);
            if (!skipw) PG8_WAIT_V(8); PG8_WAIT_L(0); PG8_BAR; PG8_MMA(1, 0, At, B0); PG8_MMA(1, 1, At, B1); PG8_BAR; PG8_SCHED;
            PG8_LDB(B0, 1, 0); PG8_LDB(B1, 1, 1); PG8_SCHED; PG8_LDA(At, 1, 0); PG8_STA(PG8_SA(0, 1), a2, 1, last);
            PG8_WAIT_V(8); PG8_WAIT_L(0); PG8_BAR; PG8_MMA(0, 0, At, B0); PG8_MMA(0, 1, At, B1); PG8_BAR; PG8_SCHED;
            PG8_LDA(At, 1, 1); PG8_STAGE(PG8_SB(1, 0), b3, voffB); PG8_STAGE(PG8_SB(1, 1), b3 + hstepB, voffB); PG8_STA(PG8_SA(1, 0), a3, 0, last);
            PG8_WAIT_V(8); PG8_WAIT_L(0); PG8_BAR; PG8_MMA(1, 0, At, B0); PG8_MMA(1, 1, At, B1); PG8_BAR; PG8_SCHED;
            } else {
            PG8_LDB(B0, 0, 0); PG8_SCHED; PG8_LDA(At, 0, 0); PG8_STA(PG8_SA(1, 1), a1, 1, false);
            PG8_WAIT_L(8); PG8_BAR; PG8_WAIT_L(0); PG8_MMA(0, 0, At, B0); PG8_BAR; PG8_SCHED;
            PG8_LDB(B1, 0, 1); PG8_STAGE(PG8_SB(0, 0), b2, voffB);
            PG8_BAR; PG8_WAIT_L(0); PG8_MMA(0, 1, At, B1); PG8_BAR;
            PG8_LDA(At, 0, 1); PG8_STA(PG8_SA(0, 0), a2, 0, last);
            PG8_BAR; PG8_WAIT_L(0); PG8_MMA(1, 0, At, B0); PG8_BAR; PG8_SCHED;
            PG8_STAGE(PG8_SB(0, 1), b2 + hstepB, voffB);
            PG8_WAIT_V(6); PG8_BAR; PG8_MMA(1, 1, At, B1); PG8_BAR;
            PG8_LDB(B0, 1, 0); PG8_SCHED; PG8_LDA(At, 1, 0); PG8_STA(PG8_SA(0, 1), a2, 1, last);
            PG8_WAIT_L(8); PG8_BAR; PG8_WAIT_L(0); PG8_MMA(0, 0, At, B0); PG8_BAR; PG8_SCHED;
            PG8_LDB(B1, 1, 1); PG8_STAGE(PG8_SB(1, 0), b3, voffB);
            PG8_BAR; PG8_WAIT_L(0); PG8_MMA(0, 1, At, B1); PG8_BAR;
            PG8_LDA(At, 1, 1); PG8_STA(PG8_SA(1, 0), a3, 0, last);
            PG8_BAR; PG8_WAIT_L(0); PG8_MMA(1, 0, At, B0); PG8_BAR; PG8_SCHED;
            PG8_STAGE(PG8_SB(1, 1), b3 + hstepB, voffB);
            PG8_WAIT_V(6); PG8_BAR; PG8_MMA(1, 1, At, B1); PG8_BAR;
            }
        }
        if constexpr (ALIGN_EPI) { if (wr == 0) PG8_BAR; }
        if constexpr (F8) {
#pragma unroll
            for (int a = 0; a < 2; ++a)
#pragma unroll
                for (int b = 0; b < 2; ++b)
                    asm volatile("s_nop 15\n\ts_nop 7" : "+v"(acc[a][b][0][0]), "+v"(acc[a][b][0][1]), "+v"(acc[a][b][1][0]), "+v"(acc[a][b][1][1]), "+v"(acc[a][b][2][0]), "+v"(acc[a][b][2][1]), "+v"(acc[a][b][3][0]), "+v"(acc[a][b][3][1]));
        }
        if constexpr (SP2 && SKIPW) PG8_WAIT_V(0);
        E(acc, cur, wr, wc, fr, fq);
        if (!has_next) break;
#pragma unroll
        for (int a = 0; a < 2; ++a)
#pragma unroll
            for (int b = 0; b < 2; ++b)
#pragma unroll
                for (int m = 0; m < 4; ++m)
#pragma unroll
                    for (int n = 0; n < 2; ++n) acc[a][b][m][n] = (f32x4){0.f, 0.f, 0.f, 0.f};
        cur = nxt; cA = nA; cB = nB; ++ui;
        if constexpr (GATH) {
#pragma unroll
            for (int h = 0; h < 2; ++h)
#pragma unroll
                for (int i = 0; i < 2; ++i) vcu[h][i] = vnx[h][i]; }
        if constexpr (ALIGN_EPI) { if (wr == 1) PG8_BAR; }
    }
    PG8_WAIT_V(0);
    if constexpr (!ALIGN_EPI) { if (wr == 0) PG8_BAR; }
    PG8_BAR;
#undef PG8_SA
#undef PG8_SB
#undef PG8_STAGE
#undef PG8_STA
#undef PG8_LDA
#undef PG8_LDB
#undef PG8_MMA
#undef PG8_WAIT_V
#undef PG8_WAIT_L
#undef PG8_BAR
#undef PG8_SCHED
}
#define GEMM_PHASE(lds, g, S, E) gemm_phase<decltype(E), decltype(S), true, true>(lds, g, S, E)
#define GEMM_PHASE8(lds, g, S, E) gemm_phase<decltype(E), decltype(S), true, true, true>(lds, g, S, E)
#define GEMM_PHASE8N(lds, g, S, E) gemm_phase<decltype(E), decltype(S), true, true, true, false>(lds, g, S, E)

__device__ __forceinline__ float rstd_from_ssq(const float* ssq, int row) {
    const f32x4* p = (const f32x4*)(ssq + (size_t)row * 16); const f32x4 a = p[0], b = p[1], c = p[2], d = p[3];
    const float s = ((a[0] + a[1]) + (a[2] + a[3])) + ((b[0] + b[1]) + (b[2] + b[3])) + ((c[0] + c[1]) + (c[2] + c[3])) + ((d[0] + d[1]) + (d[2] + d[3]));
    return __builtin_amdgcn_rsqf(s * (1.0f / DM) + EPS);
}
__device__ __forceinline__ u32x4 pack8(const f32x4 v0, const f32x4 v1) { u32x4 w; w.x = cvt_pk_bf16(v0[0], v0[1]); w.y = cvt_pk_bf16(v0[2], v0[3]); w.z = cvt_pk_bf16(v1[0], v1[1]); w.w = cvt_pk_bf16(v1[2], v1[3]); return w; }

struct EpiProj {
    static constexpr bool PERM = true, LDSX = false, MIDK = false;
    bf16_t* base; const float* rope; float* ksum;
    __device__ __forceinline__ void operator()(f32x4 (&acc)[2][2][4][2], const Unit& u, int wr, int wc, int fr, int fq) const {
        const int type = u.pn >> 1, colt = (u.pn & 1) * 256;
        bf16_t* O = base + (size_t)type * NTOK * 512;
        const bool is_q = (type == 2), is_k = (type == 3);
        if ((is_q || is_k) && !(wc & 1)) {
#pragma unroll
            for (int ai = 0; ai < 2; ++ai)
#pragma unroll
                for (int m = 0; m < 4; ++m) {
                    const int row = u.pm * 256 + 128 * ai + 64 * wr + 16 * m + fr, pos = row & (SEQ - 1);
                    const float* rp = rope + pos * 16;
                    const f32x4 cs[2] = { *(const f32x4*)(rp), *(const f32x4*)(rp + 4) }, sn[2] = { *(const f32x4*)(rp + 8), *(const f32x4*)(rp + 12) };
#pragma unroll
                    for (int bj = 0; bj < 2; ++bj)
#pragma unroll
                        for (int n = 0; n < 2; ++n) {
                            const f32x4 mine = acc[ai][bj][m][n]; f32x4 oth;
#pragma unroll
                            for (int e = 0; e < 4; ++e) oth[e] = __shfl_xor(mine[e], 16);
                            f32x4 res = mine;
                            if (fq == 0) res = mine * cs[n] - oth * sn[n];
                            else if (fq == 1) res = mine * cs[n] + oth * sn[n];
                            acc[ai][bj][m][n] = res;
                        }
                }
        }
        const float sc = is_q ? QSCALE : 1.0f;
#pragma unroll
        for (int ai = 0; ai < 2; ++ai)
#pragma unroll
            for (int m = 0; m < 4; ++m) {
                const int row = u.pm * 256 + 128 * ai + 64 * wr + 16 * m + fr;
                bf16_t* rowp = O + (size_t)row * 512 + colt + 32 * wc + 8 * fq;
#pragma unroll
                for (int bj = 0; bj < 2; ++bj) *(u32x4*)(rowp + bj * 128) = pack8(acc[ai][bj][m][0] * sc, acc[ai][bj][m][1] * sc);
            }
        if (is_k) {
#pragma unroll
            for (int bj = 0; bj < 2; ++bj)
#pragma unroll
                for (int n = 0; n < 2; ++n)
#pragma unroll
                    for (int e = 0; e < 4; ++e) {
                        float s = 0.f;
#pragma unroll
                        for (int ai = 0; ai < 2; ++ai)
#pragma unroll
                            for (int m = 0; m < 4; ++m) s += acc[ai][bj][m][n][e];
                        s += __shfl_xor(s, 1); s += __shfl_xor(s, 2); s += __shfl_xor(s, 4); s += __shfl_xor(s, 8);
                        if (fr == 0) atomicAdd(ksum + (size_t)u.pm * 512 + colt + 128 * bj + 32 * wc + 8 * fq + 4 * n + e, s);
                    }
        }
    }
};
struct EpiStore {
    static constexpr bool PERM = true, LDSX = false, MIDK = false;
    bf16_t* O; int ldc; float sc = 1.0f;
    __device__ __forceinline__ void operator()(f32x4 (&acc)[2][2][4][2], const Unit& u, int wr, int wc, int fr, int fq) const {
#pragma unroll
        for (int ai = 0; ai < 2; ++ai)
#pragma unroll
            for (int m = 0; m < 4; ++m) {
                const int row = u.pm * 256 + 128 * ai + 64 * wr + 16 * m + fr;
                bf16_t* rowp = O + (size_t)row * ldc + u.pn * 256 + 32 * wc + 8 * fq;
#pragma unroll
                for (int bj = 0; bj < 2; ++bj) *(u32x4*)(rowp + bj * 128) = pack8(acc[ai][bj][m][0] * sc, acc[ai][bj][m][1] * sc);
            }
    }
};
struct EpiStore8 {
    static constexpr bool PERM = true, LDSX = false, MIDK = false;
    unsigned char* O; int ldc; float sc;
    __device__ __forceinline__ void operator()(f32x4 (&acc)[2][2][4][2], const Unit& u, int wr, int wc, int fr, int fq) const {
#pragma unroll
        for (int ai = 0; ai < 2; ++ai)
#pragma unroll
            for (int m = 0; m < 4; ++m) {
                const int row = u.pm * 256 + 128 * ai + 64 * wr + 16 * m + fr;
                unsigned char* rowp = O + (size_t)row * ldc + u.pn * 256 + 32 * wc + 8 * fq;
#pragma unroll
                for (int bj = 0; bj < 2; ++bj) { const f32x4 a0 = acc[ai][bj][m][0] * sc, a1 = acc[ai][bj][m][1] * sc; u32x2 w; w.x = pk4_fp8(a0[0], a0[1], a0[2], a0[3]); w.y = pk4_fp8(a1[0], a1[1], a1[2], a1[3]); *(u32x2*)(rowp + bj * 128) = w; }
            }
    }
};
template <bool BASE_F32, bool KSPLIT> struct EpiResid {
    static constexpr bool PERM = true, LDSX = false, MIDK = KSPLIT;
    const void* base; bf16_t* hb; float* ssq; const float* ssql; const float* ssqa; unsigned char* h8; float asc; const float* rs0 = nullptr; const float* gmix = nullptr;
    __device__ __forceinline__ void stats(int row, int fq, float& rl, float& ra) const {
        const f32x4 pl = *(const f32x4*)(ssql + (size_t)row * 16 + 4 * fq); const f32x2 pa = *(const f32x2*)(ssqa + (size_t)row * 8 + 2 * fq);
        float sl = (pl[0] + pl[1]) + (pl[2] + pl[3]), sa = pa[0] + pa[1];
        sl += __shfl_xor(sl, 16); sl += __shfl_xor(sl, 32); sa += __shfl_xor(sa, 16); sa += __shfl_xor(sa, 32);
        rl = __builtin_amdgcn_rsqf(sl * (1.0f / 512.0f) + EPS); ra = __builtin_amdgcn_rsqf(sa * (1.0f / 512.0f) + EPS);
    }
    __device__ __forceinline__ void midk(f32x4 (&acc)[2][2][4][2], const Unit& u, int wr, int wc, int fr, int fq) const {
        asm volatile("" : "+v"(fr), "+v"(fq));
#pragma unroll
        for (int ai = 0; ai < 2; ++ai)
#pragma unroll
            for (int m = 0; m < 4; ++m) { float rl, ra; stats(u.pm * 256 + 128 * ai + 64 * wr + 16 * m + fr, fq, rl, ra); const float ratio = rl * __builtin_amdgcn_rcpf(ra);
#pragma unroll
                for (int bj = 0; bj < 2; ++bj)
#pragma unroll
                    for (int n = 0; n < 2; ++n) acc[ai][bj][m][n] *= ratio; }
    }
    __device__ __forceinline__ void operator()(f32x4 (&acc)[2][2][4][2], const Unit& u, int wr, int wc, int fr, int fq) const {
        f32x4 ginv[2][2];
        if constexpr (BASE_F32) {
#pragma unroll
            for (int bj = 0; bj < 2; ++bj)
#pragma unroll
                for (int n = 0; n < 2; ++n) { const f32x4 g = *(const f32x4*)(gmix + u.pn * 256 + 128 * bj + 32 * wc + 8 * fq + 4 * n);
                    ginv[bj][n] = (f32x4){__builtin_amdgcn_rcpf(g[0]), __builtin_amdgcn_rcpf(g[1]), __builtin_amdgcn_rcpf(g[2]), __builtin_amdgcn_rcpf(g[3])}; } }
#pragma unroll
        for (int ai = 0; ai < 2; ++ai)
#pragma unroll
            for (int m = 0; m < 4; ++m) {
                const int row = u.pm * 256 + 128 * ai + 64 * wr + 16 * m + fr; float q = 0.f, osc = asc, irs = 1.0f;
                if constexpr (KSPLIT) { float rl; stats(row, fq, rl, osc); osc *= asc; }
                if constexpr (BASE_F32) irs = __builtin_amdgcn_rcpf(rs0[row]);
#pragma unroll
                for (int bj = 0; bj < 2; ++bj) {
                    const int col = u.pn * 256 + 128 * bj + 32 * wc + 8 * fq;
                    f32x4 b0, b1;
                    if constexpr (BASE_F32) { const u32x4 w = *(const u32x4*)((const bf16_t*)base + (size_t)row * DM + col);
                        b0 = (f32x4){bflo(w.x), bfhi(w.x), bflo(w.y), bfhi(w.y)} * (ginv[bj][0] * irs); b1 = (f32x4){bflo(w.z), bfhi(w.z), bflo(w.w), bfhi(w.w)} * (ginv[bj][1] * irs); }
                    else { const u32x4 w = *(const u32x4*)((const bf16_t*)base + (size_t)row * LDH + col); b0 = (f32x4){bflo(w.x), bfhi(w.x), bflo(w.y), bfhi(w.y)}; b1 = (f32x4){bflo(w.z), bfhi(w.z), bflo(w.w), bfhi(w.w)}; }
                    const f32x4 v0 = b0 + acc[ai][bj][m][0] * osc, v1 = b1 + acc[ai][bj][m][1] * osc;
                    q += ((v0[0] * v0[0] + v0[1] * v0[1]) + (v0[2] * v0[2] + v0[3] * v0[3])) + ((v1[0] * v1[0] + v1[1] * v1[1]) + (v1[2] * v1[2] + v1[3] * v1[3]));
                    *(u32x4*)(hb + (size_t)row * LDH + col) = pack8(v0, v1);
                    if (h8) { u32x2 w8; w8.x = pk4_fp8(v0[0], v0[1], v0[2], v0[3]); w8.y = pk4_fp8(v1[0], v1[1], v1[2], v1[3]); *(u32x2*)(h8 + (size_t)row * DM + col) = w8; }
                }
                q += __shfl_xor(q, 16); q += __shfl_xor(q, 32);
                if (fq == 0) ssq[(size_t)row * 16 + u.pn * 4 + wc] = q;
            }
    }
};
#define XBAR() do { asm volatile("s_waitcnt lgkmcnt(0)" ::: "memory"); __builtin_amdgcn_s_barrier(); asm volatile("" ::: "memory"); } while (0)
struct EpiSoftmax {
    static constexpr bool PERM = true, LDSX = false, MIDK = false;
    unsigned char* O; int ldc; LAS unsigned char* xl; const float* ssq; float cs;
    __device__ __forceinline__ void operator()(f32x4 (&acc)[2][2][4][2], const Unit& u, int wr, int wc, int fr, int fq) const {
        LAS float* P = (LAS float*)xl;
        LAS float* Q = (LAS float*)(xl + 4096);
#pragma unroll
        for (int ai = 0; ai < 2; ++ai)
#pragma unroll
            for (int m = 0; m < 4; ++m) {
                float v = -INFINITY; const float sc = rstd_from_ssq(ssq, u.pm * 256 + 128 * ai + 64 * wr + 16 * m + fr) * cs;
#pragma unroll
                for (int bj = 0; bj < 2; ++bj)
#pragma unroll
                    for (int n = 0; n < 2; ++n) { const f32x4 x = acc[ai][bj][m][n] * sc; acc[ai][bj][m][n] = x; v = fmaxf(v, fmaxf(fmaxf(x[0], x[1]), fmaxf(x[2], x[3]))); }
                v = fmaxf(v, __shfl_xor(v, 16)); v = fmaxf(v, __shfl_xor(v, 32));
                if (fq == 0) P[(128 * ai + 64 * wr + 16 * m + fr) * 4 + wc] = v;
            }
        XBAR();
#pragma unroll
        for (int ai = 0; ai < 2; ++ai)
#pragma unroll
            for (int m = 0; m < 4; ++m) {
                const int r = 128 * ai + 64 * wr + 16 * m + fr;
                const float v = fmaxf(fmaxf(P[r * 4 + 0], P[r * 4 + 1]), fmaxf(P[r * 4 + 2], P[r * 4 + 3]));
                float s = 0.f;
#pragma unroll
                for (int bj = 0; bj < 2; ++bj)
#pragma unroll
                    for (int n = 0; n < 2; ++n) { f32x4 x = acc[ai][bj][m][n];
#pragma unroll
                        for (int e = 0; e < 4; ++e) { x[e] = __builtin_amdgcn_exp2f(x[e] - v); s += x[e]; }
                        acc[ai][bj][m][n] = x; }
                s += __shfl_xor(s, 16); s += __shfl_xor(s, 32);
                if (fq == 0) Q[r * 4 + wc] = s;
            }
        XBAR();
#pragma unroll
        for (int ai = 0; ai < 2; ++ai)
#pragma unroll
            for (int m = 0; m < 4; ++m) {
                const int r = 128 * ai + 64 * wr + 16 * m + fr;
                const float inv = PX_SC * __builtin_amdgcn_rcpf((Q[r * 4 + 0] + Q[r * 4 + 1]) + (Q[r * 4 + 2] + Q[r * 4 + 3]));
                unsigned char* rowp = O + (size_t)(u.pm * 256 + r) * ldc + u.pn * 256 + 32 * wc + 8 * fq;
#pragma unroll
                for (int bj = 0; bj < 2; ++bj) { const f32x4 a0 = acc[ai][bj][m][0] * inv, a1 = acc[ai][bj][m][1] * inv; u32x2 w; w.x = pk4_fp8(a0[0], a0[1], a0[2], a0[3]); w.y = pk4_fp8(a1[0], a1[1], a1[2], a1[3]); *(u32x2*)(rowp + bj * 128) = w; }
            }
        XBAR();
    }
};
struct EpiGateUp {
    static constexpr bool PERM = true, LDSX = false, MIDK = false;
    unsigned char* O; const float* lrs;
    __device__ __forceinline__ void operator()(f32x4 (&acc)[2][2][4][2], const Unit& u, int wr, int wc, int fr, int fq) const {
#pragma unroll
        for (int ai = 0; ai < 2; ++ai)
#pragma unroll
            for (int m = 0; m < 4; ++m) {
                const int r = 128 * ai + 64 * wr + 16 * m + fr, row = u.pm * 256 + r; const float rs = (r < u.nvalid) ? lrs[u.lbase + r] * (1.0f / WGU_SC) : 0.f;
                f32x4 o[2];
#pragma unroll
                for (int n = 0; n < 2; ++n)
#pragma unroll
                    for (int e = 0; e < 4; ++e) { const float g = acc[ai][0][m][n][e] * rs, up = acc[ai][1][m][n][e] * rs; o[n][e] = g * sigmoidf_(g) * up * ACT_SC; }
                u32x2 w8; w8.x = pk4_fp8(o[0][0], o[0][1], o[0][2], o[0][3]); w8.y = pk4_fp8(o[1][0], o[1][1], o[1][2], o[1][3]);
                *(u32x2*)(O + (size_t)row * DFF + u.pn * 128 + 32 * wc + 8 * fq) = w8;
            }
    }
};

struct Args { const float* in[27]; float* out; unsigned char* ws; int ph_lo, ph_hi; float invf[8]; };
struct Ctx { LAS unsigned char* lds; int tid, lane, wave, vcu, G; };

__device__ __forceinline__ void tr_load(f32x4 (&v)[8], const float* W, int ldw, int k0, int n0s, int lane) {
    const int kr = lane >> 3, ch = lane & 7;
#pragma unroll
    for (int i = 0; i < 8; ++i) v[i] = *(const f32x4*)(W + (size_t)(k0 + 8 * i + kr) * ldw + n0s + 4 * ch);
}
__device__ __forceinline__ void tr_finish(const f32x4 (&v)[8], int k0, bf16_t* WT, int ldt, int r0d, const float* gain, LAS float* scr, int lane) {
    const int kr = lane >> 3, ch = lane & 7, c = lane & 7;
    f32x4 g0 = {1.f, 1.f, 1.f, 1.f}, g1 = {1.f, 1.f, 1.f, 1.f};
    if (gain) { g0 = *(const f32x4*)(gain + k0 + 8 * c); g1 = *(const f32x4*)(gain + k0 + 8 * c + 4); }
#pragma unroll
    for (int i = 0; i < 8; ++i) { LAS float* d = scr + (8 * i + kr) * 33 + 4 * ch; d[0] = v[i][0]; d[1] = v[i][1]; d[2] = v[i][2]; d[3] = v[i][3]; }
    LDS_WAIT(); asm volatile("" ::: "memory");
#pragma unroll
    for (int j = 0; j < 4; ++j) { const int n = (lane >> 3) + 8 * j; const LAS float* s = scr + (8 * c) * 33 + n;
        u32x4 o; o.x = cvt_pk_bf16(s[0 * 33] * g0[0], s[1 * 33] * g0[1]); o.y = cvt_pk_bf16(s[2 * 33] * g0[2], s[3 * 33] * g0[3]); o.z = cvt_pk_bf16(s[4 * 33] * g1[0], s[5 * 33] * g1[1]); o.w = cvt_pk_bf16(s[6 * 33] * g1[2], s[7 * 33] * g1[3]);
        *(u32x4*)(WT + (size_t)(r0d + n) * ldt + k0 + 8 * c) = o; }
    LDS_WAIT(); asm volatile("" ::: "memory");
}
__device__ __forceinline__ void tr_finish8(const f32x4 (&v)[8], int k0, unsigned char* WT8, int ldt, int r0d, const float* gain, float sc, LAS float* scr, int lane) {
    const int kr = lane >> 3, ch = lane & 7, c = lane & 7;
    f32x4 g0 = {sc, sc, sc, sc}, g1 = {sc, sc, sc, sc};
    if (gain) { g0 = *(const f32x4*)(gain + k0 + 8 * c) * sc; g1 = *(const f32x4*)(gain + k0 + 8 * c + 4) * sc; }
#pragma unroll
    for (int i = 0; i < 8; ++i) { LAS float* d = scr + (8 * i + kr) * 33 + 4 * ch; d[0] = v[i][0]; d[1] = v[i][1]; d[2] = v[i][2]; d[3] = v[i][3]; }
    LDS_WAIT(); asm volatile("" ::: "memory");
#pragma unroll
    for (int j = 0; j < 4; ++j) { const int n = (lane >> 3) + 8 * j; const LAS float* s = scr + (8 * c) * 33 + n;
        u32x2 o; o.x = pk4_fp8(s[0 * 33] * g0[0], s[1 * 33] * g0[1], s[2 * 33] * g0[2], s[3 * 33] * g0[3]); o.y = pk4_fp8(s[4 * 33] * g1[0], s[5 * 33] * g1[1], s[6 * 33] * g1[2], s[7 * 33] * g1[3]);
        *(u32x2*)(WT8 + (size_t)(r0d + n) * ldt + k0 + 8 * c) = o; }
    LDS_WAIT(); asm volatile("" ::: "memory");
}
__device__ __forceinline__ void tr_item(const float* W, int ldw, int k0, int n0s, bf16_t* WT, int ldt, int r0d, const float* gain, LAS float* scr, int lane) {
    f32x4 v[8]; tr_load(v, W, ldw, k0, n0s, lane); tr_finish(v, k0, WT, ldt, r0d, gain, scr, lane);
}

__device__ __forceinline__ void rms_row2_to_bf16(const float* xrow, const float* gain, bf16_t* orow, int lane, float* rstd_out = nullptr) {
    const f32x4* xr = (const f32x4*)xrow + lane; const f32x4* gr = (const f32x4*)gain + lane;
    f32x4 v[2][4]; float s[2] = {0.f, 0.f};
#pragma unroll
    for (int r = 0; r < 2; ++r)
#pragma unroll
        for (int j = 0; j < 4; ++j) v[r][j] = xr[256 * r + 64 * j];
#pragma unroll
    for (int r = 0; r < 2; ++r)
#pragma unroll
        for (int j = 0; j < 4; ++j) s[r] += (v[r][j][0] * v[r][j][0] + v[r][j][1] * v[r][j][1]) + (v[r][j][2] * v[r][j][2] + v[r][j][3] * v[r][j][3]);
#pragma unroll
    for (int r = 0; r < 2; ++r) { const float rstd = 1.0f / sqrtf(wave_sum(s[r]) * (1.0f / DM) + EPS); u32x2* o8 = (u32x2*)(orow + (size_t)r * DM) + lane; if (rstd_out && lane == 0) rstd_out[r] = rstd;
#pragma unroll
        for (int j = 0; j < 4; ++j) { const f32x4 g = gr[64 * j]; u32x2 w; w.x = cvt_pk_bf16(v[r][j][0] * rstd * g[0], v[r][j][1] * rstd * g[1]); w.y = cvt_pk_bf16(v[r][j][2] * rstd * g[2], v[r][j][3] * rstd * g[3]); o8[64 * j] = w; } }
}

__device__ __forceinline__ void conv_wdn(const Args& a, const Ctx& C, int gw, int NGW, int it_lo, int NIT) {
    LAS float* scr = (LAS float*)(C.lds + C.wave * 16384); const int lane = C.lane;
    f32x4 va[8], vb[8];
#define WDN_LOAD(v, it) do { const int e_ = (it) / 256, r_ = (it) % 256; tr_load(v, a.in[25] + (size_t)e_ * DFF * DM, DM, 64 * (r_ / 32), 32 * (r_ % 32), lane); } while (0)
#define WDN_FIN(v, it) do { const int e_ = (it) / 256, r_ = (it) % 256; tr_finish8(v, 64 * (r_ / 32), a.ws + WS_WDN, DFF, e_ * 1024 + 32 * (r_ % 32), nullptr, WDN_SC, scr, lane); } while (0)
    int it = it_lo + gw; if (it < NIT) WDN_LOAD(va, it);
    for (; it < NIT; it += 2 * NGW) {
        const int it1 = it + NGW, it2 = it + 2 * NGW;
        if (it1 < NIT) WDN_LOAD(vb, it1);
        WDN_FIN(va, it);
        if (it2 < NIT) WDN_LOAD(va, it2);
        if (it1 < NIT) WDN_FIN(vb, it1);
    }
#undef WDN_LOAD
#undef WDN_FIN
}
__device__ __forceinline__ void ph_prologue(const Args& a, const Ctx& C) {
    unsigned char* ws = a.ws;
    LAS float* scr = (LAS float*)(C.lds + C.wave * 16384);
    const int gw = C.vcu * 8 + C.wave, NGW = C.G * 8, lane = C.lane;
    for (int it = gw; it < 16 * 80; it += NGW) { const int kb = it / 80, nb = it % 80; tr_item(a.in[3], DIN, 64 * kb, 32 * nb, (bf16_t*)(ws + WS_WIN), DM, 32 * nb, nullptr, scr, lane); }
    for (int it = gw; it < 16 * 64; it += NGW) { const int kb = it / 64, nb = it % 64;
        if (nb < 32) tr_item(a.in[17], 2 * DM, 64 * kb, 32 * nb, (bf16_t*)(ws + WS_WXK), DM, 32 * nb, nullptr, scr, lane);
        else tr_item(a.in[17], 2 * DM, 64 * kb, 32 * nb, (bf16_t*)(ws + WS_WXV), DM, 32 * (nb - 32), nullptr, scr, lane); }
    for (int it = gw; it < 16 * 32; it += NGW) { const int kb = it / 32, nb = it % 32;
        tr_item(a.in[13], DM, 64 * kb, 32 * nb, (bf16_t*)(ws + WS_WOUT), DM, 32 * nb, (kb < 8) ? a.in[11] : (a.in[12] - DLRU), scr, lane);
        tr_item(a.in[18], DM, 64 * kb, 32 * nb, (bf16_t*)(ws + WS_WXO), DM, 32 * nb, nullptr, scr, lane); }
    for (int r = gw; r < DM; r += NGW) { const float gk = a.in[14][r]; const f32x4* src = (const f32x4*)(a.in[16] + (size_t)r * DM) + lane; u32x2* dst = (u32x2*)((bf16_t*)(ws + WS_WXQ) + (size_t)r * DM) + lane;
#pragma unroll
        for (int j = 0; j < 4; ++j) { const f32x4 v = src[64 * j]; u32x2 w; w.x = cvt_pk_bf16(v[0] * gk, v[1] * gk); w.y = cvt_pk_bf16(v[2] * gk, v[3] * gk); dst[64 * j] = w; } }
    { bf16_t* WR = (bf16_t*)(ws + WS_WR); const int gt = C.vcu * 512 + C.tid, NT = C.G * 512;
      for (int i = gt; i < 48 * DM; i += NT) { const int r = i / DM, k = i % DM; float v = 0.f;
          if (r < 4) v = a.in[20][k * NGRP + r] * a.in[19][k]; else if (r < 36) v = a.in[22][k * NEXP + (r - 4)] * a.in[19][k];
          WR[i] = (bf16_t)(cvt_pk_bf16(v, 0.f) & 0xffffu); }
      float* rope = (float*)(ws + WS_ROPE);
      for (int i = gt; i < SEQ * 8; i += NT) { const int pos = i >> 3, j = i & 7; const float ang = (float)pos * a.invf[j];
          const double tw = 6.283185307179586476925286766559; const double ad = (double)ang; const double red = ad - tw * __builtin_rint(ad / tw); const float rf = (float)red;
          rope[pos * 16 + j] = __cosf(rf); rope[pos * 16 + 8 + j] = __sinf(rf); } }
    for (int m = 2 * gw; m < NTOK; m += 2 * NGW) rms_row2_to_bf16(a.in[0] + (size_t)m * DM, a.in[2], (bf16_t*)(ws + WS_B) + (size_t)m * DM, lane, (float*)(ws + WS_TOK + TOK_D) + m);
    for (int m = 2 * gw; m < NMEM; m += 2 * NGW) rms_row2_to_bf16(a.in[1] + (size_t)m * DM, a.in[15], (bf16_t*)(ws + WS_MEMN) + (size_t)m * DM, lane);
}

__device__ __forceinline__ float gelu_tanh(float x) { const float x2 = x * x; const float z2 = x * (-2.0f * 0.7978845608028654f * 1.4426950408889634f) * (1.0f + 0.044715f * x2);
    return x * __builtin_amdgcn_rcpf(1.0f + __builtin_amdgcn_exp2f(z2)); }
__device__ __forceinline__ bool moe_item_load(f32x4 (&v)[8], const Args& a, int s, int lane) {
    if (s < NEXP * 512) { const int e = s / 512, r = s % 512, kb = r / 32, nb = r % 32, j = nb >> 3, half = (nb >> 2) & 1, q = nb & 3;
        tr_load(v, a.in[24] + (size_t)e * DM * DM, DM, 64 * kb, half * 512 + j * 128 + q * 32, lane); return true; }
    const int it = s - NEXP * 512 + WDN_SPLIT; if (it >= NEXP * 256) return false;
    const int e = it / 256, r = it % 256; tr_load(v, a.in[25] + (size_t)e * DFF * DM, DM, 64 * (r / 32), 32 * (r % 32), lane); return true;
}
__device__ __forceinline__ void moe_item_finish(const f32x4 (&v)[8], const Args& a, int s, LAS float* scr, int lane) {
    if (s < NEXP * 512) { const int e = s / 512, r = s % 512, kb = r / 32, nb = r % 32, j = nb >> 3, half = (nb >> 2) & 1, q = nb & 3;
        tr_finish8(v, 64 * kb, a.ws + WS_WGU, DM, e * 1024 + j * 256 + half * 128 + q * 32, a.in[19], WGU_SC, scr, lane); return; }
    const int it = s - NEXP * 512 + WDN_SPLIT; const int e = it / 256, r = it % 256;
    tr_finish8(v, 64 * (r / 32), a.ws + WS_WDN, DFF, e * 1024 + 32 * (r % 32), nullptr, WDN_SC, scr, lane);
}
__device__ __forceinline__ void lru_unit(const Args& a, const Ctx& C, int b, int blk, int half, int L) {
    unsigned char* ws = a.ws;
    const bf16_t* XL = (const bf16_t*)(ws + WS_A); const bf16_t* GL = XL + (size_t)NTOK * 512; bf16_t* YC = (bf16_t*)(ws + WS_C); float* SSQL = (float*)(ws + WS_SSQL);
    const int tid = C.tid, lane = C.lane, wave = C.wave, fr = lane & 15, fq = lane >> 4;
    LAS float* cscr = (LAS float*)(C.lds + 46336 + wave * 8448);
    LAS float* XW = (LAS float*)(C.lds + wave * 5120);
    LAS bf16_t* GW = (LAS bf16_t*)(C.lds + wave * 5120 + 2304);
    LAS bf16_t* YW = (LAS bf16_t*)(C.lds + wave * 5120 + 3584);
    LAS float* WSUM = (LAS float*)(C.lds + 40960);
    LAS float* CW = (LAS float*)(C.lds + 45056);
    const int c0 = blk * 64, oc0 = c0 + half * 32;
    bf16x8 wfr[2][2][2];
#pragma unroll
    for (int gt = 0; gt < 2; ++gt) { const float* W = a.in[gt == 0 ? 6 : 8] + (size_t)blk * 64 * 64;
#pragma unroll
        for (int nt = 0; nt < 2; ++nt)
#pragma unroll
            for (int ks = 0; ks < 2; ++ks) { u32x4 w; float f[8];
#pragma unroll
                for (int j = 0; j < 8; ++j) f[j] = W[(32 * ks + 8 * fq + j) * 64 + half * 32 + 16 * nt + fr];
                w.x = cvt_pk_bf16(f[0], f[1]); w.y = cvt_pk_bf16(f[2], f[3]); w.z = cvt_pk_bf16(f[4], f[5]); w.w = cvt_pk_bf16(f[6], f[7]);
                wfr[gt][nt][ks] = __builtin_bit_cast(bf16x8, w); } }
    LAS bf16x8* WF = (LAS bf16x8*)(C.lds + 113920);
    if (wave == 0) {
#pragma unroll
        for (int gt = 0; gt < 2; ++gt)
#pragma unroll
            for (int nt = 0; nt < 2; ++nt)
#pragma unroll
                for (int ks = 0; ks < 2; ++ks) WF[((gt * 2 + nt) * 2 + ks) * 64 + lane] = wfr[gt][nt][ks]; }
    float brg[2], big[2], sp[2], hc[2] = {0.f, 0.f};
#pragma unroll
    for (int nt = 0; nt < 2; ++nt) { const int ch = oc0 + 16 * nt + fr; brg[nt] = a.in[7][ch] * -1.4426950408889634f; big[nt] = a.in[9][ch] * -1.4426950408889634f; const float lam = a.in[10][ch];
        sp[nt] = -8.0f * 1.4426950408889634f * ((lam > 15.f) ? __expf(-lam) : log1pf(__expf(-lam))); }
    if (tid < 320) { const int k = tid >> 6, c = tid & 63; CW[tid] = (k < 4) ? a.in[4][k * DLRU + c0 + c] : a.in[5][c0 + c]; }
    u32x4 xr1[4][2], gr1;
    const bf16_t* xrow0 = XL + ((size_t)b * SEQ + 16 * wave + fr) * 512 + c0 + 8 * fq;
    const bf16_t* grow0 = GL + ((size_t)b * SEQ + 16 * wave + (lane >> 2)) * 512 + oc0 + 8 * (lane & 3);
    const int tloc = 16 * wave + fr;
#define LRU_PREFETCH(t0_, xr, gr) do { _Pragma("unroll") for (int k = 0; k < 4; ++k) { const int tt = (t0_) + tloc - 3 + k; \
        if (tt >= 0) { const bf16_t* xp = xrow0 + (ptrdiff_t)((t0_) - 3 + k) * 512; xr[k][0] = *(const u32x4*)xp; xr[k][1] = *(const u32x4*)(xp + 32); } else { xr[k][0] = (u32x4){0u, 0u, 0u, 0u}; xr[k][1] = (u32x4){0u, 0u, 0u, 0u}; } } \
        gr = *(const u32x4*)(grow0 + (size_t)(t0_) * 512); } while (0)
    LRU_PREFETCH(0, xr1, gr1);
    __syncthreads();
    for (int ch2 = 0; ch2 < SEQ / 256; ++ch2) {
#pragma unroll
      for (int sub = 0; sub < 2; ++sub) { const int ch = 2 * ch2 + sub, t0 = ch * 128; auto& xr = xr1; auto& gr = gr1;
        f32x4 cv[8]; const int cslot = sub * (NEXP * 512) + (ch2 * 256 + L) * 8 + wave; const bool chas = moe_item_load(cv, a, cslot, lane);
        bf16x8 af[2];
#pragma unroll
        for (int ks = 0; ks < 2; ++ks) { float accv[8];
            { const f32x4 b0 = *(const LAS f32x4*)(CW + 256 + 32 * ks + 8 * fq), b1 = *(const LAS f32x4*)(CW + 256 + 32 * ks + 8 * fq + 4);
              accv[0] = b0[0]; accv[1] = b0[1]; accv[2] = b0[2]; accv[3] = b0[3]; accv[4] = b1[0]; accv[5] = b1[1]; accv[6] = b1[2]; accv[7] = b1[3]; }
#pragma unroll
            for (int k = 0; k < 4; ++k) { const f32x4 w0 = *(const LAS f32x4*)(CW + 64 * k + 32 * ks + 8 * fq), w1 = *(const LAS f32x4*)(CW + 64 * k + 32 * ks + 8 * fq + 4); const u32x4 x = xr[k][ks];
                accv[0] += w0[0] * bflo(x.x); accv[1] += w0[1] * bfhi(x.x); accv[2] += w0[2] * bflo(x.y); accv[3] += w0[3] * bfhi(x.y);
                accv[4] += w1[0] * bflo(x.z); accv[5] += w1[1] * bfhi(x.z); accv[6] += w1[2] * bflo(x.w); accv[7] += w1[3] * bfhi(x.w); }
            u32x4 p; p.x = cvt_pk_bf16(accv[0], accv[1]); p.y = cvt_pk_bf16(accv[2], accv[3]); p.z = cvt_pk_bf16(accv[4], accv[5]); p.w = cvt_pk_bf16(accv[6], accv[7]);
            af[ks] = __builtin_bit_cast(bf16x8, p);
            if (ks == half) { *(LAS f32x4*)(XW + fr * 36 + 8 * fq) = (f32x4){accv[0], accv[1], accv[2], accv[3]}; *(LAS f32x4*)(XW + fr * 36 + 8 * fq + 4) = (f32x4){accv[4], accv[5], accv[6], accv[7]}; } }
        *(LAS u32x4*)(GW + (lane >> 2) * 40 + 8 * (lane & 3)) = gr;
        if (ch + 1 < SEQ / 128) LRU_PREFETCH(t0 + 128, xr, gr);
        LDS_WAIT(); asm volatile("" ::: "memory");
        float Hl[2][4], Al[2][4], Aex[2], Hex[2];
        { f32x4 ar[2] = {{0.f, 0.f, 0.f, 0.f}, {0.f, 0.f, 0.f, 0.f}}, ai_[2] = {{0.f, 0.f, 0.f, 0.f}, {0.f, 0.f, 0.f, 0.f}};
#pragma unroll
          for (int ks = 0; ks < 2; ++ks)
#pragma unroll
              for (int nt = 0; nt < 2; ++nt) { ar[nt] = __builtin_amdgcn_mfma_f32_16x16x32_bf16(af[ks], WF[((0 * 2 + nt) * 2 + ks) * 64 + lane], ar[nt], 0, 0, 0); ai_[nt] = __builtin_amdgcn_mfma_f32_16x16x32_bf16(af[ks], WF[((1 * 2 + nt) * 2 + ks) * 64 + lane], ai_[nt], 0, 0, 0); }
#pragma unroll
          for (int nt = 0; nt < 2; ++nt) {
              float hrun = 0.f, arun = 1.f;
#pragma unroll
              for (int r = 0; r < 4; ++r) { const int chn = 16 * nt + fr;
                  const float rg = __builtin_amdgcn_rcpf(1.0f + __builtin_amdgcn_exp2f(__builtin_fmaf(ar[nt][r], -1.4426950408889634f, brg[nt])));
                  const float ig = __builtin_amdgcn_rcpf(1.0f + __builtin_amdgcn_exp2f(__builtin_fmaf(ai_[nt][r], -1.4426950408889634f, big[nt])));
                  const float av = __builtin_amdgcn_exp2f(rg * sp[nt]); const float mult = __builtin_amdgcn_sqrtf(fmaxf(1.0f - av * av, 0.f));
                  const float uv = mult * ig * XW[(4 * fq + r) * 36 + chn];
                  hrun = av * hrun + uv; arun *= av; Hl[nt][r] = hrun; Al[nt][r] = arun; }
              const float A0 = __shfl(arun, fr), H0 = __shfl(hrun, fr), A1 = __shfl(arun, fr + 16), H1 = __shfl(hrun, fr + 16), A2 = __shfl(arun, fr + 32), H2 = __shfl(hrun, fr + 32), A3 = __shfl(arun, fr + 48), H3 = __shfl(hrun, fr + 48);
              const float h01 = A1 * H0 + H1, a01 = A1 * A0, h012 = A2 * h01 + H2, a012 = A2 * a01;
              Aex[nt] = (fq == 0) ? 1.f : (fq == 1) ? A0 : (fq == 2) ? a01 : a012;
              Hex[nt] = (fq == 0) ? 0.f : (fq == 1) ? H0 : (fq == 2) ? h01 : h012;
              if (fq == 0) *(LAS f32x2*)(WSUM + (((ch & 1) * 8 + wave) * 32 + 16 * nt + fr) * 2) = (f32x2){A3 * a012, A3 * h012 + H3}; } }
        __syncthreads();
        { float ssr[4] = {0.f, 0.f, 0.f, 0.f};
#pragma unroll
          for (int nt = 0; nt < 2; ++nt) { const int chn = 16 * nt + fr; float x = hc[nt], mine = 0.f;
#pragma unroll
              for (int w2 = 0; w2 < 8; ++w2) { const f32x2 sm = *(const LAS f32x2*)(WSUM + (((ch & 1) * 8 + w2) * 32 + chn) * 2); if (w2 == wave) mine = x; x = sm[0] * x + sm[1]; }
              hc[nt] = x;
              const float hstart = Aex[nt] * mine + Hex[nt];
#pragma unroll
              for (int r = 0; r < 4; ++r) { const int tl = 4 * fq + r; const float h = Al[nt][r] * hstart + Hl[nt][r];
                  const float y = h * gelu_tanh(bf2f(GW[tl * 40 + chn])); const unsigned yb = cvt_pk_bf16(y, 0.f) & 0xffffu; YW[tl * 40 + chn] = (bf16_t)yb;
                  const float yr = __uint_as_float(yb << 16); ssr[r] += yr * yr; } }
#pragma unroll
          for (int r = 0; r < 4; ++r) { float q = ssr[r]; q += __shfl_xor(q, 1); q += __shfl_xor(q, 2); q += __shfl_xor(q, 4); q += __shfl_xor(q, 8);
              if (fr == 0) SSQL[((size_t)b * SEQ + t0 + 16 * wave + 4 * fq + r) * 16 + blk * 2 + half] = q; } }
        LDS_WAIT(); asm volatile("" ::: "memory");
        *(u32x4*)(YC + ((size_t)b * SEQ + t0 + 16 * wave + (lane >> 2)) * DM + oc0 + 8 * (lane & 3)) = *(const LAS u32x4*)(YW + (lane >> 2) * 40 + 8 * (lane & 3));
        if (chas) moe_item_finish(cv, a, cslot, cscr, lane);
      }
    }
#undef LRU_PREFETCH
    __syncthreads();
}


__device__ __forceinline__ void ph_router(const Args& a, const Ctx& C) {
    unsigned char* ws = a.ws;
    const bf16_t* H2B = (const bf16_t*)a.out + DM; const bf16_t* WR = (const bf16_t*)(ws + WS_WR); const float* SSQ2 = (const float*)(ws + WS_SSQ2);
    unsigned* CNT = (unsigned*)(ws + WS_CTL) + CW_CNT;
    int* TOKE = (int*)(ws + WS_TOK + TOK_E); int* TOKR = (int*)(ws + WS_TOK + TOK_R); float* TOKG = (float*)(ws + WS_TOK + TOK_G); int* LTOK = (int*)(ws + WS_LTOK); float* LRS = (float*)(ws + WS_LRS);
    constexpr int WRS = 1032;
    LAS bf16_t* WRL = (LAS bf16_t*)C.lds;
    LAS float* LG = (LAS float*)(C.lds + 99072) + C.wave * (16 * 49);
    LAS unsigned* lcnt = (LAS unsigned*)(C.lds + 99072 + 25088); LAS unsigned* lbase = lcnt + 32;
    const int lane = C.lane, fr = lane & 15, fq = lane >> 4;
    for (int i = C.tid; i < 48 * 128; i += 512) { const int r = i >> 7, c8 = i & 127; *(LAS u32x4*)(WRL + r * WRS + 8 * c8) = *(const u32x4*)(WR + (size_t)r * DM + 8 * c8); }
    for (int pass = 0; (pass * C.G) * 128 < NTOK; ++pass) {
        const int blk = pass * C.G + C.vcu; const bool live = blk * 128 < NTOK;
        if (C.tid < 32) lcnt[C.tid] = 0u;
        __syncthreads();
        int E1 = 0, E2 = 0; unsigned r1 = 0, r2 = 0; float ga = 0.f, gb = 0.f, rstd_t = 0.f; const int tb = blk * 128 + 16 * C.wave;
        if (live) {
            f32x4 acc[3] = {{0.f, 0.f, 0.f, 0.f}, {0.f, 0.f, 0.f, 0.f}, {0.f, 0.f, 0.f, 0.f}};
            bf16x8 af[32];
#pragma unroll
            for (int ks = 0; ks < 32; ++ks) af[ks] = *(const bf16x8*)(H2B + (size_t)(tb + fr) * LDH + 32 * ks + 8 * fq);
#pragma unroll
            for (int ks = 0; ks < 32; ++ks) {
#pragma unroll
                for (int nt = 0; nt < 3; ++nt) { const bf16x8 bfg = *(const LAS bf16x8*)(WRL + (16 * nt + fr) * WRS + 32 * ks + 8 * fq); acc[nt] = __builtin_amdgcn_mfma_f32_16x16x32_bf16(af[ks], bfg, acc[nt], 0, 0, 0); } }
#pragma unroll
            for (int nt = 0; nt < 3; ++nt)
#pragma unroll
                for (int r = 0; r < 4; ++r) LG[(4 * fq + r) * 49 + 16 * nt + fr] = acc[nt][r];
            LDS_WAIT(); asm volatile("" ::: "memory");
            if (lane < 16) { const int t = tb + lane; const float rstd = rstd_from_ssq(SSQ2, t); rstd_t = rstd; const LAS float* lg = LG + lane * 49;
                float g[4]; int grp = 0;
#pragma unroll
                for (int i = 0; i < 4; ++i) g[i] = lg[i] * rstd + a.in[21][i];
#pragma unroll
                for (int i = 1; i < 4; ++i) if (g[i] > g[grp]) grp = i;
                float gs = 0.f;
#pragma unroll
                for (int i = 0; i < 4; ++i) gs += __expf(g[i] - g[grp]);
                const float gw_ = 1.0f / gs;
                float e[8];
#pragma unroll
                for (int i = 0; i < 8; ++i) e[i] = lg[4 + 8 * grp + i] * rstd + a.in[23][8 * grp + i];
                int i1 = 0;
#pragma unroll
                for (int i = 1; i < 8; ++i) if (e[i] > e[i1]) i1 = i;
                int i2 = (i1 == 0) ? 1 : 0;
#pragma unroll
                for (int i = 0; i < 8; ++i) if (i != i1 && i != i2 && e[i] > e[i2]) i2 = i;
                const float eb = __expf(e[i2] - e[i1]); ga = gw_ / (1.0f + eb); gb = gw_ * eb / (1.0f + eb);
                E1 = grp * 8 + i1; E2 = grp * 8 + i2;
                r1 = atomicAdd((unsigned*)&lcnt[E1], 1u); r2 = atomicAdd((unsigned*)&lcnt[E2], 1u);
            }
        }
        __syncthreads();
        if (C.tid < 32) lbase[C.tid] = lcnt[C.tid] ? __hip_atomic_fetch_add(CNT + C.tid, lcnt[C.tid], __ATOMIC_RELAXED, __HIP_MEMORY_SCOPE_AGENT) : 0u;
        __syncthreads();
        if (live && lane < 16) { const int t = tb + lane;
            const int k1 = (int)(lbase[E1] + r1), k2 = (int)(lbase[E2] + r2);
            TOKE[2 * t] = E1; TOKR[2 * t] = k1; TOKG[2 * t] = ga; LTOK[E1 * LCAP + k1] = t; LRS[E1 * LCAP + k1] = rstd_t;
            TOKE[2 * t + 1] = E2; TOKR[2 * t + 1] = k2; TOKG[2 * t + 1] = gb; LTOK[E2 * LCAP + k2] = t; LRS[E2 * LCAP + k2] = rstd_t; }
        __syncthreads();
    }
}
__device__ __forceinline__ void moe_table(const Args& a, const Ctx& C) {
    LAS int* ts = (LAS int*)(C.lds + MOE_OFF);
    if (C.tid == 0) { const unsigned* CNT = (const unsigned*)(a.ws + WS_CTL) + CW_CNT; int acc = 0;
        for (int e = 0; e < NEXP; ++e) { ts[e] = acc; const unsigned c = __hip_atomic_load(CNT + e, __ATOMIC_RELAXED, __HIP_MEMORY_SCOPE_AGENT); ts[33 + e] = (int)c; acc += (int)((c + 255u) >> 8); }
        ts[NEXP] = acc; }
    __syncthreads();
}
__device__ __forceinline__ void ph_final(const Args& a, const Ctx& C, float* outp) {
    unsigned char* ws = a.ws;
    const unsigned char* YB = ws + WS_A; const float* TOKG = (const float*)(ws + WS_TOK + TOK_G); const int* TOKE = (const int*)(ws + WS_TOK + TOK_E); const int* TOKR = (const int*)(ws + WS_TOK + TOK_R);
    const LAS int* ts = (const LAS int*)(C.lds + MOE_OFF);
    const bf16_t* H2B = (const bf16_t*)a.out + DM; const float* gf = a.in[26];
    const int gw = C.vcu * 8 + C.wave, NGW = C.G * 8, lane = C.lane;
    f32x4 gn[4];
#pragma unroll
    for (int q = 0; q < 4; ++q) gn[q] = *(const f32x4*)(gf + 512 * (q >> 1) + 8 * lane + 4 * (q & 1));
    const int nit = (NTOK + NGW - 1) / NGW;
    int dnx = 0; float gnx = 0.f;
#define FIN_IDX(ib) do { const int tt_ = gw + ((ib) + (lane >> 1)) * NGW; dnx = 0; gnx = 0.f; \
        if (lane < 8 && tt_ < NTOK) { const int e_ = TOKE[2 * tt_ + (lane & 1)]; dnx = ts[e_] * 256 + TOKR[2 * tt_ + (lane & 1)]; gnx = TOKG[2 * tt_ + (lane & 1)]; } } while (0)
    FIN_IDX(0);
    for (int ib = 0; ib < nit; ib += 4) {
        const int dcur = dnx; const float gcur = gnx;
        if (ib + 4 < nit) FIN_IDX(ib + 4);
        u32x4 hw[4][2]; u32x2 y0[4][2], y1[4][2];
#pragma unroll
        for (int j = 0; j < 4; ++j) { const int t = gw + (ib + j) * NGW; const int d0 = __builtin_amdgcn_readlane(dcur, 2 * j), d1 = __builtin_amdgcn_readlane(dcur, 2 * j + 1);
            if (t < NTOK) {
#pragma unroll
                for (int hf = 0; hf < 2; ++hf) { hw[j][hf] = *((const u32x4*)(H2B + (size_t)t * LDH + 512 * hf) + lane); y0[j][hf] = *((const u32x2*)(YB + (size_t)d0 * DM + 512 * hf) + lane); y1[j][hf] = *((const u32x2*)(YB + (size_t)d1 * DM + 512 * hf) + lane); } } }
#pragma unroll
        for (int j = 0; j < 4; ++j) { const int t = gw + (ib + j) * NGW;
            const float g0 = __builtin_bit_cast(float, __builtin_amdgcn_readlane(__builtin_bit_cast(int, gcur), 2 * j)) * (1.0f / YB_SC), g1 = __builtin_bit_cast(float, __builtin_amdgcn_readlane(__builtin_bit_cast(int, gcur), 2 * j + 1)) * (1.0f / YB_SC);
            if (t < NTOK) { float v[16]; float s2 = 0.f;
#pragma unroll
                for (int hf = 0; hf < 2; ++hf)
#pragma unroll
                    for (int w = 0; w < 2; ++w) { const int yw0 = (int)y0[j][hf][w], yw1 = (int)y1[j][hf][w];
                        const f32x2 pa = __builtin_amdgcn_cvt_pk_f32_fp8(yw0, false), pb = __builtin_amdgcn_cvt_pk_f32_fp8(yw0, true), qa = __builtin_amdgcn_cvt_pk_f32_fp8(yw1, false), qb = __builtin_amdgcn_cvt_pk_f32_fp8(yw1, true);
                        const unsigned ha = hw[j][hf][2 * w], hb = hw[j][hf][2 * w + 1];
                        const float e0 = bflo(ha) + g0 * pa[0] + g1 * qa[0], e1 = bfhi(ha) + g0 * pa[1] + g1 * qa[1], e2 = bflo(hb) + g0 * pb[0] + g1 * qb[0], e3 = bfhi(hb) + g0 * pb[1] + g1 * qb[1];
                        v[8 * hf + 4 * w] = e0; v[8 * hf + 4 * w + 1] = e1; v[8 * hf + 4 * w + 2] = e2; v[8 * hf + 4 * w + 3] = e3; s2 += (e0 * e0 + e1 * e1) + (e2 * e2 + e3 * e3); }
                const float rstd = __builtin_amdgcn_rsqf(wave_sum(s2) * (1.0f / DM) + EPS);
#pragma unroll
                for (int q = 0; q < 4; ++q) { const f32x4 o = {v[4 * q] * rstd * gn[q][0], v[4 * q + 1] * rstd * gn[q][1], v[4 * q + 2] * rstd * gn[q][2], v[4 * q + 3] * rstd * gn[q][3]};
                    *(f32x4*)(outp + (size_t)t * DM + 512 * (q >> 1) + 8 * lane + 4 * (q & 1)) = o; } } }
    }
#undef FIN_IDX
}

#include <hip/hip_bf16.h>
#include <cmath>
namespace attn_body {
using bf16=__hip_bfloat16;
using bf16x8=__attribute__((ext_vector_type(8)))short;
using s16x4=__attribute__((ext_vector_type(4)))short;
using f32x16=__attribute__((ext_vector_type(16)))float;
using u32x4=__attribute__((ext_vector_type(4)))unsigned;
using f32x4_t=__attribute__((ext_vector_type(4)))float;
constexpr int BATCH=16,NHEAD=8,SEQ=2048,D=64,DM=NHEAD*D,DMO=1024;
constexpr int NW=8,QBLK=32,QB=QBLK*NW,KVBLK=64,NQB=SEQ/QB;
constexpr int ATTN_PITCH=DM, ATTN_UNIT_ROWS=QB;
__device__ __forceinline__ int crow(int r,int hi){return (r&3)+8*(r>>2)+4*hi;}
#define SBAR() __builtin_amdgcn_sched_barrier(0)
__device__ __forceinline__ void cmask(f32x16&p0,f32x16&p1,int jb,int qrel,int hi){
  const float NEG=-INFINITY; int kb=64*jb+4*hi; asm volatile("":"+v"(kb));
  #pragma unroll
  for(int r=0;r<16;++r){int kv=kb+(r&3)+8*(r>>2); if(kv>qrel)p0[r]=NEG; if(kv+32>qrel)p1[r]=NEG;}
}

constexpr int NSLOT=3, SLOTB=8192;
constexpr int LDS_K=0, LDS_V=NSLOT*SLOTB, LDS_WS=2*NSLOT*SLOTB, LDS_OST=LDS_WS+NW*64*4, LDS_BYTES=LDS_OST+NW*4096;
constexpr float C2=0.125f*1.4426950408889634f;
__device__ __forceinline__ void glds16(const char*sbase,unsigned voff,unsigned lds_dst){unsigned keep;
  asm volatile("s_nop 4\n\ts_mov_b32 %0, m0\n\ts_mov_b32 m0, %3\n\ts_nop 0\n\tglobal_load_lds_dwordx4 %1, %2\n\ts_mov_b32 m0, %0":"=&s"(keep):"v"(voff),"s"(sbase),"s"(lds_dst):"memory");}
__device__ __forceinline__ const char* uni_ptr(const void*p){const unsigned long long v=(unsigned long long)p;const unsigned lo=__builtin_amdgcn_readfirstlane((unsigned)v),hi=__builtin_amdgcn_readfirstlane((unsigned)(v>>32));return (const char*)(((unsigned long long)hi<<32)|lo);}
__device__ __forceinline__ float max3f(float a,float b,float c){float r;asm("v_max3_f32 %0, %1, %2, %3":"=v"(r):"v"(a),"v"(b),"v"(c));return r;}
__device__ __forceinline__ float max2f(float a,float b){float r;asm("v_max_f32_e32 %0, %1, %2":"=v"(r):"v"(a),"v"(b));return r;}
__device__ __forceinline__ float fadd_s(float a,float b){float r;asm("v_add_f32_e32 %0, %1, %2":"=v"(r):"v"(a),"v"(b));return r;}
__device__ __forceinline__ float fsub_s(float a,float b){float r;asm("v_sub_f32_e32 %0, %1, %2":"=v"(r):"v"(a),"v"(b));return r;}
typedef float f32x2_t __attribute__((ext_vector_type(2))); typedef __bf16 bf16x2_t __attribute__((ext_vector_type(2)));
__device__ __forceinline__ unsigned cvtpk_s(float lo,float hi){f32x2_t v={lo,hi};bf16x2_t b=__builtin_convertvector(v,bf16x2_t);return __builtin_bit_cast(unsigned,b);}
#define WAIT_BAR(N) asm volatile("s_waitcnt vmcnt(" #N ") lgkmcnt(0)\n\ts_barrier":::"memory")

__device__ __forceinline__ void qkt(f32x16&p0,f32x16&p1,const char*Kslot,const bf16x8*qr,const f32x16&negm,int r32,int hi){
  const char*kb=Kslot+hi*1024+r32*16;
  #pragma unroll
  for(int d0=0;d0<4;++d0){
    const bf16x8 b0=*reinterpret_cast<const bf16x8*>(kb+d0*2048);
    const bf16x8 b1=*reinterpret_cast<const bf16x8*>(kb+d0*2048+512);
    if(d0==0){p0=__builtin_amdgcn_mfma_f32_32x32x16_bf16(b0,qr[0],negm,0,0,0);p1=__builtin_amdgcn_mfma_f32_32x32x16_bf16(b1,qr[0],negm,0,0,0);}
    else{p0=__builtin_amdgcn_mfma_f32_32x32x16_bf16(b0,qr[d0],p0,0,0,0);p1=__builtin_amdgcn_mfma_f32_32x32x16_bf16(b1,qr[d0],p1,0,0,0);}}
}
typedef __attribute__((address_space(3))) const char* lds_cptr;
typedef short v4i16_t __attribute__((ext_vector_type(4)));
__device__ __forceinline__ void kload8(bf16x8*kf,lds_cptr kp){
  kf[0]=*(const __attribute__((address_space(3))) bf16x8*)(kp);      kf[1]=*(const __attribute__((address_space(3))) bf16x8*)(kp+512);
  kf[2]=*(const __attribute__((address_space(3))) bf16x8*)(kp+2048); kf[3]=*(const __attribute__((address_space(3))) bf16x8*)(kp+2560);
  kf[4]=*(const __attribute__((address_space(3))) bf16x8*)(kp+4096); kf[5]=*(const __attribute__((address_space(3))) bf16x8*)(kp+4608);
  kf[6]=*(const __attribute__((address_space(3))) bf16x8*)(kp+6144); kf[7]=*(const __attribute__((address_space(3))) bf16x8*)(kp+6656);
}
__device__ __forceinline__ void kload2(bf16x8*kf,lds_cptr kp,int j){ kf[2*j]=*(const __attribute__((address_space(3))) bf16x8*)(kp+j*2048); kf[2*j+1]=*(const __attribute__((address_space(3))) bf16x8*)(kp+j*2048+512); }
__device__ __forceinline__ s16x4 vtr(lds_cptr p){ return __builtin_bit_cast(s16x4,__builtin_amdgcn_ds_read_tr16_b64_v4i16((__attribute__((address_space(3))) v4i16_t*)p)); }
__device__ __forceinline__ float rowmax(const f32x16&p0,const f32x16&p1){
  float a=max3f(p0[0],p0[1],p1[0]),b=max3f(p0[2],p0[3],p1[1]);a=max3f(a,p1[2],p1[3]);
  #pragma unroll
  for(int r=4;r<16;r+=4){a=max3f(a,p0[r],p0[r+1]);b=max3f(b,p0[r+2],p0[r+3]);a=max3f(a,p1[r],p1[r+1]);b=max3f(b,p1[r+2],p1[r+3]);}
  const float m=max2f(a,b);
  auto rr=__builtin_amdgcn_permlane32_swap(__float_as_uint(m),__float_as_uint(m),false,false);
  return max2f(__uint_as_float(rr[0]),__uint_as_float(rr[1]));
}
__device__ __forceinline__ void pv(f32x16*o,int vb,bf16x8 pa0,bf16x8 pa1,bf16x8 pa2,bf16x8 pa3){
  #pragma unroll
  for(int d0=0;d0<2;++d0){s16x4 lo[4],hi[4];
    #pragma unroll
    for(int ks=0;ks<4;++ks){
      asm volatile("ds_read_b64_tr_b16 %0,%1 offset:%c2":"=&v"(lo[ks]):"v"(vb),"i"(d0*4096+ks*1024):"memory");
      asm volatile("ds_read_b64_tr_b16 %0,%1 offset:%c2":"=&v"(hi[ks]):"v"(vb),"i"(d0*4096+ks*1024+512):"memory");}
    asm volatile("s_waitcnt lgkmcnt(0)":::"memory");SBAR();
    #define PK(k) (bf16x8){lo[k][0],lo[k][1],lo[k][2],lo[k][3],hi[k][0],hi[k][1],hi[k][2],hi[k][3]}
    o[d0]=__builtin_amdgcn_mfma_f32_32x32x16_bf16(pa0,PK(0),o[d0],0,0,0);
    o[d0]=__builtin_amdgcn_mfma_f32_32x32x16_bf16(pa1,PK(1),o[d0],0,0,0);
    o[d0]=__builtin_amdgcn_mfma_f32_32x32x16_bf16(pa2,PK(2),o[d0],0,0,0);
    o[d0]=__builtin_amdgcn_mfma_f32_32x32x16_bf16(pa3,PK(3),o[d0],0,0,0);
    #undef PK
  }
}

#ifndef ATTN_STORE16
#define ATTN_STORE16(p,v) (*(u32x4*)(p)=(v))
#endif
template<int THRL> __device__ __forceinline__ void attn_unit(int b,int h,int qb,const bf16*Q,const bf16*__restrict__ K,const bf16*__restrict__ V,bf16*O,const float*__restrict__ KSUM,float*__restrict__ SSQA,char*shm){
  int tid=threadIdx.x; asm volatile("":"+v"(tid));
  const int lane=tid&63,r32=lane&31,hi=lane>>5; const int wid=__builtin_amdgcn_readfirstlane(tid>>6);
  const long rowbase=(long)b*SEQ; const int q0=qb*QB;
  const bf16*Qw=Q+(rowbase+q0+wid*QBLK)*DM+h*D;
  const bf16*Kh=K+rowbase*DM+h*D,*Vh=V+rowbase*DM+h*D;
  const unsigned lds0=(unsigned)(uintptr_t)shm;
  float*wsf=(float*)(shm+LDS_WS)+wid*64;
  const char*Khu=uni_ptr(Kh);const char*Vhu=uni_ptr(Vh);
  const unsigned kvo=(unsigned)(lane*DM+wid*8)*2u;
  const unsigned vvo=(unsigned)((16*(wid&3)+(lane>>2))*DM+(wid>>2)*32+(lane&3)*8)*2u;
  const unsigned kdst=lds0+LDS_K+wid*1024, vdst=lds0+LDS_V+wid*1024;
  #define DMA_K(t,slot) glds16(Khu+(size_t)(t)*(KVBLK*DM*2),kvo,(unsigned)__builtin_amdgcn_readfirstlane(kdst+(slot)))
  #define DMA_V(t,slot) glds16(Vhu+(size_t)(t)*(KVBLK*DM*2),vvo,(unsigned)__builtin_amdgcn_readfirstlane(vdst+(slot)))
  const int vb0=(int)(lds0+LDS_V)+((lane>>4)&1)*32+(lane&3)*8+(4*hi+((lane&15)>>2))*64;
  const char*Kbase=shm+LDS_K; bf16x8 kf[8];
  const lds_cptr shm3=(lds_cptr)shm; const lds_cptr kp0=shm3+LDS_K+hi*1024+r32*16; const lds_cptr vp0=shm3+LDS_V+((lane>>4)&1)*32+(lane&3)*8+(4*hi+((lane&15)>>2))*64;
  const int NT=(q0+QB)/KVBLK;
  DMA_K(0,0);DMA_V(0,0);DMA_K(1,SLOTB);
  bf16x8 qr[4];
  #pragma unroll
  for(int d0=0;d0<4;++d0)qr[d0]=*reinterpret_cast<const bf16x8*>(&Qw[(long)r32*DM+d0*16+hi*8]);
  unsigned selm=1u<<qb;
  { float g[8];
    #pragma unroll
    for(int n=0;n<8;++n){ g[n]=-INFINITY;
      if(n<qb){ const float*ks=KSUM+(long)(b*8+n)*DM+h*D+hi*8; float s=0.f;
        #pragma unroll
        for(int d0=0;d0<4;++d0){ const f32x4_t k0=*reinterpret_cast<const f32x4_t*>(ks+d0*16), k1=*reinterpret_cast<const f32x4_t*>(ks+d0*16+4);
          const u32x4 qw=__builtin_bit_cast(u32x4,qr[d0]);
          s+=__uint_as_float(qw[0]<<16)*k0[0]+__uint_as_float(qw[0]&0xffff0000u)*k0[1]+__uint_as_float(qw[1]<<16)*k0[2]+__uint_as_float(qw[1]&0xffff0000u)*k0[3]
            +__uint_as_float(qw[2]<<16)*k1[0]+__uint_as_float(qw[2]&0xffff0000u)*k1[1]+__uint_as_float(qw[3]<<16)*k1[2]+__uint_as_float(qw[3]&0xffff0000u)*k1[3]; }
        s+=__shfl_xor(s,32); g[n]=s; } }
    const int npick=qb<3?qb:3;
    for(int p=0;p<npick;++p){ int best=-1; float bv=-INFINITY;
      #pragma unroll
      for(int n=0;n<8;++n){ const bool ok=(n<qb)&&!((selm>>n)&1u)&&(best<0||g[n]>bv); if(ok){best=n;bv=g[n];} }
      if(best>=0)selm|=1u<<best; } }
  #define BMASK(P0,P1,t) do{ float bias_=((selm>>((t)>>2))&1u)?-mhat:-INFINITY; asm volatile("":"+v"(bias_)); _Pragma("unroll") for(int r=0;r<16;++r){P0[r]+=bias_;P1[r]+=bias_;} }while(0)
  float mhat=0.f,l_reg=0.f;f32x16 o[2];{float z0_=0.f;asm volatile("":"+v"(z0_));_Pragma("unroll") for(int r=0;r<16;++r){o[0][r]=z0_;o[1][r]=z0_;}}const f32x16 negm=f32x16{};
  const int qrel=wid*QBLK+r32;
  #define CMASK(P0,P1,t) do{int jb_=(t)-(NT-4); if(jb_>=0)cmask(P0,P1,jb_,qrel,hi);}while(0)
  bool resc=false;
  #define START(P0,P1) do{ const float rm=__builtin_fmaxf(rowmax(P0,P1),-100.0f); resc=false; \
    { const float dl=rm; mhat=fadd_s(mhat,dl); \
      _Pragma("unroll") for(int r=0;r<16;++r){P0[r]=fsub_s(P0[r],dl);P1[r]=fsub_s(P1[r],dl);} \
      } \
    _Pragma("unroll") for(int r=0;r<16;++r)P0[r]=__builtin_amdgcn_exp2f(P0[r]); }while(0)
  #define RESC() do{ if(resc){ asm volatile("s_waitcnt lgkmcnt(0)":::"memory"); \
      _Pragma("unroll") for(int d_=0;d_<2;++d_) _Pragma("unroll") for(int r=0;r<16;++r)o[d_][r]*=wsf[crow(r,hi)]; } }while(0)
  f32x16 pA0,pA1,pB0,pB1;
  int sl_prev=0,sl_cur=0,sl_next=SLOTB;
  #define ROT() do{sl_prev=sl_cur;sl_cur=sl_next;sl_next=(sl_next==(NSLOT-1)*SLOTB)?0:sl_next+SLOTB;}while(0)
  DMA_K(2,2*SLOTB);
  WAIT_BAR(3);
  qkt(pA0,pA1,Kbase,qr,negm,r32,hi);asm volatile("s_nop 15\n\ts_nop 7":"+v"(pA0),"+v"(pA1));CMASK(pA0,pA1,0);BMASK(pA0,pA1,0);
  START(pA0,pA1);
  _Pragma("unroll") for(int r=0;r<16;++r)pA1[r]=__builtin_amdgcn_exp2f(pA1[r]);
  WAIT_BAR(0);
  DMA_K(3,0);DMA_V(1,SLOTB);
  ROT();
  kload8(kf,kp0+sl_cur);
  WAIT_BAR(2);
  s16x4 vlo[8],vhi[8]; u32x4 pw0,pw1,pw2,pw3;
  #define PKW(P,B) cvtpk_s(P[B],P[B+1])
  #define PAF(k) __builtin_bit_cast(bf16x8,pw##k)
  #define VFR(i) (bf16x8){vlo[i][0],vlo[i][1],vlo[i][2],vlo[i][3],vhi[i][0],vhi[i][1],vhi[i][2],vhi[i][3]}
  #define PIN(x) asm volatile("":"+v"(x))
  #define MX3(a,b,c) __builtin_fmaxf(__builtin_fmaxf((a),(b)),(c))
  #define GAPA(MF,A0,A1,A2,A3,W0,W1,PW) do{ MF; sacc+=A0; sacc+=A1; sacc+=A2; sacc+=A3; PIN(sacc); W0; W1; PIN(PW); SBAR(); }while(0)
  #define EX(v) __builtin_amdgcn_exp2f(v)
  #define GAPB(MF,X,B) do{ MF; X[B]=EX(X[B]); X[B+1]=EX(X[B+1]); X[B+2]=EX(X[B+2]); X[B+3]=EX(X[B+3]); PIN(X); SBAR(); }while(0)
  #define VRD(i) do{ vlo[i]=vtr(vp_+(((i)>>2)*4096+((i)&3)*1024)); vhi[i]=vtr(vp_+(((i)>>2)*4096+((i)&3)*1024+512)); }while(0)
  #define KRD(G,j) do{ if(G){ kload2(kf,kp0+sl_next,j); SBAR(); } }while(0)
  #define STEP(C0,C1,P0,P1,t,GK,GV,GL) do{ SBAR(); \
    const lds_cptr vp_=vp0+sl_prev; \
    VRD(0); SBAR(); float sacc=(P0[0]+P0[1]); \
    GAPA(C0=__builtin_amdgcn_mfma_f32_32x32x16_bf16(kf[0],qr[0],negm,0,0,0), P0[2],P0[3],P0[4],P0[5],     pw0[0]=PKW(P0,0), pw0[1]=PKW(P0,2), pw0); \
    VRD(4); SBAR(); GAPA(C1=__builtin_amdgcn_mfma_f32_32x32x16_bf16(kf[1],qr[0],negm,0,0,0), P0[6],P0[7],P0[8],P0[9],     pw0[2]=PKW(P0,4), pw0[3]=PKW(P0,6), pw0); \
    VRD(1); SBAR(); GAPA(C0=__builtin_amdgcn_mfma_f32_32x32x16_bf16(kf[2],qr[1],C0,0,0,0),   P0[10],P0[11],P0[12],P0[13], pw1[0]=PKW(P0,8), pw1[1]=PKW(P0,10), pw1); \
    VRD(5); SBAR(); GAPA(C1=__builtin_amdgcn_mfma_f32_32x32x16_bf16(kf[3],qr[1],C1,0,0,0),   P0[14],P0[15],P1[0],P1[1],   pw1[2]=PKW(P0,12),pw1[3]=PKW(P0,14), pw1); \
    VRD(2); SBAR(); GAPA(C0=__builtin_amdgcn_mfma_f32_32x32x16_bf16(kf[4],qr[2],C0,0,0,0),   P1[2],P1[3],P1[4],P1[5],     pw2[0]=PKW(P1,0), pw2[1]=PKW(P1,2), pw2); \
    VRD(6); SBAR(); GAPA(C1=__builtin_amdgcn_mfma_f32_32x32x16_bf16(kf[5],qr[2],C1,0,0,0),   P1[6],P1[7],P1[8],P1[9],     pw2[2]=PKW(P1,4), pw2[3]=PKW(P1,6), pw2); \
    VRD(3); SBAR(); GAPA(C0=__builtin_amdgcn_mfma_f32_32x32x16_bf16(kf[6],qr[3],C0,0,0,0),   P1[10],P1[11],P1[12],P1[13], pw3[0]=PKW(P1,8), pw3[1]=PKW(P1,10), pw3); \
    VRD(7); SBAR(); GAPA(C1=__builtin_amdgcn_mfma_f32_32x32x16_bf16(kf[7],qr[3],C1,0,0,0),   P1[14],P1[15],0.f,0.f,       pw3[2]=PKW(P1,12),pw3[3]=PKW(P1,14), pw3); \
    l_reg+=sacc; \
    if(GK){DMA_K((t)+3,sl_cur);} if(GV){DMA_V((t)+1,sl_next);} \
    CMASK(C0,C1,t); BMASK(C0,C1,t); \
    { float a=MX3(C0[0],C0[1],C1[0]),b=MX3(C0[2],C0[3],C1[1]); a=MX3(a,C1[2],C1[3]); \
      _Pragma("unroll") for(int r=4;r<16;r+=4){a=MX3(a,C0[r],C0[r+1]);b=MX3(b,C0[r+2],C0[r+3]);a=MX3(a,C1[r],C1[r+1]);b=MX3(b,C1[r+2],C1[r+3]);} \
      float rm=__builtin_fmaxf(a,b); { auto rr=__builtin_amdgcn_permlane32_swap(__float_as_uint(rm),__float_as_uint(rm),false,false); rm=__builtin_fmaxf(__uint_as_float(rr[0]),__uint_as_float(rr[1])); } \
      resc=false; \
      if(__builtin_expect(__any(rm>(float)THRL),0)){ const float dl=__builtin_fmaxf(rm,0.f); mhat+=dl; \
        _Pragma("unroll") for(int r=0;r<16;++r){C0[r]-=dl;C1[r]-=dl;} \
        const float f=__builtin_amdgcn_exp2f(-dl); l_reg*=f; if(hi==0)wsf[r32]=f; resc=true; } } \
    SBAR(); \
    GAPB(o[0]=__builtin_amdgcn_mfma_f32_32x32x16_bf16(PAF(0),VFR(0),o[0],0,0,0), C0,0); \
    GAPB(o[1]=__builtin_amdgcn_mfma_f32_32x32x16_bf16(PAF(0),VFR(4),o[1],0,0,0), C0,4); \
    KRD(GL,0); GAPB(o[0]=__builtin_amdgcn_mfma_f32_32x32x16_bf16(PAF(1),VFR(1),o[0],0,0,0), C0,8); \
    KRD(GL,1); GAPB(o[1]=__builtin_amdgcn_mfma_f32_32x32x16_bf16(PAF(1),VFR(5),o[1],0,0,0), C0,12); \
    KRD(GL,2); GAPB(o[0]=__builtin_amdgcn_mfma_f32_32x32x16_bf16(PAF(2),VFR(2),o[0],0,0,0), C1,0); \
    KRD(GL,3); GAPB(o[1]=__builtin_amdgcn_mfma_f32_32x32x16_bf16(PAF(2),VFR(6),o[1],0,0,0), C1,4); \
    GAPB(o[0]=__builtin_amdgcn_mfma_f32_32x32x16_bf16(PAF(3),VFR(3),o[0],0,0,0), C1,8); \
    GAPB(o[1]=__builtin_amdgcn_mfma_f32_32x32x16_bf16(PAF(3),VFR(7),o[1],0,0,0), C1,12); \
    }while(0)
  int t=1;
  #undef CMASK
  #define CMASK(P0,P1,t) do{}while(0)
  for(;t+5<NT;t+=2){
    STEP(pB0,pB1,pA0,pA1,t,true,true,true);     WAIT_BAR(2); RESC(); ROT();
    STEP(pA0,pA1,pB0,pB1,t+1,true,true,true);   WAIT_BAR(2); RESC(); ROT();
  }
  #undef CMASK
  #define CMASK(P0,P1,t) do{int jb_=(t)-(NT-4); if(jb_>=0)cmask(P0,P1,jb_,qrel,hi);}while(0)
  #define ENDW(tt) do{ if((tt)+3<NT){WAIT_BAR(2);} else if((tt)+2<NT){WAIT_BAR(1);} else {WAIT_BAR(0);} }while(0)
  for(;t+1<NT;t+=2){
    STEP(pB0,pB1,pA0,pA1,t,(t+3<NT),(t+1<NT),(t+1<NT));       ENDW(t);   RESC(); ROT();
    STEP(pA0,pA1,pB0,pB1,t+1,(t+4<NT),(t+2<NT),(t+2<NT));     ENDW(t+1); RESC(); ROT();
  }
  STEP(pB0,pB1,pA0,pA1,NT-1,false,false,false); RESC();
  { float sacc=pB0[0]+pB0[1]; _Pragma("unroll") for(int r=2;r<16;++r)sacc+=pB0[r]; _Pragma("unroll") for(int r=0;r<16;++r)sacc+=pB1[r]; l_reg+=sacc;
    pw0=(u32x4){PKW(pB0,0),PKW(pB0,2),PKW(pB0,4),PKW(pB0,6)};pw1=(u32x4){PKW(pB0,8),PKW(pB0,10),PKW(pB0,12),PKW(pB0,14)};pw2=(u32x4){PKW(pB1,0),PKW(pB1,2),PKW(pB1,4),PKW(pB1,6)};pw3=(u32x4){PKW(pB1,8),PKW(pB1,10),PKW(pB1,12),PKW(pB1,14)};
    SBAR(); pv(o,vb0+sl_cur,PAF(0),PAF(1),PAF(2),PAF(3)); }
  #undef PKW
  #undef PAF
  #undef VFR
  #undef PIN
  #undef MX3
  #undef GAPA
  #undef GAPB
  #undef EX
  #undef VRD
  #undef KRD
  #undef STEP
  #undef ENDW
  {auto rr=__builtin_amdgcn_permlane32_swap(__float_as_uint(l_reg),__float_as_uint(l_reg),false,false);l_reg=__uint_as_float(rr[0])+__uint_as_float(rr[1]);}
  if(hi==0)wsf[32+r32]=l_reg;asm volatile("s_waitcnt lgkmcnt(0)":::"memory");
  float rli[16];
  #pragma unroll
  for(int r=0;r<16;++r)rli[r]=__builtin_amdgcn_rcpf(wsf[32+crow(r,hi)]);
  bf16*Ow=O+(rowbase+q0+wid*QBLK)*DMO+h*D;
  { bf16*stg=(bf16*)(shm+LDS_OST)+wid*2048;
    #pragma unroll
    for(int r=0;r<16;++r){const int orow=crow(r,hi);
      #pragma unroll
      for(int d0=0;d0<2;++d0)stg[orow*64+d0*32+r32]=__float2bfloat16(o[d0][r]*rli[r]);}
    asm volatile("s_waitcnt lgkmcnt(0)":::"memory");
    #pragma unroll
    for(int i=0;i<4;++i){const int row=i*8+(lane>>3),ch=lane&7; const u32x4 v=*(const u32x4*)(stg+row*64+ch*8); ATTN_STORE16(Ow+(long)row*DMO+ch*8,v);
      float q=0.f;
      #pragma unroll
      for(int e=0;e<4;++e){const float lo=__uint_as_float(v[e]<<16),hi2=__uint_as_float(v[e]&0xffff0000u);q+=lo*lo+hi2*hi2;}
      q+=__shfl_xor(q,1);q+=__shfl_xor(q,2);q+=__shfl_xor(q,4);
      if(ch==0)SSQA[(rowbase+q0+wid*QBLK+row)*8+h]=q;} }
  asm volatile("s_waitcnt lgkmcnt(0)\n\ts_barrier":::"memory");
  #undef BMASK
  #undef DMA_K
  #undef DMA_V
  #undef CMASK
  #undef START
  #undef RESC
  #undef ROT
}
constexpr int ATTN_LDS_BYTES=LDS_BYTES;
#undef SBAR
#undef WAIT_BAR
}

__global__ void __launch_bounds__(512, 2) mk_fwd(Args args) {
    extern __shared__ __attribute__((aligned(16))) unsigned char lds_raw[];
    Ctx C; C.lds = (LAS unsigned char*)lds_raw; C.tid = threadIdx.x; C.lane = C.tid & 63; C.wave = __builtin_amdgcn_readfirstlane(C.tid >> 6);
    C.G = gridDim.x; { const int bx = blockIdx.x; C.vcu = (C.G % 8 == 0) ? (bx % 8) * (C.G / 8) + bx / 8 : bx; }
    unsigned char* ws = args.ws;
    for (int u = C.tid; u < (LDS_BYTES - LDSCTL_OFF) / 4; u += 512) ((LAS unsigned*)(C.lds + LDSCTL_OFF))[u] = 0u;
    __syncthreads();
    XcdBarrier bar; bar.bar = (unsigned*)(ws + WS_CTL) + CW_BAR; bar.x = 0; bar.st = nullptr;
    if (N_LAUNCHES == 1) bar = xcd_barrier_post((unsigned*)(ws + WS_CTL) + CW_BAR, (volatile LAS unsigned*)(C.lds + MISC_OFF) + 8);
    const int lo = args.ph_lo, hi = args.ph_hi;
#define IN(k) (lo <= (k) && (k) < hi)
#define FRESH() do { int t_ = threadIdx.x; asm volatile("" : "+v"(t_)); C.tid = t_; C.lane = t_ & 63; C.wave = __builtin_amdgcn_readfirstlane(t_ >> 6); } while (0)
#define SEAM(k) do { if (IN(k) && IN((k) + 1)) xcd_barrier(bar); } while (0)
    const int cb = (int)blockIdx.x;

    if (IN(0)) { FRESH(); ph_prologue(args, C); SEAM(0); }
    if (IN(1)) {
        { Gemm g{(const bf16_t*)(ws + WS_B), (const bf16_t*)(ws + WS_WIN), DM, DM, DM}; PlainOrder S; S.init(NTOK, DIN, C.G, cb, DM, DM);
          EpiProj E{(bf16_t*)(ws + WS_A), (const float*)(ws + WS_ROPE), (float*)(ws + WS_KSUM)}; GEMM_PHASE(C.lds, g, S, E); }
        { Gemm g{(const bf16_t*)(ws + WS_MEMN), (const bf16_t*)(ws + WS_WXK), DM, DM, DM}; PlainOrder S; S.init(NMEM, DM, C.G, cb, DM, DM);
          EpiStore E{(bf16_t*)(ws + WS_KM), DM}; GEMM_PHASE(C.lds, g, S, E); }
        { Gemm g{(const bf16_t*)(ws + WS_MEMN), (const bf16_t*)(ws + WS_WXV), DM, DM, DM}; PlainOrder S; S.init(NMEM, DM, C.G, (cb + C.G - 64 % C.G) % C.G, DM, DM);
          EpiStore E{(bf16_t*)(ws + WS_VMT), DM}; GEMM_PHASE(C.lds, g, S, E); }
        { FRESH(); if (C.G == 256) { if (cb >= 128) conv_wdn(args, C, (cb - 128) * 8 + C.wave, 128 * 8, 0, WDN_SPLIT); }
          else conv_wdn(args, C, C.vcu * 8 + C.wave, C.G * 8, 0, WDN_SPLIT); }
        SEAM(1);
    }
    if (IN(2)) { FRESH();
        for (int L = C.vcu; L < 256; L += C.G) lru_unit(args, C, L >> 4, (L >> 1) & 7, L & 1, L);
        for (int i = 0;; ++i) { const int aidx = i * C.G + C.vcu; if (aidx >= 1024) break; const int cc = aidx & 255, ii = aidx >> 8, bh = cc >> 1;
            const int qb = (cc & 1) ? ((ii == 0) ? 6 : (ii == 1) ? 1 : (ii == 2) ? 5 : 2) : ((ii == 0) ? 7 : (ii == 1) ? 0 : (ii == 2) ? 4 : 3);
            { const attn_body::bf16* Qp = (const attn_body::bf16*)(ws + WS_A) + (size_t)2 * NTOK * 512;
              attn_body::attn_unit<8>(bh >> 3, bh & 7, qb, Qp, Qp + (size_t)NTOK * 512, Qp + (size_t)2 * NTOK * 512, (attn_body::bf16*)(ws + WS_C) + 512, (const float*)(ws + WS_KSUM), (float*)(ws + WS_SSQA), (char*)lds_raw); } }
        SEAM(2);
    }
    if (IN(4)) { Gemm g{(const bf16_t*)(ws + WS_C), (const bf16_t*)(ws + WS_WOUT), DM, DM, DM}; PlainOrder S; S.init(NTOK, DM, C.G, cb, DM, DM);
        EpiResid<true, true> E{(const bf16_t*)(ws + WS_B), (bf16_t*)args.out, (float*)(ws + WS_SSQ1), (const float*)(ws + WS_SSQL), (const float*)(ws + WS_SSQA), ws + WS_A + 64 * MiB, 1.0f, (const float*)(ws + WS_TOK + TOK_D), args.in[2]};     GEMM_PHASE(C.lds, g, S, E);
        { Gemm g2{(const bf16_t*)(ws + WS_KM), (const bf16_t*)(ws + WS_WXQ), DM, DM, XHD}; XpreOrder S2{C.G, cb, 0}; EpiStore8 E2{ws + WS_A, DM, QKT_SC}; GEMM_PHASE(C.lds, g2, S2, E2); }
        { Gemm g3{(const bf16_t*)(ws + WS_WXO), (const bf16_t*)(ws + WS_VMT), DM, DM, XHD}; XpreOrder S3{C.G, cb, 1}; EpiStore8 E3{ws + WS_A + 32 * MiB, DM, VWT_SC}; GEMM_PHASE(C.lds, g3, S3, E3); }
        SEAM(4); }
    if (IN(5)) { Gemm g{(const bf16_t*)(ws + WS_A + 64 * MiB), (const bf16_t*)(ws + WS_A), DM / 2, DM / 2, DM / 2}; XattnOrder S{C.G, cb, 0, DM / 2, DM / 2};
        EpiSoftmax E{ws + WS_A + 96 * MiB, DM, C.lds + LDSCTL_OFF + 4096, (const float*)(ws + WS_SSQ1), XSCALE / QKT_SC}; GEMM_PHASE8N(C.lds, g, S, E); SEAM(5); }
    if (IN(8)) { Gemm g{(const bf16_t*)(ws + WS_A + 96 * MiB), (const bf16_t*)(ws + WS_A + 32 * MiB), DM / 2, DM / 2, DM / 2}; XattnOrder S{C.G, cb, 1, DM / 2, DM / 2};
        EpiResid<false, false> E{(const bf16_t*)args.out, (bf16_t*)args.out + DM, (float*)(ws + WS_SSQ2), nullptr, nullptr, ws + WS_H2F8, 1.0f / (PX_SC * VWT_SC)}; GEMM_PHASE8(C.lds, g, S, E); SEAM(8); }
    if (IN(9)) { FRESH(); ph_router(args, C); SEAM(9); }
    if (IN(11)) { FRESH(); moe_table(args, C); Gemm g{(const bf16_t*)(ws + WS_H2F8), (const bf16_t*)(ws + WS_WGU), DM / 2, DM / 2, DM / 2};
        MoeOrder<true> S{(const LAS int*)(C.lds + MOE_OFF), C.G, cb, DM / 2, DM / 2, (const int*)(ws + WS_LTOK), (unsigned)DM};
        EpiGateUp E{ws + WS_B, (const float*)(ws + WS_LRS)}; GEMM_PHASE8(C.lds, g, S, E); SEAM(11); }
    if (IN(12)) { FRESH(); moe_table(args, C); Gemm g{(const bf16_t*)(ws + WS_B), (const bf16_t*)(ws + WS_WDN), DFF / 2, DFF / 2, DFF / 2};
        MoeOrder<false> S{(const LAS int*)(C.lds + MOE_OFF), C.G, cb, DFF / 2, DFF / 2, nullptr, 0u};
        EpiStore8 E{ws + WS_A, DM, YB_SC / (WDN_SC * ACT_SC)}; GEMM_PHASE8(C.lds, g, S, E); SEAM(12); }
    if (IN(13)) { FRESH(); moe_table(args, C); ph_final(args, C, args.out); }
#undef IN
#undef FRESH
#undef SEAM
}

extern "C" void kernel_launch(void* const* d_in, const int* in_sizes, int n_in, void* d_out, int out_size, void* d_ws, size_t ws_size, hipStream_t stream) {
    static int grid = 0;
    if (grid == 0) {
        if (n_in != 27 || out_size != NTOK * DM || ws_size < WS_END) { fprintf(stderr, "kernel_launch: unexpected shapes (n_in %d out %d ws %zu)\n", n_in, out_size, ws_size); grid = -1; return; }
        int dev = 0, cus = 0, per_cu = 0;
        if (hipGetDevice(&dev) != hipSuccess || hipDeviceGetAttribute(&cus, hipDeviceAttributeMultiprocessorCount, dev) != hipSuccess) { grid = -1; return; }
        if (hipFuncSetAttribute((const void*)mk_fwd, hipFuncAttributeMaxDynamicSharedMemorySize, LDS_BYTES) != hipSuccess) { fprintf(stderr, "kernel_launch: hipFuncSetAttribute failed\n"); grid = -1; return; }
        if (hipOccupancyMaxActiveBlocksPerMultiprocessor(&per_cu, (const void*)mk_fwd, 512, LDS_BYTES) != hipSuccess || per_cu < 1) fprintf(stderr, "kernel_launch: occupancy query reports %d\n", per_cu);
        (void)hipGetLastError();
        grid = cus;
    }
    if (grid < 0) return;
    (void)hipMemsetAsync((char*)d_ws + WS_CTL, 0, CTL_ZERO_BYTES, stream);
    Args a{};
    for (int i = 0; i < 27; ++i) a.in[i] = (const float*)d_in[i];
    a.out = (float*)d_out; a.ws = (unsigned char*)d_ws;
    const float invf[8] = {1.0f, 0.1939227432012558f, 0.03760603070259094f, 0.007292664609849453f, 0.0014142135623842478f, 0.00027424818836152554f, 5.318296098266728e-05f, 1.0313386155758053e-05f};
    for (int i = 0; i < 8; ++i) a.invf[i] = invf[i];
    if (N_LAUNCHES == 1) { a.ph_lo = 0; a.ph_hi = N_PHASES; hipLaunchKernelGGL(mk_fwd, dim3(grid), dim3(512), LDS_BYTES, stream, a); }
    else for (int p = 0; p < N_PHASES; ++p) { a.ph_lo = p; a.ph_hi = p + 1; hipLaunchKernelGGL(mk_fwd, dim3(grid), dim3(512), LDS_BYTES, stream, a); }
}
```

```cpp
#include <hip/hip_runtime.h>
#include <cstdio>
#include <cstdint>

#define LAS __attribute__((address_space(3)))
#define GAS __attribute__((address_space(1)))
typedef unsigned short bf16_t;
typedef short bf16x8 __attribute__((ext_vector_type(8)));
typedef float f32x4 __attribute__((ext_vector_type(4)));
typedef float f32x2 __attribute__((ext_vector_type(2)));
typedef unsigned u32x4 __attribute__((ext_vector_type(4)));
typedef unsigned u32x2 __attribute__((ext_vector_type(2)));

#ifndef MK_N_LAUNCHES
#define MK_N_LAUNCHES 1
#endif
constexpr int N_PHASES = 14;
constexpr int N_LAUNCHES = MK_N_LAUNCHES;

constexpr int BATCH = 16, SEQ = 2048, DM = 1024, NTOK = BATCH * SEQ;
constexpr int DLRU = 512, DATT = 512, DIN = 2560, NHEAD = 8, HD = 64, NBLK = 8, MBLK = 256;
constexpr int MEMLEN = 256, NXH = 4, XHD = 256, NMEM = BATCH * MEMLEN;
constexpr int NEXP = 32, EPG = 8, NGRP = 4, DFF = 512;
constexpr float EPS = 1e-6f;
constexpr float QKT_SC = 8.0f, VWT_SC = 8.0f, PX_SC = 256.0f;
constexpr float WGU_SC = 64.0f, WDN_SC = 32.0f, ACT_SC = 16.0f, YB_SC = 16.0f;
constexpr int WDN_SPLIT = 3072;
constexpr int MAXTILES = 288, LCAP = 65536, LDH = 2048;
constexpr float QSCALE = 0.125f * 1.4426950408889634f;
constexpr float XSCALE = 0.0625f * 1.4426950408889634f;

constexpr size_t MiB = 1u << 20;
constexpr size_t WS_CTL = 0, CTL_ZERO_BYTES = 1 * MiB;
constexpr int CW_TMO = 0, CW_BAR = 4096, CW_CNT = 8192;
constexpr size_t WS_KSUM = 512 * 1024;
constexpr size_t WS_WIN = 2 * MiB, WS_WXK = 7 * MiB, WS_WXV = 9 * MiB, WS_WOUT = 11 * MiB, WS_WXQ = 13 * MiB, WS_WXO = 15 * MiB;
constexpr size_t WS_WR = 17 * MiB, WS_ROPE = 18 * MiB, WS_SSQ1 = 19 * MiB, WS_SSQ2 = 21 * MiB, WS_TOK = 23 * MiB, WS_RSC = 24 * MiB;
constexpr size_t WS_MEMN = 25 * MiB, WS_KM = 33 * MiB, WS_VMT = 41 * MiB, WS_WGU = 49 * MiB, WS_WDN = 113 * MiB;
constexpr size_t WS_A = 145 * MiB, WS_B = 305 * MiB, WS_C = 385 * MiB, WS_SSQL = 449 * MiB, WS_SSQA = 451 * MiB, WS_LTOK = 452 * MiB, WS_LRS = 460 * MiB, WS_H2F8 = 468 * MiB, WS_END = 500 * MiB;
constexpr size_t TOK_E = 0, TOK_R = 256 * 1024, TOK_G = 512 * 1024, TOK_D = 768 * 1024;

constexpr int RING_BYTES = 131072;
constexpr int LDSCTL_OFF = RING_BYTES, MISC_OFF = LDSCTL_OFF + 320, MOE_OFF = LDSCTL_OFF + 1024;
constexpr int LDS_BYTES = 147456;

__device__ __forceinline__ unsigned cvt_pk_bf16(float lo, float hi) { unsigned r; asm volatile("v_cvt_pk_bf16_f32 %0, %1, %2" : "=v"(r) : "v"(lo), "v"(hi)); return r; }
__device__ __forceinline__ float bflo(unsigned w) { return __uint_as_float(w << 16); }
__device__ __forceinline__ float bfhi(unsigned w) { return __uint_as_float(w & 0xffff0000u); }
__device__ __forceinline__ float bf2f(bf16_t b) { return __uint_as_float((unsigned)b << 16); }
__device__ __forceinline__ float wave_sum(float v) {
#pragma unroll
    for (int o = 1; o < 64; o <<= 1) v += __shfl_xor(v, o);
    return v;
}
#define LDS_WAIT() asm volatile("s_waitcnt lgkmcnt(0)" ::: "memory")
__device__ __forceinline__ float sigmoidf_(float x) { return __builtin_amdgcn_rcpf(1.0f + __builtin_amdgcn_exp2f(x * -1.4426950408889634f)); }

#define XB_TMO      128
#define XB_XCNT(j)  (256  + 64 * (j))
#define XB_XSUB(j)  (1280 + 64 * (j))
#define XB_XGEN(j)  (2304 + 64 * (j))
#define XB_TOP      3328
#define XB_TOPGEN   3392
#define XCD_BAR_WORDS 3456
#define XB_SPIN_CAP (1u << 18)
__device__ __forceinline__ unsigned xb_ld(unsigned* p)              { return __hip_atomic_load(p, __ATOMIC_RELAXED, __HIP_MEMORY_SCOPE_AGENT); }
__device__ __forceinline__ unsigned xb_add(unsigned* p, unsigned v) { return __hip_atomic_fetch_add(p, v, __ATOMIC_RELAXED, __HIP_MEMORY_SCOPE_AGENT); }
__device__ __forceinline__ unsigned xb_xcc_id() { return (unsigned)__builtin_amdgcn_s_getreg((3 << 11) | 20) & 0xFu; }
#define XB_SPIN(cond, bar) do { unsigned _sp = 0; while (cond) { __builtin_amdgcn_s_sleep(1); \
    if ((++_sp & 255u) == 0u) { if (xb_ld(&(bar)[XB_TMO])) break; if (_sp > XB_SPIN_CAP) { atomicAdd(&(bar)[XB_TMO], 1u); break; } } } } while (0)
struct XcdBarrier { unsigned* bar; unsigned x; volatile LAS unsigned* st; };
__device__ __forceinline__ XcdBarrier xcd_barrier_post(unsigned* bar, volatile LAS unsigned* st) {
    XcdBarrier b; b.bar = bar; b.x = xb_xcc_id(); b.st = st;
    if (threadIdx.x == 0) (void)xb_add(&bar[XB_XCNT(b.x)], 1u);
    return b;
}
__device__ __forceinline__ void xcd_barrier_complete(unsigned* bar, unsigned x, unsigned& nloc, unsigned& nx) {
    const unsigned G = gridDim.x * gridDim.y * gridDim.z;
    unsigned sum, cnt, mine, sp = 0u;
    for (;;) {
        sum = 0u; cnt = 0u; mine = 0u;
#pragma unroll
        for (unsigned j = 0; j < 16; ++j) { const unsigned c = xb_ld(&bar[XB_XCNT(j)]); sum += c; cnt += (c > 0u) ? 1u : 0u; mine = (j == x) ? c : mine; }
        if (sum == G) break;
        __builtin_amdgcn_s_sleep(1);
        if ((++sp & 255u) == 0u) { if (xb_ld(&bar[XB_TMO])) break; if (sp > XB_SPIN_CAP) { atomicAdd(&bar[XB_TMO], 1u); break; } }
    }
    nloc = mine > 0u ? mine : 1u; nx = cnt > 0u ? cnt : 1u;
}
__device__ __forceinline__ void xcd_barrier(const XcdBarrier& b) {
    asm volatile("s_waitcnt vmcnt(0)" ::: "memory");
    __syncthreads();
    if (threadIdx.x == 0) {
        unsigned* bar = b.bar;
        __builtin_amdgcn_s_waitcnt(0);
        unsigned nloc = b.st[0], nx = b.st[1];
        if (nloc == 0u) { xcd_barrier_complete(bar, b.x, nloc, nx); b.st[0] = nloc; b.st[1] = nx; }
        const unsigned old = xb_add(&bar[XB_XSUB(b.x)], 1u);
        const unsigned gen = old / nloc;
        if (old + 1u == (gen + 1u) * nloc) {
            __builtin_amdgcn_fence(__ATOMIC_RELEASE, "agent");
            asm volatile("s_waitcnt vmcnt(0)" ::: "memory");
            const unsigned og = xb_add(&bar[XB_TOP], 1u);
            const unsigned tg = og / nx;
            if (og + 1u == (tg + 1u) * nx) xb_add(&bar[XB_TOPGEN], 1u);
            else XB_SPIN(xb_ld(&bar[XB_TOPGEN]) == tg, bar);
            __builtin_amdgcn_fence(__ATOMIC_ACQUIRE, "agent");
            xb_add(&bar[XB_XGEN(b.x)], 1u);
            asm volatile("s_waitcnt vmcnt(0)" ::: "memory");
        } else {
            XB_SPIN(xb_ld(&bar[XB_XGEN(b.x)]) == gen, bar);
            __builtin_amdgcn_fence(__ATOMIC_ACQUIRE, "agent");
            asm volatile("s_waitcnt vmcnt(0)" ::: "memory");
        }
    }
    __syncthreads();
}

struct Unit { int pm, pn; size_t a_off, b_off; int lbase, nvalid; };
struct Gemm { const bf16_t* A; const bf16_t* Bt; int lda, ldb, K; };
__host__ __device__ __forceinline__ int perm32(int rho) { const int n = rho >> 4, i = rho & 15; return 8 * (i >> 2) + 4 * n + (i & 3); }

struct PlainOrder {     static constexpr bool GATHER = false;
    int nM, nN, nwg, G, c, lda, ldb;
    __device__ void init(int M, int N, int G_, int c_, int lda_, int ldb_) { nM = M / 256; nN = N / 256; nwg = nM * nN; G = G_; c = c_; lda = lda_; ldb = ldb_; }
    __device__ bool next(int i, Unit& u) const {
        const long L = (long)i * G + c; if (L >= nwg) return false;
        int wgid = (int)L; { const int q = nwg / 8, r = nwg % 8, xcd = wgid % 8, off = wgid / 8; wgid = (xcd < r ? xcd * (q + 1) : r * (q + 1) + (xcd - r) * q) + off; }
        const int nig = 8 * nN, gid = wgid / nig, fm = gid * 8, gsz = (nM - fm) < 8 ? (nM - fm) : 8;
        u.pm = fm + ((wgid % nig) % gsz); u.pn = (wgid % nig) / gsz;
        u.a_off = (size_t)u.pm * 256 * lda; u.b_off = (size_t)u.pn * 256 * ldb; return true;
    }
};
struct XpreOrder {
    static constexpr bool GATHER = false;
    int G, c, mode;
    __device__ bool next(int i, Unit& u) const {
        const int L = i * G + c; if (L >= 256) return false;
        const int b = L >> 4, x = (L >> 2) & 3, y = L & 3;
        if (mode == 0) { const int h = x, kt = y; u.pm = b * 4 + h; u.pn = kt; u.a_off = (size_t)b * MEMLEN * DM + h * XHD; u.b_off = (size_t)kt * 256 * DM + h * XHD; }
        else { const int nt = x, h = y; u.pm = b * 4 + nt; u.pn = h; u.a_off = (size_t)nt * 256 * DM + h * XHD; u.b_off = (size_t)b * MEMLEN * DM + h * XHD; }
        return true;
    }
};
struct XattnOrder {
    static constexpr bool GATHER = false;
    int G, c, mode, lda, ldb;
    __device__ bool next(int i, Unit& u) const {
        int L = i * G + c; if (L >= (NTOK / 256) * 4) return false;
        if (G == 256) { const int x = c & 7, idx = c >> 3; L = ((x + 8 * i) * 8 + (idx >> 2)) * 4 + (idx & 3); }
        u.pm = L >> 2; u.pn = L & 3; const int b = u.pm >> 3;
        u.a_off = (size_t)u.pm * 256 * lda;
        u.b_off = mode == 0 ? (size_t)(b * 4 + u.pn) * 256 * ldb : (size_t)(b * 1024 + u.pn * 256) * ldb;
        return true;
    }
};
template <bool GATH_> struct MoeOrder {
    static constexpr bool GATHER = GATH_;
    const LAS int* ts; int G, c, lda, ldb; const int* ltok; unsigned rowbytes;
    __device__ bool next(int i, Unit& u) const {
        const int L = i * G + c; if (L >= ts[NEXP] * 4) return false;
        const int T = L >> 2, j = L & 3; int e = 0; while (ts[e + 1] <= T) ++e;
        const int lt = T - ts[e];
        u.pm = T; u.pn = j; u.a_off = GATH_ ? (size_t)0 : (size_t)T * 256 * lda; u.b_off = ((size_t)e * 1024 + j * 256) * ldb;
        u.lbase = e * LCAP + lt * 256; u.nvalid = ts[33 + e] - lt * 256; return true;
    }
    __device__ __forceinline__ unsigned rowoff(const Unit& u, int r) const { return (r < u.nvalid) ? (unsigned)ltok[u.lbase + r] * rowbytes : 0u; }
};


typedef int v8i __attribute__((ext_vector_type(8)));
typedef int v4i __attribute__((ext_vector_type(4)));
__device__ __forceinline__ v8i cat8(bf16x8 lo, bf16x8 hi) { const v4i a = __builtin_bit_cast(v4i, lo), b = __builtin_bit_cast(v4i, hi); return __builtin_shufflevector(a, b, 0, 1, 2, 3, 4, 5, 6, 7); }
template <int H> __device__ __forceinline__ bf16x8 half8(v8i v) { const v4i h = H ? __builtin_shufflevector(v, v, 4, 5, 6, 7) : __builtin_shufflevector(v, v, 0, 1, 2, 3); return __builtin_bit_cast(bf16x8, h); }
__device__ __forceinline__ unsigned pk4_fp8(float a, float b, float c, float d) { int w = __builtin_amdgcn_cvt_pk_fp8_f32(a, b, 0, false); w = __builtin_amdgcn_cvt_pk_fp8_f32(c, d, w, true); return (unsigned)w; }
__host__ __device__ __forceinline__ int lds_byte(int r, int c) { const int st = (r >> 4) * 2 + (c >> 5), rr = r & 15, cc = c & 31, ob = rr * 64 + cc * 2; return st * 1024 + (ob ^ (((ob >> 9) & 1) << 5)); }
__host__ __device__ __forceinline__ void stage_rc(int b, int& R, int& C) { const int st = b / 1024, sb = b % 1024, swz = sb ^ (((sb >> 9) & 1) << 5); R = (st >> 1) * 16 + swz / 64; C = (st & 1) * 32 + (swz % 64) / 2; }
template <class Epi, class Sched, bool ALIGN_EPI = false, bool SP2 = false, bool F8 = false, bool SKIPW = true>
__device__ __forceinline__ void gemm_phase(LAS unsigned char* lds, const Gemm g, const Sched& S, const Epi& E) {
    constexpr int BK = 64, HALF = 128, HTB = HALF * BK * 2;
    int tid = threadIdx.x; asm volatile("" : "+v"(tid));
    const int wid = __builtin_amdgcn_readfirstlane(tid >> 6), lane = tid & 63, wr = wid >> 2, wc = wid & 3, fr = lane & 15, fq = lane >> 4;
    const int K = g.K, nt = K / BK;
    unsigned voffA[2], voffB[2];
#pragma unroll
    for (int i = 0; i < 2; ++i) { int R, C; stage_rc(tid * 16 + i * 8192, R, C); const int Rb = Epi::PERM ? ((R & ~31) + perm32(R & 31)) : R;
        voffA[i] = (unsigned)(R * g.lda + C) * 2u; voffB[i] = (unsigned)(Rb * g.ldb + C) * 2u; }
    constexpr bool GATH = Sched::GATHER;
    unsigned vcu[2][2] = {{0u, 0u}, {0u, 0u}}, vnx[2][2] = {{0u, 0u}, {0u, 0u}}; int gR[2] = {0, 0}; unsigned gC[2] = {0u, 0u};
    if constexpr (GATH) {
#pragma unroll
        for (int i = 0; i < 2; ++i) { int R, Cq; stage_rc(tid * 16 + i * 8192, R, Cq); gR[i] = R; gC[i] = (unsigned)Cq * 2u; } }
    const size_t kstep = (size_t)(BK * 2);
    const size_t hstepA = (size_t)HALF * g.lda * 2, hstepB = (size_t)HALF * g.ldb * 2;
    const unsigned ldsw = (unsigned)wid * 1024u;
    const int aoff = lds_byte(wr * 64 + fr, fq * 8), boff = lds_byte(wc * 32 + fr, fq * 8);
    constexpr int aoff1 = 1024, boff1 = 1024;
#define PG8_SA(b, h) (((b) * 2 + (h)) * HTB)
#define PG8_SB(b, h) ((4 + (b) * 2 + (h)) * HTB)
#define PG8_STAGE(bufoff, gbase, voff) do { _Pragma("unroll") for (int _i = 0; _i < 2; ++_i) \
        __builtin_amdgcn_global_load_lds((const unsigned*)((const char*)(gbase) + (voff)[_i]), (LAS unsigned*)(lds + (bufoff) + ldsw + _i * 8192), 16, 0, 0); } while (0)
#define PG8_STA(bufoff, ptr, h, nx) do { if constexpr (GATH) { const unsigned vsel_[2] = {(nx) ? vnx[h][0] : vcu[h][0], (nx) ? vnx[h][1] : vcu[h][1]}; PG8_STAGE(bufoff, ptr, vsel_); } \
        else { PG8_STAGE(bufoff, (ptr) + (h) * hstepA, voffA); } } while (0)
#define PG8_LDA(dst, b, h) do { _Pragma("unroll") for (int m = 0; m < 4; ++m) dst[m] = cat8(*(const LAS bf16x8*)(lds + PG8_SA(b, h) + aoff + m * 2048), *(const LAS bf16x8*)(lds + PG8_SA(b, h) + aoff + m * 2048 + aoff1)); } while (0)
#define PG8_LDB(dst, b, h) do { _Pragma("unroll") for (int n = 0; n < 2; ++n) dst[n] = cat8(*(const LAS bf16x8*)(lds + PG8_SB(b, h) + boff + n * 2048), *(const LAS bf16x8*)(lds + PG8_SB(b, h) + boff + n * 2048 + boff1)); } while (0)
#define PG8_MMA(ai, bj, At, Bt) do { __builtin_amdgcn_s_setprio(1); \
        if constexpr (F8) { _Pragma("unroll") for (int m = 0; m < 4; ++m) _Pragma("unroll") for (int n = 0; n < 2; ++n) \
            asm volatile("s_nop 1\n\tv_mfma_scale_f32_16x16x128_f8f6f4 %0, %1, %2, %0, %3, %3 op_sel_hi:[0,0,0]" : "+v"(acc[ai][bj][m][n]) : "v"(Bt[n]), "v"(At[m]), "v"(sc127)); } \
        else { _Pragma("unroll") for (int m = 0; m < 4; ++m) _Pragma("unroll") for (int n = 0; n < 2; ++n) { \
            acc[ai][bj][m][n] = __builtin_amdgcn_mfma_f32_16x16x32_bf16(half8<0>(Bt[n]), half8<0>(At[m]), acc[ai][bj][m][n], 0, 0, 0); \
            acc[ai][bj][m][n] = __builtin_amdgcn_mfma_f32_16x16x32_bf16(half8<1>(Bt[n]), half8<1>(At[m]), acc[ai][bj][m][n], 0, 0, 0); } } \
        __builtin_amdgcn_s_setprio(0); } while (0)
#define PG8_WAIT_V(n) asm volatile("s_waitcnt vmcnt(" #n ")" ::: "memory")
#define PG8_WAIT_L(n) asm volatile("s_waitcnt lgkmcnt(" #n ")" ::: "memory")
#define PG8_BAR __builtin_amdgcn_s_barrier()
#define PG8_SCHED __builtin_amdgcn_sched_barrier(0)
    Unit cur, nxt; int ui = 0;
    if (!S.next(0, cur)) return;
    f32x4 acc[2][2][4][2];
#pragma unroll
    for (int a = 0; a < 2; ++a)
#pragma unroll
        for (int b = 0; b < 2; ++b)
#pragma unroll
            for (int m = 0; m < 4; ++m)
#pragma unroll
                for (int n = 0; n < 2; ++n) acc[a][b][m][n] = (f32x4){0.f, 0.f, 0.f, 0.f};
    int sc127 = 127; asm volatile("" : "+v"(sc127));
    v8i At[4], B0[2], B1[2];
    const char* cA = (const char*)(g.A + cur.a_off); const char* cB = (const char*)(g.Bt + cur.b_off);
    if constexpr (GATH) {
#pragma unroll
        for (int h = 0; h < 2; ++h)
#pragma unroll
            for (int i = 0; i < 2; ++i) vcu[h][i] = S.rowoff(cur, h * HALF + gR[i]) + gC[i]; }
    if constexpr (SP2) {
        PG8_STAGE(PG8_SB(0, 0), cB, voffB); PG8_STAGE(PG8_SB(0, 1), cB + hstepB, voffB); PG8_STA(PG8_SA(0, 0), cA, 0, false); PG8_STA(PG8_SA(0, 1), cA, 1, false);
        if (wr == 1) PG8_BAR;
        PG8_WAIT_V(2); PG8_BAR;
        PG8_STAGE(PG8_SB(1, 0), cB + kstep, voffB); PG8_STA(PG8_SA(1, 0), cA + kstep, 0, false); PG8_STAGE(PG8_SB(1, 1), cB + hstepB + kstep, voffB);
        PG8_WAIT_V(6); PG8_BAR;
    } else {
        PG8_STAGE(PG8_SB(0, 0), cB, voffB); PG8_STA(PG8_SA(0, 0), cA, 0, false); PG8_STAGE(PG8_SB(0, 1), cB + hstepB, voffB); PG8_STA(PG8_SA(0, 1), cA, 1, false);
        if (wr == 1) PG8_BAR;
        PG8_WAIT_V(4); PG8_BAR;
        PG8_STAGE(PG8_SB(1, 0), cB + kstep, voffB); PG8_STA(PG8_SA(1, 0), cA + kstep, 0, false); PG8_STAGE(PG8_SB(1, 1), cB + hstepB + kstep, voffB);
        PG8_WAIT_V(6); PG8_BAR;
    }
    for (;;) {
        const bool has_next = S.next(ui + 1, nxt);
        const char* nA = has_next ? (const char*)(g.A + nxt.a_off) : cA; const char* nB = has_next ? (const char*)(g.Bt + nxt.b_off) : cB;
        if constexpr (GATH) {
#pragma unroll
            for (int h = 0; h < 2; ++h)
#pragma unroll
                for (int i = 0; i < 2; ++i) vnx[h][i] = has_next ? (S.rowoff(nxt, h * HALF + gR[i]) + gC[i]) : vcu[h][i]; }
#pragma unroll 1
        for (int t = 0; t < nt; t += 2) {
            if constexpr (Epi::MIDK) { if (t == (nt >> 1)) E.midk(acc, cur, wr, wc, fr, fq); }
            const bool last = (t == nt - 2); const bool skipw = SKIPW && SP2 && (t == 0) && (ui > 0);
            const char* a1 = cA + (size_t)(t + 1) * kstep;
            const char* a2 = last ? nA : cA + (size_t)(t + 2) * kstep; const char* b2 = last ? nB : cB + (size_t)(t + 2) * kstep;
            const char* a3 = a2 + kstep; const char* b3 = b2 + kstep;
            if constexpr (SP2) {
            PG8_LDB(B0, 0, 0); PG8_LDB(B1, 0, 1); PG8_SCHED; PG8_LDA(At, 0, 0); PG8_STA(PG8_SA(1, 1), a1, 1, false);
            if (!skipw) PG8_WAIT_V(8); PG8_WAIT_L(0); PG8_BAR; PG8_MMA(0, 0, At, B0); PG8_MMA(0, 1, At, B1); PG8_BAR; PG8_SCHED;
            PG8_LDA(At, 0, 1); PG8_STAGE(PG8_SB(0, 0), b2, voffB); PG8_STAGE(PG8_SB(0, 1), b2 + hstepB, voffB); PG8_STA(PG8_SA(0, 0), a2, 0, last);
            if (!skipw) PG8_WAIT_V(8); PG8_WAIT_L(0); PG8_BAR; PG8_MMA(1, 0, At, B0); PG8_MMA(1, 1, At, B1); PG8_BAR; PG8_SCHED;
            PG8_LDB(B0, 1, 0); PG8_LDB(B1, 1, 1); PG8_SCHED; PG8_LDA(At, 1, 0); PG8_STA(PG8_SA(0, 1), a2, 1, last);
            PG8_WAIT_V(8); PG8_WAIT_L(0); PG8_BAR; PG8_MMA(0, 0, At, B0); PG8_MMA(0, 1, At, B1); PG8_BAR; PG8_SCHED;
            PG8_LDA(At, 1, 1); PG8_STAGE(PG8_SB(1, 0), b3, voffB); PG8_STAGE(PG8_SB(1, 1), b3 + hstepB, voffB); PG8_STA(PG8_SA(1, 0), a3, 0, last);
            PG8_WAIT_V(8); PG8_WAIT_L(0); PG8_BAR; PG8_MMA(1, 0, At, B0); PG8_MMA(1, 1, At, B1); PG8_BAR; PG8_SCHED;
            } else {
            PG8_LDB(B0, 0, 0); PG8_SCHED; PG8_LDA(At, 0, 0); PG8_STA(PG8_SA(1, 1), a1, 1, false);
            PG8_WAIT_L(8); PG8_BAR; PG8_WAIT_L(0); PG8_MMA(0, 0, At, B0); PG8_BAR; PG8_SCHED;
            PG8_LDB(B1, 0, 1); PG8_STAGE(PG8_SB(0, 0), b2, voffB);
            PG8_BAR; PG8_WAIT_L(0); PG8_MMA(0, 1, At, B1); PG8_BAR;
            PG8_LDA(At, 0, 1); PG8_STA(PG8_SA(0, 0), a2, 0, last);
            PG8_BAR; PG8_WAIT_L(0); PG8_MMA(1, 0, At, B0); PG8_BAR; PG8_SCHED;
            PG8_STAGE(PG8_SB(0, 1), b2 + hstepB, voffB);
            PG8_WAIT_V(6); PG8_BAR; PG8_MMA(1, 1, At, B1); PG8_BAR;
            PG8_LDB(B0, 1, 0); PG8_SCHED; PG8_LDA(At, 1, 0); PG8_STA(PG8_SA(0, 1), a2, 1, last);
            PG8_WAIT_L(8); PG8_BAR; PG8_WAIT_L(0); PG8_MMA(0, 0, At, B0); PG8_BAR; PG8_SCHED;
            PG8_LDB(B1, 1, 1); PG8_STAGE(PG8_SB(1, 0), b3, voffB);
            PG8_BAR; PG8_WAIT_L(0); PG8_MMA(0, 1, At, B1); PG8_BAR;
            PG8_LDA(At, 1, 1); PG8_STA(PG8_SA(1, 0), a3, 0, last);
            PG8_BAR; PG8_WAIT_L(0); PG8_MMA(1, 0, At, B0); PG8_BAR; PG8_SCHED;
            PG8_STAGE(PG8_SB(1, 1), b3 + hstepB, voffB);
            PG8_WAIT_V(6); PG8_BAR; PG8_MMA(1, 1, At, B1); PG8_BAR;
            }
        }
        if constexpr (ALIGN_EPI) { if (wr == 0) PG8_BAR; }
        if constexpr (F8) {
#pragma unroll
            for (int a = 0; a < 2; ++a)
#pragma unroll
                for (int b = 0; b < 2; ++b)
                    asm volatile("s_nop 15\n\ts_nop 7" : "+v"(acc[a][b][0][0]), "+v"(acc[a][b][0][1]), "+v"(acc[a][b][1][0]), "+v"(acc[a][b][1][1]), "+v"(acc[a][b][2][0]), "+v"(acc[a][b][2][1]), "+v"(acc[a][b][3][0]), "+v"(acc[a][b][3][1]));
        }
        if constexpr (SP2 && SKIPW) PG8_WAIT_V(0);
        E(acc, cur, wr, wc, fr, fq);
        if (!has_next) break;
#pragma unroll
        for (int a = 0; a < 2; ++a)
#pragma unroll
            for (int b = 0; b < 2; ++b)
#pragma unroll
                for (int m = 0; m < 4; ++m)
#pragma unroll
                    for (int n = 0; n < 2; ++n) acc[a][b][m][n] = (f32x4){0.f, 0.f, 0.f, 0.f};
        cur = nxt; cA = nA; cB = nB; ++ui;
        if constexpr (GATH) {
#pragma unroll
            for (int h = 0; h < 2; ++h)
#pragma unroll
                for (int i = 0; i < 2; ++i) vcu[h][i] = vnx[h][i]; }
        if constexpr (ALIGN_EPI) { if (wr == 1) PG8_BAR; }
    }
    PG8_WAIT_V(0);
    if constexpr (!ALIGN_EPI) { if (wr == 0) PG8_BAR; }
    PG8_BAR;
#undef PG8_SA
#undef PG8_SB
#undef PG8_STAGE
#undef PG8_STA
#undef PG8_LDA
#undef PG8_LDB
#undef PG8_MMA
#undef PG8_WAIT_V
#undef PG8_WAIT_L
#undef PG8_BAR
#undef PG8_SCHED
}
#define GEMM_PHASE(lds, g, S, E) gemm_phase<decltype(E), decltype(S), true, true>(lds, g, S, E)
#define GEMM_PHASE8(lds, g, S, E) gemm_phase<decltype(E), decltype(S), true, true, true>(lds, g, S, E)
#define GEMM_PHASE8N(lds, g, S, E) gemm_phase<decltype(E), decltype(S), true, true, true, false>(lds, g, S, E)

__device__ __forceinline__ float rstd_from_ssq(const float* ssq, int row) {
    const f32x4* p = (const f32x4*)(ssq + (size_t)row * 16); const f32x4 a = p[0], b = p[1], c = p[2], d = p[3];
    const float s = ((a[0] + a[1]) + (a[2] + a[3])) + ((b[0] + b[1]) + (b[2] + b[3])) + ((c[0] + c[1]) + (c[2] + c[3])) + ((d[0] + d[1]) + (d[2] + d[3]));
    return __builtin_amdgcn_rsqf(s * (1.0f / DM) + EPS);
}
__device__ __forceinline__ u32x4 pack8(const f32x4 v0, const f32x4 v1) { u32x4 w; w.x = cvt_pk_bf16(v0[0], v0[1]); w.y = cvt_pk_bf16(v0[2], v0[3]); w.z = cvt_pk_bf16(v1[0], v1[1]); w.w = cvt_pk_bf16(v1[2], v1[3]); return w; }

struct EpiProj {
    static constexpr bool PERM = true, LDSX = false, MIDK = false;
    bf16_t* base; const float* rope; float* ksum;
    __device__ __forceinline__ void operator()(f32x4 (&acc)[2][2][4][2], const Unit& u, int wr, int wc, int fr, int fq) const {
        const int type = u.pn >> 1, colt = (u.pn & 1) * 256;
        bf16_t* O = base + (size_t)type * NTOK * 512;
        const bool is_q = (type == 2), is_k = (type == 3);
        if ((is_q || is_k) && !(wc & 1)) {
#pragma unroll
            for (int ai = 0; ai < 2; ++ai)
#pragma unroll
                for (int m = 0; m < 4; ++m) {
                    const int row = u.pm * 256 + 128 * ai + 64 * wr + 16 * m + fr, pos = row & (SEQ - 1);
                    const float* rp = rope + pos * 16;
                    const f32x4 cs[2] = { *(const f32x4*)(rp), *(const f32x4*)(rp + 4) }, sn[2] = { *(const f32x4*)(rp + 8), *(const f32x4*)(rp + 12) };
#pragma unroll
                    for (int bj = 0; bj < 2; ++bj)
#pragma unroll
                        for (int n = 0; n < 2; ++n) {
                            const f32x4 mine = acc[ai][bj][m][n]; f32x4 oth;
#pragma unroll
                            for (int e = 0; e < 4; ++e) oth[e] = __shfl_xor(mine[e], 16);
                            f32x4 res = mine;
                            if (fq == 0) res = mine * cs[n] - oth * sn[n];
                            else if (fq == 1) res = mine * cs[n] + oth * sn[n];
                            acc[ai][bj][m][n] = res;
                        }
                }
        }
        const float sc = is_q ? QSCALE : 1.0f;
#pragma unroll
        for (int ai = 0; ai < 2; ++ai)
#pragma unroll
            for (int m = 0; m < 4; ++m) {
                const int row = u.pm * 256 + 128 * ai + 64 * wr + 16 * m + fr;
                bf16_t* rowp = O + (size_t)row * 512 + colt + 32 * wc + 8 * fq;
#pragma unroll
                for (int bj = 0; bj < 2; ++bj) *(u32x4*)(rowp + bj * 128) = pack8(acc[ai][bj][m][0] * sc, acc[ai][bj][m][1] * sc);
            }
        if (is_k) {
#pragma unroll
            for (int bj = 0; bj < 2; ++bj)
#pragma unroll
                for (int n = 0; n < 2; ++n)
#pragma unroll
                    for (int e = 0; e < 4; ++e) {
                        float s = 0.f;
#pragma unroll
                        for (int ai = 0; ai < 2; ++ai)
#pragma unroll
                            for (int m = 0; m < 4; ++m) s += acc[ai][bj][m][n][e];
                        s += __shfl_xor(s, 1); s += __shfl_xor(s, 2); s += __shfl_xor(s, 4); s += __shfl_xor(s, 8);
                        if (fr == 0) atomicAdd(ksum + (size_t)u.pm * 512 + colt + 128 * bj + 32 * wc + 8 * fq + 4 * n + e, s);
                    }
        }
    }
};
struct EpiStore {
    static constexpr bool PERM = true, LDSX = false, MIDK = false;
    bf16_t* O; int ldc; float sc = 1.0f;
    __device__ __forceinline__ void operator()(f32x4 (&acc)[2][2][4][2], const Unit& u, int wr, int wc, int fr, int fq) const {
#pragma unroll
        for (int ai = 0; ai < 2; ++ai)
#pragma unroll
            for (int m = 0; m < 4; ++m) {
                const int row = u.pm * 256 + 128 * ai + 64 * wr + 16 * m + fr;
                bf16_t* rowp = O + (size_t)row * ldc + u.pn * 256 + 32 * wc + 8 * fq;
#pragma unroll
                for (int bj = 0; bj < 2; ++bj) *(u32x4*)(rowp + bj * 128) = pack8(acc[ai][bj][m][0] * sc, acc[ai][bj][m][1] * sc);
            }
    }
};
struct EpiStore8 {
    static constexpr bool PERM = true, LDSX = false, MIDK = false;
    unsigned char* O; int ldc; float sc;
    __device__ __forceinline__ void operator()(f32x4 (&acc)[2][2][4][2], const Unit& u, int wr, int wc, int fr, int fq) const {
#pragma unroll
        for (int ai = 0; ai < 2; ++ai)
#pragma unroll
            for (int m = 0; m < 4; ++m) {
                const int row = u.pm * 256 + 128 * ai + 64 * wr + 16 * m + fr;
                unsigned char* rowp = O + (size_t)row * ldc + u.pn * 256 + 32 * wc + 8 * fq;
#pragma unroll
                for (int bj = 0; bj < 2; ++bj) { const f32x4 a0 = acc[ai][bj][m][0] * sc, a1 = acc[ai][bj][m][1] * sc; u32x2 w; w.x = pk4_fp8(a0[0], a0[1], a0[2], a0[3]); w.y = pk4_fp8(a1[0], a1[1], a1[2], a1[3]); *(u32x2*)(rowp + bj * 128) = w; }
            }
    }
};
template <bool BASE_F32, bool KSPLIT> struct EpiResid {
    static constexpr bool PERM = true, LDSX = false, MIDK = KSPLIT;
    const void* base; bf16_t* hb; float* ssq; const float* ssql; const float* ssqa; unsigned char* h8; float asc; const float* rs0 = nullptr; const float* gmix = nullptr;
    __device__ __forceinline__ void stats(int row, int fq, float& rl, float& ra) const {
        const f32x4 pl = *(const f32x4*)(ssql + (size_t)row * 16 + 4 * fq); const f32x2 pa = *(const f32x2*)(ssqa + (size_t)row * 8 + 2 * fq);
        float sl = (pl[0] + pl[1]) + (pl[2] + pl[3]), sa = pa[0] + pa[1];
        sl += __shfl_xor(sl, 16); sl += __shfl_xor(sl, 32); sa += __shfl_xor(sa, 16); sa += __shfl_xor(sa, 32);
        rl = __builtin_amdgcn_rsqf(sl * (1.0f / 512.0f) + EPS); ra = __builtin_amdgcn_rsqf(sa * (1.0f / 512.0f) + EPS);
    }
    __device__ __forceinline__ void midk(f32x4 (&acc)[2][2][4][2], const Unit& u, int wr, int wc, int fr, int fq) const {
        asm volatile("" : "+v"(fr), "+v"(fq));
#pragma unroll
        for (int ai = 0; ai < 2; ++ai)
#pragma unroll
            for (int m = 0; m < 4; ++m) { float rl, ra; stats(u.pm * 256 + 128 * ai + 64 * wr + 16 * m + fr, fq, rl, ra); const float ratio = rl * __builtin_amdgcn_rcpf(ra);
#pragma unroll
                for (int bj = 0; bj < 2; ++bj)
#pragma unroll
                    for (int n = 0; n < 2; ++n) acc[ai][bj][m][n] *= ratio; }
    }
    __device__ __forceinline__ void operator()(f32x4 (&acc)[2][2][4][2], const Unit& u, int wr, int wc, int fr, int fq) const {
        f32x4 ginv[2][2];
        if constexpr (BASE_F32) {
#pragma unroll
            for (int bj = 0; bj < 2; ++bj)
#pragma unroll
                for (int n = 0; n < 2; ++n) { const f32x4 g = *(const f32x4*)(gmix + u.pn * 256 + 128 * bj + 32 * wc + 8 * fq + 4 * n);
                    ginv[bj][n] = (f32x4){__builtin_amdgcn_rcpf(g[0]), __builtin_amdgcn_rcpf(g[1]), __builtin_amdgcn_rcpf(g[2]), __builtin_amdgcn_rcpf(g[3])}; } }
#pragma unroll
        for (int ai = 0; ai < 2; ++ai)
#pragma unroll
            for (int m = 0; m < 4; ++m) {
                const int row = u.pm * 256 + 128 * ai + 64 * wr + 16 * m + fr; float q = 0.f, osc = asc, irs = 1.0f;
                if constexpr (KSPLIT) { float rl; stats(row, fq, rl, osc); osc *= asc; }
                if constexpr (BASE_F32) irs = __builtin_amdgcn_rcpf(rs0[row]);
#pragma unroll
                for (int bj = 0; bj < 2; ++bj) {
                    const int col = u.pn * 256 + 128 * bj + 32 * wc + 8 * fq;
                    f32x4 b0, b1;
                    if constexpr (BASE_F32) { const u32x4 w = *(const u32x4*)((const bf16_t*)base + (size_t)row * DM + col);
                        b0 = (f32x4){bflo(w.x), bfhi(w.x), bflo(w.y), bfhi(w.y)} * (ginv[bj][0] * irs); b1 = (f32x4){bflo(w.z), bfhi(w.z), bflo(w.w), bfhi(w.w)} * (ginv[bj][1] * irs); }
                    else { const u32x4 w = *(const u32x4*)((const bf16_t*)base + (size_t)row * LDH + col); b0 = (f32x4){bflo(w.x), bfhi(w.x), bflo(w.y), bfhi(w.y)}; b1 = (f32x4){bflo(w.z), bfhi(w.z), bflo(w.w), bfhi(w.w)}; }
                    const f32x4 v0 = b0 + acc[ai][bj][m][0] * osc, v1 = b1 + acc[ai][bj][m][1] * osc;
                    q += ((v0[0] * v0[0] + v0[1] * v0[1]) + (v0[2] * v0[2] + v0[3] * v0[3])) + ((v1[0] * v1[0] + v1[1] * v1[1]) + (v1[2] * v1[2] + v1[3] * v1[3]));
                    *(u32x4*)(hb + (size_t)row * LDH + col) = pack8(v0, v1);
                    if (h8) { u32x2 w8; w8.x = pk4_fp8(v0[0], v0[1], v0[2], v0[3]); w8.y = pk4_fp8(v1[0], v1[1], v1[2], v1[3]); *(u32x2*)(h8 + (size_t)row * DM + col) = w8; }
                }
                q += __shfl_xor(q, 16); q += __shfl_xor(q, 32);
                if (fq == 0) ssq[(size_t)row * 16 + u.pn * 4 + wc] = q;
            }
    }
};
#define XBAR() do { asm volatile("s_waitcnt lgkmcnt(0)" ::: "memory"); __builtin_amdgcn_s_barrier(); asm volatile("" ::: "memory"); } while (0)
struct EpiSoftmax {
    static constexpr bool PERM = true, LDSX = false, MIDK = false;
    unsigned char* O; int ldc; LAS unsigned char* xl; const float* ssq; float cs;
    __device__ __forceinline__ void operator()(f32x4 (&acc)[2][2][4][2], const Unit& u, int wr, int wc, int fr, int fq) const {
        LAS float* P = (LAS float*)xl;
        LAS float* Q = (LAS float*)(xl + 4096);
#pragma unroll
        for (int ai = 0; ai < 2; ++ai)
#pragma unroll
            for (int m = 0; m < 4; ++m) {
                float v = -INFINITY; const float sc = rstd_from_ssq(ssq, u.pm * 256 + 128 * ai + 64 * wr + 16 * m + fr) * cs;
#pragma unroll
                for (int bj = 0; bj < 2; ++bj)
#pragma unroll
                    for (int n = 0; n < 2; ++n) { const f32x4 x = acc[ai][bj][m][n] * sc; acc[ai][bj][m][n] = x; v = fmaxf(v, fmaxf(fmaxf(x[0], x[1]), fmaxf(x[2], x[3]))); }
                v = fmaxf(v, __shfl_xor(v, 16)); v = fmaxf(v, __shfl_xor(v, 32));
                if (fq == 0) P[(128 * ai + 64 * wr + 16 * m + fr) * 4 + wc] = v;
            }
        XBAR();
#pragma unroll
        for (int ai = 0; ai < 2; ++ai)
#pragma unroll
            for (int m = 0; m < 4; ++m) {
                const int r = 128 * ai + 64 * wr + 16 * m + fr;
                const float v = fmaxf(fmaxf(P[r * 4 + 0], P[r * 4 + 1]), fmaxf(P[r * 4 + 2], P[r * 4 + 3]));
                float s = 0.f;
#pragma unroll
                for (int bj = 0; bj < 2; ++bj)
#pragma unroll
                    for (int n = 0; n < 2; ++n) { f32x4 x = acc[ai][bj][m][n];
#pragma unroll
                        for (int e = 0; e < 4; ++e) { x[e] = __builtin_amdgcn_exp2f(x[e] - v); s += x[e]; }
                        acc[ai][bj][m][n] = x; }
                s += __shfl_xor(s, 16); s += __shfl_xor(s, 32);
                if (fq == 0) Q[r * 4 + wc] = s;
            }
        XBAR();
#pragma unroll
        for (int ai = 0; ai < 2; ++ai)
#pragma unroll
            for (int m = 0; m < 4; ++m) {
                const int r = 128 * ai + 64 * wr + 16 * m + fr;
                const float inv = PX_SC * __builtin_amdgcn_rcpf((Q[r * 4 + 0] + Q[r * 4 + 1]) + (Q[r * 4 + 2] + Q[r * 4 + 3]));
                unsigned char* rowp = O + (size_t)(u.pm * 256 + r) * ldc + u.pn * 256 + 32 * wc + 8 * fq;
#pragma unroll
                for (int bj = 0; bj < 2; ++bj) { const f32x4 a0 = acc[ai][bj][m][0] * inv, a1 = acc[ai][bj][m][1] * inv; u32x2 w; w.x = pk4_fp8(a0[0], a0[1], a0[2], a0[3]); w.y = pk4_fp8(a1[0], a1[1], a1[2], a1[3]); *(u32x2*)(rowp + bj * 128) = w; }
            }
        XBAR();
    }
};
struct EpiGateUp {
    static constexpr bool PERM = true, LDSX = false, MIDK = false;
    unsigned char* O; const float* lrs;
    __device__ __forceinline__ void operator()(f32x4 (&acc)[2][2][4][2], const Unit& u, int wr, int wc, int fr, int fq) const {
#pragma unroll
        for (int ai = 0; ai < 2; ++ai)
#pragma unroll
            for (int m = 0; m < 4; ++m) {
                const int r = 128 * ai + 64 * wr + 16 * m + fr, row = u.pm * 256 + r; const float rs = (r < u.nvalid) ? lrs[u.lbase + r] * (1.0f / WGU_SC) : 0.f;
                f32x4 o[2];
#pragma unroll
                for (int n = 0; n < 2; ++n)
#pragma unroll
                    for (int e = 0; e < 4; ++e) { const float g = acc[ai][0][m][n][e] * rs, up = acc[ai][1][m][n][e] * rs; o[n][e] = g * sigmoidf_(g) * up * ACT_SC; }
                u32x2 w8; w8.x = pk4_fp8(o[0][0], o[0][1], o[0][2], o[0][3]); w8.y = pk4_fp8(o[1][0], o[1][1], o[1][2], o[1][3]);
                *(u32x2*)(O + (size_t)row * DFF + u.pn * 128 + 32 * wc + 8 * fq) = w8;
            }
    }
};

struct Args { const float* in[27]; float* out; unsigned char* ws; int ph_lo, ph_hi; float invf[8]; };
struct Ctx { LAS unsigned char* lds; int tid, lane, wave, vcu, G; };

__device__ __forceinline__ void tr_load(f32x4 (&v)[8], const float* W, int ldw, int k0, int n0s, int lane) {
    const int kr = lane >> 3, ch = lane & 7;
#pragma unroll
    for (int i = 0; i < 8; ++i) v[i] = *(const f32x4*)(W + (size_t)(k0 + 8 * i + kr) * ldw + n0s + 4 * ch);
}
__device__ __forceinline__ void tr_finish(const f32x4 (&v)[8], int k0, bf16_t* WT, int ldt, int r0d, const float* gain, LAS float* scr, int lane) {
    const int kr = lane >> 3, ch = lane & 7, c = lane & 7;
    f32x4 g0 = {1.f, 1.f, 1.f, 1.f}, g1 = {1.f, 1.f, 1.f, 1.f};
    if (gain) { g0 = *(const f32x4*)(gain + k0 + 8 * c); g1 = *(const f32x4*)(gain + k0 + 8 * c + 4); }
#pragma unroll
    for (int i = 0; i < 8; ++i) { LAS float* d = scr + (8 * i + kr) * 33 + 4 * ch; d[0] = v[i][0]; d[1] = v[i][1]; d[2] = v[i][2]; d[3] = v[i][3]; }
    LDS_WAIT(); asm volatile("" ::: "memory");
#pragma unroll
    for (int j = 0; j < 4; ++j) { const int n = (lane >> 3) + 8 * j; const LAS float* s = scr + (8 * c) * 33 + n;
        u32x4 o; o.x = cvt_pk_bf16(s[0 * 33] * g0[0], s[1 * 33] * g0[1]); o.y = cvt_pk_bf16(s[2 * 33] * g0[2], s[3 * 33] * g0[3]); o.z = cvt_pk_bf16(s[4 * 33] * g1[0], s[5 * 33] * g1[1]); o.w = cvt_pk_bf16(s[6 * 33] * g1[2], s[7 * 33] * g1[3]);
        *(u32x4*)(WT + (size_t)(r0d + n) * ldt + k0 + 8 * c) = o; }
    LDS_WAIT(); asm volatile("" ::: "memory");
}
__device__ __forceinline__ void tr_finish8(const f32x4 (&v)[8], int k0, unsigned char* WT8, int ldt, int r0d, const float* gain, float sc, LAS float* scr, int lane) {
    const int kr = lane >> 3, ch = lane & 7, c = lane & 7;
    f32x4 g0 = {sc, sc, sc, sc}, g1 = {sc, sc, sc, sc};
    if (gain) { g0 = *(const f32x4*)(gain + k0 + 8 * c) * sc; g1 = *(const f32x4*)(gain + k0 + 8 * c + 4) * sc; }
#pragma unroll
    for (int i = 0; i < 8; ++i) { LAS float* d = scr + (8 * i + kr) * 33 + 4 * ch; d[0] = v[i][0]; d[1] = v[i][1]; d[2] = v[i][2]; d[3] = v[i][3]; }
    LDS_WAIT(); asm volatile("" ::: "memory");
#pragma unroll
    for (int j = 0; j < 4; ++j) { const int n = (lane >> 3) + 8 * j; const LAS float* s = scr + (8 * c) * 33 + n;
        u32x2 o; o.x = pk4_fp8(s[0 * 33] * g0[0], s[1 * 33] * g0[1], s[2 * 33] * g0[2], s[3 * 33] * g0[3]); o.y = pk4_fp8(s[4 * 33] * g1[0], s[5 * 33] * g1[1], s[6 * 33] * g1[2], s[7 * 33] * g1[3]);
        *(u32x2*)(WT8 + (size_t)(r0d + n) * ldt + k0 + 8 * c) = o; }
    LDS_WAIT(); asm volatile("" ::: "memory");
}
__device__ __forceinline__ void tr_item(const float* W, int ldw, int k0, int n0s, bf16_t* WT, int ldt, int r0d, const float* gain, LAS float* scr, int lane) {
    f32x4 v[8]; tr_load(v, W, ldw, k0, n0s, lane); tr_finish(v, k0, WT, ldt, r0d, gain, scr, lane);
}

__device__ __forceinline__ void rms_row2_to_bf16(const float* xrow, const float* gain, bf16_t* orow, int lane, float* rstd_out = nullptr) {
    const f32x4* xr = (const f32x4*)xrow + lane; const f32x4* gr = (const f32x4*)gain + lane;
    f32x4 v[2][4]; float s[2] = {0.f, 0.f};
#pragma unroll
    for (int r = 0; r < 2; ++r)
#pragma unroll
        for (int j = 0; j < 4; ++j) v[r][j] = xr[256 * r + 64 * j];
#pragma unroll
    for (int r = 0; r < 2; ++r)
#pragma unroll
        for (int j = 0; j < 4; ++j) s[r] += (v[r][j][0] * v[r][j][0] + v[r][j][1] * v[r][j][1]) + (v[r][j][2] * v[r][j][2] + v[r][j][3] * v[r][j][3]);
#pragma unroll
    for (int r = 0; r < 2; ++r) { const float rstd = 1.0f / sqrtf(wave_sum(s[r]) * (1.0f / DM) + EPS); u32x2* o8 = (u32x2*)(orow + (size_t)r * DM) + lane; if (rstd_out && lane == 0) rstd_out[r] = rstd;
#pragma unroll
        for (int j = 0; j < 4; ++j) { const f32x4 g = gr[64 * j]; u32x2 w; w.x = cvt_pk_bf16(v[r][j][0] * rstd * g[0], v[r][j][1] * rstd * g[1]); w.y = cvt_pk_bf16(v[r][j][2] * rstd * g[2], v[r][j][3] * rstd * g[3]); o8[64 * j] = w; } }
}

__device__ __forceinline__ void conv_wdn(const Args& a, const Ctx& C, int gw, int NGW, int it_lo, int NIT) {
    LAS float* scr = (LAS float*)(C.lds + C.wave * 16384); const int lane = C.lane;
    f32x4 va[8], vb[8];
#define WDN_LOAD(v, it) do { const int e_ = (it) / 256, r_ = (it) % 256; tr_load(v, a.in[25] + (size_t)e_ * DFF * DM, DM, 64 * (r_ / 32), 32 * (r_ % 32), lane); } while (0)
#define WDN_FIN(v, it) do { const int e_ = (it) / 256, r_ = (it) % 256; tr_finish8(v, 64 * (r_ / 32), a.ws + WS_WDN, DFF, e_ * 1024 + 32 * (r_ % 32), nullptr, WDN_SC, scr, lane); } while (0)
    int it = it_lo + gw; if (it < NIT) WDN_LOAD(va, it);
    for (; it < NIT; it += 2 * NGW) {
        const int it1 = it + NGW, it2 = it + 2 * NGW;
        if (it1 < NIT) WDN_LOAD(vb, it1);
        WDN_FIN(va, it);
        if (it2 < NIT) WDN_LOAD(va, it2);
        if (it1 < NIT) WDN_FIN(vb, it1);
    }
#undef WDN_LOAD
#undef WDN_FIN
}
__device__ __forceinline__ void ph_prologue(const Args& a, const Ctx& C) {
    unsigned char* ws = a.ws;
    LAS float* scr = (LAS float*)(C.lds + C.wave * 16384);
    const int gw = C.vcu * 8 + C.wave, NGW = C.G * 8, lane = C.lane;
    for (int it = gw; it < 16 * 80; it += NGW) { const int kb = it / 80, nb = it % 80; tr_item(a.in[3], DIN, 64 * kb, 32 * nb, (bf16_t*)(ws + WS_WIN), DM, 32 * nb, nullptr, scr, lane); }
    for (int it = gw; it < 16 * 64; it += NGW) { const int kb = it / 64, nb = it % 64;
        if (nb < 32) tr_item(a.in[17], 2 * DM, 64 * kb, 32 * nb, (bf16_t*)(ws + WS_WXK), DM, 32 * nb, nullptr, scr, lane);
        else tr_item(a.in[17], 2 * DM, 64 * kb, 32 * nb, (bf16_t*)(ws + WS_WXV), DM, 32 * (nb - 32), nullptr, scr, lane); }
    for (int it = gw; it < 16 * 32; it += NGW) { const int kb = it / 32, nb = it % 32;
        tr_item(a.in[13], DM, 64 * kb, 32 * nb, (bf16_t*)(ws + WS_WOUT), DM, 32 * nb, (kb < 8) ? a.in[11] : (a.in[12] - DLRU), scr, lane);
        tr_item(a.in[18], DM, 64 * kb, 32 * nb, (bf16_t*)(ws + WS_WXO), DM, 32 * nb, nullptr, scr, lane); }
    for (int r = gw; r < DM; r += NGW) { const float gk = a.in[14][r]; const f32x4* src = (const f32x4*)(a.in[16] + (size_t)r * DM) + lane; u32x2* dst = (u32x2*)((bf16_t*)(ws + WS_WXQ) + (size_t)r * DM) + lane;
#pragma unroll
        for (int j = 0; j < 4; ++j) { const f32x4 v = src[64 * j]; u32x2 w; w.x = cvt_pk_bf16(v[0] * gk, v[1] * gk); w.y = cvt_pk_bf16(v[2] * gk, v[3] * gk); dst[64 * j] = w; } }
    { bf16_t* WR = (bf16_t*)(ws + WS_WR); const int gt = C.vcu * 512 + C.tid, NT = C.G * 512;
      for (int i = gt; i < 48 * DM; i += NT) { const int r = i / DM, k = i % DM; float v = 0.f;
          if (r < 4) v = a.in[20][k * NGRP + r] * a.in[19][k]; else if (r < 36) v = a.in[22][k * NEXP + (r - 4)] * a.in[19][k];
          WR[i] = (bf16_t)(cvt_pk_bf16(v, 0.f) & 0xffffu); }
      float* rope = (float*)(ws + WS_ROPE);
      for (int i = gt; i < SEQ * 8; i += NT) { const int pos = i >> 3, j = i & 7; const float ang = (float)pos * a.invf[j];
          const double tw = 6.283185307179586476925286766559; const double ad = (double)ang; const double red = ad - tw * __builtin_rint(ad / tw); const float rf = (float)red;
          rope[pos * 16 + j] = __cosf(rf); rope[pos * 16 + 8 + j] = __sinf(rf); } }
    for (int m = 2 * gw; m < NTOK; m += 2 * NGW) rms_row2_to_bf16(a.in[0] + (size_t)m * DM, a.in[2], (bf16_t*)(ws + WS_B) + (size_t)m * DM, lane, (float*)(ws + WS_TOK + TOK_D) + m);
    for (int m = 2 * gw; m < NMEM; m += 2 * NGW) rms_row2_to_bf16(a.in[1] + (size_t)m * DM, a.in[15], (bf16_t*)(ws + WS_MEMN) + (size_t)m * DM, lane);
}

__device__ __forceinline__ float gelu_tanh(float x) { const float x2 = x * x; const float z2 = x * (-2.0f * 0.7978845608028654f * 1.4426950408889634f) * (1.0f + 0.044715f * x2);
    return x * __builtin_amdgcn_rcpf(1.0f + __builtin_amdgcn_exp2f(z2)); }
__device__ __forceinline__ bool moe_item_load(f32x4 (&v)[8], const Args& a, int s, int lane) {
    if (s < NEXP * 512) { const int e = s / 512, r = s % 512, kb = r / 32, nb = r % 32, j = nb >> 3, half = (nb >> 2) & 1, q = nb & 3;
        tr_load(v, a.in[24] + (size_t)e * DM * DM, DM, 64 * kb, half * 512 + j * 128 + q * 32, lane); return true; }
    const int it = s - NEXP * 512 + WDN_SPLIT; if (it >= NEXP * 256) return false;
    const int e = it / 256, r = it % 256; tr_load(v, a.in[25] + (size_t)e * DFF * DM, DM, 64 * (r / 32), 32 * (r % 32), lane); return true;
}
__device__ __forceinline__ void moe_item_finish(const f32x4 (&v)[8], const Args& a, int s, LAS float* scr, int lane) {
    if (s < NEXP * 512) { const int e = s / 512, r = s % 512, kb = r / 32, nb = r % 32, j = nb >> 3, half = (nb >> 2) & 1, q = nb & 3;
        tr_finish8(v, 64 * kb, a.ws + WS_WGU, DM, e * 1024 + j * 256 + half * 128 + q * 32, a.in[19], WGU_SC, scr, lane); return; }
    const int it = s - NEXP * 512 + WDN_SPLIT; const int e = it / 256, r = it % 256;
    tr_finish8(v, 64 * (r / 32), a.ws + WS_WDN, DFF, e * 1024 + 32 * (r % 32), nullptr, WDN_SC, scr, lane);
}
__device__ __forceinline__ void lru_unit(const Args& a, const Ctx& C, int b, int blk, int half, int L) {
    unsigned char* ws = a.ws;
    const bf16_t* XL = (const bf16_t*)(ws + WS_A); const bf16_t* GL = XL + (size_t)NTOK * 512; bf16_t* YC = (bf16_t*)(ws + WS_C); float* SSQL = (float*)(ws + WS_SSQL);
    const int tid = C.tid, lane = C.lane, wave = C.wave, fr = lane & 15, fq = lane >> 4;
    LAS float* cscr = (LAS float*)(C.lds + 46336 + wave * 8448);
    LAS float* XW = (LAS float*)(C.lds + wave * 5120);
    LAS bf16_t* GW = (LAS bf16_t*)(C.lds + wave * 5120 + 2304);
    LAS bf16_t* YW = (LAS bf16_t*)(C.lds + wave * 5120 + 3584);
    LAS float* WSUM = (LAS float*)(C.lds + 40960);
    LAS float* CW = (LAS float*)(C.lds + 45056);
    const int c0 = blk * 64, oc0 = c0 + half * 32;
    bf16x8 wfr[2][2][2];
#pragma unroll
    for (int gt = 0; gt < 2; ++gt) { const float* W = a.in[gt == 0 ? 6 : 8] + (size_t)blk * 64 * 64;
#pragma unroll
        for (int nt = 0; nt < 2; ++nt)
#pragma unroll
            for (int ks = 0; ks < 2; ++ks) { u32x4 w; float f[8];
#pragma unroll
                for (int j = 0; j < 8; ++j) f[j] = W[(32 * ks + 8 * fq + j) * 64 + half * 32 + 16 * nt + fr];
                w.x = cvt_pk_bf16(f[0], f[1]); w.y = cvt_pk_bf16(f[2], f[3]); w.z = cvt_pk_bf16(f[4], f[5]); w.w = cvt_pk_bf16(f[6], f[7]);
                wfr[gt][nt][ks] = __builtin_bit_cast(bf16x8, w); } }
    LAS bf16x8* WF = (LAS bf16x8*)(C.lds + 113920);
    if (wave == 0) {
#pragma unroll
        for (int gt = 0; gt < 2; ++gt)
#pragma unroll
            for (int nt = 0; nt < 2; ++nt)
#pragma unroll
                for (int ks = 0; ks < 2; ++ks) WF[((gt * 2 + nt) * 2 + ks) * 64 + lane] = wfr[gt][nt][ks]; }
    float brg[2], big[2], sp[2], hc[2] = {0.f, 0.f};
#pragma unroll
    for (int nt = 0; nt < 2; ++nt) { const int ch = oc0 + 16 * nt + fr; brg[nt] = a.in[7][ch] * -1.4426950408889634f; big[nt] = a.in[9][ch] * -1.4426950408889634f; const float lam = a.in[10][ch];
        sp[nt] = -8.0f * 1.4426950408889634f * ((lam > 15.f) ? __expf(-lam) : log1pf(__expf(-lam))); }
    if (tid < 320) { const int k = tid >> 6, c = tid & 63; CW[tid] = (k < 4) ? a.in[4][k * DLRU + c0 + c] : a.in[5][c0 + c]; }
    u32x4 xr1[4][2], gr1;
    const bf16_t* xrow0 = XL + ((size_t)b * SEQ + 16 * wave + fr) * 512 + c0 + 8 * fq;
    const bf16_t* grow0 = GL + ((size_t)b * SEQ + 16 * wave + (lane >> 2)) * 512 + oc0 + 8 * (lane & 3);
    const int tloc = 16 * wave + fr;
#define LRU_PREFETCH(t0_, xr, gr) do { _Pragma("unroll") for (int k = 0; k < 4; ++k) { const int tt = (t0_) + tloc - 3 + k; \
        if (tt >= 0) { const bf16_t* xp = xrow0 + (ptrdiff_t)((t0_) - 3 + k) * 512; xr[k][0] = *(const u32x4*)xp; xr[k][1] = *(const u32x4*)(xp + 32); } else { xr[k][0] = (u32x4){0u, 0u, 0u, 0u}; xr[k][1] = (u32x4){0u, 0u, 0u, 0u}; } } \
        gr = *(const u32x4*)(grow0 + (size_t)(t0_) * 512); } while (0)
    LRU_PREFETCH(0, xr1, gr1);
    __syncthreads();
    for (int ch2 = 0; ch2 < SEQ / 256; ++ch2) {
#pragma unroll
      for (int sub = 0; sub < 2; ++sub) { const int ch = 2 * ch2 + sub, t0 = ch * 128; auto& xr = xr1; auto& gr = gr1;
        f32x4 cv[8]; const int cslot = sub * (NEXP * 512) + (ch2 * 256 + L) * 8 + wave; const bool chas = moe_item_load(cv, a, cslot, lane);
        bf16x8 af[2];
#pragma unroll
        for (int ks = 0; ks < 2; ++ks) { float accv[8];
            { const f32x4 b0 = *(const LAS f32x4*)(CW + 256 + 32 * ks + 8 * fq), b1 = *(const LAS f32x4*)(CW + 256 + 32 * ks + 8 * fq + 4);
              accv[0] = b0[0]; accv[1] = b0[1]; accv[2] = b0[2]; accv[3] = b0[3]; accv[4] = b1[0]; accv[5] = b1[1]; accv[6] = b1[2]; accv[7] = b1[3]; }
#pragma unroll
            for (int k = 0; k < 4; ++k) { const f32x4 w0 = *(const LAS f32x4*)(CW + 64 * k + 32 * ks + 8 * fq), w1 = *(const LAS f32x4*)(CW + 64 * k + 32 * ks + 8 * fq + 4); const u32x4 x = xr[k][ks];
                accv[0] += w0[0] * bflo(x.x); accv[1] += w0[1] * bfhi(x.x); accv[2] += w0[2] * bflo(x.y); accv[3] += w0[3] * bfhi(x.y);
                accv[4] += w1[0] * bflo(x.z); accv[5] += w1[1] * bfhi(x.z); accv[6] += w1[2] * bflo(x.w); accv[7] += w1[3] * bfhi(x.w); }
            u32x4 p; p.x = cvt_pk_bf16(accv[0], accv[1]); p.y = cvt_pk_bf16(accv[2], accv[3]); p.z = cvt_pk_bf16(accv[4], accv[5]); p.w = cvt_pk_bf16(accv[6], accv[7]);
            af[ks] = __builtin_bit_cast(bf16x8, p);
            if (ks == half) { *(LAS f32x4*)(XW + fr * 36 + 8 * fq) = (f32x4){accv[0], accv[1], accv[2], accv[3]}; *(LAS f32x4*)(XW + fr * 36 + 8 * fq + 4) = (f32x4){accv[4], accv[5], accv[6], accv[7]}; } }
        *(LAS u32x4*)(GW + (lane >> 2) * 40 + 8 * (lane & 3)) = gr;
        if (ch + 1 < SEQ / 128) LRU_PREFETCH(t0 + 128, xr, gr);
        LDS_WAIT(); asm volatile("" ::: "memory");
        float Hl[2][4], Al[2][4], Aex[2], Hex[2];
        { f32x4 ar[2] = {{0.f, 0.f, 0.f, 0.f}, {0.f, 0.f, 0.f, 0.f}}, ai_[2] = {{0.f, 0.f, 0.f, 0.f}, {0.f, 0.f, 0.f, 0.f}};
#pragma unroll
          for (int ks = 0; ks < 2; ++ks)
#pragma unroll
              for (int nt = 0; nt < 2; ++nt) { ar[nt] = __builtin_amdgcn_mfma_f32_16x16x32_bf16(af[ks], WF[((0 * 2 + nt) * 2 + ks) * 64 + lane], ar[nt], 0, 0, 0); ai_[nt] = __builtin_amdgcn_mfma_f32_16x16x32_bf16(af[ks], WF[((1 * 2 + nt) * 2 + ks) * 64 + lane], ai_[nt], 0, 0, 0); }
#pragma unroll
          for (int nt = 0; nt < 2; ++nt) {
              float hrun = 0.f, arun = 1.f;
#pragma unroll
              for (int r = 0; r < 4; ++r) { const int chn = 16 * nt + fr;
                  const float rg = __builtin_amdgcn_rcpf(1.0f + __builtin_amdgcn_exp2f(__builtin_fmaf(ar[nt][r], -1.4426950408889634f, brg[nt])));
                  const float ig = __builtin_amdgcn_rcpf(1.0f + __builtin_amdgcn_exp2f(__builtin_fmaf(ai_[nt][r], -1.4426950408889634f, big[nt])));
                  const float av = __builtin_amdgcn_exp2f(rg * sp[nt]); const float mult = __builtin_amdgcn_sqrtf(fmaxf(1.0f - av * av, 0.f));
                  const float uv = mult * ig * XW[(4 * fq + r) * 36 + chn];
                  hrun = av * hrun + uv; arun *= av; Hl[nt][r] = hrun; Al[nt][r] = arun; }
              const float A0 = __shfl(arun, fr), H0 = __shfl(hrun, fr), A1 = __shfl(arun, fr + 16), H1 = __shfl(hrun, fr + 16), A2 = __shfl(arun, fr + 32), H2 = __shfl(hrun, fr + 32), A3 = __shfl(arun, fr + 48), H3 = __shfl(hrun, fr + 48);
              const float h01 = A1 * H0 + H1, a01 = A1 * A0, h012 = A2 * h01 + H2, a012 = A2 * a01;
              Aex[nt] = (fq == 0) ? 1.f : (fq == 1) ? A0 : (fq == 2) ? a01 : a012;
              Hex[nt] = (fq == 0) ? 0.f : (fq == 1) ? H0 : (fq == 2) ? h01 : h012;
              if (fq == 0) *(LAS f32x2*)(WSUM + (((ch & 1) * 8 + wave) * 32 + 16 * nt + fr) * 2) = (f32x2){A3 * a012, A3 * h012 + H3}; } }
        __syncthreads();
        { float ssr[4] = {0.f, 0.f, 0.f, 0.f};
#pragma unroll
          for (int nt = 0; nt < 2; ++nt) { const int chn = 16 * nt + fr; float x = hc[nt], mine = 0.f;
#pragma unroll
              for (int w2 = 0; w2 < 8; ++w2) { const f32x2 sm = *(const LAS f32x2*)(WSUM + (((ch & 1) * 8 + w2) * 32 + chn) * 2); if (w2 == wave) mine = x; x = sm[0] * x + sm[1]; }
              hc[nt] = x;
              const float hstart = Aex[nt] * mine + Hex[nt];
#pragma unroll
              for (int r = 0; r < 4; ++r) { const int tl = 4 * fq + r; const float h = Al[nt][r] * hstart + Hl[nt][r];
                  const float y = h * gelu_tanh(bf2f(GW[tl * 40 + chn])); const unsigned yb = cvt_pk_bf16(y, 0.f) & 0xffffu; YW[tl * 40 + chn] = (bf16_t)yb;
                  const float yr = __uint_as_float(yb << 16); ssr[r] += yr * yr; } }
#pragma unroll
          for (int r = 0; r < 4; ++r) { float q = ssr[r]; q += __shfl_xor(q, 1); q += __shfl_xor(q, 2); q += __shfl_xor(q, 4); q += __shfl_xor(q, 8);
              if (fr == 0) SSQL[((size_t)b * SEQ + t0 + 16 * wave + 4 * fq + r) * 16 + blk * 2 + half] = q; } }
        LDS_WAIT(); asm volatile("" ::: "memory");
        *(u32x4*)(YC + ((size_t)b * SEQ + t0 + 16 * wave + (lane >> 2)) * DM + oc0 + 8 * (lane & 3)) = *(const LAS u32x4*)(YW + (lane >> 2) * 40 + 8 * (lane & 3));
        if (chas) moe_item_finish(cv, a, cslot, cscr, lane);
      }
    }
#undef LRU_PREFETCH
    __syncthreads();
}


__device__ __forceinline__ void ph_router(const Args& a, const Ctx& C) {
    unsigned char* ws = a.ws;
    const bf16_t* H2B = (const bf16_t*)a.out + DM; const bf16_t* WR = (const bf16_t*)(ws + WS_WR); const float* SSQ2 = (const float*)(ws + WS_SSQ2);
    unsigned* CNT = (unsigned*)(ws + WS_CTL) + CW_CNT;
    int* TOKE = (int*)(ws + WS_TOK + TOK_E); int* TOKR = (int*)(ws + WS_TOK + TOK_R); float* TOKG = (float*)(ws + WS_TOK + TOK_G); int* LTOK = (int*)(ws + WS_LTOK); float* LRS = (float*)(ws + WS_LRS);
    constexpr int WRS = 1032;
    LAS bf16_t* WRL = (LAS bf16_t*)C.lds;
    LAS float* LG = (LAS float*)(C.lds + 99072) + C.wave * (16 * 49);
    LAS unsigned* lcnt = (LAS unsigned*)(C.lds + 99072 + 25088); LAS unsigned* lbase = lcnt + 32;
    const int lane = C.lane, fr = lane & 15, fq = lane >> 4;
    for (int i = C.tid; i < 48 * 128; i += 512) { const int r = i >> 7, c8 = i & 127; *(LAS u32x4*)(WRL + r * WRS + 8 * c8) = *(const u32x4*)(WR + (size_t)r * DM + 8 * c8); }
    for (int pass = 0; (pass * C.G) * 128 < NTOK; ++pass) {
        const int blk = pass * C.G + C.vcu; const bool live = blk * 128 < NTOK;
        if (C.tid < 32) lcnt[C.tid] = 0u;
        __syncthreads();
        int E1 = 0, E2 = 0; unsigned r1 = 0, r2 = 0; float ga = 0.f, gb = 0.f, rstd_t = 0.f; const int tb = blk * 128 + 16 * C.wave;
        if (live) {
            f32x4 acc[3] = {{0.f, 0.f, 0.f, 0.f}, {0.f, 0.f, 0.f, 0.f}, {0.f, 0.f, 0.f, 0.f}};
            bf16x8 af[32];
#pragma unroll
            for (int ks = 0; ks < 32; ++ks) af[ks] = *(const bf16x8*)(H2B + (size_t)(tb + fr) * LDH + 32 * ks + 8 * fq);
#pragma unroll
            for (int ks = 0; ks < 32; ++ks) {
#pragma unroll
                for (int nt = 0; nt < 3; ++nt) { const bf16x8 bfg = *(const LAS bf16x8*)(WRL + (16 * nt + fr) * WRS + 32 * ks + 8 * fq); acc[nt] = __builtin_amdgcn_mfma_f32_16x16x32_bf16(af[ks], bfg, acc[nt], 0, 0, 0); } }
#pragma unroll
            for (int nt = 0; nt < 3; ++nt)
#pragma unroll
                for (int r = 0; r < 4; ++r) LG[(4 * fq + r) * 49 + 16 * nt + fr] = acc[nt][r];
            LDS_WAIT(); asm volatile("" ::: "memory");
            if (lane < 16) { const int t = tb + lane; const float rstd = rstd_from_ssq(SSQ2, t); rstd_t = rstd; const LAS float* lg = LG + lane * 49;
                float g[4]; int grp = 0;
#pragma unroll
                for (int i = 0; i < 4; ++i) g[i] = lg[i] * rstd + a.in[21][i];
#pragma unroll
                for (int i = 1; i < 4; ++i) if (g[i] > g[grp]) grp = i;
                float gs = 0.f;
#pragma unroll
                for (int i = 0; i < 4; ++i) gs += __expf(g[i] - g[grp]);
                const float gw_ = 1.0f / gs;
                float e[8];
#pragma unroll
                for (int i = 0; i < 8; ++i) e[i] = lg[4 + 8 * grp + i] * rstd + a.in[23][8 * grp + i];
                int i1 = 0;
#pragma unroll
                for (int i = 1; i < 8; ++i) if (e[i] > e[i1]) i1 = i;
                int i2 = (i1 == 0) ? 1 : 0;
#pragma unroll
                for (int i = 0; i < 8; ++i) if (i != i1 && i != i2 && e[i] > e[i2]) i2 = i;
                const float eb = __expf(e[i2] - e[i1]); ga = gw_ / (1.0f + eb); gb = gw_ * eb / (1.0f + eb);
                E1 = grp * 8 + i1; E2 = grp * 8 + i2;
                r1 = atomicAdd((unsigned*)&lcnt[E1], 1u); r2 = atomicAdd((unsigned*)&lcnt[E2], 1u);
            }
        }
        __syncthreads();
        if (C.tid < 32) lbase[C.tid] = lcnt[C.tid] ? __hip_atomic_fetch_add(CNT + C.tid, lcnt[C.tid], __ATOMIC_RELAXED, __HIP_MEMORY_SCOPE_AGENT) : 0u;
        __syncthreads();
        if (live && lane < 16) { const int t = tb + lane;
            const int k1 = (int)(lbase[E1] + r1), k2 = (int)(lbase[E2] + r2);
            TOKE[2 * t] = E1; TOKR[2 * t] = k1; TOKG[2 * t] = ga; LTOK[E1 * LCAP + k1] = t; LRS[E1 * LCAP + k1] = rstd_t;
            TOKE[2 * t + 1] = E2; TOKR[2 * t + 1] = k2; TOKG[2 * t + 1] = gb; LTOK[E2 * LCAP + k2] = t; LRS[E2 * LCAP + k2] = rstd_t; }
        __syncthreads();
    }
}
__device__ __forceinline__ void moe_table(const Args& a, const Ctx& C) {
    LAS int* ts = (LAS int*)(C.lds + MOE_OFF);
    if (C.tid == 0) { const unsigned* CNT = (const unsigned*)(a.ws + WS_CTL) + CW_CNT; int acc = 0;
        for (int e = 0; e < NEXP; ++e) { ts[e] = acc; const unsigned c = __hip_atomic_load(CNT + e, __ATOMIC_RELAXED, __HIP_MEMORY_SCOPE_AGENT); ts[33 + e] = (int)c; acc += (int)((c + 255u) >> 8); }
        ts[NEXP] = acc; }
    __syncthreads();
}
__device__ __forceinline__ void ph_final(const Args& a, const Ctx& C, float* outp) {
    unsigned char* ws = a.ws;
    const unsigned char* YB = ws + WS_A; const float* TOKG = (const float*)(ws + WS_TOK + TOK_G); const int* TOKE = (const int*)(ws + WS_TOK + TOK_E); const int* TOKR = (const int*)(ws + WS_TOK + TOK_R);
    const LAS int* ts = (const LAS int*)(C.lds + MOE_OFF);
    const bf16_t* H2B = (const bf16_t*)a.out + DM; const float* gf = a.in[26];
    const int gw = C.vcu * 8 + C.wave, NGW = C.G * 8, lane = C.lane;
    f32x4 gn[4];
#pragma unroll
    for (int q = 0; q < 4; ++q) gn[q] = *(const f32x4*)(gf + 512 * (q >> 1) + 8 * lane + 4 * (q & 1));
    const int nit = (NTOK + NGW - 1) / NGW;
    int dnx = 0; float gnx = 0.f;
#define FIN_IDX(ib) do { const int tt_ = gw + ((ib) + (lane >> 1)) * NGW; dnx = 0; gnx = 0.f; \
        if (lane < 8 && tt_ < NTOK) { const int e_ = TOKE[2 * tt_ + (lane & 1)]; dnx = ts[e_] * 256 + TOKR[2 * tt_ + (lane & 1)]; gnx = TOKG[2 * tt_ + (lane & 1)]; } } while (0)
    FIN_IDX(0);
    for (int ib = 0; ib < nit; ib += 4) {
        const int dcur = dnx; const float gcur = gnx;
        if (ib + 4 < nit) FIN_IDX(ib + 4);
        u32x4 hw[4][2]; u32x2 y0[4][2], y1[4][2];
#pragma unroll
        for (int j = 0; j < 4; ++j) { const int t = gw + (ib + j) * NGW; const int d0 = __builtin_amdgcn_readlane(dcur, 2 * j), d1 = __builtin_amdgcn_readlane(dcur, 2 * j + 1);
            if (t < NTOK) {
#pragma unroll
                for (int hf = 0; hf < 2; ++hf) { hw[j][hf] = *((const u32x4*)(H2B + (size_t)t * LDH + 512 * hf) + lane); y0[j][hf] = *((const u32x2*)(YB + (size_t)d0 * DM + 512 * hf) + lane); y1[j][hf] = *((const u32x2*)(YB + (size_t)d1 * DM + 512 * hf) + lane); } } }
#pragma unroll
        for (int j = 0; j < 4; ++j) { const int t = gw + (ib + j) * NGW;
            const float g0 = __builtin_bit_cast(float, __builtin_amdgcn_readlane(__builtin_bit_cast(int, gcur), 2 * j)) * (1.0f / YB_SC), g1 = __builtin_bit_cast(float, __builtin_amdgcn_readlane(__builtin_bit_cast(int, gcur), 2 * j + 1)) * (1.0f / YB_SC);
            if (t < NTOK) { float v[16]; float s2 = 0.f;
#pragma unroll
                for (int hf = 0; hf < 2; ++hf)
#pragma unroll
                    for (int w = 0; w < 2; ++w) { const int yw0 = (int)y0[j][hf][w], yw1 = (int)y1[j][hf][w];
                        const f32x2 pa = __builtin_amdgcn_cvt_pk_f32_fp8(yw0, false), pb = __builtin_amdgcn_cvt_pk_f32_fp8(yw0, true), qa = __builtin_amdgcn_cvt_pk_f32_fp8(yw1, false), qb = __builtin_amdgcn_cvt_pk_f32_fp8(yw1, true);
                        const unsigned ha = hw[j][hf][2 * w], hb = hw[j][hf][2 * w + 1];
                        const float e0 = bflo(ha) + g0 * pa[0] + g1 * qa[0], e1 = bfhi(ha) + g0 * pa[1] + g1 * qa[1], e2 = bflo(hb) + g0 * pb[0] + g1 * qb[0], e3 = bfhi(hb) + g0 * pb[1] + g1 * qb[1];
                        v[8 * hf + 4 * w] = e0; v[8 * hf + 4 * w + 1] = e1; v[8 * hf + 4 * w + 2] = e2; v[8 * hf + 4 * w + 3] = e3; s2 += (e0 * e0 + e1 * e1) + (e2 * e2 + e3 * e3); }
                const float rstd = __builtin_amdgcn_rsqf(wave_sum(s2) * (1.0f / DM) + EPS);
#pragma unroll
                for (int q = 0; q < 4; ++q) { const f32x4 o = {v[4 * q] * rstd * gn[q][0], v[4 * q + 1] * rstd * gn[q][1], v[4 * q + 2] * rstd * gn[q][2], v[4 * q + 3] * rstd * gn[q][3]};
                    *(f32x4*)(outp + (size_t)t * DM + 512 * (q >> 1) + 8 * lane + 4 * (q & 1)) = o; } } }
    }
#undef FIN_IDX
}

#include <hip/hip_bf16.h>
#include <cmath>
namespace attn_body {
using bf16=__hip_bfloat16;
using bf16x8=__attribute__((ext_vector_type(8)))short;
using s16x4=__attribute__((ext_vector_type(4)))short;
using f32x16=__attribute__((ext_vector_type(16)))float;
using u32x4=__attribute__((ext_vector_type(4)))unsigned;
using f32x4_t=__attribute__((ext_vector_type(4)))float;
constexpr int BATCH=16,NHEAD=8,SEQ=2048,D=64,DM=NHEAD*D,DMO=1024;
constexpr int NW=8,QBLK=32,QB=QBLK*NW,KVBLK=64,NQB=SEQ/QB;
constexpr int ATTN_PITCH=DM, ATTN_UNIT_ROWS=QB;
__device__ __forceinline__ int crow(int r,int hi){return (r&3)+8*(r>>2)+4*hi;}
#define SBAR() __builtin_amdgcn_sched_barrier(0)
__device__ __forceinline__ void cmask(f32x16&p0,f32x16&p1,int jb,int qrel,int hi){
  const float NEG=-INFINITY; int kb=64*jb+4*hi; asm volatile("":"+v"(kb));
  #pragma unroll
  for(int r=0;r<16;++r){int kv=kb+(r&3)+8*(r>>2); if(kv>qrel)p0[r]=NEG; if(kv+32>qrel)p1[r]=NEG;}
}

constexpr int NSLOT=3, SLOTB=8192;
constexpr int LDS_K=0, LDS_V=NSLOT*SLOTB, LDS_WS=2*NSLOT*SLOTB, LDS_OST=LDS_WS+NW*64*4, LDS_BYTES=LDS_OST+NW*4096;
constexpr float C2=0.125f*1.4426950408889634f;
__device__ __forceinline__ void glds16(const char*sbase,unsigned voff,unsigned lds_dst){unsigned keep;
  asm volatile("s_nop 4\n\ts_mov_b32 %0, m0\n\ts_mov_b32 m0, %3\n\ts_nop 0\n\tglobal_load_lds_dwordx4 %1, %2\n\ts_mov_b32 m0, %0":"=&s"(keep):"v"(voff),"s"(sbase),"s"(lds_dst):"memory");}
__device__ __forceinline__ const char* uni_ptr(const void*p){const unsigned long long v=(unsigned long long)p;const unsigned lo=__builtin_amdgcn_readfirstlane((unsigned)v),hi=__builtin_amdgcn_readfirstlane((unsigned)(v>>32));return (const char*)(((unsigned long long)hi<<32)|lo);}
__device__ __forceinline__ float max3f(float a,float b,float c){float r;asm("v_max3_f32 %0, %1, %2, %3":"=v"(r):"v"(a),"v"(b),"v"(c));return r;}
__device__ __forceinline__ float max2f(float a,float b){float r;asm("v_max_f32_e32 %0, %1, %2":"=v"(r):"v"(a),"v"(b));return r;}
__device__ __forceinline__ float fadd_s(float a,float b){float r;asm("v_add_f32_e32 %0, %1, %2":"=v"(r):"v"(a),"v"(b));return r;}
__device__ __forceinline__ float fsub_s(float a,float b){float r;asm("v_sub_f32_e32 %0, %1, %2":"=v"(r):"v"(a),"v"(b));return r;}
typedef float f32x2_t __attribute__((ext_vector_type(2))); typedef __bf16 bf16x2_t __attribute__((ext_vector_type(2)));
__device__ __forceinline__ unsigned cvtpk_s(float lo,float hi){f32x2_t v={lo,hi};bf16x2_t b=__builtin_convertvector(v,bf16x2_t);return __builtin_bit_cast(unsigned,b);}
#define WAIT_BAR(N) asm volatile("s_waitcnt vmcnt(" #N ") lgkmcnt(0)\n\ts_barrier":::"memory")

__device__ __forceinline__ void qkt(f32x16&p0,f32x16&p1,const char*Kslot,const bf16x8*qr,const f32x16&negm,int r32,int hi){
  const char*kb=Kslot+hi*1024+r32*16;
  #pragma unroll
  for(int d0=0;d0<4;++d0){
    const bf16x8 b0=*reinterpret_cast<const bf16x8*>(kb+d0*2048);
    const bf16x8 b1=*reinterpret_cast<const bf16x8*>(kb+d0*2048+512);
    if(d0==0){p0=__builtin_amdgcn_mfma_f32_32x32x16_bf16(b0,qr[0],negm,0,0,0);p1=__builtin_amdgcn_mfma_f32_32x32x16_bf16(b1,qr[0],negm,0,0,0);}
    else{p0=__builtin_amdgcn_mfma_f32_32x32x16_bf16(b0,qr[d0],p0,0,0,0);p1=__builtin_amdgcn_mfma_f32_32x32x16_bf16(b1,qr[d0],p1,0,0,0);}}
}
typedef __attribute__((address_space(3))) const char* lds_cptr;
typedef short v4i16_t __attribute__((ext_vector_type(4)));
__device__ __forceinline__ void kload8(bf16x8*kf,lds_cptr kp){
  kf[0]=*(const __attribute__((address_space(3))) bf16x8*)(kp);      kf[1]=*(const __attribute__((address_space(3))) bf16x8*)(kp+512);
  kf[2]=*(const __attribute__((address_space(3))) bf16x8*)(kp+2048); kf[3]=*(const __attribute__((address_space(3))) bf16x8*)(kp+2560);
  kf[4]=*(const __attribute__((address_space(3))) bf16x8*)(kp+4096); kf[5]=*(const __attribute__((address_space(3))) bf16x8*)(kp+4608);
  kf[6]=*(const __attribute__((address_space(3))) bf16x8*)(kp+6144); kf[7]=*(const __attribute__((address_space(3))) bf16x8*)(kp+6656);
}
__device__ __forceinline__ void kload2(bf16x8*kf,lds_cptr kp,int j){ kf[2*j]=*(const __attribute__((address_space(3))) bf16x8*)(kp+j*2048); kf[2*j+1]=*(const __attribute__((address_space(3))) bf16x8*)(kp+j*2048+512); }
__device__ __forceinline__ s16x4 vtr(lds_cptr p){ return __builtin_bit_cast(s16x4,__builtin_amdgcn_ds_read_tr16_b64_v4i16((__attribute__((address_space(3))) v4i16_t*)p)); }
__device__ __forceinline__ float rowmax(const f32x16&p0,const f32x16&p1){
  float a=max3f(p0[0],p0[1],p1[0]),b=max3f(p0[2],p0[3],p1[1]);a=max3f(a,p1[2],p1[3]);
  #pragma unroll
  for(int r=4;r<16;r+=4){a=max3f(a,p0[r],p0[r+1]);b=max3f(b,p0[r+2],p0[r+3]);a=max3f(a,p1[r],p1[r+1]);b=max3f(b,p1[r+2],p1[r+3]);}
  const float m=max2f(a,b);
  auto rr=__builtin_amdgcn_permlane32_swap(__float_as_uint(m),__float_as_uint(m),false,false);
  return max2f(__uint_as_float(rr[0]),__uint_as_float(rr[1]));
}
__device__ __forceinline__ void pv(f32x16*o,int vb,bf16x8 pa0,bf16x8 pa1,bf16x8 pa2,bf16x8 pa3){
  #pragma unroll
  for(int d0=0;d0<2;++d0){s16x4 lo[4],hi[4];
    #pragma unroll
    for(int ks=0;ks<4;++ks){
      asm volatile("ds_read_b64_tr_b16 %0,%1 offset:%c2":"=&v"(lo[ks]):"v"(vb),"i"(d0*4096+ks*1024):"memory");
      asm volatile("ds_read_b64_tr_b16 %0,%1 offset:%c2":"=&v"(hi[ks]):"v"(vb),"i"(d0*4096+ks*1024+512):"memory");}
    asm volatile("s_waitcnt lgkmcnt(0)":::"memory");SBAR();
    #define PK(k) (bf16x8){lo[k][0],lo[k][1],lo[k][2],lo[k][3],hi[k][0],hi[k][1],hi[k][2],hi[k][3]}
    o[d0]=__builtin_amdgcn_mfma_f32_32x32x16_bf16(pa0,PK(0),o[d0],0,0,0);
    o[d0]=__builtin_amdgcn_mfma_f32_32x32x16_bf16(pa1,PK(1),o[d0],0,0,0);
    o[d0]=__builtin_amdgcn_mfma_f32_32x32x16_bf16(pa2,PK(2),o[d0],0,0,0);
    o[d0]=__builtin_amdgcn_mfma_f32_32x32x16_bf16(pa3,PK(3),o[d0],0,0,0);
    #undef PK
  }
}

#ifndef ATTN_STORE16
#define ATTN_STORE16(p,v) (*(u32x4*)(p)=(v))
#endif
template<int THRL> __device__ __forceinline__ void attn_unit(int b,int h,int qb,const bf16*Q,const bf16*__restrict__ K,const bf16*__restrict__ V,bf16*O,const float*__restrict__ KSUM,float*__restrict__ SSQA,char*shm){
  int tid=threadIdx.x; asm volatile("":"+v"(tid));
  const int lane=tid&63,r32=lane&31,hi=lane>>5; const int wid=__builtin_amdgcn_readfirstlane(tid>>6);
  const long rowbase=(long)b*SEQ; const int q0=qb*QB;
  const bf16*Qw=Q+(rowbase+q0+wid*QBLK)*DM+h*D;
  const bf16*Kh=K+rowbase*DM+h*D,*Vh=V+rowbase*DM+h*D;
  const unsigned lds0=(unsigned)(uintptr_t)shm;
  float*wsf=(float*)(shm+LDS_WS)+wid*64;
  const char*Khu=uni_ptr(Kh);const char*Vhu=uni_ptr(Vh);
  const unsigned kvo=(unsigned)(lane*DM+wid*8)*2u;
  const unsigned vvo=(unsigned)((16*(wid&3)+(lane>>2))*DM+(wid>>2)*32+(lane&3)*8)*2u;
  const unsigned kdst=lds0+LDS_K+wid*1024, vdst=lds0+LDS_V+wid*1024;
  #define DMA_K(t,slot) glds16(Khu+(size_t)(t)*(KVBLK*DM*2),kvo,(unsigned)__builtin_amdgcn_readfirstlane(kdst+(slot)))
  #define DMA_V(t,slot) glds16(Vhu+(size_t)(t)*(KVBLK*DM*2),vvo,(unsigned)__builtin_amdgcn_readfirstlane(vdst+(slot)))
  const int vb0=(int)(lds0+LDS_V)+((lane>>4)&1)*32+(lane&3)*8+(4*hi+((lane&15)>>2))*64;
  const char*Kbase=shm+LDS_K; bf16x8 kf[8];
  const lds_cptr shm3=(lds_cptr)shm; const lds_cptr kp0=shm3+LDS_K+hi*1024+r32*16; const lds_cptr vp0=shm3+LDS_V+((lane>>4)&1)*32+(lane&3)*8+(4*hi+((lane&15)>>2))*64;
  const int NT=(q0+QB)/KVBLK;
  DMA_K(0,0);DMA_V(0,0);DMA_K(1,SLOTB);
  bf16x8 qr[4];
  #pragma unroll
  for(int d0=0;d0<4;++d0)qr[d0]=*reinterpret_cast<const bf16x8*>(&Qw[(long)r32*DM+d0*16+hi*8]);
  unsigned selm=1u<<qb;
  { float g[8];
    #pragma unroll
    for(int n=0;n<8;++n){ g[n]=-INFINITY;
      if(n<qb){ const float*ks=KSUM+(long)(b*8+n)*DM+h*D+hi*8; float s=0.f;
        #pragma unroll
        for(int d0=0;d0<4;++d0){ const f32x4_t k0=*reinterpret_cast<const f32x4_t*>(ks+d0*16), k1=*reinterpret_cast<const f32x4_t*>(ks+d0*16+4);
          const u32x4 qw=__builtin_bit_cast(u32x4,qr[d0]);
          s+=__uint_as_float(qw[0]<<16)*k0[0]+__uint_as_float(qw[0]&0xffff0000u)*k0[1]+__uint_as_float(qw[1]<<16)*k0[2]+__uint_as_float(qw[1]&0xffff0000u)*k0[3]
            +__uint_as_float(qw[2]<<16)*k1[0]+__uint_as_float(qw[2]&0xffff0000u)*k1[1]+__uint_as_float(qw[3]<<16)*k1[2]+__uint_as_float(qw[3]&0xffff0000u)*k1[3]; }
        s+=__shfl_xor(s,32); g[n]=s; } }
    const int npick=qb<3?qb:3;
    for(int p=0;p<npick;++p){ int best=-1; float bv=-INFINITY;
      #pragma unroll
      for(int n=0;n<8;++n){ const bool ok=(n<qb)&&!((selm>>n)&1u)&&(best<0||g[n]>bv); if(ok){best=n;bv=g[n];} }
      if(best>=0)selm|=1u<<best; } }
  #define BMASK(P0,P1,t) do{ float bias_=((selm>>((t)>>2))&1u)?-mhat:-INFINITY; asm volatile("":"+v"(bias_)); _Pragma("unroll") for(int r=0;r<16;++r){P0[r]+=bias_;P1[r]+=bias_;} }while(0)
  float mhat=0.f,l_reg=0.f;f32x16 o[2];{float z0_=0.f;asm volatile("":"+v"(z0_));_Pragma("unroll") for(int r=0;r<16;++r){o[0][r]=z0_;o[1][r]=z0_;}}const f32x16 negm=f32x16{};
  const int qrel=wid*QBLK+r32;
  #define CMASK(P0,P1,t) do{int jb_=(t)-(NT-4); if(jb_>=0)cmask(P0,P1,jb_,qrel,hi);}while(0)
  bool resc=false;
  #define START(P0,P1) do{ const float rm=__builtin_fmaxf(rowmax(P0,P1),-100.0f); resc=false; \
    { const float dl=rm; mhat=fadd_s(mhat,dl); \
      _Pragma("unroll") for(int r=0;r<16;++r){P0[r]=fsub_s(P0[r],dl);P1[r]=fsub_s(P1[r],dl);} \
      } \
    _Pragma("unroll") for(int r=0;r<16;++r)P0[r]=__builtin_amdgcn_exp2f(P0[r]); }while(0)
  #define RESC() do{ if(resc){ asm volatile("s_waitcnt lgkmcnt(0)":::"memory"); \
      _Pragma("unroll") for(int d_=0;d_<2;++d_) _Pragma("unroll") for(int r=0;r<16;++r)o[d_][r]*=wsf[crow(r,hi)]; } }while(0)
  f32x16 pA0,pA1,pB0,pB1;
  int sl_prev=0,sl_cur=0,sl_next=SLOTB;
  #define ROT() do{sl_prev=sl_cur;sl_cur=sl_next;sl_next=(sl_next==(NSLOT-1)*SLOTB)?0:sl_next+SLOTB;}while(0)
  DMA_K(2,2*SLOTB);
  WAIT_BAR(3);
  qkt(pA0,pA1,Kbase,qr,negm,r32,hi);asm volatile("s_nop 15\n\ts_nop 7":"+v"(pA0),"+v"(pA1));CMASK(pA0,pA1,0);BMASK(pA0,pA1,0);
  START(pA0,pA1);
  _Pragma("unroll") for(int r=0;r<16;++r)pA1[r]=__builtin_amdgcn_exp2f(pA1[r]);
  WAIT_BAR(0);
  DMA_K(3,0);DMA_V(1,SLOTB);
  ROT();
  kload8(kf,kp0+sl_cur);
  WAIT_BAR(2);
  s16x4 vlo[8],vhi[8]; u32x4 pw0,pw1,pw2,pw3;
  #define PKW(P,B) cvtpk_s(P[B],P[B+1])
  #define PAF(k) __builtin_bit_cast(bf16x8,pw##k)
  #define VFR(i) (bf16x8){vlo[i][0],vlo[i][1],vlo[i][2],vlo[i][3],vhi[i][0],vhi[i][1],vhi[i][2],vhi[i][3]}
  #define PIN(x) asm volatile("":"+v"(x))
  #define MX3(a,b,c) __builtin_fmaxf(__builtin_fmaxf((a),(b)),(c))
  #define GAPA(MF,A0,A1,A2,A3,W0,W1,PW) do{ MF; sacc+=A0; sacc+=A1; sacc+=A2; sacc+=A3; PIN(sacc); W0; W1; PIN(PW); SBAR(); }while(0)
  #define EX(v) __builtin_amdgcn_exp2f(v)
  #define GAPB(MF,X,B) do{ MF; X[B]=EX(X[B]); X[B+1]=EX(X[B+1]); X[B+2]=EX(X[B+2]); X[B+3]=EX(X[B+3]); PIN(X); SBAR(); }while(0)
  #define VRD(i) do{ vlo[i]=vtr(vp_+(((i)>>2)*4096+((i)&3)*1024)); vhi[i]=vtr(vp_+(((i)>>2)*4096+((i)&3)*1024+512)); }while(0)
  #define KRD(G,j) do{ if(G){ kload2(kf,kp0+sl_next,j); SBAR(); } }while(0)
  #define STEP(C0,C1,P0,P1,t,GK,GV,GL) do{ SBAR(); \
    const lds_cptr vp_=vp0+sl_prev; \
    VRD(0); SBAR(); float sacc=(P0[0]+P0[1]); \
    GAPA(C0=__builtin_amdgcn_mfma_f32_32x32x16_bf16(kf[0],qr[0],negm,0,0,0), P0[2],P0[3],P0[4],P0[5],     pw0[0]=PKW(P0,0), pw0[1]=PKW(P0,2), pw0); \
    VRD(4); SBAR(); GAPA(C1=__builtin_amdgcn_mfma_f32_32x32x16_bf16(kf[1],qr[0],negm,0,0,0), P0[6],P0[7],P0[8],P0[9],     pw0[2]=PKW(P0,4), pw0[3]=PKW(P0,6), pw0); \
    VRD(1); SBAR(); GAPA(C0=__builtin_amdgcn_mfma_f32_32x32x16_bf16(kf[2],qr[1],C0,0,0,0),   P0[10],P0[11],P0[12],P0[13], pw1[0]=PKW(P0,8), pw1[1]=PKW(P0,10), pw1); \
    VRD(5); SBAR(); GAPA(C1=__builtin_amdgcn_mfma_f32_32x32x16_bf16(kf[3],qr[1],C1,0,0,0),   P0[14],P0[15],P1[0],P1[1],   pw1[2]=PKW(P0,12),pw1[3]=PKW(P0,14), pw1); \
    VRD(2); SBAR(); GAPA(C0=__builtin_amdgcn_mfma_f32_32x32x16_bf16(kf[4],qr[2],C0,0,0,0),   P1[2],P1[3],P1[4],P1[5],     pw2[0]=PKW(P1,0), pw2[1]=PKW(P1,2), pw2); \
    VRD(6); SBAR(); GAPA(C1=__builtin_amdgcn_mfma_f32_32x32x16_bf16(kf[5],qr[2],C1,0,0,0),   P1[6],P1[7],P1[8],P1[9],     pw2[2]=PKW(P1,4), pw2[3]=PKW(P1,6), pw2); \
    VRD(3); SBAR(); GAPA(C0=__builtin_amdgcn_mfma_f32_32x32x16_bf16(kf[6],qr[3],C0,0,0,0),   P1[10],P1[11],P1[12],P1[13], pw3[0]=PKW(P1,8), pw3[1]=PKW(P1,10), pw3); \
    VRD(7); SBAR(); GAPA(C1=__builtin_amdgcn_mfma_f32_32x32x16_bf16(kf[7],qr[3],C1,0,0,0),   P1[14],P1[15],0.f,0.f,       pw3[2]=PKW(P1,12),pw3[3]=PKW(P1,14), pw3); \
    l_reg+=sacc; \
    if(GK){DMA_K((t)+3,sl_cur);} if(GV){DMA_V((t)+1,sl_next);} \
    CMASK(C0,C1,t); BMASK(C0,C1,t); \
    { float a=MX3(C0[0],C0[1],C1[0]),b=MX3(C0[2],C0[3],C1[1]); a=MX3(a,C1[2],C1[3]); \
      _Pragma("unroll") for(int r=4;r<16;r+=4){a=MX3(a,C0[r],C0[r+1]);b=MX3(b,C0[r+2],C0[r+3]);a=MX3(a,C1[r],C1[r+1]);b=MX3(b,C1[r+2],C1[r+3]);} \
      float rm=__builtin_fmaxf(a,b); { auto rr=__builtin_amdgcn_permlane32_swap(__float_as_uint(rm),__float_as_uint(rm),false,false); rm=__builtin_fmaxf(__uint_as_float(rr[0]),__uint_as_float(rr[1])); } \
      resc=false; \
      if(__builtin_expect(__any(rm>(float)THRL),0)){ const float dl=__builtin_fmaxf(rm,0.f); mhat+=dl; \
        _Pragma("unroll") for(int r=0;r<16;++r){C0[r]-=dl;C1[r]-=dl;} \
        const float f=__builtin_amdgcn_exp2f(-dl); l_reg*=f; if(hi==0)wsf[r32]=f; resc=true; } } \
    SBAR(); \
    GAPB(o[0]=__builtin_amdgcn_mfma_f32_32x32x16_bf16(PAF(0),VFR(0),o[0],0,0,0), C0,0); \
    GAPB(o[1]=__builtin_amdgcn_mfma_f32_32x32x16_bf16(PAF(0),VFR(4),o[1],0,0,0), C0,4); \
    KRD(GL,0); GAPB(o[0]=__builtin_amdgcn_mfma_f32_32x32x16_bf16(PAF(1),VFR(1),o[0],0,0,0), C0,8); \
    KRD(GL,1); GAPB(o[1]=__builtin_amdgcn_mfma_f32_32x32x16_bf16(PAF(1),VFR(5),o[1],0,0,0), C0,12); \
    KRD(GL,2); GAPB(o[0]=__builtin_amdgcn_mfma_f32_32x32x16_bf16(PAF(2),VFR(2),o[0],0,0,0), C1,0); \
    KRD(GL,3); GAPB(o[1]=__builtin_amdgcn_mfma_f32_32x32x16_bf16(PAF(2),VFR(6),o[1],0,0,0), C1,4); \
    GAPB(o[0]=__builtin_amdgcn_mfma_f32_32x32x16_bf16(PAF(3),VFR(3),o[0],0,0,0), C1,8); \
    GAPB(o[1]=__builtin_amdgcn_mfma_f32_32x32x16_bf16(PAF(3),VFR(7),o[1],0,0,0), C1,12); \
    }while(0)
  int t=1;
  #undef CMASK
  #define CMASK(P0,P1,t) do{}while(0)
  for(;t+5<NT;t+=2){
    STEP(pB0,pB1,pA0,pA1,t,true,true,true);     WAIT_BAR(2); RESC(); ROT();
    STEP(pA0,pA1,pB0,pB1,t+1,true,true,true);   WAIT_BAR(2); RESC(); ROT();
  }
  #undef CMASK
  #define CMASK(P0,P1,t) do{int jb_=(t)-(NT-4); if(jb_>=0)cmask(P0,P1,jb_,qrel,hi);}while(0)
  #define ENDW(tt) do{ if((tt)+3<NT){WAIT_BAR(2);} else if((tt)+2<NT){WAIT_BAR(1);} else {WAIT_BAR(0);} }while(0)
  for(;t+1<NT;t+=2){
    STEP(pB0,pB1,pA0,pA1,t,(t+3<NT),(t+1<NT),(t+1<NT));       ENDW(t);   RESC(); ROT();
    STEP(pA0,pA1,pB0,pB1,t+1,(t+4<NT),(t+2<NT),(t+2<NT));     ENDW(t+1); RESC(); ROT();
  }
  STEP(pB0,pB1,pA0,pA1,NT-1,false,false,false); RESC();
  { float sacc=pB0[0]+pB0[1]; _Pragma("unroll") for(int r=2;r<16;++r)sacc+=pB0[r]; _Pragma("unroll") for(int r=0;r<16;++r)sacc+=pB1[r]; l_reg+=sacc;
    pw0=(u32x4){PKW(pB0,0),PKW(pB0,2),PKW(pB0,4),PKW(pB0,6)};pw1=(u32x4){PKW(pB0,8),PKW(pB0,10),PKW(pB0,12),PKW(pB0,14)};pw2=(u32x4){PKW(pB1,0),PKW(pB1,2),PKW(pB1,4),PKW(pB1,6)};pw3=(u32x4){PKW(pB1,8),PKW(pB1,10),PKW(pB1,12),PKW(pB1,14)};
    SBAR(); pv(o,vb0+sl_cur,PAF(0),PAF(1),PAF(2),PAF(3)); }
  #undef PKW
  #undef PAF
  #undef VFR
  #undef PIN
  #undef MX3
  #undef GAPA
  #undef GAPB
  #undef EX
  #undef VRD
  #undef KRD
  #undef STEP
  #undef ENDW
  {auto rr=__builtin_amdgcn_permlane32_swap(__float_as_uint(l_reg),__float_as_uint(l_reg),false,false);l_reg=__uint_as_float(rr[0])+__uint_as_float(rr[1]);}
  if(hi==0)wsf[32+r32]=l_reg;asm volatile("s_waitcnt lgkmcnt(0)":::"memory");
  float rli[16];
  #pragma unroll
  for(int r=0;r<16;++r)rli[r]=__builtin_amdgcn_rcpf(wsf[32+crow(r,hi)]);
  bf16*Ow=O+(rowbase+q0+wid*QBLK)*DMO+h*D;
  { bf16*stg=(bf16*)(shm+LDS_OST)+wid*2048;
    #pragma unroll
    for(int r=0;r<16;++r){const int orow=crow(r,hi);
      #pragma unroll
      for(int d0=0;d0<2;++d0)stg[orow*64+d0*32+r32]=__float2bfloat16(o[d0][r]*rli[r]);}
    asm volatile("s_waitcnt lgkmcnt(0)":::"memory");
    #pragma unroll
    for(int i=0;i<4;++i){const int row=i*8+(lane>>3),ch=lane&7; const u32x4 v=*(const u32x4*)(stg+row*64+ch*8); ATTN_STORE16(Ow+(long)row*DMO+ch*8,v);
      float q=0.f;
      #pragma unroll
      for(int e=0;e<4;++e){const float lo=__uint_as_float(v[e]<<16),hi2=__uint_as_float(v[e]&0xffff0000u);q+=lo*lo+hi2*hi2;}
      q+=__shfl_xor(q,1);q+=__shfl_xor(q,2);q+=__shfl_xor(q,4);
      if(ch==0)SSQA[(rowbase+q0+wid*QBLK+row)*8+h]=q;} }
  asm volatile("s_waitcnt lgkmcnt(0)\n\ts_barrier":::"memory");
  #undef BMASK
  #undef DMA_K
  #undef DMA_V
  #undef CMASK
  #undef START
  #undef RESC
  #undef ROT
}
constexpr int ATTN_LDS_BYTES=LDS_BYTES;
#undef SBAR
#undef WAIT_BAR
}

__global__ void __launch_bounds__(512, 2) mk_fwd(Args args) {
    extern __shared__ __attribute__((aligned(16))) unsigned char lds_raw[];
    Ctx C; C.lds = (LAS unsigned char*)lds_raw; C.tid = threadIdx.x; C.lane = C.tid & 63; C.wave = __builtin_amdgcn_readfirstlane(C.tid >> 6);
    C.G = gridDim.x; { const int bx = blockIdx.x; C.vcu = (C.G % 8 == 0) ? (bx % 8) * (C.G / 8) + bx / 8 : bx; }
    unsigned char* ws = args.ws;
    for (int u = C.tid; u < (LDS_BYTES - LDSCTL_OFF) / 4; u += 512) ((LAS unsigned*)(C.lds + LDSCTL_OFF))[u] = 0u;
    __syncthreads();
    XcdBarrier bar; bar.bar = (unsigned*)(ws + WS_CTL) + CW_BAR; bar.x = 0; bar.st = nullptr;
    if (N_LAUNCHES == 1) bar = xcd_barrier_post((unsigned*)(ws + WS_CTL) + CW_BAR, (volatile LAS unsigned*)(C.lds + MISC_OFF) + 8);
    const int lo = args.ph_lo, hi = args.ph_hi;
#define IN(k) (lo <= (k) && (k) < hi)
#define FRESH() do { int t_ = threadIdx.x; asm volatile("" : "+v"(t_)); C.tid = t_; C.lane = t_ & 63; C.wave = __builtin_amdgcn_readfirstlane(t_ >> 6); } while (0)
#define SEAM(k) do { if (IN(k) && IN((k) + 1)) xcd_barrier(bar); } while (0)
    const int cb = (int)blockIdx.x;

    if (IN(0)) { FRESH(); ph_prologue(args, C); SEAM(0); }
    if (IN(1)) {
        { Gemm g{(const bf16_t*)(ws + WS_B), (const bf16_t*)(ws + WS_WIN), DM, DM, DM}; PlainOrder S; S.init(NTOK, DIN, C.G, cb, DM, DM);
          EpiProj E{(bf16_t*)(ws + WS_A), (const float*)(ws + WS_ROPE), (float*)(ws + WS_KSUM)}; GEMM_PHASE(C.lds, g, S, E); }
        { Gemm g{(const bf16_t*)(ws + WS_MEMN), (const bf16_t*)(ws + WS_WXK), DM, DM, DM}; PlainOrder S; S.init(NMEM, DM, C.G, cb, DM, DM);
          EpiStore E{(bf16_t*)(ws + WS_KM), DM}; GEMM_PHASE(C.lds, g, S, E); }
        { Gemm g{(const bf16_t*)(ws + WS_MEMN), (const bf16_t*)(ws + WS_WXV), DM, DM, DM}; PlainOrder S; S.init(NMEM, DM, C.G, (cb + C.G - 64 % C.G) % C.G, DM, DM);
          EpiStore E{(bf16_t*)(ws + WS_VMT), DM}; GEMM_PHASE(C.lds, g, S, E); }
        { FRESH(); if (C.G == 256) { if (cb >= 128) conv_wdn(args, C, (cb - 128) * 8 + C.wave, 128 * 8, 0, WDN_SPLIT); }
          else conv_wdn(args, C, C.vcu * 8 + C.wave, C.G * 8, 0, WDN_SPLIT); }
        SEAM(1);
    }
    if (IN(2)) { FRESH();
        for (int L = C.vcu; L < 256; L += C.G) lru_unit(args, C, L >> 4, (L >> 1) & 7, L & 1, L);
        for (int i = 0;; ++i) { const int aidx = i * C.G + C.vcu; if (aidx >= 1024) break; const int cc = aidx & 255, ii = aidx >> 8, bh = cc >> 1;
            const int qb = (cc & 1) ? ((ii == 0) ? 6 : (ii == 1) ? 1 : (ii == 2) ? 5 : 2) : ((ii == 0) ? 7 : (ii == 1) ? 0 : (ii == 2) ? 4 : 3);
            { const attn_body::bf16* Qp = (const attn_body::bf16*)(ws + WS_A) + (size_t)2 * NTOK * 512;
              attn_body::attn_unit<8>(bh >> 3, bh & 7, qb, Qp, Qp + (size_t)NTOK * 512, Qp + (size_t)2 * NTOK * 512, (attn_body::bf16*)(ws + WS_C) + 512, (const float*)(ws + WS_KSUM), (float*)(ws + WS_SSQA), (char*)lds_raw); } }
        SEAM(2);
    }
    if (IN(4)) { Gemm g{(const bf16_t*)(ws + WS_C), (const bf16_t*)(ws + WS_WOUT), DM, DM, DM}; PlainOrder S; S.init(NTOK, DM, C.G, cb, DM, DM);
        EpiResid<true, true> E{(const bf16_t*)(ws + WS_B), (bf16_t*)args.out, (float*)(ws + WS_SSQ1), (const float*)(ws + WS_SSQL), (const float*)(ws + WS_SSQA), ws + WS_A + 64 * MiB, 1.0f, (const float*)(ws + WS_TOK + TOK_D), args.in[2]};     GEMM_PHASE(C.lds, g, S, E);
        { Gemm g2{(const bf16_t*)(ws + WS_KM), (const bf16_t*)(ws + WS_WXQ), DM, DM, XHD}; XpreOrder S2{C.G, cb, 0}; EpiStore8 E2{ws + WS_A, DM, QKT_SC}; GEMM_PHASE(C.lds, g2, S2, E2); }
        { Gemm g3{(const bf16_t*)(ws + WS_WXO), (const bf16_t*)(ws + WS_VMT), DM, DM, XHD}; XpreOrder S3{C.G, cb, 1}; EpiStore8 E3{ws + WS_A + 32 * MiB, DM, VWT_SC}; GEMM_PHASE(C.lds, g3, S3, E3); }
        SEAM(4); }
    if (IN(5)) { Gemm g{(const bf16_t*)(ws + WS_A + 64 * MiB), (const bf16_t*)(ws + WS_A), DM / 2, DM / 2, DM / 2}; XattnOrder S{C.G, cb, 0, DM / 2, DM / 2};
        EpiSoftmax E{ws + WS_A + 96 * MiB, DM, C.lds + LDSCTL_OFF + 4096, (const float*)(ws + WS_SSQ1), XSCALE / QKT_SC}; GEMM_PHASE8N(C.lds, g, S, E); SEAM(5); }
    if (IN(8)) { Gemm g{(const bf16_t*)(ws + WS_A + 96 * MiB), (const bf16_t*)(ws + WS_A + 32 * MiB), DM / 2, DM / 2, DM / 2}; XattnOrder S{C.G, cb, 1, DM / 2, DM / 2};
        EpiResid<false, false> E{(const bf16_t*)args.out, (bf16_t*)args.out + DM, (float*)(ws + WS_SSQ2), nullptr, nullptr, ws + WS_H2F8, 1.0f / (PX_SC * VWT_SC)}; GEMM_PHASE8(C.lds, g, S, E); SEAM(8); }
    if (IN(9)) { FRESH(); ph_router(args, C); SEAM(9); }
    if (IN(11)) { FRESH(); moe_table(args, C); Gemm g{(const bf16_t*)(ws + WS_H2F8), (const bf16_t*)(ws + WS_WGU), DM / 2, DM / 2, DM / 2};
        MoeOrder<true> S{(const LAS int*)(C.lds + MOE_OFF), C.G, cb, DM / 2, DM / 2, (const int*)(ws + WS_LTOK), (unsigned)DM};
        EpiGateUp E{ws + WS_B, (const float*)(ws + WS_LRS)}; GEMM_PHASE8(C.lds, g, S, E); SEAM(11); }
    if (IN(12)) { FRESH(); moe_table(args, C); Gemm g{(const bf16_t*)(ws + WS_B), (const bf16_t*)(ws + WS_WDN), DFF / 2, DFF / 2, DFF / 2};
        MoeOrder<false> S{(const LAS int*)(C.lds + MOE_OFF), C.G, cb, DFF / 2, DFF / 2, nullptr, 0u};
        EpiStore8 E{ws + WS_A, DM, YB_SC / (WDN_SC * ACT_SC)}; GEMM_PHASE8(C.lds, g, S, E); SEAM(12); }
    if (IN(13)) { FRESH(); moe_table(args, C); ph_final(args, C, args.out); }
#undef IN
#undef FRESH
#undef SEAM
}

extern "C" void kernel_launch(void* const* d_in, const int* in_sizes, int n_in, void* d_out, int out_size, void* d_ws, size_t ws_size, hipStream_t stream) {
    static int grid = 0;
    if (grid == 0) {
        if (n_in != 27 || out_size != NTOK * DM || ws_size < WS_END) { fprintf(stderr, "kernel_launch: unexpected shapes (n_in %d out %d ws %zu)\n", n_in, out_size, ws_size); grid = -1; return; }
        int dev = 0, cus = 0, per_cu = 0;
        if (hipGetDevice(&dev) != hipSuccess || hipDeviceGetAttribute(&cus, hipDeviceAttributeMultiprocessorCount, dev) != hipSuccess) { grid = -1; return; }
        if (hipFuncSetAttribute((const void*)mk_fwd, hipFuncAttributeMaxDynamicSharedMemorySize, LDS_BYTES) != hipSuccess) { fprintf(stderr, "kernel_launch: hipFuncSetAttribute failed\n"); grid = -1; return; }
        if (hipOccupancyMaxActiveBlocksPerMultiprocessor(&per_cu, (const void*)mk_fwd, 512, LDS_BYTES) != hipSuccess || per_cu < 1) fprintf(stderr, "kernel_launch: occupancy query reports %d\n", per_cu);
        (void)hipGetLastError();
        grid = cus;
    }
    if (grid < 0) return;
    (void)hipMemsetAsync((char*)d_ws + WS_CTL, 0, CTL_ZERO_BYTES, stream);
    Args a{};
    for (int i = 0; i < 27; ++i) a.in[i] = (const float*)d_in[i];
    a.out = (float*)d_out; a.ws = (unsigned char*)d_ws;
    const float invf[8] = {1.0f, 0.1939227432012558f, 0.03760603070259094f, 0.007292664609849453f, 0.0014142135623842478f, 0.00027424818836152554f, 5.318296098266728e-05f, 1.0313386155758053e-05f};
    for (int i = 0; i < 8; ++i) a.invf[i] = invf[i];
    if (N_LAUNCHES == 1) { a.ph_lo = 0; a.ph_hi = N_PHASES; hipLaunchKernelGGL(mk_fwd, dim3(grid), dim3(512), LDS_BYTES, stream, a); }
    else for (int p = 0; p < N_PHASES; ++p) { a.ph_lo = p; a.ph_hi = p + 1; hipLaunchKernelGGL(mk_fwd, dim3(grid), dim3(512), LDS_BYTES, stream, a); }
}
```

```cpp
#include <hip/hip_runtime.h>
#include <cstdio>
#include <cstdint>

#define LAS __attribute__((address_space(3)))
#define GAS __attribute__((address_space(1)))
typedef unsigned short bf16_t;
typedef short bf16x8 __attribute__((ext_vector_type(8)));
typedef float f32x4 __attribute__((ext_vector_type(4)));
typedef float f32x2 __attribute__((ext_vector_type(2)));
typedef unsigned u32x4 __attribute__((ext_vector_type(4)));
typedef unsigned u32x2 __attribute__((ext_vector_type(2)));

#ifndef MK_N_LAUNCHES
#define MK_N_LAUNCHES 1
#endif
constexpr int N_PHASES = 14;
constexpr int N_LAUNCHES = MK_N_LAUNCHES;

constexpr int BATCH = 16, SEQ = 2048, DM = 1024, NTOK = BATCH * SEQ;
constexpr int DLRU = 512, DATT = 512, DIN = 2560, NHEAD = 8, HD = 64, NBLK = 8, MBLK = 256;
constexpr int MEMLEN = 256, NXH = 4, XHD = 256, NMEM = BATCH * MEMLEN;
constexpr int NEXP = 32, EPG = 8, NGRP = 4, DFF = 512;
constexpr float EPS = 1e-6f;
constexpr float QKT_SC = 8.0f, VWT_SC = 8.0f, PX_SC = 256.0f;
constexpr float WGU_SC = 64.0f, WDN_SC = 32.0f, ACT_SC = 16.0f, YB_SC = 16.0f;
constexpr int WDN_SPLIT = 3072;
constexpr int MAXTILES = 288, LCAP = 65536, LDH = 2048;
constexpr float QSCALE = 0.125f * 1.4426950408889634f;
constexpr float XSCALE = 0.0625f * 1.4426950408889634f;

constexpr size_t MiB = 1u << 20;
constexpr size_t WS_CTL = 0, CTL_ZERO_BYTES = 1 * MiB;
constexpr int CW_TMO = 0, CW_BAR = 4096, CW_CNT = 8192;
constexpr size_t WS_KSUM = 512 * 1024;
constexpr size_t WS_WIN = 2 * MiB, WS_WXK = 7 * MiB, WS_WXV = 9 * MiB, WS_WOUT = 11 * MiB, WS_WXQ = 13 * MiB, WS_WXO = 15 * MiB;
constexpr size_t WS_WR = 17 * MiB, WS_ROPE = 18 * MiB, WS_SSQ1 = 19 * MiB, WS_SSQ2 = 21 * MiB, WS_TOK = 23 * MiB, WS_RSC = 24 * MiB;
constexpr size_t WS_MEMN = 25 * MiB, WS_KM = 33 * MiB, WS_VMT = 41 * MiB, WS_WGU = 49 * MiB, WS_WDN = 113 * MiB;
constexpr size_t WS_A = 145 * MiB, WS_B = 305 * MiB, WS_C = 385 * MiB, WS_SSQL = 449 * MiB, WS_SSQA = 451 * MiB, WS_LTOK = 452 * MiB, WS_LRS = 460 * MiB, WS_H2F8 = 468 * MiB, WS_END = 500 * MiB;
constexpr size_t TOK_E = 0, TOK_R = 256 * 1024, TOK_G = 512 * 1024, TOK_D = 768 * 1024;

constexpr int RING_BYTES = 131072;
constexpr int LDSCTL_OFF = RING_BYTES, MISC_OFF = LDSCTL_OFF + 320, MOE_OFF = LDSCTL_OFF + 1024;
constexpr int LDS_BYTES = 147456;

__device__ __forceinline__ unsigned cvt_pk_bf16(float lo, float hi) { unsigned r; asm volatile("v_cvt_pk_bf16_f32 %0, %1, %2" : "=v"(r) : "v"(lo), "v"(hi)); return r; }
__device__ __forceinline__ float bflo(unsigned w) { return __uint_as_float(w << 16); }
__device__ __forceinline__ float bfhi(unsigned w) { return __uint_as_float(w & 0xffff0000u); }
__device__ __forceinline__ float bf2f(bf16_t b) { return __uint_as_float((unsigned)b << 16); }
__device__ __forceinline__ float wave_sum(float v) {
#pragma unroll
    for (int o = 1; o < 64; o <<= 1) v += __shfl_xor(v, o);
    return v;
}
#define LDS_WAIT() asm volatile("s_waitcnt lgkmcnt(0)" ::: "memory")
__device__ __forceinline__ float sigmoidf_(float x) { return __builtin_amdgcn_rcpf(1.0f + __builtin_amdgcn_exp2f(x * -1.4426950408889634f)); }

#define XB_TMO      128
#define XB_XCNT(j)  (256  + 64 * (j))
#define XB_XSUB(j)  (1280 + 64 * (j))
#define XB_XGEN(j)  (2304 + 64 * (j))
#define XB_TOP      3328
#define XB_TOPGEN   3392
#define XCD_BAR_WORDS 3456
#define XB_SPIN_CAP (1u << 18)
__device__ __forceinline__ unsigned xb_ld(unsigned* p)              { return __hip_atomic_load(p, __ATOMIC_RELAXED, __HIP_MEMORY_SCOPE_AGENT); }
__device__ __forceinline__ unsigned xb_add(unsigned* p, unsigned v) { return __hip_atomic_fetch_add(p, v, __ATOMIC_RELAXED, __HIP_MEMORY_SCOPE_AGENT); }
__device__ __forceinline__ unsigned xb_xcc_id() { return (unsigned)__builtin_amdgcn_s_getreg((3 << 11) | 20) & 0xFu; }
#define XB_SPIN(cond, bar) do { unsigned _sp = 0; while (cond) { __builtin_amdgcn_s_sleep(1); \
    if ((++_sp & 255u) == 0u) { if (xb_ld(&(bar)[XB_TMO])) break; if (_sp > XB_SPIN_CAP) { atomicAdd(&(bar)[XB_TMO], 1u); break; } } } } while (0)
struct XcdBarrier { unsigned* bar; unsigned x; volatile LAS unsigned* st; };
__device__ __forceinline__ XcdBarrier xcd_barrier_post(unsigned* bar, volatile LAS unsigned* st) {
    XcdBarrier b; b.bar = bar; b.x = xb_xcc_id(); b.st = st;
    if (threadIdx.x == 0) (void)xb_add(&bar[XB_XCNT(b.x)], 1u);
    return b;
}
__device__ __forceinline__ void xcd_barrier_complete(unsigned* bar, unsigned x, unsigned& nloc, unsigned& nx) {
    const unsigned G = gridDim.x * gridDim.y * gridDim.z;
    unsigned sum, cnt, mine, sp = 0u;
    for (;;) {
        sum = 0u; cnt = 0u; mine = 0u;
#pragma unroll
        for (unsigned j = 0; j < 16; ++j) { const unsigned c = xb_ld(&bar[XB_XCNT(j)]); sum += c; cnt += (c > 0u) ? 1u : 0u; mine = (j == x) ? c : mine; }
        if (sum == G) break;
        __builtin_amdgcn_s_sleep(1);
        if ((++sp & 255u) == 0u) { if (xb_ld(&bar[XB_TMO])) break; if (sp > XB_SPIN_CAP) { atomicAdd(&bar[XB_TMO], 1u); break; } }
    }
    nloc = mine > 0u ? mine : 1u; nx = cnt > 0u ? cnt : 1u;
}
__device__ __forceinline__ void xcd_barrier(const XcdBarrier& b) {
    asm volatile("s_waitcnt vmcnt(0)" ::: "memory");
    __syncthreads();
    if (threadIdx.x == 0) {
        unsigned* bar = b.bar;
        __builtin_amdgcn_s_waitcnt(0);
        unsigned nloc = b.st[0], nx = b.st[1];
        if (nloc == 0u) { xcd_barrier_complete(bar, b.x, nloc, nx); b.st[0] = nloc; b.st[1] = nx; }
        const unsigned old = xb_add(&bar[XB_XSUB(b.x)], 1u);
        const unsigned gen = old / nloc;
        if (old + 1u == (gen + 1u) * nloc) {
            __builtin_amdgcn_fence(__ATOMIC_RELEASE, "agent");
            asm volatile("s_waitcnt vmcnt(0)" ::: "memory");
            const unsigned og = xb_add(&bar[XB_TOP], 1u);
            const unsigned tg = og / nx;
            if (og + 1u == (tg + 1u) * nx) xb_add(&bar[XB_TOPGEN], 1u);
            else XB_SPIN(xb_ld(&bar[XB_TOPGEN]) == tg, bar);
            __builtin_amdgcn_fence(__ATOMIC_ACQUIRE, "agent");
            xb_add(&bar[XB_XGEN(b.x)], 1u);
            asm volatile("s_waitcnt vmcnt(0)" ::: "memory");
        } else {
            XB_SPIN(xb_ld(&bar[XB_XGEN(b.x)]) == gen, bar);
            __builtin_amdgcn_fence(__ATOMIC_ACQUIRE, "agent");
            asm volatile("s_waitcnt vmcnt(0)" ::: "memory");
        }
    }
    __syncthreads();
}

struct Unit { int pm, pn; size_t a_off, b_off; int lbase, nvalid; };
struct Gemm { const bf16_t* A; const bf16_t* Bt; int lda, ldb, K; };
__host__ __device__ __forceinline__ int perm32(int rho) { const int n = rho >> 4, i = rho & 15; return 8 * (i >> 2) + 4 * n + (i & 3); }

struct PlainOrder {     static constexpr bool GATHER = false;
    int nM, nN, nwg, G, c, lda, ldb;
    __device__ void init(int M, int N, int G_, int c_, int lda_, int ldb_) { nM = M / 256; nN = N / 256; nwg = nM * nN; G = G_; c = c_; lda = lda_; ldb = ldb_; }
    __device__ bool next(int i, Unit& u) const {
        const long L = (long)i * G + c; if (L >= nwg) return false;
        int wgid = (int)L; { const int q = nwg / 8, r = nwg % 8, xcd = wgid % 8, off = wgid / 8; wgid = (xcd < r ? xcd * (q + 1) : r * (q + 1) + (xcd - r) * q) + off; }
        const int nig = 8 * nN, gid = wgid / nig, fm = gid * 8, gsz = (nM - fm) < 8 ? (nM - fm) : 8;
        u.pm = fm + ((wgid % nig) % gsz); u.pn = (wgid % nig) / gsz;
        u.a_off = (size_t)u.pm * 256 * lda; u.b_off = (size_t)u.pn * 256 * ldb; return true;
    }
};
struct XpreOrder {
    static constexpr bool GATHER = false;
    int G, c, mode;
    __device__ bool next(int i, Unit& u) const {
        const int L = i * G + c; if (L >= 256) return false;
        const int b = L >> 4, x = (L >> 2) & 3, y = L & 3;
        if (mode == 0) { const int h = x, kt = y; u.pm = b * 4 + h; u.pn = kt; u.a_off = (size_t)b * MEMLEN * DM + h * XHD; u.b_off = (size_t)kt * 256 * DM + h * XHD; }
        else { const int nt = x, h = y; u.pm = b * 4 + nt; u.pn = h; u.a_off = (size_t)nt * 256 * DM + h * XHD; u.b_off = (size_t)b * MEMLEN * DM + h * XHD; }
        return true;
    }
};
struct XattnOrder {
    static constexpr bool GATHER = false;
    int G, c, mode, lda, ldb;
    __device__ bool next(int i, Unit& u) const {
        int L = i * G + c; if (L >= (NTOK / 256) * 4) return false;
        if (G == 256) { const int x = c & 7, idx = c >> 3; L = ((x + 8 * i) * 8 + (idx >> 2)) * 4 + (idx & 3); }
        u.pm = L >> 2; u.pn = L & 3; const int b = u.pm >> 3;
        u.a_off = (size_t)u.pm * 256 * lda;
        u.b_off = mode == 0 ? (size_t)(b * 4 + u.pn) * 256 * ldb : (size_t)(b * 1024 + u.pn * 256) * ldb;
        return true;
    }
};
template <bool GATH_> struct MoeOrder {
    static constexpr bool GATHER = GATH_;
    const LAS int* ts; int G, c, lda, ldb; const int* ltok; unsigned rowbytes;
    __device__ bool next(int i, Unit& u) const {
        const int L = i * G + c; if (L >= ts[NEXP] * 4) return false;
        const int T = L >> 2, j = L & 3; int e = 0; while (ts[e + 1] <= T) ++e;
        const int lt = T - ts[e];
        u.pm = T; u.pn = j; u.a_off = GATH_ ? (size_t)0 : (size_t)T * 256 * lda; u.b_off = ((size_t)e * 1024 + j * 256) * ldb;
        u.lbase = e * LCAP + lt * 256; u.nvalid = ts[33 + e] - lt * 256; return true;
    }
    __device__ __forceinline__ unsigned rowoff(const Unit& u, int r) const { return (r < u.nvalid) ? (unsigned)ltok[u.lbase + r] * rowbytes : 0u; }
};


typedef int v8i __attribute__((ext_vector_type(8)));
typedef int v4i __attribute__((ext_vector_type(4)));
__device__ __forceinline__ v8i cat8(bf16x8 lo, bf16x8 hi) { const v4i a = __builtin_bit_cast(v4i, lo), b = __builtin_bit_cast(v4i, hi); return __builtin_shufflevector(a, b, 0, 1, 2, 3, 4, 5, 6, 7); }
template <int H> __device__ __forceinline__ bf16x8 half8(v8i v) { const v4i h = H ? __builtin_shufflevector(v, v, 4, 5, 6, 7) : __builtin_shufflevector(v, v, 0, 1, 2, 3); return __builtin_bit_cast(bf16x8, h); }
__device__ __forceinline__ unsigned pk4_fp8(float a, float b, float c, float d) { int w = __builtin_amdgcn_cvt_pk_fp8_f32(a, b, 0, false); w = __builtin_amdgcn_cvt_pk_fp8_f32(c, d, w, true); return (unsigned)w; }
__host__ __device__ __forceinline__ int lds_byte(int r, int c) { const int st = (r >> 4) * 2 + (c >> 5), rr = r & 15, cc = c & 31, ob = rr * 64 + cc * 2; return st * 1024 + (ob ^ (((ob >> 9) & 1) << 5)); }
__host__ __device__ __forceinline__ void stage_rc(int b, int& R, int& C) { const int st = b / 1024, sb = b % 1024, swz = sb ^ (((sb >> 9) & 1) << 5); R = (st >> 1) * 16 + swz / 64; C = (st & 1) * 32 + (swz % 64) / 2; }
template <class Epi, class Sched, bool ALIGN_EPI = false, bool SP2 = false, bool F8 = false, bool SKIPW = true>
__device__ __forceinline__ void gemm_phase(LAS unsigned char* lds, const Gemm g, const Sched& S, const Epi& E) {
    constexpr int BK = 64, HALF = 128, HTB = HALF * BK * 2;
    int tid = threadIdx.x; asm volatile("" : "+v"(tid));
    const int wid = __builtin_amdgcn_readfirstlane(tid >> 6), lane = tid & 63, wr = wid >> 2, wc = wid & 3, fr = lane & 15, fq = lane >> 4;
    const int K = g.K, nt = K / BK;
    unsigned voffA[2], voffB[2];
#pragma unroll
    for (int i = 0; i < 2; ++i) { int R, C; stage_rc(tid * 16 + i * 8192, R, C); const int Rb = Epi::PERM ? ((R & ~31) + perm32(R & 31)) : R;
        voffA[i] = (unsigned)(R * g.lda + C) * 2u; voffB[i] = (unsigned)(Rb * g.ldb + C) * 2u; }
    constexpr bool GATH = Sched::GATHER;
    unsigned vcu[2][2] = {{0u, 0u}, {0u, 0u}}, vnx[2][2] = {{0u, 0u}, {0u, 0u}}; int gR[2] = {0, 0}; unsigned gC[2] = {0u, 0u};
    if constexpr (GATH) {
#pragma unroll
        for (int i = 0; i < 2; ++i) { int R, Cq; stage_rc(tid * 16 + i * 8192, R, Cq); gR[i] = R; gC[i] = (unsigned)Cq * 2u; } }
    const size_t kstep = (size_t)(BK * 2);
    const size_t hstepA = (size_t)HALF * g.lda * 2, hstepB = (size_t)HALF * g.ldb * 2;
    const unsigned ldsw = (unsigned)wid * 1024u;
    const int aoff = lds_byte(wr * 64 + fr, fq * 8), boff = lds_byte(wc * 32 + fr, fq * 8);
    constexpr int aoff1 = 1024, boff1 = 1024;
#define PG8_SA(b, h) (((b) * 2 + (h)) * HTB)
#define PG8_SB(b, h) ((4 + (b) * 2 + (h)) * HTB)
#define PG8_STAGE(bufoff, gbase, voff) do { _Pragma("unroll") for (int _i = 0; _i < 2; ++_i) \
        __builtin_amdgcn_global_load_lds((const unsigned*)((const char*)(gbase) + (voff)[_i]), (LAS unsigned*)(lds + (bufoff) + ldsw + _i * 8192), 16, 0, 0); } while (0)
#define PG8_STA(bufoff, ptr, h, nx) do { if constexpr (GATH) { const unsigned vsel_[2] = {(nx) ? vnx[h][0] : vcu[h][0], (nx) ? vnx[h][1] : vcu[h][1]}; PG8_STAGE(bufoff, ptr, vsel_); } \
        else { PG8_STAGE(bufoff, (ptr) + (h) * hstepA, voffA); } } while (0)
#define PG8_LDA(dst, b, h) do { _Pragma("unroll") for (int m = 0; m < 4; ++m) dst[m] = cat8(*(const LAS bf16x8*)(lds + PG8_SA(b, h) + aoff + m * 2048), *(const LAS bf16x8*)(lds + PG8_SA(b, h) + aoff + m * 2048 + aoff1)); } while (0)
#define PG8_LDB(dst, b, h) do { _Pragma("unroll") for (int n = 0; n < 2; ++n) dst[n] = cat8(*(const LAS bf16x8*)(lds + PG8_SB(b, h) + boff + n * 2048), *(const LAS bf16x8*)(lds + PG8_SB(b, h) + boff + n * 2048 + boff1)); } while (0)
#define PG8_MMA(ai, bj, At, Bt) do { __builtin_amdgcn_s_setprio(1); \
        if constexpr (F8) { _Pragma("unroll") for (int m = 0; m < 4; ++m) _Pragma("unroll") for (int n = 0; n < 2; ++n) \
            asm volatile("s_nop 1\n\tv_mfma_scale_f32_16x16x128_f8f6f4 %0, %1, %2, %0, %3, %3 op_sel_hi:[0,0,0]" : "+v"(acc[ai][bj][m][n]) : "v"(Bt[n]), "v"(At[m]), "v"(sc127)); } \
        else { _Pragma("unroll") for (int m = 0; m < 4; ++m) _Pragma("unroll") for (int n = 0; n < 2; ++n) { \
            acc[ai][bj][m][n] = __builtin_amdgcn_mfma_f32_16x16x32_bf16(half8<0>(Bt[n]), half8<0>(At[m]), acc[ai][bj][m][n], 0, 0, 0); \
            acc[ai][bj][m][n] = __builtin_amdgcn_mfma_f32_16x16x32_bf16(half8<1>(Bt[n]), half8<1>(At[m]), acc[ai][bj][m][n], 0, 0, 0); } } \
        __builtin_amdgcn_s_setprio(0); } while (0)
#define PG8_WAIT_V(n) asm volatile("s_waitcnt vmcnt(" #n ")" ::: "memory")
#define PG8_WAIT_L(n) asm volatile("s_waitcnt lgkmcnt(" #n ")" ::: "memory")
#define PG8_BAR __builtin_amdgcn_s_barrier()
#define PG8_SCHED __builtin_amdgcn_sched_barrier(0)
    Unit cur, nxt; int ui = 0;
    if (!S.next(0, cur)) return;
    f32x4 acc[2][2][4][2];
#pragma unroll
    for (int a = 0; a < 2; ++a)
#pragma unroll
        for (int b = 0; b < 2; ++b)
#pragma unroll
            for (int m = 0; m < 4; ++m)
#pragma unroll
                for (int n = 0; n < 2; ++n) acc[a][b][m][n] = (f32x4){0.f, 0.f, 0.f, 0.f};
    int sc127 = 127; asm volatile("" : "+v"(sc127));
    v8i At[4], B0[2], B1[2];
    const char* cA = (const char*)(g.A + cur.a_off); const char* cB = (const char*)(g.Bt + cur.b_off);
    if constexpr (GATH) {
#pragma unroll
        for (int h = 0; h < 2; ++h)
#pragma unroll
            for (int i = 0; i < 2; ++i) vcu[h][i] = S.rowoff(cur, h * HALF + gR[i]) + gC[i]; }
    if constexpr (SP2) {
        PG8_STAGE(PG8_SB(0, 0), cB, voffB); PG8_STAGE(PG8_SB(0, 1), cB + hstepB, voffB); PG8_STA(PG8_SA(0, 0), cA, 0, false); PG8_STA(PG8_SA(0, 1), cA, 1, false);
        if (wr == 1) PG8_BAR;
        PG8_WAIT_V(2); PG8_BAR;
        PG8_STAGE(PG8_SB(1, 0), cB + kstep, voffB); PG8_STA(PG8_SA(1, 0), cA + kstep, 0, false); PG8_STAGE(PG8_SB(1, 1), cB + hstepB + kstep, voffB);
        PG8_WAIT_V(6); PG8_BAR;
    } else {
        PG8_STAGE(PG8_SB(0, 0), cB, voffB); PG8_STA(PG8_SA(0, 0), cA, 0, false); PG8_STAGE(PG8_SB(0, 1), cB + hstepB, voffB); PG8_STA(PG8_SA(0, 1), cA, 1, false);
        if (wr == 1) PG8_BAR;
        PG8_WAIT_V(4); PG8_BAR;
        PG8_STAGE(PG8_SB(1, 0), cB + kstep, voffB); PG8_STA(PG8_SA(1, 0), cA + kstep, 0, false); PG8_STAGE(PG8_SB(1, 1), cB + hstepB + kstep, voffB);
        PG8_WAIT_V(6); PG8_BAR;
    }
    for (;;) {
        const bool has_next = S.next(ui + 1, nxt);
        const char* nA = has_next ? (const char*)(g.A + nxt.a_off) : cA; const char* nB = has_next ? (const char*)(g.Bt + nxt.b_off) : cB;
        if constexpr (GATH) {
#pragma unroll
            for (int h = 0; h < 2; ++h)
#pragma unroll
                for (int i = 0; i < 2; ++i) vnx[h][i] = has_next ? (S.rowoff(nxt, h * HALF + gR[i]) + gC[i]) : vcu[h][i]; }
#pragma unroll 1
        for (int t = 0; t < nt; t += 2) {
            if constexpr (Epi::MIDK) { if (t == (nt >> 1)) E.midk(acc, cur, wr, wc, fr, fq); }
            const bool last = (t == nt - 2); const bool skipw = SKIPW && SP2 && (t == 0) && (ui > 0);
            const char* a1 = cA + (size_t)(t + 1) * kstep;
            const char* a2 = last ? nA : cA + (size_t)(t + 2) * kstep; const char* b2 = last ? nB : cB + (size_t)(t + 2) * kstep;
            const char* a3 = a2 + kstep; const char* b3 = b2 + kstep;
            if constexpr (SP2) {
            PG8_LDB(B0, 0, 0); PG8_LDB(B1, 0, 1); PG8_SCHED; PG8_LDA(At, 0, 0); PG8_STA(PG8_SA(1, 1), a1, 1, false);
            if (!skipw) PG8_WAIT_V(8); PG8_WAIT_L(0); PG8_BAR; PG8_MMA(0, 0, At, B0); PG8_MMA(0, 1, At, B1); PG8_BAR; PG8_SCHED;
            PG8_LDA(At, 0, 1); PG8_STAGE(PG8_SB(0, 0), b2, voffB); PG8_STAGE(PG8_SB(0, 1), b2 + hstepB, voffB); PG8_STA(PG8_SA(0, 0), a2, 0, last);
            if (!skipw) PG8_WAIT_V(8); PG8_WAIT_L(0); PG8_BAR; PG8_MMA(1, 0, At, B0); PG8_MMA(1, 1, At, B1); PG8_BAR; PG8_SCHED;
            PG8_LDB(B0, 1, 0); PG8_LDB(B1, 1, 1); PG8_SCHED; PG8_LDA(At, 1, 0); PG8_STA(PG8_SA(0, 1), a2, 1, last);
            PG8_WAIT_V(8); PG8_WAIT_L(0); PG8_BAR; PG8_MMA(0, 0, At, B0); PG8_MMA(0, 1, At, B1); PG8_BAR; PG8_SCHED;
            PG8_LDA(At, 1, 1); PG8_STAGE(PG8_SB(1, 0), b3, voffB); PG8_STAGE(PG8_SB(1, 1), b3 + hstepB, voffB); PG8_STA(PG8_SA(1, 0), a3, 0, last);
            PG8_WAIT_V(8); PG8_WAIT_L(0); PG8_BAR; PG8_MMA(1, 0, At, B0); PG8_MMA(1, 1, At, B1); PG8_BAR; PG8_SCHED;
            } else {
            PG8_LDB(B0, 0, 0); PG8_SCHED; PG8_LDA(At, 0, 0); PG8_STA(PG8_SA(1, 1), a1, 1, false);
            PG8_WAIT_L(8); PG8_BAR; PG8_WAIT_L(0); PG8_MMA(0, 0, At, B0); PG8_BAR; PG8_SCHED;
            PG8_LDB(B1, 0, 1); PG8_STAGE(PG8_SB(0, 0), b2, voffB);
            PG8_BAR; PG8_WAIT_L(0); PG8_MMA(0, 1, At, B1); PG8_BAR;
            PG8_LDA(At, 0, 1); PG8_STA(PG8_SA(0, 0), a2, 0, last);
            PG8_BAR; PG8_WAIT_L(0); PG8_MMA(1, 0, At, B0); PG8_BAR; PG8_SCHED;
            PG8_STAGE(PG8_SB(0, 1), b2 + hstepB, voffB);
            PG8_WAIT_V(6); PG8_BAR; PG8_MMA(1, 1, At, B1); PG8_BAR;
            PG8_LDB(B0, 1, 0); PG8_SCHED; PG8_LDA(At, 1, 0); PG8_STA(PG8_SA(0, 1), a2, 1, last);
            PG8_WAIT_L(8); PG8_BAR; PG8_WAIT_L(0); PG8_MMA(0, 0, At, B0); PG8_BAR; PG8_SCHED;
            PG8_LDB(B1, 1, 1); PG8_STAGE(PG8_SB(1, 0), b3, voffB);
            PG8_BAR; PG8_WAIT_L(0); PG8_MMA(0, 1, At, B1); PG8_BAR;
            PG8_LDA(At, 1, 1); PG8_STA(PG8_SA(1, 0), a3, 0, last);
            PG8_BAR; PG8_WAIT_L(0); PG8_MMA(1, 0, At, B0); PG8_BAR; PG8_SCHED;
            PG8_STAGE(PG8_SB(1, 1), b3 + hstepB, voffB);
            PG8_WAIT_V(6); PG8_BAR; PG8_MMA(1, 1, At, B1); PG8_BAR;
            }
        }
        if constexpr (ALIGN_EPI) { if (wr == 0) PG8_BAR; }
        if constexpr (F8) {
#pragma unroll
            for (int a = 0; a < 2; ++a)
#pragma unroll
                for (int b = 0; b < 2; ++b)
                    asm volatile("s_nop 15\n\ts_nop 7" : "+v"(acc[a][b][0][0]), "+v"(acc[a][b][0][1]), "+v"(acc[a][b][1][0]), "+v"(acc[a][b][1][1]), "+v"(acc[a][b][2][0]), "+v"(acc[a][b][2][1]), "+v"(acc[a][b][3][0]), "+v"(acc[a][b][3][1]));
        }
        if constexpr (SP2 && SKIPW) PG8_WAIT_V(0);
        E(acc, cur, wr, wc, fr, fq);
        if (!has_next) break;
#pragma unroll
        for (int a = 0; a < 2; ++a)
#pragma unroll
            for (int b = 0; b < 2; ++b)
#pragma unroll
                for (int m = 0; m < 4; ++m)
#pragma unroll
                    for (int n = 0; n < 2; ++n) acc[a][b][m][n] = (f32x4){0.f, 0.f, 0.f, 0.f};
        cur = nxt; cA = nA; cB = nB; ++ui;
        if constexpr (GATH) {
#pragma unroll
            for (int h = 0; h < 2; ++h)
#pragma unroll
                for (int i = 0; i < 2; ++i) vcu[h][i] = vnx[h][i]; }
        if constexpr (ALIGN_EPI) { if (wr == 1) PG8_BAR; }
    }
    PG8_WAIT_V(0);
    if constexpr (!ALIGN_EPI) { if (wr == 0) PG8_BAR; }
    PG8_BAR;
#undef PG8_SA
#undef PG8_SB
#undef PG8_STAGE
#undef PG8_STA
#undef PG8_LDA
#undef PG8_LDB
#undef PG8_MMA
#undef PG8_WAIT_V
#undef PG8_WAIT_L
#undef PG8_BAR
#undef PG8_SCHED
}
#define GEMM_PHASE(lds, g, S, E) gemm_phase<decltype(E), decltype(S), true, true>(lds, g, S, E)
#define GEMM_PHASE8(lds, g, S, E) gemm_phase<decltype(E), decltype(S), true, true, true>(lds, g, S, E)
#define GEMM_PHASE8N(lds, g, S, E) gemm_phase<decltype(E), decltype(S), true, true, true, false>(lds, g, S, E)

__device__ __forceinline__ float rstd_from_ssq(const float* ssq, int row) {
    const f32x4* p = (const f32x4*)(ssq + (size_t)row * 16); const f32x4 a = p[0], b = p[1], c = p[2], d = p[3];
    const float s = ((a[0] + a[1]) + (a[2] + a[3])) + ((b[0] + b[1]) + (b[2] + b[3])) + ((c[0] + c[1]) + (c[2] + c[3])) + ((d[0] + d[1]) + (d[2] + d[3]));
    return __builtin_amdgcn_rsqf(s * (1.0f / DM) + EPS);
}
__device__ __forceinline__ u32x4 pack8(const f32x4 v0, const f32x4 v1) { u32x4 w; w.x = cvt_pk_bf16(v0[0], v0[1]); w.y = cvt_pk_bf16(v0[2], v0[3]); w.z = cvt_pk_bf16(v1[0], v1[1]); w.w = cvt_pk_bf16(v1[2], v1[3]); return w; }

struct EpiProj {
    static constexpr bool PERM = true, LDSX = false, MIDK = false;
    bf16_t* base; const float* rope; float* ksum;
    __device__ __forceinline__ void operator()(f32x4 (&acc)[2][2][4][2], const Unit& u, int wr, int wc, int fr, int fq) const {
        const int type = u.pn >> 1, colt = (u.pn & 1) * 256;
        bf16_t* O = base + (size_t)type * NTOK * 512;
        const bool is_q = (type == 2), is_k = (type == 3);
        if ((is_q || is_k) && !(wc & 1)) {
#pragma unroll
            for (int ai = 0; ai < 2; ++ai)
#pragma unroll
                for (int m = 0; m < 4; ++m) {
                    const int row = u.pm * 256 + 128 * ai + 64 * wr + 16 * m + fr, pos = row & (SEQ - 1);
                    const float* rp = rope + pos * 16;
                    const f32x4 cs[2] = { *(const f32x4*)(rp), *(const f32x4*)(rp + 4) }, sn[2] = { *(const f32x4*)(rp + 8), *(const f32x4*)(rp + 12) };
#pragma unroll
                    for (int bj = 0; bj < 2; ++bj)
#pragma unroll
                        for (int n = 0; n < 2; ++n) {
                            const f32x4 mine = acc[ai][bj][m][n]; f32x4 oth;
#pragma unroll
                            for (int e = 0; e < 4; ++e) oth[e] = __shfl_xor(mine[e], 16);
                            f32x4 res = mine;
                            if (fq == 0) res = mine * cs[n] - oth * sn[n];
                            else if (fq == 1) res = mine * cs[n] + oth * sn[n];
                            acc[ai][bj][m][n] = res;
                        }
                }
        }
        const float sc = is_q ? QSCALE : 1.0f;
#pragma unroll
        for (int ai = 0; ai < 2; ++ai)
#pragma unroll
            for (int m = 0; m < 4; ++m) {
                const int row = u.pm * 256 + 128 * ai + 64 * wr + 16 * m + fr;
                bf16_t* rowp = O + (size_t)row * 512 + colt + 32 * wc + 8 * fq;
#pragma unroll
                for (int bj = 0; bj < 2; ++bj) *(u32x4*)(rowp + bj * 128) = pack8(acc[ai][bj][m][0] * sc, acc[ai][bj][m][1] * sc);
            }
        if (is_k) {
#pragma unroll
            for (int bj = 0; bj < 2; ++bj)
#pragma unroll
                for (int n = 0; n < 2; ++n)
#pragma unroll
                    for (int e = 0; e < 4; ++e) {
                        float s = 0.f;
#pragma unroll
                        for (int ai = 0; ai < 2; ++ai)
#pragma unroll
                            for (int m = 0; m < 4; ++m) s += acc[ai][bj][m][n][e];
                        s += __shfl_xor(s, 1); s += __shfl_xor(s, 2); s += __shfl_xor(s, 4); s += __shfl_xor(s, 8);
                        if (fr == 0) atomicAdd(ksum + (size_t)u.pm * 512 + colt + 128 * bj + 32 * wc + 8 * fq + 4 * n + e, s);
                    }
        }
    }
};
struct EpiStore {
    static constexpr bool PERM = true, LDSX = false, MIDK = false;
    bf16_t* O; int ldc; float sc = 1.0f;
    __device__ __forceinline__ void operator()(f32x4 (&acc)[2][2][4][2], const Unit& u, int wr, int wc, int fr, int fq) const {
#pragma unroll
        for (int ai = 0; ai < 2; ++ai)
#pragma unroll
            for (int m = 0; m < 4; ++m) {
                const int row = u.pm * 256 + 128 * ai + 64 * wr + 16 * m + fr;
                bf16_t* rowp = O + (size_t)row * ldc + u.pn * 256 + 32 * wc + 8 * fq;
#pragma unroll
                for (int bj = 0; bj < 2; ++bj) *(u32x4*)(rowp + bj * 128) = pack8(acc[ai][bj][m][0] * sc, acc[ai][bj][m][1] * sc);
            }
    }
};
struct EpiStore8 {
    static constexpr bool PERM = true, LDSX = false, MIDK = false;
    unsigned char* O; int ldc; float sc;
    __device__ __forceinline__ void operator()(f32x4 (&acc)[2][2][4][2], const Unit& u, int wr, int wc, int fr, int fq) const {
#pragma unroll
        for (int ai = 0; ai < 2; ++ai)
#pragma unroll
            for (int m = 0; m < 4; ++m) {
                const int row = u.pm * 256 + 128 * ai + 64 * wr + 16 * m + fr;
                unsigned char* rowp = O + (size_t)row * ldc + u.pn * 256 + 32 * wc + 8 * fq;
#pragma unroll
                for (int bj = 0; bj < 2; ++bj) { const f32x4 a0 = acc[ai][bj][m][0] * sc, a1 = acc[ai][bj][m][1] * sc; u32x2 w; w.x = pk4_fp8(a0[0], a0[1], a0[2], a0[3]); w.y = pk4_fp8(a1[0], a1[1], a1[2], a1[3]); *(u32x2*)(rowp + bj * 128) = w; }
            }
    }
};
template <bool BASE_F32, bool KSPLIT> struct EpiResid {
    static constexpr bool PERM = true, LDSX = false, MIDK = KSPLIT;
    const void* base; bf16_t* hb; float* ssq; const float* ssql; const float* ssqa; unsigned char* h8; float asc; const float* rs0 = nullptr; const float* gmix = nullptr;
    __device__ __forceinline__ void stats(int row, int fq, float& rl, float& ra) const {
        const f32x4 pl = *(const f32x4*)(ssql + (size_t)row * 16 + 4 * fq); const f32x2 pa = *(const f32x2*)(ssqa + (size_t)row * 8 + 2 * fq);
        float sl = (pl[0] + pl[1]) + (pl[2] + pl[3]), sa = pa[0] + pa[1];
        sl += __shfl_xor(sl, 16); sl += __shfl_xor(sl, 32); sa += __shfl_xor(sa, 16); sa += __shfl_xor(sa, 32);
        rl = __builtin_amdgcn_rsqf(sl * (1.0f / 512.0f) + EPS); ra = __builtin_amdgcn_rsqf(sa * (1.0f / 512.0f) + EPS);
    }
    __device__ __forceinline__ void midk(f32x4 (&acc)[2][2][4][2], const Unit& u, int wr, int wc, int fr, int fq) const {
        asm volatile("" : "+v"(fr), "+v"(fq));
#pragma unroll
        for (int ai = 0; ai < 2; ++ai)
#pragma unroll
            for (int m = 0; m < 4; ++m) { float rl, ra; stats(u.pm * 256 + 128 * ai + 64 * wr + 16 * m + fr, fq, rl, ra); const float ratio = rl * __builtin_amdgcn_rcpf(ra);
#pragma unroll
                for (int bj = 0; bj < 2; ++bj)
#pragma unroll
                    for (int n = 0; n < 2; ++n) acc[ai][bj][m][n] *= ratio; }
    }
    __device__ __forceinline__ void operator()(f32x4 (&acc)[2][2][4][2], const Unit& u, int wr, int wc, int fr, int fq) const {
        f32x4 ginv[2][2];
        if constexpr (BASE_F32) {
#pragma unroll
            for (int bj = 0; bj < 2; ++bj)
#pragma unroll
                for (int n = 0; n < 2; ++n) { const f32x4 g = *(const f32x4*)(gmix + u.pn * 256 + 128 * bj + 32 * wc + 8 * fq + 4 * n);
                    ginv[bj][n] = (f32x4){__builtin_amdgcn_rcpf(g[0]), __builtin_amdgcn_rcpf(g[1]), __builtin_amdgcn_rcpf(g[2]), __builtin_amdgcn_rcpf(g[3])}; } }
#pragma unroll
        for (int ai = 0; ai < 2; ++ai)
#pragma unroll
            for (int m = 0; m < 4; ++m) {
                const int row = u.pm * 256 + 128 * ai + 64 * wr + 16 * m + fr; float q = 0.f, osc = asc, irs = 1.0f;
                if constexpr (KSPLIT) { float rl; stats(row, fq, rl, osc); osc *= asc; }
                if constexpr (BASE_F32) irs = __builtin_amdgcn_rcpf(rs0[row]);
#pragma unroll
                for (int bj = 0; bj < 2; ++bj) {
                    const int col = u.pn * 256 + 128 * bj + 32 * wc + 8 * fq;
                    f32x4 b0, b1;
                    if constexpr (BASE_F32) { const u32x4 w = *(const u32x4*)((const bf16_t*)base + (size_t)row * DM + col);
                        b0 = (f32x4){bflo(w.x), bfhi(w.x), bflo(w.y), bfhi(w.y)} * (ginv[bj][0] * irs); b1 = (f32x4){bflo(w.z), bfhi(w.z), bflo(w.w), bfhi(w.w)} * (ginv[bj][1] * irs); }
                    else { const u32x4 w = *(const u32x4*)((const bf16_t*)base + (size_t)row * LDH + col); b0 = (f32x4){bflo(w.x), bfhi(w.x), bflo(w.y), bfhi(w.y)}; b1 = (f32x4){bflo(w.z), bfhi(w.z), bflo(w.w), bfhi(w.w)}; }
                    const f32x4 v0 = b0 + acc[ai][bj][m][0] * osc, v1 = b1 + acc[ai][bj][m][1] * osc;
                    q += ((v0[0] * v0[0] + v0[1] * v0[1]) + (v0[2] * v0[2] + v0[3] * v0[3])) + ((v1[0] * v1[0] + v1[1] * v1[1]) + (v1[2] * v1[2] + v1[3] * v1[3]));
                    *(u32x4*)(hb + (size_t)row * LDH + col) = pack8(v0, v1);
                    if (h8) { u32x2 w8; w8.x = pk4_fp8(v0[0], v0[1], v0[2], v0[3]); w8.y = pk4_fp8(v1[0], v1[1], v1[2], v1[3]); *(u32x2*)(h8 + (size_t)row * DM + col) = w8; }
                }
                q += __shfl_xor(q, 16); q += __shfl_xor(q, 32);
                if (fq == 0) ssq[(size_t)row * 16 + u.pn * 4 + wc] = q;
            }
    }
};
#define XBAR() do { asm volatile("s_waitcnt lgkmcnt(0)" ::: "memory"); __builtin_amdgcn_s_barrier(); asm volatile("" ::: "memory"); } while (0)
struct EpiSoftmax {
    static constexpr bool PERM = true, LDSX = false, MIDK = false;
    unsigned char* O; int ldc; LAS unsigned char* xl; const float* ssq; float cs;
    __device__ __forceinline__ void operator()(f32x4 (&acc)[2][2][4][2], const Unit& u, int wr, int wc, int fr, int fq) const {
        LAS float* P = (LAS float*)xl;
        LAS float* Q = (LAS float*)(xl + 4096);
#pragma unroll
        for (int ai = 0; ai < 2; ++ai)
#pragma unroll
            for (int m = 0; m < 4; ++m) {
                float v = -INFINITY; const float sc = rstd_from_ssq(ssq, u.pm * 256 + 128 * ai + 64 * wr + 16 * m + fr) * cs;
#pragma unroll
                for (int bj = 0; bj < 2; ++bj)
#pragma unroll
                    for (int n = 0; n < 2; ++n) { const f32x4 x = acc[ai][bj][m][n] * sc; acc[ai][bj][m][n] = x; v = fmaxf(v, fmaxf(fmaxf(x[0], x[1]), fmaxf(x[2], x[3]))); }
                v = fmaxf(v, __shfl_xor(v, 16)); v = fmaxf(v, __shfl_xor(v, 32));
                if (fq == 0) P[(128 * ai + 64 * wr + 16 * m + fr) * 4 + wc] = v;
            }
        XBAR();
#pragma unroll
        for (int ai = 0; ai < 2; ++ai)
#pragma unroll
            for (int m = 0; m < 4; ++m) {
                const int r = 128 * ai + 64 * wr + 16 * m + fr;
                const float v = fmaxf(fmaxf(P[r * 4 + 0], P[r * 4 + 1]), fmaxf(P[r * 4 + 2], P[r * 4 + 3]));
                float s = 0.f;
#pragma unroll
                for (int bj = 0; bj < 2; ++bj)
#pragma unroll
                    for (int n = 0; n < 2; ++n) { f32x4 x = acc[ai][bj][m][n];
#pragma unroll
                        for (int e = 0; e < 4; ++e) { x[e] = __builtin_amdgcn_exp2f(x[e] - v); s += x[e]; }
                        acc[ai][bj][m][n] = x; }
                s += __shfl_xor(s, 16); s += __shfl_xor(s, 32);
                if (fq == 0) Q[r * 4 + wc] = s;
            }
        XBAR();
#pragma unroll
        for (int ai = 0; ai < 2; ++ai)
#pragma unroll
            for (int m = 0; m < 4; ++m) {
                const int r = 128 * ai + 64 * wr + 16 * m + fr;
                const float inv = PX_SC * __builtin_amdgcn_rcpf((Q[r * 4 + 0] + Q[r * 4 + 1]) + (Q[r * 4 + 2] + Q[r * 4 + 3]));
                unsigned char* rowp = O + (size_t)(u.pm * 256 + r) * ldc + u.pn * 256 + 32 * wc + 8 * fq;
#pragma unroll
                for (int bj = 0; bj < 2; ++bj) { const f32x4 a0 = acc[ai][bj][m][0] * inv, a1 = acc[ai][bj][m][1] * inv; u32x2 w; w.x = pk4_fp8(a0[0], a0[1], a0[2], a0[3]); w.y = pk4_fp8(a1[0], a1[1], a1[2], a1[3]); *(u32x2*)(rowp + bj * 128) = w; }
            }
        XBAR();
    }
};
struct EpiGateUp {
    static constexpr bool PERM = true, LDSX = false, MIDK = false;
    unsigned char* O; const float* lrs;
    __device__ __forceinline__ void operator()(f32x4 (&acc)[2][2][4][2], const Unit& u, int wr, int wc, int fr, int fq) const {
#pragma unroll
        for (int ai = 0; ai < 2; ++ai)
#pragma unroll
            for (int m = 0; m < 4; ++m) {
                const int r = 128 * ai + 64 * wr + 16 * m + fr, row = u.pm * 256 + r; const float rs = (r < u.nvalid) ? lrs[u.lbase + r] * (1.0f / WGU_SC) : 0.f;
                f32x4 o[2];
#pragma unroll
                for (int n = 0; n < 2; ++n)
#pragma unroll
                    for (int e = 0; e < 4; ++e) { const float g = acc[ai][0][m][n][e] * rs, up = acc[ai][1][m][n][e] * rs; o[n][e] = g * sigmoidf_(g) * up * ACT_SC; }
                u32x2 w8; w8.x = pk4_fp8(o[0][0], o[0][1], o[0][2], o[0][3]); w8.y = pk4_fp8(o[1][0], o[1][1], o[1][2], o[1][3]);
                *(u32x2*)(O + (size_t)row * DFF + u.pn * 128 + 32 * wc + 8 * fq) = w8;
            }
    }
};

struct Args { const float* in[27]; float* out; unsigned char* ws; int ph_lo, ph_hi; float invf[8]; };
struct Ctx { LAS unsigned char* lds; int tid, lane, wave, vcu, G; };

__device__ __forceinline__ void tr_load(f32x4 (&v)[8], const float* W, int ldw, int k0, int n0s, int lane) {
    const int kr = lane >> 3, ch = lane & 7;
#pragma unroll
    for (int i = 0; i < 8; ++i) v[i] = *(const f32x4*)(W + (size_t)(k0 + 8 * i + kr) * ldw + n0s + 4 * ch);
}
__device__ __forceinline__ void tr_finish(const f32x4 (&v)[8], int k0, bf16_t* WT, int ldt, int r0d, const float* gain, LAS float* scr, int lane) {
    const int kr = lane >> 3, ch = lane & 7, c = lane & 7;
    f32x4 g0 = {1.f, 1.f, 1.f, 1.f}, g1 = {1.f, 1.f, 1.f, 1.f};
    if (gain) { g0 = *(const f32x4*)(gain + k0 + 8 * c); g1 = *(const f32x4*)(gain + k0 + 8 * c + 4); }
#pragma unroll
    for (int i = 0; i < 8; ++i) { LAS float* d = scr + (8 * i + kr) * 33 + 4 * ch; d[0] = v[i][0]; d[1] = v[i][1]; d[2] = v[i][2]; d[3] = v[i][3]; }
    LDS_WAIT(); asm volatile("" ::: "memory");
#pragma unroll
    for (int j = 0; j < 4; ++j) { const int n = (lane >> 3) + 8 * j; const LAS float* s = scr + (8 * c) * 33 + n;
        u32x4 o; o.x = cvt_pk_bf16(s[0 * 33] * g0[0], s[1 * 33] * g0[1]); o.y = cvt_pk_bf16(s[2 * 33] * g0[2], s[3 * 33] * g0[3]); o.z = cvt_pk_bf16(s[4 * 33] * g1[0], s[5 * 33] * g1[1]); o.w = cvt_pk_bf16(s[6 * 33] * g1[2], s[7 * 33] * g1[3]);
        *(u32x4*)(WT + (size_t)(r0d + n) * ldt + k0 + 8 * c) = o; }
    LDS_WAIT(); asm volatile("" ::: "memory");
}
__device__ __forceinline__ void tr_finish8(const f32x4 (&v)[8], int k0, unsigned char* WT8, int ldt, int r0d, const float* gain, float sc, LAS float* scr, int lane) {
    const int kr = lane >> 3, ch = lane & 7, c = lane & 7;
    f32x4 g0 = {sc, sc, sc, sc}, g1 = {sc, sc, sc, sc};
    if (gain) { g0 = *(const f32x4*)(gain + k0 + 8 * c) * sc; g1 = *(const f32x4*)(gain + k0 + 8 * c + 4) * sc; }
#pragma unroll
    for (int i = 0; i < 8; ++i) { LAS float* d = scr + (8 * i + kr) * 33 + 4 * ch; d[0] = v[i][0]; d[1] = v[i][1]; d[2] = v[i][2]; d[3] = v[i][3]; }
    LDS_WAIT(); asm volatile("" ::: "memory");
#pragma unroll
    for (int j = 0; j < 4; ++j) { const int n = (lane >> 3) + 8 * j; const LAS float* s = scr + (8 * c) * 33 + n;
        u32x2 o; o.x = pk4_fp8(s[0 * 33] * g0[0], s[1 * 33] * g0[1], s[2 * 33] * g0[2], s[3 * 33] * g0[3]); o.y = pk4_fp8(s[4 * 33] * g1[0], s[5 * 33] * g1[1], s[6 * 33] * g1[2], s[7 * 33] * g1[3]);
        *(u32x2*)(WT8 + (size_t)(r0d + n) * ldt + k0 + 8 * c) = o; }
    LDS_WAIT(); asm volatile("" ::: "memory");
}
__device__ __forceinline__ void tr_item(const float* W, int ldw, int k0, int n0s, bf16_t* WT, int ldt, int r0d, const float* gain, LAS float* scr, int lane) {
    f32x4 v[8]; tr_load(v, W, ldw, k0, n0s, lane); tr_finish(v, k0, WT, ldt, r0d, gain, scr, lane);
}

__device__ __forceinline__ void rms_row2_to_bf16(const float* xrow, const float* gain, bf16_t* orow, int lane, float* rstd_out = nullptr) {
    const f32x4* xr = (const f32x4*)xrow + lane; const f32x4* gr = (const f32x4*)gain + lane;
    f32x4 v[2][4]; float s[2] = {0.f, 0.f};
#pragma unroll
    for (int r = 0; r < 2; ++r)
#pragma unroll
        for (int j = 0; j < 4; ++j) v[r][j] = xr[256 * r + 64 * j];
#pragma unroll
    for (int r = 0; r < 2; ++r)
#pragma unroll
        for (int j = 0; j < 4; ++j) s[r] += (v[r][j][0] * v[r][j][0] + v[r][j][1] * v[r][j][1]) + (v[r][j][2] * v[r][j][2] + v[r][j][3] * v[r][j][3]);
#pragma unroll
    for (int r = 0; r < 2; ++r) { const float rstd = 1.0f / sqrtf(wave_sum(s[r]) * (1.0f / DM) + EPS); u32x2* o8 = (u32x2*)(orow + (size_t)r * DM) + lane; if (rstd_out && lane == 0) rstd_out[r] = rstd;
#pragma unroll
        for (int j = 0; j < 4; ++j) { const f32x4 g = gr[64 * j]; u32x2 w; w.x = cvt_pk_bf16(v[r][j][0] * rstd * g[0], v[r][j][1] * rstd * g[1]); w.y = cvt_pk_bf16(v[r][j][2] * rstd * g[2], v[r][j][3] * rstd * g[3]); o8[64 * j] = w; } }
}

__device__ __forceinline__ void conv_wdn(const Args& a, const Ctx& C, int gw, int NGW, int it_lo, int NIT) {
    LAS float* scr = (LAS float*)(C.lds + C.wave * 16384); const int lane = C.lane;
    f32x4 va[8], vb[8];
#define WDN_LOAD(v, it) do { const int e_ = (it) / 256, r_ = (it) % 256; tr_load(v, a.in[25] + (size_t)e_ * DFF * DM, DM, 64 * (r_ / 32), 32 * (r_ % 32), lane); } while (0)
#define WDN_FIN(v, it) do { const int e_ = (it) / 256, r_ = (it) % 256; tr_finish8(v, 64 * (r_ / 32), a.ws + WS_WDN, DFF, e_ * 1024 + 32 * (r_ % 32), nullptr, WDN_SC, scr, lane); } while (0)
    int it = it_lo + gw; if (it < NIT) WDN_LOAD(va, it);
    for (; it < NIT; it += 2 * NGW) {
        const int it1 = it + NGW, it2 = it + 2 * NGW;
        if (it1 < NIT) WDN_LOAD(vb, it1);
        WDN_FIN(va, it);
        if (it2 < NIT) WDN_LOAD(va, it2);
        if (it1 < NIT) WDN_FIN(vb, it1);
    }
#undef WDN_LOAD
#undef WDN_FIN
}
__device__ __forceinline__ void ph_prologue(const Args& a, const Ctx& C) {
    unsigned char* ws = a.ws;
    LAS float* scr = (LAS float*)(C.lds + C.wave * 16384);
    const int gw = C.vcu * 8 + C.wave, NGW = C.G * 8, lane = C.lane;
    for (int it = gw; it < 16 * 80; it += NGW) { const int kb = it / 80, nb = it % 80; tr_item(a.in[3], DIN, 64 * kb, 32 * nb, (bf16_t*)(ws + WS_WIN), DM, 32 * nb, nullptr, scr, lane); }
    for (int it = gw; it < 16 * 64; it += NGW) { const int kb = it / 64, nb = it % 64;
        if (nb < 32) tr_item(a.in[17], 2 * DM, 64 * kb, 32 * nb, (bf16_t*)(ws + WS_WXK), DM, 32 * nb, nullptr, scr, lane);
        else tr_item(a.in[17], 2 * DM, 64 * kb, 32 * nb, (bf16_t*)(ws + WS_WXV), DM, 32 * (nb - 32), nullptr, scr, lane); }
    for (int it = gw; it < 16 * 32; it += NGW) { const int kb = it / 32, nb = it % 32;
        tr_item(a.in[13], DM, 64 * kb, 32 * nb, (bf16_t*)(ws + WS_WOUT), DM, 32 * nb, (kb < 8) ? a.in[11] : (a.in[12] - DLRU), scr, lane);
        tr_item(a.in[18], DM, 64 * kb, 32 * nb, (bf16_t*)(ws + WS_WXO), DM, 32 * nb, nullptr, scr, lane); }
    for (int r = gw; r < DM; r += NGW) { const float gk = a.in[14][r]; const f32x4* src = (const f32x4*)(a.in[16] + (size_t)r * DM) + lane; u32x2* dst = (u32x2*)((bf16_t*)(ws + WS_WXQ) + (size_t)r * DM) + lane;
#pragma unroll
        for (int j = 0; j < 4; ++j) { const f32x4 v = src[64 * j]; u32x2 w; w.x = cvt_pk_bf16(v[0] * gk, v[1] * gk); w.y = cvt_pk_bf16(v[2] * gk, v[3] * gk); dst[64 * j] = w; } }
    { bf16_t* WR = (bf16_t*)(ws + WS_WR); const int gt = C.vcu * 512 + C.tid, NT = C.G * 512;
      for (int i = gt; i < 48 * DM; i += NT) { const int r = i / DM, k = i % DM; float v = 0.f;
          if (r < 4) v = a.in[20][k * NGRP + r] * a.in[19][k]; else if (r < 36) v = a.in[22][k * NEXP + (r - 4)] * a.in[19][k];
          WR[i] = (bf16_t)(cvt_pk_bf16(v, 0.f) & 0xffffu); }
      float* rope = (float*)(ws + WS_ROPE);
      for (int i = gt; i < SEQ * 8; i += NT) { const int pos = i >> 3, j = i & 7; const float ang = (float)pos * a.invf[j];
          const double tw = 6.283185307179586476925286766559; const double ad = (double)ang; const double red = ad - tw * __builtin_rint(ad / tw); const float rf = (float)red;
          rope[pos * 16 + j] = __cosf(rf); rope[pos * 16 + 8 + j] = __sinf(rf); } }
    for (int m = 2 * gw; m < NTOK; m += 2 * NGW) rms_row2_to_bf16(a.in[0] + (size_t)m * DM, a.in[2], (bf16_t*)(ws + WS_B) + (size_t)m * DM, lane, (float*)(ws + WS_TOK + TOK_D) + m);
    for (int m = 2 * gw; m < NMEM; m += 2 * NGW) rms_row2_to_bf16(a.in[1] + (size_t)m * DM, a.in[15], (bf16_t*)(ws + WS_MEMN) + (size_t)m * DM, lane);
}

__device__ __forceinline__ float gelu_tanh(float x) { const float x2 = x * x; const float z2 = x * (-2.0f * 0.7978845608028654f * 1.4426950408889634f) * (1.0f + 0.044715f * x2);
    return x * __builtin_amdgcn_rcpf(1.0f + __builtin_amdgcn_exp2f(z2)); }
__device__ __forceinline__ bool moe_item_load(f32x4 (&v)[8], const Args& a, int s, int lane) {
    if (s < NEXP * 512) { const int e = s / 512, r = s % 512, kb = r / 32, nb = r % 32, j = nb >> 3, half = (nb >> 2) & 1, q = nb & 3;
        tr_load(v, a.in[24] + (size_t)e * DM * DM, DM, 64 * kb, half * 512 + j * 128 + q * 32, lane); return true; }
    const int it = s - NEXP * 512 + WDN_SPLIT; if (it >= NEXP * 256) return false;
    const int e = it / 256, r = it % 256; tr_load(v, a.in[25] + (size_t)e * DFF * DM, DM, 64 * (r / 32), 32 * (r % 32), lane); return true;
}
__device__ __forceinline__ void moe_item_finish(const f32x4 (&v)[8], const Args& a, int s, LAS float* scr, int lane) {
    if (s < NEXP * 512) { const int e = s / 512, r = s % 512, kb = r / 32, nb = r % 32, j = nb >> 3, half = (nb >> 2) & 1, q = nb & 3;
        tr_finish8(v, 64 * kb, a.ws + WS_WGU, DM, e * 1024 + j * 256 + half * 128 + q * 32, a.in[19], WGU_SC, scr, lane); return; }
    const int it = s - NEXP * 512 + WDN_SPLIT; const int e = it / 256, r = it % 256;
    tr_finish8(v, 64 * (r / 32), a.ws + WS_WDN, DFF, e * 1024 + 32 * (r % 32), nullptr, WDN_SC, scr, lane);
}
__device__ __forceinline__ void lru_unit(const Args& a, const Ctx& C, int b, int blk, int half, int L) {
    unsigned char* ws = a.ws;
    const bf16_t* XL = (const bf16_t*)(ws + WS_A); const bf16_t* GL = XL + (size_t)NTOK * 512; bf16_t* YC = (bf16_t*)(ws + WS_C); float* SSQL = (float*)(ws + WS_SSQL);
    const int tid = C.tid, lane = C.lane, wave = C.wave, fr = lane & 15, fq = lane >> 4;
    LAS float* cscr = (LAS float*)(C.lds + 46336 + wave * 8448);
    LAS float* XW = (LAS float*)(C.lds + wave * 5120);
    LAS bf16_t* GW = (LAS bf16_t*)(C.lds + wave * 5120 + 2304);
    LAS bf16_t* YW = (LAS bf16_t*)(C.lds + wave * 5120 + 3584);
    LAS float* WSUM = (LAS float*)(C.lds + 40960);
    LAS float* CW = (LAS float*)(C.lds + 45056);
    const int c0 = blk * 64, oc0 = c0 + half * 32;
    bf16x8 wfr[2][2][2];
#pragma unroll
    for (int gt = 0; gt < 2; ++gt) { const float* W = a.in[gt == 0 ? 6 : 8] + (size_t)blk * 64 * 64;
#pragma unroll
        for (int nt = 0; nt < 2; ++nt)
#pragma unroll
            for (int ks = 0; ks < 2; ++ks) { u32x4 w; float f[8];
#pragma unroll
                for (int j = 0; j < 8; ++j) f[j] = W[(32 * ks + 8 * fq + j) * 64 + half * 32 + 16 * nt + fr];
                w.x = cvt_pk_bf16(f[0], f[1]); w.y = cvt_pk_bf16(f[2], f[3]); w.z = cvt_pk_bf16(f[4], f[5]); w.w = cvt_pk_bf16(f[6], f[7]);
                wfr[gt][nt][ks] = __builtin_bit_cast(bf16x8, w); } }
    LAS bf16x8* WF = (LAS bf16x8*)(C.lds + 113920);
    if (wave == 0) {
#pragma unroll
        for (int gt = 0; gt < 2; ++gt)
#pragma unroll
            for (int nt = 0; nt < 2; ++nt)
#pragma unroll
                for (int ks = 0; ks < 2; ++ks) WF[((gt * 2 + nt) * 2 + ks) * 64 + lane] = wfr[gt][nt][ks]; }
    float brg[2], big[2], sp[2], hc[2] = {0.f, 0.f};
#pragma unroll
    for (int nt = 0; nt < 2; ++nt) { const int ch = oc0 + 16 * nt + fr; brg[nt] = a.in[7][ch] * -1.4426950408889634f; big[nt] = a.in[9][ch] * -1.4426950408889634f; const float lam = a.in[10][ch];
        sp[nt] = -8.0f * 1.4426950408889634f * ((lam > 15.f) ? __expf(-lam) : log1pf(__expf(-lam))); }
    if (tid < 320) { const int k = tid >> 6, c = tid & 63; CW[tid] = (k < 4) ? a.in[4][k * DLRU + c0 + c] : a.in[5][c0 + c]; }
    u32x4 xr1[4][2], gr1;
    const bf16_t* xrow0 = XL + ((size_t)b * SEQ + 16 * wave + fr) * 512 + c0 + 8 * fq;
    const bf16_t* grow0 = GL + ((size_t)b * SEQ + 16 * wave + (lane >> 2)) * 512 + oc0 + 8 * (lane & 3);
    const int tloc = 16 * wave + fr;
#define LRU_PREFETCH(t0_, xr, gr) do { _Pragma("unroll") for (int k = 0; k < 4; ++k) { const int tt = (t0_) + tloc - 3 + k; \
        if (tt >= 0) { const bf16_t* xp = xrow0 + (ptrdiff_t)((t0_) - 3 + k) * 512; xr[k][0] = *(const u32x4*)xp; xr[k][1] = *(const u32x4*)(xp + 32); } else { xr[k][0] = (u32x4){0u, 0u, 0u, 0u}; xr[k][1] = (u32x4){0u, 0u, 0u, 0u}; } } \
        gr = *(const u32x4*)(grow0 + (size_t)(t0_) * 512); } while (0)
    LRU_PREFETCH(0, xr1, gr1);
    __syncthreads();
    for (int ch2 = 0; ch2 < SEQ / 256; ++ch2) {
#pragma unroll
      for (int sub = 0; sub < 2; ++sub) { const int ch = 2 * ch2 + sub, t0 = ch * 128; auto& xr = xr1; auto& gr = gr1;
        f32x4 cv[8]; const int cslot = sub * (NEXP * 512) + (ch2 * 256 + L) * 8 + wave; const bool chas = moe_item_load(cv, a, cslot, lane);
        bf16x8 af[2];
#pragma unroll
        for (int ks = 0; ks < 2; ++ks) { float accv[8];
            { const f32x4 b0 = *(const LAS f32x4*)(CW + 256 + 32 * ks + 8 * fq), b1 = *(const LAS f32x4*)(CW + 256 + 32 * ks + 8 * fq + 4);
              accv[0] = b0[0]; accv[1] = b0[1]; accv[2] = b0[2]; accv[3] = b0[3]; accv[4] = b1[0]; accv[5] = b1[1]; accv[6] = b1[2]; accv[7] = b1[3]; }
#pragma unroll
            for (int k = 0; k < 4; ++k) { const f32x4 w0 = *(const LAS f32x4*)(CW + 64 * k + 32 * ks + 8 * fq), w1 = *(const LAS f32x4*)(CW + 64 * k + 32 * ks + 8 * fq + 4); const u32x4 x = xr[k][ks];
                accv[0] += w0[0] * bflo(x.x); accv[1] += w0[1] * bfhi(x.x); accv[2] += w0[2] * bflo(x.y); accv[3] += w0[3] * bfhi(x.y);
                accv[4] += w1[0] * bflo(x.z); accv[5] += w1[1] * bfhi(x.z); accv[6] += w1[2] * bflo(x.w); accv[7] += w1[3] * bfhi(x.w); }
            u32x4 p; p.x = cvt_pk_bf16(accv[0], accv[1]); p.y = cvt_pk_bf16(accv[2], accv[3]); p.z = cvt_pk_bf16(accv[4], accv[5]); p.w = cvt_pk_bf16(accv[6], accv[7]);
            af[ks] = __builtin_bit_cast(bf16x8, p);
            if (ks == half) { *(LAS f32x4*)(XW + fr * 36 + 8 * fq) = (f32x4){accv[0], accv[1], accv[2], accv[3]}; *(LAS f32x4*)(XW + fr * 36 + 8 * fq + 4) = (f32x4){accv[4], accv[5], accv[6], accv[7]}; } }
        *(LAS u32x4*)(GW + (lane >> 2) * 40 + 8 * (lane & 3)) = gr;
        if (ch + 1 < SEQ / 128) LRU_PREFETCH(t0 + 128, xr, gr);
        LDS_WAIT(); asm volatile("" ::: "memory");
        float Hl[2][4], Al[2][4], Aex[2], Hex[2];
        { f32x4 ar[2] = {{0.f, 0.f, 0.f, 0.f}, {0.f, 0.f, 0.f, 0.f}}, ai_[2] = {{0.f, 0.f, 0.f, 0.f}, {0.f, 0.f, 0.f, 0.f}};
#pragma unroll
          for (int ks = 0; ks < 2; ++ks)
#pragma unroll
              for (int nt = 0; nt < 2; ++nt) { ar[nt] = __builtin_amdgcn_mfma_f32_16x16x32_bf16(af[ks], WF[((0 * 2 + nt) * 2 + ks) * 64 + lane], ar[nt], 0, 0, 0); ai_[nt] = __builtin_amdgcn_mfma_f32_16x16x32_bf16(af[ks], WF[((1 * 2 + nt) * 2 + ks) * 64 + lane], ai_[nt], 0, 0, 0); }
#pragma unroll
          for (int nt = 0; nt < 2; ++nt) {
              float hrun = 0.f, arun = 1.f;
#pragma unroll
              for (int r = 0; r < 4; ++r) { const int chn = 16 * nt + fr;
                  const float rg = __builtin_amdgcn_rcpf(1.0f + __builtin_amdgcn_exp2f(__builtin_fmaf(ar[nt][r], -1.4426950408889634f, brg[nt])));
                  const float ig = __builtin_amdgcn_rcpf(1.0f + __builtin_amdgcn_exp2f(__builtin_fmaf(ai_[nt][r], -1.4426950408889634f, big[nt])));
                  const float av = __builtin_amdgcn_exp2f(rg * sp[nt]); const float mult = __builtin_amdgcn_sqrtf(fmaxf(1.0f - av * av, 0.f));
                  const float uv = mult * ig * XW[(4 * fq + r) * 36 + chn];
                  hrun = av * hrun + uv; arun *= av; Hl[nt][r] = hrun; Al[nt][r] = arun; }
              const float A0 = __shfl(arun, fr), H0 = __shfl(hrun, fr), A1 = __shfl(arun, fr + 16), H1 = __shfl(hrun, fr + 16), A2 = __shfl(arun, fr + 32), H2 = __shfl(hrun, fr + 32), A3 = __shfl(arun, fr + 48), H3 = __shfl(hrun, fr + 48);
              const float h01 = A1 * H0 + H1, a01 = A1 * A0, h012 = A2 * h01 + H2, a012 = A2 * a01;
              Aex[nt] = (fq == 0) ? 1.f : (fq == 1) ? A0 : (fq == 2) ? a01 : a012;
              Hex[nt] = (fq == 0) ? 0.f : (fq == 1) ? H0 : (fq == 2) ? h01 : h012;
              if (fq == 0) *(LAS f32x2*)(WSUM + (((ch & 1) * 8 + wave) * 32 + 16 * nt + fr) * 2) = (f32x2){A3 * a012, A3 * h012 + H3}; } }
        __syncthreads();
        { float ssr[4] = {0.f, 0.f, 0.f, 0.f};
#pragma unroll
          for (int nt = 0; nt < 2; ++nt) { const int chn = 16 * nt + fr; float x = hc[nt], mine = 0.f;
#pragma unroll
              for (int w2 = 0; w2 < 8; ++w2) { const f32x2 sm = *(const LAS f32x2*)(WSUM + (((ch & 1) * 8 + w2) * 32 + chn) * 2); if (w2 == wave) mine = x; x = sm[0] * x + sm[1]; }
              hc[nt] = x;
              const float hstart = Aex[nt] * mine + Hex[nt];
#pragma unroll
              for (int r = 0; r < 4; ++r) { const int tl = 4 * fq + r; const float h = Al[nt][r] * hstart + Hl[nt][r];
                  const float y = h * gelu_tanh(bf2f(GW[tl * 40 + chn])); const unsigned yb = cvt_pk_bf16(y, 0.f) & 0xffffu; YW[tl * 40 + chn] = (bf16_t)yb;
                  const float yr = __uint_as_float(yb << 16); ssr[r] += yr * yr; } }
#pragma unroll
          for (int r = 0; r < 4; ++r) { float q = ssr[r]; q += __shfl_xor(q, 1); q += __shfl_xor(q, 2); q += __shfl_xor(q, 4); q += __shfl_xor(q, 8);
              if (fr == 0) SSQL[((size_t)b * SEQ + t0 + 16 * wave + 4 * fq + r) * 16 + blk * 2 + half] = q; } }
        LDS_WAIT(); asm volatile("" ::: "memory");
        *(u32x4*)(YC + ((size_t)b * SEQ + t0 + 16 * wave + (lane >> 2)) * DM + oc0 + 8 * (lane & 3)) = *(const LAS u32x4*)(YW + (lane >> 2) * 40 + 8 * (lane & 3));
        if (chas) moe_item_finish(cv, a, cslot, cscr, lane);
      }
    }
#undef LRU_PREFETCH
    __syncthreads();
}


__device__ __forceinline__ void ph_router(const Args& a, const Ctx& C) {
    unsigned char* ws = a.ws;
    const bf16_t* H2B = (const bf16_t*)a.out + DM; const bf16_t* WR = (const bf16_t*)(ws + WS_WR); const float* SSQ2 = (const float*)(ws + WS_SSQ2);
    unsigned* CNT = (unsigned*)(ws + WS_CTL) + CW_CNT;
    int* TOKE = (int*)(ws + WS_TOK + TOK_E); int* TOKR = (int*)(ws + WS_TOK + TOK_R); float* TOKG = (float*)(ws + WS_TOK + TOK_G); int* LTOK = (int*)(ws + WS_LTOK); float* LRS = (float*)(ws + WS_LRS);
    constexpr int WRS = 1032;
    LAS bf16_t* WRL = (LAS bf16_t*)C.lds;
    LAS float* LG = (LAS float*)(C.lds + 99072) + C.wave * (16 * 49);
    LAS unsigned* lcnt = (LAS unsigned*)(C.lds + 99072 + 25088); LAS unsigned* lbase = lcnt + 32;
    const int lane = C.lane, fr = lane & 15, fq = lane >> 4;
    for (int i = C.tid; i < 48 * 128; i += 512) { const int r = i >> 7, c8 = i & 127; *(LAS u32x4*)(WRL + r * WRS + 8 * c8) = *(const u32x4*)(WR + (size_t)r * DM + 8 * c8); }
    for (int pass = 0; (pass * C.G) * 128 < NTOK; ++pass) {
        const int blk = pass * C.G + C.vcu; const bool live = blk * 128 < NTOK;
        if (C.tid < 32) lcnt[C.tid] = 0u;
        __syncthreads();
        int E1 = 0, E2 = 0; unsigned r1 = 0, r2 = 0; float ga = 0.f, gb = 0.f, rstd_t = 0.f; const int tb = blk * 128 + 16 * C.wave;
        if (live) {
            f32x4 acc[3] = {{0.f, 0.f, 0.f, 0.f}, {0.f, 0.f, 0.f, 0.f}, {0.f, 0.f, 0.f, 0.f}};
            bf16x8 af[32];
#pragma unroll
            for (int ks = 0; ks < 32; ++ks) af[ks] = *(const bf16x8*)(H2B + (size_t)(tb + fr) * LDH + 32 * ks + 8 * fq);
#pragma unroll
            for (int ks = 0; ks < 32; ++ks) {
#pragma unroll
                for (int nt = 0; nt < 3; ++nt) { const bf16x8 bfg = *(const LAS bf16x8*)(WRL + (16 * nt + fr) * WRS + 32 * ks + 8 * fq); acc[nt] = __builtin_amdgcn_mfma_f32_16x16x32_bf16(af[ks], bfg, acc[nt], 0, 0, 0); } }
#pragma unroll
            for (int nt = 0; nt < 3; ++nt)
#pragma unroll
                for (int r = 0; r < 4; ++r) LG[(4 * fq + r) * 49 + 16 * nt + fr] = acc[nt][r];
            LDS_WAIT(); asm volatile("" ::: "memory");
            if (lane < 16) { const int t = tb + lane; const float rstd = rstd_from_ssq(SSQ2, t); rstd_t = rstd; const LAS float* lg = LG + lane * 49;
                float g[4]; int grp = 0;
#pragma unroll
                for (int i = 0; i < 4; ++i) g[i] = lg[i] * rstd + a.in[21][i];
#pragma unroll
                for (int i = 1; i < 4; ++i) if (g[i] > g[grp]) grp = i;
                float gs = 0.f;
#pragma unroll
                for (int i = 0; i < 4; ++i) gs += __expf(g[i] - g[grp]);
                const float gw_ = 1.0f / gs;
                float e[8];
#pragma unroll
                for (int i = 0; i < 8; ++i) e[i] = lg[4 + 8 * grp + i] * rstd + a.in[23][8 * grp + i];
                int i1 = 0;
#pragma unroll
                for (int i = 1; i < 8; ++i) if (e[i] > e[i1]) i1 = i;
                int i2 = (i1 == 0) ? 1 : 0;
#pragma unroll
                for (int i = 0; i < 8; ++i) if (i != i1 && i != i2 && e[i] > e[i2]) i2 = i;
                const float eb = __expf(e[i2] - e[i1]); ga = gw_ / (1.0f + eb); gb = gw_ * eb / (1.0f + eb);
                E1 = grp * 8 + i1; E2 = grp * 8 + i2;
                r1 = atomicAdd((unsigned*)&lcnt[E1], 1u); r2 = atomicAdd((unsigned*)&lcnt[E2], 1u);
            }
        }
        __syncthreads();
        if (C.tid < 32) lbase[C.tid] = lcnt[C.tid] ? __hip_atomic_fetch_add(CNT + C.tid, lcnt[C.tid], __ATOMIC_RELAXED, __HIP_MEMORY_SCOPE_AGENT) : 0u;
        __syncthreads();
        if (live && lane < 16) { const int t = tb + lane;
            const int k1 = (int)(lbase[E1] + r1), k2 = (int)(lbase[E2] + r2);
            TOKE[2 * t] = E1; TOKR[2 * t] = k1; TOKG[2 * t] = ga; LTOK[E1 * LCAP + k1] = t; LRS[E1 * LCAP + k1] = rstd_t;
            TOKE[2 * t + 1] = E2; TOKR[2 * t + 1] = k2; TOKG[2 * t + 1] = gb; LTOK[E2 * LCAP + k2] = t; LRS[E2 * LCAP + k2] = rstd_t; }
        __syncthreads();
    }
}
__device__ __forceinline__ void moe_table(const Args& a, const Ctx& C) {
    LAS int* ts = (LAS int*)(C.lds + MOE_OFF);
    if (C.tid == 0) { const unsigned* CNT = (const unsigned*)(a.ws + WS_CTL) + CW_CNT; int acc = 0;
        for (int e = 0; e < NEXP; ++e) { ts[e] = acc; const unsigned c = __hip_atomic_load(CNT + e, __ATOMIC_RELAXED, __HIP_MEMORY_SCOPE_AGENT); ts[33 + e] = (int)c; acc += (int)((c + 255u) >> 8); }
        ts[NEXP] = acc; }
    __syncthreads();
}
__device__ __forceinline__ void ph_final(const Args& a, const Ctx& C, float* outp) {
    unsigned char* ws = a.ws;
    const unsigned char* YB = ws + WS_A; const float* TOKG = (const float*)(ws + WS_TOK + TOK_G); const int* TOKE = (const int*)(ws + WS_TOK + TOK_E); const int* TOKR = (const int*)(ws + WS_TOK + TOK_R);
    const LAS int* ts = (const LAS int*)(C.lds + MOE_OFF);
    const bf16_t* H2B = (const bf16_t*)a.out + DM; const float* gf = a.in[26];
    const int gw = C.vcu * 8 + C.wave, NGW = C.G * 8, lane = C.lane;
    f32x4 gn[4];
#pragma unroll
    for (int q = 0; q < 4; ++q) gn[q] = *(const f32x4*)(gf + 512 * (q >> 1) + 8 * lane + 4 * (q & 1));
    const int nit = (NTOK + NGW - 1) / NGW;
    int dnx = 0; float gnx = 0.f;
#define FIN_IDX(ib) do { const int tt_ = gw + ((ib) + (lane >> 1)) * NGW; dnx = 0; gnx = 0.f; \
        if (lane < 8 && tt_ < NTOK) { const int e_ = TOKE[2 * tt_ + (lane & 1)]; dnx = ts[e_] * 256 + TOKR[2 * tt_ + (lane & 1)]; gnx = TOKG[2 * tt_ + (lane & 1)]; } } while (0)
    FIN_IDX(0);
    for (int ib = 0; ib < nit; ib += 4) {
        const int dcur = dnx; const float gcur = gnx;
        if (ib + 4 < nit) FIN_IDX(ib + 4);
        u32x4 hw[4][2]; u32x2 y0[4][2], y1[4][2];
#pragma unroll
        for (int j = 0; j < 4; ++j) { const int t = gw + (ib + j) * NGW; const int d0 = __builtin_amdgcn_readlane(dcur, 2 * j), d1 = __builtin_amdgcn_readlane(dcur, 2 * j + 1);
            if (t < NTOK) {
#pragma unroll
                for (int hf = 0; hf < 2; ++hf) { hw[j][hf] = *((const u32x4*)(H2B + (size_t)t * LDH + 512 * hf) + lane); y0[j][hf] = *((const u32x2*)(YB + (size_t)d0 * DM + 512 * hf) + lane); y1[j][hf] = *((const u32x2*)(YB + (size_t)d1 * DM + 512 * hf) + lane); } } }
#pragma unroll
        for (int j = 0; j < 4; ++j) { const int t = gw + (ib + j) * NGW;
            const float g0 = __builtin_bit_cast(float, __builtin_amdgcn_readlane(__builtin_bit_cast(int, gcur), 2 * j)) * (1.0f / YB_SC), g1 = __builtin_bit_cast(float, __builtin_amdgcn_readlane(__builtin_bit_cast(int, gcur), 2 * j + 1)) * (1.0f / YB_SC);
            if (t < NTOK) { float v[16]; float s2 = 0.f;
#pragma unroll
                for (int hf = 0; hf < 2; ++hf)
#pragma unroll
                    for (int w = 0; w < 2; ++w) { const int yw0 = (int)y0[j][hf][w], yw1 = (int)y1[j][hf][w];
                        const f32x2 pa = __builtin_amdgcn_cvt_pk_f32_fp8(yw0, false), pb = __builtin_amdgcn_cvt_pk_f32_fp8(yw0, true), qa = __builtin_amdgcn_cvt_pk_f32_fp8(yw1, false), qb = __builtin_amdgcn_cvt_pk_f32_fp8(yw1, true);
                        const unsigned ha = hw[j][hf][2 * w], hb = hw[j][hf][2 * w + 1];
                        const float e0 = bflo(ha) + g0 * pa[0] + g1 * qa[0], e1 = bfhi(ha) + g0 * pa[1] + g1 * qa[1], e2 = bflo(hb) + g0 * pb[0] + g1 * qb[0], e3 = bfhi(hb) + g0 * pb[1] + g1 * qb[1];
                        v[8 * hf + 4 * w] = e0; v[8 * hf + 4 * w + 1] = e1; v[8 * hf + 4 * w + 2] = e2; v[8 * hf + 4 * w + 3] = e3; s2 += (e0 * e0 + e1 * e1) + (e2 * e2 + e3 * e3); }
                const float rstd = __builtin_amdgcn_rsqf(wave_sum(s2) * (1.0f / DM) + EPS);
#pragma unroll
                for (int q = 0; q < 4; ++q) { const f32x4 o = {v[4 * q] * rstd * gn[q][0], v[4 * q + 1] * rstd * gn[q][1], v[4 * q + 2] * rstd * gn[q][2], v[4 * q + 3] * rstd * gn[q][3]};
                    *(f32x4*)(outp + (size_t)t * DM + 512 * (q >> 1) + 8 * lane + 4 * (q & 1)) = o; } } }
    }
#undef FIN_IDX
}

#include <hip/hip_bf16.h>
#include <cmath>
namespace attn_body {
using bf16=__hip_bfloat16;
using bf16x8=__attribute__((ext_vector_type(8)))short;
using s16x4=__attribute__((ext_vector_type(4)))short;
using f32x16=__attribute__((ext_vector_type(16)))float;
using u32x4=__attribute__((ext_vector_type(4)))unsigned;
using f32x4_t=__attribute__((ext_vector_type(4)))float;
constexpr int BATCH=16,NHEAD=8,SEQ=2048,D=64,DM=NHEAD*D,DMO=1024;
constexpr int NW=8,QBLK=32,QB=QBLK*NW,KVBLK=64,NQB=SEQ/QB;
constexpr int ATTN_PITCH=DM, ATTN_UNIT_ROWS=QB;
__device__ __forceinline__ int crow(int r,int hi){return (r&3)+8*(r>>2)+4*hi;}
#define SBAR() __builtin_amdgcn_sched_barrier(0)
__device__ __forceinline__ void cmask(f32x16&p0,f32x16&p1,int jb,int qrel,int hi){
  const float NEG=-INFINITY; int kb=64*jb+4*hi; asm volatile("":"+v"(kb));
  #pragma unroll
  for(int r=0;r<16;++r){int kv=kb+(r&3)+8*(r>>2); if(kv>qrel)p0[r]=NEG; if(kv+32>qrel)p1[r]=NEG;}
}

constexpr int NSLOT=3, SLOTB=8192;
constexpr int LDS_K=0, LDS_V=NSLOT*SLOTB, LDS_WS=2*NSLOT*SLOTB, LDS_OST=LDS_WS+NW*64*4, LDS_BYTES=LDS_OST+NW*4096;
constexpr float C2=0.125f*1.4426950408889634f;
__device__ __forceinline__ void glds16(const char*sbase,unsigned voff,unsigned lds_dst){unsigned keep;
  asm volatile("s_nop 4\n\ts_mov_b32 %0, m0\n\ts_mov_b32 m0, %3\n\ts_nop 0\n\tglobal_load_lds_dwordx4 %1, %2\n\ts_mov_b32 m0, %0":"=&s"(keep):"v"(voff),"s"(sbase),"s"(lds_dst):"memory");}
__device__ __forceinline__ const char* uni_ptr(const void*p){const unsigned long long v=(unsigned long long)p;const unsigned lo=__builtin_amdgcn_readfirstlane((unsigned)v),hi=__builtin_amdgcn_readfirstlane((unsigned)(v>>32));return (const char*)(((unsigned long long)hi<<32)|lo);}
__device__ __forceinline__ float max3f(float a,float b,float c){float r;asm("v_max3_f32 %0, %1, %2, %3":"=v"(r):"v"(a),"v"(b),"v"(c));return r;}
__device__ __forceinline__ float max2f(float a,float b){float r;asm("v_max_f32_e32 %0, %1, %2":"=v"(r):"v"(a),"v"(b));return r;}
__device__ __forceinline__ float fadd_s(float a,float b){float r;asm("v_add_f32_e32 %0, %1, %2":"=v"(r):"v"(a),"v"(b));return r;}
__device__ __forceinline__ float fsub_s(float a,float b){float r;asm("v_sub_f32_e32 %0, %1, %2":"=v"(r):"v"(a),"v"(b));return r;}
typedef float f32x2_t __attribute__((ext_vector_type(2))); typedef __bf16 bf16x2_t __attribute__((ext_vector_type(2)));
__device__ __forceinline__ unsigned cvtpk_s(float lo,float hi){f32x2_t v={lo,hi};bf16x2_t b=__builtin_convertvector(v,bf16x2_t);return __builtin_bit_cast(unsigned,b);}
#define WAIT_BAR(N) asm volatile("s_waitcnt vmcnt(" #N ") lgkmcnt(0)\n\ts_barrier":::"memory")

__device__ __forceinline__ void qkt(f32x16&p0,f32x16&p1,const char*Kslot,const bf16x8*qr,const f32x16&negm,int r32,int hi){
  const char*kb=Kslot+hi*1024+r32*16;
  #pragma unroll
  for(int d0=0;d0<4;++d0){
    const bf16x8 b0=*reinterpret_cast<const bf16x8*>(kb+d0*2048);
    const bf16x8 b1=*reinterpret_cast<const bf16x8*>(kb+d0*2048+512);
    if(d0==0){p0=__builtin_amdgcn_mfma_f32_32x32x16_bf16(b0,qr[0],negm,0,0,0);p1=__builtin_amdgcn_mfma_f32_32x32x16_bf16(b1,qr[0],negm,0,0,0);}
    else{p0=__builtin_amdgcn_mfma_f32_32x32x16_bf16(b0,qr[d0],p0,0,0,0);p1=__builtin_amdgcn_mfma_f32_32x32x16_bf16(b1,qr[d0],p1,0,0,0);}}
}
typedef __attribute__((address_space(3))) const char* lds_cptr;
typedef short v4i16_t __attribute__((ext_vector_type(4)));
__device__ __forceinline__ void kload8(bf16x8*kf,lds_cptr kp){
  kf[0]=*(const __attribute__((address_space(3))) bf16x8*)(kp);      kf[1]=*(const __attribute__((address_space(3))) bf16x8*)(kp+512);
  kf[2]=*(const __attribute__((address_space(3))) bf16x8*)(kp+2048); kf[3]=*(const __attribute__((address_space(3))) bf16x8*)(kp+2560);
  kf[4]=*(const __attribute__((address_space(3))) bf16x8*)(kp+4096); kf[5]=*(const __attribute__((address_space(3))) bf16x8*)(kp+4608);
  kf[6]=*(const __attribute__((address_space(3))) bf16x8*)(kp+6144); kf[7]=*(const __attribute__((address_space(3))) bf16x8*)(kp+6656);
}
__device__ __forceinline__ void kload2(bf16x8*kf,lds_cptr kp,int j){ kf[2*j]=*(const __attribute__((address_space(3))) bf16x8*)(kp+j*2048); kf[2*j+1]=*(const __attribute__((address_space(3))) bf16x8*)(kp+j*2048+512); }
__device__ __forceinline__ s16x4 vtr(lds_cptr p){ return __builtin_bit_cast(s16x4,__builtin_amdgcn_ds_read_tr16_b64_v4i16((__attribute__((address_space(3))) v4i16_t*)p)); }
__device__ __forceinline__ float rowmax(const f32x16&p0,const f32x16&p1){
  float a=max3f(p0[0],p0[1],p1[0]),b=max3f(p0[2],p0[3],p1[1]);a=max3f(a,p1[2],p1[3]);
  #pragma unroll
  for(int r=4;r<16;r+=4){a=max3f(a,p0[r],p0[r+1]);b=max3f(b,p0[r+2],p0[r+3]);a=max3f(a,p1[r],p1[r+1]);b=max3f(b,p1[r+2],p1[r+3]);}
  const float m=max2f(a,b);
  auto rr=__builtin_amdgcn_permlane32_swap(__float_as_uint(m),__float_as_uint(m),false,false);
  return max2f(__uint_as_float(rr[0]),__uint_as_float(rr[1]));
}
__device__ __forceinline__ void pv(f32x16*o,int vb,bf16x8 pa0,bf16x8 pa1,bf16x8 pa2,bf16x8 pa3){
  #pragma unroll
  for(int d0=0;d0<2;++d0){s16x4 lo[4],hi[4];
    #pragma unroll
    for(int ks=0;ks<4;++ks){
      asm volatile("ds_read_b64_tr_b16 %0,%1 offset:%c2":"=&v"(lo[ks]):"v"(vb),"i"(d0*4096+ks*1024):"memory");
      asm volatile("ds_read_b64_tr_b16 %0,%1 offset:%c2":"=&v"(hi[ks]):"v"(vb),"i"(d0*4096+ks*1024+512):"memory");}
    asm volatile("s_waitcnt lgkmcnt(0)":::"memory");SBAR();
    #define PK(k) (bf16x8){lo[k][0],lo[k][1],lo[k][2],lo[k][3],hi[k][0],hi[k][1],hi[k][2],hi[k][3]}
    o[d0]=__builtin_amdgcn_mfma_f32_32x32x16_bf16(pa0,PK(0),o[d0],0,0,0);
    o[d0]=__builtin_amdgcn_mfma_f32_32x32x16_bf16(pa1,PK(1),o[d0],0,0,0);
    o[d0]=__builtin_amdgcn_mfma_f32_32x32x16_bf16(pa2,PK(2),o[d0],0,0,0);
    o[d0]=__builtin_amdgcn_mfma_f32_32x32x16_bf16(pa3,PK(3),o[d0],0,0,0);
    #undef PK
  }
}

#ifndef ATTN_STORE16
#define ATTN_STORE16(p,v) (*(u32x4*)(p)=(v))
#endif
template<int THRL> __device__ __forceinline__ void attn_unit(int b,int h,int qb,const bf16*Q,const bf16*__restrict__ K,const bf16*__restrict__ V,bf16*O,const float*__restrict__ KSUM,float*__restrict__ SSQA,char*shm){
  int tid=threadIdx.x; asm volatile("":"+v"(tid));
  const int lane=tid&63,r32=lane&31,hi=lane>>5; const int wid=__builtin_amdgcn_readfirstlane(tid>>6);
  const long rowbase=(long)b*SEQ; const int q0=qb*QB;
  const bf16*Qw=Q+(rowbase+q0+wid*QBLK)*DM+h*D;
  const bf16*Kh=K+rowbase*DM+h*D,*Vh=V+rowbase*DM+h*D;
  const unsigned lds0=(unsigned)(uintptr_t)shm;
  float*wsf=(float*)(shm+LDS_WS)+wid*64;
  const char*Khu=uni_ptr(Kh);const char*Vhu=uni_ptr(Vh);
  const unsigned kvo=(unsigned)(lane*DM+wid*8)*2u;
  const unsigned vvo=(unsigned)((16*(wid&3)+(lane>>2))*DM+(wid>>2)*32+(lane&3)*8)*2u;
  const unsigned kdst=lds0+LDS_K+wid*1024, vdst=lds0+LDS_V+wid*1024;
  #define DMA_K(t,slot) glds16(Khu+(size_t)(t)*(KVBLK*DM*2),kvo,(unsigned)__builtin_amdgcn_readfirstlane(kdst+(slot)))
  #define DMA_V(t,slot) glds16(Vhu+(size_t)(t)*(KVBLK*DM*2),vvo,(unsigned)__builtin_amdgcn_readfirstlane(vdst+(slot)))
  const int vb0=(int)(lds0+LDS_V)+((lane>>4)&1)*32+(lane&3)*8+(4*hi+((lane&15)>>2))*64;
  const char*Kbase=shm+LDS_K; bf16x8 kf[8];
  const lds_cptr shm3=(lds_cptr)shm; const lds_cptr kp0=shm3+LDS_K+hi*1024+r32*16; const lds_cptr vp0=shm3+LDS_V+((lane>>4)&1)*32+(lane&3)*8+(4*hi+((lane&15)>>2))*64;
  const int NT=(q0+QB)/KVBLK;
  DMA_K(0,0);DMA_V(0,0);DMA_K(1,SLOTB);
  bf16x8 qr[4];
  #pragma unroll
  for(int d0=0;d0<4;++d0)qr[d0]=*reinterpret_cast<const bf16x8*>(&Qw[(long)r32*DM+d0*16+hi*8]);
  unsigned selm=1u<<qb;
  { float g[8];
    #pragma unroll
    for(int n=0;n<8;++n){ g[n]=-INFINITY;
      if(n<qb){ const float*ks=KSUM+(long)(b*8+n)*DM+h*D+hi*8; float s=0.f;
        #pragma unroll
        for(int d0=0;d0<4;++d0){ const f32x4_t k0=*reinterpret_cast<const f32x4_t*>(ks+d0*16), k1=*reinterpret_cast<const f32x4_t*>(ks+d0*16+4);
          const u32x4 qw=__builtin_bit_cast(u32x4,qr[d0]);
          s+=__uint_as_float(qw[0]<<16)*k0[0]+__uint_as_float(qw[0]&0xffff0000u)*k0[1]+__uint_as_float(qw[1]<<16)*k0[2]+__uint_as_float(qw[1]&0xffff0000u)*k0[3]
            +__uint_as_float(qw[2]<<16)*k1[0]+__uint_as_float(qw[2]&0xffff0000u)*k1[1]+__uint_as_float(qw[3]<<16)*k1[2]+__uint_as_float(qw[3]&0xffff0000u)*k1[3]; }
        s+=__shfl_xor(s,32); g[n]=s; } }
    const int npick=qb<3?qb:3;
    for(int p=0;p<npick;++p){ int best=-1; float bv=-INFINITY;
      #pragma unroll
      for(int n=0;n<8;++n){ const bool ok=(n<qb)&&!((selm>>n)&1u)&&(best<0||g[n]>bv); if(ok){best=n;bv=g[n];} }
      if(best>=0)selm|=1u<<best; } }
  #define BMASK(P0,P1,t) do{ float bias_=((selm>>((t)>>2))&1u)?-mhat:-INFINITY; asm volatile("":"+v"(bias_)); _Pragma("unroll") for(int r=0;r<16;++r){P0[r]+=bias_;P1[r]+=bias_;} }while(0)
  float mhat=0.f,l_reg=0.f;f32x16 o[2];{float z0_=0.f;asm volatile("":"+v"(z0_));_Pragma("unroll") for(int r=0;r<16;++r){o[0][r]=z0_;o[1][r]=z0_;}}const f32x16 negm=f32x16{};
  const int qrel=wid*QBLK+r32;
  #define CMASK(P0,P1,t) do{int jb_=(t)-(NT-4); if(jb_>=0)cmask(P0,P1,jb_,qrel,hi);}while(0)
  bool resc=false;
  #define START(P0,P1) do{ const float rm=__builtin_fmaxf(rowmax(P0,P1),-100.0f); resc=false; \
    { const float dl=rm; mhat=fadd_s(mhat,dl); \
      _Pragma("unroll") for(int r=0;r<16;++r){P0[r]=fsub_s(P0[r],dl);P1[r]=fsub_s(P1[r],dl);} \
      } \
    _Pragma("unroll") for(int r=0;r<16;++r)P0[r]=__builtin_amdgcn_exp2f(P0[r]); }while(0)
  #define RESC() do{ if(resc){ asm volatile("s_waitcnt lgkmcnt(0)":::"memory"); \
      _Pragma("unroll") for(int d_=0;d_<2;++d_) _Pragma("unroll") for(int r=0;r<16;++r)o[d_][r]*=wsf[crow(r,hi)]; } }while(0)
  f32x16 pA0,pA1,pB0,pB1;
  int sl_prev=0,sl_cur=0,sl_next=SLOTB;
  #define ROT() do{sl_prev=sl_cur;sl_cur=sl_next;sl_next=(sl_next==(NSLOT-1)*SLOTB)?0:sl_next+SLOTB;}while(0)
  DMA_K(2,2*SLOTB);
  WAIT_BAR(3);
  qkt(pA0,pA1,Kbase,qr,negm,r32,hi);asm volatile("s_nop 15\n\ts_nop 7":"+v"(pA0),"+v"(pA1));CMASK(pA0,pA1,0);BMASK(pA0,pA1,0);
  START(pA0,pA1);
  _Pragma("unroll") for(int r=0;r<16;++r)pA1[r]=__builtin_amdgcn_exp2f(pA1[r]);
  WAIT_BAR(0);
  DMA_K(3,0);DMA_V(1,SLOTB);
  ROT();
  kload8(kf,kp0+sl_cur);
  WAIT_BAR(2);
  s16x4 vlo[8],vhi[8]; u32x4 pw0,pw1,pw2,pw3;
  #define PKW(P,B) cvtpk_s(P[B],P[B+1])
  #define PAF(k) __builtin_bit_cast(bf16x8,pw##k)
  #define VFR(i) (bf16x8){vlo[i][0],vlo[i][1],vlo[i][2],vlo[i][3],vhi[i][0],vhi[i][1],vhi[i][2],vhi[i][3]}
  #define PIN(x) asm volatile("":"+v"(x))
  #define MX3(a,b,c) __builtin_fmaxf(__builtin_fmaxf((a),(b)),(c))
  #define GAPA(MF,A0,A1,A2,A3,W0,W1,PW) do{ MF; sacc+=A0; sacc+=A1; sacc+=A2; sacc+=A3; PIN(sacc); W0; W1; PIN(PW); SBAR(); }while(0)
  #define EX(v) __builtin_amdgcn_exp2f(v)
  #define GAPB(MF,X,B) do{ MF; X[B]=EX(X[B]); X[B+1]=EX(X[B+1]); X[B+2]=EX(X[B+2]); X[B+3]=EX(X[B+3]); PIN(X); SBAR(); }while(0)
  #define VRD(i) do{ vlo[i]=vtr(vp_+(((i)>>2)*4096+((i)&3)*1024)); vhi[i]=vtr(vp_+(((i)>>2)*4096+((i)&3)*1024+512)); }while(0)
  #define KRD(G,j) do{ if(G){ kload2(kf,kp0+sl_next,j); SBAR(); } }while(0)
  #define STEP(C0,C1,P0,P1,t,GK,GV,GL) do{ SBAR(); \
    const lds_cptr vp_=vp0+sl_prev; \
    VRD(0); SBAR(); float sacc=(P0[0]+P0[1]); \
    GAPA(C0=__builtin_amdgcn_mfma_f32_32x32x16_bf16(kf[0],qr[0],negm,0,0,0), P0[2],P0[3],P0[4],P0[5],     pw0[0]=PKW(P0,0), pw0[1]=PKW(P0,2), pw0); \
    VRD(4); SBAR(); GAPA(C1=__builtin_amdgcn_mfma_f32_32x32x16_bf16(kf[1],qr[0],negm,0,0,0), P0[6],P0[7],P0[8],P0[9],     pw0[2]=PKW(P0,4), pw0[3]=PKW(P0,6), pw0); \
    VRD(1); SBAR(); GAPA(C0=__builtin_amdgcn_mfma_f32_32x32x16_bf16(kf[2],qr[1],C0,0,0,0),   P0[10],P0[11],P0[12],P0[13], pw1[0]=PKW(P0,8), pw1[1]=PKW(P0,10), pw1); \
    VRD(5); SBAR(); GAPA(C1=__builtin_amdgcn_mfma_f32_32x32x16_bf16(kf[3],qr[1],C1,0,0,0),   P0[14],P0[15],P1[0],P1[1],   pw1[2]=PKW(P0,12),pw1[3]=PKW(P0,14), pw1); \
    VRD(2); SBAR(); GAPA(C0=__builtin_amdgcn_mfma_f32_32x32x16_bf16(kf[4],qr[2],C0,0,0,0),   P1[2],P1[3],P1[4],P1[5],     pw2[0]=PKW(P1,0), pw2[1]=PKW(P1,2), pw2); \
    VRD(6); SBAR(); GAPA(C1=__builtin_amdgcn_mfma_f32_32x32x16_bf16(kf[5],qr[2],C1,0,0,0),   P1[6],P1[7],P1[8],P1[9],     pw2[2]=PKW(P1,4), pw2[3]=PKW(P1,6), pw2); \
    VRD(3); SBAR(); GAPA(C0=__builtin_amdgcn_mfma_f32_32x32x16_bf16(kf[6],qr[3],C0,0,0,0),   P1[10],P1[11],P1[12],P1[13], pw3[0]=PKW(P1,8), pw3[1]=PKW(P1,10), pw3); \
    VRD(7); SBAR(); GAPA(C1=__builtin_amdgcn_mfma_f32_32x32x16_bf16(kf[7],qr[3],C1,0,0,0),   P1[14],P1[15],0.f,0.f,       pw3[2]=PKW(P1,12),pw3[3]=PKW(P1,14), pw3); \
    l_reg+=sacc; \
    if(GK){DMA_K((t)+3,sl_cur);} if(GV){DMA_V((t)+1,sl_next);} \
    CMASK(C0,C1,t); BMASK(C0,C1,t); \
    { float a=MX3(C0[0],C0[1],C1[0]),b=MX3(C0[2],C0[3],C1[1]); a=MX3(a,C1[2],C1[3]); \
      _Pragma("unroll") for(int r=4;r<16;r+=4){a=MX3(a,C0[r],C0[r+1]);b=MX3(b,C0[r+2],C0[r+3]);a=MX3(a,C1[r],C1[r+1]);b=MX3(b,C1[r+2],C1[r+3]);} \
      float rm=__builtin_fmaxf(a,b); { auto rr=__builtin_amdgcn_permlane32_swap(__float_as_uint(rm),__float_as_uint(rm),false,false); rm=__builtin_fmaxf(__uint_as_float(rr[0]),__uint_as_float(rr[1])); } \
      resc=false; \
      if(__builtin_expect(__any(rm>(float)THRL),0)){ const float dl=__builtin_fmaxf(rm,0.f); mhat+=dl; \
        _Pragma("unroll") for(int r=0;r<16;++r){C0[r]-=dl;C1[r]-=dl;} \
        const float f=__builtin_amdgcn_exp2f(-dl); l_reg*=f; if(hi==0)wsf[r32]=f; resc=true; } } \
    SBAR(); \
    GAPB(o[0]=__builtin_amdgcn_mfma_f32_32x32x16_bf16(PAF(0),VFR(0),o[0],0,0,0), C0,0); \
    GAPB(o[1]=__builtin_amdgcn_mfma_f32_32x32x16_bf16(PAF(0),VFR(4),o[1],0,0,0), C0,4); \
    KRD(GL,0); GAPB(o[0]=__builtin_amdgcn_mfma_f32_32x32x16_bf16(PAF(1),VFR(1),o[0],0,0,0), C0,8); \
    KRD(GL,1); GAPB(o[1]=__builtin_amdgcn_mfma_f32_32x32x16_bf16(PAF(1),VFR(5),o[1],0,0,0), C0,12); \
    KRD(GL,2); GAPB(o[0]=__builtin_amdgcn_mfma_f32_32x32x16_bf16(PAF(2),VFR(2),o[0],0,0,0), C1,0); \
    KRD(GL,3); GAPB(o[1]=__builtin_amdgcn_mfma_f32_32x32x16_bf16(PAF(2),VFR(6),o[1],0,0,0), C1,4); \
    GAPB(o[0]=__builtin_amdgcn_mfma_f32_32x32x16_bf16(PAF(3),VFR(3),o[0],0,0,0), C1,8); \
    GAPB(o[1]=__builtin_amdgcn_mfma_f32_32x32x16_bf16(PAF(3),VFR(7),o[1],0,0,0), C1,12); \
    }while(0)
  int t=1;
  #undef CMASK
  #define CMASK(P0,P1,t) do{}while(0)
  for(;t+5<NT;t+=2){
    STEP(pB0,pB1,pA0,pA1,t,true,true,true);     WAIT_BAR(2); RESC(); ROT();
    STEP(pA0,pA1,pB0,pB1,t+1,true,true,true);   WAIT_BAR(2); RESC(); ROT();
  }
  #undef CMASK
  #define CMASK(P0,P1,t) do{int jb_=(t)-(NT-4); if(jb_>=0)cmask(P0,P1,jb_,qrel,hi);}while(0)
  #define ENDW(tt) do{ if((tt)+3<NT){WAIT_BAR(2);} else if((tt)+2<NT){WAIT_BAR(1);} else {WAIT_BAR(0);} }while(0)
  for(;t+1<NT;t+=2){
    STEP(pB0,pB1,pA0,pA1,t,(t+3<NT),(t+1<NT),(t+1<NT));       ENDW(t);   RESC(); ROT();
    STEP(pA0,pA1,pB0,pB1,t+1,(t+4<NT),(t+2<NT),(t+2<NT));     ENDW(t+1); RESC(); ROT();
  }
  STEP(pB0,pB1,pA0,pA1,NT-1,false,false,false); RESC();
  { float sacc=pB0[0]+pB0[1]; _Pragma("unroll") for(int r=2;r<16;++r)sacc+=pB0[r]; _Pragma("unroll") for(int r=0;r<16;++r)sacc+=pB1[r]; l_reg+=sacc;
    pw0=(u32x4){PKW(pB0,0),PKW(pB0,2),PKW(pB0,4),PKW(pB0,6)};pw1=(u32x4){PKW(pB0,8),PKW(pB0,10),PKW(pB0,12),PKW(pB0,14)};pw2=(u32x4){PKW(pB1,0),PKW(pB1,2),PKW(pB1,4),PKW(pB1,6)};pw3=(u32x4){PKW(pB1,8),PKW(pB1,10),PKW(pB1,12),PKW(pB1,14)};
    SBAR(); pv(o,vb0+sl_cur,PAF(0),PAF(1),PAF(2),PAF(3)); }
  #undef PKW
  #undef PAF
  #undef VFR
  #undef PIN
  #undef MX3
  #undef GAPA
  #undef GAPB
  #undef EX
  #undef VRD
  #undef KRD
  #undef STEP
  #undef ENDW
  {auto rr=__builtin_amdgcn_permlane32_swap(__float_as_uint(l_reg),__float_as_uint(l_reg),false,false);l_reg=__uint_as_float(rr[0])+__uint_as_float(rr[1]);}
  if(hi==0)wsf[32+r32]=l_reg;asm volatile("s_waitcnt lgkmcnt(0)":::"memory");
  float rli[16];
  #pragma unroll
  for(int r=0;r<16;++r)rli[r]=__builtin_amdgcn_rcpf(wsf[32+crow(r,hi)]);
  bf16*Ow=O+(rowbase+q0+wid*QBLK)*DMO+h*D;
  { bf16*stg=(bf16*)(shm+LDS_OST)+wid*2048;
    #pragma unroll
    for(int r=0;r<16;++r){const int orow=crow(r,hi);
      #pragma unroll
      for(int d0=0;d0<2;++d0)stg[orow*64+d0*32+r32]=__float2bfloat16(o[d0][r]*rli[r]);}
    asm volatile("s_waitcnt lgkmcnt(0)":::"memory");
    #pragma unroll
    for(int i=0;i<4;++i){const int row=i*8+(lane>>3),ch=lane&7; const u32x4 v=*(const u32x4*)(stg+row*64+ch*8); ATTN_STORE16(Ow+(long)row*DMO+ch*8,v);
      float q=0.f;
      #pragma unroll
      for(int e=0;e<4;++e){const float lo=__uint_as_float(v[e]<<16),hi2=__uint_as_float(v[e]&0xffff0000u);q+=lo*lo+hi2*hi2;}
      q+=__shfl_xor(q,1);q+=__shfl_xor(q,2);q+=__shfl_xor(q,4);
      if(ch==0)SSQA[(rowbase+q0+wid*QBLK+row)*8+h]=q;} }
  asm volatile("s_waitcnt lgkmcnt(0)\n\ts_barrier":::"memory");
  #undef BMASK
  #undef DMA_K
  #undef DMA_V
  #undef CMASK
  #undef START
  #undef RESC
  #undef ROT
}
constexpr int ATTN_LDS_BYTES=LDS_BYTES;
#undef SBAR
#undef WAIT_BAR
}

__global__ void __launch_bounds__(512, 2) mk_fwd(Args args) {
    extern __shared__ __attribute__((aligned(16))) unsigned char lds_raw[];
    Ctx C; C.lds = (LAS unsigned char*)lds_raw; C.tid = threadIdx.x; C.lane = C.tid & 63; C.wave = __builtin_amdgcn_readfirstlane(C.tid >> 6);
    C.G = gridDim.x; { const int bx = blockIdx.x; C.vcu = (C.G % 8 == 0) ? (bx % 8) * (C.G / 8) + bx / 8 : bx; }
    unsigned char* ws = args.ws;
    for (int u = C.tid; u < (LDS_BYTES - LDSCTL_OFF) / 4; u += 512) ((LAS unsigned*)(C.lds + LDSCTL_OFF))[u] = 0u;
    __syncthreads();
    XcdBarrier bar; bar.bar = (unsigned*)(ws + WS_CTL) + CW_BAR; bar.x = 0; bar.st = nullptr;
    if (N_LAUNCHES == 1) bar = xcd_barrier_post((unsigned*)(ws + WS_CTL) + CW_BAR, (volatile LAS unsigned*)(C.lds + MISC_OFF) + 8);
    const int lo = args.ph_lo, hi = args.ph_hi;
#define IN(k) (lo <= (k) && (k) < hi)
#define FRESH() do { int t_ = threadIdx.x; asm volatile("" : "+v"(t_)); C.tid = t_; C.lane = t_ & 63; C.wave = __builtin_amdgcn_readfirstlane(t_ >> 6); } while (0)
#define SEAM(k) do { if (IN(k) && IN((k) + 1)) xcd_barrier(bar); } while (0)
    const int cb = (int)blockIdx.x;

    if (IN(0)) { FRESH(); ph_prologue(args, C); SEAM(0); }
    if (IN(1)) {
        { Gemm g{(const bf16_t*)(ws + WS_B), (const bf16_t*)(ws + WS_WIN), DM, DM, DM}; PlainOrder S; S.init(NTOK, DIN, C.G, cb, DM, DM);
          EpiProj E{(bf16_t*)(ws + WS_A), (const float*)(ws + WS_ROPE), (float*)(ws + WS_KSUM)}; GEMM_PHASE(C.lds, g, S, E); }
        { Gemm g{(const bf16_t*)(ws + WS_MEMN), (const bf16_t*)(ws + WS_WXK), DM, DM, DM}; PlainOrder S; S.init(NMEM, DM, C.G, cb, DM, DM);
          EpiStore E{(bf16_t*)(ws + WS_KM), DM}; GEMM_PHASE(C.lds, g, S, E); }
        { Gemm g{(const bf16_t*)(ws + WS_MEMN), (const bf16_t*)(ws + WS_WXV), DM, DM, DM}; PlainOrder S; S.init(NMEM, DM, C.G, (cb + C.G - 64 % C.G) % C.G, DM, DM);
          EpiStore E{(bf16_t*)(ws + WS_VMT), DM}; GEMM_PHASE(C.lds, g, S, E); }
        { FRESH(); if (C.G == 256) { if (cb >= 128) conv_wdn(args, C, (cb - 128) * 8 + C.wave, 128 * 8, 0, WDN_SPLIT); }
          else conv_wdn(args, C, C.vcu * 8 + C.wave, C.G * 8, 0, WDN_SPLIT); }
        SEAM(1);
    }
    if (IN(2)) { FRESH();
        for (int i = 0;; ++i) { const int aidx = i * C.G + C.vcu; if (aidx >= 1024) break; const int cc = aidx & 255, ii = aidx >> 8, bh = cc >> 1;
            const int qb = (cc & 1) ? ((ii == 0) ? 6 : (ii == 1) ? 1 : (ii == 2) ? 5 : 2) : ((ii == 0) ? 7 : (ii == 1) ? 0 : (ii == 2) ? 4 : 3);
            { const attn_body::bf16* Qp = (const attn_body::bf16*)(ws + WS_A) + (size_t)2 * NTOK * 512;
              attn_body::attn_unit<8>(bh >> 3, bh & 7, qb, Qp, Qp + (size_t)NTOK * 512, Qp + (size_t)2 * NTOK * 512, (attn_body::bf16*)(ws + WS_C) + 512, (const float*)(ws + WS_KSUM), (float*)(ws + WS_SSQA), (char*)lds_raw); } }
        FRESH();
        for (int L = C.vcu; L < 256; L += C.G) lru_unit(args, C, L >> 4, (L >> 1) & 7, L & 1, L);
        SEAM(2);
    }
    if (IN(4)) { Gemm g{(const bf16_t*)(ws + WS_C), (const bf16_t*)(ws + WS_WOUT), DM, DM, DM}; PlainOrder S; S.init(NTOK, DM, C.G, cb, DM, DM);
        EpiResid<true, true> E{(const bf16_t*)(ws + WS_B), (bf16_t*)args.out, (float*)(ws + WS_SSQ1), (const float*)(ws + WS_SSQL), (const float*)(ws + WS_SSQA), ws + WS_A + 64 * MiB, 1.0f, (const float*)(ws + WS_TOK + TOK_D), args.in[2]};     GEMM_PHASE(C.lds, g, S, E);
        { Gemm g2{(const bf16_t*)(ws + WS_KM), (const bf16_t*)(ws + WS_WXQ), DM, DM, XHD}; XpreOrder S2{C.G, cb, 0}; EpiStore8 E2{ws + WS_A, DM, QKT_SC}; GEMM_PHASE(C.lds, g2, S2, E2); }
        { Gemm g3{(const bf16_t*)(ws + WS_WXO), (const bf16_t*)(ws + WS_VMT), DM, DM, XHD}; XpreOrder S3{C.G, cb, 1}; EpiStore8 E3{ws + WS_A + 32 * MiB, DM, VWT_SC}; GEMM_PHASE(C.lds, g3, S3, E3); }
        SEAM(4); }
    if (IN(5)) { Gemm g{(const bf16_t*)(ws + WS_A + 64 * MiB), (const bf16_t*)(ws + WS_A), DM / 2, DM / 2, DM / 2}; XattnOrder S{C.G, cb, 0, DM / 2, DM / 2};
        EpiSoftmax E{ws + WS_A + 96 * MiB, DM, C.lds + LDSCTL_OFF + 4096, (const float*)(ws + WS_SSQ1), XSCALE / QKT_SC}; GEMM_PHASE8N(C.lds, g, S, E); SEAM(5); }
    if (IN(8)) { Gemm g{(const bf16_t*)(ws + WS_A + 96 * MiB), (const bf16_t*)(ws + WS_A + 32 * MiB), DM / 2, DM / 2, DM / 2}; XattnOrder S{C.G, cb, 1, DM / 2, DM / 2};
        EpiResid<false, false> E{(const bf16_t*)args.out, (bf16_t*)args.out + DM, (float*)(ws + WS_SSQ2), nullptr, nullptr, ws + WS_H2F8, 1.0f / (PX_SC * VWT_SC)}; GEMM_PHASE8(C.lds, g, S, E); SEAM(8); }
    if (IN(9)) { FRESH(); ph_router(args, C); SEAM(9); }
    if (IN(11)) { FRESH(); moe_table(args, C); Gemm g{(const bf16_t*)(ws + WS_H2F8), (const bf16_t*)(ws + WS_WGU), DM / 2, DM / 2, DM / 2};
        MoeOrder<true> S{(const LAS int*)(C.lds + MOE_OFF), C.G, cb, DM / 2, DM / 2, (const int*)(ws + WS_LTOK), (unsigned)DM};
        EpiGateUp E{ws + WS_B, (const float*)(ws + WS_LRS)}; GEMM_PHASE8(C.lds, g, S, E); SEAM(11); }
    if (IN(12)) { FRESH(); moe_table(args, C); Gemm g{(const bf16_t*)(ws + WS_B), (const bf16_t*)(ws + WS_WDN), DFF / 2, DFF / 2, DFF / 2};
        MoeOrder<false> S{(const LAS int*)(C.lds + MOE_OFF), C.G, cb, DFF / 2, DFF / 2, nullptr, 0u};
        EpiStore8 E{ws + WS_A, DM, YB_SC / (WDN_SC * ACT_SC)}; GEMM_PHASE8(C.lds, g, S, E); SEAM(12); }
    if (IN(13)) { FRESH(); moe_table(args, C); ph_final(args, C, args.out); }
#undef IN
#undef FRESH
#undef SEAM
}

extern "C" void kernel_launch(void* const* d_in, const int* in_sizes, int n_in, void* d_out, int out_size, void* d_ws, size_t ws_size, hipStream_t stream) {
    static int grid = 0;
    if (grid == 0) {
        if (n_in != 27 || out_size != NTOK * DM || ws_size < WS_END) { fprintf(stderr, "kernel_launch: unexpected shapes (n_in %d out %d ws %zu)\n", n_in, out_size, ws_size); grid = -1; return; }
        int dev = 0, cus = 0, per_cu = 0;
        if (hipGetDevice(&dev) != hipSuccess || hipDeviceGetAttribute(&cus, hipDeviceAttributeMultiprocessorCount, dev) != hipSuccess) { grid = -1; return; }
        if (hipFuncSetAttribute((const void*)mk_fwd, hipFuncAttributeMaxDynamicSharedMemorySize, LDS_BYTES) != hipSuccess) { fprintf(stderr, "kernel_launch: hipFuncSetAttribute failed\n"); grid = -1; return; }
        if (hipOccupancyMaxActiveBlocksPerMultiprocessor(&per_cu, (const void*)mk_fwd, 512, LDS_BYTES) != hipSuccess || per_cu < 1) fprintf(stderr, "kernel_launch: occupancy query reports %d\n", per_cu);
        (void)hipGetLastError();
        grid = cus;
    }
    if (grid < 0) return;
    (void)hipMemsetAsync((char*)d_ws + WS_CTL, 0, CTL_ZERO_BYTES, stream);
    Args a{};
    for (int i = 0; i < 27; ++i) a.in[i] = (const float*)d_in[i];
    a.out = (float*)d_out; a.ws = (unsigned char*)d_ws;
    const float invf[8] = {1.0f, 0.1939227432012558f, 0.03760603070259094f, 0.007292664609849453f, 0.0014142135623842478f, 0.00027424818836152554f, 5.318296098266728e-05f, 1.0313386155758053e-05f};
    for (int i = 0; i < 8; ++i) a.invf[i] = invf[i];
    if (N_LAUNCHES == 1) { a.ph_lo = 0; a.ph_hi = N_PHASES; hipLaunchKernelGGL(mk_fwd, dim3(grid), dim3(512), LDS_BYTES, stream, a); }
    else for (int p = 0; p < N_PHASES; ++p) { a.ph_lo = p; a.ph_hi = p + 1; hipLaunchKernelGGL(mk_fwd, dim3(grid), dim3(512), LDS_BYTES, stream, a); }
}
```

```cpp
#include <hip/hip_runtime.h>
#include <cstdio>
#include <cstdint>

#define LAS __attribute__((address_space(3)))
#define GAS __attribute__((address_space(1)))
typedef unsigned short bf16_t;
typedef short bf16x8 __attribute__((ext_vector_type(8)));
typedef float f32x4 __attribute__((ext_vector_type(4)));
typedef float f32x2 __attribute__((ext_vector_type(2)));
typedef unsigned u32x4 __attribute__((ext_vector_type(4)));
typedef unsigned u32x2 __attribute__((ext_vector_type(2)));

#ifndef MK_N_LAUNCHES
#define MK_N_LAUNCHES 1
#endif
constexpr int N_PHASES = 14;
constexpr int N_LAUNCHES = MK_N_LAUNCHES;

constexpr int BATCH = 16, SEQ = 2048, DM = 1024, NTOK = BATCH * SEQ;
constexpr int DLRU = 512, DATT = 512, DIN = 2560, NHEAD = 8, HD = 64, NBLK = 8, MBLK = 256;
constexpr int MEMLEN = 256, NXH = 4, XHD = 256, NMEM = BATCH * MEMLEN;
constexpr int NEXP = 32, EPG = 8, NGRP = 4, DFF = 512;
constexpr float EPS = 1e-6f;
constexpr float QKT_SC = 8.0f, VWT_SC = 8.0f, PX_SC = 256.0f;
constexpr float WGU_SC = 64.0f, WDN_SC = 32.0f, ACT_SC = 16.0f, YB_SC = 16.0f;
constexpr int WDN_SPLIT = 3072;
constexpr int MAXTILES = 288, LCAP = 65536, LDH = 2048;
constexpr float QSCALE = 0.125f * 1.4426950408889634f;
constexpr float XSCALE = 0.0625f * 1.4426950408889634f;

constexpr size_t MiB = 1u << 20;
constexpr size_t WS_CTL = 0, CTL_ZERO_BYTES = 1 * MiB;
constexpr int CW_TMO = 0, CW_BAR = 4096, CW_CNT = 8192;
constexpr size_t WS_KSUM = 512 * 1024;
constexpr size_t WS_WIN = 2 * MiB, WS_WXK = 7 * MiB, WS_WXV = 9 * MiB, WS_WOUT = 11 * MiB, WS_WXQ = 13 * MiB, WS_WXO = 15 * MiB;
constexpr size_t WS_WR = 17 * MiB, WS_ROPE = 18 * MiB, WS_SSQ1 = 19 * MiB, WS_SSQ2 = 21 * MiB, WS_TOK = 23 * MiB, WS_RSC = 24 * MiB;
constexpr size_t WS_MEMN = 25 * MiB, WS_KM = 33 * MiB, WS_VMT = 41 * MiB, WS_WGU = 49 * MiB, WS_WDN = 113 * MiB;
constexpr size_t WS_A = 145 * MiB, WS_B = 305 * MiB, WS_C = 385 * MiB, WS_SSQL = 449 * MiB, WS_SSQA = 451 * MiB, WS_LTOK = 452 * MiB, WS_LRS = 460 * MiB, WS_H2F8 = 468 * MiB, WS_END = 500 * MiB;
constexpr size_t TOK_E = 0, TOK_R = 256 * 1024, TOK_G = 512 * 1024, TOK_D = 768 * 1024;

constexpr int RING_BYTES = 131072;
constexpr int LDSCTL_OFF = RING_BYTES, MISC_OFF = LDSCTL_OFF + 320, MOE_OFF = LDSCTL_OFF + 1024;
constexpr int LDS_BYTES = 147456;

__device__ __forceinline__ unsigned cvt_pk_bf16(float lo, float hi) { unsigned r; asm volatile("v_cvt_pk_bf16_f32 %0, %1, %2" : "=v"(r) : "v"(lo), "v"(hi)); return r; }
__device__ __forceinline__ float bflo(unsigned w) { return __uint_as_float(w << 16); }
__device__ __forceinline__ float bfhi(unsigned w) { return __uint_as_float(w & 0xffff0000u); }
__device__ __forceinline__ float bf2f(bf16_t b) { return __uint_as_float((unsigned)b << 16); }
__device__ __forceinline__ float wave_sum(float v) {
#pragma unroll
    for (int o = 1; o < 64; o <<= 1) v += __shfl_xor(v, o);
    return v;
}
#define LDS_WAIT() asm volatile("s_waitcnt lgkmcnt(0)" ::: "memory")
__device__ __forceinline__ float sigmoidf_(float x) { return __builtin_amdgcn_rcpf(1.0f + __builtin_amdgcn_exp2f(x * -1.4426950408889634f)); }

#define XB_TMO      128
#define XB_XCNT(j)  (256  + 64 * (j))
#define XB_XSUB(j)  (1280 + 64 * (j))
#define XB_XGEN(j)  (2304 + 64 * (j))
#define XB_TOP      3328
#define XB_TOPGEN   3392
#define XCD_BAR_WORDS 3456
#define XB_SPIN_CAP (1u << 18)
__device__ __forceinline__ unsigned xb_ld(unsigned* p)              { return __hip_atomic_load(p, __ATOMIC_RELAXED, __HIP_MEMORY_SCOPE_AGENT); }
__device__ __forceinline__ unsigned xb_add(unsigned* p, unsigned v) { return __hip_atomic_fetch_add(p, v, __ATOMIC_RELAXED, __HIP_MEMORY_SCOPE_AGENT); }
__device__ __forceinline__ unsigned xb_xcc_id() { return (unsigned)__builtin_amdgcn_s_getreg((3 << 11) | 20) & 0xFu; }
#define XB_SPIN(cond, bar) do { unsigned _sp = 0; while (cond) { __builtin_amdgcn_s_sleep(1); \
    if ((++_sp & 255u) == 0u) { if (xb_ld(&(bar)[XB_TMO])) break; if (_sp > XB_SPIN_CAP) { atomicAdd(&(bar)[XB_TMO], 1u); break; } } } } while (0)
struct XcdBarrier { unsigned* bar; unsigned x; volatile LAS unsigned* st; };
__device__ __forceinline__ XcdBarrier xcd_barrier_post(unsigned* bar, volatile LAS unsigned* st) {
    XcdBarrier b; b.bar = bar; b.x = xb_xcc_id(); b.st = st;
    if (threadIdx.x == 0) (void)xb_add(&bar[XB_XCNT(b.x)], 1u);
    return b;
}
__device__ __forceinline__ void xcd_barrier_complete(unsigned* bar, unsigned x, unsigned& nloc, unsigned& nx) {
    const unsigned G = gridDim.x * gridDim.y * gridDim.z;
    unsigned sum, cnt, mine, sp = 0u;
    for (;;) {
        sum = 0u; cnt = 0u; mine = 0u;
#pragma unroll
        for (unsigned j = 0; j < 16; ++j) { const unsigned c = xb_ld(&bar[XB_XCNT(j)]); sum += c; cnt += (c > 0u) ? 1u : 0u; mine = (j == x) ? c : mine; }
        if (sum == G) break;
        __builtin_amdgcn_s_sleep(1);
        if ((++sp & 255u) == 0u) { if (xb_ld(&bar[XB_TMO])) break; if (sp > XB_SPIN_CAP) { atomicAdd(&bar[XB_TMO], 1u); break; } }
    }
    nloc = mine > 0u ? mine : 1u; nx = cnt > 0u ? cnt : 1u;
}
__device__ __forceinline__ void xcd_barrier(const XcdBarrier& b) {
    asm volatile("s_waitcnt vmcnt(0)" ::: "memory");
    __syncthreads();
    if (threadIdx.x == 0) {
        unsigned* bar = b.bar;
        __builtin_amdgcn_s_waitcnt(0);
        unsigned nloc = b.st[0], nx = b.st[1];
        if (nloc == 0u) { xcd_barrier_complete(bar, b.x, nloc, nx); b.st[0] = nloc; b.st[1] = nx; }
        const unsigned old = xb_add(&bar[XB_XSUB(b.x)], 1u);
        const unsigned gen = old / nloc;
        if (old + 1u == (gen + 1u) * nloc) {
            __builtin_amdgcn_fence(__ATOMIC_RELEASE, "agent");
            asm volatile("s_waitcnt vmcnt(0)" ::: "memory");
            const unsigned og = xb_add(&bar[XB_TOP], 1u);
            const unsigned tg = og / nx;
            if (og + 1u == (tg + 1u) * nx) xb_add(&bar[XB_TOPGEN], 1u);
            else XB_SPIN(xb_ld(&bar[XB_TOPGEN]) == tg, bar);
            __builtin_amdgcn_fence(__ATOMIC_ACQUIRE, "agent");
            xb_add(&bar[XB_XGEN(b.x)], 1u);
            asm volatile("s_waitcnt vmcnt(0)" ::: "memory");
        } else {
            XB_SPIN(xb_ld(&bar[XB_XGEN(b.x)]) == gen, bar);
            __builtin_amdgcn_fence(__ATOMIC_ACQUIRE, "agent");
            asm volatile("s_waitcnt vmcnt(0)" ::: "memory");
        }
    }
    __syncthreads();
}

struct Unit { int pm, pn; size_t a_off, b_off; int lbase, nvalid; };
struct Gemm { const bf16_t* A; const bf16_t* Bt; int lda, ldb, K; };
__host__ __device__ __forceinline__ int perm32(int rho) { const int n = rho >> 4, i = rho & 15; return 8 * (i >> 2) + 4 * n + (i & 3); }

struct PlainOrder {     static constexpr bool GATHER = false;
    int nM, nN, nwg, G, c, lda, ldb;
    __device__ void init(int M, int N, int G_, int c_, int lda_, int ldb_) { nM = M / 256; nN = N / 256; nwg = nM * nN; G = G_; c = c_; lda = lda_; ldb = ldb_; }
    __device__ bool next(int i, Unit& u) const {
        const long L = (long)i * G + c; if (L >= nwg) return false;
        int wgid = (int)L; { const int q = nwg / 8, r = nwg % 8, xcd = wgid % 8, off = wgid / 8; wgid = (xcd < r ? xcd * (q + 1) : r * (q + 1) + (xcd - r) * q) + off; }
        const int nig = 8 * nN, gid = wgid / nig, fm = gid * 8, gsz = (nM - fm) < 8 ? (nM - fm) : 8;
        u.pm = fm + ((wgid % nig) % gsz); u.pn = (wgid % nig) / gsz;
        u.a_off = (size_t)u.pm * 256 * lda; u.b_off = (size_t)u.pn * 256 * ldb; return true;
    }
};
struct XpreOrder {
    static constexpr bool GATHER = false, HOOKS = false;
    int G, c;
    __device__ bool next(int i, Unit& u) const {
        const int L = i * G + c; if (L >= 512) return false;
        const int mode = L >> 8, l = L & 255, b = l >> 4, x = (l >> 2) & 3, y = l & 3;
        if (mode == 0) { const int h = x, kt = y; u.pm = b * 4 + h; u.pn = kt; u.a_off = WS_KM / 2 + (size_t)b * MEMLEN * DM + h * XHD; u.b_off = WS_WXQ / 2 + (size_t)kt * 256 * DM + h * XHD; }
        else { const int nt = x, h = y; u.pm = b * 4 + nt; u.pn = h; u.a_off = WS_WXO / 2 + (size_t)nt * 256 * DM + h * XHD; u.b_off = WS_VMT / 2 + (size_t)b * MEMLEN * DM + h * XHD; }
        u.lbase = mode; return true;
    }
};
struct XattnOrder {
    static constexpr bool GATHER = false;
    int G, c, mode, lda, ldb;
    __device__ bool next(int i, Unit& u) const {
        int L = i * G + c; if (L >= (NTOK / 256) * 4) return false;
        if (G == 256) { const int x = c & 7, idx = c >> 3; L = ((x + 8 * i) * 8 + (idx >> 2)) * 4 + (idx & 3); }
        u.pm = L >> 2; u.pn = L & 3; const int b = u.pm >> 3;
        u.a_off = (size_t)u.pm * 256 * lda;
        u.b_off = mode == 0 ? (size_t)(b * 4 + u.pn) * 256 * ldb : (size_t)(b * 1024 + u.pn * 256) * ldb;
        return true;
    }
};
template <bool GATH_> struct MoeOrder {
    static constexpr bool GATHER = GATH_;
    const LAS int* ts; int G, c, lda, ldb; const int* ltok; unsigned rowbytes;
    __device__ bool next(int i, Unit& u) const {
        const int L = i * G + c; if (L >= ts[NEXP] * 4) return false;
        const int T = L >> 2, j = L & 3; int e = 0; while (ts[e + 1] <= T) ++e;
        const int lt = T - ts[e];
        u.pm = T; u.pn = j; u.a_off = GATH_ ? (size_t)0 : (size_t)T * 256 * lda; u.b_off = ((size_t)e * 1024 + j * 256) * ldb;
        u.lbase = e * LCAP + lt * 256; u.nvalid = ts[33 + e] - lt * 256; return true;
    }
    __device__ __forceinline__ unsigned rowoff(const Unit& u, int r) const { return (r < u.nvalid) ? (unsigned)ltok[u.lbase + r] * rowbytes : 0u; }
};


typedef int v8i __attribute__((ext_vector_type(8)));
typedef int v4i __attribute__((ext_vector_type(4)));
__device__ __forceinline__ v8i cat8(bf16x8 lo, bf16x8 hi) { const v4i a = __builtin_bit_cast(v4i, lo), b = __builtin_bit_cast(v4i, hi); return __builtin_shufflevector(a, b, 0, 1, 2, 3, 4, 5, 6, 7); }
template <int H> __device__ __forceinline__ bf16x8 half8(v8i v) { const v4i h = H ? __builtin_shufflevector(v, v, 4, 5, 6, 7) : __builtin_shufflevector(v, v, 0, 1, 2, 3); return __builtin_bit_cast(bf16x8, h); }
__device__ __forceinline__ unsigned pk4_fp8(float a, float b, float c, float d) { int w = __builtin_amdgcn_cvt_pk_fp8_f32(a, b, 0, false); w = __builtin_amdgcn_cvt_pk_fp8_f32(c, d, w, true); return (unsigned)w; }
__host__ __device__ __forceinline__ int lds_byte(int r, int c) { const int st = (r >> 4) * 2 + (c >> 5), rr = r & 15, cc = c & 31, ob = rr * 64 + cc * 2; return st * 1024 + (ob ^ (((ob >> 9) & 1) << 5)); }
__host__ __device__ __forceinline__ void stage_rc(int b, int& R, int& C) { const int st = b / 1024, sb = b % 1024, swz = sb ^ (((sb >> 9) & 1) << 5); R = (st >> 1) * 16 + swz / 64; C = (st & 1) * 32 + (swz % 64) / 2; }
template <class Epi, class Sched, bool ALIGN_EPI = false, bool SP2 = false, bool F8 = false, bool SKIPW = true>
__device__ __forceinline__ void gemm_phase(LAS unsigned char* lds, const Gemm g, const Sched& S, const Epi& E) {
    constexpr int BK = 64, HALF = 128, HTB = HALF * BK * 2;
    int tid = threadIdx.x; asm volatile("" : "+v"(tid));
    const int wid = __builtin_amdgcn_readfirstlane(tid >> 6), lane = tid & 63, wr = wid >> 2, wc = wid & 3, fr = lane & 15, fq = lane >> 4;
    const int K = g.K, nt = K / BK;
    unsigned voffA[2], voffB[2];
#pragma unroll
    for (int i = 0; i < 2; ++i) { int R, C; stage_rc(tid * 16 + i * 8192, R, C); const int Rb = Epi::PERM ? ((R & ~31) + perm32(R & 31)) : R;
        voffA[i] = (unsigned)(R * g.lda + C) * 2u; voffB[i] = (unsigned)(Rb * g.ldb + C) * 2u; }
    constexpr bool GATH = Sched::GATHER;
    unsigned vcu[2][2] = {{0u, 0u}, {0u, 0u}}, vnx[2][2] = {{0u, 0u}, {0u, 0u}}; int gR[2] = {0, 0}; unsigned gC[2] = {0u, 0u};
    if constexpr (GATH) {
#pragma unroll
        for (int i = 0; i < 2; ++i) { int R, Cq; stage_rc(tid * 16 + i * 8192, R, Cq); gR[i] = R; gC[i] = (unsigned)Cq * 2u; } }
    const size_t kstep = (size_t)(BK * 2);
    const size_t hstepA = (size_t)HALF * g.lda * 2, hstepB = (size_t)HALF * g.ldb * 2;
    const unsigned ldsw = (unsigned)wid * 1024u;
    const int aoff = lds_byte(wr * 64 + fr, fq * 8), boff = lds_byte(wc * 32 + fr, fq * 8);
    constexpr int aoff1 = 1024, boff1 = 1024;
#define PG8_SA(b, h) (((b) * 2 + (h)) * HTB)
#define PG8_SB(b, h) ((4 + (b) * 2 + (h)) * HTB)
#define PG8_STAGE(bufoff, gbase, voff) do { _Pragma("unroll") for (int _i = 0; _i < 2; ++_i) \
        __builtin_amdgcn_global_load_lds((const unsigned*)((const char*)(gbase) + (voff)[_i]), (LAS unsigned*)(lds + (bufoff) + ldsw + _i * 8192), 16, 0, 0); } while (0)
#define PG8_STA(bufoff, ptr, h, nx) do { if constexpr (GATH) { const unsigned vsel_[2] = {(nx) ? vnx[h][0] : vcu[h][0], (nx) ? vnx[h][1] : vcu[h][1]}; PG8_STAGE(bufoff, ptr, vsel_); } \
        else { PG8_STAGE(bufoff, (ptr) + (h) * hstepA, voffA); } } while (0)
#define PG8_LDA(dst, b, h) do { _Pragma("unroll") for (int m = 0; m < 4; ++m) dst[m] = cat8(*(const LAS bf16x8*)(lds + PG8_SA(b, h) + aoff + m * 2048), *(const LAS bf16x8*)(lds + PG8_SA(b, h) + aoff + m * 2048 + aoff1)); } while (0)
#define PG8_LDB(dst, b, h) do { _Pragma("unroll") for (int n = 0; n < 2; ++n) dst[n] = cat8(*(const LAS bf16x8*)(lds + PG8_SB(b, h) + boff + n * 2048), *(const LAS bf16x8*)(lds + PG8_SB(b, h) + boff + n * 2048 + boff1)); } while (0)
#define PG8_MMA(ai, bj, At, Bt) do { __builtin_amdgcn_s_setprio(1); \
        if constexpr (F8) { _Pragma("unroll") for (int m = 0; m < 4; ++m) _Pragma("unroll") for (int n = 0; n < 2; ++n) \
            asm volatile("s_nop 1\n\tv_mfma_scale_f32_16x16x128_f8f6f4 %0, %1, %2, %0, %3, %3 op_sel_hi:[0,0,0]" : "+v"(acc[ai][bj][m][n]) : "v"(Bt[n]), "v"(At[m]), "v"(sc127)); } \
        else { _Pragma("unroll") for (int m = 0; m < 4; ++m) _Pragma("unroll") for (int n = 0; n < 2; ++n) { \
            acc[ai][bj][m][n] = __builtin_amdgcn_mfma_f32_16x16x32_bf16(half8<0>(Bt[n]), half8<0>(At[m]), acc[ai][bj][m][n], 0, 0, 0); \
            acc[ai][bj][m][n] = __builtin_amdgcn_mfma_f32_16x16x32_bf16(half8<1>(Bt[n]), half8<1>(At[m]), acc[ai][bj][m][n], 0, 0, 0); } } \
        __builtin_amdgcn_s_setprio(0); } while (0)
#define PG8_WAIT_V(n) asm volatile("s_waitcnt vmcnt(" #n ")" ::: "memory")
#define PG8_WAIT_L(n) asm volatile("s_waitcnt lgkmcnt(" #n ")" ::: "memory")
#define PG8_BAR __builtin_amdgcn_s_barrier()
#define PG8_SCHED __builtin_amdgcn_sched_barrier(0)
    Unit cur, nxt; int ui = 0;
    if (!S.next(0, cur)) return;
    f32x4 acc[2][2][4][2];
#pragma unroll
    for (int a = 0; a < 2; ++a)
#pragma unroll
        for (int b = 0; b < 2; ++b)
#pragma unroll
            for (int m = 0; m < 4; ++m)
#pragma unroll
                for (int n = 0; n < 2; ++n) acc[a][b][m][n] = (f32x4){0.f, 0.f, 0.f, 0.f};
    int sc127 = 127; asm volatile("" : "+v"(sc127));
    v8i At[4], B0[2], B1[2];
    const char* cA = (const char*)(g.A + cur.a_off); const char* cB = (const char*)(g.Bt + cur.b_off);
    if constexpr (GATH) {
#pragma unroll
        for (int h = 0; h < 2; ++h)
#pragma unroll
            for (int i = 0; i < 2; ++i) vcu[h][i] = S.rowoff(cur, h * HALF + gR[i]) + gC[i]; }
    if constexpr (SP2) {
        PG8_STAGE(PG8_SB(0, 0), cB, voffB); PG8_STAGE(PG8_SB(0, 1), cB + hstepB, voffB); PG8_STA(PG8_SA(0, 0), cA, 0, false); PG8_STA(PG8_SA(0, 1), cA, 1, false);
        if (wr == 1) PG8_BAR;
        PG8_WAIT_V(2); PG8_BAR;
        PG8_STAGE(PG8_SB(1, 0), cB + kstep, voffB); PG8_STA(PG8_SA(1, 0), cA + kstep, 0, false); PG8_STAGE(PG8_SB(1, 1), cB + hstepB + kstep, voffB);
        PG8_WAIT_V(6); PG8_BAR;
    } else {
        PG8_STAGE(PG8_SB(0, 0), cB, voffB); PG8_STA(PG8_SA(0, 0), cA, 0, false); PG8_STAGE(PG8_SB(0, 1), cB + hstepB, voffB); PG8_STA(PG8_SA(0, 1), cA, 1, false);
        if (wr == 1) PG8_BAR;
        PG8_WAIT_V(4); PG8_BAR;
        PG8_STAGE(PG8_SB(1, 0), cB + kstep, voffB); PG8_STA(PG8_SA(1, 0), cA + kstep, 0, false); PG8_STAGE(PG8_SB(1, 1), cB + hstepB + kstep, voffB);
        PG8_WAIT_V(6); PG8_BAR;
    }
    for (;;) {
        const bool has_next = S.next(ui + 1, nxt);
        const char* nA = has_next ? (const char*)(g.A + nxt.a_off) : cA; const char* nB = has_next ? (const char*)(g.Bt + nxt.b_off) : cB;
        if constexpr (GATH) {
#pragma unroll
            for (int h = 0; h < 2; ++h)
#pragma unroll
                for (int i = 0; i < 2; ++i) vnx[h][i] = has_next ? (S.rowoff(nxt, h * HALF + gR[i]) + gC[i]) : vcu[h][i]; }
#pragma unroll 1
        for (int t = 0; t < nt; t += 2) {
            if constexpr (Epi::MIDK) { if (t == (nt >> 1)) E.midk(acc, cur, wr, wc, fr, fq); }
            const bool last = (t == nt - 2); const bool skipw = SKIPW && SP2 && (t == 0) && (ui > 0);
            const char* a1 = cA + (size_t)(t + 1) * kstep;
            const char* a2 = last ? nA : cA + (size_t)(t + 2) * kstep; const char* b2 = last ? nB : cB + (size_t)(t + 2) * kstep;
            const char* a3 = a2 + kstep; const char* b3 = b2 + kstep;
            if constexpr (SP2) {
            PG8_LDB(B0, 0, 0); PG8_LDB(B1, 0, 1); PG8_SCHED; PG8_LDA(At, 0, 0); PG8_STA(PG8_SA(1, 1), a1, 1, false);
            if (!skipw) PG8_WAIT_V(8); PG8_WAIT_L(0); PG8_BAR; PG8_MMA(0, 0, At, B0); PG8_MMA(0, 1, At, B1); PG8_BAR; PG8_SCHED;
            PG8_LDA(At, 0, 1); PG8_STAGE(PG8_SB(0, 0), b2, voffB); PG8_STAGE(PG8_SB(0, 1), b2 + hstepB, voffB); PG8_STA(PG8_SA(0, 0), a2, 0, last);
            if (!skipw) PG8_WAIT_V(8); PG8_WAIT_L(0); PG8_BAR; PG8_MMA(1, 0, At, B0); PG8_MMA(1, 1, At, B1); PG8_BAR; PG8_SCHED;
            PG8_LDB(B0, 1, 0); PG8_LDB(B1, 1, 1); PG8_SCHED; PG8_LDA(At, 1, 0); PG8_STA(PG8_SA(0, 1), a2, 1, last);
            PG8_WAIT_V(8); PG8_WAIT_L(0); PG8_BAR; PG8_MMA(0, 0, At, B0); PG8_MMA(0, 1, At, B1); PG8_BAR; PG8_SCHED;
            PG8_LDA(At, 1, 1); PG8_STAGE(PG8_SB(1, 0), b3, voffB); PG8_STAGE(PG8_SB(1, 1), b3 + hstepB, voffB); PG8_STA(PG8_SA(1, 0), a3, 0, last);
            PG8_WAIT_V(8); PG8_WAIT_L(0); PG8_BAR; PG8_MMA(1, 0, At, B0); PG8_MMA(1, 1, At, B1); PG8_BAR; PG8_SCHED;
            } else {
            PG8_LDB(B0, 0, 0); PG8_SCHED; PG8_LDA(At, 0, 0); PG8_STA(PG8_SA(1, 1), a1, 1, false);
            PG8_WAIT_L(8); PG8_BAR; PG8_WAIT_L(0); PG8_MMA(0, 0, At, B0); PG8_BAR; PG8_SCHED;
            PG8_LDB(B1, 0, 1); PG8_STAGE(PG8_SB(0, 0), b2, voffB);
            PG8_BAR; PG8_WAIT_L(0); PG8_MMA(0, 1, At, B1); PG8_BAR;
            PG8_LDA(At, 0, 1); PG8_STA(PG8_SA(0, 0), a2, 0, last);
            PG8_BAR; PG8_WAIT_L(0); PG8_MMA(1, 0, At, B0); PG8_BAR; PG8_SCHED;
            PG8_STAGE(PG8_SB(0, 1), b2 + hstepB, voffB);
            PG8_WAIT_V(6); PG8_BAR; PG8_MMA(1, 1, At, B1); PG8_BAR;
            PG8_LDB(B0, 1, 0); PG8_SCHED; PG8_LDA(At, 1, 0); PG8_STA(PG8_SA(0, 1), a2, 1, last);
            PG8_WAIT_L(8); PG8_BAR; PG8_WAIT_L(0); PG8_MMA(0, 0, At, B0); PG8_BAR; PG8_SCHED;
            PG8_LDB(B1, 1, 1); PG8_STAGE(PG8_SB(1, 0), b3, voffB);
            PG8_BAR; PG8_WAIT_L(0); PG8_MMA(0, 1, At, B1); PG8_BAR;
            PG8_LDA(At, 1, 1); PG8_STA(PG8_SA(1, 0), a3, 0, last);
            PG8_BAR; PG8_WAIT_L(0); PG8_MMA(1, 0, At, B0); PG8_BAR; PG8_SCHED;
            PG8_STAGE(PG8_SB(1, 1), b3 + hstepB, voffB);
            PG8_WAIT_V(6); PG8_BAR; PG8_MMA(1, 1, At, B1); PG8_BAR;
            }
        }
        if constexpr (ALIGN_EPI) { if (wr == 0) PG8_BAR; }
        if constexpr (F8) {
#pragma unroll
            for (int a = 0; a < 2; ++a)
#pragma unroll
                for (int b = 0; b < 2; ++b)
                    asm volatile("s_nop 15\n\ts_nop 7" : "+v"(acc[a][b][0][0]), "+v"(acc[a][b][0][1]), "+v"(acc[a][b][1][0]), "+v"(acc[a][b][1][1]), "+v"(acc[a][b][2][0]), "+v"(acc[a][b][2][1]), "+v"(acc[a][b][3][0]), "+v"(acc[a][b][3][1]));
        }
        if constexpr (SP2 && SKIPW) PG8_WAIT_V(0);
        E(acc, cur, wr, wc, fr, fq);
        if (!has_next) break;
#pragma unroll
        for (int a = 0; a < 2; ++a)
#pragma unroll
            for (int b = 0; b < 2; ++b)
#pragma unroll
                for (int m = 0; m < 4; ++m)
#pragma unroll
                    for (int n = 0; n < 2; ++n) acc[a][b][m][n] = (f32x4){0.f, 0.f, 0.f, 0.f};
        cur = nxt; cA = nA; cB = nB; ++ui;
        if constexpr (GATH) {
#pragma unroll
            for (int h = 0; h < 2; ++h)
#pragma unroll
                for (int i = 0; i < 2; ++i) vcu[h][i] = vnx[h][i]; }
        if constexpr (ALIGN_EPI) { if (wr == 1) PG8_BAR; }
    }
    PG8_WAIT_V(0);
    if constexpr (!ALIGN_EPI) { if (wr == 0) PG8_BAR; }
    PG8_BAR;
#undef PG8_SA
#undef PG8_SB
#undef PG8_STAGE
#undef PG8_STA
#undef PG8_LDA
#undef PG8_LDB
#undef PG8_MMA
#undef PG8_WAIT_V
#undef PG8_WAIT_L
#undef PG8_BAR
#undef PG8_SCHED
}
#define GEMM_PHASE(lds, g, S, E) gemm_phase<decltype(E), decltype(S), true, true>(lds, g, S, E)
#define GEMM_PHASE8(lds, g, S, E) gemm_phase<decltype(E), decltype(S), true, true, true>(lds, g, S, E)
#define GEMM_PHASE8N(lds, g, S, E) gemm_phase<decltype(E), decltype(S), true, true, true, false>(lds, g, S, E)

__device__ __forceinline__ float rstd_from_ssq(const float* ssq, int row) {
    const f32x4* p = (const f32x4*)(ssq + (size_t)row * 16); const f32x4 a = p[0], b = p[1], c = p[2], d = p[3];
    const float s = ((a[0] + a[1]) + (a[2] + a[3])) + ((b[0] + b[1]) + (b[2] + b[3])) + ((c[0] + c[1]) + (c[2] + c[3])) + ((d[0] + d[1]) + (d[2] + d[3]));
    return __builtin_amdgcn_rsqf(s * (1.0f / DM) + EPS);
}
__device__ __forceinline__ u32x4 pack8(const f32x4 v0, const f32x4 v1) { u32x4 w; w.x = cvt_pk_bf16(v0[0], v0[1]); w.y = cvt_pk_bf16(v0[2], v0[3]); w.z = cvt_pk_bf16(v1[0], v1[1]); w.w = cvt_pk_bf16(v1[2], v1[3]); return w; }

struct EpiProj {
    static constexpr bool PERM = true, LDSX = false, MIDK = false;
    bf16_t* base; const float* rope; float* ksum;
    __device__ __forceinline__ void operator()(f32x4 (&acc)[2][2][4][2], const Unit& u, int wr, int wc, int fr, int fq) const {
        const int type = u.pn >> 1, colt = (u.pn & 1) * 256;
        bf16_t* O = base + (size_t)type * NTOK * 512;
        const bool is_q = (type == 2), is_k = (type == 3);
        if ((is_q || is_k) && !(wc & 1)) {
#pragma unroll
            for (int ai = 0; ai < 2; ++ai)
#pragma unroll
                for (int m = 0; m < 4; ++m) {
                    const int row = u.pm * 256 + 128 * ai + 64 * wr + 16 * m + fr, pos = row & (SEQ - 1);
                    const float* rp = rope + pos * 16;
                    const f32x4 cs[2] = { *(const f32x4*)(rp), *(const f32x4*)(rp + 4) }, sn[2] = { *(const f32x4*)(rp + 8), *(const f32x4*)(rp + 12) };
#pragma unroll
                    for (int bj = 0; bj < 2; ++bj)
#pragma unroll
                        for (int n = 0; n < 2; ++n) {
                            const f32x4 mine = acc[ai][bj][m][n]; f32x4 oth;
#pragma unroll
                            for (int e = 0; e < 4; ++e) oth[e] = __shfl_xor(mine[e], 16);
                            f32x4 res = mine;
                            if (fq == 0) res = mine * cs[n] - oth * sn[n];
                            else if (fq == 1) res = mine * cs[n] + oth * sn[n];
                            acc[ai][bj][m][n] = res;
                        }
                }
        }
        const float sc = is_q ? QSCALE : 1.0f;
#pragma unroll
        for (int ai = 0; ai < 2; ++ai)
#pragma unroll
            for (int m = 0; m < 4; ++m) {
                const int row = u.pm * 256 + 128 * ai + 64 * wr + 16 * m + fr;
                bf16_t* rowp = O + (size_t)row * 512 + colt + 32 * wc + 8 * fq;
#pragma unroll
                for (int bj = 0; bj < 2; ++bj) *(u32x4*)(rowp + bj * 128) = pack8(acc[ai][bj][m][0] * sc, acc[ai][bj][m][1] * sc);
            }
        if (is_k) {
#pragma unroll
            for (int bj = 0; bj < 2; ++bj)
#pragma unroll
                for (int n = 0; n < 2; ++n)
#pragma unroll
                    for (int e = 0; e < 4; ++e) {
                        float s = 0.f;
#pragma unroll
                        for (int ai = 0; ai < 2; ++ai)
#pragma unroll
                            for (int m = 0; m < 4; ++m) s += acc[ai][bj][m][n][e];
                        s += __shfl_xor(s, 1); s += __shfl_xor(s, 2); s += __shfl_xor(s, 4); s += __shfl_xor(s, 8);
                        if (fr == 0) atomicAdd(ksum + (size_t)u.pm * 512 + colt + 128 * bj + 32 * wc + 8 * fq + 4 * n + e, s);
                    }
        }
    }
};
struct EpiStore {
    static constexpr bool PERM = true, LDSX = false, MIDK = false;
    bf16_t* O; int ldc; float sc = 1.0f;
    __device__ __forceinline__ void operator()(f32x4 (&acc)[2][2][4][2], const Unit& u, int wr, int wc, int fr, int fq) const {
#pragma unroll
        for (int ai = 0; ai < 2; ++ai)
#pragma unroll
            for (int m = 0; m < 4; ++m) {
                const int row = u.pm * 256 + 128 * ai + 64 * wr + 16 * m + fr;
                bf16_t* rowp = O + (size_t)row * ldc + u.pn * 256 + 32 * wc + 8 * fq;
#pragma unroll
                for (int bj = 0; bj < 2; ++bj) *(u32x4*)(rowp + bj * 128) = pack8(acc[ai][bj][m][0] * sc, acc[ai][bj][m][1] * sc);
            }
    }
};
struct EpiStore8 {
    static constexpr bool PERM = true, LDSX = false, MIDK = false;
    unsigned char* O; int ldc; float sc;
    __device__ __forceinline__ void operator()(f32x4 (&acc)[2][2][4][2], const Unit& u, int wr, int wc, int fr, int fq) const {
#pragma unroll
        for (int ai = 0; ai < 2; ++ai)
#pragma unroll
            for (int m = 0; m < 4; ++m) {
                const int row = u.pm * 256 + 128 * ai + 64 * wr + 16 * m + fr;
                unsigned char* rowp = O + (size_t)row * ldc + u.pn * 256 + 32 * wc + 8 * fq;
#pragma unroll
                for (int bj = 0; bj < 2; ++bj) { const f32x4 a0 = acc[ai][bj][m][0] * sc, a1 = acc[ai][bj][m][1] * sc; u32x2 w; w.x = pk4_fp8(a0[0], a0[1], a0[2], a0[3]); w.y = pk4_fp8(a1[0], a1[1], a1[2], a1[3]); *(u32x2*)(rowp + bj * 128) = w; }
            }
    }
};
struct EpiStore8x {
    static constexpr bool PERM = true, LDSX = false, MIDK = false, P16 = false;
    unsigned char* O0; unsigned char* O1; float sc0, sc1;
    __device__ __forceinline__ void operator()(f32x4 (&acc)[2][2][4][2], const Unit& u, int wr, int wc, int fr, int fq) const {
        unsigned char* O = u.lbase ? O1 : O0; const float sc = u.lbase ? sc1 : sc0;
#pragma unroll
        for (int ai = 0; ai < 2; ++ai)
#pragma unroll
            for (int m = 0; m < 4; ++m) {
                const int row = u.pm * 256 + 128 * ai + 64 * wr + 16 * m + fr;
                unsigned char* rowp = O + (size_t)row * DM + u.pn * 256 + 32 * wc + 8 * fq;
#pragma unroll
                for (int bj = 0; bj < 2; ++bj) { const f32x4 a0 = acc[ai][bj][m][0] * sc, a1 = acc[ai][bj][m][1] * sc; u32x2 w; w.x = pk4_fp8(a0[0], a0[1], a0[2], a0[3]); w.y = pk4_fp8(a1[0], a1[1], a1[2], a1[3]); *(u32x2*)(rowp + bj * 128) = w; }
            }
    }
};
template <bool BASE_F32, bool KSPLIT> struct EpiResid {
    static constexpr bool PERM = true, LDSX = false, MIDK = KSPLIT;
    const void* base; bf16_t* hb; float* ssq; const float* ssql; const float* ssqa; unsigned char* h8; float asc; const float* rs0 = nullptr; const float* gmix = nullptr;
    __device__ __forceinline__ void stats(int row, int fq, float& rl, float& ra) const {
        const f32x4 pl = *(const f32x4*)(ssql + (size_t)row * 16 + 4 * fq); const f32x2 pa = *(const f32x2*)(ssqa + (size_t)row * 8 + 2 * fq);
        float sl = (pl[0] + pl[1]) + (pl[2] + pl[3]), sa = pa[0] + pa[1];
        sl += __shfl_xor(sl, 16); sl += __shfl_xor(sl, 32); sa += __shfl_xor(sa, 16); sa += __shfl_xor(sa, 32);
        rl = __builtin_amdgcn_rsqf(sl * (1.0f / 512.0f) + EPS); ra = __builtin_amdgcn_rsqf(sa * (1.0f / 512.0f) + EPS);
    }
    __device__ __forceinline__ void midk(f32x4 (&acc)[2][2][4][2], const Unit& u, int wr, int wc, int fr, int fq) const {
        asm volatile("" : "+v"(fr), "+v"(fq));
#pragma unroll
        for (int ai = 0; ai < 2; ++ai)
#pragma unroll
            for (int m = 0; m < 4; ++m) { float rl, ra; stats(u.pm * 256 + 128 * ai + 64 * wr + 16 * m + fr, fq, rl, ra); const float ratio = rl * __builtin_amdgcn_rcpf(ra);
#pragma unroll
                for (int bj = 0; bj < 2; ++bj)
#pragma unroll
                    for (int n = 0; n < 2; ++n) acc[ai][bj][m][n] *= ratio; }
    }
    __device__ __forceinline__ void operator()(f32x4 (&acc)[2][2][4][2], const Unit& u, int wr, int wc, int fr, int fq) const {
        f32x4 ginv[2][2];
        if constexpr (BASE_F32) {
#pragma unroll
            for (int bj = 0; bj < 2; ++bj)
#pragma unroll
                for (int n = 0; n < 2; ++n) { const f32x4 g = *(const f32x4*)(gmix + u.pn * 256 + 128 * bj + 32 * wc + 8 * fq + 4 * n);
                    ginv[bj][n] = (f32x4){__builtin_amdgcn_rcpf(g[0]), __builtin_amdgcn_rcpf(g[1]), __builtin_amdgcn_rcpf(g[2]), __builtin_amdgcn_rcpf(g[3])}; } }
#pragma unroll
        for (int ai = 0; ai < 2; ++ai)
#pragma unroll
            for (int m = 0; m < 4; ++m) {
                const int row = u.pm * 256 + 128 * ai + 64 * wr + 16 * m + fr; float q = 0.f, osc = asc, irs = 1.0f;
                if constexpr (KSPLIT) { float rl; stats(row, fq, rl, osc); osc *= asc; }
                if constexpr (BASE_F32) irs = __builtin_amdgcn_rcpf(rs0[row]);
#pragma unroll
                for (int bj = 0; bj < 2; ++bj) {
                    const int col = u.pn * 256 + 128 * bj + 32 * wc + 8 * fq;
                    f32x4 b0, b1;
                    if constexpr (BASE_F32) { const u32x4 w = *(const u32x4*)((const bf16_t*)base + (size_t)row * DM + col);
                        b0 = (f32x4){bflo(w.x), bfhi(w.x), bflo(w.y), bfhi(w.y)} * (ginv[bj][0] * irs); b1 = (f32x4){bflo(w.z), bfhi(w.z), bflo(w.w), bfhi(w.w)} * (ginv[bj][1] * irs); }
                    else { const u32x4 w = *(const u32x4*)((const bf16_t*)base + (size_t)row * LDH + col); b0 = (f32x4){bflo(w.x), bfhi(w.x), bflo(w.y), bfhi(w.y)}; b1 = (f32x4){bflo(w.z), bfhi(w.z), bflo(w.w), bfhi(w.w)}; }
                    const f32x4 v0 = b0 + acc[ai][bj][m][0] * osc, v1 = b1 + acc[ai][bj][m][1] * osc;
                    q += ((v0[0] * v0[0] + v0[1] * v0[1]) + (v0[2] * v0[2] + v0[3] * v0[3])) + ((v1[0] * v1[0] + v1[1] * v1[1]) + (v1[2] * v1[2] + v1[3] * v1[3]));
                    *(u32x4*)(hb + (size_t)row * LDH + col) = pack8(v0, v1);
                    if (h8) { u32x2 w8; w8.x = pk4_fp8(v0[0], v0[1], v0[2], v0[3]); w8.y = pk4_fp8(v1[0], v1[1], v1[2], v1[3]); *(u32x2*)(h8 + (size_t)row * DM + col) = w8; }
                }
                q += __shfl_xor(q, 16); q += __shfl_xor(q, 32);
                if (fq == 0) ssq[(size_t)row * 16 + u.pn * 4 + wc] = q;
            }
    }
};
#define XBAR() do { asm volatile("s_waitcnt lgkmcnt(0)" ::: "memory"); __builtin_amdgcn_s_barrier(); asm volatile("" ::: "memory"); } while (0)
struct EpiSoftmax {
    static constexpr bool PERM = true, LDSX = false, MIDK = false;
    unsigned char* O; int ldc; LAS unsigned char* xl; const float* ssq; float cs;
    __device__ __forceinline__ void operator()(f32x4 (&acc)[2][2][4][2], const Unit& u, int wr, int wc, int fr, int fq) const {
        LAS float* P = (LAS float*)xl;
        LAS float* Q = (LAS float*)(xl + 4096);
#pragma unroll
        for (int ai = 0; ai < 2; ++ai)
#pragma unroll
            for (int m = 0; m < 4; ++m) {
                float v = -INFINITY; const float sc = rstd_from_ssq(ssq, u.pm * 256 + 128 * ai + 64 * wr + 16 * m + fr) * cs;
#pragma unroll
                for (int bj = 0; bj < 2; ++bj)
#pragma unroll
                    for (int n = 0; n < 2; ++n) { const f32x4 x = acc[ai][bj][m][n] * sc; acc[ai][bj][m][n] = x; v = fmaxf(v, fmaxf(fmaxf(x[0], x[1]), fmaxf(x[2], x[3]))); }
                v = fmaxf(v, __shfl_xor(v, 16)); v = fmaxf(v, __shfl_xor(v, 32));
                if (fq == 0) P[(128 * ai + 64 * wr + 16 * m + fr) * 4 + wc] = v;
            }
        XBAR();
#pragma unroll
        for (int ai = 0; ai < 2; ++ai)
#pragma unroll
            for (int m = 0; m < 4; ++m) {
                const int r = 128 * ai + 64 * wr + 16 * m + fr;
                const float v = fmaxf(fmaxf(P[r * 4 + 0], P[r * 4 + 1]), fmaxf(P[r * 4 + 2], P[r * 4 + 3]));
                float s = 0.f;
#pragma unroll
                for (int bj = 0; bj < 2; ++bj)
#pragma unroll
                    for (int n = 0; n < 2; ++n) { f32x4 x = acc[ai][bj][m][n];
#pragma unroll
                        for (int e = 0; e < 4; ++e) { x[e] = __builtin_amdgcn_exp2f(x[e] - v); s += x[e]; }
                        acc[ai][bj][m][n] = x; }
                s += __shfl_xor(s, 16); s += __shfl_xor(s, 32);
                if (fq == 0) Q[r * 4 + wc] = s;
            }
        XBAR();
#pragma unroll
        for (int ai = 0; ai < 2; ++ai)
#pragma unroll
            for (int m = 0; m < 4; ++m) {
                const int r = 128 * ai + 64 * wr + 16 * m + fr;
                const float inv = PX_SC * __builtin_amdgcn_rcpf((Q[r * 4 + 0] + Q[r * 4 + 1]) + (Q[r * 4 + 2] + Q[r * 4 + 3]));
                unsigned char* rowp = O + (size_t)(u.pm * 256 + r) * ldc + u.pn * 256 + 32 * wc + 8 * fq;
#pragma unroll
                for (int bj = 0; bj < 2; ++bj) { const f32x4 a0 = acc[ai][bj][m][0] * inv, a1 = acc[ai][bj][m][1] * inv; u32x2 w; w.x = pk4_fp8(a0[0], a0[1], a0[2], a0[3]); w.y = pk4_fp8(a1[0], a1[1], a1[2], a1[3]); *(u32x2*)(rowp + bj * 128) = w; }
            }
        XBAR();
    }
};
struct EpiGateUp {
    static constexpr bool PERM = true, LDSX = false, MIDK = false;
    unsigned char* O; const float* lrs;
    __device__ __forceinline__ void operator()(f32x4 (&acc)[2][2][4][2], const Unit& u, int wr, int wc, int fr, int fq) const {
#pragma unroll
        for (int ai = 0; ai < 2; ++ai)
#pragma unroll
            for (int m = 0; m < 4; ++m) {
                const int r = 128 * ai + 64 * wr + 16 * m + fr, row = u.pm * 256 + r; const float rs = (r < u.nvalid) ? lrs[u.lbase + r] * (1.0f / WGU_SC) : 0.f;
                f32x4 o[2];
#pragma unroll
                for (int n = 0; n < 2; ++n)
#pragma unroll
                    for (int e = 0; e < 4; ++e) { const float g = acc[ai][0][m][n][e] * rs, up = acc[ai][1][m][n][e] * rs; o[n][e] = g * sigmoidf_(g) * up * ACT_SC; }
                u32x2 w8; w8.x = pk4_fp8(o[0][0], o[0][1], o[0][2], o[0][3]); w8.y = pk4_fp8(o[1][0], o[1][1], o[1][2], o[1][3]);
                *(u32x2*)(O + (size_t)row * DFF + u.pn * 128 + 32 * wc + 8 * fq) = w8;
            }
    }
};

struct Args { const float* in[27]; float* out; unsigned char* ws; int ph_lo, ph_hi; float invf[8]; };
struct Ctx { LAS unsigned char* lds; int tid, lane, wave, vcu, G; };

__device__ __forceinline__ void tr_load(f32x4 (&v)[8], const float* W, int ldw, int k0, int n0s, int lane) {
    const int kr = lane >> 3, ch = lane & 7;
#pragma unroll
    for (int i = 0; i < 8; ++i) v[i] = *(const f32x4*)(W + (size_t)(k0 + 8 * i + kr) * ldw + n0s + 4 * ch);
}
__device__ __forceinline__ void tr_finish(const f32x4 (&v)[8], int k0, bf16_t* WT, int ldt, int r0d, const float* gain, LAS float* scr, int lane) {
    const int kr = lane >> 3, ch = lane & 7, c = lane & 7;
    f32x4 g0 = {1.f, 1.f, 1.f, 1.f}, g1 = {1.f, 1.f, 1.f, 1.f};
    if (gain) { g0 = *(const f32x4*)(gain + k0 + 8 * c); g1 = *(const f32x4*)(gain + k0 + 8 * c + 4); }
#pragma unroll
    for (int i = 0; i < 8; ++i) { LAS float* d = scr + (8 * i + kr) * 33 + 4 * ch; d[0] = v[i][0]; d[1] = v[i][1]; d[2] = v[i][2]; d[3] = v[i][3]; }
    LDS_WAIT(); asm volatile("" ::: "memory");
#pragma unroll
    for (int j = 0; j < 4; ++j) { const int n = (lane >> 3) + 8 * j; const LAS float* s = scr + (8 * c) * 33 + n;
        u32x4 o; o.x = cvt_pk_bf16(s[0 * 33] * g0[0], s[1 * 33] * g0[1]); o.y = cvt_pk_bf16(s[2 * 33] * g0[2], s[3 * 33] * g0[3]); o.z = cvt_pk_bf16(s[4 * 33] * g1[0], s[5 * 33] * g1[1]); o.w = cvt_pk_bf16(s[6 * 33] * g1[2], s[7 * 33] * g1[3]);
        *(u32x4*)(WT + (size_t)(r0d + n) * ldt + k0 + 8 * c) = o; }
    LDS_WAIT(); asm volatile("" ::: "memory");
}
__device__ __forceinline__ void tr_finish8(const f32x4 (&v)[8], int k0, unsigned char* WT8, int ldt, int r0d, const float* gain, float sc, LAS float* scr, int lane) {
    const int kr = lane >> 3, ch = lane & 7, c = lane & 7;
    f32x4 g0 = {sc, sc, sc, sc}, g1 = {sc, sc, sc, sc};
    if (gain) { g0 = *(const f32x4*)(gain + k0 + 8 * c) * sc; g1 = *(const f32x4*)(gain + k0 + 8 * c + 4) * sc; }
#pragma unroll
    for (int i = 0; i < 8; ++i) { LAS float* d = scr + (8 * i + kr) * 33 + 4 * ch; d[0] = v[i][0]; d[1] = v[i][1]; d[2] = v[i][2]; d[3] = v[i][3]; }
    LDS_WAIT(); asm volatile("" ::: "memory");
#pragma unroll
    for (int j = 0; j < 4; ++j) { const int n = (lane >> 3) + 8 * j; const LAS float* s = scr + (8 * c) * 33 + n;
        u32x2 o; o.x = pk4_fp8(s[0 * 33] * g0[0], s[1 * 33] * g0[1], s[2 * 33] * g0[2], s[3 * 33] * g0[3]); o.y = pk4_fp8(s[4 * 33] * g1[0], s[5 * 33] * g1[1], s[6 * 33] * g1[2], s[7 * 33] * g1[3]);
        *(u32x2*)(WT8 + (size_t)(r0d + n) * ldt + k0 + 8 * c) = o; }
    LDS_WAIT(); asm volatile("" ::: "memory");
}
__device__ __forceinline__ void tr_item(const float* W, int ldw, int k0, int n0s, bf16_t* WT, int ldt, int r0d, const float* gain, LAS float* scr, int lane) {
    f32x4 v[8]; tr_load(v, W, ldw, k0, n0s, lane); tr_finish(v, k0, WT, ldt, r0d, gain, scr, lane);
}

__device__ __forceinline__ void rms_row2_to_bf16(const float* xrow, const float* gain, bf16_t* orow, int lane, float* rstd_out = nullptr) {
    const f32x4* xr = (const f32x4*)xrow + lane; const f32x4* gr = (const f32x4*)gain + lane;
    f32x4 v[2][4]; float s[2] = {0.f, 0.f};
#pragma unroll
    for (int r = 0; r < 2; ++r)
#pragma unroll
        for (int j = 0; j < 4; ++j) v[r][j] = xr[256 * r + 64 * j];
#pragma unroll
    for (int r = 0; r < 2; ++r)
#pragma unroll
        for (int j = 0; j < 4; ++j) s[r] += (v[r][j][0] * v[r][j][0] + v[r][j][1] * v[r][j][1]) + (v[r][j][2] * v[r][j][2] + v[r][j][3] * v[r][j][3]);
#pragma unroll
    for (int r = 0; r < 2; ++r) { const float rstd = 1.0f / sqrtf(wave_sum(s[r]) * (1.0f / DM) + EPS); u32x2* o8 = (u32x2*)(orow + (size_t)r * DM) + lane; if (rstd_out && lane == 0) rstd_out[r] = rstd;
#pragma unroll
        for (int j = 0; j < 4; ++j) { const f32x4 g = gr[64 * j]; u32x2 w; w.x = cvt_pk_bf16(v[r][j][0] * rstd * g[0], v[r][j][1] * rstd * g[1]); w.y = cvt_pk_bf16(v[r][j][2] * rstd * g[2], v[r][j][3] * rstd * g[3]); o8[64 * j] = w; } }
}

__device__ __forceinline__ void conv_wdn(const Args& a, const Ctx& C, int gw, int NGW, int it_lo, int NIT) {
    LAS float* scr = (LAS float*)(C.lds + C.wave * 16384); const int lane = C.lane;
    f32x4 va[8], vb[8];
#define WDN_LOAD(v, it) do { const int e_ = (it) / 256, r_ = (it) % 256; tr_load(v, a.in[25] + (size_t)e_ * DFF * DM, DM, 64 * (r_ / 32), 32 * (r_ % 32), lane); } while (0)
#define WDN_FIN(v, it) do { const int e_ = (it) / 256, r_ = (it) % 256; tr_finish8(v, 64 * (r_ / 32), a.ws + WS_WDN, DFF, e_ * 1024 + 32 * (r_ % 32), nullptr, WDN_SC, scr, lane); } while (0)
    int it = it_lo + gw; if (it < NIT) WDN_LOAD(va, it);
    for (; it < NIT; it += 2 * NGW) {
        const int it1 = it + NGW, it2 = it + 2 * NGW;
        if (it1 < NIT) WDN_LOAD(vb, it1);
        WDN_FIN(va, it);
        if (it2 < NIT) WDN_LOAD(va, it2);
        if (it1 < NIT) WDN_FIN(vb, it1);
    }
#undef WDN_LOAD
#undef WDN_FIN
}
__device__ __forceinline__ void ph_prologue(const Args& a, const Ctx& C) {
    unsigned char* ws = a.ws;
    LAS float* scr = (LAS float*)(C.lds + C.wave * 16384);
    const int gw = C.vcu * 8 + C.wave, NGW = C.G * 8, lane = C.lane;
    for (int it = gw; it < 16 * 80; it += NGW) { const int kb = it / 80, nb = it % 80; tr_item(a.in[3], DIN, 64 * kb, 32 * nb, (bf16_t*)(ws + WS_WIN), DM, 32 * nb, nullptr, scr, lane); }
    for (int it = gw; it < 16 * 64; it += NGW) { const int kb = it / 64, nb = it % 64;
        if (nb < 32) tr_item(a.in[17], 2 * DM, 64 * kb, 32 * nb, (bf16_t*)(ws + WS_WXK), DM, 32 * nb, nullptr, scr, lane);
        else tr_item(a.in[17], 2 * DM, 64 * kb, 32 * nb, (bf16_t*)(ws + WS_WXV), DM, 32 * (nb - 32), nullptr, scr, lane); }
    for (int it = gw; it < 16 * 32; it += NGW) { const int kb = it / 32, nb = it % 32;
        tr_item(a.in[13], DM, 64 * kb, 32 * nb, (bf16_t*)(ws + WS_WOUT), DM, 32 * nb, (kb < 8) ? a.in[11] : (a.in[12] - DLRU), scr, lane);
        tr_item(a.in[18], DM, 64 * kb, 32 * nb, (bf16_t*)(ws + WS_WXO), DM, 32 * nb, nullptr, scr, lane); }
    for (int r = gw; r < DM; r += NGW) { const float gk = a.in[14][r]; const f32x4* src = (const f32x4*)(a.in[16] + (size_t)r * DM) + lane; u32x2* dst = (u32x2*)((bf16_t*)(ws + WS_WXQ) + (size_t)r * DM) + lane;
#pragma unroll
        for (int j = 0; j < 4; ++j) { const f32x4 v = src[64 * j]; u32x2 w; w.x = cvt_pk_bf16(v[0] * gk, v[1] * gk); w.y = cvt_pk_bf16(v[2] * gk, v[3] * gk); dst[64 * j] = w; } }
    { bf16_t* WR = (bf16_t*)(ws + WS_WR); const int gt = C.vcu * 512 + C.tid, NT = C.G * 512;
      for (int i = gt; i < 48 * DM; i += NT) { const int r = i / DM, k = i % DM; float v = 0.f;
          if (r < 4) v = a.in[20][k * NGRP + r] * a.in[19][k]; else if (r < 36) v = a.in[22][k * NEXP + (r - 4)] * a.in[19][k];
          WR[i] = (bf16_t)(cvt_pk_bf16(v, 0.f) & 0xffffu); }
      float* rope = (float*)(ws + WS_ROPE);
      for (int i = gt; i < SEQ * 8; i += NT) { const int pos = i >> 3, j = i & 7; const float ang = (float)pos * a.invf[j];
          const double tw = 6.283185307179586476925286766559; const double ad = (double)ang; const double red = ad - tw * __builtin_rint(ad / tw); const float rf = (float)red;
          rope[pos * 16 + j] = __cosf(rf); rope[pos * 16 + 8 + j] = __sinf(rf); } }
    for (int m = 2 * gw; m < NTOK; m += 2 * NGW) rms_row2_to_bf16(a.in[0] + (size_t)m * DM, a.in[2], (bf16_t*)(ws + WS_B) + (size_t)m * DM, lane, (float*)(ws + WS_TOK + TOK_D) + m);
    for (int m = 2 * gw; m < NMEM; m += 2 * NGW) rms_row2_to_bf16(a.in[1] + (size_t)m * DM, a.in[15], (bf16_t*)(ws + WS_MEMN) + (size_t)m * DM, lane);
}

__device__ __forceinline__ float gelu_tanh(float x) { const float x2 = x * x; const float z2 = x * (-2.0f * 0.7978845608028654f * 1.4426950408889634f) * (1.0f + 0.044715f * x2);
    return x * __builtin_amdgcn_rcpf(1.0f + __builtin_amdgcn_exp2f(z2)); }
__device__ __forceinline__ bool moe_item_load(f32x4 (&v)[8], const Args& a, int s, int lane) {
    if (s < NEXP * 512) { const int e = s / 512, r = s % 512, kb = r / 32, nb = r % 32, j = nb >> 3, half = (nb >> 2) & 1, q = nb & 3;
        tr_load(v, a.in[24] + (size_t)e * DM * DM, DM, 64 * kb, half * 512 + j * 128 + q * 32, lane); return true; }
    const int it = s - NEXP * 512 + WDN_SPLIT; if (it >= NEXP * 256) return false;
    const int e = it / 256, r = it % 256; tr_load(v, a.in[25] + (size_t)e * DFF * DM, DM, 64 * (r / 32), 32 * (r % 32), lane); return true;
}
__device__ __forceinline__ void moe_item_finish(const f32x4 (&v)[8], const Args& a, int s, LAS float* scr, int lane) {
    if (s < NEXP * 512) { const int e = s / 512, r = s % 512, kb = r / 32, nb = r % 32, j = nb >> 3, half = (nb >> 2) & 1, q = nb & 3;
        tr_finish8(v, 64 * kb, a.ws + WS_WGU, DM, e * 1024 + j * 256 + half * 128 + q * 32, a.in[19], WGU_SC, scr, lane); return; }
    const int it = s - NEXP * 512 + WDN_SPLIT; const int e = it / 256, r = it % 256;
    tr_finish8(v, 64 * (r / 32), a.ws + WS_WDN, DFF, e * 1024 + 32 * (r % 32), nullptr, WDN_SC, scr, lane);
}
__device__ __forceinline__ void lru_unit(const Args& a, const Ctx& C, int b, int blk, int half, int L) {
    unsigned char* ws = a.ws;
    const bf16_t* XL = (const bf16_t*)(ws + WS_A); const bf16_t* GL = XL + (size_t)NTOK * 512; bf16_t* YC = (bf16_t*)(ws + WS_C); float* SSQL = (float*)(ws + WS_SSQL);
    const int tid = C.tid, lane = C.lane, wave = C.wave, fr = lane & 15, fq = lane >> 4;
    LAS float* cscr = (LAS float*)(C.lds + 46336 + wave * 8448);
    LAS float* XW = (LAS float*)(C.lds + wave * 5120);
    LAS bf16_t* GW = (LAS bf16_t*)(C.lds + wave * 5120 + 2304);
    LAS bf16_t* YW = (LAS bf16_t*)(C.lds + wave * 5120 + 3584);
    LAS float* WSUM = (LAS float*)(C.lds + 40960);
    LAS float* CW = (LAS float*)(C.lds + 45056);
    const int c0 = blk * 64, oc0 = c0 + half * 32;
    bf16x8 wfr[2][2][2];
#pragma unroll
    for (int gt = 0; gt < 2; ++gt) { const float* W = a.in[gt == 0 ? 6 : 8] + (size_t)blk * 64 * 64;
#pragma unroll
        for (int nt = 0; nt < 2; ++nt)
#pragma unroll
            for (int ks = 0; ks < 2; ++ks) { u32x4 w; float f[8];
#pragma unroll
                for (int j = 0; j < 8; ++j) f[j] = W[(32 * ks + 8 * fq + j) * 64 + half * 32 + 16 * nt + fr];
                w.x = cvt_pk_bf16(f[0], f[1]); w.y = cvt_pk_bf16(f[2], f[3]); w.z = cvt_pk_bf16(f[4], f[5]); w.w = cvt_pk_bf16(f[6], f[7]);
                wfr[gt][nt][ks] = __builtin_bit_cast(bf16x8, w); } }
    LAS bf16x8* WF = (LAS bf16x8*)(C.lds + 113920);
    if (wave == 0) {
#pragma unroll
        for (int gt = 0; gt < 2; ++gt)
#pragma unroll
            for (int nt = 0; nt < 2; ++nt)
#pragma unroll
                for (int ks = 0; ks < 2; ++ks) WF[((gt * 2 + nt) * 2 + ks) * 64 + lane] = wfr[gt][nt][ks]; }
    float brg[2], big[2], sp[2], hc[2] = {0.f, 0.f};
#pragma unroll
    for (int nt = 0; nt < 2; ++nt) { const int ch = oc0 + 16 * nt + fr; brg[nt] = a.in[7][ch] * -1.4426950408889634f; big[nt] = a.in[9][ch] * -1.4426950408889634f; const float lam = a.in[10][ch];
        sp[nt] = -8.0f * 1.4426950408889634f * ((lam > 15.f) ? __expf(-lam) : log1pf(__expf(-lam))); }
    if (tid < 320) { const int k = tid >> 6, c = tid & 63; CW[tid] = (k < 4) ? a.in[4][k * DLRU + c0 + c] : a.in[5][c0 + c]; }
    u32x4 xr1[4][2], gr1;
    const bf16_t* xrow0 = XL + ((size_t)b * SEQ + 16 * wave + fr) * 512 + c0 + 8 * fq;
    const bf16_t* grow0 = GL + ((size_t)b * SEQ + 16 * wave + (lane >> 2)) * 512 + oc0 + 8 * (lane & 3);
    const int tloc = 16 * wave + fr;
#define LRU_PREFETCH(t0_, xr, gr) do { _Pragma("unroll") for (int k = 0; k < 4; ++k) { const int tt = (t0_) + tloc - 3 + k; \
        if (tt >= 0) { const bf16_t* xp = xrow0 + (ptrdiff_t)((t0_) - 3 + k) * 512; xr[k][0] = *(const u32x4*)xp; xr[k][1] = *(const u32x4*)(xp + 32); } else { xr[k][0] = (u32x4){0u, 0u, 0u, 0u}; xr[k][1] = (u32x4){0u, 0u, 0u, 0u}; } } \
        gr = *(const u32x4*)(grow0 + (size_t)(t0_) * 512); } while (0)
    LRU_PREFETCH(0, xr1, gr1);
    __syncthreads();
    for (int ch2 = 0; ch2 < SEQ / 256; ++ch2) {
#pragma unroll
      for (int sub = 0; sub < 2; ++sub) { const int ch = 2 * ch2 + sub, t0 = ch * 128; auto& xr = xr1; auto& gr = gr1;
        f32x4 cv[8]; const int cslot = sub * (NEXP * 512) + (ch2 * 256 + L) * 8 + wave; const bool chas = moe_item_load(cv, a, cslot, lane);
        bf16x8 af[2];
#pragma unroll
        for (int ks = 0; ks < 2; ++ks) { float accv[8];
            { const f32x4 b0 = *(const LAS f32x4*)(CW + 256 + 32 * ks + 8 * fq), b1 = *(const LAS f32x4*)(CW + 256 + 32 * ks + 8 * fq + 4);
              accv[0] = b0[0]; accv[1] = b0[1]; accv[2] = b0[2]; accv[3] = b0[3]; accv[4] = b1[0]; accv[5] = b1[1]; accv[6] = b1[2]; accv[7] = b1[3]; }
#pragma unroll
            for (int k = 0; k < 4; ++k) { const f32x4 w0 = *(const LAS f32x4*)(CW + 64 * k + 32 * ks + 8 * fq), w1 = *(const LAS f32x4*)(CW + 64 * k + 32 * ks + 8 * fq + 4); const u32x4 x = xr[k][ks];
                accv[0] += w0[0] * bflo(x.x); accv[1] += w0[1] * bfhi(x.x); accv[2] += w0[2] * bflo(x.y); accv[3] += w0[3] * bfhi(x.y);
                accv[4] += w1[0] * bflo(x.z); accv[5] += w1[1] * bfhi(x.z); accv[6] += w1[2] * bflo(x.w); accv[7] += w1[3] * bfhi(x.w); }
            u32x4 p; p.x = cvt_pk_bf16(accv[0], accv[1]); p.y = cvt_pk_bf16(accv[2], accv[3]); p.z = cvt_pk_bf16(accv[4], accv[5]); p.w = cvt_pk_bf16(accv[6], accv[7]);
            af[ks] = __builtin_bit_cast(bf16x8, p);
            if (ks == half) { *(LAS f32x4*)(XW + fr * 36 + 8 * fq) = (f32x4){accv[0], accv[1], accv[2], accv[3]}; *(LAS f32x4*)(XW + fr * 36 + 8 * fq + 4) = (f32x4){accv[4], accv[5], accv[6], accv[7]}; } }
        *(LAS u32x4*)(GW + (lane >> 2) * 40 + 8 * (lane & 3)) = gr;
        if (ch + 1 < SEQ / 128) LRU_PREFETCH(t0 + 128, xr, gr);
        LDS_WAIT(); asm volatile("" ::: "memory");
        float Hl[2][4], Al[2][4], Aex[2], Hex[2];
        { f32x4 ar[2] = {{0.f, 0.f, 0.f, 0.f}, {0.f, 0.f, 0.f, 0.f}}, ai_[2] = {{0.f, 0.f, 0.f, 0.f}, {0.f, 0.f, 0.f, 0.f}};
#pragma unroll
          for (int ks = 0; ks < 2; ++ks)
#pragma unroll
              for (int nt = 0; nt < 2; ++nt) { ar[nt] = __builtin_amdgcn_mfma_f32_16x16x32_bf16(af[ks], WF[((0 * 2 + nt) * 2 + ks) * 64 + lane], ar[nt], 0, 0, 0); ai_[nt] = __builtin_amdgcn_mfma_f32_16x16x32_bf16(af[ks], WF[((1 * 2 + nt) * 2 + ks) * 64 + lane], ai_[nt], 0, 0, 0); }
#pragma unroll
          for (int nt = 0; nt < 2; ++nt) {
              float hrun = 0.f, arun = 1.f;
#pragma unroll
              for (int r = 0; r < 4; ++r) { const int chn = 16 * nt + fr;
                  const float rg = __builtin_amdgcn_rcpf(1.0f + __builtin_amdgcn_exp2f(__builtin_fmaf(ar[nt][r], -1.4426950408889634f, brg[nt])));
                  const float ig = __builtin_amdgcn_rcpf(1.0f + __builtin_amdgcn_exp2f(__builtin_fmaf(ai_[nt][r], -1.4426950408889634f, big[nt])));
                  const float av = __builtin_amdgcn_exp2f(rg * sp[nt]); const float mult = __builtin_amdgcn_sqrtf(fmaxf(1.0f - av * av, 0.f));
                  const float uv = mult * ig * XW[(4 * fq + r) * 36 + chn];
                  hrun = av * hrun + uv; arun *= av; Hl[nt][r] = hrun; Al[nt][r] = arun; }
              const float A0 = __shfl(arun, fr), H0 = __shfl(hrun, fr), A1 = __shfl(arun, fr + 16), H1 = __shfl(hrun, fr + 16), A2 = __shfl(arun, fr + 32), H2 = __shfl(hrun, fr + 32), A3 = __shfl(arun, fr + 48), H3 = __shfl(hrun, fr + 48);
              const float h01 = A1 * H0 + H1, a01 = A1 * A0, h012 = A2 * h01 + H2, a012 = A2 * a01;
              Aex[nt] = (fq == 0) ? 1.f : (fq == 1) ? A0 : (fq == 2) ? a01 : a012;
              Hex[nt] = (fq == 0) ? 0.f : (fq == 1) ? H0 : (fq == 2) ? h01 : h012;
              if (fq == 0) *(LAS f32x2*)(WSUM + (((ch & 1) * 8 + wave) * 32 + 16 * nt + fr) * 2) = (f32x2){A3 * a012, A3 * h012 + H3}; } }
        __syncthreads();
        { float ssr[4] = {0.f, 0.f, 0.f, 0.f};
#pragma unroll
          for (int nt = 0; nt < 2; ++nt) { const int chn = 16 * nt + fr; float x = hc[nt], mine = 0.f;
#pragma unroll
              for (int w2 = 0; w2 < 8; ++w2) { const f32x2 sm = *(const LAS f32x2*)(WSUM + (((ch & 1) * 8 + w2) * 32 + chn) * 2); if (w2 == wave) mine = x; x = sm[0] * x + sm[1]; }
              hc[nt] = x;
              const float hstart = Aex[nt] * mine + Hex[nt];
#pragma unroll
              for (int r = 0; r < 4; ++r) { const int tl = 4 * fq + r; const float h = Al[nt][r] * hstart + Hl[nt][r];
                  const float y = h * gelu_tanh(bf2f(GW[tl * 40 + chn])); const unsigned yb = cvt_pk_bf16(y, 0.f) & 0xffffu; YW[tl * 40 + chn] = (bf16_t)yb;
                  const float yr = __uint_as_float(yb << 16); ssr[r] += yr * yr; } }
#pragma unroll
          for (int r = 0; r < 4; ++r) { float q = ssr[r]; q += __shfl_xor(q, 1); q += __shfl_xor(q, 2); q += __shfl_xor(q, 4); q += __shfl_xor(q, 8);
              if (fr == 0) SSQL[((size_t)b * SEQ + t0 + 16 * wave + 4 * fq + r) * 16 + blk * 2 + half] = q; } }
        LDS_WAIT(); asm volatile("" ::: "memory");
        *(u32x4*)(YC + ((size_t)b * SEQ + t0 + 16 * wave + (lane >> 2)) * DM + oc0 + 8 * (lane & 3)) = *(const LAS u32x4*)(YW + (lane >> 2) * 40 + 8 * (lane & 3));
        if (chas) moe_item_finish(cv, a, cslot, cscr, lane);
      }
    }
#undef LRU_PREFETCH
    __syncthreads();
}


__device__ __forceinline__ void ph_router(const Args& a, const Ctx& C) {
    unsigned char* ws = a.ws;
    const bf16_t* H2B = (const bf16_t*)a.out + DM; const bf16_t* WR = (const bf16_t*)(ws + WS_WR); const float* SSQ2 = (const float*)(ws + WS_SSQ2);
    unsigned* CNT = (unsigned*)(ws + WS_CTL) + CW_CNT;
    int* TOKE = (int*)(ws + WS_TOK + TOK_E); int* TOKR = (int*)(ws + WS_TOK + TOK_R); float* TOKG = (float*)(ws + WS_TOK + TOK_G); int* LTOK = (int*)(ws + WS_LTOK); float* LRS = (float*)(ws + WS_LRS);
    constexpr int WRS = 1032;
    LAS bf16_t* WRL = (LAS bf16_t*)C.lds;
    LAS float* LG = (LAS float*)(C.lds + 99072) + C.wave * (16 * 49);
    LAS unsigned* lcnt = (LAS unsigned*)(C.lds + 99072 + 25088); LAS unsigned* lbase = lcnt + 32;
    const int lane = C.lane, fr = lane & 15, fq = lane >> 4;
    for (int i = C.tid; i < 48 * 128; i += 512) { const int r = i >> 7, c8 = i & 127; *(LAS u32x4*)(WRL + r * WRS + 8 * c8) = *(const u32x4*)(WR + (size_t)r * DM + 8 * c8); }
    for (int pass = 0; (pass * C.G) * 128 < NTOK; ++pass) {
        const int blk = pass * C.G + C.vcu; const bool live = blk * 128 < NTOK;
        if (C.tid < 32) lcnt[C.tid] = 0u;
        __syncthreads();
        int E1 = 0, E2 = 0; unsigned r1 = 0, r2 = 0; float ga = 0.f, gb = 0.f, rstd_t = 0.f; const int tb = blk * 128 + 16 * C.wave;
        if (live) {
            f32x4 acc[3] = {{0.f, 0.f, 0.f, 0.f}, {0.f, 0.f, 0.f, 0.f}, {0.f, 0.f, 0.f, 0.f}};
            bf16x8 af[32];
#pragma unroll
            for (int ks = 0; ks < 32; ++ks) af[ks] = *(const bf16x8*)(H2B + (size_t)(tb + fr) * LDH + 32 * ks + 8 * fq);
#pragma unroll
            for (int ks = 0; ks < 32; ++ks) {
#pragma unroll
                for (int nt = 0; nt < 3; ++nt) { const bf16x8 bfg = *(const LAS bf16x8*)(WRL + (16 * nt + fr) * WRS + 32 * ks + 8 * fq); acc[nt] = __builtin_amdgcn_mfma_f32_16x16x32_bf16(af[ks], bfg, acc[nt], 0, 0, 0); } }
#pragma unroll
            for (int nt = 0; nt < 3; ++nt)
#pragma unroll
                for (int r = 0; r < 4; ++r) LG[(4 * fq + r) * 49 + 16 * nt + fr] = acc[nt][r];
            LDS_WAIT(); asm volatile("" ::: "memory");
            if (lane < 16) { const int t = tb + lane; const float rstd = rstd_from_ssq(SSQ2, t); rstd_t = rstd; const LAS float* lg = LG + lane * 49;
                float g[4]; int grp = 0;
#pragma unroll
                for (int i = 0; i < 4; ++i) g[i] = lg[i] * rstd + a.in[21][i];
#pragma unroll
                for (int i = 1; i < 4; ++i) if (g[i] > g[grp]) grp = i;
                float gs = 0.f;
#pragma unroll
                for (int i = 0; i < 4; ++i) gs += __expf(g[i] - g[grp]);
                const float gw_ = 1.0f / gs;
                float e[8];
#pragma unroll
                for (int i = 0; i < 8; ++i) e[i] = lg[4 + 8 * grp + i] * rstd + a.in[23][8 * grp + i];
                int i1 = 0;
#pragma unroll
                for (int i = 1; i < 8; ++i) if (e[i] > e[i1]) i1 = i;
                int i2 = (i1 == 0) ? 1 : 0;
#pragma unroll
                for (int i = 0; i < 8; ++i) if (i != i1 && i != i2 && e[i] > e[i2]) i2 = i;
                const float eb = __expf(e[i2] - e[i1]); ga = gw_ / (1.0f + eb); gb = gw_ * eb / (1.0f + eb);
                E1 = grp * 8 + i1; E2 = grp * 8 + i2;
                r1 = atomicAdd((unsigned*)&lcnt[E1], 1u); r2 = atomicAdd((unsigned*)&lcnt[E2], 1u);
            }
        }
        __syncthreads();
        if (C.tid < 32) lbase[C.tid] = lcnt[C.tid] ? __hip_atomic_fetch_add(CNT + C.tid, lcnt[C.tid], __ATOMIC_RELAXED, __HIP_MEMORY_SCOPE_AGENT) : 0u;
        __syncthreads();
        if (live && lane < 16) { const int t = tb + lane;
            const int k1 = (int)(lbase[E1] + r1), k2 = (int)(lbase[E2] + r2);
            TOKE[2 * t] = E1; TOKR[2 * t] = k1; TOKG[2 * t] = ga; LTOK[E1 * LCAP + k1] = t; LRS[E1 * LCAP + k1] = rstd_t;
            TOKE[2 * t + 1] = E2; TOKR[2 * t + 1] = k2; TOKG[2 * t + 1] = gb; LTOK[E2 * LCAP + k2] = t; LRS[E2 * LCAP + k2] = rstd_t; }
        __syncthreads();
    }
}
__device__ __forceinline__ void moe_table(const Args& a, const Ctx& C) {
    LAS int* ts = (LAS int*)(C.lds + MOE_OFF);
    if (C.tid == 0) { const unsigned* CNT = (const unsigned*)(a.ws + WS_CTL) + CW_CNT; int acc = 0;
        for (int e = 0; e < NEXP; ++e) { ts[e] = acc; const unsigned c = __hip_atomic_load(CNT + e, __ATOMIC_RELAXED, __HIP_MEMORY_SCOPE_AGENT); ts[33 + e] = (int)c; acc += (int)((c + 255u) >> 8); }
        ts[NEXP] = acc; }
    __syncthreads();
}
__device__ __forceinline__ void ph_final(const Args& a, const Ctx& C, float* outp) {
    unsigned char* ws = a.ws;
    const unsigned char* YB = ws + WS_A; const float* TOKG = (const float*)(ws + WS_TOK + TOK_G); const int* TOKE = (const int*)(ws + WS_TOK + TOK_E); const int* TOKR = (const int*)(ws + WS_TOK + TOK_R);
    const LAS int* ts = (const LAS int*)(C.lds + MOE_OFF);
    const bf16_t* H2B = (const bf16_t*)a.out + DM; const float* gf = a.in[26];
    const int gw = C.vcu * 8 + C.wave, NGW = C.G * 8, lane = C.lane;
    f32x4 gn[4];
#pragma unroll
    for (int q = 0; q < 4; ++q) gn[q] = *(const f32x4*)(gf + 512 * (q >> 1) + 8 * lane + 4 * (q & 1));
    const int nit = (NTOK + NGW - 1) / NGW;
    int dnx = 0; float gnx = 0.f;
#define FIN_IDX(ib) do { const int tt_ = gw + ((ib) + (lane >> 1)) * NGW; dnx = 0; gnx = 0.f; \
        if (lane < 8 && tt_ < NTOK) { const int e_ = TOKE[2 * tt_ + (lane & 1)]; dnx = ts[e_] * 256 + TOKR[2 * tt_ + (lane & 1)]; gnx = TOKG[2 * tt_ + (lane & 1)]; } } while (0)
    FIN_IDX(0);
    for (int ib = 0; ib < nit; ib += 4) {
        const int dcur = dnx; const float gcur = gnx;
        if (ib + 4 < nit) FIN_IDX(ib + 4);
        u32x4 hw[4][2]; u32x2 y0[4][2], y1[4][2];
#pragma unroll
        for (int j = 0; j < 4; ++j) { const int t = gw + (ib + j) * NGW; const int d0 = __builtin_amdgcn_readlane(dcur, 2 * j), d1 = __builtin_amdgcn_readlane(dcur, 2 * j + 1);
            if (t < NTOK) {
#pragma unroll
                for (int hf = 0; hf < 2; ++hf) { hw[j][hf] = *((const u32x4*)(H2B + (size_t)t * LDH + 512 * hf) + lane); y0[j][hf] = *((const u32x2*)(YB + (size_t)d0 * DM + 512 * hf) + lane); y1[j][hf] = *((const u32x2*)(YB + (size_t)d1 * DM + 512 * hf) + lane); } } }
#pragma unroll
        for (int j = 0; j < 4; ++j) { const int t = gw + (ib + j) * NGW;
            const float g0 = __builtin_bit_cast(float, __builtin_amdgcn_readlane(__builtin_bit_cast(int, gcur), 2 * j)) * (1.0f / YB_SC), g1 = __builtin_bit_cast(float, __builtin_amdgcn_readlane(__builtin_bit_cast(int, gcur), 2 * j + 1)) * (1.0f / YB_SC);
            if (t < NTOK) { float v[16]; float s2 = 0.f;
#pragma unroll
                for (int hf = 0; hf < 2; ++hf)
#pragma unroll
                    for (int w = 0; w < 2; ++w) { const int yw0 = (int)y0[j][hf][w], yw1 = (int)y1[j][hf][w];
                        const f32x2 pa = __builtin_amdgcn_cvt_pk_f32_fp8(yw0, false), pb = __builtin_amdgcn_cvt_pk_f32_fp8(yw0, true), qa = __builtin_amdgcn_cvt_pk_f32_fp8(yw1, false), qb = __builtin_amdgcn_cvt_pk_f32_fp8(yw1, true);
                        const unsigned ha = hw[j][hf][2 * w], hb = hw[j][hf][2 * w + 1];
                        const float e0 = bflo(ha) + g0 * pa[0] + g1 * qa[0], e1 = bfhi(ha) + g0 * pa[1] + g1 * qa[1], e2 = bflo(hb) + g0 * pb[0] + g1 * qb[0], e3 = bfhi(hb) + g0 * pb[1] + g1 * qb[1];
                        v[8 * hf + 4 * w] = e0; v[8 * hf + 4 * w + 1] = e1; v[8 * hf + 4 * w + 2] = e2; v[8 * hf + 4 * w + 3] = e3; s2 += (e0 * e0 + e1 * e1) + (e2 * e2 + e3 * e3); }
                const float rstd = __builtin_amdgcn_rsqf(wave_sum(s2) * (1.0f / DM) + EPS);
#pragma unroll
                for (int q = 0; q < 4; ++q) { const f32x4 o = {v[4 * q] * rstd * gn[q][0], v[4 * q + 1] * rstd * gn[q][1], v[4 * q + 2] * rstd * gn[q][2], v[4 * q + 3] * rstd * gn[q][3]};
                    *(f32x4*)(outp + (size_t)t * DM + 512 * (q >> 1) + 8 * lane + 4 * (q & 1)) = o; } } }
    }
#undef FIN_IDX
}

#include <hip/hip_bf16.h>
#include <cmath>
namespace attn_body {
using bf16=__hip_bfloat16;
using bf16x8=__attribute__((ext_vector_type(8)))short;
using s16x4=__attribute__((ext_vector_type(4)))short;
using f32x16=__attribute__((ext_vector_type(16)))float;
using u32x4=__attribute__((ext_vector_type(4)))unsigned;
using f32x4_t=__attribute__((ext_vector_type(4)))float;
constexpr int BATCH=16,NHEAD=8,SEQ=2048,D=64,DM=NHEAD*D,DMO=1024;
constexpr int NW=8,QBLK=32,QB=QBLK*NW,KVBLK=64,NQB=SEQ/QB;
constexpr int ATTN_PITCH=DM, ATTN_UNIT_ROWS=QB;
__device__ __forceinline__ int crow(int r,int hi){return (r&3)+8*(r>>2)+4*hi;}
#define SBAR() __builtin_amdgcn_sched_barrier(0)
__device__ __forceinline__ void cmask(f32x16&p0,f32x16&p1,int jb,int qrel,int hi){
  const float NEG=-INFINITY; int kb=64*jb+4*hi; asm volatile("":"+v"(kb));
  #pragma unroll
  for(int r=0;r<16;++r){int kv=kb+(r&3)+8*(r>>2); if(kv>qrel)p0[r]=NEG; if(kv+32>qrel)p1[r]=NEG;}
}

constexpr int NSLOT=3, SLOTB=8192;
constexpr int LDS_K=0, LDS_V=NSLOT*SLOTB, LDS_WS=2*NSLOT*SLOTB, LDS_OST=LDS_WS+NW*64*4, LDS_BYTES=LDS_OST+NW*4096;
constexpr float C2=0.125f*1.4426950408889634f;
__device__ __forceinline__ void glds16(const char*sbase,unsigned voff,unsigned lds_dst){unsigned keep;
  asm volatile("s_nop 4\n\ts_mov_b32 %0, m0\n\ts_mov_b32 m0, %3\n\ts_nop 0\n\tglobal_load_lds_dwordx4 %1, %2\n\ts_mov_b32 m0, %0":"=&s"(keep):"v"(voff),"s"(sbase),"s"(lds_dst):"memory");}
__device__ __forceinline__ const char* uni_ptr(const void*p){const unsigned long long v=(unsigned long long)p;const unsigned lo=__builtin_amdgcn_readfirstlane((unsigned)v),hi=__builtin_amdgcn_readfirstlane((unsigned)(v>>32));return (const char*)(((unsigned long long)hi<<32)|lo);}
__device__ __forceinline__ float max3f(float a,float b,float c){float r;asm("v_max3_f32 %0, %1, %2, %3":"=v"(r):"v"(a),"v"(b),"v"(c));return r;}
__device__ __forceinline__ float max2f(float a,float b){float r;asm("v_max_f32_e32 %0, %1, %2":"=v"(r):"v"(a),"v"(b));return r;}
__device__ __forceinline__ float fadd_s(float a,float b){float r;asm("v_add_f32_e32 %0, %1, %2":"=v"(r):"v"(a),"v"(b));return r;}
__device__ __forceinline__ float fsub_s(float a,float b){float r;asm("v_sub_f32_e32 %0, %1, %2":"=v"(r):"v"(a),"v"(b));return r;}
typedef float f32x2_t __attribute__((ext_vector_type(2))); typedef __bf16 bf16x2_t __attribute__((ext_vector_type(2)));
__device__ __forceinline__ unsigned cvtpk_s(float lo,float hi){f32x2_t v={lo,hi};bf16x2_t b=__builtin_convertvector(v,bf16x2_t);return __builtin_bit_cast(unsigned,b);}
#define WAIT_BAR(N) asm volatile("s_waitcnt vmcnt(" #N ") lgkmcnt(0)\n\ts_barrier":::"memory")

__device__ __forceinline__ void qkt(f32x16&p0,f32x16&p1,const char*Kslot,const bf16x8*qr,const f32x16&negm,int r32,int hi){
  const char*kb=Kslot+hi*1024+r32*16;
  #pragma unroll
  for(int d0=0;d0<4;++d0){
    const bf16x8 b0=*reinterpret_cast<const bf16x8*>(kb+d0*2048);
    const bf16x8 b1=*reinterpret_cast<const bf16x8*>(kb+d0*2048+512);
    if(d0==0){p0=__builtin_amdgcn_mfma_f32_32x32x16_bf16(b0,qr[0],negm,0,0,0);p1=__builtin_amdgcn_mfma_f32_32x32x16_bf16(b1,qr[0],negm,0,0,0);}
    else{p0=__builtin_amdgcn_mfma_f32_32x32x16_bf16(b0,qr[d0],p0,0,0,0);p1=__builtin_amdgcn_mfma_f32_32x32x16_bf16(b1,qr[d0],p1,0,0,0);}}
}
typedef __attribute__((address_space(3))) const char* lds_cptr;
typedef short v4i16_t __attribute__((ext_vector_type(4)));
__device__ __forceinline__ void kload8(bf16x8*kf,lds_cptr kp){
  kf[0]=*(const __attribute__((address_space(3))) bf16x8*)(kp);      kf[1]=*(const __attribute__((address_space(3))) bf16x8*)(kp+512);
  kf[2]=*(const __attribute__((address_space(3))) bf16x8*)(kp+2048); kf[3]=*(const __attribute__((address_space(3))) bf16x8*)(kp+2560);
  kf[4]=*(const __attribute__((address_space(3))) bf16x8*)(kp+4096); kf[5]=*(const __attribute__((address_space(3))) bf16x8*)(kp+4608);
  kf[6]=*(const __attribute__((address_space(3))) bf16x8*)(kp+6144); kf[7]=*(const __attribute__((address_space(3))) bf16x8*)(kp+6656);
}
__device__ __forceinline__ void kload2(bf16x8*kf,lds_cptr kp,int j){ kf[2*j]=*(const __attribute__((address_space(3))) bf16x8*)(kp+j*2048); kf[2*j+1]=*(const __attribute__((address_space(3))) bf16x8*)(kp+j*2048+512); }
__device__ __forceinline__ s16x4 vtr(lds_cptr p){ return __builtin_bit_cast(s16x4,__builtin_amdgcn_ds_read_tr16_b64_v4i16((__attribute__((address_space(3))) v4i16_t*)p)); }
__device__ __forceinline__ float rowmax(const f32x16&p0,const f32x16&p1){
  float a=max3f(p0[0],p0[1],p1[0]),b=max3f(p0[2],p0[3],p1[1]);a=max3f(a,p1[2],p1[3]);
  #pragma unroll
  for(int r=4;r<16;r+=4){a=max3f(a,p0[r],p0[r+1]);b=max3f(b,p0[r+2],p0[r+3]);a=max3f(a,p1[r],p1[r+1]);b=max3f(b,p1[r+2],p1[r+3]);}
  const float m=max2f(a,b);
  auto rr=__builtin_amdgcn_permlane32_swap(__float_as_uint(m),__float_as_uint(m),false,false);
  return max2f(__uint_as_float(rr[0]),__uint_as_float(rr[1]));
}
__device__ __forceinline__ void pv(f32x16*o,int vb,bf16x8 pa0,bf16x8 pa1,bf16x8 pa2,bf16x8 pa3){
  #pragma unroll
  for(int d0=0;d0<2;++d0){s16x4 lo[4],hi[4];
    #pragma unroll
    for(int ks=0;ks<4;++ks){
      asm volatile("ds_read_b64_tr_b16 %0,%1 offset:%c2":"=&v"(lo[ks]):"v"(vb),"i"(d0*4096+ks*1024):"memory");
      asm volatile("ds_read_b64_tr_b16 %0,%1 offset:%c2":"=&v"(hi[ks]):"v"(vb),"i"(d0*4096+ks*1024+512):"memory");}
    asm volatile("s_waitcnt lgkmcnt(0)":::"memory");SBAR();
    #define PK(k) (bf16x8){lo[k][0],lo[k][1],lo[k][2],lo[k][3],hi[k][0],hi[k][1],hi[k][2],hi[k][3]}
    o[d0]=__builtin_amdgcn_mfma_f32_32x32x16_bf16(pa0,PK(0),o[d0],0,0,0);
    o[d0]=__builtin_amdgcn_mfma_f32_32x32x16_bf16(pa1,PK(1),o[d0],0,0,0);
    o[d0]=__builtin_amdgcn_mfma_f32_32x32x16_bf16(pa2,PK(2),o[d0],0,0,0);
    o[d0]=__builtin_amdgcn_mfma_f32_32x32x16_bf16(pa3,PK(3),o[d0],0,0,0);
    #undef PK
  }
}

#ifndef ATTN_STORE16
#define ATTN_STORE16(p,v) (*(u32x4*)(p)=(v))
#endif
template<int THRL> __device__ __forceinline__ void attn_unit(int b,int h,int qb,const bf16*Q,const bf16*__restrict__ K,const bf16*__restrict__ V,bf16*O,const float*__restrict__ KSUM,float*__restrict__ SSQA,char*shm){
  int tid=threadIdx.x; asm volatile("":"+v"(tid));
  const int lane=tid&63,r32=lane&31,hi=lane>>5; const int wid=__builtin_amdgcn_readfirstlane(tid>>6);
  const long rowbase=(long)b*SEQ; const int q0=qb*QB;
  const bf16*Qw=Q+(rowbase+q0+wid*QBLK)*DM+h*D;
  const bf16*Kh=K+rowbase*DM+h*D,*Vh=V+rowbase*DM+h*D;
  const unsigned lds0=(unsigned)(uintptr_t)shm;
  float*wsf=(float*)(shm+LDS_WS)+wid*64;
  const char*Khu=uni_ptr(Kh);const char*Vhu=uni_ptr(Vh);
  const unsigned kvo=(unsigned)(lane*DM+wid*8)*2u;
  const unsigned vvo=(unsigned)((16*(wid&3)+(lane>>2))*DM+(wid>>2)*32+(lane&3)*8)*2u;
  const unsigned kdst=lds0+LDS_K+wid*1024, vdst=lds0+LDS_V+wid*1024;
  #define DMA_K(t,slot) glds16(Khu+(size_t)(t)*(KVBLK*DM*2),kvo,(unsigned)__builtin_amdgcn_readfirstlane(kdst+(slot)))
  #define DMA_V(t,slot) glds16(Vhu+(size_t)(t)*(KVBLK*DM*2),vvo,(unsigned)__builtin_amdgcn_readfirstlane(vdst+(slot)))
  const int vb0=(int)(lds0+LDS_V)+((lane>>4)&1)*32+(lane&3)*8+(4*hi+((lane&15)>>2))*64;
  const char*Kbase=shm+LDS_K; bf16x8 kf[8];
  const lds_cptr shm3=(lds_cptr)shm; const lds_cptr kp0=shm3+LDS_K+hi*1024+r32*16; const lds_cptr vp0=shm3+LDS_V+((lane>>4)&1)*32+(lane&3)*8+(4*hi+((lane&15)>>2))*64;
  const int NT=(q0+QB)/KVBLK;
  DMA_K(0,0);DMA_V(0,0);DMA_K(1,SLOTB);
  bf16x8 qr[4];
  #pragma unroll
  for(int d0=0;d0<4;++d0)qr[d0]=*reinterpret_cast<const bf16x8*>(&Qw[(long)r32*DM+d0*16+hi*8]);
  unsigned selm=1u<<qb;
  { float g[8];
    #pragma unroll
    for(int n=0;n<8;++n){ g[n]=-INFINITY;
      if(n<qb){ const float*ks=KSUM+(long)(b*8+n)*DM+h*D+hi*8; float s=0.f;
        #pragma unroll
        for(int d0=0;d0<4;++d0){ const f32x4_t k0=*reinterpret_cast<const f32x4_t*>(ks+d0*16), k1=*reinterpret_cast<const f32x4_t*>(ks+d0*16+4);
          const u32x4 qw=__builtin_bit_cast(u32x4,qr[d0]);
          s+=__uint_as_float(qw[0]<<16)*k0[0]+__uint_as_float(qw[0]&0xffff0000u)*k0[1]+__uint_as_float(qw[1]<<16)*k0[2]+__uint_as_float(qw[1]&0xffff0000u)*k0[3]
            +__uint_as_float(qw[2]<<16)*k1[0]+__uint_as_float(qw[2]&0xffff0000u)*k1[1]+__uint_as_float(qw[3]<<16)*k1[2]+__uint_as_float(qw[3]&0xffff0000u)*k1[3]; }
        s+=__shfl_xor(s,32); g[n]=s; } }
    const int npick=qb<3?qb:3;
    for(int p=0;p<npick;++p){ int best=-1; float bv=-INFINITY;
      #pragma unroll
      for(int n=0;n<8;++n){ const bool ok=(n<qb)&&!((selm>>n)&1u)&&(best<0||g[n]>bv); if(ok){best=n;bv=g[n];} }
      if(best>=0)selm|=1u<<best; } }
  #define BMASK(P0,P1,t) do{ float bias_=((selm>>((t)>>2))&1u)?-mhat:-INFINITY; asm volatile("":"+v"(bias_)); _Pragma("unroll") for(int r=0;r<16;++r){P0[r]+=bias_;P1[r]+=bias_;} }while(0)
  float mhat=0.f,l_reg=0.f;f32x16 o[2];{float z0_=0.f;asm volatile("":"+v"(z0_));_Pragma("unroll") for(int r=0;r<16;++r){o[0][r]=z0_;o[1][r]=z0_;}}const f32x16 negm=f32x16{};
  const int qrel=wid*QBLK+r32;
  #define CMASK(P0,P1,t) do{int jb_=(t)-(NT-4); if(jb_>=0)cmask(P0,P1,jb_,qrel,hi);}while(0)
  bool resc=false;
  #define START(P0,P1) do{ const float rm=__builtin_fmaxf(rowmax(P0,P1),-100.0f); resc=false; \
    { const float dl=rm; mhat=fadd_s(mhat,dl); \
      _Pragma("unroll") for(int r=0;r<16;++r){P0[r]=fsub_s(P0[r],dl);P1[r]=fsub_s(P1[r],dl);} \
      } \
    _Pragma("unroll") for(int r=0;r<16;++r)P0[r]=__builtin_amdgcn_exp2f(P0[r]); }while(0)
  #define RESC() do{ if(resc){ asm volatile("s_waitcnt lgkmcnt(0)":::"memory"); \
      _Pragma("unroll") for(int d_=0;d_<2;++d_) _Pragma("unroll") for(int r=0;r<16;++r)o[d_][r]*=wsf[crow(r,hi)]; } }while(0)
  f32x16 pA0,pA1,pB0,pB1;
  int sl_prev=0,sl_cur=0,sl_next=SLOTB;
  #define ROT() do{sl_prev=sl_cur;sl_cur=sl_next;sl_next=(sl_next==(NSLOT-1)*SLOTB)?0:sl_next+SLOTB;}while(0)
  DMA_K(2,2*SLOTB);
  WAIT_BAR(3);
  qkt(pA0,pA1,Kbase,qr,negm,r32,hi);asm volatile("s_nop 15\n\ts_nop 7":"+v"(pA0),"+v"(pA1));CMASK(pA0,pA1,0);BMASK(pA0,pA1,0);
  START(pA0,pA1);
  _Pragma("unroll") for(int r=0;r<16;++r)pA1[r]=__builtin_amdgcn_exp2f(pA1[r]);
  WAIT_BAR(0);
  DMA_K(3,0);DMA_V(1,SLOTB);
  ROT();
  kload8(kf,kp0+sl_cur);
  WAIT_BAR(2);
  s16x4 vlo[8],vhi[8]; u32x4 pw0,pw1,pw2,pw3;
  #define PKW(P,B) cvtpk_s(P[B],P[B+1])
  #define PAF(k) __builtin_bit_cast(bf16x8,pw##k)
  #define VFR(i) (bf16x8){vlo[i][0],vlo[i][1],vlo[i][2],vlo[i][3],vhi[i][0],vhi[i][1],vhi[i][2],vhi[i][3]}
  #define PIN(x) asm volatile("":"+v"(x))
  #define MX3(a,b,c) __builtin_fmaxf(__builtin_fmaxf((a),(b)),(c))
  #define GAPA(MF,A0,A1,A2,A3,W0,W1,PW) do{ MF; sacc+=A0; sacc+=A1; sacc+=A2; sacc+=A3; PIN(sacc); W0; W1; PIN(PW); SBAR(); }while(0)
  #define EX(v) __builtin_amdgcn_exp2f(v)
  #define GAPB(MF,X,B) do{ MF; X[B]=EX(X[B]); X[B+1]=EX(X[B+1]); X[B+2]=EX(X[B+2]); X[B+3]=EX(X[B+3]); PIN(X); SBAR(); }while(0)
  #define VRD(i) do{ vlo[i]=vtr(vp_+(((i)>>2)*4096+((i)&3)*1024)); vhi[i]=vtr(vp_+(((i)>>2)*4096+((i)&3)*1024+512)); }while(0)
  #define KRD(G,j) do{ if(G){ kload2(kf,kp0+sl_next,j); SBAR(); } }while(0)
  #define STEP(C0,C1,P0,P1,t,GK,GV,GL) do{ SBAR(); \
    const lds_cptr vp_=vp0+sl_prev; \
    VRD(0); SBAR(); float sacc=(P0[0]+P0[1]); \
    GAPA(C0=__builtin_amdgcn_mfma_f32_32x32x16_bf16(kf[0],qr[0],negm,0,0,0), P0[2],P0[3],P0[4],P0[5],     pw0[0]=PKW(P0,0), pw0[1]=PKW(P0,2), pw0); \
    VRD(4); SBAR(); GAPA(C1=__builtin_amdgcn_mfma_f32_32x32x16_bf16(kf[1],qr[0],negm,0,0,0), P0[6],P0[7],P0[8],P0[9],     pw0[2]=PKW(P0,4), pw0[3]=PKW(P0,6), pw0); \
    VRD(1); SBAR(); GAPA(C0=__builtin_amdgcn_mfma_f32_32x32x16_bf16(kf[2],qr[1],C0,0,0,0),   P0[10],P0[11],P0[12],P0[13], pw1[0]=PKW(P0,8), pw1[1]=PKW(P0,10), pw1); \
    VRD(5); SBAR(); GAPA(C1=__builtin_amdgcn_mfma_f32_32x32x16_bf16(kf[3],qr[1],C1,0,0,0),   P0[14],P0[15],P1[0],P1[1],   pw1[2]=PKW(P0,12),pw1[3]=PKW(P0,14), pw1); \
    VRD(2); SBAR(); GAPA(C0=__builtin_amdgcn_mfma_f32_32x32x16_bf16(kf[4],qr[2],C0,0,0,0),   P1[2],P1[3],P1[4],P1[5],     pw2[0]=PKW(P1,0), pw2[1]=PKW(P1,2), pw2); \
    VRD(6); SBAR(); GAPA(C1=__builtin_amdgcn_mfma_f32_32x32x16_bf16(kf[5],qr[2],C1,0,0,0),   P1[6],P1[7],P1[8],P1[9],     pw2[2]=PKW(P1,4), pw2[3]=PKW(P1,6), pw2); \
    VRD(3); SBAR(); GAPA(C0=__builtin_amdgcn_mfma_f32_32x32x16_bf16(kf[6],qr[3],C0,0,0,0),   P1[10],P1[11],P1[12],P1[13], pw3[0]=PKW(P1,8), pw3[1]=PKW(P1,10), pw3); \
    VRD(7); SBAR(); GAPA(C1=__builtin_amdgcn_mfma_f32_32x32x16_bf16(kf[7],qr[3],C1,0,0,0),   P1[14],P1[15],0.f,0.f,       pw3[2]=PKW(P1,12),pw3[3]=PKW(P1,14), pw3); \
    l_reg+=sacc; \
    if(GK){DMA_K((t)+3,sl_cur);} if(GV){DMA_V((t)+1,sl_next);} \
    CMASK(C0,C1,t); BMASK(C0,C1,t); \
    { float a=MX3(C0[0],C0[1],C1[0]),b=MX3(C0[2],C0[3],C1[1]); a=MX3(a,C1[2],C1[3]); \
      _Pragma("unroll") for(int r=4;r<16;r+=4){a=MX3(a,C0[r],C0[r+1]);b=MX3(b,C0[r+2],C0[r+3]);a=MX3(a,C1[r],C1[r+1]);b=MX3(b,C1[r+2],C1[r+3]);} \
      float rm=__builtin_fmaxf(a,b); { auto rr=__builtin_amdgcn_permlane32_swap(__float_as_uint(rm),__float_as_uint(rm),false,false); rm=__builtin_fmaxf(__uint_as_float(rr[0]),__uint_as_float(rr[1])); } \
      resc=false; \
      if(__builtin_expect(__any(rm>(float)THRL),0)){ const float dl=__builtin_fmaxf(rm,0.f); mhat+=dl; \
        _Pragma("unroll") for(int r=0;r<16;++r){C0[r]-=dl;C1[r]-=dl;} \
        const float f=__builtin_amdgcn_exp2f(-dl); l_reg*=f; if(hi==0)wsf[r32]=f; resc=true; } } \
    SBAR(); \
    GAPB(o[0]=__builtin_amdgcn_mfma_f32_32x32x16_bf16(PAF(0),VFR(0),o[0],0,0,0), C0,0); \
    GAPB(o[1]=__builtin_amdgcn_mfma_f32_32x32x16_bf16(PAF(0),VFR(4),o[1],0,0,0), C0,4); \
    KRD(GL,0); GAPB(o[0]=__builtin_amdgcn_mfma_f32_32x32x16_bf16(PAF(1),VFR(1),o[0],0,0,0), C0,8); \
    KRD(GL,1); GAPB(o[1]=__builtin_amdgcn_mfma_f32_32x32x16_bf16(PAF(1),VFR(5),o[1],0,0,0), C0,12); \
    KRD(GL,2); GAPB(o[0]=__builtin_amdgcn_mfma_f32_32x32x16_bf16(PAF(2),VFR(2),o[0],0,0,0), C1,0); \
    KRD(GL,3); GAPB(o[1]=__builtin_amdgcn_mfma_f32_32x32x16_bf16(PAF(2),VFR(6),o[1],0,0,0), C1,4); \
    GAPB(o[0]=__builtin_amdgcn_mfma_f32_32x32x16_bf16(PAF(3),VFR(3),o[0],0,0,0), C1,8); \
    GAPB(o[1]=__builtin_amdgcn_mfma_f32_32x32x16_bf16(PAF(3),VFR(7),o[1],0,0,0), C1,12); \
    }while(0)
  int t=1;
  #undef CMASK
  #define CMASK(P0,P1,t) do{}while(0)
  for(;t+5<NT;t+=2){
    STEP(pB0,pB1,pA0,pA1,t,true,true,true);     WAIT_BAR(2); RESC(); ROT();
    STEP(pA0,pA1,pB0,pB1,t+1,true,true,true);   WAIT_BAR(2); RESC(); ROT();
  }
  #undef CMASK
  #define CMASK(P0,P1,t) do{int jb_=(t)-(NT-4); if(jb_>=0)cmask(P0,P1,jb_,qrel,hi);}while(0)
  #define ENDW(tt) do{ if((tt)+3<NT){WAIT_BAR(2);} else if((tt)+2<NT){WAIT_BAR(1);} else {WAIT_BAR(0);} }while(0)
  for(;t+1<NT;t+=2){
    STEP(pB0,pB1,pA0,pA1,t,(t+3<NT),(t+1<NT),(t+1<NT));       ENDW(t);   RESC(); ROT();
    STEP(pA0,pA1,pB0,pB1,t+1,(t+4<NT),(t+2<NT),(t+2<NT));     ENDW(t+1); RESC(); ROT();
  }
  STEP(pB0,pB1,pA0,pA1,NT-1,false,false,false); RESC();
  { float sacc=pB0[0]+pB0[1]; _Pragma("unroll") for(int r=2;r<16;++r)sacc+=pB0[r]; _Pragma("unroll") for(int r=0;r<16;++r)sacc+=pB1[r]; l_reg+=sacc;
    pw0=(u32x4){PKW(pB0,0),PKW(pB0,2),PKW(pB0,4),PKW(pB0,6)};pw1=(u32x4){PKW(pB0,8),PKW(pB0,10),PKW(pB0,12),PKW(pB0,14)};pw2=(u32x4){PKW(pB1,0),PKW(pB1,2),PKW(pB1,4),PKW(pB1,6)};pw3=(u32x4){PKW(pB1,8),PKW(pB1,10),PKW(pB1,12),PKW(pB1,14)};
    SBAR(); pv(o,vb0+sl_cur,PAF(0),PAF(1),PAF(2),PAF(3)); }
  #undef PKW
  #undef PAF
  #undef VFR
  #undef PIN
  #undef MX3
  #undef GAPA
  #undef GAPB
  #undef EX
  #undef VRD
  #undef KRD
  #undef STEP
  #undef ENDW
  {auto rr=__builtin_amdgcn_permlane32_swap(__float_as_uint(l_reg),__float_as_uint(l_reg),false,false);l_reg=__uint_as_float(rr[0])+__uint_as_float(rr[1]);}
  if(hi==0)wsf[32+r32]=l_reg;asm volatile("s_waitcnt lgkmcnt(0)":::"memory");
  float rli[16];
  #pragma unroll
  for(int r=0;r<16;++r)rli[r]=__builtin_amdgcn_rcpf(wsf[32+crow(r,hi)]);
  bf16*Ow=O+(rowbase+q0+wid*QBLK)*DMO+h*D;
  { bf16*stg=(bf16*)(shm+LDS_OST)+wid*2048;
    #pragma unroll
    for(int r=0;r<16;++r){const int orow=crow(r,hi);
      #pragma unroll
      for(int d0=0;d0<2;++d0)stg[orow*64+d0*32+r32]=__float2bfloat16(o[d0][r]*rli[r]);}
    asm volatile("s_waitcnt lgkmcnt(0)":::"memory");
    #pragma unroll
    for(int i=0;i<4;++i){const int row=i*8+(lane>>3),ch=lane&7; const u32x4 v=*(const u32x4*)(stg+row*64+ch*8); ATTN_STORE16(Ow+(long)row*DMO+ch*8,v);
      float q=0.f;
      #pragma unroll
      for(int e=0;e<4;++e){const float lo=__uint_as_float(v[e]<<16),hi2=__uint_as_float(v[e]&0xffff0000u);q+=lo*lo+hi2*hi2;}
      q+=__shfl_xor(q,1);q+=__shfl_xor(q,2);q+=__shfl_xor(q,4);
      if(ch==0)SSQA[(rowbase+q0+wid*QBLK+row)*8+h]=q;} }
  asm volatile("s_waitcnt lgkmcnt(0)\n\ts_barrier":::"memory");
  #undef BMASK
  #undef DMA_K
  #undef DMA_V
  #undef CMASK
  #undef START
  #undef RESC
  #undef ROT
}
constexpr int ATTN_LDS_BYTES=LDS_BYTES;
#undef SBAR
#undef WAIT_BAR
}

__global__ void __launch_bounds__(512, 2) mk_fwd(Args args) {
    extern __shared__ __attribute__((aligned(16))) unsigned char lds_raw[];
    Ctx C; C.lds = (LAS unsigned char*)lds_raw; C.tid = threadIdx.x; C.lane = C.tid & 63; C.wave = __builtin_amdgcn_readfirstlane(C.tid >> 6);
    C.G = gridDim.x; { const int bx = blockIdx.x; C.vcu = (C.G % 8 == 0) ? (bx % 8) * (C.G / 8) + bx / 8 : bx; }
    unsigned char* ws = args.ws;
    for (int u = C.tid; u < (LDS_BYTES - LDSCTL_OFF) / 4; u += 512) ((LAS unsigned*)(C.lds + LDSCTL_OFF))[u] = 0u;
    __syncthreads();
    XcdBarrier bar; bar.bar = (unsigned*)(ws + WS_CTL) + CW_BAR; bar.x = 0; bar.st = nullptr;
    if (N_LAUNCHES == 1) bar = xcd_barrier_post((unsigned*)(ws + WS_CTL) + CW_BAR, (volatile LAS unsigned*)(C.lds + MISC_OFF) + 8);
    const int lo = args.ph_lo, hi = args.ph_hi;
#define IN(k) (lo <= (k) && (k) < hi)
#define FRESH() do { int t_ = threadIdx.x; asm volatile("" : "+v"(t_)); C.tid = t_; C.lane = t_ & 63; C.wave = __builtin_amdgcn_readfirstlane(t_ >> 6); } while (0)
#define SEAM(k) do { if (IN(k) && IN((k) + 1)) xcd_barrier(bar); } while (0)
    const int cb = (int)blockIdx.x;

    if (IN(0)) { FRESH(); ph_prologue(args, C); SEAM(0); }
    if (IN(1)) {
        { Gemm g{(const bf16_t*)(ws + WS_B), (const bf16_t*)(ws + WS_WIN), DM, DM, DM}; PlainOrder S; S.init(NTOK, DIN, C.G, cb, DM, DM);
          EpiProj E{(bf16_t*)(ws + WS_A), (const float*)(ws + WS_ROPE), (float*)(ws + WS_KSUM)}; GEMM_PHASE(C.lds, g, S, E); }
        { Gemm g{(const bf16_t*)(ws + WS_MEMN), (const bf16_t*)(ws + WS_WXK), DM, DM, DM}; PlainOrder S; S.init(NMEM, DM, C.G, cb, DM, DM);
          EpiStore E{(bf16_t*)(ws + WS_KM), DM}; GEMM_PHASE(C.lds, g, S, E); }
        { Gemm g{(const bf16_t*)(ws + WS_MEMN), (const bf16_t*)(ws + WS_WXV), DM, DM, DM}; PlainOrder S; S.init(NMEM, DM, C.G, (cb + C.G - 64 % C.G) % C.G, DM, DM);
          EpiStore E{(bf16_t*)(ws + WS_VMT), DM}; GEMM_PHASE(C.lds, g, S, E); }
        { FRESH(); if (C.G == 256) { if (cb >= 128) conv_wdn(args, C, (cb - 128) * 8 + C.wave, 128 * 8, 0, WDN_SPLIT); }
          else conv_wdn(args, C, C.vcu * 8 + C.wave, C.G * 8, 0, WDN_SPLIT); }
        SEAM(1);
    }
    if (IN(2)) { FRESH();
        for (int i = 0;; ++i) { const int aidx = i * C.G + C.vcu; if (aidx >= 1024) break; const int cc = aidx & 255, ii = aidx >> 8, bh = cc >> 1;
            const int qb = (cc & 1) ? ((ii == 0) ? 6 : (ii == 1) ? 1 : (ii == 2) ? 5 : 2) : ((ii == 0) ? 7 : (ii == 1) ? 0 : (ii == 2) ? 4 : 3);
            { const attn_body::bf16* Qp = (const attn_body::bf16*)(ws + WS_A) + (size_t)2 * NTOK * 512;
              attn_body::attn_unit<8>(bh >> 3, bh & 7, qb, Qp, Qp + (size_t)NTOK * 512, Qp + (size_t)2 * NTOK * 512, (attn_body::bf16*)(ws + WS_C) + 512, (const float*)(ws + WS_KSUM), (float*)(ws + WS_SSQA), (char*)lds_raw); } }
        FRESH();
        for (int L = C.vcu; L < 256; L += C.G) lru_unit(args, C, L >> 4, (L >> 1) & 7, L & 1, L);
        SEAM(2);
    }
    if (IN(4)) { Gemm g{(const bf16_t*)(ws + WS_C), (const bf16_t*)(ws + WS_WOUT), DM, DM, DM}; PlainOrder S; S.init(NTOK, DM, C.G, cb, DM, DM);
        EpiResid<true, true> E{(const bf16_t*)(ws + WS_B), (bf16_t*)args.out, (float*)(ws + WS_SSQ1), (const float*)(ws + WS_SSQL), (const float*)(ws + WS_SSQA), ws + WS_A + 64 * MiB, 1.0f, (const float*)(ws + WS_TOK + TOK_D), args.in[2]};     GEMM_PHASE(C.lds, g, S, E);
        { Gemm g2{(const bf16_t*)ws, (const bf16_t*)ws, DM, DM, XHD}; XpreOrder S2{C.G, cb}; EpiStore8x E2{ws + WS_A, ws + WS_A + 32 * MiB, QKT_SC, VWT_SC}; GEMM_PHASE(C.lds, g2, S2, E2); }
        SEAM(4); }
    if (IN(5)) { Gemm g{(const bf16_t*)(ws + WS_A + 64 * MiB), (const bf16_t*)(ws + WS_A), DM / 2, DM / 2, DM / 2}; XattnOrder S{C.G, cb, 0, DM / 2, DM / 2};
        EpiSoftmax E{ws + WS_A + 96 * MiB, DM, C.lds + LDSCTL_OFF + 4096, (const float*)(ws + WS_SSQ1), XSCALE / QKT_SC}; GEMM_PHASE8N(C.lds, g, S, E); SEAM(5); }
    if (IN(8)) { Gemm g{(const bf16_t*)(ws + WS_A + 96 * MiB), (const bf16_t*)(ws + WS_A + 32 * MiB), DM / 2, DM / 2, DM / 2}; XattnOrder S{C.G, cb, 1, DM / 2, DM / 2};
        EpiResid<false, false> E{(const bf16_t*)args.out, (bf16_t*)args.out + DM, (float*)(ws + WS_SSQ2), nullptr, nullptr, ws + WS_H2F8, 1.0f / (PX_SC * VWT_SC)}; GEMM_PHASE8(C.lds, g, S, E); SEAM(8); }
    if (IN(9)) { FRESH(); ph_router(args, C); SEAM(9); }
    if (IN(11)) { FRESH(); moe_table(args, C); Gemm g{(const bf16_t*)(ws + WS_H2F8), (const bf16_t*)(ws + WS_WGU), DM / 2, DM / 2, DM / 2};
        MoeOrder<true> S{(const LAS int*)(C.lds + MOE_OFF), C.G, cb, DM / 2, DM / 2, (const int*)(ws + WS_LTOK), (unsigned)DM};
        EpiGateUp E{ws + WS_B, (const float*)(ws + WS_LRS)}; GEMM_PHASE8(C.lds, g, S, E); SEAM(11); }
    if (IN(12)) { FRESH(); moe_table(args, C); Gemm g{(const bf16_t*)(ws + WS_B), (const bf16_t*)(ws + WS_WDN), DFF / 2, DFF / 2, DFF / 2};
        MoeOrder<false> S{(const LAS int*)(C.lds + MOE_OFF), C.G, cb, DFF / 2, DFF / 2, nullptr, 0u};
        EpiStore8 E{ws + WS_A, DM, YB_SC / (WDN_SC * ACT_SC)}; GEMM_PHASE8(C.lds, g, S, E); SEAM(12); }
    if (IN(13)) { FRESH(); moe_table(args, C); ph_final(args, C, args.out); }
#undef IN
#undef FRESH
#undef SEAM
}

extern "C" void kernel_launch(void* const* d_in, const int* in_sizes, int n_in, void* d_out, int out_size, void* d_ws, size_t ws_size, hipStream_t stream) {
    static int grid = 0;
    if (grid == 0) {
        if (n_in != 27 || out_size != NTOK * DM || ws_size < WS_END) { fprintf(stderr, "kernel_launch: unexpected shapes (n_in %d out %d ws %zu)\n", n_in, out_size, ws_size); grid = -1; return; }
        int dev = 0, cus = 0, per_cu = 0;
        if (hipGetDevice(&dev) != hipSuccess || hipDeviceGetAttribute(&cus, hipDeviceAttributeMultiprocessorCount, dev) != hipSuccess) { grid = -1; return; }
        if (hipFuncSetAttribute((const void*)mk_fwd, hipFuncAttributeMaxDynamicSharedMemorySize, LDS_BYTES) != hipSuccess) { fprintf(stderr, "kernel_launch: hipFuncSetAttribute failed\n"); grid = -1; return; }
        if (hipOccupancyMaxActiveBlocksPerMultiprocessor(&per_cu, (const void*)mk_fwd, 512, LDS_BYTES) != hipSuccess || per_cu < 1) fprintf(stderr, "kernel_launch: occupancy query reports %d\n", per_cu);
        (void)hipGetLastError();
        grid = cus;
    }
    if (grid < 0) return;
    (void)hipMemsetAsync((char*)d_ws + WS_CTL, 0, CTL_ZERO_BYTES, stream);
    Args a{};
    for (int i = 0; i < 27; ++i) a.in[i] = (const float*)d_in[i];
    a.out = (float*)d_out; a.ws = (unsigned char*)d_ws;
    const float invf[8] = {1.0f, 0.1939227432012558f, 0.03760603070259094f, 0.007292664609849453f, 0.0014142135623842478f, 0.00027424818836152554f, 5.318296098266728e-05f, 1.0313386155758053e-05f};
    for (int i = 0; i < 8; ++i) a.invf[i] = invf[i];
    if (N_LAUNCHES == 1) { a.ph_lo = 0; a.ph_hi = N_PHASES; hipLaunchKernelGGL(mk_fwd, dim3(grid), dim3(512), LDS_BYTES, stream, a); }
    else for (int p = 0; p < N_PHASES; ++p) { a.ph_lo = p; a.ph_hi = p + 1; hipLaunchKernelGGL(mk_fwd, dim3(grid), dim3(512), LDS_BYTES, stream, a); }
}
```

```cpp
#include <hip/hip_runtime.h>
#include <cstdio>
#include <cstdint>

#define LAS __attribute__((address_space(3)))
#define GAS __attribute__((address_space(1)))
typedef unsigned short bf16_t;
typedef short bf16x8 __attribute__((ext_vector_type(8)));
typedef float f32x4 __attribute__((ext_vector_type(4)));
typedef float f32x2 __attribute__((ext_vector_type(2)));
typedef unsigned u32x4 __attribute__((ext_vector_type(4)));
typedef unsigned u32x2 __attribute__((ext_vector_type(2)));

#ifndef MK_N_LAUNCHES
#define MK_N_LAUNCHES 1
#endif
constexpr int N_PHASES = 14;
constexpr int N_LAUNCHES = MK_N_LAUNCHES;

constexpr int BATCH = 16, SEQ = 2048, DM = 1024, NTOK = BATCH * SEQ;
constexpr int DLRU = 512, DATT = 512, DIN = 2560, NHEAD = 8, HD = 64, NBLK = 8, MBLK = 256;
constexpr int MEMLEN = 256, NXH = 4, XHD = 256, NMEM = BATCH * MEMLEN;
constexpr int NEXP = 32, EPG = 8, NGRP = 4, DFF = 512;
constexpr float EPS = 1e-6f;
constexpr float KV_SC = 64.0f;
constexpr float QKT_SC = 8.0f, VWT_SC = 8.0f, PX_SC = 256.0f;
constexpr float WGU_SC = 64.0f, WDN_SC = 32.0f, ACT_SC = 16.0f, YB_SC = 16.0f;
constexpr int WDN_SPLIT = 3072;
constexpr int MAXTILES = 288, LCAP = 65536, LDH = 2048;
constexpr float QSCALE = 0.125f * 1.4426950408889634f;
constexpr float XSCALE = 0.0625f * 1.4426950408889634f;

constexpr size_t MiB = 1u << 20;
constexpr size_t WS_CTL = 0, CTL_ZERO_BYTES = 1 * MiB;
constexpr int CW_TMO = 0, CW_BAR = 4096, CW_CNT = 8192;
constexpr size_t WS_KSUM = 512 * 1024;
constexpr size_t WS_WIN = 2 * MiB, WS_WXK = 7 * MiB, WS_WXV = 9 * MiB, WS_WOUT = 11 * MiB, WS_WXQ = 13 * MiB, WS_WXO = 15 * MiB;
constexpr size_t WS_WR = 17 * MiB, WS_ROPE = 18 * MiB, WS_SSQ1 = 19 * MiB, WS_SSQ2 = 21 * MiB, WS_TOK = 23 * MiB, WS_RSC = 24 * MiB;
constexpr size_t WS_MEMN = 25 * MiB, WS_KM = 33 * MiB, WS_VMT = 41 * MiB, WS_WGU = 49 * MiB, WS_WDN = 113 * MiB;
constexpr size_t WS_A = 145 * MiB, WS_B = 305 * MiB, WS_C = 385 * MiB, WS_SSQL = 449 * MiB, WS_SSQA = 451 * MiB, WS_LTOK = 452 * MiB, WS_LRS = 460 * MiB, WS_H2F8 = 468 * MiB, WS_END = 500 * MiB;
constexpr size_t TOK_E = 0, TOK_R = 256 * 1024, TOK_G = 512 * 1024, TOK_D = 768 * 1024;

constexpr int RING_BYTES = 131072;
constexpr int LDSCTL_OFF = RING_BYTES, MISC_OFF = LDSCTL_OFF + 320, MOE_OFF = LDSCTL_OFF + 1024;
constexpr int LDS_BYTES = 147456;

__device__ __forceinline__ unsigned cvt_pk_bf16(float lo, float hi) { unsigned r; asm volatile("v_cvt_pk_bf16_f32 %0, %1, %2" : "=v"(r) : "v"(lo), "v"(hi)); return r; }
__device__ __forceinline__ float bflo(unsigned w) { return __uint_as_float(w << 16); }
__device__ __forceinline__ float bfhi(unsigned w) { return __uint_as_float(w & 0xffff0000u); }
__device__ __forceinline__ float bf2f(bf16_t b) { return __uint_as_float((unsigned)b << 16); }
__device__ __forceinline__ float wave_sum(float v) {
#pragma unroll
    for (int o = 1; o < 64; o <<= 1) v += __shfl_xor(v, o);
    return v;
}
#define LDS_WAIT() asm volatile("s_waitcnt lgkmcnt(0)" ::: "memory")
__device__ __forceinline__ float sigmoidf_(float x) { return __builtin_amdgcn_rcpf(1.0f + __builtin_amdgcn_exp2f(x * -1.4426950408889634f)); }

#define XB_TMO      128
#define XB_XCNT(j)  (256  + 64 * (j))
#define XB_XSUB(j)  (1280 + 64 * (j))
#define XB_XGEN(j)  (2304 + 64 * (j))
#define XB_TOP      3328
#define XB_TOPGEN   3392
#define XCD_BAR_WORDS 3456
#define XB_SPIN_CAP (1u << 18)
__device__ __forceinline__ unsigned xb_ld(unsigned* p)              { return __hip_atomic_load(p, __ATOMIC_RELAXED, __HIP_MEMORY_SCOPE_AGENT); }
__device__ __forceinline__ unsigned xb_add(unsigned* p, unsigned v) { return __hip_atomic_fetch_add(p, v, __ATOMIC_RELAXED, __HIP_MEMORY_SCOPE_AGENT); }
__device__ __forceinline__ unsigned xb_xcc_id() { return (unsigned)__builtin_amdgcn_s_getreg((3 << 11) | 20) & 0xFu; }
#define XB_SPIN(cond, bar) do { unsigned _sp = 0; while (cond) { __builtin_amdgcn_s_sleep(1); \
    if ((++_sp & 255u) == 0u) { if (xb_ld(&(bar)[XB_TMO])) break; if (_sp > XB_SPIN_CAP) { atomicAdd(&(bar)[XB_TMO], 1u); break; } } } } while (0)
struct XcdBarrier { unsigned* bar; unsigned x; volatile LAS unsigned* st; };
__device__ __forceinline__ XcdBarrier xcd_barrier_post(unsigned* bar, volatile LAS unsigned* st) {
    XcdBarrier b; b.bar = bar; b.x = xb_xcc_id(); b.st = st;
    if (threadIdx.x == 0) (void)xb_add(&bar[XB_XCNT(b.x)], 1u);
    return b;
}
__device__ __forceinline__ void xcd_barrier_complete(unsigned* bar, unsigned x, unsigned& nloc, unsigned& nx) {
    const unsigned G = gridDim.x * gridDim.y * gridDim.z;
    unsigned sum, cnt, mine, sp = 0u;
    for (;;) {
        sum = 0u; cnt = 0u; mine = 0u;
#pragma unroll
        for (unsigned j = 0; j < 16; ++j) { const unsigned c = xb_ld(&bar[XB_XCNT(j)]); sum += c; cnt += (c > 0u) ? 1u : 0u; mine = (j == x) ? c : mine; }
        if (sum == G) break;
        __builtin_amdgcn_s_sleep(1);
        if ((++sp & 255u) == 0u) { if (xb_ld(&bar[XB_TMO])) break; if (sp > XB_SPIN_CAP) { atomicAdd(&bar[XB_TMO], 1u); break; } }
    }
    nloc = mine > 0u ? mine : 1u; nx = cnt > 0u ? cnt : 1u;
}
__device__ __forceinline__ void xcd_barrier(const XcdBarrier& b) {
    asm volatile("s_waitcnt vmcnt(0)" ::: "memory");
    __syncthreads();
    if (threadIdx.x == 0) {
        unsigned* bar = b.bar;
        __builtin_amdgcn_s_waitcnt(0);
        unsigned nloc = b.st[0], nx = b.st[1];
        if (nloc == 0u) { xcd_barrier_complete(bar, b.x, nloc, nx); b.st[0] = nloc; b.st[1] = nx; }
        const unsigned old = xb_add(&bar[XB_XSUB(b.x)], 1u);
        const unsigned gen = old / nloc;
        if (old + 1u == (gen + 1u) * nloc) {
            __builtin_amdgcn_fence(__ATOMIC_RELEASE, "agent");
            asm volatile("s_waitcnt vmcnt(0)" ::: "memory");
            const unsigned og = xb_add(&bar[XB_TOP], 1u);
            const unsigned tg = og / nx;
            if (og + 1u == (tg + 1u) * nx) xb_add(&bar[XB_TOPGEN], 1u);
            else XB_SPIN(xb_ld(&bar[XB_TOPGEN]) == tg, bar);
            __builtin_amdgcn_fence(__ATOMIC_ACQUIRE, "agent");
            xb_add(&bar[XB_XGEN(b.x)], 1u);
            asm volatile("s_waitcnt vmcnt(0)" ::: "memory");
        } else {
            XB_SPIN(xb_ld(&bar[XB_XGEN(b.x)]) == gen, bar);
            __builtin_amdgcn_fence(__ATOMIC_ACQUIRE, "agent");
            asm volatile("s_waitcnt vmcnt(0)" ::: "memory");
        }
    }
    __syncthreads();
}

struct Unit { int pm, pn; size_t a_off, b_off; int lbase, nvalid; };
struct Gemm { const bf16_t* A; const bf16_t* Bt; int lda, ldb, K; };
__host__ __device__ __forceinline__ int perm32(int rho) { const int n = rho >> 4, i = rho & 15; return 8 * (i >> 2) + 4 * n + (i & 3); }

struct PlainOrder {     static constexpr bool GATHER = false;
    int nM, nN, nwg, G, c, lda, ldb;
    __device__ void init(int M, int N, int G_, int c_, int lda_, int ldb_) { nM = M / 256; nN = N / 256; nwg = nM * nN; G = G_; c = c_; lda = lda_; ldb = ldb_; }
    __device__ bool next(int i, Unit& u) const {
        const long L = (long)i * G + c; if (L >= nwg) return false;
        int wgid = (int)L; { const int q = nwg / 8, r = nwg % 8, xcd = wgid % 8, off = wgid / 8; wgid = (xcd < r ? xcd * (q + 1) : r * (q + 1) + (xcd - r) * q) + off; }
        const int nig = 8 * nN, gid = wgid / nig, fm = gid * 8, gsz = (nM - fm) < 8 ? (nM - fm) : 8;
        u.pm = fm + ((wgid % nig) % gsz); u.pn = (wgid % nig) / gsz;
        u.a_off = (size_t)u.pm * 256 * lda; u.b_off = (size_t)u.pn * 256 * ldb; return true;
    }
};
struct XpreOrder {
    static constexpr bool GATHER = false, HOOKS = false;
    int G, c;
    __device__ bool next(int i, Unit& u) const {
        const int L = i * G + c; if (L >= 512) return false;
        const int mode = L >> 8, l = L & 255, b = l >> 4, x = (l >> 2) & 3, y = l & 3;
        if (mode == 0) { const int h = x, kt = y; u.pm = b * 4 + h; u.pn = kt; u.a_off = WS_KM / 2 + (size_t)b * MEMLEN * DM + h * XHD; u.b_off = WS_WXQ / 2 + (size_t)kt * 256 * DM + h * XHD; }
        else { const int nt = x, h = y; u.pm = b * 4 + nt; u.pn = h; u.a_off = WS_WXO / 2 + (size_t)nt * 256 * DM + h * XHD; u.b_off = WS_VMT / 2 + (size_t)b * MEMLEN * DM + h * XHD; }
        u.lbase = mode; return true;
    }
};
struct XattnOrder {
    static constexpr bool GATHER = false;
    int G, c, mode, lda, ldb;
    __device__ bool next(int i, Unit& u) const {
        int L = i * G + c; if (L >= (NTOK / 256) * 4) return false;
        if (G == 256) { const int x = c & 7, idx = c >> 3; L = ((x + 8 * i) * 8 + (idx >> 2)) * 4 + (idx & 3); }
        u.pm = L >> 2; u.pn = L & 3; const int b = u.pm >> 3;
        u.a_off = (size_t)u.pm * 256 * lda;
        u.b_off = mode == 0 ? (size_t)(b * 4 + u.pn) * 256 * ldb : (size_t)(b * 1024 + u.pn * 256) * ldb;
        return true;
    }
};
template <bool GATH_> struct MoeOrder {
    static constexpr bool GATHER = GATH_;
    const LAS int* ts; int G, c, lda, ldb; const int* ltok; unsigned rowbytes;
    __device__ bool next(int i, Unit& u) const {
        const int L = i * G + c; if (L >= ts[NEXP] * 4) return false;
        const int T = L >> 2, j = L & 3; int e = 0; while (ts[e + 1] <= T) ++e;
        const int lt = T - ts[e];
        u.pm = T; u.pn = j; u.a_off = GATH_ ? (size_t)0 : (size_t)T * 256 * lda; u.b_off = ((size_t)e * 1024 + j * 256) * ldb;
        u.lbase = e * LCAP + lt * 256; u.nvalid = ts[33 + e] - lt * 256; return true;
    }
    __device__ __forceinline__ unsigned rowoff(const Unit& u, int r) const { return (r < u.nvalid) ? (unsigned)ltok[u.lbase + r] * rowbytes : 0u; }
};


typedef int v8i __attribute__((ext_vector_type(8)));
typedef int v4i __attribute__((ext_vector_type(4)));
__device__ __forceinline__ v8i cat8(bf16x8 lo, bf16x8 hi) { const v4i a = __builtin_bit_cast(v4i, lo), b = __builtin_bit_cast(v4i, hi); return __builtin_shufflevector(a, b, 0, 1, 2, 3, 4, 5, 6, 7); }
template <int H> __device__ __forceinline__ bf16x8 half8(v8i v) { const v4i h = H ? __builtin_shufflevector(v, v, 4, 5, 6, 7) : __builtin_shufflevector(v, v, 0, 1, 2, 3); return __builtin_bit_cast(bf16x8, h); }
__device__ __forceinline__ unsigned pk4_fp8(float a, float b, float c, float d) { int w = __builtin_amdgcn_cvt_pk_fp8_f32(a, b, 0, false); w = __builtin_amdgcn_cvt_pk_fp8_f32(c, d, w, true); return (unsigned)w; }
__host__ __device__ __forceinline__ int lds_byte(int r, int c) { const int st = (r >> 4) * 2 + (c >> 5), rr = r & 15, cc = c & 31, ob = rr * 64 + cc * 2; return st * 1024 + (ob ^ (((ob >> 9) & 1) << 5)); }
__host__ __device__ __forceinline__ void stage_rc(int b, int& R, int& C) { const int st = b / 1024, sb = b % 1024, swz = sb ^ (((sb >> 9) & 1) << 5); R = (st >> 1) * 16 + swz / 64; C = (st & 1) * 32 + (swz % 64) / 2; }
template <class Epi, class Sched, bool ALIGN_EPI = false, bool SP2 = false, bool F8 = false, bool SKIPW = true>
__device__ __forceinline__ void gemm_phase(LAS unsigned char* lds, const Gemm g, const Sched& S, const Epi& E) {
    constexpr int BK = 64, HALF = 128, HTB = HALF * BK * 2;
    int tid = threadIdx.x; asm volatile("" : "+v"(tid));
    const int wid = __builtin_amdgcn_readfirstlane(tid >> 6), lane = tid & 63, wr = wid >> 2, wc = wid & 3, fr = lane & 15, fq = lane >> 4;
    const int K = g.K, nt = K / BK;
    unsigned voffA[2], voffB[2];
#pragma unroll
    for (int i = 0; i < 2; ++i) { int R, C; stage_rc(tid * 16 + i * 8192, R, C); const int Rb = Epi::PERM ? ((R & ~31) + perm32(R & 31)) : R;
        voffA[i] = (unsigned)(R * g.lda + C) * 2u; voffB[i] = (unsigned)(Rb * g.ldb + C) * 2u; }
    constexpr bool GATH = Sched::GATHER;
    unsigned vcu[2][2] = {{0u, 0u}, {0u, 0u}}, vnx[2][2] = {{0u, 0u}, {0u, 0u}}; int gR[2] = {0, 0}; unsigned gC[2] = {0u, 0u};
    if constexpr (GATH) {
#pragma unroll
        for (int i = 0; i < 2; ++i) { int R, Cq; stage_rc(tid * 16 + i * 8192, R, Cq); gR[i] = R; gC[i] = (unsigned)Cq * 2u; } }
    const size_t kstep = (size_t)(BK * 2);
    const size_t hstepA = (size_t)HALF * g.lda * 2, hstepB = (size_t)HALF * g.ldb * 2;
    const unsigned ldsw = (unsigned)wid * 1024u;
    const int aoff = lds_byte(wr * 64 + fr, fq * 8), boff = lds_byte(wc * 32 + fr, fq * 8);
    constexpr int aoff1 = 1024, boff1 = 1024;
#define PG8_SA(b, h) (((b) * 2 + (h)) * HTB)
#define PG8_SB(b, h) ((4 + (b) * 2 + (h)) * HTB)
#define PG8_STAGE(bufoff, gbase, voff) do { _Pragma("unroll") for (int _i = 0; _i < 2; ++_i) \
        __builtin_amdgcn_global_load_lds((const unsigned*)((const char*)(gbase) + (voff)[_i]), (LAS unsigned*)(lds + (bufoff) + ldsw + _i * 8192), 16, 0, 0); } while (0)
#define PG8_STA(bufoff, ptr, h, nx) do { if constexpr (GATH) { const unsigned vsel_[2] = {(nx) ? vnx[h][0] : vcu[h][0], (nx) ? vnx[h][1] : vcu[h][1]}; PG8_STAGE(bufoff, ptr, vsel_); } \
        else { PG8_STAGE(bufoff, (ptr) + (h) * hstepA, voffA); } } while (0)
#define PG8_LDA(dst, b, h) do { _Pragma("unroll") for (int m = 0; m < 4; ++m) dst[m] = cat8(*(const LAS bf16x8*)(lds + PG8_SA(b, h) + aoff + m * 2048), *(const LAS bf16x8*)(lds + PG8_SA(b, h) + aoff + m * 2048 + aoff1)); } while (0)
#define PG8_LDB(dst, b, h) do { _Pragma("unroll") for (int n = 0; n < 2; ++n) dst[n] = cat8(*(const LAS bf16x8*)(lds + PG8_SB(b, h) + boff + n * 2048), *(const LAS bf16x8*)(lds + PG8_SB(b, h) + boff + n * 2048 + boff1)); } while (0)
#define PG8_MMA(ai, bj, At, Bt) do { __builtin_amdgcn_s_setprio(1); \
        if constexpr (F8) { _Pragma("unroll") for (int m = 0; m < 4; ++m) _Pragma("unroll") for (int n = 0; n < 2; ++n) \
            asm volatile("s_nop 1\n\tv_mfma_scale_f32_16x16x128_f8f6f4 %0, %1, %2, %0, %3, %3 op_sel_hi:[0,0,0]" : "+v"(acc[ai][bj][m][n]) : "v"(Bt[n]), "v"(At[m]), "v"(sc127)); } \
        else { _Pragma("unroll") for (int m = 0; m < 4; ++m) _Pragma("unroll") for (int n = 0; n < 2; ++n) { \
            acc[ai][bj][m][n] = __builtin_amdgcn_mfma_f32_16x16x32_bf16(half8<0>(Bt[n]), half8<0>(At[m]), acc[ai][bj][m][n], 0, 0, 0); \
            acc[ai][bj][m][n] = __builtin_amdgcn_mfma_f32_16x16x32_bf16(half8<1>(Bt[n]), half8<1>(At[m]), acc[ai][bj][m][n], 0, 0, 0); } } \
        __builtin_amdgcn_s_setprio(0); } while (0)
#define PG8_WAIT_V(n) asm volatile("s_waitcnt vmcnt(" #n ")" ::: "memory")
#define PG8_WAIT_L(n) asm volatile("s_waitcnt lgkmcnt(" #n ")" ::: "memory")
#define PG8_BAR __builtin_amdgcn_s_barrier()
#define PG8_SCHED __builtin_amdgcn_sched_barrier(0)
    Unit cur, nxt; int ui = 0;
    if (!S.next(0, cur)) return;
    f32x4 acc[2][2][4][2];
#pragma unroll
    for (int a = 0; a < 2; ++a)
#pragma unroll
        for (int b = 0; b < 2; ++b)
#pragma unroll
            for (int m = 0; m < 4; ++m)
#pragma unroll
                for (int n = 0; n < 2; ++n) acc[a][b][m][n] = (f32x4){0.f, 0.f, 0.f, 0.f};
    int sc127 = 127; asm volatile("" : "+v"(sc127));
    v8i At[4], B0[2], B1[2];
    const char* cA = (const char*)(g.A + cur.a_off); const char* cB = (const char*)(g.Bt + cur.b_off);
    if constexpr (GATH) {
#pragma unroll
        for (int h = 0; h < 2; ++h)
#pragma unroll
            for (int i = 0; i < 2; ++i) vcu[h][i] = S.rowoff(cur, h * HALF + gR[i]) + gC[i]; }
    if constexpr (SP2) {
        PG8_STAGE(PG8_SB(0, 0), cB, voffB); PG8_STAGE(PG8_SB(0, 1), cB + hstepB, voffB); PG8_STA(PG8_SA(0, 0), cA, 0, false); PG8_STA(PG8_SA(0, 1), cA, 1, false);
        if (wr == 1) PG8_BAR;
        PG8_WAIT_V(2); PG8_BAR;
        PG8_STAGE(PG8_SB(1, 0), cB + kstep, voffB); PG8_STA(PG8_SA(1, 0), cA + kstep, 0, false); PG8_STAGE(PG8_SB(1, 1), cB + hstepB + kstep, voffB);
        PG8_WAIT_V(6); PG8_BAR;
    } else {
        PG8_STAGE(PG8_SB(0, 0), cB, voffB); PG8_STA(PG8_SA(0, 0), cA, 0, false); PG8_STAGE(PG8_SB(0, 1), cB + hstepB, voffB); PG8_STA(PG8_SA(0, 1), cA, 1, false);
        if (wr == 1) PG8_BAR;
        PG8_WAIT_V(4); PG8_BAR;
        PG8_STAGE(PG8_SB(1, 0), cB + kstep, voffB); PG8_STA(PG8_SA(1, 0), cA + kstep, 0, false); PG8_STAGE(PG8_SB(1, 1), cB + hstepB + kstep, voffB);
        PG8_WAIT_V(6); PG8_BAR;
    }
    for (;;) {
        const bool has_next = S.next(ui + 1, nxt);
        const char* nA = has_next ? (const char*)(g.A + nxt.a_off) : cA; const char* nB = has_next ? (const char*)(g.Bt + nxt.b_off) : cB;
        if constexpr (GATH) {
#pragma unroll
            for (int h = 0; h < 2; ++h)
#pragma unroll
                for (int i = 0; i < 2; ++i) vnx[h][i] = has_next ? (S.rowoff(nxt, h * HALF + gR[i]) + gC[i]) : vcu[h][i]; }
#pragma unroll 1
        for (int t = 0; t < nt; t += 2) {
            if constexpr (Epi::MIDK) { if (t == (nt >> 1)) E.midk(acc, cur, wr, wc, fr, fq); }
            const bool last = (t == nt - 2); const bool skipw = SKIPW && SP2 && (t == 0) && (ui > 0);
            const char* a1 = cA + (size_t)(t + 1) * kstep;
            const char* a2 = last ? nA : cA + (size_t)(t + 2) * kstep; const char* b2 = last ? nB : cB + (size_t)(t + 2) * kstep;
            const char* a3 = a2 + kstep; const char* b3 = b2 + kstep;
            if constexpr (SP2) {
            PG8_LDB(B0, 0, 0); PG8_LDB(B1, 0, 1); PG8_SCHED; PG8_LDA(At, 0, 0); PG8_STA(PG8_SA(1, 1), a1, 1, false);
            if (!skipw) PG8_WAIT_V(8); PG8_WAIT_L(0); PG8_BAR; PG8_MMA(0, 0, At, B0); PG8_MMA(0, 1, At, B1); PG8_BAR; PG8_SCHED;
            PG8_LDA(At, 0, 1); PG8_STAGE(PG8_SB(0, 0), b2, voffB); PG8_STAGE(PG8_SB(0, 1), b2 + hstepB, voffB); PG8_STA(PG8_SA(0, 0), a2, 0, last);
            if (!skipw) PG8_WAIT_V(8); PG8_WAIT_L(0); PG8_BAR; PG8_MMA(1, 0, At, B0); PG8_MMA(1, 1, At, B1); PG8_BAR; PG8_SCHED;
            PG8_LDB(B0, 1, 0); PG8_LDB(B1, 1, 1); PG8_SCHED; PG8_LDA(At, 1, 0); PG8_STA(PG8_SA(0, 1), a2, 1, last);
            PG8_WAIT_V(8); PG8_WAIT_L(0); PG8_BAR; PG8_MMA(0, 0, At, B0); PG8_MMA(0, 1, At, B1); PG8_BAR; PG8_SCHED;
            PG8_LDA(At, 1, 1); PG8_STAGE(PG8_SB(1, 0), b3, voffB); PG8_STAGE(PG8_SB(1, 1), b3 + hstepB, voffB); PG8_STA(PG8_SA(1, 0), a3, 0, last);
            PG8_WAIT_V(8); PG8_WAIT_L(0); PG8_BAR; PG8_MMA(1, 0, At, B0); PG8_MMA(1, 1, At, B1); PG8_BAR; PG8_SCHED;
            } else {
            PG8_LDB(B0, 0, 0); PG8_SCHED; PG8_LDA(At, 0, 0); PG8_STA(PG8_SA(1, 1), a1, 1, false);
            PG8_WAIT_L(8); PG8_BAR; PG8_WAIT_L(0); PG8_MMA(0, 0, At, B0); PG8_BAR; PG8_SCHED;
            PG8_LDB(B1, 0, 1); PG8_STAGE(PG8_SB(0, 0), b2, voffB);
            PG8_BAR; PG8_WAIT_L(0); PG8_MMA(0, 1, At, B1); PG8_BAR;
            PG8_LDA(At, 0, 1); PG8_STA(PG8_SA(0, 0), a2, 0, last);
            PG8_BAR; PG8_WAIT_L(0); PG8_MMA(1, 0, At, B0); PG8_BAR; PG8_SCHED;
            PG8_STAGE(PG8_SB(0, 1), b2 + hstepB, voffB);
            PG8_WAIT_V(6); PG8_BAR; PG8_MMA(1, 1, At, B1); PG8_BAR;
            PG8_LDB(B0, 1, 0); PG8_SCHED; PG8_LDA(At, 1, 0); PG8_STA(PG8_SA(0, 1), a2, 1, last);
            PG8_WAIT_L(8); PG8_BAR; PG8_WAIT_L(0); PG8_MMA(0, 0, At, B0); PG8_BAR; PG8_SCHED;
            PG8_LDB(B1, 1, 1); PG8_STAGE(PG8_SB(1, 0), b3, voffB);
            PG8_BAR; PG8_WAIT_L(0); PG8_MMA(0, 1, At, B1); PG8_BAR;
            PG8_LDA(At, 1, 1); PG8_STA(PG8_SA(1, 0), a3, 0, last);
            PG8_BAR; PG8_WAIT_L(0); PG8_MMA(1, 0, At, B0); PG8_BAR; PG8_SCHED;
            PG8_STAGE(PG8_SB(1, 1), b3 + hstepB, voffB);
            PG8_WAIT_V(6); PG8_BAR; PG8_MMA(1, 1, At, B1); PG8_BAR;
            }
        }
        if constexpr (ALIGN_EPI) { if (wr == 0) PG8_BAR; }
        if constexpr (F8) {
#pragma unroll
            for (int a = 0; a < 2; ++a)
#pragma unroll
                for (int b = 0; b < 2; ++b)
                    asm volatile("s_nop 15\n\ts_nop 7" : "+v"(acc[a][b][0][0]), "+v"(acc[a][b][0][1]), "+v"(acc[a][b][1][0]), "+v"(acc[a][b][1][1]), "+v"(acc[a][b][2][0]), "+v"(acc[a][b][2][1]), "+v"(acc[a][b][3][0]), "+v"(acc[a][b][3][1]));
        }
        if constexpr (SP2 && SKIPW) PG8_WAIT_V(0);
        E(acc, cur, wr, wc, fr, fq);
        if (!has_next) break;
#pragma unroll
        for (int a = 0; a < 2; ++a)
#pragma unroll
            for (int b = 0; b < 2; ++b)
#pragma unroll
                for (int m = 0; m < 4; ++m)
#pragma unroll
                    for (int n = 0; n < 2; ++n) acc[a][b][m][n] = (f32x4){0.f, 0.f, 0.f, 0.f};
        cur = nxt; cA = nA; cB = nB; ++ui;
        if constexpr (GATH) {
#pragma unroll
            for (int h = 0; h < 2; ++h)
#pragma unroll
                for (int i = 0; i < 2; ++i) vcu[h][i] = vnx[h][i]; }
        if constexpr (ALIGN_EPI) { if (wr == 1) PG8_BAR; }
    }
    PG8_WAIT_V(0);
    if constexpr (!ALIGN_EPI) { if (wr == 0) PG8_BAR; }
    PG8_BAR;
#undef PG8_SA
#undef PG8_SB
#undef PG8_STAGE
#undef PG8_STA
#undef PG8_LDA
#undef PG8_LDB
#undef PG8_MMA
#undef PG8_WAIT_V
#undef PG8_WAIT_L
#undef PG8_BAR
#undef PG8_SCHED
}
#define GEMM_PHASE(lds, g, S, E) gemm_phase<decltype(E), decltype(S), true, true>(lds, g, S, E)
#define GEMM_PHASE8(lds, g, S, E) gemm_phase<decltype(E), decltype(S), true, true, true>(lds, g, S, E)
#define GEMM_PHASE8N(lds, g, S, E) gemm_phase<decltype(E), decltype(S), true, true, true, false>(lds, g, S, E)

__device__ __forceinline__ float rstd_from_ssq(const float* ssq, int row) {
    const f32x4* p = (const f32x4*)(ssq + (size_t)row * 16); const f32x4 a = p[0], b = p[1], c = p[2], d = p[3];
    const float s = ((a[0] + a[1]) + (a[2] + a[3])) + ((b[0] + b[1]) + (b[2] + b[3])) + ((c[0] + c[1]) + (c[2] + c[3])) + ((d[0] + d[1]) + (d[2] + d[3]));
    return __builtin_amdgcn_rsqf(s * (1.0f / DM) + EPS);
}
__device__ __forceinline__ u32x4 pack8(const f32x4 v0, const f32x4 v1) { u32x4 w; w.x = cvt_pk_bf16(v0[0], v0[1]); w.y = cvt_pk_bf16(v0[2], v0[3]); w.z = cvt_pk_bf16(v1[0], v1[1]); w.w = cvt_pk_bf16(v1[2], v1[3]); return w; }

struct EpiProj {
    static constexpr bool PERM = true, LDSX = false, MIDK = false;
    bf16_t* base; const float* rope; float* ksum;
    __device__ __forceinline__ void operator()(f32x4 (&acc)[2][2][4][2], const Unit& u, int wr, int wc, int fr, int fq) const {
        const int type = u.pn >> 1, colt = (u.pn & 1) * 256;
        bf16_t* O = base + (size_t)type * NTOK * 512;
        const bool is_q = (type == 2), is_k = (type == 3);
        if ((is_q || is_k) && !(wc & 1)) {
#pragma unroll
            for (int ai = 0; ai < 2; ++ai)
#pragma unroll
                for (int m = 0; m < 4; ++m) {
                    const int row = u.pm * 256 + 128 * ai + 64 * wr + 16 * m + fr, pos = row & (SEQ - 1);
                    const float* rp = rope + pos * 16;
                    const f32x4 cs[2] = { *(const f32x4*)(rp), *(const f32x4*)(rp + 4) }, sn[2] = { *(const f32x4*)(rp + 8), *(const f32x4*)(rp + 12) };
#pragma unroll
                    for (int bj = 0; bj < 2; ++bj)
#pragma unroll
                        for (int n = 0; n < 2; ++n) {
                            const f32x4 mine = acc[ai][bj][m][n]; f32x4 oth;
#pragma unroll
                            for (int e = 0; e < 4; ++e) oth[e] = __shfl_xor(mine[e], 16);
                            f32x4 res = mine;
                            if (fq == 0) res = mine * cs[n] - oth * sn[n];
                            else if (fq == 1) res = mine * cs[n] + oth * sn[n];
                            acc[ai][bj][m][n] = res;
                        }
                }
        }
        const float sc = is_q ? QSCALE : 1.0f;
#pragma unroll
        for (int ai = 0; ai < 2; ++ai)
#pragma unroll
            for (int m = 0; m < 4; ++m) {
                const int row = u.pm * 256 + 128 * ai + 64 * wr + 16 * m + fr;
                bf16_t* rowp = O + (size_t)row * 512 + colt + 32 * wc + 8 * fq;
#pragma unroll
                for (int bj = 0; bj < 2; ++bj) *(u32x4*)(rowp + bj * 128) = pack8(acc[ai][bj][m][0] * sc, acc[ai][bj][m][1] * sc);
            }
        if (is_k) {
#pragma unroll
            for (int bj = 0; bj < 2; ++bj)
#pragma unroll
                for (int n = 0; n < 2; ++n)
#pragma unroll
                    for (int e = 0; e < 4; ++e) {
                        float s = 0.f;
#pragma unroll
                        for (int ai = 0; ai < 2; ++ai)
#pragma unroll
                            for (int m = 0; m < 4; ++m) s += acc[ai][bj][m][n][e];
                        s += __shfl_xor(s, 1); s += __shfl_xor(s, 2); s += __shfl_xor(s, 4); s += __shfl_xor(s, 8);
                        if (fr == 0) atomicAdd(ksum + (size_t)u.pm * 512 + colt + 128 * bj + 32 * wc + 8 * fq + 4 * n + e, s);
                    }
        }
    }
};
struct EpiStore {
    static constexpr bool PERM = true, LDSX = false, MIDK = false;
    bf16_t* O; int ldc; float sc = 1.0f;
    __device__ __forceinline__ void operator()(f32x4 (&acc)[2][2][4][2], const Unit& u, int wr, int wc, int fr, int fq) const {
#pragma unroll
        for (int ai = 0; ai < 2; ++ai)
#pragma unroll
            for (int m = 0; m < 4; ++m) {
                const int row = u.pm * 256 + 128 * ai + 64 * wr + 16 * m + fr;
                bf16_t* rowp = O + (size_t)row * ldc + u.pn * 256 + 32 * wc + 8 * fq;
#pragma unroll
                for (int bj = 0; bj < 2; ++bj) *(u32x4*)(rowp + bj * 128) = pack8(acc[ai][bj][m][0] * sc, acc[ai][bj][m][1] * sc);
            }
    }
};
struct EpiStore8 {
    static constexpr bool PERM = true, LDSX = false, MIDK = false;
    unsigned char* O; int ldc; float sc;
    __device__ __forceinline__ void operator()(f32x4 (&acc)[2][2][4][2], const Unit& u, int wr, int wc, int fr, int fq) const {
#pragma unroll
        for (int ai = 0; ai < 2; ++ai)
#pragma unroll
            for (int m = 0; m < 4; ++m) {
                const int row = u.pm * 256 + 128 * ai + 64 * wr + 16 * m + fr;
                unsigned char* rowp = O + (size_t)row * ldc + u.pn * 256 + 32 * wc + 8 * fq;
#pragma unroll
                for (int bj = 0; bj < 2; ++bj) { const f32x4 a0 = acc[ai][bj][m][0] * sc, a1 = acc[ai][bj][m][1] * sc; u32x2 w; w.x = pk4_fp8(a0[0], a0[1], a0[2], a0[3]); w.y = pk4_fp8(a1[0], a1[1], a1[2], a1[3]); *(u32x2*)(rowp + bj * 128) = w; }
            }
    }
};
struct EpiStore8x {
    static constexpr bool PERM = true, LDSX = false, MIDK = false, P16 = false;
    unsigned char* O0; unsigned char* O1; float sc0, sc1;
    __device__ __forceinline__ void operator()(f32x4 (&acc)[2][2][4][2], const Unit& u, int wr, int wc, int fr, int fq) const {
        unsigned char* O = u.lbase ? O1 : O0; const float sc = u.lbase ? sc1 : sc0;
#pragma unroll
        for (int ai = 0; ai < 2; ++ai)
#pragma unroll
            for (int m = 0; m < 4; ++m) {
                const int row = u.pm * 256 + 128 * ai + 64 * wr + 16 * m + fr;
                unsigned char* rowp = O + (size_t)row * DM + u.pn * 256 + 32 * wc + 8 * fq;
#pragma unroll
                for (int bj = 0; bj < 2; ++bj) { const f32x4 a0 = acc[ai][bj][m][0] * sc, a1 = acc[ai][bj][m][1] * sc; u32x2 w; w.x = pk4_fp8(a0[0], a0[1], a0[2], a0[3]); w.y = pk4_fp8(a1[0], a1[1], a1[2], a1[3]); *(u32x2*)(rowp + bj * 128) = w; }
            }
    }
};
template <bool BASE_F32, bool KSPLIT> struct EpiResid {
    static constexpr bool PERM = true, LDSX = false, MIDK = KSPLIT;
    const void* base; bf16_t* hb; float* ssq; const float* ssql; const float* ssqa; unsigned char* h8; float asc; const float* rs0 = nullptr; const float* gmix = nullptr;
    __device__ __forceinline__ void stats(int row, int fq, float& rl, float& ra) const {
        const f32x4 pl = *(const f32x4*)(ssql + (size_t)row * 16 + 4 * fq); const f32x2 pa = *(const f32x2*)(ssqa + (size_t)row * 8 + 2 * fq);
        float sl = (pl[0] + pl[1]) + (pl[2] + pl[3]), sa = pa[0] + pa[1];
        sl += __shfl_xor(sl, 16); sl += __shfl_xor(sl, 32); sa += __shfl_xor(sa, 16); sa += __shfl_xor(sa, 32);
        rl = __builtin_amdgcn_rsqf(sl * (1.0f / 512.0f) + EPS); ra = __builtin_amdgcn_rsqf(sa * (1.0f / 512.0f) + EPS);
    }
    __device__ __forceinline__ void midk(f32x4 (&acc)[2][2][4][2], const Unit& u, int wr, int wc, int fr, int fq) const {
        asm volatile("" : "+v"(fr), "+v"(fq));
#pragma unroll
        for (int ai = 0; ai < 2; ++ai)
#pragma unroll
            for (int m = 0; m < 4; ++m) { float rl, ra; stats(u.pm * 256 + 128 * ai + 64 * wr + 16 * m + fr, fq, rl, ra); const float ratio = rl * __builtin_amdgcn_rcpf(ra);
#pragma unroll
                for (int bj = 0; bj < 2; ++bj)
#pragma unroll
                    for (int n = 0; n < 2; ++n) acc[ai][bj][m][n] *= ratio; }
    }
    __device__ __forceinline__ void operator()(f32x4 (&acc)[2][2][4][2], const Unit& u, int wr, int wc, int fr, int fq) const {
        f32x4 ginv[2][2];
        if constexpr (BASE_F32) {
#pragma unroll
            for (int bj = 0; bj < 2; ++bj)
#pragma unroll
                for (int n = 0; n < 2; ++n) { const f32x4 g = *(const f32x4*)(gmix + u.pn * 256 + 128 * bj + 32 * wc + 8 * fq + 4 * n);
                    ginv[bj][n] = (f32x4){__builtin_amdgcn_rcpf(g[0]), __builtin_amdgcn_rcpf(g[1]), __builtin_amdgcn_rcpf(g[2]), __builtin_amdgcn_rcpf(g[3])}; } }
#pragma unroll
        for (int ai = 0; ai < 2; ++ai)
#pragma unroll
            for (int m = 0; m < 4; ++m) {
                const int row = u.pm * 256 + 128 * ai + 64 * wr + 16 * m + fr; float q = 0.f, osc = asc, irs = 1.0f;
                if constexpr (KSPLIT) { float rl; stats(row, fq, rl, osc); osc *= asc; }
                if constexpr (BASE_F32) irs = __builtin_amdgcn_rcpf(rs0[row]);
#pragma unroll
                for (int bj = 0; bj < 2; ++bj) {
                    const int col = u.pn * 256 + 128 * bj + 32 * wc + 8 * fq;
                    f32x4 b0, b1;
                    if constexpr (BASE_F32) { const u32x4 w = *(const u32x4*)((const bf16_t*)base + (size_t)row * DM + col);
                        b0 = (f32x4){bflo(w.x), bfhi(w.x), bflo(w.y), bfhi(w.y)} * (ginv[bj][0] * irs); b1 = (f32x4){bflo(w.z), bfhi(w.z), bflo(w.w), bfhi(w.w)} * (ginv[bj][1] * irs); }
                    else { const u32x4 w = *(const u32x4*)((const bf16_t*)base + (size_t)row * LDH + col); b0 = (f32x4){bflo(w.x), bfhi(w.x), bflo(w.y), bfhi(w.y)}; b1 = (f32x4){bflo(w.z), bfhi(w.z), bflo(w.w), bfhi(w.w)}; }
                    const f32x4 v0 = b0 + acc[ai][bj][m][0] * osc, v1 = b1 + acc[ai][bj][m][1] * osc;
                    q += ((v0[0] * v0[0] + v0[1] * v0[1]) + (v0[2] * v0[2] + v0[3] * v0[3])) + ((v1[0] * v1[0] + v1[1] * v1[1]) + (v1[2] * v1[2] + v1[3] * v1[3]));
                    *(u32x4*)(hb + (size_t)row * LDH + col) = pack8(v0, v1);
                    if (h8) { u32x2 w8; w8.x = pk4_fp8(v0[0], v0[1], v0[2], v0[3]); w8.y = pk4_fp8(v1[0], v1[1], v1[2], v1[3]); *(u32x2*)(h8 + (size_t)row * DM + col) = w8; }
                }
                q += __shfl_xor(q, 16); q += __shfl_xor(q, 32);
                if (fq == 0) ssq[(size_t)row * 16 + u.pn * 4 + wc] = q;
            }
    }
};
#define XBAR() do { asm volatile("s_waitcnt lgkmcnt(0)" ::: "memory"); __builtin_amdgcn_s_barrier(); asm volatile("" ::: "memory"); } while (0)
struct EpiSoftmax {
    static constexpr bool PERM = true, LDSX = false, MIDK = false;
    unsigned char* O; int ldc; LAS unsigned char* xl; const float* ssq; float cs;
    __device__ __forceinline__ void operator()(f32x4 (&acc)[2][2][4][2], const Unit& u, int wr, int wc, int fr, int fq) const {
        LAS float* P = (LAS float*)xl;
        LAS float* Q = (LAS float*)(xl + 4096);
#pragma unroll
        for (int ai = 0; ai < 2; ++ai)
#pragma unroll
            for (int m = 0; m < 4; ++m) {
                float v = -INFINITY; const float sc = rstd_from_ssq(ssq, u.pm * 256 + 128 * ai + 64 * wr + 16 * m + fr) * cs;
#pragma unroll
                for (int bj = 0; bj < 2; ++bj)
#pragma unroll
                    for (int n = 0; n < 2; ++n) { const f32x4 x = acc[ai][bj][m][n] * sc; acc[ai][bj][m][n] = x; v = fmaxf(v, fmaxf(fmaxf(x[0], x[1]), fmaxf(x[2], x[3]))); }
                v = fmaxf(v, __shfl_xor(v, 16)); v = fmaxf(v, __shfl_xor(v, 32));
                if (fq == 0) P[(128 * ai + 64 * wr + 16 * m + fr) * 4 + wc] = v;
            }
        XBAR();
#pragma unroll
        for (int ai = 0; ai < 2; ++ai)
#pragma unroll
            for (int m = 0; m < 4; ++m) {
                const int r = 128 * ai + 64 * wr + 16 * m + fr;
                const float v = fmaxf(fmaxf(P[r * 4 + 0], P[r * 4 + 1]), fmaxf(P[r * 4 + 2], P[r * 4 + 3]));
                float s = 0.f;
#pragma unroll
                for (int bj = 0; bj < 2; ++bj)
#pragma unroll
                    for (int n = 0; n < 2; ++n) { f32x4 x = acc[ai][bj][m][n];
#pragma unroll
                        for (int e = 0; e < 4; ++e) { x[e] = __builtin_amdgcn_exp2f(x[e] - v); s += x[e]; }
                        acc[ai][bj][m][n] = x; }
                s += __shfl_xor(s, 16); s += __shfl_xor(s, 32);
                if (fq == 0) Q[r * 4 + wc] = s;
            }
        XBAR();
#pragma unroll
        for (int ai = 0; ai < 2; ++ai)
#pragma unroll
            for (int m = 0; m < 4; ++m) {
                const int r = 128 * ai + 64 * wr + 16 * m + fr;
                const float inv = PX_SC * __builtin_amdgcn_rcpf((Q[r * 4 + 0] + Q[r * 4 + 1]) + (Q[r * 4 + 2] + Q[r * 4 + 3]));
                unsigned char* rowp = O + (size_t)(u.pm * 256 + r) * ldc + u.pn * 256 + 32 * wc + 8 * fq;
#pragma unroll
                for (int bj = 0; bj < 2; ++bj) { const f32x4 a0 = acc[ai][bj][m][0] * inv, a1 = acc[ai][bj][m][1] * inv; u32x2 w; w.x = pk4_fp8(a0[0], a0[1], a0[2], a0[3]); w.y = pk4_fp8(a1[0], a1[1], a1[2], a1[3]); *(u32x2*)(rowp + bj * 128) = w; }
            }
        XBAR();
    }
};
struct EpiGateUp {
    static constexpr bool PERM = true, LDSX = false, MIDK = false;
    unsigned char* O; const float* lrs;
    __device__ __forceinline__ void operator()(f32x4 (&acc)[2][2][4][2], const Unit& u, int wr, int wc, int fr, int fq) const {
#pragma unroll
        for (int ai = 0; ai < 2; ++ai)
#pragma unroll
            for (int m = 0; m < 4; ++m) {
                const int r = 128 * ai + 64 * wr + 16 * m + fr, row = u.pm * 256 + r; const float rs = (r < u.nvalid) ? lrs[u.lbase + r] * (1.0f / WGU_SC) : 0.f;
                f32x4 o[2];
#pragma unroll
                for (int n = 0; n < 2; ++n)
#pragma unroll
                    for (int e = 0; e < 4; ++e) { const float g = acc[ai][0][m][n][e] * rs, up = acc[ai][1][m][n][e] * rs; o[n][e] = g * sigmoidf_(g) * up * ACT_SC; }
                u32x2 w8; w8.x = pk4_fp8(o[0][0], o[0][1], o[0][2], o[0][3]); w8.y = pk4_fp8(o[1][0], o[1][1], o[1][2], o[1][3]);
                *(u32x2*)(O + (size_t)row * DFF + u.pn * 128 + 32 * wc + 8 * fq) = w8;
            }
    }
};

struct Args { const float* in[27]; float* out; unsigned char* ws; int ph_lo, ph_hi; float invf[8]; };
struct Ctx { LAS unsigned char* lds; int tid, lane, wave, vcu, G; };

__device__ __forceinline__ void tr_load(f32x4 (&v)[8], const float* W, int ldw, int k0, int n0s, int lane) {
    const int kr = lane >> 3, ch = lane & 7;
#pragma unroll
    for (int i = 0; i < 8; ++i) v[i] = *(const f32x4*)(W + (size_t)(k0 + 8 * i + kr) * ldw + n0s + 4 * ch);
}
__device__ __forceinline__ void tr_finish(const f32x4 (&v)[8], int k0, bf16_t* WT, int ldt, int r0d, const float* gain, LAS float* scr, int lane) {
    const int kr = lane >> 3, ch = lane & 7, c = lane & 7;
    f32x4 g0 = {1.f, 1.f, 1.f, 1.f}, g1 = {1.f, 1.f, 1.f, 1.f};
    if (gain) { g0 = *(const f32x4*)(gain + k0 + 8 * c); g1 = *(const f32x4*)(gain + k0 + 8 * c + 4); }
#pragma unroll
    for (int i = 0; i < 8; ++i) { LAS float* d = scr + (8 * i + kr) * 33 + 4 * ch; d[0] = v[i][0]; d[1] = v[i][1]; d[2] = v[i][2]; d[3] = v[i][3]; }
    LDS_WAIT(); asm volatile("" ::: "memory");
#pragma unroll
    for (int j = 0; j < 4; ++j) { const int n = (lane >> 3) + 8 * j; const LAS float* s = scr + (8 * c) * 33 + n;
        u32x4 o; o.x = cvt_pk_bf16(s[0 * 33] * g0[0], s[1 * 33] * g0[1]); o.y = cvt_pk_bf16(s[2 * 33] * g0[2], s[3 * 33] * g0[3]); o.z = cvt_pk_bf16(s[4 * 33] * g1[0], s[5 * 33] * g1[1]); o.w = cvt_pk_bf16(s[6 * 33] * g1[2], s[7 * 33] * g1[3]);
        *(u32x4*)(WT + (size_t)(r0d + n) * ldt + k0 + 8 * c) = o; }
    LDS_WAIT(); asm volatile("" ::: "memory");
}
__device__ __forceinline__ void tr_finish8(const f32x4 (&v)[8], int k0, unsigned char* WT8, int ldt, int r0d, const float* gain, float sc, LAS float* scr, int lane) {
    const int kr = lane >> 3, ch = lane & 7, c = lane & 7;
    f32x4 g0 = {sc, sc, sc, sc}, g1 = {sc, sc, sc, sc};
    if (gain) { g0 = *(const f32x4*)(gain + k0 + 8 * c) * sc; g1 = *(const f32x4*)(gain + k0 + 8 * c + 4) * sc; }
#pragma unroll
    for (int i = 0; i < 8; ++i) { LAS float* d = scr + (8 * i + kr) * 33 + 4 * ch; d[0] = v[i][0]; d[1] = v[i][1]; d[2] = v[i][2]; d[3] = v[i][3]; }
    LDS_WAIT(); asm volatile("" ::: "memory");
#pragma unroll
    for (int j = 0; j < 4; ++j) { const int n = (lane >> 3) + 8 * j; const LAS float* s = scr + (8 * c) * 33 + n;
        u32x2 o; o.x = pk4_fp8(s[0 * 33] * g0[0], s[1 * 33] * g0[1], s[2 * 33] * g0[2], s[3 * 33] * g0[3]); o.y = pk4_fp8(s[4 * 33] * g1[0], s[5 * 33] * g1[1], s[6 * 33] * g1[2], s[7 * 33] * g1[3]);
        *(u32x2*)(WT8 + (size_t)(r0d + n) * ldt + k0 + 8 * c) = o; }
    LDS_WAIT(); asm volatile("" ::: "memory");
}
__device__ __forceinline__ void tr_item(const float* W, int ldw, int k0, int n0s, bf16_t* WT, int ldt, int r0d, const float* gain, LAS float* scr, int lane) {
    f32x4 v[8]; tr_load(v, W, ldw, k0, n0s, lane); tr_finish(v, k0, WT, ldt, r0d, gain, scr, lane);
}

__device__ __forceinline__ void rms_row2_to_bf16(const float* xrow, const float* gain, bf16_t* orow, int lane, float* rstd_out = nullptr) {
    const f32x4* xr = (const f32x4*)xrow + lane; const f32x4* gr = (const f32x4*)gain + lane;
    f32x4 v[2][4]; float s[2] = {0.f, 0.f};
#pragma unroll
    for (int r = 0; r < 2; ++r)
#pragma unroll
        for (int j = 0; j < 4; ++j) v[r][j] = xr[256 * r + 64 * j];
#pragma unroll
    for (int r = 0; r < 2; ++r)
#pragma unroll
        for (int j = 0; j < 4; ++j) s[r] += (v[r][j][0] * v[r][j][0] + v[r][j][1] * v[r][j][1]) + (v[r][j][2] * v[r][j][2] + v[r][j][3] * v[r][j][3]);
#pragma unroll
    for (int r = 0; r < 2; ++r) { const float rstd = 1.0f / sqrtf(wave_sum(s[r]) * (1.0f / DM) + EPS); u32x2* o8 = (u32x2*)(orow + (size_t)r * DM) + lane; if (rstd_out && lane == 0) rstd_out[r] = rstd;
#pragma unroll
        for (int j = 0; j < 4; ++j) { const f32x4 g = gr[64 * j]; u32x2 w; w.x = cvt_pk_bf16(v[r][j][0] * rstd * g[0], v[r][j][1] * rstd * g[1]); w.y = cvt_pk_bf16(v[r][j][2] * rstd * g[2], v[r][j][3] * rstd * g[3]); o8[64 * j] = w; } }
}

__device__ __forceinline__ void conv_wdn(const Args& a, const Ctx& C, int gw, int NGW, int it_lo, int NIT) {
    LAS float* scr = (LAS float*)(C.lds + C.wave * 16384); const int lane = C.lane;
    f32x4 va[8], vb[8];
#define WDN_LOAD(v, it) do { const int e_ = (it) / 256, r_ = (it) % 256; tr_load(v, a.in[25] + (size_t)e_ * DFF * DM, DM, 64 * (r_ / 32), 32 * (r_ % 32), lane); } while (0)
#define WDN_FIN(v, it) do { const int e_ = (it) / 256, r_ = (it) % 256; tr_finish8(v, 64 * (r_ / 32), a.ws + WS_WDN, DFF, e_ * 1024 + 32 * (r_ % 32), nullptr, WDN_SC, scr, lane); } while (0)
    int it = it_lo + gw; if (it < NIT) WDN_LOAD(va, it);
    for (; it < NIT; it += 2 * NGW) {
        const int it1 = it + NGW, it2 = it + 2 * NGW;
        if (it1 < NIT) WDN_LOAD(vb, it1);
        WDN_FIN(va, it);
        if (it2 < NIT) WDN_LOAD(va, it2);
        if (it1 < NIT) WDN_FIN(vb, it1);
    }
#undef WDN_LOAD
#undef WDN_FIN
}
__device__ __forceinline__ void rms_row2_to_fp8(const float* xrow, const float* gain, unsigned char* orow, int lane) {
    const f32x4* xr = (const f32x4*)xrow + lane; const f32x4* gr = (const f32x4*)gain + lane;
    f32x4 v[2][4]; float s[2] = {0.f, 0.f};
#pragma unroll
    for (int r = 0; r < 2; ++r)
#pragma unroll
        for (int j = 0; j < 4; ++j) v[r][j] = xr[256 * r + 64 * j];
#pragma unroll
    for (int r = 0; r < 2; ++r)
#pragma unroll
        for (int j = 0; j < 4; ++j) s[r] += (v[r][j][0] * v[r][j][0] + v[r][j][1] * v[r][j][1]) + (v[r][j][2] * v[r][j][2] + v[r][j][3] * v[r][j][3]);
#pragma unroll
    for (int r = 0; r < 2; ++r) { const float rstd = 1.0f / sqrtf(wave_sum(s[r]) * (1.0f / DM) + EPS); unsigned* o4 = (unsigned*)(orow + (size_t)r * DM) + lane;
#pragma unroll
        for (int j = 0; j < 4; ++j) { const f32x4 g = gr[64 * j]; o4[64 * j] = pk4_fp8(v[r][j][0] * rstd * g[0], v[r][j][1] * rstd * g[1], v[r][j][2] * rstd * g[2], v[r][j][3] * rstd * g[3]); } }
}
__device__ __forceinline__ void ph_prologue(const Args& a, const Ctx& C) {
    unsigned char* ws = a.ws;
    LAS float* scr = (LAS float*)(C.lds + C.wave * 16384);
    const int gw = C.vcu * 8 + C.wave, NGW = C.G * 8, lane = C.lane;
    for (int it = gw; it < 16 * 80; it += NGW) { const int kb = it / 80, nb = it % 80; tr_item(a.in[3], DIN, 64 * kb, 32 * nb, (bf16_t*)(ws + WS_WIN), DM, 32 * nb, nullptr, scr, lane); }
    for (int it = gw; it < 16 * 64; it += NGW) { const int kb = it / 64, nb = it % 64;
        f32x4 vk_[8]; tr_load(vk_, a.in[17], 2 * DM, 64 * kb, 32 * nb, lane);
        if (nb < 32) tr_finish8(vk_, 64 * kb, ws + WS_WXK, DM, 32 * nb, nullptr, KV_SC, scr, lane);
        else tr_finish8(vk_, 64 * kb, ws + WS_WXV, DM, 32 * (nb - 32), nullptr, KV_SC, scr, lane); }
    for (int it = gw; it < 16 * 32; it += NGW) { const int kb = it / 32, nb = it % 32;
        tr_item(a.in[13], DM, 64 * kb, 32 * nb, (bf16_t*)(ws + WS_WOUT), DM, 32 * nb, (kb < 8) ? a.in[11] : (a.in[12] - DLRU), scr, lane);
        tr_item(a.in[18], DM, 64 * kb, 32 * nb, (bf16_t*)(ws + WS_WXO), DM, 32 * nb, nullptr, scr, lane); }
    for (int r = gw; r < DM; r += NGW) { const float gk = a.in[14][r]; const f32x4* src = (const f32x4*)(a.in[16] + (size_t)r * DM) + lane; u32x2* dst = (u32x2*)((bf16_t*)(ws + WS_WXQ) + (size_t)r * DM) + lane;
#pragma unroll
        for (int j = 0; j < 4; ++j) { const f32x4 v = src[64 * j]; u32x2 w; w.x = cvt_pk_bf16(v[0] * gk, v[1] * gk); w.y = cvt_pk_bf16(v[2] * gk, v[3] * gk); dst[64 * j] = w; } }
    { bf16_t* WR = (bf16_t*)(ws + WS_WR); const int gt = C.vcu * 512 + C.tid, NT = C.G * 512;
      for (int i = gt; i < 48 * DM; i += NT) { const int r = i / DM, k = i % DM; float v = 0.f;
          if (r < 4) v = a.in[20][k * NGRP + r] * a.in[19][k]; else if (r < 36) v = a.in[22][k * NEXP + (r - 4)] * a.in[19][k];
          WR[i] = (bf16_t)(cvt_pk_bf16(v, 0.f) & 0xffffu); }
      float* rope = (float*)(ws + WS_ROPE);
      for (int i = gt; i < SEQ * 8; i += NT) { const int pos = i >> 3, j = i & 7; const float ang = (float)pos * a.invf[j];
          const double tw = 6.283185307179586476925286766559; const double ad = (double)ang; const double red = ad - tw * __builtin_rint(ad / tw); const float rf = (float)red;
          rope[pos * 16 + j] = __cosf(rf); rope[pos * 16 + 8 + j] = __sinf(rf); } }
    for (int m = 2 * gw; m < NTOK; m += 2 * NGW) rms_row2_to_bf16(a.in[0] + (size_t)m * DM, a.in[2], (bf16_t*)(ws + WS_B) + (size_t)m * DM, lane, (float*)(ws + WS_TOK + TOK_D) + m);
    for (int m = 2 * gw; m < NMEM; m += 2 * NGW) rms_row2_to_fp8(a.in[1] + (size_t)m * DM, a.in[15], ws + WS_MEMN + (size_t)m * DM, lane);
}

__device__ __forceinline__ float gelu_tanh(float x) { const float x2 = x * x; const float z2 = x * (-2.0f * 0.7978845608028654f * 1.4426950408889634f) * (1.0f + 0.044715f * x2);
    return x * __builtin_amdgcn_rcpf(1.0f + __builtin_amdgcn_exp2f(z2)); }
__device__ __forceinline__ bool moe_item_load(f32x4 (&v)[8], const Args& a, int s, int lane) {
    if (s < NEXP * 512) { const int e = s / 512, r = s % 512, kb = r / 32, nb = r % 32, j = nb >> 3, half = (nb >> 2) & 1, q = nb & 3;
        tr_load(v, a.in[24] + (size_t)e * DM * DM, DM, 64 * kb, half * 512 + j * 128 + q * 32, lane); return true; }
    const int it = s - NEXP * 512 + WDN_SPLIT; if (it >= NEXP * 256) return false;
    const int e = it / 256, r = it % 256; tr_load(v, a.in[25] + (size_t)e * DFF * DM, DM, 64 * (r / 32), 32 * (r % 32), lane); return true;
}
__device__ __forceinline__ void moe_item_finish(const f32x4 (&v)[8], const Args& a, int s, LAS float* scr, int lane) {
    if (s < NEXP * 512) { const int e = s / 512, r = s % 512, kb = r / 32, nb = r % 32, j = nb >> 3, half = (nb >> 2) & 1, q = nb & 3;
        tr_finish8(v, 64 * kb, a.ws + WS_WGU, DM, e * 1024 + j * 256 + half * 128 + q * 32, a.in[19], WGU_SC, scr, lane); return; }
    const int it = s - NEXP * 512 + WDN_SPLIT; const int e = it / 256, r = it % 256;
    tr_finish8(v, 64 * (r / 32), a.ws + WS_WDN, DFF, e * 1024 + 32 * (r % 32), nullptr, WDN_SC, scr, lane);
}
__device__ __forceinline__ void lru_unit(const Args& a, const Ctx& C, int b, int blk, int half, int L) {
    unsigned char* ws = a.ws;
    const bf16_t* XL = (const bf16_t*)(ws + WS_A); const bf16_t* GL = XL + (size_t)NTOK * 512; bf16_t* YC = (bf16_t*)(ws + WS_C); float* SSQL = (float*)(ws + WS_SSQL);
    const int tid = C.tid, lane = C.lane, wave = C.wave, fr = lane & 15, fq = lane >> 4;
    LAS float* cscr = (LAS float*)(C.lds + 46336 + wave * 8448);
    LAS float* XW = (LAS float*)(C.lds + wave * 5120);
    LAS bf16_t* GW = (LAS bf16_t*)(C.lds + wave * 5120 + 2304);
    LAS bf16_t* YW = (LAS bf16_t*)(C.lds + wave * 5120 + 3584);
    LAS float* WSUM = (LAS float*)(C.lds + 40960);
    LAS float* CW = (LAS float*)(C.lds + 45056);
    const int c0 = blk * 64, oc0 = c0 + half * 32;
    bf16x8 wfr[2][2][2];
#pragma unroll
    for (int gt = 0; gt < 2; ++gt) { const float* W = a.in[gt == 0 ? 6 : 8] + (size_t)blk * 64 * 64;
#pragma unroll
        for (int nt = 0; nt < 2; ++nt)
#pragma unroll
            for (int ks = 0; ks < 2; ++ks) { u32x4 w; float f[8];
#pragma unroll
                for (int j = 0; j < 8; ++j) f[j] = W[(32 * ks + 8 * fq + j) * 64 + half * 32 + 16 * nt + fr];
                w.x = cvt_pk_bf16(f[0], f[1]); w.y = cvt_pk_bf16(f[2], f[3]); w.z = cvt_pk_bf16(f[4], f[5]); w.w = cvt_pk_bf16(f[6], f[7]);
                wfr[gt][nt][ks] = __builtin_bit_cast(bf16x8, w); } }
    LAS bf16x8* WF = (LAS bf16x8*)(C.lds + 113920);
    if (wave == 0) {
#pragma unroll
        for (int gt = 0; gt < 2; ++gt)
#pragma unroll
            for (int nt = 0; nt < 2; ++nt)
#pragma unroll
                for (int ks = 0; ks < 2; ++ks) WF[((gt * 2 + nt) * 2 + ks) * 64 + lane] = wfr[gt][nt][ks]; }
    float brg[2], big[2], sp[2], hc[2] = {0.f, 0.f};
#pragma unroll
    for (int nt = 0; nt < 2; ++nt) { const int ch = oc0 + 16 * nt + fr; brg[nt] = a.in[7][ch] * -1.4426950408889634f; big[nt] = a.in[9][ch] * -1.4426950408889634f; const float lam = a.in[10][ch];
        sp[nt] = -8.0f * 1.4426950408889634f * ((lam > 15.f) ? __expf(-lam) : log1pf(__expf(-lam))); }
    if (tid < 320) { const int k = tid >> 6, c = tid & 63; CW[tid] = (k < 4) ? a.in[4][k * DLRU + c0 + c] : a.in[5][c0 + c]; }
    u32x4 xr1[4][2], gr1;
    const bf16_t* xrow0 = XL + ((size_t)b * SEQ + 16 * wave + fr) * 512 + c0 + 8 * fq;
    const bf16_t* grow0 = GL + ((size_t)b * SEQ + 16 * wave + (lane >> 2)) * 512 + oc0 + 8 * (lane & 3);
    const int tloc = 16 * wave + fr;
#define LRU_PREFETCH(t0_, xr, gr) do { _Pragma("unroll") for (int k = 0; k < 4; ++k) { const int tt = (t0_) + tloc - 3 + k; \
        if (tt >= 0) { const bf16_t* xp = xrow0 + (ptrdiff_t)((t0_) - 3 + k) * 512; xr[k][0] = *(const u32x4*)xp; xr[k][1] = *(const u32x4*)(xp + 32); } else { xr[k][0] = (u32x4){0u, 0u, 0u, 0u}; xr[k][1] = (u32x4){0u, 0u, 0u, 0u}; } } \
        gr = *(const u32x4*)(grow0 + (size_t)(t0_) * 512); } while (0)
    LRU_PREFETCH(0, xr1, gr1);
    __syncthreads();
    for (int ch2 = 0; ch2 < SEQ / 256; ++ch2) {
#pragma unroll
      for (int sub = 0; sub < 2; ++sub) { const int ch = 2 * ch2 + sub, t0 = ch * 128; auto& xr = xr1; auto& gr = gr1;
        f32x4 cv[8]; const int cslot = sub * (NEXP * 512) + (ch2 * 256 + L) * 8 + wave; const bool chas = moe_item_load(cv, a, cslot, lane);
        bf16x8 af[2];
#pragma unroll
        for (int ks = 0; ks < 2; ++ks) { float accv[8];
            { const f32x4 b0 = *(const LAS f32x4*)(CW + 256 + 32 * ks + 8 * fq), b1 = *(const LAS f32x4*)(CW + 256 + 32 * ks + 8 * fq + 4);
              accv[0] = b0[0]; accv[1] = b0[1]; accv[2] = b0[2]; accv[3] = b0[3]; accv[4] = b1[0]; accv[5] = b1[1]; accv[6] = b1[2]; accv[7] = b1[3]; }
#pragma unroll
            for (int k = 0; k < 4; ++k) { const f32x4 w0 = *(const LAS f32x4*)(CW + 64 * k + 32 * ks + 8 * fq), w1 = *(const LAS f32x4*)(CW + 64 * k + 32 * ks + 8 * fq + 4); const u32x4 x = xr[k][ks];
                accv[0] += w0[0] * bflo(x.x); accv[1] += w0[1] * bfhi(x.x); accv[2] += w0[2] * bflo(x.y); accv[3] += w0[3] * bfhi(x.y);
                accv[4] += w1[0] * bflo(x.z); accv[5] += w1[1] * bfhi(x.z); accv[6] += w1[2] * bflo(x.w); accv[7] += w1[3] * bfhi(x.w); }
            u32x4 p; p.x = cvt_pk_bf16(accv[0], accv[1]); p.y = cvt_pk_bf16(accv[2], accv[3]); p.z = cvt_pk_bf16(accv[4], accv[5]); p.w = cvt_pk_bf16(accv[6], accv[7]);
            af[ks] = __builtin_bit_cast(bf16x8, p);
            if (ks == half) { *(LAS f32x4*)(XW + fr * 36 + 8 * fq) = (f32x4){accv[0], accv[1], accv[2], accv[3]}; *(LAS f32x4*)(XW + fr * 36 + 8 * fq + 4) = (f32x4){accv[4], accv[5], accv[6], accv[7]}; } }
        *(LAS u32x4*)(GW + (lane >> 2) * 40 + 8 * (lane & 3)) = gr;
        if (ch + 1 < SEQ / 128) LRU_PREFETCH(t0 + 128, xr, gr);
        LDS_WAIT(); asm volatile("" ::: "memory");
        float Hl[2][4], Al[2][4], Aex[2], Hex[2];
        { f32x4 ar[2] = {{0.f, 0.f, 0.f, 0.f}, {0.f, 0.f, 0.f, 0.f}}, ai_[2] = {{0.f, 0.f, 0.f, 0.f}, {0.f, 0.f, 0.f, 0.f}};
#pragma unroll
          for (int ks = 0; ks < 2; ++ks)
#pragma unroll
              for (int nt = 0; nt < 2; ++nt) { ar[nt] = __builtin_amdgcn_mfma_f32_16x16x32_bf16(af[ks], WF[((0 * 2 + nt) * 2 + ks) * 64 + lane], ar[nt], 0, 0, 0); ai_[nt] = __builtin_amdgcn_mfma_f32_16x16x32_bf16(af[ks], WF[((1 * 2 + nt) * 2 + ks) * 64 + lane], ai_[nt], 0, 0, 0); }
#pragma unroll
          for (int nt = 0; nt < 2; ++nt) {
              float hrun = 0.f, arun = 1.f;
#pragma unroll
              for (int r = 0; r < 4; ++r) { const int chn = 16 * nt + fr;
                  const float rg = __builtin_amdgcn_rcpf(1.0f + __builtin_amdgcn_exp2f(__builtin_fmaf(ar[nt][r], -1.4426950408889634f, brg[nt])));
                  const float ig = __builtin_amdgcn_rcpf(1.0f + __builtin_amdgcn_exp2f(__builtin_fmaf(ai_[nt][r], -1.4426950408889634f, big[nt])));
                  const float av = __builtin_amdgcn_exp2f(rg * sp[nt]); const float mult = __builtin_amdgcn_sqrtf(fmaxf(1.0f - av * av, 0.f));
                  const float uv = mult * ig * XW[(4 * fq + r) * 36 + chn];
                  hrun = av * hrun + uv; arun *= av; Hl[nt][r] = hrun; Al[nt][r] = arun; }
              const float A0 = __shfl(arun, fr), H0 = __shfl(hrun, fr), A1 = __shfl(arun, fr + 16), H1 = __shfl(hrun, fr + 16), A2 = __shfl(arun, fr + 32), H2 = __shfl(hrun, fr + 32), A3 = __shfl(arun, fr + 48), H3 = __shfl(hrun, fr + 48);
              const float h01 = A1 * H0 + H1, a01 = A1 * A0, h012 = A2 * h01 + H2, a012 = A2 * a01;
              Aex[nt] = (fq == 0) ? 1.f : (fq == 1) ? A0 : (fq == 2) ? a01 : a012;
              Hex[nt] = (fq == 0) ? 0.f : (fq == 1) ? H0 : (fq == 2) ? h01 : h012;
              if (fq == 0) *(LAS f32x2*)(WSUM + (((ch & 1) * 8 + wave) * 32 + 16 * nt + fr) * 2) = (f32x2){A3 * a012, A3 * h012 + H3}; } }
        __syncthreads();
        { float ssr[4] = {0.f, 0.f, 0.f, 0.f};
#pragma unroll
          for (int nt = 0; nt < 2; ++nt) { const int chn = 16 * nt + fr; float x = hc[nt], mine = 0.f;
#pragma unroll
              for (int w2 = 0; w2 < 8; ++w2) { const f32x2 sm = *(const LAS f32x2*)(WSUM + (((ch & 1) * 8 + w2) * 32 + chn) * 2); if (w2 == wave) mine = x; x = sm[0] * x + sm[1]; }
              hc[nt] = x;
              const float hstart = Aex[nt] * mine + Hex[nt];
#pragma unroll
              for (int r = 0; r < 4; ++r) { const int tl = 4 * fq + r; const float h = Al[nt][r] * hstart + Hl[nt][r];
                  const float y = h * gelu_tanh(bf2f(GW[tl * 40 + chn])); const unsigned yb = cvt_pk_bf16(y, 0.f) & 0xffffu; YW[tl * 40 + chn] = (bf16_t)yb;
                  const float yr = __uint_as_float(yb << 16); ssr[r] += yr * yr; } }
#pragma unroll
          for (int r = 0; r < 4; ++r) { float q = ssr[r]; q += __shfl_xor(q, 1); q += __shfl_xor(q, 2); q += __shfl_xor(q, 4); q += __shfl_xor(q, 8);
              if (fr == 0) SSQL[((size_t)b * SEQ + t0 + 16 * wave + 4 * fq + r) * 16 + blk * 2 + half] = q; } }
        LDS_WAIT(); asm volatile("" ::: "memory");
        *(u32x4*)(YC + ((size_t)b * SEQ + t0 + 16 * wave + (lane >> 2)) * DM + oc0 + 8 * (lane & 3)) = *(const LAS u32x4*)(YW + (lane >> 2) * 40 + 8 * (lane & 3));
        if (chas) moe_item_finish(cv, a, cslot, cscr, lane);
      }
    }
#undef LRU_PREFETCH
    __syncthreads();
}


__device__ __forceinline__ void ph_router(const Args& a, const Ctx& C) {
    unsigned char* ws = a.ws;
    const bf16_t* H2B = (const bf16_t*)a.out + DM; const bf16_t* WR = (const bf16_t*)(ws + WS_WR); const float* SSQ2 = (const float*)(ws + WS_SSQ2);
    unsigned* CNT = (unsigned*)(ws + WS_CTL) + CW_CNT;
    int* TOKE = (int*)(ws + WS_TOK + TOK_E); int* TOKR = (int*)(ws + WS_TOK + TOK_R); float* TOKG = (float*)(ws + WS_TOK + TOK_G); int* LTOK = (int*)(ws + WS_LTOK); float* LRS = (float*)(ws + WS_LRS);
    constexpr int WRS = 1032;
    LAS bf16_t* WRL = (LAS bf16_t*)C.lds;
    LAS float* LG = (LAS float*)(C.lds + 99072) + C.wave * (16 * 49);
    LAS unsigned* lcnt = (LAS unsigned*)(C.lds + 99072 + 25088); LAS unsigned* lbase = lcnt + 32;
    const int lane = C.lane, fr = lane & 15, fq = lane >> 4;
    for (int i = C.tid; i < 48 * 128; i += 512) { const int r = i >> 7, c8 = i & 127; *(LAS u32x4*)(WRL + r * WRS + 8 * c8) = *(const u32x4*)(WR + (size_t)r * DM + 8 * c8); }
    for (int pass = 0; (pass * C.G) * 128 < NTOK; ++pass) {
        const int blk = pass * C.G + C.vcu; const bool live = blk * 128 < NTOK;
        if (C.tid < 32) lcnt[C.tid] = 0u;
        __syncthreads();
        int E1 = 0, E2 = 0; unsigned r1 = 0, r2 = 0; float ga = 0.f, gb = 0.f, rstd_t = 0.f; const int tb = blk * 128 + 16 * C.wave;
        if (live) {
            f32x4 acc[3] = {{0.f, 0.f, 0.f, 0.f}, {0.f, 0.f, 0.f, 0.f}, {0.f, 0.f, 0.f, 0.f}};
            bf16x8 af[32];
#pragma unroll
            for (int ks = 0; ks < 32; ++ks) af[ks] = *(const bf16x8*)(H2B + (size_t)(tb + fr) * LDH + 32 * ks + 8 * fq);
#pragma unroll
            for (int ks = 0; ks < 32; ++ks) {
#pragma unroll
                for (int nt = 0; nt < 3; ++nt) { const bf16x8 bfg = *(const LAS bf16x8*)(WRL + (16 * nt + fr) * WRS + 32 * ks + 8 * fq); acc[nt] = __builtin_amdgcn_mfma_f32_16x16x32_bf16(af[ks], bfg, acc[nt], 0, 0, 0); } }
#pragma unroll
            for (int nt = 0; nt < 3; ++nt)
#pragma unroll
                for (int r = 0; r < 4; ++r) LG[(4 * fq + r) * 49 + 16 * nt + fr] = acc[nt][r];
            LDS_WAIT(); asm volatile("" ::: "memory");
            if (lane < 16) { const int t = tb + lane; const float rstd = rstd_from_ssq(SSQ2, t); rstd_t = rstd; const LAS float* lg = LG + lane * 49;
                float g[4]; int grp = 0;
#pragma unroll
                for (int i = 0; i < 4; ++i) g[i] = lg[i] * rstd + a.in[21][i];
#pragma unroll
                for (int i = 1; i < 4; ++i) if (g[i] > g[grp]) grp = i;
                float gs = 0.f;
#pragma unroll
                for (int i = 0; i < 4; ++i) gs += __expf(g[i] - g[grp]);
                const float gw_ = 1.0f / gs;
                float e[8];
#pragma unroll
                for (int i = 0; i < 8; ++i) e[i] = lg[4 + 8 * grp + i] * rstd + a.in[23][8 * grp + i];
                int i1 = 0;
#pragma unroll
                for (int i = 1; i < 8; ++i) if (e[i] > e[i1]) i1 = i;
                int i2 = (i1 == 0) ? 1 : 0;
#pragma unroll
                for (int i = 0; i < 8; ++i) if (i != i1 && i != i2 && e[i] > e[i2]) i2 = i;
                const float eb = __expf(e[i2] - e[i1]); ga = gw_ / (1.0f + eb); gb = gw_ * eb / (1.0f + eb);
                E1 = grp * 8 + i1; E2 = grp * 8 + i2;
                r1 = atomicAdd((unsigned*)&lcnt[E1], 1u); r2 = atomicAdd((unsigned*)&lcnt[E2], 1u);
            }
        }
        __syncthreads();
        if (C.tid < 32) lbase[C.tid] = lcnt[C.tid] ? __hip_atomic_fetch_add(CNT + C.tid, lcnt[C.tid], __ATOMIC_RELAXED, __HIP_MEMORY_SCOPE_AGENT) : 0u;
        __syncthreads();
        if (live && lane < 16) { const int t = tb + lane;
            const int k1 = (int)(lbase[E1] + r1), k2 = (int)(lbase[E2] + r2);
            TOKE[2 * t] = E1; TOKR[2 * t] = k1; TOKG[2 * t] = ga; LTOK[E1 * LCAP + k1] = t; LRS[E1 * LCAP + k1] = rstd_t;
            TOKE[2 * t + 1] = E2; TOKR[2 * t + 1] = k2; TOKG[2 * t + 1] = gb; LTOK[E2 * LCAP + k2] = t; LRS[E2 * LCAP + k2] = rstd_t; }
        __syncthreads();
    }
}
__device__ __forceinline__ void moe_table(const Args& a, const Ctx& C) {
    LAS int* ts = (LAS int*)(C.lds + MOE_OFF);
    if (C.tid == 0) { const unsigned* CNT = (const unsigned*)(a.ws + WS_CTL) + CW_CNT; int acc = 0;
        for (int e = 0; e < NEXP; ++e) { ts[e] = acc; const unsigned c = __hip_atomic_load(CNT + e, __ATOMIC_RELAXED, __HIP_MEMORY_SCOPE_AGENT); ts[33 + e] = (int)c; acc += (int)((c + 255u) >> 8); }
        ts[NEXP] = acc; }
    __syncthreads();
}
__device__ __forceinline__ void ph_final(const Args& a, const Ctx& C, float* outp) {
    unsigned char* ws = a.ws;
    const unsigned char* YB = ws + WS_A; const float* TOKG = (const float*)(ws + WS_TOK + TOK_G); const int* TOKE = (const int*)(ws + WS_TOK + TOK_E); const int* TOKR = (const int*)(ws + WS_TOK + TOK_R);
    const LAS int* ts = (const LAS int*)(C.lds + MOE_OFF);
    const bf16_t* H2B = (const bf16_t*)a.out + DM; const float* gf = a.in[26];
    const int gw = C.vcu * 8 + C.wave, NGW = C.G * 8, lane = C.lane;
    f32x4 gn[4];
#pragma unroll
    for (int q = 0; q < 4; ++q) gn[q] = *(const f32x4*)(gf + 512 * (q >> 1) + 8 * lane + 4 * (q & 1));
    const int nit = (NTOK + NGW - 1) / NGW;
    int dnx = 0; float gnx = 0.f;
#define FIN_IDX(ib) do { const int tt_ = gw + ((ib) + (lane >> 1)) * NGW; dnx = 0; gnx = 0.f; \
        if (lane < 8 && tt_ < NTOK) { const int e_ = TOKE[2 * tt_ + (lane & 1)]; dnx = ts[e_] * 256 + TOKR[2 * tt_ + (lane & 1)]; gnx = TOKG[2 * tt_ + (lane & 1)]; } } while (0)
    FIN_IDX(0);
    for (int ib = 0; ib < nit; ib += 4) {
        const int dcur = dnx; const float gcur = gnx;
        if (ib + 4 < nit) FIN_IDX(ib + 4);
        u32x4 hw[4][2]; u32x2 y0[4][2], y1[4][2];
#pragma unroll
        for (int j = 0; j < 4; ++j) { const int t = gw + (ib + j) * NGW; const int d0 = __builtin_amdgcn_readlane(dcur, 2 * j), d1 = __builtin_amdgcn_readlane(dcur, 2 * j + 1);
            if (t < NTOK) {
#pragma unroll
                for (int hf = 0; hf < 2; ++hf) { hw[j][hf] = *((const u32x4*)(H2B + (size_t)t * LDH + 512 * hf) + lane); y0[j][hf] = *((const u32x2*)(YB + (size_t)d0 * DM + 512 * hf) + lane); y1[j][hf] = *((const u32x2*)(YB + (size_t)d1 * DM + 512 * hf) + lane); } } }
#pragma unroll
        for (int j = 0; j < 4; ++j) { const int t = gw + (ib + j) * NGW;
            const float g0 = __builtin_bit_cast(float, __builtin_amdgcn_readlane(__builtin_bit_cast(int, gcur), 2 * j)) * (1.0f / YB_SC), g1 = __builtin_bit_cast(float, __builtin_amdgcn_readlane(__builtin_bit_cast(int, gcur), 2 * j + 1)) * (1.0f / YB_SC);
            if (t < NTOK) { float v[16]; float s2 = 0.f;
#pragma unroll
                for (int hf = 0; hf < 2; ++hf)
#pragma unroll
                    for (int w = 0; w < 2; ++w) { const int yw0 = (int)y0[j][hf][w], yw1 = (int)y1[j][hf][w];
                        const f32x2 pa = __builtin_amdgcn_cvt_pk_f32_fp8(yw0, false), pb = __builtin_amdgcn_cvt_pk_f32_fp8(yw0, true), qa = __builtin_amdgcn_cvt_pk_f32_fp8(yw1, false), qb = __builtin_amdgcn_cvt_pk_f32_fp8(yw1, true);
                        const unsigned ha = hw[j][hf][2 * w], hb = hw[j][hf][2 * w + 1];
                        const float e0 = bflo(ha) + g0 * pa[0] + g1 * qa[0], e1 = bfhi(ha) + g0 * pa[1] + g1 * qa[1], e2 = bflo(hb) + g0 * pb[0] + g1 * qb[0], e3 = bfhi(hb) + g0 * pb[1] + g1 * qb[1];
                        v[8 * hf + 4 * w] = e0; v[8 * hf + 4 * w + 1] = e1; v[8 * hf + 4 * w + 2] = e2; v[8 * hf + 4 * w + 3] = e3; s2 += (e0 * e0 + e1 * e1) + (e2 * e2 + e3 * e3); }
                const float rstd = __builtin_amdgcn_rsqf(wave_sum(s2) * (1.0f / DM) + EPS);
#pragma unroll
                for (int q = 0; q < 4; ++q) { const f32x4 o = {v[4 * q] * rstd * gn[q][0], v[4 * q + 1] * rstd * gn[q][1], v[4 * q + 2] * rstd * gn[q][2], v[4 * q + 3] * rstd * gn[q][3]};
                    *(f32x4*)(outp + (size_t)t * DM + 512 * (q >> 1) + 8 * lane + 4 * (q & 1)) = o; } } }
    }
#undef FIN_IDX
}

#include <hip/hip_bf16.h>
#include <cmath>
namespace attn_body {
using bf16=__hip_bfloat16;
using bf16x8=__attribute__((ext_vector_type(8)))short;
using s16x4=__attribute__((ext_vector_type(4)))short;
using f32x16=__attribute__((ext_vector_type(16)))float;
using u32x4=__attribute__((ext_vector_type(4)))unsigned;
using f32x4_t=__attribute__((ext_vector_type(4)))float;
constexpr int BATCH=16,NHEAD=8,SEQ=2048,D=64,DM=NHEAD*D,DMO=1024;
constexpr int NW=8,QBLK=32,QB=QBLK*NW,KVBLK=64,NQB=SEQ/QB;
constexpr int ATTN_PITCH=DM, ATTN_UNIT_ROWS=QB;
__device__ __forceinline__ int crow(int r,int hi){return (r&3)+8*(r>>2)+4*hi;}
#define SBAR() __builtin_amdgcn_sched_barrier(0)
__device__ __forceinline__ void cmask(f32x16&p0,f32x16&p1,int jb,int qrel,int hi){
  const float NEG=-INFINITY; int kb=64*jb+4*hi; asm volatile("":"+v"(kb));
  #pragma unroll
  for(int r=0;r<16;++r){int kv=kb+(r&3)+8*(r>>2); if(kv>qrel)p0[r]=NEG; if(kv+32>qrel)p1[r]=NEG;}
}

constexpr int NSLOT=3, SLOTB=8192;
constexpr int LDS_K=0, LDS_V=NSLOT*SLOTB, LDS_WS=2*NSLOT*SLOTB, LDS_OST=LDS_WS+NW*64*4, LDS_BYTES=LDS_OST+NW*4096;
constexpr float C2=0.125f*1.4426950408889634f;
__device__ __forceinline__ void glds16(const char*sbase,unsigned voff,unsigned lds_dst){unsigned keep;
  asm volatile("s_nop 4\n\ts_mov_b32 %0, m0\n\ts_mov_b32 m0, %3\n\ts_nop 0\n\tglobal_load_lds_dwordx4 %1, %2\n\ts_mov_b32 m0, %0":"=&s"(keep):"v"(voff),"s"(sbase),"s"(lds_dst):"memory");}
__device__ __forceinline__ const char* uni_ptr(const void*p){const unsigned long long v=(unsigned long long)p;const unsigned lo=__builtin_amdgcn_readfirstlane((unsigned)v),hi=__builtin_amdgcn_readfirstlane((unsigned)(v>>32));return (const char*)(((unsigned long long)hi<<32)|lo);}
__device__ __forceinline__ float max3f(float a,float b,float c){float r;asm("v_max3_f32 %0, %1, %2, %3":"=v"(r):"v"(a),"v"(b),"v"(c));return r;}
__device__ __forceinline__ float max2f(float a,float b){float r;asm("v_max_f32_e32 %0, %1, %2":"=v"(r):"v"(a),"v"(b));return r;}
__device__ __forceinline__ float fadd_s(float a,float b){float r;asm("v_add_f32_e32 %0, %1, %2":"=v"(r):"v"(a),"v"(b));return r;}
__device__ __forceinline__ float fsub_s(float a,float b){float r;asm("v_sub_f32_e32 %0, %1, %2":"=v"(r):"v"(a),"v"(b));return r;}
typedef float f32x2_t __attribute__((ext_vector_type(2))); typedef __bf16 bf16x2_t __attribute__((ext_vector_type(2)));
__device__ __forceinline__ unsigned cvtpk_s(float lo,float hi){f32x2_t v={lo,hi};bf16x2_t b=__builtin_convertvector(v,bf16x2_t);return __builtin_bit_cast(unsigned,b);}
#define WAIT_BAR(N) asm volatile("s_waitcnt vmcnt(" #N ") lgkmcnt(0)\n\ts_barrier":::"memory")

__device__ __forceinline__ void qkt(f32x16&p0,f32x16&p1,const char*Kslot,const bf16x8*qr,const f32x16&negm,int r32,int hi){
  const char*kb=Kslot+hi*1024+r32*16;
  #pragma unroll
  for(int d0=0;d0<4;++d0){
    const bf16x8 b0=*reinterpret_cast<const bf16x8*>(kb+d0*2048);
    const bf16x8 b1=*reinterpret_cast<const bf16x8*>(kb+d0*2048+512);
    if(d0==0){p0=__builtin_amdgcn_mfma_f32_32x32x16_bf16(b0,qr[0],negm,0,0,0);p1=__builtin_amdgcn_mfma_f32_32x32x16_bf16(b1,qr[0],negm,0,0,0);}
    else{p0=__builtin_amdgcn_mfma_f32_32x32x16_bf16(b0,qr[d0],p0,0,0,0);p1=__builtin_amdgcn_mfma_f32_32x32x16_bf16(b1,qr[d0],p1,0,0,0);}}
}
typedef __attribute__((address_space(3))) const char* lds_cptr;
typedef short v4i16_t __attribute__((ext_vector_type(4)));
__device__ __forceinline__ void kload8(bf16x8*kf,lds_cptr kp){
  kf[0]=*(const __attribute__((address_space(3))) bf16x8*)(kp);      kf[1]=*(const __attribute__((address_space(3))) bf16x8*)(kp+512);
  kf[2]=*(const __attribute__((address_space(3))) bf16x8*)(kp+2048); kf[3]=*(const __attribute__((address_space(3))) bf16x8*)(kp+2560);
  kf[4]=*(const __attribute__((address_space(3))) bf16x8*)(kp+4096); kf[5]=*(const __attribute__((address_space(3))) bf16x8*)(kp+4608);
  kf[6]=*(const __attribute__((address_space(3))) bf16x8*)(kp+6144); kf[7]=*(const __attribute__((address_space(3))) bf16x8*)(kp+6656);
}
__device__ __forceinline__ void kload2(bf16x8*kf,lds_cptr kp,int j){ kf[2*j]=*(const __attribute__((address_space(3))) bf16x8*)(kp+j*2048); kf[2*j+1]=*(const __attribute__((address_space(3))) bf16x8*)(kp+j*2048+512); }
__device__ __forceinline__ s16x4 vtr(lds_cptr p){ return __builtin_bit_cast(s16x4,__builtin_amdgcn_ds_read_tr16_b64_v4i16((__attribute__((address_space(3))) v4i16_t*)p)); }
__device__ __forceinline__ float rowmax(const f32x16&p0,const f32x16&p1){
  float a=max3f(p0[0],p0[1],p1[0]),b=max3f(p0[2],p0[3],p1[1]);a=max3f(a,p1[2],p1[3]);
  #pragma unroll
  for(int r=4;r<16;r+=4){a=max3f(a,p0[r],p0[r+1]);b=max3f(b,p0[r+2],p0[r+3]);a=max3f(a,p1[r],p1[r+1]);b=max3f(b,p1[r+2],p1[r+3]);}
  const float m=max2f(a,b);
  auto rr=__builtin_amdgcn_permlane32_swap(__float_as_uint(m),__float_as_uint(m),false,false);
  return max2f(__uint_as_float(rr[0]),__uint_as_float(rr[1]));
}
__device__ __forceinline__ void pv(f32x16*o,int vb,bf16x8 pa0,bf16x8 pa1,bf16x8 pa2,bf16x8 pa3){
  #pragma unroll
  for(int d0=0;d0<2;++d0){s16x4 lo[4],hi[4];
    #pragma unroll
    for(int ks=0;ks<4;++ks){
      asm volatile("ds_read_b64_tr_b16 %0,%1 offset:%c2":"=&v"(lo[ks]):"v"(vb),"i"(d0*4096+ks*1024):"memory");
      asm volatile("ds_read_b64_tr_b16 %0,%1 offset:%c2":"=&v"(hi[ks]):"v"(vb),"i"(d0*4096+ks*1024+512):"memory");}
    asm volatile("s_waitcnt lgkmcnt(0)":::"memory");SBAR();
    #define PK(k) (bf16x8){lo[k][0],lo[k][1],lo[k][2],lo[k][3],hi[k][0],hi[k][1],hi[k][2],hi[k][3]}
    o[d0]=__builtin_amdgcn_mfma_f32_32x32x16_bf16(pa0,PK(0),o[d0],0,0,0);
    o[d0]=__builtin_amdgcn_mfma_f32_32x32x16_bf16(pa1,PK(1),o[d0],0,0,0);
    o[d0]=__builtin_amdgcn_mfma_f32_32x32x16_bf16(pa2,PK(2),o[d0],0,0,0);
    o[d0]=__builtin_amdgcn_mfma_f32_32x32x16_bf16(pa3,PK(3),o[d0],0,0,0);
    #undef PK
  }
}

#ifndef ATTN_STORE16
#define ATTN_STORE16(p,v) (*(u32x4*)(p)=(v))
#endif
template<int THRL> __device__ __forceinline__ void attn_unit(int b,int h,int qb,const bf16*Q,const bf16*__restrict__ K,const bf16*__restrict__ V,bf16*O,const float*__restrict__ KSUM,float*__restrict__ SSQA,char*shm){
  int tid=threadIdx.x; asm volatile("":"+v"(tid));
  const int lane=tid&63,r32=lane&31,hi=lane>>5; const int wid=__builtin_amdgcn_readfirstlane(tid>>6);
  const long rowbase=(long)b*SEQ; const int q0=qb*QB;
  const bf16*Qw=Q+(rowbase+q0+wid*QBLK)*DM+h*D;
  const bf16*Kh=K+rowbase*DM+h*D,*Vh=V+rowbase*DM+h*D;
  const unsigned lds0=(unsigned)(uintptr_t)shm;
  float*wsf=(float*)(shm+LDS_WS)+wid*64;
  const char*Khu=uni_ptr(Kh);const char*Vhu=uni_ptr(Vh);
  const unsigned kvo=(unsigned)(lane*DM+wid*8)*2u;
  const unsigned vvo=(unsigned)((16*(wid&3)+(lane>>2))*DM+(wid>>2)*32+(lane&3)*8)*2u;
  const unsigned kdst=lds0+LDS_K+wid*1024, vdst=lds0+LDS_V+wid*1024;
  #define DMA_K(t,slot) glds16(Khu+(size_t)(t)*(KVBLK*DM*2),kvo,(unsigned)__builtin_amdgcn_readfirstlane(kdst+(slot)))
  #define DMA_V(t,slot) glds16(Vhu+(size_t)(t)*(KVBLK*DM*2),vvo,(unsigned)__builtin_amdgcn_readfirstlane(vdst+(slot)))
  const int vb0=(int)(lds0+LDS_V)+((lane>>4)&1)*32+(lane&3)*8+(4*hi+((lane&15)>>2))*64;
  const char*Kbase=shm+LDS_K; bf16x8 kf[8];
  const lds_cptr shm3=(lds_cptr)shm; const lds_cptr kp0=shm3+LDS_K+hi*1024+r32*16; const lds_cptr vp0=shm3+LDS_V+((lane>>4)&1)*32+(lane&3)*8+(4*hi+((lane&15)>>2))*64;
  const int NT=(q0+QB)/KVBLK;
  DMA_K(0,0);DMA_V(0,0);DMA_K(1,SLOTB);
  bf16x8 qr[4];
  #pragma unroll
  for(int d0=0;d0<4;++d0)qr[d0]=*reinterpret_cast<const bf16x8*>(&Qw[(long)r32*DM+d0*16+hi*8]);
  unsigned selm=1u<<qb;
  { float g[8];
    #pragma unroll
    for(int n=0;n<8;++n){ g[n]=-INFINITY;
      if(n<qb){ const float*ks=KSUM+(long)(b*8+n)*DM+h*D+hi*8; float s=0.f;
        #pragma unroll
        for(int d0=0;d0<4;++d0){ const f32x4_t k0=*reinterpret_cast<const f32x4_t*>(ks+d0*16), k1=*reinterpret_cast<const f32x4_t*>(ks+d0*16+4);
          const u32x4 qw=__builtin_bit_cast(u32x4,qr[d0]);
          s+=__uint_as_float(qw[0]<<16)*k0[0]+__uint_as_float(qw[0]&0xffff0000u)*k0[1]+__uint_as_float(qw[1]<<16)*k0[2]+__uint_as_float(qw[1]&0xffff0000u)*k0[3]
            +__uint_as_float(qw[2]<<16)*k1[0]+__uint_as_float(qw[2]&0xffff0000u)*k1[1]+__uint_as_float(qw[3]<<16)*k1[2]+__uint_as_float(qw[3]&0xffff0000u)*k1[3]; }
        s+=__shfl_xor(s,32); g[n]=s; } }
    const int npick=qb<3?qb:3;
    for(int p=0;p<npick;++p){ int best=-1; float bv=-INFINITY;
      #pragma unroll
      for(int n=0;n<8;++n){ const bool ok=(n<qb)&&!((selm>>n)&1u)&&(best<0||g[n]>bv); if(ok){best=n;bv=g[n];} }
      if(best>=0)selm|=1u<<best; } }
  #define BMASK(P0,P1,t) do{ float bias_=((selm>>((t)>>2))&1u)?-mhat:-INFINITY; asm volatile("":"+v"(bias_)); _Pragma("unroll") for(int r=0;r<16;++r){P0[r]+=bias_;P1[r]+=bias_;} }while(0)
  float mhat=0.f,l_reg=0.f;f32x16 o[2];{float z0_=0.f;asm volatile("":"+v"(z0_));_Pragma("unroll") for(int r=0;r<16;++r){o[0][r]=z0_;o[1][r]=z0_;}}const f32x16 negm=f32x16{};
  const int qrel=wid*QBLK+r32;
  #define CMASK(P0,P1,t) do{int jb_=(t)-(NT-4); if(jb_>=0)cmask(P0,P1,jb_,qrel,hi);}while(0)
  bool resc=false;
  #define START(P0,P1) do{ const float rm=__builtin_fmaxf(rowmax(P0,P1),-100.0f); resc=false; \
    { const float dl=rm; mhat=fadd_s(mhat,dl); \
      _Pragma("unroll") for(int r=0;r<16;++r){P0[r]=fsub_s(P0[r],dl);P1[r]=fsub_s(P1[r],dl);} \
      } \
    _Pragma("unroll") for(int r=0;r<16;++r)P0[r]=__builtin_amdgcn_exp2f(P0[r]); }while(0)
  #define RESC() do{ if(resc){ asm volatile("s_waitcnt lgkmcnt(0)":::"memory"); \
      _Pragma("unroll") for(int d_=0;d_<2;++d_) _Pragma("unroll") for(int r=0;r<16;++r)o[d_][r]*=wsf[crow(r,hi)]; } }while(0)
  f32x16 pA0,pA1,pB0,pB1;
  int sl_prev=0,sl_cur=0,sl_next=SLOTB;
  #define ROT() do{sl_prev=sl_cur;sl_cur=sl_next;sl_next=(sl_next==(NSLOT-1)*SLOTB)?0:sl_next+SLOTB;}while(0)
  DMA_K(2,2*SLOTB);
  WAIT_BAR(3);
  qkt(pA0,pA1,Kbase,qr,negm,r32,hi);asm volatile("s_nop 15\n\ts_nop 7":"+v"(pA0),"+v"(pA1));CMASK(pA0,pA1,0);BMASK(pA0,pA1,0);
  START(pA0,pA1);
  _Pragma("unroll") for(int r=0;r<16;++r)pA1[r]=__builtin_amdgcn_exp2f(pA1[r]);
  WAIT_BAR(0);
  DMA_K(3,0);DMA_V(1,SLOTB);
  ROT();
  kload8(kf,kp0+sl_cur);
  WAIT_BAR(2);
  s16x4 vlo[8],vhi[8]; u32x4 pw0,pw1,pw2,pw3;
  #define PKW(P,B) cvtpk_s(P[B],P[B+1])
  #define PAF(k) __builtin_bit_cast(bf16x8,pw##k)
  #define VFR(i) (bf16x8){vlo[i][0],vlo[i][1],vlo[i][2],vlo[i][3],vhi[i][0],vhi[i][1],vhi[i][2],vhi[i][3]}
  #define PIN(x) asm volatile("":"+v"(x))
  #define MX3(a,b,c) __builtin_fmaxf(__builtin_fmaxf((a),(b)),(c))
  #define GAPA(MF,A0,A1,A2,A3,W0,W1,PW) do{ MF; sacc+=A0; sacc+=A1; sacc+=A2; sacc+=A3; PIN(sacc); W0; W1; PIN(PW); SBAR(); }while(0)
  #define EX(v) __builtin_amdgcn_exp2f(v)
  #define GAPB(MF,X,B) do{ MF; X[B]=EX(X[B]); X[B+1]=EX(X[B+1]); X[B+2]=EX(X[B+2]); X[B+3]=EX(X[B+3]); PIN(X); SBAR(); }while(0)
  #define VRD(i) do{ vlo[i]=vtr(vp_+(((i)>>2)*4096+((i)&3)*1024)); vhi[i]=vtr(vp_+(((i)>>2)*4096+((i)&3)*1024+512)); }while(0)
  #define KRD(G,j) do{ if(G){ kload2(kf,kp0+sl_next,j); SBAR(); } }while(0)
  #define STEP(C0,C1,P0,P1,t,GK,GV,GL) do{ SBAR(); \
    const lds_cptr vp_=vp0+sl_prev; \
    VRD(0); SBAR(); float sacc=(P0[0]+P0[1]); \
    GAPA(C0=__builtin_amdgcn_mfma_f32_32x32x16_bf16(kf[0],qr[0],negm,0,0,0), P0[2],P0[3],P0[4],P0[5],     pw0[0]=PKW(P0,0), pw0[1]=PKW(P0,2), pw0); \
    VRD(4); SBAR(); GAPA(C1=__builtin_amdgcn_mfma_f32_32x32x16_bf16(kf[1],qr[0],negm,0,0,0), P0[6],P0[7],P0[8],P0[9],     pw0[2]=PKW(P0,4), pw0[3]=PKW(P0,6), pw0); \
    VRD(1); SBAR(); GAPA(C0=__builtin_amdgcn_mfma_f32_32x32x16_bf16(kf[2],qr[1],C0,0,0,0),   P0[10],P0[11],P0[12],P0[13], pw1[0]=PKW(P0,8), pw1[1]=PKW(P0,10), pw1); \
    VRD(5); SBAR(); GAPA(C1=__builtin_amdgcn_mfma_f32_32x32x16_bf16(kf[3],qr[1],C1,0,0,0),   P0[14],P0[15],P1[0],P1[1],   pw1[2]=PKW(P0,12),pw1[3]=PKW(P0,14), pw1); \
    VRD(2); SBAR(); GAPA(C0=__builtin_amdgcn_mfma_f32_32x32x16_bf16(kf[4],qr[2],C0,0,0,0),   P1[2],P1[3],P1[4],P1[5],     pw2[0]=PKW(P1,0), pw2[1]=PKW(P1,2), pw2); \
    VRD(6); SBAR(); GAPA(C1=__builtin_amdgcn_mfma_f32_32x32x16_bf16(kf[5],qr[2],C1,0,0,0),   P1[6],P1[7],P1[8],P1[9],     pw2[2]=PKW(P1,4), pw2[3]=PKW(P1,6), pw2); \
    VRD(3); SBAR(); GAPA(C0=__builtin_amdgcn_mfma_f32_32x32x16_bf16(kf[6],qr[3],C0,0,0,0),   P1[10],P1[11],P1[12],P1[13], pw3[0]=PKW(P1,8), pw3[1]=PKW(P1,10), pw3); \
    VRD(7); SBAR(); GAPA(C1=__builtin_amdgcn_mfma_f32_32x32x16_bf16(kf[7],qr[3],C1,0,0,0),   P1[14],P1[15],0.f,0.f,       pw3[2]=PKW(P1,12),pw3[3]=PKW(P1,14), pw3); \
    l_reg+=sacc; \
    if(GK){DMA_K((t)+3,sl_cur);} if(GV){DMA_V((t)+1,sl_next);} \
    CMASK(C0,C1,t); BMASK(C0,C1,t); \
    { float a=MX3(C0[0],C0[1],C1[0]),b=MX3(C0[2],C0[3],C1[1]); a=MX3(a,C1[2],C1[3]); \
      _Pragma("unroll") for(int r=4;r<16;r+=4){a=MX3(a,C0[r],C0[r+1]);b=MX3(b,C0[r+2],C0[r+3]);a=MX3(a,C1[r],C1[r+1]);b=MX3(b,C1[r+2],C1[r+3]);} \
      float rm=__builtin_fmaxf(a,b); { auto rr=__builtin_amdgcn_permlane32_swap(__float_as_uint(rm),__float_as_uint(rm),false,false); rm=__builtin_fmaxf(__uint_as_float(rr[0]),__uint_as_float(rr[1])); } \
      resc=false; \
      if(__builtin_expect(__any(rm>(float)THRL),0)){ const float dl=__builtin_fmaxf(rm,0.f); mhat+=dl; \
        _Pragma("unroll") for(int r=0;r<16;++r){C0[r]-=dl;C1[r]-=dl;} \
        const float f=__builtin_amdgcn_exp2f(-dl); l_reg*=f; if(hi==0)wsf[r32]=f; resc=true; } } \
    SBAR(); \
    GAPB(o[0]=__builtin_amdgcn_mfma_f32_32x32x16_bf16(PAF(0),VFR(0),o[0],0,0,0), C0,0); \
    GAPB(o[1]=__builtin_amdgcn_mfma_f32_32x32x16_bf16(PAF(0),VFR(4),o[1],0,0,0), C0,4); \
    KRD(GL,0); GAPB(o[0]=__builtin_amdgcn_mfma_f32_32x32x16_bf16(PAF(1),VFR(1),o[0],0,0,0), C0,8); \
    KRD(GL,1); GAPB(o[1]=__builtin_amdgcn_mfma_f32_32x32x16_bf16(PAF(1),VFR(5),o[1],0,0,0), C0,12); \
    KRD(GL,2); GAPB(o[0]=__builtin_amdgcn_mfma_f32_32x32x16_bf16(PAF(2),VFR(2),o[0],0,0,0), C1,0); \
    KRD(GL,3); GAPB(o[1]=__builtin_amdgcn_mfma_f32_32x32x16_bf16(PAF(2),VFR(6),o[1],0,0,0), C1,4); \
    GAPB(o[0]=__builtin_amdgcn_mfma_f32_32x32x16_bf16(PAF(3),VFR(3),o[0],0,0,0), C1,8); \
    GAPB(o[1]=__builtin_amdgcn_mfma_f32_32x32x16_bf16(PAF(3),VFR(7),o[1],0,0,0), C1,12); \
    }while(0)
  int t=1;
  #undef CMASK
  #define CMASK(P0,P1,t) do{}while(0)
  for(;t+5<NT;t+=2){
    STEP(pB0,pB1,pA0,pA1,t,true,true,true);     WAIT_BAR(2); RESC(); ROT();
    STEP(pA0,pA1,pB0,pB1,t+1,true,true,true);   WAIT_BAR(2); RESC(); ROT();
  }
  #undef CMASK
  #define CMASK(P0,P1,t) do{int jb_=(t)-(NT-4); if(jb_>=0)cmask(P0,P1,jb_,qrel,hi);}while(0)
  #define ENDW(tt) do{ if((tt)+3<NT){WAIT_BAR(2);} else if((tt)+2<NT){WAIT_BAR(1);} else {WAIT_BAR(0);} }while(0)
  for(;t+1<NT;t+=2){
    STEP(pB0,pB1,pA0,pA1,t,(t+3<NT),(t+1<NT),(t+1<NT));       ENDW(t);   RESC(); ROT();
    STEP(pA0,pA1,pB0,pB1,t+1,(t+4<NT),(t+2<NT),(t+2<NT));     ENDW(t+1); RESC(); ROT();
  }
  STEP(pB0,pB1,pA0,pA1,NT-1,false,false,false); RESC();
  { float sacc=pB0[0]+pB0[1]; _Pragma("unroll") for(int r=2;r<16;++r)sacc+=pB0[r]; _Pragma("unroll") for(int r=0;r<16;++r)sacc+=pB1[r]; l_reg+=sacc;
    pw0=(u32x4){PKW(pB0,0),PKW(pB0,2),PKW(pB0,4),PKW(pB0,6)};pw1=(u32x4){PKW(pB0,8),PKW(pB0,10),PKW(pB0,12),PKW(pB0,14)};pw2=(u32x4){PKW(pB1,0),PKW(pB1,2),PKW(pB1,4),PKW(pB1,6)};pw3=(u32x4){PKW(pB1,8),PKW(pB1,10),PKW(pB1,12),PKW(pB1,14)};
    SBAR(); pv(o,vb0+sl_cur,PAF(0),PAF(1),PAF(2),PAF(3)); }
  #undef PKW
  #undef PAF
  #undef VFR
  #undef PIN
  #undef MX3
  #undef GAPA
  #undef GAPB
  #undef EX
  #undef VRD
  #undef KRD
  #undef STEP
  #undef ENDW
  {auto rr=__builtin_amdgcn_permlane32_swap(__float_as_uint(l_reg),__float_as_uint(l_reg),false,false);l_reg=__uint_as_float(rr[0])+__uint_as_float(rr[1]);}
  if(hi==0)wsf[32+r32]=l_reg;asm volatile("s_waitcnt lgkmcnt(0)":::"memory");
  float rli[16];
  #pragma unroll
  for(int r=0;r<16;++r)rli[r]=__builtin_amdgcn_rcpf(wsf[32+crow(r,hi)]);
  bf16*Ow=O+(rowbase+q0+wid*QBLK)*DMO+h*D;
  { bf16*stg=(bf16*)(shm+LDS_OST)+wid*2048;
    #pragma unroll
    for(int r=0;r<16;++r){const int orow=crow(r,hi);
      #pragma unroll
      for(int d0=0;d0<2;++d0)stg[orow*64+d0*32+r32]=__float2bfloat16(o[d0][r]*rli[r]);}
    asm volatile("s_waitcnt lgkmcnt(0)":::"memory");
    #pragma unroll
    for(int i=0;i<4;++i){const int row=i*8+(lane>>3),ch=lane&7; const u32x4 v=*(const u32x4*)(stg+row*64+ch*8); ATTN_STORE16(Ow+(long)row*DMO+ch*8,v);
      float q=0.f;
      #pragma unroll
      for(int e=0;e<4;++e){const float lo=__uint_as_float(v[e]<<16),hi2=__uint_as_float(v[e]&0xffff0000u);q+=lo*lo+hi2*hi2;}
      q+=__shfl_xor(q,1);q+=__shfl_xor(q,2);q+=__shfl_xor(q,4);
      if(ch==0)SSQA[(rowbase+q0+wid*QBLK+row)*8+h]=q;} }
  asm volatile("s_waitcnt lgkmcnt(0)\n\ts_barrier":::"memory");
  #undef BMASK
  #undef DMA_K
  #undef DMA_V
  #undef CMASK
  #undef START
  #undef RESC
  #undef ROT
}
constexpr int ATTN_LDS_BYTES=LDS_BYTES;
#undef SBAR
#undef WAIT_BAR
}

__global__ void __launch_bounds__(512, 2) mk_fwd(Args args) {
    extern __shared__ __attribute__((aligned(16))) unsigned char lds_raw[];
    Ctx C; C.lds = (LAS unsigned char*)lds_raw; C.tid = threadIdx.x; C.lane = C.tid & 63; C.wave = __builtin_amdgcn_readfirstlane(C.tid >> 6);
    C.G = gridDim.x; { const int bx = blockIdx.x; C.vcu = (C.G % 8 == 0) ? (bx % 8) * (C.G / 8) + bx / 8 : bx; }
    unsigned char* ws = args.ws;
    for (int u = C.tid; u < (LDS_BYTES - LDSCTL_OFF) / 4; u += 512) ((LAS unsigned*)(C.lds + LDSCTL_OFF))[u] = 0u;
    __syncthreads();
    XcdBarrier bar; bar.bar = (unsigned*)(ws + WS_CTL) + CW_BAR; bar.x = 0; bar.st = nullptr;
    if (N_LAUNCHES == 1) bar = xcd_barrier_post((unsigned*)(ws + WS_CTL) + CW_BAR, (volatile LAS unsigned*)(C.lds + MISC_OFF) + 8);
    const int lo = args.ph_lo, hi = args.ph_hi;
#define IN(k) (lo <= (k) && (k) < hi)
#define FRESH() do { int t_ = threadIdx.x; asm volatile("" : "+v"(t_)); C.tid = t_; C.lane = t_ & 63; C.wave = __builtin_amdgcn_readfirstlane(t_ >> 6); } while (0)
#define SEAM(k) do { if (IN(k) && IN((k) + 1)) xcd_barrier(bar); } while (0)
    const int cb = (int)blockIdx.x;

    if (IN(0)) { FRESH(); ph_prologue(args, C); SEAM(0); }
    if (IN(1)) {
        { Gemm g{(const bf16_t*)(ws + WS_B), (const bf16_t*)(ws + WS_WIN), DM, DM, DM}; PlainOrder S; S.init(NTOK, DIN, C.G, cb, DM, DM);
          EpiProj E{(bf16_t*)(ws + WS_A), (const float*)(ws + WS_ROPE), (float*)(ws + WS_KSUM)}; GEMM_PHASE(C.lds, g, S, E); }
        { Gemm g{(const bf16_t*)(ws + WS_MEMN), (const bf16_t*)(ws + WS_WXK), DM / 2, DM / 2, DM / 2}; PlainOrder S; S.init(NMEM, DM, C.G, cb, DM / 2, DM / 2);
          EpiStore E{(bf16_t*)(ws + WS_KM), DM, 1.0f / KV_SC}; GEMM_PHASE8(C.lds, g, S, E); }
        { Gemm g{(const bf16_t*)(ws + WS_MEMN), (const bf16_t*)(ws + WS_WXV), DM / 2, DM / 2, DM / 2}; PlainOrder S; S.init(NMEM, DM, C.G, (cb + C.G - 64 % C.G) % C.G, DM / 2, DM / 2);
          EpiStore E{(bf16_t*)(ws + WS_VMT), DM, 1.0f / KV_SC}; GEMM_PHASE8(C.lds, g, S, E); }
        { FRESH(); if (C.G == 256) { if (cb >= 128) conv_wdn(args, C, (cb - 128) * 8 + C.wave, 128 * 8, 0, WDN_SPLIT); }
          else conv_wdn(args, C, C.vcu * 8 + C.wave, C.G * 8, 0, WDN_SPLIT); }
        SEAM(1);
    }
    if (IN(2)) { FRESH();
        for (int i = 0;; ++i) { const int aidx = i * C.G + C.vcu; if (aidx >= 1024) break; const int cc = aidx & 255, ii = aidx >> 8, bh = cc >> 1;
            const int qb = (cc & 1) ? ((ii == 0) ? 6 : (ii == 1) ? 1 : (ii == 2) ? 5 : 2) : ((ii == 0) ? 7 : (ii == 1) ? 0 : (ii == 2) ? 4 : 3);
            { const attn_body::bf16* Qp = (const attn_body::bf16*)(ws + WS_A) + (size_t)2 * NTOK * 512;
              attn_body::attn_unit<8>(bh >> 3, bh & 7, qb, Qp, Qp + (size_t)NTOK * 512, Qp + (size_t)2 * NTOK * 512, (attn_body::bf16*)(ws + WS_C) + 512, (const float*)(ws + WS_KSUM), (float*)(ws + WS_SSQA), (char*)lds_raw); } }
        FRESH();
        for (int L = C.vcu; L < 256; L += C.G) lru_unit(args, C, L >> 4, (L >> 1) & 7, L & 1, L);
        SEAM(2);
    }
    if (IN(4)) { Gemm g{(const bf16_t*)(ws + WS_C), (const bf16_t*)(ws + WS_WOUT), DM, DM, DM}; PlainOrder S; S.init(NTOK, DM, C.G, cb, DM, DM);
        EpiResid<true, true> E{(const bf16_t*)(ws + WS_B), (bf16_t*)args.out, (float*)(ws + WS_SSQ1), (const float*)(ws + WS_SSQL), (const float*)(ws + WS_SSQA), ws + WS_A + 64 * MiB, 1.0f, (const float*)(ws + WS_TOK + TOK_D), args.in[2]};     GEMM_PHASE(C.lds, g, S, E);
        { Gemm g2{(const bf16_t*)ws, (const bf16_t*)ws, DM, DM, XHD}; XpreOrder S2{C.G, cb}; EpiStore8x E2{ws + WS_A, ws + WS_A + 32 * MiB, QKT_SC, VWT_SC}; GEMM_PHASE(C.lds, g2, S2, E2); }
        SEAM(4); }
    if (IN(5)) { Gemm g{(const bf16_t*)(ws + WS_A + 64 * MiB), (const bf16_t*)(ws + WS_A), DM / 2, DM / 2, DM / 2}; XattnOrder S{C.G, cb, 0, DM / 2, DM / 2};
        EpiSoftmax E{ws + WS_A + 96 * MiB, DM, C.lds + LDSCTL_OFF + 4096, (const float*)(ws + WS_SSQ1), XSCALE / QKT_SC}; GEMM_PHASE8N(C.lds, g, S, E); SEAM(5); }
    if (IN(8)) { Gemm g{(const bf16_t*)(ws + WS_A + 96 * MiB), (const bf16_t*)(ws + WS_A + 32 * MiB), DM / 2, DM / 2, DM / 2}; XattnOrder S{C.G, cb, 1, DM / 2, DM / 2};
        EpiResid<false, false> E{(const bf16_t*)args.out, (bf16_t*)args.out + DM, (float*)(ws + WS_SSQ2), nullptr, nullptr, ws + WS_H2F8, 1.0f / (PX_SC * VWT_SC)}; GEMM_PHASE8(C.lds, g, S, E); SEAM(8); }
    if (IN(9)) { FRESH(); ph_router(args, C); SEAM(9); }
    if (IN(11)) { FRESH(); moe_table(args, C); Gemm g{(const bf16_t*)(ws + WS_H2F8), (const bf16_t*)(ws + WS_WGU), DM / 2, DM / 2, DM / 2};
        MoeOrder<true> S{(const LAS int*)(C.lds + MOE_OFF), C.G, cb, DM / 2, DM / 2, (const int*)(ws + WS_LTOK), (unsigned)DM};
        EpiGateUp E{ws + WS_B, (const float*)(ws + WS_LRS)}; GEMM_PHASE8(C.lds, g, S, E); SEAM(11); }
    if (IN(12)) { FRESH(); moe_table(args, C); Gemm g{(const bf16_t*)(ws + WS_B), (const bf16_t*)(ws + WS_WDN), DFF / 2, DFF / 2, DFF / 2};
        MoeOrder<false> S{(const LAS int*)(C.lds + MOE_OFF), C.G, cb, DFF / 2, DFF / 2, nullptr, 0u};
        EpiStore8 E{ws + WS_A, DM, YB_SC / (WDN_SC * ACT_SC)}; GEMM_PHASE8(C.lds, g, S, E); SEAM(12); }
    if (IN(13)) { FRESH(); moe_table(args, C); ph_final(args, C, args.out); }
#undef IN
#undef FRESH
#undef SEAM
}

extern "C" void kernel_launch(void* const* d_in, const int* in_sizes, int n_in, void* d_out, int out_size, void* d_ws, size_t ws_size, hipStream_t stream) {
    static int grid = 0;
    if (grid == 0) {
        if (n_in != 27 || out_size != NTOK * DM || ws_size < WS_END) { fprintf(stderr, "kernel_launch: unexpected shapes (n_in %d out %d ws %zu)\n", n_in, out_size, ws_size); grid = -1; return; }
        int dev = 0, cus = 0, per_cu = 0;
        if (hipGetDevice(&dev) != hipSuccess || hipDeviceGetAttribute(&cus, hipDeviceAttributeMultiprocessorCount, dev) != hipSuccess) { grid = -1; return; }
        if (hipFuncSetAttribute((const void*)mk_fwd, hipFuncAttributeMaxDynamicSharedMemorySize, LDS_BYTES) != hipSuccess) { fprintf(stderr, "kernel_launch: hipFuncSetAttribute failed\n"); grid = -1; return; }
        if (hipOccupancyMaxActiveBlocksPerMultiprocessor(&per_cu, (const void*)mk_fwd, 512, LDS_BYTES) != hipSuccess || per_cu < 1) fprintf(stderr, "kernel_launch: occupancy query reports %d\n", per_cu);
        (void)hipGetLastError();
        grid = cus;
    }
    if (grid < 0) return;
    (void)hipMemsetAsync((char*)d_ws + WS_CTL, 0, CTL_ZERO_BYTES, stream);
    Args a{};
    for (int i = 0; i < 27; ++i) a.in[i] = (const float*)d_in[i];
    a.out = (float*)d_out; a.ws = (unsigned char*)d_ws;
    const float invf[8] = {1.0f, 0.1939227432012558f, 0.03760603070259094f, 0.007292664609849453f, 0.0014142135623842478f, 0.00027424818836152554f, 5.318296098266728e-05f, 1.0313386155758053e-05f};
    for (int i = 0; i < 8; ++i) a.invf[i] = invf[i];
    if (N_LAUNCHES == 1) { a.ph_lo = 0; a.ph_hi = N_PHASES; hipLaunchKernelGGL(mk_fwd, dim3(grid), dim3(512), LDS_BYTES, stream, a); }
    else for (int p = 0; p < N_PHASES; ++p) { a.ph_lo = p; a.ph_hi = p + 1; hipLaunchKernelGGL(mk_fwd, dim3(grid), dim3(512), LDS_BYTES, stream, a); }
}
```
